# Optimizing an MI355X kernel written in HIP

```python
import jax, jax.numpy as jnp
from jax import lax
import numpy as np

D_MODEL = 2048
BATCH = 4
SEQ = 4096
DEPTH = 4
DEC_BATCH = 8
DEC_SEQ = 4096
PAST_LEN = 128

N_META = 16
ML_HEADS = 4
ML_HEAD_DIM = 256
ML_WIDTH = ML_HEADS * ML_HEAD_DIM
ML_CHUNK = 64
META_PAD = ML_CHUNK - N_META
N_GATES = 4 * ML_HEADS
I_GATE_BIAS = 0.0
F_GATE_BIAS = 3.0
MLA_HEADS = 8
Q_LORA = 512
KV_LORA = 256
QK_NOPE = 128
QK_ROPE = 64
V_HEAD = 128
MLA_WIDTH = MLA_HEADS * V_HEAD
ROPE_THETA = 10000.0
ATTN_BLOCK = 128
MIX_WIDTH = ML_WIDTH + MLA_WIDTH
IN_COLS = 4 * ML_WIDTH + N_GATES + Q_LORA + KV_LORA + QK_ROPE
IN_SPLITS = (ML_WIDTH, 2 * ML_WIDTH, 3 * ML_WIDTH, 4 * ML_WIDTH,
             4 * ML_WIDTH + N_GATES,
             4 * ML_WIDTH + N_GATES + Q_LORA,
             4 * ML_WIDTH + N_GATES + Q_LORA + KV_LORA)
D_FF = 5632
CONV_W = 3
ALPHA = (2 * DEPTH) ** 0.25
BETA = (8 * DEPTH) ** -0.25
EPS = 1e-5
NEG = -1e30

kernel_name = 'hybrid_mlstm_mla_convffn_encoder'


def _layer_norm(x, g, b):
    xf = x.astype(jnp.float32)
    mu = jnp.mean(xf, axis=-1, keepdims=True)
    var = jnp.mean(jnp.square(xf - mu), axis=-1, keepdims=True)
    y = (xf - mu) * lax.rsqrt(var + EPS) * g.astype(jnp.float32) + b.astype(jnp.float32)
    return y.astype(x.dtype)


def _rms_norm(x, g):
    xf = x.astype(jnp.float32)
    y = xf * lax.rsqrt(jnp.mean(jnp.square(xf), axis=-1, keepdims=True) + EPS) * g.astype(jnp.float32)
    return y.astype(x.dtype)


def _rope_tables(seqlen):
    inv_freq = ROPE_THETA ** (-jnp.arange(0, QK_ROPE, 2, dtype=jnp.float32) / QK_ROPE)
    ang = jnp.arange(seqlen, dtype=jnp.float32)[:, None] * inv_freq[None, :]
    return jnp.cos(ang), jnp.sin(ang)


def _rope(x, cos, sin):
    half = QK_ROPE // 2
    xf = x.astype(jnp.float32)
    x1, x2 = xf[..., :half], xf[..., half:]
    return jnp.concatenate([x1 * cos - x2 * sin, x1 * sin + x2 * cos], axis=-1).astype(x.dtype)


def _mlstm_scan(q, k, v, log_i, log_f):
    bsz, nh, plen, dh = q.shape
    n_chunks = plen // ML_CHUNK

    def to_chunks(a):
        a = a.reshape(a.shape[:2] + (n_chunks, ML_CHUNK) + a.shape[3:])
        return jnp.moveaxis(a, 2, 0)

    lower = jnp.tril(jnp.ones((ML_CHUNK, ML_CHUNK), dtype=bool))

    def step(carry, inp):
        c_state, n_state, m_state = carry
        qc, kc, vc, lic, lfc = inp
        b = jnp.cumsum(lfc, axis=-1)
        d_mat = b[..., :, None] - b[..., None, :] + lic[..., None, :]
        d_mat = jnp.where(lower, d_mat, -jnp.inf)
        m_inter = b + m_state[..., None]
        m_t = jnp.maximum(m_inter, jnp.max(d_mat, axis=-1))
        w_inter = jnp.exp(m_inter - m_t)
        s = jnp.einsum('bhtd,bhsd->bhts', qc, kc) * jnp.exp(d_mat - m_t[..., None])
        num = (w_inter[..., None] * jnp.einsum('bhtd,bhde->bhte', qc, c_state)
               + jnp.einsum('bhts,bhse->bhte', s, vc))
        den = w_inter * jnp.einsum('bhtd,bhd->bht', qc, n_state) + jnp.sum(s, axis=-1)
        h = num / jnp.maximum(jnp.abs(den), jnp.exp(-m_t))[..., None]
        b_last = b[..., -1]
        g = b_last[..., None] - b + lic
        m_new = jnp.maximum(b_last + m_state, jnp.max(g, axis=-1))
        a = jnp.exp(b_last + m_state - m_new)
        w = jnp.exp(g - m_new[..., None])
        c_new = a[..., None, None] * c_state + jnp.einsum('bhs,bhsd,bhse->bhde', w, kc, vc)
        n_new = a[..., None] * n_state + jnp.einsum('bhs,bhsd->bhd', w, kc)
        return (c_new, n_new, m_new), h

    init = (jnp.zeros((bsz, nh, dh, dh), jnp.float32),
            jnp.zeros((bsz, nh, dh), jnp.float32),
            jnp.zeros((bsz, nh), jnp.float32))
    _, h = lax.scan(step, init, (to_chunks(q), to_chunks(k), to_chunks(v),
                                 to_chunks(log_i), to_chunks(log_f)))
    return jnp.moveaxis(h, 0, 2).reshape(bsz, nh, plen, dh)


def _mlstm_group(u_q, u_k, u_v, u_o, u_gate, b_gate, norm_g):
    bsz, seqlen, _ = u_q.shape
    f32 = jnp.float32

    def heads(a):
        return a.astype(f32).reshape(bsz, seqlen, ML_HEADS, ML_HEAD_DIM).transpose(0, 2, 1, 3)

    def pad(a, value=0.0):
        widths = ((0, 0), (0, 0), (META_PAD, 0)) + ((0, 0),) * (a.ndim - 3)
        return jnp.pad(a, widths, constant_values=value)

    def flip(a):
        return jnp.flip(a, axis=2)

    q = pad(heads(u_q))
    k = pad(heads(u_k) * ML_HEAD_DIM ** -0.5)
    v = pad(heads(u_v))
    gates = (u_gate.astype(f32) + b_gate.astype(f32)).transpose(0, 2, 1)
    i_fw, f_fw, i_bw, f_bw = jnp.split(gates, 4, axis=1)
    h_fw = _mlstm_scan(q, k, v, pad(i_fw, NEG), pad(jax.nn.log_sigmoid(f_fw)))
    h_bw = flip(_mlstm_scan(flip(q), flip(k), flip(v),
                            flip(pad(i_bw, NEG)), flip(pad(jax.nn.log_sigmoid(f_bw)))))
    h = (h_fw + h_bw)[:, :, META_PAD:]
    mu = jnp.mean(h, axis=-1, keepdims=True)
    var = jnp.mean(jnp.square(h - mu), axis=-1, keepdims=True)
    h = (h - mu) * lax.rsqrt(var + EPS) * norm_g.astype(f32).reshape(ML_HEADS, 1, ML_HEAD_DIM)
    h = h.transpose(0, 2, 1, 3).reshape(bsz, seqlen, ML_WIDTH)
    return (jax.nn.sigmoid(u_o.astype(f32)) * h).astype(u_o.dtype)


def _mla_group(u_dq, u_dkv, u_kr, q_norm_g, kv_norm_g, w_uq, w_ukv, cos, sin):
    bsz, seqlen, _ = u_dq.shape
    q = (_rms_norm(u_dq, q_norm_g) @ w_uq).reshape(bsz, seqlen, MLA_HEADS, QK_NOPE + QK_ROPE)
    q_nope = q[..., :QK_NOPE]
    q_rope = _rope(q[..., QK_NOPE:], cos[:, None, :], sin[:, None, :])
    kv = (_rms_norm(u_dkv, kv_norm_g) @ w_ukv).reshape(bsz, seqlen, MLA_HEADS, QK_NOPE + V_HEAD)
    k_nope, v = kv[..., :QK_NOPE], kv[..., QK_NOPE:]
    k_rope = _rope(u_kr, cos, sin)
    scale = (QK_NOPE + QK_ROPE) ** -0.5

    def attend(blk):
        qn, qr = blk
        s = (jnp.einsum('bthd,bshd->bhts', qn, k_nope)
             + jnp.einsum('bthd,bsd->bhts', qr, k_rope))
        p = jax.nn.softmax(s.astype(jnp.float32) * scale, axis=-1).astype(v.dtype)
        return jnp.einsum('bhts,bshd->bthd', p, v)

    o_meta = attend((q_nope[:, :N_META], q_rope[:, :N_META]))
    n_real = seqlen - N_META
    n_blocks = n_real // ATTN_BLOCK

    def to_blocks(a):
        a = a[:, N_META:].reshape((bsz, n_blocks, ATTN_BLOCK) + a.shape[2:])
        return jnp.moveaxis(a, 1, 0)

    o_real = lax.map(attend, (to_blocks(q_nope), to_blocks(q_rope)))
    o_real = jnp.moveaxis(o_real, 0, 1).reshape(bsz, n_real, MLA_HEADS, V_HEAD)
    return jnp.concatenate([o_meta, o_real], axis=1).reshape(bsz, seqlen, MLA_WIDTH)


def _dwconv(g, w, b):
    seqlen = g.shape[1]
    half = CONV_W // 2
    gp = jnp.pad(g, ((0, 0), (half, half), (0, 0)))
    out = gp[:, 0:seqlen] * w[0]
    for j in range(1, CONV_W):
        out = out + gp[:, j:j + seqlen] * w[j]
    return out + b


def _layer(h, cos, sin, w_in, b_gate, ml_norm_g, q_norm_g, kv_norm_g, w_uq, w_ukv, w_out,
           ln1_g, ln1_b, w_up, conv_w, conv_b, w_down, ln2_g, ln2_b):
    u = h @ w_in
    u_q, u_k, u_v, u_o, u_gate, u_dq, u_dkv, u_kr = jnp.split(u, IN_SPLITS, axis=-1)
    mix = jnp.concatenate([
        _mlstm_group(u_q, u_k, u_v, u_o, u_gate, b_gate, ml_norm_g),
        _mla_group(u_dq, u_dkv, u_kr, q_norm_g, kv_norm_g, w_uq, w_ukv, cos, sin),
    ], axis=-1) @ w_out
    h = _layer_norm(ALPHA * h + mix, ln1_g, ln1_b)
    gate, val = jnp.split(h @ w_up, 2, axis=-1)
    ffn = (jax.nn.silu(_dwconv(gate, conv_w, conv_b)) * val) @ w_down
    return _layer_norm(ALPHA * h + ffn, ln2_g, ln2_b)


def _trunk(x, meta_tokens, params):
    bsz = x.shape[0]
    meta = jnp.broadcast_to(meta_tokens.astype(x.dtype)[None], (bsz, N_META, D_MODEL))
    h = jnp.concatenate([meta, x], axis=1)
    cos, sin = _rope_tables(h.shape[1])
    for l in range(DEPTH):
        h = _layer(h, cos, sin, *[p[l] for p in params])
    return h[:, N_META:]


def setup_inputs(seed: int = 0) -> dict:
    key = jax.random.key(seed)
    ks = jax.random.split(key, 24)

    def nrm(k, shape, scale):
        return jax.random.normal(k, shape, jnp.float32) * scale

    gate_offset = jnp.repeat(jnp.array([I_GATE_BIAS, F_GATE_BIAS, I_GATE_BIAS, F_GATE_BIAS],
                                       jnp.float32), ML_HEADS)
    return {
        'x_prompt': nrm(ks[0], (BATCH, SEQ, D_MODEL), 1.0),
        'x_sample': nrm(ks[1], (DEC_BATCH, DEC_SEQ, D_MODEL), 1.0),
        'meta_tokens': nrm(ks[2], (N_META, D_MODEL), 1.0),
        'w_in': nrm(ks[3], (DEPTH, D_MODEL, IN_COLS), D_MODEL ** -0.5),
        'b_gates': gate_offset + nrm(ks[4], (DEPTH, N_GATES), 0.1),
        'ml_norm_g': 1.0 + nrm(ks[5], (DEPTH, ML_WIDTH), 0.02),
        'q_norm_g': 1.0 + nrm(ks[6], (DEPTH, Q_LORA), 0.02),
        'kv_norm_g': 1.0 + nrm(ks[7], (DEPTH, KV_LORA), 0.02),
        'w_uq': nrm(ks[8], (DEPTH, Q_LORA, MLA_HEADS * (QK_NOPE + QK_ROPE)), Q_LORA ** -0.5),
        'w_ukv': nrm(ks[9], (DEPTH, KV_LORA, MLA_HEADS * (QK_NOPE + V_HEAD)), KV_LORA ** -0.5),
        'w_out': nrm(ks[10], (DEPTH, MIX_WIDTH, D_MODEL), MIX_WIDTH ** -0.5 * BETA),
        'ln1_g': 1.0 + nrm(ks[11], (DEPTH, D_MODEL), 0.02),
        'ln1_b': nrm(ks[12], (DEPTH, D_MODEL), 0.02),
        'w_up': nrm(ks[13], (DEPTH, D_MODEL, 2 * D_FF), D_MODEL ** -0.5),
        'conv_w': nrm(ks[14], (DEPTH, CONV_W, D_FF), CONV_W ** -0.5),
        'conv_b': nrm(ks[15], (DEPTH, D_FF), 0.02),
        'w_down': nrm(ks[16], (DEPTH, D_FF, D_MODEL), D_FF ** -0.5 * BETA),
        'ln2_g': 1.0 + nrm(ks[17], (DEPTH, D_MODEL), 0.02),
        'ln2_b': nrm(ks[18], (DEPTH, D_MODEL), 0.02),
    }


def reference(x_prompt, x_sample, meta_tokens, w_in, b_gates, ml_norm_g, q_norm_g, kv_norm_g,
              w_uq, w_ukv, w_out, ln1_g, ln1_b, w_up, conv_w, conv_b, w_down, ln2_g, ln2_b):
    params = (w_in, b_gates, ml_norm_g, q_norm_g, kv_norm_g, w_uq, w_ukv, w_out,
              ln1_g, ln1_b, w_up, conv_w, conv_b, w_down, ln2_g, ln2_b)
    y_prompt = _trunk(x_prompt, meta_tokens, params)
    y_sample = _trunk(x_sample, meta_tokens, params)
    return (y_prompt, y_sample)
```

```cpp
#include <hip/hip_runtime.h>
#include <cstdio>
#include <cstdint>

#define LAS __attribute__((address_space(3)))
#define GAS __attribute__((address_space(1)))
typedef float f32x2 __attribute__((ext_vector_type(2)));
typedef float f32x8 __attribute__((ext_vector_type(8)));
typedef float f32x16 __attribute__((ext_vector_type(16)));
typedef unsigned u32x2 __attribute__((ext_vector_type(2)));
typedef short s16x4 __attribute__((ext_vector_type(4)));
typedef __bf16 bf16x2v __attribute__((ext_vector_type(2)));

constexpr int DM = 2048, NSEQ = 12, LREAL = 4096, NMETA = 16, DEPTH = 4;
constexpr int NMAIN = NSEQ * LREAL;
constexpr int MROW0 = NMAIN;
constexpr int NTOK = NMAIN + NSEQ * NMETA;
constexpr int NPAN = 193, TP = NPAN * 256;
constexpr int PMETA = 192;
constexpr int INC = 4944, NIN = 5120;
constexpr int DFF = 5632, NUP = 2 * DFF;
constexpr int MLW = 1024, NQ = 1536, NKV = 2048;
constexpr float ALPHA = 1.681792830507429f;
constexpr float EPS = 1e-5f;
constexpr float NEGBIG = -1e30f;

constexpr size_t MiB = 1u << 20;
constexpr size_t WS_CTL = 0, CTL_BYTES = 1 * MiB;
constexpr size_t WS_COS = 1 * MiB;
constexpr size_t WS_SIN = WS_COS + (size_t)4112 * 32 * 4;
constexpr size_t WS_PAR = 2 * MiB + 128 * 1024;
constexpr int PO_BG = 0, PO_MLG = PO_BG + DEPTH * 16, PO_QG = PO_MLG + DEPTH * 1024, PO_KVG = PO_QG + DEPTH * 512, PO_L1G = PO_KVG + DEPTH * 256, PO_L1B = PO_L1G + DEPTH * 2048,
              PO_CW = PO_L1B + DEPTH * 2048, PO_CB = PO_CW + DEPTH * 3 * 5632, PO_L2G = PO_CB + DEPTH * 5632, PO_L2B = PO_L2G + DEPTH * 2048, PO_ONE = PO_L2B + DEPTH * 2048, PO_ZERO = PO_ONE + 2048, PO_END = PO_ZERO + 2048;
static_assert(WS_PAR + (size_t)PO_END * 4 <= 3 * MiB && WS_PAR >= 1 * MiB + 2 * 4112 * 32 * 4, "PAR block placement");
constexpr size_t WS_WIN = 3 * MiB;
constexpr size_t WS_WUQ = WS_WIN + (size_t)NIN * DM * 2;
constexpr size_t WS_WUKV = WS_WUQ + (size_t)NQ * 512 * 2;
constexpr size_t WS_WOUT = WS_WUKV + (size_t)NKV * 256 * 2;
constexpr size_t WS_WUP = WS_WOUT + (size_t)DM * DM * 2;
constexpr size_t WS_WDN = WS_WUP + (size_t)NUP * DM * 2;
constexpr size_t WS_STAT1 = WS_WDN + (size_t)DM * DFF * 2;
constexpr size_t WS_STAT2 = WS_CTL + 512 * 1024;
constexpr size_t WS_H = 100 * MiB;
constexpr size_t WS_HB = WS_H + (size_t)TP * DM * 4;
constexpr size_t WS_R = WS_HB + (size_t)TP * DM * 2;
constexpr size_t WS_UQKVO = WS_R;
constexpr size_t WS_UDQ = WS_UQKVO + (size_t)TP * 4096 * 2;
constexpr size_t WS_UDKV = WS_UDQ + (size_t)TP * 512 * 2;
constexpr size_t WS_GATES = WS_UDKV + (size_t)TP * 256 * 2;
constexpr size_t WS_MKV = WS_GATES + (size_t)TP * 16 * 4;
constexpr size_t WS_KR = WS_MKV + (size_t)TP * NKV * 2;
constexpr size_t WS_RSTD = WS_KR + (size_t)TP * 64 * 2;
constexpr size_t WS_END_A = WS_RSTD + (size_t)TP * 2 * 4;
constexpr size_t WS_ACT = WS_R;
constexpr size_t WS_END_B = WS_ACT + (size_t)TP * DFF * 2;
constexpr size_t WS_NEED = (WS_END_A > WS_END_B ? WS_END_A : WS_END_B);
static_assert(WS_STAT1 + (size_t)TP * 8 <= WS_H && WS_STAT2 + (size_t)TP * 8 <= WS_CTL + CTL_BYTES, "weights and row statistics fit below H");
constexpr size_t DO_HSUM = 0;
constexpr size_t DO_MQ = DO_HSUM + (size_t)TP * MLW * 4;
constexpr size_t DO_GP = 340 * MiB;
constexpr size_t DO_SIDE = 0;
constexpr size_t DO_GVM = 32 * MiB;
static_assert(DO_MQ + (size_t)TP * NQ * 2 <= DO_GP && DO_GP + (size_t)96 * 65 * 200 * 4 <= (size_t)NMAIN * DM * 4 && (size_t)192 * 6 * DFF * 4 <= DO_GVM && DO_GVM + (size_t)256 * NUP * 2 <= (size_t)NMAIN * DM * 4, "d_out scratch fits");
constexpr int CW_BAR = 4096;

constexpr int RING_BYTES = 131072;
constexpr int MISC_OFF = RING_BYTES;
constexpr int LDS_BYTES = 147456;
constexpr int GRID = 256;

__device__ __forceinline__ int pos_of_row(int row) { return row < NMAIN ? NMETA + (row & (LREAL - 1)) : ((row - NMAIN) & (NMETA - 1)); }
__device__ __forceinline__ unsigned pk2(float lo, float hi) { f32x2 v = {lo, hi}; return __builtin_bit_cast(unsigned, __builtin_convertvector(v, bf16x2v)); }
__device__ __forceinline__ float bf_lo(unsigned w) { return __uint_as_float(w << 16); }
__device__ __forceinline__ float bf_hi(unsigned w) { return __uint_as_float(w & 0xffff0000u); }
__device__ __forceinline__ float wave_sum(float v) {
#pragma unroll
    for (int o = 1; o < 64; o <<= 1) v += __shfl_xor(v, o);
    return v;
}
__device__ __forceinline__ float wave_max(float v) {
#pragma unroll
    for (int o = 1; o < 64; o <<= 1) v = fmaxf(v, __shfl_xor(v, o));
    return v;
}
namespace pg8 {
#define PG8_LAS __attribute__((address_space(3)))
typedef unsigned short bf16_t;
typedef short bf16x8 __attribute__((ext_vector_type(8)));
typedef float f32x4 __attribute__((ext_vector_type(4)));
typedef unsigned u32x4 __attribute__((ext_vector_type(4)));
constexpr int BM = 256, BK = 64, HALF = 128, HTB = HALF * BK * 2  , STAGE_BYTES = 8 * HTB, NXCD = 8, WGM = 8;

__host__ __device__ __forceinline__ int lds_byte(int r, int c) { const int st = (r >> 4) * 2 + (c >> 5), rr = r & 15, cc = c & 31, ob = rr * 64 + cc * 2; return st * 1024 + (ob ^ (((ob >> 9) & 1) << 5)); }
__host__ __device__ __forceinline__ void stage_rc(int b, int& R, int& C) { const int st = b / 1024, sb = b % 1024, swz = sb ^ (((sb >> 9) & 1) << 5); R = (st >> 1) * 16 + swz / 64; C = (st & 1) * 32 + (swz % 64) / 2; }
__host__ __device__ __forceinline__ int perm32(int rho) { const int n = rho >> 4, i = rho & 15; return 8 * (i >> 2) + 4 * n + (i & 3); }

struct Unit { int pm, pn, kk; };
struct Gemm { const bf16_t* A; const bf16_t* Bt; int M, N, K, ld; };

struct PanelOrder {
    int nM, nN, nwg, G, c, nMain, pm0, pmx;
    __device__ void init(int nMain_, int pm0_, int extra, int pmx_, int N, int G_, int c_) { nMain = nMain_; pm0 = pm0_; pmx = pmx_; nM = nMain_ + extra; nN = N / BM; nwg = nM * nN; G = G_; c = c_; }
    __device__ bool next(int i, Unit& u) const {
        const long L = (long)i * G + c; if (L >= nwg) return false;
        int wgid = (int)L; { const int q = nwg / NXCD, r = nwg % NXCD, xcd = wgid % NXCD, off = wgid / NXCD; wgid = (xcd < r ? xcd * (q + 1) : r * (q + 1) + (xcd - r) * q) + off; }
        const int nig = WGM * nN, gid = wgid / nig, fm = gid * WGM, gsz = (nM - fm) < WGM ? (nM - fm) : WGM;
        const int pl = fm + ((wgid % nig) % gsz); u.pm = pl < nMain ? pm0 + pl : pmx; u.pn = (wgid % nig) / gsz; u.kk = 0; return true;
    }
    __device__ __forceinline__ void a_ready(const Unit&) const {}
    __device__ __forceinline__ void done(const Unit&) const {}
};

struct SplitOrder {
    int pm, nN, nwg, G, c;
    __device__ void init(int pm_, int N, int nsplit, int G_, int c_) { pm = pm_; nN = N / BM; nwg = nN * nsplit; G = G_; c = c_; }
    __device__ bool next(int i, Unit& u) const { const int L = i * G + c; if (L >= nwg) return false; u.pm = pm; u.pn = L % nN; u.kk = L / nN; return true; }
    __device__ __forceinline__ void a_ready(const Unit&) const {}
    __device__ __forceinline__ void done(const Unit&) const {}
};

__device__ __forceinline__ u32x4 pack8(const f32x4 v0, const f32x4 v1) { u32x4 w; w.x = pk2(v0[0], v0[1]); w.y = pk2(v0[2], v0[3]); w.z = pk2(v1[0], v1[1]); w.w = pk2(v1[2], v1[3]); return w; }

struct EpiBf16G {
    static constexpr bool PERM = true, AFTER_DRAIN = false;
    bf16_t* O; int ldc; const float* rs; int pm_sub, pm_sp, pm_sp_out;
    __device__ __forceinline__ void operator()(const f32x4 (&acc)[2][2][4][2], const Unit& u, int wr, int wc, int fr, int fq) const {
        const int opm = (u.pm == pm_sp) ? pm_sp_out : u.pm - pm_sub;
        const int rin = u.pm * BM + wr * 64 + fr, rout = opm * BM + wr * 64 + fr, col0 = u.pn * BM + wc * 32 + 8 * fq;
#pragma unroll
        for (int ai = 0; ai < 2; ++ai)
#pragma unroll
            for (int m = 0; m < 4; ++m) { const float sc = rs ? rs[(size_t)(rin + ai * HALF + m * 16) * 2] : 1.f;
                bf16_t* rowp = O + (size_t)(rout + ai * HALF + m * 16) * ldc + col0;
#pragma unroll
                for (int bj = 0; bj < 2; ++bj) *(u32x4*)(rowp + bj * HALF) = pack8(acc[ai][bj][m][0] * sc, acc[ai][bj][m][1] * sc); }
    }
};
struct EpiWin {
    static constexpr bool PERM = true, AFTER_DRAIN = false;
    bf16_t *UQKVO, *UDQ, *UDKV, *KR; float* GATES; const float *COS, *SIN;
    __device__ __forceinline__ void operator()(const f32x4 (&acc)[2][2][4][2], const Unit& u, int wr, int wc, int fr, int fq) const {
        const int row0 = u.pm * BM + wr * 64 + fr;
        if (u.pn < 19) {
            bf16_t* base; int ldc, colt;
            if (u.pn < 16) { base = UQKVO; ldc = 4096; colt = u.pn * BM; } else if (u.pn < 18) { base = UDQ; ldc = 512; colt = (u.pn - 16) * BM; } else { base = UDKV; ldc = 256; colt = 0; }
            const int col0 = colt + wc * 32 + 8 * fq;
#pragma unroll
            for (int ai = 0; ai < 2; ++ai)
#pragma unroll
                for (int m = 0; m < 4; ++m) { bf16_t* rowp = base + (size_t)(row0 + ai * HALF + m * 16) * ldc + col0;
#pragma unroll
                    for (int bj = 0; bj < 2; ++bj) *(u32x4*)(rowp + bj * HALF) = pack8(acc[ai][bj][m][0], acc[ai][bj][m][1]); }
        } else {
            if (wc < 2) { const int g = 4 * wc + fq;
#pragma unroll
                for (int ai = 0; ai < 2; ++ai)
#pragma unroll
                    for (int m = 0; m < 4; ++m) { const int row = row0 + ai * HALF + m * 16, pos = pos_of_row(row);
                        const f32x4 cs = *(const f32x4*)(COS + pos * 32 + 4 * g), sn = *(const f32x4*)(SIN + pos * 32 + 4 * g);
                        const f32x4 x1 = acc[ai][0][m][0], x2 = acc[ai][0][m][1];
                        *(u32x4*)(KR + (size_t)row * 64 + 8 * g) = pack8(x1 * cs - x2 * sn, x1 * sn + x2 * cs); }
            } else if (wc == 2 && fq < 2) {
#pragma unroll
                for (int ai = 0; ai < 2; ++ai)
#pragma unroll
                    for (int m = 0; m < 4; ++m) { float* gp = GATES + (size_t)(row0 + ai * HALF + m * 16) * 16 + 8 * fq;
                        *(f32x4*)gp = acc[ai][0][m][0]; *(f32x4*)(gp + 4) = acc[ai][0][m][1]; }
            }
        }
    }
};
struct EpiQ {
    static constexpr bool PERM = true, AFTER_DRAIN = false;
    bf16_t* MQ; const float *RSTD, *COS, *SIN;
    __device__ __forceinline__ void operator()(const f32x4 (&acc)[2][2][4][2], const Unit& u, int wr, int wc, int fr, int fq) const {
        const int row0 = u.pm * BM + wr * 64 + fr, colb = u.pn * BM + wc * 32 + 8 * fq;
#pragma unroll
        for (int ai = 0; ai < 2; ++ai)
#pragma unroll
            for (int m = 0; m < 4; ++m) { const int row = row0 + ai * HALF + m * 16, pos = pos_of_row(row); const float sc = RSTD[(size_t)row * 2];
#pragma unroll
                for (int bj = 0; bj < 2; ++bj) { const int col0 = colb + bj * HALF, o = col0 % 192;
                    f32x4 v0 = acc[ai][bj][m][0] * sc, v1 = acc[ai][bj][m][1] * sc;
                    if (o >= 128) { const int g = (o - 128) >> 3; const f32x4 cs = *(const f32x4*)(COS + pos * 32 + 4 * g), sn = *(const f32x4*)(SIN + pos * 32 + 4 * g);
                        const f32x4 x1 = v0, x2 = v1; v0 = x1 * cs - x2 * sn; v1 = x1 * sn + x2 * cs; }
                    *(u32x4*)(MQ + (size_t)row * NQ + col0) = pack8(v0, v1); } }
    }
};
__device__ __forceinline__ void resid_ln_tile(float* __restrict__ Cw, const float* __restrict__ Cr, const float* __restrict__ st, const float* __restrict__ g, const float* __restrict__ b,
                                              int ldc, float alpha, const f32x4 (&acc)[2][2][4][2], int row0, int col0) {
    asm volatile("" ::: "memory");
#pragma unroll
    for (int ai = 0; ai < 2; ++ai)
#pragma unroll
        for (int bj = 0; bj < 2; ++bj) {
            f32x4 gv[2], bv[2], hv[4][2]; f32x2 ms[4];
#pragma unroll
            for (int n = 0; n < 2; ++n) { gv[n] = *(const f32x4*)(g + col0 + bj * HALF + n * 16) * alpha; bv[n] = *(const f32x4*)(b + col0 + bj * HALF + n * 16) * alpha; }
#pragma unroll
            for (int m = 0; m < 4; ++m) { const int row = row0 + ai * HALF + m * 16; ms[m] = *(const f32x2*)(st + (size_t)row * 2);
#pragma unroll
                for (int n = 0; n < 2; ++n) hv[m][n] = *(const f32x4*)(Cr + (size_t)row * ldc + col0 + bj * HALF + n * 16); }
#pragma unroll
            for (int m = 0; m < 4; ++m) { const int row = row0 + ai * HALF + m * 16;
#pragma unroll
                for (int n = 0; n < 2; ++n) *(f32x4*)(Cw + (size_t)row * ldc + col0 + bj * HALF + n * 16) = (hv[m][n] - ms[m][0]) * ms[m][1] * gv[n] + bv[n] + acc[ai][bj][m][n]; }
        }
}
struct EpiResidLn {
    static constexpr bool PERM = false, AFTER_DRAIN = false;
    float* C; int ldc; float alpha; const float* st; const float* g; const float* b;
    __device__ __forceinline__ void operator()(const f32x4 (&acc)[2][2][4][2], const Unit& u, int wr, int wc, int fr, int fq) const {
        resid_ln_tile(this->C, this->C, this->st, this->g, this->b, this->ldc, this->alpha, acc, u.pm * BM + wr * 64 + fr, u.pn * BM + wc * 32 + 4 * fq);
    }
};
struct EpiAtomic {
    static constexpr bool PERM = false, AFTER_DRAIN = false;
    float* C; int ldc;
    __device__ __forceinline__ void operator()(const f32x4 (&acc)[2][2][4][2], const Unit& u, int wr, int wc, int fr, int fq) const {
        const int row0 = u.pm * BM + wr * 64 + fr, col0 = u.pn * BM + wc * 32 + 4 * fq;
#pragma unroll
        for (int ai = 0; ai < 2; ++ai)
#pragma unroll
            for (int m = 0; m < 4; ++m) { float* rowp = C + (size_t)(row0 + ai * HALF + m * 16) * ldc + col0;
#pragma unroll
                for (int bj = 0; bj < 2; ++bj)
#pragma unroll
                    for (int n = 0; n < 2; ++n) { float* p = rowp + bj * HALF + n * 16;
#pragma unroll
                        for (int e = 0; e < 4; ++e) unsafeAtomicAdd(p + e, acc[ai][bj][m][n][e]); } }
    }
};

__device__ __forceinline__ float dpp_ror1(float x) { return __int_as_float(__builtin_amdgcn_mov_dpp(__float_as_int(x), 0x121, 0xf, 0xf, false)); }
__device__ __forceinline__ float dpp_ror15(float x) { return __int_as_float(__builtin_amdgcn_mov_dpp(__float_as_int(x), 0x12f, 0xf, 0xf, false)); }
struct EpiFfn {
    static constexpr bool PERM = true, AFTER_DRAIN = false;
    bf16_t* ACT; float* SIDE; bf16_t* GVM; const float *cw, *cb; PG8_LAS float* X;
    __device__ __forceinline__ void operator()(const f32x4 (&acc)[2][2][4][2], const Unit& u, int wr_in, int wc_in, int fr_in, int fq_in) const {
        int fr = fr_in, fq = fq_in, wr = wr_in, wc = wc_in; asm volatile("" : "+v"(fr), "+v"(fq), "+s"(wr), "+s"(wc));
        const int cj = wc * 32 + 8 * fq, c0 = u.pn * 128 + cj;
        if (u.pm == PMETA) {
#pragma unroll
            for (int ai = 0; ai < 2; ++ai)
#pragma unroll
                for (int m = 0; m < 4; ++m) { bf16_t* rowp = GVM + (size_t)(ai * HALF + wr * 64 + m * 16 + fr) * NUP + c0;
                    *(u32x4*)rowp = pack8(acc[ai][0][m][0], acc[ai][0][m][1]); *(u32x4*)(rowp + DFF) = pack8(acc[ai][1][m][0], acc[ai][1][m][1]); }
            return;
        }
        f32x4 w0[2], w1[2], w2[2], bb[2];
#pragma unroll
        for (int n = 0; n < 2; ++n) { w0[n] = *(const f32x4*)(cw + c0 + 4 * n); w1[n] = *(const f32x4*)(cw + DFF + c0 + 4 * n); w2[n] = *(const f32x4*)(cw + 2 * DFF + c0 + 4 * n); bb[n] = *(const f32x4*)(cb + c0 + 4 * n); }
#pragma unroll
        for (int ai = 0; ai < 2; ++ai) { const int b = 2 * ai + wr;
            if (fr == 0) { *(PG8_LAS f32x4*)(X + (b * 2 + 0) * 128 + cj) = acc[ai][0][0][0]; *(PG8_LAS f32x4*)(X + (b * 2 + 0) * 128 + cj + 4) = acc[ai][0][0][1]; }
            if (fr == 15) { *(PG8_LAS f32x4*)(X + (b * 2 + 1) * 128 + cj) = acc[ai][0][3][0]; *(PG8_LAS f32x4*)(X + (b * 2 + 1) * 128 + cj + 4) = acc[ai][0][3][1]; } }
        asm volatile("s_waitcnt lgkmcnt(0)" ::: "memory"); __builtin_amdgcn_s_barrier(); asm volatile("" ::: "memory");
        const bool is15 = fr == 15, is0 = fr == 0;
        const unsigned rowb = (unsigned)(u.pm * BM + wr * 64 + fr) * DFF + c0;
#pragma unroll
        for (int ai = 0; ai < 2; ++ai) { const int b = 2 * ai + wr;
            f32x4 xp[2], xn[2];
#pragma unroll
            for (int n = 0; n < 2; ++n) { xp[n] = b > 0 ? *(const PG8_LAS f32x4*)(X + ((b - 1) * 2 + 1) * 128 + cj + 4 * n) : (f32x4){0.f, 0.f, 0.f, 0.f};
                                          xn[n] = b < 3 ? *(const PG8_LAS f32x4*)(X + ((b + 1) * 2 + 0) * 128 + cj + 4 * n) : (f32x4){0.f, 0.f, 0.f, 0.f}; }
#pragma unroll
            for (int m = 0; m < 4; ++m) { u32x4 ow;
#pragma unroll
                for (int n = 0; n < 2; ++n) { f32x4 o;
#pragma unroll
                    for (int e = 0; e < 4; ++e) { const float g = acc[ai][0][m][n][e];
                        const float gup = m > 0 ? acc[ai][0][m > 0 ? m - 1 : 0][n][e] : xp[n][e], gdn = m < 3 ? acc[ai][0][m < 3 ? m + 1 : 3][n][e] : xn[n][e];
                        const float pv = dpp_ror1(is15 ? gup : g);
                        const float nx = dpp_ror15(is0 ? gdn : g);
                        const float x = w0[n][e] * pv + w1[n][e] * g + w2[n][e] * nx + bb[n][e];
                        o[e] = x * __builtin_amdgcn_rcpf(1.f + __expf(-x)) * acc[ai][1][m][n][e]; }
                    if (n == 0) { ow.x = pk2(o[0], o[1]); ow.y = pk2(o[2], o[3]); } else { ow.z = pk2(o[0], o[1]); ow.w = pk2(o[2], o[3]); } }
                bf16_t* dst = ACT + (rowb + (unsigned)(ai * HALF + m * 16) * DFF);
                if ((ai == 0 && m == 0) || (ai == 1 && m == 3)) {
                    const int r = ai * HALF + wr * 64 + m * 16 + fr;
                    if (r != 0 && r != 255) *(u32x4*)dst = ow;
                    const int slot = r == 0 ? 0 : r == 1 ? 1 : r == 254 ? 2 : r == 255 ? 3 : -1;
                    if (slot >= 0) { float* sp = SIDE + ((size_t)u.pm * 6 + slot) * DFF + c0; *(f32x4*)sp = acc[ai][0][m][0]; *(f32x4*)(sp + 4) = acc[ai][0][m][1];
                        if (slot == 0 || slot == 3) { float* vp = SIDE + ((size_t)u.pm * 6 + (slot == 0 ? 4 : 5)) * DFF + c0; *(f32x4*)vp = acc[ai][1][m][0]; *(f32x4*)(vp + 4) = acc[ai][1][m][1]; } }
                } else *(u32x4*)dst = ow;
            }
        }
    }
};
template <class Epi, class Sched, bool ALIGN_EPI = false, bool SP2 = false>
__device__ __forceinline__ void gemm_phase(PG8_LAS unsigned char* lds, const Gemm g, const Sched& S, const Epi& E) {
    int tid_ = threadIdx.x; asm volatile("" : "+v"(tid_));
    const int tid = tid_, wid = __builtin_amdgcn_readfirstlane(tid >> 6), lane = tid & 63, wr = wid >> 2, wc = wid & 3, fr = lane & 15, fq = lane >> 4;
    const int K = g.ld, nt = g.K / BK;
    unsigned voffA[2], voffB[2];
#pragma unroll
    for (int i = 0; i < 2; ++i) { int R, C; stage_rc(tid * 16 + i * 8192, R, C); const int Rb = Epi::PERM ? ((R & ~31) + perm32(R & 31)) : R;
        voffA[i] = (unsigned)(R * K + C) * 2u; voffB[i] = (unsigned)(Rb * K + C) * 2u; }
    const size_t kstep = (size_t)(BK * 2);
    const size_t hstep = (size_t)HALF * K * 2;
    const size_t tstep = 2 * hstep;
    const unsigned ldsw = (unsigned)wid * 1024u;
    const int aoff = lds_byte(wr * 64 + fr, fq * 8), boff = lds_byte(wc * 32 + fr, fq * 8);
#define PG8_SA(b, h) (((b) * 2 + (h)) * HTB)
#define PG8_SB(b, h) ((4 + (b) * 2 + (h)) * HTB)
#define PG8_STAGE(bufoff, gbase, voff) do { _Pragma("unroll") for (int _i = 0; _i < 2; ++_i) \
        __builtin_amdgcn_global_load_lds((const unsigned*)((const char*)(gbase) + (voff)[_i]), (PG8_LAS unsigned*)(lds + (bufoff) + ldsw + _i * 8192), 16, 0, 0); } while (0)
#define PG8_LDA(dst, b, h) do { _Pragma("unroll") for (int m = 0; m < 4; ++m) _Pragma("unroll") for (int k = 0; k < 2; ++k) dst[m][k] = *(const PG8_LAS bf16x8*)(lds + PG8_SA(b, h) + aoff + m * 2048 + k * 1024); } while (0)
#define PG8_LDB(dst, b, h) do { _Pragma("unroll") for (int n = 0; n < 2; ++n) _Pragma("unroll") for (int k = 0; k < 2; ++k) dst[n][k] = *(const PG8_LAS bf16x8*)(lds + PG8_SB(b, h) + boff + n * 2048 + k * 1024); } while (0)
#define PG8_MMA(ai, bj, At, Bt) do { __builtin_amdgcn_s_setprio(1); _Pragma("unroll") for (int m = 0; m < 4; ++m) _Pragma("unroll") for (int n = 0; n < 2; ++n) _Pragma("unroll") for (int k = 0; k < 2; ++k) \
        acc[ai][bj][m][n] = __builtin_amdgcn_mfma_f32_16x16x32_bf16(Bt[n][k], At[m][k], acc[ai][bj][m][n], 0, 0, 0); __builtin_amdgcn_s_setprio(0); } while (0)
#define PG8_WAIT_V(n) asm volatile("s_waitcnt vmcnt(" #n ")" ::: "memory")
#define PG8_WAIT_L(n) asm volatile("s_waitcnt lgkmcnt(" #n ")" ::: "memory")
#define PG8_BAR __builtin_amdgcn_s_barrier()
#define PG8_SCHED __builtin_amdgcn_sched_barrier(0)
    Unit cur, nxt; int ui = 0;
    if (!S.next(0, cur)) return;
    f32x4 acc[2][2][4][2];
#pragma unroll
    for (int a = 0; a < 2; ++a)
#pragma unroll
        for (int b = 0; b < 2; ++b)
#pragma unroll
            for (int m = 0; m < 4; ++m)
#pragma unroll
                for (int n = 0; n < 2; ++n) acc[a][b][m][n] = (f32x4){0.f, 0.f, 0.f, 0.f};
    bf16x8 At[4][2], B0[2][2], B1[2][2];
    const size_t sstep = (size_t)g.K * 2;
    const char* cA = (const char*)g.A + (size_t)cur.pm * tstep + (size_t)cur.kk * sstep; const char* cB = (const char*)g.Bt + (size_t)cur.pn * tstep + (size_t)cur.kk * sstep;
    S.a_ready(cur);
    if constexpr (SP2) {
        PG8_STAGE(PG8_SB(0, 0), cB, voffB); PG8_STAGE(PG8_SB(0, 1), cB + hstep, voffB); PG8_STAGE(PG8_SA(0, 0), cA, voffA); PG8_STAGE(PG8_SA(0, 1), cA + hstep, voffA);
        if (wr == 1) PG8_BAR;
        PG8_WAIT_V(2); PG8_BAR;
        PG8_STAGE(PG8_SB(1, 0), cB + kstep, voffB); PG8_STAGE(PG8_SA(1, 0), cA + kstep, voffA); PG8_STAGE(PG8_SB(1, 1), cB + hstep + kstep, voffB);
        PG8_WAIT_V(6); PG8_BAR;
    } else {
        PG8_STAGE(PG8_SB(0, 0), cB, voffB); PG8_STAGE(PG8_SA(0, 0), cA, voffA); PG8_STAGE(PG8_SB(0, 1), cB + hstep, voffB); PG8_STAGE(PG8_SA(0, 1), cA + hstep, voffA);
        if (wr == 1) PG8_BAR;
        PG8_WAIT_V(4); PG8_BAR;
        PG8_STAGE(PG8_SB(1, 0), cB + kstep, voffB); PG8_STAGE(PG8_SA(1, 0), cA + kstep, voffA); PG8_STAGE(PG8_SB(1, 1), cB + hstep + kstep, voffB);
        PG8_WAIT_V(6); PG8_BAR;
    }
    for (;;) {
        const bool has_next = S.next(ui + 1, nxt);
        const char* nA = has_next ? (const char*)g.A + (size_t)nxt.pm * tstep + (size_t)nxt.kk * sstep : cA; const char* nB = has_next ? (const char*)g.Bt + (size_t)nxt.pn * tstep + (size_t)nxt.kk * sstep : cB;
        for (int t = 0; t < nt; t += 2) {
            const bool last = (t == nt - 2);
            const char* a1 = cA + (size_t)(t + 1) * kstep;
            const char* a2 = last ? nA : cA + (size_t)(t + 2) * kstep; const char* b2 = last ? nB : cB + (size_t)(t + 2) * kstep;
            const char* a3 = a2 + kstep; const char* b3 = b2 + kstep;
            if (last && has_next) S.a_ready(nxt);
            if constexpr (SP2) {
            PG8_LDB(B0, 0, 0); PG8_LDB(B1, 0, 1); PG8_SCHED; PG8_LDA(At, 0, 0); PG8_STAGE(PG8_SA(1, 1), a1 + hstep, voffA);
            PG8_WAIT_V(8); PG8_WAIT_L(0); PG8_BAR; PG8_MMA(0, 0, At, B0); PG8_MMA(0, 1, At, B1); PG8_BAR; PG8_SCHED;
            PG8_LDA(At, 0, 1); PG8_STAGE(PG8_SB(0, 0), b2, voffB); PG8_STAGE(PG8_SB(0, 1), b2 + hstep, voffB); PG8_STAGE(PG8_SA(0, 0), a2, voffA);
            PG8_WAIT_V(8); PG8_WAIT_L(0); PG8_BAR; PG8_MMA(1, 0, At, B0); PG8_MMA(1, 1, At, B1); PG8_BAR; PG8_SCHED;
            PG8_LDB(B0, 1, 0); PG8_LDB(B1, 1, 1); PG8_SCHED; PG8_LDA(At, 1, 0); PG8_STAGE(PG8_SA(0, 1), a2 + hstep, voffA);
            PG8_WAIT_V(8); PG8_WAIT_L(0); PG8_BAR; PG8_MMA(0, 0, At, B0); PG8_MMA(0, 1, At, B1); PG8_BAR; PG8_SCHED;
            PG8_LDA(At, 1, 1); PG8_STAGE(PG8_SB(1, 0), b3, voffB); PG8_STAGE(PG8_SB(1, 1), b3 + hstep, voffB); PG8_STAGE(PG8_SA(1, 0), a3, voffA);
            PG8_WAIT_V(8); PG8_WAIT_L(0); PG8_BAR; PG8_MMA(1, 0, At, B0); PG8_MMA(1, 1, At, B1); PG8_BAR; PG8_SCHED;
            } else {
            PG8_LDB(B0, 0, 0); PG8_SCHED; PG8_LDA(At, 0, 0); PG8_STAGE(PG8_SA(1, 1), a1 + hstep, voffA);
            PG8_WAIT_L(8); PG8_BAR; PG8_WAIT_L(0); PG8_MMA(0, 0, At, B0); PG8_BAR; PG8_SCHED;
            PG8_LDB(B1, 0, 1); PG8_STAGE(PG8_SB(0, 0), b2, voffB);
            PG8_BAR; PG8_WAIT_L(0); PG8_MMA(0, 1, At, B1); PG8_BAR;
            PG8_LDA(At, 0, 1); PG8_STAGE(PG8_SA(0, 0), a2, voffA);
            PG8_BAR; PG8_WAIT_L(0); PG8_MMA(1, 0, At, B0); PG8_BAR; PG8_SCHED;
            PG8_STAGE(PG8_SB(0, 1), b2 + hstep, voffB);
            PG8_WAIT_V(6); PG8_BAR; PG8_MMA(1, 1, At, B1); PG8_BAR;
            PG8_LDB(B0, 1, 0); PG8_SCHED; PG8_LDA(At, 1, 0); PG8_STAGE(PG8_SA(0, 1), a2 + hstep, voffA);
            PG8_WAIT_L(8); PG8_BAR; PG8_WAIT_L(0); PG8_MMA(0, 0, At, B0); PG8_BAR; PG8_SCHED;
            PG8_LDB(B1, 1, 1); PG8_STAGE(PG8_SB(1, 0), b3, voffB);
            PG8_BAR; PG8_WAIT_L(0); PG8_MMA(0, 1, At, B1); PG8_BAR;
            PG8_LDA(At, 1, 1); PG8_STAGE(PG8_SA(1, 0), a3, voffA);
            PG8_BAR; PG8_WAIT_L(0); PG8_MMA(1, 0, At, B0); PG8_BAR; PG8_SCHED;
            PG8_STAGE(PG8_SB(1, 1), b3 + hstep, voffB);
            PG8_WAIT_V(6); PG8_BAR; PG8_MMA(1, 1, At, B1); PG8_BAR;
            }
        }
        if constexpr (ALIGN_EPI) { if (wr == 0) PG8_BAR; }
        if constexpr (!Epi::AFTER_DRAIN) { E(acc, cur, wr, wc, fr, fq); S.done(cur); }
        if (!has_next) break;
#pragma unroll
        for (int a = 0; a < 2; ++a)
#pragma unroll
            for (int b = 0; b < 2; ++b)
#pragma unroll
                for (int m = 0; m < 4; ++m)
#pragma unroll
                    for (int n = 0; n < 2; ++n) acc[a][b][m][n] = (f32x4){0.f, 0.f, 0.f, 0.f};
        cur = nxt; cA = nA; cB = nB; ++ui;
        if constexpr (ALIGN_EPI) { if (wr == 1) PG8_BAR; }
    }
    PG8_WAIT_V(0);
    if constexpr (!ALIGN_EPI) { if (wr == 0) PG8_BAR; }
    PG8_BAR;
    if constexpr (Epi::AFTER_DRAIN) { E.fused(acc, cur, wr, wc, fr, fq, lds, wid, lane); S.done(cur); }
#undef PG8_SA
#undef PG8_SB
#undef PG8_STAGE
#undef PG8_LDA
#undef PG8_LDB
#undef PG8_MMA
#undef PG8_WAIT_V
#undef PG8_WAIT_L
#undef PG8_BAR
#undef PG8_SCHED
}
}
#define XB_TMO      128
#define XB_XCNT(j)  (256  + 64 * (j))
#define XB_XSUB(j)  (1280 + 64 * (j))
#define XB_XGEN(j)  (2304 + 64 * (j))
#define XB_TOP      3328
#define XB_TOPGEN   3392
#define XCD_BAR_WORDS 3456
#define XB_SPIN_CAP (1u << 21)

__device__ __forceinline__ unsigned xb_ld(unsigned* p)              { return __hip_atomic_load(p, __ATOMIC_RELAXED, __HIP_MEMORY_SCOPE_AGENT); }
__device__ __forceinline__ unsigned xb_add(unsigned* p, unsigned v) { return __hip_atomic_fetch_add(p, v, __ATOMIC_RELAXED, __HIP_MEMORY_SCOPE_AGENT); }
__device__ __forceinline__ unsigned xb_xcc_id() { return (unsigned)__builtin_amdgcn_s_getreg((3 << 11) | 20) & 0xFu; }
#define XB_SPIN(cond, bar) do { unsigned _sp = 0; while (cond) { __builtin_amdgcn_s_sleep(1); \
    if ((++_sp & 255u) == 0u) { if (xb_ld(&(bar)[XB_TMO])) break; if (_sp > XB_SPIN_CAP) { atomicAdd(&(bar)[XB_TMO], 1u); break; } } } } while (0)

struct XcdBarrier {
    unsigned* bar; unsigned x;
    volatile LAS unsigned* st;
};

__device__ __forceinline__ XcdBarrier xcd_barrier_post(unsigned* bar, volatile LAS unsigned* st) {
    XcdBarrier b; b.bar = bar; b.x = (unsigned)__builtin_amdgcn_readfirstlane((int)xb_xcc_id()); b.st = st;
    if (threadIdx.x == 0) (void)xb_add(&bar[XB_XCNT(b.x)], 1u);
    return b;
}
__device__ __forceinline__ void xcd_barrier_complete(unsigned* bar, unsigned x, unsigned& nloc, unsigned& nx) {
    const unsigned G = gridDim.x * gridDim.y * gridDim.z;
    unsigned sum, cnt, mine, sp = 0u;
    for (;;) {
        sum = 0u; cnt = 0u; mine = 0u;
#pragma unroll
        for (unsigned j = 0; j < 16; ++j) { const unsigned c = xb_ld(&bar[XB_XCNT(j)]); sum += c; cnt += (c > 0u) ? 1u : 0u; }
        mine = xb_ld(&bar[XB_XCNT(x)]);
        if (sum == G) { mine = xb_ld(&bar[XB_XCNT(x)]); break; }
        __builtin_amdgcn_s_sleep(1);
        if ((++sp & 255u) == 0u) { if (xb_ld(&bar[XB_TMO])) break; if (sp > XB_SPIN_CAP) { atomicAdd(&bar[XB_TMO], 1u); break; } }
    }
    nloc = mine > 0u ? mine : 1u; nx = cnt > 0u ? cnt : 1u;
}

__device__ __forceinline__ void xcd_barrier(const XcdBarrier& b) {
    asm volatile("s_waitcnt vmcnt(0)" ::: "memory");
    __syncthreads();
    if (threadIdx.x == 0) {
        unsigned* bar = b.bar; unsigned bx_ = b.x;
        asm volatile("" : "+s"(bx_));
        __builtin_amdgcn_s_waitcnt(0);
        unsigned nloc = b.st[0], nx = b.st[1];
        if (nloc == 0u) { xcd_barrier_complete(bar, bx_, nloc, nx); b.st[0] = nloc; b.st[1] = nx; }
        const unsigned old = xb_add(&bar[XB_XSUB(bx_)], 1u);
        const unsigned gen = old / nloc;
        if (old + 1u == (gen + 1u) * nloc) {
            __builtin_amdgcn_fence(__ATOMIC_RELEASE, "agent");
            asm volatile("s_waitcnt vmcnt(0)" ::: "memory");
            const unsigned og = xb_add(&bar[XB_TOP], 1u);
            const unsigned tg = og / nx;
            if (og + 1u == (tg + 1u) * nx) xb_add(&bar[XB_TOPGEN], 1u);
            else XB_SPIN(xb_ld(&bar[XB_TOPGEN]) == tg, bar);
            __builtin_amdgcn_fence(__ATOMIC_ACQUIRE, "agent");
            xb_add(&bar[XB_XGEN(bx_)], 1u);
            asm volatile("s_waitcnt vmcnt(0)" ::: "memory");
        } else {
            XB_SPIN(xb_ld(&bar[XB_XGEN(bx_)]) == gen, bar);
            __builtin_amdgcn_fence(__ATOMIC_ACQUIRE, "agent");
            asm volatile("s_waitcnt vmcnt(0)" ::: "memory");
        }
    }
    __syncthreads();
}

typedef unsigned short bf16_t;
typedef short bf16x8 __attribute__((ext_vector_type(8)));
typedef float f32x4 __attribute__((ext_vector_type(4)));
typedef unsigned u32x4 __attribute__((ext_vector_type(4)));
#define LDS_WAIT() asm volatile("s_waitcnt lgkmcnt(0)" ::: "memory")

struct Params {
    const float* in[19];
};
struct Frame {
    LAS unsigned char* lds;
    int tid, lane, wave, G, bx, vcu, gw, ngw;
};
__device__ __forceinline__ const float* uptr(const LAS unsigned long long* t, int k) {
    const unsigned long long v = t[k]; const unsigned lo = __builtin_amdgcn_readfirstlane((unsigned)v), hi = __builtin_amdgcn_readfirstlane((unsigned)(v >> 32));
    return (const float*)(const GAS float*)(((unsigned long long)hi << 32) | lo); }

template <class CMap>
__device__ __forceinline__ void transpose_item(const float* W, int K, int Nsrc, bf16_t* WT, const float* ks, LAS float* scr, int kb, int nb, int lane, CMap cmap) {
    const int k0 = 64 * kb, n0 = 32 * nb; const int sc = cmap(n0 + (lane & 31));
#pragma unroll 8
    for (int i = 0; i < 32; ++i) { const int kk = 2 * i + (lane >> 5); float v = 0.f; if (sc >= 0) v = W[(size_t)(k0 + kk) * Nsrc + sc]; if (ks) v *= ks[k0 + kk]; scr[kk * 33 + (lane & 31)] = v; }
    LDS_WAIT(); asm volatile("" ::: "memory");
    const int c = lane & 7;
#pragma unroll
    for (int j = 0; j < 4; ++j) { const int n = (lane >> 3) + 8 * j; const LAS float* s = scr + (8 * c) * 33 + n;
        u32x4 o; o.x = pk2(s[0 * 33], s[1 * 33]); o.y = pk2(s[2 * 33], s[3 * 33]); o.z = pk2(s[4 * 33], s[5 * 33]); o.w = pk2(s[6 * 33], s[7 * 33]);
        *(u32x4*)(WT + (size_t)(n0 + n) * K + k0 + 8 * c) = o; }
    LDS_WAIT(); asm volatile("" ::: "memory");
}
__device__ __forceinline__ int rope_perm(int m) { const int g = m >> 3, j = m & 7; return j < 4 ? 4 * g + j : 32 + 4 * g + (j - 4); }
struct CMapIn { __device__ int operator()(int n) const {
    if (n < 4096) return n; if (n < 4608) return 4112 + (n - 4096); if (n < 4864) return 4624 + (n - 4608);
    if (n < 4928) return 4880 + rope_perm(n - 4864); if (n < 4944) return 4096 + (n - 4928); return -1; } };
struct CMapQ { __device__ int operator()(int n) const { const int h = n / 192, o = n % 192; return o < 128 ? n : h * 192 + 128 + rope_perm(o - 128); } };
struct CMapUp { __device__ int operator()(int n) const { const int pn = n >> 8, j = n & 255; return j < 128 ? 128 * pn + j : DFF + 128 * pn + (j - 128); } };
struct CMapId { __device__ int operator()(int n) const { return n; } };

__device__ __forceinline__ void convert_weights(const Frame& F, unsigned char* ws, const LAS unsigned long long* pt, int l) {
    LAS float* scr = (LAS float*)(F.lds + F.wave * 8448);
    const float* w_in = uptr(pt, 3) + (size_t)l * DM * INC; const float* w_uq = uptr(pt, 8) + (size_t)l * 512 * NQ; const float* w_ukv = uptr(pt, 9) + (size_t)l * 256 * NKV;
    const float* w_out = uptr(pt, 10) + (size_t)l * DM * DM; const float* w_up = uptr(pt, 13) + (size_t)l * DM * NUP; const float* w_dn = uptr(pt, 16) + (size_t)l * DFF * DM;
    const float* qg = uptr(pt, 6) + (size_t)l * 512; const float* kvg = uptr(pt, 7) + (size_t)l * 256;
    { const int nnb = NIN / 32, items = (DM / 64) * nnb; for (int it = F.gw; it < items; it += F.ngw) transpose_item(w_in, DM, INC, (bf16_t*)(ws + WS_WIN), nullptr, scr, it / nnb, it % nnb, F.lane, CMapIn()); }
    { const int nnb = NQ / 32, items = (512 / 64) * nnb; for (int it = F.gw; it < items; it += F.ngw) transpose_item(w_uq, 512, NQ, (bf16_t*)(ws + WS_WUQ), qg, scr, it / nnb, it % nnb, F.lane, CMapQ()); }
    { const int nnb = NKV / 32, items = (256 / 64) * nnb; for (int it = F.gw; it < items; it += F.ngw) transpose_item(w_ukv, 256, NKV, (bf16_t*)(ws + WS_WUKV), kvg, scr, it / nnb, it % nnb, F.lane, CMapId()); }
    { const int nnb = DM / 32, items = (DM / 64) * nnb; for (int it = F.gw; it < items; it += F.ngw) transpose_item(w_out, DM, DM, (bf16_t*)(ws + WS_WOUT), nullptr, scr, it / nnb, it % nnb, F.lane, CMapId()); }
    { const int nnb = NUP / 32, items = (DM / 64) * nnb; for (int it = F.gw; it < items; it += F.ngw) transpose_item(w_up, DM, NUP, (bf16_t*)(ws + WS_WUP), nullptr, scr, it / nnb, it % nnb, F.lane, CMapUp()); }
    { const int nnb = DM / 32, items = (DFF / 64) * nnb; for (int it = F.gw; it < items; it += F.ngw) transpose_item(w_dn, DFF, DM, (bf16_t*)(ws + WS_WDN), nullptr, scr, it / nnb, it % nnb, F.lane, CMapId()); }
}

__device__ __forceinline__ void prologue(const Frame& F, unsigned char* ws, const LAS unsigned long long* pt) {
    float* COS = (float*)(ws + WS_COS); float* SIN = (float*)(ws + WS_SIN);
    for (int i = F.bx * 512 + F.tid; i < 4112 * 32; i += F.G * 512) { const int pos = i >> 5, f = i & 31;
        const float inv = powf(10000.0f, -(float)(2 * f) / 64.0f); const float ang = (float)pos * inv; float s, c; sincosf(ang, &s, &c); COS[i] = c; SIN[i] = s; }
    { float* PAR = (float*)(ws + WS_PAR); const int gt = F.bx * 512 + F.tid, nt = F.G * 512;
      for (int i = gt; i < DEPTH * 16; i += nt) PAR[PO_BG + i] = uptr(pt, 4)[i];
      for (int i = gt; i < DEPTH * 1024; i += nt) PAR[PO_MLG + i] = uptr(pt, 5)[i];
      for (int i = gt; i < DEPTH * 512; i += nt) PAR[PO_QG + i] = uptr(pt, 6)[i];
      for (int i = gt; i < DEPTH * 256; i += nt) PAR[PO_KVG + i] = uptr(pt, 7)[i];
      for (int i = gt; i < 2048; i += nt) { PAR[PO_ONE + i] = 1.f; PAR[PO_ZERO + i] = 0.f; }
      { float* ST2 = (float*)(ws + WS_STAT2); for (int i = gt; i < TP; i += nt) { ST2[2 * i] = 0.f; ST2[2 * i + 1] = 1.f; } }
      for (int i = gt; i < DEPTH * 2048; i += nt) { PAR[PO_L1G + i] = uptr(pt, 11)[i]; PAR[PO_L1B + i] = uptr(pt, 12)[i]; PAR[PO_L2G + i] = uptr(pt, 17)[i]; PAR[PO_L2B + i] = uptr(pt, 18)[i]; }
      for (int i = gt; i < DEPTH * 3 * 5632; i += nt) PAR[PO_CW + i] = uptr(pt, 14)[i];
      for (int i = gt; i < DEPTH * 5632; i += nt) PAR[PO_CB + i] = uptr(pt, 15)[i]; }
    float* H = (float*)(ws + WS_H); bf16_t* HB = (bf16_t*)(ws + WS_HB);
    const float* xp = uptr(pt, 0); const float* xs = uptr(pt, 1); const float* mt = uptr(pt, 2);
    for (int row = F.gw; row < TP; row += F.ngw) {
        const float* src = nullptr;
        if (row < 4 * LREAL) src = xp + (size_t)row * DM; else if (row < NMAIN) src = xs + (size_t)(row - 4 * LREAL) * DM; else if (row < NTOK) src = mt + (size_t)((row - NMAIN) & 15) * DM;
        f32x4* hd = (f32x4*)(H + (size_t)row * DM) + F.lane; u32x2* bd = (u32x2*)(HB + (size_t)row * DM) + F.lane;
#pragma unroll
        for (int j = 0; j < 8; ++j) { f32x4 v = {0.f, 0.f, 0.f, 0.f}; if (src) v = ((const f32x4*)src)[F.lane + 64 * j]; hd[64 * j] = row >= NMAIN ? v * ALPHA : v;
            u32x2 b; b.x = pk2(v[0], v[1]); b.y = pk2(v[2], v[3]); bd[64 * j] = b; }
    }
}

__device__ __forceinline__ void ln_rows(const Frame& F, float* H, bf16_t* HB, const float* g, const float* b, float* ST, float* out) {
    for (int row = F.gw; row < TP; row += F.ngw) {
        f32x4* hp = (f32x4*)(H + (size_t)row * DM) + F.lane; f32x4 v[8]; float s = 0.f;
#pragma unroll
        for (int j = 0; j < 8; ++j) { v[j] = hp[64 * j]; s += (v[j][0] + v[j][1]) + (v[j][2] + v[j][3]); }
        const float mean = wave_sum(s) * (1.f / DM); float q = 0.f;
#pragma unroll
        for (int j = 0; j < 8; ++j) { v[j] = v[j] - mean; q += (v[j][0] * v[j][0] + v[j][1] * v[j][1]) + (v[j][2] * v[j][2] + v[j][3] * v[j][3]); }
        const float rstd = rsqrtf(wave_sum(q) * (1.f / DM) + EPS);
        if (F.lane == 0) { f32x2 ms = {mean, rstd}; *(f32x2*)(ST + (size_t)row * 2) = ms; }
        u32x2* bd = (u32x2*)(HB + (size_t)row * DM) + F.lane;
#pragma unroll
        for (int j = 0; j < 8; ++j) { const f32x4 gg = ((const f32x4*)g)[F.lane + 64 * j], bb = ((const f32x4*)b)[F.lane + 64 * j]; const f32x4 y = v[j] * rstd * gg + bb;
            u32x2 w; w.x = pk2(y[0], y[1]); w.y = pk2(y[2], y[3]); bd[64 * j] = w;
            if (row >= NMAIN) hp[64 * j] = y * ALPHA;
            else if (out) ((f32x4*)(out + (size_t)row * DM))[F.lane + 64 * j] = y; }
    }
}

__device__ __forceinline__ void rstd_rows(const Frame& F, const bf16_t* UDQ, const bf16_t* UDKV, float* RSTD) {
    for (int row = F.gw; row < TP; row += F.ngw) {
        const u32x4 a = ((const u32x4*)(UDQ + (size_t)row * 512))[F.lane]; float s = 0.f;
#pragma unroll
        for (int j = 0; j < 4; ++j) { const float x = bf_lo(a[j]), y = bf_hi(a[j]); s += x * x + y * y; }
        float t = 0.f;
        if (F.lane < 32) { const u32x4 c = ((const u32x4*)(UDKV + (size_t)row * 256))[F.lane];
#pragma unroll
            for (int j = 0; j < 4; ++j) { const float x = bf_lo(c[j]), y = bf_hi(c[j]); t += x * x + y * y; } }
        s = wave_sum(s); t = wave_sum(t);
        if (F.lane == 0) { RSTD[(size_t)row * 2] = rsqrtf(s * (1.f / 512.f) + EPS); RSTD[(size_t)row * 2 + 1] = rsqrtf(t * (1.f / 256.f) + EPS); }
    }
}

__device__ __forceinline__ void mlstm_finalize(const Frame& F, int gw0, int ngw0, const float* HSUM, const bf16_t* UQKVO, const float* ng, bf16_t* MIX) {
    for (int row = gw0; row < TP; row += ngw0) {
#pragma unroll
        for (int j = 0; j < 4; ++j) {
            f32x4 v = ((const f32x4*)(HSUM + (size_t)row * MLW + 256 * j))[F.lane];
            const float mean = wave_sum((v[0] + v[1]) + (v[2] + v[3])) * (1.f / 256.f); v = v - mean;
            const float rstd = rsqrtf(wave_sum((v[0] * v[0] + v[1] * v[1]) + (v[2] * v[2] + v[3] * v[3])) * (1.f / 256.f) + EPS);
            const f32x4 gg = ((const f32x4*)(ng + 256 * j))[F.lane];
            const u32x2 uo = ((const u32x2*)(UQKVO + (size_t)row * 4096 + 3072 + 256 * j))[F.lane];
            const float o0 = bf_lo(uo.x), o1 = bf_hi(uo.x), o2 = bf_lo(uo.y), o3 = bf_hi(uo.y);
            const float y0 = v[0] * rstd * gg[0] / (1.f + __expf(-o0)), y1 = v[1] * rstd * gg[1] / (1.f + __expf(-o1));
            const float y2 = v[2] * rstd * gg[2] / (1.f + __expf(-o2)), y3 = v[3] * rstd * gg[3] / (1.f + __expf(-o3));
            u32x2 w; w.x = pk2(y0, y1); w.y = pk2(y2, y3); ((u32x2*)(MIX + (size_t)row * DM + 256 * j))[F.lane] = w;
        }
    }
}

__device__ __forceinline__ f32x8 ld8f(const float* p) { const f32x4 a = *(const f32x4*)p, b = *(const f32x4*)(p + 4); return (f32x8){a[0], a[1], a[2], a[3], b[0], b[1], b[2], b[3]}; }
__device__ __forceinline__ f32x8 ld8b(const bf16_t* p) { const u32x4 v = *(const u32x4*)p; return (f32x8){bf_lo(v[0]), bf_hi(v[0]), bf_lo(v[1]), bf_hi(v[1]), bf_lo(v[2]), bf_hi(v[2]), bf_lo(v[3]), bf_hi(v[3])}; }
__device__ __forceinline__ void act_store(bf16_t* dst, const f32x8 gp, const f32x8 gc, const f32x8 gn, const f32x8 vv, const f32x8 w0, const f32x8 w1, const f32x8 w2, const f32x8 bb) {
    float o[8];
#pragma unroll
    for (int i = 0; i < 8; ++i) { const float x = w0[i] * gp[i] + w1[i] * gc[i] + w2[i] * gn[i] + bb[i]; o[i] = x / (1.f + __expf(-x)) * vv[i]; }
    u32x4 w; w.x = pk2(o[0], o[1]); w.y = pk2(o[2], o[3]); w.z = pk2(o[4], o[5]); w.w = pk2(o[6], o[7]); *(u32x4*)dst = w;
}
__device__ __forceinline__ void ffn_fixup(const Frame& F, const float* SIDE, const bf16_t* GVM, bf16_t* ACT, const float* cw, const float* cb) {
    constexpr int NCH = DFF / 8;
    const f32x8 zero = {0.f, 0.f, 0.f, 0.f, 0.f, 0.f, 0.f, 0.f};
    const int gt = F.bx * 512 + F.tid, nt = GRID * 512;
    for (int idx = gt; idx < 192 * 2 * NCH; idx += nt) {
        const int ch = idx % NCH, rsel = (idx / NCH) & 1, pm = idx / (2 * NCH), c0 = 8 * ch, sq = pm >> 4;
        const f32x8 w0 = ld8f(cw + c0), w1 = ld8f(cw + DFF + c0), w2 = ld8f(cw + 2 * DFF + c0), bb = ld8f(cb + c0);
        const float* S0 = SIDE + (size_t)pm * 6 * DFF + c0;
        if (rsel == 0) { const f32x8 gp = (pm & 15) ? ld8f(S0 - 6 * DFF + 3 * DFF) : ld8b(GVM + (size_t)(16 * sq + 15) * NUP + c0);
            act_store(ACT + (size_t)(pm * 256) * DFF + c0, gp, ld8f(S0), ld8f(S0 + DFF), ld8f(S0 + 4 * DFF), w0, w1, w2, bb);
        } else { const f32x8 gn = ((pm & 15) != 15) ? ld8f(S0 + 6 * DFF) : zero;
            act_store(ACT + (size_t)(pm * 256 + 255) * DFF + c0, ld8f(S0 + 2 * DFF), ld8f(S0 + 3 * DFF), gn, ld8f(S0 + 5 * DFF), w0, w1, w2, bb); }
    }
    for (int idx = gt; idx < NSEQ * NCH; idx += nt) {
        const int ch = idx % NCH, sq = idx / NCH, c0 = 8 * ch;
        const f32x8 w0 = ld8f(cw + c0), w1 = ld8f(cw + DFF + c0), w2 = ld8f(cw + 2 * DFF + c0), bb = ld8f(cb + c0);
        f32x8 gp = zero, gc = ld8b(GVM + (size_t)(16 * sq) * NUP + c0);
        for (int p = 0; p < 16; ++p) {
            const f32x8 gn = p < 15 ? ld8b(GVM + (size_t)(16 * sq + p + 1) * NUP + c0) : ld8f(SIDE + (size_t)(16 * sq) * 6 * DFF + c0);
            act_store(ACT + (size_t)(MROW0 + 16 * sq + p) * DFF + c0, gp, gc, gn, ld8b(GVM + (size_t)(16 * sq + p) * NUP + DFF + c0), w0, w1, w2, bb);
            gp = gc; gc = gn;
        }
    }
}

namespace att {
constexpr int NW = 8, QBLK = 32, KVBLK = 64, NT = 65;
constexpr int KROW = 400;
constexpr int SHM_V = KVBLK * 128 * 2, SHM_K = KVBLK * KROW;
constexpr int OFF_V = 0, OFF_K = 3 * SHM_V, OFF_WS = OFF_K + 3 * SHM_K, LDS_TOTAL = OFF_WS + NW * 64 * 4;
static_assert(LDS_TOTAL <= RING_BYTES, "attention LDS");
constexpr float SCALE = 0.07216878364870323f;
constexpr float THR = 8.f;
#define SBAR() __builtin_amdgcn_sched_barrier(0)
__device__ __forceinline__ int crow(int r, int hi) { return (r & 3) + 8 * (r >> 2) + 4 * hi; }
__device__ __forceinline__ unsigned cvtpk(float lo, float hi) { unsigned r; asm volatile("v_cvt_pk_bf16_f32 %0, %1, %2" : "=v"(r) : "v"(lo), "v"(hi)); return r; }

template <bool MASK16>
__device__ __forceinline__ void partialSM(f32x16& p0, f32x16& p1, float& m_reg, float& mn, float& alpha) {
    constexpr float C = SCALE * 1.4426950408889634f;
    if (MASK16) {
#pragma unroll
        for (int r = 8; r < 16; ++r) p0[r] = NEGBIG;
#pragma unroll
        for (int r = 0; r < 16; ++r) p1[r] = NEGBIG;
    }
    float pmax = p0[0];
#pragma unroll
    for (int r = 1; r < 16; ++r) pmax = fmaxf(pmax, p0[r]);
#pragma unroll
    for (int r = 0; r < 16; ++r) pmax = fmaxf(pmax, p1[r]);
    { auto rr = __builtin_amdgcn_permlane32_swap(__float_as_uint(pmax), __float_as_uint(pmax), false, false); pmax = fmaxf(__uint_as_float(rr[0]), __uint_as_float(rr[1])); }
    if (__builtin_expect(__all(pmax - m_reg <= THR / SCALE), 1)) { mn = m_reg; alpha = 1.f; }
    else { mn = fmaxf(m_reg, pmax); alpha = __builtin_amdgcn_exp2f((m_reg - mn) * C); m_reg = mn; }
    const float mnC = -mn * C;
#pragma unroll
    for (int r = 0; r < 16; ++r) p0[r] = fmaf(p0[r], C, mnC);
#pragma unroll
    for (int r = 0; r < 16; ++r) p1[r] = fmaf(p1[r], C, mnC);
#pragma unroll
    for (int r = 0; r < 16; ++r) p0[r] = __builtin_amdgcn_exp2f(p0[r]);
}
__device__ __forceinline__ void finishSM(f32x16& p0, f32x16& p1, float alpha, float& l_reg, bf16x8& pa0, bf16x8& pa1, bf16x8& pa2, bf16x8& pa3) {
#pragma unroll
    for (int r = 0; r < 16; ++r) p1[r] = __builtin_amdgcn_exp2f(p1[r]);
    float ps = 0;
#pragma unroll
    for (int r = 0; r < 16; ++r) ps += p0[r];
#pragma unroll
    for (int r = 0; r < 16; ++r) ps += p1[r];
    { auto rr = __builtin_amdgcn_permlane32_swap(__float_as_uint(ps), __float_as_uint(ps), false, false); ps = __uint_as_float(rr[0]) + __uint_as_float(rr[1]); }
    l_reg = l_reg * alpha + ps;
#define PK4(P, BASE, OUT) do { unsigned a0 = cvtpk(P[BASE + 0], P[BASE + 1]), a1 = cvtpk(P[BASE + 2], P[BASE + 3]);   \
    unsigned b0 = cvtpk(P[BASE + 4], P[BASE + 5]), b1 = cvtpk(P[BASE + 6], P[BASE + 7]);                              \
    auto r0 = __builtin_amdgcn_permlane32_swap(a0, b0, false, false); auto r1 = __builtin_amdgcn_permlane32_swap(a1, b1, false, false); \
    u32x4 w = {r0[0], r1[0], r0[1], r1[1]}; OUT = __builtin_bit_cast(bf16x8, w); } while (0)
    PK4(p0, 0, pa0); PK4(p0, 8, pa1); PK4(p1, 0, pa2); PK4(p1, 8, pa3);
#undef PK4
}
__device__ __forceinline__ void qkt(f32x16& p0, f32x16& p1, const LAS char* Ks, const bf16x8* qr, int r32, int hi) {
#pragma unroll
    for (int r = 0; r < 16; ++r) { p0[r] = 0.f; p1[r] = 0.f; }
#pragma unroll
    for (int d0 = 0; d0 < 12; ++d0) { const int cb = (d0 * 16 + hi * 8) * 2;
        const bf16x8 b0 = *(const LAS bf16x8*)(Ks + r32 * KROW + cb);
        const bf16x8 b1 = *(const LAS bf16x8*)(Ks + (32 + r32) * KROW + cb);
        p0 = __builtin_amdgcn_mfma_f32_32x32x16_bf16(b0, qr[d0], p0, 0, 0, 0);
        p1 = __builtin_amdgcn_mfma_f32_32x32x16_bf16(b1, qr[d0], p1, 0, 0, 0); }
}
__device__ __forceinline__ int v_st(int k, int c) { const int kk = (k & ~0xC) | ((k & 4) << 1) | ((k & 8) >> 1); return ((kk >> 3) * 4 + (c >> 5)) * 512 + ((kk & 7) * 32 + (c & 31)) * 2; }
__device__ __forceinline__ int v_rd_base(int lane) { return ((lane & 3) << 3) | (((lane >> 2) & 3) << 6) | (((lane >> 4) & 1) << 5) | (((lane >> 5) & 1) << 8); }
constexpr int v_rd_off(int d0, int ks, int half) { return d0 * 512 + ks * 4096 + half * 2048; }
template <int OFF> __device__ __forceinline__ s16x4 tr_read(int vb) { s16x4 r; asm volatile("ds_read_b64_tr_b16 %0, %1 offset:%2" : "=&v"(r) : "v"(vb), "i"(OFF) : "memory"); return r; }
template <int D0> __device__ __forceinline__ void pv_one(f32x16& od, int vb, bf16x8 pa0, bf16x8 pa1, bf16x8 pa2, bf16x8 pa3) {
    const s16x4 l0 = tr_read<v_rd_off(D0, 0, 0)>(vb), h0 = tr_read<v_rd_off(D0, 0, 1)>(vb), l1 = tr_read<v_rd_off(D0, 1, 0)>(vb), h1 = tr_read<v_rd_off(D0, 1, 1)>(vb);
    const s16x4 l2 = tr_read<v_rd_off(D0, 2, 0)>(vb), h2 = tr_read<v_rd_off(D0, 2, 1)>(vb), l3 = tr_read<v_rd_off(D0, 3, 0)>(vb), h3 = tr_read<v_rd_off(D0, 3, 1)>(vb);
    asm volatile("s_waitcnt lgkmcnt(0)" ::: "memory"); SBAR();
#define PKV(L, H) (bf16x8){L[0], L[1], L[2], L[3], H[0], H[1], H[2], H[3]}
    od = __builtin_amdgcn_mfma_f32_32x32x16_bf16(pa0, PKV(l0, h0), od, 0, 0, 0);
    od = __builtin_amdgcn_mfma_f32_32x32x16_bf16(pa1, PKV(l1, h1), od, 0, 0, 0);
    od = __builtin_amdgcn_mfma_f32_32x32x16_bf16(pa2, PKV(l2, h2), od, 0, 0, 0);
    od = __builtin_amdgcn_mfma_f32_32x32x16_bf16(pa3, PKV(l3, h3), od, 0, 0, 0);
#undef PKV
}
__device__ __forceinline__ void pv_d0(f32x16* o, int vb, bf16x8 pa0, bf16x8 pa1, bf16x8 pa2, bf16x8 pa3) {
    pv_one<0>(o[0], vb, pa0, pa1, pa2, pa3); pv_one<1>(o[1], vb, pa0, pa1, pa2, pa3); pv_one<2>(o[2], vb, pa0, pa1, pa2, pa3); pv_one<3>(o[3], vb, pa0, pa1, pa2, pa3);
}

__device__ __forceinline__ void attn_unit(int s, int h, int qb, const bf16_t* __restrict__ MQ, const bf16_t* __restrict__ MKV, const bf16_t* __restrict__ KR, bf16_t* __restrict__ MIX, LAS char* lds) {
    int tid_ = threadIdx.x; asm volatile("" : "+v"(tid_));
    const int tid = tid_, wid = tid >> 6, lane = tid & 63, r32 = lane & 31, hi = lane >> 5;
    LAS char* V_lds = lds + OFF_V; LAS char* K_lds = lds + OFF_K;
    LAS float* wsf = (LAS float*)(lds + OFF_WS) + wid * 64; LAS float* li_l = wsf; LAS float* al_l = wsf + 32;
    float m_reg = NEGBIG, l_reg = 0; f32x16 o[4]; bf16x8 qr[12];
#pragma unroll
    for (int d = 0; d < 4; ++d)
#pragma unroll
        for (int r = 0; r < 16; ++r) o[d][r] = 0.f;
    const int qi = wid * QBLK + r32;
    const unsigned qrow = qb < 16 ? (unsigned)s * LREAL + 256 * qb + qi : (unsigned)MROW0 + 16 * s + (qi < 15 ? qi : 15);
    { const bf16_t* Qw = MQ + (qrow * NQ + h * 192 + hi * 8);
#pragma unroll
      for (int d0 = 0; d0 < 12; ++d0) qr[d0] = *(const bf16x8*)(Qw + d0 * 16); }
    const int sr = tid >> 4, sc = (tid & 15) * 8, vst0 = v_st(sr, sc), vst1 = v_st(32 + sr, sc);
    const int kr_r = tid >> 3, kr_c = (tid & 7) * 8;
    const int vb0 = (int)(uintptr_t)V_lds + v_rd_base(lane);
    bf16x8 vs0, vs1, ks0, ks1, kr0;
    const unsigned mainrow0 = (unsigned)s * LREAL, metarow0 = (unsigned)MROW0 + 16 * s;
    const bf16_t* MKVh = MKV + h * 256;
#define KROWG(kt, k) ((kt) < 64 ? mainrow0 + 64u * (kt) + (k) : metarow0 + ((k) < 15 ? (k) : 15))
#define SLOAD(kt) do { const unsigned g0 = KROWG(kt, sr) * NKV + sc, g1 = KROWG(kt, 32 + sr) * NKV + sc, g2 = KROWG(kt, kr_r) * 64 + kr_c; \
    vs0 = *(const bf16x8*)(MKVh + 128 + g0); vs1 = *(const bf16x8*)(MKVh + 128 + g1); \
    ks0 = *(const bf16x8*)(MKVh + g0); ks1 = *(const bf16x8*)(MKVh + g1); kr0 = *(const bf16x8*)(KR + g2); } while (0)
#define SWRITE(b) do { *(LAS bf16x8*)(V_lds + (b) * SHM_V + vst0) = vs0; *(LAS bf16x8*)(V_lds + (b) * SHM_V + vst1) = vs1; \
    *(LAS bf16x8*)(K_lds + (b) * SHM_K + sr * KROW + sc * 2) = ks0; *(LAS bf16x8*)(K_lds + (b) * SHM_K + (32 + sr) * KROW + sc * 2) = ks1; \
    *(LAS bf16x8*)(K_lds + (b) * SHM_K + kr_r * KROW + 256 + kr_c * 2) = kr0; } while (0)
#define RESC(a) do { if (__any((a) < 1.f)) { if (hi == 0) al_l[r32] = (a); asm volatile("s_waitcnt lgkmcnt(0)" ::: "memory"); \
    _Pragma("unroll") for (int d = 0; d < 4; ++d) _Pragma("unroll") for (int r = 0; r < 16; ++r) o[d][r] *= al_l[crow(r, hi)]; } } while (0)
    f32x16 pA0, pA1, pB0, pB1; float mnA, mnB, alA, alB; bf16x8 pa0, pa1, pa2, pa3;
    __syncthreads();
    SLOAD(0); SWRITE(0); __syncthreads();
    qkt(pA0, pA1, K_lds, qr, r32, hi); partialSM<false>(pA0, pA1, m_reg, mnA, alA);
    SLOAD(1); SWRITE(1); __syncthreads();
    RESC(alA);
    int s0 = 0, s1 = 1, s2 = 2;
    for (int j = 1; j + 1 < NT; j += 2) {
        SBAR(); qkt(pB0, pB1, K_lds + s1 * SHM_K, qr, r32, hi);
        finishSM(pA0, pA1, alA, l_reg, pa0, pa1, pa2, pa3); SBAR();
        SLOAD(j + 1); SBAR();
        pv_d0(o, vb0 + s0 * SHM_V, pa0, pa1, pa2, pa3); partialSM<false>(pB0, pB1, m_reg, mnB, alB);
        SWRITE(s2);
        RESC(alB); __syncthreads();
        SBAR(); qkt(pA0, pA1, K_lds + s2 * SHM_K, qr, r32, hi);
        finishSM(pB0, pB1, alB, l_reg, pa0, pa1, pa2, pa3); SBAR();
        if (j + 2 < NT) SLOAD(j + 2); SBAR();
        pv_d0(o, vb0 + s1 * SHM_V, pa0, pa1, pa2, pa3);
        if (j + 1 == NT - 1) partialSM<true>(pA0, pA1, m_reg, mnA, alA); else partialSM<false>(pA0, pA1, m_reg, mnA, alA);
        if (j + 2 < NT) SWRITE(s0);
        RESC(alA); __syncthreads();
        { const int t0 = s0, t1 = s1; s0 = s2; s1 = t0; s2 = t1; }
    }
    finishSM(pA0, pA1, alA, l_reg, pa0, pa1, pa2, pa3); SBAR();
    pv_d0(o, vb0 + s0 * SHM_V, pa0, pa1, pa2, pa3);
    if (hi == 0) li_l[r32] = l_reg; asm volatile("s_waitcnt lgkmcnt(0)" ::: "memory");
    float rli[16];
#pragma unroll
    for (int r = 0; r < 16; ++r) rli[r] = __builtin_amdgcn_rcpf(li_l[crow(r, hi)]);
    if (qb < 16) {
        bf16_t* Ow = MIX + ((long)s * LREAL + 256 * qb + wid * QBLK) * DM + MLW + h * 128;
#pragma unroll
        for (int r = 0; r < 16; ++r) { const int orow = crow(r, hi);
#pragma unroll
            for (int d0 = 0; d0 < 4; ++d0) Ow[(long)orow * DM + d0 * 32 + r32] = (bf16_t)(pk2(o[d0][r] * rli[r], 0.f) & 0xffffu); }
    } else if (wid == 0) {
        bf16_t* Ow = MIX + ((long)MROW0 + 16 * s) * DM + MLW + h * 128;
#pragma unroll
        for (int r = 0; r < 16; ++r) { const int orow = crow(r, hi);
            if (orow < 16) {
#pragma unroll
                for (int d0 = 0; d0 < 4; ++d0) Ow[(long)orow * DM + d0 * 32 + r32] = (bf16_t)(pk2(o[d0][r] * rli[r], 0.f) & 0xffffu); } }
    }
#undef KROWG
#undef SLOAD
#undef SWRITE
#undef RESC
}
__device__ __forceinline__ void attn_phase(int vcu, const bf16_t* MQ, const bf16_t* MKV, const bf16_t* KR, bf16_t* MIX, LAS char* lds) {
    for (int i = (vcu < 96 ? -1 : 0); i < 6; ++i) { int sh, qb; if (i < 0) { sh = vcu; qb = 16; } else { const int id = i * GRID + vcu; sh = id >> 4; qb = id & 15; }
        attn_unit(sh >> 3, sh & 7, qb, MQ, MKV, KR, MIX, lds); }
}
#undef SBAR
}

namespace ml {
constexpr int QI = 0, KI = 32768, VI = 65536, SI = 81920, CI = 98304;
constexpr int SC_CT = 0, SC_BM = 64, SC_WI = 128, SC_EI = 192, SC_WW = 256, SC_DEN = 320, SC_QN = 448, SC_N = 512, SC_A = 768;
constexpr int GP_REC = 200;
__device__ __forceinline__ unsigned off_b(unsigned row, unsigned ch) { return 256u * row + 16u * (ch ^ (((row & 3) << 2) | ((row >> 2) & 3))); }
__device__ __forceinline__ unsigned row_read_addr_16(unsigned lane, unsigned rb, unsigned s) { return off_b((lane & 15) + 16 * rb, 4 * s + (lane >> 4)); }
__device__ __forceinline__ unsigned tr_read_addr_16(unsigned lane, unsigned c, unsigned ks, unsigned t) {
    const unsigned g = lane >> 4, q = (lane & 15) >> 2, p = lane & 3; return off_b(32 * ks + 8 * g + 4 * t + q, 2 * c + (p >> 1)) + 8 * (p & 1); }
__device__ __forceinline__ bf16x8 tr_frag(unsigned a0, unsigned a1) {
    const s16x4 lo = __builtin_amdgcn_ds_read_tr16_b64_v4i16((LAS s16x4*)a0), hi = __builtin_amdgcn_ds_read_tr16_b64_v4i16((LAS s16x4*)a1);
    return (bf16x8){lo[0], lo[1], lo[2], lo[3], hi[0], hi[1], hi[2], hi[3]};
}
__device__ __forceinline__ f32x4 mfma16(bf16x8 a, bf16x8 b, f32x4 c) { return __builtin_amdgcn_mfma_f32_16x16x32_bf16(a, b, c, 0, 0, 0); }
__device__ __forceinline__ float log_sigmoid(float x) { return fminf(x, 0.f) - __logf(1.f + __expf(-fabsf(x))); }

__device__ __forceinline__ void gate_prep(int gw, int ngw, int lane, const float* __restrict__ GATES, const float* __restrict__ bgl, float* __restrict__ GP) {
    for (int it = gw; it < 96 * 65; it += ngw) {
        const int chain = it / 65, c = it % 65, s = chain >> 3, hd = (chain >> 1) & 3, dir = chain & 1;
        const long g = c == 0 ? (lane >= 48 ? (long)MROW0 + 16 * s + lane - 48 : -1L) : (long)s * LREAL + 64 * (c - 1) + lane;
        float li = NEGBIG, lf = 0.f;
        if (g >= 0) { li = GATES[g * 16 + (dir ? 8 : 0) + hd] + bgl[(dir ? 8 : 0) + hd]; lf = log_sigmoid(GATES[g * 16 + (dir ? 12 : 4) + hd] + bgl[(dir ? 12 : 4) + hd]); }
        float x = dir ? __shfl(lf, 63 - lane) : lf;
#pragma unroll
        for (int o = 1; o < 64; o <<= 1) { const float y = __shfl_up(x, o); if (lane >= o) x += y; }
        const float btot = __shfl(x, 63);
        const float b = dir ? __shfl(x, 63 - lane) : x;
        const float a_s = li - b;
        float pm = dir ? __shfl(a_s, 63 - lane) : a_s;
#pragma unroll
        for (int o = 1; o < 64; o <<= 1) { const float y = __shfl_up(pm, o); if (lane >= o) pm = fmaxf(pm, y); }
        pm = dir ? __shfl(pm, 63 - lane) : pm;
        const float gmax = wave_max(btot - b + li);
        float* rec = GP + (size_t)it * GP_REC;
        rec[lane] = b; rec[64 + lane] = li; rec[128 + lane] = pm; if (lane == 0) { rec[192] = btot; rec[193] = gmax; }
    }
}

__device__ __forceinline__ void mlstm_unit(int s, int hd, int js, const bf16_t* __restrict__ UQKVO, const float* __restrict__ GP, float* __restrict__ HSUM, LAS unsigned char* lds, LAS float* sc) {
    const int wid = __builtin_amdgcn_readfirstlane((int)threadIdx.x >> 6);
    const unsigned ldsb = (unsigned)(uintptr_t)lds;
    const int tt = wid >> 1, nb = 2 * (wid & 1);
#define ROWRD(img, rb, s_) (*(const LAS bf16x8*)(uintptr_t)(RB[s_] + (unsigned)((img) + 4096 * (rb))))
#define TRFRAG(img, c_, ks) tr_frag(BT[0][(c_) & 1] + TQ[(c_) >> 1] + (unsigned)((img) + 8192 * (ks)), BT[1][(c_) & 1] + TQ[(c_) >> 1] + (unsigned)((img) + 8192 * (ks)))
    f32x4 accC[2][4], accN[2];
    for (int dir = 0; dir < 2; ++dir) {
        int tid; { int t0_ = threadIdx.x; asm volatile("" : "+v"(t0_)); tid = t0_; }
#pragma unroll
        for (int mi = 0; mi < 2; ++mi)
#pragma unroll
            for (int c = 0; c < 4; ++c) accC[mi][c] = (f32x4){0.f, 0.f, 0.f, 0.f};
        accN[0] = (f32x4){0.f, 0.f, 0.f, 0.f}; accN[1] = (f32x4){0.f, 0.f, 0.f, 0.f};
        if (tid < 256) sc[SC_N + tid] = 0.f;
        for (int i = tid; i < 32768 / 16; i += 512) *(LAS u32x4*)(lds + CI + i * 16) = (u32x4){0u, 0u, 0u, 0u};
        float m_state = 0.f;
        const float* GPc = GP + (size_t)(((s * 4 + hd) * 2 + dir) * 65) * GP_REC;
        u32x4 sq[4], sk[4], sv; float sb = 0.f, sli = NEGBIG, spm = NEGBIG, sbt = 0.f, sgm = NEGBIG;
#define ROWG(c, r) ((c) == 0 ? ((r) >= 48 ? (long)MROW0 + 16 * s + (r) - 48 : -1L) : (long)s * LREAL + 64 * ((c) - 1) + (r))
#define STAGE_LOAD(c) do { \
        _Pragma("unroll") for (int i = 0; i < 4; ++i) { const int id = tid + 512 * i, r = id >> 5, ch = id & 31; const long g = ROWG(c, r); \
            sq[i] = (u32x4){0u, 0u, 0u, 0u}; sk[i] = (u32x4){0u, 0u, 0u, 0u}; \
            if (g >= 0) { sq[i] = *(const u32x4*)(UQKVO + g * 4096 + hd * 256 + ch * 8); sk[i] = *(const u32x4*)(UQKVO + g * 4096 + 1024 + hd * 256 + ch * 8); } } \
        { const int r = tid >> 3, ch = tid & 7; const long g = ROWG(c, r); sv = (u32x4){0u, 0u, 0u, 0u}; if (g >= 0) sv = *(const u32x4*)(UQKVO + g * 4096 + 2048 + hd * 256 + js * 64 + ch * 8); } \
        if (tid < 64) { const float* rec = GPc + (size_t)(c) * GP_REC; sb = rec[tid]; sli = rec[64 + tid]; spm = rec[128 + tid]; sbt = rec[192]; sgm = rec[193]; } } while (0)
#define STAGE_WRITE() do { \
        _Pragma("unroll") for (int i = 0; i < 4; ++i) { const int id = tid + 512 * i, r = id >> 5, ch = id & 31; \
            *(LAS u32x4*)(lds + QI + (ch >> 4) * 16384 + off_b(r, ch & 15)) = sq[i]; *(LAS u32x4*)(lds + KI + (ch >> 4) * 16384 + off_b(r, ch & 15)) = sk[i]; } \
        { const int r = tid >> 3, ch = tid & 7; *(LAS u32x4*)(lds + VI + off_b(r, ch)) = sv; } \
        if (tid < 64) { const float m_inter = sb + m_state, mt = fmaxf(m_inter, sb + spm); const float m_new = fmaxf(sbt + m_state, sgm); \
            sc[SC_CT + tid] = sli - sb; sc[SC_BM + tid] = sb - mt; sc[SC_WI + tid] = __expf(m_inter - mt); sc[SC_EI + tid] = __expf(-mt); \
            sc[SC_WW + tid] = __expf(sbt - sb + sli - m_new) * 0.0625f; if (tid == 0) sc[SC_A] = __expf(sbt + m_state - m_new); m_state = m_new; } } while (0)
        const int c_first = dir ? 64 : 0, c_step = dir ? -1 : 1;
        STAGE_LOAD(c_first);
        __syncthreads();
        STAGE_WRITE();
        for (int ci = 0; ci < 65; ++ci) {
            const int c = c_first + c_step * ci;
            { int t2_ = threadIdx.x; asm volatile("" : "+v"(t2_)); tid = t2_; }
            const int lane = tid & 63, l15 = lane & 15, lg = lane >> 4;
            unsigned RB[4], BT[2][2], TQ[4];
            { const unsigned fl = ((l15 & 3) << 2) | (l15 >> 2), q = l15 >> 2, p = lane & 3, g = lg;
#pragma unroll
              for (int s_ = 0; s_ < 4; ++s_) { RB[s_] = ldsb + 256u * l15 + 16u * (lg ^ (fl & 3)) + 64u * (s_ ^ (fl >> 2)); TQ[s_] = 64u * (s_ ^ q); }
#pragma unroll
              for (int t_ = 0; t_ < 2; ++t_)
#pragma unroll
                  for (int cl = 0; cl < 2; ++cl) BT[t_][cl] = ldsb + 256u * (8 * g + q) + 8u * (p & 1) + 1024u * t_ + 16u * ((p >> 1) ^ t_) + 32u * (cl ^ (g & 1)); }
            __syncthreads();
            if (ci + 1 < 65) STAGE_LOAD(c + c_step);
            bf16x8 qf[8];
#pragma unroll
            for (int k = 0; k < 8; ++k) qf[k] = ROWRD(QI + (k >> 2) * 16384, tt, k & 3);
            f32x4 sT[2], oc[2];
#pragma unroll
            for (int i = 0; i < 2; ++i) { sT[i] = (f32x4){0.f, 0.f, 0.f, 0.f}; oc[i] = (f32x4){0.f, 0.f, 0.f, 0.f}; }
#pragma unroll
            for (int i = 0; i < 2; ++i)
#pragma unroll
                for (int k = 0; k < 8; ++k) {
                    const bf16x8 kf = ROWRD(KI + (k >> 2) * 16384, nb + i, k & 3);
                    sT[i] = mfma16(kf, qf[k], sT[i]);
                    const bf16x8 cf = ROWRD(CI + (k >> 2) * 16384, nb + i, k & 3);
                    oc[i] = mfma16(qf[k], cf, oc[i]);
                }
            {
                const int t = 16 * tt + l15; const float bmt = sc[SC_BM + t]; float rs = 0.f;
#pragma unroll
                for (int i = 0; i < 2; ++i) { const int s0 = 16 * (nb + i) + 4 * lg; const f32x4 ctv = *(const LAS f32x4*)(sc + SC_CT + s0); float v[4];
#pragma unroll
                    for (int e = 0; e < 4; ++e) { const int sx = s0 + e; const bool ok = dir ? (sx >= t) : (sx <= t);
                        const float ex = ok ? (bmt + ctv[e]) : NEGBIG; v[e] = sT[i][e] * 0.0625f * __expf(ex); rs += v[e]; }
                    u32x2 w; w.x = pk2(v[0], v[1]); w.y = pk2(v[2], v[3]);
                    *(LAS u32x2*)(lds + SI + off_b(t, s0 >> 3) + (s0 & 7) * 2) = w; }
                rs += __shfl_xor(rs, 16); rs += __shfl_xor(rs, 32);
                if (lg == 0) sc[SC_DEN + 64 * (wid & 1) + t] = rs;
            }
            { const int r = tid >> 3, ch = tid & 7; const u32x4 v = *(const LAS u32x4*)(lds + VI + off_b(r, ch)); const float w = sc[SC_WW + r]; u32x4 o;
#pragma unroll
              for (int jx = 0; jx < 4; ++jx) o[jx] = pk2(bf_lo(v[jx]) * w, bf_hi(v[jx]) * w);
              *(LAS u32x4*)(lds + VI + off_b(r, 8 + ch)) = o; }
            { const int r = tid >> 3, part = tid & 7; float d = 0.f;
#pragma unroll
              for (int i = 0; i < 4; ++i) { const int ch32 = part * 4 + i; const u32x4 v = *(const LAS u32x4*)(lds + QI + (ch32 >> 4) * 16384 + off_b(r, ch32 & 15));
                  const f32x4 n0 = *(const LAS f32x4*)(sc + SC_N + ch32 * 8), n1 = *(const LAS f32x4*)(sc + SC_N + ch32 * 8 + 4);
                  d += bf_lo(v[0]) * n0[0] + bf_hi(v[0]) * n0[1] + bf_lo(v[1]) * n0[2] + bf_hi(v[1]) * n0[3] + bf_lo(v[2]) * n1[0] + bf_hi(v[2]) * n1[1] + bf_lo(v[3]) * n1[2] + bf_hi(v[3]) * n1[3]; }
              d += __shfl_xor(d, 1); d += __shfl_xor(d, 2); d += __shfl_xor(d, 4);
              if (part == 0) sc[SC_QN + r] = d; }
            { const f32x4 wi = *(const LAS f32x4*)(sc + SC_WI + 16 * tt + 4 * lg);
#pragma unroll
              for (int i = 0; i < 2; ++i) oc[i] = oc[i] * wi; }
            __syncthreads();
            const float a_dec = sc[SC_A];
#pragma unroll
            for (int ks = 0; ks < 2; ++ks) { const bf16x8 sf = ROWRD(SI, tt, ks);
#pragma unroll
                for (int i = 0; i < 2; ++i) { const bf16x8 vf = TRFRAG(VI, nb + i, ks);
                    oc[i] = mfma16(sf, vf, oc[i]); } }
            { const int t0 = 16 * tt + 4 * lg;
              const f32x4 wi = *(const LAS f32x4*)(sc + SC_WI + t0), qn = *(const LAS f32x4*)(sc + SC_QN + t0), d0 = *(const LAS f32x4*)(sc + SC_DEN + t0), d1 = *(const LAS f32x4*)(sc + SC_DEN + 64 + t0), ei = *(const LAS f32x4*)(sc + SC_EI + t0);
#pragma unroll
              for (int e = 0; e < 4; ++e) { const long g = ROWG(c, t0 + e);
                const float den = wi[e] * qn[e] + (d0[e] + d1[e]); const float inv = 1.f / fmaxf(fabsf(den), ei[e]);
                if (g >= 0) {
#pragma unroll
                    for (int i = 0; i < 2; ++i) { float* hp = HSUM + g * MLW + hd * 256 + js * 64 + 16 * (nb + i) + l15; const float hv = oc[i][e] * inv; if (dir) unsafeAtomicAdd(hp, hv); else *hp = hv; } } } }
#pragma unroll
            for (int mi = 0; mi < 2; ++mi)
#pragma unroll
                for (int cc = 0; cc < 4; ++cc) accC[mi][cc] = accC[mi][cc] * a_dec;
            accN[0] = accN[0] * a_dec; accN[1] = accN[1] * a_dec;
            const unsigned ktq = (unsigned)(KI + (wid >> 2) * 16384) + 64u * ((unsigned)(wid & 3) ^ (unsigned)(l15 >> 2));
#pragma unroll
            for (int ks = 0; ks < 2; ++ks) {
                bf16x8 kf[2], wf[4];
#pragma unroll
                for (int mi = 0; mi < 2; ++mi) kf[mi] = tr_frag(BT[0][mi] + ktq + (unsigned)(8192 * ks), BT[1][mi] + ktq + (unsigned)(8192 * ks));
#pragma unroll
                for (int cc = 0; cc < 4; ++cc) wf[cc] = TRFRAG(VI, 4 + cc, ks);
                { const f32x4 wa = *(const LAS f32x4*)(sc + SC_WW + 32 * ks + 8 * lg), wb = *(const LAS f32x4*)(sc + SC_WW + 32 * ks + 8 * lg + 4);
                  u32x4 wq; wq.x = pk2(wa[0], wa[1]); wq.y = pk2(wa[2], wa[3]); wq.z = pk2(wb[0], wb[1]); wq.w = pk2(wb[2], wb[3]);
                  if (l15 != 0) wq = (u32x4){0u, 0u, 0u, 0u};
                  const bf16x8 wfn = __builtin_bit_cast(bf16x8, wq);
#pragma unroll
                  for (int mi = 0; mi < 2; ++mi) accN[mi] = mfma16(kf[mi], wfn, accN[mi]); }
#pragma unroll
                for (int mi = 0; mi < 2; ++mi)
#pragma unroll
                    for (int cc = 0; cc < 4; ++cc) accC[mi][cc] = mfma16(kf[mi], wf[cc], accC[mi][cc]);
            }
#pragma unroll
            for (int mi = 0; mi < 2; ++mi)
#pragma unroll
                for (int cc = 0; cc < 4; ++cc) { const int dk0 = 32 * wid + 16 * mi + 4 * lg, dv = 16 * cc + l15; u32x2 w; w.x = pk2(accC[mi][cc][0], accC[mi][cc][1]); w.y = pk2(accC[mi][cc][2], accC[mi][cc][3]);
                    *(LAS u32x2*)(lds + CI + (dk0 >> 7) * 16384 + off_b(dv, (dk0 & 127) >> 3) + (dk0 & 7) * 2) = w; }
            if (l15 == 0) { *(LAS f32x4*)(sc + SC_N + 32 * wid + 4 * lg) = accN[0]; *(LAS f32x4*)(sc + SC_N + 32 * wid + 16 + 4 * lg) = accN[1]; }
            __syncthreads();
            if (ci + 1 < 65) STAGE_WRITE();
        }
    }
#undef ROWG
#undef STAGE_LOAD
#undef STAGE_WRITE
#undef ROWRD
#undef TRFRAG
}
__device__ __forceinline__ void mlstm_phase(int bx, const bf16_t* UQKVO, const float* GP, float* HSUM, LAS unsigned char* lds, LAS float* sc) {
    if (bx >= 192) return;
    const int xcd = bx & 7, idx = bx >> 3, pair = xcd * 6 + (idx >> 2), js = idx & 3;
    mlstm_unit(pair >> 2, pair & 3, js, UQKVO, GP, HSUM, lds, sc);
}
}

#ifndef PHM
#define PHM 0xffff
#endif
#ifndef REP_ML
#define REP_ML 1
#endif
#ifndef REP_ATTN
#define REP_ATTN 1
#endif
#ifndef KV_SPLIT
#define KV_SPLIT 193
#endif
#ifndef REP_WIN
#define REP_WIN 1
#endif
#ifndef REP_UP
#define REP_UP 1
#endif
__global__ void __launch_bounds__(512, 2) fwd_kernel(Params P, unsigned char* ws_arg, unsigned char* out_arg) {
    extern __shared__ __attribute__((aligned(16))) unsigned char lds_raw[];
    Frame F;
    F.lds = (LAS unsigned char*)lds_raw;
    F.tid = threadIdx.x; F.lane = F.tid & 63; F.wave = __builtin_amdgcn_readfirstlane(F.tid >> 6);
    F.G = GRID; F.bx = blockIdx.x; F.vcu = (F.bx % 8) * (GRID / 8) + F.bx / 8;
    F.gw = F.vcu * 8 + F.wave; F.ngw = F.G * 8;
    { unsigned char* ws0 = ws_arg;
      for (int u = F.tid; u < (LDS_BYTES - MISC_OFF) / 4; u += 512) ((LAS unsigned*)(F.lds + MISC_OFF))[u] = 0u;
      __syncthreads();
      (void)ws0; }
    LAS unsigned long long* ptab = (LAS unsigned long long*)(F.lds + MISC_OFF + 64);
    if (F.tid == 0) {
#pragma unroll
        for (int k = 0; k < 19; ++k) ptab[k] = (unsigned long long)(uintptr_t)P.in[k]; }
    __syncthreads();
    XcdBarrier bar = xcd_barrier_post((unsigned*)(ws_arg + WS_CTL) + CW_BAR, (volatile LAS unsigned*)(F.lds + MISC_OFF));
    LAS float* sc = (LAS float*)(F.lds + MISC_OFF + 1024);
#define BXL() ({ int b__ = F.bx; asm volatile("" : "+s"(b__)); b__; })
#define PFRAME() Frame Fp = F; { int t_ = threadIdx.x; asm volatile("" : "+v"(t_)); Fp.tid = t_; Fp.lane = t_ & 63; int b_ = BXL(); Fp.bx = b_; Fp.vcu = (b_ % 8) * (GRID / 8) + b_ / 8; Fp.gw = Fp.vcu * 8 + Fp.wave; }
#define WSB() ({ GAS unsigned char* w__ = (GAS unsigned char*)ws_arg; asm volatile("" : "+s"(w__)); (unsigned char*)w__; })
#define DOB() ({ GAS unsigned char* w__ = (GAS unsigned char*)out_arg; asm volatile("" : "+s"(w__)); (unsigned char*)w__; })

    { unsigned char* ws = WSB(); prologue(F, ws, ptab); convert_weights(F, ws, ptab, 0); }
    xcd_barrier(bar);

    for (int l = 0; l < DEPTH; ++l) {
        { unsigned char* ws = WSB();
          pg8::Gemm g{(bf16_t*)(ws + WS_HB), (bf16_t*)(ws + WS_WIN), TP, NIN, DM, DM}; pg8::PanelOrder S; S.init(NPAN, 0, 0, 0, NIN, F.G, BXL());
          pg8::EpiWin E{(bf16_t*)(ws + WS_UQKVO), (bf16_t*)(ws + WS_UDQ), (bf16_t*)(ws + WS_UDKV), (bf16_t*)(ws + WS_KR), (float*)(ws + WS_GATES), (const float*)(ws + WS_COS), (const float*)(ws + WS_SIN)};
#if PHM & 2
          pg8::gemm_phase<pg8::EpiWin, pg8::PanelOrder, true, true>(F.lds, g, S, E);
#endif
        }
#if REP_WIN > 1
        __syncthreads();
        { unsigned char* ws = WSB();
          pg8::Gemm g{(bf16_t*)(ws + WS_HB), (bf16_t*)(ws + WS_WIN), TP, NIN, DM, DM}; pg8::PanelOrder S; S.init(NPAN, 0, 0, 0, NIN, F.G, BXL());
          pg8::EpiWin E{(bf16_t*)(ws + WS_UQKVO), (bf16_t*)(ws + WS_UDQ), (bf16_t*)(ws + WS_UDKV), (bf16_t*)(ws + WS_KR), (float*)(ws + WS_GATES), (const float*)(ws + WS_COS), (const float*)(ws + WS_SIN)};
          pg8::gemm_phase<pg8::EpiWin, pg8::PanelOrder, true, true>(F.lds, g, S, E);
        }
#endif
        xcd_barrier(bar);
        { unsigned char* ws = WSB(); unsigned char* dob = DOB(); PFRAME(); rstd_rows(Fp, (bf16_t*)(ws + WS_UDQ), (bf16_t*)(ws + WS_UDKV), (float*)(ws + WS_RSTD));
          ml::gate_prep(Fp.gw, Fp.ngw, Fp.lane, (const float*)(ws + WS_GATES), (const float*)(ws + WS_PAR) + PO_BG + l * 16, (float*)(dob + DO_GP)); }
        xcd_barrier(bar);
        if (F.bx >= 192) {
        { unsigned char* ws = WSB(); unsigned char* dob = DOB();
          pg8::Gemm g{(bf16_t*)(ws + WS_UDQ), (bf16_t*)(ws + WS_WUQ), TP, NQ, 512, 512}; pg8::PanelOrder S; S.init(NPAN, 0, 0, 0, NQ, GRID - 192, BXL() - 192);
          pg8::EpiQ E{(bf16_t*)(dob + DO_MQ), (const float*)(ws + WS_RSTD), (const float*)(ws + WS_COS), (const float*)(ws + WS_SIN)};
#if PHM & 4
          pg8::gemm_phase<pg8::EpiQ, pg8::PanelOrder, true, true>(F.lds, g, S, E);
#endif
        }
        { unsigned char* ws = WSB();
          pg8::Gemm g{(bf16_t*)(ws + WS_UDKV), (bf16_t*)(ws + WS_WUKV), TP, NKV, 256, 256}; pg8::PanelOrder S; S.init(NPAN, 0, 0, 0, NKV, GRID - 192, BXL() - 192);
          pg8::EpiBf16G E{(bf16_t*)(ws + WS_MKV), NKV, (const float*)(ws + WS_RSTD) + 1, 0, -1, 0};
#if PHM & 8
          pg8::gemm_phase<pg8::EpiBf16G, pg8::PanelOrder, true, true>(F.lds, g, S, E);
#endif
        }
        } else {
#ifndef NO_ML
        for (int rep_ = 0; rep_ < REP_ML; ++rep_)
        { unsigned char* ws = WSB(); unsigned char* dob = DOB();
          ml::mlstm_phase(BXL(), (const bf16_t*)(ws + WS_UQKVO), (const float*)(dob + DO_GP), (float*)(dob + DO_HSUM), F.lds, sc); }
#endif
        }
        xcd_barrier(bar);
        { unsigned char* ws = WSB(); unsigned char* dob = DOB(); PFRAME();
          if (Fp.vcu >= 96) mlstm_finalize(Fp, (Fp.vcu - 96) * 8 + Fp.wave, (GRID - 96) * 8, (const float*)(dob + DO_HSUM), (const bf16_t*)(ws + WS_UQKVO), (const float*)(ws + WS_PAR) + PO_MLG + l * MLW, (bf16_t*)(ws + WS_HB)); }
#ifndef NO_ATTN
        for (int rep_ = 0; rep_ < REP_ATTN; ++rep_)
        { unsigned char* ws = WSB(); unsigned char* dob = DOB();
          att::attn_phase(({ int b__ = BXL(); (b__ % 8) * (GRID / 8) + b__ / 8; }), (const bf16_t*)(dob + DO_MQ), (const bf16_t*)(ws + WS_MKV), (const bf16_t*)(ws + WS_KR), (bf16_t*)(ws + WS_HB), (LAS char*)F.lds); }
#endif
        xcd_barrier(bar);
        { unsigned char* ws = WSB();
          pg8::Gemm g{(bf16_t*)(ws + WS_HB), (bf16_t*)(ws + WS_WOUT), TP, DM, DM, DM}; pg8::PanelOrder S; S.init(192, 0, 0, 0, DM, F.G, BXL());
          pg8::EpiResidLn E{(float*)(ws + WS_H), DM, ALPHA, (const float*)(ws + WS_STAT2), (const float*)(ws + WS_PAR) + (l > 0 ? PO_L2G + (l - 1) * DM : PO_ONE), (const float*)(ws + WS_PAR) + (l > 0 ? PO_L2B + (l - 1) * DM : PO_ZERO)};
#if PHM & 16
          pg8::gemm_phase<pg8::EpiResidLn, pg8::PanelOrder, true, true>(F.lds, g, S, E);
#endif
        }
        { unsigned char* ws = WSB();
          pg8::Gemm g{(bf16_t*)(ws + WS_HB), (bf16_t*)(ws + WS_WOUT), TP, DM, DM / 4, DM}; pg8::SplitOrder S; S.init(PMETA, DM, 4, F.G, BXL());
          pg8::EpiAtomic E{(float*)(ws + WS_H), DM};
#if PHM & 16
          pg8::gemm_phase<pg8::EpiAtomic, pg8::SplitOrder, true, true>(F.lds, g, S, E);
#endif
        }
        xcd_barrier(bar);
        { unsigned char* ws = WSB(); PFRAME(); ln_rows(Fp, (float*)(ws + WS_H), (bf16_t*)(ws + WS_HB), (const float*)(ws + WS_PAR) + PO_L1G + l * DM, (const float*)(ws + WS_PAR) + PO_L1B + l * DM, (float*)(ws + WS_STAT1), nullptr); }
        xcd_barrier(bar);
        { unsigned char* ws = WSB(); unsigned char* dob = DOB();
          pg8::Gemm g{(bf16_t*)(ws + WS_HB), (bf16_t*)(ws + WS_WUP), TP, NUP, DM, DM}; pg8::PanelOrder S; S.init(NPAN, 0, 0, 0, NUP, F.G, BXL());
          pg8::EpiFfn E{(bf16_t*)(ws + WS_ACT), (float*)(dob + DO_SIDE), (bf16_t*)(dob + DO_GVM), (const float*)(ws + WS_PAR) + PO_CW + (size_t)l * 3 * DFF, (const float*)(ws + WS_PAR) + PO_CB + (size_t)l * DFF, (LAS float*)(F.lds + MISC_OFF + 8192)};
#if PHM & 32
          pg8::gemm_phase<pg8::EpiFfn, pg8::PanelOrder, true, true>(F.lds, g, S, E);
#if REP_UP > 1
          __syncthreads(); pg8::gemm_phase<pg8::EpiFfn, pg8::PanelOrder, true, true>(F.lds, g, S, E);
#endif
#endif
        }
        xcd_barrier(bar);
        { unsigned char* ws = WSB(); unsigned char* dob = DOB(); PFRAME();
          ffn_fixup(Fp, (const float*)(dob + DO_SIDE), (const bf16_t*)(dob + DO_GVM), (bf16_t*)(ws + WS_ACT), (const float*)(ws + WS_PAR) + PO_CW + (size_t)l * 3 * DFF, (const float*)(ws + WS_PAR) + PO_CB + (size_t)l * DFF); }
        xcd_barrier(bar);
        { unsigned char* ws = WSB();
          pg8::Gemm g{(bf16_t*)(ws + WS_ACT), (bf16_t*)(ws + WS_WDN), TP, DM, DFF, DFF}; pg8::PanelOrder S; S.init(192, 0, 0, 0, DM, F.G, BXL());
          pg8::EpiResidLn E{(float*)(ws + WS_H), DM, ALPHA, (const float*)(ws + WS_STAT1), (const float*)(ws + WS_PAR) + PO_L1G + l * DM, (const float*)(ws + WS_PAR) + PO_L1B + l * DM};
#if PHM & 64
          pg8::gemm_phase<pg8::EpiResidLn, pg8::PanelOrder, true, true>(F.lds, g, S, E);
#endif
        }
        { unsigned char* ws = WSB();
          pg8::Gemm g{(bf16_t*)(ws + WS_ACT), (bf16_t*)(ws + WS_WDN), TP, DM, DFF / 11, DFF}; pg8::SplitOrder S; S.init(PMETA, DM, 11, F.G, BXL());
          pg8::EpiAtomic E{(float*)(ws + WS_H), DM};
#if PHM & 64
          pg8::gemm_phase<pg8::EpiAtomic, pg8::SplitOrder, true, true>(F.lds, g, S, E);
#endif
        }
        xcd_barrier(bar);
        { unsigned char* ws = WSB(); unsigned char* dob = DOB();
          PFRAME(); ln_rows(Fp, (float*)(ws + WS_H), (bf16_t*)(ws + WS_HB), (const float*)(ws + WS_PAR) + PO_L2G + l * DM, (const float*)(ws + WS_PAR) + PO_L2B + l * DM, (float*)(ws + WS_STAT2), l == DEPTH - 1 ? (float*)dob : nullptr); }
        if (l + 1 < DEPTH) { unsigned char* ws = WSB(); PFRAME(); convert_weights(Fp, ws, ptab, l + 1); }
        xcd_barrier(bar);
    }
}

extern "C" void kernel_launch(void* const* d_in, const int* in_sizes, int n_in, void* d_out, int out_size, void* d_ws, size_t ws_size, hipStream_t stream) {
    static int grid = 0;
    if (grid == 0) {
        if (n_in != 19 || out_size != NMAIN * DM || ws_size < WS_NEED) { fprintf(stderr, "kernel_launch: unexpected shapes (n_in %d out %d ws %zu need %zu)\n", n_in, out_size, ws_size, (size_t)WS_NEED); grid = -1; return; }
        int dev = 0, cus = 0;
        if (hipGetDevice(&dev) != hipSuccess || hipDeviceGetAttribute(&cus, hipDeviceAttributeMultiprocessorCount, dev) != hipSuccess) { grid = -1; return; }
        if (hipFuncSetAttribute((const void*)fwd_kernel, hipFuncAttributeMaxDynamicSharedMemorySize, LDS_BYTES) != hipSuccess) { fprintf(stderr, "kernel_launch: hipFuncSetAttribute failed\n"); grid = -1; return; }
        int per_cu = 0;
        if (hipOccupancyMaxActiveBlocksPerMultiprocessor(&per_cu, (const void*)fwd_kernel, 512, LDS_BYTES) != hipSuccess || per_cu < 1) { fprintf(stderr, "kernel_launch: occupancy query says %d blocks per CU\n", per_cu); (void)hipGetLastError(); grid = -1; return; }
        if (cus < GRID) { fprintf(stderr, "kernel_launch: needs %d CUs, device has %d\n", GRID, cus); grid = -1; return; }
        grid = GRID;
    }
    if (grid < 0) return;
    (void)hipMemsetAsync((char*)d_ws + WS_CTL, 0, CTL_BYTES, stream);
    Params p{};
    for (int i = 0; i < 19; ++i) p.in[i] = (const float*)d_in[i];
    hipLaunchKernelGGL(fwd_kernel, dim3(grid), dim3(512), LDS_BYTES, stream, p, (unsigned char*)d_ws, (unsigned char*)d_out);
}
```

```cpp
#include <hip/hip_runtime.h>
#include <cstdio>
#include <cstdint>

#define LAS __attribute__((address_space(3)))
#define GAS __attribute__((address_space(1)))
typedef float f32x2 __attribute__((ext_vector_type(2)));
typedef float f32x8 __attribute__((ext_vector_type(8)));
typedef float f32x16 __attribute__((ext_vector_type(16)));
typedef unsigned u32x2 __attribute__((ext_vector_type(2)));
typedef short s16x4 __attribute__((ext_vector_type(4)));
typedef __bf16 bf16x2v __attribute__((ext_vector_type(2)));

constexpr int DM = 2048, NSEQ = 12, LREAL = 4096, NMETA = 16, DEPTH = 4;
constexpr int NMAIN = NSEQ * LREAL;
constexpr int MROW0 = NMAIN;
constexpr int NTOK = NMAIN + NSEQ * NMETA;
constexpr int NPAN = 193, TP = NPAN * 256;
constexpr int PMETA = 192;
constexpr int INC = 4944, NIN = 5120;
constexpr int DFF = 5632, NUP = 2 * DFF;
constexpr int MLW = 1024, NQ = 1536, NKV = 2048;
constexpr float ALPHA = 1.681792830507429f;
constexpr float EPS = 1e-5f;
constexpr float NEGBIG = -1e30f;

constexpr size_t MiB = 1u << 20;
constexpr size_t WS_CTL = 0, CTL_BYTES = 1 * MiB;
constexpr size_t WS_COS = 1 * MiB;
constexpr size_t WS_SIN = WS_COS + (size_t)4112 * 32 * 4;
constexpr size_t WS_PAR = 2 * MiB + 128 * 1024;
constexpr int PO_BG = 0, PO_MLG = PO_BG + DEPTH * 16, PO_QG = PO_MLG + DEPTH * 1024, PO_KVG = PO_QG + DEPTH * 512, PO_L1G = PO_KVG + DEPTH * 256, PO_L1B = PO_L1G + DEPTH * 2048,
              PO_CW = PO_L1B + DEPTH * 2048, PO_CB = PO_CW + DEPTH * 3 * 5632, PO_L2G = PO_CB + DEPTH * 5632, PO_L2B = PO_L2G + DEPTH * 2048, PO_ONE = PO_L2B + DEPTH * 2048, PO_ZERO = PO_ONE + 2048, PO_END = PO_ZERO + 2048;
static_assert(WS_PAR + (size_t)PO_END * 4 <= 3 * MiB && WS_PAR >= 1 * MiB + 2 * 4112 * 32 * 4, "PAR block placement");
constexpr size_t WS_WIN = 3 * MiB;
constexpr size_t WS_WUQ = WS_WIN + (size_t)NIN * DM * 2;
constexpr size_t WS_WUKV = WS_WUQ + (size_t)NQ * 512 * 2;
constexpr size_t WS_WOUT = WS_WUKV + (size_t)NKV * 256 * 2;
constexpr size_t WS_WUP = WS_WOUT + (size_t)DM * DM * 2;
constexpr size_t WS_WDN = WS_WUP + (size_t)NUP * DM * 2;
constexpr size_t WS_STAT1 = WS_WDN + (size_t)DM * DFF * 2;
constexpr size_t WS_STAT2 = WS_CTL + 512 * 1024;
constexpr size_t WS_H = 100 * MiB;
constexpr size_t WS_HB = WS_H + (size_t)TP * DM * 4;
constexpr size_t WS_R = WS_HB + (size_t)TP * DM * 2;
constexpr size_t WS_UQKVO = WS_R;
constexpr size_t WS_UDQ = WS_UQKVO + (size_t)TP * 4096 * 2;
constexpr size_t WS_UDKV = WS_UDQ + (size_t)TP * 512 * 2;
constexpr size_t WS_GATES = WS_UDKV + (size_t)TP * 256 * 2;
constexpr size_t WS_MKV = WS_GATES + (size_t)TP * 16 * 4;
constexpr size_t WS_KR = WS_MKV + (size_t)TP * NKV * 2;
constexpr size_t WS_RSTD = WS_KR + (size_t)TP * 64 * 2;
constexpr size_t WS_END_A = WS_RSTD + (size_t)TP * 2 * 4;
constexpr size_t WS_ACT = WS_R;
constexpr size_t WS_END_B = WS_ACT + (size_t)TP * DFF * 2;
constexpr size_t WS_NEED = (WS_END_A > WS_END_B ? WS_END_A : WS_END_B);
static_assert(WS_STAT1 + (size_t)TP * 8 <= WS_H && WS_STAT2 + (size_t)TP * 8 <= WS_CTL + CTL_BYTES, "weights and row statistics fit below H");
constexpr size_t DO_HSUM = 0;
constexpr size_t DO_MQ = DO_HSUM + (size_t)TP * MLW * 4;
constexpr size_t DO_GP = 340 * MiB;
constexpr size_t DO_SIDE = 0;
constexpr size_t DO_GVM = 32 * MiB;
static_assert(DO_MQ + (size_t)TP * NQ * 2 <= DO_GP && DO_GP + (size_t)96 * 65 * 200 * 4 <= (size_t)NMAIN * DM * 4 && (size_t)192 * 6 * DFF * 4 <= DO_GVM && DO_GVM + (size_t)256 * NUP * 2 <= (size_t)NMAIN * DM * 4, "d_out scratch fits");
constexpr int CW_BAR = 4096;

constexpr int RING_BYTES = 131072;
constexpr int MISC_OFF = RING_BYTES;
constexpr int LDS_BYTES = 147456;
constexpr int GRID = 256;

__device__ __forceinline__ int pos_of_row(int row) { return row < NMAIN ? NMETA + (row & (LREAL - 1)) : ((row - NMAIN) & (NMETA - 1)); }
__device__ __forceinline__ unsigned pk2(float lo, float hi) { f32x2 v = {lo, hi}; return __builtin_bit_cast(unsigned, __builtin_convertvector(v, bf16x2v)); }
__device__ __forceinline__ float bf_lo(unsigned w) { return __uint_as_float(w << 16); }
__device__ __forceinline__ float bf_hi(unsigned w) { return __uint_as_float(w & 0xffff0000u); }
__device__ __forceinline__ float wave_sum(float v) {
#pragma unroll
    for (int o = 1; o < 64; o <<= 1) v += __shfl_xor(v, o);
    return v;
}
__device__ __forceinline__ float wave_max(float v) {
#pragma unroll
    for (int o = 1; o < 64; o <<= 1) v = fmaxf(v, __shfl_xor(v, o));
    return v;
}
namespace pg8 {
#define PG8_LAS __attribute__((address_space(3)))
typedef unsigned short bf16_t;
typedef short bf16x8 __attribute__((ext_vector_type(8)));
typedef float f32x4 __attribute__((ext_vector_type(4)));
typedef unsigned u32x4 __attribute__((ext_vector_type(4)));
constexpr int BM = 256, BK = 64, HALF = 128, HTB = HALF * BK * 2  , STAGE_BYTES = 8 * HTB, NXCD = 8, WGM = 4;

__host__ __device__ __forceinline__ int lds_byte(int r, int c) { const int st = (r >> 4) * 2 + (c >> 5), rr = r & 15, cc = c & 31, ob = rr * 64 + cc * 2; return st * 1024 + (ob ^ (((ob >> 9) & 1) << 5)); }
__host__ __device__ __forceinline__ void stage_rc(int b, int& R, int& C) { const int st = b / 1024, sb = b % 1024, swz = sb ^ (((sb >> 9) & 1) << 5); R = (st >> 1) * 16 + swz / 64; C = (st & 1) * 32 + (swz % 64) / 2; }
__host__ __device__ __forceinline__ int perm32(int rho) { const int n = rho >> 4, i = rho & 15; return 8 * (i >> 2) + 4 * n + (i & 3); }

struct Unit { int pm, pn, kk; };
struct Gemm { const bf16_t* A; const bf16_t* Bt; int M, N, K, ld; };

struct PanelOrder {
    int nM, nN, nwg, G, c, nMain, pm0, pmx;
    __device__ void init(int nMain_, int pm0_, int extra, int pmx_, int N, int G_, int c_) { nMain = nMain_; pm0 = pm0_; pmx = pmx_; nM = nMain_ + extra; nN = N / BM; nwg = nM * nN; G = G_; c = c_; }
    __device__ bool next(int i, Unit& u) const {
        const long L = (long)i * G + c; if (L >= nwg) return false;
        int wgid = (int)L; { const int q = nwg / NXCD, r = nwg % NXCD, xcd = wgid % NXCD, off = wgid / NXCD; wgid = (xcd < r ? xcd * (q + 1) : r * (q + 1) + (xcd - r) * q) + off; }
        const int nig = WGM * nN, gid = wgid / nig, fm = gid * WGM, gsz = (nM - fm) < WGM ? (nM - fm) : WGM;
        const int pl = fm + ((wgid % nig) % gsz); u.pm = pl < nMain ? pm0 + pl : pmx; u.pn = (wgid % nig) / gsz; u.kk = 0; return true;
    }
    __device__ __forceinline__ void a_ready(const Unit&) const {}
    __device__ __forceinline__ void done(const Unit&) const {}
};

struct SplitOrder {
    int pm, nN, nwg, G, c;
    __device__ void init(int pm_, int N, int nsplit, int G_, int c_) { pm = pm_; nN = N / BM; nwg = nN * nsplit; G = G_; c = c_; }
    __device__ bool next(int i, Unit& u) const { const int L = i * G + c; if (L >= nwg) return false; u.pm = pm; u.pn = L % nN; u.kk = L / nN; return true; }
    __device__ __forceinline__ void a_ready(const Unit&) const {}
    __device__ __forceinline__ void done(const Unit&) const {}
};

__device__ __forceinline__ u32x4 pack8(const f32x4 v0, const f32x4 v1) { u32x4 w; w.x = pk2(v0[0], v0[1]); w.y = pk2(v0[2], v0[3]); w.z = pk2(v1[0], v1[1]); w.w = pk2(v1[2], v1[3]); return w; }

struct EpiBf16G {
    static constexpr bool PERM = true, AFTER_DRAIN = false;
    bf16_t* O; int ldc; const float* rs; int pm_sub, pm_sp, pm_sp_out;
    __device__ __forceinline__ void operator()(const f32x4 (&acc)[2][2][4][2], const Unit& u, int wr, int wc, int fr, int fq) const {
        const int opm = (u.pm == pm_sp) ? pm_sp_out : u.pm - pm_sub;
        const int rin = u.pm * BM + wr * 64 + fr, rout = opm * BM + wr * 64 + fr, col0 = u.pn * BM + wc * 32 + 8 * fq;
#pragma unroll
        for (int ai = 0; ai < 2; ++ai)
#pragma unroll
            for (int m = 0; m < 4; ++m) { const float sc = rs ? rs[(size_t)(rin + ai * HALF + m * 16) * 2] : 1.f;
                bf16_t* rowp = O + (size_t)(rout + ai * HALF + m * 16) * ldc + col0;
#pragma unroll
                for (int bj = 0; bj < 2; ++bj) *(u32x4*)(rowp + bj * HALF) = pack8(acc[ai][bj][m][0] * sc, acc[ai][bj][m][1] * sc); }
    }
};
struct EpiWin {
    static constexpr bool PERM = true, AFTER_DRAIN = false;
    bf16_t *UQKVO, *UDQ, *UDKV, *KR; float* GATES; const float *COS, *SIN;
    __device__ __forceinline__ void operator()(const f32x4 (&acc)[2][2][4][2], const Unit& u, int wr, int wc, int fr, int fq) const {
        const int row0 = u.pm * BM + wr * 64 + fr;
        if (u.pn < 19) {
            bf16_t* base; int ldc, colt;
            if (u.pn < 16) { base = UQKVO; ldc = 4096; colt = u.pn * BM; } else if (u.pn < 18) { base = UDQ; ldc = 512; colt = (u.pn - 16) * BM; } else { base = UDKV; ldc = 256; colt = 0; }
            const int col0 = colt + wc * 32 + 8 * fq;
#pragma unroll
            for (int ai = 0; ai < 2; ++ai)
#pragma unroll
                for (int m = 0; m < 4; ++m) { bf16_t* rowp = base + (size_t)(row0 + ai * HALF + m * 16) * ldc + col0;
#pragma unroll
                    for (int bj = 0; bj < 2; ++bj) *(u32x4*)(rowp + bj * HALF) = pack8(acc[ai][bj][m][0], acc[ai][bj][m][1]); }
        } else {
            if (wc < 2) { const int g = 4 * wc + fq;
#pragma unroll
                for (int ai = 0; ai < 2; ++ai)
#pragma unroll
                    for (int m = 0; m < 4; ++m) { const int row = row0 + ai * HALF + m * 16, pos = pos_of_row(row);
                        const f32x4 cs = *(const f32x4*)(COS + pos * 32 + 4 * g), sn = *(const f32x4*)(SIN + pos * 32 + 4 * g);
                        const f32x4 x1 = acc[ai][0][m][0], x2 = acc[ai][0][m][1];
                        *(u32x4*)(KR + (size_t)row * 64 + 8 * g) = pack8(x1 * cs - x2 * sn, x1 * sn + x2 * cs); }
            } else if (wc == 2 && fq < 2) {
#pragma unroll
                for (int ai = 0; ai < 2; ++ai)
#pragma unroll
                    for (int m = 0; m < 4; ++m) { float* gp = GATES + (size_t)(row0 + ai * HALF + m * 16) * 16 + 8 * fq;
                        *(f32x4*)gp = acc[ai][0][m][0]; *(f32x4*)(gp + 4) = acc[ai][0][m][1]; }
            }
        }
    }
};
struct EpiQ {
    static constexpr bool PERM = true, AFTER_DRAIN = false;
    bf16_t* MQ; const float *RSTD, *COS, *SIN;
    __device__ __forceinline__ void operator()(const f32x4 (&acc)[2][2][4][2], const Unit& u, int wr, int wc, int fr, int fq) const {
        const int row0 = u.pm * BM + wr * 64 + fr, colb = u.pn * BM + wc * 32 + 8 * fq;
#pragma unroll
        for (int ai = 0; ai < 2; ++ai)
#pragma unroll
            for (int m = 0; m < 4; ++m) { const int row = row0 + ai * HALF + m * 16, pos = pos_of_row(row); const float sc = RSTD[(size_t)row * 2];
#pragma unroll
                for (int bj = 0; bj < 2; ++bj) { const int col0 = colb + bj * HALF, o = col0 % 192;
                    f32x4 v0 = acc[ai][bj][m][0] * sc, v1 = acc[ai][bj][m][1] * sc;
                    if (o >= 128) { const int g = (o - 128) >> 3; const f32x4 cs = *(const f32x4*)(COS + pos * 32 + 4 * g), sn = *(const f32x4*)(SIN + pos * 32 + 4 * g);
                        const f32x4 x1 = v0, x2 = v1; v0 = x1 * cs - x2 * sn; v1 = x1 * sn + x2 * cs; }
                    *(u32x4*)(MQ + (size_t)row * NQ + col0) = pack8(v0, v1); } }
    }
};
__device__ __forceinline__ void resid_ln_tile(float* __restrict__ Cw, const float* __restrict__ Cr, const float* __restrict__ st, const float* __restrict__ g, const float* __restrict__ b,
                                              int ldc, float alpha, const f32x4 (&acc)[2][2][4][2], int row0, int col0) {
    asm volatile("" ::: "memory");
#pragma unroll
    for (int ai = 0; ai < 2; ++ai)
#pragma unroll
        for (int bj = 0; bj < 2; ++bj) {
            f32x4 gv[2], bv[2], hv[4][2]; f32x2 ms[4];
#pragma unroll
            for (int n = 0; n < 2; ++n) { gv[n] = *(const f32x4*)(g + col0 + bj * HALF + n * 16) * alpha; bv[n] = *(const f32x4*)(b + col0 + bj * HALF + n * 16) * alpha; }
#pragma unroll
            for (int m = 0; m < 4; ++m) { const int row = row0 + ai * HALF + m * 16; ms[m] = *(const f32x2*)(st + (size_t)row * 2);
#pragma unroll
                for (int n = 0; n < 2; ++n) hv[m][n] = *(const f32x4*)(Cr + (size_t)row * ldc + col0 + bj * HALF + n * 16); }
#pragma unroll
            for (int m = 0; m < 4; ++m) { const int row = row0 + ai * HALF + m * 16;
#pragma unroll
                for (int n = 0; n < 2; ++n) *(f32x4*)(Cw + (size_t)row * ldc + col0 + bj * HALF + n * 16) = (hv[m][n] - ms[m][0]) * ms[m][1] * gv[n] + bv[n] + acc[ai][bj][m][n]; }
        }
}
struct EpiResidLn {
    static constexpr bool PERM = false, AFTER_DRAIN = false;
    float* C; int ldc; float alpha; const float* st; const float* g; const float* b;
    __device__ __forceinline__ void operator()(const f32x4 (&acc)[2][2][4][2], const Unit& u, int wr, int wc, int fr, int fq) const {
        resid_ln_tile(this->C, this->C, this->st, this->g, this->b, this->ldc, this->alpha, acc, u.pm * BM + wr * 64 + fr, u.pn * BM + wc * 32 + 4 * fq);
    }
};
struct EpiAtomic {
    static constexpr bool PERM = false, AFTER_DRAIN = false;
    float* C; int ldc;
    __device__ __forceinline__ void operator()(const f32x4 (&acc)[2][2][4][2], const Unit& u, int wr, int wc, int fr, int fq) const {
        const int row0 = u.pm * BM + wr * 64 + fr, col0 = u.pn * BM + wc * 32 + 4 * fq;
#pragma unroll
        for (int ai = 0; ai < 2; ++ai)
#pragma unroll
            for (int m = 0; m < 4; ++m) { float* rowp = C + (size_t)(row0 + ai * HALF + m * 16) * ldc + col0;
#pragma unroll
                for (int bj = 0; bj < 2; ++bj)
#pragma unroll
                    for (int n = 0; n < 2; ++n) { float* p = rowp + bj * HALF + n * 16;
#pragma unroll
                        for (int e = 0; e < 4; ++e) unsafeAtomicAdd(p + e, acc[ai][bj][m][n][e]); } }
    }
};

__device__ __forceinline__ float dpp_ror1(float x) { return __int_as_float(__builtin_amdgcn_mov_dpp(__float_as_int(x), 0x121, 0xf, 0xf, false)); }
__device__ __forceinline__ float dpp_ror15(float x) { return __int_as_float(__builtin_amdgcn_mov_dpp(__float_as_int(x), 0x12f, 0xf, 0xf, false)); }
struct EpiFfn {
    static constexpr bool PERM = true, AFTER_DRAIN = false;
    bf16_t* ACT; float* SIDE; bf16_t* GVM; const float *cw, *cb; PG8_LAS float* X;
    __device__ __forceinline__ void operator()(const f32x4 (&acc)[2][2][4][2], const Unit& u, int wr_in, int wc_in, int fr_in, int fq_in) const {
        int fr = fr_in, fq = fq_in, wr = wr_in, wc = wc_in; asm volatile("" : "+v"(fr), "+v"(fq), "+s"(wr), "+s"(wc));
        const int cj = wc * 32 + 8 * fq, c0 = u.pn * 128 + cj;
        if (u.pm == PMETA) {
#pragma unroll
            for (int ai = 0; ai < 2; ++ai)
#pragma unroll
                for (int m = 0; m < 4; ++m) { bf16_t* rowp = GVM + (size_t)(ai * HALF + wr * 64 + m * 16 + fr) * NUP + c0;
                    *(u32x4*)rowp = pack8(acc[ai][0][m][0], acc[ai][0][m][1]); *(u32x4*)(rowp + DFF) = pack8(acc[ai][1][m][0], acc[ai][1][m][1]); }
            return;
        }
        f32x4 w0[2], w1[2], w2[2], bb[2];
#pragma unroll
        for (int n = 0; n < 2; ++n) { w0[n] = *(const f32x4*)(cw + c0 + 4 * n); w1[n] = *(const f32x4*)(cw + DFF + c0 + 4 * n); w2[n] = *(const f32x4*)(cw + 2 * DFF + c0 + 4 * n); bb[n] = *(const f32x4*)(cb + c0 + 4 * n); }
#pragma unroll
        for (int ai = 0; ai < 2; ++ai) { const int b = 2 * ai + wr;
            if (fr == 0) { *(PG8_LAS f32x4*)(X + (b * 2 + 0) * 128 + cj) = acc[ai][0][0][0]; *(PG8_LAS f32x4*)(X + (b * 2 + 0) * 128 + cj + 4) = acc[ai][0][0][1]; }
            if (fr == 15) { *(PG8_LAS f32x4*)(X + (b * 2 + 1) * 128 + cj) = acc[ai][0][3][0]; *(PG8_LAS f32x4*)(X + (b * 2 + 1) * 128 + cj + 4) = acc[ai][0][3][1]; } }
        asm volatile("s_waitcnt lgkmcnt(0)" ::: "memory"); __builtin_amdgcn_s_barrier(); asm volatile("" ::: "memory");
        const bool is15 = fr == 15, is0 = fr == 0;
        const unsigned rowb = (unsigned)(u.pm * BM + wr * 64 + fr) * DFF + c0;
#pragma unroll
        for (int ai = 0; ai < 2; ++ai) { const int b = 2 * ai + wr;
            f32x4 xp[2], xn[2];
#pragma unroll
            for (int n = 0; n < 2; ++n) { xp[n] = b > 0 ? *(const PG8_LAS f32x4*)(X + ((b - 1) * 2 + 1) * 128 + cj + 4 * n) : (f32x4){0.f, 0.f, 0.f, 0.f};
                                          xn[n] = b < 3 ? *(const PG8_LAS f32x4*)(X + ((b + 1) * 2 + 0) * 128 + cj + 4 * n) : (f32x4){0.f, 0.f, 0.f, 0.f}; }
#pragma unroll
            for (int m = 0; m < 4; ++m) { u32x4 ow;
#pragma unroll
                for (int n = 0; n < 2; ++n) { f32x4 o;
#pragma unroll
                    for (int e = 0; e < 4; ++e) { const float g = acc[ai][0][m][n][e];
                        const float gup = m > 0 ? acc[ai][0][m > 0 ? m - 1 : 0][n][e] : xp[n][e], gdn = m < 3 ? acc[ai][0][m < 3 ? m + 1 : 3][n][e] : xn[n][e];
                        const float pv = dpp_ror1(is15 ? gup : g);
                        const float nx = dpp_ror15(is0 ? gdn : g);
                        const float x = w0[n][e] * pv + w1[n][e] * g + w2[n][e] * nx + bb[n][e];
                        o[e] = x * __builtin_amdgcn_rcpf(1.f + __expf(-x)) * acc[ai][1][m][n][e]; }
                    if (n == 0) { ow.x = pk2(o[0], o[1]); ow.y = pk2(o[2], o[3]); } else { ow.z = pk2(o[0], o[1]); ow.w = pk2(o[2], o[3]); } }
                bf16_t* dst = ACT + (rowb + (unsigned)(ai * HALF + m * 16) * DFF);
                if ((ai == 0 && m == 0) || (ai == 1 && m == 3)) {
                    const int r = ai * HALF + wr * 64 + m * 16 + fr;
                    if (r != 0 && r != 255) *(u32x4*)dst = ow;
                    const int slot = r == 0 ? 0 : r == 1 ? 1 : r == 254 ? 2 : r == 255 ? 3 : -1;
                    if (slot >= 0) { float* sp = SIDE + ((size_t)u.pm * 6 + slot) * DFF + c0; *(f32x4*)sp = acc[ai][0][m][0]; *(f32x4*)(sp + 4) = acc[ai][0][m][1];
                        if (slot == 0 || slot == 3) { float* vp = SIDE + ((size_t)u.pm * 6 + (slot == 0 ? 4 : 5)) * DFF + c0; *(f32x4*)vp = acc[ai][1][m][0]; *(f32x4*)(vp + 4) = acc[ai][1][m][1]; } }
                } else *(u32x4*)dst = ow;
            }
        }
    }
};
template <class Epi, class Sched, bool ALIGN_EPI = false, bool SP2 = false>
__device__ __forceinline__ void gemm_phase(PG8_LAS unsigned char* lds, const Gemm g, const Sched& S, const Epi& E) {
    int tid_ = threadIdx.x; asm volatile("" : "+v"(tid_));
    const int tid = tid_, wid = __builtin_amdgcn_readfirstlane(tid >> 6), lane = tid & 63, wr = wid >> 2, wc = wid & 3, fr = lane & 15, fq = lane >> 4;
    const int K = g.ld, nt = g.K / BK;
    unsigned voffA[2], voffB[2];
#pragma unroll
    for (int i = 0; i < 2; ++i) { int R, C; stage_rc(tid * 16 + i * 8192, R, C); const int Rb = Epi::PERM ? ((R & ~31) + perm32(R & 31)) : R;
        voffA[i] = (unsigned)(R * K + C) * 2u; voffB[i] = (unsigned)(Rb * K + C) * 2u; }
    const size_t kstep = (size_t)(BK * 2);
    const size_t hstep = (size_t)HALF * K * 2;
    const size_t tstep = 2 * hstep;
    const unsigned ldsw = (unsigned)wid * 1024u;
    const int aoff = lds_byte(wr * 64 + fr, fq * 8), boff = lds_byte(wc * 32 + fr, fq * 8);
#define PG8_SA(b, h) (((b) * 2 + (h)) * HTB)
#define PG8_SB(b, h) ((4 + (b) * 2 + (h)) * HTB)
#define PG8_STAGE(bufoff, gbase, voff) do { _Pragma("unroll") for (int _i = 0; _i < 2; ++_i) \
        __builtin_amdgcn_global_load_lds((const unsigned*)((const char*)(gbase) + (voff)[_i]), (PG8_LAS unsigned*)(lds + (bufoff) + ldsw + _i * 8192), 16, 0, 0); } while (0)
#define PG8_LDA(dst, b, h) do { _Pragma("unroll") for (int m = 0; m < 4; ++m) _Pragma("unroll") for (int k = 0; k < 2; ++k) dst[m][k] = *(const PG8_LAS bf16x8*)(lds + PG8_SA(b, h) + aoff + m * 2048 + k * 1024); } while (0)
#define PG8_LDB(dst, b, h) do { _Pragma("unroll") for (int n = 0; n < 2; ++n) _Pragma("unroll") for (int k = 0; k < 2; ++k) dst[n][k] = *(const PG8_LAS bf16x8*)(lds + PG8_SB(b, h) + boff + n * 2048 + k * 1024); } while (0)
#define PG8_MMA(ai, bj, At, Bt) do { __builtin_amdgcn_s_setprio(1); _Pragma("unroll") for (int m = 0; m < 4; ++m) _Pragma("unroll") for (int n = 0; n < 2; ++n) _Pragma("unroll") for (int k = 0; k < 2; ++k) \
        acc[ai][bj][m][n] = __builtin_amdgcn_mfma_f32_16x16x32_bf16(Bt[n][k], At[m][k], acc[ai][bj][m][n], 0, 0, 0); __builtin_amdgcn_s_setprio(0); } while (0)
#define PG8_WAIT_V(n) asm volatile("s_waitcnt vmcnt(" #n ")" ::: "memory")
#define PG8_WAIT_L(n) asm volatile("s_waitcnt lgkmcnt(" #n ")" ::: "memory")
#define PG8_BAR __builtin_amdgcn_s_barrier()
#define PG8_SCHED __builtin_amdgcn_sched_barrier(0)
    Unit cur, nxt; int ui = 0;
    if (!S.next(0, cur)) return;
    f32x4 acc[2][2][4][2];
#pragma unroll
    for (int a = 0; a < 2; ++a)
#pragma unroll
        for (int b = 0; b < 2; ++b)
#pragma unroll
            for (int m = 0; m < 4; ++m)
#pragma unroll
                for (int n = 0; n < 2; ++n) acc[a][b][m][n] = (f32x4){0.f, 0.f, 0.f, 0.f};
    bf16x8 At[4][2], B0[2][2], B1[2][2];
    const size_t sstep = (size_t)g.K * 2;
    const char* cA = (const char*)g.A + (size_t)cur.pm * tstep + (size_t)cur.kk * sstep; const char* cB = (const char*)g.Bt + (size_t)cur.pn * tstep + (size_t)cur.kk * sstep;
    S.a_ready(cur);
    if constexpr (SP2) {
        PG8_STAGE(PG8_SB(0, 0), cB, voffB); PG8_STAGE(PG8_SB(0, 1), cB + hstep, voffB); PG8_STAGE(PG8_SA(0, 0), cA, voffA); PG8_STAGE(PG8_SA(0, 1), cA + hstep, voffA);
        if (wr == 1) PG8_BAR;
        PG8_WAIT_V(2); PG8_BAR;
        PG8_STAGE(PG8_SB(1, 0), cB + kstep, voffB); PG8_STAGE(PG8_SA(1, 0), cA + kstep, voffA); PG8_STAGE(PG8_SB(1, 1), cB + hstep + kstep, voffB);
        PG8_WAIT_V(6); PG8_BAR;
    } else {
        PG8_STAGE(PG8_SB(0, 0), cB, voffB); PG8_STAGE(PG8_SA(0, 0), cA, voffA); PG8_STAGE(PG8_SB(0, 1), cB + hstep, voffB); PG8_STAGE(PG8_SA(0, 1), cA + hstep, voffA);
        if (wr == 1) PG8_BAR;
        PG8_WAIT_V(4); PG8_BAR;
        PG8_STAGE(PG8_SB(1, 0), cB + kstep, voffB); PG8_STAGE(PG8_SA(1, 0), cA + kstep, voffA); PG8_STAGE(PG8_SB(1, 1), cB + hstep + kstep, voffB);
        PG8_WAIT_V(6); PG8_BAR;
    }
    for (;;) {
        const bool has_next = S.next(ui + 1, nxt);
        const char* nA = has_next ? (const char*)g.A + (size_t)nxt.pm * tstep + (size_t)nxt.kk * sstep : cA; const char* nB = has_next ? (const char*)g.Bt + (size_t)nxt.pn * tstep + (size_t)nxt.kk * sstep : cB;
        for (int t = 0; t < nt; t += 2) {
            const bool last = (t == nt - 2);
            const char* a1 = cA + (size_t)(t + 1) * kstep;
            const char* a2 = last ? nA : cA + (size_t)(t + 2) * kstep; const char* b2 = last ? nB : cB + (size_t)(t + 2) * kstep;
            const char* a3 = a2 + kstep; const char* b3 = b2 + kstep;
            if (last && has_next) S.a_ready(nxt);
            if constexpr (SP2) {
            PG8_LDB(B0, 0, 0); PG8_LDB(B1, 0, 1); PG8_SCHED; PG8_LDA(At, 0, 0); PG8_STAGE(PG8_SA(1, 1), a1 + hstep, voffA);
            PG8_WAIT_V(8); PG8_WAIT_L(0); PG8_BAR; PG8_MMA(0, 0, At, B0); PG8_MMA(0, 1, At, B1); PG8_BAR; PG8_SCHED;
            PG8_LDA(At, 0, 1); PG8_STAGE(PG8_SB(0, 0), b2, voffB); PG8_STAGE(PG8_SB(0, 1), b2 + hstep, voffB); PG8_STAGE(PG8_SA(0, 0), a2, voffA);
            PG8_WAIT_V(8); PG8_WAIT_L(0); PG8_BAR; PG8_MMA(1, 0, At, B0); PG8_MMA(1, 1, At, B1); PG8_BAR; PG8_SCHED;
            PG8_LDB(B0, 1, 0); PG8_LDB(B1, 1, 1); PG8_SCHED; PG8_LDA(At, 1, 0); PG8_STAGE(PG8_SA(0, 1), a2 + hstep, voffA);
            PG8_WAIT_V(8); PG8_WAIT_L(0); PG8_BAR; PG8_MMA(0, 0, At, B0); PG8_MMA(0, 1, At, B1); PG8_BAR; PG8_SCHED;
            PG8_LDA(At, 1, 1); PG8_STAGE(PG8_SB(1, 0), b3, voffB); PG8_STAGE(PG8_SB(1, 1), b3 + hstep, voffB); PG8_STAGE(PG8_SA(1, 0), a3, voffA);
            PG8_WAIT_V(8); PG8_WAIT_L(0); PG8_BAR; PG8_MMA(1, 0, At, B0); PG8_MMA(1, 1, At, B1); PG8_BAR; PG8_SCHED;
            } else {
            PG8_LDB(B0, 0, 0); PG8_SCHED; PG8_LDA(At, 0, 0); PG8_STAGE(PG8_SA(1, 1), a1 + hstep, voffA);
            PG8_WAIT_L(8); PG8_BAR; PG8_WAIT_L(0); PG8_MMA(0, 0, At, B0); PG8_BAR; PG8_SCHED;
            PG8_LDB(B1, 0, 1); PG8_STAGE(PG8_SB(0, 0), b2, voffB);
            PG8_BAR; PG8_WAIT_L(0); PG8_MMA(0, 1, At, B1); PG8_BAR;
            PG8_LDA(At, 0, 1); PG8_STAGE(PG8_SA(0, 0), a2, voffA);
            PG8_BAR; PG8_WAIT_L(0); PG8_MMA(1, 0, At, B0); PG8_BAR; PG8_SCHED;
            PG8_STAGE(PG8_SB(0, 1), b2 + hstep, voffB);
            PG8_WAIT_V(6); PG8_BAR; PG8_MMA(1, 1, At, B1); PG8_BAR;
            PG8_LDB(B0, 1, 0); PG8_SCHED; PG8_LDA(At, 1, 0); PG8_STAGE(PG8_SA(0, 1), a2 + hstep, voffA);
            PG8_WAIT_L(8); PG8_BAR; PG8_WAIT_L(0); PG8_MMA(0, 0, At, B0); PG8_BAR; PG8_SCHED;
            PG8_LDB(B1, 1, 1); PG8_STAGE(PG8_SB(1, 0), b3, voffB);
            PG8_BAR; PG8_WAIT_L(0); PG8_MMA(0, 1, At, B1); PG8_BAR;
            PG8_LDA(At, 1, 1); PG8_STAGE(PG8_SA(1, 0), a3, voffA);
            PG8_BAR; PG8_WAIT_L(0); PG8_MMA(1, 0, At, B0); PG8_BAR; PG8_SCHED;
            PG8_STAGE(PG8_SB(1, 1), b3 + hstep, voffB);
            PG8_WAIT_V(6); PG8_BAR; PG8_MMA(1, 1, At, B1); PG8_BAR;
            }
        }
        if constexpr (ALIGN_EPI) { if (wr == 0) PG8_BAR; }
        if constexpr (!Epi::AFTER_DRAIN) { E(acc, cur, wr, wc, fr, fq); S.done(cur); }
        if (!has_next) break;
#pragma unroll
        for (int a = 0; a < 2; ++a)
#pragma unroll
            for (int b = 0; b < 2; ++b)
#pragma unroll
                for (int m = 0; m < 4; ++m)
#pragma unroll
                    for (int n = 0; n < 2; ++n) acc[a][b][m][n] = (f32x4){0.f, 0.f, 0.f, 0.f};
        cur = nxt; cA = nA; cB = nB; ++ui;
        if constexpr (ALIGN_EPI) { if (wr == 1) PG8_BAR; }
    }
    PG8_WAIT_V(0);
    if constexpr (!ALIGN_EPI) { if (wr == 0) PG8_BAR; }
    PG8_BAR;
    if constexpr (Epi::AFTER_DRAIN) { E.fused(acc, cur, wr, wc, fr, fq, lds, wid, lane); S.done(cur); }
#undef PG8_SA
#undef PG8_SB
#undef PG8_STAGE
#undef PG8_LDA
#undef PG8_LDB
#undef PG8_MMA
#undef PG8_WAIT_V
#undef PG8_WAIT_L
#undef PG8_BAR
#undef PG8_SCHED
}
}
#define XB_TMO      128
#define XB_XCNT(j)  (256  + 64 * (j))
#define XB_XSUB(j)  (1280 + 64 * (j))
#define XB_XGEN(j)  (2304 + 64 * (j))
#define XB_TOP      3328
#define XB_TOPGEN   3392
#define XCD_BAR_WORDS 3456
#define XB_SPIN_CAP (1u << 21)

__device__ __forceinline__ unsigned xb_ld(unsigned* p)              { return __hip_atomic_load(p, __ATOMIC_RELAXED, __HIP_MEMORY_SCOPE_AGENT); }
__device__ __forceinline__ unsigned xb_add(unsigned* p, unsigned v) { return __hip_atomic_fetch_add(p, v, __ATOMIC_RELAXED, __HIP_MEMORY_SCOPE_AGENT); }
__device__ __forceinline__ unsigned xb_xcc_id() { return (unsigned)__builtin_amdgcn_s_getreg((3 << 11) | 20) & 0xFu; }
#define XB_SPIN(cond, bar) do { unsigned _sp = 0; while (cond) { __builtin_amdgcn_s_sleep(1); \
    if ((++_sp & 255u) == 0u) { if (xb_ld(&(bar)[XB_TMO])) break; if (_sp > XB_SPIN_CAP) { atomicAdd(&(bar)[XB_TMO], 1u); break; } } } } while (0)

struct XcdBarrier {
    unsigned* bar; unsigned x;
    volatile LAS unsigned* st;
};

__device__ __forceinline__ XcdBarrier xcd_barrier_post(unsigned* bar, volatile LAS unsigned* st) {
    XcdBarrier b; b.bar = bar; b.x = (unsigned)__builtin_amdgcn_readfirstlane((int)xb_xcc_id()); b.st = st;
    if (threadIdx.x == 0) (void)xb_add(&bar[XB_XCNT(b.x)], 1u);
    return b;
}
__device__ __forceinline__ void xcd_barrier_complete(unsigned* bar, unsigned x, unsigned& nloc, unsigned& nx) {
    const unsigned G = gridDim.x * gridDim.y * gridDim.z;
    unsigned sum, cnt, mine, sp = 0u;
    for (;;) {
        sum = 0u; cnt = 0u; mine = 0u;
#pragma unroll
        for (unsigned j = 0; j < 16; ++j) { const unsigned c = xb_ld(&bar[XB_XCNT(j)]); sum += c; cnt += (c > 0u) ? 1u : 0u; }
        mine = xb_ld(&bar[XB_XCNT(x)]);
        if (sum == G) { mine = xb_ld(&bar[XB_XCNT(x)]); break; }
        __builtin_amdgcn_s_sleep(1);
        if ((++sp & 255u) == 0u) { if (xb_ld(&bar[XB_TMO])) break; if (sp > XB_SPIN_CAP) { atomicAdd(&bar[XB_TMO], 1u); break; } }
    }
    nloc = mine > 0u ? mine : 1u; nx = cnt > 0u ? cnt : 1u;
}

__device__ __forceinline__ void xcd_barrier(const XcdBarrier& b) {
    asm volatile("s_waitcnt vmcnt(0)" ::: "memory");
    __syncthreads();
    if (threadIdx.x == 0) {
        unsigned* bar = b.bar; unsigned bx_ = b.x;
        asm volatile("" : "+s"(bx_));
        __builtin_amdgcn_s_waitcnt(0);
        unsigned nloc = b.st[0], nx = b.st[1];
        if (nloc == 0u) { xcd_barrier_complete(bar, bx_, nloc, nx); b.st[0] = nloc; b.st[1] = nx; }
        const unsigned old = xb_add(&bar[XB_XSUB(bx_)], 1u);
        const unsigned gen = old / nloc;
        if (old + 1u == (gen + 1u) * nloc) {
            __builtin_amdgcn_fence(__ATOMIC_RELEASE, "agent");
            asm volatile("s_waitcnt vmcnt(0)" ::: "memory");
            const unsigned og = xb_add(&bar[XB_TOP], 1u);
            const unsigned tg = og / nx;
            if (og + 1u == (tg + 1u) * nx) xb_add(&bar[XB_TOPGEN], 1u);
            else XB_SPIN(xb_ld(&bar[XB_TOPGEN]) == tg, bar);
            __builtin_amdgcn_fence(__ATOMIC_ACQUIRE, "agent");
            xb_add(&bar[XB_XGEN(bx_)], 1u);
            asm volatile("s_waitcnt vmcnt(0)" ::: "memory");
        } else {
            XB_SPIN(xb_ld(&bar[XB_XGEN(bx_)]) == gen, bar);
            __builtin_amdgcn_fence(__ATOMIC_ACQUIRE, "agent");
            asm volatile("s_waitcnt vmcnt(0)" ::: "memory");
        }
    }
    __syncthreads();
}

typedef unsigned short bf16_t;
typedef short bf16x8 __attribute__((ext_vector_type(8)));
typedef float f32x4 __attribute__((ext_vector_type(4)));
typedef unsigned u32x4 __attribute__((ext_vector_type(4)));
#define LDS_WAIT() asm volatile("s_waitcnt lgkmcnt(0)" ::: "memory")

struct Params {
    const float* in[19];
};
struct Frame {
    LAS unsigned char* lds;
    int tid, lane, wave, G, bx, vcu, gw, ngw;
};
__device__ __forceinline__ const float* uptr(const LAS unsigned long long* t, int k) {
    const unsigned long long v = t[k]; const unsigned lo = __builtin_amdgcn_readfirstlane((unsigned)v), hi = __builtin_amdgcn_readfirstlane((unsigned)(v >> 32));
    return (const float*)(const GAS float*)(((unsigned long long)hi << 32) | lo); }

template <class CMap>
__device__ __forceinline__ void transpose_item(const float* W, int K, int Nsrc, bf16_t* WT, const float* ks, LAS float* scr, int kb, int nb, int lane, CMap cmap) {
    const int k0 = 64 * kb, n0 = 32 * nb; const int sc = cmap(n0 + (lane & 31));
#pragma unroll 8
    for (int i = 0; i < 32; ++i) { const int kk = 2 * i + (lane >> 5); float v = 0.f; if (sc >= 0) v = W[(size_t)(k0 + kk) * Nsrc + sc]; if (ks) v *= ks[k0 + kk]; scr[kk * 33 + (lane & 31)] = v; }
    LDS_WAIT(); asm volatile("" ::: "memory");
    const int c = lane & 7;
#pragma unroll
    for (int j = 0; j < 4; ++j) { const int n = (lane >> 3) + 8 * j; const LAS float* s = scr + (8 * c) * 33 + n;
        u32x4 o; o.x = pk2(s[0 * 33], s[1 * 33]); o.y = pk2(s[2 * 33], s[3 * 33]); o.z = pk2(s[4 * 33], s[5 * 33]); o.w = pk2(s[6 * 33], s[7 * 33]);
        *(u32x4*)(WT + (size_t)(n0 + n) * K + k0 + 8 * c) = o; }
    LDS_WAIT(); asm volatile("" ::: "memory");
}
__device__ __forceinline__ int rope_perm(int m) { const int g = m >> 3, j = m & 7; return j < 4 ? 4 * g + j : 32 + 4 * g + (j - 4); }
struct CMapIn { __device__ int operator()(int n) const {
    if (n < 4096) return n; if (n < 4608) return 4112 + (n - 4096); if (n < 4864) return 4624 + (n - 4608);
    if (n < 4928) return 4880 + rope_perm(n - 4864); if (n < 4944) return 4096 + (n - 4928); return -1; } };
struct CMapQ { __device__ int operator()(int n) const { const int h = n / 192, o = n % 192; return o < 128 ? n : h * 192 + 128 + rope_perm(o - 128); } };
struct CMapUp { __device__ int operator()(int n) const { const int pn = n >> 8, j = n & 255; return j < 128 ? 128 * pn + j : DFF + 128 * pn + (j - 128); } };
struct CMapId { __device__ int operator()(int n) const { return n; } };

__device__ __forceinline__ void convert_weights(const Frame& F, unsigned char* ws, const LAS unsigned long long* pt, int l) {
    LAS float* scr = (LAS float*)(F.lds + F.wave * 8448);
    const float* w_in = uptr(pt, 3) + (size_t)l * DM * INC; const float* w_uq = uptr(pt, 8) + (size_t)l * 512 * NQ; const float* w_ukv = uptr(pt, 9) + (size_t)l * 256 * NKV;
    const float* w_out = uptr(pt, 10) + (size_t)l * DM * DM; const float* w_up = uptr(pt, 13) + (size_t)l * DM * NUP; const float* w_dn = uptr(pt, 16) + (size_t)l * DFF * DM;
    const float* qg = uptr(pt, 6) + (size_t)l * 512; const float* kvg = uptr(pt, 7) + (size_t)l * 256;
    { const int nnb = NIN / 32, items = (DM / 64) * nnb; for (int it = F.gw; it < items; it += F.ngw) transpose_item(w_in, DM, INC, (bf16_t*)(ws + WS_WIN), nullptr, scr, it / nnb, it % nnb, F.lane, CMapIn()); }
    { const int nnb = NQ / 32, items = (512 / 64) * nnb; for (int it = F.gw; it < items; it += F.ngw) transpose_item(w_uq, 512, NQ, (bf16_t*)(ws + WS_WUQ), qg, scr, it / nnb, it % nnb, F.lane, CMapQ()); }
    { const int nnb = NKV / 32, items = (256 / 64) * nnb; for (int it = F.gw; it < items; it += F.ngw) transpose_item(w_ukv, 256, NKV, (bf16_t*)(ws + WS_WUKV), kvg, scr, it / nnb, it % nnb, F.lane, CMapId()); }
    { const int nnb = DM / 32, items = (DM / 64) * nnb; for (int it = F.gw; it < items; it += F.ngw) transpose_item(w_out, DM, DM, (bf16_t*)(ws + WS_WOUT), nullptr, scr, it / nnb, it % nnb, F.lane, CMapId()); }
    { const int nnb = NUP / 32, items = (DM / 64) * nnb; for (int it = F.gw; it < items; it += F.ngw) transpose_item(w_up, DM, NUP, (bf16_t*)(ws + WS_WUP), nullptr, scr, it / nnb, it % nnb, F.lane, CMapUp()); }
    { const int nnb = DM / 32, items = (DFF / 64) * nnb; for (int it = F.gw; it < items; it += F.ngw) transpose_item(w_dn, DFF, DM, (bf16_t*)(ws + WS_WDN), nullptr, scr, it / nnb, it % nnb, F.lane, CMapId()); }
}

__device__ __forceinline__ void prologue(const Frame& F, unsigned char* ws, const LAS unsigned long long* pt) {
    float* COS = (float*)(ws + WS_COS); float* SIN = (float*)(ws + WS_SIN);
    for (int i = F.bx * 512 + F.tid; i < 4112 * 32; i += F.G * 512) { const int pos = i >> 5, f = i & 31;
        const float inv = powf(10000.0f, -(float)(2 * f) / 64.0f); const float ang = (float)pos * inv; float s, c; sincosf(ang, &s, &c); COS[i] = c; SIN[i] = s; }
    { float* PAR = (float*)(ws + WS_PAR); const int gt = F.bx * 512 + F.tid, nt = F.G * 512;
      for (int i = gt; i < DEPTH * 16; i += nt) PAR[PO_BG + i] = uptr(pt, 4)[i];
      for (int i = gt; i < DEPTH * 1024; i += nt) PAR[PO_MLG + i] = uptr(pt, 5)[i];
      for (int i = gt; i < DEPTH * 512; i += nt) PAR[PO_QG + i] = uptr(pt, 6)[i];
      for (int i = gt; i < DEPTH * 256; i += nt) PAR[PO_KVG + i] = uptr(pt, 7)[i];
      for (int i = gt; i < 2048; i += nt) { PAR[PO_ONE + i] = 1.f; PAR[PO_ZERO + i] = 0.f; }
      { float* ST2 = (float*)(ws + WS_STAT2); for (int i = gt; i < TP; i += nt) { ST2[2 * i] = 0.f; ST2[2 * i + 1] = 1.f; } }
      for (int i = gt; i < DEPTH * 2048; i += nt) { PAR[PO_L1G + i] = uptr(pt, 11)[i]; PAR[PO_L1B + i] = uptr(pt, 12)[i]; PAR[PO_L2G + i] = uptr(pt, 17)[i]; PAR[PO_L2B + i] = uptr(pt, 18)[i]; }
      for (int i = gt; i < DEPTH * 3 * 5632; i += nt) PAR[PO_CW + i] = uptr(pt, 14)[i];
      for (int i = gt; i < DEPTH * 5632; i += nt) PAR[PO_CB + i] = uptr(pt, 15)[i]; }
    float* H = (float*)(ws + WS_H); bf16_t* HB = (bf16_t*)(ws + WS_HB);
    const float* xp = uptr(pt, 0); const float* xs = uptr(pt, 1); const float* mt = uptr(pt, 2);
    for (int row = F.gw; row < TP; row += F.ngw) {
        const float* src = nullptr;
        if (row < 4 * LREAL) src = xp + (size_t)row * DM; else if (row < NMAIN) src = xs + (size_t)(row - 4 * LREAL) * DM; else if (row < NTOK) src = mt + (size_t)((row - NMAIN) & 15) * DM;
        f32x4* hd = (f32x4*)(H + (size_t)row * DM) + F.lane; u32x2* bd = (u32x2*)(HB + (size_t)row * DM) + F.lane;
#pragma unroll
        for (int j = 0; j < 8; ++j) { f32x4 v = {0.f, 0.f, 0.f, 0.f}; if (src) v = ((const f32x4*)src)[F.lane + 64 * j]; hd[64 * j] = row >= NMAIN ? v * ALPHA : v;
            u32x2 b; b.x = pk2(v[0], v[1]); b.y = pk2(v[2], v[3]); bd[64 * j] = b; }
    }
}

__device__ __forceinline__ void ln_rows(const Frame& F, float* H, bf16_t* HB, const float* g, const float* b, float* ST, float* out) {
    for (int row = F.gw; row < TP; row += F.ngw) {
        f32x4* hp = (f32x4*)(H + (size_t)row * DM) + F.lane; f32x4 v[8]; float s = 0.f;
#pragma unroll
        for (int j = 0; j < 8; ++j) { v[j] = hp[64 * j]; s += (v[j][0] + v[j][1]) + (v[j][2] + v[j][3]); }
        const float mean = wave_sum(s) * (1.f / DM); float q = 0.f;
#pragma unroll
        for (int j = 0; j < 8; ++j) { v[j] = v[j] - mean; q += (v[j][0] * v[j][0] + v[j][1] * v[j][1]) + (v[j][2] * v[j][2] + v[j][3] * v[j][3]); }
        const float rstd = rsqrtf(wave_sum(q) * (1.f / DM) + EPS);
        if (F.lane == 0) { f32x2 ms = {mean, rstd}; *(f32x2*)(ST + (size_t)row * 2) = ms; }
        u32x2* bd = (u32x2*)(HB + (size_t)row * DM) + F.lane;
#pragma unroll
        for (int j = 0; j < 8; ++j) { const f32x4 gg = ((const f32x4*)g)[F.lane + 64 * j], bb = ((const f32x4*)b)[F.lane + 64 * j]; const f32x4 y = v[j] * rstd * gg + bb;
            u32x2 w; w.x = pk2(y[0], y[1]); w.y = pk2(y[2], y[3]); bd[64 * j] = w;
            if (row >= NMAIN) hp[64 * j] = y * ALPHA;
            else if (out) ((f32x4*)(out + (size_t)row * DM))[F.lane + 64 * j] = y; }
    }
}

__device__ __forceinline__ void rstd_rows(const Frame& F, const bf16_t* UDQ, const bf16_t* UDKV, float* RSTD) {
    for (int row = F.gw; row < TP; row += F.ngw) {
        const u32x4 a = ((const u32x4*)(UDQ + (size_t)row * 512))[F.lane]; float s = 0.f;
#pragma unroll
        for (int j = 0; j < 4; ++j) { const float x = bf_lo(a[j]), y = bf_hi(a[j]); s += x * x + y * y; }
        float t = 0.f;
        if (F.lane < 32) { const u32x4 c = ((const u32x4*)(UDKV + (size_t)row * 256))[F.lane];
#pragma unroll
            for (int j = 0; j < 4; ++j) { const float x = bf_lo(c[j]), y = bf_hi(c[j]); t += x * x + y * y; } }
        s = wave_sum(s); t = wave_sum(t);
        if (F.lane == 0) { RSTD[(size_t)row * 2] = rsqrtf(s * (1.f / 512.f) + EPS); RSTD[(size_t)row * 2 + 1] = rsqrtf(t * (1.f / 256.f) + EPS); }
    }
}

__device__ __forceinline__ void mlstm_finalize(const Frame& F, int gw0, int ngw0, const float* HSUM, const bf16_t* UQKVO, const float* ng, bf16_t* MIX) {
    for (int row = gw0; row < TP; row += ngw0) {
#pragma unroll
        for (int j = 0; j < 4; ++j) {
            f32x4 v = ((const f32x4*)(HSUM + (size_t)row * MLW + 256 * j))[F.lane];
            const float mean = wave_sum((v[0] + v[1]) + (v[2] + v[3])) * (1.f / 256.f); v = v - mean;
            const float rstd = rsqrtf(wave_sum((v[0] * v[0] + v[1] * v[1]) + (v[2] * v[2] + v[3] * v[3])) * (1.f / 256.f) + EPS);
            const f32x4 gg = ((const f32x4*)(ng + 256 * j))[F.lane];
            const u32x2 uo = ((const u32x2*)(UQKVO + (size_t)row * 4096 + 3072 + 256 * j))[F.lane];
            const float o0 = bf_lo(uo.x), o1 = bf_hi(uo.x), o2 = bf_lo(uo.y), o3 = bf_hi(uo.y);
            const float y0 = v[0] * rstd * gg[0] / (1.f + __expf(-o0)), y1 = v[1] * rstd * gg[1] / (1.f + __expf(-o1));
            const float y2 = v[2] * rstd * gg[2] / (1.f + __expf(-o2)), y3 = v[3] * rstd * gg[3] / (1.f + __expf(-o3));
            u32x2 w; w.x = pk2(y0, y1); w.y = pk2(y2, y3); ((u32x2*)(MIX + (size_t)row * DM + 256 * j))[F.lane] = w;
        }
    }
}

__device__ __forceinline__ f32x8 ld8f(const float* p) { const f32x4 a = *(const f32x4*)p, b = *(const f32x4*)(p + 4); return (f32x8){a[0], a[1], a[2], a[3], b[0], b[1], b[2], b[3]}; }
__device__ __forceinline__ f32x8 ld8b(const bf16_t* p) { const u32x4 v = *(const u32x4*)p; return (f32x8){bf_lo(v[0]), bf_hi(v[0]), bf_lo(v[1]), bf_hi(v[1]), bf_lo(v[2]), bf_hi(v[2]), bf_lo(v[3]), bf_hi(v[3])}; }
__device__ __forceinline__ void act_store(bf16_t* dst, const f32x8 gp, const f32x8 gc, const f32x8 gn, const f32x8 vv, const f32x8 w0, const f32x8 w1, const f32x8 w2, const f32x8 bb) {
    float o[8];
#pragma unroll
    for (int i = 0; i < 8; ++i) { const float x = w0[i] * gp[i] + w1[i] * gc[i] + w2[i] * gn[i] + bb[i]; o[i] = x / (1.f + __expf(-x)) * vv[i]; }
    u32x4 w; w.x = pk2(o[0], o[1]); w.y = pk2(o[2], o[3]); w.z = pk2(o[4], o[5]); w.w = pk2(o[6], o[7]); *(u32x4*)dst = w;
}
__device__ __forceinline__ void ffn_fixup(const Frame& F, const float* SIDE, const bf16_t* GVM, bf16_t* ACT, const float* cw, const float* cb) {
    constexpr int NCH = DFF / 8;
    const f32x8 zero = {0.f, 0.f, 0.f, 0.f, 0.f, 0.f, 0.f, 0.f};
    const int gt = F.bx * 512 + F.tid, nt = GRID * 512;
    for (int idx = gt; idx < 192 * 2 * NCH; idx += nt) {
        const int ch = idx % NCH, rsel = (idx / NCH) & 1, pm = idx / (2 * NCH), c0 = 8 * ch, sq = pm >> 4;
        const f32x8 w0 = ld8f(cw + c0), w1 = ld8f(cw + DFF + c0), w2 = ld8f(cw + 2 * DFF + c0), bb = ld8f(cb + c0);
        const float* S0 = SIDE + (size_t)pm * 6 * DFF + c0;
        if (rsel == 0) { const f32x8 gp = (pm & 15) ? ld8f(S0 - 6 * DFF + 3 * DFF) : ld8b(GVM + (size_t)(16 * sq + 15) * NUP + c0);
            act_store(ACT + (size_t)(pm * 256) * DFF + c0, gp, ld8f(S0), ld8f(S0 + DFF), ld8f(S0 + 4 * DFF), w0, w1, w2, bb);
        } else { const f32x8 gn = ((pm & 15) != 15) ? ld8f(S0 + 6 * DFF) : zero;
            act_store(ACT + (size_t)(pm * 256 + 255) * DFF + c0, ld8f(S0 + 2 * DFF), ld8f(S0 + 3 * DFF), gn, ld8f(S0 + 5 * DFF), w0, w1, w2, bb); }
    }
    for (int idx = gt; idx < NSEQ * NCH; idx += nt) {
        const int ch = idx % NCH, sq = idx / NCH, c0 = 8 * ch;
        const f32x8 w0 = ld8f(cw + c0), w1 = ld8f(cw + DFF + c0), w2 = ld8f(cw + 2 * DFF + c0), bb = ld8f(cb + c0);
        f32x8 gp = zero, gc = ld8b(GVM + (size_t)(16 * sq) * NUP + c0);
        for (int p = 0; p < 16; ++p) {
            const f32x8 gn = p < 15 ? ld8b(GVM + (size_t)(16 * sq + p + 1) * NUP + c0) : ld8f(SIDE + (size_t)(16 * sq) * 6 * DFF + c0);
            act_store(ACT + (size_t)(MROW0 + 16 * sq + p) * DFF + c0, gp, gc, gn, ld8b(GVM + (size_t)(16 * sq + p) * NUP + DFF + c0), w0, w1, w2, bb);
            gp = gc; gc = gn;
        }
    }
}

namespace att {
constexpr int NW = 8, QBLK = 32, KVBLK = 64, NT = 65;
constexpr int KROW = 400;
constexpr int SHM_V = KVBLK * 128 * 2, SHM_K = KVBLK * KROW;
constexpr int OFF_V = 0, OFF_K = 3 * SHM_V, OFF_WS = OFF_K + 3 * SHM_K, LDS_TOTAL = OFF_WS + NW * 64 * 4;
static_assert(LDS_TOTAL <= RING_BYTES, "attention LDS");
constexpr float SCALE = 0.07216878364870323f;
constexpr float THR = 8.f;
#define SBAR() __builtin_amdgcn_sched_barrier(0)
__device__ __forceinline__ int crow(int r, int hi) { return (r & 3) + 8 * (r >> 2) + 4 * hi; }
__device__ __forceinline__ unsigned cvtpk(float lo, float hi) { unsigned r; asm volatile("v_cvt_pk_bf16_f32 %0, %1, %2" : "=v"(r) : "v"(lo), "v"(hi)); return r; }

template <bool MASK16>
__device__ __forceinline__ void partialSM(f32x16& p0, f32x16& p1, float& m_reg, float& mn, float& alpha) {
    constexpr float C = SCALE * 1.4426950408889634f;
    if (MASK16) {
#pragma unroll
        for (int r = 8; r < 16; ++r) p0[r] = NEGBIG;
#pragma unroll
        for (int r = 0; r < 16; ++r) p1[r] = NEGBIG;
    }
    float pmax = p0[0];
#pragma unroll
    for (int r = 1; r < 16; ++r) pmax = fmaxf(pmax, p0[r]);
#pragma unroll
    for (int r = 0; r < 16; ++r) pmax = fmaxf(pmax, p1[r]);
    { auto rr = __builtin_amdgcn_permlane32_swap(__float_as_uint(pmax), __float_as_uint(pmax), false, false); pmax = fmaxf(__uint_as_float(rr[0]), __uint_as_float(rr[1])); }
    if (__builtin_expect(__all(pmax - m_reg <= THR / SCALE), 1)) { mn = m_reg; alpha = 1.f; }
    else { mn = fmaxf(m_reg, pmax); alpha = __builtin_amdgcn_exp2f((m_reg - mn) * C); m_reg = mn; }
    const float mnC = -mn * C;
#pragma unroll
    for (int r = 0; r < 16; ++r) p0[r] = fmaf(p0[r], C, mnC);
#pragma unroll
    for (int r = 0; r < 16; ++r) p1[r] = fmaf(p1[r], C, mnC);
#pragma unroll
    for (int r = 0; r < 16; ++r) p0[r] = __builtin_amdgcn_exp2f(p0[r]);
}
__device__ __forceinline__ void finishSM(f32x16& p0, f32x16& p1, float alpha, float& l_reg, bf16x8& pa0, bf16x8& pa1, bf16x8& pa2, bf16x8& pa3) {
#pragma unroll
    for (int r = 0; r < 16; ++r) p1[r] = __builtin_amdgcn_exp2f(p1[r]);
    float ps = 0;
#pragma unroll
    for (int r = 0; r < 16; ++r) ps += p0[r];
#pragma unroll
    for (int r = 0; r < 16; ++r) ps += p1[r];
    { auto rr = __builtin_amdgcn_permlane32_swap(__float_as_uint(ps), __float_as_uint(ps), false, false); ps = __uint_as_float(rr[0]) + __uint_as_float(rr[1]); }
    l_reg = l_reg * alpha + ps;
#define PK4(P, BASE, OUT) do { unsigned a0 = cvtpk(P[BASE + 0], P[BASE + 1]), a1 = cvtpk(P[BASE + 2], P[BASE + 3]);   \
    unsigned b0 = cvtpk(P[BASE + 4], P[BASE + 5]), b1 = cvtpk(P[BASE + 6], P[BASE + 7]);                              \
    auto r0 = __builtin_amdgcn_permlane32_swap(a0, b0, false, false); auto r1 = __builtin_amdgcn_permlane32_swap(a1, b1, false, false); \
    u32x4 w = {r0[0], r1[0], r0[1], r1[1]}; OUT = __builtin_bit_cast(bf16x8, w); } while (0)
    PK4(p0, 0, pa0); PK4(p0, 8, pa1); PK4(p1, 0, pa2); PK4(p1, 8, pa3);
#undef PK4
}
__device__ __forceinline__ void qkt(f32x16& p0, f32x16& p1, const LAS char* Ks, const bf16x8* qr, int r32, int hi) {
#pragma unroll
    for (int r = 0; r < 16; ++r) { p0[r] = 0.f; p1[r] = 0.f; }
#pragma unroll
    for (int d0 = 0; d0 < 12; ++d0) { const int cb = (d0 * 16 + hi * 8) * 2;
        const bf16x8 b0 = *(const LAS bf16x8*)(Ks + r32 * KROW + cb);
        const bf16x8 b1 = *(const LAS bf16x8*)(Ks + (32 + r32) * KROW + cb);
        p0 = __builtin_amdgcn_mfma_f32_32x32x16_bf16(b0, qr[d0], p0, 0, 0, 0);
        p1 = __builtin_amdgcn_mfma_f32_32x32x16_bf16(b1, qr[d0], p1, 0, 0, 0); }
}
__device__ __forceinline__ int v_st(int k, int c) { const int kk = (k & ~0xC) | ((k & 4) << 1) | ((k & 8) >> 1); return ((kk >> 3) * 4 + (c >> 5)) * 512 + ((kk & 7) * 32 + (c & 31)) * 2; }
__device__ __forceinline__ int v_rd_base(int lane) { return ((lane & 3) << 3) | (((lane >> 2) & 3) << 6) | (((lane >> 4) & 1) << 5) | (((lane >> 5) & 1) << 8); }
constexpr int v_rd_off(int d0, int ks, int half) { return d0 * 512 + ks * 4096 + half * 2048; }
template <int OFF> __device__ __forceinline__ s16x4 tr_read(int vb) { s16x4 r; asm volatile("ds_read_b64_tr_b16 %0, %1 offset:%2" : "=&v"(r) : "v"(vb), "i"(OFF) : "memory"); return r; }
template <int D0> __device__ __forceinline__ void pv_one(f32x16& od, int vb, bf16x8 pa0, bf16x8 pa1, bf16x8 pa2, bf16x8 pa3) {
    const s16x4 l0 = tr_read<v_rd_off(D0, 0, 0)>(vb), h0 = tr_read<v_rd_off(D0, 0, 1)>(vb), l1 = tr_read<v_rd_off(D0, 1, 0)>(vb), h1 = tr_read<v_rd_off(D0, 1, 1)>(vb);
    const s16x4 l2 = tr_read<v_rd_off(D0, 2, 0)>(vb), h2 = tr_read<v_rd_off(D0, 2, 1)>(vb), l3 = tr_read<v_rd_off(D0, 3, 0)>(vb), h3 = tr_read<v_rd_off(D0, 3, 1)>(vb);
    asm volatile("s_waitcnt lgkmcnt(0)" ::: "memory"); SBAR();
#define PKV(L, H) (bf16x8){L[0], L[1], L[2], L[3], H[0], H[1], H[2], H[3]}
    od = __builtin_amdgcn_mfma_f32_32x32x16_bf16(pa0, PKV(l0, h0), od, 0, 0, 0);
    od = __builtin_amdgcn_mfma_f32_32x32x16_bf16(pa1, PKV(l1, h1), od, 0, 0, 0);
    od = __builtin_amdgcn_mfma_f32_32x32x16_bf16(pa2, PKV(l2, h2), od, 0, 0, 0);
    od = __builtin_amdgcn_mfma_f32_32x32x16_bf16(pa3, PKV(l3, h3), od, 0, 0, 0);
#undef PKV
}
__device__ __forceinline__ void pv_d0(f32x16* o, int vb, bf16x8 pa0, bf16x8 pa1, bf16x8 pa2, bf16x8 pa3) {
    pv_one<0>(o[0], vb, pa0, pa1, pa2, pa3); pv_one<1>(o[1], vb, pa0, pa1, pa2, pa3); pv_one<2>(o[2], vb, pa0, pa1, pa2, pa3); pv_one<3>(o[3], vb, pa0, pa1, pa2, pa3);
}

__device__ __forceinline__ void attn_unit(int s, int h, int qb, const bf16_t* __restrict__ MQ, const bf16_t* __restrict__ MKV, const bf16_t* __restrict__ KR, bf16_t* __restrict__ MIX, LAS char* lds) {
    int tid_ = threadIdx.x; asm volatile("" : "+v"(tid_));
    const int tid = tid_, wid = tid >> 6, lane = tid & 63, r32 = lane & 31, hi = lane >> 5;
    LAS char* V_lds = lds + OFF_V; LAS char* K_lds = lds + OFF_K;
    LAS float* wsf = (LAS float*)(lds + OFF_WS) + wid * 64; LAS float* li_l = wsf; LAS float* al_l = wsf + 32;
    float m_reg = NEGBIG, l_reg = 0; f32x16 o[4]; bf16x8 qr[12];
#pragma unroll
    for (int d = 0; d < 4; ++d)
#pragma unroll
        for (int r = 0; r < 16; ++r) o[d][r] = 0.f;
    const int qi = wid * QBLK + r32;
    const unsigned qrow = qb < 16 ? (unsigned)s * LREAL + 256 * qb + qi : (unsigned)MROW0 + 16 * s + (qi < 15 ? qi : 15);
    { const bf16_t* Qw = MQ + (qrow * NQ + h * 192 + hi * 8);
#pragma unroll
      for (int d0 = 0; d0 < 12; ++d0) qr[d0] = *(const bf16x8*)(Qw + d0 * 16); }
    const int sr = tid >> 4, sc = (tid & 15) * 8, vst0 = v_st(sr, sc), vst1 = v_st(32 + sr, sc);
    const int kr_r = tid >> 3, kr_c = (tid & 7) * 8;
    const int vb0 = (int)(uintptr_t)V_lds + v_rd_base(lane);
    bf16x8 vs0, vs1, ks0, ks1, kr0;
    const unsigned mainrow0 = (unsigned)s * LREAL, metarow0 = (unsigned)MROW0 + 16 * s;
    const bf16_t* MKVh = MKV + h * 256;
#define KROWG(kt, k) ((kt) < 64 ? mainrow0 + 64u * (kt) + (k) : metarow0 + ((k) < 15 ? (k) : 15))
#define SLOAD(kt) do { const unsigned g0 = KROWG(kt, sr) * NKV + sc, g1 = KROWG(kt, 32 + sr) * NKV + sc, g2 = KROWG(kt, kr_r) * 64 + kr_c; \
    vs0 = *(const bf16x8*)(MKVh + 128 + g0); vs1 = *(const bf16x8*)(MKVh + 128 + g1); \
    ks0 = *(const bf16x8*)(MKVh + g0); ks1 = *(const bf16x8*)(MKVh + g1); kr0 = *(const bf16x8*)(KR + g2); } while (0)
#define SWRITE(b) do { *(LAS bf16x8*)(V_lds + (b) * SHM_V + vst0) = vs0; *(LAS bf16x8*)(V_lds + (b) * SHM_V + vst1) = vs1; \
    *(LAS bf16x8*)(K_lds + (b) * SHM_K + sr * KROW + sc * 2) = ks0; *(LAS bf16x8*)(K_lds + (b) * SHM_K + (32 + sr) * KROW + sc * 2) = ks1; \
    *(LAS bf16x8*)(K_lds + (b) * SHM_K + kr_r * KROW + 256 + kr_c * 2) = kr0; } while (0)
#define RESC(a) do { if (__any((a) < 1.f)) { if (hi == 0) al_l[r32] = (a); asm volatile("s_waitcnt lgkmcnt(0)" ::: "memory"); \
    _Pragma("unroll") for (int d = 0; d < 4; ++d) _Pragma("unroll") for (int r = 0; r < 16; ++r) o[d][r] *= al_l[crow(r, hi)]; } } while (0)
    f32x16 pA0, pA1, pB0, pB1; float mnA, mnB, alA, alB; bf16x8 pa0, pa1, pa2, pa3;
    __syncthreads();
    SLOAD(0); SWRITE(0); __syncthreads();
    qkt(pA0, pA1, K_lds, qr, r32, hi); partialSM<false>(pA0, pA1, m_reg, mnA, alA);
    SLOAD(1); SWRITE(1); __syncthreads();
    RESC(alA);
    int s0 = 0, s1 = 1, s2 = 2;
    for (int j = 1; j + 1 < NT; j += 2) {
        SBAR(); qkt(pB0, pB1, K_lds + s1 * SHM_K, qr, r32, hi);
        finishSM(pA0, pA1, alA, l_reg, pa0, pa1, pa2, pa3); SBAR();
        SLOAD(j + 1); SBAR();
        pv_d0(o, vb0 + s0 * SHM_V, pa0, pa1, pa2, pa3); partialSM<false>(pB0, pB1, m_reg, mnB, alB);
        SWRITE(s2);
        RESC(alB); __syncthreads();
        SBAR(); qkt(pA0, pA1, K_lds + s2 * SHM_K, qr, r32, hi);
        finishSM(pB0, pB1, alB, l_reg, pa0, pa1, pa2, pa3); SBAR();
        if (j + 2 < NT) SLOAD(j + 2); SBAR();
        pv_d0(o, vb0 + s1 * SHM_V, pa0, pa1, pa2, pa3);
        if (j + 1 == NT - 1) partialSM<true>(pA0, pA1, m_reg, mnA, alA); else partialSM<false>(pA0, pA1, m_reg, mnA, alA);
        if (j + 2 < NT) SWRITE(s0);
        RESC(alA); __syncthreads();
        { const int t0 = s0, t1 = s1; s0 = s2; s1 = t0; s2 = t1; }
    }
    finishSM(pA0, pA1, alA, l_reg, pa0, pa1, pa2, pa3); SBAR();
    pv_d0(o, vb0 + s0 * SHM_V, pa0, pa1, pa2, pa3);
    if (hi == 0) li_l[r32] = l_reg; asm volatile("s_waitcnt lgkmcnt(0)" ::: "memory");
    float rli[16];
#pragma unroll
    for (int r = 0; r < 16; ++r) rli[r] = __builtin_amdgcn_rcpf(li_l[crow(r, hi)]);
    if (qb < 16) {
        bf16_t* Ow = MIX + ((long)s * LREAL + 256 * qb + wid * QBLK) * DM + MLW + h * 128;
#pragma unroll
        for (int r = 0; r < 16; ++r) { const int orow = crow(r, hi);
#pragma unroll
            for (int d0 = 0; d0 < 4; ++d0) Ow[(long)orow * DM + d0 * 32 + r32] = (bf16_t)(pk2(o[d0][r] * rli[r], 0.f) & 0xffffu); }
    } else if (wid == 0) {
        bf16_t* Ow = MIX + ((long)MROW0 + 16 * s) * DM + MLW + h * 128;
#pragma unroll
        for (int r = 0; r < 16; ++r) { const int orow = crow(r, hi);
            if (orow < 16) {
#pragma unroll
                for (int d0 = 0; d0 < 4; ++d0) Ow[(long)orow * DM + d0 * 32 + r32] = (bf16_t)(pk2(o[d0][r] * rli[r], 0.f) & 0xffffu); } }
    }
#undef KROWG
#undef SLOAD
#undef SWRITE
#undef RESC
}
__device__ __forceinline__ void attn_phase(int vcu, const bf16_t* MQ, const bf16_t* MKV, const bf16_t* KR, bf16_t* MIX, LAS char* lds) {
    for (int i = (vcu < 96 ? -1 : 0); i < 6; ++i) { int sh, qb; if (i < 0) { sh = vcu; qb = 16; } else { const int id = i * GRID + vcu; sh = id >> 4; qb = id & 15; }
        attn_unit(sh >> 3, sh & 7, qb, MQ, MKV, KR, MIX, lds); }
}
#undef SBAR
}

namespace ml {
constexpr int QI = 0, KI = 32768, VI = 65536, SI = 81920, CI = 98304;
constexpr int SC_CT = 0, SC_BM = 64, SC_WI = 128, SC_EI = 192, SC_WW = 256, SC_DEN = 320, SC_QN = 448, SC_N = 512, SC_A = 768;
constexpr int GP_REC = 200;
__device__ __forceinline__ unsigned off_b(unsigned row, unsigned ch) { return 256u * row + 16u * (ch ^ (((row & 3) << 2) | ((row >> 2) & 3))); }
__device__ __forceinline__ unsigned row_read_addr_16(unsigned lane, unsigned rb, unsigned s) { return off_b((lane & 15) + 16 * rb, 4 * s + (lane >> 4)); }
__device__ __forceinline__ unsigned tr_read_addr_16(unsigned lane, unsigned c, unsigned ks, unsigned t) {
    const unsigned g = lane >> 4, q = (lane & 15) >> 2, p = lane & 3; return off_b(32 * ks + 8 * g + 4 * t + q, 2 * c + (p >> 1)) + 8 * (p & 1); }
__device__ __forceinline__ bf16x8 tr_frag(unsigned a0, unsigned a1) {
    const s16x4 lo = __builtin_amdgcn_ds_read_tr16_b64_v4i16((LAS s16x4*)a0), hi = __builtin_amdgcn_ds_read_tr16_b64_v4i16((LAS s16x4*)a1);
    return (bf16x8){lo[0], lo[1], lo[2], lo[3], hi[0], hi[1], hi[2], hi[3]};
}
__device__ __forceinline__ f32x4 mfma16(bf16x8 a, bf16x8 b, f32x4 c) { return __builtin_amdgcn_mfma_f32_16x16x32_bf16(a, b, c, 0, 0, 0); }
__device__ __forceinline__ float log_sigmoid(float x) { return fminf(x, 0.f) - __logf(1.f + __expf(-fabsf(x))); }

__device__ __forceinline__ void gate_prep(int gw, int ngw, int lane, const float* __restrict__ GATES, const float* __restrict__ bgl, float* __restrict__ GP) {
    for (int it = gw; it < 96 * 65; it += ngw) {
        const int chain = it / 65, c = it % 65, s = chain >> 3, hd = (chain >> 1) & 3, dir = chain & 1;
        const long g = c == 0 ? (lane >= 48 ? (long)MROW0 + 16 * s + lane - 48 : -1L) : (long)s * LREAL + 64 * (c - 1) + lane;
        float li = NEGBIG, lf = 0.f;
        if (g >= 0) { li = GATES[g * 16 + (dir ? 8 : 0) + hd] + bgl[(dir ? 8 : 0) + hd]; lf = log_sigmoid(GATES[g * 16 + (dir ? 12 : 4) + hd] + bgl[(dir ? 12 : 4) + hd]); }
        float x = dir ? __shfl(lf, 63 - lane) : lf;
#pragma unroll
        for (int o = 1; o < 64; o <<= 1) { const float y = __shfl_up(x, o); if (lane >= o) x += y; }
        const float btot = __shfl(x, 63);
        const float b = dir ? __shfl(x, 63 - lane) : x;
        const float a_s = li - b;
        float pm = dir ? __shfl(a_s, 63 - lane) : a_s;
#pragma unroll
        for (int o = 1; o < 64; o <<= 1) { const float y = __shfl_up(pm, o); if (lane >= o) pm = fmaxf(pm, y); }
        pm = dir ? __shfl(pm, 63 - lane) : pm;
        const float gmax = wave_max(btot - b + li);
        float* rec = GP + (size_t)it * GP_REC;
        rec[lane] = b; rec[64 + lane] = li; rec[128 + lane] = pm; if (lane == 0) { rec[192] = btot; rec[193] = gmax; }
    }
}

__device__ __forceinline__ void mlstm_unit(int s, int hd, int js, const bf16_t* __restrict__ UQKVO, const float* __restrict__ GP, float* __restrict__ HSUM, LAS unsigned char* lds, LAS float* sc) {
    const int wid = __builtin_amdgcn_readfirstlane((int)threadIdx.x >> 6);
    const unsigned ldsb = (unsigned)(uintptr_t)lds;
    const int tt = wid >> 1, nb = 2 * (wid & 1);
#define ROWRD(img, rb, s_) (*(const LAS bf16x8*)(uintptr_t)(RB[s_] + (unsigned)((img) + 4096 * (rb))))
#define TRFRAG(img, c_, ks) tr_frag(BT[0][(c_) & 1] + TQ[(c_) >> 1] + (unsigned)((img) + 8192 * (ks)), BT[1][(c_) & 1] + TQ[(c_) >> 1] + (unsigned)((img) + 8192 * (ks)))
    f32x4 accC[2][4], accN[2];
    for (int dir = 0; dir < 2; ++dir) {
        int tid; { int t0_ = threadIdx.x; asm volatile("" : "+v"(t0_)); tid = t0_; }
#pragma unroll
        for (int mi = 0; mi < 2; ++mi)
#pragma unroll
            for (int c = 0; c < 4; ++c) accC[mi][c] = (f32x4){0.f, 0.f, 0.f, 0.f};
        accN[0] = (f32x4){0.f, 0.f, 0.f, 0.f}; accN[1] = (f32x4){0.f, 0.f, 0.f, 0.f};
        if (tid < 256) sc[SC_N + tid] = 0.f;
        for (int i = tid; i < 32768 / 16; i += 512) *(LAS u32x4*)(lds + CI + i * 16) = (u32x4){0u, 0u, 0u, 0u};
        float m_state = 0.f;
        const float* GPc = GP + (size_t)(((s * 4 + hd) * 2 + dir) * 65) * GP_REC;
        u32x4 sq[4], sk[4], sv; float sb = 0.f, sli = NEGBIG, spm = NEGBIG, sbt = 0.f, sgm = NEGBIG;
#define ROWG(c, r) ((c) == 0 ? ((r) >= 48 ? (long)MROW0 + 16 * s + (r) - 48 : -1L) : (long)s * LREAL + 64 * ((c) - 1) + (r))
#define STAGE_LOAD(c) do { \
        _Pragma("unroll") for (int i = 0; i < 4; ++i) { const int id = tid + 512 * i, r = id >> 5, ch = id & 31; const long g = ROWG(c, r); \
            sq[i] = (u32x4){0u, 0u, 0u, 0u}; sk[i] = (u32x4){0u, 0u, 0u, 0u}; \
            if (g >= 0) { sq[i] = *(const u32x4*)(UQKVO + g * 4096 + hd * 256 + ch * 8); sk[i] = *(const u32x4*)(UQKVO + g * 4096 + 1024 + hd * 256 + ch * 8); } } \
        { const int r = tid >> 3, ch = tid & 7; const long g = ROWG(c, r); sv = (u32x4){0u, 0u, 0u, 0u}; if (g >= 0) sv = *(const u32x4*)(UQKVO + g * 4096 + 2048 + hd * 256 + js * 64 + ch * 8); } \
        if (tid < 64) { const float* rec = GPc + (size_t)(c) * GP_REC; sb = rec[tid]; sli = rec[64 + tid]; spm = rec[128 + tid]; sbt = rec[192]; sgm = rec[193]; } } while (0)
#define STAGE_WRITE() do { \
        _Pragma("unroll") for (int i = 0; i < 4; ++i) { const int id = tid + 512 * i, r = id >> 5, ch = id & 31; \
            *(LAS u32x4*)(lds + QI + (ch >> 4) * 16384 + off_b(r, ch & 15)) = sq[i]; *(LAS u32x4*)(lds + KI + (ch >> 4) * 16384 + off_b(r, ch & 15)) = sk[i]; } \
        { const int r = tid >> 3, ch = tid & 7; *(LAS u32x4*)(lds + VI + off_b(r, ch)) = sv; } \
        if (tid < 64) { const float m_inter = sb + m_state, mt = fmaxf(m_inter, sb + spm); const float m_new = fmaxf(sbt + m_state, sgm); \
            sc[SC_CT + tid] = sli - sb; sc[SC_BM + tid] = sb - mt; sc[SC_WI + tid] = __expf(m_inter - mt); sc[SC_EI + tid] = __expf(-mt); \
            sc[SC_WW + tid] = __expf(sbt - sb + sli - m_new) * 0.0625f; if (tid == 0) sc[SC_A] = __expf(sbt + m_state - m_new); m_state = m_new; } } while (0)
        const int c_first = dir ? 64 : 0, c_step = dir ? -1 : 1;
        STAGE_LOAD(c_first);
        __syncthreads();
        STAGE_WRITE();
        for (int ci = 0; ci < 65; ++ci) {
            const int c = c_first + c_step * ci;
            { int t2_ = threadIdx.x; asm volatile("" : "+v"(t2_)); tid = t2_; }
            const int lane = tid & 63, l15 = lane & 15, lg = lane >> 4;
            unsigned RB[4], BT[2][2], TQ[4];
            { const unsigned fl = ((l15 & 3) << 2) | (l15 >> 2), q = l15 >> 2, p = lane & 3, g = lg;
#pragma unroll
              for (int s_ = 0; s_ < 4; ++s_) { RB[s_] = ldsb + 256u * l15 + 16u * (lg ^ (fl & 3)) + 64u * (s_ ^ (fl >> 2)); TQ[s_] = 64u * (s_ ^ q); }
#pragma unroll
              for (int t_ = 0; t_ < 2; ++t_)
#pragma unroll
                  for (int cl = 0; cl < 2; ++cl) BT[t_][cl] = ldsb + 256u * (8 * g + q) + 8u * (p & 1) + 1024u * t_ + 16u * ((p >> 1) ^ t_) + 32u * (cl ^ (g & 1)); }
            __syncthreads();
            if (ci + 1 < 65) STAGE_LOAD(c + c_step);
            bf16x8 qf[8];
#pragma unroll
            for (int k = 0; k < 8; ++k) qf[k] = ROWRD(QI + (k >> 2) * 16384, tt, k & 3);
            f32x4 sT[2], oc[2];
#pragma unroll
            for (int i = 0; i < 2; ++i) { sT[i] = (f32x4){0.f, 0.f, 0.f, 0.f}; oc[i] = (f32x4){0.f, 0.f, 0.f, 0.f}; }
#pragma unroll
            for (int i = 0; i < 2; ++i)
#pragma unroll
                for (int k = 0; k < 8; ++k) {
                    const bf16x8 kf = ROWRD(KI + (k >> 2) * 16384, nb + i, k & 3);
                    sT[i] = mfma16(kf, qf[k], sT[i]);
                    const bf16x8 cf = ROWRD(CI + (k >> 2) * 16384, nb + i, k & 3);
                    oc[i] = mfma16(qf[k], cf, oc[i]);
                }
            {
                const int t = 16 * tt + l15; const float bmt = sc[SC_BM + t]; float rs = 0.f;
#pragma unroll
                for (int i = 0; i < 2; ++i) { const int s0 = 16 * (nb + i) + 4 * lg; const f32x4 ctv = *(const LAS f32x4*)(sc + SC_CT + s0); float v[4];
#pragma unroll
                    for (int e = 0; e < 4; ++e) { const int sx = s0 + e; const bool ok = dir ? (sx >= t) : (sx <= t);
                        const float ex = ok ? (bmt + ctv[e]) : NEGBIG; v[e] = sT[i][e] * 0.0625f * __expf(ex); rs += v[e]; }
                    u32x2 w; w.x = pk2(v[0], v[1]); w.y = pk2(v[2], v[3]);
                    *(LAS u32x2*)(lds + SI + off_b(t, s0 >> 3) + (s0 & 7) * 2) = w; }
                rs += __shfl_xor(rs, 16); rs += __shfl_xor(rs, 32);
                if (lg == 0) sc[SC_DEN + 64 * (wid & 1) + t] = rs;
            }
            { const int r = tid >> 3, ch = tid & 7; const u32x4 v = *(const LAS u32x4*)(lds + VI + off_b(r, ch)); const float w = sc[SC_WW + r]; u32x4 o;
#pragma unroll
              for (int jx = 0; jx < 4; ++jx) o[jx] = pk2(bf_lo(v[jx]) * w, bf_hi(v[jx]) * w);
              *(LAS u32x4*)(lds + VI + off_b(r, 8 + ch)) = o; }
            { const int r = tid >> 3, part = tid & 7; float d = 0.f;
#pragma unroll
              for (int i = 0; i < 4; ++i) { const int ch32 = part * 4 + i; const u32x4 v = *(const LAS u32x4*)(lds + QI + (ch32 >> 4) * 16384 + off_b(r, ch32 & 15));
                  const f32x4 n0 = *(const LAS f32x4*)(sc + SC_N + ch32 * 8), n1 = *(const LAS f32x4*)(sc + SC_N + ch32 * 8 + 4);
                  d += bf_lo(v[0]) * n0[0] + bf_hi(v[0]) * n0[1] + bf_lo(v[1]) * n0[2] + bf_hi(v[1]) * n0[3] + bf_lo(v[2]) * n1[0] + bf_hi(v[2]) * n1[1] + bf_lo(v[3]) * n1[2] + bf_hi(v[3]) * n1[3]; }
              d += __shfl_xor(d, 1); d += __shfl_xor(d, 2); d += __shfl_xor(d, 4);
              if (part == 0) sc[SC_QN + r] = d; }
            { const f32x4 wi = *(const LAS f32x4*)(sc + SC_WI + 16 * tt + 4 * lg);
#pragma unroll
              for (int i = 0; i < 2; ++i) oc[i] = oc[i] * wi; }
            __syncthreads();
            const float a_dec = sc[SC_A];
#pragma unroll
            for (int ks = 0; ks < 2; ++ks) { const bf16x8 sf = ROWRD(SI, tt, ks);
#pragma unroll
                for (int i = 0; i < 2; ++i) { const bf16x8 vf = TRFRAG(VI, nb + i, ks);
                    oc[i] = mfma16(sf, vf, oc[i]); } }
            { const int t0 = 16 * tt + 4 * lg;
              const f32x4 wi = *(const LAS f32x4*)(sc + SC_WI + t0), qn = *(const LAS f32x4*)(sc + SC_QN + t0), d0 = *(const LAS f32x4*)(sc + SC_DEN + t0), d1 = *(const LAS f32x4*)(sc + SC_DEN + 64 + t0), ei = *(const LAS f32x4*)(sc + SC_EI + t0);
#pragma unroll
              for (int e = 0; e < 4; ++e) { const long g = ROWG(c, t0 + e);
                const float den = wi[e] * qn[e] + (d0[e] + d1[e]); const float inv = 1.f / fmaxf(fabsf(den), ei[e]);
                if (g >= 0) {
#pragma unroll
                    for (int i = 0; i < 2; ++i) { float* hp = HSUM + g * MLW + hd * 256 + js * 64 + 16 * (nb + i) + l15; const float hv = oc[i][e] * inv; if (dir) unsafeAtomicAdd(hp, hv); else *hp = hv; } } } }
#pragma unroll
            for (int mi = 0; mi < 2; ++mi)
#pragma unroll
                for (int cc = 0; cc < 4; ++cc) accC[mi][cc] = accC[mi][cc] * a_dec;
            accN[0] = accN[0] * a_dec; accN[1] = accN[1] * a_dec;
            const unsigned ktq = (unsigned)(KI + (wid >> 2) * 16384) + 64u * ((unsigned)(wid & 3) ^ (unsigned)(l15 >> 2));
#pragma unroll
            for (int ks = 0; ks < 2; ++ks) {
                bf16x8 kf[2], wf[4];
#pragma unroll
                for (int mi = 0; mi < 2; ++mi) kf[mi] = tr_frag(BT[0][mi] + ktq + (unsigned)(8192 * ks), BT[1][mi] + ktq + (unsigned)(8192 * ks));
#pragma unroll
                for (int cc = 0; cc < 4; ++cc) wf[cc] = TRFRAG(VI, 4 + cc, ks);
                { const f32x4 wa = *(const LAS f32x4*)(sc + SC_WW + 32 * ks + 8 * lg), wb = *(const LAS f32x4*)(sc + SC_WW + 32 * ks + 8 * lg + 4);
                  u32x4 wq; wq.x = pk2(wa[0], wa[1]); wq.y = pk2(wa[2], wa[3]); wq.z = pk2(wb[0], wb[1]); wq.w = pk2(wb[2], wb[3]);
                  if (l15 != 0) wq = (u32x4){0u, 0u, 0u, 0u};
                  const bf16x8 wfn = __builtin_bit_cast(bf16x8, wq);
#pragma unroll
                  for (int mi = 0; mi < 2; ++mi) accN[mi] = mfma16(kf[mi], wfn, accN[mi]); }
#pragma unroll
                for (int mi = 0; mi < 2; ++mi)
#pragma unroll
                    for (int cc = 0; cc < 4; ++cc) accC[mi][cc] = mfma16(kf[mi], wf[cc], accC[mi][cc]);
            }
#pragma unroll
            for (int mi = 0; mi < 2; ++mi)
#pragma unroll
                for (int cc = 0; cc < 4; ++cc) { const int dk0 = 32 * wid + 16 * mi + 4 * lg, dv = 16 * cc + l15; u32x2 w; w.x = pk2(accC[mi][cc][0], accC[mi][cc][1]); w.y = pk2(accC[mi][cc][2], accC[mi][cc][3]);
                    *(LAS u32x2*)(lds + CI + (dk0 >> 7) * 16384 + off_b(dv, (dk0 & 127) >> 3) + (dk0 & 7) * 2) = w; }
            if (l15 == 0) { *(LAS f32x4*)(sc + SC_N + 32 * wid + 4 * lg) = accN[0]; *(LAS f32x4*)(sc + SC_N + 32 * wid + 16 + 4 * lg) = accN[1]; }
            __syncthreads();
            if (ci + 1 < 65) STAGE_WRITE();
        }
    }
#undef ROWG
#undef STAGE_LOAD
#undef STAGE_WRITE
#undef ROWRD
#undef TRFRAG
}
__device__ __forceinline__ void mlstm_phase(int bx, const bf16_t* UQKVO, const float* GP, float* HSUM, LAS unsigned char* lds, LAS float* sc) {
    if (bx >= 192) return;
    const int xcd = bx & 7, idx = bx >> 3, pair = xcd * 6 + (idx >> 2), js = idx & 3;
    mlstm_unit(pair >> 2, pair & 3, js, UQKVO, GP, HSUM, lds, sc);
}
}

#ifndef PHM
#define PHM 0xffff
#endif
#ifndef REP_ML
#define REP_ML 1
#endif
#ifndef REP_ATTN
#define REP_ATTN 1
#endif
#ifndef KV_SPLIT
#define KV_SPLIT 193
#endif
#ifndef REP_WIN
#define REP_WIN 1
#endif
#ifndef REP_UP
#define REP_UP 1
#endif
__global__ void __launch_bounds__(512, 2) fwd_kernel(Params P, unsigned char* ws_arg, unsigned char* out_arg) {
    extern __shared__ __attribute__((aligned(16))) unsigned char lds_raw[];
    Frame F;
    F.lds = (LAS unsigned char*)lds_raw;
    F.tid = threadIdx.x; F.lane = F.tid & 63; F.wave = __builtin_amdgcn_readfirstlane(F.tid >> 6);
    F.G = GRID; F.bx = blockIdx.x; F.vcu = (F.bx % 8) * (GRID / 8) + F.bx / 8;
    F.gw = F.vcu * 8 + F.wave; F.ngw = F.G * 8;
    { unsigned char* ws0 = ws_arg;
      for (int u = F.tid; u < (LDS_BYTES - MISC_OFF) / 4; u += 512) ((LAS unsigned*)(F.lds + MISC_OFF))[u] = 0u;
      __syncthreads();
      (void)ws0; }
    LAS unsigned long long* ptab = (LAS unsigned long long*)(F.lds + MISC_OFF + 64);
    if (F.tid == 0) {
#pragma unroll
        for (int k = 0; k < 19; ++k) ptab[k] = (unsigned long long)(uintptr_t)P.in[k]; }
    __syncthreads();
    XcdBarrier bar = xcd_barrier_post((unsigned*)(ws_arg + WS_CTL) + CW_BAR, (volatile LAS unsigned*)(F.lds + MISC_OFF));
    LAS float* sc = (LAS float*)(F.lds + MISC_OFF + 1024);
#define BXL() ({ int b__ = F.bx; asm volatile("" : "+s"(b__)); b__; })
#define PFRAME() Frame Fp = F; { int t_ = threadIdx.x; asm volatile("" : "+v"(t_)); Fp.tid = t_; Fp.lane = t_ & 63; int b_ = BXL(); Fp.bx = b_; Fp.vcu = (b_ % 8) * (GRID / 8) + b_ / 8; Fp.gw = Fp.vcu * 8 + Fp.wave; }
#define WSB() ({ GAS unsigned char* w__ = (GAS unsigned char*)ws_arg; asm volatile("" : "+s"(w__)); (unsigned char*)w__; })
#define DOB() ({ GAS unsigned char* w__ = (GAS unsigned char*)out_arg; asm volatile("" : "+s"(w__)); (unsigned char*)w__; })

    { unsigned char* ws = WSB(); prologue(F, ws, ptab); convert_weights(F, ws, ptab, 0); }
    xcd_barrier(bar);

    for (int l = 0; l < DEPTH; ++l) {
        { unsigned char* ws = WSB();
          pg8::Gemm g{(bf16_t*)(ws + WS_HB), (bf16_t*)(ws + WS_WIN), TP, NIN, DM, DM}; pg8::PanelOrder S; S.init(NPAN, 0, 0, 0, NIN, F.G, BXL());
          pg8::EpiWin E{(bf16_t*)(ws + WS_UQKVO), (bf16_t*)(ws + WS_UDQ), (bf16_t*)(ws + WS_UDKV), (bf16_t*)(ws + WS_KR), (float*)(ws + WS_GATES), (const float*)(ws + WS_COS), (const float*)(ws + WS_SIN)};
#if PHM & 2
          pg8::gemm_phase<pg8::EpiWin, pg8::PanelOrder, true, true>(F.lds, g, S, E);
#endif
        }
#if REP_WIN > 1
        __syncthreads();
        { unsigned char* ws = WSB();
          pg8::Gemm g{(bf16_t*)(ws + WS_HB), (bf16_t*)(ws + WS_WIN), TP, NIN, DM, DM}; pg8::PanelOrder S; S.init(NPAN, 0, 0, 0, NIN, F.G, BXL());
          pg8::EpiWin E{(bf16_t*)(ws + WS_UQKVO), (bf16_t*)(ws + WS_UDQ), (bf16_t*)(ws + WS_UDKV), (bf16_t*)(ws + WS_KR), (float*)(ws + WS_GATES), (const float*)(ws + WS_COS), (const float*)(ws + WS_SIN)};
          pg8::gemm_phase<pg8::EpiWin, pg8::PanelOrder, true, true>(F.lds, g, S, E);
        }
#endif
        xcd_barrier(bar);
        { unsigned char* ws = WSB(); unsigned char* dob = DOB(); PFRAME(); rstd_rows(Fp, (bf16_t*)(ws + WS_UDQ), (bf16_t*)(ws + WS_UDKV), (float*)(ws + WS_RSTD));
          ml::gate_prep(Fp.gw, Fp.ngw, Fp.lane, (const float*)(ws + WS_GATES), (const float*)(ws + WS_PAR) + PO_BG + l * 16, (float*)(dob + DO_GP)); }
        xcd_barrier(bar);
        if (F.bx >= 192) {
        { unsigned char* ws = WSB(); unsigned char* dob = DOB();
          pg8::Gemm g{(bf16_t*)(ws + WS_UDQ), (bf16_t*)(ws + WS_WUQ), TP, NQ, 512, 512}; pg8::PanelOrder S; S.init(NPAN, 0, 0, 0, NQ, GRID - 192, BXL() - 192);
          pg8::EpiQ E{(bf16_t*)(dob + DO_MQ), (const float*)(ws + WS_RSTD), (const float*)(ws + WS_COS), (const float*)(ws + WS_SIN)};
#if PHM & 4
          pg8::gemm_phase<pg8::EpiQ, pg8::PanelOrder, true, true>(F.lds, g, S, E);
#endif
        }
        { unsigned char* ws = WSB();
          pg8::Gemm g{(bf16_t*)(ws + WS_UDKV), (bf16_t*)(ws + WS_WUKV), TP, NKV, 256, 256}; pg8::PanelOrder S; S.init(NPAN, 0, 0, 0, NKV, GRID - 192, BXL() - 192);
          pg8::EpiBf16G E{(bf16_t*)(ws + WS_MKV), NKV, (const float*)(ws + WS_RSTD) + 1, 0, -1, 0};
#if PHM & 8
          pg8::gemm_phase<pg8::EpiBf16G, pg8::PanelOrder, true, true>(F.lds, g, S, E);
#endif
        }
        } else {
#ifndef NO_ML
        for (int rep_ = 0; rep_ < REP_ML; ++rep_)
        { unsigned char* ws = WSB(); unsigned char* dob = DOB();
          ml::mlstm_phase(BXL(), (const bf16_t*)(ws + WS_UQKVO), (const float*)(dob + DO_GP), (float*)(dob + DO_HSUM), F.lds, sc); }
#endif
        }
        xcd_barrier(bar);
        { unsigned char* ws = WSB(); unsigned char* dob = DOB(); PFRAME();
          if (Fp.vcu >= 96) mlstm_finalize(Fp, (Fp.vcu - 96) * 8 + Fp.wave, (GRID - 96) * 8, (const float*)(dob + DO_HSUM), (const bf16_t*)(ws + WS_UQKVO), (const float*)(ws + WS_PAR) + PO_MLG + l * MLW, (bf16_t*)(ws + WS_HB)); }
#ifndef NO_ATTN
        for (int rep_ = 0; rep_ < REP_ATTN; ++rep_)
        { unsigned char* ws = WSB(); unsigned char* dob = DOB();
          att::attn_phase(({ int b__ = BXL(); (b__ % 8) * (GRID / 8) + b__ / 8; }), (const bf16_t*)(dob + DO_MQ), (const bf16_t*)(ws + WS_MKV), (const bf16_t*)(ws + WS_KR), (bf16_t*)(ws + WS_HB), (LAS char*)F.lds); }
#endif
        xcd_barrier(bar);
        { unsigned char* ws = WSB();
          pg8::Gemm g{(bf16_t*)(ws + WS_HB), (bf16_t*)(ws + WS_WOUT), TP, DM, DM, DM}; pg8::PanelOrder S; S.init(192, 0, 0, 0, DM, F.G, BXL());
          pg8::EpiResidLn E{(float*)(ws + WS_H), DM, ALPHA, (const float*)(ws + WS_STAT2), (const float*)(ws + WS_PAR) + (l > 0 ? PO_L2G + (l - 1) * DM : PO_ONE), (const float*)(ws + WS_PAR) + (l > 0 ? PO_L2B + (l - 1) * DM : PO_ZERO)};
#if PHM & 16
          pg8::gemm_phase<pg8::EpiResidLn, pg8::PanelOrder, true, true>(F.lds, g, S, E);
#endif
        }
        { unsigned char* ws = WSB();
          pg8::Gemm g{(bf16_t*)(ws + WS_HB), (bf16_t*)(ws + WS_WOUT), TP, DM, DM / 4, DM}; pg8::SplitOrder S; S.init(PMETA, DM, 4, F.G, BXL());
          pg8::EpiAtomic E{(float*)(ws + WS_H), DM};
#if PHM & 16
          pg8::gemm_phase<pg8::EpiAtomic, pg8::SplitOrder, true, true>(F.lds, g, S, E);
#endif
        }
        xcd_barrier(bar);
        { unsigned char* ws = WSB(); PFRAME(); ln_rows(Fp, (float*)(ws + WS_H), (bf16_t*)(ws + WS_HB), (const float*)(ws + WS_PAR) + PO_L1G + l * DM, (const float*)(ws + WS_PAR) + PO_L1B + l * DM, (float*)(ws + WS_STAT1), nullptr); }
        xcd_barrier(bar);
        { unsigned char* ws = WSB(); unsigned char* dob = DOB();
          pg8::Gemm g{(bf16_t*)(ws + WS_HB), (bf16_t*)(ws + WS_WUP), TP, NUP, DM, DM}; pg8::PanelOrder S; S.init(NPAN, 0, 0, 0, NUP, F.G, BXL());
          pg8::EpiFfn E{(bf16_t*)(ws + WS_ACT), (float*)(dob + DO_SIDE), (bf16_t*)(dob + DO_GVM), (const float*)(ws + WS_PAR) + PO_CW + (size_t)l * 3 * DFF, (const float*)(ws + WS_PAR) + PO_CB + (size_t)l * DFF, (LAS float*)(F.lds + MISC_OFF + 8192)};
#if PHM & 32
          pg8::gemm_phase<pg8::EpiFfn, pg8::PanelOrder, true, true>(F.lds, g, S, E);
#if REP_UP > 1
          __syncthreads(); pg8::gemm_phase<pg8::EpiFfn, pg8::PanelOrder, true, true>(F.lds, g, S, E);
#endif
#endif
        }
        xcd_barrier(bar);
        { unsigned char* ws = WSB(); unsigned char* dob = DOB(); PFRAME();
          ffn_fixup(Fp, (const float*)(dob + DO_SIDE), (const bf16_t*)(dob + DO_GVM), (bf16_t*)(ws + WS_ACT), (const float*)(ws + WS_PAR) + PO_CW + (size_t)l * 3 * DFF, (const float*)(ws + WS_PAR) + PO_CB + (size_t)l * DFF); }
        xcd_barrier(bar);
        { unsigned char* ws = WSB();
          pg8::Gemm g{(bf16_t*)(ws + WS_ACT), (bf16_t*)(ws + WS_WDN), TP, DM, DFF, DFF}; pg8::PanelOrder S; S.init(192, 0, 0, 0, DM, F.G, BXL());
          pg8::EpiResidLn E{(float*)(ws + WS_H), DM, ALPHA, (const float*)(ws + WS_STAT1), (const float*)(ws + WS_PAR) + PO_L1G + l * DM, (const float*)(ws + WS_PAR) + PO_L1B + l * DM};
#if PHM & 64
          pg8::gemm_phase<pg8::EpiResidLn, pg8::PanelOrder, true, true>(F.lds, g, S, E);
#endif
        }
        { unsigned char* ws = WSB();
          pg8::Gemm g{(bf16_t*)(ws + WS_ACT), (bf16_t*)(ws + WS_WDN), TP, DM, DFF / 11, DFF}; pg8::SplitOrder S; S.init(PMETA, DM, 11, F.G, BXL());
          pg8::EpiAtomic E{(float*)(ws + WS_H), DM};
#if PHM & 64
          pg8::gemm_phase<pg8::EpiAtomic, pg8::SplitOrder, true, true>(F.lds, g, S, E);
#endif
        }
        xcd_barrier(bar);
        { unsigned char* ws = WSB(); unsigned char* dob = DOB();
          PFRAME(); ln_rows(Fp, (float*)(ws + WS_H), (bf16_t*)(ws + WS_HB), (const float*)(ws + WS_PAR) + PO_L2G + l * DM, (const float*)(ws + WS_PAR) + PO_L2B + l * DM, (float*)(ws + WS_STAT2), l == DEPTH - 1 ? (float*)dob : nullptr); }
        if (l + 1 < DEPTH) { unsigned char* ws = WSB(); PFRAME(); convert_weights(Fp, ws, ptab, l + 1); }
        xcd_barrier(bar);
    }
}

extern "C" void kernel_launch(void* const* d_in, const int* in_sizes, int n_in, void* d_out, int out_size, void* d_ws, size_t ws_size, hipStream_t stream) {
    static int grid = 0;
    if (grid == 0) {
        if (n_in != 19 || out_size != NMAIN * DM || ws_size < WS_NEED) { fprintf(stderr, "kernel_launch: unexpected shapes (n_in %d out %d ws %zu need %zu)\n", n_in, out_size, ws_size, (size_t)WS_NEED); grid = -1; return; }
        int dev = 0, cus = 0;
        if (hipGetDevice(&dev) != hipSuccess || hipDeviceGetAttribute(&cus, hipDeviceAttributeMultiprocessorCount, dev) != hipSuccess) { grid = -1; return; }
        if (hipFuncSetAttribute((const void*)fwd_kernel, hipFuncAttributeMaxDynamicSharedMemorySize, LDS_BYTES) != hipSuccess) { fprintf(stderr, "kernel_launch: hipFuncSetAttribute failed\n"); grid = -1; return; }
        int per_cu = 0;
        if (hipOccupancyMaxActiveBlocksPerMultiprocessor(&per_cu, (const void*)fwd_kernel, 512, LDS_BYTES) != hipSuccess || per_cu < 1) { fprintf(stderr, "kernel_launch: occupancy query says %d blocks per CU\n", per_cu); (void)hipGetLastError(); grid = -1; return; }
        if (cus < GRID) { fprintf(stderr, "kernel_launch: needs %d CUs, device has %d\n", GRID, cus); grid = -1; return; }
        grid = GRID;
    }
    if (grid < 0) return;
    (void)hipMemsetAsync((char*)d_ws + WS_CTL, 0, CTL_BYTES, stream);
    Params p{};
    for (int i = 0; i < 19; ++i) p.in[i] = (const float*)d_in[i];
    hipLaunchKernelGGL(fwd_kernel, dim3(grid), dim3(512), LDS_BYTES, stream, p, (unsigned char*)d_ws, (unsigned char*)d_out);
}
```

```cpp
#include <hip/hip_runtime.h>
#include <cstdio>
#include <cstdint>

#define LAS __attribute__((address_space(3)))
#define GAS __attribute__((address_space(1)))
typedef float f32x2 __attribute__((ext_vector_type(2)));
typedef float f32x8 __attribute__((ext_vector_type(8)));
typedef float f32x16 __attribute__((ext_vector_type(16)));
typedef unsigned u32x2 __attribute__((ext_vector_type(2)));
typedef short s16x4 __attribute__((ext_vector_type(4)));
typedef __bf16 bf16x2v __attribute__((ext_vector_type(2)));

constexpr int DM = 2048, NSEQ = 12, LREAL = 4096, NMETA = 16, DEPTH = 4;
constexpr int NMAIN = NSEQ * LREAL;
constexpr int MROW0 = NMAIN;
constexpr int NTOK = NMAIN + NSEQ * NMETA;
constexpr int NPAN = 193, TP = NPAN * 256;
constexpr int PMETA = 192;
constexpr int INC = 4944, NIN = 5120;
constexpr int DFF = 5632, NUP = 2 * DFF;
constexpr int MLW = 1024, NQ = 1536, NKV = 2048;
constexpr float ALPHA = 1.681792830507429f;
constexpr float EPS = 1e-5f;
constexpr float NEGBIG = -1e30f;

constexpr size_t MiB = 1u << 20;
constexpr size_t WS_CTL = 0, CTL_BYTES = 1 * MiB;
constexpr size_t WS_COS = 1 * MiB;
constexpr size_t WS_SIN = WS_COS + (size_t)4112 * 32 * 4;
constexpr size_t WS_PAR = 2 * MiB + 128 * 1024;
constexpr int PO_BG = 0, PO_MLG = PO_BG + DEPTH * 16, PO_QG = PO_MLG + DEPTH * 1024, PO_KVG = PO_QG + DEPTH * 512, PO_L1G = PO_KVG + DEPTH * 256, PO_L1B = PO_L1G + DEPTH * 2048,
              PO_CW = PO_L1B + DEPTH * 2048, PO_CB = PO_CW + DEPTH * 3 * 5632, PO_L2G = PO_CB + DEPTH * 5632, PO_L2B = PO_L2G + DEPTH * 2048, PO_ONE = PO_L2B + DEPTH * 2048, PO_ZERO = PO_ONE + 2048, PO_END = PO_ZERO + 2048;
static_assert(WS_PAR + (size_t)PO_END * 4 <= 3 * MiB && WS_PAR >= 1 * MiB + 2 * 4112 * 32 * 4, "PAR block placement");
constexpr size_t WS_WIN = 3 * MiB;
constexpr size_t WS_WUQ = WS_WIN + (size_t)NIN * DM * 2;
constexpr size_t WS_WUKV = WS_WUQ + (size_t)NQ * 512 * 2;
constexpr size_t WS_WOUT = WS_WUKV + (size_t)NKV * 256 * 2;
constexpr size_t WS_WUP = WS_WOUT + (size_t)DM * DM * 2;
constexpr size_t WS_WDN = WS_WUP + (size_t)NUP * DM * 2;
constexpr size_t WS_STAT1 = WS_WDN + (size_t)DM * DFF * 2;
constexpr size_t WS_STAT2 = WS_CTL + 512 * 1024;
constexpr size_t WS_H = 100 * MiB;
constexpr size_t WS_HB = WS_H + (size_t)TP * DM * 4;
constexpr size_t WS_R = WS_HB + (size_t)TP * DM * 2;
constexpr size_t WS_UQKVO = WS_R;
constexpr size_t WS_UDQ = WS_UQKVO + (size_t)TP * 4096 * 2;
constexpr size_t WS_UDKV = WS_UDQ + (size_t)TP * 512 * 2;
constexpr size_t WS_GATES = WS_UDKV + (size_t)TP * 256 * 2;
constexpr size_t WS_MKV = WS_GATES + (size_t)TP * 16 * 4;
constexpr size_t WS_KR = WS_MKV + (size_t)TP * NKV * 2;
constexpr size_t WS_RSTD = WS_KR + (size_t)TP * 64 * 2;
constexpr size_t WS_END_A = WS_RSTD + (size_t)TP * 2 * 4;
constexpr size_t WS_ACT = WS_R;
constexpr size_t WS_END_B = WS_ACT + (size_t)TP * DFF * 2;
constexpr size_t WS_NEED = (WS_END_A > WS_END_B ? WS_END_A : WS_END_B);
static_assert(WS_STAT1 + (size_t)TP * 8 <= WS_H && WS_STAT2 + (size_t)TP * 8 <= WS_CTL + CTL_BYTES, "weights and row statistics fit below H");
constexpr size_t DO_HSUM = 0;
constexpr size_t DO_MQ = DO_HSUM + (size_t)TP * MLW * 4;
constexpr size_t DO_GP = 340 * MiB;
constexpr size_t DO_SIDE = 0;
constexpr size_t DO_GVM = 32 * MiB;
static_assert(DO_MQ + (size_t)TP * NQ * 2 <= DO_GP && DO_GP + (size_t)96 * 65 * 200 * 4 <= (size_t)NMAIN * DM * 4 && (size_t)192 * 6 * DFF * 4 <= DO_GVM && DO_GVM + (size_t)256 * NUP * 2 <= (size_t)NMAIN * DM * 4, "d_out scratch fits");
constexpr int CW_BAR = 4096;

constexpr int RING_BYTES = 131072;
constexpr int MISC_OFF = RING_BYTES;
constexpr int LDS_BYTES = 147456;
constexpr int GRID = 256;

__device__ __forceinline__ int pos_of_row(int row) { return row < NMAIN ? NMETA + (row & (LREAL - 1)) : ((row - NMAIN) & (NMETA - 1)); }
__device__ __forceinline__ unsigned pk2(float lo, float hi) { f32x2 v = {lo, hi}; return __builtin_bit_cast(unsigned, __builtin_convertvector(v, bf16x2v)); }
__device__ __forceinline__ float bf_lo(unsigned w) { return __uint_as_float(w << 16); }
__device__ __forceinline__ float bf_hi(unsigned w) { return __uint_as_float(w & 0xffff0000u); }
__device__ __forceinline__ float wave_sum(float v) {
#pragma unroll
    for (int o = 1; o < 64; o <<= 1) v += __shfl_xor(v, o);
    return v;
}
__device__ __forceinline__ float wave_max(float v) {
#pragma unroll
    for (int o = 1; o < 64; o <<= 1) v = fmaxf(v, __shfl_xor(v, o));
    return v;
}
namespace pg8 {
#define PG8_LAS __attribute__((address_space(3)))
typedef unsigned short bf16_t;
typedef short bf16x8 __attribute__((ext_vector_type(8)));
typedef float f32x4 __attribute__((ext_vector_type(4)));
typedef unsigned u32x4 __attribute__((ext_vector_type(4)));
constexpr int BM = 256, BK = 64, HALF = 128, HTB = HALF * BK * 2  , STAGE_BYTES = 8 * HTB, NXCD = 8, WGM = 4;

__host__ __device__ __forceinline__ int lds_byte(int r, int c) { const int st = (r >> 4) * 2 + (c >> 5), rr = r & 15, cc = c & 31, ob = rr * 64 + cc * 2; return st * 1024 + (ob ^ (((ob >> 9) & 1) << 5)); }
__host__ __device__ __forceinline__ void stage_rc(int b, int& R, int& C) { const int st = b / 1024, sb = b % 1024, swz = sb ^ (((sb >> 9) & 1) << 5); R = (st >> 1) * 16 + swz / 64; C = (st & 1) * 32 + (swz % 64) / 2; }
__host__ __device__ __forceinline__ int perm32(int rho) { const int n = rho >> 4, i = rho & 15; return 8 * (i >> 2) + 4 * n + (i & 3); }

struct Unit { int pm, pn, kk; };
struct Gemm { const bf16_t* A; const bf16_t* Bt; int M, N, K, ld; };

struct PanelOrder {
    int nM, nN, nwg, G, c, nMain, pm0, pmx;
    __device__ void init(int nMain_, int pm0_, int extra, int pmx_, int N, int G_, int c_) { nMain = nMain_; pm0 = pm0_; pmx = pmx_; nM = nMain_ + extra; nN = N / BM; nwg = nM * nN; G = G_; c = c_; }
    __device__ bool next(int i, Unit& u) const {
        const long L = (long)i * G + c; if (L >= nwg) return false;
        int wgid = (int)L; { const int q = nwg / NXCD, r = nwg % NXCD, xcd = wgid % NXCD, off = wgid / NXCD; wgid = (xcd < r ? xcd * (q + 1) : r * (q + 1) + (xcd - r) * q) + off; }
        const int nig = WGM * nN, gid = wgid / nig, fm = gid * WGM, gsz = (nM - fm) < WGM ? (nM - fm) : WGM;
        const int pl = fm + ((wgid % nig) % gsz); u.pm = pl < nMain ? pm0 + pl : pmx; u.pn = (wgid % nig) / gsz; u.kk = 0; return true;
    }
    __device__ __forceinline__ void a_ready(const Unit&) const {}
    __device__ __forceinline__ void done(const Unit&) const {}
};

struct SplitOrder {
    int pm, nN, nwg, G, c;
    __device__ void init(int pm_, int N, int nsplit, int G_, int c_) { pm = pm_; nN = N / BM; nwg = nN * nsplit; G = G_; c = c_; }
    __device__ bool next(int i, Unit& u) const { const int L = i * G + c; if (L >= nwg) return false; u.pm = pm; u.pn = L % nN; u.kk = L / nN; return true; }
    __device__ __forceinline__ void a_ready(const Unit&) const {}
    __device__ __forceinline__ void done(const Unit&) const {}
};

__device__ __forceinline__ u32x4 pack8(const f32x4 v0, const f32x4 v1) { u32x4 w; w.x = pk2(v0[0], v0[1]); w.y = pk2(v0[2], v0[3]); w.z = pk2(v1[0], v1[1]); w.w = pk2(v1[2], v1[3]); return w; }

struct EpiBf16G {
    static constexpr bool PERM = true, AFTER_DRAIN = false;
    bf16_t* O; int ldc; const float* rs; int pm_sub, pm_sp, pm_sp_out;
    __device__ __forceinline__ void operator()(const f32x4 (&acc)[2][2][4][2], const Unit& u, int wr, int wc, int fr, int fq) const {
        const int opm = (u.pm == pm_sp) ? pm_sp_out : u.pm - pm_sub;
        const int rin = u.pm * BM + wr * 64 + fr, rout = opm * BM + wr * 64 + fr, col0 = u.pn * BM + wc * 32 + 8 * fq;
#pragma unroll
        for (int ai = 0; ai < 2; ++ai)
#pragma unroll
            for (int m = 0; m < 4; ++m) { const float sc = rs ? rs[(size_t)(rin + ai * HALF + m * 16) * 2] : 1.f;
                bf16_t* rowp = O + (size_t)(rout + ai * HALF + m * 16) * ldc + col0;
#pragma unroll
                for (int bj = 0; bj < 2; ++bj) *(u32x4*)(rowp + bj * HALF) = pack8(acc[ai][bj][m][0] * sc, acc[ai][bj][m][1] * sc); }
    }
};
struct EpiWin {
    static constexpr bool PERM = true, AFTER_DRAIN = false;
    bf16_t *UQKVO, *UDQ, *UDKV, *KR; float* GATES; const float *COS, *SIN;
    __device__ __forceinline__ void operator()(const f32x4 (&acc)[2][2][4][2], const Unit& u, int wr, int wc, int fr, int fq) const {
        const int row0 = u.pm * BM + wr * 64 + fr;
        if (u.pn < 19) {
            bf16_t* base; int ldc, colt;
            if (u.pn < 16) { base = UQKVO; ldc = 4096; colt = u.pn * BM; } else if (u.pn < 18) { base = UDQ; ldc = 512; colt = (u.pn - 16) * BM; } else { base = UDKV; ldc = 256; colt = 0; }
            const int col0 = colt + wc * 32 + 8 * fq;
#pragma unroll
            for (int ai = 0; ai < 2; ++ai)
#pragma unroll
                for (int m = 0; m < 4; ++m) { bf16_t* rowp = base + (size_t)(row0 + ai * HALF + m * 16) * ldc + col0;
#pragma unroll
                    for (int bj = 0; bj < 2; ++bj) *(u32x4*)(rowp + bj * HALF) = pack8(acc[ai][bj][m][0], acc[ai][bj][m][1]); }
        } else {
            if (wc < 2) { const int g = 4 * wc + fq;
#pragma unroll
                for (int ai = 0; ai < 2; ++ai)
#pragma unroll
                    for (int m = 0; m < 4; ++m) { const int row = row0 + ai * HALF + m * 16, pos = pos_of_row(row);
                        const f32x4 cs = *(const f32x4*)(COS + pos * 32 + 4 * g), sn = *(const f32x4*)(SIN + pos * 32 + 4 * g);
                        const f32x4 x1 = acc[ai][0][m][0], x2 = acc[ai][0][m][1];
                        *(u32x4*)(KR + (size_t)row * 64 + 8 * g) = pack8(x1 * cs - x2 * sn, x1 * sn + x2 * cs); }
            } else if (wc == 2 && fq < 2) {
#pragma unroll
                for (int ai = 0; ai < 2; ++ai)
#pragma unroll
                    for (int m = 0; m < 4; ++m) { float* gp = GATES + (size_t)(row0 + ai * HALF + m * 16) * 16 + 8 * fq;
                        *(f32x4*)gp = acc[ai][0][m][0]; *(f32x4*)(gp + 4) = acc[ai][0][m][1]; }
            }
        }
    }
};
struct EpiQ {
    static constexpr bool PERM = true, AFTER_DRAIN = false;
    bf16_t* MQ; const float *RSTD, *COS, *SIN;
    __device__ __forceinline__ void operator()(const f32x4 (&acc)[2][2][4][2], const Unit& u, int wr, int wc, int fr, int fq) const {
        const int row0 = u.pm * BM + wr * 64 + fr, colb = u.pn * BM + wc * 32 + 8 * fq;
#pragma unroll
        for (int ai = 0; ai < 2; ++ai)
#pragma unroll
            for (int m = 0; m < 4; ++m) { const int row = row0 + ai * HALF + m * 16, pos = pos_of_row(row); const float sc = RSTD[(size_t)row * 2];
#pragma unroll
                for (int bj = 0; bj < 2; ++bj) { const int col0 = colb + bj * HALF, o = col0 % 192;
                    f32x4 v0 = acc[ai][bj][m][0] * sc, v1 = acc[ai][bj][m][1] * sc;
                    if (o >= 128) { const int g = (o - 128) >> 3; const f32x4 cs = *(const f32x4*)(COS + pos * 32 + 4 * g), sn = *(const f32x4*)(SIN + pos * 32 + 4 * g);
                        const f32x4 x1 = v0, x2 = v1; v0 = x1 * cs - x2 * sn; v1 = x1 * sn + x2 * cs; }
                    *(u32x4*)(MQ + (size_t)row * NQ + col0) = pack8(v0, v1); } }
    }
};
__device__ __forceinline__ void resid_ln_tile(float* __restrict__ Cw, const float* __restrict__ Cr, const float* __restrict__ st, const float* __restrict__ g, const float* __restrict__ b,
                                              int ldc, float alpha, const f32x4 (&acc)[2][2][4][2], int row0, int col0) {
    asm volatile("" ::: "memory");
#pragma unroll
    for (int ai = 0; ai < 2; ++ai)
#pragma unroll
        for (int bj = 0; bj < 2; ++bj) {
            f32x4 gv[2], bv[2], hv[4][2]; f32x2 ms[4];
#pragma unroll
            for (int n = 0; n < 2; ++n) { gv[n] = *(const f32x4*)(g + col0 + bj * HALF + n * 16) * alpha; bv[n] = *(const f32x4*)(b + col0 + bj * HALF + n * 16) * alpha; }
#pragma unroll
            for (int m = 0; m < 4; ++m) { const int row = row0 + ai * HALF + m * 16; ms[m] = *(const f32x2*)(st + (size_t)row * 2);
#pragma unroll
                for (int n = 0; n < 2; ++n) hv[m][n] = *(const f32x4*)(Cr + (size_t)row * ldc + col0 + bj * HALF + n * 16); }
#pragma unroll
            for (int m = 0; m < 4; ++m) { const int row = row0 + ai * HALF + m * 16;
#pragma unroll
                for (int n = 0; n < 2; ++n) *(f32x4*)(Cw + (size_t)row * ldc + col0 + bj * HALF + n * 16) = (hv[m][n] - ms[m][0]) * ms[m][1] * gv[n] + bv[n] + acc[ai][bj][m][n]; }
        }
}
struct EpiResidLn {
    static constexpr bool PERM = false, AFTER_DRAIN = false;
    float* C; int ldc; float alpha; const float* st; const float* g; const float* b;
    __device__ __forceinline__ void operator()(const f32x4 (&acc)[2][2][4][2], const Unit& u, int wr, int wc, int fr, int fq) const {
        resid_ln_tile(this->C, this->C, this->st, this->g, this->b, this->ldc, this->alpha, acc, u.pm * BM + wr * 64 + fr, u.pn * BM + wc * 32 + 4 * fq);
    }
};
struct EpiAtomic {
    static constexpr bool PERM = false, AFTER_DRAIN = false;
    float* C; int ldc;
    __device__ __forceinline__ void operator()(const f32x4 (&acc)[2][2][4][2], const Unit& u, int wr, int wc, int fr, int fq) const {
        const int row0 = u.pm * BM + wr * 64 + fr, col0 = u.pn * BM + wc * 32 + 4 * fq;
#pragma unroll
        for (int ai = 0; ai < 2; ++ai)
#pragma unroll
            for (int m = 0; m < 4; ++m) { float* rowp = C + (size_t)(row0 + ai * HALF + m * 16) * ldc + col0;
#pragma unroll
                for (int bj = 0; bj < 2; ++bj)
#pragma unroll
                    for (int n = 0; n < 2; ++n) { float* p = rowp + bj * HALF + n * 16;
#pragma unroll
                        for (int e = 0; e < 4; ++e) unsafeAtomicAdd(p + e, acc[ai][bj][m][n][e]); } }
    }
};

__device__ __forceinline__ float dpp_ror1(float x) { return __int_as_float(__builtin_amdgcn_mov_dpp(__float_as_int(x), 0x121, 0xf, 0xf, false)); }
__device__ __forceinline__ float dpp_ror15(float x) { return __int_as_float(__builtin_amdgcn_mov_dpp(__float_as_int(x), 0x12f, 0xf, 0xf, false)); }
struct EpiFfn {
    static constexpr bool PERM = true, AFTER_DRAIN = false;
    bf16_t* ACT; float* SIDE; bf16_t* GVM; const float *cw, *cb; PG8_LAS float* X;
    __device__ __forceinline__ void operator()(const f32x4 (&acc)[2][2][4][2], const Unit& u, int wr_in, int wc_in, int fr_in, int fq_in) const {
        int fr = fr_in, fq = fq_in, wr = wr_in, wc = wc_in; asm volatile("" : "+v"(fr), "+v"(fq), "+s"(wr), "+s"(wc));
        const int cj = wc * 32 + 8 * fq, c0 = u.pn * 128 + cj;
        if (u.pm == PMETA) {
#pragma unroll
            for (int ai = 0; ai < 2; ++ai)
#pragma unroll
                for (int m = 0; m < 4; ++m) { bf16_t* rowp = GVM + (size_t)(ai * HALF + wr * 64 + m * 16 + fr) * NUP + c0;
                    *(u32x4*)rowp = pack8(acc[ai][0][m][0], acc[ai][0][m][1]); *(u32x4*)(rowp + DFF) = pack8(acc[ai][1][m][0], acc[ai][1][m][1]); }
            return;
        }
        f32x4 w0[2], w1[2], w2[2], bb[2];
#pragma unroll
        for (int n = 0; n < 2; ++n) { w0[n] = *(const f32x4*)(cw + c0 + 4 * n); w1[n] = *(const f32x4*)(cw + DFF + c0 + 4 * n); w2[n] = *(const f32x4*)(cw + 2 * DFF + c0 + 4 * n); bb[n] = *(const f32x4*)(cb + c0 + 4 * n); }
#pragma unroll
        for (int ai = 0; ai < 2; ++ai) { const int b = 2 * ai + wr;
            if (fr == 0) { *(PG8_LAS f32x4*)(X + (b * 2 + 0) * 128 + cj) = acc[ai][0][0][0]; *(PG8_LAS f32x4*)(X + (b * 2 + 0) * 128 + cj + 4) = acc[ai][0][0][1]; }
            if (fr == 15) { *(PG8_LAS f32x4*)(X + (b * 2 + 1) * 128 + cj) = acc[ai][0][3][0]; *(PG8_LAS f32x4*)(X + (b * 2 + 1) * 128 + cj + 4) = acc[ai][0][3][1]; } }
        asm volatile("s_waitcnt lgkmcnt(0)" ::: "memory"); __builtin_amdgcn_s_barrier(); asm volatile("" ::: "memory");
        const bool is15 = fr == 15, is0 = fr == 0;
        const unsigned rowb = (unsigned)(u.pm * BM + wr * 64 + fr) * DFF + c0;
#pragma unroll
        for (int ai = 0; ai < 2; ++ai) { const int b = 2 * ai + wr;
            f32x4 xp[2], xn[2];
#pragma unroll
            for (int n = 0; n < 2; ++n) { xp[n] = b > 0 ? *(const PG8_LAS f32x4*)(X + ((b - 1) * 2 + 1) * 128 + cj + 4 * n) : (f32x4){0.f, 0.f, 0.f, 0.f};
                                          xn[n] = b < 3 ? *(const PG8_LAS f32x4*)(X + ((b + 1) * 2 + 0) * 128 + cj + 4 * n) : (f32x4){0.f, 0.f, 0.f, 0.f}; }
#pragma unroll
            for (int m = 0; m < 4; ++m) { u32x4 ow;
#pragma unroll
                for (int n = 0; n < 2; ++n) { f32x4 o;
#pragma unroll
                    for (int e = 0; e < 4; ++e) { const float g = acc[ai][0][m][n][e];
                        const float gup = m > 0 ? acc[ai][0][m > 0 ? m - 1 : 0][n][e] : xp[n][e], gdn = m < 3 ? acc[ai][0][m < 3 ? m + 1 : 3][n][e] : xn[n][e];
                        const float pv = dpp_ror1(is15 ? gup : g);
                        const float nx = dpp_ror15(is0 ? gdn : g);
                        const float x = w0[n][e] * pv + w1[n][e] * g + w2[n][e] * nx + bb[n][e];
                        o[e] = x * __builtin_amdgcn_rcpf(1.f + __expf(-x)) * acc[ai][1][m][n][e]; }
                    if (n == 0) { ow.x = pk2(o[0], o[1]); ow.y = pk2(o[2], o[3]); } else { ow.z = pk2(o[0], o[1]); ow.w = pk2(o[2], o[3]); } }
                bf16_t* dst = ACT + (rowb + (unsigned)(ai * HALF + m * 16) * DFF);
                if ((ai == 0 && m == 0) || (ai == 1 && m == 3)) {
                    const int r = ai * HALF + wr * 64 + m * 16 + fr;
                    if (r != 0 && r != 255) *(u32x4*)dst = ow;
                    const int slot = r == 0 ? 0 : r == 1 ? 1 : r == 254 ? 2 : r == 255 ? 3 : -1;
                    if (slot >= 0) { float* sp = SIDE + ((size_t)u.pm * 6 + slot) * DFF + c0; *(f32x4*)sp = acc[ai][0][m][0]; *(f32x4*)(sp + 4) = acc[ai][0][m][1];
                        if (slot == 0 || slot == 3) { float* vp = SIDE + ((size_t)u.pm * 6 + (slot == 0 ? 4 : 5)) * DFF + c0; *(f32x4*)vp = acc[ai][1][m][0]; *(f32x4*)(vp + 4) = acc[ai][1][m][1]; } }
                } else *(u32x4*)dst = ow;
            }
        }
    }
};
template <class Epi, class Sched, bool ALIGN_EPI = false, bool SP2 = false>
__device__ __forceinline__ void gemm_phase(PG8_LAS unsigned char* lds, const Gemm g, const Sched& S, const Epi& E) {
    int tid_ = threadIdx.x; asm volatile("" : "+v"(tid_));
    const int tid = tid_, wid = __builtin_amdgcn_readfirstlane(tid >> 6), lane = tid & 63, wr = wid >> 2, wc = wid & 3, fr = lane & 15, fq = lane >> 4;
    const int K = g.ld, nt = g.K / BK;
    unsigned voffA[2], voffB[2];
#pragma unroll
    for (int i = 0; i < 2; ++i) { int R, C; stage_rc(tid * 16 + i * 8192, R, C); const int Rb = Epi::PERM ? ((R & ~31) + perm32(R & 31)) : R;
        voffA[i] = (unsigned)(R * K + C) * 2u; voffB[i] = (unsigned)(Rb * K + C) * 2u; }
    const size_t kstep = (size_t)(BK * 2);
    const size_t hstep = (size_t)HALF * K * 2;
    const size_t tstep = 2 * hstep;
    const unsigned ldsw = (unsigned)wid * 1024u;
    const int aoff = lds_byte(wr * 64 + fr, fq * 8), boff = lds_byte(wc * 32 + fr, fq * 8);
#define PG8_SA(b, h) (((b) * 2 + (h)) * HTB)
#define PG8_SB(b, h) ((4 + (b) * 2 + (h)) * HTB)
#define PG8_STAGE(bufoff, gbase, voff) do { _Pragma("unroll") for (int _i = 0; _i < 2; ++_i) \
        __builtin_amdgcn_global_load_lds((const unsigned*)((const char*)(gbase) + (voff)[_i]), (PG8_LAS unsigned*)(lds + (bufoff) + ldsw + _i * 8192), 16, 0, 0); } while (0)
#define PG8_LDA(dst, b, h) do { _Pragma("unroll") for (int m = 0; m < 4; ++m) _Pragma("unroll") for (int k = 0; k < 2; ++k) dst[m][k] = *(const PG8_LAS bf16x8*)(lds + PG8_SA(b, h) + aoff + m * 2048 + k * 1024); } while (0)
#define PG8_LDB(dst, b, h) do { _Pragma("unroll") for (int n = 0; n < 2; ++n) _Pragma("unroll") for (int k = 0; k < 2; ++k) dst[n][k] = *(const PG8_LAS bf16x8*)(lds + PG8_SB(b, h) + boff + n * 2048 + k * 1024); } while (0)
#define PG8_MMA(ai, bj, At, Bt) do { __builtin_amdgcn_s_setprio(1); _Pragma("unroll") for (int m = 0; m < 4; ++m) _Pragma("unroll") for (int n = 0; n < 2; ++n) _Pragma("unroll") for (int k = 0; k < 2; ++k) \
        acc[ai][bj][m][n] = __builtin_amdgcn_mfma_f32_16x16x32_bf16(Bt[n][k], At[m][k], acc[ai][bj][m][n], 0, 0, 0); __builtin_amdgcn_s_setprio(0); } while (0)
#define PG8_WAIT_V(n) asm volatile("s_waitcnt vmcnt(" #n ")" ::: "memory")
#define PG8_WAIT_L(n) asm volatile("s_waitcnt lgkmcnt(" #n ")" ::: "memory")
#define PG8_BAR __builtin_amdgcn_s_barrier()
#define PG8_SCHED __builtin_amdgcn_sched_barrier(0)
    Unit cur, nxt; int ui = 0;
    if (!S.next(0, cur)) return;
    f32x4 acc[2][2][4][2];
#pragma unroll
    for (int a = 0; a < 2; ++a)
#pragma unroll
        for (int b = 0; b < 2; ++b)
#pragma unroll
            for (int m = 0; m < 4; ++m)
#pragma unroll
                for (int n = 0; n < 2; ++n) acc[a][b][m][n] = (f32x4){0.f, 0.f, 0.f, 0.f};
    bf16x8 At[4][2], B0[2][2], B1[2][2];
    const size_t sstep = (size_t)g.K * 2;
    const char* cA = (const char*)g.A + (size_t)cur.pm * tstep + (size_t)cur.kk * sstep; const char* cB = (const char*)g.Bt + (size_t)cur.pn * tstep + (size_t)cur.kk * sstep;
    S.a_ready(cur);
    if constexpr (SP2) {
        PG8_STAGE(PG8_SB(0, 0), cB, voffB); PG8_STAGE(PG8_SB(0, 1), cB + hstep, voffB); PG8_STAGE(PG8_SA(0, 0), cA, voffA); PG8_STAGE(PG8_SA(0, 1), cA + hstep, voffA);
        if (wr == 1) PG8_BAR;
        PG8_WAIT_V(2); PG8_BAR;
        PG8_STAGE(PG8_SB(1, 0), cB + kstep, voffB); PG8_STAGE(PG8_SA(1, 0), cA + kstep, voffA); PG8_STAGE(PG8_SB(1, 1), cB + hstep + kstep, voffB);
        PG8_WAIT_V(6); PG8_BAR;
    } else {
        PG8_STAGE(PG8_SB(0, 0), cB, voffB); PG8_STAGE(PG8_SA(0, 0), cA, voffA); PG8_STAGE(PG8_SB(0, 1), cB + hstep, voffB); PG8_STAGE(PG8_SA(0, 1), cA + hstep, voffA);
        if (wr == 1) PG8_BAR;
        PG8_WAIT_V(4); PG8_BAR;
        PG8_STAGE(PG8_SB(1, 0), cB + kstep, voffB); PG8_STAGE(PG8_SA(1, 0), cA + kstep, voffA); PG8_STAGE(PG8_SB(1, 1), cB + hstep + kstep, voffB);
        PG8_WAIT_V(6); PG8_BAR;
    }
    for (;;) {
        const bool has_next = S.next(ui + 1, nxt);
        const char* nA = has_next ? (const char*)g.A + (size_t)nxt.pm * tstep + (size_t)nxt.kk * sstep : cA; const char* nB = has_next ? (const char*)g.Bt + (size_t)nxt.pn * tstep + (size_t)nxt.kk * sstep : cB;
        for (int t = 0; t < nt; t += 2) {
            const bool last = (t == nt - 2);
            const char* a1 = cA + (size_t)(t + 1) * kstep;
            const char* a2 = last ? nA : cA + (size_t)(t + 2) * kstep; const char* b2 = last ? nB : cB + (size_t)(t + 2) * kstep;
            const char* a3 = a2 + kstep; const char* b3 = b2 + kstep;
            if (last && has_next) S.a_ready(nxt);
            if constexpr (SP2) {
            PG8_LDB(B0, 0, 0); PG8_LDB(B1, 0, 1); PG8_SCHED; PG8_LDA(At, 0, 0); PG8_STAGE(PG8_SA(1, 1), a1 + hstep, voffA);
            PG8_WAIT_V(8); PG8_WAIT_L(0); PG8_BAR; PG8_MMA(0, 0, At, B0); PG8_MMA(0, 1, At, B1); PG8_BAR; PG8_SCHED;
            PG8_LDA(At, 0, 1); PG8_STAGE(PG8_SB(0, 0), b2, voffB); PG8_STAGE(PG8_SB(0, 1), b2 + hstep, voffB); PG8_STAGE(PG8_SA(0, 0), a2, voffA);
            PG8_WAIT_V(8); PG8_WAIT_L(0); PG8_BAR; PG8_MMA(1, 0, At, B0); PG8_MMA(1, 1, At, B1); PG8_BAR; PG8_SCHED;
            PG8_LDB(B0, 1, 0); PG8_LDB(B1, 1, 1); PG8_SCHED; PG8_LDA(At, 1, 0); PG8_STAGE(PG8_SA(0, 1), a2 + hstep, voffA);
            PG8_WAIT_V(8); PG8_WAIT_L(0); PG8_BAR; PG8_MMA(0, 0, At, B0); PG8_MMA(0, 1, At, B1); PG8_BAR; PG8_SCHED;
            PG8_LDA(At, 1, 1); PG8_STAGE(PG8_SB(1, 0), b3, voffB); PG8_STAGE(PG8_SB(1, 1), b3 + hstep, voffB); PG8_STAGE(PG8_SA(1, 0), a3, voffA);
            PG8_WAIT_V(8); PG8_WAIT_L(0); PG8_BAR; PG8_MMA(1, 0, At, B0); PG8_MMA(1, 1, At, B1); PG8_BAR; PG8_SCHED;
            } else {
            PG8_LDB(B0, 0, 0); PG8_SCHED; PG8_LDA(At, 0, 0); PG8_STAGE(PG8_SA(1, 1), a1 + hstep, voffA);
            PG8_WAIT_L(8); PG8_BAR; PG8_WAIT_L(0); PG8_MMA(0, 0, At, B0); PG8_BAR; PG8_SCHED;
            PG8_LDB(B1, 0, 1); PG8_STAGE(PG8_SB(0, 0), b2, voffB);
            PG8_BAR; PG8_WAIT_L(0); PG8_MMA(0, 1, At, B1); PG8_BAR;
            PG8_LDA(At, 0, 1); PG8_STAGE(PG8_SA(0, 0), a2, voffA);
            PG8_BAR; PG8_WAIT_L(0); PG8_MMA(1, 0, At, B0); PG8_BAR; PG8_SCHED;
            PG8_STAGE(PG8_SB(0, 1), b2 + hstep, voffB);
            PG8_WAIT_V(6); PG8_BAR; PG8_MMA(1, 1, At, B1); PG8_BAR;
            PG8_LDB(B0, 1, 0); PG8_SCHED; PG8_LDA(At, 1, 0); PG8_STAGE(PG8_SA(0, 1), a2 + hstep, voffA);
            PG8_WAIT_L(8); PG8_BAR; PG8_WAIT_L(0); PG8_MMA(0, 0, At, B0); PG8_BAR; PG8_SCHED;
            PG8_LDB(B1, 1, 1); PG8_STAGE(PG8_SB(1, 0), b3, voffB);
            PG8_BAR; PG8_WAIT_L(0); PG8_MMA(0, 1, At, B1); PG8_BAR;
            PG8_LDA(At, 1, 1); PG8_STAGE(PG8_SA(1, 0), a3, voffA);
            PG8_BAR; PG8_WAIT_L(0); PG8_MMA(1, 0, At, B0); PG8_BAR; PG8_SCHED;
            PG8_STAGE(PG8_SB(1, 1), b3 + hstep, voffB);
            PG8_WAIT_V(6); PG8_BAR; PG8_MMA(1, 1, At, B1); PG8_BAR;
            }
        }
        if constexpr (ALIGN_EPI) { if (wr == 0) PG8_BAR; }
        if constexpr (!Epi::AFTER_DRAIN) { E(acc, cur, wr, wc, fr, fq); S.done(cur); }
        if (!has_next) break;
#pragma unroll
        for (int a = 0; a < 2; ++a)
#pragma unroll
            for (int b = 0; b < 2; ++b)
#pragma unroll
                for (int m = 0; m < 4; ++m)
#pragma unroll
                    for (int n = 0; n < 2; ++n) acc[a][b][m][n] = (f32x4){0.f, 0.f, 0.f, 0.f};
        cur = nxt; cA = nA; cB = nB; ++ui;
        if constexpr (ALIGN_EPI) { if (wr == 1) PG8_BAR; }
    }
    PG8_WAIT_V(0);
    if constexpr (!ALIGN_EPI) { if (wr == 0) PG8_BAR; }
    PG8_BAR;
    if constexpr (Epi::AFTER_DRAIN) { E.fused(acc, cur, wr, wc, fr, fq, lds, wid, lane); S.done(cur); }
#undef PG8_SA
#undef PG8_SB
#undef PG8_STAGE
#undef PG8_LDA
#undef PG8_LDB
#undef PG8_MMA
#undef PG8_WAIT_V
#undef PG8_WAIT_L
#undef PG8_BAR
#undef PG8_SCHED
}
}
#define XB_TMO      128
#define XB_XCNT(j)  (256  + 64 * (j))
#define XB_XSUB(j)  (1280 + 64 * (j))
#define XB_XGEN(j)  (2304 + 64 * (j))
#define XB_TOP      3328
#define XB_TOPGEN   3392
#define XCD_BAR_WORDS 3456
#define XB_SPIN_CAP (1u << 21)

__device__ __forceinline__ unsigned xb_ld(unsigned* p)              { return __hip_atomic_load(p, __ATOMIC_RELAXED, __HIP_MEMORY_SCOPE_AGENT); }
__device__ __forceinline__ unsigned xb_add(unsigned* p, unsigned v) { return __hip_atomic_fetch_add(p, v, __ATOMIC_RELAXED, __HIP_MEMORY_SCOPE_AGENT); }
__device__ __forceinline__ unsigned xb_xcc_id() { return (unsigned)__builtin_amdgcn_s_getreg((3 << 11) | 20) & 0xFu; }
#define XB_SPIN(cond, bar) do { unsigned _sp = 0; while (cond) { __builtin_amdgcn_s_sleep(1); \
    if ((++_sp & 255u) == 0u) { if (xb_ld(&(bar)[XB_TMO])) break; if (_sp > XB_SPIN_CAP) { atomicAdd(&(bar)[XB_TMO], 1u); break; } } } } while (0)

struct XcdBarrier {
    unsigned* bar; unsigned x;
    volatile LAS unsigned* st;
};

__device__ __forceinline__ XcdBarrier xcd_barrier_post(unsigned* bar, volatile LAS unsigned* st) {
    XcdBarrier b; b.bar = bar; b.x = (unsigned)__builtin_amdgcn_readfirstlane((int)xb_xcc_id()); b.st = st;
    if (threadIdx.x == 0) (void)xb_add(&bar[XB_XCNT(b.x)], 1u);
    return b;
}
__device__ __forceinline__ void xcd_barrier_complete(unsigned* bar, unsigned x, unsigned& nloc, unsigned& nx) {
    const unsigned G = gridDim.x * gridDim.y * gridDim.z;
    unsigned sum, cnt, mine, sp = 0u;
    for (;;) {
        sum = 0u; cnt = 0u; mine = 0u;
#pragma unroll
        for (unsigned j = 0; j < 16; ++j) { const unsigned c = xb_ld(&bar[XB_XCNT(j)]); sum += c; cnt += (c > 0u) ? 1u : 0u; }
        mine = xb_ld(&bar[XB_XCNT(x)]);
        if (sum == G) { mine = xb_ld(&bar[XB_XCNT(x)]); break; }
        __builtin_amdgcn_s_sleep(1);
        if ((++sp & 255u) == 0u) { if (xb_ld(&bar[XB_TMO])) break; if (sp > XB_SPIN_CAP) { atomicAdd(&bar[XB_TMO], 1u); break; } }
    }
    nloc = mine > 0u ? mine : 1u; nx = cnt > 0u ? cnt : 1u;
}

__device__ __forceinline__ void xcd_barrier(const XcdBarrier& b) {
    asm volatile("s_waitcnt vmcnt(0)" ::: "memory");
    __syncthreads();
    if (threadIdx.x == 0) {
        unsigned* bar = b.bar; unsigned bx_ = b.x;
        asm volatile("" : "+s"(bx_));
        __builtin_amdgcn_s_waitcnt(0);
        unsigned nloc = b.st[0], nx = b.st[1];
        if (nloc == 0u) { xcd_barrier_complete(bar, bx_, nloc, nx); b.st[0] = nloc; b.st[1] = nx; }
        const unsigned old = xb_add(&bar[XB_XSUB(bx_)], 1u);
        const unsigned gen = old / nloc;
        if (old + 1u == (gen + 1u) * nloc) {
            __builtin_amdgcn_fence(__ATOMIC_RELEASE, "agent");
            asm volatile("s_waitcnt vmcnt(0)" ::: "memory");
            const unsigned og = xb_add(&bar[XB_TOP], 1u);
            const unsigned tg = og / nx;
            if (og + 1u == (tg + 1u) * nx) xb_add(&bar[XB_TOPGEN], 1u);
            else XB_SPIN(xb_ld(&bar[XB_TOPGEN]) == tg, bar);
            __builtin_amdgcn_fence(__ATOMIC_ACQUIRE, "agent");
            xb_add(&bar[XB_XGEN(bx_)], 1u);
            asm volatile("s_waitcnt vmcnt(0)" ::: "memory");
        } else {
            XB_SPIN(xb_ld(&bar[XB_XGEN(bx_)]) == gen, bar);
            __builtin_amdgcn_fence(__ATOMIC_ACQUIRE, "agent");
            asm volatile("s_waitcnt vmcnt(0)" ::: "memory");
        }
    }
    __syncthreads();
}

typedef unsigned short bf16_t;
typedef short bf16x8 __attribute__((ext_vector_type(8)));
typedef float f32x4 __attribute__((ext_vector_type(4)));
typedef unsigned u32x4 __attribute__((ext_vector_type(4)));
#define LDS_WAIT() asm volatile("s_waitcnt lgkmcnt(0)" ::: "memory")

struct Params {
    const float* in[19];
};
struct Frame {
    LAS unsigned char* lds;
    int tid, lane, wave, G, bx, vcu, gw, ngw;
};
__device__ __forceinline__ const float* uptr(const LAS unsigned long long* t, int k) {
    const unsigned long long v = t[k]; const unsigned lo = __builtin_amdgcn_readfirstlane((unsigned)v), hi = __builtin_amdgcn_readfirstlane((unsigned)(v >> 32));
    return (const float*)(const GAS float*)(((unsigned long long)hi << 32) | lo); }

template <class CMap>
__device__ __forceinline__ void transpose_load(float (&v)[32], const float* W, int Nsrc, const float* ks, int kb, int nb, int lane, CMap cmap) {
    const int k0 = 64 * kb, n0 = 32 * nb; const int sc = cmap(n0 + (lane & 31));
#pragma unroll
    for (int i = 0; i < 32; ++i) { const int kk = 2 * i + (lane >> 5); float x = 0.f; if (sc >= 0) x = W[(size_t)(k0 + kk) * Nsrc + sc]; if (ks) x *= ks[k0 + kk]; v[i] = x; }
}
__device__ __forceinline__ void transpose_store(const float (&v)[32], int K, bf16_t* WT, LAS float* scr, int kb, int nb, int lane) {
    const int k0 = 64 * kb, n0 = 32 * nb;
#pragma unroll
    for (int i = 0; i < 32; ++i) scr[(2 * i + (lane >> 5)) * 33 + (lane & 31)] = v[i];
    LDS_WAIT(); asm volatile("" ::: "memory");
    const int c = lane & 7;
#pragma unroll
    for (int j = 0; j < 4; ++j) { const int n = (lane >> 3) + 8 * j; const LAS float* s = scr + (8 * c) * 33 + n;
        u32x4 o; o.x = pk2(s[0 * 33], s[1 * 33]); o.y = pk2(s[2 * 33], s[3 * 33]); o.z = pk2(s[4 * 33], s[5 * 33]); o.w = pk2(s[6 * 33], s[7 * 33]);
        *(u32x4*)(WT + (size_t)(n0 + n) * K + k0 + 8 * c) = o; }
    LDS_WAIT(); asm volatile("" ::: "memory");
}
template <class CMap>
__device__ __forceinline__ void transpose_matrix(const Frame& F, const float* W, int K, int Nsrc, int Ndst, bf16_t* WT, const float* ks, LAS float* scr, CMap cmap) {
    const int nnb = Ndst / 32, items = (K / 64) * nnb;
    for (int it = F.gw; it < items; it += 2 * F.ngw) { const int it2 = it + F.ngw; float va[32], vb[32];
        transpose_load(va, W, Nsrc, ks, it / nnb, it % nnb, F.lane, cmap);
        if (it2 < items) transpose_load(vb, W, Nsrc, ks, it2 / nnb, it2 % nnb, F.lane, cmap);
        transpose_store(va, K, WT, scr, it / nnb, it % nnb, F.lane);
        if (it2 < items) transpose_store(vb, K, WT, scr, it2 / nnb, it2 % nnb, F.lane); }
}
__device__ __forceinline__ int rope_perm(int m) { const int g = m >> 3, j = m & 7; return j < 4 ? 4 * g + j : 32 + 4 * g + (j - 4); }
struct CMapIn { __device__ int operator()(int n) const {
    if (n < 4096) return n; if (n < 4608) return 4112 + (n - 4096); if (n < 4864) return 4624 + (n - 4608);
    if (n < 4928) return 4880 + rope_perm(n - 4864); if (n < 4944) return 4096 + (n - 4928); return -1; } };
struct CMapQ { __device__ int operator()(int n) const { const int h = n / 192, o = n % 192; return o < 128 ? n : h * 192 + 128 + rope_perm(o - 128); } };
struct CMapUp { __device__ int operator()(int n) const { const int pn = n >> 8, j = n & 255; return j < 128 ? 128 * pn + j : DFF + 128 * pn + (j - 128); } };
struct CMapId { __device__ int operator()(int n) const { return n; } };

__device__ __forceinline__ void convert_weights(const Frame& F, unsigned char* ws, const LAS unsigned long long* pt, int l) {
    LAS float* scr = (LAS float*)(F.lds + F.wave * 8448);
    const float* w_in = uptr(pt, 3) + (size_t)l * DM * INC; const float* w_uq = uptr(pt, 8) + (size_t)l * 512 * NQ; const float* w_ukv = uptr(pt, 9) + (size_t)l * 256 * NKV;
    const float* w_out = uptr(pt, 10) + (size_t)l * DM * DM; const float* w_up = uptr(pt, 13) + (size_t)l * DM * NUP; const float* w_dn = uptr(pt, 16) + (size_t)l * DFF * DM;
    const float* qg = uptr(pt, 6) + (size_t)l * 512; const float* kvg = uptr(pt, 7) + (size_t)l * 256;
    transpose_matrix(F, w_in, DM, INC, NIN, (bf16_t*)(ws + WS_WIN), nullptr, scr, CMapIn());
    transpose_matrix(F, w_uq, 512, NQ, NQ, (bf16_t*)(ws + WS_WUQ), qg, scr, CMapQ());
    transpose_matrix(F, w_ukv, 256, NKV, NKV, (bf16_t*)(ws + WS_WUKV), kvg, scr, CMapId());
    transpose_matrix(F, w_out, DM, DM, DM, (bf16_t*)(ws + WS_WOUT), nullptr, scr, CMapId());
    transpose_matrix(F, w_up, DM, NUP, NUP, (bf16_t*)(ws + WS_WUP), nullptr, scr, CMapUp());
    transpose_matrix(F, w_dn, DFF, DM, DM, (bf16_t*)(ws + WS_WDN), nullptr, scr, CMapId());
}

__device__ __forceinline__ void prologue(const Frame& F, unsigned char* ws, const LAS unsigned long long* pt) {
    float* COS = (float*)(ws + WS_COS); float* SIN = (float*)(ws + WS_SIN);
    for (int i = F.bx * 512 + F.tid; i < 4112 * 32; i += F.G * 512) { const int pos = i >> 5, f = i & 31;
        const float inv = powf(10000.0f, -(float)(2 * f) / 64.0f); const float ang = (float)pos * inv; float s, c; sincosf(ang, &s, &c); COS[i] = c; SIN[i] = s; }
    { float* PAR = (float*)(ws + WS_PAR); const int gt = F.bx * 512 + F.tid, nt = F.G * 512;
      for (int i = gt; i < DEPTH * 16; i += nt) PAR[PO_BG + i] = uptr(pt, 4)[i];
      for (int i = gt; i < DEPTH * 1024; i += nt) PAR[PO_MLG + i] = uptr(pt, 5)[i];
      for (int i = gt; i < DEPTH * 512; i += nt) PAR[PO_QG + i] = uptr(pt, 6)[i];
      for (int i = gt; i < DEPTH * 256; i += nt) PAR[PO_KVG + i] = uptr(pt, 7)[i];
      for (int i = gt; i < 2048; i += nt) { PAR[PO_ONE + i] = 1.f; PAR[PO_ZERO + i] = 0.f; }
      { float* ST2 = (float*)(ws + WS_STAT2); for (int i = gt; i < TP; i += nt) { ST2[2 * i] = 0.f; ST2[2 * i + 1] = 1.f; } }
      for (int i = gt; i < DEPTH * 2048; i += nt) { PAR[PO_L1G + i] = uptr(pt, 11)[i]; PAR[PO_L1B + i] = uptr(pt, 12)[i]; PAR[PO_L2G + i] = uptr(pt, 17)[i]; PAR[PO_L2B + i] = uptr(pt, 18)[i]; }
      for (int i = gt; i < DEPTH * 3 * 5632; i += nt) PAR[PO_CW + i] = uptr(pt, 14)[i];
      for (int i = gt; i < DEPTH * 5632; i += nt) PAR[PO_CB + i] = uptr(pt, 15)[i]; }
    float* H = (float*)(ws + WS_H); bf16_t* HB = (bf16_t*)(ws + WS_HB);
    const float* xp = uptr(pt, 0); const float* xs = uptr(pt, 1); const float* mt = uptr(pt, 2);
    for (int row0 = F.gw; row0 < TP; row0 += 2 * F.ngw) {
        f32x4 v[2][8];
#pragma unroll
        for (int r = 0; r < 2; ++r) { const int row = row0 + r * F.ngw; const float* src = nullptr;
            if (row < 4 * LREAL) src = xp + (size_t)row * DM; else if (row < NMAIN) src = xs + (size_t)(row - 4 * LREAL) * DM; else if (row < NTOK) src = mt + (size_t)((row - NMAIN) & 15) * DM;
#pragma unroll
            for (int j = 0; j < 8; ++j) { v[r][j] = (f32x4){0.f, 0.f, 0.f, 0.f}; if (src) v[r][j] = ((const f32x4*)src)[F.lane + 64 * j]; } }
#pragma unroll
        for (int r = 0; r < 2; ++r) { const int row = row0 + r * F.ngw; if (row < TP) {
            f32x4* hd = (f32x4*)(H + (size_t)row * DM) + F.lane; u32x2* bd = (u32x2*)(HB + (size_t)row * DM) + F.lane;
#pragma unroll
            for (int j = 0; j < 8; ++j) { const f32x4 x = v[r][j]; hd[64 * j] = row >= NMAIN ? x * ALPHA : x;
                u32x2 w; w.x = pk2(x[0], x[1]); w.y = pk2(x[2], x[3]); bd[64 * j] = w; } } }
    }
}

__device__ __forceinline__ void ln_one(const f32x4 (&vin)[8], int row, int lane, float* __restrict__ Hw, bf16_t* __restrict__ HB, const float* __restrict__ g, const float* __restrict__ b, float* __restrict__ ST, float* __restrict__ out) {
    f32x4 v[8]; float s = 0.f;
#pragma unroll
    for (int j = 0; j < 8; ++j) { v[j] = vin[j]; s += (v[j][0] + v[j][1]) + (v[j][2] + v[j][3]); }
    const float mean = wave_sum(s) * (1.f / DM); float q = 0.f;
#pragma unroll
    for (int j = 0; j < 8; ++j) { v[j] = v[j] - mean; q += (v[j][0] * v[j][0] + v[j][1] * v[j][1]) + (v[j][2] * v[j][2] + v[j][3] * v[j][3]); }
    const float rstd = rsqrtf(wave_sum(q) * (1.f / DM) + EPS);
    if (lane == 0) { f32x2 ms = {mean, rstd}; *(f32x2*)(ST + (size_t)row * 2) = ms; }
    u32x2* bd = (u32x2*)(HB + (size_t)row * DM) + lane; f32x4* hp = (f32x4*)(Hw + (size_t)row * DM) + lane;
#pragma unroll
    for (int j = 0; j < 8; ++j) { const f32x4 gg = ((const f32x4*)g)[lane + 64 * j], bb = ((const f32x4*)b)[lane + 64 * j]; const f32x4 y = v[j] * rstd * gg + bb;
        u32x2 w; w.x = pk2(y[0], y[1]); w.y = pk2(y[2], y[3]); bd[64 * j] = w;
        if (row >= NMAIN) hp[64 * j] = y * ALPHA;
        else if (out) ((f32x4*)(out + (size_t)row * DM))[lane + 64 * j] = y; }
}
__device__ __forceinline__ void ln_rows(const Frame& F, float* H, bf16_t* HB, const float* g, const float* b, float* ST, float* out) {
    const float* __restrict__ Hr = H;
    for (int row = F.gw; row < TP; row += 2 * F.ngw) {
        const int row2 = row + F.ngw; const bool two = row2 < TP;
        f32x4 va[8], vb[8];
#pragma unroll
        for (int j = 0; j < 8; ++j) va[j] = ((const f32x4*)(Hr + (size_t)row * DM))[F.lane + 64 * j];
#pragma unroll
        for (int j = 0; j < 8; ++j) vb[j] = two ? ((const f32x4*)(Hr + (size_t)row2 * DM))[F.lane + 64 * j] : (f32x4){0.f, 0.f, 0.f, 0.f};
        ln_one(va, row, F.lane, H, HB, g, b, ST, out);
        if (two) ln_one(vb, row2, F.lane, H, HB, g, b, ST, out);
    }
}

__device__ __forceinline__ void rstd_rows(const Frame& F, const bf16_t* UDQ, const bf16_t* UDKV, float* RSTD) {
    for (int row = F.gw; row < TP; row += F.ngw) {
        const u32x4 a = ((const u32x4*)(UDQ + (size_t)row * 512))[F.lane]; float s = 0.f;
#pragma unroll
        for (int j = 0; j < 4; ++j) { const float x = bf_lo(a[j]), y = bf_hi(a[j]); s += x * x + y * y; }
        float t = 0.f;
        if (F.lane < 32) { const u32x4 c = ((const u32x4*)(UDKV + (size_t)row * 256))[F.lane];
#pragma unroll
            for (int j = 0; j < 4; ++j) { const float x = bf_lo(c[j]), y = bf_hi(c[j]); t += x * x + y * y; } }
        s = wave_sum(s); t = wave_sum(t);
        if (F.lane == 0) { RSTD[(size_t)row * 2] = rsqrtf(s * (1.f / 512.f) + EPS); RSTD[(size_t)row * 2 + 1] = rsqrtf(t * (1.f / 256.f) + EPS); }
    }
}

__device__ __forceinline__ void mlstm_finalize(const Frame& F, int gw0, int ngw0, const float* HSUM, const bf16_t* UQKVO, const float* ng, bf16_t* MIX) {
    for (int row = gw0; row < TP; row += ngw0) {
#pragma unroll
        for (int j = 0; j < 4; ++j) {
            f32x4 v = ((const f32x4*)(HSUM + (size_t)row * MLW + 256 * j))[F.lane];
            const float mean = wave_sum((v[0] + v[1]) + (v[2] + v[3])) * (1.f / 256.f); v = v - mean;
            const float rstd = rsqrtf(wave_sum((v[0] * v[0] + v[1] * v[1]) + (v[2] * v[2] + v[3] * v[3])) * (1.f / 256.f) + EPS);
            const f32x4 gg = ((const f32x4*)(ng + 256 * j))[F.lane];
            const u32x2 uo = ((const u32x2*)(UQKVO + (size_t)row * 4096 + 3072 + 256 * j))[F.lane];
            const float o0 = bf_lo(uo.x), o1 = bf_hi(uo.x), o2 = bf_lo(uo.y), o3 = bf_hi(uo.y);
            const float y0 = v[0] * rstd * gg[0] / (1.f + __expf(-o0)), y1 = v[1] * rstd * gg[1] / (1.f + __expf(-o1));
            const float y2 = v[2] * rstd * gg[2] / (1.f + __expf(-o2)), y3 = v[3] * rstd * gg[3] / (1.f + __expf(-o3));
            u32x2 w; w.x = pk2(y0, y1); w.y = pk2(y2, y3); ((u32x2*)(MIX + (size_t)row * DM + 256 * j))[F.lane] = w;
        }
    }
}

__device__ __forceinline__ f32x8 ld8f(const float* p) { const f32x4 a = *(const f32x4*)p, b = *(const f32x4*)(p + 4); return (f32x8){a[0], a[1], a[2], a[3], b[0], b[1], b[2], b[3]}; }
__device__ __forceinline__ f32x8 ld8b(const bf16_t* p) { const u32x4 v = *(const u32x4*)p; return (f32x8){bf_lo(v[0]), bf_hi(v[0]), bf_lo(v[1]), bf_hi(v[1]), bf_lo(v[2]), bf_hi(v[2]), bf_lo(v[3]), bf_hi(v[3])}; }
__device__ __forceinline__ void act_store(bf16_t* dst, const f32x8 gp, const f32x8 gc, const f32x8 gn, const f32x8 vv, const f32x8 w0, const f32x8 w1, const f32x8 w2, const f32x8 bb) {
    float o[8];
#pragma unroll
    for (int i = 0; i < 8; ++i) { const float x = w0[i] * gp[i] + w1[i] * gc[i] + w2[i] * gn[i] + bb[i]; o[i] = x / (1.f + __expf(-x)) * vv[i]; }
    u32x4 w; w.x = pk2(o[0], o[1]); w.y = pk2(o[2], o[3]); w.z = pk2(o[4], o[5]); w.w = pk2(o[6], o[7]); *(u32x4*)dst = w;
}
__device__ __forceinline__ void ffn_fixup(const Frame& F, const float* SIDE, const bf16_t* GVM, bf16_t* ACT, const float* cw, const float* cb) {
    constexpr int NCH = DFF / 8;
    const f32x8 zero = {0.f, 0.f, 0.f, 0.f, 0.f, 0.f, 0.f, 0.f};
    const int gt = F.bx * 512 + F.tid, nt = GRID * 512;
    for (int idx = gt; idx < 192 * 2 * NCH; idx += nt) {
        const int ch = idx % NCH, rsel = (idx / NCH) & 1, pm = idx / (2 * NCH), c0 = 8 * ch, sq = pm >> 4;
        const f32x8 w0 = ld8f(cw + c0), w1 = ld8f(cw + DFF + c0), w2 = ld8f(cw + 2 * DFF + c0), bb = ld8f(cb + c0);
        const float* S0 = SIDE + (size_t)pm * 6 * DFF + c0;
        if (rsel == 0) { const f32x8 gp = (pm & 15) ? ld8f(S0 - 6 * DFF + 3 * DFF) : ld8b(GVM + (size_t)(16 * sq + 15) * NUP + c0);
            act_store(ACT + (size_t)(pm * 256) * DFF + c0, gp, ld8f(S0), ld8f(S0 + DFF), ld8f(S0 + 4 * DFF), w0, w1, w2, bb);
        } else { const f32x8 gn = ((pm & 15) != 15) ? ld8f(S0 + 6 * DFF) : zero;
            act_store(ACT + (size_t)(pm * 256 + 255) * DFF + c0, ld8f(S0 + 2 * DFF), ld8f(S0 + 3 * DFF), gn, ld8f(S0 + 5 * DFF), w0, w1, w2, bb); }
    }
    for (int idx = gt; idx < NSEQ * NCH; idx += nt) {
        const int ch = idx % NCH, sq = idx / NCH, c0 = 8 * ch;
        const f32x8 w0 = ld8f(cw + c0), w1 = ld8f(cw + DFF + c0), w2 = ld8f(cw + 2 * DFF + c0), bb = ld8f(cb + c0);
        f32x8 gp = zero, gc = ld8b(GVM + (size_t)(16 * sq) * NUP + c0);
        for (int p = 0; p < 16; ++p) {
            const f32x8 gn = p < 15 ? ld8b(GVM + (size_t)(16 * sq + p + 1) * NUP + c0) : ld8f(SIDE + (size_t)(16 * sq) * 6 * DFF + c0);
            act_store(ACT + (size_t)(MROW0 + 16 * sq + p) * DFF + c0, gp, gc, gn, ld8b(GVM + (size_t)(16 * sq + p) * NUP + DFF + c0), w0, w1, w2, bb);
            gp = gc; gc = gn;
        }
    }
}

namespace att {
constexpr int NW = 8, QBLK = 32, KVBLK = 64, NT = 65;
constexpr int KROW = 400;
constexpr int SHM_V = KVBLK * 128 * 2, SHM_K = KVBLK * KROW;
constexpr int OFF_V = 0, OFF_K = 3 * SHM_V, OFF_WS = OFF_K + 3 * SHM_K, LDS_TOTAL = OFF_WS + NW * 64 * 4;
static_assert(LDS_TOTAL <= RING_BYTES, "attention LDS");
constexpr float SCALE = 0.07216878364870323f;
constexpr float THR = 8.f;
#define SBAR() __builtin_amdgcn_sched_barrier(0)
__device__ __forceinline__ int crow(int r, int hi) { return (r & 3) + 8 * (r >> 2) + 4 * hi; }
__device__ __forceinline__ unsigned cvtpk(float lo, float hi) { unsigned r; asm volatile("v_cvt_pk_bf16_f32 %0, %1, %2" : "=v"(r) : "v"(lo), "v"(hi)); return r; }

template <bool MASK16>
__device__ __forceinline__ void partialSM(f32x16& p0, f32x16& p1, float& m_reg, float& mn, float& alpha) {
    constexpr float C = SCALE * 1.4426950408889634f;
    if (MASK16) {
#pragma unroll
        for (int r = 8; r < 16; ++r) p0[r] = NEGBIG;
#pragma unroll
        for (int r = 0; r < 16; ++r) p1[r] = NEGBIG;
    }
    float pmax = p0[0];
#pragma unroll
    for (int r = 1; r < 16; ++r) pmax = fmaxf(pmax, p0[r]);
#pragma unroll
    for (int r = 0; r < 16; ++r) pmax = fmaxf(pmax, p1[r]);
    { auto rr = __builtin_amdgcn_permlane32_swap(__float_as_uint(pmax), __float_as_uint(pmax), false, false); pmax = fmaxf(__uint_as_float(rr[0]), __uint_as_float(rr[1])); }
    if (__builtin_expect(__all(pmax - m_reg <= THR / SCALE), 1)) { mn = m_reg; alpha = 1.f; }
    else { mn = fmaxf(m_reg, pmax); alpha = __builtin_amdgcn_exp2f((m_reg - mn) * C); m_reg = mn; }
    const float mnC = -mn * C;
#pragma unroll
    for (int r = 0; r < 16; ++r) p0[r] = fmaf(p0[r], C, mnC);
#pragma unroll
    for (int r = 0; r < 16; ++r) p1[r] = fmaf(p1[r], C, mnC);
#pragma unroll
    for (int r = 0; r < 16; ++r) p0[r] = __builtin_amdgcn_exp2f(p0[r]);
}
__device__ __forceinline__ void finishSM(f32x16& p0, f32x16& p1, float alpha, float& l_reg, bf16x8& pa0, bf16x8& pa1, bf16x8& pa2, bf16x8& pa3) {
#pragma unroll
    for (int r = 0; r < 16; ++r) p1[r] = __builtin_amdgcn_exp2f(p1[r]);
    float ps = 0;
#pragma unroll
    for (int r = 0; r < 16; ++r) ps += p0[r];
#pragma unroll
    for (int r = 0; r < 16; ++r) ps += p1[r];
    { auto rr = __builtin_amdgcn_permlane32_swap(__float_as_uint(ps), __float_as_uint(ps), false, false); ps = __uint_as_float(rr[0]) + __uint_as_float(rr[1]); }
    l_reg = l_reg * alpha + ps;
#define PK4(P, BASE, OUT) do { unsigned a0 = cvtpk(P[BASE + 0], P[BASE + 1]), a1 = cvtpk(P[BASE + 2], P[BASE + 3]);   \
    unsigned b0 = cvtpk(P[BASE + 4], P[BASE + 5]), b1 = cvtpk(P[BASE + 6], P[BASE + 7]);                              \
    auto r0 = __builtin_amdgcn_permlane32_swap(a0, b0, false, false); auto r1 = __builtin_amdgcn_permlane32_swap(a1, b1, false, false); \
    u32x4 w = {r0[0], r1[0], r0[1], r1[1]}; OUT = __builtin_bit_cast(bf16x8, w); } while (0)
    PK4(p0, 0, pa0); PK4(p0, 8, pa1); PK4(p1, 0, pa2); PK4(p1, 8, pa3);
#undef PK4
}
__device__ __forceinline__ void qkt(f32x16& p0, f32x16& p1, const LAS char* Ks, const bf16x8* qr, int r32, int hi) {
#pragma unroll
    for (int r = 0; r < 16; ++r) { p0[r] = 0.f; p1[r] = 0.f; }
#pragma unroll
    for (int d0 = 0; d0 < 12; ++d0) { const int cb = (d0 * 16 + hi * 8) * 2;
        const bf16x8 b0 = *(const LAS bf16x8*)(Ks + r32 * KROW + cb);
        const bf16x8 b1 = *(const LAS bf16x8*)(Ks + (32 + r32) * KROW + cb);
        p0 = __builtin_amdgcn_mfma_f32_32x32x16_bf16(b0, qr[d0], p0, 0, 0, 0);
        p1 = __builtin_amdgcn_mfma_f32_32x32x16_bf16(b1, qr[d0], p1, 0, 0, 0); }
}
__device__ __forceinline__ int v_st(int k, int c) { const int kk = (k & ~0xC) | ((k & 4) << 1) | ((k & 8) >> 1); return ((kk >> 3) * 4 + (c >> 5)) * 512 + ((kk & 7) * 32 + (c & 31)) * 2; }
__device__ __forceinline__ int v_rd_base(int lane) { return ((lane & 3) << 3) | (((lane >> 2) & 3) << 6) | (((lane >> 4) & 1) << 5) | (((lane >> 5) & 1) << 8); }
constexpr int v_rd_off(int d0, int ks, int half) { return d0 * 512 + ks * 4096 + half * 2048; }
template <int OFF> __device__ __forceinline__ s16x4 tr_read(int vb) { s16x4 r; asm volatile("ds_read_b64_tr_b16 %0, %1 offset:%2" : "=&v"(r) : "v"(vb), "i"(OFF) : "memory"); return r; }
template <int D0> __device__ __forceinline__ void pv_one(f32x16& od, int vb, bf16x8 pa0, bf16x8 pa1, bf16x8 pa2, bf16x8 pa3) {
    const s16x4 l0 = tr_read<v_rd_off(D0, 0, 0)>(vb), h0 = tr_read<v_rd_off(D0, 0, 1)>(vb), l1 = tr_read<v_rd_off(D0, 1, 0)>(vb), h1 = tr_read<v_rd_off(D0, 1, 1)>(vb);
    const s16x4 l2 = tr_read<v_rd_off(D0, 2, 0)>(vb), h2 = tr_read<v_rd_off(D0, 2, 1)>(vb), l3 = tr_read<v_rd_off(D0, 3, 0)>(vb), h3 = tr_read<v_rd_off(D0, 3, 1)>(vb);
    asm volatile("s_waitcnt lgkmcnt(0)" ::: "memory"); SBAR();
#define PKV(L, H) (bf16x8){L[0], L[1], L[2], L[3], H[0], H[1], H[2], H[3]}
    od = __builtin_amdgcn_mfma_f32_32x32x16_bf16(pa0, PKV(l0, h0), od, 0, 0, 0);
    od = __builtin_amdgcn_mfma_f32_32x32x16_bf16(pa1, PKV(l1, h1), od, 0, 0, 0);
    od = __builtin_amdgcn_mfma_f32_32x32x16_bf16(pa2, PKV(l2, h2), od, 0, 0, 0);
    od = __builtin_amdgcn_mfma_f32_32x32x16_bf16(pa3, PKV(l3, h3), od, 0, 0, 0);
#undef PKV
}
__device__ __forceinline__ void pv_d0(f32x16* o, int vb, bf16x8 pa0, bf16x8 pa1, bf16x8 pa2, bf16x8 pa3) {
    pv_one<0>(o[0], vb, pa0, pa1, pa2, pa3); pv_one<1>(o[1], vb, pa0, pa1, pa2, pa3); pv_one<2>(o[2], vb, pa0, pa1, pa2, pa3); pv_one<3>(o[3], vb, pa0, pa1, pa2, pa3);
}

__device__ __forceinline__ void attn_unit(int s, int h, int qb, const bf16_t* __restrict__ MQ, const bf16_t* __restrict__ MKV, const bf16_t* __restrict__ KR, bf16_t* __restrict__ MIX, LAS char* lds) {
    int tid_ = threadIdx.x; asm volatile("" : "+v"(tid_));
    const int tid = tid_, wid = tid >> 6, lane = tid & 63, r32 = lane & 31, hi = lane >> 5;
    LAS char* V_lds = lds + OFF_V; LAS char* K_lds = lds + OFF_K;
    LAS float* wsf = (LAS float*)(lds + OFF_WS) + wid * 64; LAS float* li_l = wsf; LAS float* al_l = wsf + 32;
    float m_reg = NEGBIG, l_reg = 0; f32x16 o[4]; bf16x8 qr[12];
#pragma unroll
    for (int d = 0; d < 4; ++d)
#pragma unroll
        for (int r = 0; r < 16; ++r) o[d][r] = 0.f;
    const int qi = wid * QBLK + r32;
    const unsigned qrow = qb < 16 ? (unsigned)s * LREAL + 256 * qb + qi : (unsigned)MROW0 + 16 * s + (qi < 15 ? qi : 15);
    { const bf16_t* Qw = MQ + (qrow * NQ + h * 192 + hi * 8);
#pragma unroll
      for (int d0 = 0; d0 < 12; ++d0) qr[d0] = *(const bf16x8*)(Qw + d0 * 16); }
    const int sr = tid >> 4, sc = (tid & 15) * 8, vst0 = v_st(sr, sc), vst1 = v_st(32 + sr, sc);
    const int kr_r = tid >> 3, kr_c = (tid & 7) * 8;
    const int vb0 = (int)(uintptr_t)V_lds + v_rd_base(lane);
    bf16x8 vs0, vs1, ks0, ks1, kr0;
    const unsigned mainrow0 = (unsigned)s * LREAL, metarow0 = (unsigned)MROW0 + 16 * s;
    const bf16_t* MKVh = MKV + h * 256;
#define KROWG(kt, k) ((kt) < 64 ? mainrow0 + 64u * (kt) + (k) : metarow0 + ((k) < 15 ? (k) : 15))
#define SLOAD(kt) do { const unsigned g0 = KROWG(kt, sr) * NKV + sc, g1 = KROWG(kt, 32 + sr) * NKV + sc, g2 = KROWG(kt, kr_r) * 64 + kr_c; \
    vs0 = *(const bf16x8*)(MKVh + 128 + g0); vs1 = *(const bf16x8*)(MKVh + 128 + g1); \
    ks0 = *(const bf16x8*)(MKVh + g0); ks1 = *(const bf16x8*)(MKVh + g1); kr0 = *(const bf16x8*)(KR + g2); } while (0)
#define SWRITE(b) do { *(LAS bf16x8*)(V_lds + (b) * SHM_V + vst0) = vs0; *(LAS bf16x8*)(V_lds + (b) * SHM_V + vst1) = vs1; \
    *(LAS bf16x8*)(K_lds + (b) * SHM_K + sr * KROW + sc * 2) = ks0; *(LAS bf16x8*)(K_lds + (b) * SHM_K + (32 + sr) * KROW + sc * 2) = ks1; \
    *(LAS bf16x8*)(K_lds + (b) * SHM_K + kr_r * KROW + 256 + kr_c * 2) = kr0; } while (0)
#define RESC(a) do { if (__any((a) < 1.f)) { if (hi == 0) al_l[r32] = (a); asm volatile("s_waitcnt lgkmcnt(0)" ::: "memory"); \
    _Pragma("unroll") for (int d = 0; d < 4; ++d) _Pragma("unroll") for (int r = 0; r < 16; ++r) o[d][r] *= al_l[crow(r, hi)]; } } while (0)
    f32x16 pA0, pA1, pB0, pB1; float mnA, mnB, alA, alB; bf16x8 pa0, pa1, pa2, pa3;
    __syncthreads();
    SLOAD(0); SWRITE(0); __syncthreads();
    qkt(pA0, pA1, K_lds, qr, r32, hi); partialSM<false>(pA0, pA1, m_reg, mnA, alA);
    SLOAD(1); SWRITE(1); __syncthreads();
    RESC(alA);
    int s0 = 0, s1 = 1, s2 = 2;
    for (int j = 1; j + 1 < NT; j += 2) {
        SBAR(); qkt(pB0, pB1, K_lds + s1 * SHM_K, qr, r32, hi);
        finishSM(pA0, pA1, alA, l_reg, pa0, pa1, pa2, pa3); SBAR();
        SLOAD(j + 1); SBAR();
        pv_d0(o, vb0 + s0 * SHM_V, pa0, pa1, pa2, pa3); partialSM<false>(pB0, pB1, m_reg, mnB, alB);
        SWRITE(s2);
        RESC(alB); __syncthreads();
        SBAR(); qkt(pA0, pA1, K_lds + s2 * SHM_K, qr, r32, hi);
        finishSM(pB0, pB1, alB, l_reg, pa0, pa1, pa2, pa3); SBAR();
        if (j + 2 < NT) SLOAD(j + 2); SBAR();
        pv_d0(o, vb0 + s1 * SHM_V, pa0, pa1, pa2, pa3);
        if (j + 1 == NT - 1) partialSM<true>(pA0, pA1, m_reg, mnA, alA); else partialSM<false>(pA0, pA1, m_reg, mnA, alA);
        if (j + 2 < NT) SWRITE(s0);
        RESC(alA); __syncthreads();
        { const int t0 = s0, t1 = s1; s0 = s2; s1 = t0; s2 = t1; }
    }
    finishSM(pA0, pA1, alA, l_reg, pa0, pa1, pa2, pa3); SBAR();
    pv_d0(o, vb0 + s0 * SHM_V, pa0, pa1, pa2, pa3);
    if (hi == 0) li_l[r32] = l_reg; asm volatile("s_waitcnt lgkmcnt(0)" ::: "memory");
    float rli[16];
#pragma unroll
    for (int r = 0; r < 16; ++r) rli[r] = __builtin_amdgcn_rcpf(li_l[crow(r, hi)]);
    if (qb < 16) {
        bf16_t* Ow = MIX + ((long)s * LREAL + 256 * qb + wid * QBLK) * DM + MLW + h * 128;
#pragma unroll
        for (int r = 0; r < 16; ++r) { const int orow = crow(r, hi);
#pragma unroll
            for (int d0 = 0; d0 < 4; ++d0) Ow[(long)orow * DM + d0 * 32 + r32] = (bf16_t)(pk2(o[d0][r] * rli[r], 0.f) & 0xffffu); }
    } else if (wid == 0) {
        bf16_t* Ow = MIX + ((long)MROW0 + 16 * s) * DM + MLW + h * 128;
#pragma unroll
        for (int r = 0; r < 16; ++r) { const int orow = crow(r, hi);
            if (orow < 16) {
#pragma unroll
                for (int d0 = 0; d0 < 4; ++d0) Ow[(long)orow * DM + d0 * 32 + r32] = (bf16_t)(pk2(o[d0][r] * rli[r], 0.f) & 0xffffu); } }
    }
#undef KROWG
#undef SLOAD
#undef SWRITE
#undef RESC
}
__device__ __forceinline__ void attn_phase(int vcu, const bf16_t* MQ, const bf16_t* MKV, const bf16_t* KR, bf16_t* MIX, LAS char* lds) {
    for (int i = (vcu < 96 ? -1 : 0); i < 6; ++i) { int sh, qb; if (i < 0) { sh = vcu; qb = 16; } else { const int id = i * GRID + vcu; sh = id >> 4; qb = id & 15; }
        attn_unit(sh >> 3, sh & 7, qb, MQ, MKV, KR, MIX, lds); }
}
#undef SBAR
}

namespace ml {
constexpr int QI = 0, KI = 32768, VI = 65536, SI = 81920, CI = 98304;
constexpr int SC_CT = 0, SC_BM = 64, SC_WI = 128, SC_EI = 192, SC_WW = 256, SC_DEN = 320, SC_QN = 448, SC_N = 512, SC_A = 768;
constexpr int GP_REC = 200;
__device__ __forceinline__ unsigned off_b(unsigned row, unsigned ch) { return 256u * row + 16u * (ch ^ (((row & 3) << 2) | ((row >> 2) & 3))); }
__device__ __forceinline__ unsigned row_read_addr_16(unsigned lane, unsigned rb, unsigned s) { return off_b((lane & 15) + 16 * rb, 4 * s + (lane >> 4)); }
__device__ __forceinline__ unsigned tr_read_addr_16(unsigned lane, unsigned c, unsigned ks, unsigned t) {
    const unsigned g = lane >> 4, q = (lane & 15) >> 2, p = lane & 3; return off_b(32 * ks + 8 * g + 4 * t + q, 2 * c + (p >> 1)) + 8 * (p & 1); }
__device__ __forceinline__ bf16x8 tr_frag(unsigned a0, unsigned a1) {
    const s16x4 lo = __builtin_amdgcn_ds_read_tr16_b64_v4i16((LAS s16x4*)a0), hi = __builtin_amdgcn_ds_read_tr16_b64_v4i16((LAS s16x4*)a1);
    return (bf16x8){lo[0], lo[1], lo[2], lo[3], hi[0], hi[1], hi[2], hi[3]};
}
__device__ __forceinline__ f32x4 mfma16(bf16x8 a, bf16x8 b, f32x4 c) { return __builtin_amdgcn_mfma_f32_16x16x32_bf16(a, b, c, 0, 0, 0); }
__device__ __forceinline__ float log_sigmoid(float x) { return fminf(x, 0.f) - __logf(1.f + __expf(-fabsf(x))); }

__device__ __forceinline__ void gate_prep(int gw, int ngw, int lane, const float* __restrict__ GATES, const float* __restrict__ bgl, float* __restrict__ GP) {
    for (int it = gw; it < 96 * 65; it += ngw) {
        const int chain = it / 65, c = it % 65, s = chain >> 3, hd = (chain >> 1) & 3, dir = chain & 1;
        const long g = c == 0 ? (lane >= 48 ? (long)MROW0 + 16 * s + lane - 48 : -1L) : (long)s * LREAL + 64 * (c - 1) + lane;
        float li = NEGBIG, lf = 0.f;
        if (g >= 0) { li = GATES[g * 16 + (dir ? 8 : 0) + hd] + bgl[(dir ? 8 : 0) + hd]; lf = log_sigmoid(GATES[g * 16 + (dir ? 12 : 4) + hd] + bgl[(dir ? 12 : 4) + hd]); }
        float x = dir ? __shfl(lf, 63 - lane) : lf;
#pragma unroll
        for (int o = 1; o < 64; o <<= 1) { const float y = __shfl_up(x, o); if (lane >= o) x += y; }
        const float btot = __shfl(x, 63);
        const float b = dir ? __shfl(x, 63 - lane) : x;
        const float a_s = li - b;
        float pm = dir ? __shfl(a_s, 63 - lane) : a_s;
#pragma unroll
        for (int o = 1; o < 64; o <<= 1) { const float y = __shfl_up(pm, o); if (lane >= o) pm = fmaxf(pm, y); }
        pm = dir ? __shfl(pm, 63 - lane) : pm;
        const float gmax = wave_max(btot - b + li);
        float* rec = GP + (size_t)it * GP_REC;
        rec[lane] = b; rec[64 + lane] = li; rec[128 + lane] = pm; if (lane == 0) { rec[192] = btot; rec[193] = gmax; }
    }
}

__device__ __forceinline__ void mlstm_unit(int s, int hd, int js, const bf16_t* __restrict__ UQKVO, const float* __restrict__ GP, float* __restrict__ HSUM, LAS unsigned char* lds, LAS float* sc) {
    const int wid = __builtin_amdgcn_readfirstlane((int)threadIdx.x >> 6);
    const unsigned ldsb = (unsigned)(uintptr_t)lds;
    const int tt = wid >> 1, nb = 2 * (wid & 1);
#define ROWRD(img, rb, s_) (*(const LAS bf16x8*)(uintptr_t)(RB[s_] + (unsigned)((img) + 4096 * (rb))))
#define TRFRAG(img, c_, ks) tr_frag(BT[0][(c_) & 1] + TQ[(c_) >> 1] + (unsigned)((img) + 8192 * (ks)), BT[1][(c_) & 1] + TQ[(c_) >> 1] + (unsigned)((img) + 8192 * (ks)))
    f32x4 accC[2][4], accN[2];
    for (int dir = 0; dir < 2; ++dir) {
        int tid; { int t0_ = threadIdx.x; asm volatile("" : "+v"(t0_)); tid = t0_; }
#pragma unroll
        for (int mi = 0; mi < 2; ++mi)
#pragma unroll
            for (int c = 0; c < 4; ++c) accC[mi][c] = (f32x4){0.f, 0.f, 0.f, 0.f};
        accN[0] = (f32x4){0.f, 0.f, 0.f, 0.f}; accN[1] = (f32x4){0.f, 0.f, 0.f, 0.f};
        if (tid < 256) sc[SC_N + tid] = 0.f;
        for (int i = tid; i < 32768 / 16; i += 512) *(LAS u32x4*)(lds + CI + i * 16) = (u32x4){0u, 0u, 0u, 0u};
        float m_state = 0.f;
        const float* GPc = GP + (size_t)(((s * 4 + hd) * 2 + dir) * 65) * GP_REC;
        u32x4 sq[4], sk[4], sv; float sb = 0.f, sli = NEGBIG, spm = NEGBIG, sbt = 0.f, sgm = NEGBIG;
#define ROWG(c, r) ((c) == 0 ? ((r) >= 48 ? (long)MROW0 + 16 * s + (r) - 48 : -1L) : (long)s * LREAL + 64 * ((c) - 1) + (r))
#define STAGE_LOAD(c) do { \
        _Pragma("unroll") for (int i = 0; i < 4; ++i) { const int id = tid + 512 * i, r = id >> 5, ch = id & 31; const long g = ROWG(c, r); \
            sq[i] = (u32x4){0u, 0u, 0u, 0u}; sk[i] = (u32x4){0u, 0u, 0u, 0u}; \
            if (g >= 0) { sq[i] = *(const u32x4*)(UQKVO + g * 4096 + hd * 256 + ch * 8); sk[i] = *(const u32x4*)(UQKVO + g * 4096 + 1024 + hd * 256 + ch * 8); } } \
        { const int r = tid >> 3, ch = tid & 7; const long g = ROWG(c, r); sv = (u32x4){0u, 0u, 0u, 0u}; if (g >= 0) sv = *(const u32x4*)(UQKVO + g * 4096 + 2048 + hd * 256 + js * 64 + ch * 8); } \
        if (tid < 64) { const float* rec = GPc + (size_t)(c) * GP_REC; sb = rec[tid]; sli = rec[64 + tid]; spm = rec[128 + tid]; sbt = rec[192]; sgm = rec[193]; } } while (0)
#define STAGE_WRITE() do { \
        _Pragma("unroll") for (int i = 0; i < 4; ++i) { const int id = tid + 512 * i, r = id >> 5, ch = id & 31; \
            *(LAS u32x4*)(lds + QI + (ch >> 4) * 16384 + off_b(r, ch & 15)) = sq[i]; *(LAS u32x4*)(lds + KI + (ch >> 4) * 16384 + off_b(r, ch & 15)) = sk[i]; } \
        { const int r = tid >> 3, ch = tid & 7; *(LAS u32x4*)(lds + VI + off_b(r, ch)) = sv; } \
        if (tid < 64) { const float m_inter = sb + m_state, mt = fmaxf(m_inter, sb + spm); const float m_new = fmaxf(sbt + m_state, sgm); \
            sc[SC_CT + tid] = sli - sb; sc[SC_BM + tid] = sb - mt; sc[SC_WI + tid] = __expf(m_inter - mt); sc[SC_EI + tid] = __expf(-mt); \
            sc[SC_WW + tid] = __expf(sbt - sb + sli - m_new) * 0.0625f; if (tid == 0) sc[SC_A] = __expf(sbt + m_state - m_new); m_state = m_new; } } while (0)
        const int c_first = dir ? 64 : 0, c_step = dir ? -1 : 1;
        STAGE_LOAD(c_first);
        __syncthreads();
        STAGE_WRITE();
        for (int ci = 0; ci < 65; ++ci) {
            const int c = c_first + c_step * ci;
            { int t2_ = threadIdx.x; asm volatile("" : "+v"(t2_)); tid = t2_; }
            const int lane = tid & 63, l15 = lane & 15, lg = lane >> 4;
            unsigned RB[4], BT[2][2], TQ[4];
            { const unsigned fl = ((l15 & 3) << 2) | (l15 >> 2), q = l15 >> 2, p = lane & 3, g = lg;
#pragma unroll
              for (int s_ = 0; s_ < 4; ++s_) { RB[s_] = ldsb + 256u * l15 + 16u * (lg ^ (fl & 3)) + 64u * (s_ ^ (fl >> 2)); TQ[s_] = 64u * (s_ ^ q); }
#pragma unroll
              for (int t_ = 0; t_ < 2; ++t_)
#pragma unroll
                  for (int cl = 0; cl < 2; ++cl) BT[t_][cl] = ldsb + 256u * (8 * g + q) + 8u * (p & 1) + 1024u * t_ + 16u * ((p >> 1) ^ t_) + 32u * (cl ^ (g & 1)); }
            __syncthreads();
            if (ci + 1 < 65) STAGE_LOAD(c + c_step);
            bf16x8 qf[8];
#pragma unroll
            for (int k = 0; k < 8; ++k) qf[k] = ROWRD(QI + (k >> 2) * 16384, tt, k & 3);
            f32x4 sT[2], oc[2];
#pragma unroll
            for (int i = 0; i < 2; ++i) { sT[i] = (f32x4){0.f, 0.f, 0.f, 0.f}; oc[i] = (f32x4){0.f, 0.f, 0.f, 0.f}; }
#pragma unroll
            for (int i = 0; i < 2; ++i)
#pragma unroll
                for (int k = 0; k < 8; ++k) {
                    const bf16x8 kf = ROWRD(KI + (k >> 2) * 16384, nb + i, k & 3);
                    sT[i] = mfma16(kf, qf[k], sT[i]);
                    const bf16x8 cf = ROWRD(CI + (k >> 2) * 16384, nb + i, k & 3);
                    oc[i] = mfma16(qf[k], cf, oc[i]);
                }
            {
                const int t = 16 * tt + l15; const float bmt = sc[SC_BM + t]; float rs = 0.f;
#pragma unroll
                for (int i = 0; i < 2; ++i) { const int s0 = 16 * (nb + i) + 4 * lg; const f32x4 ctv = *(const LAS f32x4*)(sc + SC_CT + s0); float v[4];
#pragma unroll
                    for (int e = 0; e < 4; ++e) { const int sx = s0 + e; const bool ok = dir ? (sx >= t) : (sx <= t);
                        const float ex = ok ? (bmt + ctv[e]) : NEGBIG; v[e] = sT[i][e] * 0.0625f * __expf(ex); rs += v[e]; }
                    u32x2 w; w.x = pk2(v[0], v[1]); w.y = pk2(v[2], v[3]);
                    *(LAS u32x2*)(lds + SI + off_b(t, s0 >> 3) + (s0 & 7) * 2) = w; }
                rs += __shfl_xor(rs, 16); rs += __shfl_xor(rs, 32);
                if (lg == 0) sc[SC_DEN + 64 * (wid & 1) + t] = rs;
            }
            { const int r = tid >> 3, ch = tid & 7; const u32x4 v = *(const LAS u32x4*)(lds + VI + off_b(r, ch)); const float w = sc[SC_WW + r]; u32x4 o;
#pragma unroll
              for (int jx = 0; jx < 4; ++jx) o[jx] = pk2(bf_lo(v[jx]) * w, bf_hi(v[jx]) * w);
              *(LAS u32x4*)(lds + VI + off_b(r, 8 + ch)) = o; }
            { const int r = tid >> 3, part = tid & 7; float d = 0.f;
#pragma unroll
              for (int i = 0; i < 4; ++i) { const int ch32 = part * 4 + i; const u32x4 v = *(const LAS u32x4*)(lds + QI + (ch32 >> 4) * 16384 + off_b(r, ch32 & 15));
                  const f32x4 n0 = *(const LAS f32x4*)(sc + SC_N + ch32 * 8), n1 = *(const LAS f32x4*)(sc + SC_N + ch32 * 8 + 4);
                  d += bf_lo(v[0]) * n0[0] + bf_hi(v[0]) * n0[1] + bf_lo(v[1]) * n0[2] + bf_hi(v[1]) * n0[3] + bf_lo(v[2]) * n1[0] + bf_hi(v[2]) * n1[1] + bf_lo(v[3]) * n1[2] + bf_hi(v[3]) * n1[3]; }
              d += __shfl_xor(d, 1); d += __shfl_xor(d, 2); d += __shfl_xor(d, 4);
              if (part == 0) sc[SC_QN + r] = d; }
            { const f32x4 wi = *(const LAS f32x4*)(sc + SC_WI + 16 * tt + 4 * lg);
#pragma unroll
              for (int i = 0; i < 2; ++i) oc[i] = oc[i] * wi; }
            __syncthreads();
            const float a_dec = sc[SC_A];
#pragma unroll
            for (int ks = 0; ks < 2; ++ks) { const bf16x8 sf = ROWRD(SI, tt, ks);
#pragma unroll
                for (int i = 0; i < 2; ++i) { const bf16x8 vf = TRFRAG(VI, nb + i, ks);
                    oc[i] = mfma16(sf, vf, oc[i]); } }
            { const int t0 = 16 * tt + 4 * lg;
              const f32x4 wi = *(const LAS f32x4*)(sc + SC_WI + t0), qn = *(const LAS f32x4*)(sc + SC_QN + t0), d0 = *(const LAS f32x4*)(sc + SC_DEN + t0), d1 = *(const LAS f32x4*)(sc + SC_DEN + 64 + t0), ei = *(const LAS f32x4*)(sc + SC_EI + t0);
#pragma unroll
              for (int e = 0; e < 4; ++e) { const long g = ROWG(c, t0 + e);
                const float den = wi[e] * qn[e] + (d0[e] + d1[e]); const float inv = 1.f / fmaxf(fabsf(den), ei[e]);
                if (g >= 0) {
#pragma unroll
                    for (int i = 0; i < 2; ++i) { float* hp = HSUM + g * MLW + hd * 256 + js * 64 + 16 * (nb + i) + l15; const float hv = oc[i][e] * inv; if (dir) unsafeAtomicAdd(hp, hv); else *hp = hv; } } } }
#pragma unroll
            for (int mi = 0; mi < 2; ++mi)
#pragma unroll
                for (int cc = 0; cc < 4; ++cc) accC[mi][cc] = accC[mi][cc] * a_dec;
            accN[0] = accN[0] * a_dec; accN[1] = accN[1] * a_dec;
            const unsigned ktq = (unsigned)(KI + (wid >> 2) * 16384) + 64u * ((unsigned)(wid & 3) ^ (unsigned)(l15 >> 2));
#pragma unroll
            for (int ks = 0; ks < 2; ++ks) {
                bf16x8 kf[2], wf[4];
#pragma unroll
                for (int mi = 0; mi < 2; ++mi) kf[mi] = tr_frag(BT[0][mi] + ktq + (unsigned)(8192 * ks), BT[1][mi] + ktq + (unsigned)(8192 * ks));
#pragma unroll
                for (int cc = 0; cc < 4; ++cc) wf[cc] = TRFRAG(VI, 4 + cc, ks);
                { const f32x4 wa = *(const LAS f32x4*)(sc + SC_WW + 32 * ks + 8 * lg), wb = *(const LAS f32x4*)(sc + SC_WW + 32 * ks + 8 * lg + 4);
                  u32x4 wq; wq.x = pk2(wa[0], wa[1]); wq.y = pk2(wa[2], wa[3]); wq.z = pk2(wb[0], wb[1]); wq.w = pk2(wb[2], wb[3]);
                  if (l15 != 0) wq = (u32x4){0u, 0u, 0u, 0u};
                  const bf16x8 wfn = __builtin_bit_cast(bf16x8, wq);
#pragma unroll
                  for (int mi = 0; mi < 2; ++mi) accN[mi] = mfma16(kf[mi], wfn, accN[mi]); }
#pragma unroll
                for (int mi = 0; mi < 2; ++mi)
#pragma unroll
                    for (int cc = 0; cc < 4; ++cc) accC[mi][cc] = mfma16(kf[mi], wf[cc], accC[mi][cc]);
            }
#pragma unroll
            for (int mi = 0; mi < 2; ++mi)
#pragma unroll
                for (int cc = 0; cc < 4; ++cc) { const int dk0 = 32 * wid + 16 * mi + 4 * lg, dv = 16 * cc + l15; u32x2 w; w.x = pk2(accC[mi][cc][0], accC[mi][cc][1]); w.y = pk2(accC[mi][cc][2], accC[mi][cc][3]);
                    *(LAS u32x2*)(lds + CI + (dk0 >> 7) * 16384 + off_b(dv, (dk0 & 127) >> 3) + (dk0 & 7) * 2) = w; }
            if (l15 == 0) { *(LAS f32x4*)(sc + SC_N + 32 * wid + 4 * lg) = accN[0]; *(LAS f32x4*)(sc + SC_N + 32 * wid + 16 + 4 * lg) = accN[1]; }
            __syncthreads();
            if (ci + 1 < 65) STAGE_WRITE();
        }
    }
#undef ROWG
#undef STAGE_LOAD
#undef STAGE_WRITE
#undef ROWRD
#undef TRFRAG
}
__device__ __forceinline__ void mlstm_phase(int bx, const bf16_t* UQKVO, const float* GP, float* HSUM, LAS unsigned char* lds, LAS float* sc) {
    if (bx >= 192) return;
    const int xcd = bx & 7, idx = bx >> 3, pair = xcd * 6 + (idx >> 2), js = idx & 3;
    mlstm_unit(pair >> 2, pair & 3, js, UQKVO, GP, HSUM, lds, sc);
}
}

#ifndef PHM
#define PHM 0xffff
#endif
#ifndef REP_ML
#define REP_ML 1
#endif
#ifndef REP_ATTN
#define REP_ATTN 1
#endif
#ifndef REP_CONV
#define REP_CONV 1
#endif
#ifndef REP_SMALL
#define REP_SMALL 1
#endif
#ifndef KV_SPLIT
#define KV_SPLIT 193
#endif
#ifndef REP_WIN
#define REP_WIN 1
#endif
#ifndef REP_UP
#define REP_UP 1
#endif
__global__ void __launch_bounds__(512, 2) fwd_kernel(Params P, unsigned char* ws_arg, unsigned char* out_arg) {
    extern __shared__ __attribute__((aligned(16))) unsigned char lds_raw[];
    Frame F;
    F.lds = (LAS unsigned char*)lds_raw;
    F.tid = threadIdx.x; F.lane = F.tid & 63; F.wave = __builtin_amdgcn_readfirstlane(F.tid >> 6);
    F.G = GRID; F.bx = blockIdx.x; F.vcu = (F.bx % 8) * (GRID / 8) + F.bx / 8;
    F.gw = F.vcu * 8 + F.wave; F.ngw = F.G * 8;
    { unsigned char* ws0 = ws_arg;
      for (int u = F.tid; u < (LDS_BYTES - MISC_OFF) / 4; u += 512) ((LAS unsigned*)(F.lds + MISC_OFF))[u] = 0u;
      __syncthreads();
      (void)ws0; }
    LAS unsigned long long* ptab = (LAS unsigned long long*)(F.lds + MISC_OFF + 64);
    if (F.tid == 0) {
#pragma unroll
        for (int k = 0; k < 19; ++k) ptab[k] = (unsigned long long)(uintptr_t)P.in[k]; }
    __syncthreads();
    XcdBarrier bar = xcd_barrier_post((unsigned*)(ws_arg + WS_CTL) + CW_BAR, (volatile LAS unsigned*)(F.lds + MISC_OFF));
    LAS float* sc = (LAS float*)(F.lds + MISC_OFF + 1024);
#define BXL() ({ int b__ = F.bx; asm volatile("" : "+s"(b__)); b__; })
#define PFRAME() Frame Fp = F; { int t_ = threadIdx.x; asm volatile("" : "+v"(t_)); Fp.tid = t_; Fp.lane = t_ & 63; int b_ = BXL(); Fp.bx = b_; Fp.vcu = (b_ % 8) * (GRID / 8) + b_ / 8; Fp.gw = Fp.vcu * 8 + Fp.wave; }
#define WSB() ({ GAS unsigned char* w__ = (GAS unsigned char*)ws_arg; asm volatile("" : "+s"(w__)); (unsigned char*)w__; })
#define DOB() ({ GAS unsigned char* w__ = (GAS unsigned char*)out_arg; asm volatile("" : "+s"(w__)); (unsigned char*)w__; })

    { unsigned char* ws = WSB(); prologue(F, ws, ptab); convert_weights(F, ws, ptab, 0); }
    xcd_barrier(bar);

    for (int l = 0; l < DEPTH; ++l) {
        { unsigned char* ws = WSB();
          pg8::Gemm g{(bf16_t*)(ws + WS_HB), (bf16_t*)(ws + WS_WIN), TP, NIN, DM, DM}; pg8::PanelOrder S; S.init(NPAN, 0, 0, 0, NIN, F.G, BXL());
          pg8::EpiWin E{(bf16_t*)(ws + WS_UQKVO), (bf16_t*)(ws + WS_UDQ), (bf16_t*)(ws + WS_UDKV), (bf16_t*)(ws + WS_KR), (float*)(ws + WS_GATES), (const float*)(ws + WS_COS), (const float*)(ws + WS_SIN)};
#if PHM & 2
          pg8::gemm_phase<pg8::EpiWin, pg8::PanelOrder, true, true>(F.lds, g, S, E);
#endif
        }
#if REP_WIN > 1
        __syncthreads();
        { unsigned char* ws = WSB();
          pg8::Gemm g{(bf16_t*)(ws + WS_HB), (bf16_t*)(ws + WS_WIN), TP, NIN, DM, DM}; pg8::PanelOrder S; S.init(NPAN, 0, 0, 0, NIN, F.G, BXL());
          pg8::EpiWin E{(bf16_t*)(ws + WS_UQKVO), (bf16_t*)(ws + WS_UDQ), (bf16_t*)(ws + WS_UDKV), (bf16_t*)(ws + WS_KR), (float*)(ws + WS_GATES), (const float*)(ws + WS_COS), (const float*)(ws + WS_SIN)};
          pg8::gemm_phase<pg8::EpiWin, pg8::PanelOrder, true, true>(F.lds, g, S, E);
        }
#endif
        xcd_barrier(bar);
        { unsigned char* ws = WSB(); unsigned char* dob = DOB(); PFRAME(); rstd_rows(Fp, (bf16_t*)(ws + WS_UDQ), (bf16_t*)(ws + WS_UDKV), (float*)(ws + WS_RSTD));
          ml::gate_prep(Fp.gw, Fp.ngw, Fp.lane, (const float*)(ws + WS_GATES), (const float*)(ws + WS_PAR) + PO_BG + l * 16, (float*)(dob + DO_GP)); }
#if REP_SMALL > 1
        { unsigned char* ws = WSB(); unsigned char* dob = DOB(); PFRAME(); rstd_rows(Fp, (bf16_t*)(ws + WS_UDQ), (bf16_t*)(ws + WS_UDKV), (float*)(ws + WS_RSTD));
          ml::gate_prep(Fp.gw, Fp.ngw, Fp.lane, (const float*)(ws + WS_GATES), (const float*)(ws + WS_PAR) + PO_BG + l * 16, (float*)(dob + DO_GP)); }
#endif
        xcd_barrier(bar);
        if (F.bx >= 192) {
        { unsigned char* ws = WSB(); unsigned char* dob = DOB();
          pg8::Gemm g{(bf16_t*)(ws + WS_UDQ), (bf16_t*)(ws + WS_WUQ), TP, NQ, 512, 512}; pg8::PanelOrder S; S.init(NPAN, 0, 0, 0, NQ, GRID - 192, BXL() - 192);
          pg8::EpiQ E{(bf16_t*)(dob + DO_MQ), (const float*)(ws + WS_RSTD), (const float*)(ws + WS_COS), (const float*)(ws + WS_SIN)};
#if PHM & 4
          pg8::gemm_phase<pg8::EpiQ, pg8::PanelOrder, true, true>(F.lds, g, S, E);
#endif
        }
        { unsigned char* ws = WSB();
          pg8::Gemm g{(bf16_t*)(ws + WS_UDKV), (bf16_t*)(ws + WS_WUKV), TP, NKV, 256, 256}; pg8::PanelOrder S; S.init(NPAN, 0, 0, 0, NKV, GRID - 192, BXL() - 192);
          pg8::EpiBf16G E{(bf16_t*)(ws + WS_MKV), NKV, (const float*)(ws + WS_RSTD) + 1, 0, -1, 0};
#if PHM & 8
          pg8::gemm_phase<pg8::EpiBf16G, pg8::PanelOrder, true, true>(F.lds, g, S, E);
#endif
        }
        } else {
#ifndef NO_ML
        for (int rep_ = 0; rep_ < REP_ML; ++rep_)
        { unsigned char* ws = WSB(); unsigned char* dob = DOB();
          ml::mlstm_phase(BXL(), (const bf16_t*)(ws + WS_UQKVO), (const float*)(dob + DO_GP), (float*)(dob + DO_HSUM), F.lds, sc); }
#endif
        }
        xcd_barrier(bar);
        { unsigned char* ws = WSB(); unsigned char* dob = DOB(); PFRAME();
          if (Fp.vcu >= 96) mlstm_finalize(Fp, (Fp.vcu - 96) * 8 + Fp.wave, (GRID - 96) * 8, (const float*)(dob + DO_HSUM), (const bf16_t*)(ws + WS_UQKVO), (const float*)(ws + WS_PAR) + PO_MLG + l * MLW, (bf16_t*)(ws + WS_HB)); }
#ifndef NO_ATTN
        for (int rep_ = 0; rep_ < REP_ATTN; ++rep_)
        { unsigned char* ws = WSB(); unsigned char* dob = DOB();
          att::attn_phase(({ int b__ = BXL(); (b__ % 8) * (GRID / 8) + b__ / 8; }), (const bf16_t*)(dob + DO_MQ), (const bf16_t*)(ws + WS_MKV), (const bf16_t*)(ws + WS_KR), (bf16_t*)(ws + WS_HB), (LAS char*)F.lds); }
#endif
        xcd_barrier(bar);
        { unsigned char* ws = WSB();
          pg8::Gemm g{(bf16_t*)(ws + WS_HB), (bf16_t*)(ws + WS_WOUT), TP, DM, DM, DM}; pg8::PanelOrder S; S.init(192, 0, 0, 0, DM, F.G, BXL());
          pg8::EpiResidLn E{(float*)(ws + WS_H), DM, ALPHA, (const float*)(ws + WS_STAT2), (const float*)(ws + WS_PAR) + (l > 0 ? PO_L2G + (l - 1) * DM : PO_ONE), (const float*)(ws + WS_PAR) + (l > 0 ? PO_L2B + (l - 1) * DM : PO_ZERO)};
#if PHM & 16
          pg8::gemm_phase<pg8::EpiResidLn, pg8::PanelOrder, true, true>(F.lds, g, S, E);
#endif
        }
        { unsigned char* ws = WSB();
          pg8::Gemm g{(bf16_t*)(ws + WS_HB), (bf16_t*)(ws + WS_WOUT), TP, DM, DM / 4, DM}; pg8::SplitOrder S; S.init(PMETA, DM, 4, F.G, BXL());
          pg8::EpiAtomic E{(float*)(ws + WS_H), DM};
#if PHM & 16
          pg8::gemm_phase<pg8::EpiAtomic, pg8::SplitOrder, true, true>(F.lds, g, S, E);
#endif
        }
        xcd_barrier(bar);
        { unsigned char* ws = WSB(); PFRAME(); ln_rows(Fp, (float*)(ws + WS_H), (bf16_t*)(ws + WS_HB), (const float*)(ws + WS_PAR) + PO_L1G + l * DM, (const float*)(ws + WS_PAR) + PO_L1B + l * DM, (float*)(ws + WS_STAT1), nullptr); }
        xcd_barrier(bar);
        { unsigned char* ws = WSB(); unsigned char* dob = DOB();
          pg8::Gemm g{(bf16_t*)(ws + WS_HB), (bf16_t*)(ws + WS_WUP), TP, NUP, DM, DM}; pg8::PanelOrder S; S.init(NPAN, 0, 0, 0, NUP, F.G, BXL());
          pg8::EpiFfn E{(bf16_t*)(ws + WS_ACT), (float*)(dob + DO_SIDE), (bf16_t*)(dob + DO_GVM), (const float*)(ws + WS_PAR) + PO_CW + (size_t)l * 3 * DFF, (const float*)(ws + WS_PAR) + PO_CB + (size_t)l * DFF, (LAS float*)(F.lds + MISC_OFF + 8192)};
#if PHM & 32
          pg8::gemm_phase<pg8::EpiFfn, pg8::PanelOrder, true, true>(F.lds, g, S, E);
#if REP_UP > 1
          __syncthreads(); pg8::gemm_phase<pg8::EpiFfn, pg8::PanelOrder, true, true>(F.lds, g, S, E);
#endif
#endif
        }
        xcd_barrier(bar);
        { unsigned char* ws = WSB(); unsigned char* dob = DOB(); PFRAME();
          ffn_fixup(Fp, (const float*)(dob + DO_SIDE), (const bf16_t*)(dob + DO_GVM), (bf16_t*)(ws + WS_ACT), (const float*)(ws + WS_PAR) + PO_CW + (size_t)l * 3 * DFF, (const float*)(ws + WS_PAR) + PO_CB + (size_t)l * DFF); }
#if REP_SMALL > 1
        { unsigned char* ws = WSB(); unsigned char* dob = DOB(); PFRAME();
          ffn_fixup(Fp, (const float*)(dob + DO_SIDE), (const bf16_t*)(dob + DO_GVM), (bf16_t*)(ws + WS_ACT), (const float*)(ws + WS_PAR) + PO_CW + (size_t)l * 3 * DFF, (const float*)(ws + WS_PAR) + PO_CB + (size_t)l * DFF); }
#endif
        xcd_barrier(bar);
        { unsigned char* ws = WSB();
          pg8::Gemm g{(bf16_t*)(ws + WS_ACT), (bf16_t*)(ws + WS_WDN), TP, DM, DFF, DFF}; pg8::PanelOrder S; S.init(192, 0, 0, 0, DM, F.G, BXL());
          pg8::EpiResidLn E{(float*)(ws + WS_H), DM, ALPHA, (const float*)(ws + WS_STAT1), (const float*)(ws + WS_PAR) + PO_L1G + l * DM, (const float*)(ws + WS_PAR) + PO_L1B + l * DM};
#if PHM & 64
          pg8::gemm_phase<pg8::EpiResidLn, pg8::PanelOrder, true, true>(F.lds, g, S, E);
#endif
        }
        { unsigned char* ws = WSB();
          pg8::Gemm g{(bf16_t*)(ws + WS_ACT), (bf16_t*)(ws + WS_WDN), TP, DM, DFF / 11, DFF}; pg8::SplitOrder S; S.init(PMETA, DM, 11, F.G, BXL());
          pg8::EpiAtomic E{(float*)(ws + WS_H), DM};
#if PHM & 64
          pg8::gemm_phase<pg8::EpiAtomic, pg8::SplitOrder, true, true>(F.lds, g, S, E);
#endif
        }
        xcd_barrier(bar);
        { unsigned char* ws = WSB(); unsigned char* dob = DOB();
          PFRAME(); ln_rows(Fp, (float*)(ws + WS_H), (bf16_t*)(ws + WS_HB), (const float*)(ws + WS_PAR) + PO_L2G + l * DM, (const float*)(ws + WS_PAR) + PO_L2B + l * DM, (float*)(ws + WS_STAT2), l == DEPTH - 1 ? (float*)dob : nullptr); }
        if (l + 1 < DEPTH) { unsigned char* ws = WSB(); PFRAME(); convert_weights(Fp, ws, ptab, l + 1); }
#if REP_CONV > 1
        if (l + 1 < DEPTH) { __syncthreads(); unsigned char* ws = WSB(); PFRAME(); convert_weights(Fp, ws, ptab, l + 1); }
#endif
        xcd_barrier(bar);
    }
}

extern "C" void kernel_launch(void* const* d_in, const int* in_sizes, int n_in, void* d_out, int out_size, void* d_ws, size_t ws_size, hipStream_t stream) {
    static int grid = 0;
    if (grid == 0) {
        if (n_in != 19 || out_size != NMAIN * DM || ws_size < WS_NEED) { fprintf(stderr, "kernel_launch: unexpected shapes (n_in %d out %d ws %zu need %zu)\n", n_in, out_size, ws_size, (size_t)WS_NEED); grid = -1; return; }
        int dev = 0, cus = 0;
        if (hipGetDevice(&dev) != hipSuccess || hipDeviceGetAttribute(&cus, hipDeviceAttributeMultiprocessorCount, dev) != hipSuccess) { grid = -1; return; }
        if (hipFuncSetAttribute((const void*)fwd_kernel, hipFuncAttributeMaxDynamicSharedMemorySize, LDS_BYTES) != hipSuccess) { fprintf(stderr, "kernel_launch: hipFuncSetAttribute failed\n"); grid = -1; return; }
        int per_cu = 0;
        if (hipOccupancyMaxActiveBlocksPerMultiprocessor(&per_cu, (const void*)fwd_kernel, 512, LDS_BYTES) != hipSuccess || per_cu < 1) { fprintf(stderr, "kernel_launch: occupancy query says %d blocks per CU\n", per_cu); (void)hipGetLastError(); grid = -1; return; }
        if (cus < GRID) { fprintf(stderr, "kernel_launch: needs %d CUs, device has %d\n", GRID, cus); grid = -1; return; }
        grid = GRID;
    }
    if (grid < 0) return;
    (void)hipMemsetAsync((char*)d_ws + WS_CTL, 0, CTL_BYTES, stream);
    Params p{};
    for (int i = 0; i < 19; ++i) p.in[i] = (const float*)d_in[i];
    hipLaunchKernelGGL(fwd_kernel, dim3(grid), dim3(512), LDS_BYTES, stream, p, (unsigned char*)d_ws, (unsigned char*)d_out);
}
```

```cpp
#include <hip/hip_runtime.h>
#include <cstdio>
#include <cstdint>

#define LAS __attribute__((address_space(3)))
#define GAS __attribute__((address_space(1)))
typedef float f32x2 __attribute__((ext_vector_type(2)));
typedef float f32x8 __attribute__((ext_vector_type(8)));
typedef float f32x16 __attribute__((ext_vector_type(16)));
typedef unsigned u32x2 __attribute__((ext_vector_type(2)));
typedef short s16x4 __attribute__((ext_vector_type(4)));
typedef __bf16 bf16x2v __attribute__((ext_vector_type(2)));

constexpr int DM = 2048, NSEQ = 12, LREAL = 4096, NMETA = 16, DEPTH = 4;
constexpr int NMAIN = NSEQ * LREAL;
constexpr int MROW0 = NMAIN;
constexpr int NTOK = NMAIN + NSEQ * NMETA;
constexpr int NPAN = 193, TP = NPAN * 256;
constexpr int PMETA = 192;
constexpr int INC = 4944, NIN = 5120;
constexpr int DFF = 5632, NUP = 2 * DFF;
constexpr int MLW = 1024, NQ = 1536, NKV = 2048;
constexpr float ALPHA = 1.681792830507429f;
constexpr float EPS = 1e-5f;
constexpr float NEGBIG = -1e30f;

constexpr size_t MiB = 1u << 20;
constexpr size_t WS_CTL = 0, CTL_BYTES = 1 * MiB;
constexpr size_t WS_COS = 1 * MiB;
constexpr size_t WS_SIN = WS_COS + (size_t)4112 * 32 * 4;
constexpr size_t WS_PAR = 2 * MiB + 128 * 1024;
constexpr int PO_BG = 0, PO_MLG = PO_BG + DEPTH * 16, PO_QG = PO_MLG + DEPTH * 1024, PO_KVG = PO_QG + DEPTH * 512, PO_L1G = PO_KVG + DEPTH * 256, PO_L1B = PO_L1G + DEPTH * 2048,
              PO_CW = PO_L1B + DEPTH * 2048, PO_CB = PO_CW + DEPTH * 3 * 5632, PO_L2G = PO_CB + DEPTH * 5632, PO_L2B = PO_L2G + DEPTH * 2048, PO_ONE = PO_L2B + DEPTH * 2048, PO_ZERO = PO_ONE + 2048, PO_END = PO_ZERO + 2048;
static_assert(WS_PAR + (size_t)PO_END * 4 <= 3 * MiB && WS_PAR >= 1 * MiB + 2 * 4112 * 32 * 4, "PAR block placement");
constexpr size_t WS_WIN = 3 * MiB;
constexpr size_t WS_WUQ = WS_WIN + (size_t)NIN * DM * 2;
constexpr size_t WS_WUKV = WS_WUQ + (size_t)NQ * 512 * 2;
constexpr size_t WS_WOUT = WS_WUKV + (size_t)NKV * 256 * 2;
constexpr size_t WS_WUP = WS_WOUT + (size_t)DM * DM * 2;
constexpr size_t WS_WDN = WS_WUP + (size_t)NUP * DM * 2;
constexpr size_t WS_STAT1 = WS_WDN + (size_t)DM * DFF * 2;
constexpr size_t WS_STAT2 = WS_CTL + 512 * 1024;
constexpr size_t WS_H = 100 * MiB;
constexpr size_t WS_PART = WS_H + 208 * MiB;
static_assert((size_t)NMAIN * DM * 2 <= 208 * MiB && 208 * MiB + (size_t)11 * 256 * DM * 4 <= (size_t)NMAIN * DM * 4, "PART sits between the bf16 rows and the f32 meta rows of H");
constexpr size_t WS_HB = WS_H + (size_t)TP * DM * 4;
constexpr size_t WS_R = WS_HB + (size_t)TP * DM * 2;
constexpr size_t WS_UQKVO = WS_R;
constexpr size_t WS_UDQ = WS_UQKVO + (size_t)TP * 4096 * 2;
constexpr size_t WS_UDKV = WS_UDQ + (size_t)TP * 512 * 2;
constexpr size_t WS_GATES = WS_UDKV + (size_t)TP * 256 * 2;
constexpr size_t WS_MKV = WS_GATES + (size_t)TP * 16 * 4;
constexpr size_t WS_KR = WS_MKV + (size_t)TP * NKV * 2;
constexpr size_t WS_RSTD = WS_KR + (size_t)TP * 64 * 2;
constexpr size_t WS_END_A = WS_RSTD + (size_t)TP * 2 * 4;
constexpr size_t WS_ACT = WS_R;
constexpr size_t WS_END_B = WS_ACT + (size_t)TP * DFF * 2;
constexpr size_t WS_NEED = (WS_END_A > WS_END_B ? WS_END_A : WS_END_B);
static_assert(WS_STAT1 + (size_t)TP * 8 <= WS_H && WS_STAT2 + (size_t)TP * 8 <= WS_CTL + CTL_BYTES, "weights and row statistics fit below H");
constexpr size_t DO_HSUM = 0;
constexpr size_t DO_MQ = DO_HSUM + (size_t)TP * MLW * 4;
constexpr size_t DO_GP = 340 * MiB;
constexpr size_t DO_SIDE = 0;
constexpr size_t DO_GVM = 32 * MiB;
static_assert(DO_MQ + (size_t)TP * NQ * 2 <= DO_GP && DO_GP + (size_t)96 * 65 * 200 * 4 <= (size_t)NMAIN * DM * 4 && (size_t)192 * 6 * DFF * 4 <= DO_GVM && DO_GVM + (size_t)256 * NUP * 2 <= (size_t)NMAIN * DM * 4, "d_out scratch fits");
constexpr int CW_BAR = 4096;

constexpr int RING_BYTES = 131072;
constexpr int MISC_OFF = RING_BYTES;
constexpr int LDS_BYTES = 147456;
constexpr int GRID = 256;

__device__ __forceinline__ int pos_of_row(int row) { return row < NMAIN ? NMETA + (row & (LREAL - 1)) : ((row - NMAIN) & (NMETA - 1)); }
__device__ __forceinline__ unsigned pk2(float lo, float hi) { f32x2 v = {lo, hi}; return __builtin_bit_cast(unsigned, __builtin_convertvector(v, bf16x2v)); }
__device__ __forceinline__ float bf_lo(unsigned w) { return __uint_as_float(w << 16); }
__device__ __forceinline__ float bf_hi(unsigned w) { return __uint_as_float(w & 0xffff0000u); }
__device__ __forceinline__ float wave_sum(float v) {
#pragma unroll
    for (int o = 1; o < 64; o <<= 1) v += __shfl_xor(v, o);
    return v;
}
__device__ __forceinline__ float wave_max(float v) {
#pragma unroll
    for (int o = 1; o < 64; o <<= 1) v = fmaxf(v, __shfl_xor(v, o));
    return v;
}
namespace pg8 {
#define PG8_LAS __attribute__((address_space(3)))
typedef unsigned short bf16_t;
typedef short bf16x8 __attribute__((ext_vector_type(8)));
typedef float f32x4 __attribute__((ext_vector_type(4)));
typedef unsigned u32x4 __attribute__((ext_vector_type(4)));
constexpr int BM = 256, BK = 64, HALF = 128, HTB = HALF * BK * 2  , STAGE_BYTES = 8 * HTB, NXCD = 8, WGM = 4;

__host__ __device__ __forceinline__ int lds_byte(int r, int c) { const int st = (r >> 4) * 2 + (c >> 5), rr = r & 15, cc = c & 31, ob = rr * 64 + cc * 2; return st * 1024 + (ob ^ (((ob >> 9) & 1) << 5)); }
__host__ __device__ __forceinline__ void stage_rc(int b, int& R, int& C) { const int st = b / 1024, sb = b % 1024, swz = sb ^ (((sb >> 9) & 1) << 5); R = (st >> 1) * 16 + swz / 64; C = (st & 1) * 32 + (swz % 64) / 2; }
__host__ __device__ __forceinline__ int perm32(int rho) { const int n = rho >> 4, i = rho & 15; return 8 * (i >> 2) + 4 * n + (i & 3); }

struct Unit { int pm, pn, kk; };
struct Gemm { const bf16_t* A; const bf16_t* Bt; int M, N, K, ld; };

struct PanelOrder {
    int nM, nN, nwg, G, c, nMain, pm0, pmx;
    __device__ void init(int nMain_, int pm0_, int extra, int pmx_, int N, int G_, int c_) { nMain = nMain_; pm0 = pm0_; pmx = pmx_; nM = nMain_ + extra; nN = N / BM; nwg = nM * nN; G = G_; c = c_; }
    __device__ bool next(int i, Unit& u) const {
        const long L = (long)i * G + c; if (L >= nwg) return false;
        int wgid = (int)L; { const int q = nwg / NXCD, r = nwg % NXCD, xcd = wgid % NXCD, off = wgid / NXCD; wgid = (xcd < r ? xcd * (q + 1) : r * (q + 1) + (xcd - r) * q) + off; }
        const int nig = WGM * nN, gid = wgid / nig, fm = gid * WGM, gsz = (nM - fm) < WGM ? (nM - fm) : WGM;
        const int pl = fm + ((wgid % nig) % gsz); u.pm = pl < nMain ? pm0 + pl : pmx; u.pn = (wgid % nig) / gsz; u.kk = 0; return true;
    }
    __device__ __forceinline__ void a_ready(const Unit&) const {}
    __device__ __forceinline__ void done(const Unit&) const {}
};

struct SplitOrder {
    int pm, nN, nwg, G, c;
    __device__ void init(int pm_, int N, int nsplit, int G_, int c_) { pm = pm_; nN = N / BM; nwg = nN * nsplit; G = G_; c = c_; }
    __device__ bool next(int i, Unit& u) const { const int L = i * G + c; if (L >= nwg) return false; u.pm = pm; u.pn = L % nN; u.kk = L / nN; return true; }
    __device__ __forceinline__ void a_ready(const Unit&) const {}
    __device__ __forceinline__ void done(const Unit&) const {}
};

__device__ __forceinline__ u32x4 pack8(const f32x4 v0, const f32x4 v1) { u32x4 w; w.x = pk2(v0[0], v0[1]); w.y = pk2(v0[2], v0[3]); w.z = pk2(v1[0], v1[1]); w.w = pk2(v1[2], v1[3]); return w; }

struct EpiBf16G {
    static constexpr bool PERM = true, AFTER_DRAIN = false;
    bf16_t* O; int ldc; const float* rs; int pm_sub, pm_sp, pm_sp_out;
    __device__ __forceinline__ void operator()(const f32x4 (&acc)[2][2][4][2], const Unit& u, int wr, int wc, int fr, int fq) const {
        const int opm = (u.pm == pm_sp) ? pm_sp_out : u.pm - pm_sub;
        const int rin = u.pm * BM + wr * 64 + fr, rout = opm * BM + wr * 64 + fr, col0 = u.pn * BM + wc * 32 + 8 * fq;
#pragma unroll
        for (int ai = 0; ai < 2; ++ai)
#pragma unroll
            for (int m = 0; m < 4; ++m) { const float sc = rs ? rs[(size_t)(rin + ai * HALF + m * 16) * 2] : 1.f;
                bf16_t* rowp = O + (size_t)(rout + ai * HALF + m * 16) * ldc + col0;
#pragma unroll
                for (int bj = 0; bj < 2; ++bj) *(u32x4*)(rowp + bj * HALF) = pack8(acc[ai][bj][m][0] * sc, acc[ai][bj][m][1] * sc); }
    }
};
struct EpiWin {
    static constexpr bool PERM = true, AFTER_DRAIN = false;
    bf16_t *UQKVO, *UDQ, *UDKV, *KR; float* GATES; const float *COS, *SIN;
    __device__ __forceinline__ void operator()(const f32x4 (&acc)[2][2][4][2], const Unit& u, int wr, int wc, int fr, int fq) const {
        const int row0 = u.pm * BM + wr * 64 + fr;
        if (u.pn < 19) {
            bf16_t* base; int ldc, colt;
            if (u.pn < 16) { base = UQKVO; ldc = 4096; colt = u.pn * BM; } else if (u.pn < 18) { base = UDQ; ldc = 512; colt = (u.pn - 16) * BM; } else { base = UDKV; ldc = 256; colt = 0; }
            const int col0 = colt + wc * 32 + 8 * fq;
#pragma unroll
            for (int ai = 0; ai < 2; ++ai)
#pragma unroll
                for (int m = 0; m < 4; ++m) { bf16_t* rowp = base + (size_t)(row0 + ai * HALF + m * 16) * ldc + col0;
#pragma unroll
                    for (int bj = 0; bj < 2; ++bj) *(u32x4*)(rowp + bj * HALF) = pack8(acc[ai][bj][m][0], acc[ai][bj][m][1]); }
        } else {
            if (wc < 2) { const int g = 4 * wc + fq;
#pragma unroll
                for (int ai = 0; ai < 2; ++ai)
#pragma unroll
                    for (int m = 0; m < 4; ++m) { const int row = row0 + ai * HALF + m * 16, pos = pos_of_row(row);
                        const f32x4 cs = *(const f32x4*)(COS + pos * 32 + 4 * g), sn = *(const f32x4*)(SIN + pos * 32 + 4 * g);
                        const f32x4 x1 = acc[ai][0][m][0], x2 = acc[ai][0][m][1];
                        *(u32x4*)(KR + (size_t)row * 64 + 8 * g) = pack8(x1 * cs - x2 * sn, x1 * sn + x2 * cs); }
            } else if (wc == 2 && fq < 2) {
#pragma unroll
                for (int ai = 0; ai < 2; ++ai)
#pragma unroll
                    for (int m = 0; m < 4; ++m) { float* gp = GATES + (size_t)(row0 + ai * HALF + m * 16) * 16 + 8 * fq;
                        *(f32x4*)gp = acc[ai][0][m][0]; *(f32x4*)(gp + 4) = acc[ai][0][m][1]; }
            }
        }
    }
};
struct EpiQ {
    static constexpr bool PERM = true, AFTER_DRAIN = false;
    bf16_t* MQ; const float *RSTD, *COS, *SIN;
    __device__ __forceinline__ void operator()(const f32x4 (&acc)[2][2][4][2], const Unit& u, int wr, int wc, int fr, int fq) const {
        const int row0 = u.pm * BM + wr * 64 + fr, colb = u.pn * BM + wc * 32 + 8 * fq;
#pragma unroll
        for (int ai = 0; ai < 2; ++ai)
#pragma unroll
            for (int m = 0; m < 4; ++m) { const int row = row0 + ai * HALF + m * 16, pos = pos_of_row(row); const float sc = RSTD[(size_t)row * 2];
#pragma unroll
                for (int bj = 0; bj < 2; ++bj) { const int col0 = colb + bj * HALF, o = col0 % 192;
                    f32x4 v0 = acc[ai][bj][m][0] * sc, v1 = acc[ai][bj][m][1] * sc;
                    if (o >= 128) { const int g = (o - 128) >> 3; const f32x4 cs = *(const f32x4*)(COS + pos * 32 + 4 * g), sn = *(const f32x4*)(SIN + pos * 32 + 4 * g);
                        const f32x4 x1 = v0, x2 = v1; v0 = x1 * cs - x2 * sn; v1 = x1 * sn + x2 * cs; }
                    *(u32x4*)(MQ + (size_t)row * NQ + col0) = pack8(v0, v1); } }
    }
};
__device__ __forceinline__ void resid_ln_tile(float* __restrict__ Cw, const float* __restrict__ Cr, const float* __restrict__ st, const float* __restrict__ g, const float* __restrict__ b,
                                              int ldc, float alpha, const f32x4 (&acc)[2][2][4][2], int row0, int col0) {
    asm volatile("" ::: "memory");
#pragma unroll
    for (int ai = 0; ai < 2; ++ai)
#pragma unroll
        for (int bj = 0; bj < 2; ++bj) {
            f32x4 gv[2], bv[2], hv[4][2]; f32x2 ms[4];
#pragma unroll
            for (int n = 0; n < 2; ++n) { gv[n] = *(const f32x4*)(g + col0 + bj * HALF + n * 16) * alpha; bv[n] = *(const f32x4*)(b + col0 + bj * HALF + n * 16) * alpha; }
#pragma unroll
            for (int m = 0; m < 4; ++m) { const int row = row0 + ai * HALF + m * 16; ms[m] = *(const f32x2*)(st + (size_t)row * 2);
#pragma unroll
                for (int n = 0; n < 2; ++n) hv[m][n] = *(const f32x4*)(Cr + (size_t)row * ldc + col0 + bj * HALF + n * 16); }
#pragma unroll
            for (int m = 0; m < 4; ++m) { const int row = row0 + ai * HALF + m * 16;
#pragma unroll
                for (int n = 0; n < 2; ++n) *(f32x4*)(Cw + (size_t)row * ldc + col0 + bj * HALF + n * 16) = (hv[m][n] - ms[m][0]) * ms[m][1] * gv[n] + bv[n] + acc[ai][bj][m][n]; }
        }
}
__device__ __forceinline__ void resid_ln_tile_bf(bf16_t* __restrict__ Cw, const bf16_t* __restrict__ Cr, const float* __restrict__ st, const float* __restrict__ g, const float* __restrict__ b,
                                                 int ldc, float alpha, const f32x4 (&acc)[2][2][4][2], int row0, int col0) {
    asm volatile("" ::: "memory");
#pragma unroll
    for (int ai = 0; ai < 2; ++ai)
#pragma unroll
        for (int bj = 0; bj < 2; ++bj) {
            f32x4 gv[2], bv[2]; u32x4 hv[4]; f32x2 ms[4];
#pragma unroll
            for (int n = 0; n < 2; ++n) { gv[n] = *(const f32x4*)(g + col0 + bj * HALF + n * 4) * alpha; bv[n] = *(const f32x4*)(b + col0 + bj * HALF + n * 4) * alpha; }
#pragma unroll
            for (int m = 0; m < 4; ++m) { const int row = row0 + ai * HALF + m * 16; ms[m] = *(const f32x2*)(st + (size_t)row * 2);
                hv[m] = *(const u32x4*)(Cr + (size_t)row * ldc + col0 + bj * HALF); }
#pragma unroll
            for (int m = 0; m < 4; ++m) { const int row = row0 + ai * HALF + m * 16;
                const f32x4 h0 = {bf_lo(hv[m].x), bf_hi(hv[m].x), bf_lo(hv[m].y), bf_hi(hv[m].y)}, h1 = {bf_lo(hv[m].z), bf_hi(hv[m].z), bf_lo(hv[m].w), bf_hi(hv[m].w)};
                *(u32x4*)(Cw + (size_t)row * ldc + col0 + bj * HALF) = pack8((h0 - ms[m][0]) * ms[m][1] * gv[0] + bv[0] + acc[ai][bj][m][0], (h1 - ms[m][0]) * ms[m][1] * gv[1] + bv[1] + acc[ai][bj][m][1]); }
        }
}
struct EpiResidLn {
    static constexpr bool PERM = true, AFTER_DRAIN = false;
    bf16_t* C; int ldc; float alpha; const float* st; const float* g; const float* b;
    __device__ __forceinline__ void operator()(const f32x4 (&acc)[2][2][4][2], const Unit& u, int wr, int wc, int fr, int fq) const {
        resid_ln_tile_bf(this->C, this->C, this->st, this->g, this->b, this->ldc, this->alpha, acc, u.pm * BM + wr * 64 + fr, u.pn * BM + wc * 32 + 8 * fq);
    }
};
struct EpiPart {
    static constexpr bool PERM = false, AFTER_DRAIN = false;
    float* P; int ldc;
    __device__ __forceinline__ void operator()(const f32x4 (&acc)[2][2][4][2], const Unit& u, int wr, int wc, int fr, int fq) const {
        const int row0 = u.kk * BM + wr * 64 + fr, col0 = u.pn * BM + wc * 32 + 4 * fq;
#pragma unroll
        for (int ai = 0; ai < 2; ++ai)
#pragma unroll
            for (int m = 0; m < 4; ++m) { float* rowp = P + (size_t)(row0 + ai * HALF + m * 16) * ldc + col0;
#pragma unroll
                for (int bj = 0; bj < 2; ++bj)
#pragma unroll
                    for (int n = 0; n < 2; ++n) *(f32x4*)(rowp + bj * HALF + n * 16) = acc[ai][bj][m][n]; }
    }
};

__device__ __forceinline__ float dpp_ror1(float x) { return __int_as_float(__builtin_amdgcn_mov_dpp(__float_as_int(x), 0x121, 0xf, 0xf, false)); }
__device__ __forceinline__ float dpp_ror15(float x) { return __int_as_float(__builtin_amdgcn_mov_dpp(__float_as_int(x), 0x12f, 0xf, 0xf, false)); }
struct EpiFfn {
    static constexpr bool PERM = true, AFTER_DRAIN = false;
    bf16_t* ACT; float* SIDE; bf16_t* GVM; const float *cw, *cb; PG8_LAS float* X;
    __device__ __forceinline__ void operator()(const f32x4 (&acc)[2][2][4][2], const Unit& u, int wr_in, int wc_in, int fr_in, int fq_in) const {
        int fr = fr_in, fq = fq_in, wr = wr_in, wc = wc_in; asm volatile("" : "+v"(fr), "+v"(fq), "+s"(wr), "+s"(wc));
        const int cj = wc * 32 + 8 * fq, c0 = u.pn * 128 + cj;
        if (u.pm == PMETA) {
#pragma unroll
            for (int ai = 0; ai < 2; ++ai)
#pragma unroll
                for (int m = 0; m < 4; ++m) { bf16_t* rowp = GVM + (size_t)(ai * HALF + wr * 64 + m * 16 + fr) * NUP + c0;
                    *(u32x4*)rowp = pack8(acc[ai][0][m][0], acc[ai][0][m][1]); *(u32x4*)(rowp + DFF) = pack8(acc[ai][1][m][0], acc[ai][1][m][1]); }
            return;
        }
        f32x4 w0[2], w1[2], w2[2], bb[2];
#pragma unroll
        for (int n = 0; n < 2; ++n) { w0[n] = *(const f32x4*)(cw + c0 + 4 * n); w1[n] = *(const f32x4*)(cw + DFF + c0 + 4 * n); w2[n] = *(const f32x4*)(cw + 2 * DFF + c0 + 4 * n); bb[n] = *(const f32x4*)(cb + c0 + 4 * n); }
#pragma unroll
        for (int ai = 0; ai < 2; ++ai) { const int b = 2 * ai + wr;
            if (fr == 0) { *(PG8_LAS f32x4*)(X + (b * 2 + 0) * 128 + cj) = acc[ai][0][0][0]; *(PG8_LAS f32x4*)(X + (b * 2 + 0) * 128 + cj + 4) = acc[ai][0][0][1]; }
            if (fr == 15) { *(PG8_LAS f32x4*)(X + (b * 2 + 1) * 128 + cj) = acc[ai][0][3][0]; *(PG8_LAS f32x4*)(X + (b * 2 + 1) * 128 + cj + 4) = acc[ai][0][3][1]; } }
        asm volatile("s_waitcnt lgkmcnt(0)" ::: "memory"); __builtin_amdgcn_s_barrier(); asm volatile("" ::: "memory");
        const bool is15 = fr == 15, is0 = fr == 0;
        const unsigned rowb = (unsigned)(u.pm * BM + wr * 64 + fr) * DFF + c0;
#pragma unroll
        for (int ai = 0; ai < 2; ++ai) { const int b = 2 * ai + wr;
            f32x4 xp[2], xn[2];
#pragma unroll
            for (int n = 0; n < 2; ++n) { xp[n] = b > 0 ? *(const PG8_LAS f32x4*)(X + ((b - 1) * 2 + 1) * 128 + cj + 4 * n) : (f32x4){0.f, 0.f, 0.f, 0.f};
                                          xn[n] = b < 3 ? *(const PG8_LAS f32x4*)(X + ((b + 1) * 2 + 0) * 128 + cj + 4 * n) : (f32x4){0.f, 0.f, 0.f, 0.f}; }
#pragma unroll
            for (int m = 0; m < 4; ++m) { u32x4 ow;
#pragma unroll
                for (int n = 0; n < 2; ++n) { f32x4 o;
#pragma unroll
                    for (int e = 0; e < 4; ++e) { const float g = acc[ai][0][m][n][e];
                        const float gup = m > 0 ? acc[ai][0][m > 0 ? m - 1 : 0][n][e] : xp[n][e], gdn = m < 3 ? acc[ai][0][m < 3 ? m + 1 : 3][n][e] : xn[n][e];
                        const float pv = dpp_ror1(is15 ? gup : g);
                        const float nx = dpp_ror15(is0 ? gdn : g);
                        const float x = w0[n][e] * pv + w1[n][e] * g + w2[n][e] * nx + bb[n][e];
                        o[e] = x * __builtin_amdgcn_rcpf(1.f + __expf(-x)) * acc[ai][1][m][n][e]; }
                    if (n == 0) { ow.x = pk2(o[0], o[1]); ow.y = pk2(o[2], o[3]); } else { ow.z = pk2(o[0], o[1]); ow.w = pk2(o[2], o[3]); } }
                bf16_t* dst = ACT + (rowb + (unsigned)(ai * HALF + m * 16) * DFF);
                if ((ai == 0 && m == 0) || (ai == 1 && m == 3)) {
                    const int r = ai * HALF + wr * 64 + m * 16 + fr;
                    if (r != 0 && r != 255) *(u32x4*)dst = ow;
                    const int slot = r == 0 ? 0 : r == 1 ? 1 : r == 254 ? 2 : r == 255 ? 3 : -1;
                    if (slot >= 0) { float* sp = SIDE + ((size_t)u.pm * 6 + slot) * DFF + c0; *(f32x4*)sp = acc[ai][0][m][0]; *(f32x4*)(sp + 4) = acc[ai][0][m][1];
                        if (slot == 0 || slot == 3) { float* vp = SIDE + ((size_t)u.pm * 6 + (slot == 0 ? 4 : 5)) * DFF + c0; *(f32x4*)vp = acc[ai][1][m][0]; *(f32x4*)(vp + 4) = acc[ai][1][m][1]; } }
                } else *(u32x4*)dst = ow;
            }
        }
    }
};
template <class Epi, class Sched, bool ALIGN_EPI = false, bool SP2 = false>
__device__ __forceinline__ void gemm_phase(PG8_LAS unsigned char* lds, const Gemm g, const Sched& S, const Epi& E) {
    int tid_ = threadIdx.x; asm volatile("" : "+v"(tid_));
    const int tid = tid_, wid = __builtin_amdgcn_readfirstlane(tid >> 6), lane = tid & 63, wr = wid >> 2, wc = wid & 3, fr = lane & 15, fq = lane >> 4;
    const int K = g.ld, nt = g.K / BK;
    unsigned voffA[2], voffB[2];
#pragma unroll
    for (int i = 0; i < 2; ++i) { int R, C; stage_rc(tid * 16 + i * 8192, R, C); const int Rb = Epi::PERM ? ((R & ~31) + perm32(R & 31)) : R;
        voffA[i] = (unsigned)(R * K + C) * 2u; voffB[i] = (unsigned)(Rb * K + C) * 2u; }
    const size_t kstep = (size_t)(BK * 2);
    const size_t hstep = (size_t)HALF * K * 2;
    const size_t tstep = 2 * hstep;
    const unsigned ldsw = (unsigned)wid * 1024u;
    const int aoff = lds_byte(wr * 64 + fr, fq * 8), boff = lds_byte(wc * 32 + fr, fq * 8);
#define PG8_SA(b, h) (((b) * 2 + (h)) * HTB)
#define PG8_SB(b, h) ((4 + (b) * 2 + (h)) * HTB)
#define PG8_STAGE(bufoff, gbase, voff) do { _Pragma("unroll") for (int _i = 0; _i < 2; ++_i) \
        __builtin_amdgcn_global_load_lds((const unsigned*)((const char*)(gbase) + (voff)[_i]), (PG8_LAS unsigned*)(lds + (bufoff) + ldsw + _i * 8192), 16, 0, 0); } while (0)
#define PG8_LDA(dst, b, h) do { _Pragma("unroll") for (int m = 0; m < 4; ++m) _Pragma("unroll") for (int k = 0; k < 2; ++k) dst[m][k] = *(const PG8_LAS bf16x8*)(lds + PG8_SA(b, h) + aoff + m * 2048 + k * 1024); } while (0)
#define PG8_LDB(dst, b, h) do { _Pragma("unroll") for (int n = 0; n < 2; ++n) _Pragma("unroll") for (int k = 0; k < 2; ++k) dst[n][k] = *(const PG8_LAS bf16x8*)(lds + PG8_SB(b, h) + boff + n * 2048 + k * 1024); } while (0)
#define PG8_MMA(ai, bj, At, Bt) do { __builtin_amdgcn_s_setprio(1); _Pragma("unroll") for (int m = 0; m < 4; ++m) _Pragma("unroll") for (int n = 0; n < 2; ++n) _Pragma("unroll") for (int k = 0; k < 2; ++k) \
        acc[ai][bj][m][n] = __builtin_amdgcn_mfma_f32_16x16x32_bf16(Bt[n][k], At[m][k], acc[ai][bj][m][n], 0, 0, 0); __builtin_amdgcn_s_setprio(0); } while (0)
#define PG8_WAIT_V(n) asm volatile("s_waitcnt vmcnt(" #n ")" ::: "memory")
#define PG8_WAIT_L(n) asm volatile("s_waitcnt lgkmcnt(" #n ")" ::: "memory")
#define PG8_BAR __builtin_amdgcn_s_barrier()
#define PG8_SCHED __builtin_amdgcn_sched_barrier(0)
    Unit cur, nxt; int ui = 0;
    if (!S.next(0, cur)) return;
    f32x4 acc[2][2][4][2];
#pragma unroll
    for (int a = 0; a < 2; ++a)
#pragma unroll
        for (int b = 0; b < 2; ++b)
#pragma unroll
            for (int m = 0; m < 4; ++m)
#pragma unroll
                for (int n = 0; n < 2; ++n) acc[a][b][m][n] = (f32x4){0.f, 0.f, 0.f, 0.f};
    bf16x8 At[4][2], B0[2][2], B1[2][2];
    const size_t sstep = (size_t)g.K * 2;
    const char* cA = (const char*)g.A + (size_t)cur.pm * tstep + (size_t)cur.kk * sstep; const char* cB = (const char*)g.Bt + (size_t)cur.pn * tstep + (size_t)cur.kk * sstep;
    S.a_ready(cur);
    if constexpr (SP2) {
        PG8_STAGE(PG8_SB(0, 0), cB, voffB); PG8_STAGE(PG8_SB(0, 1), cB + hstep, voffB); PG8_STAGE(PG8_SA(0, 0), cA, voffA); PG8_STAGE(PG8_SA(0, 1), cA + hstep, voffA);
        if (wr == 1) PG8_BAR;
        PG8_WAIT_V(2); PG8_BAR;
        PG8_STAGE(PG8_SB(1, 0), cB + kstep, voffB); PG8_STAGE(PG8_SA(1, 0), cA + kstep, voffA); PG8_STAGE(PG8_SB(1, 1), cB + hstep + kstep, voffB);
        PG8_WAIT_V(6); PG8_BAR;
    } else {
        PG8_STAGE(PG8_SB(0, 0), cB, voffB); PG8_STAGE(PG8_SA(0, 0), cA, voffA); PG8_STAGE(PG8_SB(0, 1), cB + hstep, voffB); PG8_STAGE(PG8_SA(0, 1), cA + hstep, voffA);
        if (wr == 1) PG8_BAR;
        PG8_WAIT_V(4); PG8_BAR;
        PG8_STAGE(PG8_SB(1, 0), cB + kstep, voffB); PG8_STAGE(PG8_SA(1, 0), cA + kstep, voffA); PG8_STAGE(PG8_SB(1, 1), cB + hstep + kstep, voffB);
        PG8_WAIT_V(6); PG8_BAR;
    }
    for (;;) {
        const bool has_next = S.next(ui + 1, nxt);
        const char* nA = has_next ? (const char*)g.A + (size_t)nxt.pm * tstep + (size_t)nxt.kk * sstep : cA; const char* nB = has_next ? (const char*)g.Bt + (size_t)nxt.pn * tstep + (size_t)nxt.kk * sstep : cB;
        for (int t = 0; t < nt; t += 2) {
            const bool last = (t == nt - 2);
            const char* a1 = cA + (size_t)(t + 1) * kstep;
            const char* a2 = last ? nA : cA + (size_t)(t + 2) * kstep; const char* b2 = last ? nB : cB + (size_t)(t + 2) * kstep;
            const char* a3 = a2 + kstep; const char* b3 = b2 + kstep;
            if (last && has_next) S.a_ready(nxt);
            if constexpr (SP2) {
            PG8_LDB(B0, 0, 0); PG8_LDB(B1, 0, 1); PG8_SCHED; PG8_LDA(At, 0, 0); PG8_STAGE(PG8_SA(1, 1), a1 + hstep, voffA);
            PG8_WAIT_V(8); PG8_WAIT_L(0); PG8_BAR; PG8_MMA(0, 0, At, B0); PG8_MMA(0, 1, At, B1); PG8_BAR; PG8_SCHED;
            PG8_LDA(At, 0, 1); PG8_STAGE(PG8_SB(0, 0), b2, voffB); PG8_STAGE(PG8_SB(0, 1), b2 + hstep, voffB); PG8_STAGE(PG8_SA(0, 0), a2, voffA);
            PG8_WAIT_V(8); PG8_WAIT_L(0); PG8_BAR; PG8_MMA(1, 0, At, B0); PG8_MMA(1, 1, At, B1); PG8_BAR; PG8_SCHED;
            PG8_LDB(B0, 1, 0); PG8_LDB(B1, 1, 1); PG8_SCHED; PG8_LDA(At, 1, 0); PG8_STAGE(PG8_SA(0, 1), a2 + hstep, voffA);
            PG8_WAIT_V(8); PG8_WAIT_L(0); PG8_BAR; PG8_MMA(0, 0, At, B0); PG8_MMA(0, 1, At, B1); PG8_BAR; PG8_SCHED;
            PG8_LDA(At, 1, 1); PG8_STAGE(PG8_SB(1, 0), b3, voffB); PG8_STAGE(PG8_SB(1, 1), b3 + hstep, voffB); PG8_STAGE(PG8_SA(1, 0), a3, voffA);
            PG8_WAIT_V(8); PG8_WAIT_L(0); PG8_BAR; PG8_MMA(1, 0, At, B0); PG8_MMA(1, 1, At, B1); PG8_BAR; PG8_SCHED;
            } else {
            PG8_LDB(B0, 0, 0); PG8_SCHED; PG8_LDA(At, 0, 0); PG8_STAGE(PG8_SA(1, 1), a1 + hstep, voffA);
            PG8_WAIT_L(8); PG8_BAR; PG8_WAIT_L(0); PG8_MMA(0, 0, At, B0); PG8_BAR; PG8_SCHED;
            PG8_LDB(B1, 0, 1); PG8_STAGE(PG8_SB(0, 0), b2, voffB);
            PG8_BAR; PG8_WAIT_L(0); PG8_MMA(0, 1, At, B1); PG8_BAR;
            PG8_LDA(At, 0, 1); PG8_STAGE(PG8_SA(0, 0), a2, voffA);
            PG8_BAR; PG8_WAIT_L(0); PG8_MMA(1, 0, At, B0); PG8_BAR; PG8_SCHED;
            PG8_STAGE(PG8_SB(0, 1), b2 + hstep, voffB);
            PG8_WAIT_V(6); PG8_BAR; PG8_MMA(1, 1, At, B1); PG8_BAR;
            PG8_LDB(B0, 1, 0); PG8_SCHED; PG8_LDA(At, 1, 0); PG8_STAGE(PG8_SA(0, 1), a2 + hstep, voffA);
            PG8_WAIT_L(8); PG8_BAR; PG8_WAIT_L(0); PG8_MMA(0, 0, At, B0); PG8_BAR; PG8_SCHED;
            PG8_LDB(B1, 1, 1); PG8_STAGE(PG8_SB(1, 0), b3, voffB);
            PG8_BAR; PG8_WAIT_L(0); PG8_MMA(0, 1, At, B1); PG8_BAR;
            PG8_LDA(At, 1, 1); PG8_STAGE(PG8_SA(1, 0), a3, voffA);
            PG8_BAR; PG8_WAIT_L(0); PG8_MMA(1, 0, At, B0); PG8_BAR; PG8_SCHED;
            PG8_STAGE(PG8_SB(1, 1), b3 + hstep, voffB);
            PG8_WAIT_V(6); PG8_BAR; PG8_MMA(1, 1, At, B1); PG8_BAR;
            }
        }
        if constexpr (ALIGN_EPI) { if (wr == 0) PG8_BAR; }
        if constexpr (!Epi::AFTER_DRAIN) { E(acc, cur, wr, wc, fr, fq); S.done(cur); }
        if (!has_next) break;
#pragma unroll
        for (int a = 0; a < 2; ++a)
#pragma unroll
            for (int b = 0; b < 2; ++b)
#pragma unroll
                for (int m = 0; m < 4; ++m)
#pragma unroll
                    for (int n = 0; n < 2; ++n) acc[a][b][m][n] = (f32x4){0.f, 0.f, 0.f, 0.f};
        cur = nxt; cA = nA; cB = nB; ++ui;
        if constexpr (ALIGN_EPI) { if (wr == 1) PG8_BAR; }
    }
    PG8_WAIT_V(0);
    if constexpr (!ALIGN_EPI) { if (wr == 0) PG8_BAR; }
    PG8_BAR;
    if constexpr (Epi::AFTER_DRAIN) { E.fused(acc, cur, wr, wc, fr, fq, lds, wid, lane); S.done(cur); }
#undef PG8_SA
#undef PG8_SB
#undef PG8_STAGE
#undef PG8_LDA
#undef PG8_LDB
#undef PG8_MMA
#undef PG8_WAIT_V
#undef PG8_WAIT_L
#undef PG8_BAR
#undef PG8_SCHED
}
}
#define XB_TMO      128
#define XB_XCNT(j)  (256  + 64 * (j))
#define XB_XSUB(j)  (1280 + 64 * (j))
#define XB_XGEN(j)  (2304 + 64 * (j))
#define XB_TOP      3328
#define XB_TOPGEN   3392
#define XCD_BAR_WORDS 3456
#define XB_SPIN_CAP (1u << 21)

__device__ __forceinline__ unsigned xb_ld(unsigned* p)              { return __hip_atomic_load(p, __ATOMIC_RELAXED, __HIP_MEMORY_SCOPE_AGENT); }
__device__ __forceinline__ unsigned xb_add(unsigned* p, unsigned v) { return __hip_atomic_fetch_add(p, v, __ATOMIC_RELAXED, __HIP_MEMORY_SCOPE_AGENT); }
__device__ __forceinline__ unsigned xb_xcc_id() { return (unsigned)__builtin_amdgcn_s_getreg((3 << 11) | 20) & 0xFu; }
#define XB_SPIN(cond, bar) do { unsigned _sp = 0; while (cond) { __builtin_amdgcn_s_sleep(1); \
    if ((++_sp & 255u) == 0u) { if (xb_ld(&(bar)[XB_TMO])) break; if (_sp > XB_SPIN_CAP) { atomicAdd(&(bar)[XB_TMO], 1u); break; } } } } while (0)

struct XcdBarrier {
    unsigned* bar; unsigned x;
    volatile LAS unsigned* st;
};

__device__ __forceinline__ XcdBarrier xcd_barrier_post(unsigned* bar, volatile LAS unsigned* st) {
    XcdBarrier b; b.bar = bar; b.x = (unsigned)__builtin_amdgcn_readfirstlane((int)xb_xcc_id()); b.st = st;
    if (threadIdx.x == 0) (void)xb_add(&bar[XB_XCNT(b.x)], 1u);
    return b;
}
__device__ __forceinline__ void xcd_barrier_complete(unsigned* bar, unsigned x, unsigned& nloc, unsigned& nx) {
    const unsigned G = gridDim.x * gridDim.y * gridDim.z;
    unsigned sum, cnt, mine, sp = 0u;
    for (;;) {
        sum = 0u; cnt = 0u; mine = 0u;
#pragma unroll
        for (unsigned j = 0; j < 16; ++j) { const unsigned c = xb_ld(&bar[XB_XCNT(j)]); sum += c; cnt += (c > 0u) ? 1u : 0u; }
        mine = xb_ld(&bar[XB_XCNT(x)]);
        if (sum == G) { mine = xb_ld(&bar[XB_XCNT(x)]); break; }
        __builtin_amdgcn_s_sleep(1);
        if ((++sp & 255u) == 0u) { if (xb_ld(&bar[XB_TMO])) break; if (sp > XB_SPIN_CAP) { atomicAdd(&bar[XB_TMO], 1u); break; } }
    }
    nloc = mine > 0u ? mine : 1u; nx = cnt > 0u ? cnt : 1u;
}

__device__ __forceinline__ void xcd_barrier(const XcdBarrier& b) {
    asm volatile("s_waitcnt vmcnt(0)" ::: "memory");
    __syncthreads();
    if (threadIdx.x == 0) {
        unsigned* bar = b.bar; unsigned bx_ = b.x;
        asm volatile("" : "+s"(bx_));
        __builtin_amdgcn_s_waitcnt(0);
        unsigned nloc = b.st[0], nx = b.st[1];
        if (nloc == 0u) { xcd_barrier_complete(bar, bx_, nloc, nx); b.st[0] = nloc; b.st[1] = nx; }
        const unsigned old = xb_add(&bar[XB_XSUB(bx_)], 1u);
        const unsigned gen = old / nloc;
        if (old + 1u == (gen + 1u) * nloc) {
            __builtin_amdgcn_fence(__ATOMIC_RELEASE, "agent");
            asm volatile("s_waitcnt vmcnt(0)" ::: "memory");
            const unsigned og = xb_add(&bar[XB_TOP], 1u);
            const unsigned tg = og / nx;
            if (og + 1u == (tg + 1u) * nx) xb_add(&bar[XB_TOPGEN], 1u);
            else XB_SPIN(xb_ld(&bar[XB_TOPGEN]) == tg, bar);
            __builtin_amdgcn_fence(__ATOMIC_ACQUIRE, "agent");
            xb_add(&bar[XB_XGEN(bx_)], 1u);
            asm volatile("s_waitcnt vmcnt(0)" ::: "memory");
        } else {
            XB_SPIN(xb_ld(&bar[XB_XGEN(bx_)]) == gen, bar);
            __builtin_amdgcn_fence(__ATOMIC_ACQUIRE, "agent");
            asm volatile("s_waitcnt vmcnt(0)" ::: "memory");
        }
    }
    __syncthreads();
}

typedef unsigned short bf16_t;
typedef short bf16x8 __attribute__((ext_vector_type(8)));
typedef float f32x4 __attribute__((ext_vector_type(4)));
typedef unsigned u32x4 __attribute__((ext_vector_type(4)));
#define LDS_WAIT() asm volatile("s_waitcnt lgkmcnt(0)" ::: "memory")

struct Params {
    const float* in[19];
};
struct Frame {
    LAS unsigned char* lds;
    int tid, lane, wave, G, bx, vcu, gw, ngw;
};
__device__ __forceinline__ const float* uptr(const LAS unsigned long long* t, int k) {
    const unsigned long long v = t[k]; const unsigned lo = __builtin_amdgcn_readfirstlane((unsigned)v), hi = __builtin_amdgcn_readfirstlane((unsigned)(v >> 32));
    return (const float*)(const GAS float*)(((unsigned long long)hi << 32) | lo); }

template <class CMap>
__device__ __forceinline__ void transpose_load(float (&v)[32], const float* W, int Nsrc, const float* ks, int kb, int nb, int lane, CMap cmap) {
    const int k0 = 64 * kb, n0 = 32 * nb; const int sc = cmap(n0 + (lane & 31));
#pragma unroll
    for (int i = 0; i < 32; ++i) { const int kk = 2 * i + (lane >> 5); float x = 0.f; if (sc >= 0) x = W[(size_t)(k0 + kk) * Nsrc + sc]; if (ks) x *= ks[k0 + kk]; v[i] = x; }
}
__device__ __forceinline__ void transpose_store(const float (&v)[32], int K, bf16_t* WT, LAS float* scr, int kb, int nb, int lane) {
    const int k0 = 64 * kb, n0 = 32 * nb;
#pragma unroll
    for (int i = 0; i < 32; ++i) scr[(2 * i + (lane >> 5)) * 33 + (lane & 31)] = v[i];
    LDS_WAIT(); asm volatile("" ::: "memory");
    const int c = lane & 7;
#pragma unroll
    for (int j = 0; j < 4; ++j) { const int n = (lane >> 3) + 8 * j; const LAS float* s = scr + (8 * c) * 33 + n;
        u32x4 o; o.x = pk2(s[0 * 33], s[1 * 33]); o.y = pk2(s[2 * 33], s[3 * 33]); o.z = pk2(s[4 * 33], s[5 * 33]); o.w = pk2(s[6 * 33], s[7 * 33]);
        *(u32x4*)(WT + (size_t)(n0 + n) * K + k0 + 8 * c) = o; }
    LDS_WAIT(); asm volatile("" ::: "memory");
}
template <class CMap>
__device__ __forceinline__ void transpose_matrix(const Frame& F, const float* W, int K, int Nsrc, int Ndst, bf16_t* WT, const float* ks, LAS float* scr, CMap cmap) {
    const int nnb = Ndst / 32, items = (K / 64) * nnb;
    for (int it = F.gw; it < items; it += 2 * F.ngw) { const int it2 = it + F.ngw; float va[32], vb[32];
        transpose_load(va, W, Nsrc, ks, it / nnb, it % nnb, F.lane, cmap);
        if (it2 < items) transpose_load(vb, W, Nsrc, ks, it2 / nnb, it2 % nnb, F.lane, cmap);
        transpose_store(va, K, WT, scr, it / nnb, it % nnb, F.lane);
        if (it2 < items) transpose_store(vb, K, WT, scr, it2 / nnb, it2 % nnb, F.lane); }
}
__device__ __forceinline__ int rope_perm(int m) { const int g = m >> 3, j = m & 7; return j < 4 ? 4 * g + j : 32 + 4 * g + (j - 4); }
struct CMapIn { __device__ int operator()(int n) const {
    if (n < 4096) return n; if (n < 4608) return 4112 + (n - 4096); if (n < 4864) return 4624 + (n - 4608);
    if (n < 4928) return 4880 + rope_perm(n - 4864); if (n < 4944) return 4096 + (n - 4928); return -1; } };
struct CMapQ { __device__ int operator()(int n) const { const int h = n / 192, o = n % 192; return o < 128 ? n : h * 192 + 128 + rope_perm(o - 128); } };
struct CMapUp { __device__ int operator()(int n) const { const int pn = n >> 8, j = n & 255; return j < 128 ? 128 * pn + j : DFF + 128 * pn + (j - 128); } };
struct CMapId { __device__ int operator()(int n) const { return n; } };

__device__ __forceinline__ void convert_weights(const Frame& F, unsigned char* ws, const LAS unsigned long long* pt, int l) {
    LAS float* scr = (LAS float*)(F.lds + F.wave * 8448);
    const float* w_in = uptr(pt, 3) + (size_t)l * DM * INC; const float* w_uq = uptr(pt, 8) + (size_t)l * 512 * NQ; const float* w_ukv = uptr(pt, 9) + (size_t)l * 256 * NKV;
    const float* w_out = uptr(pt, 10) + (size_t)l * DM * DM; const float* w_up = uptr(pt, 13) + (size_t)l * DM * NUP; const float* w_dn = uptr(pt, 16) + (size_t)l * DFF * DM;
    const float* qg = uptr(pt, 6) + (size_t)l * 512; const float* kvg = uptr(pt, 7) + (size_t)l * 256;
    transpose_matrix(F, w_in, DM, INC, NIN, (bf16_t*)(ws + WS_WIN), nullptr, scr, CMapIn());
    transpose_matrix(F, w_uq, 512, NQ, NQ, (bf16_t*)(ws + WS_WUQ), qg, scr, CMapQ());
    transpose_matrix(F, w_ukv, 256, NKV, NKV, (bf16_t*)(ws + WS_WUKV), kvg, scr, CMapId());
    transpose_matrix(F, w_out, DM, DM, DM, (bf16_t*)(ws + WS_WOUT), nullptr, scr, CMapId());
    transpose_matrix(F, w_up, DM, NUP, NUP, (bf16_t*)(ws + WS_WUP), nullptr, scr, CMapUp());
    transpose_matrix(F, w_dn, DFF, DM, DM, (bf16_t*)(ws + WS_WDN), nullptr, scr, CMapId());
}

__device__ __forceinline__ void prologue(const Frame& F, unsigned char* ws, const LAS unsigned long long* pt) {
    float* COS = (float*)(ws + WS_COS); float* SIN = (float*)(ws + WS_SIN);
    for (int i = F.bx * 512 + F.tid; i < 4112 * 32; i += F.G * 512) { const int pos = i >> 5, f = i & 31;
        const float inv = powf(10000.0f, -(float)(2 * f) / 64.0f); const float ang = (float)pos * inv; float s, c; sincosf(ang, &s, &c); COS[i] = c; SIN[i] = s; }
    { float* PAR = (float*)(ws + WS_PAR); const int gt = F.bx * 512 + F.tid, nt = F.G * 512;
      for (int i = gt; i < DEPTH * 16; i += nt) PAR[PO_BG + i] = uptr(pt, 4)[i];
      for (int i = gt; i < DEPTH * 1024; i += nt) PAR[PO_MLG + i] = uptr(pt, 5)[i];
      for (int i = gt; i < DEPTH * 512; i += nt) PAR[PO_QG + i] = uptr(pt, 6)[i];
      for (int i = gt; i < DEPTH * 256; i += nt) PAR[PO_KVG + i] = uptr(pt, 7)[i];
      for (int i = gt; i < 2048; i += nt) { PAR[PO_ONE + i] = 1.f; PAR[PO_ZERO + i] = 0.f; }
      { float* ST2 = (float*)(ws + WS_STAT2); for (int i = gt; i < TP; i += nt) { ST2[2 * i] = 0.f; ST2[2 * i + 1] = 1.f; } }
      for (int i = gt; i < DEPTH * 2048; i += nt) { PAR[PO_L1G + i] = uptr(pt, 11)[i]; PAR[PO_L1B + i] = uptr(pt, 12)[i]; PAR[PO_L2G + i] = uptr(pt, 17)[i]; PAR[PO_L2B + i] = uptr(pt, 18)[i]; }
      for (int i = gt; i < DEPTH * 3 * 5632; i += nt) PAR[PO_CW + i] = uptr(pt, 14)[i];
      for (int i = gt; i < DEPTH * 5632; i += nt) PAR[PO_CB + i] = uptr(pt, 15)[i]; }
    float* H = (float*)(ws + WS_H); bf16_t* HB = (bf16_t*)(ws + WS_HB);
    const float* xp = uptr(pt, 0); const float* xs = uptr(pt, 1); const float* mt = uptr(pt, 2);
    for (int row0 = F.gw; row0 < TP; row0 += 2 * F.ngw) {
        f32x4 v[2][8];
#pragma unroll
        for (int r = 0; r < 2; ++r) { const int row = row0 + r * F.ngw; const float* src = nullptr;
            if (row < 4 * LREAL) src = xp + (size_t)row * DM; else if (row < NMAIN) src = xs + (size_t)(row - 4 * LREAL) * DM; else if (row < NTOK) src = mt + (size_t)((row - NMAIN) & 15) * DM;
#pragma unroll
            for (int j = 0; j < 8; ++j) { v[r][j] = (f32x4){0.f, 0.f, 0.f, 0.f}; if (src) v[r][j] = ((const f32x4*)src)[F.lane + 64 * j]; } }
#pragma unroll
        for (int r = 0; r < 2; ++r) { const int row = row0 + r * F.ngw; if (row < TP) {
            f32x4* hd = (f32x4*)(H + (size_t)row * DM) + F.lane; u32x2* bd = (u32x2*)(HB + (size_t)row * DM) + F.lane; u32x2* hb = (u32x2*)((bf16_t*)H + (size_t)row * DM) + F.lane;
#pragma unroll
            for (int j = 0; j < 8; ++j) { const f32x4 x = v[r][j];
                u32x2 w; w.x = pk2(x[0], x[1]); w.y = pk2(x[2], x[3]); bd[64 * j] = w;
                if (row >= NMAIN) hd[64 * j] = x * ALPHA;
                else hb[64 * j] = w; } } }
    }
}

__device__ __forceinline__ void ln_one(const f32x4 (&vin)[8], int row, int lane, float* __restrict__ Hw, bf16_t* __restrict__ HB, const float* __restrict__ g, const float* __restrict__ b, float* __restrict__ ST) {
    f32x4 v[8]; float s = 0.f;
#pragma unroll
    for (int j = 0; j < 8; ++j) { v[j] = vin[j]; s += (v[j][0] + v[j][1]) + (v[j][2] + v[j][3]); }
    const float mean = wave_sum(s) * (1.f / DM); float q = 0.f;
#pragma unroll
    for (int j = 0; j < 8; ++j) { v[j] = v[j] - mean; q += (v[j][0] * v[j][0] + v[j][1] * v[j][1]) + (v[j][2] * v[j][2] + v[j][3] * v[j][3]); }
    const float rstd = rsqrtf(wave_sum(q) * (1.f / DM) + EPS);
    if (lane == 0) { f32x2 ms = {mean, rstd}; *(f32x2*)(ST + (size_t)row * 2) = ms; }
    u32x2* bd = (u32x2*)(HB + (size_t)row * DM) + lane; f32x4* hp = (f32x4*)(Hw + (size_t)row * DM) + lane;
#pragma unroll
    for (int j = 0; j < 8; ++j) { const f32x4 gg = ((const f32x4*)g)[lane + 64 * j], bb = ((const f32x4*)b)[lane + 64 * j]; const f32x4 y = v[j] * rstd * gg + bb;
        u32x2 w; w.x = pk2(y[0], y[1]); w.y = pk2(y[2], y[3]); bd[64 * j] = w;
        hp[64 * j] = y * ALPHA; }
}
__device__ __forceinline__ void ln_one_bf(const u32x4 (&vin)[4], int row, int lane, bf16_t* __restrict__ HB, const float* __restrict__ g, const float* __restrict__ b, float* __restrict__ ST, float* __restrict__ out) {
    f32x4 v[8]; float s = 0.f;
#pragma unroll
    for (int j = 0; j < 4; ++j) { v[2 * j] = (f32x4){bf_lo(vin[j].x), bf_hi(vin[j].x), bf_lo(vin[j].y), bf_hi(vin[j].y)}; v[2 * j + 1] = (f32x4){bf_lo(vin[j].z), bf_hi(vin[j].z), bf_lo(vin[j].w), bf_hi(vin[j].w)}; }
#pragma unroll
    for (int j = 0; j < 8; ++j) s += (v[j][0] + v[j][1]) + (v[j][2] + v[j][3]);
    const float mean = wave_sum(s) * (1.f / DM); float q = 0.f;
#pragma unroll
    for (int j = 0; j < 8; ++j) { v[j] = v[j] - mean; q += (v[j][0] * v[j][0] + v[j][1] * v[j][1]) + (v[j][2] * v[j][2] + v[j][3] * v[j][3]); }
    const float rstd = rsqrtf(wave_sum(q) * (1.f / DM) + EPS);
    if (lane == 0) { f32x2 ms = {mean, rstd}; *(f32x2*)(ST + (size_t)row * 2) = ms; }
    u32x4* bd = (u32x4*)(HB + (size_t)row * DM) + lane;
#pragma unroll
    for (int j = 0; j < 4; ++j) { const int c4 = 2 * (lane + 64 * j);
        const f32x4 y0 = v[2 * j] * rstd * ((const f32x4*)g)[c4] + ((const f32x4*)b)[c4], y1 = v[2 * j + 1] * rstd * ((const f32x4*)g)[c4 + 1] + ((const f32x4*)b)[c4 + 1];
        bd[64 * j] = pg8::pack8(y0, y1);
        if (out) { f32x4* op = (f32x4*)(out + (size_t)row * DM) + c4; op[0] = y0; op[1] = y1; } }
}
__device__ __forceinline__ void ln_rows(const Frame& F, float* H, bf16_t* HB, const float* g, const float* b, float* ST, float* out, const float* PART, int nk) {
    const bf16_t* __restrict__ Hr = (const bf16_t*)H;
    for (int row = F.gw; row < NMAIN; row += 2 * F.ngw) {
        const int row2 = row + F.ngw;
        u32x4 va[4], vb[4];
#pragma unroll
        for (int j = 0; j < 4; ++j) va[j] = ((const u32x4*)(Hr + (size_t)row * DM))[F.lane + 64 * j];
#pragma unroll
        for (int j = 0; j < 4; ++j) vb[j] = ((const u32x4*)(Hr + (size_t)row2 * DM))[F.lane + 64 * j];
        ln_one_bf(va, row, F.lane, HB, g, b, ST, out);
        ln_one_bf(vb, row2, F.lane, HB, g, b, ST, out);
    }
    if (F.gw < TP - NMAIN) {
        const int row = NMAIN + F.gw; const float* __restrict__ Hm = H; f32x4 va[8];
#pragma unroll
        for (int j = 0; j < 8; ++j) va[j] = ((const f32x4*)(Hm + (size_t)row * DM))[F.lane + 64 * j];
        for (int k = 0; k < nk; ++k) {
            const float* __restrict__ pp = PART + ((size_t)k * 256 + F.gw) * DM;
#pragma unroll
            for (int j = 0; j < 8; ++j) va[j] += ((const f32x4*)pp)[F.lane + 64 * j]; }
        ln_one(va, row, F.lane, H, HB, g, b, ST);
    }
}

__device__ __forceinline__ void rstd_rows(const Frame& F, const bf16_t* UDQ, const bf16_t* UDKV, float* RSTD) {
    for (int row = F.gw; row < TP; row += F.ngw) {
        const u32x4 a = ((const u32x4*)(UDQ + (size_t)row * 512))[F.lane]; float s = 0.f;
#pragma unroll
        for (int j = 0; j < 4; ++j) { const float x = bf_lo(a[j]), y = bf_hi(a[j]); s += x * x + y * y; }
        float t = 0.f;
        if (F.lane < 32) { const u32x4 c = ((const u32x4*)(UDKV + (size_t)row * 256))[F.lane];
#pragma unroll
            for (int j = 0; j < 4; ++j) { const float x = bf_lo(c[j]), y = bf_hi(c[j]); t += x * x + y * y; } }
        s = wave_sum(s); t = wave_sum(t);
        if (F.lane == 0) { RSTD[(size_t)row * 2] = rsqrtf(s * (1.f / 512.f) + EPS); RSTD[(size_t)row * 2 + 1] = rsqrtf(t * (1.f / 256.f) + EPS); }
    }
}

__device__ __forceinline__ void mlstm_finalize(const Frame& F, int gw0, int ngw0, const float* HSUM, const bf16_t* UQKVO, const float* ng, bf16_t* MIX) {
    for (int row = gw0; row < TP; row += ngw0) {
#pragma unroll
        for (int j = 0; j < 4; ++j) {
            f32x4 v = ((const f32x4*)(HSUM + (size_t)row * MLW + 256 * j))[F.lane];
            const float mean = wave_sum((v[0] + v[1]) + (v[2] + v[3])) * (1.f / 256.f); v = v - mean;
            const float rstd = rsqrtf(wave_sum((v[0] * v[0] + v[1] * v[1]) + (v[2] * v[2] + v[3] * v[3])) * (1.f / 256.f) + EPS);
            const f32x4 gg = ((const f32x4*)(ng + 256 * j))[F.lane];
            const u32x2 uo = ((const u32x2*)(UQKVO + (size_t)row * 4096 + 3072 + 256 * j))[F.lane];
            const float o0 = bf_lo(uo.x), o1 = bf_hi(uo.x), o2 = bf_lo(uo.y), o3 = bf_hi(uo.y);
            const float y0 = v[0] * rstd * gg[0] / (1.f + __expf(-o0)), y1 = v[1] * rstd * gg[1] / (1.f + __expf(-o1));
            const float y2 = v[2] * rstd * gg[2] / (1.f + __expf(-o2)), y3 = v[3] * rstd * gg[3] / (1.f + __expf(-o3));
            u32x2 w; w.x = pk2(y0, y1); w.y = pk2(y2, y3); ((u32x2*)(MIX + (size_t)row * DM + 256 * j))[F.lane] = w;
        }
    }
}

__device__ __forceinline__ f32x8 ld8f(const float* p) { const f32x4 a = *(const f32x4*)p, b = *(const f32x4*)(p + 4); return (f32x8){a[0], a[1], a[2], a[3], b[0], b[1], b[2], b[3]}; }
__device__ __forceinline__ f32x8 ld8b(const bf16_t* p) { const u32x4 v = *(const u32x4*)p; return (f32x8){bf_lo(v[0]), bf_hi(v[0]), bf_lo(v[1]), bf_hi(v[1]), bf_lo(v[2]), bf_hi(v[2]), bf_lo(v[3]), bf_hi(v[3])}; }
__device__ __forceinline__ void act_store(bf16_t* dst, const f32x8 gp, const f32x8 gc, const f32x8 gn, const f32x8 vv, const f32x8 w0, const f32x8 w1, const f32x8 w2, const f32x8 bb) {
    float o[8];
#pragma unroll
    for (int i = 0; i < 8; ++i) { const float x = w0[i] * gp[i] + w1[i] * gc[i] + w2[i] * gn[i] + bb[i]; o[i] = x / (1.f + __expf(-x)) * vv[i]; }
    u32x4 w; w.x = pk2(o[0], o[1]); w.y = pk2(o[2], o[3]); w.z = pk2(o[4], o[5]); w.w = pk2(o[6], o[7]); *(u32x4*)dst = w;
}
__device__ __forceinline__ void ffn_fixup(const Frame& F, const float* SIDE, const bf16_t* GVM, bf16_t* ACT, const float* cw, const float* cb) {
    constexpr int NCH = DFF / 8;
    const f32x8 zero = {0.f, 0.f, 0.f, 0.f, 0.f, 0.f, 0.f, 0.f};
    const int gt = F.bx * 512 + F.tid, nt = GRID * 512;
    for (int idx = gt; idx < 192 * 2 * NCH; idx += nt) {
        const int ch = idx % NCH, rsel = (idx / NCH) & 1, pm = idx / (2 * NCH), c0 = 8 * ch, sq = pm >> 4;
        const f32x8 w0 = ld8f(cw + c0), w1 = ld8f(cw + DFF + c0), w2 = ld8f(cw + 2 * DFF + c0), bb = ld8f(cb + c0);
        const float* S0 = SIDE + (size_t)pm * 6 * DFF + c0;
        if (rsel == 0) { const f32x8 gp = (pm & 15) ? ld8f(S0 - 6 * DFF + 3 * DFF) : ld8b(GVM + (size_t)(16 * sq + 15) * NUP + c0);
            act_store(ACT + (size_t)(pm * 256) * DFF + c0, gp, ld8f(S0), ld8f(S0 + DFF), ld8f(S0 + 4 * DFF), w0, w1, w2, bb);
        } else { const f32x8 gn = ((pm & 15) != 15) ? ld8f(S0 + 6 * DFF) : zero;
            act_store(ACT + (size_t)(pm * 256 + 255) * DFF + c0, ld8f(S0 + 2 * DFF), ld8f(S0 + 3 * DFF), gn, ld8f(S0 + 5 * DFF), w0, w1, w2, bb); }
    }
    for (int idx = gt; idx < NSEQ * NCH; idx += nt) {
        const int ch = idx % NCH, sq = idx / NCH, c0 = 8 * ch;
        const f32x8 w0 = ld8f(cw + c0), w1 = ld8f(cw + DFF + c0), w2 = ld8f(cw + 2 * DFF + c0), bb = ld8f(cb + c0);
        f32x8 gp = zero, gc = ld8b(GVM + (size_t)(16 * sq) * NUP + c0);
        for (int p = 0; p < 16; ++p) {
            const f32x8 gn = p < 15 ? ld8b(GVM + (size_t)(16 * sq + p + 1) * NUP + c0) : ld8f(SIDE + (size_t)(16 * sq) * 6 * DFF + c0);
            act_store(ACT + (size_t)(MROW0 + 16 * sq + p) * DFF + c0, gp, gc, gn, ld8b(GVM + (size_t)(16 * sq + p) * NUP + DFF + c0), w0, w1, w2, bb);
            gp = gc; gc = gn;
        }
    }
}

namespace att {
constexpr int NW = 8, QBLK = 32, KVBLK = 64, NT = 65;
constexpr int KROW = 400;
constexpr int SHM_V = KVBLK * 128 * 2, SHM_K = KVBLK * KROW;
constexpr int OFF_V = 0, OFF_K = 3 * SHM_V, OFF_WS = OFF_K + 3 * SHM_K, LDS_TOTAL = OFF_WS + NW * 64 * 4;
static_assert(LDS_TOTAL <= RING_BYTES, "attention LDS");
constexpr float SCALE = 0.07216878364870323f;
constexpr float THR = 8.f;
#define SBAR() __builtin_amdgcn_sched_barrier(0)
__device__ __forceinline__ int crow(int r, int hi) { return (r & 3) + 8 * (r >> 2) + 4 * hi; }
__device__ __forceinline__ unsigned cvtpk(float lo, float hi) { unsigned r; asm volatile("v_cvt_pk_bf16_f32 %0, %1, %2" : "=v"(r) : "v"(lo), "v"(hi)); return r; }

template <bool MASK16>
__device__ __forceinline__ void partialSM(f32x16& p0, f32x16& p1, float& m_reg, float& mn, float& alpha) {
    constexpr float C = SCALE * 1.4426950408889634f;
    if (MASK16) {
#pragma unroll
        for (int r = 8; r < 16; ++r) p0[r] = NEGBIG;
#pragma unroll
        for (int r = 0; r < 16; ++r) p1[r] = NEGBIG;
    }
    float pmax = p0[0];
#pragma unroll
    for (int r = 1; r < 16; ++r) pmax = fmaxf(pmax, p0[r]);
#pragma unroll
    for (int r = 0; r < 16; ++r) pmax = fmaxf(pmax, p1[r]);
    { auto rr = __builtin_amdgcn_permlane32_swap(__float_as_uint(pmax), __float_as_uint(pmax), false, false); pmax = fmaxf(__uint_as_float(rr[0]), __uint_as_float(rr[1])); }
    if (__builtin_expect(__all(pmax - m_reg <= THR / SCALE), 1)) { mn = m_reg; alpha = 1.f; }
    else { mn = fmaxf(m_reg, pmax); alpha = __builtin_amdgcn_exp2f((m_reg - mn) * C); m_reg = mn; }
    const float mnC = -mn * C;
#pragma unroll
    for (int r = 0; r < 16; ++r) p0[r] = fmaf(p0[r], C, mnC);
#pragma unroll
    for (int r = 0; r < 16; ++r) p1[r] = fmaf(p1[r], C, mnC);
#pragma unroll
    for (int r = 0; r < 16; ++r) p0[r] = __builtin_amdgcn_exp2f(p0[r]);
}
__device__ __forceinline__ void finishSM(f32x16& p0, f32x16& p1, float alpha, float& l_reg, bf16x8& pa0, bf16x8& pa1, bf16x8& pa2, bf16x8& pa3) {
#pragma unroll
    for (int r = 0; r < 16; ++r) p1[r] = __builtin_amdgcn_exp2f(p1[r]);
    float ps = 0;
#pragma unroll
    for (int r = 0; r < 16; ++r) ps += p0[r];
#pragma unroll
    for (int r = 0; r < 16; ++r) ps += p1[r];
    { auto rr = __builtin_amdgcn_permlane32_swap(__float_as_uint(ps), __float_as_uint(ps), false, false); ps = __uint_as_float(rr[0]) + __uint_as_float(rr[1]); }
    l_reg = l_reg * alpha + ps;
#define PK4(P, BASE, OUT) do { unsigned a0 = cvtpk(P[BASE + 0], P[BASE + 1]), a1 = cvtpk(P[BASE + 2], P[BASE + 3]);   \
    unsigned b0 = cvtpk(P[BASE + 4], P[BASE + 5]), b1 = cvtpk(P[BASE + 6], P[BASE + 7]);                              \
    auto r0 = __builtin_amdgcn_permlane32_swap(a0, b0, false, false); auto r1 = __builtin_amdgcn_permlane32_swap(a1, b1, false, false); \
    u32x4 w = {r0[0], r1[0], r0[1], r1[1]}; OUT = __builtin_bit_cast(bf16x8, w); } while (0)
    PK4(p0, 0, pa0); PK4(p0, 8, pa1); PK4(p1, 0, pa2); PK4(p1, 8, pa3);
#undef PK4
}
__device__ __forceinline__ void qkt(f32x16& p0, f32x16& p1, const LAS char* Ks, const bf16x8* qr, int r32, int hi) {
#pragma unroll
    for (int r = 0; r < 16; ++r) { p0[r] = 0.f; p1[r] = 0.f; }
#pragma unroll
    for (int d0 = 0; d0 < 12; ++d0) { const int cb = (d0 * 16 + hi * 8) * 2;
        const bf16x8 b0 = *(const LAS bf16x8*)(Ks + r32 * KROW + cb);
        const bf16x8 b1 = *(const LAS bf16x8*)(Ks + (32 + r32) * KROW + cb);
        p0 = __builtin_amdgcn_mfma_f32_32x32x16_bf16(b0, qr[d0], p0, 0, 0, 0);
        p1 = __builtin_amdgcn_mfma_f32_32x32x16_bf16(b1, qr[d0], p1, 0, 0, 0); }
}
__device__ __forceinline__ int v_st(int k, int c) { const int kk = (k & ~0xC) | ((k & 4) << 1) | ((k & 8) >> 1); return ((kk >> 3) * 4 + (c >> 5)) * 512 + ((kk & 7) * 32 + (c & 31)) * 2; }
__device__ __forceinline__ int v_rd_base(int lane) { return ((lane & 3) << 3) | (((lane >> 2) & 3) << 6) | (((lane >> 4) & 1) << 5) | (((lane >> 5) & 1) << 8); }
constexpr int v_rd_off(int d0, int ks, int half) { return d0 * 512 + ks * 4096 + half * 2048; }
template <int OFF> __device__ __forceinline__ s16x4 tr_read(int vb) { s16x4 r; asm volatile("ds_read_b64_tr_b16 %0, %1 offset:%2" : "=&v"(r) : "v"(vb), "i"(OFF) : "memory"); return r; }
template <int D0> __device__ __forceinline__ void pv_one(f32x16& od, int vb, bf16x8 pa0, bf16x8 pa1, bf16x8 pa2, bf16x8 pa3) {
    const s16x4 l0 = tr_read<v_rd_off(D0, 0, 0)>(vb), h0 = tr_read<v_rd_off(D0, 0, 1)>(vb), l1 = tr_read<v_rd_off(D0, 1, 0)>(vb), h1 = tr_read<v_rd_off(D0, 1, 1)>(vb);
    const s16x4 l2 = tr_read<v_rd_off(D0, 2, 0)>(vb), h2 = tr_read<v_rd_off(D0, 2, 1)>(vb), l3 = tr_read<v_rd_off(D0, 3, 0)>(vb), h3 = tr_read<v_rd_off(D0, 3, 1)>(vb);
    asm volatile("s_waitcnt lgkmcnt(0)" ::: "memory"); SBAR();
#define PKV(L, H) (bf16x8){L[0], L[1], L[2], L[3], H[0], H[1], H[2], H[3]}
    od = __builtin_amdgcn_mfma_f32_32x32x16_bf16(pa0, PKV(l0, h0), od, 0, 0, 0);
    od = __builtin_amdgcn_mfma_f32_32x32x16_bf16(pa1, PKV(l1, h1), od, 0, 0, 0);
    od = __builtin_amdgcn_mfma_f32_32x32x16_bf16(pa2, PKV(l2, h2), od, 0, 0, 0);
    od = __builtin_amdgcn_mfma_f32_32x32x16_bf16(pa3, PKV(l3, h3), od, 0, 0, 0);
#undef PKV
}
__device__ __forceinline__ void pv_d0(f32x16* o, int vb, bf16x8 pa0, bf16x8 pa1, bf16x8 pa2, bf16x8 pa3) {
    pv_one<0>(o[0], vb, pa0, pa1, pa2, pa3); pv_one<1>(o[1], vb, pa0, pa1, pa2, pa3); pv_one<2>(o[2], vb, pa0, pa1, pa2, pa3); pv_one<3>(o[3], vb, pa0, pa1, pa2, pa3);
}

__device__ __forceinline__ void attn_unit(int s, int h, int qb, const bf16_t* __restrict__ MQ, const bf16_t* __restrict__ MKV, const bf16_t* __restrict__ KR, bf16_t* __restrict__ MIX, LAS char* lds) {
    int tid_ = threadIdx.x; asm volatile("" : "+v"(tid_));
    const int tid = tid_, wid = tid >> 6, lane = tid & 63, r32 = lane & 31, hi = lane >> 5;
    LAS char* V_lds = lds + OFF_V; LAS char* K_lds = lds + OFF_K;
    LAS float* wsf = (LAS float*)(lds + OFF_WS) + wid * 64; LAS float* li_l = wsf; LAS float* al_l = wsf + 32;
    float m_reg = NEGBIG, l_reg = 0; f32x16 o[4]; bf16x8 qr[12];
#pragma unroll
    for (int d = 0; d < 4; ++d)
#pragma unroll
        for (int r = 0; r < 16; ++r) o[d][r] = 0.f;
    const int qi = wid * QBLK + r32;
    const unsigned qrow = qb < 16 ? (unsigned)s * LREAL + 256 * qb + qi : (unsigned)MROW0 + 16 * s + (qi < 15 ? qi : 15);
    { const bf16_t* Qw = MQ + (qrow * NQ + h * 192 + hi * 8);
#pragma unroll
      for (int d0 = 0; d0 < 12; ++d0) qr[d0] = *(const bf16x8*)(Qw + d0 * 16); }
    const int sr = tid >> 4, sc = (tid & 15) * 8, vst0 = v_st(sr, sc), vst1 = v_st(32 + sr, sc);
    const int kr_r = tid >> 3, kr_c = (tid & 7) * 8;
    const int vb0 = (int)(uintptr_t)V_lds + v_rd_base(lane);
    bf16x8 vs0, vs1, ks0, ks1, kr0;
    const unsigned mainrow0 = (unsigned)s * LREAL, metarow0 = (unsigned)MROW0 + 16 * s;
    const bf16_t* MKVh = MKV + h * 256;
#define KROWG(kt, k) ((kt) < 64 ? mainrow0 + 64u * (kt) + (k) : metarow0 + ((k) < 15 ? (k) : 15))
#define SLOAD(kt) do { const unsigned g0 = KROWG(kt, sr) * NKV + sc, g1 = KROWG(kt, 32 + sr) * NKV + sc, g2 = KROWG(kt, kr_r) * 64 + kr_c; \
    vs0 = *(const bf16x8*)(MKVh + 128 + g0); vs1 = *(const bf16x8*)(MKVh + 128 + g1); \
    ks0 = *(const bf16x8*)(MKVh + g0); ks1 = *(const bf16x8*)(MKVh + g1); kr0 = *(const bf16x8*)(KR + g2); } while (0)
#define SWRITE(b) do { *(LAS bf16x8*)(V_lds + (b) * SHM_V + vst0) = vs0; *(LAS bf16x8*)(V_lds + (b) * SHM_V + vst1) = vs1; \
    *(LAS bf16x8*)(K_lds + (b) * SHM_K + sr * KROW + sc * 2) = ks0; *(LAS bf16x8*)(K_lds + (b) * SHM_K + (32 + sr) * KROW + sc * 2) = ks1; \
    *(LAS bf16x8*)(K_lds + (b) * SHM_K + kr_r * KROW + 256 + kr_c * 2) = kr0; } while (0)
#define RESC(a) do { if (__any((a) < 1.f)) { if (hi == 0) al_l[r32] = (a); asm volatile("s_waitcnt lgkmcnt(0)" ::: "memory"); \
    _Pragma("unroll") for (int d = 0; d < 4; ++d) _Pragma("unroll") for (int r = 0; r < 16; ++r) o[d][r] *= al_l[crow(r, hi)]; } } while (0)
    f32x16 pA0, pA1, pB0, pB1; float mnA, mnB, alA, alB; bf16x8 pa0, pa1, pa2, pa3;
    __syncthreads();
    SLOAD(0); SWRITE(0); __syncthreads();
    qkt(pA0, pA1, K_lds, qr, r32, hi); partialSM<false>(pA0, pA1, m_reg, mnA, alA);
    SLOAD(1); SWRITE(1); __syncthreads();
    RESC(alA);
    int s0 = 0, s1 = 1, s2 = 2;
    for (int j = 1; j + 1 < NT; j += 2) {
        SBAR(); qkt(pB0, pB1, K_lds + s1 * SHM_K, qr, r32, hi);
        finishSM(pA0, pA1, alA, l_reg, pa0, pa1, pa2, pa3); SBAR();
        SLOAD(j + 1); SBAR();
        pv_d0(o, vb0 + s0 * SHM_V, pa0, pa1, pa2, pa3); partialSM<false>(pB0, pB1, m_reg, mnB, alB);
        SWRITE(s2);
        RESC(alB); __syncthreads();
        SBAR(); qkt(pA0, pA1, K_lds + s2 * SHM_K, qr, r32, hi);
        finishSM(pB0, pB1, alB, l_reg, pa0, pa1, pa2, pa3); SBAR();
        if (j + 2 < NT) SLOAD(j + 2); SBAR();
        pv_d0(o, vb0 + s1 * SHM_V, pa0, pa1, pa2, pa3);
        if (j + 1 == NT - 1) partialSM<true>(pA0, pA1, m_reg, mnA, alA); else partialSM<false>(pA0, pA1, m_reg, mnA, alA);
        if (j + 2 < NT) SWRITE(s0);
        RESC(alA); __syncthreads();
        { const int t0 = s0, t1 = s1; s0 = s2; s1 = t0; s2 = t1; }
    }
    finishSM(pA0, pA1, alA, l_reg, pa0, pa1, pa2, pa3); SBAR();
    pv_d0(o, vb0 + s0 * SHM_V, pa0, pa1, pa2, pa3);
    if (hi == 0) li_l[r32] = l_reg; asm volatile("s_waitcnt lgkmcnt(0)" ::: "memory");
    float rli[16];
#pragma unroll
    for (int r = 0; r < 16; ++r) rli[r] = __builtin_amdgcn_rcpf(li_l[crow(r, hi)]);
    if (qb < 16) {
        bf16_t* Ow = MIX + ((long)s * LREAL + 256 * qb + wid * QBLK) * DM + MLW + h * 128;
#pragma unroll
        for (int r = 0; r < 16; ++r) { const int orow = crow(r, hi);
#pragma unroll
            for (int d0 = 0; d0 < 4; ++d0) Ow[(long)orow * DM + d0 * 32 + r32] = (bf16_t)(pk2(o[d0][r] * rli[r], 0.f) & 0xffffu); }
    } else if (wid == 0) {
        bf16_t* Ow = MIX + ((long)MROW0 + 16 * s) * DM + MLW + h * 128;
#pragma unroll
        for (int r = 0; r < 16; ++r) { const int orow = crow(r, hi);
            if (orow < 16) {
#pragma unroll
                for (int d0 = 0; d0 < 4; ++d0) Ow[(long)orow * DM + d0 * 32 + r32] = (bf16_t)(pk2(o[d0][r] * rli[r], 0.f) & 0xffffu); } }
    }
#undef KROWG
#undef SLOAD
#undef SWRITE
#undef RESC
}
__device__ __forceinline__ void attn_phase(int vcu, const bf16_t* MQ, const bf16_t* MKV, const bf16_t* KR, bf16_t* MIX, LAS char* lds) {
    for (int i = (vcu < 96 ? -1 : 0); i < 6; ++i) { int sh, qb; if (i < 0) { sh = vcu; qb = 16; } else { const int id = i * GRID + vcu; sh = id >> 4; qb = id & 15; }
        attn_unit(sh >> 3, sh & 7, qb, MQ, MKV, KR, MIX, lds); }
}
#undef SBAR
}

namespace ml {
constexpr int QI = 0, KI = 32768, VI = 65536, SI = 81920, CI = 98304;
constexpr int SC_CT = 0, SC_BM = 64, SC_WI = 128, SC_EI = 192, SC_WW = 256, SC_DEN = 320, SC_QN = 448, SC_N = 512, SC_A = 768;
constexpr int GP_REC = 200;
__device__ __forceinline__ unsigned off_b(unsigned row, unsigned ch) { return 256u * row + 16u * (ch ^ (((row & 3) << 2) | ((row >> 2) & 3))); }
__device__ __forceinline__ unsigned row_read_addr_16(unsigned lane, unsigned rb, unsigned s) { return off_b((lane & 15) + 16 * rb, 4 * s + (lane >> 4)); }
__device__ __forceinline__ unsigned tr_read_addr_16(unsigned lane, unsigned c, unsigned ks, unsigned t) {
    const unsigned g = lane >> 4, q = (lane & 15) >> 2, p = lane & 3; return off_b(32 * ks + 8 * g + 4 * t + q, 2 * c + (p >> 1)) + 8 * (p & 1); }
__device__ __forceinline__ bf16x8 tr_frag(unsigned a0, unsigned a1) {
    const s16x4 lo = __builtin_amdgcn_ds_read_tr16_b64_v4i16((LAS s16x4*)a0), hi = __builtin_amdgcn_ds_read_tr16_b64_v4i16((LAS s16x4*)a1);
    return (bf16x8){lo[0], lo[1], lo[2], lo[3], hi[0], hi[1], hi[2], hi[3]};
}
__device__ __forceinline__ f32x4 mfma16(bf16x8 a, bf16x8 b, f32x4 c) { return __builtin_amdgcn_mfma_f32_16x16x32_bf16(a, b, c, 0, 0, 0); }
__device__ __forceinline__ float log_sigmoid(float x) { return fminf(x, 0.f) - __logf(1.f + __expf(-fabsf(x))); }

__device__ __forceinline__ void gate_prep(int gw, int ngw, int lane, const float* __restrict__ GATES, const float* __restrict__ bgl, float* __restrict__ GP) {
    for (int it = gw; it < 96 * 65; it += ngw) {
        const int chain = it / 65, c = it % 65, s = chain >> 3, hd = (chain >> 1) & 3, dir = chain & 1;
        const long g = c == 0 ? (lane >= 48 ? (long)MROW0 + 16 * s + lane - 48 : -1L) : (long)s * LREAL + 64 * (c - 1) + lane;
        float li = NEGBIG, lf = 0.f;
        if (g >= 0) { li = GATES[g * 16 + (dir ? 8 : 0) + hd] + bgl[(dir ? 8 : 0) + hd]; lf = log_sigmoid(GATES[g * 16 + (dir ? 12 : 4) + hd] + bgl[(dir ? 12 : 4) + hd]); }
        float x = dir ? __shfl(lf, 63 - lane) : lf;
#pragma unroll
        for (int o = 1; o < 64; o <<= 1) { const float y = __shfl_up(x, o); if (lane >= o) x += y; }
        const float btot = __shfl(x, 63);
        const float b = dir ? __shfl(x, 63 - lane) : x;
        const float a_s = li - b;
        float pm = dir ? __shfl(a_s, 63 - lane) : a_s;
#pragma unroll
        for (int o = 1; o < 64; o <<= 1) { const float y = __shfl_up(pm, o); if (lane >= o) pm = fmaxf(pm, y); }
        pm = dir ? __shfl(pm, 63 - lane) : pm;
        const float gmax = wave_max(btot - b + li);
        float* rec = GP + (size_t)it * GP_REC;
        rec[lane] = b; rec[64 + lane] = li; rec[128 + lane] = pm; if (lane == 0) { rec[192] = btot; rec[193] = gmax; }
    }
}

__device__ __forceinline__ void mlstm_unit(int s, int hd, int js, const bf16_t* __restrict__ UQKVO, const float* __restrict__ GP, float* __restrict__ HSUM, LAS unsigned char* lds, LAS float* sc) {
    const int wid = __builtin_amdgcn_readfirstlane((int)threadIdx.x >> 6);
    const unsigned ldsb = (unsigned)(uintptr_t)lds;
    const int tt = wid >> 1, nb = 2 * (wid & 1);
#define ROWRD(img, rb, s_) (*(const LAS bf16x8*)(uintptr_t)(RB[s_] + (unsigned)((img) + 4096 * (rb))))
#define TRFRAG(img, c_, ks) tr_frag(BT[0][(c_) & 1] + TQ[(c_) >> 1] + (unsigned)((img) + 8192 * (ks)), BT[1][(c_) & 1] + TQ[(c_) >> 1] + (unsigned)((img) + 8192 * (ks)))
    f32x4 accC[2][4], accN[2];
    for (int dir = 0; dir < 2; ++dir) {
        int tid; { int t0_ = threadIdx.x; asm volatile("" : "+v"(t0_)); tid = t0_; }
#pragma unroll
        for (int mi = 0; mi < 2; ++mi)
#pragma unroll
            for (int c = 0; c < 4; ++c) accC[mi][c] = (f32x4){0.f, 0.f, 0.f, 0.f};
        accN[0] = (f32x4){0.f, 0.f, 0.f, 0.f}; accN[1] = (f32x4){0.f, 0.f, 0.f, 0.f};
        if (tid < 256) sc[SC_N + tid] = 0.f;
        for (int i = tid; i < 32768 / 16; i += 512) *(LAS u32x4*)(lds + CI + i * 16) = (u32x4){0u, 0u, 0u, 0u};
        float m_state = 0.f;
        const float* GPc = GP + (size_t)(((s * 4 + hd) * 2 + dir) * 65) * GP_REC;
        u32x4 sq[4], sk[4], sv; float sb = 0.f, sli = NEGBIG, spm = NEGBIG, sbt = 0.f, sgm = NEGBIG;
#define ROWG(c, r) ((c) == 0 ? ((r) >= 48 ? (long)MROW0 + 16 * s + (r) - 48 : -1L) : (long)s * LREAL + 64 * ((c) - 1) + (r))
#define STAGE_LOAD(c) do { \
        _Pragma("unroll") for (int i = 0; i < 4; ++i) { const int id = tid + 512 * i, r = id >> 5, ch = id & 31; const long g = ROWG(c, r); \
            sq[i] = (u32x4){0u, 0u, 0u, 0u}; sk[i] = (u32x4){0u, 0u, 0u, 0u}; \
            if (g >= 0) { sq[i] = *(const u32x4*)(UQKVO + g * 4096 + hd * 256 + ch * 8); sk[i] = *(const u32x4*)(UQKVO + g * 4096 + 1024 + hd * 256 + ch * 8); } } \
        { const int r = tid >> 3, ch = tid & 7; const long g = ROWG(c, r); sv = (u32x4){0u, 0u, 0u, 0u}; if (g >= 0) sv = *(const u32x4*)(UQKVO + g * 4096 + 2048 + hd * 256 + js * 64 + ch * 8); } \
        if (tid < 64) { const float* rec = GPc + (size_t)(c) * GP_REC; sb = rec[tid]; sli = rec[64 + tid]; spm = rec[128 + tid]; sbt = rec[192]; sgm = rec[193]; } } while (0)
#define STAGE_WRITE() do { \
        _Pragma("unroll") for (int i = 0; i < 4; ++i) { const int id = tid + 512 * i, r = id >> 5, ch = id & 31; \
            *(LAS u32x4*)(lds + QI + (ch >> 4) * 16384 + off_b(r, ch & 15)) = sq[i]; *(LAS u32x4*)(lds + KI + (ch >> 4) * 16384 + off_b(r, ch & 15)) = sk[i]; } \
        { const int r = tid >> 3, ch = tid & 7; *(LAS u32x4*)(lds + VI + off_b(r, ch)) = sv; } \
        if (tid < 64) { const float m_inter = sb + m_state, mt = fmaxf(m_inter, sb + spm); const float m_new = fmaxf(sbt + m_state, sgm); \
            sc[SC_CT + tid] = sli - sb; sc[SC_BM + tid] = sb - mt; sc[SC_WI + tid] = __expf(m_inter - mt); sc[SC_EI + tid] = __expf(-mt); \
            sc[SC_WW + tid] = __expf(sbt - sb + sli - m_new) * 0.0625f; if (tid == 0) sc[SC_A] = __expf(sbt + m_state - m_new); m_state = m_new; } } while (0)
        const int c_first = dir ? 64 : 0, c_step = dir ? -1 : 1;
        STAGE_LOAD(c_first);
        __syncthreads();
        STAGE_WRITE();
        for (int ci = 0; ci < 65; ++ci) {
            const int c = c_first + c_step * ci;
            { int t2_ = threadIdx.x; asm volatile("" : "+v"(t2_)); tid = t2_; }
            const int lane = tid & 63, l15 = lane & 15, lg = lane >> 4;
            unsigned RB[4], BT[2][2], TQ[4];
            { const unsigned fl = ((l15 & 3) << 2) | (l15 >> 2), q = l15 >> 2, p = lane & 3, g = lg;
#pragma unroll
              for (int s_ = 0; s_ < 4; ++s_) { RB[s_] = ldsb + 256u * l15 + 16u * (lg ^ (fl & 3)) + 64u * (s_ ^ (fl >> 2)); TQ[s_] = 64u * (s_ ^ q); }
#pragma unroll
              for (int t_ = 0; t_ < 2; ++t_)
#pragma unroll
                  for (int cl = 0; cl < 2; ++cl) BT[t_][cl] = ldsb + 256u * (8 * g + q) + 8u * (p & 1) + 1024u * t_ + 16u * ((p >> 1) ^ t_) + 32u * (cl ^ (g & 1)); }
            __syncthreads();
            if (ci + 1 < 65) STAGE_LOAD(c + c_step);
            bf16x8 qf[8];
#pragma unroll
            for (int k = 0; k < 8; ++k) qf[k] = ROWRD(QI + (k >> 2) * 16384, tt, k & 3);
            f32x4 sT[2], oc[2];
#pragma unroll
            for (int i = 0; i < 2; ++i) { sT[i] = (f32x4){0.f, 0.f, 0.f, 0.f}; oc[i] = (f32x4){0.f, 0.f, 0.f, 0.f}; }
#pragma unroll
            for (int i = 0; i < 2; ++i)
#pragma unroll
                for (int k = 0; k < 8; ++k) {
                    const bf16x8 kf = ROWRD(KI + (k >> 2) * 16384, nb + i, k & 3);
                    sT[i] = mfma16(kf, qf[k], sT[i]);
                    const bf16x8 cf = ROWRD(CI + (k >> 2) * 16384, nb + i, k & 3);
                    oc[i] = mfma16(qf[k], cf, oc[i]);
                }
            {
                const int t = 16 * tt + l15; const float bmt = sc[SC_BM + t]; float rs = 0.f;
#pragma unroll
                for (int i = 0; i < 2; ++i) { const int s0 = 16 * (nb + i) + 4 * lg; const f32x4 ctv = *(const LAS f32x4*)(sc + SC_CT + s0); float v[4];
#pragma unroll
                    for (int e = 0; e < 4; ++e) { const int sx = s0 + e; const bool ok = dir ? (sx >= t) : (sx <= t);
                        const float ex = ok ? (bmt + ctv[e]) : NEGBIG; v[e] = sT[i][e] * 0.0625f * __expf(ex); rs += v[e]; }
                    u32x2 w; w.x = pk2(v[0], v[1]); w.y = pk2(v[2], v[3]);
                    *(LAS u32x2*)(lds + SI + off_b(t, s0 >> 3) + (s0 & 7) * 2) = w; }
                rs += __shfl_xor(rs, 16); rs += __shfl_xor(rs, 32);
                if (lg == 0) sc[SC_DEN + 64 * (wid & 1) + t] = rs;
            }
            { const int r = tid >> 3, ch = tid & 7; const u32x4 v = *(const LAS u32x4*)(lds + VI + off_b(r, ch)); const float w = sc[SC_WW + r]; u32x4 o;
#pragma unroll
              for (int jx = 0; jx < 4; ++jx) o[jx] = pk2(bf_lo(v[jx]) * w, bf_hi(v[jx]) * w);
              *(LAS u32x4*)(lds + VI + off_b(r, 8 + ch)) = o; }
            { const int r = tid >> 3, part = tid & 7; float d = 0.f;
#pragma unroll
              for (int i = 0; i < 4; ++i) { const int ch32 = part * 4 + i; const u32x4 v = *(const LAS u32x4*)(lds + QI + (ch32 >> 4) * 16384 + off_b(r, ch32 & 15));
                  const f32x4 n0 = *(const LAS f32x4*)(sc + SC_N + ch32 * 8), n1 = *(const LAS f32x4*)(sc + SC_N + ch32 * 8 + 4);
                  d += bf_lo(v[0]) * n0[0] + bf_hi(v[0]) * n0[1] + bf_lo(v[1]) * n0[2] + bf_hi(v[1]) * n0[3] + bf_lo(v[2]) * n1[0] + bf_hi(v[2]) * n1[1] + bf_lo(v[3]) * n1[2] + bf_hi(v[3]) * n1[3]; }
              d += __shfl_xor(d, 1); d += __shfl_xor(d, 2); d += __shfl_xor(d, 4);
              if (part == 0) sc[SC_QN + r] = d; }
            { const f32x4 wi = *(const LAS f32x4*)(sc + SC_WI + 16 * tt + 4 * lg);
#pragma unroll
              for (int i = 0; i < 2; ++i) oc[i] = oc[i] * wi; }
            __syncthreads();
            const float a_dec = sc[SC_A];
#pragma unroll
            for (int ks = 0; ks < 2; ++ks) { const bf16x8 sf = ROWRD(SI, tt, ks);
#pragma unroll
                for (int i = 0; i < 2; ++i) { const bf16x8 vf = TRFRAG(VI, nb + i, ks);
                    oc[i] = mfma16(sf, vf, oc[i]); } }
            { const int t0 = 16 * tt + 4 * lg;
              const f32x4 wi = *(const LAS f32x4*)(sc + SC_WI + t0), qn = *(const LAS f32x4*)(sc + SC_QN + t0), d0 = *(const LAS f32x4*)(sc + SC_DEN + t0), d1 = *(const LAS f32x4*)(sc + SC_DEN + 64 + t0), ei = *(const LAS f32x4*)(sc + SC_EI + t0);
#pragma unroll
              for (int e = 0; e < 4; ++e) { const long g = ROWG(c, t0 + e);
                const float den = wi[e] * qn[e] + (d0[e] + d1[e]); const float inv = 1.f / fmaxf(fabsf(den), ei[e]);
                if (g >= 0) {
#pragma unroll
                    for (int i = 0; i < 2; ++i) { float* hp = HSUM + g * MLW + hd * 256 + js * 64 + 16 * (nb + i) + l15; const float hv = oc[i][e] * inv; if (dir) unsafeAtomicAdd(hp, hv); else *hp = hv; } } } }
#pragma unroll
            for (int mi = 0; mi < 2; ++mi)
#pragma unroll
                for (int cc = 0; cc < 4; ++cc) accC[mi][cc] = accC[mi][cc] * a_dec;
            accN[0] = accN[0] * a_dec; accN[1] = accN[1] * a_dec;
            const unsigned ktq = (unsigned)(KI + (wid >> 2) * 16384) + 64u * ((unsigned)(wid & 3) ^ (unsigned)(l15 >> 2));
#pragma unroll
            for (int ks = 0; ks < 2; ++ks) {
                bf16x8 kf[2], wf[4];
#pragma unroll
                for (int mi = 0; mi < 2; ++mi) kf[mi] = tr_frag(BT[0][mi] + ktq + (unsigned)(8192 * ks), BT[1][mi] + ktq + (unsigned)(8192 * ks));
#pragma unroll
                for (int cc = 0; cc < 4; ++cc) wf[cc] = TRFRAG(VI, 4 + cc, ks);
                { const f32x4 wa = *(const LAS f32x4*)(sc + SC_WW + 32 * ks + 8 * lg), wb = *(const LAS f32x4*)(sc + SC_WW + 32 * ks + 8 * lg + 4);
                  u32x4 wq; wq.x = pk2(wa[0], wa[1]); wq.y = pk2(wa[2], wa[3]); wq.z = pk2(wb[0], wb[1]); wq.w = pk2(wb[2], wb[3]);
                  if (l15 != 0) wq = (u32x4){0u, 0u, 0u, 0u};
                  const bf16x8 wfn = __builtin_bit_cast(bf16x8, wq);
#pragma unroll
                  for (int mi = 0; mi < 2; ++mi) accN[mi] = mfma16(kf[mi], wfn, accN[mi]); }
#pragma unroll
                for (int mi = 0; mi < 2; ++mi)
#pragma unroll
                    for (int cc = 0; cc < 4; ++cc) accC[mi][cc] = mfma16(kf[mi], wf[cc], accC[mi][cc]);
            }
#pragma unroll
            for (int mi = 0; mi < 2; ++mi)
#pragma unroll
                for (int cc = 0; cc < 4; ++cc) { const int dk0 = 32 * wid + 16 * mi + 4 * lg, dv = 16 * cc + l15; u32x2 w; w.x = pk2(accC[mi][cc][0], accC[mi][cc][1]); w.y = pk2(accC[mi][cc][2], accC[mi][cc][3]);
                    *(LAS u32x2*)(lds + CI + (dk0 >> 7) * 16384 + off_b(dv, (dk0 & 127) >> 3) + (dk0 & 7) * 2) = w; }
            if (l15 == 0) { *(LAS f32x4*)(sc + SC_N + 32 * wid + 4 * lg) = accN[0]; *(LAS f32x4*)(sc + SC_N + 32 * wid + 16 + 4 * lg) = accN[1]; }
            __syncthreads();
            if (ci + 1 < 65) STAGE_WRITE();
        }
    }
#undef ROWG
#undef STAGE_LOAD
#undef STAGE_WRITE
#undef ROWRD
#undef TRFRAG
}
__device__ __forceinline__ void mlstm_phase(int bx, const bf16_t* UQKVO, const float* GP, float* HSUM, LAS unsigned char* lds, LAS float* sc) {
    if (bx >= 192) return;
    const int xcd = bx & 7, idx = bx >> 3, pair = xcd * 6 + (idx >> 2), js = idx & 3;
    mlstm_unit(pair >> 2, pair & 3, js, UQKVO, GP, HSUM, lds, sc);
}
}

#ifndef PHM
#define PHM 0xffff
#endif
#ifndef REP_ML
#define REP_ML 1
#endif
#ifndef REP_ATTN
#define REP_ATTN 1
#endif
#ifndef REP_CONV
#define REP_CONV 1
#endif
#ifndef REP_SMALL
#define REP_SMALL 1
#endif
#ifndef KV_SPLIT
#define KV_SPLIT 193
#endif
#ifndef REP_WIN
#define REP_WIN 1
#endif
#ifndef REP_UP
#define REP_UP 1
#endif
__global__ void __launch_bounds__(512, 2) fwd_kernel(Params P, unsigned char* ws_arg, unsigned char* out_arg) {
    extern __shared__ __attribute__((aligned(16))) unsigned char lds_raw[];
    Frame F;
    F.lds = (LAS unsigned char*)lds_raw;
    F.tid = threadIdx.x; F.lane = F.tid & 63; F.wave = __builtin_amdgcn_readfirstlane(F.tid >> 6);
    F.G = GRID; F.bx = blockIdx.x; F.vcu = (F.bx % 8) * (GRID / 8) + F.bx / 8;
    F.gw = F.vcu * 8 + F.wave; F.ngw = F.G * 8;
    { unsigned char* ws0 = ws_arg;
      for (int u = F.tid; u < (LDS_BYTES - MISC_OFF) / 4; u += 512) ((LAS unsigned*)(F.lds + MISC_OFF))[u] = 0u;
      __syncthreads();
      (void)ws0; }
    LAS unsigned long long* ptab = (LAS unsigned long long*)(F.lds + MISC_OFF + 64);
    if (F.tid == 0) {
#pragma unroll
        for (int k = 0; k < 19; ++k) ptab[k] = (unsigned long long)(uintptr_t)P.in[k]; }
    __syncthreads();
    XcdBarrier bar = xcd_barrier_post((unsigned*)(ws_arg + WS_CTL) + CW_BAR, (volatile LAS unsigned*)(F.lds + MISC_OFF));
    LAS float* sc = (LAS float*)(F.lds + MISC_OFF + 1024);
#define BXL() ({ int b__ = F.bx; asm volatile("" : "+s"(b__)); b__; })
#define PFRAME() Frame Fp = F; { int t_ = threadIdx.x; asm volatile("" : "+v"(t_)); Fp.tid = t_; Fp.lane = t_ & 63; int b_ = BXL(); Fp.bx = b_; Fp.vcu = (b_ % 8) * (GRID / 8) + b_ / 8; Fp.gw = Fp.vcu * 8 + Fp.wave; }
#define WSB() ({ GAS unsigned char* w__ = (GAS unsigned char*)ws_arg; asm volatile("" : "+s"(w__)); (unsigned char*)w__; })
#ifndef STAG_N
#define STAG_N 1
#endif
#ifdef STAG_ON
#define STAGGER() do { int s__ = (BXL() * 37) & 255; for (int i__ = 0; i__ < s__; ++i__) __builtin_amdgcn_s_sleep(STAG_N); } while (0)
#else
#define STAGGER() do {} while (0)
#endif
#define DOB() ({ GAS unsigned char* w__ = (GAS unsigned char*)out_arg; asm volatile("" : "+s"(w__)); (unsigned char*)w__; })

    { unsigned char* ws = WSB(); prologue(F, ws, ptab); convert_weights(F, ws, ptab, 0); }
    xcd_barrier(bar);

    for (int l = 0; l < DEPTH; ++l) {
        { unsigned char* ws = WSB();
          pg8::Gemm g{(bf16_t*)(ws + WS_HB), (bf16_t*)(ws + WS_WIN), TP, NIN, DM, DM}; pg8::PanelOrder S; S.init(NPAN, 0, 0, 0, NIN, F.G, BXL());
          pg8::EpiWin E{(bf16_t*)(ws + WS_UQKVO), (bf16_t*)(ws + WS_UDQ), (bf16_t*)(ws + WS_UDKV), (bf16_t*)(ws + WS_KR), (float*)(ws + WS_GATES), (const float*)(ws + WS_COS), (const float*)(ws + WS_SIN)};
#if PHM & 2
          STAGGER(); pg8::gemm_phase<pg8::EpiWin, pg8::PanelOrder, true, true>(F.lds, g, S, E);
#endif
        }
#if REP_WIN > 1
        __syncthreads();
        { unsigned char* ws = WSB();
          pg8::Gemm g{(bf16_t*)(ws + WS_HB), (bf16_t*)(ws + WS_WIN), TP, NIN, DM, DM}; pg8::PanelOrder S; S.init(NPAN, 0, 0, 0, NIN, F.G, BXL());
          pg8::EpiWin E{(bf16_t*)(ws + WS_UQKVO), (bf16_t*)(ws + WS_UDQ), (bf16_t*)(ws + WS_UDKV), (bf16_t*)(ws + WS_KR), (float*)(ws + WS_GATES), (const float*)(ws + WS_COS), (const float*)(ws + WS_SIN)};
          pg8::gemm_phase<pg8::EpiWin, pg8::PanelOrder, true, true>(F.lds, g, S, E);
        }
#endif
        xcd_barrier(bar);
        { unsigned char* ws = WSB(); unsigned char* dob = DOB(); PFRAME(); rstd_rows(Fp, (bf16_t*)(ws + WS_UDQ), (bf16_t*)(ws + WS_UDKV), (float*)(ws + WS_RSTD));
          ml::gate_prep(Fp.gw, Fp.ngw, Fp.lane, (const float*)(ws + WS_GATES), (const float*)(ws + WS_PAR) + PO_BG + l * 16, (float*)(dob + DO_GP)); }
#if REP_SMALL > 1
        { unsigned char* ws = WSB(); unsigned char* dob = DOB(); PFRAME(); rstd_rows(Fp, (bf16_t*)(ws + WS_UDQ), (bf16_t*)(ws + WS_UDKV), (float*)(ws + WS_RSTD));
          ml::gate_prep(Fp.gw, Fp.ngw, Fp.lane, (const float*)(ws + WS_GATES), (const float*)(ws + WS_PAR) + PO_BG + l * 16, (float*)(dob + DO_GP)); }
#endif
        xcd_barrier(bar);
        if (F.bx >= 192) {
        { unsigned char* ws = WSB(); unsigned char* dob = DOB();
          pg8::Gemm g{(bf16_t*)(ws + WS_UDQ), (bf16_t*)(ws + WS_WUQ), TP, NQ, 512, 512}; pg8::PanelOrder S; S.init(NPAN, 0, 0, 0, NQ, GRID - 192, BXL() - 192);
          pg8::EpiQ E{(bf16_t*)(dob + DO_MQ), (const float*)(ws + WS_RSTD), (const float*)(ws + WS_COS), (const float*)(ws + WS_SIN)};
#if PHM & 4
          pg8::gemm_phase<pg8::EpiQ, pg8::PanelOrder, true, true>(F.lds, g, S, E);
#endif
        }
        { unsigned char* ws = WSB();
          pg8::Gemm g{(bf16_t*)(ws + WS_UDKV), (bf16_t*)(ws + WS_WUKV), TP, NKV, 256, 256}; pg8::PanelOrder S; S.init(NPAN, 0, 0, 0, NKV, GRID - 192, BXL() - 192);
          pg8::EpiBf16G E{(bf16_t*)(ws + WS_MKV), NKV, (const float*)(ws + WS_RSTD) + 1, 0, -1, 0};
#if PHM & 8
          pg8::gemm_phase<pg8::EpiBf16G, pg8::PanelOrder, true, true>(F.lds, g, S, E);
#endif
        }
        } else {
#ifndef NO_ML
        for (int rep_ = 0; rep_ < REP_ML; ++rep_)
        { unsigned char* ws = WSB(); unsigned char* dob = DOB();
          ml::mlstm_phase(BXL(), (const bf16_t*)(ws + WS_UQKVO), (const float*)(dob + DO_GP), (float*)(dob + DO_HSUM), F.lds, sc); }
#endif
        }
        xcd_barrier(bar);
        { unsigned char* ws = WSB(); unsigned char* dob = DOB(); PFRAME();
          if (Fp.vcu >= 96) mlstm_finalize(Fp, (Fp.vcu - 96) * 8 + Fp.wave, (GRID - 96) * 8, (const float*)(dob + DO_HSUM), (const bf16_t*)(ws + WS_UQKVO), (const float*)(ws + WS_PAR) + PO_MLG + l * MLW, (bf16_t*)(ws + WS_HB)); }
#ifndef NO_ATTN
        for (int rep_ = 0; rep_ < REP_ATTN; ++rep_)
        { unsigned char* ws = WSB(); unsigned char* dob = DOB();
          att::attn_phase(({ int b__ = BXL(); (b__ % 8) * (GRID / 8) + b__ / 8; }), (const bf16_t*)(dob + DO_MQ), (const bf16_t*)(ws + WS_MKV), (const bf16_t*)(ws + WS_KR), (bf16_t*)(ws + WS_HB), (LAS char*)F.lds); }
#endif
        xcd_barrier(bar);
        { unsigned char* ws = WSB();
          pg8::Gemm g{(bf16_t*)(ws + WS_HB), (bf16_t*)(ws + WS_WOUT), TP, DM, DM, DM}; pg8::PanelOrder S; S.init(192, 0, 0, 0, DM, F.G, BXL());
          pg8::EpiResidLn E{(bf16_t*)(ws + WS_H), DM, ALPHA, (const float*)(ws + WS_STAT2), (const float*)(ws + WS_PAR) + (l > 0 ? PO_L2G + (l - 1) * DM : PO_ONE), (const float*)(ws + WS_PAR) + (l > 0 ? PO_L2B + (l - 1) * DM : PO_ZERO)};
#if PHM & 16
          STAGGER(); pg8::gemm_phase<pg8::EpiResidLn, pg8::PanelOrder, true, true>(F.lds, g, S, E);
#endif
        }
        { unsigned char* ws = WSB();
          pg8::Gemm g{(bf16_t*)(ws + WS_HB), (bf16_t*)(ws + WS_WOUT), TP, DM, DM / 4, DM}; pg8::SplitOrder S; S.init(PMETA, DM, 4, F.G, BXL());
          pg8::EpiPart E{(float*)(ws + WS_PART), DM};
#if PHM & 16
          pg8::gemm_phase<pg8::EpiPart, pg8::SplitOrder, true, true>(F.lds, g, S, E);
#endif
        }
        xcd_barrier(bar);
        { unsigned char* ws = WSB(); PFRAME(); ln_rows(Fp, (float*)(ws + WS_H), (bf16_t*)(ws + WS_HB), (const float*)(ws + WS_PAR) + PO_L1G + l * DM, (const float*)(ws + WS_PAR) + PO_L1B + l * DM, (float*)(ws + WS_STAT1), nullptr, (const float*)(ws + WS_PART), 4); }
        xcd_barrier(bar);
        { unsigned char* ws = WSB(); unsigned char* dob = DOB();
          pg8::Gemm g{(bf16_t*)(ws + WS_HB), (bf16_t*)(ws + WS_WUP), TP, NUP, DM, DM}; pg8::PanelOrder S; S.init(NPAN, 0, 0, 0, NUP, F.G, BXL());
          pg8::EpiFfn E{(bf16_t*)(ws + WS_ACT), (float*)(dob + DO_SIDE), (bf16_t*)(dob + DO_GVM), (const float*)(ws + WS_PAR) + PO_CW + (size_t)l * 3 * DFF, (const float*)(ws + WS_PAR) + PO_CB + (size_t)l * DFF, (LAS float*)(F.lds + MISC_OFF + 8192)};
#if PHM & 32
          STAGGER(); pg8::gemm_phase<pg8::EpiFfn, pg8::PanelOrder, true, true>(F.lds, g, S, E);
#if REP_UP > 1
          __syncthreads(); pg8::gemm_phase<pg8::EpiFfn, pg8::PanelOrder, true, true>(F.lds, g, S, E);
#endif
#endif
        }
        xcd_barrier(bar);
        { unsigned char* ws = WSB(); unsigned char* dob = DOB(); PFRAME();
          ffn_fixup(Fp, (const float*)(dob + DO_SIDE), (const bf16_t*)(dob + DO_GVM), (bf16_t*)(ws + WS_ACT), (const float*)(ws + WS_PAR) + PO_CW + (size_t)l * 3 * DFF, (const float*)(ws + WS_PAR) + PO_CB + (size_t)l * DFF); }
#if REP_SMALL > 1
        { unsigned char* ws = WSB(); unsigned char* dob = DOB(); PFRAME();
          ffn_fixup(Fp, (const float*)(dob + DO_SIDE), (const bf16_t*)(dob + DO_GVM), (bf16_t*)(ws + WS_ACT), (const float*)(ws + WS_PAR) + PO_CW + (size_t)l * 3 * DFF, (const float*)(ws + WS_PAR) + PO_CB + (size_t)l * DFF); }
#endif
        xcd_barrier(bar);
        { unsigned char* ws = WSB();
          pg8::Gemm g{(bf16_t*)(ws + WS_ACT), (bf16_t*)(ws + WS_WDN), TP, DM, DFF, DFF}; pg8::PanelOrder S; S.init(192, 0, 0, 0, DM, F.G, BXL());
          pg8::EpiResidLn E{(bf16_t*)(ws + WS_H), DM, ALPHA, (const float*)(ws + WS_STAT1), (const float*)(ws + WS_PAR) + PO_L1G + l * DM, (const float*)(ws + WS_PAR) + PO_L1B + l * DM};
#if PHM & 64
          STAGGER(); pg8::gemm_phase<pg8::EpiResidLn, pg8::PanelOrder, true, true>(F.lds, g, S, E);
#endif
        }
        { unsigned char* ws = WSB();
          pg8::Gemm g{(bf16_t*)(ws + WS_ACT), (bf16_t*)(ws + WS_WDN), TP, DM, DFF / 11, DFF}; pg8::SplitOrder S; S.init(PMETA, DM, 11, F.G, BXL());
          pg8::EpiPart E{(float*)(ws + WS_PART), DM};
#if PHM & 64
          pg8::gemm_phase<pg8::EpiPart, pg8::SplitOrder, true, true>(F.lds, g, S, E);
#endif
        }
        xcd_barrier(bar);
        { unsigned char* ws = WSB(); unsigned char* dob = DOB();
          PFRAME(); ln_rows(Fp, (float*)(ws + WS_H), (bf16_t*)(ws + WS_HB), (const float*)(ws + WS_PAR) + PO_L2G + l * DM, (const float*)(ws + WS_PAR) + PO_L2B + l * DM, (float*)(ws + WS_STAT2), l == DEPTH - 1 ? (float*)dob : nullptr, (const float*)(ws + WS_PART), 11); }
        if (l + 1 < DEPTH) { unsigned char* ws = WSB(); PFRAME(); convert_weights(Fp, ws, ptab, l + 1); }
#if REP_CONV > 1
        if (l + 1 < DEPTH) { __syncthreads(); unsigned char* ws = WSB(); PFRAME(); convert_weights(Fp, ws, ptab, l + 1); }
#endif
        xcd_barrier(bar);
    }
}

extern "C" void kernel_launch(void* const* d_in, const int* in_sizes, int n_in, void* d_out, int out_size, void* d_ws, size_t ws_size, hipStream_t stream) {
    static int grid = 0;
    if (grid == 0) {
        if (n_in != 19 || out_size != NMAIN * DM || ws_size < WS_NEED) { fprintf(stderr, "kernel_launch: unexpected shapes (n_in %d out %d ws %zu need %zu)\n", n_in, out_size, ws_size, (size_t)WS_NEED); grid = -1; return; }
        int dev = 0, cus = 0;
        if (hipGetDevice(&dev) != hipSuccess || hipDeviceGetAttribute(&cus, hipDeviceAttributeMultiprocessorCount, dev) != hipSuccess) { grid = -1; return; }
        if (hipFuncSetAttribute((const void*)fwd_kernel, hipFuncAttributeMaxDynamicSharedMemorySize, LDS_BYTES) != hipSuccess) { fprintf(stderr, "kernel_launch: hipFuncSetAttribute failed\n"); grid = -1; return; }
        int per_cu = 0;
        if (hipOccupancyMaxActiveBlocksPerMultiprocessor(&per_cu, (const void*)fwd_kernel, 512, LDS_BYTES) != hipSuccess || per_cu < 1) { fprintf(stderr, "kernel_launch: occupancy query says %d blocks per CU\n", per_cu); (void)hipGetLastError(); grid = -1; return; }
        if (cus < GRID) { fprintf(stderr, "kernel_launch: needs %d CUs, device has %d\n", GRID, cus); grid = -1; return; }
        grid = GRID;
    }
    if (grid < 0) return;
    (void)hipMemsetAsync((char*)d_ws + WS_CTL, 0, CTL_BYTES, stream);
    Params p{};
    for (int i = 0; i < 19; ++i) p.in[i] = (const float*)d_in[i];
    hipLaunchKernelGGL(fwd_kernel, dim3(grid), dim3(512), LDS_BYTES, stream, p, (unsigned char*)d_ws, (unsigned char*)d_out);
}
```

```cpp
#include <hip/hip_runtime.h>
#include <cstdio>
#include <cstdint>

#define LAS __attribute__((address_space(3)))
#define GAS __attribute__((address_space(1)))
typedef float f32x2 __attribute__((ext_vector_type(2)));
typedef float f32x8 __attribute__((ext_vector_type(8)));
typedef float f32x16 __attribute__((ext_vector_type(16)));
typedef unsigned u32x2 __attribute__((ext_vector_type(2)));
typedef short s16x4 __attribute__((ext_vector_type(4)));
typedef __bf16 bf16x2v __attribute__((ext_vector_type(2)));

constexpr int DM = 2048, NSEQ = 12, LREAL = 4096, NMETA = 16, DEPTH = 4;
constexpr int NMAIN = NSEQ * LREAL;
constexpr int MROW0 = NMAIN;
constexpr int NTOK = NMAIN + NSEQ * NMETA;
constexpr int NPAN = 193, TP = NPAN * 256;
constexpr int PMETA = 192;
constexpr int INC = 4944, NIN = 5120;
constexpr int DFF = 5632, NUP = 2 * DFF;
constexpr int MLW = 1024, NQ = 1536, NKV = 2048;
constexpr float ALPHA = 1.681792830507429f;
constexpr float EPS = 1e-5f;
constexpr float NEGBIG = -1e30f;

constexpr size_t MiB = 1u << 20;
constexpr size_t WS_CTL = 0, CTL_BYTES = 1 * MiB;
constexpr size_t WS_COS = 1 * MiB;
constexpr size_t WS_SIN = WS_COS + (size_t)4112 * 32 * 4;
constexpr size_t WS_PAR = 2 * MiB + 128 * 1024;
constexpr int PO_BG = 0, PO_MLG = PO_BG + DEPTH * 16, PO_QG = PO_MLG + DEPTH * 1024, PO_KVG = PO_QG + DEPTH * 512, PO_L1G = PO_KVG + DEPTH * 256, PO_L1B = PO_L1G + DEPTH * 2048,
              PO_CW = PO_L1B + DEPTH * 2048, PO_CB = PO_CW + DEPTH * 3 * 5632, PO_L2G = PO_CB + DEPTH * 5632, PO_L2B = PO_L2G + DEPTH * 2048, PO_ONE = PO_L2B + DEPTH * 2048, PO_ZERO = PO_ONE + 2048, PO_END = PO_ZERO + 2048;
static_assert(WS_PAR + (size_t)PO_END * 4 <= 3 * MiB && WS_PAR >= 1 * MiB + 2 * 4112 * 32 * 4, "PAR block placement");
constexpr size_t WS_WIN = 3 * MiB;
constexpr size_t WS_WUQ = WS_WIN + (size_t)NIN * DM * 2;
constexpr size_t WS_WUKV = WS_WUQ + (size_t)NQ * 512 * 2;
constexpr size_t WS_WOUT = WS_WUKV + (size_t)NKV * 256 * 2;
constexpr size_t WS_WUP = WS_WOUT + (size_t)DM * DM * 2;
constexpr size_t WS_WDN = WS_WUP + (size_t)NUP * DM * 2;
constexpr size_t WS_STAT1 = WS_WDN + (size_t)DM * DFF * 2;
constexpr size_t WS_STAT2 = WS_CTL + 512 * 1024;
constexpr size_t WS_H = 100 * MiB;
constexpr size_t WS_PART = WS_H + 208 * MiB;
static_assert((size_t)NMAIN * DM * 2 <= 208 * MiB && 208 * MiB + (size_t)11 * 256 * DM * 4 <= (size_t)NMAIN * DM * 4, "PART sits between the bf16 rows and the f32 meta rows of H");
constexpr size_t WS_HB = WS_H + (size_t)TP * DM * 4;
constexpr size_t WS_R = WS_HB + (size_t)TP * DM * 2;
constexpr size_t WS_UQKVO = WS_R;
constexpr size_t WS_UDQ = WS_UQKVO + (size_t)TP * 4096 * 2;
constexpr size_t WS_UDKV = WS_UDQ + (size_t)TP * 512 * 2;
constexpr size_t WS_GATES = WS_UDKV + (size_t)TP * 256 * 2;
constexpr size_t WS_MKV = WS_GATES + (size_t)TP * 16 * 4;
constexpr size_t WS_KR = WS_MKV + (size_t)TP * NKV * 2;
constexpr size_t WS_RSTD = WS_KR + (size_t)TP * 64 * 2;
constexpr size_t WS_END_A = WS_RSTD + (size_t)TP * 2 * 4;
constexpr size_t WS_ACT = WS_R;
constexpr size_t WS_END_B = WS_ACT + (size_t)TP * DFF * 2;
constexpr size_t WS_NEED = (WS_END_A > WS_END_B ? WS_END_A : WS_END_B);
static_assert(WS_STAT1 + (size_t)TP * 8 <= WS_H && WS_STAT2 + (size_t)TP * 8 <= WS_CTL + CTL_BYTES, "weights and row statistics fit below H");
constexpr size_t DO_HSUM = 0;
constexpr size_t DO_MQ = DO_HSUM + (size_t)TP * MLW * 4;
constexpr size_t DO_GP = 340 * MiB;
constexpr size_t DO_SIDE = 0;
constexpr size_t DO_GVM = 32 * MiB;
static_assert(DO_MQ + (size_t)TP * NQ * 2 <= DO_GP && DO_GP + (size_t)96 * 65 * 200 * 4 <= (size_t)NMAIN * DM * 4 && (size_t)192 * 6 * DFF * 4 <= DO_GVM && DO_GVM + (size_t)256 * NUP * 2 <= (size_t)NMAIN * DM * 4, "d_out scratch fits");
constexpr int CW_BAR = 4096;

constexpr int RING_BYTES = 131072;
constexpr int MISC_OFF = RING_BYTES;
constexpr int LDS_BYTES = 147456;
constexpr int GRID = 256;

__device__ __forceinline__ int pos_of_row(int row) { return row < NMAIN ? NMETA + (row & (LREAL - 1)) : ((row - NMAIN) & (NMETA - 1)); }
__device__ __forceinline__ unsigned pk2(float lo, float hi) { f32x2 v = {lo, hi}; return __builtin_bit_cast(unsigned, __builtin_convertvector(v, bf16x2v)); }
__device__ __forceinline__ float bf_lo(unsigned w) { return __uint_as_float(w << 16); }
__device__ __forceinline__ float bf_hi(unsigned w) { return __uint_as_float(w & 0xffff0000u); }
typedef _Float16 f16x2v __attribute__((ext_vector_type(2)));
__device__ __forceinline__ unsigned pk2h(float lo, float hi) { f32x2 v = {lo, hi}; return __builtin_bit_cast(unsigned, __builtin_convertvector(v, f16x2v)); }
__device__ __forceinline__ float hf_lo(unsigned w) { return (float)__builtin_bit_cast(f16x2v, w)[0]; }
__device__ __forceinline__ float hf_hi(unsigned w) { return (float)__builtin_bit_cast(f16x2v, w)[1]; }
__device__ __forceinline__ float wave_sum(float v) {
#pragma unroll
    for (int o = 1; o < 64; o <<= 1) v += __shfl_xor(v, o);
    return v;
}
__device__ __forceinline__ float wave_max(float v) {
#pragma unroll
    for (int o = 1; o < 64; o <<= 1) v = fmaxf(v, __shfl_xor(v, o));
    return v;
}
namespace pg8 {
#define PG8_LAS __attribute__((address_space(3)))
typedef unsigned short bf16_t;
typedef short bf16x8 __attribute__((ext_vector_type(8)));
typedef float f32x4 __attribute__((ext_vector_type(4)));
typedef unsigned u32x4 __attribute__((ext_vector_type(4)));
constexpr int BM = 256, BK = 64, HALF = 128, HTB = HALF * BK * 2  , STAGE_BYTES = 8 * HTB, NXCD = 8, WGM = 4;

__host__ __device__ __forceinline__ int lds_byte(int r, int c) { const int st = (r >> 4) * 2 + (c >> 5), rr = r & 15, cc = c & 31, ob = rr * 64 + cc * 2; return st * 1024 + (ob ^ (((ob >> 9) & 1) << 5)); }
__host__ __device__ __forceinline__ void stage_rc(int b, int& R, int& C) { const int st = b / 1024, sb = b % 1024, swz = sb ^ (((sb >> 9) & 1) << 5); R = (st >> 1) * 16 + swz / 64; C = (st & 1) * 32 + (swz % 64) / 2; }
__host__ __device__ __forceinline__ int perm32(int rho) { const int n = rho >> 4, i = rho & 15; return 8 * (i >> 2) + 4 * n + (i & 3); }

struct Unit { int pm, pn, kk; };
struct Gemm { const bf16_t* A; const bf16_t* Bt; int M, N, K, ld; };

struct PanelOrder {
    int nM, nN, nwg, G, c, nMain, pm0, pmx;
    __device__ void init(int nMain_, int pm0_, int extra, int pmx_, int N, int G_, int c_) { nMain = nMain_; pm0 = pm0_; pmx = pmx_; nM = nMain_ + extra; nN = N / BM; nwg = nM * nN; G = G_; c = c_; }
    __device__ bool next(int i, Unit& u) const {
        const long L = (long)i * G + c; if (L >= nwg) return false;
        int wgid = (int)L; { const int q = nwg / NXCD, r = nwg % NXCD, xcd = wgid % NXCD, off = wgid / NXCD; wgid = (xcd < r ? xcd * (q + 1) : r * (q + 1) + (xcd - r) * q) + off; }
        const int nig = WGM * nN, gid = wgid / nig, fm = gid * WGM, gsz = (nM - fm) < WGM ? (nM - fm) : WGM;
        const int pl = fm + ((wgid % nig) % gsz); u.pm = pl < nMain ? pm0 + pl : pmx; u.pn = (wgid % nig) / gsz; u.kk = 0; return true;
    }
    __device__ __forceinline__ void a_ready(const Unit&) const {}
    __device__ __forceinline__ void done(const Unit&) const {}
};

struct SplitOrder {
    int pm, nN, nwg, G, c;
    __device__ void init(int pm_, int N, int nsplit, int G_, int c_) { pm = pm_; nN = N / BM; nwg = nN * nsplit; G = G_; c = c_; }
    __device__ bool next(int i, Unit& u) const { const int L = i * G + c; if (L >= nwg) return false; u.pm = pm; u.pn = L % nN; u.kk = L / nN; return true; }
    __device__ __forceinline__ void a_ready(const Unit&) const {}
    __device__ __forceinline__ void done(const Unit&) const {}
};

__device__ __forceinline__ u32x4 pack8(const f32x4 v0, const f32x4 v1) { u32x4 w; w.x = pk2(v0[0], v0[1]); w.y = pk2(v0[2], v0[3]); w.z = pk2(v1[0], v1[1]); w.w = pk2(v1[2], v1[3]); return w; }

struct EpiBf16G {
    static constexpr bool PERM = true, AFTER_DRAIN = false;
    bf16_t* O; int ldc; const float* rs; int pm_sub, pm_sp, pm_sp_out;
    __device__ __forceinline__ void operator()(const f32x4 (&acc)[2][2][4][2], const Unit& u, int wr, int wc, int fr, int fq) const {
        const int opm = (u.pm == pm_sp) ? pm_sp_out : u.pm - pm_sub;
        const int rin = u.pm * BM + wr * 64 + fr, rout = opm * BM + wr * 64 + fr, col0 = u.pn * BM + wc * 32 + 8 * fq;
#pragma unroll
        for (int ai = 0; ai < 2; ++ai)
#pragma unroll
            for (int m = 0; m < 4; ++m) { const float sc = rs ? rs[(size_t)(rin + ai * HALF + m * 16) * 2] : 1.f;
                bf16_t* rowp = O + (size_t)(rout + ai * HALF + m * 16) * ldc + col0;
#pragma unroll
                for (int bj = 0; bj < 2; ++bj) *(u32x4*)(rowp + bj * HALF) = pack8(acc[ai][bj][m][0] * sc, acc[ai][bj][m][1] * sc); }
    }
};
struct EpiWin {
    static constexpr bool PERM = true, AFTER_DRAIN = false;
    bf16_t *UQKVO, *UDQ, *UDKV, *KR; float* GATES; const float *COS, *SIN;
    __device__ __forceinline__ void operator()(const f32x4 (&acc)[2][2][4][2], const Unit& u, int wr, int wc, int fr, int fq) const {
        const int row0 = u.pm * BM + wr * 64 + fr;
        if (u.pn < 19) {
            bf16_t* base; int ldc, colt;
            if (u.pn < 16) { base = UQKVO; ldc = 4096; colt = u.pn * BM; } else if (u.pn < 18) { base = UDQ; ldc = 512; colt = (u.pn - 16) * BM; } else { base = UDKV; ldc = 256; colt = 0; }
            const int col0 = colt + wc * 32 + 8 * fq;
#pragma unroll
            for (int ai = 0; ai < 2; ++ai)
#pragma unroll
                for (int m = 0; m < 4; ++m) { bf16_t* rowp = base + (size_t)(row0 + ai * HALF + m * 16) * ldc + col0;
#pragma unroll
                    for (int bj = 0; bj < 2; ++bj) *(u32x4*)(rowp + bj * HALF) = pack8(acc[ai][bj][m][0], acc[ai][bj][m][1]); }
        } else {
            if (wc < 2) { const int g = 4 * wc + fq;
#pragma unroll
                for (int ai = 0; ai < 2; ++ai)
#pragma unroll
                    for (int m = 0; m < 4; ++m) { const int row = row0 + ai * HALF + m * 16, pos = pos_of_row(row);
                        const f32x4 cs = *(const f32x4*)(COS + pos * 32 + 4 * g), sn = *(const f32x4*)(SIN + pos * 32 + 4 * g);
                        const f32x4 x1 = acc[ai][0][m][0], x2 = acc[ai][0][m][1];
                        *(u32x4*)(KR + (size_t)row * 64 + 8 * g) = pack8(x1 * cs - x2 * sn, x1 * sn + x2 * cs); }
            } else if (wc == 2 && fq < 2) {
#pragma unroll
                for (int ai = 0; ai < 2; ++ai)
#pragma unroll
                    for (int m = 0; m < 4; ++m) { float* gp = GATES + (size_t)(row0 + ai * HALF + m * 16) * 16 + 8 * fq;
                        *(f32x4*)gp = acc[ai][0][m][0]; *(f32x4*)(gp + 4) = acc[ai][0][m][1]; }
            }
        }
    }
};
struct EpiQ {
    static constexpr bool PERM = true, AFTER_DRAIN = false;
    bf16_t* MQ; const float *RSTD, *COS, *SIN;
    __device__ __forceinline__ void operator()(const f32x4 (&acc)[2][2][4][2], const Unit& u, int wr, int wc, int fr, int fq) const {
        const int row0 = u.pm * BM + wr * 64 + fr, colb = u.pn * BM + wc * 32 + 8 * fq;
#pragma unroll
        for (int ai = 0; ai < 2; ++ai)
#pragma unroll
            for (int m = 0; m < 4; ++m) { const int row = row0 + ai * HALF + m * 16, pos = pos_of_row(row); const float sc = RSTD[(size_t)row * 2];
#pragma unroll
                for (int bj = 0; bj < 2; ++bj) { const int col0 = colb + bj * HALF, o = col0 % 192;
                    f32x4 v0 = acc[ai][bj][m][0] * sc, v1 = acc[ai][bj][m][1] * sc;
                    if (o >= 128) { const int g = (o - 128) >> 3; const f32x4 cs = *(const f32x4*)(COS + pos * 32 + 4 * g), sn = *(const f32x4*)(SIN + pos * 32 + 4 * g);
                        const f32x4 x1 = v0, x2 = v1; v0 = x1 * cs - x2 * sn; v1 = x1 * sn + x2 * cs; }
                    *(u32x4*)(MQ + (size_t)row * NQ + col0) = pack8(v0, v1); } }
    }
};
__device__ __forceinline__ void resid_ln_tile(float* __restrict__ Cw, const float* __restrict__ Cr, const float* __restrict__ st, const float* __restrict__ g, const float* __restrict__ b,
                                              int ldc, float alpha, const f32x4 (&acc)[2][2][4][2], int row0, int col0) {
    asm volatile("" ::: "memory");
#pragma unroll
    for (int ai = 0; ai < 2; ++ai)
#pragma unroll
        for (int bj = 0; bj < 2; ++bj) {
            f32x4 gv[2], bv[2], hv[4][2]; f32x2 ms[4];
#pragma unroll
            for (int n = 0; n < 2; ++n) { gv[n] = *(const f32x4*)(g + col0 + bj * HALF + n * 16) * alpha; bv[n] = *(const f32x4*)(b + col0 + bj * HALF + n * 16) * alpha; }
#pragma unroll
            for (int m = 0; m < 4; ++m) { const int row = row0 + ai * HALF + m * 16; ms[m] = *(const f32x2*)(st + (size_t)row * 2);
#pragma unroll
                for (int n = 0; n < 2; ++n) hv[m][n] = *(const f32x4*)(Cr + (size_t)row * ldc + col0 + bj * HALF + n * 16); }
#pragma unroll
            for (int m = 0; m < 4; ++m) { const int row = row0 + ai * HALF + m * 16;
#pragma unroll
                for (int n = 0; n < 2; ++n) *(f32x4*)(Cw + (size_t)row * ldc + col0 + bj * HALF + n * 16) = (hv[m][n] - ms[m][0]) * ms[m][1] * gv[n] + bv[n] + acc[ai][bj][m][n]; }
        }
}
__device__ __forceinline__ void resid_ln_tile_bf(bf16_t* __restrict__ Cw, const bf16_t* __restrict__ Cr, const float* __restrict__ st, const float* __restrict__ g, const float* __restrict__ b,
                                                 int ldc, float alpha, const f32x4 (&acc)[2][2][4][2], int row0, int col0) {
    asm volatile("" ::: "memory");
#pragma unroll
    for (int ai = 0; ai < 2; ++ai)
#pragma unroll
        for (int bj = 0; bj < 2; ++bj) {
            f32x4 gv[2], bv[2]; u32x4 hv[4]; f32x2 ms[4];
#pragma unroll
            for (int n = 0; n < 2; ++n) { gv[n] = *(const f32x4*)(g + col0 + bj * HALF + n * 4) * alpha; bv[n] = *(const f32x4*)(b + col0 + bj * HALF + n * 4) * alpha; }
#pragma unroll
            for (int m = 0; m < 4; ++m) { const int row = row0 + ai * HALF + m * 16; ms[m] = *(const f32x2*)(st + (size_t)row * 2);
                hv[m] = *(const u32x4*)(Cr + (size_t)row * ldc + col0 + bj * HALF); }
#pragma unroll
            for (int m = 0; m < 4; ++m) { const int row = row0 + ai * HALF + m * 16;
                const f32x4 h0 = {hf_lo(hv[m].x), hf_hi(hv[m].x), hf_lo(hv[m].y), hf_hi(hv[m].y)}, h1 = {hf_lo(hv[m].z), hf_hi(hv[m].z), hf_lo(hv[m].w), hf_hi(hv[m].w)};
                const f32x4 o0 = (h0 - ms[m][0]) * ms[m][1] * gv[0] + bv[0] + acc[ai][bj][m][0], o1 = (h1 - ms[m][0]) * ms[m][1] * gv[1] + bv[1] + acc[ai][bj][m][1];
                u32x4 w; w.x = pk2h(o0[0], o0[1]); w.y = pk2h(o0[2], o0[3]); w.z = pk2h(o1[0], o1[1]); w.w = pk2h(o1[2], o1[3]);
                *(u32x4*)(Cw + (size_t)row * ldc + col0 + bj * HALF) = w; }
        }
}
struct EpiResidLn {
    static constexpr bool PERM = true, AFTER_DRAIN = false;
    bf16_t* C; int ldc; float alpha; const float* st; const float* g; const float* b;
    __device__ __forceinline__ void operator()(const f32x4 (&acc)[2][2][4][2], const Unit& u, int wr, int wc, int fr, int fq) const {
        resid_ln_tile_bf(this->C, this->C, this->st, this->g, this->b, this->ldc, this->alpha, acc, u.pm * BM + wr * 64 + fr, u.pn * BM + wc * 32 + 8 * fq);
    }
};
struct EpiPart {
    static constexpr bool PERM = false, AFTER_DRAIN = false;
    float* P; int ldc;
    __device__ __forceinline__ void operator()(const f32x4 (&acc)[2][2][4][2], const Unit& u, int wr, int wc, int fr, int fq) const {
        const int row0 = u.kk * BM + wr * 64 + fr, col0 = u.pn * BM + wc * 32 + 4 * fq;
#pragma unroll
        for (int ai = 0; ai < 2; ++ai)
#pragma unroll
            for (int m = 0; m < 4; ++m) { float* rowp = P + (size_t)(row0 + ai * HALF + m * 16) * ldc + col0;
#pragma unroll
                for (int bj = 0; bj < 2; ++bj)
#pragma unroll
                    for (int n = 0; n < 2; ++n) *(f32x4*)(rowp + bj * HALF + n * 16) = acc[ai][bj][m][n]; }
    }
};

__device__ __forceinline__ float dpp_ror1(float x) { return __int_as_float(__builtin_amdgcn_mov_dpp(__float_as_int(x), 0x121, 0xf, 0xf, false)); }
__device__ __forceinline__ float dpp_ror15(float x) { return __int_as_float(__builtin_amdgcn_mov_dpp(__float_as_int(x), 0x12f, 0xf, 0xf, false)); }
struct EpiFfn {
    static constexpr bool PERM = true, AFTER_DRAIN = false;
    bf16_t* ACT; float* SIDE; bf16_t* GVM; const float *cw, *cb; PG8_LAS float* X;
    __device__ __forceinline__ void operator()(const f32x4 (&acc)[2][2][4][2], const Unit& u, int wr_in, int wc_in, int fr_in, int fq_in) const {
        int fr = fr_in, fq = fq_in, wr = wr_in, wc = wc_in; asm volatile("" : "+v"(fr), "+v"(fq), "+s"(wr), "+s"(wc));
        const int cj = wc * 32 + 8 * fq, c0 = u.pn * 128 + cj;
        if (u.pm == PMETA) {
#pragma unroll
            for (int ai = 0; ai < 2; ++ai)
#pragma unroll
                for (int m = 0; m < 4; ++m) { bf16_t* rowp = GVM + (size_t)(ai * HALF + wr * 64 + m * 16 + fr) * NUP + c0;
                    *(u32x4*)rowp = pack8(acc[ai][0][m][0], acc[ai][0][m][1]); *(u32x4*)(rowp + DFF) = pack8(acc[ai][1][m][0], acc[ai][1][m][1]); }
            return;
        }
        f32x4 w0[2], w1[2], w2[2], bb[2];
#pragma unroll
        for (int n = 0; n < 2; ++n) { w0[n] = *(const f32x4*)(cw + c0 + 4 * n); w1[n] = *(const f32x4*)(cw + DFF + c0 + 4 * n); w2[n] = *(const f32x4*)(cw + 2 * DFF + c0 + 4 * n); bb[n] = *(const f32x4*)(cb + c0 + 4 * n); }
#pragma unroll
        for (int ai = 0; ai < 2; ++ai) { const int b = 2 * ai + wr;
            if (fr == 0) { *(PG8_LAS f32x4*)(X + (b * 2 + 0) * 128 + cj) = acc[ai][0][0][0]; *(PG8_LAS f32x4*)(X + (b * 2 + 0) * 128 + cj + 4) = acc[ai][0][0][1]; }
            if (fr == 15) { *(PG8_LAS f32x4*)(X + (b * 2 + 1) * 128 + cj) = acc[ai][0][3][0]; *(PG8_LAS f32x4*)(X + (b * 2 + 1) * 128 + cj + 4) = acc[ai][0][3][1]; } }
        asm volatile("s_waitcnt lgkmcnt(0)" ::: "memory"); __builtin_amdgcn_s_barrier(); asm volatile("" ::: "memory");
        const bool is15 = fr == 15, is0 = fr == 0;
        const unsigned rowb = (unsigned)(u.pm * BM + wr * 64 + fr) * DFF + c0;
#pragma unroll
        for (int ai = 0; ai < 2; ++ai) { const int b = 2 * ai + wr;
            f32x4 xp[2], xn[2];
#pragma unroll
            for (int n = 0; n < 2; ++n) { xp[n] = b > 0 ? *(const PG8_LAS f32x4*)(X + ((b - 1) * 2 + 1) * 128 + cj + 4 * n) : (f32x4){0.f, 0.f, 0.f, 0.f};
                                          xn[n] = b < 3 ? *(const PG8_LAS f32x4*)(X + ((b + 1) * 2 + 0) * 128 + cj + 4 * n) : (f32x4){0.f, 0.f, 0.f, 0.f}; }
#pragma unroll
            for (int m = 0; m < 4; ++m) { u32x4 ow;
#pragma unroll
                for (int n = 0; n < 2; ++n) { f32x4 o;
#pragma unroll
                    for (int e = 0; e < 4; ++e) { const float g = acc[ai][0][m][n][e];
                        const float gup = m > 0 ? acc[ai][0][m > 0 ? m - 1 : 0][n][e] : xp[n][e], gdn = m < 3 ? acc[ai][0][m < 3 ? m + 1 : 3][n][e] : xn[n][e];
                        const float pv = dpp_ror1(is15 ? gup : g);
                        const float nx = dpp_ror15(is0 ? gdn : g);
                        const float x = w0[n][e] * pv + w1[n][e] * g + w2[n][e] * nx + bb[n][e];
                        o[e] = x * __builtin_amdgcn_rcpf(1.f + __expf(-x)) * acc[ai][1][m][n][e]; }
                    if (n == 0) { ow.x = pk2(o[0], o[1]); ow.y = pk2(o[2], o[3]); } else { ow.z = pk2(o[0], o[1]); ow.w = pk2(o[2], o[3]); } }
                bf16_t* dst = ACT + (rowb + (unsigned)(ai * HALF + m * 16) * DFF);
                if ((ai == 0 && m == 0) || (ai == 1 && m == 3)) {
                    const int r = ai * HALF + wr * 64 + m * 16 + fr;
                    if (r != 0 && r != 255) *(u32x4*)dst = ow;
                    const int slot = r == 0 ? 0 : r == 1 ? 1 : r == 254 ? 2 : r == 255 ? 3 : -1;
                    if (slot >= 0) { float* sp = SIDE + ((size_t)u.pm * 6 + slot) * DFF + c0; *(f32x4*)sp = acc[ai][0][m][0]; *(f32x4*)(sp + 4) = acc[ai][0][m][1];
                        if (slot == 0 || slot == 3) { float* vp = SIDE + ((size_t)u.pm * 6 + (slot == 0 ? 4 : 5)) * DFF + c0; *(f32x4*)vp = acc[ai][1][m][0]; *(f32x4*)(vp + 4) = acc[ai][1][m][1]; } }
                } else *(u32x4*)dst = ow;
            }
        }
    }
};
template <class Epi, class Sched, bool ALIGN_EPI = false, bool SP2 = false>
__device__ __forceinline__ void gemm_phase(PG8_LAS unsigned char* lds, const Gemm g, const Sched& S, const Epi& E) {
    int tid_ = threadIdx.x; asm volatile("" : "+v"(tid_));
    const int tid = tid_, wid = __builtin_amdgcn_readfirstlane(tid >> 6), lane = tid & 63, wr = wid >> 2, wc = wid & 3, fr = lane & 15, fq = lane >> 4;
    const int K = g.ld, nt = g.K / BK;
    unsigned voffA[2], voffB[2];
#pragma unroll
    for (int i = 0; i < 2; ++i) { int R, C; stage_rc(tid * 16 + i * 8192, R, C); const int Rb = Epi::PERM ? ((R & ~31) + perm32(R & 31)) : R;
        voffA[i] = (unsigned)(R * K + C) * 2u; voffB[i] = (unsigned)(Rb * K + C) * 2u; }
    const size_t kstep = (size_t)(BK * 2);
    const size_t hstep = (size_t)HALF * K * 2;
    const size_t tstep = 2 * hstep;
    const unsigned ldsw = (unsigned)wid * 1024u;
    const int aoff = lds_byte(wr * 64 + fr, fq * 8), boff = lds_byte(wc * 32 + fr, fq * 8);
#define PG8_SA(b, h) (((b) * 2 + (h)) * HTB)
#define PG8_SB(b, h) ((4 + (b) * 2 + (h)) * HTB)
#define PG8_STAGE(bufoff, gbase, voff) do { _Pragma("unroll") for (int _i = 0; _i < 2; ++_i) \
        __builtin_amdgcn_global_load_lds((const unsigned*)((const char*)(gbase) + (voff)[_i]), (PG8_LAS unsigned*)(lds + (bufoff) + ldsw + _i * 8192), 16, 0, 0); } while (0)
#define PG8_LDA(dst, b, h) do { _Pragma("unroll") for (int m = 0; m < 4; ++m) _Pragma("unroll") for (int k = 0; k < 2; ++k) dst[m][k] = *(const PG8_LAS bf16x8*)(lds + PG8_SA(b, h) + aoff + m * 2048 + k * 1024); } while (0)
#define PG8_LDB(dst, b, h) do { _Pragma("unroll") for (int n = 0; n < 2; ++n) _Pragma("unroll") for (int k = 0; k < 2; ++k) dst[n][k] = *(const PG8_LAS bf16x8*)(lds + PG8_SB(b, h) + boff + n * 2048 + k * 1024); } while (0)
#define PG8_MMA(ai, bj, At, Bt) do { __builtin_amdgcn_s_setprio(1); _Pragma("unroll") for (int m = 0; m < 4; ++m) _Pragma("unroll") for (int n = 0; n < 2; ++n) _Pragma("unroll") for (int k = 0; k < 2; ++k) \
        acc[ai][bj][m][n] = __builtin_amdgcn_mfma_f32_16x16x32_bf16(Bt[n][k], At[m][k], acc[ai][bj][m][n], 0, 0, 0); __builtin_amdgcn_s_setprio(0); } while (0)
#define PG8_WAIT_V(n) asm volatile("s_waitcnt vmcnt(" #n ")" ::: "memory")
#define PG8_WAIT_L(n) asm volatile("s_waitcnt lgkmcnt(" #n ")" ::: "memory")
#define PG8_BAR __builtin_amdgcn_s_barrier()
#define PG8_SCHED __builtin_amdgcn_sched_barrier(0)
    Unit cur, nxt; int ui = 0;
    if (!S.next(0, cur)) return;
    f32x4 acc[2][2][4][2];
#pragma unroll
    for (int a = 0; a < 2; ++a)
#pragma unroll
        for (int b = 0; b < 2; ++b)
#pragma unroll
            for (int m = 0; m < 4; ++m)
#pragma unroll
                for (int n = 0; n < 2; ++n) acc[a][b][m][n] = (f32x4){0.f, 0.f, 0.f, 0.f};
    bf16x8 At[4][2], B0[2][2], B1[2][2];
    const size_t sstep = (size_t)g.K * 2;
    const char* cA = (const char*)g.A + (size_t)cur.pm * tstep + (size_t)cur.kk * sstep; const char* cB = (const char*)g.Bt + (size_t)cur.pn * tstep + (size_t)cur.kk * sstep;
    S.a_ready(cur);
    if constexpr (SP2) {
        PG8_STAGE(PG8_SB(0, 0), cB, voffB); PG8_STAGE(PG8_SB(0, 1), cB + hstep, voffB); PG8_STAGE(PG8_SA(0, 0), cA, voffA); PG8_STAGE(PG8_SA(0, 1), cA + hstep, voffA);
        if (wr == 1) PG8_BAR;
        PG8_WAIT_V(2); PG8_BAR;
        PG8_STAGE(PG8_SB(1, 0), cB + kstep, voffB); PG8_STAGE(PG8_SA(1, 0), cA + kstep, voffA); PG8_STAGE(PG8_SB(1, 1), cB + hstep + kstep, voffB);
        PG8_WAIT_V(6); PG8_BAR;
    } else {
        PG8_STAGE(PG8_SB(0, 0), cB, voffB); PG8_STAGE(PG8_SA(0, 0), cA, voffA); PG8_STAGE(PG8_SB(0, 1), cB + hstep, voffB); PG8_STAGE(PG8_SA(0, 1), cA + hstep, voffA);
        if (wr == 1) PG8_BAR;
        PG8_WAIT_V(4); PG8_BAR;
        PG8_STAGE(PG8_SB(1, 0), cB + kstep, voffB); PG8_STAGE(PG8_SA(1, 0), cA + kstep, voffA); PG8_STAGE(PG8_SB(1, 1), cB + hstep + kstep, voffB);
        PG8_WAIT_V(6); PG8_BAR;
    }
    for (;;) {
        const bool has_next = S.next(ui + 1, nxt);
        const char* nA = has_next ? (const char*)g.A + (size_t)nxt.pm * tstep + (size_t)nxt.kk * sstep : cA; const char* nB = has_next ? (const char*)g.Bt + (size_t)nxt.pn * tstep + (size_t)nxt.kk * sstep : cB;
        for (int t = 0; t < nt; t += 2) {
            const bool last = (t == nt - 2);
            const char* a1 = cA + (size_t)(t + 1) * kstep;
            const char* a2 = last ? nA : cA + (size_t)(t + 2) * kstep; const char* b2 = last ? nB : cB + (size_t)(t + 2) * kstep;
            const char* a3 = a2 + kstep; const char* b3 = b2 + kstep;
            if (last && has_next) S.a_ready(nxt);
            if constexpr (SP2) {
            PG8_LDB(B0, 0, 0); PG8_LDB(B1, 0, 1); PG8_SCHED; PG8_LDA(At, 0, 0); PG8_STAGE(PG8_SA(1, 1), a1 + hstep, voffA);
            PG8_WAIT_V(8); PG8_WAIT_L(0); PG8_BAR; PG8_MMA(0, 0, At, B0); PG8_MMA(0, 1, At, B1); PG8_BAR; PG8_SCHED;
            PG8_LDA(At, 0, 1); PG8_STAGE(PG8_SB(0, 0), b2, voffB); PG8_STAGE(PG8_SB(0, 1), b2 + hstep, voffB); PG8_STAGE(PG8_SA(0, 0), a2, voffA);
            PG8_WAIT_V(8); PG8_WAIT_L(0); PG8_BAR; PG8_MMA(1, 0, At, B0); PG8_MMA(1, 1, At, B1); PG8_BAR; PG8_SCHED;
            PG8_LDB(B0, 1, 0); PG8_LDB(B1, 1, 1); PG8_SCHED; PG8_LDA(At, 1, 0); PG8_STAGE(PG8_SA(0, 1), a2 + hstep, voffA);
            PG8_WAIT_V(8); PG8_WAIT_L(0); PG8_BAR; PG8_MMA(0, 0, At, B0); PG8_MMA(0, 1, At, B1); PG8_BAR; PG8_SCHED;
            PG8_LDA(At, 1, 1); PG8_STAGE(PG8_SB(1, 0), b3, voffB); PG8_STAGE(PG8_SB(1, 1), b3 + hstep, voffB); PG8_STAGE(PG8_SA(1, 0), a3, voffA);
            PG8_WAIT_V(8); PG8_WAIT_L(0); PG8_BAR; PG8_MMA(1, 0, At, B0); PG8_MMA(1, 1, At, B1); PG8_BAR; PG8_SCHED;
            } else {
            PG8_LDB(B0, 0, 0); PG8_SCHED; PG8_LDA(At, 0, 0); PG8_STAGE(PG8_SA(1, 1), a1 + hstep, voffA);
            PG8_WAIT_L(8); PG8_BAR; PG8_WAIT_L(0); PG8_MMA(0, 0, At, B0); PG8_BAR; PG8_SCHED;
            PG8_LDB(B1, 0, 1); PG8_STAGE(PG8_SB(0, 0), b2, voffB);
            PG8_BAR; PG8_WAIT_L(0); PG8_MMA(0, 1, At, B1); PG8_BAR;
            PG8_LDA(At, 0, 1); PG8_STAGE(PG8_SA(0, 0), a2, voffA);
            PG8_BAR; PG8_WAIT_L(0); PG8_MMA(1, 0, At, B0); PG8_BAR; PG8_SCHED;
            PG8_STAGE(PG8_SB(0, 1), b2 + hstep, voffB);
            PG8_WAIT_V(6); PG8_BAR; PG8_MMA(1, 1, At, B1); PG8_BAR;
            PG8_LDB(B0, 1, 0); PG8_SCHED; PG8_LDA(At, 1, 0); PG8_STAGE(PG8_SA(0, 1), a2 + hstep, voffA);
            PG8_WAIT_L(8); PG8_BAR; PG8_WAIT_L(0); PG8_MMA(0, 0, At, B0); PG8_BAR; PG8_SCHED;
            PG8_LDB(B1, 1, 1); PG8_STAGE(PG8_SB(1, 0), b3, voffB);
            PG8_BAR; PG8_WAIT_L(0); PG8_MMA(0, 1, At, B1); PG8_BAR;
            PG8_LDA(At, 1, 1); PG8_STAGE(PG8_SA(1, 0), a3, voffA);
            PG8_BAR; PG8_WAIT_L(0); PG8_MMA(1, 0, At, B0); PG8_BAR; PG8_SCHED;
            PG8_STAGE(PG8_SB(1, 1), b3 + hstep, voffB);
            PG8_WAIT_V(6); PG8_BAR; PG8_MMA(1, 1, At, B1); PG8_BAR;
            }
        }
        if constexpr (ALIGN_EPI) { if (wr == 0) PG8_BAR; }
        if constexpr (!Epi::AFTER_DRAIN) { E(acc, cur, wr, wc, fr, fq); S.done(cur); }
        if (!has_next) break;
#pragma unroll
        for (int a = 0; a < 2; ++a)
#pragma unroll
            for (int b = 0; b < 2; ++b)
#pragma unroll
                for (int m = 0; m < 4; ++m)
#pragma unroll
                    for (int n = 0; n < 2; ++n) acc[a][b][m][n] = (f32x4){0.f, 0.f, 0.f, 0.f};
        cur = nxt; cA = nA; cB = nB; ++ui;
        if constexpr (ALIGN_EPI) { if (wr == 1) PG8_BAR; }
    }
    PG8_WAIT_V(0);
    if constexpr (!ALIGN_EPI) { if (wr == 0) PG8_BAR; }
    PG8_BAR;
    if constexpr (Epi::AFTER_DRAIN) { E.fused(acc, cur, wr, wc, fr, fq, lds, wid, lane); S.done(cur); }
#undef PG8_SA
#undef PG8_SB
#undef PG8_STAGE
#undef PG8_LDA
#undef PG8_LDB
#undef PG8_MMA
#undef PG8_WAIT_V
#undef PG8_WAIT_L
#undef PG8_BAR
#undef PG8_SCHED
}
}
#define XB_TMO      128
#define XB_XCNT(j)  (256  + 64 * (j))
#define XB_XSUB(j)  (1280 + 64 * (j))
#define XB_XGEN(j)  (2304 + 64 * (j))
#define XB_TOP      3328
#define XB_TOPGEN   3392
#define XCD_BAR_WORDS 3456
#define XB_SPIN_CAP (1u << 21)

__device__ __forceinline__ unsigned xb_ld(unsigned* p)              { return __hip_atomic_load(p, __ATOMIC_RELAXED, __HIP_MEMORY_SCOPE_AGENT); }
__device__ __forceinline__ unsigned xb_add(unsigned* p, unsigned v) { return __hip_atomic_fetch_add(p, v, __ATOMIC_RELAXED, __HIP_MEMORY_SCOPE_AGENT); }
__device__ __forceinline__ unsigned xb_xcc_id() { return (unsigned)__builtin_amdgcn_s_getreg((3 << 11) | 20) & 0xFu; }
#define XB_SPIN(cond, bar) do { unsigned _sp = 0; while (cond) { __builtin_amdgcn_s_sleep(1); \
    if ((++_sp & 255u) == 0u) { if (xb_ld(&(bar)[XB_TMO])) break; if (_sp > XB_SPIN_CAP) { atomicAdd(&(bar)[XB_TMO], 1u); break; } } } } while (0)

struct XcdBarrier {
    unsigned* bar; unsigned x;
    volatile LAS unsigned* st;
};

__device__ __forceinline__ XcdBarrier xcd_barrier_post(unsigned* bar, volatile LAS unsigned* st) {
    XcdBarrier b; b.bar = bar; b.x = (unsigned)__builtin_amdgcn_readfirstlane((int)xb_xcc_id()); b.st = st;
    if (threadIdx.x == 0) (void)xb_add(&bar[XB_XCNT(b.x)], 1u);
    return b;
}
__device__ __forceinline__ void xcd_barrier_complete(unsigned* bar, unsigned x, unsigned& nloc, unsigned& nx) {
    const unsigned G = gridDim.x * gridDim.y * gridDim.z;
    unsigned sum, cnt, mine, sp = 0u;
    for (;;) {
        sum = 0u; cnt = 0u; mine = 0u;
#pragma unroll
        for (unsigned j = 0; j < 16; ++j) { const unsigned c = xb_ld(&bar[XB_XCNT(j)]); sum += c; cnt += (c > 0u) ? 1u : 0u; }
        mine = xb_ld(&bar[XB_XCNT(x)]);
        if (sum == G) { mine = xb_ld(&bar[XB_XCNT(x)]); break; }
        __builtin_amdgcn_s_sleep(1);
        if ((++sp & 255u) == 0u) { if (xb_ld(&bar[XB_TMO])) break; if (sp > XB_SPIN_CAP) { atomicAdd(&bar[XB_TMO], 1u); break; } }
    }
    nloc = mine > 0u ? mine : 1u; nx = cnt > 0u ? cnt : 1u;
}

__device__ __forceinline__ void xcd_barrier(const XcdBarrier& b) {
    asm volatile("s_waitcnt vmcnt(0)" ::: "memory");
    __syncthreads();
    if (threadIdx.x == 0) {
        unsigned* bar = b.bar; unsigned bx_ = b.x;
        asm volatile("" : "+s"(bx_));
        __builtin_amdgcn_s_waitcnt(0);
        unsigned nloc = b.st[0], nx = b.st[1];
        if (nloc == 0u) { xcd_barrier_complete(bar, bx_, nloc, nx); b.st[0] = nloc; b.st[1] = nx; }
        const unsigned old = xb_add(&bar[XB_XSUB(bx_)], 1u);
        const unsigned gen = old / nloc;
        if (old + 1u == (gen + 1u) * nloc) {
            __builtin_amdgcn_fence(__ATOMIC_RELEASE, "agent");
            asm volatile("s_waitcnt vmcnt(0)" ::: "memory");
            const unsigned og = xb_add(&bar[XB_TOP], 1u);
            const unsigned tg = og / nx;
            if (og + 1u == (tg + 1u) * nx) xb_add(&bar[XB_TOPGEN], 1u);
            else XB_SPIN(xb_ld(&bar[XB_TOPGEN]) == tg, bar);
            __builtin_amdgcn_fence(__ATOMIC_ACQUIRE, "agent");
            xb_add(&bar[XB_XGEN(bx_)], 1u);
            asm volatile("s_waitcnt vmcnt(0)" ::: "memory");
        } else {
            XB_SPIN(xb_ld(&bar[XB_XGEN(bx_)]) == gen, bar);
            __builtin_amdgcn_fence(__ATOMIC_ACQUIRE, "agent");
            asm volatile("s_waitcnt vmcnt(0)" ::: "memory");
        }
    }
    __syncthreads();
}

typedef unsigned short bf16_t;
typedef short bf16x8 __attribute__((ext_vector_type(8)));
typedef float f32x4 __attribute__((ext_vector_type(4)));
typedef unsigned u32x4 __attribute__((ext_vector_type(4)));
#define LDS_WAIT() asm volatile("s_waitcnt lgkmcnt(0)" ::: "memory")

struct Params {
    const float* in[19];
};
struct Frame {
    LAS unsigned char* lds;
    int tid, lane, wave, G, bx, vcu, gw, ngw;
};
__device__ __forceinline__ const float* uptr(const LAS unsigned long long* t, int k) {
    const unsigned long long v = t[k]; const unsigned lo = __builtin_amdgcn_readfirstlane((unsigned)v), hi = __builtin_amdgcn_readfirstlane((unsigned)(v >> 32));
    return (const float*)(const GAS float*)(((unsigned long long)hi << 32) | lo); }

template <class CMap>
__device__ __forceinline__ void transpose_load(float (&v)[32], const float* W, int Nsrc, const float* ks, int kb, int nb, int lane, CMap cmap) {
    const int k0 = 64 * kb, n0 = 32 * nb; const int sc = cmap(n0 + (lane & 31));
#pragma unroll
    for (int i = 0; i < 32; ++i) { const int kk = 2 * i + (lane >> 5); float x = 0.f; if (sc >= 0) x = W[(size_t)(k0 + kk) * Nsrc + sc]; if (ks) x *= ks[k0 + kk]; v[i] = x; }
}
__device__ __forceinline__ void transpose_store(const float (&v)[32], int K, bf16_t* WT, LAS float* scr, int kb, int nb, int lane) {
    const int k0 = 64 * kb, n0 = 32 * nb;
#pragma unroll
    for (int i = 0; i < 32; ++i) scr[(2 * i + (lane >> 5)) * 33 + (lane & 31)] = v[i];
    LDS_WAIT(); asm volatile("" ::: "memory");
    const int c = lane & 7;
#pragma unroll
    for (int j = 0; j < 4; ++j) { const int n = (lane >> 3) + 8 * j; const LAS float* s = scr + (8 * c) * 33 + n;
        u32x4 o; o.x = pk2(s[0 * 33], s[1 * 33]); o.y = pk2(s[2 * 33], s[3 * 33]); o.z = pk2(s[4 * 33], s[5 * 33]); o.w = pk2(s[6 * 33], s[7 * 33]);
        *(u32x4*)(WT + (size_t)(n0 + n) * K + k0 + 8 * c) = o; }
    LDS_WAIT(); asm volatile("" ::: "memory");
}
template <class CMap>
__device__ __forceinline__ void transpose_matrix(const Frame& F, const float* W, int K, int Nsrc, int Ndst, bf16_t* WT, const float* ks, LAS float* scr, CMap cmap) {
    const int nnb = Ndst / 32, items = (K / 64) * nnb;
    for (int it = F.gw; it < items; it += 2 * F.ngw) { const int it2 = it + F.ngw; float va[32], vb[32];
        transpose_load(va, W, Nsrc, ks, it / nnb, it % nnb, F.lane, cmap);
        if (it2 < items) transpose_load(vb, W, Nsrc, ks, it2 / nnb, it2 % nnb, F.lane, cmap);
        transpose_store(va, K, WT, scr, it / nnb, it % nnb, F.lane);
        if (it2 < items) transpose_store(vb, K, WT, scr, it2 / nnb, it2 % nnb, F.lane); }
}
__device__ __forceinline__ int rope_perm(int m) { const int g = m >> 3, j = m & 7; return j < 4 ? 4 * g + j : 32 + 4 * g + (j - 4); }
struct CMapIn { __device__ int operator()(int n) const {
    if (n < 4096) return n; if (n < 4608) return 4112 + (n - 4096); if (n < 4864) return 4624 + (n - 4608);
    if (n < 4928) return 4880 + rope_perm(n - 4864); if (n < 4944) return 4096 + (n - 4928); return -1; } };
struct CMapQ { __device__ int operator()(int n) const { const int h = n / 192, o = n % 192; return o < 128 ? n : h * 192 + 128 + rope_perm(o - 128); } };
struct CMapUp { __device__ int operator()(int n) const { const int pn = n >> 8, j = n & 255; return j < 128 ? 128 * pn + j : DFF + 128 * pn + (j - 128); } };
struct CMapId { __device__ int operator()(int n) const { return n; } };

__device__ __forceinline__ void convert_weights(const Frame& F, unsigned char* ws, const LAS unsigned long long* pt, int l) {
    LAS float* scr = (LAS float*)(F.lds + F.wave * 8448);
    const float* w_in = uptr(pt, 3) + (size_t)l * DM * INC; const float* w_uq = uptr(pt, 8) + (size_t)l * 512 * NQ; const float* w_ukv = uptr(pt, 9) + (size_t)l * 256 * NKV;
    const float* w_out = uptr(pt, 10) + (size_t)l * DM * DM; const float* w_up = uptr(pt, 13) + (size_t)l * DM * NUP; const float* w_dn = uptr(pt, 16) + (size_t)l * DFF * DM;
    const float* qg = uptr(pt, 6) + (size_t)l * 512; const float* kvg = uptr(pt, 7) + (size_t)l * 256;
    transpose_matrix(F, w_in, DM, INC, NIN, (bf16_t*)(ws + WS_WIN), nullptr, scr, CMapIn());
    transpose_matrix(F, w_uq, 512, NQ, NQ, (bf16_t*)(ws + WS_WUQ), qg, scr, CMapQ());
    transpose_matrix(F, w_ukv, 256, NKV, NKV, (bf16_t*)(ws + WS_WUKV), kvg, scr, CMapId());
    transpose_matrix(F, w_out, DM, DM, DM, (bf16_t*)(ws + WS_WOUT), nullptr, scr, CMapId());
    transpose_matrix(F, w_up, DM, NUP, NUP, (bf16_t*)(ws + WS_WUP), nullptr, scr, CMapUp());
    transpose_matrix(F, w_dn, DFF, DM, DM, (bf16_t*)(ws + WS_WDN), nullptr, scr, CMapId());
}

__device__ __forceinline__ void prologue(const Frame& F, unsigned char* ws, const LAS unsigned long long* pt) {
    float* COS = (float*)(ws + WS_COS); float* SIN = (float*)(ws + WS_SIN);
    for (int i = F.bx * 512 + F.tid; i < 4112 * 32; i += F.G * 512) { const int pos = i >> 5, f = i & 31;
        const float inv = powf(10000.0f, -(float)(2 * f) / 64.0f); const float ang = (float)pos * inv; float s, c; sincosf(ang, &s, &c); COS[i] = c; SIN[i] = s; }
    { float* PAR = (float*)(ws + WS_PAR); const int gt = F.bx * 512 + F.tid, nt = F.G * 512;
      for (int i = gt; i < DEPTH * 16; i += nt) PAR[PO_BG + i] = uptr(pt, 4)[i];
      for (int i = gt; i < DEPTH * 1024; i += nt) PAR[PO_MLG + i] = uptr(pt, 5)[i];
      for (int i = gt; i < DEPTH * 512; i += nt) PAR[PO_QG + i] = uptr(pt, 6)[i];
      for (int i = gt; i < DEPTH * 256; i += nt) PAR[PO_KVG + i] = uptr(pt, 7)[i];
      for (int i = gt; i < 2048; i += nt) { PAR[PO_ONE + i] = 1.f; PAR[PO_ZERO + i] = 0.f; }
      { float* ST2 = (float*)(ws + WS_STAT2); for (int i = gt; i < TP; i += nt) { ST2[2 * i] = 0.f; ST2[2 * i + 1] = 1.f; } }
      for (int i = gt; i < DEPTH * 2048; i += nt) { PAR[PO_L1G + i] = uptr(pt, 11)[i]; PAR[PO_L1B + i] = uptr(pt, 12)[i]; PAR[PO_L2G + i] = uptr(pt, 17)[i]; PAR[PO_L2B + i] = uptr(pt, 18)[i]; }
      for (int i = gt; i < DEPTH * 3 * 5632; i += nt) PAR[PO_CW + i] = uptr(pt, 14)[i];
      for (int i = gt; i < DEPTH * 5632; i += nt) PAR[PO_CB + i] = uptr(pt, 15)[i]; }
    float* H = (float*)(ws + WS_H); bf16_t* HB = (bf16_t*)(ws + WS_HB);
    const float* xp = uptr(pt, 0); const float* xs = uptr(pt, 1); const float* mt = uptr(pt, 2);
    for (int row0 = F.gw; row0 < TP; row0 += 2 * F.ngw) {
        f32x4 v[2][8];
#pragma unroll
        for (int r = 0; r < 2; ++r) { const int row = row0 + r * F.ngw; const float* src = nullptr;
            if (row < 4 * LREAL) src = xp + (size_t)row * DM; else if (row < NMAIN) src = xs + (size_t)(row - 4 * LREAL) * DM; else if (row < NTOK) src = mt + (size_t)((row - NMAIN) & 15) * DM;
#pragma unroll
            for (int j = 0; j < 8; ++j) { v[r][j] = (f32x4){0.f, 0.f, 0.f, 0.f}; if (src) v[r][j] = ((const f32x4*)src)[F.lane + 64 * j]; } }
#pragma unroll
        for (int r = 0; r < 2; ++r) { const int row = row0 + r * F.ngw; if (row < TP) {
            f32x4* hd = (f32x4*)(H + (size_t)row * DM) + F.lane; u32x2* bd = (u32x2*)(HB + (size_t)row * DM) + F.lane; u32x2* hb = (u32x2*)((bf16_t*)H + (size_t)row * DM) + F.lane;
#pragma unroll
            for (int j = 0; j < 8; ++j) { const f32x4 x = v[r][j];
                u32x2 w; w.x = pk2(x[0], x[1]); w.y = pk2(x[2], x[3]); bd[64 * j] = w;
                if (row >= NMAIN) hd[64 * j] = x * ALPHA;
                else { u32x2 wh; wh.x = pk2h(x[0], x[1]); wh.y = pk2h(x[2], x[3]); hb[64 * j] = wh; } } } }
    }
}

__device__ __forceinline__ void ln_one(const f32x4 (&vin)[8], int row, int lane, float* __restrict__ Hw, bf16_t* __restrict__ HB, const float* __restrict__ g, const float* __restrict__ b, float* __restrict__ ST) {
    f32x4 v[8]; float s = 0.f;
#pragma unroll
    for (int j = 0; j < 8; ++j) { v[j] = vin[j]; s += (v[j][0] + v[j][1]) + (v[j][2] + v[j][3]); }
    const float mean = wave_sum(s) * (1.f / DM); float q = 0.f;
#pragma unroll
    for (int j = 0; j < 8; ++j) { v[j] = v[j] - mean; q += (v[j][0] * v[j][0] + v[j][1] * v[j][1]) + (v[j][2] * v[j][2] + v[j][3] * v[j][3]); }
    const float rstd = rsqrtf(wave_sum(q) * (1.f / DM) + EPS);
    if (lane == 0) { f32x2 ms = {mean, rstd}; *(f32x2*)(ST + (size_t)row * 2) = ms; }
    u32x2* bd = (u32x2*)(HB + (size_t)row * DM) + lane; f32x4* hp = (f32x4*)(Hw + (size_t)row * DM) + lane;
#pragma unroll
    for (int j = 0; j < 8; ++j) { const f32x4 gg = ((const f32x4*)g)[lane + 64 * j], bb = ((const f32x4*)b)[lane + 64 * j]; const f32x4 y = v[j] * rstd * gg + bb;
        u32x2 w; w.x = pk2(y[0], y[1]); w.y = pk2(y[2], y[3]); bd[64 * j] = w;
        hp[64 * j] = y * ALPHA; }
}
__device__ __forceinline__ void ln_one_bf(const u32x4 (&vin)[4], int row, int lane, bf16_t* __restrict__ HB, const float* __restrict__ g, const float* __restrict__ b, float* __restrict__ ST, float* __restrict__ out) {
    f32x4 v[8]; float s = 0.f;
#pragma unroll
    for (int j = 0; j < 4; ++j) { v[2 * j] = (f32x4){hf_lo(vin[j].x), hf_hi(vin[j].x), hf_lo(vin[j].y), hf_hi(vin[j].y)}; v[2 * j + 1] = (f32x4){hf_lo(vin[j].z), hf_hi(vin[j].z), hf_lo(vin[j].w), hf_hi(vin[j].w)}; }
#pragma unroll
    for (int j = 0; j < 8; ++j) s += (v[j][0] + v[j][1]) + (v[j][2] + v[j][3]);
    const float mean = wave_sum(s) * (1.f / DM); float q = 0.f;
#pragma unroll
    for (int j = 0; j < 8; ++j) { v[j] = v[j] - mean; q += (v[j][0] * v[j][0] + v[j][1] * v[j][1]) + (v[j][2] * v[j][2] + v[j][3] * v[j][3]); }
    const float rstd = rsqrtf(wave_sum(q) * (1.f / DM) + EPS);
    if (lane == 0) { f32x2 ms = {mean, rstd}; *(f32x2*)(ST + (size_t)row * 2) = ms; }
    u32x4* bd = (u32x4*)(HB + (size_t)row * DM) + lane;
#pragma unroll
    for (int j = 0; j < 4; ++j) { const int c4 = 2 * (lane + 64 * j);
        const f32x4 y0 = v[2 * j] * rstd * ((const f32x4*)g)[c4] + ((const f32x4*)b)[c4], y1 = v[2 * j + 1] * rstd * ((const f32x4*)g)[c4 + 1] + ((const f32x4*)b)[c4 + 1];
        bd[64 * j] = pg8::pack8(y0, y1);
        if (out) { f32x4* op = (f32x4*)(out + (size_t)row * DM) + c4; op[0] = y0; op[1] = y1; } }
}
__device__ __forceinline__ void ln_rows(const Frame& F, float* H, bf16_t* HB, const float* g, const float* b, float* ST, float* out, const float* PART, int nk) {
    const bf16_t* __restrict__ Hr = (const bf16_t*)H;
    for (int row = F.gw; row < NMAIN; row += 2 * F.ngw) {
        const int row2 = row + F.ngw;
        u32x4 va[4], vb[4];
#pragma unroll
        for (int j = 0; j < 4; ++j) va[j] = ((const u32x4*)(Hr + (size_t)row * DM))[F.lane + 64 * j];
#pragma unroll
        for (int j = 0; j < 4; ++j) vb[j] = ((const u32x4*)(Hr + (size_t)row2 * DM))[F.lane + 64 * j];
        ln_one_bf(va, row, F.lane, HB, g, b, ST, out);
        ln_one_bf(vb, row2, F.lane, HB, g, b, ST, out);
    }
    if (F.gw < TP - NMAIN) {
        const int row = NMAIN + F.gw; const float* __restrict__ Hm = H; f32x4 va[8];
#pragma unroll
        for (int j = 0; j < 8; ++j) va[j] = ((const f32x4*)(Hm + (size_t)row * DM))[F.lane + 64 * j];
        for (int k = 0; k < nk; ++k) {
            const float* __restrict__ pp = PART + ((size_t)k * 256 + F.gw) * DM;
#pragma unroll
            for (int j = 0; j < 8; ++j) va[j] += ((const f32x4*)pp)[F.lane + 64 * j]; }
        ln_one(va, row, F.lane, H, HB, g, b, ST);
    }
}

__device__ __forceinline__ void rstd_rows(const Frame& F, const bf16_t* UDQ, const bf16_t* UDKV, float* RSTD) {
    for (int row = F.gw; row < TP; row += F.ngw) {
        const u32x4 a = ((const u32x4*)(UDQ + (size_t)row * 512))[F.lane]; float s = 0.f;
#pragma unroll
        for (int j = 0; j < 4; ++j) { const float x = bf_lo(a[j]), y = bf_hi(a[j]); s += x * x + y * y; }
        float t = 0.f;
        if (F.lane < 32) { const u32x4 c = ((const u32x4*)(UDKV + (size_t)row * 256))[F.lane];
#pragma unroll
            for (int j = 0; j < 4; ++j) { const float x = bf_lo(c[j]), y = bf_hi(c[j]); t += x * x + y * y; } }
        s = wave_sum(s); t = wave_sum(t);
        if (F.lane == 0) { RSTD[(size_t)row * 2] = rsqrtf(s * (1.f / 512.f) + EPS); RSTD[(size_t)row * 2 + 1] = rsqrtf(t * (1.f / 256.f) + EPS); }
    }
}

__device__ __forceinline__ void mlstm_finalize(const Frame& F, int gw0, int ngw0, const float* HSUM, const bf16_t* UQKVO, const float* ng, bf16_t* MIX) {
    for (int row = gw0; row < TP; row += ngw0) {
#pragma unroll
        for (int j = 0; j < 4; ++j) {
            f32x4 v = ((const f32x4*)(HSUM + (size_t)row * MLW + 256 * j))[F.lane];
            const float mean = wave_sum((v[0] + v[1]) + (v[2] + v[3])) * (1.f / 256.f); v = v - mean;
            const float rstd = rsqrtf(wave_sum((v[0] * v[0] + v[1] * v[1]) + (v[2] * v[2] + v[3] * v[3])) * (1.f / 256.f) + EPS);
            const f32x4 gg = ((const f32x4*)(ng + 256 * j))[F.lane];
            const u32x2 uo = ((const u32x2*)(UQKVO + (size_t)row * 4096 + 3072 + 256 * j))[F.lane];
            const float o0 = bf_lo(uo.x), o1 = bf_hi(uo.x), o2 = bf_lo(uo.y), o3 = bf_hi(uo.y);
            const float y0 = v[0] * rstd * gg[0] / (1.f + __expf(-o0)), y1 = v[1] * rstd * gg[1] / (1.f + __expf(-o1));
            const float y2 = v[2] * rstd * gg[2] / (1.f + __expf(-o2)), y3 = v[3] * rstd * gg[3] / (1.f + __expf(-o3));
            u32x2 w; w.x = pk2(y0, y1); w.y = pk2(y2, y3); ((u32x2*)(MIX + (size_t)row * DM + 256 * j))[F.lane] = w;
        }
    }
}

__device__ __forceinline__ f32x8 ld8f(const float* p) { const f32x4 a = *(const f32x4*)p, b = *(const f32x4*)(p + 4); return (f32x8){a[0], a[1], a[2], a[3], b[0], b[1], b[2], b[3]}; }
__device__ __forceinline__ f32x8 ld8b(const bf16_t* p) { const u32x4 v = *(const u32x4*)p; return (f32x8){bf_lo(v[0]), bf_hi(v[0]), bf_lo(v[1]), bf_hi(v[1]), bf_lo(v[2]), bf_hi(v[2]), bf_lo(v[3]), bf_hi(v[3])}; }
__device__ __forceinline__ void act_store(bf16_t* dst, const f32x8 gp, const f32x8 gc, const f32x8 gn, const f32x8 vv, const f32x8 w0, const f32x8 w1, const f32x8 w2, const f32x8 bb) {
    float o[8];
#pragma unroll
    for (int i = 0; i < 8; ++i) { const float x = w0[i] * gp[i] + w1[i] * gc[i] + w2[i] * gn[i] + bb[i]; o[i] = x / (1.f + __expf(-x)) * vv[i]; }
    u32x4 w; w.x = pk2(o[0], o[1]); w.y = pk2(o[2], o[3]); w.z = pk2(o[4], o[5]); w.w = pk2(o[6], o[7]); *(u32x4*)dst = w;
}
__device__ __forceinline__ void ffn_fixup(const Frame& F, const float* SIDE, const bf16_t* GVM, bf16_t* ACT, const float* cw, const float* cb) {
    constexpr int NCH = DFF / 8;
    const f32x8 zero = {0.f, 0.f, 0.f, 0.f, 0.f, 0.f, 0.f, 0.f};
    const int gt = F.bx * 512 + F.tid, nt = GRID * 512;
    for (int idx = gt; idx < 192 * 2 * NCH; idx += nt) {
        const int ch = idx % NCH, rsel = (idx / NCH) & 1, pm = idx / (2 * NCH), c0 = 8 * ch, sq = pm >> 4;
        const f32x8 w0 = ld8f(cw + c0), w1 = ld8f(cw + DFF + c0), w2 = ld8f(cw + 2 * DFF + c0), bb = ld8f(cb + c0);
        const float* S0 = SIDE + (size_t)pm * 6 * DFF + c0;
        if (rsel == 0) { const f32x8 gp = (pm & 15) ? ld8f(S0 - 6 * DFF + 3 * DFF) : ld8b(GVM + (size_t)(16 * sq + 15) * NUP + c0);
            act_store(ACT + (size_t)(pm * 256) * DFF + c0, gp, ld8f(S0), ld8f(S0 + DFF), ld8f(S0 + 4 * DFF), w0, w1, w2, bb);
        } else { const f32x8 gn = ((pm & 15) != 15) ? ld8f(S0 + 6 * DFF) : zero;
            act_store(ACT + (size_t)(pm * 256 + 255) * DFF + c0, ld8f(S0 + 2 * DFF), ld8f(S0 + 3 * DFF), gn, ld8f(S0 + 5 * DFF), w0, w1, w2, bb); }
    }
    for (int idx = gt; idx < NSEQ * NCH; idx += nt) {
        const int ch = idx % NCH, sq = idx / NCH, c0 = 8 * ch;
        const f32x8 w0 = ld8f(cw + c0), w1 = ld8f(cw + DFF + c0), w2 = ld8f(cw + 2 * DFF + c0), bb = ld8f(cb + c0);
        f32x8 gp = zero, gc = ld8b(GVM + (size_t)(16 * sq) * NUP + c0);
        for (int p = 0; p < 16; ++p) {
            const f32x8 gn = p < 15 ? ld8b(GVM + (size_t)(16 * sq + p + 1) * NUP + c0) : ld8f(SIDE + (size_t)(16 * sq) * 6 * DFF + c0);
            act_store(ACT + (size_t)(MROW0 + 16 * sq + p) * DFF + c0, gp, gc, gn, ld8b(GVM + (size_t)(16 * sq + p) * NUP + DFF + c0), w0, w1, w2, bb);
            gp = gc; gc = gn;
        }
    }
}

namespace att {
constexpr int NW = 8, QBLK = 32, KVBLK = 64, NT = 65;
constexpr int KROW = 400;
constexpr int SHM_V = KVBLK * 128 * 2, SHM_K = KVBLK * KROW;
constexpr int OFF_V = 0, OFF_K = 3 * SHM_V, OFF_WS = OFF_K + 3 * SHM_K, LDS_TOTAL = OFF_WS + NW * 64 * 4;
static_assert(LDS_TOTAL <= RING_BYTES, "attention LDS");
constexpr float SCALE = 0.07216878364870323f;
constexpr float THR = 8.f;
#define SBAR() __builtin_amdgcn_sched_barrier(0)
__device__ __forceinline__ int crow(int r, int hi) { return (r & 3) + 8 * (r >> 2) + 4 * hi; }
__device__ __forceinline__ unsigned cvtpk(float lo, float hi) { unsigned r; asm volatile("v_cvt_pk_bf16_f32 %0, %1, %2" : "=v"(r) : "v"(lo), "v"(hi)); return r; }

template <bool MASK16>
__device__ __forceinline__ void partialSM(f32x16& p0, f32x16& p1, float& m_reg, float& mn, float& alpha) {
    constexpr float C = SCALE * 1.4426950408889634f;
    if (MASK16) {
#pragma unroll
        for (int r = 8; r < 16; ++r) p0[r] = NEGBIG;
#pragma unroll
        for (int r = 0; r < 16; ++r) p1[r] = NEGBIG;
    }
    float pmax = p0[0];
#pragma unroll
    for (int r = 1; r < 16; ++r) pmax = fmaxf(pmax, p0[r]);
#pragma unroll
    for (int r = 0; r < 16; ++r) pmax = fmaxf(pmax, p1[r]);
    { auto rr = __builtin_amdgcn_permlane32_swap(__float_as_uint(pmax), __float_as_uint(pmax), false, false); pmax = fmaxf(__uint_as_float(rr[0]), __uint_as_float(rr[1])); }
    if (__builtin_expect(__all(pmax - m_reg <= THR / SCALE), 1)) { mn = m_reg; alpha = 1.f; }
    else { mn = fmaxf(m_reg, pmax); alpha = __builtin_amdgcn_exp2f((m_reg - mn) * C); m_reg = mn; }
    const float mnC = -mn * C;
#pragma unroll
    for (int r = 0; r < 16; ++r) p0[r] = fmaf(p0[r], C, mnC);
#pragma unroll
    for (int r = 0; r < 16; ++r) p1[r] = fmaf(p1[r], C, mnC);
#pragma unroll
    for (int r = 0; r < 16; ++r) p0[r] = __builtin_amdgcn_exp2f(p0[r]);
}
__device__ __forceinline__ void finishSM(f32x16& p0, f32x16& p1, float alpha, float& l_reg, bf16x8& pa0, bf16x8& pa1, bf16x8& pa2, bf16x8& pa3) {
#pragma unroll
    for (int r = 0; r < 16; ++r) p1[r] = __builtin_amdgcn_exp2f(p1[r]);
    float ps = 0;
#pragma unroll
    for (int r = 0; r < 16; ++r) ps += p0[r];
#pragma unroll
    for (int r = 0; r < 16; ++r) ps += p1[r];
    { auto rr = __builtin_amdgcn_permlane32_swap(__float_as_uint(ps), __float_as_uint(ps), false, false); ps = __uint_as_float(rr[0]) + __uint_as_float(rr[1]); }
    l_reg = l_reg * alpha + ps;
#define PK4(P, BASE, OUT) do { unsigned a0 = cvtpk(P[BASE + 0], P[BASE + 1]), a1 = cvtpk(P[BASE + 2], P[BASE + 3]);   \
    unsigned b0 = cvtpk(P[BASE + 4], P[BASE + 5]), b1 = cvtpk(P[BASE + 6], P[BASE + 7]);                              \
    auto r0 = __builtin_amdgcn_permlane32_swap(a0, b0, false, false); auto r1 = __builtin_amdgcn_permlane32_swap(a1, b1, false, false); \
    u32x4 w = {r0[0], r1[0], r0[1], r1[1]}; OUT = __builtin_bit_cast(bf16x8, w); } while (0)
    PK4(p0, 0, pa0); PK4(p0, 8, pa1); PK4(p1, 0, pa2); PK4(p1, 8, pa3);
#undef PK4
}
__device__ __forceinline__ void qkt(f32x16& p0, f32x16& p1, const LAS char* Ks, const bf16x8* qr, int r32, int hi) {
#pragma unroll
    for (int r = 0; r < 16; ++r) { p0[r] = 0.f; p1[r] = 0.f; }
#pragma unroll
    for (int d0 = 0; d0 < 12; ++d0) { const int cb = (d0 * 16 + hi * 8) * 2;
        const bf16x8 b0 = *(const LAS bf16x8*)(Ks + r32 * KROW + cb);
        const bf16x8 b1 = *(const LAS bf16x8*)(Ks + (32 + r32) * KROW + cb);
        p0 = __builtin_amdgcn_mfma_f32_32x32x16_bf16(b0, qr[d0], p0, 0, 0, 0);
        p1 = __builtin_amdgcn_mfma_f32_32x32x16_bf16(b1, qr[d0], p1, 0, 0, 0); }
}
__device__ __forceinline__ int v_st(int k, int c) { const int kk = (k & ~0xC) | ((k & 4) << 1) | ((k & 8) >> 1); return ((kk >> 3) * 4 + (c >> 5)) * 512 + ((kk & 7) * 32 + (c & 31)) * 2; }
__device__ __forceinline__ int v_rd_base(int lane) { return ((lane & 3) << 3) | (((lane >> 2) & 3) << 6) | (((lane >> 4) & 1) << 5) | (((lane >> 5) & 1) << 8); }
constexpr int v_rd_off(int d0, int ks, int half) { return d0 * 512 + ks * 4096 + half * 2048; }
template <int OFF> __device__ __forceinline__ s16x4 tr_read(int vb) { s16x4 r; asm volatile("ds_read_b64_tr_b16 %0, %1 offset:%2" : "=&v"(r) : "v"(vb), "i"(OFF) : "memory"); return r; }
template <int D0> __device__ __forceinline__ void pv_one(f32x16& od, int vb, bf16x8 pa0, bf16x8 pa1, bf16x8 pa2, bf16x8 pa3) {
    const s16x4 l0 = tr_read<v_rd_off(D0, 0, 0)>(vb), h0 = tr_read<v_rd_off(D0, 0, 1)>(vb), l1 = tr_read<v_rd_off(D0, 1, 0)>(vb), h1 = tr_read<v_rd_off(D0, 1, 1)>(vb);
    const s16x4 l2 = tr_read<v_rd_off(D0, 2, 0)>(vb), h2 = tr_read<v_rd_off(D0, 2, 1)>(vb), l3 = tr_read<v_rd_off(D0, 3, 0)>(vb), h3 = tr_read<v_rd_off(D0, 3, 1)>(vb);
    asm volatile("s_waitcnt lgkmcnt(0)" ::: "memory"); SBAR();
#define PKV(L, H) (bf16x8){L[0], L[1], L[2], L[3], H[0], H[1], H[2], H[3]}
    od = __builtin_amdgcn_mfma_f32_32x32x16_bf16(pa0, PKV(l0, h0), od, 0, 0, 0);
    od = __builtin_amdgcn_mfma_f32_32x32x16_bf16(pa1, PKV(l1, h1), od, 0, 0, 0);
    od = __builtin_amdgcn_mfma_f32_32x32x16_bf16(pa2, PKV(l2, h2), od, 0, 0, 0);
    od = __builtin_amdgcn_mfma_f32_32x32x16_bf16(pa3, PKV(l3, h3), od, 0, 0, 0);
#undef PKV
}
__device__ __forceinline__ void pv_d0(f32x16* o, int vb, bf16x8 pa0, bf16x8 pa1, bf16x8 pa2, bf16x8 pa3) {
    pv_one<0>(o[0], vb, pa0, pa1, pa2, pa3); pv_one<1>(o[1], vb, pa0, pa1, pa2, pa3); pv_one<2>(o[2], vb, pa0, pa1, pa2, pa3); pv_one<3>(o[3], vb, pa0, pa1, pa2, pa3);
}

__device__ __forceinline__ void attn_unit(int s, int h, int qb, const bf16_t* __restrict__ MQ, const bf16_t* __restrict__ MKV, const bf16_t* __restrict__ KR, bf16_t* __restrict__ MIX, LAS char* lds) {
    int tid_ = threadIdx.x; asm volatile("" : "+v"(tid_));
    const int tid = tid_, wid = tid >> 6, lane = tid & 63, r32 = lane & 31, hi = lane >> 5;
    LAS char* V_lds = lds + OFF_V; LAS char* K_lds = lds + OFF_K;
    LAS float* wsf = (LAS float*)(lds + OFF_WS) + wid * 64; LAS float* li_l = wsf; LAS float* al_l = wsf + 32;
    float m_reg = NEGBIG, l_reg = 0; f32x16 o[4]; bf16x8 qr[12];
#pragma unroll
    for (int d = 0; d < 4; ++d)
#pragma unroll
        for (int r = 0; r < 16; ++r) o[d][r] = 0.f;
    const int qi = wid * QBLK + r32;
    const unsigned qrow = qb < 16 ? (unsigned)s * LREAL + 256 * qb + qi : (unsigned)MROW0 + 16 * s + (qi < 15 ? qi : 15);
    { const bf16_t* Qw = MQ + (qrow * NQ + h * 192 + hi * 8);
#pragma unroll
      for (int d0 = 0; d0 < 12; ++d0) qr[d0] = *(const bf16x8*)(Qw + d0 * 16); }
    const int sr = tid >> 4, sc = (tid & 15) * 8, vst0 = v_st(sr, sc), vst1 = v_st(32 + sr, sc);
    const int kr_r = tid >> 3, kr_c = (tid & 7) * 8;
    const int vb0 = (int)(uintptr_t)V_lds + v_rd_base(lane);
    bf16x8 vs0, vs1, ks0, ks1, kr0;
    const unsigned mainrow0 = (unsigned)s * LREAL, metarow0 = (unsigned)MROW0 + 16 * s;
    const bf16_t* MKVh = MKV + h * 256;
#define KROWG(kt, k) ((kt) < 64 ? mainrow0 + 64u * (kt) + (k) : metarow0 + ((k) < 15 ? (k) : 15))
#define SLOAD(kt) do { const unsigned g0 = KROWG(kt, sr) * NKV + sc, g1 = KROWG(kt, 32 + sr) * NKV + sc, g2 = KROWG(kt, kr_r) * 64 + kr_c; \
    vs0 = *(const bf16x8*)(MKVh + 128 + g0); vs1 = *(const bf16x8*)(MKVh + 128 + g1); \
    ks0 = *(const bf16x8*)(MKVh + g0); ks1 = *(const bf16x8*)(MKVh + g1); kr0 = *(const bf16x8*)(KR + g2); } while (0)
#define SWRITE(b) do { *(LAS bf16x8*)(V_lds + (b) * SHM_V + vst0) = vs0; *(LAS bf16x8*)(V_lds + (b) * SHM_V + vst1) = vs1; \
    *(LAS bf16x8*)(K_lds + (b) * SHM_K + sr * KROW + sc * 2) = ks0; *(LAS bf16x8*)(K_lds + (b) * SHM_K + (32 + sr) * KROW + sc * 2) = ks1; \
    *(LAS bf16x8*)(K_lds + (b) * SHM_K + kr_r * KROW + 256 + kr_c * 2) = kr0; } while (0)
#define RESC(a) do { if (__any((a) < 1.f)) { if (hi == 0) al_l[r32] = (a); asm volatile("s_waitcnt lgkmcnt(0)" ::: "memory"); \
    _Pragma("unroll") for (int d = 0; d < 4; ++d) _Pragma("unroll") for (int r = 0; r < 16; ++r) o[d][r] *= al_l[crow(r, hi)]; } } while (0)
    f32x16 pA0, pA1, pB0, pB1; float mnA, mnB, alA, alB; bf16x8 pa0, pa1, pa2, pa3;
    __syncthreads();
    SLOAD(0); SWRITE(0); __syncthreads();
    qkt(pA0, pA1, K_lds, qr, r32, hi); partialSM<false>(pA0, pA1, m_reg, mnA, alA);
    SLOAD(1); SWRITE(1); __syncthreads();
    RESC(alA);
    int s0 = 0, s1 = 1, s2 = 2;
    for (int j = 1; j + 1 < NT; j += 2) {
        SBAR(); qkt(pB0, pB1, K_lds + s1 * SHM_K, qr, r32, hi);
        finishSM(pA0, pA1, alA, l_reg, pa0, pa1, pa2, pa3); SBAR();
        SLOAD(j + 1); SBAR();
        pv_d0(o, vb0 + s0 * SHM_V, pa0, pa1, pa2, pa3); partialSM<false>(pB0, pB1, m_reg, mnB, alB);
        SWRITE(s2);
        RESC(alB); __syncthreads();
        SBAR(); qkt(pA0, pA1, K_lds + s2 * SHM_K, qr, r32, hi);
        finishSM(pB0, pB1, alB, l_reg, pa0, pa1, pa2, pa3); SBAR();
        if (j + 2 < NT) SLOAD(j + 2); SBAR();
        pv_d0(o, vb0 + s1 * SHM_V, pa0, pa1, pa2, pa3);
        if (j + 1 == NT - 1) partialSM<true>(pA0, pA1, m_reg, mnA, alA); else partialSM<false>(pA0, pA1, m_reg, mnA, alA);
        if (j + 2 < NT) SWRITE(s0);
        RESC(alA); __syncthreads();
        { const int t0 = s0, t1 = s1; s0 = s2; s1 = t0; s2 = t1; }
    }
    finishSM(pA0, pA1, alA, l_reg, pa0, pa1, pa2, pa3); SBAR();
    pv_d0(o, vb0 + s0 * SHM_V, pa0, pa1, pa2, pa3);
    if (hi == 0) li_l[r32] = l_reg; asm volatile("s_waitcnt lgkmcnt(0)" ::: "memory");
    float rli[16];
#pragma unroll
    for (int r = 0; r < 16; ++r) rli[r] = __builtin_amdgcn_rcpf(li_l[crow(r, hi)]);
    if (qb < 16) {
        bf16_t* Ow = MIX + ((long)s * LREAL + 256 * qb + wid * QBLK) * DM + MLW + h * 128;
#pragma unroll
        for (int r = 0; r < 16; ++r) { const int orow = crow(r, hi);
#pragma unroll
            for (int d0 = 0; d0 < 4; ++d0) Ow[(long)orow * DM + d0 * 32 + r32] = (bf16_t)(pk2(o[d0][r] * rli[r], 0.f) & 0xffffu); }
    } else if (wid == 0) {
        bf16_t* Ow = MIX + ((long)MROW0 + 16 * s) * DM + MLW + h * 128;
#pragma unroll
        for (int r = 0; r < 16; ++r) { const int orow = crow(r, hi);
            if (orow < 16) {
#pragma unroll
                for (int d0 = 0; d0 < 4; ++d0) Ow[(long)orow * DM + d0 * 32 + r32] = (bf16_t)(pk2(o[d0][r] * rli[r], 0.f) & 0xffffu); } }
    }
#undef KROWG
#undef SLOAD
#undef SWRITE
#undef RESC
}
__device__ __forceinline__ void attn_phase(int vcu, const bf16_t* MQ, const bf16_t* MKV, const bf16_t* KR, bf16_t* MIX, LAS char* lds) {
    for (int i = (vcu < 96 ? -1 : 0); i < 6; ++i) { int sh, qb; if (i < 0) { sh = vcu; qb = 16; } else { const int id = i * GRID + vcu; sh = id >> 4; qb = id & 15; }
        attn_unit(sh >> 3, sh & 7, qb, MQ, MKV, KR, MIX, lds); }
}
#undef SBAR
}

namespace ml {
constexpr int QI = 0, KI = 32768, VI = 65536, SI = 81920, CI = 98304;
constexpr int SC_CT = 0, SC_BM = 64, SC_WI = 128, SC_EI = 192, SC_WW = 256, SC_DEN = 320, SC_QN = 448, SC_N = 512, SC_A = 768;
constexpr int GP_REC = 200;
__device__ __forceinline__ unsigned off_b(unsigned row, unsigned ch) { return 256u * row + 16u * (ch ^ (((row & 3) << 2) | ((row >> 2) & 3))); }
__device__ __forceinline__ unsigned row_read_addr_16(unsigned lane, unsigned rb, unsigned s) { return off_b((lane & 15) + 16 * rb, 4 * s + (lane >> 4)); }
__device__ __forceinline__ unsigned tr_read_addr_16(unsigned lane, unsigned c, unsigned ks, unsigned t) {
    const unsigned g = lane >> 4, q = (lane & 15) >> 2, p = lane & 3; return off_b(32 * ks + 8 * g + 4 * t + q, 2 * c + (p >> 1)) + 8 * (p & 1); }
__device__ __forceinline__ bf16x8 tr_frag(unsigned a0, unsigned a1) {
    const s16x4 lo = __builtin_amdgcn_ds_read_tr16_b64_v4i16((LAS s16x4*)a0), hi = __builtin_amdgcn_ds_read_tr16_b64_v4i16((LAS s16x4*)a1);
    return (bf16x8){lo[0], lo[1], lo[2], lo[3], hi[0], hi[1], hi[2], hi[3]};
}
__device__ __forceinline__ f32x4 mfma16(bf16x8 a, bf16x8 b, f32x4 c) { return __builtin_amdgcn_mfma_f32_16x16x32_bf16(a, b, c, 0, 0, 0); }
__device__ __forceinline__ float log_sigmoid(float x) { return fminf(x, 0.f) - __logf(1.f + __expf(-fabsf(x))); }

__device__ __forceinline__ void gate_prep(int gw, int ngw, int lane, const float* __restrict__ GATES, const float* __restrict__ bgl, float* __restrict__ GP) {
    for (int it = gw; it < 96 * 65; it += ngw) {
        const int chain = it / 65, c = it % 65, s = chain >> 3, hd = (chain >> 1) & 3, dir = chain & 1;
        const long g = c == 0 ? (lane >= 48 ? (long)MROW0 + 16 * s + lane - 48 : -1L) : (long)s * LREAL + 64 * (c - 1) + lane;
        float li = NEGBIG, lf = 0.f;
        if (g >= 0) { li = GATES[g * 16 + (dir ? 8 : 0) + hd] + bgl[(dir ? 8 : 0) + hd]; lf = log_sigmoid(GATES[g * 16 + (dir ? 12 : 4) + hd] + bgl[(dir ? 12 : 4) + hd]); }
        float x = dir ? __shfl(lf, 63 - lane) : lf;
#pragma unroll
        for (int o = 1; o < 64; o <<= 1) { const float y = __shfl_up(x, o); if (lane >= o) x += y; }
        const float btot = __shfl(x, 63);
        const float b = dir ? __shfl(x, 63 - lane) : x;
        const float a_s = li - b;
        float pm = dir ? __shfl(a_s, 63 - lane) : a_s;
#pragma unroll
        for (int o = 1; o < 64; o <<= 1) { const float y = __shfl_up(pm, o); if (lane >= o) pm = fmaxf(pm, y); }
        pm = dir ? __shfl(pm, 63 - lane) : pm;
        const float gmax = wave_max(btot - b + li);
        float* rec = GP + (size_t)it * GP_REC;
        rec[lane] = b; rec[64 + lane] = li; rec[128 + lane] = pm; if (lane == 0) { rec[192] = btot; rec[193] = gmax; }
    }
}

__device__ __forceinline__ void mlstm_unit(int s, int hd, int js, const bf16_t* __restrict__ UQKVO, const float* __restrict__ GP, float* __restrict__ HSUM, LAS unsigned char* lds, LAS float* sc) {
    const int wid = __builtin_amdgcn_readfirstlane((int)threadIdx.x >> 6);
    const unsigned ldsb = (unsigned)(uintptr_t)lds;
    const int tt = wid >> 1, nb = 2 * (wid & 1);
#define ROWRD(img, rb, s_) (*(const LAS bf16x8*)(uintptr_t)(RB[s_] + (unsigned)((img) + 4096 * (rb))))
#define TRFRAG(img, c_, ks) tr_frag(BT[0][(c_) & 1] + TQ[(c_) >> 1] + (unsigned)((img) + 8192 * (ks)), BT[1][(c_) & 1] + TQ[(c_) >> 1] + (unsigned)((img) + 8192 * (ks)))
    f32x4 accC[2][4], accN[2];
    for (int dir = 0; dir < 2; ++dir) {
        int tid; { int t0_ = threadIdx.x; asm volatile("" : "+v"(t0_)); tid = t0_; }
#pragma unroll
        for (int mi = 0; mi < 2; ++mi)
#pragma unroll
            for (int c = 0; c < 4; ++c) accC[mi][c] = (f32x4){0.f, 0.f, 0.f, 0.f};
        accN[0] = (f32x4){0.f, 0.f, 0.f, 0.f}; accN[1] = (f32x4){0.f, 0.f, 0.f, 0.f};
        if (tid < 256) sc[SC_N + tid] = 0.f;
        for (int i = tid; i < 32768 / 16; i += 512) *(LAS u32x4*)(lds + CI + i * 16) = (u32x4){0u, 0u, 0u, 0u};
        float m_state = 0.f;
        const float* GPc = GP + (size_t)(((s * 4 + hd) * 2 + dir) * 65) * GP_REC;
        u32x4 sq[4], sk[4], sv; float sb = 0.f, sli = NEGBIG, spm = NEGBIG, sbt = 0.f, sgm = NEGBIG;
#define ROWG(c, r) ((c) == 0 ? ((r) >= 48 ? (long)MROW0 + 16 * s + (r) - 48 : -1L) : (long)s * LREAL + 64 * ((c) - 1) + (r))
#define STAGE_LOAD(c) do { \
        _Pragma("unroll") for (int i = 0; i < 4; ++i) { const int id = tid + 512 * i, r = id >> 5, ch = id & 31; const long g = ROWG(c, r); \
            sq[i] = (u32x4){0u, 0u, 0u, 0u}; sk[i] = (u32x4){0u, 0u, 0u, 0u}; \
            if (g >= 0) { sq[i] = *(const u32x4*)(UQKVO + g * 4096 + hd * 256 + ch * 8); sk[i] = *(const u32x4*)(UQKVO + g * 4096 + 1024 + hd * 256 + ch * 8); } } \
        { const int r = tid >> 3, ch = tid & 7; const long g = ROWG(c, r); sv = (u32x4){0u, 0u, 0u, 0u}; if (g >= 0) sv = *(const u32x4*)(UQKVO + g * 4096 + 2048 + hd * 256 + js * 64 + ch * 8); } \
        if (tid < 64) { const float* rec = GPc + (size_t)(c) * GP_REC; sb = rec[tid]; sli = rec[64 + tid]; spm = rec[128 + tid]; sbt = rec[192]; sgm = rec[193]; } } while (0)
#define STAGE_WRITE() do { \
        _Pragma("unroll") for (int i = 0; i < 4; ++i) { const int id = tid + 512 * i, r = id >> 5, ch = id & 31; \
            *(LAS u32x4*)(lds + QI + (ch >> 4) * 16384 + off_b(r, ch & 15)) = sq[i]; *(LAS u32x4*)(lds + KI + (ch >> 4) * 16384 + off_b(r, ch & 15)) = sk[i]; } \
        { const int r = tid >> 3, ch = tid & 7; *(LAS u32x4*)(lds + VI + off_b(r, ch)) = sv; } \
        if (tid < 64) { const float m_inter = sb + m_state, mt = fmaxf(m_inter, sb + spm); const float m_new = fmaxf(sbt + m_state, sgm); \
            sc[SC_CT + tid] = sli - sb; sc[SC_BM + tid] = sb - mt; sc[SC_WI + tid] = __expf(m_inter - mt); sc[SC_EI + tid] = __expf(-mt); \
            sc[SC_WW + tid] = __expf(sbt - sb + sli - m_new) * 0.0625f; if (tid == 0) sc[SC_A] = __expf(sbt + m_state - m_new); m_state = m_new; } } while (0)
        const int c_first = dir ? 64 : 0, c_step = dir ? -1 : 1;
        STAGE_LOAD(c_first);
        __syncthreads();
        STAGE_WRITE();
        for (int ci = 0; ci < 65; ++ci) {
            const int c = c_first + c_step * ci;
            { int t2_ = threadIdx.x; asm volatile("" : "+v"(t2_)); tid = t2_; }
            const int lane = tid & 63, l15 = lane & 15, lg = lane >> 4;
            unsigned RB[4], BT[2][2], TQ[4];
            { const unsigned fl = ((l15 & 3) << 2) | (l15 >> 2), q = l15 >> 2, p = lane & 3, g = lg;
#pragma unroll
              for (int s_ = 0; s_ < 4; ++s_) { RB[s_] = ldsb + 256u * l15 + 16u * (lg ^ (fl & 3)) + 64u * (s_ ^ (fl >> 2)); TQ[s_] = 64u * (s_ ^ q); }
#pragma unroll
              for (int t_ = 0; t_ < 2; ++t_)
#pragma unroll
                  for (int cl = 0; cl < 2; ++cl) BT[t_][cl] = ldsb + 256u * (8 * g + q) + 8u * (p & 1) + 1024u * t_ + 16u * ((p >> 1) ^ t_) + 32u * (cl ^ (g & 1)); }
            __syncthreads();
            if (ci + 1 < 65) STAGE_LOAD(c + c_step);
            bf16x8 qf[8];
#pragma unroll
            for (int k = 0; k < 8; ++k) qf[k] = ROWRD(QI + (k >> 2) * 16384, tt, k & 3);
            f32x4 sT[2], oc[2];
#pragma unroll
            for (int i = 0; i < 2; ++i) { sT[i] = (f32x4){0.f, 0.f, 0.f, 0.f}; oc[i] = (f32x4){0.f, 0.f, 0.f, 0.f}; }
#pragma unroll
            for (int i = 0; i < 2; ++i)
#pragma unroll
                for (int k = 0; k < 8; ++k) {
                    const bf16x8 kf = ROWRD(KI + (k >> 2) * 16384, nb + i, k & 3);
                    sT[i] = mfma16(kf, qf[k], sT[i]);
                    const bf16x8 cf = ROWRD(CI + (k >> 2) * 16384, nb + i, k & 3);
                    oc[i] = mfma16(qf[k], cf, oc[i]);
                }
            {
                const int t = 16 * tt + l15; const float bmt = sc[SC_BM + t]; float rs = 0.f;
#pragma unroll
                for (int i = 0; i < 2; ++i) { const int s0 = 16 * (nb + i) + 4 * lg; const f32x4 ctv = *(const LAS f32x4*)(sc + SC_CT + s0); float v[4];
#pragma unroll
                    for (int e = 0; e < 4; ++e) { const int sx = s0 + e; const bool ok = dir ? (sx >= t) : (sx <= t);
                        const float ex = ok ? (bmt + ctv[e]) : NEGBIG; v[e] = sT[i][e] * 0.0625f * __expf(ex); rs += v[e]; }
                    u32x2 w; w.x = pk2(v[0], v[1]); w.y = pk2(v[2], v[3]);
                    *(LAS u32x2*)(lds + SI + off_b(t, s0 >> 3) + (s0 & 7) * 2) = w; }
                rs += __shfl_xor(rs, 16); rs += __shfl_xor(rs, 32);
                if (lg == 0) sc[SC_DEN + 64 * (wid & 1) + t] = rs;
            }
            { const int r = tid >> 3, ch = tid & 7; const u32x4 v = *(const LAS u32x4*)(lds + VI + off_b(r, ch)); const float w = sc[SC_WW + r]; u32x4 o;
#pragma unroll
              for (int jx = 0; jx < 4; ++jx) o[jx] = pk2(bf_lo(v[jx]) * w, bf_hi(v[jx]) * w);
              *(LAS u32x4*)(lds + VI + off_b(r, 8 + ch)) = o; }
            { const int r = tid >> 3, part = tid & 7; float d = 0.f;
#pragma unroll
              for (int i = 0; i < 4; ++i) { const int ch32 = part * 4 + i; const u32x4 v = *(const LAS u32x4*)(lds + QI + (ch32 >> 4) * 16384 + off_b(r, ch32 & 15));
                  const f32x4 n0 = *(const LAS f32x4*)(sc + SC_N + ch32 * 8), n1 = *(const LAS f32x4*)(sc + SC_N + ch32 * 8 + 4);
                  d += bf_lo(v[0]) * n0[0] + bf_hi(v[0]) * n0[1] + bf_lo(v[1]) * n0[2] + bf_hi(v[1]) * n0[3] + bf_lo(v[2]) * n1[0] + bf_hi(v[2]) * n1[1] + bf_lo(v[3]) * n1[2] + bf_hi(v[3]) * n1[3]; }
              d += __shfl_xor(d, 1); d += __shfl_xor(d, 2); d += __shfl_xor(d, 4);
              if (part == 0) sc[SC_QN + r] = d; }
            { const f32x4 wi = *(const LAS f32x4*)(sc + SC_WI + 16 * tt + 4 * lg);
#pragma unroll
              for (int i = 0; i < 2; ++i) oc[i] = oc[i] * wi; }
            __syncthreads();
            const float a_dec = sc[SC_A];
#pragma unroll
            for (int ks = 0; ks < 2; ++ks) { const bf16x8 sf = ROWRD(SI, tt, ks);
#pragma unroll
                for (int i = 0; i < 2; ++i) { const bf16x8 vf = TRFRAG(VI, nb + i, ks);
                    oc[i] = mfma16(sf, vf, oc[i]); } }
            { const int t0 = 16 * tt + 4 * lg;
              const f32x4 wi = *(const LAS f32x4*)(sc + SC_WI + t0), qn = *(const LAS f32x4*)(sc + SC_QN + t0), d0 = *(const LAS f32x4*)(sc + SC_DEN + t0), d1 = *(const LAS f32x4*)(sc + SC_DEN + 64 + t0), ei = *(const LAS f32x4*)(sc + SC_EI + t0);
#pragma unroll
              for (int e = 0; e < 4; ++e) { const long g = ROWG(c, t0 + e);
                const float den = wi[e] * qn[e] + (d0[e] + d1[e]); const float inv = 1.f / fmaxf(fabsf(den), ei[e]);
                if (g >= 0) {
#pragma unroll
                    for (int i = 0; i < 2; ++i) { float* hp = HSUM + g * MLW + hd * 256 + js * 64 + 16 * (nb + i) + l15; const float hv = oc[i][e] * inv; if (dir) unsafeAtomicAdd(hp, hv); else *hp = hv; } } } }
#pragma unroll
            for (int mi = 0; mi < 2; ++mi)
#pragma unroll
                for (int cc = 0; cc < 4; ++cc) accC[mi][cc] = accC[mi][cc] * a_dec;
            accN[0] = accN[0] * a_dec; accN[1] = accN[1] * a_dec;
            const unsigned ktq = (unsigned)(KI + (wid >> 2) * 16384) + 64u * ((unsigned)(wid & 3) ^ (unsigned)(l15 >> 2));
#pragma unroll
            for (int ks = 0; ks < 2; ++ks) {
                bf16x8 kf[2], wf[4];
#pragma unroll
                for (int mi = 0; mi < 2; ++mi) kf[mi] = tr_frag(BT[0][mi] + ktq + (unsigned)(8192 * ks), BT[1][mi] + ktq + (unsigned)(8192 * ks));
#pragma unroll
                for (int cc = 0; cc < 4; ++cc) wf[cc] = TRFRAG(VI, 4 + cc, ks);
                { const f32x4 wa = *(const LAS f32x4*)(sc + SC_WW + 32 * ks + 8 * lg), wb = *(const LAS f32x4*)(sc + SC_WW + 32 * ks + 8 * lg + 4);
                  u32x4 wq; wq.x = pk2(wa[0], wa[1]); wq.y = pk2(wa[2], wa[3]); wq.z = pk2(wb[0], wb[1]); wq.w = pk2(wb[2], wb[3]);
                  if (l15 != 0) wq = (u32x4){0u, 0u, 0u, 0u};
                  const bf16x8 wfn = __builtin_bit_cast(bf16x8, wq);
#pragma unroll
                  for (int mi = 0; mi < 2; ++mi) accN[mi] = mfma16(kf[mi], wfn, accN[mi]); }
#pragma unroll
                for (int mi = 0; mi < 2; ++mi)
#pragma unroll
                    for (int cc = 0; cc < 4; ++cc) accC[mi][cc] = mfma16(kf[mi], wf[cc], accC[mi][cc]);
            }
#pragma unroll
            for (int mi = 0; mi < 2; ++mi)
#pragma unroll
                for (int cc = 0; cc < 4; ++cc) { const int dk0 = 32 * wid + 16 * mi + 4 * lg, dv = 16 * cc + l15; u32x2 w; w.x = pk2(accC[mi][cc][0], accC[mi][cc][1]); w.y = pk2(accC[mi][cc][2], accC[mi][cc][3]);
                    *(LAS u32x2*)(lds + CI + (dk0 >> 7) * 16384 + off_b(dv, (dk0 & 127) >> 3) + (dk0 & 7) * 2) = w; }
            if (l15 == 0) { *(LAS f32x4*)(sc + SC_N + 32 * wid + 4 * lg) = accN[0]; *(LAS f32x4*)(sc + SC_N + 32 * wid + 16 + 4 * lg) = accN[1]; }
            __syncthreads();
            if (ci + 1 < 65) STAGE_WRITE();
        }
    }
#undef ROWG
#undef STAGE_LOAD
#undef STAGE_WRITE
#undef ROWRD
#undef TRFRAG
}
__device__ __forceinline__ void mlstm_phase(int bx, const bf16_t* UQKVO, const float* GP, float* HSUM, LAS unsigned char* lds, LAS float* sc) {
    if (bx >= 192) return;
    const int xcd = bx & 7, idx = bx >> 3, pair = xcd * 6 + (idx >> 2), js = idx & 3;
    mlstm_unit(pair >> 2, pair & 3, js, UQKVO, GP, HSUM, lds, sc);
}
}

#ifndef PHM
#define PHM 0xffff
#endif
#ifndef REP_ML
#define REP_ML 1
#endif
#ifndef REP_ATTN
#define REP_ATTN 1
#endif
#ifndef REP_CONV
#define REP_CONV 1
#endif
#ifndef REP_SMALL
#define REP_SMALL 1
#endif
#ifndef KV_SPLIT
#define KV_SPLIT 193
#endif
#ifndef REP_WIN
#define REP_WIN 1
#endif
#ifndef REP_UP
#define REP_UP 1
#endif
__global__ void __launch_bounds__(512, 2) fwd_kernel(Params P, unsigned char* ws_arg, unsigned char* out_arg) {
    extern __shared__ __attribute__((aligned(16))) unsigned char lds_raw[];
    Frame F;
    F.lds = (LAS unsigned char*)lds_raw;
    F.tid = threadIdx.x; F.lane = F.tid & 63; F.wave = __builtin_amdgcn_readfirstlane(F.tid >> 6);
    F.G = GRID; F.bx = blockIdx.x; F.vcu = (F.bx % 8) * (GRID / 8) + F.bx / 8;
    F.gw = F.vcu * 8 + F.wave; F.ngw = F.G * 8;
    { unsigned char* ws0 = ws_arg;
      for (int u = F.tid; u < (LDS_BYTES - MISC_OFF) / 4; u += 512) ((LAS unsigned*)(F.lds + MISC_OFF))[u] = 0u;
      __syncthreads();
      (void)ws0; }
    LAS unsigned long long* ptab = (LAS unsigned long long*)(F.lds + MISC_OFF + 64);
    if (F.tid == 0) {
#pragma unroll
        for (int k = 0; k < 19; ++k) ptab[k] = (unsigned long long)(uintptr_t)P.in[k]; }
    __syncthreads();
    XcdBarrier bar = xcd_barrier_post((unsigned*)(ws_arg + WS_CTL) + CW_BAR, (volatile LAS unsigned*)(F.lds + MISC_OFF));
    LAS float* sc = (LAS float*)(F.lds + MISC_OFF + 1024);
#define BXL() ({ int b__ = F.bx; asm volatile("" : "+s"(b__)); b__; })
#define PFRAME() Frame Fp = F; { int t_ = threadIdx.x; asm volatile("" : "+v"(t_)); Fp.tid = t_; Fp.lane = t_ & 63; int b_ = BXL(); Fp.bx = b_; Fp.vcu = (b_ % 8) * (GRID / 8) + b_ / 8; Fp.gw = Fp.vcu * 8 + Fp.wave; }
#define WSB() ({ GAS unsigned char* w__ = (GAS unsigned char*)ws_arg; asm volatile("" : "+s"(w__)); (unsigned char*)w__; })
#ifndef STAG_N
#define STAG_N 1
#endif
#ifdef STAG_ON
#define STAGGER() do { int s__ = (BXL() * 37) & 255; for (int i__ = 0; i__ < s__; ++i__) __builtin_amdgcn_s_sleep(STAG_N); } while (0)
#else
#define STAGGER() do {} while (0)
#endif
#define DOB() ({ GAS unsigned char* w__ = (GAS unsigned char*)out_arg; asm volatile("" : "+s"(w__)); (unsigned char*)w__; })

    { unsigned char* ws = WSB(); prologue(F, ws, ptab); convert_weights(F, ws, ptab, 0); }
    xcd_barrier(bar);

    for (int l = 0; l < DEPTH; ++l) {
        { unsigned char* ws = WSB();
          pg8::Gemm g{(bf16_t*)(ws + WS_HB), (bf16_t*)(ws + WS_WIN), TP, NIN, DM, DM}; pg8::PanelOrder S; S.init(NPAN, 0, 0, 0, NIN, F.G, BXL());
          pg8::EpiWin E{(bf16_t*)(ws + WS_UQKVO), (bf16_t*)(ws + WS_UDQ), (bf16_t*)(ws + WS_UDKV), (bf16_t*)(ws + WS_KR), (float*)(ws + WS_GATES), (const float*)(ws + WS_COS), (const float*)(ws + WS_SIN)};
#if PHM & 2
          STAGGER(); pg8::gemm_phase<pg8::EpiWin, pg8::PanelOrder, true, true>(F.lds, g, S, E);
#endif
        }
#if REP_WIN > 1
        __syncthreads();
        { unsigned char* ws = WSB();
          pg8::Gemm g{(bf16_t*)(ws + WS_HB), (bf16_t*)(ws + WS_WIN), TP, NIN, DM, DM}; pg8::PanelOrder S; S.init(NPAN, 0, 0, 0, NIN, F.G, BXL());
          pg8::EpiWin E{(bf16_t*)(ws + WS_UQKVO), (bf16_t*)(ws + WS_UDQ), (bf16_t*)(ws + WS_UDKV), (bf16_t*)(ws + WS_KR), (float*)(ws + WS_GATES), (const float*)(ws + WS_COS), (const float*)(ws + WS_SIN)};
          pg8::gemm_phase<pg8::EpiWin, pg8::PanelOrder, true, true>(F.lds, g, S, E);
        }
#endif
        xcd_barrier(bar);
        { unsigned char* ws = WSB(); unsigned char* dob = DOB(); PFRAME(); rstd_rows(Fp, (bf16_t*)(ws + WS_UDQ), (bf16_t*)(ws + WS_UDKV), (float*)(ws + WS_RSTD));
          ml::gate_prep(Fp.gw, Fp.ngw, Fp.lane, (const float*)(ws + WS_GATES), (const float*)(ws + WS_PAR) + PO_BG + l * 16, (float*)(dob + DO_GP)); }
#if REP_SMALL > 1
        { unsigned char* ws = WSB(); unsigned char* dob = DOB(); PFRAME(); rstd_rows(Fp, (bf16_t*)(ws + WS_UDQ), (bf16_t*)(ws + WS_UDKV), (float*)(ws + WS_RSTD));
          ml::gate_prep(Fp.gw, Fp.ngw, Fp.lane, (const float*)(ws + WS_GATES), (const float*)(ws + WS_PAR) + PO_BG + l * 16, (float*)(dob + DO_GP)); }
#endif
        xcd_barrier(bar);
        if (F.bx >= 192) {
        { unsigned char* ws = WSB(); unsigned char* dob = DOB();
          pg8::Gemm g{(bf16_t*)(ws + WS_UDQ), (bf16_t*)(ws + WS_WUQ), TP, NQ, 512, 512}; pg8::PanelOrder S; S.init(NPAN, 0, 0, 0, NQ, GRID - 192, BXL() - 192);
          pg8::EpiQ E{(bf16_t*)(dob + DO_MQ), (const float*)(ws + WS_RSTD), (const float*)(ws + WS_COS), (const float*)(ws + WS_SIN)};
#if PHM & 4
          pg8::gemm_phase<pg8::EpiQ, pg8::PanelOrder, true, true>(F.lds, g, S, E);
#endif
        }
        { unsigned char* ws = WSB();
          pg8::Gemm g{(bf16_t*)(ws + WS_UDKV), (bf16_t*)(ws + WS_WUKV), TP, NKV, 256, 256}; pg8::PanelOrder S; S.init(NPAN, 0, 0, 0, NKV, GRID - 192, BXL() - 192);
          pg8::EpiBf16G E{(bf16_t*)(ws + WS_MKV), NKV, (const float*)(ws + WS_RSTD) + 1, 0, -1, 0};
#if PHM & 8
          pg8::gemm_phase<pg8::EpiBf16G, pg8::PanelOrder, true, true>(F.lds, g, S, E);
#endif
        }
        } else {
#ifndef NO_ML
        for (int rep_ = 0; rep_ < REP_ML; ++rep_)
        { unsigned char* ws = WSB(); unsigned char* dob = DOB();
          ml::mlstm_phase(BXL(), (const bf16_t*)(ws + WS_UQKVO), (const float*)(dob + DO_GP), (float*)(dob + DO_HSUM), F.lds, sc); }
#endif
        }
        xcd_barrier(bar);
        { unsigned char* ws = WSB(); unsigned char* dob = DOB(); PFRAME();
          if (Fp.vcu >= 96) mlstm_finalize(Fp, (Fp.vcu - 96) * 8 + Fp.wave, (GRID - 96) * 8, (const float*)(dob + DO_HSUM), (const bf16_t*)(ws + WS_UQKVO), (const float*)(ws + WS_PAR) + PO_MLG + l * MLW, (bf16_t*)(ws + WS_HB)); }
#ifndef NO_ATTN
        for (int rep_ = 0; rep_ < REP_ATTN; ++rep_)
        { unsigned char* ws = WSB(); unsigned char* dob = DOB();
          att::attn_phase(({ int b__ = BXL(); (b__ % 8) * (GRID / 8) + b__ / 8; }), (const bf16_t*)(dob + DO_MQ), (const bf16_t*)(ws + WS_MKV), (const bf16_t*)(ws + WS_KR), (bf16_t*)(ws + WS_HB), (LAS char*)F.lds); }
#endif
        xcd_barrier(bar);
        { unsigned char* ws = WSB();
          pg8::Gemm g{(bf16_t*)(ws + WS_HB), (bf16_t*)(ws + WS_WOUT), TP, DM, DM, DM}; pg8::PanelOrder S; S.init(192, 0, 0, 0, DM, F.G, BXL());
          pg8::EpiResidLn E{(bf16_t*)(ws + WS_H), DM, ALPHA, (const float*)(ws + WS_STAT2), (const float*)(ws + WS_PAR) + (l > 0 ? PO_L2G + (l - 1) * DM : PO_ONE), (const float*)(ws + WS_PAR) + (l > 0 ? PO_L2B + (l - 1) * DM : PO_ZERO)};
#if PHM & 16
          STAGGER(); pg8::gemm_phase<pg8::EpiResidLn, pg8::PanelOrder, true, true>(F.lds, g, S, E);
#endif
        }
        { unsigned char* ws = WSB();
          pg8::Gemm g{(bf16_t*)(ws + WS_HB), (bf16_t*)(ws + WS_WOUT), TP, DM, DM / 4, DM}; pg8::SplitOrder S; S.init(PMETA, DM, 4, F.G, BXL());
          pg8::EpiPart E{(float*)(ws + WS_PART), DM};
#if PHM & 16
          pg8::gemm_phase<pg8::EpiPart, pg8::SplitOrder, true, true>(F.lds, g, S, E);
#endif
        }
        xcd_barrier(bar);
        { unsigned char* ws = WSB(); PFRAME(); ln_rows(Fp, (float*)(ws + WS_H), (bf16_t*)(ws + WS_HB), (const float*)(ws + WS_PAR) + PO_L1G + l * DM, (const float*)(ws + WS_PAR) + PO_L1B + l * DM, (float*)(ws + WS_STAT1), nullptr, (const float*)(ws + WS_PART), 4); }
        xcd_barrier(bar);
        { unsigned char* ws = WSB(); unsigned char* dob = DOB();
          pg8::Gemm g{(bf16_t*)(ws + WS_HB), (bf16_t*)(ws + WS_WUP), TP, NUP, DM, DM}; pg8::PanelOrder S; S.init(NPAN, 0, 0, 0, NUP, F.G, BXL());
          pg8::EpiFfn E{(bf16_t*)(ws + WS_ACT), (float*)(dob + DO_SIDE), (bf16_t*)(dob + DO_GVM), (const float*)(ws + WS_PAR) + PO_CW + (size_t)l * 3 * DFF, (const float*)(ws + WS_PAR) + PO_CB + (size_t)l * DFF, (LAS float*)(F.lds + MISC_OFF + 8192)};
#if PHM & 32
          STAGGER(); pg8::gemm_phase<pg8::EpiFfn, pg8::PanelOrder, true, true>(F.lds, g, S, E);
#if REP_UP > 1
          __syncthreads(); pg8::gemm_phase<pg8::EpiFfn, pg8::PanelOrder, true, true>(F.lds, g, S, E);
#endif
#endif
        }
        xcd_barrier(bar);
        { unsigned char* ws = WSB(); unsigned char* dob = DOB(); PFRAME();
          ffn_fixup(Fp, (const float*)(dob + DO_SIDE), (const bf16_t*)(dob + DO_GVM), (bf16_t*)(ws + WS_ACT), (const float*)(ws + WS_PAR) + PO_CW + (size_t)l * 3 * DFF, (const float*)(ws + WS_PAR) + PO_CB + (size_t)l * DFF); }
#if REP_SMALL > 1
        { unsigned char* ws = WSB(); unsigned char* dob = DOB(); PFRAME();
          ffn_fixup(Fp, (const float*)(dob + DO_SIDE), (const bf16_t*)(dob + DO_GVM), (bf16_t*)(ws + WS_ACT), (const float*)(ws + WS_PAR) + PO_CW + (size_t)l * 3 * DFF, (const float*)(ws + WS_PAR) + PO_CB + (size_t)l * DFF); }
#endif
        xcd_barrier(bar);
        { unsigned char* ws = WSB();
          pg8::Gemm g{(bf16_t*)(ws + WS_ACT), (bf16_t*)(ws + WS_WDN), TP, DM, DFF, DFF}; pg8::PanelOrder S; S.init(192, 0, 0, 0, DM, F.G, BXL());
          pg8::EpiResidLn E{(bf16_t*)(ws + WS_H), DM, ALPHA, (const float*)(ws + WS_STAT1), (const float*)(ws + WS_PAR) + PO_L1G + l * DM, (const float*)(ws + WS_PAR) + PO_L1B + l * DM};
#if PHM & 64
          STAGGER(); pg8::gemm_phase<pg8::EpiResidLn, pg8::PanelOrder, true, true>(F.lds, g, S, E);
#endif
        }
        { unsigned char* ws = WSB();
          pg8::Gemm g{(bf16_t*)(ws + WS_ACT), (bf16_t*)(ws + WS_WDN), TP, DM, DFF / 11, DFF}; pg8::SplitOrder S; S.init(PMETA, DM, 11, F.G, BXL());
          pg8::EpiPart E{(float*)(ws + WS_PART), DM};
#if PHM & 64
          pg8::gemm_phase<pg8::EpiPart, pg8::SplitOrder, true, true>(F.lds, g, S, E);
#endif
        }
        xcd_barrier(bar);
        { unsigned char* ws = WSB(); unsigned char* dob = DOB();
          PFRAME(); ln_rows(Fp, (float*)(ws + WS_H), (bf16_t*)(ws + WS_HB), (const float*)(ws + WS_PAR) + PO_L2G + l * DM, (const float*)(ws + WS_PAR) + PO_L2B + l * DM, (float*)(ws + WS_STAT2), l == DEPTH - 1 ? (float*)dob : nullptr, (const float*)(ws + WS_PART), 11); }
        if (l + 1 < DEPTH) { unsigned char* ws = WSB(); PFRAME(); convert_weights(Fp, ws, ptab, l + 1); }
#if REP_CONV > 1
        if (l + 1 < DEPTH) { __syncthreads(); unsigned char* ws = WSB(); PFRAME(); convert_weights(Fp, ws, ptab, l + 1); }
#endif
        xcd_barrier(bar);
    }
}

extern "C" void kernel_launch(void* const* d_in, const int* in_sizes, int n_in, void* d_out, int out_size, void* d_ws, size_t ws_size, hipStream_t stream) {
    static int grid = 0;
    if (grid == 0) {
        if (n_in != 19 || out_size != NMAIN * DM || ws_size < WS_NEED) { fprintf(stderr, "kernel_launch: unexpected shapes (n_in %d out %d ws %zu need %zu)\n", n_in, out_size, ws_size, (size_t)WS_NEED); grid = -1; return; }
        int dev = 0, cus = 0;
        if (hipGetDevice(&dev) != hipSuccess || hipDeviceGetAttribute(&cus, hipDeviceAttributeMultiprocessorCount, dev) != hipSuccess) { grid = -1; return; }
        if (hipFuncSetAttribute((const void*)fwd_kernel, hipFuncAttributeMaxDynamicSharedMemorySize, LDS_BYTES) != hipSuccess) { fprintf(stderr, "kernel_launch: hipFuncSetAttribute failed\n"); grid = -1; return; }
        int per_cu = 0;
        if (hipOccupancyMaxActiveBlocksPerMultiprocessor(&per_cu, (const void*)fwd_kernel, 512, LDS_BYTES) != hipSuccess || per_cu < 1) { fprintf(stderr, "kernel_launch: occupancy query says %d blocks per CU\n", per_cu); (void)hipGetLastError(); grid = -1; return; }
        if (cus < GRID) { fprintf(stderr, "kernel_launch: needs %d CUs, device has %d\n", GRID, cus); grid = -1; return; }
        grid = GRID;
    }
    if (grid < 0) return;
    (void)hipMemsetAsync((char*)d_ws + WS_CTL, 0, CTL_BYTES, stream);
    Params p{};
    for (int i = 0; i < 19; ++i) p.in[i] = (const float*)d_in[i];
    hipLaunchKernelGGL(fwd_kernel, dim3(grid), dim3(512), LDS_BYTES, stream, p, (unsigned char*)d_ws, (unsigned char*)d_out);
}
```

```cpp
#include <hip/hip_runtime.h>
#include <cstdio>
#include <cstdint>

#define LAS __attribute__((address_space(3)))
#define GAS __attribute__((address_space(1)))
typedef float f32x2 __attribute__((ext_vector_type(2)));
typedef float f32x8 __attribute__((ext_vector_type(8)));
typedef float f32x16 __attribute__((ext_vector_type(16)));
typedef unsigned u32x2 __attribute__((ext_vector_type(2)));
typedef short s16x4 __attribute__((ext_vector_type(4)));
typedef __bf16 bf16x2v __attribute__((ext_vector_type(2)));

constexpr int DM = 2048, NSEQ = 12, LREAL = 4096, NMETA = 16, DEPTH = 4;
constexpr int NMAIN = NSEQ * LREAL;
constexpr int MROW0 = NMAIN;
constexpr int NTOK = NMAIN + NSEQ * NMETA;
constexpr int NPAN = 193, TP = NPAN * 256;
constexpr int PMETA = 192;
constexpr int INC = 4944, NIN = 5120;
constexpr int DFF = 5632, NUP = 2 * DFF;
constexpr int MLW = 1024, NQ = 1536, NKV = 2048;
constexpr float ALPHA = 1.681792830507429f;
constexpr float EPS = 1e-5f;
constexpr float NEGBIG = -1e30f;

constexpr size_t MiB = 1u << 20;
constexpr size_t WS_CTL = 0, CTL_BYTES = 1 * MiB;
constexpr size_t WS_COS = 1 * MiB;
constexpr size_t WS_SIN = WS_COS + (size_t)4112 * 32 * 4;
constexpr size_t WS_PAR = 2 * MiB + 128 * 1024;
constexpr int PO_BG = 0, PO_MLG = PO_BG + DEPTH * 16, PO_QG = PO_MLG + DEPTH * 1024, PO_KVG = PO_QG + DEPTH * 512, PO_L1G = PO_KVG + DEPTH * 256, PO_L1B = PO_L1G + DEPTH * 2048,
              PO_CW = PO_L1B + DEPTH * 2048, PO_CB = PO_CW + DEPTH * 3 * 5632, PO_L2G = PO_CB + DEPTH * 5632, PO_L2B = PO_L2G + DEPTH * 2048, PO_ONE = PO_L2B + DEPTH * 2048, PO_ZERO = PO_ONE + 2048, PO_END = PO_ZERO + 2048;
static_assert(WS_PAR + (size_t)PO_END * 4 <= 3 * MiB && WS_PAR >= 1 * MiB + 2 * 4112 * 32 * 4, "PAR block placement");
constexpr size_t WS_WIN = 3 * MiB;
constexpr size_t WS_WUQ = WS_WIN + (size_t)NIN * DM * 2;
constexpr size_t WS_WUKV = WS_WUQ + (size_t)NQ * 512 * 2;
constexpr size_t WS_WOUT = WS_WUKV + (size_t)NKV * 256 * 2;
constexpr size_t WS_WUP = WS_WOUT + (size_t)DM * DM * 2;
constexpr size_t WS_WDN = WS_WUP + (size_t)NUP * DM * 2;
constexpr size_t WS_STAT1 = WS_WDN + (size_t)DM * DFF * 2;
constexpr size_t WS_STAT2 = WS_CTL + 512 * 1024;
constexpr size_t WS_H = 100 * MiB;
constexpr size_t WS_PART = WS_H + 208 * MiB;
static_assert((size_t)NMAIN * DM * 2 <= 208 * MiB && 208 * MiB + (size_t)11 * 256 * DM * 4 <= (size_t)NMAIN * DM * 4, "PART sits between the bf16 rows and the f32 meta rows of H");
constexpr size_t WS_HB = WS_H + (size_t)TP * DM * 4;
constexpr size_t WS_R = WS_HB + (size_t)TP * DM * 2;
constexpr size_t WS_UQKVO = WS_R;
constexpr size_t WS_UDQ = WS_UQKVO + (size_t)TP * 4096 * 2;
constexpr size_t WS_UDKV = WS_UDQ + (size_t)TP * 512 * 2;
constexpr size_t WS_GATES = WS_UDKV + (size_t)TP * 256 * 2;
constexpr size_t WS_MKV = WS_GATES + (size_t)TP * 16 * 4;
constexpr size_t WS_KR = WS_MKV + (size_t)TP * NKV * 2;
constexpr size_t WS_RSTD = WS_KR + (size_t)TP * 64 * 2;
constexpr size_t WS_END_A = WS_RSTD + (size_t)TP * 2 * 4;
constexpr size_t WS_ACT = WS_R;
constexpr size_t WS_END_B = WS_ACT + (size_t)TP * DFF * 2;
constexpr size_t WS_NEED = (WS_END_A > WS_END_B ? WS_END_A : WS_END_B);
static_assert(WS_STAT1 + (size_t)TP * 8 <= WS_H && WS_STAT2 + (size_t)TP * 8 <= WS_CTL + CTL_BYTES, "weights and row statistics fit below H");
constexpr size_t DO_HSUM = 0;
constexpr size_t DO_MQ = DO_HSUM + (size_t)TP * MLW * 4;
constexpr size_t DO_GP = 340 * MiB;
constexpr size_t DO_SIDE = 0;
constexpr size_t DO_GVM = 32 * MiB;
static_assert(DO_MQ + (size_t)TP * NQ * 2 <= DO_GP && DO_GP + (size_t)96 * 65 * 200 * 4 <= (size_t)NMAIN * DM * 4 && (size_t)192 * 6 * DFF * 4 <= DO_GVM && DO_GVM + (size_t)256 * NUP * 2 <= (size_t)NMAIN * DM * 4, "d_out scratch fits");
constexpr int CW_BAR = 4096;

constexpr int RING_BYTES = 131072;
constexpr int MISC_OFF = RING_BYTES;
constexpr int LDS_BYTES = 147456;
constexpr int GRID = 256;

__device__ __forceinline__ int pos_of_row(int row) { return row < NMAIN ? NMETA + (row & (LREAL - 1)) : ((row - NMAIN) & (NMETA - 1)); }
__device__ __forceinline__ unsigned pk2(float lo, float hi) { f32x2 v = {lo, hi}; return __builtin_bit_cast(unsigned, __builtin_convertvector(v, bf16x2v)); }
__device__ __forceinline__ float bf_lo(unsigned w) { return __uint_as_float(w << 16); }
__device__ __forceinline__ float bf_hi(unsigned w) { return __uint_as_float(w & 0xffff0000u); }
typedef _Float16 f16x2v __attribute__((ext_vector_type(2)));
__device__ __forceinline__ unsigned pk2h(float lo, float hi) { f32x2 v = {lo, hi}; return __builtin_bit_cast(unsigned, __builtin_convertvector(v, f16x2v)); }
__device__ __forceinline__ float hf_lo(unsigned w) { return (float)__builtin_bit_cast(f16x2v, w)[0]; }
__device__ __forceinline__ float hf_hi(unsigned w) { return (float)__builtin_bit_cast(f16x2v, w)[1]; }
__device__ __forceinline__ float wave_sum(float v) {
#pragma unroll
    for (int o = 1; o < 64; o <<= 1) v += __shfl_xor(v, o);
    return v;
}
__device__ __forceinline__ float wave_max(float v) {
#pragma unroll
    for (int o = 1; o < 64; o <<= 1) v = fmaxf(v, __shfl_xor(v, o));
    return v;
}
namespace pg8 {
#define PG8_LAS __attribute__((address_space(3)))
typedef unsigned short bf16_t;
typedef short bf16x8 __attribute__((ext_vector_type(8)));
typedef float f32x4 __attribute__((ext_vector_type(4)));
typedef unsigned u32x4 __attribute__((ext_vector_type(4)));
constexpr int BM = 256, BK = 64, HALF = 128, HTB = HALF * BK * 2  , STAGE_BYTES = 8 * HTB, NXCD = 8, WGM = 4;

__host__ __device__ __forceinline__ int lds_byte(int r, int c) { const int st = (r >> 4) * 2 + (c >> 5), rr = r & 15, cc = c & 31, ob = rr * 64 + cc * 2; return st * 1024 + (ob ^ (((ob >> 9) & 1) << 5)); }
__host__ __device__ __forceinline__ void stage_rc(int b, int& R, int& C) { const int st = b / 1024, sb = b % 1024, swz = sb ^ (((sb >> 9) & 1) << 5); R = (st >> 1) * 16 + swz / 64; C = (st & 1) * 32 + (swz % 64) / 2; }
__host__ __device__ __forceinline__ int perm32(int rho) { const int n = rho >> 4, i = rho & 15; return 8 * (i >> 2) + 4 * n + (i & 3); }

struct Unit { int pm, pn, kk; };
struct Gemm { const bf16_t* A; const bf16_t* Bt; int M, N, K, ld; };

struct PanelOrder {
    int nM, nN, nwg, G, c, nMain, pm0, pmx;
    __device__ void init(int nMain_, int pm0_, int extra, int pmx_, int N, int G_, int c_) { nMain = nMain_; pm0 = pm0_; pmx = pmx_; nM = nMain_ + extra; nN = N / BM; nwg = nM * nN; G = G_; c = c_; }
    __device__ bool next(int i, Unit& u) const {
        const long L = (long)i * G + c; if (L >= nwg) return false;
        int wgid = (int)L; { const int q = nwg / NXCD, r = nwg % NXCD, xcd = wgid % NXCD, off = wgid / NXCD; wgid = (xcd < r ? xcd * (q + 1) : r * (q + 1) + (xcd - r) * q) + off; }
        const int nig = WGM * nN, gid = wgid / nig, fm = gid * WGM, gsz = (nM - fm) < WGM ? (nM - fm) : WGM;
        const int pl = fm + ((wgid % nig) % gsz); u.pm = pl < nMain ? pm0 + pl : pmx; u.pn = (wgid % nig) / gsz; u.kk = 0; return true;
    }
    __device__ __forceinline__ void a_ready(const Unit&) const {}
    __device__ __forceinline__ void done(const Unit&) const {}
};

struct SplitOrder {
    int pm, nN, nwg, G, c;
    __device__ void init(int pm_, int N, int nsplit, int G_, int c_) { pm = pm_; nN = N / BM; nwg = nN * nsplit; G = G_; c = c_; }
    __device__ bool next(int i, Unit& u) const { const int L = i * G + c; if (L >= nwg) return false; u.pm = pm; u.pn = L % nN; u.kk = L / nN; return true; }
    __device__ __forceinline__ void a_ready(const Unit&) const {}
    __device__ __forceinline__ void done(const Unit&) const {}
};

__device__ __forceinline__ u32x4 pack8(const f32x4 v0, const f32x4 v1) { u32x4 w; w.x = pk2(v0[0], v0[1]); w.y = pk2(v0[2], v0[3]); w.z = pk2(v1[0], v1[1]); w.w = pk2(v1[2], v1[3]); return w; }

struct EpiBf16G {
    static constexpr bool PERM = true, AFTER_DRAIN = false, PERMA = false;
    bf16_t* O; int ldc; const float* rs; int pm_sub, pm_sp, pm_sp_out;
    __device__ __forceinline__ void operator()(const f32x4 (&acc)[2][2][4][2], const Unit& u, int wr, int wc, int fr, int fq) const {
        const int opm = (u.pm == pm_sp) ? pm_sp_out : u.pm - pm_sub;
        const int rin = u.pm * BM + wr * 64 + fr, rout = opm * BM + wr * 64 + fr, col0 = u.pn * BM + wc * 32 + 8 * fq;
#pragma unroll
        for (int ai = 0; ai < 2; ++ai)
#pragma unroll
            for (int m = 0; m < 4; ++m) { const float sc = rs ? rs[(size_t)(rin + ai * HALF + m * 16) * 2] : 1.f;
                bf16_t* rowp = O + (size_t)(rout + ai * HALF + m * 16) * ldc + col0;
#pragma unroll
                for (int bj = 0; bj < 2; ++bj) *(u32x4*)(rowp + bj * HALF) = pack8(acc[ai][bj][m][0] * sc, acc[ai][bj][m][1] * sc); }
    }
};
struct EpiWin {
    static constexpr bool PERM = true, AFTER_DRAIN = false, PERMA = false;
    bf16_t *UQKVO, *UDQ, *UDKV, *KR; float* GATES; const float *COS, *SIN;
    __device__ __forceinline__ void operator()(const f32x4 (&acc)[2][2][4][2], const Unit& u, int wr, int wc, int fr, int fq) const {
        const int row0 = u.pm * BM + wr * 64 + fr;
        if (u.pn < 19) {
            bf16_t* base; int ldc, colt;
            if (u.pn < 16) { base = UQKVO; ldc = 4096; colt = u.pn * BM; } else if (u.pn < 18) { base = UDQ; ldc = 512; colt = (u.pn - 16) * BM; } else { base = UDKV; ldc = 256; colt = 0; }
            const int col0 = colt + wc * 32 + 8 * fq;
#pragma unroll
            for (int ai = 0; ai < 2; ++ai)
#pragma unroll
                for (int m = 0; m < 4; ++m) { bf16_t* rowp = base + (size_t)(row0 + ai * HALF + m * 16) * ldc + col0;
#pragma unroll
                    for (int bj = 0; bj < 2; ++bj) *(u32x4*)(rowp + bj * HALF) = pack8(acc[ai][bj][m][0], acc[ai][bj][m][1]); }
        } else {
            if (wc < 2) { const int g = 4 * wc + fq;
#pragma unroll
                for (int ai = 0; ai < 2; ++ai)
#pragma unroll
                    for (int m = 0; m < 4; ++m) { const int row = row0 + ai * HALF + m * 16, pos = pos_of_row(row);
                        const f32x4 cs = *(const f32x4*)(COS + pos * 32 + 4 * g), sn = *(const f32x4*)(SIN + pos * 32 + 4 * g);
                        const f32x4 x1 = acc[ai][0][m][0], x2 = acc[ai][0][m][1];
                        *(u32x4*)(KR + (size_t)row * 64 + 8 * g) = pack8(x1 * cs - x2 * sn, x1 * sn + x2 * cs); }
            } else if (wc == 2 && fq < 2) {
#pragma unroll
                for (int ai = 0; ai < 2; ++ai)
#pragma unroll
                    for (int m = 0; m < 4; ++m) { float* gp = GATES + (size_t)(row0 + ai * HALF + m * 16) * 16 + 8 * fq;
                        *(f32x4*)gp = acc[ai][0][m][0]; *(f32x4*)(gp + 4) = acc[ai][0][m][1]; }
            }
        }
    }
};
struct EpiQ {
    static constexpr bool PERM = true, AFTER_DRAIN = false, PERMA = false;
    bf16_t* MQ; const float *RSTD, *COS, *SIN;
    __device__ __forceinline__ void operator()(const f32x4 (&acc)[2][2][4][2], const Unit& u, int wr, int wc, int fr, int fq) const {
        const int row0 = u.pm * BM + wr * 64 + fr, colb = u.pn * BM + wc * 32 + 8 * fq;
#pragma unroll
        for (int ai = 0; ai < 2; ++ai)
#pragma unroll
            for (int m = 0; m < 4; ++m) { const int row = row0 + ai * HALF + m * 16, pos = pos_of_row(row); const float sc = RSTD[(size_t)row * 2];
#pragma unroll
                for (int bj = 0; bj < 2; ++bj) { const int col0 = colb + bj * HALF, o = col0 % 192;
                    f32x4 v0 = acc[ai][bj][m][0] * sc, v1 = acc[ai][bj][m][1] * sc;
                    if (o >= 128) { const int g = (o - 128) >> 3; const f32x4 cs = *(const f32x4*)(COS + pos * 32 + 4 * g), sn = *(const f32x4*)(SIN + pos * 32 + 4 * g);
                        const f32x4 x1 = v0, x2 = v1; v0 = x1 * cs - x2 * sn; v1 = x1 * sn + x2 * cs; }
                    *(u32x4*)(MQ + (size_t)row * NQ + col0) = pack8(v0, v1); } }
    }
};
__device__ __forceinline__ void resid_ln_tile(float* __restrict__ Cw, const float* __restrict__ Cr, const float* __restrict__ st, const float* __restrict__ g, const float* __restrict__ b,
                                              int ldc, float alpha, const f32x4 (&acc)[2][2][4][2], int row0, int col0) {
    asm volatile("" ::: "memory");
#pragma unroll
    for (int ai = 0; ai < 2; ++ai)
#pragma unroll
        for (int bj = 0; bj < 2; ++bj) {
            f32x4 gv[2], bv[2], hv[4][2]; f32x2 ms[4];
#pragma unroll
            for (int n = 0; n < 2; ++n) { gv[n] = *(const f32x4*)(g + col0 + bj * HALF + n * 16) * alpha; bv[n] = *(const f32x4*)(b + col0 + bj * HALF + n * 16) * alpha; }
#pragma unroll
            for (int m = 0; m < 4; ++m) { const int row = row0 + ai * HALF + m * 16; ms[m] = *(const f32x2*)(st + (size_t)row * 2);
#pragma unroll
                for (int n = 0; n < 2; ++n) hv[m][n] = *(const f32x4*)(Cr + (size_t)row * ldc + col0 + bj * HALF + n * 16); }
#pragma unroll
            for (int m = 0; m < 4; ++m) { const int row = row0 + ai * HALF + m * 16;
#pragma unroll
                for (int n = 0; n < 2; ++n) *(f32x4*)(Cw + (size_t)row * ldc + col0 + bj * HALF + n * 16) = (hv[m][n] - ms[m][0]) * ms[m][1] * gv[n] + bv[n] + acc[ai][bj][m][n]; }
        }
}
__device__ __forceinline__ void resid_ln_tile_bf(bf16_t* __restrict__ Cw, const bf16_t* __restrict__ Cr, const float* __restrict__ st, const float* __restrict__ g, const float* __restrict__ b,
                                                 int ldc, float alpha, const f32x4 (&acc)[2][2][4][2], int row0, int col0) {
    asm volatile("" ::: "memory");
#pragma unroll
    for (int ai = 0; ai < 2; ++ai)
#pragma unroll
        for (int bj = 0; bj < 2; ++bj) {
            f32x4 gv[2], bv[2]; u32x4 hv[4]; f32x2 ms[4];
#pragma unroll
            for (int n = 0; n < 2; ++n) { gv[n] = *(const f32x4*)(g + col0 + bj * HALF + n * 4) * alpha; bv[n] = *(const f32x4*)(b + col0 + bj * HALF + n * 4) * alpha; }
#pragma unroll
            for (int m = 0; m < 4; ++m) { const int row = row0 + ai * HALF + m * 16; ms[m] = *(const f32x2*)(st + (size_t)row * 2);
                hv[m] = *(const u32x4*)(Cr + (size_t)row * ldc + col0 + bj * HALF); }
#pragma unroll
            for (int m = 0; m < 4; ++m) { const int row = row0 + ai * HALF + m * 16;
                const f32x4 h0 = {hf_lo(hv[m].x), hf_hi(hv[m].x), hf_lo(hv[m].y), hf_hi(hv[m].y)}, h1 = {hf_lo(hv[m].z), hf_hi(hv[m].z), hf_lo(hv[m].w), hf_hi(hv[m].w)};
                const f32x4 o0 = (h0 - ms[m][0]) * ms[m][1] * gv[0] + bv[0] + acc[ai][bj][m][0], o1 = (h1 - ms[m][0]) * ms[m][1] * gv[1] + bv[1] + acc[ai][bj][m][1];
                u32x4 w; w.x = pk2h(o0[0], o0[1]); w.y = pk2h(o0[2], o0[3]); w.z = pk2h(o1[0], o1[1]); w.w = pk2h(o1[2], o1[3]);
                *(u32x4*)(Cw + (size_t)row * ldc + col0 + bj * HALF) = w; }
        }
}
struct EpiResidLn {
    static constexpr bool PERM = true, AFTER_DRAIN = false, PERMA = false;
    bf16_t* C; int ldc; float alpha; const float* st; const float* g; const float* b;
    __device__ __forceinline__ void operator()(const f32x4 (&acc)[2][2][4][2], const Unit& u, int wr, int wc, int fr, int fq) const {
        resid_ln_tile_bf(this->C, this->C, this->st, this->g, this->b, this->ldc, this->alpha, acc, u.pm * BM + wr * 64 + fr, u.pn * BM + wc * 32 + 8 * fq);
    }
};
struct EpiPart {
    static constexpr bool PERM = false, AFTER_DRAIN = false, PERMA = false;
    float* P; int ldc;
    __device__ __forceinline__ void operator()(const f32x4 (&acc)[2][2][4][2], const Unit& u, int wr, int wc, int fr, int fq) const {
        const int row0 = u.kk * BM + wr * 64 + fr, col0 = u.pn * BM + wc * 32 + 4 * fq;
#pragma unroll
        for (int ai = 0; ai < 2; ++ai)
#pragma unroll
            for (int m = 0; m < 4; ++m) { float* rowp = P + (size_t)(row0 + ai * HALF + m * 16) * ldc + col0;
#pragma unroll
                for (int bj = 0; bj < 2; ++bj)
#pragma unroll
                    for (int n = 0; n < 2; ++n) *(f32x4*)(rowp + bj * HALF + n * 16) = acc[ai][bj][m][n]; }
    }
};

__device__ __forceinline__ float dpp_shr1_old(float old, float x) { return __int_as_float(__builtin_amdgcn_update_dpp(__float_as_int(old), __float_as_int(x), 0x111, 0xf, 0xf, false)); }
__device__ __forceinline__ float dpp_shl1_old(float old, float x) { return __int_as_float(__builtin_amdgcn_update_dpp(__float_as_int(old), __float_as_int(x), 0x101, 0xf, 0xf, false)); }
struct EpiFfn {
    static constexpr bool PERM = true, AFTER_DRAIN = false, PERMA = true;
    bf16_t* ACT; float* SIDE; bf16_t* GVM; const float *cw, *cb; PG8_LAS float* X;
    __device__ __forceinline__ void operator()(const f32x4 (&acc)[2][2][4][2], const Unit& u, int wr_in, int wc_in, int fr_in, int fq_in) const {
        int fr = fr_in, fq = fq_in, wr = wr_in, wc = wc_in; asm volatile("" : "+v"(fr), "+v"(fq), "+s"(wr), "+s"(wc));
        const int cj = wc * 32 + 8 * fq, c0 = u.pn * 128 + cj;
        if (u.pm == PMETA) {
#pragma unroll
            for (int ai = 0; ai < 2; ++ai)
#pragma unroll
                for (int m = 0; m < 4; ++m) { bf16_t* rowp = GVM + (size_t)(ai * HALF + wr * 64 + 4 * fr + m) * NUP + c0;
                    *(u32x4*)rowp = pack8(acc[ai][0][m][0], acc[ai][0][m][1]); *(u32x4*)(rowp + DFF) = pack8(acc[ai][1][m][0], acc[ai][1][m][1]); }
            return;
        }
        f32x4 w0[2], w1[2], w2[2], bb[2];
#pragma unroll
        for (int n = 0; n < 2; ++n) { w0[n] = *(const f32x4*)(cw + c0 + 4 * n); w1[n] = *(const f32x4*)(cw + DFF + c0 + 4 * n); w2[n] = *(const f32x4*)(cw + 2 * DFF + c0 + 4 * n); bb[n] = *(const f32x4*)(cb + c0 + 4 * n); }
#pragma unroll
        for (int ai = 0; ai < 2; ++ai) { const int b = 2 * ai + wr;
            if (fr == 0) { *(PG8_LAS f32x4*)(X + (b * 2 + 0) * 128 + cj) = acc[ai][0][0][0]; *(PG8_LAS f32x4*)(X + (b * 2 + 0) * 128 + cj + 4) = acc[ai][0][0][1]; }
            if (fr == 15) { *(PG8_LAS f32x4*)(X + (b * 2 + 1) * 128 + cj) = acc[ai][0][3][0]; *(PG8_LAS f32x4*)(X + (b * 2 + 1) * 128 + cj + 4) = acc[ai][0][3][1]; } }
        asm volatile("s_waitcnt lgkmcnt(0)" ::: "memory"); __builtin_amdgcn_s_barrier(); asm volatile("" ::: "memory");
        const unsigned rowb = (unsigned)(u.pm * BM + wr * 64 + 4 * fr) * DFF + c0;
#pragma unroll
        for (int ai = 0; ai < 2; ++ai) { const int b = 2 * ai + wr;
            f32x4 xp[2], xn[2];
#pragma unroll
            for (int n = 0; n < 2; ++n) { xp[n] = b > 0 ? *(const PG8_LAS f32x4*)(X + ((b - 1) * 2 + 1) * 128 + cj + 4 * n) : (f32x4){0.f, 0.f, 0.f, 0.f};
                                          xn[n] = b < 3 ? *(const PG8_LAS f32x4*)(X + ((b + 1) * 2 + 0) * 128 + cj + 4 * n) : (f32x4){0.f, 0.f, 0.f, 0.f}; }
            f32x4 up0[2], dn3[2];
#pragma unroll
            for (int n = 0; n < 2; ++n)
#pragma unroll
                for (int e = 0; e < 4; ++e) { up0[n][e] = dpp_shr1_old(xp[n][e], acc[ai][0][3][n][e]); dn3[n][e] = dpp_shl1_old(xn[n][e], acc[ai][0][0][n][e]); }
#pragma unroll
            for (int m = 0; m < 4; ++m) { u32x4 ow;
#pragma unroll
                for (int n = 0; n < 2; ++n) {
                    const f32x4 g = acc[ai][0][m][n], pv = m > 0 ? acc[ai][0][m > 0 ? m - 1 : 0][n] : up0[n], nx = m < 3 ? acc[ai][0][m < 3 ? m + 1 : 3][n] : dn3[n];
                    const f32x4 x = w0[n] * pv + w1[n] * g + w2[n] * nx + bb[n]; f32x4 o;
#pragma unroll
                    for (int e = 0; e < 4; ++e) o[e] = x[e] * __builtin_amdgcn_rcpf(1.f + __expf(-x[e])) * acc[ai][1][m][n][e];
                    if (n == 0) { ow.x = pk2(o[0], o[1]); ow.y = pk2(o[2], o[3]); } else { ow.z = pk2(o[0], o[1]); ow.w = pk2(o[2], o[3]); } }
                bf16_t* dst = ACT + (rowb + (unsigned)(ai * HALF + m) * DFF);
                if (ai == 0 ? m < 2 : m >= 2) {
                    const int r = ai * HALF + wr * 64 + 4 * fr + m;
                    if (r != 0 && r != 255) *(u32x4*)dst = ow;
                    const int slot = r == 0 ? 0 : r == 1 ? 1 : r == 254 ? 2 : r == 255 ? 3 : -1;
                    if (slot >= 0) { float* sp = SIDE + ((size_t)u.pm * 6 + slot) * DFF + c0; *(f32x4*)sp = acc[ai][0][m][0]; *(f32x4*)(sp + 4) = acc[ai][0][m][1];
                        if (slot == 0 || slot == 3) { float* vp = SIDE + ((size_t)u.pm * 6 + (slot == 0 ? 4 : 5)) * DFF + c0; *(f32x4*)vp = acc[ai][1][m][0]; *(f32x4*)(vp + 4) = acc[ai][1][m][1]; } }
                } else *(u32x4*)dst = ow;
            }
        }
    }
};
template <class Epi, class Sched, bool ALIGN_EPI = false, bool SP2 = false>
__device__ __forceinline__ void gemm_phase(PG8_LAS unsigned char* lds, const Gemm g, const Sched& S, const Epi& E) {
    int tid_ = threadIdx.x; asm volatile("" : "+v"(tid_));
    const int tid = tid_, wid = __builtin_amdgcn_readfirstlane(tid >> 6), lane = tid & 63, wr = wid >> 2, wc = wid & 3, fr = lane & 15, fq = lane >> 4;
    const int K = g.ld, nt = g.K / BK;
    unsigned voffA[2], voffB[2];
#pragma unroll
    for (int i = 0; i < 2; ++i) { int R, C; stage_rc(tid * 16 + i * 8192, R, C); const int Rb = Epi::PERM ? ((R & ~31) + perm32(R & 31)) : R;
        const int Ra = Epi::PERMA ? ((R & ~63) | ((R & 15) << 2) | ((R >> 4) & 3)) : R;
        voffA[i] = (unsigned)(Ra * K + C) * 2u; voffB[i] = (unsigned)(Rb * K + C) * 2u; }
    const size_t kstep = (size_t)(BK * 2);
    const size_t hstep = (size_t)HALF * K * 2;
    const size_t tstep = 2 * hstep;
    const unsigned ldsw = (unsigned)wid * 1024u;
    const int aoff = lds_byte(wr * 64 + fr, fq * 8), boff = lds_byte(wc * 32 + fr, fq * 8);
#define PG8_SA(b, h) (((b) * 2 + (h)) * HTB)
#define PG8_SB(b, h) ((4 + (b) * 2 + (h)) * HTB)
#define PG8_STAGE(bufoff, gbase, voff) do { _Pragma("unroll") for (int _i = 0; _i < 2; ++_i) \
        __builtin_amdgcn_global_load_lds((const unsigned*)((const char*)(gbase) + (voff)[_i]), (PG8_LAS unsigned*)(lds + (bufoff) + ldsw + _i * 8192), 16, 0, 0); } while (0)
#define PG8_LDA(dst, b, h) do { _Pragma("unroll") for (int m = 0; m < 4; ++m) _Pragma("unroll") for (int k = 0; k < 2; ++k) dst[m][k] = *(const PG8_LAS bf16x8*)(lds + PG8_SA(b, h) + aoff + m * 2048 + k * 1024); } while (0)
#define PG8_LDB(dst, b, h) do { _Pragma("unroll") for (int n = 0; n < 2; ++n) _Pragma("unroll") for (int k = 0; k < 2; ++k) dst[n][k] = *(const PG8_LAS bf16x8*)(lds + PG8_SB(b, h) + boff + n * 2048 + k * 1024); } while (0)
#define PG8_MMA(ai, bj, At, Bt) do { __builtin_amdgcn_s_setprio(1); _Pragma("unroll") for (int m = 0; m < 4; ++m) _Pragma("unroll") for (int n = 0; n < 2; ++n) _Pragma("unroll") for (int k = 0; k < 2; ++k) \
        acc[ai][bj][m][n] = __builtin_amdgcn_mfma_f32_16x16x32_bf16(Bt[n][k], At[m][k], acc[ai][bj][m][n], 0, 0, 0); __builtin_amdgcn_s_setprio(0); } while (0)
#define PG8_WAIT_V(n) asm volatile("s_waitcnt vmcnt(" #n ")" ::: "memory")
#define PG8_WAIT_L(n) asm volatile("s_waitcnt lgkmcnt(" #n ")" ::: "memory")
#define PG8_BAR __builtin_amdgcn_s_barrier()
#define PG8_SCHED __builtin_amdgcn_sched_barrier(0)
    Unit cur, nxt; int ui = 0;
    if (!S.next(0, cur)) return;
    f32x4 acc[2][2][4][2];
#pragma unroll
    for (int a = 0; a < 2; ++a)
#pragma unroll
        for (int b = 0; b < 2; ++b)
#pragma unroll
            for (int m = 0; m < 4; ++m)
#pragma unroll
                for (int n = 0; n < 2; ++n) acc[a][b][m][n] = (f32x4){0.f, 0.f, 0.f, 0.f};
    bf16x8 At[4][2], B0[2][2], B1[2][2];
    const size_t sstep = (size_t)g.K * 2;
    const char* cA = (const char*)g.A + (size_t)cur.pm * tstep + (size_t)cur.kk * sstep; const char* cB = (const char*)g.Bt + (size_t)cur.pn * tstep + (size_t)cur.kk * sstep;
    S.a_ready(cur);
    if constexpr (SP2) {
        PG8_STAGE(PG8_SB(0, 0), cB, voffB); PG8_STAGE(PG8_SB(0, 1), cB + hstep, voffB); PG8_STAGE(PG8_SA(0, 0), cA, voffA); PG8_STAGE(PG8_SA(0, 1), cA + hstep, voffA);
        if (wr == 1) PG8_BAR;
        PG8_WAIT_V(2); PG8_BAR;
        PG8_STAGE(PG8_SB(1, 0), cB + kstep, voffB); PG8_STAGE(PG8_SA(1, 0), cA + kstep, voffA); PG8_STAGE(PG8_SB(1, 1), cB + hstep + kstep, voffB);
        PG8_WAIT_V(6); PG8_BAR;
    } else {
        PG8_STAGE(PG8_SB(0, 0), cB, voffB); PG8_STAGE(PG8_SA(0, 0), cA, voffA); PG8_STAGE(PG8_SB(0, 1), cB + hstep, voffB); PG8_STAGE(PG8_SA(0, 1), cA + hstep, voffA);
        if (wr == 1) PG8_BAR;
        PG8_WAIT_V(4); PG8_BAR;
        PG8_STAGE(PG8_SB(1, 0), cB + kstep, voffB); PG8_STAGE(PG8_SA(1, 0), cA + kstep, voffA); PG8_STAGE(PG8_SB(1, 1), cB + hstep + kstep, voffB);
        PG8_WAIT_V(6); PG8_BAR;
    }
    for (;;) {
        const bool has_next = S.next(ui + 1, nxt);
        const char* nA = has_next ? (const char*)g.A + (size_t)nxt.pm * tstep + (size_t)nxt.kk * sstep : cA; const char* nB = has_next ? (const char*)g.Bt + (size_t)nxt.pn * tstep + (size_t)nxt.kk * sstep : cB;
        for (int t = 0; t < nt; t += 2) {
            const bool last = (t == nt - 2);
            const char* a1 = cA + (size_t)(t + 1) * kstep;
            const char* a2 = last ? nA : cA + (size_t)(t + 2) * kstep; const char* b2 = last ? nB : cB + (size_t)(t + 2) * kstep;
            const char* a3 = a2 + kstep; const char* b3 = b2 + kstep;
            if (last && has_next) S.a_ready(nxt);
            if constexpr (SP2) {
            PG8_LDB(B0, 0, 0); PG8_LDB(B1, 0, 1); PG8_SCHED; PG8_LDA(At, 0, 0); PG8_STAGE(PG8_SA(1, 1), a1 + hstep, voffA);
            PG8_WAIT_V(8); PG8_WAIT_L(0); PG8_BAR; PG8_MMA(0, 0, At, B0); PG8_MMA(0, 1, At, B1); PG8_BAR; PG8_SCHED;
            PG8_LDA(At, 0, 1); PG8_STAGE(PG8_SB(0, 0), b2, voffB); PG8_STAGE(PG8_SB(0, 1), b2 + hstep, voffB); PG8_STAGE(PG8_SA(0, 0), a2, voffA);
            PG8_WAIT_V(8); PG8_WAIT_L(0); PG8_BAR; PG8_MMA(1, 0, At, B0); PG8_MMA(1, 1, At, B1); PG8_BAR; PG8_SCHED;
            PG8_LDB(B0, 1, 0); PG8_LDB(B1, 1, 1); PG8_SCHED; PG8_LDA(At, 1, 0); PG8_STAGE(PG8_SA(0, 1), a2 + hstep, voffA);
            PG8_WAIT_V(8); PG8_WAIT_L(0); PG8_BAR; PG8_MMA(0, 0, At, B0); PG8_MMA(0, 1, At, B1); PG8_BAR; PG8_SCHED;
            PG8_LDA(At, 1, 1); PG8_STAGE(PG8_SB(1, 0), b3, voffB); PG8_STAGE(PG8_SB(1, 1), b3 + hstep, voffB); PG8_STAGE(PG8_SA(1, 0), a3, voffA);
            PG8_WAIT_V(8); PG8_WAIT_L(0); PG8_BAR; PG8_MMA(1, 0, At, B0); PG8_MMA(1, 1, At, B1); PG8_BAR; PG8_SCHED;
            } else {
            PG8_LDB(B0, 0, 0); PG8_SCHED; PG8_LDA(At, 0, 0); PG8_STAGE(PG8_SA(1, 1), a1 + hstep, voffA);
            PG8_WAIT_L(8); PG8_BAR; PG8_WAIT_L(0); PG8_MMA(0, 0, At, B0); PG8_BAR; PG8_SCHED;
            PG8_LDB(B1, 0, 1); PG8_STAGE(PG8_SB(0, 0), b2, voffB);
            PG8_BAR; PG8_WAIT_L(0); PG8_MMA(0, 1, At, B1); PG8_BAR;
            PG8_LDA(At, 0, 1); PG8_STAGE(PG8_SA(0, 0), a2, voffA);
            PG8_BAR; PG8_WAIT_L(0); PG8_MMA(1, 0, At, B0); PG8_BAR; PG8_SCHED;
            PG8_STAGE(PG8_SB(0, 1), b2 + hstep, voffB);
            PG8_WAIT_V(6); PG8_BAR; PG8_MMA(1, 1, At, B1); PG8_BAR;
            PG8_LDB(B0, 1, 0); PG8_SCHED; PG8_LDA(At, 1, 0); PG8_STAGE(PG8_SA(0, 1), a2 + hstep, voffA);
            PG8_WAIT_L(8); PG8_BAR; PG8_WAIT_L(0); PG8_MMA(0, 0, At, B0); PG8_BAR; PG8_SCHED;
            PG8_LDB(B1, 1, 1); PG8_STAGE(PG8_SB(1, 0), b3, voffB);
            PG8_BAR; PG8_WAIT_L(0); PG8_MMA(0, 1, At, B1); PG8_BAR;
            PG8_LDA(At, 1, 1); PG8_STAGE(PG8_SA(1, 0), a3, voffA);
            PG8_BAR; PG8_WAIT_L(0); PG8_MMA(1, 0, At, B0); PG8_BAR; PG8_SCHED;
            PG8_STAGE(PG8_SB(1, 1), b3 + hstep, voffB);
            PG8_WAIT_V(6); PG8_BAR; PG8_MMA(1, 1, At, B1); PG8_BAR;
            }
        }
        if constexpr (ALIGN_EPI) { if (wr == 0) PG8_BAR; }
        if constexpr (!Epi::AFTER_DRAIN) { E(acc, cur, wr, wc, fr, fq); S.done(cur); }
        if (!has_next) break;
#pragma unroll
        for (int a = 0; a < 2; ++a)
#pragma unroll
            for (int b = 0; b < 2; ++b)
#pragma unroll
                for (int m = 0; m < 4; ++m)
#pragma unroll
                    for (int n = 0; n < 2; ++n) acc[a][b][m][n] = (f32x4){0.f, 0.f, 0.f, 0.f};
        cur = nxt; cA = nA; cB = nB; ++ui;
        if constexpr (ALIGN_EPI) { if (wr == 1) PG8_BAR; }
    }
    PG8_WAIT_V(0);
    if constexpr (!ALIGN_EPI) { if (wr == 0) PG8_BAR; }
    PG8_BAR;
    if constexpr (Epi::AFTER_DRAIN) { E.fused(acc, cur, wr, wc, fr, fq, lds, wid, lane); S.done(cur); }
#undef PG8_SA
#undef PG8_SB
#undef PG8_STAGE
#undef PG8_LDA
#undef PG8_LDB
#undef PG8_MMA
#undef PG8_WAIT_V
#undef PG8_WAIT_L
#undef PG8_BAR
#undef PG8_SCHED
}
}
#define XB_TMO      128
#define XB_XCNT(j)  (256  + 64 * (j))
#define XB_XSUB(j)  (1280 + 64 * (j))
#define XB_XGEN(j)  (2304 + 64 * (j))
#define XB_TOP      3328
#define XB_TOPGEN   3392
#define XCD_BAR_WORDS 3456
#define XB_SPIN_CAP (1u << 21)

__device__ __forceinline__ unsigned xb_ld(unsigned* p)              { return __hip_atomic_load(p, __ATOMIC_RELAXED, __HIP_MEMORY_SCOPE_AGENT); }
__device__ __forceinline__ unsigned xb_add(unsigned* p, unsigned v) { return __hip_atomic_fetch_add(p, v, __ATOMIC_RELAXED, __HIP_MEMORY_SCOPE_AGENT); }
__device__ __forceinline__ unsigned xb_xcc_id() { return (unsigned)__builtin_amdgcn_s_getreg((3 << 11) | 20) & 0xFu; }
#define XB_SPIN(cond, bar) do { unsigned _sp = 0; while (cond) { __builtin_amdgcn_s_sleep(1); \
    if ((++_sp & 255u) == 0u) { if (xb_ld(&(bar)[XB_TMO])) break; if (_sp > XB_SPIN_CAP) { atomicAdd(&(bar)[XB_TMO], 1u); break; } } } } while (0)

struct XcdBarrier {
    unsigned* bar; unsigned x;
    volatile LAS unsigned* st;
};

__device__ __forceinline__ XcdBarrier xcd_barrier_post(unsigned* bar, volatile LAS unsigned* st) {
    XcdBarrier b; b.bar = bar; b.x = (unsigned)__builtin_amdgcn_readfirstlane((int)xb_xcc_id()); b.st = st;
    if (threadIdx.x == 0) (void)xb_add(&bar[XB_XCNT(b.x)], 1u);
    return b;
}
__device__ __forceinline__ void xcd_barrier_complete(unsigned* bar, unsigned x, unsigned& nloc, unsigned& nx) {
    const unsigned G = gridDim.x * gridDim.y * gridDim.z;
    unsigned sum, cnt, mine, sp = 0u;
    for (;;) {
        sum = 0u; cnt = 0u; mine = 0u;
#pragma unroll
        for (unsigned j = 0; j < 16; ++j) { const unsigned c = xb_ld(&bar[XB_XCNT(j)]); sum += c; cnt += (c > 0u) ? 1u : 0u; }
        mine = xb_ld(&bar[XB_XCNT(x)]);
        if (sum == G) { mine = xb_ld(&bar[XB_XCNT(x)]); break; }
        __builtin_amdgcn_s_sleep(1);
        if ((++sp & 255u) == 0u) { if (xb_ld(&bar[XB_TMO])) break; if (sp > XB_SPIN_CAP) { atomicAdd(&bar[XB_TMO], 1u); break; } }
    }
    nloc = mine > 0u ? mine : 1u; nx = cnt > 0u ? cnt : 1u;
}

__device__ __forceinline__ void xcd_barrier(const XcdBarrier& b) {
    asm volatile("s_waitcnt vmcnt(0)" ::: "memory");
    __syncthreads();
    if (threadIdx.x == 0) {
        unsigned* bar = b.bar; unsigned bx_ = b.x;
        asm volatile("" : "+s"(bx_));
        __builtin_amdgcn_s_waitcnt(0);
        unsigned nloc = b.st[0], nx = b.st[1];
        if (nloc == 0u) { xcd_barrier_complete(bar, bx_, nloc, nx); b.st[0] = nloc; b.st[1] = nx; }
        const unsigned old = xb_add(&bar[XB_XSUB(bx_)], 1u);
        const unsigned gen = old / nloc;
        if (old + 1u == (gen + 1u) * nloc) {
            __builtin_amdgcn_fence(__ATOMIC_RELEASE, "agent");
            asm volatile("s_waitcnt vmcnt(0)" ::: "memory");
            const unsigned og = xb_add(&bar[XB_TOP], 1u);
            const unsigned tg = og / nx;
            if (og + 1u == (tg + 1u) * nx) xb_add(&bar[XB_TOPGEN], 1u);
            else XB_SPIN(xb_ld(&bar[XB_TOPGEN]) == tg, bar);
            __builtin_amdgcn_fence(__ATOMIC_ACQUIRE, "agent");
            xb_add(&bar[XB_XGEN(bx_)], 1u);
            asm volatile("s_waitcnt vmcnt(0)" ::: "memory");
        } else {
            XB_SPIN(xb_ld(&bar[XB_XGEN(bx_)]) == gen, bar);
            __builtin_amdgcn_fence(__ATOMIC_ACQUIRE, "agent");
            asm volatile("s_waitcnt vmcnt(0)" ::: "memory");
        }
    }
    __syncthreads();
}

typedef unsigned short bf16_t;
typedef short bf16x8 __attribute__((ext_vector_type(8)));
typedef float f32x4 __attribute__((ext_vector_type(4)));
typedef unsigned u32x4 __attribute__((ext_vector_type(4)));
#define LDS_WAIT() asm volatile("s_waitcnt lgkmcnt(0)" ::: "memory")

struct Params {
    const float* in[19];
};
struct Frame {
    LAS unsigned char* lds;
    int tid, lane, wave, G, bx, vcu, gw, ngw;
};
__device__ __forceinline__ const float* uptr(const LAS unsigned long long* t, int k) {
    const unsigned long long v = t[k]; const unsigned lo = __builtin_amdgcn_readfirstlane((unsigned)v), hi = __builtin_amdgcn_readfirstlane((unsigned)(v >> 32));
    return (const float*)(const GAS float*)(((unsigned long long)hi << 32) | lo); }

template <class CMap>
__device__ __forceinline__ void transpose_load(float (&v)[32], const float* W, int Nsrc, const float* ks, int kb, int nb, int lane, CMap cmap) {
    const int k0 = 64 * kb, n0 = 32 * nb; const int sc = cmap(n0 + (lane & 31));
#pragma unroll
    for (int i = 0; i < 32; ++i) { const int kk = 2 * i + (lane >> 5); float x = 0.f; if (sc >= 0) x = W[(size_t)(k0 + kk) * Nsrc + sc]; if (ks) x *= ks[k0 + kk]; v[i] = x; }
}
__device__ __forceinline__ void transpose_store(const float (&v)[32], int K, bf16_t* WT, LAS float* scr, int kb, int nb, int lane) {
    const int k0 = 64 * kb, n0 = 32 * nb;
#pragma unroll
    for (int i = 0; i < 32; ++i) scr[(2 * i + (lane >> 5)) * 33 + (lane & 31)] = v[i];
    LDS_WAIT(); asm volatile("" ::: "memory");
    const int c = lane & 7;
#pragma unroll
    for (int j = 0; j < 4; ++j) { const int n = (lane >> 3) + 8 * j; const LAS float* s = scr + (8 * c) * 33 + n;
        u32x4 o; o.x = pk2(s[0 * 33], s[1 * 33]); o.y = pk2(s[2 * 33], s[3 * 33]); o.z = pk2(s[4 * 33], s[5 * 33]); o.w = pk2(s[6 * 33], s[7 * 33]);
        *(u32x4*)(WT + (size_t)(n0 + n) * K + k0 + 8 * c) = o; }
    LDS_WAIT(); asm volatile("" ::: "memory");
}
template <class CMap>
__device__ __forceinline__ void transpose_matrix(const Frame& F, const float* W, int K, int Nsrc, int Ndst, bf16_t* WT, const float* ks, LAS float* scr, CMap cmap) {
    const int nnb = Ndst / 32, items = (K / 64) * nnb;
    for (int it = F.gw; it < items; it += 2 * F.ngw) { const int it2 = it + F.ngw; float va[32], vb[32];
        transpose_load(va, W, Nsrc, ks, it / nnb, it % nnb, F.lane, cmap);
        if (it2 < items) transpose_load(vb, W, Nsrc, ks, it2 / nnb, it2 % nnb, F.lane, cmap);
        transpose_store(va, K, WT, scr, it / nnb, it % nnb, F.lane);
        if (it2 < items) transpose_store(vb, K, WT, scr, it2 / nnb, it2 % nnb, F.lane); }
}
__device__ __forceinline__ int rope_perm(int m) { const int g = m >> 3, j = m & 7; return j < 4 ? 4 * g + j : 32 + 4 * g + (j - 4); }
struct CMapIn { __device__ int operator()(int n) const {
    if (n < 4096) return n; if (n < 4608) return 4112 + (n - 4096); if (n < 4864) return 4624 + (n - 4608);
    if (n < 4928) return 4880 + rope_perm(n - 4864); if (n < 4944) return 4096 + (n - 4928); return -1; } };
struct CMapQ { __device__ int operator()(int n) const { const int h = n / 192, o = n % 192; return o < 128 ? n : h * 192 + 128 + rope_perm(o - 128); } };
struct CMapUp { __device__ int operator()(int n) const { const int pn = n >> 8, j = n & 255; return j < 128 ? 128 * pn + j : DFF + 128 * pn + (j - 128); } };
struct CMapId { __device__ int operator()(int n) const { return n; } };

__device__ __forceinline__ void convert_weights(const Frame& F, unsigned char* ws, const LAS unsigned long long* pt, int l) {
    LAS float* scr = (LAS float*)(F.lds + F.wave * 8448);
    const float* w_in = uptr(pt, 3) + (size_t)l * DM * INC; const float* w_uq = uptr(pt, 8) + (size_t)l * 512 * NQ; const float* w_ukv = uptr(pt, 9) + (size_t)l * 256 * NKV;
    const float* w_out = uptr(pt, 10) + (size_t)l * DM * DM; const float* w_up = uptr(pt, 13) + (size_t)l * DM * NUP; const float* w_dn = uptr(pt, 16) + (size_t)l * DFF * DM;
    const float* qg = uptr(pt, 6) + (size_t)l * 512; const float* kvg = uptr(pt, 7) + (size_t)l * 256;
    transpose_matrix(F, w_in, DM, INC, NIN, (bf16_t*)(ws + WS_WIN), nullptr, scr, CMapIn());
    transpose_matrix(F, w_uq, 512, NQ, NQ, (bf16_t*)(ws + WS_WUQ), qg, scr, CMapQ());
    transpose_matrix(F, w_ukv, 256, NKV, NKV, (bf16_t*)(ws + WS_WUKV), kvg, scr, CMapId());
    transpose_matrix(F, w_out, DM, DM, DM, (bf16_t*)(ws + WS_WOUT), nullptr, scr, CMapId());
    transpose_matrix(F, w_up, DM, NUP, NUP, (bf16_t*)(ws + WS_WUP), nullptr, scr, CMapUp());
    transpose_matrix(F, w_dn, DFF, DM, DM, (bf16_t*)(ws + WS_WDN), nullptr, scr, CMapId());
}

__device__ __forceinline__ void prologue(const Frame& F, unsigned char* ws, const LAS unsigned long long* pt) {
    float* COS = (float*)(ws + WS_COS); float* SIN = (float*)(ws + WS_SIN);
    for (int i = F.bx * 512 + F.tid; i < 4112 * 32; i += F.G * 512) { const int pos = i >> 5, f = i & 31;
        const float inv = powf(10000.0f, -(float)(2 * f) / 64.0f); const float ang = (float)pos * inv; float s, c; sincosf(ang, &s, &c); COS[i] = c; SIN[i] = s; }
    { float* PAR = (float*)(ws + WS_PAR); const int gt = F.bx * 512 + F.tid, nt = F.G * 512;
      for (int i = gt; i < DEPTH * 16; i += nt) PAR[PO_BG + i] = uptr(pt, 4)[i];
      for (int i = gt; i < DEPTH * 1024; i += nt) PAR[PO_MLG + i] = uptr(pt, 5)[i];
      for (int i = gt; i < DEPTH * 512; i += nt) PAR[PO_QG + i] = uptr(pt, 6)[i];
      for (int i = gt; i < DEPTH * 256; i += nt) PAR[PO_KVG + i] = uptr(pt, 7)[i];
      for (int i = gt; i < 2048; i += nt) { PAR[PO_ONE + i] = 1.f; PAR[PO_ZERO + i] = 0.f; }
      { float* ST2 = (float*)(ws + WS_STAT2); for (int i = gt; i < TP; i += nt) { ST2[2 * i] = 0.f; ST2[2 * i + 1] = 1.f; } }
      for (int i = gt; i < DEPTH * 2048; i += nt) { PAR[PO_L1G + i] = uptr(pt, 11)[i]; PAR[PO_L1B + i] = uptr(pt, 12)[i]; PAR[PO_L2G + i] = uptr(pt, 17)[i]; PAR[PO_L2B + i] = uptr(pt, 18)[i]; }
      for (int i = gt; i < DEPTH * 3 * 5632; i += nt) PAR[PO_CW + i] = uptr(pt, 14)[i];
      for (int i = gt; i < DEPTH * 5632; i += nt) PAR[PO_CB + i] = uptr(pt, 15)[i]; }
    float* H = (float*)(ws + WS_H); bf16_t* HB = (bf16_t*)(ws + WS_HB);
    const float* xp = uptr(pt, 0); const float* xs = uptr(pt, 1); const float* mt = uptr(pt, 2);
    for (int row0 = F.gw; row0 < TP; row0 += 2 * F.ngw) {
        f32x4 v[2][8];
#pragma unroll
        for (int r = 0; r < 2; ++r) { const int row = row0 + r * F.ngw; const float* src = nullptr;
            if (row < 4 * LREAL) src = xp + (size_t)row * DM; else if (row < NMAIN) src = xs + (size_t)(row - 4 * LREAL) * DM; else if (row < NTOK) src = mt + (size_t)((row - NMAIN) & 15) * DM;
#pragma unroll
            for (int j = 0; j < 8; ++j) { v[r][j] = (f32x4){0.f, 0.f, 0.f, 0.f}; if (src) v[r][j] = ((const f32x4*)src)[F.lane + 64 * j]; } }
#pragma unroll
        for (int r = 0; r < 2; ++r) { const int row = row0 + r * F.ngw; if (row < TP) {
            f32x4* hd = (f32x4*)(H + (size_t)row * DM) + F.lane; u32x2* bd = (u32x2*)(HB + (size_t)row * DM) + F.lane; u32x2* hb = (u32x2*)((bf16_t*)H + (size_t)row * DM) + F.lane;
#pragma unroll
            for (int j = 0; j < 8; ++j) { const f32x4 x = v[r][j];
                u32x2 w; w.x = pk2(x[0], x[1]); w.y = pk2(x[2], x[3]); bd[64 * j] = w;
                if (row >= NMAIN) hd[64 * j] = x * ALPHA;
                else { u32x2 wh; wh.x = pk2h(x[0], x[1]); wh.y = pk2h(x[2], x[3]); hb[64 * j] = wh; } } } }
    }
}

__device__ __forceinline__ void ln_one(const f32x4 (&vin)[8], int row, int lane, float* __restrict__ Hw, bf16_t* __restrict__ HB, const float* __restrict__ g, const float* __restrict__ b, float* __restrict__ ST) {
    f32x4 v[8]; float s = 0.f;
#pragma unroll
    for (int j = 0; j < 8; ++j) { v[j] = vin[j]; s += (v[j][0] + v[j][1]) + (v[j][2] + v[j][3]); }
    const float mean = wave_sum(s) * (1.f / DM); float q = 0.f;
#pragma unroll
    for (int j = 0; j < 8; ++j) { v[j] = v[j] - mean; q += (v[j][0] * v[j][0] + v[j][1] * v[j][1]) + (v[j][2] * v[j][2] + v[j][3] * v[j][3]); }
    const float rstd = rsqrtf(wave_sum(q) * (1.f / DM) + EPS);
    if (lane == 0) { f32x2 ms = {mean, rstd}; *(f32x2*)(ST + (size_t)row * 2) = ms; }
    u32x2* bd = (u32x2*)(HB + (size_t)row * DM) + lane; f32x4* hp = (f32x4*)(Hw + (size_t)row * DM) + lane;
#pragma unroll
    for (int j = 0; j < 8; ++j) { const f32x4 gg = ((const f32x4*)g)[lane + 64 * j], bb = ((const f32x4*)b)[lane + 64 * j]; const f32x4 y = v[j] * rstd * gg + bb;
        u32x2 w; w.x = pk2(y[0], y[1]); w.y = pk2(y[2], y[3]); bd[64 * j] = w;
        hp[64 * j] = y * ALPHA; }
}
__device__ __forceinline__ void ln_one_bf(const u32x4 (&vin)[4], int row, int lane, bf16_t* __restrict__ HB, const float* __restrict__ g, const float* __restrict__ b, float* __restrict__ ST, float* __restrict__ out) {
    f32x4 v[8]; float s = 0.f;
#pragma unroll
    for (int j = 0; j < 4; ++j) { v[2 * j] = (f32x4){hf_lo(vin[j].x), hf_hi(vin[j].x), hf_lo(vin[j].y), hf_hi(vin[j].y)}; v[2 * j + 1] = (f32x4){hf_lo(vin[j].z), hf_hi(vin[j].z), hf_lo(vin[j].w), hf_hi(vin[j].w)}; }
#pragma unroll
    for (int j = 0; j < 8; ++j) s += (v[j][0] + v[j][1]) + (v[j][2] + v[j][3]);
    const float mean = wave_sum(s) * (1.f / DM); float q = 0.f;
#pragma unroll
    for (int j = 0; j < 8; ++j) { v[j] = v[j] - mean; q += (v[j][0] * v[j][0] + v[j][1] * v[j][1]) + (v[j][2] * v[j][2] + v[j][3] * v[j][3]); }
    const float rstd = rsqrtf(wave_sum(q) * (1.f / DM) + EPS);
    if (lane == 0) { f32x2 ms = {mean, rstd}; *(f32x2*)(ST + (size_t)row * 2) = ms; }
    u32x4* bd = (u32x4*)(HB + (size_t)row * DM) + lane;
#pragma unroll
    for (int j = 0; j < 4; ++j) { const int c4 = 2 * (lane + 64 * j);
        const f32x4 y0 = v[2 * j] * rstd * ((const f32x4*)g)[c4] + ((const f32x4*)b)[c4], y1 = v[2 * j + 1] * rstd * ((const f32x4*)g)[c4 + 1] + ((const f32x4*)b)[c4 + 1];
        bd[64 * j] = pg8::pack8(y0, y1);
        if (out) { f32x4* op = (f32x4*)(out + (size_t)row * DM) + c4; op[0] = y0; op[1] = y1; } }
}
__device__ __forceinline__ void ln_rows(const Frame& F, float* H, bf16_t* HB, const float* g, const float* b, float* ST, float* out, const float* PART, int nk) {
    const bf16_t* __restrict__ Hr = (const bf16_t*)H;
    for (int row = F.gw; row < NMAIN; row += 2 * F.ngw) {
        const int row2 = row + F.ngw;
        u32x4 va[4], vb[4];
#pragma unroll
        for (int j = 0; j < 4; ++j) va[j] = ((const u32x4*)(Hr + (size_t)row * DM))[F.lane + 64 * j];
#pragma unroll
        for (int j = 0; j < 4; ++j) vb[j] = ((const u32x4*)(Hr + (size_t)row2 * DM))[F.lane + 64 * j];
        ln_one_bf(va, row, F.lane, HB, g, b, ST, out);
        ln_one_bf(vb, row2, F.lane, HB, g, b, ST, out);
    }
    if (F.gw < TP - NMAIN) {
        const int row = NMAIN + F.gw; const float* __restrict__ Hm = H; f32x4 va[8];
#pragma unroll
        for (int j = 0; j < 8; ++j) va[j] = ((const f32x4*)(Hm + (size_t)row * DM))[F.lane + 64 * j];
        for (int k = 0; k < nk; ++k) {
            const float* __restrict__ pp = PART + ((size_t)k * 256 + F.gw) * DM;
#pragma unroll
            for (int j = 0; j < 8; ++j) va[j] += ((const f32x4*)pp)[F.lane + 64 * j]; }
        ln_one(va, row, F.lane, H, HB, g, b, ST);
    }
}

__device__ __forceinline__ void rstd_rows(const Frame& F, const bf16_t* UDQ, const bf16_t* UDKV, float* RSTD) {
    for (int row = F.gw; row < TP; row += F.ngw) {
        const u32x4 a = ((const u32x4*)(UDQ + (size_t)row * 512))[F.lane]; float s = 0.f;
#pragma unroll
        for (int j = 0; j < 4; ++j) { const float x = bf_lo(a[j]), y = bf_hi(a[j]); s += x * x + y * y; }
        float t = 0.f;
        if (F.lane < 32) { const u32x4 c = ((const u32x4*)(UDKV + (size_t)row * 256))[F.lane];
#pragma unroll
            for (int j = 0; j < 4; ++j) { const float x = bf_lo(c[j]), y = bf_hi(c[j]); t += x * x + y * y; } }
        s = wave_sum(s); t = wave_sum(t);
        if (F.lane == 0) { RSTD[(size_t)row * 2] = rsqrtf(s * (1.f / 512.f) + EPS); RSTD[(size_t)row * 2 + 1] = rsqrtf(t * (1.f / 256.f) + EPS); }
    }
}

__device__ __forceinline__ void mlstm_finalize(const Frame& F, int gw0, int ngw0, const float* HSUM, const bf16_t* UQKVO, const float* ng, bf16_t* MIX) {
    for (int row = gw0; row < TP; row += ngw0) {
#pragma unroll
        for (int j = 0; j < 4; ++j) {
            f32x4 v = ((const f32x4*)(HSUM + (size_t)row * MLW + 256 * j))[F.lane];
            const float mean = wave_sum((v[0] + v[1]) + (v[2] + v[3])) * (1.f / 256.f); v = v - mean;
            const float rstd = rsqrtf(wave_sum((v[0] * v[0] + v[1] * v[1]) + (v[2] * v[2] + v[3] * v[3])) * (1.f / 256.f) + EPS);
            const f32x4 gg = ((const f32x4*)(ng + 256 * j))[F.lane];
            const u32x2 uo = ((const u32x2*)(UQKVO + (size_t)row * 4096 + 3072 + 256 * j))[F.lane];
            const float o0 = bf_lo(uo.x), o1 = bf_hi(uo.x), o2 = bf_lo(uo.y), o3 = bf_hi(uo.y);
            const float y0 = v[0] * rstd * gg[0] / (1.f + __expf(-o0)), y1 = v[1] * rstd * gg[1] / (1.f + __expf(-o1));
            const float y2 = v[2] * rstd * gg[2] / (1.f + __expf(-o2)), y3 = v[3] * rstd * gg[3] / (1.f + __expf(-o3));
            u32x2 w; w.x = pk2(y0, y1); w.y = pk2(y2, y3); ((u32x2*)(MIX + (size_t)row * DM + 256 * j))[F.lane] = w;
        }
    }
}

__device__ __forceinline__ f32x8 ld8f(const float* p) { const f32x4 a = *(const f32x4*)p, b = *(const f32x4*)(p + 4); return (f32x8){a[0], a[1], a[2], a[3], b[0], b[1], b[2], b[3]}; }
__device__ __forceinline__ f32x8 ld8b(const bf16_t* p) { const u32x4 v = *(const u32x4*)p; return (f32x8){bf_lo(v[0]), bf_hi(v[0]), bf_lo(v[1]), bf_hi(v[1]), bf_lo(v[2]), bf_hi(v[2]), bf_lo(v[3]), bf_hi(v[3])}; }
__device__ __forceinline__ void act_store(bf16_t* dst, const f32x8 gp, const f32x8 gc, const f32x8 gn, const f32x8 vv, const f32x8 w0, const f32x8 w1, const f32x8 w2, const f32x8 bb) {
    float o[8];
#pragma unroll
    for (int i = 0; i < 8; ++i) { const float x = w0[i] * gp[i] + w1[i] * gc[i] + w2[i] * gn[i] + bb[i]; o[i] = x / (1.f + __expf(-x)) * vv[i]; }
    u32x4 w; w.x = pk2(o[0], o[1]); w.y = pk2(o[2], o[3]); w.z = pk2(o[4], o[5]); w.w = pk2(o[6], o[7]); *(u32x4*)dst = w;
}
__device__ __forceinline__ void ffn_fixup(const Frame& F, const float* SIDE, const bf16_t* GVM, bf16_t* ACT, const float* cw, const float* cb) {
    constexpr int NCH = DFF / 8;
    const f32x8 zero = {0.f, 0.f, 0.f, 0.f, 0.f, 0.f, 0.f, 0.f};
    const int gt = F.bx * 512 + F.tid, nt = GRID * 512;
    for (int idx = gt; idx < 192 * 2 * NCH; idx += nt) {
        const int ch = idx % NCH, rsel = (idx / NCH) & 1, pm = idx / (2 * NCH), c0 = 8 * ch, sq = pm >> 4;
        const f32x8 w0 = ld8f(cw + c0), w1 = ld8f(cw + DFF + c0), w2 = ld8f(cw + 2 * DFF + c0), bb = ld8f(cb + c0);
        const float* S0 = SIDE + (size_t)pm * 6 * DFF + c0;
        if (rsel == 0) { const f32x8 gp = (pm & 15) ? ld8f(S0 - 6 * DFF + 3 * DFF) : ld8b(GVM + (size_t)(16 * sq + 15) * NUP + c0);
            act_store(ACT + (size_t)(pm * 256) * DFF + c0, gp, ld8f(S0), ld8f(S0 + DFF), ld8f(S0 + 4 * DFF), w0, w1, w2, bb);
        } else { const f32x8 gn = ((pm & 15) != 15) ? ld8f(S0 + 6 * DFF) : zero;
            act_store(ACT + (size_t)(pm * 256 + 255) * DFF + c0, ld8f(S0 + 2 * DFF), ld8f(S0 + 3 * DFF), gn, ld8f(S0 + 5 * DFF), w0, w1, w2, bb); }
    }
    for (int idx = gt; idx < NSEQ * NCH; idx += nt) {
        const int ch = idx % NCH, sq = idx / NCH, c0 = 8 * ch;
        const f32x8 w0 = ld8f(cw + c0), w1 = ld8f(cw + DFF + c0), w2 = ld8f(cw + 2 * DFF + c0), bb = ld8f(cb + c0);
        f32x8 gp = zero, gc = ld8b(GVM + (size_t)(16 * sq) * NUP + c0);
        for (int p = 0; p < 16; ++p) {
            const f32x8 gn = p < 15 ? ld8b(GVM + (size_t)(16 * sq + p + 1) * NUP + c0) : ld8f(SIDE + (size_t)(16 * sq) * 6 * DFF + c0);
            act_store(ACT + (size_t)(MROW0 + 16 * sq + p) * DFF + c0, gp, gc, gn, ld8b(GVM + (size_t)(16 * sq + p) * NUP + DFF + c0), w0, w1, w2, bb);
            gp = gc; gc = gn;
        }
    }
}

namespace att {
constexpr int NW = 8, QBLK = 32, KVBLK = 64, NT = 65;
constexpr int KROW = 400;
constexpr int SHM_V = KVBLK * 128 * 2, SHM_K = KVBLK * KROW;
constexpr int OFF_V = 0, OFF_K = 3 * SHM_V, OFF_WS = OFF_K + 3 * SHM_K, LDS_TOTAL = OFF_WS + NW * 64 * 4;
static_assert(LDS_TOTAL <= RING_BYTES, "attention LDS");
constexpr float SCALE = 0.07216878364870323f;
constexpr float THR = 8.f;
#define SBAR() __builtin_amdgcn_sched_barrier(0)
__device__ __forceinline__ int crow(int r, int hi) { return (r & 3) + 8 * (r >> 2) + 4 * hi; }
__device__ __forceinline__ unsigned cvtpk(float lo, float hi) { unsigned r; asm volatile("v_cvt_pk_bf16_f32 %0, %1, %2" : "=v"(r) : "v"(lo), "v"(hi)); return r; }

template <bool MASK16>
__device__ __forceinline__ void partialSM(f32x16& p0, f32x16& p1, float& m_reg, float& mn, float& alpha) {
    constexpr float C = SCALE * 1.4426950408889634f;
    if (MASK16) {
#pragma unroll
        for (int r = 8; r < 16; ++r) p0[r] = NEGBIG;
#pragma unroll
        for (int r = 0; r < 16; ++r) p1[r] = NEGBIG;
    }
    float pmax = p0[0];
#pragma unroll
    for (int r = 1; r < 16; ++r) pmax = fmaxf(pmax, p0[r]);
#pragma unroll
    for (int r = 0; r < 16; ++r) pmax = fmaxf(pmax, p1[r]);
    { auto rr = __builtin_amdgcn_permlane32_swap(__float_as_uint(pmax), __float_as_uint(pmax), false, false); pmax = fmaxf(__uint_as_float(rr[0]), __uint_as_float(rr[1])); }
    if (__builtin_expect(__all(pmax - m_reg <= THR / SCALE), 1)) { mn = m_reg; alpha = 1.f; }
    else { mn = fmaxf(m_reg, pmax); alpha = __builtin_amdgcn_exp2f((m_reg - mn) * C); m_reg = mn; }
    const float mnC = -mn * C;
#pragma unroll
    for (int r = 0; r < 16; ++r) p0[r] = fmaf(p0[r], C, mnC);
#pragma unroll
    for (int r = 0; r < 16; ++r) p1[r] = fmaf(p1[r], C, mnC);
#pragma unroll
    for (int r = 0; r < 16; ++r) p0[r] = __builtin_amdgcn_exp2f(p0[r]);
}
__device__ __forceinline__ void finishSM(f32x16& p0, f32x16& p1, float alpha, float& l_reg, bf16x8& pa0, bf16x8& pa1, bf16x8& pa2, bf16x8& pa3) {
#pragma unroll
    for (int r = 0; r < 16; ++r) p1[r] = __builtin_amdgcn_exp2f(p1[r]);
    float ps = 0;
#pragma unroll
    for (int r = 0; r < 16; ++r) ps += p0[r];
#pragma unroll
    for (int r = 0; r < 16; ++r) ps += p1[r];
    { auto rr = __builtin_amdgcn_permlane32_swap(__float_as_uint(ps), __float_as_uint(ps), false, false); ps = __uint_as_float(rr[0]) + __uint_as_float(rr[1]); }
    l_reg = l_reg * alpha + ps;
#define PK4(P, BASE, OUT) do { unsigned a0 = cvtpk(P[BASE + 0], P[BASE + 1]), a1 = cvtpk(P[BASE + 2], P[BASE + 3]);   \
    unsigned b0 = cvtpk(P[BASE + 4], P[BASE + 5]), b1 = cvtpk(P[BASE + 6], P[BASE + 7]);                              \
    auto r0 = __builtin_amdgcn_permlane32_swap(a0, b0, false, false); auto r1 = __builtin_amdgcn_permlane32_swap(a1, b1, false, false); \
    u32x4 w = {r0[0], r1[0], r0[1], r1[1]}; OUT = __builtin_bit_cast(bf16x8, w); } while (0)
    PK4(p0, 0, pa0); PK4(p0, 8, pa1); PK4(p1, 0, pa2); PK4(p1, 8, pa3);
#undef PK4
}
__device__ __forceinline__ void qkt(f32x16& p0, f32x16& p1, const LAS char* Ks, const bf16x8* qr, int r32, int hi) {
#pragma unroll
    for (int r = 0; r < 16; ++r) { p0[r] = 0.f; p1[r] = 0.f; }
#pragma unroll
    for (int d0 = 0; d0 < 12; ++d0) { const int cb = (d0 * 16 + hi * 8) * 2;
        const bf16x8 b0 = *(const LAS bf16x8*)(Ks + r32 * KROW + cb);
        const bf16x8 b1 = *(const LAS bf16x8*)(Ks + (32 + r32) * KROW + cb);
        p0 = __builtin_amdgcn_mfma_f32_32x32x16_bf16(b0, qr[d0], p0, 0, 0, 0);
        p1 = __builtin_amdgcn_mfma_f32_32x32x16_bf16(b1, qr[d0], p1, 0, 0, 0); }
}
__device__ __forceinline__ int v_st(int k, int c) { const int kk = (k & ~0xC) | ((k & 4) << 1) | ((k & 8) >> 1); return ((kk >> 3) * 4 + (c >> 5)) * 512 + ((kk & 7) * 32 + (c & 31)) * 2; }
__device__ __forceinline__ int v_rd_base(int lane) { return ((lane & 3) << 3) | (((lane >> 2) & 3) << 6) | (((lane >> 4) & 1) << 5) | (((lane >> 5) & 1) << 8); }
constexpr int v_rd_off(int d0, int ks, int half) { return d0 * 512 + ks * 4096 + half * 2048; }
template <int OFF> __device__ __forceinline__ s16x4 tr_read(int vb) { s16x4 r; asm volatile("ds_read_b64_tr_b16 %0, %1 offset:%2" : "=&v"(r) : "v"(vb), "i"(OFF) : "memory"); return r; }
template <int D0> __device__ __forceinline__ void pv_one(f32x16& od, int vb, bf16x8 pa0, bf16x8 pa1, bf16x8 pa2, bf16x8 pa3) {
    const s16x4 l0 = tr_read<v_rd_off(D0, 0, 0)>(vb), h0 = tr_read<v_rd_off(D0, 0, 1)>(vb), l1 = tr_read<v_rd_off(D0, 1, 0)>(vb), h1 = tr_read<v_rd_off(D0, 1, 1)>(vb);
    const s16x4 l2 = tr_read<v_rd_off(D0, 2, 0)>(vb), h2 = tr_read<v_rd_off(D0, 2, 1)>(vb), l3 = tr_read<v_rd_off(D0, 3, 0)>(vb), h3 = tr_read<v_rd_off(D0, 3, 1)>(vb);
    asm volatile("s_waitcnt lgkmcnt(0)" ::: "memory"); SBAR();
#define PKV(L, H) (bf16x8){L[0], L[1], L[2], L[3], H[0], H[1], H[2], H[3]}
    od = __builtin_amdgcn_mfma_f32_32x32x16_bf16(pa0, PKV(l0, h0), od, 0, 0, 0);
    od = __builtin_amdgcn_mfma_f32_32x32x16_bf16(pa1, PKV(l1, h1), od, 0, 0, 0);
    od = __builtin_amdgcn_mfma_f32_32x32x16_bf16(pa2, PKV(l2, h2), od, 0, 0, 0);
    od = __builtin_amdgcn_mfma_f32_32x32x16_bf16(pa3, PKV(l3, h3), od, 0, 0, 0);
#undef PKV
}
__device__ __forceinline__ void pv_d0(f32x16* o, int vb, bf16x8 pa0, bf16x8 pa1, bf16x8 pa2, bf16x8 pa3) {
    pv_one<0>(o[0], vb, pa0, pa1, pa2, pa3); pv_one<1>(o[1], vb, pa0, pa1, pa2, pa3); pv_one<2>(o[2], vb, pa0, pa1, pa2, pa3); pv_one<3>(o[3], vb, pa0, pa1, pa2, pa3);
}

__device__ __forceinline__ void attn_unit(int s, int h, int qb, const bf16_t* __restrict__ MQ, const bf16_t* __restrict__ MKV, const bf16_t* __restrict__ KR, bf16_t* __restrict__ MIX, LAS char* lds) {
    int tid_ = threadIdx.x; asm volatile("" : "+v"(tid_));
    const int tid = tid_, wid = tid >> 6, lane = tid & 63, r32 = lane & 31, hi = lane >> 5;
    LAS char* V_lds = lds + OFF_V; LAS char* K_lds = lds + OFF_K;
    LAS float* wsf = (LAS float*)(lds + OFF_WS) + wid * 64; LAS float* li_l = wsf; LAS float* al_l = wsf + 32;
    float m_reg = NEGBIG, l_reg = 0; f32x16 o[4]; bf16x8 qr[12];
#pragma unroll
    for (int d = 0; d < 4; ++d)
#pragma unroll
        for (int r = 0; r < 16; ++r) o[d][r] = 0.f;
    const int qi = wid * QBLK + r32;
    const unsigned qrow = qb < 16 ? (unsigned)s * LREAL + 256 * qb + qi : (unsigned)MROW0 + 16 * s + (qi < 15 ? qi : 15);
    { const bf16_t* Qw = MQ + (qrow * NQ + h * 192 + hi * 8);
#pragma unroll
      for (int d0 = 0; d0 < 12; ++d0) qr[d0] = *(const bf16x8*)(Qw + d0 * 16); }
    const int sr = tid >> 4, sc = (tid & 15) * 8, vst0 = v_st(sr, sc), vst1 = v_st(32 + sr, sc);
    const int kr_r = tid >> 3, kr_c = (tid & 7) * 8;
    const int vb0 = (int)(uintptr_t)V_lds + v_rd_base(lane);
    bf16x8 vs0, vs1, ks0, ks1, kr0;
    const unsigned mainrow0 = (unsigned)s * LREAL, metarow0 = (unsigned)MROW0 + 16 * s;
    const bf16_t* MKVh = MKV + h * 256;
#define KROWG(kt, k) ((kt) < 64 ? mainrow0 + 64u * (kt) + (k) : metarow0 + ((k) < 15 ? (k) : 15))
#define SLOAD(kt) do { const unsigned g0 = KROWG(kt, sr) * NKV + sc, g1 = KROWG(kt, 32 + sr) * NKV + sc, g2 = KROWG(kt, kr_r) * 64 + kr_c; \
    vs0 = *(const bf16x8*)(MKVh + 128 + g0); vs1 = *(const bf16x8*)(MKVh + 128 + g1); \
    ks0 = *(const bf16x8*)(MKVh + g0); ks1 = *(const bf16x8*)(MKVh + g1); kr0 = *(const bf16x8*)(KR + g2); } while (0)
#define SWRITE(b) do { *(LAS bf16x8*)(V_lds + (b) * SHM_V + vst0) = vs0; *(LAS bf16x8*)(V_lds + (b) * SHM_V + vst1) = vs1; \
    *(LAS bf16x8*)(K_lds + (b) * SHM_K + sr * KROW + sc * 2) = ks0; *(LAS bf16x8*)(K_lds + (b) * SHM_K + (32 + sr) * KROW + sc * 2) = ks1; \
    *(LAS bf16x8*)(K_lds + (b) * SHM_K + kr_r * KROW + 256 + kr_c * 2) = kr0; } while (0)
#define RESC(a) do { if (__any((a) < 1.f)) { if (hi == 0) al_l[r32] = (a); asm volatile("s_waitcnt lgkmcnt(0)" ::: "memory"); \
    _Pragma("unroll") for (int d = 0; d < 4; ++d) _Pragma("unroll") for (int r = 0; r < 16; ++r) o[d][r] *= al_l[crow(r, hi)]; } } while (0)
    f32x16 pA0, pA1, pB0, pB1; float mnA, mnB, alA, alB; bf16x8 pa0, pa1, pa2, pa3;
    __syncthreads();
    SLOAD(0); SWRITE(0); __syncthreads();
    qkt(pA0, pA1, K_lds, qr, r32, hi); partialSM<false>(pA0, pA1, m_reg, mnA, alA);
    SLOAD(1); SWRITE(1); __syncthreads();
    RESC(alA);
    int s0 = 0, s1 = 1, s2 = 2;
    for (int j = 1; j + 1 < NT; j += 2) {
        SBAR(); qkt(pB0, pB1, K_lds + s1 * SHM_K, qr, r32, hi);
        finishSM(pA0, pA1, alA, l_reg, pa0, pa1, pa2, pa3); SBAR();
        SLOAD(j + 1); SBAR();
        pv_d0(o, vb0 + s0 * SHM_V, pa0, pa1, pa2, pa3); partialSM<false>(pB0, pB1, m_reg, mnB, alB);
        SWRITE(s2);
        RESC(alB); __syncthreads();
        SBAR(); qkt(pA0, pA1, K_lds + s2 * SHM_K, qr, r32, hi);
        finishSM(pB0, pB1, alB, l_reg, pa0, pa1, pa2, pa3); SBAR();
        if (j + 2 < NT) SLOAD(j + 2); SBAR();
        pv_d0(o, vb0 + s1 * SHM_V, pa0, pa1, pa2, pa3);
        if (j + 1 == NT - 1) partialSM<true>(pA0, pA1, m_reg, mnA, alA); else partialSM<false>(pA0, pA1, m_reg, mnA, alA);
        if (j + 2 < NT) SWRITE(s0);
        RESC(alA); __syncthreads();
        { const int t0 = s0, t1 = s1; s0 = s2; s1 = t0; s2 = t1; }
    }
    finishSM(pA0, pA1, alA, l_reg, pa0, pa1, pa2, pa3); SBAR();
    pv_d0(o, vb0 + s0 * SHM_V, pa0, pa1, pa2, pa3);
    if (hi == 0) li_l[r32] = l_reg; asm volatile("s_waitcnt lgkmcnt(0)" ::: "memory");
    float rli[16];
#pragma unroll
    for (int r = 0; r < 16; ++r) rli[r] = __builtin_amdgcn_rcpf(li_l[crow(r, hi)]);
    if (qb < 16) {
        bf16_t* Ow = MIX + ((long)s * LREAL + 256 * qb + wid * QBLK) * DM + MLW + h * 128;
#pragma unroll
        for (int r = 0; r < 16; ++r) { const int orow = crow(r, hi);
#pragma unroll
            for (int d0 = 0; d0 < 4; ++d0) Ow[(long)orow * DM + d0 * 32 + r32] = (bf16_t)(pk2(o[d0][r] * rli[r], 0.f) & 0xffffu); }
    } else if (wid == 0) {
        bf16_t* Ow = MIX + ((long)MROW0 + 16 * s) * DM + MLW + h * 128;
#pragma unroll
        for (int r = 0; r < 16; ++r) { const int orow = crow(r, hi);
            if (orow < 16) {
#pragma unroll
                for (int d0 = 0; d0 < 4; ++d0) Ow[(long)orow * DM + d0 * 32 + r32] = (bf16_t)(pk2(o[d0][r] * rli[r], 0.f) & 0xffffu); } }
    }
#undef KROWG
#undef SLOAD
#undef SWRITE
#undef RESC
}
__device__ __forceinline__ void attn_phase(int vcu, const bf16_t* MQ, const bf16_t* MKV, const bf16_t* KR, bf16_t* MIX, LAS char* lds) {
    for (int i = (vcu < 96 ? -1 : 0); i < 6; ++i) { int sh, qb; if (i < 0) { sh = vcu; qb = 16; } else { const int id = i * GRID + vcu; sh = id >> 4; qb = id & 15; }
        attn_unit(sh >> 3, sh & 7, qb, MQ, MKV, KR, MIX, lds); }
}
#undef SBAR
}

namespace ml {
constexpr int QI = 0, KI = 32768, VI = 65536, SI = 81920, CI = 98304;
constexpr int SC_CT = 0, SC_BM = 64, SC_WI = 128, SC_EI = 192, SC_WW = 256, SC_DEN = 320, SC_QN = 448, SC_N = 512, SC_A = 768;
constexpr int GP_REC = 200;
__device__ __forceinline__ unsigned off_b(unsigned row, unsigned ch) { return 256u * row + 16u * (ch ^ (((row & 3) << 2) | ((row >> 2) & 3))); }
__device__ __forceinline__ unsigned row_read_addr_16(unsigned lane, unsigned rb, unsigned s) { return off_b((lane & 15) + 16 * rb, 4 * s + (lane >> 4)); }
__device__ __forceinline__ unsigned tr_read_addr_16(unsigned lane, unsigned c, unsigned ks, unsigned t) {
    const unsigned g = lane >> 4, q = (lane & 15) >> 2, p = lane & 3; return off_b(32 * ks + 8 * g + 4 * t + q, 2 * c + (p >> 1)) + 8 * (p & 1); }
__device__ __forceinline__ bf16x8 tr_frag(unsigned a0, unsigned a1) {
    const s16x4 lo = __builtin_amdgcn_ds_read_tr16_b64_v4i16((LAS s16x4*)a0), hi = __builtin_amdgcn_ds_read_tr16_b64_v4i16((LAS s16x4*)a1);
    return (bf16x8){lo[0], lo[1], lo[2], lo[3], hi[0], hi[1], hi[2], hi[3]};
}
__device__ __forceinline__ f32x4 mfma16(bf16x8 a, bf16x8 b, f32x4 c) { return __builtin_amdgcn_mfma_f32_16x16x32_bf16(a, b, c, 0, 0, 0); }
__device__ __forceinline__ float log_sigmoid(float x) { return fminf(x, 0.f) - __logf(1.f + __expf(-fabsf(x))); }

__device__ __forceinline__ void gate_prep(int gw, int ngw, int lane, const float* __restrict__ GATES, const float* __restrict__ bgl, float* __restrict__ GP) {
    for (int it = gw; it < 96 * 65; it += ngw) {
        const int chain = it / 65, c = it % 65, s = chain >> 3, hd = (chain >> 1) & 3, dir = chain & 1;
        const long g = c == 0 ? (lane >= 48 ? (long)MROW0 + 16 * s + lane - 48 : -1L) : (long)s * LREAL + 64 * (c - 1) + lane;
        float li = NEGBIG, lf = 0.f;
        if (g >= 0) { li = GATES[g * 16 + (dir ? 8 : 0) + hd] + bgl[(dir ? 8 : 0) + hd]; lf = log_sigmoid(GATES[g * 16 + (dir ? 12 : 4) + hd] + bgl[(dir ? 12 : 4) + hd]); }
        float x = dir ? __shfl(lf, 63 - lane) : lf;
#pragma unroll
        for (int o = 1; o < 64; o <<= 1) { const float y = __shfl_up(x, o); if (lane >= o) x += y; }
        const float btot = __shfl(x, 63);
        const float b = dir ? __shfl(x, 63 - lane) : x;
        const float a_s = li - b;
        float pm = dir ? __shfl(a_s, 63 - lane) : a_s;
#pragma unroll
        for (int o = 1; o < 64; o <<= 1) { const float y = __shfl_up(pm, o); if (lane >= o) pm = fmaxf(pm, y); }
        pm = dir ? __shfl(pm, 63 - lane) : pm;
        const float gmax = wave_max(btot - b + li);
        float* rec = GP + (size_t)it * GP_REC;
        rec[lane] = b; rec[64 + lane] = li; rec[128 + lane] = pm; if (lane == 0) { rec[192] = btot; rec[193] = gmax; }
    }
}

__device__ __forceinline__ void mlstm_unit(int s, int hd, int js, const bf16_t* __restrict__ UQKVO, const float* __restrict__ GP, float* __restrict__ HSUM, LAS unsigned char* lds, LAS float* sc) {
    const int wid = __builtin_amdgcn_readfirstlane((int)threadIdx.x >> 6);
    const unsigned ldsb = (unsigned)(uintptr_t)lds;
    const int tt = wid >> 1, nb = 2 * (wid & 1);
#define ROWRD(img, rb, s_) (*(const LAS bf16x8*)(uintptr_t)(RB[s_] + (unsigned)((img) + 4096 * (rb))))
#define TRFRAG(img, c_, ks) tr_frag(BT[0][(c_) & 1] + TQ[(c_) >> 1] + (unsigned)((img) + 8192 * (ks)), BT[1][(c_) & 1] + TQ[(c_) >> 1] + (unsigned)((img) + 8192 * (ks)))
    f32x4 accC[2][4], accN[2];
    for (int dir = 0; dir < 2; ++dir) {
        int tid; { int t0_ = threadIdx.x; asm volatile("" : "+v"(t0_)); tid = t0_; }
#pragma unroll
        for (int mi = 0; mi < 2; ++mi)
#pragma unroll
            for (int c = 0; c < 4; ++c) accC[mi][c] = (f32x4){0.f, 0.f, 0.f, 0.f};
        accN[0] = (f32x4){0.f, 0.f, 0.f, 0.f}; accN[1] = (f32x4){0.f, 0.f, 0.f, 0.f};
        if (tid < 256) sc[SC_N + tid] = 0.f;
        for (int i = tid; i < 32768 / 16; i += 512) *(LAS u32x4*)(lds + CI + i * 16) = (u32x4){0u, 0u, 0u, 0u};
        float m_state = 0.f;
        const float* GPc = GP + (size_t)(((s * 4 + hd) * 2 + dir) * 65) * GP_REC;
        u32x4 sq[4], sk[4], sv; float sb = 0.f, sli = NEGBIG, spm = NEGBIG, sbt = 0.f, sgm = NEGBIG;
#define ROWG(c, r) ((c) == 0 ? ((r) >= 48 ? (long)MROW0 + 16 * s + (r) - 48 : -1L) : (long)s * LREAL + 64 * ((c) - 1) + (r))
#define STAGE_LOAD(c) do { \
        _Pragma("unroll") for (int i = 0; i < 4; ++i) { const int id = tid + 512 * i, r = id >> 5, ch = id & 31; const long g = ROWG(c, r); \
            sq[i] = (u32x4){0u, 0u, 0u, 0u}; sk[i] = (u32x4){0u, 0u, 0u, 0u}; \
            if (g >= 0) { sq[i] = *(const u32x4*)(UQKVO + g * 4096 + hd * 256 + ch * 8); sk[i] = *(const u32x4*)(UQKVO + g * 4096 + 1024 + hd * 256 + ch * 8); } } \
        { const int r = tid >> 3, ch = tid & 7; const long g = ROWG(c, r); sv = (u32x4){0u, 0u, 0u, 0u}; if (g >= 0) sv = *(const u32x4*)(UQKVO + g * 4096 + 2048 + hd * 256 + js * 64 + ch * 8); } \
        if (tid < 64) { const float* rec = GPc + (size_t)(c) * GP_REC; sb = rec[tid]; sli = rec[64 + tid]; spm = rec[128 + tid]; sbt = rec[192]; sgm = rec[193]; } } while (0)
#define STAGE_WRITE() do { \
        _Pragma("unroll") for (int i = 0; i < 4; ++i) { const int id = tid + 512 * i, r = id >> 5, ch = id & 31; \
            *(LAS u32x4*)(lds + QI + (ch >> 4) * 16384 + off_b(r, ch & 15)) = sq[i]; *(LAS u32x4*)(lds + KI + (ch >> 4) * 16384 + off_b(r, ch & 15)) = sk[i]; } \
        { const int r = tid >> 3, ch = tid & 7; *(LAS u32x4*)(lds + VI + off_b(r, ch)) = sv; } \
        if (tid < 64) { const float m_inter = sb + m_state, mt = fmaxf(m_inter, sb + spm); const float m_new = fmaxf(sbt + m_state, sgm); \
            sc[SC_CT + tid] = sli - sb; sc[SC_BM + tid] = sb - mt; sc[SC_WI + tid] = __expf(m_inter - mt); sc[SC_EI + tid] = __expf(-mt); \
            sc[SC_WW + tid] = __expf(sbt - sb + sli - m_new) * 0.0625f; if (tid == 0) sc[SC_A] = __expf(sbt + m_state - m_new); m_state = m_new; } } while (0)
        const int c_first = dir ? 64 : 0, c_step = dir ? -1 : 1;
        STAGE_LOAD(c_first);
        __syncthreads();
        STAGE_WRITE();
        for (int ci = 0; ci < 65; ++ci) {
            const int c = c_first + c_step * ci;
            { int t2_ = threadIdx.x; asm volatile("" : "+v"(t2_)); tid = t2_; }
            const int lane = tid & 63, l15 = lane & 15, lg = lane >> 4;
            unsigned RB[4], BT[2][2], TQ[4];
            { const unsigned fl = ((l15 & 3) << 2) | (l15 >> 2), q = l15 >> 2, p = lane & 3, g = lg;
#pragma unroll
              for (int s_ = 0; s_ < 4; ++s_) { RB[s_] = ldsb + 256u * l15 + 16u * (lg ^ (fl & 3)) + 64u * (s_ ^ (fl >> 2)); TQ[s_] = 64u * (s_ ^ q); }
#pragma unroll
              for (int t_ = 0; t_ < 2; ++t_)
#pragma unroll
                  for (int cl = 0; cl < 2; ++cl) BT[t_][cl] = ldsb + 256u * (8 * g + q) + 8u * (p & 1) + 1024u * t_ + 16u * ((p >> 1) ^ t_) + 32u * (cl ^ (g & 1)); }
            __syncthreads();
            if (ci + 1 < 65) STAGE_LOAD(c + c_step);
            bf16x8 qf[8];
#pragma unroll
            for (int k = 0; k < 8; ++k) qf[k] = ROWRD(QI + (k >> 2) * 16384, tt, k & 3);
            f32x4 sT[2], oc[2];
#pragma unroll
            for (int i = 0; i < 2; ++i) { sT[i] = (f32x4){0.f, 0.f, 0.f, 0.f}; oc[i] = (f32x4){0.f, 0.f, 0.f, 0.f}; }
#pragma unroll
            for (int i = 0; i < 2; ++i)
#pragma unroll
                for (int k = 0; k < 8; ++k) {
                    const bf16x8 kf = ROWRD(KI + (k >> 2) * 16384, nb + i, k & 3);
                    sT[i] = mfma16(kf, qf[k], sT[i]);
                    const bf16x8 cf = ROWRD(CI + (k >> 2) * 16384, nb + i, k & 3);
                    oc[i] = mfma16(qf[k], cf, oc[i]);
                }
            {
                const int t = 16 * tt + l15; const float bmt = sc[SC_BM + t]; float rs = 0.f;
#pragma unroll
                for (int i = 0; i < 2; ++i) { const int s0 = 16 * (nb + i) + 4 * lg; const f32x4 ctv = *(const LAS f32x4*)(sc + SC_CT + s0); float v[4];
#pragma unroll
                    for (int e = 0; e < 4; ++e) { const int sx = s0 + e; const bool ok = dir ? (sx >= t) : (sx <= t);
                        const float ex = ok ? (bmt + ctv[e]) : NEGBIG; v[e] = sT[i][e] * 0.0625f * __expf(ex); rs += v[e]; }
                    u32x2 w; w.x = pk2(v[0], v[1]); w.y = pk2(v[2], v[3]);
                    *(LAS u32x2*)(lds + SI + off_b(t, s0 >> 3) + (s0 & 7) * 2) = w; }
                rs += __shfl_xor(rs, 16); rs += __shfl_xor(rs, 32);
                if (lg == 0) sc[SC_DEN + 64 * (wid & 1) + t] = rs;
            }
            { const int r = tid >> 3, ch = tid & 7; const u32x4 v = *(const LAS u32x4*)(lds + VI + off_b(r, ch)); const float w = sc[SC_WW + r]; u32x4 o;
#pragma unroll
              for (int jx = 0; jx < 4; ++jx) o[jx] = pk2(bf_lo(v[jx]) * w, bf_hi(v[jx]) * w);
              *(LAS u32x4*)(lds + VI + off_b(r, 8 + ch)) = o; }
            { const int r = tid >> 3, part = tid & 7; float d = 0.f;
#pragma unroll
              for (int i = 0; i < 4; ++i) { const int ch32 = part * 4 + i; const u32x4 v = *(const LAS u32x4*)(lds + QI + (ch32 >> 4) * 16384 + off_b(r, ch32 & 15));
                  const f32x4 n0 = *(const LAS f32x4*)(sc + SC_N + ch32 * 8), n1 = *(const LAS f32x4*)(sc + SC_N + ch32 * 8 + 4);
                  d += bf_lo(v[0]) * n0[0] + bf_hi(v[0]) * n0[1] + bf_lo(v[1]) * n0[2] + bf_hi(v[1]) * n0[3] + bf_lo(v[2]) * n1[0] + bf_hi(v[2]) * n1[1] + bf_lo(v[3]) * n1[2] + bf_hi(v[3]) * n1[3]; }
              d += __shfl_xor(d, 1); d += __shfl_xor(d, 2); d += __shfl_xor(d, 4);
              if (part == 0) sc[SC_QN + r] = d; }
            { const f32x4 wi = *(const LAS f32x4*)(sc + SC_WI + 16 * tt + 4 * lg);
#pragma unroll
              for (int i = 0; i < 2; ++i) oc[i] = oc[i] * wi; }
            __syncthreads();
            const float a_dec = sc[SC_A];
#pragma unroll
            for (int ks = 0; ks < 2; ++ks) { const bf16x8 sf = ROWRD(SI, tt, ks);
#pragma unroll
                for (int i = 0; i < 2; ++i) { const bf16x8 vf = TRFRAG(VI, nb + i, ks);
                    oc[i] = mfma16(sf, vf, oc[i]); } }
            { const int t0 = 16 * tt + 4 * lg;
              const f32x4 wi = *(const LAS f32x4*)(sc + SC_WI + t0), qn = *(const LAS f32x4*)(sc + SC_QN + t0), d0 = *(const LAS f32x4*)(sc + SC_DEN + t0), d1 = *(const LAS f32x4*)(sc + SC_DEN + 64 + t0), ei = *(const LAS f32x4*)(sc + SC_EI + t0);
#pragma unroll
              for (int e = 0; e < 4; ++e) { const long g = ROWG(c, t0 + e);
                const float den = wi[e] * qn[e] + (d0[e] + d1[e]); const float inv = 1.f / fmaxf(fabsf(den), ei[e]);
                if (g >= 0) {
#pragma unroll
                    for (int i = 0; i < 2; ++i) { float* hp = HSUM + g * MLW + hd * 256 + js * 64 + 16 * (nb + i) + l15; const float hv = oc[i][e] * inv; if (dir) unsafeAtomicAdd(hp, hv); else *hp = hv; } } } }
#pragma unroll
            for (int mi = 0; mi < 2; ++mi)
#pragma unroll
                for (int cc = 0; cc < 4; ++cc) accC[mi][cc] = accC[mi][cc] * a_dec;
            accN[0] = accN[0] * a_dec; accN[1] = accN[1] * a_dec;
            const unsigned ktq = (unsigned)(KI + (wid >> 2) * 16384) + 64u * ((unsigned)(wid & 3) ^ (unsigned)(l15 >> 2));
#pragma unroll
            for (int ks = 0; ks < 2; ++ks) {
                bf16x8 kf[2], wf[4];
#pragma unroll
                for (int mi = 0; mi < 2; ++mi) kf[mi] = tr_frag(BT[0][mi] + ktq + (unsigned)(8192 * ks), BT[1][mi] + ktq + (unsigned)(8192 * ks));
#pragma unroll
                for (int cc = 0; cc < 4; ++cc) wf[cc] = TRFRAG(VI, 4 + cc, ks);
                { const f32x4 wa = *(const LAS f32x4*)(sc + SC_WW + 32 * ks + 8 * lg), wb = *(const LAS f32x4*)(sc + SC_WW + 32 * ks + 8 * lg + 4);
                  u32x4 wq; wq.x = pk2(wa[0], wa[1]); wq.y = pk2(wa[2], wa[3]); wq.z = pk2(wb[0], wb[1]); wq.w = pk2(wb[2], wb[3]);
                  if (l15 != 0) wq = (u32x4){0u, 0u, 0u, 0u};
                  const bf16x8 wfn = __builtin_bit_cast(bf16x8, wq);
#pragma unroll
                  for (int mi = 0; mi < 2; ++mi) accN[mi] = mfma16(kf[mi], wfn, accN[mi]); }
#pragma unroll
                for (int mi = 0; mi < 2; ++mi)
#pragma unroll
                    for (int cc = 0; cc < 4; ++cc) accC[mi][cc] = mfma16(kf[mi], wf[cc], accC[mi][cc]);
            }
#pragma unroll
            for (int mi = 0; mi < 2; ++mi)
#pragma unroll
                for (int cc = 0; cc < 4; ++cc) { const int dk0 = 32 * wid + 16 * mi + 4 * lg, dv = 16 * cc + l15; u32x2 w; w.x = pk2(accC[mi][cc][0], accC[mi][cc][1]); w.y = pk2(accC[mi][cc][2], accC[mi][cc][3]);
                    *(LAS u32x2*)(lds + CI + (dk0 >> 7) * 16384 + off_b(dv, (dk0 & 127) >> 3) + (dk0 & 7) * 2) = w; }
            if (l15 == 0) { *(LAS f32x4*)(sc + SC_N + 32 * wid + 4 * lg) = accN[0]; *(LAS f32x4*)(sc + SC_N + 32 * wid + 16 + 4 * lg) = accN[1]; }
            __syncthreads();
            if (ci + 1 < 65) STAGE_WRITE();
        }
    }
#undef ROWG
#undef STAGE_LOAD
#undef STAGE_WRITE
#undef ROWRD
#undef TRFRAG
}
__device__ __forceinline__ void mlstm_phase(int bx, const bf16_t* UQKVO, const float* GP, float* HSUM, LAS unsigned char* lds, LAS float* sc) {
    if (bx >= 192) return;
    const int xcd = bx & 7, idx = bx >> 3, pair = xcd * 6 + (idx >> 2), js = idx & 3;
    mlstm_unit(pair >> 2, pair & 3, js, UQKVO, GP, HSUM, lds, sc);
}
}

#ifndef PHM
#define PHM 0xffff
#endif
#ifndef REP_ML
#define REP_ML 1
#endif
#ifndef REP_ATTN
#define REP_ATTN 1
#endif
#ifndef REP_CONV
#define REP_CONV 1
#endif
#ifndef REP_SMALL
#define REP_SMALL 1
#endif
#ifndef KV_SPLIT
#define KV_SPLIT 193
#endif
#ifndef REP_WIN
#define REP_WIN 1
#endif
#ifndef REP_UP
#define REP_UP 1
#endif
__global__ void __launch_bounds__(512, 2) fwd_kernel(Params P, unsigned char* ws_arg, unsigned char* out_arg) {
    extern __shared__ __attribute__((aligned(16))) unsigned char lds_raw[];
    Frame F;
    F.lds = (LAS unsigned char*)lds_raw;
    F.tid = threadIdx.x; F.lane = F.tid & 63; F.wave = __builtin_amdgcn_readfirstlane(F.tid >> 6);
    F.G = GRID; F.bx = blockIdx.x; F.vcu = (F.bx % 8) * (GRID / 8) + F.bx / 8;
    F.gw = F.vcu * 8 + F.wave; F.ngw = F.G * 8;
    { unsigned char* ws0 = ws_arg;
      for (int u = F.tid; u < (LDS_BYTES - MISC_OFF) / 4; u += 512) ((LAS unsigned*)(F.lds + MISC_OFF))[u] = 0u;
      __syncthreads();
      (void)ws0; }
    LAS unsigned long long* ptab = (LAS unsigned long long*)(F.lds + MISC_OFF + 64);
    if (F.tid == 0) {
#pragma unroll
        for (int k = 0; k < 19; ++k) ptab[k] = (unsigned long long)(uintptr_t)P.in[k]; }
    __syncthreads();
    XcdBarrier bar = xcd_barrier_post((unsigned*)(ws_arg + WS_CTL) + CW_BAR, (volatile LAS unsigned*)(F.lds + MISC_OFF));
    LAS float* sc = (LAS float*)(F.lds + MISC_OFF + 1024);
#define BXL() ({ int b__ = F.bx; asm volatile("" : "+s"(b__)); b__; })
#define PFRAME() Frame Fp = F; { int t_ = threadIdx.x; asm volatile("" : "+v"(t_)); Fp.tid = t_; Fp.lane = t_ & 63; int b_ = BXL(); Fp.bx = b_; Fp.vcu = (b_ % 8) * (GRID / 8) + b_ / 8; Fp.gw = Fp.vcu * 8 + Fp.wave; }
#define WSB() ({ GAS unsigned char* w__ = (GAS unsigned char*)ws_arg; asm volatile("" : "+s"(w__)); (unsigned char*)w__; })
#ifndef STAG_N
#define STAG_N 1
#endif
#ifdef STAG_ON
#define STAGGER() do { int s__ = (BXL() * 37) & 255; for (int i__ = 0; i__ < s__; ++i__) __builtin_amdgcn_s_sleep(STAG_N); } while (0)
#else
#define STAGGER() do {} while (0)
#endif
#define DOB() ({ GAS unsigned char* w__ = (GAS unsigned char*)out_arg; asm volatile("" : "+s"(w__)); (unsigned char*)w__; })

    { unsigned char* ws = WSB(); prologue(F, ws, ptab); convert_weights(F, ws, ptab, 0); }
    xcd_barrier(bar);

    for (int l = 0; l < DEPTH; ++l) {
        { unsigned char* ws = WSB();
          pg8::Gemm g{(bf16_t*)(ws + WS_HB), (bf16_t*)(ws + WS_WIN), TP, NIN, DM, DM}; pg8::PanelOrder S; S.init(NPAN, 0, 0, 0, NIN, F.G, BXL());
          pg8::EpiWin E{(bf16_t*)(ws + WS_UQKVO), (bf16_t*)(ws + WS_UDQ), (bf16_t*)(ws + WS_UDKV), (bf16_t*)(ws + WS_KR), (float*)(ws + WS_GATES), (const float*)(ws + WS_COS), (const float*)(ws + WS_SIN)};
#if PHM & 2
          STAGGER(); pg8::gemm_phase<pg8::EpiWin, pg8::PanelOrder, true, true>(F.lds, g, S, E);
#endif
        }
#if REP_WIN > 1
        __syncthreads();
        { unsigned char* ws = WSB();
          pg8::Gemm g{(bf16_t*)(ws + WS_HB), (bf16_t*)(ws + WS_WIN), TP, NIN, DM, DM}; pg8::PanelOrder S; S.init(NPAN, 0, 0, 0, NIN, F.G, BXL());
          pg8::EpiWin E{(bf16_t*)(ws + WS_UQKVO), (bf16_t*)(ws + WS_UDQ), (bf16_t*)(ws + WS_UDKV), (bf16_t*)(ws + WS_KR), (float*)(ws + WS_GATES), (const float*)(ws + WS_COS), (const float*)(ws + WS_SIN)};
          pg8::gemm_phase<pg8::EpiWin, pg8::PanelOrder, true, true>(F.lds, g, S, E);
        }
#endif
        xcd_barrier(bar);
        { unsigned char* ws = WSB(); unsigned char* dob = DOB(); PFRAME(); rstd_rows(Fp, (bf16_t*)(ws + WS_UDQ), (bf16_t*)(ws + WS_UDKV), (float*)(ws + WS_RSTD));
          ml::gate_prep(Fp.gw, Fp.ngw, Fp.lane, (const float*)(ws + WS_GATES), (const float*)(ws + WS_PAR) + PO_BG + l * 16, (float*)(dob + DO_GP)); }
#if REP_SMALL > 1
        { unsigned char* ws = WSB(); unsigned char* dob = DOB(); PFRAME(); rstd_rows(Fp, (bf16_t*)(ws + WS_UDQ), (bf16_t*)(ws + WS_UDKV), (float*)(ws + WS_RSTD));
          ml::gate_prep(Fp.gw, Fp.ngw, Fp.lane, (const float*)(ws + WS_GATES), (const float*)(ws + WS_PAR) + PO_BG + l * 16, (float*)(dob + DO_GP)); }
#endif
        xcd_barrier(bar);
        if (F.bx >= 192) {
        { unsigned char* ws = WSB(); unsigned char* dob = DOB();
          pg8::Gemm g{(bf16_t*)(ws + WS_UDQ), (bf16_t*)(ws + WS_WUQ), TP, NQ, 512, 512}; pg8::PanelOrder S; S.init(NPAN, 0, 0, 0, NQ, GRID - 192, BXL() - 192);
          pg8::EpiQ E{(bf16_t*)(dob + DO_MQ), (const float*)(ws + WS_RSTD), (const float*)(ws + WS_COS), (const float*)(ws + WS_SIN)};
#if PHM & 4
          pg8::gemm_phase<pg8::EpiQ, pg8::PanelOrder, true, true>(F.lds, g, S, E);
#endif
        }
        { unsigned char* ws = WSB();
          pg8::Gemm g{(bf16_t*)(ws + WS_UDKV), (bf16_t*)(ws + WS_WUKV), TP, NKV, 256, 256}; pg8::PanelOrder S; S.init(NPAN, 0, 0, 0, NKV, GRID - 192, BXL() - 192);
          pg8::EpiBf16G E{(bf16_t*)(ws + WS_MKV), NKV, (const float*)(ws + WS_RSTD) + 1, 0, -1, 0};
#if PHM & 8
          pg8::gemm_phase<pg8::EpiBf16G, pg8::PanelOrder, true, true>(F.lds, g, S, E);
#endif
        }
        } else {
#ifndef NO_ML
        for (int rep_ = 0; rep_ < REP_ML; ++rep_)
        { unsigned char* ws = WSB(); unsigned char* dob = DOB();
          ml::mlstm_phase(BXL(), (const bf16_t*)(ws + WS_UQKVO), (const float*)(dob + DO_GP), (float*)(dob + DO_HSUM), F.lds, sc); }
#endif
        }
        xcd_barrier(bar);
        { unsigned char* ws = WSB(); unsigned char* dob = DOB(); PFRAME();
          if (Fp.vcu >= 96) mlstm_finalize(Fp, (Fp.vcu - 96) * 8 + Fp.wave, (GRID - 96) * 8, (const float*)(dob + DO_HSUM), (const bf16_t*)(ws + WS_UQKVO), (const float*)(ws + WS_PAR) + PO_MLG + l * MLW, (bf16_t*)(ws + WS_HB)); }
#ifndef NO_ATTN
        for (int rep_ = 0; rep_ < REP_ATTN; ++rep_)
        { unsigned char* ws = WSB(); unsigned char* dob = DOB();
          att::attn_phase(({ int b__ = BXL(); (b__ % 8) * (GRID / 8) + b__ / 8; }), (const bf16_t*)(dob + DO_MQ), (const bf16_t*)(ws + WS_MKV), (const bf16_t*)(ws + WS_KR), (bf16_t*)(ws + WS_HB), (LAS char*)F.lds); }
#endif
        xcd_barrier(bar);
        { unsigned char* ws = WSB();
          pg8::Gemm g{(bf16_t*)(ws + WS_HB), (bf16_t*)(ws + WS_WOUT), TP, DM, DM, DM}; pg8::PanelOrder S; S.init(192, 0, 0, 0, DM, F.G, BXL());
          pg8::EpiResidLn E{(bf16_t*)(ws + WS_H), DM, ALPHA, (const float*)(ws + WS_STAT2), (const float*)(ws + WS_PAR) + (l > 0 ? PO_L2G + (l - 1) * DM : PO_ONE), (const float*)(ws + WS_PAR) + (l > 0 ? PO_L2B + (l - 1) * DM : PO_ZERO)};
#if PHM & 16
          STAGGER(); pg8::gemm_phase<pg8::EpiResidLn, pg8::PanelOrder, true, true>(F.lds, g, S, E);
#endif
        }
        { unsigned char* ws = WSB();
          pg8::Gemm g{(bf16_t*)(ws + WS_HB), (bf16_t*)(ws + WS_WOUT), TP, DM, DM / 4, DM}; pg8::SplitOrder S; S.init(PMETA, DM, 4, F.G, BXL());
          pg8::EpiPart E{(float*)(ws + WS_PART), DM};
#if PHM & 16
          pg8::gemm_phase<pg8::EpiPart, pg8::SplitOrder, true, true>(F.lds, g, S, E);
#endif
        }
        xcd_barrier(bar);
        { unsigned char* ws = WSB(); PFRAME(); ln_rows(Fp, (float*)(ws + WS_H), (bf16_t*)(ws + WS_HB), (const float*)(ws + WS_PAR) + PO_L1G + l * DM, (const float*)(ws + WS_PAR) + PO_L1B + l * DM, (float*)(ws + WS_STAT1), nullptr, (const float*)(ws + WS_PART), 4); }
        xcd_barrier(bar);
        { unsigned char* ws = WSB(); unsigned char* dob = DOB();
          pg8::Gemm g{(bf16_t*)(ws + WS_HB), (bf16_t*)(ws + WS_WUP), TP, NUP, DM, DM}; pg8::PanelOrder S; S.init(NPAN, 0, 0, 0, NUP, F.G, BXL());
          pg8::EpiFfn E{(bf16_t*)(ws + WS_ACT), (float*)(dob + DO_SIDE), (bf16_t*)(dob + DO_GVM), (const float*)(ws + WS_PAR) + PO_CW + (size_t)l * 3 * DFF, (const float*)(ws + WS_PAR) + PO_CB + (size_t)l * DFF, (LAS float*)(F.lds + MISC_OFF + 8192)};
#if PHM & 32
          STAGGER(); pg8::gemm_phase<pg8::EpiFfn, pg8::PanelOrder, true, true>(F.lds, g, S, E);
#if REP_UP > 1
          __syncthreads(); pg8::gemm_phase<pg8::EpiFfn, pg8::PanelOrder, true, true>(F.lds, g, S, E);
#endif
#endif
        }
        xcd_barrier(bar);
        { unsigned char* ws = WSB(); unsigned char* dob = DOB(); PFRAME();
          ffn_fixup(Fp, (const float*)(dob + DO_SIDE), (const bf16_t*)(dob + DO_GVM), (bf16_t*)(ws + WS_ACT), (const float*)(ws + WS_PAR) + PO_CW + (size_t)l * 3 * DFF, (const float*)(ws + WS_PAR) + PO_CB + (size_t)l * DFF); }
#if REP_SMALL > 1
        { unsigned char* ws = WSB(); unsigned char* dob = DOB(); PFRAME();
          ffn_fixup(Fp, (const float*)(dob + DO_SIDE), (const bf16_t*)(dob + DO_GVM), (bf16_t*)(ws + WS_ACT), (const float*)(ws + WS_PAR) + PO_CW + (size_t)l * 3 * DFF, (const float*)(ws + WS_PAR) + PO_CB + (size_t)l * DFF); }
#endif
        xcd_barrier(bar);
        { unsigned char* ws = WSB();
          pg8::Gemm g{(bf16_t*)(ws + WS_ACT), (bf16_t*)(ws + WS_WDN), TP, DM, DFF, DFF}; pg8::PanelOrder S; S.init(192, 0, 0, 0, DM, F.G, BXL());
          pg8::EpiResidLn E{(bf16_t*)(ws + WS_H), DM, ALPHA, (const float*)(ws + WS_STAT1), (const float*)(ws + WS_PAR) + PO_L1G + l * DM, (const float*)(ws + WS_PAR) + PO_L1B + l * DM};
#if PHM & 64
          STAGGER(); pg8::gemm_phase<pg8::EpiResidLn, pg8::PanelOrder, true, true>(F.lds, g, S, E);
#endif
        }
        { unsigned char* ws = WSB();
          pg8::Gemm g{(bf16_t*)(ws + WS_ACT), (bf16_t*)(ws + WS_WDN), TP, DM, DFF / 11, DFF}; pg8::SplitOrder S; S.init(PMETA, DM, 11, F.G, BXL());
          pg8::EpiPart E{(float*)(ws + WS_PART), DM};
#if PHM & 64
          pg8::gemm_phase<pg8::EpiPart, pg8::SplitOrder, true, true>(F.lds, g, S, E);
#endif
        }
        xcd_barrier(bar);
        { unsigned char* ws = WSB(); unsigned char* dob = DOB();
          PFRAME(); ln_rows(Fp, (float*)(ws + WS_H), (bf16_t*)(ws + WS_HB), (const float*)(ws + WS_PAR) + PO_L2G + l * DM, (const float*)(ws + WS_PAR) + PO_L2B + l * DM, (float*)(ws + WS_STAT2), l == DEPTH - 1 ? (float*)dob : nullptr, (const float*)(ws + WS_PART), 11); }
        if (l + 1 < DEPTH) { unsigned char* ws = WSB(); PFRAME(); convert_weights(Fp, ws, ptab, l + 1); }
#if REP_CONV > 1
        if (l + 1 < DEPTH) { __syncthreads(); unsigned char* ws = WSB(); PFRAME(); convert_weights(Fp, ws, ptab, l + 1); }
#endif
        xcd_barrier(bar);
    }
}

extern "C" void kernel_launch(void* const* d_in, const int* in_sizes, int n_in, void* d_out, int out_size, void* d_ws, size_t ws_size, hipStream_t stream) {
    static int grid = 0;
    if (grid == 0) {
        if (n_in != 19 || out_size != NMAIN * DM || ws_size < WS_NEED) { fprintf(stderr, "kernel_launch: unexpected shapes (n_in %d out %d ws %zu need %zu)\n", n_in, out_size, ws_size, (size_t)WS_NEED); grid = -1; return; }
        int dev = 0, cus = 0;
        if (hipGetDevice(&dev) != hipSuccess || hipDeviceGetAttribute(&cus, hipDeviceAttributeMultiprocessorCount, dev) != hipSuccess) { grid = -1; return; }
        if (hipFuncSetAttribute((const void*)fwd_kernel, hipFuncAttributeMaxDynamicSharedMemorySize, LDS_BYTES) != hipSuccess) { fprintf(stderr, "kernel_launch: hipFuncSetAttribute failed\n"); grid = -1; return; }
        int per_cu = 0;
        if (hipOccupancyMaxActiveBlocksPerMultiprocessor(&per_cu, (const void*)fwd_kernel, 512, LDS_BYTES) != hipSuccess || per_cu < 1) { fprintf(stderr, "kernel_launch: occupancy query says %d blocks per CU\n", per_cu); (void)hipGetLastError(); grid = -1; return; }
        if (cus < GRID) { fprintf(stderr, "kernel_launch: needs %d CUs, device has %d\n", GRID, cus); grid = -1; return; }
        grid = GRID;
    }
    if (grid < 0) return;
    (void)hipMemsetAsync((char*)d_ws + WS_CTL, 0, CTL_BYTES, stream);
    Params p{};
    for (int i = 0; i < 19; ++i) p.in[i] = (const float*)d_in[i];
    hipLaunchKernelGGL(fwd_kernel, dim3(grid), dim3(512), LDS_BYTES, stream, p, (unsigned char*)d_ws, (unsigned char*)d_out);
}
```

```cpp
#include <hip/hip_runtime.h>
#include <cstdio>
#include <cstdint>

#define LAS __attribute__((address_space(3)))
#define GAS __attribute__((address_space(1)))
typedef float f32x2 __attribute__((ext_vector_type(2)));
typedef float f32x8 __attribute__((ext_vector_type(8)));
typedef float f32x16 __attribute__((ext_vector_type(16)));
typedef unsigned u32x2 __attribute__((ext_vector_type(2)));
typedef short s16x4 __attribute__((ext_vector_type(4)));
typedef __bf16 bf16x2v __attribute__((ext_vector_type(2)));

constexpr int DM = 2048, NSEQ = 12, LREAL = 4096, NMETA = 16, DEPTH = 4;
constexpr int NMAIN = NSEQ * LREAL;
constexpr int MROW0 = NMAIN;
constexpr int NTOK = NMAIN + NSEQ * NMETA;
constexpr int NPAN = 193, TP = NPAN * 256;
constexpr int PMETA = 192;
constexpr int INC = 4944, NIN = 5120;
constexpr int DFF = 5632, NUP = 2 * DFF;
constexpr int MLW = 1024, NQ = 1536, NKV = 2048;
constexpr float ALPHA = 1.681792830507429f;
constexpr float EPS = 1e-5f;
constexpr float NEGBIG = -1e30f;

constexpr size_t MiB = 1u << 20;
constexpr size_t WS_CTL = 0, CTL_BYTES = 1 * MiB;
constexpr size_t WS_COS = 1 * MiB;
constexpr size_t WS_SIN = WS_COS + (size_t)4112 * 32 * 4;
constexpr size_t WS_PAR = 2 * MiB + 128 * 1024;
constexpr int PO_BG = 0, PO_MLG = PO_BG + DEPTH * 16, PO_QG = PO_MLG + DEPTH * 1024, PO_KVG = PO_QG + DEPTH * 512, PO_L1G = PO_KVG + DEPTH * 256, PO_L1B = PO_L1G + DEPTH * 2048,
              PO_CW = PO_L1B + DEPTH * 2048, PO_CB = PO_CW + DEPTH * 3 * 5632, PO_L2G = PO_CB + DEPTH * 5632, PO_L2B = PO_L2G + DEPTH * 2048, PO_ONE = PO_L2B + DEPTH * 2048, PO_ZERO = PO_ONE + 2048, PO_END = PO_ZERO + 2048;
static_assert(WS_PAR + (size_t)PO_END * 4 <= 3 * MiB && WS_PAR >= 1 * MiB + 2 * 4112 * 32 * 4, "PAR block placement");
constexpr size_t WS_WIN = 3 * MiB;
constexpr size_t WS_WUQ = WS_WIN + (size_t)NIN * DM * 2;
constexpr size_t WS_WUKV = WS_WUQ + (size_t)NQ * 512 * 2;
constexpr size_t WS_WOUT = WS_WUKV + (size_t)NKV * 256 * 2;
constexpr size_t WS_WUP = WS_WOUT + (size_t)DM * DM * 2;
constexpr size_t WS_WDN = WS_WUP + (size_t)NUP * DM * 2;
constexpr size_t WS_STAT1 = WS_WDN + (size_t)DM * DFF * 2;
constexpr size_t WS_STAT2 = WS_CTL + 512 * 1024;
constexpr size_t WS_H = 100 * MiB;
constexpr size_t WS_PART = WS_H + 208 * MiB;
static_assert((size_t)NMAIN * DM * 2 <= 208 * MiB && 208 * MiB + (size_t)11 * 256 * DM * 4 <= (size_t)NMAIN * DM * 4, "PART sits between the bf16 rows and the f32 meta rows of H");
constexpr size_t WS_HB = WS_H + (size_t)TP * DM * 4;
constexpr size_t WS_R = WS_HB + (size_t)TP * DM * 2;
constexpr size_t WS_UQKVO = WS_R;
constexpr size_t WS_UDQ = WS_UQKVO + (size_t)TP * 4096 * 2;
constexpr size_t WS_UDKV = WS_UDQ + (size_t)TP * 512 * 2;
constexpr size_t WS_GATES = WS_UDKV + (size_t)TP * 256 * 2;
constexpr size_t WS_MKV = WS_GATES + (size_t)TP * 16 * 4;
constexpr size_t WS_KR = WS_MKV + (size_t)TP * NKV * 2;
constexpr size_t WS_RSTD = WS_KR + (size_t)TP * 64 * 2;
constexpr size_t WS_END_A = WS_RSTD + (size_t)TP * 2 * 4;
constexpr size_t WS_ACT = WS_R;
constexpr size_t WS_END_B = WS_ACT + (size_t)TP * DFF * 2;
constexpr size_t WS_NEED = (WS_END_A > WS_END_B ? WS_END_A : WS_END_B);
static_assert(WS_STAT1 + (size_t)TP * 8 <= WS_H && WS_STAT2 + (size_t)TP * 8 <= WS_CTL + CTL_BYTES, "weights and row statistics fit below H");
constexpr size_t DO_HSUM = 0;
constexpr size_t DO_MQ = DO_HSUM + (size_t)TP * MLW * 4;
constexpr size_t DO_GP = 340 * MiB;
constexpr size_t DO_SIDE = 0;
constexpr size_t DO_GVM = 32 * MiB;
static_assert(DO_MQ + (size_t)TP * NQ * 2 <= DO_GP && DO_GP + (size_t)96 * 65 * 200 * 4 <= (size_t)NMAIN * DM * 4 && (size_t)192 * 6 * DFF * 4 <= DO_GVM && DO_GVM + (size_t)256 * NUP * 2 <= (size_t)NMAIN * DM * 4, "d_out scratch fits");
constexpr int CW_BAR = 4096;

constexpr int RING_BYTES = 131072;
constexpr int MISC_OFF = RING_BYTES;
constexpr int LDS_BYTES = 147456;
constexpr int GRID = 256;

__device__ __forceinline__ int pos_of_row(int row) { return row < NMAIN ? NMETA + (row & (LREAL - 1)) : ((row - NMAIN) & (NMETA - 1)); }
__device__ __forceinline__ unsigned pk2(float lo, float hi) { f32x2 v = {lo, hi}; return __builtin_bit_cast(unsigned, __builtin_convertvector(v, bf16x2v)); }
__device__ __forceinline__ float bf_lo(unsigned w) { return __uint_as_float(w << 16); }
__device__ __forceinline__ float bf_hi(unsigned w) { return __uint_as_float(w & 0xffff0000u); }
typedef _Float16 f16x2v __attribute__((ext_vector_type(2)));
__device__ __forceinline__ unsigned pk2h(float lo, float hi) { f32x2 v = {lo, hi}; return __builtin_bit_cast(unsigned, __builtin_convertvector(v, f16x2v)); }
__device__ __forceinline__ float hf_lo(unsigned w) { return (float)__builtin_bit_cast(f16x2v, w)[0]; }
__device__ __forceinline__ float hf_hi(unsigned w) { return (float)__builtin_bit_cast(f16x2v, w)[1]; }
__device__ __forceinline__ float wave_sum(float v) {
#pragma unroll
    for (int o = 1; o < 64; o <<= 1) v += __shfl_xor(v, o);
    return v;
}
__device__ __forceinline__ float wave_max(float v) {
#pragma unroll
    for (int o = 1; o < 64; o <<= 1) v = fmaxf(v, __shfl_xor(v, o));
    return v;
}
namespace pg8 {
#define PG8_LAS __attribute__((address_space(3)))
typedef unsigned short bf16_t;
typedef short bf16x8 __attribute__((ext_vector_type(8)));
typedef float f32x4 __attribute__((ext_vector_type(4)));
typedef unsigned u32x4 __attribute__((ext_vector_type(4)));
constexpr int BM = 256, BK = 64, HALF = 128, HTB = HALF * BK * 2  , STAGE_BYTES = 8 * HTB, NXCD = 8, WGM = 4;

__host__ __device__ __forceinline__ int lds_byte(int r, int c) { const int st = (r >> 4) * 2 + (c >> 5), rr = r & 15, cc = c & 31, ob = rr * 64 + cc * 2; return st * 1024 + (ob ^ (((ob >> 9) & 1) << 5)); }
__host__ __device__ __forceinline__ void stage_rc(int b, int& R, int& C) { const int st = b / 1024, sb = b % 1024, swz = sb ^ (((sb >> 9) & 1) << 5); R = (st >> 1) * 16 + swz / 64; C = (st & 1) * 32 + (swz % 64) / 2; }
__host__ __device__ __forceinline__ int perm32(int rho) { const int n = rho >> 4, i = rho & 15; return 8 * (i >> 2) + 4 * n + (i & 3); }

struct Unit { int pm, pn, kk; };
struct Gemm { const bf16_t* A; const bf16_t* Bt; int M, N, K, ld; };

struct PanelOrder {
    int nM, nN, nwg, G, c, nMain, pm0, pmx;
    __device__ void init(int nMain_, int pm0_, int extra, int pmx_, int N, int G_, int c_) { nMain = nMain_; pm0 = pm0_; pmx = pmx_; nM = nMain_ + extra; nN = N / BM; nwg = nM * nN; G = G_; c = c_; }
    __device__ bool next(int i, Unit& u) const {
        const long L = (long)i * G + c; if (L >= nwg) return false;
        int wgid = (int)L; { const int q = nwg / NXCD, r = nwg % NXCD, xcd = wgid % NXCD, off = wgid / NXCD; wgid = (xcd < r ? xcd * (q + 1) : r * (q + 1) + (xcd - r) * q) + off; }
        const int nig = WGM * nN, gid = wgid / nig, fm = gid * WGM, gsz = (nM - fm) < WGM ? (nM - fm) : WGM;
        const int pl = fm + ((wgid % nig) % gsz); u.pm = pl < nMain ? pm0 + pl : pmx; u.pn = (wgid % nig) / gsz; u.kk = 0; return true;
    }
    __device__ __forceinline__ void a_ready(const Unit&) const {}
    __device__ __forceinline__ void done(const Unit&) const {}
};

struct SplitOrder {
    int pm, nN, nwg, G, c;
    __device__ void init(int pm_, int N, int nsplit, int G_, int c_) { pm = pm_; nN = N / BM; nwg = nN * nsplit; G = G_; c = c_; }
    __device__ bool next(int i, Unit& u) const { const int L = i * G + c; if (L >= nwg) return false; u.pm = pm; u.pn = L % nN; u.kk = L / nN; return true; }
    __device__ __forceinline__ void a_ready(const Unit&) const {}
    __device__ __forceinline__ void done(const Unit&) const {}
};

__device__ __forceinline__ u32x4 pack8(const f32x4 v0, const f32x4 v1) { u32x4 w; w.x = pk2(v0[0], v0[1]); w.y = pk2(v0[2], v0[3]); w.z = pk2(v1[0], v1[1]); w.w = pk2(v1[2], v1[3]); return w; }

struct EpiBf16G {
    static constexpr bool PERM = true, AFTER_DRAIN = false, PERMA = false;
    bf16_t* O; int ldc; const float* rs; int pm_sub, pm_sp, pm_sp_out;
    __device__ __forceinline__ void operator()(const f32x4 (&acc)[2][2][4][2], const Unit& u, int wr, int wc, int fr, int fq) const {
        const int opm = (u.pm == pm_sp) ? pm_sp_out : u.pm - pm_sub;
        const int rin = u.pm * BM + wr * 64 + fr, rout = opm * BM + wr * 64 + fr, col0 = u.pn * BM + wc * 32 + 8 * fq;
#pragma unroll
        for (int ai = 0; ai < 2; ++ai)
#pragma unroll
            for (int m = 0; m < 4; ++m) { const float sc = rs ? rs[(size_t)(rin + ai * HALF + m * 16) * 2] : 1.f;
                bf16_t* rowp = O + (size_t)(rout + ai * HALF + m * 16) * ldc + col0;
#pragma unroll
                for (int bj = 0; bj < 2; ++bj) *(u32x4*)(rowp + bj * HALF) = pack8(acc[ai][bj][m][0] * sc, acc[ai][bj][m][1] * sc); }
    }
};
struct EpiWin {
    static constexpr bool PERM = true, AFTER_DRAIN = false, PERMA = false;
    bf16_t *UQKVO, *UDQ, *UDKV, *KR; float* GATES; const float *COS, *SIN;
    __device__ __forceinline__ void operator()(const f32x4 (&acc)[2][2][4][2], const Unit& u, int wr, int wc, int fr, int fq) const {
        const int row0 = u.pm * BM + wr * 64 + fr;
        if (u.pn < 19) {
            bf16_t* base; int ldc, colt;
            if (u.pn < 16) { base = UQKVO; ldc = 4096; colt = u.pn * BM; } else if (u.pn < 18) { base = UDQ; ldc = 512; colt = (u.pn - 16) * BM; } else { base = UDKV; ldc = 256; colt = 0; }
            const int col0 = colt + wc * 32 + 8 * fq;
#pragma unroll
            for (int ai = 0; ai < 2; ++ai)
#pragma unroll
                for (int m = 0; m < 4; ++m) { bf16_t* rowp = base + (size_t)(row0 + ai * HALF + m * 16) * ldc + col0;
#pragma unroll
                    for (int bj = 0; bj < 2; ++bj) *(u32x4*)(rowp + bj * HALF) = pack8(acc[ai][bj][m][0], acc[ai][bj][m][1]); }
        } else {
            if (wc < 2) { const int g = 4 * wc + fq;
#pragma unroll
                for (int ai = 0; ai < 2; ++ai)
#pragma unroll
                    for (int m = 0; m < 4; ++m) { const int row = row0 + ai * HALF + m * 16, pos = pos_of_row(row);
                        const f32x4 cs = *(const f32x4*)(COS + pos * 32 + 4 * g), sn = *(const f32x4*)(SIN + pos * 32 + 4 * g);
                        const f32x4 x1 = acc[ai][0][m][0], x2 = acc[ai][0][m][1];
                        *(u32x4*)(KR + (size_t)row * 64 + 8 * g) = pack8(x1 * cs - x2 * sn, x1 * sn + x2 * cs); }
            } else if (wc == 2 && fq < 2) {
#pragma unroll
                for (int ai = 0; ai < 2; ++ai)
#pragma unroll
                    for (int m = 0; m < 4; ++m) { float* gp = GATES + (size_t)(row0 + ai * HALF + m * 16) * 16 + 8 * fq;
                        *(f32x4*)gp = acc[ai][0][m][0]; *(f32x4*)(gp + 4) = acc[ai][0][m][1]; }
            }
        }
    }
};
struct EpiQ {
    static constexpr bool PERM = true, AFTER_DRAIN = false, PERMA = false;
    bf16_t* MQ; const float *RSTD, *COS, *SIN;
    __device__ __forceinline__ void operator()(const f32x4 (&acc)[2][2][4][2], const Unit& u, int wr, int wc, int fr, int fq) const {
        const int row0 = u.pm * BM + wr * 64 + fr, colb = u.pn * BM + wc * 32 + 8 * fq;
#pragma unroll
        for (int ai = 0; ai < 2; ++ai)
#pragma unroll
            for (int m = 0; m < 4; ++m) { const int row = row0 + ai * HALF + m * 16, pos = pos_of_row(row); const float sc = RSTD[(size_t)row * 2];
#pragma unroll
                for (int bj = 0; bj < 2; ++bj) { const int col0 = colb + bj * HALF, o = col0 % 192;
                    f32x4 v0 = acc[ai][bj][m][0] * sc, v1 = acc[ai][bj][m][1] * sc;
                    if (o >= 128) { const int g = (o - 128) >> 3; const f32x4 cs = *(const f32x4*)(COS + pos * 32 + 4 * g), sn = *(const f32x4*)(SIN + pos * 32 + 4 * g);
                        const f32x4 x1 = v0, x2 = v1; v0 = x1 * cs - x2 * sn; v1 = x1 * sn + x2 * cs; }
                    *(u32x4*)(MQ + (size_t)row * NQ + col0) = pack8(v0, v1); } }
    }
};
__device__ __forceinline__ void resid_ln_tile(float* __restrict__ Cw, const float* __restrict__ Cr, const float* __restrict__ st, const float* __restrict__ g, const float* __restrict__ b,
                                              int ldc, float alpha, const f32x4 (&acc)[2][2][4][2], int row0, int col0) {
    asm volatile("" ::: "memory");
#pragma unroll
    for (int ai = 0; ai < 2; ++ai)
#pragma unroll
        for (int bj = 0; bj < 2; ++bj) {
            f32x4 gv[2], bv[2], hv[4][2]; f32x2 ms[4];
#pragma unroll
            for (int n = 0; n < 2; ++n) { gv[n] = *(const f32x4*)(g + col0 + bj * HALF + n * 16) * alpha; bv[n] = *(const f32x4*)(b + col0 + bj * HALF + n * 16) * alpha; }
#pragma unroll
            for (int m = 0; m < 4; ++m) { const int row = row0 + ai * HALF + m * 16; ms[m] = *(const f32x2*)(st + (size_t)row * 2);
#pragma unroll
                for (int n = 0; n < 2; ++n) hv[m][n] = *(const f32x4*)(Cr + (size_t)row * ldc + col0 + bj * HALF + n * 16); }
#pragma unroll
            for (int m = 0; m < 4; ++m) { const int row = row0 + ai * HALF + m * 16;
#pragma unroll
                for (int n = 0; n < 2; ++n) *(f32x4*)(Cw + (size_t)row * ldc + col0 + bj * HALF + n * 16) = (hv[m][n] - ms[m][0]) * ms[m][1] * gv[n] + bv[n] + acc[ai][bj][m][n]; }
        }
}
__device__ __forceinline__ void resid_ln_tile_bf(bf16_t* __restrict__ Cw, const bf16_t* __restrict__ Cr, const float* __restrict__ st, const float* __restrict__ g, const float* __restrict__ b,
                                                 int ldc, float alpha, const f32x4 (&acc)[2][2][4][2], int row0, int col0) {
    asm volatile("" ::: "memory");
#pragma unroll
    for (int ai = 0; ai < 2; ++ai)
#pragma unroll
        for (int bj = 0; bj < 2; ++bj) {
            f32x4 gv[2], bv[2]; u32x4 hv[4]; f32x2 ms[4];
#pragma unroll
            for (int n = 0; n < 2; ++n) { gv[n] = *(const f32x4*)(g + col0 + bj * HALF + n * 4) * alpha; bv[n] = *(const f32x4*)(b + col0 + bj * HALF + n * 4) * alpha; }
#pragma unroll
            for (int m = 0; m < 4; ++m) { const int row = row0 + ai * HALF + m * 16; ms[m] = *(const f32x2*)(st + (size_t)row * 2);
                hv[m] = *(const u32x4*)(Cr + (size_t)row * ldc + col0 + bj * HALF); }
#pragma unroll
            for (int m = 0; m < 4; ++m) { const int row = row0 + ai * HALF + m * 16;
                const f32x4 h0 = {hf_lo(hv[m].x), hf_hi(hv[m].x), hf_lo(hv[m].y), hf_hi(hv[m].y)}, h1 = {hf_lo(hv[m].z), hf_hi(hv[m].z), hf_lo(hv[m].w), hf_hi(hv[m].w)};
                const f32x4 o0 = (h0 - ms[m][0]) * ms[m][1] * gv[0] + bv[0] + acc[ai][bj][m][0], o1 = (h1 - ms[m][0]) * ms[m][1] * gv[1] + bv[1] + acc[ai][bj][m][1];
                u32x4 w; w.x = pk2h(o0[0], o0[1]); w.y = pk2h(o0[2], o0[3]); w.z = pk2h(o1[0], o1[1]); w.w = pk2h(o1[2], o1[3]);
                *(u32x4*)(Cw + (size_t)row * ldc + col0 + bj * HALF) = w; }
        }
}
struct EpiResidLn {
    static constexpr bool PERM = true, AFTER_DRAIN = false, PERMA = false;
    bf16_t* C; int ldc; float alpha; const float* st; const float* g; const float* b;
    __device__ __forceinline__ void operator()(const f32x4 (&acc)[2][2][4][2], const Unit& u, int wr, int wc, int fr, int fq) const {
        resid_ln_tile_bf(this->C, this->C, this->st, this->g, this->b, this->ldc, this->alpha, acc, u.pm * BM + wr * 64 + fr, u.pn * BM + wc * 32 + 8 * fq);
    }
};
struct EpiPart {
    static constexpr bool PERM = false, AFTER_DRAIN = false, PERMA = false;
    float* P; int ldc;
    __device__ __forceinline__ void operator()(const f32x4 (&acc)[2][2][4][2], const Unit& u, int wr, int wc, int fr, int fq) const {
        const int row0 = u.kk * BM + wr * 64 + fr, col0 = u.pn * BM + wc * 32 + 4 * fq;
#pragma unroll
        for (int ai = 0; ai < 2; ++ai)
#pragma unroll
            for (int m = 0; m < 4; ++m) { float* rowp = P + (size_t)(row0 + ai * HALF + m * 16) * ldc + col0;
#pragma unroll
                for (int bj = 0; bj < 2; ++bj)
#pragma unroll
                    for (int n = 0; n < 2; ++n) *(f32x4*)(rowp + bj * HALF + n * 16) = acc[ai][bj][m][n]; }
    }
};

__device__ __forceinline__ float dpp_shr1_old(float old, float x) { return __int_as_float(__builtin_amdgcn_update_dpp(__float_as_int(old), __float_as_int(x), 0x111, 0xf, 0xf, false)); }
__device__ __forceinline__ float dpp_shl1_old(float old, float x) { return __int_as_float(__builtin_amdgcn_update_dpp(__float_as_int(old), __float_as_int(x), 0x101, 0xf, 0xf, false)); }
struct EpiFfn {
    static constexpr bool PERM = true, AFTER_DRAIN = false, PERMA = true;
    bf16_t* ACT; float* SIDE; bf16_t* GVM; const float *cw, *cb; PG8_LAS float* X;
    __device__ __forceinline__ void operator()(const f32x4 (&acc)[2][2][4][2], const Unit& u, int wr_in, int wc_in, int fr_in, int fq_in) const {
        int fr = fr_in, fq = fq_in, wr = wr_in, wc = wc_in; asm volatile("" : "+v"(fr), "+v"(fq), "+s"(wr), "+s"(wc));
        const int cj = wc * 32 + 8 * fq, c0 = u.pn * 128 + cj;
        if (u.pm == PMETA) {
#pragma unroll
            for (int ai = 0; ai < 2; ++ai)
#pragma unroll
                for (int m = 0; m < 4; ++m) { bf16_t* rowp = GVM + (size_t)(ai * HALF + wr * 64 + 4 * fr + m) * NUP + c0;
                    *(u32x4*)rowp = pack8(acc[ai][0][m][0], acc[ai][0][m][1]); *(u32x4*)(rowp + DFF) = pack8(acc[ai][1][m][0], acc[ai][1][m][1]); }
            return;
        }
        f32x4 w0[2], w1[2], w2[2], bb[2];
#pragma unroll
        for (int n = 0; n < 2; ++n) { w0[n] = *(const f32x4*)(cw + c0 + 4 * n); w1[n] = *(const f32x4*)(cw + DFF + c0 + 4 * n); w2[n] = *(const f32x4*)(cw + 2 * DFF + c0 + 4 * n); bb[n] = *(const f32x4*)(cb + c0 + 4 * n); }
#pragma unroll
        for (int ai = 0; ai < 2; ++ai) { const int b = 2 * ai + wr;
            if (fr == 0) { *(PG8_LAS f32x4*)(X + (b * 2 + 0) * 128 + cj) = acc[ai][0][0][0]; *(PG8_LAS f32x4*)(X + (b * 2 + 0) * 128 + cj + 4) = acc[ai][0][0][1]; }
            if (fr == 15) { *(PG8_LAS f32x4*)(X + (b * 2 + 1) * 128 + cj) = acc[ai][0][3][0]; *(PG8_LAS f32x4*)(X + (b * 2 + 1) * 128 + cj + 4) = acc[ai][0][3][1]; } }
        asm volatile("s_waitcnt lgkmcnt(0)" ::: "memory"); __builtin_amdgcn_s_barrier(); asm volatile("" ::: "memory");
        const unsigned rowb = (unsigned)(u.pm * BM + wr * 64 + 4 * fr) * DFF + c0;
#pragma unroll
        for (int ai = 0; ai < 2; ++ai) { const int b = 2 * ai + wr;
            f32x4 xp[2], xn[2];
#pragma unroll
            for (int n = 0; n < 2; ++n) { xp[n] = b > 0 ? *(const PG8_LAS f32x4*)(X + ((b - 1) * 2 + 1) * 128 + cj + 4 * n) : (f32x4){0.f, 0.f, 0.f, 0.f};
                                          xn[n] = b < 3 ? *(const PG8_LAS f32x4*)(X + ((b + 1) * 2 + 0) * 128 + cj + 4 * n) : (f32x4){0.f, 0.f, 0.f, 0.f}; }
            f32x4 up0[2], dn3[2];
#pragma unroll
            for (int n = 0; n < 2; ++n)
#pragma unroll
                for (int e = 0; e < 4; ++e) { up0[n][e] = dpp_shr1_old(xp[n][e], acc[ai][0][3][n][e]); dn3[n][e] = dpp_shl1_old(xn[n][e], acc[ai][0][0][n][e]); }
#pragma unroll
            for (int m = 0; m < 4; ++m) { u32x4 ow;
#pragma unroll
                for (int n = 0; n < 2; ++n) {
                    const f32x4 g = acc[ai][0][m][n], pv = m > 0 ? acc[ai][0][m > 0 ? m - 1 : 0][n] : up0[n], nx = m < 3 ? acc[ai][0][m < 3 ? m + 1 : 3][n] : dn3[n];
                    const f32x4 x = w0[n] * pv + w1[n] * g + w2[n] * nx + bb[n]; f32x4 t, o;
#pragma unroll
                    for (int e = 0; e < 4; ++e) t[e] = __expf(-x[e]);
                    t = t + 1.f;
#pragma unroll
                    for (int e = 0; e < 4; ++e) t[e] = __builtin_amdgcn_rcpf(t[e]);
                    o = x * t * acc[ai][1][m][n];
                    if (n == 0) { ow.x = pk2(o[0], o[1]); ow.y = pk2(o[2], o[3]); } else { ow.z = pk2(o[0], o[1]); ow.w = pk2(o[2], o[3]); } }
                bf16_t* dst = ACT + (rowb + (unsigned)(ai * HALF + m) * DFF);
                if (ai == 0 ? m < 2 : m >= 2) {
                    const int r = ai * HALF + wr * 64 + 4 * fr + m;
                    if (r != 0 && r != 255) *(u32x4*)dst = ow;
                    const int slot = r == 0 ? 0 : r == 1 ? 1 : r == 254 ? 2 : r == 255 ? 3 : -1;
                    if (slot >= 0) { float* sp = SIDE + ((size_t)u.pm * 6 + slot) * DFF + c0; *(f32x4*)sp = acc[ai][0][m][0]; *(f32x4*)(sp + 4) = acc[ai][0][m][1];
                        if (slot == 0 || slot == 3) { float* vp = SIDE + ((size_t)u.pm * 6 + (slot == 0 ? 4 : 5)) * DFF + c0; *(f32x4*)vp = acc[ai][1][m][0]; *(f32x4*)(vp + 4) = acc[ai][1][m][1]; } }
                } else *(u32x4*)dst = ow;
            }
        }
    }
};
template <class Epi, class Sched, bool ALIGN_EPI = false, bool SP2 = false>
__device__ __forceinline__ void gemm_phase(PG8_LAS unsigned char* lds, const Gemm g, const Sched& S, const Epi& E) {
    int tid_ = threadIdx.x; asm volatile("" : "+v"(tid_));
    const int tid = tid_, wid = __builtin_amdgcn_readfirstlane(tid >> 6), lane = tid & 63, wr = wid >> 2, wc = wid & 3, fr = lane & 15, fq = lane >> 4;
    const int K = g.ld, nt = g.K / BK;
    unsigned voffA[2], voffB[2];
#pragma unroll
    for (int i = 0; i < 2; ++i) { int R, C; stage_rc(tid * 16 + i * 8192, R, C); const int Rb = Epi::PERM ? ((R & ~31) + perm32(R & 31)) : R;
        const int Ra = Epi::PERMA ? ((R & ~63) | ((R & 15) << 2) | ((R >> 4) & 3)) : R;
        voffA[i] = (unsigned)(Ra * K + C) * 2u; voffB[i] = (unsigned)(Rb * K + C) * 2u; }
    const size_t kstep = (size_t)(BK * 2);
    const size_t hstep = (size_t)HALF * K * 2;
    const size_t tstep = 2 * hstep;
    const unsigned ldsw = (unsigned)wid * 1024u;
    const int aoff = lds_byte(wr * 64 + fr, fq * 8), boff = lds_byte(wc * 32 + fr, fq * 8);
#define PG8_SA(b, h) (((b) * 2 + (h)) * HTB)
#define PG8_SB(b, h) ((4 + (b) * 2 + (h)) * HTB)
#define PG8_STAGE(bufoff, gbase, voff) do { _Pragma("unroll") for (int _i = 0; _i < 2; ++_i) \
        __builtin_amdgcn_global_load_lds((const unsigned*)((const char*)(gbase) + (voff)[_i]), (PG8_LAS unsigned*)(lds + (bufoff) + ldsw + _i * 8192), 16, 0, 0); } while (0)
#define PG8_LDA(dst, b, h) do { _Pragma("unroll") for (int m = 0; m < 4; ++m) _Pragma("unroll") for (int k = 0; k < 2; ++k) dst[m][k] = *(const PG8_LAS bf16x8*)(lds + PG8_SA(b, h) + aoff + m * 2048 + k * 1024); } while (0)
#define PG8_LDB(dst, b, h) do { _Pragma("unroll") for (int n = 0; n < 2; ++n) _Pragma("unroll") for (int k = 0; k < 2; ++k) dst[n][k] = *(const PG8_LAS bf16x8*)(lds + PG8_SB(b, h) + boff + n * 2048 + k * 1024); } while (0)
#define PG8_MMA(ai, bj, At, Bt) do { __builtin_amdgcn_s_setprio(1); _Pragma("unroll") for (int m = 0; m < 4; ++m) _Pragma("unroll") for (int n = 0; n < 2; ++n) _Pragma("unroll") for (int k = 0; k < 2; ++k) \
        acc[ai][bj][m][n] = __builtin_amdgcn_mfma_f32_16x16x32_bf16(Bt[n][k], At[m][k], acc[ai][bj][m][n], 0, 0, 0); __builtin_amdgcn_s_setprio(0); } while (0)
#define PG8_WAIT_V(n) asm volatile("s_waitcnt vmcnt(" #n ")" ::: "memory")
#define PG8_WAIT_L(n) asm volatile("s_waitcnt lgkmcnt(" #n ")" ::: "memory")
#define PG8_BAR __builtin_amdgcn_s_barrier()
#define PG8_SCHED __builtin_amdgcn_sched_barrier(0)
    Unit cur, nxt; int ui = 0;
    if (!S.next(0, cur)) return;
    f32x4 acc[2][2][4][2];
#pragma unroll
    for (int a = 0; a < 2; ++a)
#pragma unroll
        for (int b = 0; b < 2; ++b)
#pragma unroll
            for (int m = 0; m < 4; ++m)
#pragma unroll
                for (int n = 0; n < 2; ++n) acc[a][b][m][n] = (f32x4){0.f, 0.f, 0.f, 0.f};
    bf16x8 At[4][2], B0[2][2], B1[2][2];
    const size_t sstep = (size_t)g.K * 2;
    const char* cA = (const char*)g.A + (size_t)cur.pm * tstep + (size_t)cur.kk * sstep; const char* cB = (const char*)g.Bt + (size_t)cur.pn * tstep + (size_t)cur.kk * sstep;
    S.a_ready(cur);
    if constexpr (SP2) {
        PG8_STAGE(PG8_SB(0, 0), cB, voffB); PG8_STAGE(PG8_SB(0, 1), cB + hstep, voffB); PG8_STAGE(PG8_SA(0, 0), cA, voffA); PG8_STAGE(PG8_SA(0, 1), cA + hstep, voffA);
        if (wr == 1) PG8_BAR;
        PG8_WAIT_V(2); PG8_BAR;
        PG8_STAGE(PG8_SB(1, 0), cB + kstep, voffB); PG8_STAGE(PG8_SA(1, 0), cA + kstep, voffA); PG8_STAGE(PG8_SB(1, 1), cB + hstep + kstep, voffB);
        PG8_WAIT_V(6); PG8_BAR;
    } else {
        PG8_STAGE(PG8_SB(0, 0), cB, voffB); PG8_STAGE(PG8_SA(0, 0), cA, voffA); PG8_STAGE(PG8_SB(0, 1), cB + hstep, voffB); PG8_STAGE(PG8_SA(0, 1), cA + hstep, voffA);
        if (wr == 1) PG8_BAR;
        PG8_WAIT_V(4); PG8_BAR;
        PG8_STAGE(PG8_SB(1, 0), cB + kstep, voffB); PG8_STAGE(PG8_SA(1, 0), cA + kstep, voffA); PG8_STAGE(PG8_SB(1, 1), cB + hstep + kstep, voffB);
        PG8_WAIT_V(6); PG8_BAR;
    }
    for (;;) {
        const bool has_next = S.next(ui + 1, nxt);
        const char* nA = has_next ? (const char*)g.A + (size_t)nxt.pm * tstep + (size_t)nxt.kk * sstep : cA; const char* nB = has_next ? (const char*)g.Bt + (size_t)nxt.pn * tstep + (size_t)nxt.kk * sstep : cB;
        for (int t = 0; t < nt; t += 2) {
            const bool last = (t == nt - 2);
            const char* a1 = cA + (size_t)(t + 1) * kstep;
            const char* a2 = last ? nA : cA + (size_t)(t + 2) * kstep; const char* b2 = last ? nB : cB + (size_t)(t + 2) * kstep;
            const char* a3 = a2 + kstep; const char* b3 = b2 + kstep;
            if (last && has_next) S.a_ready(nxt);
            if constexpr (SP2) {
            PG8_LDB(B0, 0, 0); PG8_LDB(B1, 0, 1); PG8_SCHED; PG8_LDA(At, 0, 0); PG8_STAGE(PG8_SA(1, 1), a1 + hstep, voffA);
            PG8_WAIT_V(8); PG8_WAIT_L(0); PG8_BAR; PG8_MMA(0, 0, At, B0); PG8_MMA(0, 1, At, B1); PG8_BAR; PG8_SCHED;
            PG8_LDA(At, 0, 1); PG8_STAGE(PG8_SB(0, 0), b2, voffB); PG8_STAGE(PG8_SB(0, 1), b2 + hstep, voffB); PG8_STAGE(PG8_SA(0, 0), a2, voffA);
            PG8_WAIT_V(8); PG8_WAIT_L(0); PG8_BAR; PG8_MMA(1, 0, At, B0); PG8_MMA(1, 1, At, B1); PG8_BAR; PG8_SCHED;
            PG8_LDB(B0, 1, 0); PG8_LDB(B1, 1, 1); PG8_SCHED; PG8_LDA(At, 1, 0); PG8_STAGE(PG8_SA(0, 1), a2 + hstep, voffA);
            PG8_WAIT_V(8); PG8_WAIT_L(0); PG8_BAR; PG8_MMA(0, 0, At, B0); PG8_MMA(0, 1, At, B1); PG8_BAR; PG8_SCHED;
            PG8_LDA(At, 1, 1); PG8_STAGE(PG8_SB(1, 0), b3, voffB); PG8_STAGE(PG8_SB(1, 1), b3 + hstep, voffB); PG8_STAGE(PG8_SA(1, 0), a3, voffA);
            PG8_WAIT_V(8); PG8_WAIT_L(0); PG8_BAR; PG8_MMA(1, 0, At, B0); PG8_MMA(1, 1, At, B1); PG8_BAR; PG8_SCHED;
            } else {
            PG8_LDB(B0, 0, 0); PG8_SCHED; PG8_LDA(At, 0, 0); PG8_STAGE(PG8_SA(1, 1), a1 + hstep, voffA);
            PG8_WAIT_L(8); PG8_BAR; PG8_WAIT_L(0); PG8_MMA(0, 0, At, B0); PG8_BAR; PG8_SCHED;
            PG8_LDB(B1, 0, 1); PG8_STAGE(PG8_SB(0, 0), b2, voffB);
            PG8_BAR; PG8_WAIT_L(0); PG8_MMA(0, 1, At, B1); PG8_BAR;
            PG8_LDA(At, 0, 1); PG8_STAGE(PG8_SA(0, 0), a2, voffA);
            PG8_BAR; PG8_WAIT_L(0); PG8_MMA(1, 0, At, B0); PG8_BAR; PG8_SCHED;
            PG8_STAGE(PG8_SB(0, 1), b2 + hstep, voffB);
            PG8_WAIT_V(6); PG8_BAR; PG8_MMA(1, 1, At, B1); PG8_BAR;
            PG8_LDB(B0, 1, 0); PG8_SCHED; PG8_LDA(At, 1, 0); PG8_STAGE(PG8_SA(0, 1), a2 + hstep, voffA);
            PG8_WAIT_L(8); PG8_BAR; PG8_WAIT_L(0); PG8_MMA(0, 0, At, B0); PG8_BAR; PG8_SCHED;
            PG8_LDB(B1, 1, 1); PG8_STAGE(PG8_SB(1, 0), b3, voffB);
            PG8_BAR; PG8_WAIT_L(0); PG8_MMA(0, 1, At, B1); PG8_BAR;
            PG8_LDA(At, 1, 1); PG8_STAGE(PG8_SA(1, 0), a3, voffA);
            PG8_BAR; PG8_WAIT_L(0); PG8_MMA(1, 0, At, B0); PG8_BAR; PG8_SCHED;
            PG8_STAGE(PG8_SB(1, 1), b3 + hstep, voffB);
            PG8_WAIT_V(6); PG8_BAR; PG8_MMA(1, 1, At, B1); PG8_BAR;
            }
        }
        if constexpr (ALIGN_EPI) { if (wr == 0) PG8_BAR; }
        if constexpr (!Epi::AFTER_DRAIN) { E(acc, cur, wr, wc, fr, fq); S.done(cur); }
        if (!has_next) break;
#pragma unroll
        for (int a = 0; a < 2; ++a)
#pragma unroll
            for (int b = 0; b < 2; ++b)
#pragma unroll
                for (int m = 0; m < 4; ++m)
#pragma unroll
                    for (int n = 0; n < 2; ++n) acc[a][b][m][n] = (f32x4){0.f, 0.f, 0.f, 0.f};
        cur = nxt; cA = nA; cB = nB; ++ui;
        if constexpr (ALIGN_EPI) { if (wr == 1) PG8_BAR; }
    }
    PG8_WAIT_V(0);
    if constexpr (!ALIGN_EPI) { if (wr == 0) PG8_BAR; }
    PG8_BAR;
    if constexpr (Epi::AFTER_DRAIN) { E.fused(acc, cur, wr, wc, fr, fq, lds, wid, lane); S.done(cur); }
#undef PG8_SA
#undef PG8_SB
#undef PG8_STAGE
#undef PG8_LDA
#undef PG8_LDB
#undef PG8_MMA
#undef PG8_WAIT_V
#undef PG8_WAIT_L
#undef PG8_BAR
#undef PG8_SCHED
}
}
#define XB_TMO      128
#define XB_XCNT(j)  (256  + 64 * (j))
#define XB_XSUB(j)  (1280 + 64 * (j))
#define XB_XGEN(j)  (2304 + 64 * (j))
#define XB_TOP      3328
#define XB_TOPGEN   3392
#define XCD_BAR_WORDS 3456
#define XB_SPIN_CAP (1u << 21)

__device__ __forceinline__ unsigned xb_ld(unsigned* p)              { return __hip_atomic_load(p, __ATOMIC_RELAXED, __HIP_MEMORY_SCOPE_AGENT); }
__device__ __forceinline__ unsigned xb_add(unsigned* p, unsigned v) { return __hip_atomic_fetch_add(p, v, __ATOMIC_RELAXED, __HIP_MEMORY_SCOPE_AGENT); }
__device__ __forceinline__ unsigned xb_xcc_id() { return (unsigned)__builtin_amdgcn_s_getreg((3 << 11) | 20) & 0xFu; }
#define XB_SPIN(cond, bar) do { unsigned _sp = 0; while (cond) { __builtin_amdgcn_s_sleep(1); \
    if ((++_sp & 255u) == 0u) { if (xb_ld(&(bar)[XB_TMO])) break; if (_sp > XB_SPIN_CAP) { atomicAdd(&(bar)[XB_TMO], 1u); break; } } } } while (0)

struct XcdBarrier {
    unsigned* bar; unsigned x;
    volatile LAS unsigned* st;
};

__device__ __forceinline__ XcdBarrier xcd_barrier_post(unsigned* bar, volatile LAS unsigned* st) {
    XcdBarrier b; b.bar = bar; b.x = (unsigned)__builtin_amdgcn_readfirstlane((int)xb_xcc_id()); b.st = st;
    if (threadIdx.x == 0) (void)xb_add(&bar[XB_XCNT(b.x)], 1u);
    return b;
}
__device__ __forceinline__ void xcd_barrier_complete(unsigned* bar, unsigned x, unsigned& nloc, unsigned& nx) {
    const unsigned G = gridDim.x * gridDim.y * gridDim.z;
    unsigned sum, cnt, mine, sp = 0u;
    for (;;) {
        sum = 0u; cnt = 0u; mine = 0u;
#pragma unroll
        for (unsigned j = 0; j < 16; ++j) { const unsigned c = xb_ld(&bar[XB_XCNT(j)]); sum += c; cnt += (c > 0u) ? 1u : 0u; }
        mine = xb_ld(&bar[XB_XCNT(x)]);
        if (sum == G) { mine = xb_ld(&bar[XB_XCNT(x)]); break; }
        __builtin_amdgcn_s_sleep(1);
        if ((++sp & 255u) == 0u) { if (xb_ld(&bar[XB_TMO])) break; if (sp > XB_SPIN_CAP) { atomicAdd(&bar[XB_TMO], 1u); break; } }
    }
    nloc = mine > 0u ? mine : 1u; nx = cnt > 0u ? cnt : 1u;
}

__device__ __forceinline__ void xcd_barrier(const XcdBarrier& b) {
    asm volatile("s_waitcnt vmcnt(0)" ::: "memory");
    __syncthreads();
    if (threadIdx.x == 0) {
        unsigned* bar = b.bar; unsigned bx_ = b.x;
        asm volatile("" : "+s"(bx_));
        __builtin_amdgcn_s_waitcnt(0);
        unsigned nloc = b.st[0], nx = b.st[1];
        if (nloc == 0u) { xcd_barrier_complete(bar, bx_, nloc, nx); b.st[0] = nloc; b.st[1] = nx; }
        const unsigned old = xb_add(&bar[XB_XSUB(bx_)], 1u);
        const unsigned gen = old / nloc;
        if (old + 1u == (gen + 1u) * nloc) {
            __builtin_amdgcn_fence(__ATOMIC_RELEASE, "agent");
            asm volatile("s_waitcnt vmcnt(0)" ::: "memory");
            const unsigned og = xb_add(&bar[XB_TOP], 1u);
            const unsigned tg = og / nx;
            if (og + 1u == (tg + 1u) * nx) xb_add(&bar[XB_TOPGEN], 1u);
            else XB_SPIN(xb_ld(&bar[XB_TOPGEN]) == tg, bar);
            __builtin_amdgcn_fence(__ATOMIC_ACQUIRE, "agent");
            xb_add(&bar[XB_XGEN(bx_)], 1u);
            asm volatile("s_waitcnt vmcnt(0)" ::: "memory");
        } else {
            XB_SPIN(xb_ld(&bar[XB_XGEN(bx_)]) == gen, bar);
            __builtin_amdgcn_fence(__ATOMIC_ACQUIRE, "agent");
            asm volatile("s_waitcnt vmcnt(0)" ::: "memory");
        }
    }
    __syncthreads();
}

typedef unsigned short bf16_t;
typedef short bf16x8 __attribute__((ext_vector_type(8)));
typedef float f32x4 __attribute__((ext_vector_type(4)));
typedef unsigned u32x4 __attribute__((ext_vector_type(4)));
#define LDS_WAIT() asm volatile("s_waitcnt lgkmcnt(0)" ::: "memory")

struct Params {
    const float* in[19];
};
struct Frame {
    LAS unsigned char* lds;
    int tid, lane, wave, G, bx, vcu, gw, ngw;
};
__device__ __forceinline__ const float* uptr(const LAS unsigned long long* t, int k) {
    const unsigned long long v = t[k]; const unsigned lo = __builtin_amdgcn_readfirstlane((unsigned)v), hi = __builtin_amdgcn_readfirstlane((unsigned)(v >> 32));
    return (const float*)(const GAS float*)(((unsigned long long)hi << 32) | lo); }

template <class CMap>
__device__ __forceinline__ void transpose_load(float (&v)[32], const float* W, int Nsrc, const float* ks, int kb, int nb, int lane, CMap cmap) {
    const int k0 = 64 * kb, n0 = 32 * nb; const int sc = cmap(n0 + (lane & 31));
#pragma unroll
    for (int i = 0; i < 32; ++i) { const int kk = 2 * i + (lane >> 5); float x = 0.f; if (sc >= 0) x = W[(size_t)(k0 + kk) * Nsrc + sc]; if (ks) x *= ks[k0 + kk]; v[i] = x; }
}
__device__ __forceinline__ void transpose_store(const float (&v)[32], int K, bf16_t* WT, LAS float* scr, int kb, int nb, int lane) {
    const int k0 = 64 * kb, n0 = 32 * nb;
#pragma unroll
    for (int i = 0; i < 32; ++i) scr[(2 * i + (lane >> 5)) * 33 + (lane & 31)] = v[i];
    LDS_WAIT(); asm volatile("" ::: "memory");
    const int c = lane & 7;
#pragma unroll
    for (int j = 0; j < 4; ++j) { const int n = (lane >> 3) + 8 * j; const LAS float* s = scr + (8 * c) * 33 + n;
        u32x4 o; o.x = pk2(s[0 * 33], s[1 * 33]); o.y = pk2(s[2 * 33], s[3 * 33]); o.z = pk2(s[4 * 33], s[5 * 33]); o.w = pk2(s[6 * 33], s[7 * 33]);
        *(u32x4*)(WT + (size_t)(n0 + n) * K + k0 + 8 * c) = o; }
    LDS_WAIT(); asm volatile("" ::: "memory");
}
template <class CMap>
__device__ __forceinline__ void transpose_matrix(const Frame& F, const float* W, int K, int Nsrc, int Ndst, bf16_t* WT, const float* ks, LAS float* scr, CMap cmap) {
    const int nnb = Ndst / 32, items = (K / 64) * nnb;
    for (int it = F.gw; it < items; it += 2 * F.ngw) { const int it2 = it + F.ngw; float va[32], vb[32];
        transpose_load(va, W, Nsrc, ks, it / nnb, it % nnb, F.lane, cmap);
        if (it2 < items) transpose_load(vb, W, Nsrc, ks, it2 / nnb, it2 % nnb, F.lane, cmap);
        transpose_store(va, K, WT, scr, it / nnb, it % nnb, F.lane);
        if (it2 < items) transpose_store(vb, K, WT, scr, it2 / nnb, it2 % nnb, F.lane); }
}
__device__ __forceinline__ int rope_perm(int m) { const int g = m >> 3, j = m & 7; return j < 4 ? 4 * g + j : 32 + 4 * g + (j - 4); }
struct CMapIn { __device__ int operator()(int n) const {
    if (n < 4096) return n; if (n < 4608) return 4112 + (n - 4096); if (n < 4864) return 4624 + (n - 4608);
    if (n < 4928) return 4880 + rope_perm(n - 4864); if (n < 4944) return 4096 + (n - 4928); return -1; } };
struct CMapQ { __device__ int operator()(int n) const { const int h = n / 192, o = n % 192; return o < 128 ? n : h * 192 + 128 + rope_perm(o - 128); } };
struct CMapUp { __device__ int operator()(int n) const { const int pn = n >> 8, j = n & 255; return j < 128 ? 128 * pn + j : DFF + 128 * pn + (j - 128); } };
struct CMapId { __device__ int operator()(int n) const { return n; } };

__device__ __forceinline__ void convert_weights(const Frame& F, unsigned char* ws, const LAS unsigned long long* pt, int l) {
    LAS float* scr = (LAS float*)(F.lds + F.wave * 8448);
    const float* w_in = uptr(pt, 3) + (size_t)l * DM * INC; const float* w_uq = uptr(pt, 8) + (size_t)l * 512 * NQ; const float* w_ukv = uptr(pt, 9) + (size_t)l * 256 * NKV;
    const float* w_out = uptr(pt, 10) + (size_t)l * DM * DM; const float* w_up = uptr(pt, 13) + (size_t)l * DM * NUP; const float* w_dn = uptr(pt, 16) + (size_t)l * DFF * DM;
    const float* qg = uptr(pt, 6) + (size_t)l * 512; const float* kvg = uptr(pt, 7) + (size_t)l * 256;
    transpose_matrix(F, w_in, DM, INC, NIN, (bf16_t*)(ws + WS_WIN), nullptr, scr, CMapIn());
    transpose_matrix(F, w_uq, 512, NQ, NQ, (bf16_t*)(ws + WS_WUQ), qg, scr, CMapQ());
    transpose_matrix(F, w_ukv, 256, NKV, NKV, (bf16_t*)(ws + WS_WUKV), kvg, scr, CMapId());
    transpose_matrix(F, w_out, DM, DM, DM, (bf16_t*)(ws + WS_WOUT), nullptr, scr, CMapId());
    transpose_matrix(F, w_up, DM, NUP, NUP, (bf16_t*)(ws + WS_WUP), nullptr, scr, CMapUp());
    transpose_matrix(F, w_dn, DFF, DM, DM, (bf16_t*)(ws + WS_WDN), nullptr, scr, CMapId());
}

__device__ __forceinline__ void prologue(const Frame& F, unsigned char* ws, const LAS unsigned long long* pt) {
    float* COS = (float*)(ws + WS_COS); float* SIN = (float*)(ws + WS_SIN);
    for (int i = F.bx * 512 + F.tid; i < 4112 * 32; i += F.G * 512) { const int pos = i >> 5, f = i & 31;
        const float inv = powf(10000.0f, -(float)(2 * f) / 64.0f); const float ang = (float)pos * inv; float s, c; sincosf(ang, &s, &c); COS[i] = c; SIN[i] = s; }
    { float* PAR = (float*)(ws + WS_PAR); const int gt = F.bx * 512 + F.tid, nt = F.G * 512;
      for (int i = gt; i < DEPTH * 16; i += nt) PAR[PO_BG + i] = uptr(pt, 4)[i];
      for (int i = gt; i < DEPTH * 1024; i += nt) PAR[PO_MLG + i] = uptr(pt, 5)[i];
      for (int i = gt; i < DEPTH * 512; i += nt) PAR[PO_QG + i] = uptr(pt, 6)[i];
      for (int i = gt; i < DEPTH * 256; i += nt) PAR[PO_KVG + i] = uptr(pt, 7)[i];
      for (int i = gt; i < 2048; i += nt) { PAR[PO_ONE + i] = 1.f; PAR[PO_ZERO + i] = 0.f; }
      { float* ST2 = (float*)(ws + WS_STAT2); for (int i = gt; i < TP; i += nt) { ST2[2 * i] = 0.f; ST2[2 * i + 1] = 1.f; } }
      for (int i = gt; i < DEPTH * 2048; i += nt) { PAR[PO_L1G + i] = uptr(pt, 11)[i]; PAR[PO_L1B + i] = uptr(pt, 12)[i]; PAR[PO_L2G + i] = uptr(pt, 17)[i]; PAR[PO_L2B + i] = uptr(pt, 18)[i]; }
      for (int i = gt; i < DEPTH * 3 * 5632; i += nt) PAR[PO_CW + i] = uptr(pt, 14)[i];
      for (int i = gt; i < DEPTH * 5632; i += nt) PAR[PO_CB + i] = uptr(pt, 15)[i]; }
    float* H = (float*)(ws + WS_H); bf16_t* HB = (bf16_t*)(ws + WS_HB);
    const float* xp = uptr(pt, 0); const float* xs = uptr(pt, 1); const float* mt = uptr(pt, 2);
    for (int row0 = F.gw; row0 < TP; row0 += 2 * F.ngw) {
        f32x4 v[2][8];
#pragma unroll
        for (int r = 0; r < 2; ++r) { const int row = row0 + r * F.ngw; const float* src = nullptr;
            if (row < 4 * LREAL) src = xp + (size_t)row * DM; else if (row < NMAIN) src = xs + (size_t)(row - 4 * LREAL) * DM; else if (row < NTOK) src = mt + (size_t)((row - NMAIN) & 15) * DM;
#pragma unroll
            for (int j = 0; j < 8; ++j) { v[r][j] = (f32x4){0.f, 0.f, 0.f, 0.f}; if (src) v[r][j] = ((const f32x4*)src)[F.lane + 64 * j]; } }
#pragma unroll
        for (int r = 0; r < 2; ++r) { const int row = row0 + r * F.ngw; if (row < TP) {
            f32x4* hd = (f32x4*)(H + (size_t)row * DM) + F.lane; u32x2* bd = (u32x2*)(HB + (size_t)row * DM) + F.lane; u32x2* hb = (u32x2*)((bf16_t*)H + (size_t)row * DM) + F.lane;
#pragma unroll
            for (int j = 0; j < 8; ++j) { const f32x4 x = v[r][j];
                u32x2 w; w.x = pk2(x[0], x[1]); w.y = pk2(x[2], x[3]); bd[64 * j] = w;
                if (row >= NMAIN) hd[64 * j] = x * ALPHA;
                else { u32x2 wh; wh.x = pk2h(x[0], x[1]); wh.y = pk2h(x[2], x[3]); hb[64 * j] = wh; } } } }
    }
}

__device__ __forceinline__ void ln_one(const f32x4 (&vin)[8], int row, int lane, float* __restrict__ Hw, bf16_t* __restrict__ HB, const float* __restrict__ g, const float* __restrict__ b, float* __restrict__ ST) {
    f32x4 v[8]; float s = 0.f;
#pragma unroll
    for (int j = 0; j < 8; ++j) { v[j] = vin[j]; s += (v[j][0] + v[j][1]) + (v[j][2] + v[j][3]); }
    const float mean = wave_sum(s) * (1.f / DM); float q = 0.f;
#pragma unroll
    for (int j = 0; j < 8; ++j) { v[j] = v[j] - mean; q += (v[j][0] * v[j][0] + v[j][1] * v[j][1]) + (v[j][2] * v[j][2] + v[j][3] * v[j][3]); }
    const float rstd = rsqrtf(wave_sum(q) * (1.f / DM) + EPS);
    if (lane == 0) { f32x2 ms = {mean, rstd}; *(f32x2*)(ST + (size_t)row * 2) = ms; }
    u32x2* bd = (u32x2*)(HB + (size_t)row * DM) + lane; f32x4* hp = (f32x4*)(Hw + (size_t)row * DM) + lane;
#pragma unroll
    for (int j = 0; j < 8; ++j) { const f32x4 gg = ((const f32x4*)g)[lane + 64 * j], bb = ((const f32x4*)b)[lane + 64 * j]; const f32x4 y = v[j] * rstd * gg + bb;
        u32x2 w; w.x = pk2(y[0], y[1]); w.y = pk2(y[2], y[3]); bd[64 * j] = w;
        hp[64 * j] = y * ALPHA; }
}
__device__ __forceinline__ void ln_one_bf(const u32x4 (&vin)[4], int row, int lane, bf16_t* __restrict__ HB, const float* __restrict__ g, const float* __restrict__ b, float* __restrict__ ST, float* __restrict__ out) {
    f32x4 v[8]; float s = 0.f;
#pragma unroll
    for (int j = 0; j < 4; ++j) { v[2 * j] = (f32x4){hf_lo(vin[j].x), hf_hi(vin[j].x), hf_lo(vin[j].y), hf_hi(vin[j].y)}; v[2 * j + 1] = (f32x4){hf_lo(vin[j].z), hf_hi(vin[j].z), hf_lo(vin[j].w), hf_hi(vin[j].w)}; }
#pragma unroll
    for (int j = 0; j < 8; ++j) s += (v[j][0] + v[j][1]) + (v[j][2] + v[j][3]);
    const float mean = wave_sum(s) * (1.f / DM); float q = 0.f;
#pragma unroll
    for (int j = 0; j < 8; ++j) { v[j] = v[j] - mean; q += (v[j][0] * v[j][0] + v[j][1] * v[j][1]) + (v[j][2] * v[j][2] + v[j][3] * v[j][3]); }
    const float rstd = rsqrtf(wave_sum(q) * (1.f / DM) + EPS);
    if (lane == 0) { f32x2 ms = {mean, rstd}; *(f32x2*)(ST + (size_t)row * 2) = ms; }
    u32x4* bd = (u32x4*)(HB + (size_t)row * DM) + lane;
#pragma unroll
    for (int j = 0; j < 4; ++j) { const int c4 = 2 * (lane + 64 * j);
        const f32x4 y0 = v[2 * j] * rstd * ((const f32x4*)g)[c4] + ((const f32x4*)b)[c4], y1 = v[2 * j + 1] * rstd * ((const f32x4*)g)[c4 + 1] + ((const f32x4*)b)[c4 + 1];
        if (out) { f32x4* op = (f32x4*)(out + (size_t)row * DM) + c4; op[0] = y0; op[1] = y1; }
        else bd[64 * j] = pg8::pack8(y0, y1); }
}
__device__ __forceinline__ void ln_rows(const Frame& F, float* H, bf16_t* HB, const float* g, const float* b, float* ST, float* out, const float* PART, int nk) {
    const bf16_t* __restrict__ Hr = (const bf16_t*)H;
    for (int row = F.gw; row < NMAIN; row += 2 * F.ngw) {
        const int row2 = row + F.ngw;
        u32x4 va[4], vb[4];
#pragma unroll
        for (int j = 0; j < 4; ++j) va[j] = ((const u32x4*)(Hr + (size_t)row * DM))[F.lane + 64 * j];
#pragma unroll
        for (int j = 0; j < 4; ++j) vb[j] = ((const u32x4*)(Hr + (size_t)row2 * DM))[F.lane + 64 * j];
        ln_one_bf(va, row, F.lane, HB, g, b, ST, out);
        ln_one_bf(vb, row2, F.lane, HB, g, b, ST, out);
    }
    if (F.gw < TP - NMAIN) {
        const int row = NMAIN + F.gw; const float* __restrict__ Hm = H; f32x4 va[8];
#pragma unroll
        for (int j = 0; j < 8; ++j) va[j] = ((const f32x4*)(Hm + (size_t)row * DM))[F.lane + 64 * j];
        for (int k = 0; k < nk; ++k) {
            const float* __restrict__ pp = PART + ((size_t)k * 256 + F.gw) * DM;
#pragma unroll
            for (int j = 0; j < 8; ++j) va[j] += ((const f32x4*)pp)[F.lane + 64 * j]; }
        ln_one(va, row, F.lane, H, HB, g, b, ST);
    }
}

__device__ __forceinline__ void rstd_rows(const Frame& F, const bf16_t* UDQ, const bf16_t* UDKV, float* RSTD) {
    for (int row = F.gw; row < TP; row += F.ngw) {
        const u32x4 a = ((const u32x4*)(UDQ + (size_t)row * 512))[F.lane]; float s = 0.f;
#pragma unroll
        for (int j = 0; j < 4; ++j) { const float x = bf_lo(a[j]), y = bf_hi(a[j]); s += x * x + y * y; }
        float t = 0.f;
        if (F.lane < 32) { const u32x4 c = ((const u32x4*)(UDKV + (size_t)row * 256))[F.lane];
#pragma unroll
            for (int j = 0; j < 4; ++j) { const float x = bf_lo(c[j]), y = bf_hi(c[j]); t += x * x + y * y; } }
        s = wave_sum(s); t = wave_sum(t);
        if (F.lane == 0) { RSTD[(size_t)row * 2] = rsqrtf(s * (1.f / 512.f) + EPS); RSTD[(size_t)row * 2 + 1] = rsqrtf(t * (1.f / 256.f) + EPS); }
    }
}

__device__ __forceinline__ void mlstm_finalize(const Frame& F, int gw0, int ngw0, const float* HSUM, const bf16_t* UQKVO, const float* ng, bf16_t* MIX) {
    for (int row = gw0; row < TP; row += ngw0) {
#pragma unroll
        for (int j = 0; j < 4; ++j) {
            f32x4 v = ((const f32x4*)(HSUM + (size_t)row * MLW + 256 * j))[F.lane];
            const float mean = wave_sum((v[0] + v[1]) + (v[2] + v[3])) * (1.f / 256.f); v = v - mean;
            const float rstd = rsqrtf(wave_sum((v[0] * v[0] + v[1] * v[1]) + (v[2] * v[2] + v[3] * v[3])) * (1.f / 256.f) + EPS);
            const f32x4 gg = ((const f32x4*)(ng + 256 * j))[F.lane];
            const u32x2 uo = ((const u32x2*)(UQKVO + (size_t)row * 4096 + 3072 + 256 * j))[F.lane];
            const float o0 = bf_lo(uo.x), o1 = bf_hi(uo.x), o2 = bf_lo(uo.y), o3 = bf_hi(uo.y);
            const float y0 = v[0] * rstd * gg[0] / (1.f + __expf(-o0)), y1 = v[1] * rstd * gg[1] / (1.f + __expf(-o1));
            const float y2 = v[2] * rstd * gg[2] / (1.f + __expf(-o2)), y3 = v[3] * rstd * gg[3] / (1.f + __expf(-o3));
            u32x2 w; w.x = pk2(y0, y1); w.y = pk2(y2, y3); ((u32x2*)(MIX + (size_t)row * DM + 256 * j))[F.lane] = w;
        }
    }
}

__device__ __forceinline__ f32x8 ld8f(const float* p) { const f32x4 a = *(const f32x4*)p, b = *(const f32x4*)(p + 4); return (f32x8){a[0], a[1], a[2], a[3], b[0], b[1], b[2], b[3]}; }
__device__ __forceinline__ f32x8 ld8b(const bf16_t* p) { const u32x4 v = *(const u32x4*)p; return (f32x8){bf_lo(v[0]), bf_hi(v[0]), bf_lo(v[1]), bf_hi(v[1]), bf_lo(v[2]), bf_hi(v[2]), bf_lo(v[3]), bf_hi(v[3])}; }
__device__ __forceinline__ void act_store(bf16_t* dst, const f32x8 gp, const f32x8 gc, const f32x8 gn, const f32x8 vv, const f32x8 w0, const f32x8 w1, const f32x8 w2, const f32x8 bb) {
    float o[8];
#pragma unroll
    for (int i = 0; i < 8; ++i) { const float x = w0[i] * gp[i] + w1[i] * gc[i] + w2[i] * gn[i] + bb[i]; o[i] = x / (1.f + __expf(-x)) * vv[i]; }
    u32x4 w; w.x = pk2(o[0], o[1]); w.y = pk2(o[2], o[3]); w.z = pk2(o[4], o[5]); w.w = pk2(o[6], o[7]); *(u32x4*)dst = w;
}
__device__ __forceinline__ void ffn_fixup(const Frame& F, const float* SIDE, const bf16_t* GVM, bf16_t* ACT, const float* cw, const float* cb) {
    constexpr int NCH = DFF / 8;
    const f32x8 zero = {0.f, 0.f, 0.f, 0.f, 0.f, 0.f, 0.f, 0.f};
    const int gt = F.bx * 512 + F.tid, nt = GRID * 512;
    for (int idx = gt; idx < 192 * 2 * NCH; idx += nt) {
        const int ch = idx % NCH, rsel = (idx / NCH) & 1, pm = idx / (2 * NCH), c0 = 8 * ch, sq = pm >> 4;
        const f32x8 w0 = ld8f(cw + c0), w1 = ld8f(cw + DFF + c0), w2 = ld8f(cw + 2 * DFF + c0), bb = ld8f(cb + c0);
        const float* S0 = SIDE + (size_t)pm * 6 * DFF + c0;
        if (rsel == 0) { const f32x8 gp = (pm & 15) ? ld8f(S0 - 6 * DFF + 3 * DFF) : ld8b(GVM + (size_t)(16 * sq + 15) * NUP + c0);
            act_store(ACT + (size_t)(pm * 256) * DFF + c0, gp, ld8f(S0), ld8f(S0 + DFF), ld8f(S0 + 4 * DFF), w0, w1, w2, bb);
        } else { const f32x8 gn = ((pm & 15) != 15) ? ld8f(S0 + 6 * DFF) : zero;
            act_store(ACT + (size_t)(pm * 256 + 255) * DFF + c0, ld8f(S0 + 2 * DFF), ld8f(S0 + 3 * DFF), gn, ld8f(S0 + 5 * DFF), w0, w1, w2, bb); }
    }
    for (int idx = gt; idx < NSEQ * 16 * NCH; idx += nt) {
        const int ch = idx % NCH, rp = idx / NCH, pp = rp & 15, sq = rp >> 4, c0 = 8 * ch;
        const f32x8 w0 = ld8f(cw + c0), w1 = ld8f(cw + DFF + c0), w2 = ld8f(cw + 2 * DFF + c0), bb = ld8f(cb + c0);
        const bf16_t* G0 = GVM + (size_t)(16 * sq + pp) * NUP + c0;
        const f32x8 gp = pp > 0 ? ld8b(G0 - NUP) : zero, gc = ld8b(G0);
        const f32x8 gn = pp < 15 ? ld8b(G0 + NUP) : ld8f(SIDE + (size_t)(16 * sq) * 6 * DFF + c0);
        act_store(ACT + (size_t)(MROW0 + 16 * sq + pp) * DFF + c0, gp, gc, gn, ld8b(G0 + DFF), w0, w1, w2, bb);
    }
}

namespace att {
constexpr int NW = 8, QBLK = 32, KVBLK = 64, NT = 65;
constexpr int KROW = 400;
constexpr int SHM_V = KVBLK * 128 * 2, SHM_K = KVBLK * KROW;
constexpr int OFF_V = 0, OFF_K = 3 * SHM_V, OFF_WS = OFF_K + 3 * SHM_K, LDS_TOTAL = OFF_WS + NW * 64 * 4;
static_assert(LDS_TOTAL <= RING_BYTES, "attention LDS");
constexpr float SCALE = 0.07216878364870323f;
constexpr float THR = 8.f;
#define SBAR() __builtin_amdgcn_sched_barrier(0)
__device__ __forceinline__ int crow(int r, int hi) { return (r & 3) + 8 * (r >> 2) + 4 * hi; }
__device__ __forceinline__ unsigned cvtpk(float lo, float hi) { unsigned r; asm volatile("v_cvt_pk_bf16_f32 %0, %1, %2" : "=v"(r) : "v"(lo), "v"(hi)); return r; }

template <bool MASK16>
__device__ __forceinline__ void partialSM(f32x16& p0, f32x16& p1, float& m_reg, float& mn, float& alpha) {
    constexpr float C = SCALE * 1.4426950408889634f;
    if (MASK16) {
#pragma unroll
        for (int r = 8; r < 16; ++r) p0[r] = NEGBIG;
#pragma unroll
        for (int r = 0; r < 16; ++r) p1[r] = NEGBIG;
    }
    float pmax = p0[0];
#pragma unroll
    for (int r = 1; r < 16; ++r) pmax = fmaxf(pmax, p0[r]);
#pragma unroll
    for (int r = 0; r < 16; ++r) pmax = fmaxf(pmax, p1[r]);
    { auto rr = __builtin_amdgcn_permlane32_swap(__float_as_uint(pmax), __float_as_uint(pmax), false, false); pmax = fmaxf(__uint_as_float(rr[0]), __uint_as_float(rr[1])); }
    if (__builtin_expect(__all(pmax - m_reg <= THR / SCALE), 1)) { mn = m_reg; alpha = 1.f; }
    else { mn = fmaxf(m_reg, pmax); alpha = __builtin_amdgcn_exp2f((m_reg - mn) * C); m_reg = mn; }
    const float mnC = -mn * C;
#pragma unroll
    for (int r = 0; r < 16; ++r) p0[r] = fmaf(p0[r], C, mnC);
#pragma unroll
    for (int r = 0; r < 16; ++r) p1[r] = fmaf(p1[r], C, mnC);
#pragma unroll
    for (int r = 0; r < 16; ++r) p0[r] = __builtin_amdgcn_exp2f(p0[r]);
}
__device__ __forceinline__ void finishSM(f32x16& p0, f32x16& p1, float alpha, float& l_reg, bf16x8& pa0, bf16x8& pa1, bf16x8& pa2, bf16x8& pa3) {
#pragma unroll
    for (int r = 0; r < 16; ++r) p1[r] = __builtin_amdgcn_exp2f(p1[r]);
    float ps = 0;
#pragma unroll
    for (int r = 0; r < 16; ++r) ps += p0[r];
#pragma unroll
    for (int r = 0; r < 16; ++r) ps += p1[r];
    { auto rr = __builtin_amdgcn_permlane32_swap(__float_as_uint(ps), __float_as_uint(ps), false, false); ps = __uint_as_float(rr[0]) + __uint_as_float(rr[1]); }
    l_reg = l_reg * alpha + ps;
#define PK4(P, BASE, OUT) do { unsigned a0 = cvtpk(P[BASE + 0], P[BASE + 1]), a1 = cvtpk(P[BASE + 2], P[BASE + 3]);   \
    unsigned b0 = cvtpk(P[BASE + 4], P[BASE + 5]), b1 = cvtpk(P[BASE + 6], P[BASE + 7]);                              \
    auto r0 = __builtin_amdgcn_permlane32_swap(a0, b0, false, false); auto r1 = __builtin_amdgcn_permlane32_swap(a1, b1, false, false); \
    u32x4 w = {r0[0], r1[0], r0[1], r1[1]}; OUT = __builtin_bit_cast(bf16x8, w); } while (0)
    PK4(p0, 0, pa0); PK4(p0, 8, pa1); PK4(p1, 0, pa2); PK4(p1, 8, pa3);
#undef PK4
}
__device__ __forceinline__ void qkt(f32x16& p0, f32x16& p1, const LAS char* Ks, const bf16x8* qr, int r32, int hi) {
#pragma unroll
    for (int r = 0; r < 16; ++r) { p0[r] = 0.f; p1[r] = 0.f; }
#pragma unroll
    for (int d0 = 0; d0 < 12; ++d0) { const int cb = (d0 * 16 + hi * 8) * 2;
        const bf16x8 b0 = *(const LAS bf16x8*)(Ks + r32 * KROW + cb);
        const bf16x8 b1 = *(const LAS bf16x8*)(Ks + (32 + r32) * KROW + cb);
        p0 = __builtin_amdgcn_mfma_f32_32x32x16_bf16(b0, qr[d0], p0, 0, 0, 0);
        p1 = __builtin_amdgcn_mfma_f32_32x32x16_bf16(b1, qr[d0], p1, 0, 0, 0); }
}
__device__ __forceinline__ int v_st(int k, int c) { const int kk = (k & ~0xC) | ((k & 4) << 1) | ((k & 8) >> 1); return ((kk >> 3) * 4 + (c >> 5)) * 512 + ((kk & 7) * 32 + (c & 31)) * 2; }
__device__ __forceinline__ int v_rd_base(int lane) { return ((lane & 3) << 3) | (((lane >> 2) & 3) << 6) | (((lane >> 4) & 1) << 5) | (((lane >> 5) & 1) << 8); }
constexpr int v_rd_off(int d0, int ks, int half) { return d0 * 512 + ks * 4096 + half * 2048; }
template <int OFF> __device__ __forceinline__ s16x4 tr_read(int vb) { s16x4 r; asm volatile("ds_read_b64_tr_b16 %0, %1 offset:%2" : "=&v"(r) : "v"(vb), "i"(OFF) : "memory"); return r; }
template <int D0> __device__ __forceinline__ void pv_one(f32x16& od, int vb, bf16x8 pa0, bf16x8 pa1, bf16x8 pa2, bf16x8 pa3) {
    const s16x4 l0 = tr_read<v_rd_off(D0, 0, 0)>(vb), h0 = tr_read<v_rd_off(D0, 0, 1)>(vb), l1 = tr_read<v_rd_off(D0, 1, 0)>(vb), h1 = tr_read<v_rd_off(D0, 1, 1)>(vb);
    const s16x4 l2 = tr_read<v_rd_off(D0, 2, 0)>(vb), h2 = tr_read<v_rd_off(D0, 2, 1)>(vb), l3 = tr_read<v_rd_off(D0, 3, 0)>(vb), h3 = tr_read<v_rd_off(D0, 3, 1)>(vb);
    asm volatile("s_waitcnt lgkmcnt(0)" ::: "memory"); SBAR();
#define PKV(L, H) (bf16x8){L[0], L[1], L[2], L[3], H[0], H[1], H[2], H[3]}
    od = __builtin_amdgcn_mfma_f32_32x32x16_bf16(pa0, PKV(l0, h0), od, 0, 0, 0);
    od = __builtin_amdgcn_mfma_f32_32x32x16_bf16(pa1, PKV(l1, h1), od, 0, 0, 0);
    od = __builtin_amdgcn_mfma_f32_32x32x16_bf16(pa2, PKV(l2, h2), od, 0, 0, 0);
    od = __builtin_amdgcn_mfma_f32_32x32x16_bf16(pa3, PKV(l3, h3), od, 0, 0, 0);
#undef PKV
}
__device__ __forceinline__ void pv_d0(f32x16* o, int vb, bf16x8 pa0, bf16x8 pa1, bf16x8 pa2, bf16x8 pa3) {
    pv_one<0>(o[0], vb, pa0, pa1, pa2, pa3); pv_one<1>(o[1], vb, pa0, pa1, pa2, pa3); pv_one<2>(o[2], vb, pa0, pa1, pa2, pa3); pv_one<3>(o[3], vb, pa0, pa1, pa2, pa3);
}

__device__ __forceinline__ void attn_unit(int s, int h, int qb, const bf16_t* __restrict__ MQ, const bf16_t* __restrict__ MKV, const bf16_t* __restrict__ KR, bf16_t* __restrict__ MIX, LAS char* lds) {
    int tid_ = threadIdx.x; asm volatile("" : "+v"(tid_));
    const int tid = tid_, wid = tid >> 6, lane = tid & 63, r32 = lane & 31, hi = lane >> 5;
    LAS char* V_lds = lds + OFF_V; LAS char* K_lds = lds + OFF_K;
    LAS float* wsf = (LAS float*)(lds + OFF_WS) + wid * 64; LAS float* li_l = wsf; LAS float* al_l = wsf + 32;
    float m_reg = NEGBIG, l_reg = 0; f32x16 o[4]; bf16x8 qr[12];
#pragma unroll
    for (int d = 0; d < 4; ++d)
#pragma unroll
        for (int r = 0; r < 16; ++r) o[d][r] = 0.f;
    const int qi = wid * QBLK + r32;
    const unsigned qrow = qb < 16 ? (unsigned)s * LREAL + 256 * qb + qi : (unsigned)MROW0 + 16 * s + (qi < 15 ? qi : 15);
    { const bf16_t* Qw = MQ + (qrow * NQ + h * 192 + hi * 8);
#pragma unroll
      for (int d0 = 0; d0 < 12; ++d0) qr[d0] = *(const bf16x8*)(Qw + d0 * 16); }
    const int sr = tid >> 4, sc = (tid & 15) * 8, vst0 = v_st(sr, sc), vst1 = v_st(32 + sr, sc);
    const int kr_r = tid >> 3, kr_c = (tid & 7) * 8;
    const int vb0 = (int)(uintptr_t)V_lds + v_rd_base(lane);
    bf16x8 vs0, vs1, ks0, ks1, kr0;
    const unsigned mainrow0 = (unsigned)s * LREAL, metarow0 = (unsigned)MROW0 + 16 * s;
    const bf16_t* MKVh = MKV + h * 256;
#define KROWG(kt, k) ((kt) < 64 ? mainrow0 + 64u * (kt) + (k) : metarow0 + ((k) < 15 ? (k) : 15))
#define SLOAD(kt) do { const unsigned g0 = KROWG(kt, sr) * NKV + sc, g1 = KROWG(kt, 32 + sr) * NKV + sc, g2 = KROWG(kt, kr_r) * 64 + kr_c; \
    vs0 = *(const bf16x8*)(MKVh + 128 + g0); vs1 = *(const bf16x8*)(MKVh + 128 + g1); \
    ks0 = *(const bf16x8*)(MKVh + g0); ks1 = *(const bf16x8*)(MKVh + g1); kr0 = *(const bf16x8*)(KR + g2); } while (0)
#define SWRITE(b) do { *(LAS bf16x8*)(V_lds + (b) * SHM_V + vst0) = vs0; *(LAS bf16x8*)(V_lds + (b) * SHM_V + vst1) = vs1; \
    *(LAS bf16x8*)(K_lds + (b) * SHM_K + sr * KROW + sc * 2) = ks0; *(LAS bf16x8*)(K_lds + (b) * SHM_K + (32 + sr) * KROW + sc * 2) = ks1; \
    *(LAS bf16x8*)(K_lds + (b) * SHM_K + kr_r * KROW + 256 + kr_c * 2) = kr0; } while (0)
#define RESC(a) do { if (__any((a) < 1.f)) { if (hi == 0) al_l[r32] = (a); asm volatile("s_waitcnt lgkmcnt(0)" ::: "memory"); \
    _Pragma("unroll") for (int d = 0; d < 4; ++d) _Pragma("unroll") for (int r = 0; r < 16; ++r) o[d][r] *= al_l[crow(r, hi)]; } } while (0)
    f32x16 pA0, pA1, pB0, pB1; float mnA, mnB, alA, alB; bf16x8 pa0, pa1, pa2, pa3;
    __syncthreads();
    SLOAD(0); SWRITE(0); __syncthreads();
    qkt(pA0, pA1, K_lds, qr, r32, hi); partialSM<false>(pA0, pA1, m_reg, mnA, alA);
    SLOAD(1); SWRITE(1); __syncthreads();
    RESC(alA);
    int s0 = 0, s1 = 1, s2 = 2;
    for (int j = 1; j + 1 < NT; j += 2) {
        SBAR(); qkt(pB0, pB1, K_lds + s1 * SHM_K, qr, r32, hi);
        finishSM(pA0, pA1, alA, l_reg, pa0, pa1, pa2, pa3); SBAR();
        SLOAD(j + 1); SBAR();
        pv_d0(o, vb0 + s0 * SHM_V, pa0, pa1, pa2, pa3); partialSM<false>(pB0, pB1, m_reg, mnB, alB);
        SWRITE(s2);
        RESC(alB); __syncthreads();
        SBAR(); qkt(pA0, pA1, K_lds + s2 * SHM_K, qr, r32, hi);
        finishSM(pB0, pB1, alB, l_reg, pa0, pa1, pa2, pa3); SBAR();
        if (j + 2 < NT) SLOAD(j + 2); SBAR();
        pv_d0(o, vb0 + s1 * SHM_V, pa0, pa1, pa2, pa3);
        if (j + 1 == NT - 1) partialSM<true>(pA0, pA1, m_reg, mnA, alA); else partialSM<false>(pA0, pA1, m_reg, mnA, alA);
        if (j + 2 < NT) SWRITE(s0);
        RESC(alA); __syncthreads();
        { const int t0 = s0, t1 = s1; s0 = s2; s1 = t0; s2 = t1; }
    }
    finishSM(pA0, pA1, alA, l_reg, pa0, pa1, pa2, pa3); SBAR();
    pv_d0(o, vb0 + s0 * SHM_V, pa0, pa1, pa2, pa3);
    if (hi == 0) li_l[r32] = l_reg; asm volatile("s_waitcnt lgkmcnt(0)" ::: "memory");
    float rli[16];
#pragma unroll
    for (int r = 0; r < 16; ++r) rli[r] = __builtin_amdgcn_rcpf(li_l[crow(r, hi)]);
    if (qb < 16) {
        bf16_t* Ow = MIX + ((long)s * LREAL + 256 * qb + wid * QBLK) * DM + MLW + h * 128;
#pragma unroll
        for (int r = 0; r < 16; ++r) { const int orow = crow(r, hi);
#pragma unroll
            for (int d0 = 0; d0 < 4; ++d0) Ow[(long)orow * DM + d0 * 32 + r32] = (bf16_t)(pk2(o[d0][r] * rli[r], 0.f) & 0xffffu); }
    } else if (wid == 0) {
        bf16_t* Ow = MIX + ((long)MROW0 + 16 * s) * DM + MLW + h * 128;
#pragma unroll
        for (int r = 0; r < 16; ++r) { const int orow = crow(r, hi);
            if (orow < 16) {
#pragma unroll
                for (int d0 = 0; d0 < 4; ++d0) Ow[(long)orow * DM + d0 * 32 + r32] = (bf16_t)(pk2(o[d0][r] * rli[r], 0.f) & 0xffffu); } }
    }
#undef KROWG
#undef SLOAD
#undef SWRITE
#undef RESC
}
__device__ __forceinline__ void attn_phase(int vcu, const bf16_t* MQ, const bf16_t* MKV, const bf16_t* KR, bf16_t* MIX, LAS char* lds) {
    for (int i = (vcu < 96 ? -1 : 0); i < 6; ++i) { int sh, qb; if (i < 0) { sh = vcu; qb = 16; } else { const int id = i * GRID + vcu; sh = id >> 4; qb = id & 15; }
        attn_unit(sh >> 3, sh & 7, qb, MQ, MKV, KR, MIX, lds); }
}
#undef SBAR
}

namespace ml {
constexpr int QI = 0, KI = 32768, VI = 65536, SI = 81920, CI = 98304;
constexpr int SC_CT = 0, SC_BM = 64, SC_WI = 128, SC_EI = 192, SC_WW = 256, SC_DEN = 320, SC_QN = 448, SC_N = 512, SC_A = 768;
constexpr int GP_REC = 200;
__device__ __forceinline__ unsigned off_b(unsigned row, unsigned ch) { return 256u * row + 16u * (ch ^ (((row & 3) << 2) | ((row >> 2) & 3))); }
__device__ __forceinline__ unsigned row_read_addr_16(unsigned lane, unsigned rb, unsigned s) { return off_b((lane & 15) + 16 * rb, 4 * s + (lane >> 4)); }
__device__ __forceinline__ unsigned tr_read_addr_16(unsigned lane, unsigned c, unsigned ks, unsigned t) {
    const unsigned g = lane >> 4, q = (lane & 15) >> 2, p = lane & 3; return off_b(32 * ks + 8 * g + 4 * t + q, 2 * c + (p >> 1)) + 8 * (p & 1); }
__device__ __forceinline__ bf16x8 tr_frag(unsigned a0, unsigned a1) {
    const s16x4 lo = __builtin_amdgcn_ds_read_tr16_b64_v4i16((LAS s16x4*)a0), hi = __builtin_amdgcn_ds_read_tr16_b64_v4i16((LAS s16x4*)a1);
    return (bf16x8){lo[0], lo[1], lo[2], lo[3], hi[0], hi[1], hi[2], hi[3]};
}
__device__ __forceinline__ f32x4 mfma16(bf16x8 a, bf16x8 b, f32x4 c) { return __builtin_amdgcn_mfma_f32_16x16x32_bf16(a, b, c, 0, 0, 0); }
__device__ __forceinline__ float log_sigmoid(float x) { return fminf(x, 0.f) - __logf(1.f + __expf(-fabsf(x))); }

__device__ __forceinline__ void gate_prep(int gw, int ngw, int lane, const float* __restrict__ GATES, const float* __restrict__ bgl, float* __restrict__ GP) {
    for (int it = gw; it < 96 * 65; it += ngw) {
        const int chain = it / 65, c = it % 65, s = chain >> 3, hd = (chain >> 1) & 3, dir = chain & 1;
        const long g = c == 0 ? (lane >= 48 ? (long)MROW0 + 16 * s + lane - 48 : -1L) : (long)s * LREAL + 64 * (c - 1) + lane;
        float li = NEGBIG, lf = 0.f;
        if (g >= 0) { li = GATES[g * 16 + (dir ? 8 : 0) + hd] + bgl[(dir ? 8 : 0) + hd]; lf = log_sigmoid(GATES[g * 16 + (dir ? 12 : 4) + hd] + bgl[(dir ? 12 : 4) + hd]); }
        float x = dir ? __shfl(lf, 63 - lane) : lf;
#pragma unroll
        for (int o = 1; o < 64; o <<= 1) { const float y = __shfl_up(x, o); if (lane >= o) x += y; }
        const float btot = __shfl(x, 63);
        const float b = dir ? __shfl(x, 63 - lane) : x;
        const float a_s = li - b;
        float pm = dir ? __shfl(a_s, 63 - lane) : a_s;
#pragma unroll
        for (int o = 1; o < 64; o <<= 1) { const float y = __shfl_up(pm, o); if (lane >= o) pm = fmaxf(pm, y); }
        pm = dir ? __shfl(pm, 63 - lane) : pm;
        const float gmax = wave_max(btot - b + li);
        float* rec = GP + (size_t)it * GP_REC;
        rec[lane] = b; rec[64 + lane] = li; rec[128 + lane] = pm; if (lane == 0) { rec[192] = btot; rec[193] = gmax; }
    }
}

__device__ __forceinline__ void mlstm_unit(int s, int hd, int js, const bf16_t* __restrict__ UQKVO, const float* __restrict__ GP, float* __restrict__ HSUM, LAS unsigned char* lds, LAS float* sc) {
    const int wid = __builtin_amdgcn_readfirstlane((int)threadIdx.x >> 6);
    const unsigned ldsb = (unsigned)(uintptr_t)lds;
    const int tt = wid >> 1, nb = 2 * (wid & 1);
#define ROWRD(img, rb, s_) (*(const LAS bf16x8*)(uintptr_t)(RB[s_] + (unsigned)((img) + 4096 * (rb))))
#define TRFRAG(img, c_, ks) tr_frag(BT[0][(c_) & 1] + TQ[(c_) >> 1] + (unsigned)((img) + 8192 * (ks)), BT[1][(c_) & 1] + TQ[(c_) >> 1] + (unsigned)((img) + 8192 * (ks)))
    f32x4 accC[2][4], accN[2];
    for (int dir = 0; dir < 2; ++dir) {
        int tid; { int t0_ = threadIdx.x; asm volatile("" : "+v"(t0_)); tid = t0_; }
#pragma unroll
        for (int mi = 0; mi < 2; ++mi)
#pragma unroll
            for (int c = 0; c < 4; ++c) accC[mi][c] = (f32x4){0.f, 0.f, 0.f, 0.f};
        accN[0] = (f32x4){0.f, 0.f, 0.f, 0.f}; accN[1] = (f32x4){0.f, 0.f, 0.f, 0.f};
        if (tid < 256) sc[SC_N + tid] = 0.f;
        for (int i = tid; i < 32768 / 16; i += 512) *(LAS u32x4*)(lds + CI + i * 16) = (u32x4){0u, 0u, 0u, 0u};
        float m_state = 0.f;
        const float* GPc = GP + (size_t)(((s * 4 + hd) * 2 + dir) * 65) * GP_REC;
        u32x4 sq[4], sk[4], sv; float sb = 0.f, sli = NEGBIG, spm = NEGBIG, sbt = 0.f, sgm = NEGBIG;
#define ROWG(c, r) ((c) == 0 ? ((r) >= 48 ? (long)MROW0 + 16 * s + (r) - 48 : -1L) : (long)s * LREAL + 64 * ((c) - 1) + (r))
#define STAGE_LOAD(c) do { \
        _Pragma("unroll") for (int i = 0; i < 4; ++i) { const int id = tid + 512 * i, r = id >> 5, ch = id & 31; const long g = ROWG(c, r); \
            sq[i] = (u32x4){0u, 0u, 0u, 0u}; sk[i] = (u32x4){0u, 0u, 0u, 0u}; \
            if (g >= 0) { sq[i] = *(const u32x4*)(UQKVO + g * 4096 + hd * 256 + ch * 8); sk[i] = *(const u32x4*)(UQKVO + g * 4096 + 1024 + hd * 256 + ch * 8); } } \
        { const int r = tid >> 3, ch = tid & 7; const long g = ROWG(c, r); sv = (u32x4){0u, 0u, 0u, 0u}; if (g >= 0) sv = *(const u32x4*)(UQKVO + g * 4096 + 2048 + hd * 256 + js * 64 + ch * 8); } \
        if (tid < 64) { const float* rec = GPc + (size_t)(c) * GP_REC; sb = rec[tid]; sli = rec[64 + tid]; spm = rec[128 + tid]; sbt = rec[192]; sgm = rec[193]; } } while (0)
#define STAGE_WRITE() do { \
        _Pragma("unroll") for (int i = 0; i < 4; ++i) { const int id = tid + 512 * i, r = id >> 5, ch = id & 31; \
            *(LAS u32x4*)(lds + QI + (ch >> 4) * 16384 + off_b(r, ch & 15)) = sq[i]; *(LAS u32x4*)(lds + KI + (ch >> 4) * 16384 + off_b(r, ch & 15)) = sk[i]; } \
        { const int r = tid >> 3, ch = tid & 7; *(LAS u32x4*)(lds + VI + off_b(r, ch)) = sv; } \
        if (tid < 64) { const float m_inter = sb + m_state, mt = fmaxf(m_inter, sb + spm); const float m_new = fmaxf(sbt + m_state, sgm); \
            sc[SC_CT + tid] = sli - sb; sc[SC_BM + tid] = sb - mt; sc[SC_WI + tid] = __expf(m_inter - mt); sc[SC_EI + tid] = __expf(-mt); \
            sc[SC_WW + tid] = __expf(sbt - sb + sli - m_new) * 0.0625f; if (tid == 0) sc[SC_A] = __expf(sbt + m_state - m_new); m_state = m_new; } } while (0)
        const int c_first = dir ? 64 : 0, c_step = dir ? -1 : 1;
        STAGE_LOAD(c_first);
        __syncthreads();
        STAGE_WRITE();
        for (int ci = 0; ci < 65; ++ci) {
            const int c = c_first + c_step * ci;
            { int t2_ = threadIdx.x; asm volatile("" : "+v"(t2_)); tid = t2_; }
            const int lane = tid & 63, l15 = lane & 15, lg = lane >> 4;
            unsigned RB[4], BT[2][2], TQ[4];
            { const unsigned fl = ((l15 & 3) << 2) | (l15 >> 2), q = l15 >> 2, p = lane & 3, g = lg;
#pragma unroll
              for (int s_ = 0; s_ < 4; ++s_) { RB[s_] = ldsb + 256u * l15 + 16u * (lg ^ (fl & 3)) + 64u * (s_ ^ (fl >> 2)); TQ[s_] = 64u * (s_ ^ q); }
#pragma unroll
              for (int t_ = 0; t_ < 2; ++t_)
#pragma unroll
                  for (int cl = 0; cl < 2; ++cl) BT[t_][cl] = ldsb + 256u * (8 * g + q) + 8u * (p & 1) + 1024u * t_ + 16u * ((p >> 1) ^ t_) + 32u * (cl ^ (g & 1)); }
            __syncthreads();
            if (ci + 1 < 65) STAGE_LOAD(c + c_step);
            bf16x8 qf[8];
#pragma unroll
            for (int k = 0; k < 8; ++k) qf[k] = ROWRD(QI + (k >> 2) * 16384, tt, k & 3);
            f32x4 sT[2], oc[2];
#pragma unroll
            for (int i = 0; i < 2; ++i) { sT[i] = (f32x4){0.f, 0.f, 0.f, 0.f}; oc[i] = (f32x4){0.f, 0.f, 0.f, 0.f}; }
#pragma unroll
            for (int i = 0; i < 2; ++i)
#pragma unroll
                for (int k = 0; k < 8; ++k) {
                    const bf16x8 kf = ROWRD(KI + (k >> 2) * 16384, nb + i, k & 3);
                    sT[i] = mfma16(kf, qf[k], sT[i]);
                    const bf16x8 cf = ROWRD(CI + (k >> 2) * 16384, nb + i, k & 3);
                    oc[i] = mfma16(qf[k], cf, oc[i]);
                }
            {
                const int t = 16 * tt + l15; const float bmt = sc[SC_BM + t]; float rs = 0.f;
#pragma unroll
                for (int i = 0; i < 2; ++i) { const int s0 = 16 * (nb + i) + 4 * lg; const f32x4 ctv = *(const LAS f32x4*)(sc + SC_CT + s0); float v[4];
#pragma unroll
                    for (int e = 0; e < 4; ++e) { const int sx = s0 + e; const bool ok = dir ? (sx >= t) : (sx <= t);
                        const float ex = ok ? (bmt + ctv[e]) : NEGBIG; v[e] = sT[i][e] * 0.0625f * __expf(ex); rs += v[e]; }
                    u32x2 w; w.x = pk2(v[0], v[1]); w.y = pk2(v[2], v[3]);
                    *(LAS u32x2*)(lds + SI + off_b(t, s0 >> 3) + (s0 & 7) * 2) = w; }
                rs += __shfl_xor(rs, 16); rs += __shfl_xor(rs, 32);
                if (lg == 0) sc[SC_DEN + 64 * (wid & 1) + t] = rs;
            }
            { const int r = tid >> 3, ch = tid & 7; const u32x4 v = *(const LAS u32x4*)(lds + VI + off_b(r, ch)); const float w = sc[SC_WW + r]; u32x4 o;
#pragma unroll
              for (int jx = 0; jx < 4; ++jx) o[jx] = pk2(bf_lo(v[jx]) * w, bf_hi(v[jx]) * w);
              *(LAS u32x4*)(lds + VI + off_b(r, 8 + ch)) = o; }
            { const int r = tid >> 3, part = tid & 7; float d = 0.f;
#pragma unroll
              for (int i = 0; i < 4; ++i) { const int ch32 = part * 4 + i; const u32x4 v = *(const LAS u32x4*)(lds + QI + (ch32 >> 4) * 16384 + off_b(r, ch32 & 15));
                  const f32x4 n0 = *(const LAS f32x4*)(sc + SC_N + ch32 * 8), n1 = *(const LAS f32x4*)(sc + SC_N + ch32 * 8 + 4);
                  d += bf_lo(v[0]) * n0[0] + bf_hi(v[0]) * n0[1] + bf_lo(v[1]) * n0[2] + bf_hi(v[1]) * n0[3] + bf_lo(v[2]) * n1[0] + bf_hi(v[2]) * n1[1] + bf_lo(v[3]) * n1[2] + bf_hi(v[3]) * n1[3]; }
              d += __shfl_xor(d, 1); d += __shfl_xor(d, 2); d += __shfl_xor(d, 4);
              if (part == 0) sc[SC_QN + r] = d; }
            { const f32x4 wi = *(const LAS f32x4*)(sc + SC_WI + 16 * tt + 4 * lg);
#pragma unroll
              for (int i = 0; i < 2; ++i) oc[i] = oc[i] * wi; }
            __syncthreads();
            const float a_dec = sc[SC_A];
#pragma unroll
            for (int ks = 0; ks < 2; ++ks) { const bf16x8 sf = ROWRD(SI, tt, ks);
#pragma unroll
                for (int i = 0; i < 2; ++i) { const bf16x8 vf = TRFRAG(VI, nb + i, ks);
                    oc[i] = mfma16(sf, vf, oc[i]); } }
            { const int t0 = 16 * tt + 4 * lg;
              const f32x4 wi = *(const LAS f32x4*)(sc + SC_WI + t0), qn = *(const LAS f32x4*)(sc + SC_QN + t0), d0 = *(const LAS f32x4*)(sc + SC_DEN + t0), d1 = *(const LAS f32x4*)(sc + SC_DEN + 64 + t0), ei = *(const LAS f32x4*)(sc + SC_EI + t0);
#pragma unroll
              for (int e = 0; e < 4; ++e) { const long g = ROWG(c, t0 + e);
                const float den = wi[e] * qn[e] + (d0[e] + d1[e]); const float inv = 1.f / fmaxf(fabsf(den), ei[e]);
                if (g >= 0) {
#pragma unroll
                    for (int i = 0; i < 2; ++i) { float* hp = HSUM + g * MLW + hd * 256 + js * 64 + 16 * (nb + i) + l15; const float hv = oc[i][e] * inv; if (dir) unsafeAtomicAdd(hp, hv); else *hp = hv; } } } }
#pragma unroll
            for (int mi = 0; mi < 2; ++mi)
#pragma unroll
                for (int cc = 0; cc < 4; ++cc) accC[mi][cc] = accC[mi][cc] * a_dec;
            accN[0] = accN[0] * a_dec; accN[1] = accN[1] * a_dec;
            const unsigned ktq = (unsigned)(KI + (wid >> 2) * 16384) + 64u * ((unsigned)(wid & 3) ^ (unsigned)(l15 >> 2));
#pragma unroll
            for (int ks = 0; ks < 2; ++ks) {
                bf16x8 kf[2], wf[4];
#pragma unroll
                for (int mi = 0; mi < 2; ++mi) kf[mi] = tr_frag(BT[0][mi] + ktq + (unsigned)(8192 * ks), BT[1][mi] + ktq + (unsigned)(8192 * ks));
#pragma unroll
                for (int cc = 0; cc < 4; ++cc) wf[cc] = TRFRAG(VI, 4 + cc, ks);
                { const f32x4 wa = *(const LAS f32x4*)(sc + SC_WW + 32 * ks + 8 * lg), wb = *(const LAS f32x4*)(sc + SC_WW + 32 * ks + 8 * lg + 4);
                  u32x4 wq; wq.x = pk2(wa[0], wa[1]); wq.y = pk2(wa[2], wa[3]); wq.z = pk2(wb[0], wb[1]); wq.w = pk2(wb[2], wb[3]);
                  if (l15 != 0) wq = (u32x4){0u, 0u, 0u, 0u};
                  const bf16x8 wfn = __builtin_bit_cast(bf16x8, wq);
#pragma unroll
                  for (int mi = 0; mi < 2; ++mi) accN[mi] = mfma16(kf[mi], wfn, accN[mi]); }
#pragma unroll
                for (int mi = 0; mi < 2; ++mi)
#pragma unroll
                    for (int cc = 0; cc < 4; ++cc) accC[mi][cc] = mfma16(kf[mi], wf[cc], accC[mi][cc]);
            }
#pragma unroll
            for (int mi = 0; mi < 2; ++mi)
#pragma unroll
                for (int cc = 0; cc < 4; ++cc) { const int dk0 = 32 * wid + 16 * mi + 4 * lg, dv = 16 * cc + l15; u32x2 w; w.x = pk2(accC[mi][cc][0], accC[mi][cc][1]); w.y = pk2(accC[mi][cc][2], accC[mi][cc][3]);
                    *(LAS u32x2*)(lds + CI + (dk0 >> 7) * 16384 + off_b(dv, (dk0 & 127) >> 3) + (dk0 & 7) * 2) = w; }
            if (l15 == 0) { *(LAS f32x4*)(sc + SC_N + 32 * wid + 4 * lg) = accN[0]; *(LAS f32x4*)(sc + SC_N + 32 * wid + 16 + 4 * lg) = accN[1]; }
            __syncthreads();
            if (ci + 1 < 65) STAGE_WRITE();
        }
    }
#undef ROWG
#undef STAGE_LOAD
#undef STAGE_WRITE
#undef ROWRD
#undef TRFRAG
}
__device__ __forceinline__ void mlstm_phase(int bx, const bf16_t* UQKVO, const float* GP, float* HSUM, LAS unsigned char* lds, LAS float* sc) {
    if (bx >= 192) return;
    const int xcd = bx & 7, idx = bx >> 3, pair = xcd * 6 + (idx >> 2), js = idx & 3;
    mlstm_unit(pair >> 2, pair & 3, js, UQKVO, GP, HSUM, lds, sc);
}
}

#ifndef PHM
#define PHM 0xffff
#endif
#ifndef REP_ML
#define REP_ML 1
#endif
#ifndef REP_ATTN
#define REP_ATTN 1
#endif
#ifndef REP_CONV
#define REP_CONV 1
#endif
#ifndef REP_SMALL
#define REP_SMALL 1
#endif
#ifndef KV_SPLIT
#define KV_SPLIT 193
#endif
#ifndef REP_WIN
#define REP_WIN 1
#endif
#ifndef REP_UP
#define REP_UP 1
#endif
__global__ void __launch_bounds__(512, 2) fwd_kernel(Params P, unsigned char* ws_arg, unsigned char* out_arg) {
    extern __shared__ __attribute__((aligned(16))) unsigned char lds_raw[];
    Frame F;
    F.lds = (LAS unsigned char*)lds_raw;
    F.tid = threadIdx.x; F.lane = F.tid & 63; F.wave = __builtin_amdgcn_readfirstlane(F.tid >> 6);
    F.G = GRID; F.bx = blockIdx.x; F.vcu = (F.bx % 8) * (GRID / 8) + F.bx / 8;
    F.gw = F.vcu * 8 + F.wave; F.ngw = F.G * 8;
    { unsigned char* ws0 = ws_arg;
      for (int u = F.tid; u < (LDS_BYTES - MISC_OFF) / 4; u += 512) ((LAS unsigned*)(F.lds + MISC_OFF))[u] = 0u;
      __syncthreads();
      (void)ws0; }
    LAS unsigned long long* ptab = (LAS unsigned long long*)(F.lds + MISC_OFF + 64);
    if (F.tid == 0) {
#pragma unroll
        for (int k = 0; k < 19; ++k) ptab[k] = (unsigned long long)(uintptr_t)P.in[k]; }
    __syncthreads();
    XcdBarrier bar = xcd_barrier_post((unsigned*)(ws_arg + WS_CTL) + CW_BAR, (volatile LAS unsigned*)(F.lds + MISC_OFF));
    LAS float* sc = (LAS float*)(F.lds + MISC_OFF + 1024);
#define BXL() ({ int b__ = F.bx; asm volatile("" : "+s"(b__)); b__; })
#define PFRAME() Frame Fp = F; { int t_ = threadIdx.x; asm volatile("" : "+v"(t_)); Fp.tid = t_; Fp.lane = t_ & 63; int b_ = BXL(); Fp.bx = b_; Fp.vcu = (b_ % 8) * (GRID / 8) + b_ / 8; Fp.gw = Fp.vcu * 8 + Fp.wave; }
#define WSB() ({ GAS unsigned char* w__ = (GAS unsigned char*)ws_arg; asm volatile("" : "+s"(w__)); (unsigned char*)w__; })
#ifndef STAG_N
#define STAG_N 1
#endif
#ifdef STAG_ON
#define STAGGER() do { int s__ = (BXL() * 37) & 255; for (int i__ = 0; i__ < s__; ++i__) __builtin_amdgcn_s_sleep(STAG_N); } while (0)
#else
#define STAGGER() do {} while (0)
#endif
#define DOB() ({ GAS unsigned char* w__ = (GAS unsigned char*)out_arg; asm volatile("" : "+s"(w__)); (unsigned char*)w__; })

    { unsigned char* ws = WSB(); prologue(F, ws, ptab); convert_weights(F, ws, ptab, 0); }
    xcd_barrier(bar);

    for (int l = 0; l < DEPTH; ++l) {
        { unsigned char* ws = WSB();
          pg8::Gemm g{(bf16_t*)(ws + WS_HB), (bf16_t*)(ws + WS_WIN), TP, NIN, DM, DM}; pg8::PanelOrder S; S.init(NPAN, 0, 0, 0, NIN, F.G, BXL());
          pg8::EpiWin E{(bf16_t*)(ws + WS_UQKVO), (bf16_t*)(ws + WS_UDQ), (bf16_t*)(ws + WS_UDKV), (bf16_t*)(ws + WS_KR), (float*)(ws + WS_GATES), (const float*)(ws + WS_COS), (const float*)(ws + WS_SIN)};
#if PHM & 2
          STAGGER(); pg8::gemm_phase<pg8::EpiWin, pg8::PanelOrder, true, true>(F.lds, g, S, E);
#endif
        }
#if REP_WIN > 1
        __syncthreads();
        { unsigned char* ws = WSB();
          pg8::Gemm g{(bf16_t*)(ws + WS_HB), (bf16_t*)(ws + WS_WIN), TP, NIN, DM, DM}; pg8::PanelOrder S; S.init(NPAN, 0, 0, 0, NIN, F.G, BXL());
          pg8::EpiWin E{(bf16_t*)(ws + WS_UQKVO), (bf16_t*)(ws + WS_UDQ), (bf16_t*)(ws + WS_UDKV), (bf16_t*)(ws + WS_KR), (float*)(ws + WS_GATES), (const float*)(ws + WS_COS), (const float*)(ws + WS_SIN)};
          pg8::gemm_phase<pg8::EpiWin, pg8::PanelOrder, true, true>(F.lds, g, S, E);
        }
#endif
        xcd_barrier(bar);
        { unsigned char* ws = WSB(); unsigned char* dob = DOB(); PFRAME(); rstd_rows(Fp, (bf16_t*)(ws + WS_UDQ), (bf16_t*)(ws + WS_UDKV), (float*)(ws + WS_RSTD));
          ml::gate_prep(Fp.gw, Fp.ngw, Fp.lane, (const float*)(ws + WS_GATES), (const float*)(ws + WS_PAR) + PO_BG + l * 16, (float*)(dob + DO_GP)); }
#if REP_SMALL > 1
        { unsigned char* ws = WSB(); unsigned char* dob = DOB(); PFRAME(); rstd_rows(Fp, (bf16_t*)(ws + WS_UDQ), (bf16_t*)(ws + WS_UDKV), (float*)(ws + WS_RSTD));
          ml::gate_prep(Fp.gw, Fp.ngw, Fp.lane, (const float*)(ws + WS_GATES), (const float*)(ws + WS_PAR) + PO_BG + l * 16, (float*)(dob + DO_GP)); }
#endif
        xcd_barrier(bar);
        if (F.bx >= 192) {
        { unsigned char* ws = WSB(); unsigned char* dob = DOB();
          pg8::Gemm g{(bf16_t*)(ws + WS_UDQ), (bf16_t*)(ws + WS_WUQ), TP, NQ, 512, 512}; pg8::PanelOrder S; S.init(NPAN, 0, 0, 0, NQ, GRID - 192, BXL() - 192);
          pg8::EpiQ E{(bf16_t*)(dob + DO_MQ), (const float*)(ws + WS_RSTD), (const float*)(ws + WS_COS), (const float*)(ws + WS_SIN)};
#if PHM & 4
          pg8::gemm_phase<pg8::EpiQ, pg8::PanelOrder, true, true>(F.lds, g, S, E);
#endif
        }
        { unsigned char* ws = WSB();
          pg8::Gemm g{(bf16_t*)(ws + WS_UDKV), (bf16_t*)(ws + WS_WUKV), TP, NKV, 256, 256}; pg8::PanelOrder S; S.init(NPAN, 0, 0, 0, NKV, GRID - 192, BXL() - 192);
          pg8::EpiBf16G E{(bf16_t*)(ws + WS_MKV), NKV, (const float*)(ws + WS_RSTD) + 1, 0, -1, 0};
#if PHM & 8
          pg8::gemm_phase<pg8::EpiBf16G, pg8::PanelOrder, true, true>(F.lds, g, S, E);
#endif
        }
        } else {
#ifndef NO_ML
        for (int rep_ = 0; rep_ < REP_ML; ++rep_)
        { unsigned char* ws = WSB(); unsigned char* dob = DOB();
          ml::mlstm_phase(BXL(), (const bf16_t*)(ws + WS_UQKVO), (const float*)(dob + DO_GP), (float*)(dob + DO_HSUM), F.lds, sc); }
#endif
        }
        xcd_barrier(bar);
        { unsigned char* ws = WSB(); unsigned char* dob = DOB(); PFRAME();
          if (Fp.vcu >= 96) mlstm_finalize(Fp, (Fp.vcu - 96) * 8 + Fp.wave, (GRID - 96) * 8, (const float*)(dob + DO_HSUM), (const bf16_t*)(ws + WS_UQKVO), (const float*)(ws + WS_PAR) + PO_MLG + l * MLW, (bf16_t*)(ws + WS_HB)); }
#ifndef NO_ATTN
        for (int rep_ = 0; rep_ < REP_ATTN; ++rep_)
        { unsigned char* ws = WSB(); unsigned char* dob = DOB();
          att::attn_phase(({ int b__ = BXL(); (b__ % 8) * (GRID / 8) + b__ / 8; }), (const bf16_t*)(dob + DO_MQ), (const bf16_t*)(ws + WS_MKV), (const bf16_t*)(ws + WS_KR), (bf16_t*)(ws + WS_HB), (LAS char*)F.lds); }
#endif
        xcd_barrier(bar);
        { unsigned char* ws = WSB();
          pg8::Gemm g{(bf16_t*)(ws + WS_HB), (bf16_t*)(ws + WS_WOUT), TP, DM, DM, DM}; pg8::PanelOrder S; S.init(192, 0, 0, 0, DM, F.G, BXL());
          pg8::EpiResidLn E{(bf16_t*)(ws + WS_H), DM, ALPHA, (const float*)(ws + WS_STAT2), (const float*)(ws + WS_PAR) + (l > 0 ? PO_L2G + (l - 1) * DM : PO_ONE), (const float*)(ws + WS_PAR) + (l > 0 ? PO_L2B + (l - 1) * DM : PO_ZERO)};
#if PHM & 16
          STAGGER(); pg8::gemm_phase<pg8::EpiResidLn, pg8::PanelOrder, true, true>(F.lds, g, S, E);
#endif
        }
        { unsigned char* ws = WSB();
          pg8::Gemm g{(bf16_t*)(ws + WS_HB), (bf16_t*)(ws + WS_WOUT), TP, DM, DM / 4, DM}; pg8::SplitOrder S; S.init(PMETA, DM, 4, F.G, BXL());
          pg8::EpiPart E{(float*)(ws + WS_PART), DM};
#if PHM & 16
          pg8::gemm_phase<pg8::EpiPart, pg8::SplitOrder, true, true>(F.lds, g, S, E);
#endif
        }
        xcd_barrier(bar);
        { unsigned char* ws = WSB(); PFRAME(); ln_rows(Fp, (float*)(ws + WS_H), (bf16_t*)(ws + WS_HB), (const float*)(ws + WS_PAR) + PO_L1G + l * DM, (const float*)(ws + WS_PAR) + PO_L1B + l * DM, (float*)(ws + WS_STAT1), nullptr, (const float*)(ws + WS_PART), 4); }
        xcd_barrier(bar);
        { unsigned char* ws = WSB(); unsigned char* dob = DOB();
          pg8::Gemm g{(bf16_t*)(ws + WS_HB), (bf16_t*)(ws + WS_WUP), TP, NUP, DM, DM}; pg8::PanelOrder S; S.init(NPAN, 0, 0, 0, NUP, F.G, BXL());
          pg8::EpiFfn E{(bf16_t*)(ws + WS_ACT), (float*)(dob + DO_SIDE), (bf16_t*)(dob + DO_GVM), (const float*)(ws + WS_PAR) + PO_CW + (size_t)l * 3 * DFF, (const float*)(ws + WS_PAR) + PO_CB + (size_t)l * DFF, (LAS float*)(F.lds + MISC_OFF + 8192)};
#if PHM & 32
          STAGGER(); pg8::gemm_phase<pg8::EpiFfn, pg8::PanelOrder, true, true>(F.lds, g, S, E);
#if REP_UP > 1
          __syncthreads(); pg8::gemm_phase<pg8::EpiFfn, pg8::PanelOrder, true, true>(F.lds, g, S, E);
#endif
#endif
        }
        xcd_barrier(bar);
        { unsigned char* ws = WSB(); unsigned char* dob = DOB(); PFRAME();
          ffn_fixup(Fp, (const float*)(dob + DO_SIDE), (const bf16_t*)(dob + DO_GVM), (bf16_t*)(ws + WS_ACT), (const float*)(ws + WS_PAR) + PO_CW + (size_t)l * 3 * DFF, (const float*)(ws + WS_PAR) + PO_CB + (size_t)l * DFF); }
#if REP_SMALL > 1
        { unsigned char* ws = WSB(); unsigned char* dob = DOB(); PFRAME();
          ffn_fixup(Fp, (const float*)(dob + DO_SIDE), (const bf16_t*)(dob + DO_GVM), (bf16_t*)(ws + WS_ACT), (const float*)(ws + WS_PAR) + PO_CW + (size_t)l * 3 * DFF, (const float*)(ws + WS_PAR) + PO_CB + (size_t)l * DFF); }
#endif
        xcd_barrier(bar);
        { unsigned char* ws = WSB();
          pg8::Gemm g{(bf16_t*)(ws + WS_ACT), (bf16_t*)(ws + WS_WDN), TP, DM, DFF, DFF}; pg8::PanelOrder S; S.init(192, 0, 0, 0, DM, F.G, BXL());
          pg8::EpiResidLn E{(bf16_t*)(ws + WS_H), DM, ALPHA, (const float*)(ws + WS_STAT1), (const float*)(ws + WS_PAR) + PO_L1G + l * DM, (const float*)(ws + WS_PAR) + PO_L1B + l * DM};
#if PHM & 64
          STAGGER(); pg8::gemm_phase<pg8::EpiResidLn, pg8::PanelOrder, true, true>(F.lds, g, S, E);
#endif
        }
        { unsigned char* ws = WSB();
          pg8::Gemm g{(bf16_t*)(ws + WS_ACT), (bf16_t*)(ws + WS_WDN), TP, DM, DFF / 11, DFF}; pg8::SplitOrder S; S.init(PMETA, DM, 11, F.G, BXL());
          pg8::EpiPart E{(float*)(ws + WS_PART), DM};
#if PHM & 64
          pg8::gemm_phase<pg8::EpiPart, pg8::SplitOrder, true, true>(F.lds, g, S, E);
#endif
        }
        xcd_barrier(bar);
        { unsigned char* ws = WSB(); unsigned char* dob = DOB();
          PFRAME(); ln_rows(Fp, (float*)(ws + WS_H), (bf16_t*)(ws + WS_HB), (const float*)(ws + WS_PAR) + PO_L2G + l * DM, (const float*)(ws + WS_PAR) + PO_L2B + l * DM, (float*)(ws + WS_STAT2), l == DEPTH - 1 ? (float*)dob : nullptr, (const float*)(ws + WS_PART), 11); }
        if (l + 1 < DEPTH) { unsigned char* ws = WSB(); PFRAME(); convert_weights(Fp, ws, ptab, l + 1); }
#if REP_CONV > 1
        if (l + 1 < DEPTH) { __syncthreads(); unsigned char* ws = WSB(); PFRAME(); convert_weights(Fp, ws, ptab, l + 1); }
#endif
        xcd_barrier(bar);
    }
}

extern "C" void kernel_launch(void* const* d_in, const int* in_sizes, int n_in, void* d_out, int out_size, void* d_ws, size_t ws_size, hipStream_t stream) {
    static int grid = 0;
    if (grid == 0) {
        if (n_in != 19 || out_size != NMAIN * DM || ws_size < WS_NEED) { fprintf(stderr, "kernel_launch: unexpected shapes (n_in %d out %d ws %zu need %zu)\n", n_in, out_size, ws_size, (size_t)WS_NEED); grid = -1; return; }
        int dev = 0, cus = 0;
        if (hipGetDevice(&dev) != hipSuccess || hipDeviceGetAttribute(&cus, hipDeviceAttributeMultiprocessorCount, dev) != hipSuccess) { grid = -1; return; }
        if (hipFuncSetAttribute((const void*)fwd_kernel, hipFuncAttributeMaxDynamicSharedMemorySize, LDS_BYTES) != hipSuccess) { fprintf(stderr, "kernel_launch: hipFuncSetAttribute failed\n"); grid = -1; return; }
        int per_cu = 0;
        if (hipOccupancyMaxActiveBlocksPerMultiprocessor(&per_cu, (const void*)fwd_kernel, 512, LDS_BYTES) != hipSuccess || per_cu < 1) { fprintf(stderr, "kernel_launch: occupancy query says %d blocks per CU\n", per_cu); (void)hipGetLastError(); grid = -1; return; }
        if (cus < GRID) { fprintf(stderr, "kernel_launch: needs %d CUs, device has %d\n", GRID, cus); grid = -1; return; }
        grid = GRID;
    }
    if (grid < 0) return;
    (void)hipMemsetAsync((char*)d_ws + WS_CTL, 0, CTL_BYTES, stream);
    Params p{};
    for (int i = 0; i < 19; ++i) p.in[i] = (const float*)d_in[i];
    hipLaunchKernelGGL(fwd_kernel, dim3(grid), dim3(512), LDS_BYTES, stream, p, (unsigned char*)d_ws, (unsigned char*)d_out);
}
```

```cpp
#include <hip/hip_runtime.h>
#include <cstdio>
#include <cstdint>

#define LAS __attribute__((address_space(3)))
#define GAS __attribute__((address_space(1)))
typedef float f32x2 __attribute__((ext_vector_type(2)));
typedef float f32x8 __attribute__((ext_vector_type(8)));
typedef float f32x16 __attribute__((ext_vector_type(16)));
typedef unsigned u32x2 __attribute__((ext_vector_type(2)));
typedef short s16x4 __attribute__((ext_vector_type(4)));
typedef __bf16 bf16x2v __attribute__((ext_vector_type(2)));

constexpr int DM = 2048, NSEQ = 12, LREAL = 4096, NMETA = 16, DEPTH = 4;
constexpr int NMAIN = NSEQ * LREAL;
constexpr int MROW0 = NMAIN;
constexpr int NTOK = NMAIN + NSEQ * NMETA;
constexpr int NPAN = 193, TP = NPAN * 256;
constexpr int PMETA = 192;
constexpr int INC = 4944, NIN = 5120;
constexpr int DFF = 5632, NUP = 2 * DFF;
constexpr int MLW = 1024, NQ = 1536, NKV = 2048;
constexpr float ALPHA = 1.681792830507429f;
constexpr float EPS = 1e-5f;
constexpr float NEGBIG = -1e30f;

constexpr size_t MiB = 1u << 20;
constexpr size_t WS_CTL = 0, CTL_BYTES = 1 * MiB;
constexpr size_t WS_COS = 1 * MiB;
constexpr size_t WS_SIN = WS_COS + (size_t)4112 * 32 * 4;
constexpr size_t WS_PAR = 2 * MiB + 128 * 1024;
constexpr int PO_BG = 0, PO_MLG = PO_BG + DEPTH * 16, PO_QG = PO_MLG + DEPTH * 1024, PO_KVG = PO_QG + DEPTH * 512, PO_L1G = PO_KVG + DEPTH * 256, PO_L1B = PO_L1G + DEPTH * 2048,
              PO_CW = PO_L1B + DEPTH * 2048, PO_CB = PO_CW + DEPTH * 3 * 5632, PO_L2G = PO_CB + DEPTH * 5632, PO_L2B = PO_L2G + DEPTH * 2048, PO_ONE = PO_L2B + DEPTH * 2048, PO_ZERO = PO_ONE + 2048, PO_END = PO_ZERO + 2048;
static_assert(WS_PAR + (size_t)PO_END * 4 <= 3 * MiB && WS_PAR >= 1 * MiB + 2 * 4112 * 32 * 4, "PAR block placement");
constexpr size_t WS_WIN = 3 * MiB;
constexpr size_t WS_WUQ = WS_WIN + (size_t)NIN * DM * 2;
constexpr size_t WS_WUKV = WS_WUQ + (size_t)NQ * 512 * 2;
constexpr size_t WS_WOUT = WS_WUKV + (size_t)NKV * 256 * 2;
constexpr size_t WS_WUP = WS_WOUT + (size_t)DM * DM * 2;
constexpr size_t WS_WDN = WS_WUP + (size_t)NUP * DM * 2;
constexpr size_t WS_STAT1 = WS_WDN + (size_t)DM * DFF * 2;
constexpr size_t WS_STAT2 = WS_CTL + 512 * 1024;
constexpr size_t WS_H = 100 * MiB;
constexpr size_t WS_PART = WS_H + 208 * MiB;
static_assert((size_t)NMAIN * DM * 2 <= 208 * MiB && 208 * MiB + (size_t)11 * 256 * DM * 4 <= (size_t)NMAIN * DM * 4, "PART sits between the bf16 rows and the f32 meta rows of H");
constexpr size_t WS_WSET2 = WS_H + 240 * MiB;
constexpr size_t WSET_BYTES = WS_STAT1 - WS_WIN, WSET_DELTA = WS_WSET2 - WS_WIN;
static_assert(WS_PART + (size_t)11 * 256 * DM * 4 <= WS_WSET2 && WS_WSET2 + WSET_BYTES <= WS_H + (size_t)NMAIN * DM * 4, "second weight set sits between the split-K parts and the f32 meta rows of H");
constexpr size_t WS_HB = WS_H + (size_t)TP * DM * 4;
constexpr size_t WS_R = WS_HB + (size_t)TP * DM * 2;
constexpr size_t WS_UQKVO = WS_R;
constexpr size_t WS_UDQ = WS_UQKVO + (size_t)TP * 4096 * 2;
constexpr size_t WS_UDKV = WS_UDQ + (size_t)TP * 512 * 2;
constexpr size_t WS_GATES = WS_UDKV + (size_t)TP * 256 * 2;
constexpr size_t WS_MKV = WS_GATES + (size_t)TP * 16 * 4;
constexpr size_t WS_KR = WS_MKV + (size_t)TP * NKV * 2;
constexpr size_t WS_RSTD = WS_KR + (size_t)TP * 64 * 2;
constexpr size_t WS_END_A = WS_RSTD + (size_t)TP * 2 * 4;
constexpr size_t WS_ACT = WS_R;
constexpr size_t WS_END_B = WS_ACT + (size_t)TP * DFF * 2;
constexpr size_t WS_NEED = (WS_END_A > WS_END_B ? WS_END_A : WS_END_B);
static_assert(WS_STAT1 + (size_t)TP * 8 <= WS_H && WS_STAT2 + (size_t)TP * 8 <= WS_CTL + CTL_BYTES, "weights and row statistics fit below H");
constexpr size_t DO_HSUM = 0;
constexpr size_t DO_MQ = DO_HSUM + (size_t)TP * MLW * 4;
constexpr size_t DO_GP = 340 * MiB;
constexpr size_t DO_SIDE = 0;
constexpr size_t DO_GVM = 32 * MiB;
static_assert(DO_MQ + (size_t)TP * NQ * 2 <= DO_GP && DO_GP + (size_t)96 * 65 * 200 * 4 <= (size_t)NMAIN * DM * 4 && (size_t)192 * 6 * DFF * 4 <= DO_GVM && DO_GVM + (size_t)256 * NUP * 2 <= (size_t)NMAIN * DM * 4, "d_out scratch fits");
constexpr int CW_BAR = 4096;

constexpr int RING_BYTES = 131072;
constexpr int MISC_OFF = RING_BYTES;
constexpr int LDS_BYTES = 147456;
constexpr int GRID = 256;

__device__ __forceinline__ int pos_of_row(int row) { return row < NMAIN ? NMETA + (row & (LREAL - 1)) : ((row - NMAIN) & (NMETA - 1)); }
__device__ __forceinline__ unsigned pk2(float lo, float hi) { f32x2 v = {lo, hi}; return __builtin_bit_cast(unsigned, __builtin_convertvector(v, bf16x2v)); }
__device__ __forceinline__ float bf_lo(unsigned w) { return __uint_as_float(w << 16); }
__device__ __forceinline__ float bf_hi(unsigned w) { return __uint_as_float(w & 0xffff0000u); }
typedef _Float16 f16x2v __attribute__((ext_vector_type(2)));
__device__ __forceinline__ unsigned pk2h(float lo, float hi) { f32x2 v = {lo, hi}; return __builtin_bit_cast(unsigned, __builtin_convertvector(v, f16x2v)); }
__device__ __forceinline__ float hf_lo(unsigned w) { return (float)__builtin_bit_cast(f16x2v, w)[0]; }
__device__ __forceinline__ float hf_hi(unsigned w) { return (float)__builtin_bit_cast(f16x2v, w)[1]; }
__device__ __forceinline__ float wave_sum(float v) {
#pragma unroll
    for (int o = 1; o < 64; o <<= 1) v += __shfl_xor(v, o);
    return v;
}
__device__ __forceinline__ float wave_max(float v) {
#pragma unroll
    for (int o = 1; o < 64; o <<= 1) v = fmaxf(v, __shfl_xor(v, o));
    return v;
}
namespace pg8 {
#define PG8_LAS __attribute__((address_space(3)))
typedef unsigned short bf16_t;
typedef short bf16x8 __attribute__((ext_vector_type(8)));
typedef float f32x4 __attribute__((ext_vector_type(4)));
typedef unsigned u32x4 __attribute__((ext_vector_type(4)));
constexpr int BM = 256, BK = 64, HALF = 128, HTB = HALF * BK * 2  , STAGE_BYTES = 8 * HTB, NXCD = 8, WGM = 4;

__host__ __device__ __forceinline__ int lds_byte(int r, int c) { const int st = (r >> 4) * 2 + (c >> 5), rr = r & 15, cc = c & 31, ob = rr * 64 + cc * 2; return st * 1024 + (ob ^ (((ob >> 9) & 1) << 5)); }
__host__ __device__ __forceinline__ void stage_rc(int b, int& R, int& C) { const int st = b / 1024, sb = b % 1024, swz = sb ^ (((sb >> 9) & 1) << 5); R = (st >> 1) * 16 + swz / 64; C = (st & 1) * 32 + (swz % 64) / 2; }
__host__ __device__ __forceinline__ int perm32(int rho) { const int n = rho >> 4, i = rho & 15; return 8 * (i >> 2) + 4 * n + (i & 3); }

struct Unit { int pm, pn, kk; };
struct Gemm { const bf16_t* A; const bf16_t* Bt; int M, N, K, ld; };

struct PanelOrder {
    int nM, nN, nwg, G, c, nMain, pm0, pmx;
    __device__ void init(int nMain_, int pm0_, int extra, int pmx_, int N, int G_, int c_) { nMain = nMain_; pm0 = pm0_; pmx = pmx_; nM = nMain_ + extra; nN = N / BM; nwg = nM * nN; G = G_; c = c_; }
    __device__ bool next(int i, Unit& u) const {
        const long L = (long)i * G + c; if (L >= nwg) return false;
        int wgid = (int)L; { const int q = nwg / NXCD, r = nwg % NXCD, xcd = wgid % NXCD, off = wgid / NXCD; wgid = (xcd < r ? xcd * (q + 1) : r * (q + 1) + (xcd - r) * q) + off; }
        const int nig = WGM * nN, gid = wgid / nig, fm = gid * WGM, gsz = (nM - fm) < WGM ? (nM - fm) : WGM;
        const int pl = fm + ((wgid % nig) % gsz); u.pm = pl < nMain ? pm0 + pl : pmx; u.pn = (wgid % nig) / gsz; u.kk = 0; return true;
    }
    __device__ __forceinline__ void a_ready(const Unit&) const {}
    __device__ __forceinline__ void done(const Unit&) const {}
};

struct SplitOrder {
    int pm, nN, nwg, G, c;
    __device__ void init(int pm_, int N, int nsplit, int G_, int c_) { pm = pm_; nN = N / BM; nwg = nN * nsplit; G = G_; c = c_; }
    __device__ bool next(int i, Unit& u) const { const int L = i * G + c; if (L >= nwg) return false; u.pm = pm; u.pn = L % nN; u.kk = L / nN; return true; }
    __device__ __forceinline__ void a_ready(const Unit&) const {}
    __device__ __forceinline__ void done(const Unit&) const {}
};

__device__ __forceinline__ u32x4 pack8(const f32x4 v0, const f32x4 v1) { u32x4 w; w.x = pk2(v0[0], v0[1]); w.y = pk2(v0[2], v0[3]); w.z = pk2(v1[0], v1[1]); w.w = pk2(v1[2], v1[3]); return w; }

struct EpiBf16G {
    static constexpr bool PERM = true, AFTER_DRAIN = false, PERMA = false;
    bf16_t* O; int ldc; const float* rs; int pm_sub, pm_sp, pm_sp_out;
    __device__ __forceinline__ void operator()(const f32x4 (&acc)[2][2][4][2], const Unit& u, int wr, int wc, int fr, int fq) const {
        const int opm = (u.pm == pm_sp) ? pm_sp_out : u.pm - pm_sub;
        const int rin = u.pm * BM + wr * 64 + fr, rout = opm * BM + wr * 64 + fr, col0 = u.pn * BM + wc * 32 + 8 * fq;
#pragma unroll
        for (int ai = 0; ai < 2; ++ai)
#pragma unroll
            for (int m = 0; m < 4; ++m) { const float sc = rs ? rs[(size_t)(rin + ai * HALF + m * 16) * 2] : 1.f;
                bf16_t* rowp = O + (size_t)(rout + ai * HALF + m * 16) * ldc + col0;
#pragma unroll
                for (int bj = 0; bj < 2; ++bj) *(u32x4*)(rowp + bj * HALF) = pack8(acc[ai][bj][m][0] * sc, acc[ai][bj][m][1] * sc); }
    }
};
struct EpiWin {
    static constexpr bool PERM = true, AFTER_DRAIN = false, PERMA = false;
    bf16_t *UQKVO, *UDQ, *UDKV, *KR; float* GATES; const float *COS, *SIN;
    __device__ __forceinline__ void operator()(const f32x4 (&acc)[2][2][4][2], const Unit& u, int wr, int wc, int fr, int fq) const {
        const int row0 = u.pm * BM + wr * 64 + fr;
        if (u.pn < 19) {
            bf16_t* base; int ldc, colt;
            if (u.pn < 16) { base = UQKVO; ldc = 4096; colt = u.pn * BM; } else if (u.pn < 18) { base = UDQ; ldc = 512; colt = (u.pn - 16) * BM; } else { base = UDKV; ldc = 256; colt = 0; }
            const int col0 = colt + wc * 32 + 8 * fq;
#pragma unroll
            for (int ai = 0; ai < 2; ++ai)
#pragma unroll
                for (int m = 0; m < 4; ++m) { bf16_t* rowp = base + (size_t)(row0 + ai * HALF + m * 16) * ldc + col0;
#pragma unroll
                    for (int bj = 0; bj < 2; ++bj) *(u32x4*)(rowp + bj * HALF) = pack8(acc[ai][bj][m][0], acc[ai][bj][m][1]); }
        } else {
            if (wc < 2) { const int g = 4 * wc + fq;
#pragma unroll
                for (int ai = 0; ai < 2; ++ai)
#pragma unroll
                    for (int m = 0; m < 4; ++m) { const int row = row0 + ai * HALF + m * 16, pos = pos_of_row(row);
                        const f32x4 cs = *(const f32x4*)(COS + pos * 32 + 4 * g), sn = *(const f32x4*)(SIN + pos * 32 + 4 * g);
                        const f32x4 x1 = acc[ai][0][m][0], x2 = acc[ai][0][m][1];
                        *(u32x4*)(KR + (size_t)row * 64 + 8 * g) = pack8(x1 * cs - x2 * sn, x1 * sn + x2 * cs); }
            } else if (wc == 2 && fq < 2) {
#pragma unroll
                for (int ai = 0; ai < 2; ++ai)
#pragma unroll
                    for (int m = 0; m < 4; ++m) { float* gp = GATES + (size_t)(row0 + ai * HALF + m * 16) * 16 + 8 * fq;
                        *(f32x4*)gp = acc[ai][0][m][0]; *(f32x4*)(gp + 4) = acc[ai][0][m][1]; }
            }
        }
    }
};
struct EpiQ {
    static constexpr bool PERM = true, AFTER_DRAIN = false, PERMA = false;
    bf16_t* MQ; const float *RSTD, *COS, *SIN;
    __device__ __forceinline__ void operator()(const f32x4 (&acc)[2][2][4][2], const Unit& u, int wr, int wc, int fr, int fq) const {
        const int row0 = u.pm * BM + wr * 64 + fr, colb = u.pn * BM + wc * 32 + 8 * fq;
#pragma unroll
        for (int ai = 0; ai < 2; ++ai)
#pragma unroll
            for (int m = 0; m < 4; ++m) { const int row = row0 + ai * HALF + m * 16, pos = pos_of_row(row); const float sc = RSTD[(size_t)row * 2];
#pragma unroll
                for (int bj = 0; bj < 2; ++bj) { const int col0 = colb + bj * HALF, o = col0 % 192;
                    f32x4 v0 = acc[ai][bj][m][0] * sc, v1 = acc[ai][bj][m][1] * sc;
                    if (o >= 128) { const int g = (o - 128) >> 3; const f32x4 cs = *(const f32x4*)(COS + pos * 32 + 4 * g), sn = *(const f32x4*)(SIN + pos * 32 + 4 * g);
                        const f32x4 x1 = v0, x2 = v1; v0 = x1 * cs - x2 * sn; v1 = x1 * sn + x2 * cs; }
                    *(u32x4*)(MQ + (size_t)row * NQ + col0) = pack8(v0, v1); } }
    }
};
__device__ __forceinline__ void resid_ln_tile(float* __restrict__ Cw, const float* __restrict__ Cr, const float* __restrict__ st, const float* __restrict__ g, const float* __restrict__ b,
                                              int ldc, float alpha, const f32x4 (&acc)[2][2][4][2], int row0, int col0) {
    asm volatile("" ::: "memory");
#pragma unroll
    for (int ai = 0; ai < 2; ++ai)
#pragma unroll
        for (int bj = 0; bj < 2; ++bj) {
            f32x4 gv[2], bv[2], hv[4][2]; f32x2 ms[4];
#pragma unroll
            for (int n = 0; n < 2; ++n) { gv[n] = *(const f32x4*)(g + col0 + bj * HALF + n * 16) * alpha; bv[n] = *(const f32x4*)(b + col0 + bj * HALF + n * 16) * alpha; }
#pragma unroll
            for (int m = 0; m < 4; ++m) { const int row = row0 + ai * HALF + m * 16; ms[m] = *(const f32x2*)(st + (size_t)row * 2);
#pragma unroll
                for (int n = 0; n < 2; ++n) hv[m][n] = *(const f32x4*)(Cr + (size_t)row * ldc + col0 + bj * HALF + n * 16); }
#pragma unroll
            for (int m = 0; m < 4; ++m) { const int row = row0 + ai * HALF + m * 16;
#pragma unroll
                for (int n = 0; n < 2; ++n) *(f32x4*)(Cw + (size_t)row * ldc + col0 + bj * HALF + n * 16) = (hv[m][n] - ms[m][0]) * ms[m][1] * gv[n] + bv[n] + acc[ai][bj][m][n]; }
        }
}
__device__ __forceinline__ void resid_ln_tile_bf(bf16_t* __restrict__ Cw, const bf16_t* __restrict__ Cr, const float* __restrict__ st, const float* __restrict__ g, const float* __restrict__ b,
                                                 int ldc, float alpha, const f32x4 (&acc)[2][2][4][2], int row0, int col0) {
    asm volatile("" ::: "memory");
#pragma unroll
    for (int ai = 0; ai < 2; ++ai)
#pragma unroll
        for (int bj = 0; bj < 2; ++bj) {
            f32x4 gv[2], bv[2]; u32x4 hv[4]; f32x2 ms[4];
#pragma unroll
            for (int n = 0; n < 2; ++n) { gv[n] = *(const f32x4*)(g + col0 + bj * HALF + n * 4) * alpha; bv[n] = *(const f32x4*)(b + col0 + bj * HALF + n * 4) * alpha; }
#pragma unroll
            for (int m = 0; m < 4; ++m) { const int row = row0 + ai * HALF + m * 16; ms[m] = *(const f32x2*)(st + (size_t)row * 2);
                hv[m] = *(const u32x4*)(Cr + (size_t)row * ldc + col0 + bj * HALF); }
#pragma unroll
            for (int m = 0; m < 4; ++m) { const int row = row0 + ai * HALF + m * 16;
                const f32x4 h0 = {hf_lo(hv[m].x), hf_hi(hv[m].x), hf_lo(hv[m].y), hf_hi(hv[m].y)}, h1 = {hf_lo(hv[m].z), hf_hi(hv[m].z), hf_lo(hv[m].w), hf_hi(hv[m].w)};
                const f32x4 o0 = (h0 - ms[m][0]) * ms[m][1] * gv[0] + bv[0] + acc[ai][bj][m][0], o1 = (h1 - ms[m][0]) * ms[m][1] * gv[1] + bv[1] + acc[ai][bj][m][1];
                u32x4 w; w.x = pk2h(o0[0], o0[1]); w.y = pk2h(o0[2], o0[3]); w.z = pk2h(o1[0], o1[1]); w.w = pk2h(o1[2], o1[3]);
                *(u32x4*)(Cw + (size_t)row * ldc + col0 + bj * HALF) = w; }
        }
}
struct EpiResidLn {
    static constexpr bool PERM = true, AFTER_DRAIN = false, PERMA = false;
    bf16_t* C; int ldc; float alpha; const float* st; const float* g; const float* b;
    __device__ __forceinline__ void operator()(const f32x4 (&acc)[2][2][4][2], const Unit& u, int wr, int wc, int fr, int fq) const {
        resid_ln_tile_bf(this->C, this->C, this->st, this->g, this->b, this->ldc, this->alpha, acc, u.pm * BM + wr * 64 + fr, u.pn * BM + wc * 32 + 8 * fq);
    }
};
struct EpiPart {
    static constexpr bool PERM = false, AFTER_DRAIN = false, PERMA = false;
    float* P; int ldc;
    __device__ __forceinline__ void operator()(const f32x4 (&acc)[2][2][4][2], const Unit& u, int wr, int wc, int fr, int fq) const {
        const int row0 = u.kk * BM + wr * 64 + fr, col0 = u.pn * BM + wc * 32 + 4 * fq;
#pragma unroll
        for (int ai = 0; ai < 2; ++ai)
#pragma unroll
            for (int m = 0; m < 4; ++m) { float* rowp = P + (size_t)(row0 + ai * HALF + m * 16) * ldc + col0;
#pragma unroll
                for (int bj = 0; bj < 2; ++bj)
#pragma unroll
                    for (int n = 0; n < 2; ++n) *(f32x4*)(rowp + bj * HALF + n * 16) = acc[ai][bj][m][n]; }
    }
};

__device__ __forceinline__ float dpp_shr1_old(float old, float x) { return __int_as_float(__builtin_amdgcn_update_dpp(__float_as_int(old), __float_as_int(x), 0x111, 0xf, 0xf, false)); }
__device__ __forceinline__ float dpp_shl1_old(float old, float x) { return __int_as_float(__builtin_amdgcn_update_dpp(__float_as_int(old), __float_as_int(x), 0x101, 0xf, 0xf, false)); }
struct EpiFfn {
    static constexpr bool PERM = true, AFTER_DRAIN = false, PERMA = true;
    bf16_t* ACT; float* SIDE; bf16_t* GVM; const float *cw, *cb; PG8_LAS float* X;
    __device__ __forceinline__ void operator()(const f32x4 (&acc)[2][2][4][2], const Unit& u, int wr_in, int wc_in, int fr_in, int fq_in) const {
        int fr = fr_in, fq = fq_in, wr = wr_in, wc = wc_in; asm volatile("" : "+v"(fr), "+v"(fq), "+s"(wr), "+s"(wc));
        const int cj = wc * 32 + 8 * fq, c0 = u.pn * 128 + cj;
        if (u.pm == PMETA) {
#pragma unroll
            for (int ai = 0; ai < 2; ++ai)
#pragma unroll
                for (int m = 0; m < 4; ++m) { bf16_t* rowp = GVM + (size_t)(ai * HALF + wr * 64 + 4 * fr + m) * NUP + c0;
                    *(u32x4*)rowp = pack8(acc[ai][0][m][0], acc[ai][0][m][1]); *(u32x4*)(rowp + DFF) = pack8(acc[ai][1][m][0], acc[ai][1][m][1]); }
            return;
        }
        f32x4 w0[2], w1[2], w2[2], bb[2];
#pragma unroll
        for (int n = 0; n < 2; ++n) { w0[n] = *(const f32x4*)(cw + c0 + 4 * n); w1[n] = *(const f32x4*)(cw + DFF + c0 + 4 * n); w2[n] = *(const f32x4*)(cw + 2 * DFF + c0 + 4 * n); bb[n] = *(const f32x4*)(cb + c0 + 4 * n); }
#pragma unroll
        for (int ai = 0; ai < 2; ++ai) { const int b = 2 * ai + wr;
            if (fr == 0) { *(PG8_LAS f32x4*)(X + (b * 2 + 0) * 128 + cj) = acc[ai][0][0][0]; *(PG8_LAS f32x4*)(X + (b * 2 + 0) * 128 + cj + 4) = acc[ai][0][0][1]; }
            if (fr == 15) { *(PG8_LAS f32x4*)(X + (b * 2 + 1) * 128 + cj) = acc[ai][0][3][0]; *(PG8_LAS f32x4*)(X + (b * 2 + 1) * 128 + cj + 4) = acc[ai][0][3][1]; } }
        asm volatile("s_waitcnt lgkmcnt(0)" ::: "memory"); __builtin_amdgcn_s_barrier(); asm volatile("" ::: "memory");
        const unsigned rowb = (unsigned)(u.pm * BM + wr * 64 + 4 * fr) * DFF + c0;
#pragma unroll
        for (int ai = 0; ai < 2; ++ai) { const int b = 2 * ai + wr;
            f32x4 xp[2], xn[2];
#pragma unroll
            for (int n = 0; n < 2; ++n) { xp[n] = b > 0 ? *(const PG8_LAS f32x4*)(X + ((b - 1) * 2 + 1) * 128 + cj + 4 * n) : (f32x4){0.f, 0.f, 0.f, 0.f};
                                          xn[n] = b < 3 ? *(const PG8_LAS f32x4*)(X + ((b + 1) * 2 + 0) * 128 + cj + 4 * n) : (f32x4){0.f, 0.f, 0.f, 0.f}; }
            f32x4 up0[2], dn3[2];
#pragma unroll
            for (int n = 0; n < 2; ++n)
#pragma unroll
                for (int e = 0; e < 4; ++e) { up0[n][e] = dpp_shr1_old(xp[n][e], acc[ai][0][3][n][e]); dn3[n][e] = dpp_shl1_old(xn[n][e], acc[ai][0][0][n][e]); }
#pragma unroll
            for (int m = 0; m < 4; ++m) { u32x4 ow;
#pragma unroll
                for (int n = 0; n < 2; ++n) {
                    const f32x4 g = acc[ai][0][m][n], pv = m > 0 ? acc[ai][0][m > 0 ? m - 1 : 0][n] : up0[n], nx = m < 3 ? acc[ai][0][m < 3 ? m + 1 : 3][n] : dn3[n];
                    const f32x4 x = w0[n] * pv + w1[n] * g + w2[n] * nx + bb[n]; f32x4 t, o;
#pragma unroll
                    for (int e = 0; e < 4; ++e) t[e] = __expf(-x[e]);
                    t = t + 1.f;
#pragma unroll
                    for (int e = 0; e < 4; ++e) t[e] = __builtin_amdgcn_rcpf(t[e]);
                    o = x * t * acc[ai][1][m][n];
                    if (n == 0) { ow.x = pk2(o[0], o[1]); ow.y = pk2(o[2], o[3]); } else { ow.z = pk2(o[0], o[1]); ow.w = pk2(o[2], o[3]); } }
                bf16_t* dst = ACT + (rowb + (unsigned)(ai * HALF + m) * DFF);
                if (ai == 0 ? m < 2 : m >= 2) {
                    const int r = ai * HALF + wr * 64 + 4 * fr + m;
                    if (r != 0 && r != 255) *(u32x4*)dst = ow;
                    const int slot = r == 0 ? 0 : r == 1 ? 1 : r == 254 ? 2 : r == 255 ? 3 : -1;
                    if (slot >= 0) { float* sp = SIDE + ((size_t)u.pm * 6 + slot) * DFF + c0; *(f32x4*)sp = acc[ai][0][m][0]; *(f32x4*)(sp + 4) = acc[ai][0][m][1];
                        if (slot == 0 || slot == 3) { float* vp = SIDE + ((size_t)u.pm * 6 + (slot == 0 ? 4 : 5)) * DFF + c0; *(f32x4*)vp = acc[ai][1][m][0]; *(f32x4*)(vp + 4) = acc[ai][1][m][1]; } }
                } else *(u32x4*)dst = ow;
            }
        }
    }
};
template <class Epi, class Sched, bool ALIGN_EPI = false, bool SP2 = false>
__device__ __forceinline__ void gemm_phase(PG8_LAS unsigned char* lds, const Gemm g, const Sched& S, const Epi& E) {
    int tid_ = threadIdx.x; asm volatile("" : "+v"(tid_));
    const int tid = tid_, wid = __builtin_amdgcn_readfirstlane(tid >> 6), lane = tid & 63, wr = wid >> 2, wc = wid & 3, fr = lane & 15, fq = lane >> 4;
    const int K = g.ld, nt = g.K / BK;
    unsigned voffA[2], voffB[2];
#pragma unroll
    for (int i = 0; i < 2; ++i) { int R, C; stage_rc(tid * 16 + i * 8192, R, C); const int Rb = Epi::PERM ? ((R & ~31) + perm32(R & 31)) : R;
        const int Ra = Epi::PERMA ? ((R & ~63) | ((R & 15) << 2) | ((R >> 4) & 3)) : R;
        voffA[i] = (unsigned)(Ra * K + C) * 2u; voffB[i] = (unsigned)(Rb * K + C) * 2u; }
    const size_t kstep = (size_t)(BK * 2);
    const size_t hstep = (size_t)HALF * K * 2;
    const size_t tstep = 2 * hstep;
    const unsigned ldsw = (unsigned)wid * 1024u;
    const int aoff = lds_byte(wr * 64 + fr, fq * 8), boff = lds_byte(wc * 32 + fr, fq * 8);
#define PG8_SA(b, h) (((b) * 2 + (h)) * HTB)
#define PG8_SB(b, h) ((4 + (b) * 2 + (h)) * HTB)
#define PG8_STAGE(bufoff, gbase, voff) do { _Pragma("unroll") for (int _i = 0; _i < 2; ++_i) \
        __builtin_amdgcn_global_load_lds((const unsigned*)((const char*)(gbase) + (voff)[_i]), (PG8_LAS unsigned*)(lds + (bufoff) + ldsw + _i * 8192), 16, 0, 0); } while (0)
#define PG8_LDA(dst, b, h) do { _Pragma("unroll") for (int m = 0; m < 4; ++m) _Pragma("unroll") for (int k = 0; k < 2; ++k) dst[m][k] = *(const PG8_LAS bf16x8*)(lds + PG8_SA(b, h) + aoff + m * 2048 + k * 1024); } while (0)
#define PG8_LDB(dst, b, h) do { _Pragma("unroll") for (int n = 0; n < 2; ++n) _Pragma("unroll") for (int k = 0; k < 2; ++k) dst[n][k] = *(const PG8_LAS bf16x8*)(lds + PG8_SB(b, h) + boff + n * 2048 + k * 1024); } while (0)
#define PG8_MMA(ai, bj, At, Bt) do { __builtin_amdgcn_s_setprio(1); _Pragma("unroll") for (int m = 0; m < 4; ++m) _Pragma("unroll") for (int n = 0; n < 2; ++n) _Pragma("unroll") for (int k = 0; k < 2; ++k) \
        acc[ai][bj][m][n] = __builtin_amdgcn_mfma_f32_16x16x32_bf16(Bt[n][k], At[m][k], acc[ai][bj][m][n], 0, 0, 0); __builtin_amdgcn_s_setprio(0); } while (0)
#define PG8_WAIT_V(n) asm volatile("s_waitcnt vmcnt(" #n ")" ::: "memory")
#define PG8_WAIT_L(n) asm volatile("s_waitcnt lgkmcnt(" #n ")" ::: "memory")
#define PG8_BAR __builtin_amdgcn_s_barrier()
#define PG8_SCHED __builtin_amdgcn_sched_barrier(0)
    Unit cur, nxt; int ui = 0;
    if (!S.next(0, cur)) return;
    f32x4 acc[2][2][4][2];
#pragma unroll
    for (int a = 0; a < 2; ++a)
#pragma unroll
        for (int b = 0; b < 2; ++b)
#pragma unroll
            for (int m = 0; m < 4; ++m)
#pragma unroll
                for (int n = 0; n < 2; ++n) acc[a][b][m][n] = (f32x4){0.f, 0.f, 0.f, 0.f};
    bf16x8 At[4][2], B0[2][2], B1[2][2];
    const size_t sstep = (size_t)g.K * 2;
    const char* cA = (const char*)g.A + (size_t)cur.pm * tstep + (size_t)cur.kk * sstep; const char* cB = (const char*)g.Bt + (size_t)cur.pn * tstep + (size_t)cur.kk * sstep;
    S.a_ready(cur);
    if constexpr (SP2) {
        PG8_STAGE(PG8_SB(0, 0), cB, voffB); PG8_STAGE(PG8_SB(0, 1), cB + hstep, voffB); PG8_STAGE(PG8_SA(0, 0), cA, voffA); PG8_STAGE(PG8_SA(0, 1), cA + hstep, voffA);
        if (wr == 1) PG8_BAR;
        PG8_WAIT_V(2); PG8_BAR;
        PG8_STAGE(PG8_SB(1, 0), cB + kstep, voffB); PG8_STAGE(PG8_SA(1, 0), cA + kstep, voffA); PG8_STAGE(PG8_SB(1, 1), cB + hstep + kstep, voffB);
        PG8_WAIT_V(6); PG8_BAR;
    } else {
        PG8_STAGE(PG8_SB(0, 0), cB, voffB); PG8_STAGE(PG8_SA(0, 0), cA, voffA); PG8_STAGE(PG8_SB(0, 1), cB + hstep, voffB); PG8_STAGE(PG8_SA(0, 1), cA + hstep, voffA);
        if (wr == 1) PG8_BAR;
        PG8_WAIT_V(4); PG8_BAR;
        PG8_STAGE(PG8_SB(1, 0), cB + kstep, voffB); PG8_STAGE(PG8_SA(1, 0), cA + kstep, voffA); PG8_STAGE(PG8_SB(1, 1), cB + hstep + kstep, voffB);
        PG8_WAIT_V(6); PG8_BAR;
    }
    for (;;) {
        const bool has_next = S.next(ui + 1, nxt);
        const char* nA = has_next ? (const char*)g.A + (size_t)nxt.pm * tstep + (size_t)nxt.kk * sstep : cA; const char* nB = has_next ? (const char*)g.Bt + (size_t)nxt.pn * tstep + (size_t)nxt.kk * sstep : cB;
        for (int t = 0; t < nt; t += 2) {
            const bool last = (t == nt - 2);
            const char* a1 = cA + (size_t)(t + 1) * kstep;
            const char* a2 = last ? nA : cA + (size_t)(t + 2) * kstep; const char* b2 = last ? nB : cB + (size_t)(t + 2) * kstep;
            const char* a3 = a2 + kstep; const char* b3 = b2 + kstep;
            if (last && has_next) S.a_ready(nxt);
            if constexpr (SP2) {
            PG8_LDB(B0, 0, 0); PG8_LDB(B1, 0, 1); PG8_SCHED; PG8_LDA(At, 0, 0); PG8_STAGE(PG8_SA(1, 1), a1 + hstep, voffA);
            PG8_WAIT_V(8); PG8_WAIT_L(0); PG8_BAR; PG8_MMA(0, 0, At, B0); PG8_MMA(0, 1, At, B1); PG8_BAR; PG8_SCHED;
            PG8_LDA(At, 0, 1); PG8_STAGE(PG8_SB(0, 0), b2, voffB); PG8_STAGE(PG8_SB(0, 1), b2 + hstep, voffB); PG8_STAGE(PG8_SA(0, 0), a2, voffA);
            PG8_WAIT_V(8); PG8_WAIT_L(0); PG8_BAR; PG8_MMA(1, 0, At, B0); PG8_MMA(1, 1, At, B1); PG8_BAR; PG8_SCHED;
            PG8_LDB(B0, 1, 0); PG8_LDB(B1, 1, 1); PG8_SCHED; PG8_LDA(At, 1, 0); PG8_STAGE(PG8_SA(0, 1), a2 + hstep, voffA);
            PG8_WAIT_V(8); PG8_WAIT_L(0); PG8_BAR; PG8_MMA(0, 0, At, B0); PG8_MMA(0, 1, At, B1); PG8_BAR; PG8_SCHED;
            PG8_LDA(At, 1, 1); PG8_STAGE(PG8_SB(1, 0), b3, voffB); PG8_STAGE(PG8_SB(1, 1), b3 + hstep, voffB); PG8_STAGE(PG8_SA(1, 0), a3, voffA);
            PG8_WAIT_V(8); PG8_WAIT_L(0); PG8_BAR; PG8_MMA(1, 0, At, B0); PG8_MMA(1, 1, At, B1); PG8_BAR; PG8_SCHED;
            } else {
            PG8_LDB(B0, 0, 0); PG8_SCHED; PG8_LDA(At, 0, 0); PG8_STAGE(PG8_SA(1, 1), a1 + hstep, voffA);
            PG8_WAIT_L(8); PG8_BAR; PG8_WAIT_L(0); PG8_MMA(0, 0, At, B0); PG8_BAR; PG8_SCHED;
            PG8_LDB(B1, 0, 1); PG8_STAGE(PG8_SB(0, 0), b2, voffB);
            PG8_BAR; PG8_WAIT_L(0); PG8_MMA(0, 1, At, B1); PG8_BAR;
            PG8_LDA(At, 0, 1); PG8_STAGE(PG8_SA(0, 0), a2, voffA);
            PG8_BAR; PG8_WAIT_L(0); PG8_MMA(1, 0, At, B0); PG8_BAR; PG8_SCHED;
            PG8_STAGE(PG8_SB(0, 1), b2 + hstep, voffB);
            PG8_WAIT_V(6); PG8_BAR; PG8_MMA(1, 1, At, B1); PG8_BAR;
            PG8_LDB(B0, 1, 0); PG8_SCHED; PG8_LDA(At, 1, 0); PG8_STAGE(PG8_SA(0, 1), a2 + hstep, voffA);
            PG8_WAIT_L(8); PG8_BAR; PG8_WAIT_L(0); PG8_MMA(0, 0, At, B0); PG8_BAR; PG8_SCHED;
            PG8_LDB(B1, 1, 1); PG8_STAGE(PG8_SB(1, 0), b3, voffB);
            PG8_BAR; PG8_WAIT_L(0); PG8_MMA(0, 1, At, B1); PG8_BAR;
            PG8_LDA(At, 1, 1); PG8_STAGE(PG8_SA(1, 0), a3, voffA);
            PG8_BAR; PG8_WAIT_L(0); PG8_MMA(1, 0, At, B0); PG8_BAR; PG8_SCHED;
            PG8_STAGE(PG8_SB(1, 1), b3 + hstep, voffB);
            PG8_WAIT_V(6); PG8_BAR; PG8_MMA(1, 1, At, B1); PG8_BAR;
            }
        }
        if constexpr (ALIGN_EPI) { if (wr == 0) PG8_BAR; }
        if constexpr (!Epi::AFTER_DRAIN) { E(acc, cur, wr, wc, fr, fq); S.done(cur); }
        if (!has_next) break;
#pragma unroll
        for (int a = 0; a < 2; ++a)
#pragma unroll
            for (int b = 0; b < 2; ++b)
#pragma unroll
                for (int m = 0; m < 4; ++m)
#pragma unroll
                    for (int n = 0; n < 2; ++n) acc[a][b][m][n] = (f32x4){0.f, 0.f, 0.f, 0.f};
        cur = nxt; cA = nA; cB = nB; ++ui;
        if constexpr (ALIGN_EPI) { if (wr == 1) PG8_BAR; }
    }
    PG8_WAIT_V(0);
    if constexpr (!ALIGN_EPI) { if (wr == 0) PG8_BAR; }
    PG8_BAR;
    if constexpr (Epi::AFTER_DRAIN) { E.fused(acc, cur, wr, wc, fr, fq, lds, wid, lane); S.done(cur); }
#undef PG8_SA
#undef PG8_SB
#undef PG8_STAGE
#undef PG8_LDA
#undef PG8_LDB
#undef PG8_MMA
#undef PG8_WAIT_V
#undef PG8_WAIT_L
#undef PG8_BAR
#undef PG8_SCHED
}
}
#define XB_TMO      128
#define XB_XCNT(j)  (256  + 64 * (j))
#define XB_XSUB(j)  (1280 + 64 * (j))
#define XB_XGEN(j)  (2304 + 64 * (j))
#define XB_TOP      3328
#define XB_TOPGEN   3392
#define XCD_BAR_WORDS 3456
#define XB_SPIN_CAP (1u << 21)

__device__ __forceinline__ unsigned xb_ld(unsigned* p)              { return __hip_atomic_load(p, __ATOMIC_RELAXED, __HIP_MEMORY_SCOPE_AGENT); }
__device__ __forceinline__ unsigned xb_add(unsigned* p, unsigned v) { return __hip_atomic_fetch_add(p, v, __ATOMIC_RELAXED, __HIP_MEMORY_SCOPE_AGENT); }
__device__ __forceinline__ unsigned xb_xcc_id() { return (unsigned)__builtin_amdgcn_s_getreg((3 << 11) | 20) & 0xFu; }
#define XB_SPIN(cond, bar) do { unsigned _sp = 0; while (cond) { __builtin_amdgcn_s_sleep(1); \
    if ((++_sp & 255u) == 0u) { if (xb_ld(&(bar)[XB_TMO])) break; if (_sp > XB_SPIN_CAP) { atomicAdd(&(bar)[XB_TMO], 1u); break; } } } } while (0)

struct XcdBarrier {
    unsigned* bar; unsigned x;
    volatile LAS unsigned* st;
};

__device__ __forceinline__ XcdBarrier xcd_barrier_post(unsigned* bar, volatile LAS unsigned* st) {
    XcdBarrier b; b.bar = bar; b.x = (unsigned)__builtin_amdgcn_readfirstlane((int)xb_xcc_id()); b.st = st;
    if (threadIdx.x == 0) (void)xb_add(&bar[XB_XCNT(b.x)], 1u);
    return b;
}
__device__ __forceinline__ void xcd_barrier_complete(unsigned* bar, unsigned x, unsigned& nloc, unsigned& nx) {
    const unsigned G = gridDim.x * gridDim.y * gridDim.z;
    unsigned sum, cnt, mine, sp = 0u;
    for (;;) {
        sum = 0u; cnt = 0u; mine = 0u;
#pragma unroll
        for (unsigned j = 0; j < 16; ++j) { const unsigned c = xb_ld(&bar[XB_XCNT(j)]); sum += c; cnt += (c > 0u) ? 1u : 0u; }
        mine = xb_ld(&bar[XB_XCNT(x)]);
        if (sum == G) { mine = xb_ld(&bar[XB_XCNT(x)]); break; }
        __builtin_amdgcn_s_sleep(1);
        if ((++sp & 255u) == 0u) { if (xb_ld(&bar[XB_TMO])) break; if (sp > XB_SPIN_CAP) { atomicAdd(&bar[XB_TMO], 1u); break; } }
    }
    nloc = mine > 0u ? mine : 1u; nx = cnt > 0u ? cnt : 1u;
}

__device__ __forceinline__ void xcd_barrier(const XcdBarrier& b) {
    asm volatile("s_waitcnt vmcnt(0)" ::: "memory");
    __syncthreads();
    if (threadIdx.x == 0) {
        unsigned* bar = b.bar; unsigned bx_ = b.x;
        asm volatile("" : "+s"(bx_));
        __builtin_amdgcn_s_waitcnt(0);
        unsigned nloc = b.st[0], nx = b.st[1];
        if (nloc == 0u) { xcd_barrier_complete(bar, bx_, nloc, nx); b.st[0] = nloc; b.st[1] = nx; }
        const unsigned old = xb_add(&bar[XB_XSUB(bx_)], 1u);
        const unsigned gen = old / nloc;
        if (old + 1u == (gen + 1u) * nloc) {
            __builtin_amdgcn_fence(__ATOMIC_RELEASE, "agent");
            asm volatile("s_waitcnt vmcnt(0)" ::: "memory");
            const unsigned og = xb_add(&bar[XB_TOP], 1u);
            const unsigned tg = og / nx;
            if (og + 1u == (tg + 1u) * nx) xb_add(&bar[XB_TOPGEN], 1u);
            else XB_SPIN(xb_ld(&bar[XB_TOPGEN]) == tg, bar);
            __builtin_amdgcn_fence(__ATOMIC_ACQUIRE, "agent");
            xb_add(&bar[XB_XGEN(bx_)], 1u);
            asm volatile("s_waitcnt vmcnt(0)" ::: "memory");
        } else {
            XB_SPIN(xb_ld(&bar[XB_XGEN(bx_)]) == gen, bar);
            __builtin_amdgcn_fence(__ATOMIC_ACQUIRE, "agent");
            asm volatile("s_waitcnt vmcnt(0)" ::: "memory");
        }
    }
    __syncthreads();
}

typedef unsigned short bf16_t;
typedef short bf16x8 __attribute__((ext_vector_type(8)));
typedef float f32x4 __attribute__((ext_vector_type(4)));
typedef unsigned u32x4 __attribute__((ext_vector_type(4)));
#define LDS_WAIT() asm volatile("s_waitcnt lgkmcnt(0)" ::: "memory")

struct Params {
    const float* in[19];
};
struct Frame {
    LAS unsigned char* lds;
    int tid, lane, wave, G, bx, vcu, gw, ngw;
};
__device__ __forceinline__ const float* uptr(const LAS unsigned long long* t, int k) {
    const unsigned long long v = t[k]; const unsigned lo = __builtin_amdgcn_readfirstlane((unsigned)v), hi = __builtin_amdgcn_readfirstlane((unsigned)(v >> 32));
    return (const float*)(const GAS float*)(((unsigned long long)hi << 32) | lo); }

template <class CMap>
__device__ __forceinline__ void transpose_load(float (&v)[32], const float* W, int Nsrc, const float* ks, int kb, int nb, int lane, CMap cmap) {
    const int k0 = 64 * kb, n0 = 32 * nb; const int sc = cmap(n0 + (lane & 31));
#pragma unroll
    for (int i = 0; i < 32; ++i) { const int kk = 2 * i + (lane >> 5); float x = 0.f; if (sc >= 0) x = W[(size_t)(k0 + kk) * Nsrc + sc]; if (ks) x *= ks[k0 + kk]; v[i] = x; }
}
__device__ __forceinline__ void transpose_store(const float (&v)[32], int K, bf16_t* WT, LAS float* scr, int kb, int nb, int lane) {
    const int k0 = 64 * kb, n0 = 32 * nb;
#pragma unroll
    for (int i = 0; i < 32; ++i) scr[(2 * i + (lane >> 5)) * 33 + (lane & 31)] = v[i];
    LDS_WAIT(); asm volatile("" ::: "memory");
    const int c = lane & 7;
#pragma unroll
    for (int j = 0; j < 4; ++j) { const int n = (lane >> 3) + 8 * j; const LAS float* s = scr + (8 * c) * 33 + n;
        u32x4 o; o.x = pk2(s[0 * 33], s[1 * 33]); o.y = pk2(s[2 * 33], s[3 * 33]); o.z = pk2(s[4 * 33], s[5 * 33]); o.w = pk2(s[6 * 33], s[7 * 33]);
        *(u32x4*)(WT + (size_t)(n0 + n) * K + k0 + 8 * c) = o; }
    LDS_WAIT(); asm volatile("" ::: "memory");
}
template <class CMap>
__device__ __forceinline__ void transpose_matrix(const Frame& F, const float* W, int K, int Nsrc, int Ndst, bf16_t* WT, const float* ks, LAS float* scr, CMap cmap) {
    const int nnb = Ndst / 32, items = (K / 64) * nnb;
    for (int it = F.gw; it < items; it += 2 * F.ngw) { const int it2 = it + F.ngw; float va[32], vb[32];
        transpose_load(va, W, Nsrc, ks, it / nnb, it % nnb, F.lane, cmap);
        if (it2 < items) transpose_load(vb, W, Nsrc, ks, it2 / nnb, it2 % nnb, F.lane, cmap);
        transpose_store(va, K, WT, scr, it / nnb, it % nnb, F.lane);
        if (it2 < items) transpose_store(vb, K, WT, scr, it2 / nnb, it2 % nnb, F.lane); }
}
__device__ __forceinline__ int rope_perm(int m) { const int g = m >> 3, j = m & 7; return j < 4 ? 4 * g + j : 32 + 4 * g + (j - 4); }
struct CMapIn { __device__ int operator()(int n) const {
    if (n < 4096) return n; if (n < 4608) return 4112 + (n - 4096); if (n < 4864) return 4624 + (n - 4608);
    if (n < 4928) return 4880 + rope_perm(n - 4864); if (n < 4944) return 4096 + (n - 4928); return -1; } };
struct CMapQ { __device__ int operator()(int n) const { const int h = n / 192, o = n % 192; return o < 128 ? n : h * 192 + 128 + rope_perm(o - 128); } };
struct CMapUp { __device__ int operator()(int n) const { const int pn = n >> 8, j = n & 255; return j < 128 ? 128 * pn + j : DFF + 128 * pn + (j - 128); } };
struct CMapId { __device__ int operator()(int n) const { return n; } };

__device__ __forceinline__ void convert_weights(const Frame& F, unsigned char* ws_, const LAS unsigned long long* pt, int l, size_t wo, int slot) {
    unsigned char* ws = ws_ + wo;
    LAS float* scr = (LAS float*)(F.lds + F.wave * 8448);
    if (slot != 1) {
        const float* w_in = uptr(pt, 3) + (size_t)l * DM * INC; const float* w_uq = uptr(pt, 8) + (size_t)l * 512 * NQ; const float* w_ukv = uptr(pt, 9) + (size_t)l * 256 * NKV;
        const float* w_out = uptr(pt, 10) + (size_t)l * DM * DM; const float* w_dn = uptr(pt, 16) + (size_t)l * DFF * DM;
        const float* qg = uptr(pt, 6) + (size_t)l * 512; const float* kvg = uptr(pt, 7) + (size_t)l * 256;
        transpose_matrix(F, w_in, DM, INC, NIN, (bf16_t*)(ws + WS_WIN), nullptr, scr, CMapIn());
        transpose_matrix(F, w_uq, 512, NQ, NQ, (bf16_t*)(ws + WS_WUQ), qg, scr, CMapQ());
        transpose_matrix(F, w_ukv, 256, NKV, NKV, (bf16_t*)(ws + WS_WUKV), kvg, scr, CMapId());
        transpose_matrix(F, w_out, DM, DM, DM, (bf16_t*)(ws + WS_WOUT), nullptr, scr, CMapId());
        transpose_matrix(F, w_dn, DFF, DM, DM, (bf16_t*)(ws + WS_WDN), nullptr, scr, CMapId());
    }
    if (slot != 0) { const float* w_up = uptr(pt, 13) + (size_t)l * DM * NUP;
        transpose_matrix(F, w_up, DM, NUP, NUP, (bf16_t*)(ws + WS_WUP), nullptr, scr, CMapUp()); }
}
__device__ __forceinline__ void prologue(const Frame& F, unsigned char* ws, const LAS unsigned long long* pt) {
    float* COS = (float*)(ws + WS_COS); float* SIN = (float*)(ws + WS_SIN);
    for (int i = F.bx * 512 + F.tid; i < 4112 * 32; i += F.G * 512) { const int pos = i >> 5, f = i & 31;
        const float inv = powf(10000.0f, -(float)(2 * f) / 64.0f); const float ang = (float)pos * inv; float s, c; sincosf(ang, &s, &c); COS[i] = c; SIN[i] = s; }
    { float* PAR = (float*)(ws + WS_PAR); const int gt = F.bx * 512 + F.tid, nt = F.G * 512;
      for (int i = gt; i < DEPTH * 16; i += nt) PAR[PO_BG + i] = uptr(pt, 4)[i];
      for (int i = gt; i < DEPTH * 1024; i += nt) PAR[PO_MLG + i] = uptr(pt, 5)[i];
      for (int i = gt; i < DEPTH * 512; i += nt) PAR[PO_QG + i] = uptr(pt, 6)[i];
      for (int i = gt; i < DEPTH * 256; i += nt) PAR[PO_KVG + i] = uptr(pt, 7)[i];
      for (int i = gt; i < 2048; i += nt) { PAR[PO_ONE + i] = 1.f; PAR[PO_ZERO + i] = 0.f; }
      { float* ST2 = (float*)(ws + WS_STAT2); for (int i = gt; i < TP; i += nt) { ST2[2 * i] = 0.f; ST2[2 * i + 1] = 1.f; } }
      for (int i = gt; i < DEPTH * 2048; i += nt) { PAR[PO_L1G + i] = uptr(pt, 11)[i]; PAR[PO_L1B + i] = uptr(pt, 12)[i]; PAR[PO_L2G + i] = uptr(pt, 17)[i]; PAR[PO_L2B + i] = uptr(pt, 18)[i]; }
      for (int i = gt; i < DEPTH * 3 * 5632; i += nt) PAR[PO_CW + i] = uptr(pt, 14)[i];
      for (int i = gt; i < DEPTH * 5632; i += nt) PAR[PO_CB + i] = uptr(pt, 15)[i]; }
    float* H = (float*)(ws + WS_H); bf16_t* HB = (bf16_t*)(ws + WS_HB);
    const float* xp = uptr(pt, 0); const float* xs = uptr(pt, 1); const float* mt = uptr(pt, 2);
    for (int row0 = F.gw; row0 < TP; row0 += 2 * F.ngw) {
        f32x4 v[2][8];
#pragma unroll
        for (int r = 0; r < 2; ++r) { const int row = row0 + r * F.ngw; const float* src = nullptr;
            if (row < 4 * LREAL) src = xp + (size_t)row * DM; else if (row < NMAIN) src = xs + (size_t)(row - 4 * LREAL) * DM; else if (row < NTOK) src = mt + (size_t)((row - NMAIN) & 15) * DM;
#pragma unroll
            for (int j = 0; j < 8; ++j) { v[r][j] = (f32x4){0.f, 0.f, 0.f, 0.f}; if (src) v[r][j] = ((const f32x4*)src)[F.lane + 64 * j]; } }
#pragma unroll
        for (int r = 0; r < 2; ++r) { const int row = row0 + r * F.ngw; if (row < TP) {
            f32x4* hd = (f32x4*)(H + (size_t)row * DM) + F.lane; u32x2* bd = (u32x2*)(HB + (size_t)row * DM) + F.lane; u32x2* hb = (u32x2*)((bf16_t*)H + (size_t)row * DM) + F.lane;
#pragma unroll
            for (int j = 0; j < 8; ++j) { const f32x4 x = v[r][j];
                u32x2 w; w.x = pk2(x[0], x[1]); w.y = pk2(x[2], x[3]); bd[64 * j] = w;
                if (row >= NMAIN) hd[64 * j] = x * ALPHA;
                else { u32x2 wh; wh.x = pk2h(x[0], x[1]); wh.y = pk2h(x[2], x[3]); hb[64 * j] = wh; } } } }
    }
}

__device__ __forceinline__ void ln_one(const f32x4 (&vin)[8], int row, int lane, float* __restrict__ Hw, bf16_t* __restrict__ HB, const float* __restrict__ g, const float* __restrict__ b, float* __restrict__ ST) {
    f32x4 v[8]; float s = 0.f;
#pragma unroll
    for (int j = 0; j < 8; ++j) { v[j] = vin[j]; s += (v[j][0] + v[j][1]) + (v[j][2] + v[j][3]); }
    const float mean = wave_sum(s) * (1.f / DM); float q = 0.f;
#pragma unroll
    for (int j = 0; j < 8; ++j) { v[j] = v[j] - mean; q += (v[j][0] * v[j][0] + v[j][1] * v[j][1]) + (v[j][2] * v[j][2] + v[j][3] * v[j][3]); }
    const float rstd = rsqrtf(wave_sum(q) * (1.f / DM) + EPS);
    if (lane == 0) { f32x2 ms = {mean, rstd}; *(f32x2*)(ST + (size_t)row * 2) = ms; }
    u32x2* bd = (u32x2*)(HB + (size_t)row * DM) + lane; f32x4* hp = (f32x4*)(Hw + (size_t)row * DM) + lane;
#pragma unroll
    for (int j = 0; j < 8; ++j) { const f32x4 gg = ((const f32x4*)g)[lane + 64 * j], bb = ((const f32x4*)b)[lane + 64 * j]; const f32x4 y = v[j] * rstd * gg + bb;
        u32x2 w; w.x = pk2(y[0], y[1]); w.y = pk2(y[2], y[3]); bd[64 * j] = w;
        hp[64 * j] = y * ALPHA; }
}
__device__ __forceinline__ void ln_one_bf(const u32x4 (&vin)[4], int row, int lane, bf16_t* __restrict__ HB, const float* __restrict__ g, const float* __restrict__ b, float* __restrict__ ST, float* __restrict__ out) {
    f32x4 v[8]; float s = 0.f;
#pragma unroll
    for (int j = 0; j < 4; ++j) { v[2 * j] = (f32x4){hf_lo(vin[j].x), hf_hi(vin[j].x), hf_lo(vin[j].y), hf_hi(vin[j].y)}; v[2 * j + 1] = (f32x4){hf_lo(vin[j].z), hf_hi(vin[j].z), hf_lo(vin[j].w), hf_hi(vin[j].w)}; }
#pragma unroll
    for (int j = 0; j < 8; ++j) s += (v[j][0] + v[j][1]) + (v[j][2] + v[j][3]);
    const float mean = wave_sum(s) * (1.f / DM); float q = 0.f;
#pragma unroll
    for (int j = 0; j < 8; ++j) { v[j] = v[j] - mean; q += (v[j][0] * v[j][0] + v[j][1] * v[j][1]) + (v[j][2] * v[j][2] + v[j][3] * v[j][3]); }
    const float rstd = rsqrtf(wave_sum(q) * (1.f / DM) + EPS);
    if (lane == 0) { f32x2 ms = {mean, rstd}; *(f32x2*)(ST + (size_t)row * 2) = ms; }
    u32x4* bd = (u32x4*)(HB + (size_t)row * DM) + lane;
#pragma unroll
    for (int j = 0; j < 4; ++j) { const int c4 = 2 * (lane + 64 * j);
        const f32x4 y0 = v[2 * j] * rstd * ((const f32x4*)g)[c4] + ((const f32x4*)b)[c4], y1 = v[2 * j + 1] * rstd * ((const f32x4*)g)[c4 + 1] + ((const f32x4*)b)[c4 + 1];
        if (out) { f32x4* op = (f32x4*)(out + (size_t)row * DM) + c4; op[0] = y0; op[1] = y1; }
        else bd[64 * j] = pg8::pack8(y0, y1); }
}
__device__ __forceinline__ void ln_rows(const Frame& F, float* H, bf16_t* HB, const float* g, const float* b, float* ST, float* out, const float* PART, int nk) {
    const bf16_t* __restrict__ Hr = (const bf16_t*)H;
    for (int row = F.gw; row < NMAIN; row += 2 * F.ngw) {
        const int row2 = row + F.ngw;
        u32x4 va[4], vb[4];
#pragma unroll
        for (int j = 0; j < 4; ++j) va[j] = ((const u32x4*)(Hr + (size_t)row * DM))[F.lane + 64 * j];
#pragma unroll
        for (int j = 0; j < 4; ++j) vb[j] = ((const u32x4*)(Hr + (size_t)row2 * DM))[F.lane + 64 * j];
        ln_one_bf(va, row, F.lane, HB, g, b, ST, out);
        ln_one_bf(vb, row2, F.lane, HB, g, b, ST, out);
    }
    if (F.gw < TP - NMAIN) {
        const int row = NMAIN + F.gw; const float* __restrict__ Hm = H; f32x4 va[8];
#pragma unroll
        for (int j = 0; j < 8; ++j) va[j] = ((const f32x4*)(Hm + (size_t)row * DM))[F.lane + 64 * j];
        for (int k = 0; k < nk; ++k) {
            const float* __restrict__ pp = PART + ((size_t)k * 256 + F.gw) * DM;
#pragma unroll
            for (int j = 0; j < 8; ++j) va[j] += ((const f32x4*)pp)[F.lane + 64 * j]; }
        ln_one(va, row, F.lane, H, HB, g, b, ST);
    }
}

__device__ __forceinline__ void rstd_rows(const Frame& F, const bf16_t* UDQ, const bf16_t* UDKV, float* RSTD) {
    for (int row = F.gw; row < TP; row += F.ngw) {
        const u32x4 a = ((const u32x4*)(UDQ + (size_t)row * 512))[F.lane]; float s = 0.f;
#pragma unroll
        for (int j = 0; j < 4; ++j) { const float x = bf_lo(a[j]), y = bf_hi(a[j]); s += x * x + y * y; }
        float t = 0.f;
        if (F.lane < 32) { const u32x4 c = ((const u32x4*)(UDKV + (size_t)row * 256))[F.lane];
#pragma unroll
            for (int j = 0; j < 4; ++j) { const float x = bf_lo(c[j]), y = bf_hi(c[j]); t += x * x + y * y; } }
        s = wave_sum(s); t = wave_sum(t);
        if (F.lane == 0) { RSTD[(size_t)row * 2] = rsqrtf(s * (1.f / 512.f) + EPS); RSTD[(size_t)row * 2 + 1] = rsqrtf(t * (1.f / 256.f) + EPS); }
    }
}

__device__ __forceinline__ void mlstm_finalize(const Frame& F, int gw0, int ngw0, const float* HSUM, const bf16_t* UQKVO, const float* ng, bf16_t* MIX) {
    for (int row = gw0; row < TP; row += ngw0) {
#pragma unroll
        for (int j = 0; j < 4; ++j) {
            f32x4 v = ((const f32x4*)(HSUM + (size_t)row * MLW + 256 * j))[F.lane];
            const float mean = wave_sum((v[0] + v[1]) + (v[2] + v[3])) * (1.f / 256.f); v = v - mean;
            const float rstd = rsqrtf(wave_sum((v[0] * v[0] + v[1] * v[1]) + (v[2] * v[2] + v[3] * v[3])) * (1.f / 256.f) + EPS);
            const f32x4 gg = ((const f32x4*)(ng + 256 * j))[F.lane];
            const u32x2 uo = ((const u32x2*)(UQKVO + (size_t)row * 4096 + 3072 + 256 * j))[F.lane];
            const float o0 = bf_lo(uo.x), o1 = bf_hi(uo.x), o2 = bf_lo(uo.y), o3 = bf_hi(uo.y);
            const float y0 = v[0] * rstd * gg[0] / (1.f + __expf(-o0)), y1 = v[1] * rstd * gg[1] / (1.f + __expf(-o1));
            const float y2 = v[2] * rstd * gg[2] / (1.f + __expf(-o2)), y3 = v[3] * rstd * gg[3] / (1.f + __expf(-o3));
            u32x2 w; w.x = pk2(y0, y1); w.y = pk2(y2, y3); ((u32x2*)(MIX + (size_t)row * DM + 256 * j))[F.lane] = w;
        }
    }
}

__device__ __forceinline__ f32x8 ld8f(const float* p) { const f32x4 a = *(const f32x4*)p, b = *(const f32x4*)(p + 4); return (f32x8){a[0], a[1], a[2], a[3], b[0], b[1], b[2], b[3]}; }
__device__ __forceinline__ f32x8 ld8b(const bf16_t* p) { const u32x4 v = *(const u32x4*)p; return (f32x8){bf_lo(v[0]), bf_hi(v[0]), bf_lo(v[1]), bf_hi(v[1]), bf_lo(v[2]), bf_hi(v[2]), bf_lo(v[3]), bf_hi(v[3])}; }
__device__ __forceinline__ void act_store(bf16_t* dst, const f32x8 gp, const f32x8 gc, const f32x8 gn, const f32x8 vv, const f32x8 w0, const f32x8 w1, const f32x8 w2, const f32x8 bb) {
    float o[8];
#pragma unroll
    for (int i = 0; i < 8; ++i) { const float x = w0[i] * gp[i] + w1[i] * gc[i] + w2[i] * gn[i] + bb[i]; o[i] = x / (1.f + __expf(-x)) * vv[i]; }
    u32x4 w; w.x = pk2(o[0], o[1]); w.y = pk2(o[2], o[3]); w.z = pk2(o[4], o[5]); w.w = pk2(o[6], o[7]); *(u32x4*)dst = w;
}
__device__ __forceinline__ void ffn_fixup(const Frame& F, const float* SIDE, const bf16_t* GVM, bf16_t* ACT, const float* cw, const float* cb) {
    constexpr int NCH = DFF / 8;
    const f32x8 zero = {0.f, 0.f, 0.f, 0.f, 0.f, 0.f, 0.f, 0.f};
    const int gt = F.bx * 512 + F.tid, nt = GRID * 512;
    for (int idx = gt; idx < 192 * 2 * NCH; idx += nt) {
        const int ch = idx % NCH, rsel = (idx / NCH) & 1, pm = idx / (2 * NCH), c0 = 8 * ch, sq = pm >> 4;
        const f32x8 w0 = ld8f(cw + c0), w1 = ld8f(cw + DFF + c0), w2 = ld8f(cw + 2 * DFF + c0), bb = ld8f(cb + c0);
        const float* S0 = SIDE + (size_t)pm * 6 * DFF + c0;
        if (rsel == 0) { const f32x8 gp = (pm & 15) ? ld8f(S0 - 6 * DFF + 3 * DFF) : ld8b(GVM + (size_t)(16 * sq + 15) * NUP + c0);
            act_store(ACT + (size_t)(pm * 256) * DFF + c0, gp, ld8f(S0), ld8f(S0 + DFF), ld8f(S0 + 4 * DFF), w0, w1, w2, bb);
        } else { const f32x8 gn = ((pm & 15) != 15) ? ld8f(S0 + 6 * DFF) : zero;
            act_store(ACT + (size_t)(pm * 256 + 255) * DFF + c0, ld8f(S0 + 2 * DFF), ld8f(S0 + 3 * DFF), gn, ld8f(S0 + 5 * DFF), w0, w1, w2, bb); }
    }
    for (int idx = gt; idx < NSEQ * 16 * NCH; idx += nt) {
        const int ch = idx % NCH, rp = idx / NCH, pp = rp & 15, sq = rp >> 4, c0 = 8 * ch;
        const f32x8 w0 = ld8f(cw + c0), w1 = ld8f(cw + DFF + c0), w2 = ld8f(cw + 2 * DFF + c0), bb = ld8f(cb + c0);
        const bf16_t* G0 = GVM + (size_t)(16 * sq + pp) * NUP + c0;
        const f32x8 gp = pp > 0 ? ld8b(G0 - NUP) : zero, gc = ld8b(G0);
        const f32x8 gn = pp < 15 ? ld8b(G0 + NUP) : ld8f(SIDE + (size_t)(16 * sq) * 6 * DFF + c0);
        act_store(ACT + (size_t)(MROW0 + 16 * sq + pp) * DFF + c0, gp, gc, gn, ld8b(G0 + DFF), w0, w1, w2, bb);
    }
}

namespace att {
constexpr int NW = 8, QBLK = 32, KVBLK = 64, NT = 65;
constexpr int KROW = 400;
constexpr int SHM_V = KVBLK * 128 * 2, SHM_K = KVBLK * KROW;
constexpr int OFF_V = 0, OFF_K = 3 * SHM_V, OFF_WS = OFF_K + 3 * SHM_K, LDS_TOTAL = OFF_WS + NW * 64 * 4;
static_assert(LDS_TOTAL <= RING_BYTES, "attention LDS");
constexpr float SCALE = 0.07216878364870323f;
constexpr float THR = 8.f;
#define SBAR() __builtin_amdgcn_sched_barrier(0)
__device__ __forceinline__ int crow(int r, int hi) { return (r & 3) + 8 * (r >> 2) + 4 * hi; }
__device__ __forceinline__ unsigned cvtpk(float lo, float hi) { unsigned r; asm volatile("v_cvt_pk_bf16_f32 %0, %1, %2" : "=v"(r) : "v"(lo), "v"(hi)); return r; }

template <bool MASK16>
__device__ __forceinline__ void partialSM(f32x16& p0, f32x16& p1, float& m_reg, float& mn, float& alpha) {
    constexpr float C = SCALE * 1.4426950408889634f;
    if (MASK16) {
#pragma unroll
        for (int r = 8; r < 16; ++r) p0[r] = NEGBIG;
#pragma unroll
        for (int r = 0; r < 16; ++r) p1[r] = NEGBIG;
    }
    float pmax = p0[0];
#pragma unroll
    for (int r = 1; r < 16; ++r) pmax = fmaxf(pmax, p0[r]);
#pragma unroll
    for (int r = 0; r < 16; ++r) pmax = fmaxf(pmax, p1[r]);
    { auto rr = __builtin_amdgcn_permlane32_swap(__float_as_uint(pmax), __float_as_uint(pmax), false, false); pmax = fmaxf(__uint_as_float(rr[0]), __uint_as_float(rr[1])); }
    if (__builtin_expect(__all(pmax - m_reg <= THR / SCALE), 1)) { mn = m_reg; alpha = 1.f; }
    else { mn = fmaxf(m_reg, pmax); alpha = __builtin_amdgcn_exp2f((m_reg - mn) * C); m_reg = mn; }
    const float mnC = -mn * C;
#pragma unroll
    for (int r = 0; r < 16; ++r) p0[r] = fmaf(p0[r], C, mnC);
#pragma unroll
    for (int r = 0; r < 16; ++r) p1[r] = fmaf(p1[r], C, mnC);
#pragma unroll
    for (int r = 0; r < 16; ++r) p0[r] = __builtin_amdgcn_exp2f(p0[r]);
}
__device__ __forceinline__ void finishSM(f32x16& p0, f32x16& p1, float alpha, float& l_reg, bf16x8& pa0, bf16x8& pa1, bf16x8& pa2, bf16x8& pa3) {
#pragma unroll
    for (int r = 0; r < 16; ++r) p1[r] = __builtin_amdgcn_exp2f(p1[r]);
    float ps = 0;
#pragma unroll
    for (int r = 0; r < 16; ++r) ps += p0[r];
#pragma unroll
    for (int r = 0; r < 16; ++r) ps += p1[r];
    { auto rr = __builtin_amdgcn_permlane32_swap(__float_as_uint(ps), __float_as_uint(ps), false, false); ps = __uint_as_float(rr[0]) + __uint_as_float(rr[1]); }
    l_reg = l_reg * alpha + ps;
#define PK4(P, BASE, OUT) do { unsigned a0 = cvtpk(P[BASE + 0], P[BASE + 1]), a1 = cvtpk(P[BASE + 2], P[BASE + 3]);   \
    unsigned b0 = cvtpk(P[BASE + 4], P[BASE + 5]), b1 = cvtpk(P[BASE + 6], P[BASE + 7]);                              \
    auto r0 = __builtin_amdgcn_permlane32_swap(a0, b0, false, false); auto r1 = __builtin_amdgcn_permlane32_swap(a1, b1, false, false); \
    u32x4 w = {r0[0], r1[0], r0[1], r1[1]}; OUT = __builtin_bit_cast(bf16x8, w); } while (0)
    PK4(p0, 0, pa0); PK4(p0, 8, pa1); PK4(p1, 0, pa2); PK4(p1, 8, pa3);
#undef PK4
}
__device__ __forceinline__ void qkt(f32x16& p0, f32x16& p1, const LAS char* Ks, const bf16x8* qr, int r32, int hi) {
#pragma unroll
    for (int r = 0; r < 16; ++r) { p0[r] = 0.f; p1[r] = 0.f; }
#pragma unroll
    for (int d0 = 0; d0 < 12; ++d0) { const int cb = (d0 * 16 + hi * 8) * 2;
        const bf16x8 b0 = *(const LAS bf16x8*)(Ks + r32 * KROW + cb);
        const bf16x8 b1 = *(const LAS bf16x8*)(Ks + (32 + r32) * KROW + cb);
        p0 = __builtin_amdgcn_mfma_f32_32x32x16_bf16(b0, qr[d0], p0, 0, 0, 0);
        p1 = __builtin_amdgcn_mfma_f32_32x32x16_bf16(b1, qr[d0], p1, 0, 0, 0); }
}
__device__ __forceinline__ int v_st(int k, int c) { const int kk = (k & ~0xC) | ((k & 4) << 1) | ((k & 8) >> 1); return ((kk >> 3) * 4 + (c >> 5)) * 512 + ((kk & 7) * 32 + (c & 31)) * 2; }
__device__ __forceinline__ int v_rd_base(int lane) { return ((lane & 3) << 3) | (((lane >> 2) & 3) << 6) | (((lane >> 4) & 1) << 5) | (((lane >> 5) & 1) << 8); }
constexpr int v_rd_off(int d0, int ks, int half) { return d0 * 512 + ks * 4096 + half * 2048; }
template <int OFF> __device__ __forceinline__ s16x4 tr_read(int vb) { s16x4 r; asm volatile("ds_read_b64_tr_b16 %0, %1 offset:%2" : "=&v"(r) : "v"(vb), "i"(OFF) : "memory"); return r; }
template <int D0> __device__ __forceinline__ void pv_one(f32x16& od, int vb, bf16x8 pa0, bf16x8 pa1, bf16x8 pa2, bf16x8 pa3) {
    const s16x4 l0 = tr_read<v_rd_off(D0, 0, 0)>(vb), h0 = tr_read<v_rd_off(D0, 0, 1)>(vb), l1 = tr_read<v_rd_off(D0, 1, 0)>(vb), h1 = tr_read<v_rd_off(D0, 1, 1)>(vb);
    const s16x4 l2 = tr_read<v_rd_off(D0, 2, 0)>(vb), h2 = tr_read<v_rd_off(D0, 2, 1)>(vb), l3 = tr_read<v_rd_off(D0, 3, 0)>(vb), h3 = tr_read<v_rd_off(D0, 3, 1)>(vb);
    asm volatile("s_waitcnt lgkmcnt(0)" ::: "memory"); SBAR();
#define PKV(L, H) (bf16x8){L[0], L[1], L[2], L[3], H[0], H[1], H[2], H[3]}
    od = __builtin_amdgcn_mfma_f32_32x32x16_bf16(pa0, PKV(l0, h0), od, 0, 0, 0);
    od = __builtin_amdgcn_mfma_f32_32x32x16_bf16(pa1, PKV(l1, h1), od, 0, 0, 0);
    od = __builtin_amdgcn_mfma_f32_32x32x16_bf16(pa2, PKV(l2, h2), od, 0, 0, 0);
    od = __builtin_amdgcn_mfma_f32_32x32x16_bf16(pa3, PKV(l3, h3), od, 0, 0, 0);
#undef PKV
}
__device__ __forceinline__ void pv_d0(f32x16* o, int vb, bf16x8 pa0, bf16x8 pa1, bf16x8 pa2, bf16x8 pa3) {
    pv_one<0>(o[0], vb, pa0, pa1, pa2, pa3); pv_one<1>(o[1], vb, pa0, pa1, pa2, pa3); pv_one<2>(o[2], vb, pa0, pa1, pa2, pa3); pv_one<3>(o[3], vb, pa0, pa1, pa2, pa3);
}

__device__ __forceinline__ void attn_unit(int s, int h, int qb, const bf16_t* __restrict__ MQ, const bf16_t* __restrict__ MKV, const bf16_t* __restrict__ KR, bf16_t* __restrict__ MIX, LAS char* lds) {
    int tid_ = threadIdx.x; asm volatile("" : "+v"(tid_));
    const int tid = tid_, wid = tid >> 6, lane = tid & 63, r32 = lane & 31, hi = lane >> 5;
    LAS char* V_lds = lds + OFF_V; LAS char* K_lds = lds + OFF_K;
    LAS float* wsf = (LAS float*)(lds + OFF_WS) + wid * 64; LAS float* li_l = wsf; LAS float* al_l = wsf + 32;
    float m_reg = NEGBIG, l_reg = 0; f32x16 o[4]; bf16x8 qr[12];
#pragma unroll
    for (int d = 0; d < 4; ++d)
#pragma unroll
        for (int r = 0; r < 16; ++r) o[d][r] = 0.f;
    const int qi = wid * QBLK + r32;
    const unsigned qrow = qb < 16 ? (unsigned)s * LREAL + 256 * qb + qi : (unsigned)MROW0 + 16 * s + (qi < 15 ? qi : 15);
    { const bf16_t* Qw = MQ + (qrow * NQ + h * 192 + hi * 8);
#pragma unroll
      for (int d0 = 0; d0 < 12; ++d0) qr[d0] = *(const bf16x8*)(Qw + d0 * 16); }
    const int sr = tid >> 4, sc = (tid & 15) * 8, vst0 = v_st(sr, sc), vst1 = v_st(32 + sr, sc);
    const int kr_r = tid >> 3, kr_c = (tid & 7) * 8;
    const int vb0 = (int)(uintptr_t)V_lds + v_rd_base(lane);
    bf16x8 vs0, vs1, ks0, ks1, kr0;
    const unsigned mainrow0 = (unsigned)s * LREAL, metarow0 = (unsigned)MROW0 + 16 * s;
    const bf16_t* MKVh = MKV + h * 256;
#define KROWG(kt, k) ((kt) < 64 ? mainrow0 + 64u * (kt) + (k) : metarow0 + ((k) < 15 ? (k) : 15))
#define SLOAD(kt) do { const unsigned g0 = KROWG(kt, sr) * NKV + sc, g1 = KROWG(kt, 32 + sr) * NKV + sc, g2 = KROWG(kt, kr_r) * 64 + kr_c; \
    vs0 = *(const bf16x8*)(MKVh + 128 + g0); vs1 = *(const bf16x8*)(MKVh + 128 + g1); \
    ks0 = *(const bf16x8*)(MKVh + g0); ks1 = *(const bf16x8*)(MKVh + g1); kr0 = *(const bf16x8*)(KR + g2); } while (0)
#define SWRITE(b) do { *(LAS bf16x8*)(V_lds + (b) * SHM_V + vst0) = vs0; *(LAS bf16x8*)(V_lds + (b) * SHM_V + vst1) = vs1; \
    *(LAS bf16x8*)(K_lds + (b) * SHM_K + sr * KROW + sc * 2) = ks0; *(LAS bf16x8*)(K_lds + (b) * SHM_K + (32 + sr) * KROW + sc * 2) = ks1; \
    *(LAS bf16x8*)(K_lds + (b) * SHM_K + kr_r * KROW + 256 + kr_c * 2) = kr0; } while (0)
#define RESC(a) do { if (__any((a) < 1.f)) { if (hi == 0) al_l[r32] = (a); asm volatile("s_waitcnt lgkmcnt(0)" ::: "memory"); \
    _Pragma("unroll") for (int d = 0; d < 4; ++d) _Pragma("unroll") for (int r = 0; r < 16; ++r) o[d][r] *= al_l[crow(r, hi)]; } } while (0)
    f32x16 pA0, pA1, pB0, pB1; float mnA, mnB, alA, alB; bf16x8 pa0, pa1, pa2, pa3;
    __syncthreads();
    SLOAD(0); SWRITE(0); __syncthreads();
    qkt(pA0, pA1, K_lds, qr, r32, hi); partialSM<false>(pA0, pA1, m_reg, mnA, alA);
    SLOAD(1); SWRITE(1); __syncthreads();
    RESC(alA);
    int s0 = 0, s1 = 1, s2 = 2;
    for (int j = 1; j + 1 < NT; j += 2) {
        SBAR(); qkt(pB0, pB1, K_lds + s1 * SHM_K, qr, r32, hi);
        finishSM(pA0, pA1, alA, l_reg, pa0, pa1, pa2, pa3); SBAR();
        SLOAD(j + 1); SBAR();
        pv_d0(o, vb0 + s0 * SHM_V, pa0, pa1, pa2, pa3); partialSM<false>(pB0, pB1, m_reg, mnB, alB);
        SWRITE(s2);
        RESC(alB); __syncthreads();
        SBAR(); qkt(pA0, pA1, K_lds + s2 * SHM_K, qr, r32, hi);
        finishSM(pB0, pB1, alB, l_reg, pa0, pa1, pa2, pa3); SBAR();
        if (j + 2 < NT) SLOAD(j + 2); SBAR();
        pv_d0(o, vb0 + s1 * SHM_V, pa0, pa1, pa2, pa3);
        if (j + 1 == NT - 1) partialSM<true>(pA0, pA1, m_reg, mnA, alA); else partialSM<false>(pA0, pA1, m_reg, mnA, alA);
        if (j + 2 < NT) SWRITE(s0);
        RESC(alA); __syncthreads();
        { const int t0 = s0, t1 = s1; s0 = s2; s1 = t0; s2 = t1; }
    }
    finishSM(pA0, pA1, alA, l_reg, pa0, pa1, pa2, pa3); SBAR();
    pv_d0(o, vb0 + s0 * SHM_V, pa0, pa1, pa2, pa3);
    if (hi == 0) li_l[r32] = l_reg; asm volatile("s_waitcnt lgkmcnt(0)" ::: "memory");
    float rli[16];
#pragma unroll
    for (int r = 0; r < 16; ++r) rli[r] = __builtin_amdgcn_rcpf(li_l[crow(r, hi)]);
    if (qb < 16) {
        bf16_t* Ow = MIX + ((long)s * LREAL + 256 * qb + wid * QBLK) * DM + MLW + h * 128;
#pragma unroll
        for (int r = 0; r < 16; ++r) { const int orow = crow(r, hi);
#pragma unroll
            for (int d0 = 0; d0 < 4; ++d0) Ow[(long)orow * DM + d0 * 32 + r32] = (bf16_t)(pk2(o[d0][r] * rli[r], 0.f) & 0xffffu); }
    } else if (wid == 0) {
        bf16_t* Ow = MIX + ((long)MROW0 + 16 * s) * DM + MLW + h * 128;
#pragma unroll
        for (int r = 0; r < 16; ++r) { const int orow = crow(r, hi);
            if (orow < 16) {
#pragma unroll
                for (int d0 = 0; d0 < 4; ++d0) Ow[(long)orow * DM + d0 * 32 + r32] = (bf16_t)(pk2(o[d0][r] * rli[r], 0.f) & 0xffffu); } }
    }
#undef KROWG
#undef SLOAD
#undef SWRITE
#undef RESC
}
__device__ __forceinline__ void attn_phase(int vcu, const bf16_t* MQ, const bf16_t* MKV, const bf16_t* KR, bf16_t* MIX, LAS char* lds) {
    for (int i = (vcu < 96 ? -1 : 0); i < 6; ++i) { int sh, qb; if (i < 0) { sh = vcu; qb = 16; } else { const int id = i * GRID + vcu; sh = id >> 4; qb = id & 15; }
        attn_unit(sh >> 3, sh & 7, qb, MQ, MKV, KR, MIX, lds); }
}
#undef SBAR
}

namespace ml {
constexpr int QI = 0, KI = 32768, VI = 65536, SI = 81920, CI = 98304;
constexpr int SC_CT = 0, SC_BM = 64, SC_WI = 128, SC_EI = 192, SC_WW = 256, SC_DEN = 320, SC_QN = 448, SC_N = 512, SC_A = 768;
constexpr int GP_REC = 200;
__device__ __forceinline__ unsigned off_b(unsigned row, unsigned ch) { return 256u * row + 16u * (ch ^ (((row & 3) << 2) | ((row >> 2) & 3))); }
__device__ __forceinline__ unsigned row_read_addr_16(unsigned lane, unsigned rb, unsigned s) { return off_b((lane & 15) + 16 * rb, 4 * s + (lane >> 4)); }
__device__ __forceinline__ unsigned tr_read_addr_16(unsigned lane, unsigned c, unsigned ks, unsigned t) {
    const unsigned g = lane >> 4, q = (lane & 15) >> 2, p = lane & 3; return off_b(32 * ks + 8 * g + 4 * t + q, 2 * c + (p >> 1)) + 8 * (p & 1); }
__device__ __forceinline__ bf16x8 tr_frag(unsigned a0, unsigned a1) {
    const s16x4 lo = __builtin_amdgcn_ds_read_tr16_b64_v4i16((LAS s16x4*)a0), hi = __builtin_amdgcn_ds_read_tr16_b64_v4i16((LAS s16x4*)a1);
    return (bf16x8){lo[0], lo[1], lo[2], lo[3], hi[0], hi[1], hi[2], hi[3]};
}
__device__ __forceinline__ f32x4 mfma16(bf16x8 a, bf16x8 b, f32x4 c) { return __builtin_amdgcn_mfma_f32_16x16x32_bf16(a, b, c, 0, 0, 0); }
__device__ __forceinline__ float log_sigmoid(float x) { return fminf(x, 0.f) - __logf(1.f + __expf(-fabsf(x))); }

__device__ __forceinline__ void gate_prep(int gw, int ngw, int lane, const float* __restrict__ GATES, const float* __restrict__ bgl, float* __restrict__ GP) {
    for (int it = gw; it < 96 * 65; it += ngw) {
        const int chain = it / 65, c = it % 65, s = chain >> 3, hd = (chain >> 1) & 3, dir = chain & 1;
        const long g = c == 0 ? (lane >= 48 ? (long)MROW0 + 16 * s + lane - 48 : -1L) : (long)s * LREAL + 64 * (c - 1) + lane;
        float li = NEGBIG, lf = 0.f;
        if (g >= 0) { li = GATES[g * 16 + (dir ? 8 : 0) + hd] + bgl[(dir ? 8 : 0) + hd]; lf = log_sigmoid(GATES[g * 16 + (dir ? 12 : 4) + hd] + bgl[(dir ? 12 : 4) + hd]); }
        float x = dir ? __shfl(lf, 63 - lane) : lf;
#pragma unroll
        for (int o = 1; o < 64; o <<= 1) { const float y = __shfl_up(x, o); if (lane >= o) x += y; }
        const float btot = __shfl(x, 63);
        const float b = dir ? __shfl(x, 63 - lane) : x;
        const float a_s = li - b;
        float pm = dir ? __shfl(a_s, 63 - lane) : a_s;
#pragma unroll
        for (int o = 1; o < 64; o <<= 1) { const float y = __shfl_up(pm, o); if (lane >= o) pm = fmaxf(pm, y); }
        pm = dir ? __shfl(pm, 63 - lane) : pm;
        const float gmax = wave_max(btot - b + li);
        float* rec = GP + (size_t)it * GP_REC;
        rec[lane] = b; rec[64 + lane] = li; rec[128 + lane] = pm; if (lane == 0) { rec[192] = btot; rec[193] = gmax; }
    }
}

__device__ __forceinline__ void mlstm_unit(int s, int hd, int js, const bf16_t* __restrict__ UQKVO, const float* __restrict__ GP, float* __restrict__ HSUM, LAS unsigned char* lds, LAS float* sc) {
    const int wid = __builtin_amdgcn_readfirstlane((int)threadIdx.x >> 6);
    const unsigned ldsb = (unsigned)(uintptr_t)lds;
    const int tt = wid >> 1, nb = 2 * (wid & 1);
#define ROWRD(img, rb, s_) (*(const LAS bf16x8*)(uintptr_t)(RB[s_] + (unsigned)((img) + 4096 * (rb))))
#define TRFRAG(img, c_, ks) tr_frag(BT[0][(c_) & 1] + TQ[(c_) >> 1] + (unsigned)((img) + 8192 * (ks)), BT[1][(c_) & 1] + TQ[(c_) >> 1] + (unsigned)((img) + 8192 * (ks)))
    f32x4 accC[2][4], accN[2];
    for (int dir = 0; dir < 2; ++dir) {
        int tid; { int t0_ = threadIdx.x; asm volatile("" : "+v"(t0_)); tid = t0_; }
#pragma unroll
        for (int mi = 0; mi < 2; ++mi)
#pragma unroll
            for (int c = 0; c < 4; ++c) accC[mi][c] = (f32x4){0.f, 0.f, 0.f, 0.f};
        accN[0] = (f32x4){0.f, 0.f, 0.f, 0.f}; accN[1] = (f32x4){0.f, 0.f, 0.f, 0.f};
        if (tid < 256) sc[SC_N + tid] = 0.f;
        for (int i = tid; i < 32768 / 16; i += 512) *(LAS u32x4*)(lds + CI + i * 16) = (u32x4){0u, 0u, 0u, 0u};
        float m_state = 0.f;
        const float* GPc = GP + (size_t)(((s * 4 + hd) * 2 + dir) * 65) * GP_REC;
        u32x4 sq[4], sk[4], sv; float sb = 0.f, sli = NEGBIG, spm = NEGBIG, sbt = 0.f, sgm = NEGBIG;
#define ROWG(c, r) ((c) == 0 ? ((r) >= 48 ? (long)MROW0 + 16 * s + (r) - 48 : -1L) : (long)s * LREAL + 64 * ((c) - 1) + (r))
#define STAGE_LOAD(c) do { \
        _Pragma("unroll") for (int i = 0; i < 4; ++i) { const int id = tid + 512 * i, r = id >> 5, ch = id & 31; const long g = ROWG(c, r); \
            sq[i] = (u32x4){0u, 0u, 0u, 0u}; sk[i] = (u32x4){0u, 0u, 0u, 0u}; \
            if (g >= 0) { sq[i] = *(const u32x4*)(UQKVO + g * 4096 + hd * 256 + ch * 8); sk[i] = *(const u32x4*)(UQKVO + g * 4096 + 1024 + hd * 256 + ch * 8); } } \
        { const int r = tid >> 3, ch = tid & 7; const long g = ROWG(c, r); sv = (u32x4){0u, 0u, 0u, 0u}; if (g >= 0) sv = *(const u32x4*)(UQKVO + g * 4096 + 2048 + hd * 256 + js * 64 + ch * 8); } \
        if (tid < 64) { const float* rec = GPc + (size_t)(c) * GP_REC; sb = rec[tid]; sli = rec[64 + tid]; spm = rec[128 + tid]; sbt = rec[192]; sgm = rec[193]; } } while (0)
#define STAGE_WRITE() do { \
        _Pragma("unroll") for (int i = 0; i < 4; ++i) { const int id = tid + 512 * i, r = id >> 5, ch = id & 31; \
            *(LAS u32x4*)(lds + QI + (ch >> 4) * 16384 + off_b(r, ch & 15)) = sq[i]; *(LAS u32x4*)(lds + KI + (ch >> 4) * 16384 + off_b(r, ch & 15)) = sk[i]; } \
        { const int r = tid >> 3, ch = tid & 7; *(LAS u32x4*)(lds + VI + off_b(r, ch)) = sv; } \
        if (tid < 64) { const float m_inter = sb + m_state, mt = fmaxf(m_inter, sb + spm); const float m_new = fmaxf(sbt + m_state, sgm); \
            sc[SC_CT + tid] = sli - sb; sc[SC_BM + tid] = sb - mt; sc[SC_WI + tid] = __expf(m_inter - mt); sc[SC_EI + tid] = __expf(-mt); \
            sc[SC_WW + tid] = __expf(sbt - sb + sli - m_new) * 0.0625f; if (tid == 0) sc[SC_A] = __expf(sbt + m_state - m_new); m_state = m_new; } } while (0)
        const int c_first = dir ? 64 : 0, c_step = dir ? -1 : 1;
        STAGE_LOAD(c_first);
        __syncthreads();
        STAGE_WRITE();
        for (int ci = 0; ci < 65; ++ci) {
            const int c = c_first + c_step * ci;
            { int t2_ = threadIdx.x; asm volatile("" : "+v"(t2_)); tid = t2_; }
            const int lane = tid & 63, l15 = lane & 15, lg = lane >> 4;
            unsigned RB[4], BT[2][2], TQ[4];
            { const unsigned fl = ((l15 & 3) << 2) | (l15 >> 2), q = l15 >> 2, p = lane & 3, g = lg;
#pragma unroll
              for (int s_ = 0; s_ < 4; ++s_) { RB[s_] = ldsb + 256u * l15 + 16u * (lg ^ (fl & 3)) + 64u * (s_ ^ (fl >> 2)); TQ[s_] = 64u * (s_ ^ q); }
#pragma unroll
              for (int t_ = 0; t_ < 2; ++t_)
#pragma unroll
                  for (int cl = 0; cl < 2; ++cl) BT[t_][cl] = ldsb + 256u * (8 * g + q) + 8u * (p & 1) + 1024u * t_ + 16u * ((p >> 1) ^ t_) + 32u * (cl ^ (g & 1)); }
            __syncthreads();
            if (ci + 1 < 65) STAGE_LOAD(c + c_step);
            bf16x8 qf[8];
#pragma unroll
            for (int k = 0; k < 8; ++k) qf[k] = ROWRD(QI + (k >> 2) * 16384, tt, k & 3);
            f32x4 sT[2], oc[2];
#pragma unroll
            for (int i = 0; i < 2; ++i) { sT[i] = (f32x4){0.f, 0.f, 0.f, 0.f}; oc[i] = (f32x4){0.f, 0.f, 0.f, 0.f}; }
#pragma unroll
            for (int i = 0; i < 2; ++i)
#pragma unroll
                for (int k = 0; k < 8; ++k) {
                    const bf16x8 kf = ROWRD(KI + (k >> 2) * 16384, nb + i, k & 3);
                    sT[i] = mfma16(kf, qf[k], sT[i]);
                    const bf16x8 cf = ROWRD(CI + (k >> 2) * 16384, nb + i, k & 3);
                    oc[i] = mfma16(qf[k], cf, oc[i]);
                }
            {
                const int t = 16 * tt + l15; const float bmt = sc[SC_BM + t]; float rs = 0.f;
#pragma unroll
                for (int i = 0; i < 2; ++i) { const int s0 = 16 * (nb + i) + 4 * lg; const f32x4 ctv = *(const LAS f32x4*)(sc + SC_CT + s0); float v[4];
#pragma unroll
                    for (int e = 0; e < 4; ++e) { const int sx = s0 + e; const bool ok = dir ? (sx >= t) : (sx <= t);
                        const float ex = ok ? (bmt + ctv[e]) : NEGBIG; v[e] = sT[i][e] * 0.0625f * __expf(ex); rs += v[e]; }
                    u32x2 w; w.x = pk2(v[0], v[1]); w.y = pk2(v[2], v[3]);
                    *(LAS u32x2*)(lds + SI + off_b(t, s0 >> 3) + (s0 & 7) * 2) = w; }
                rs += __shfl_xor(rs, 16); rs += __shfl_xor(rs, 32);
                if (lg == 0) sc[SC_DEN + 64 * (wid & 1) + t] = rs;
            }
            { const int r = tid >> 3, ch = tid & 7; const u32x4 v = *(const LAS u32x4*)(lds + VI + off_b(r, ch)); const float w = sc[SC_WW + r]; u32x4 o;
#pragma unroll
              for (int jx = 0; jx < 4; ++jx) o[jx] = pk2(bf_lo(v[jx]) * w, bf_hi(v[jx]) * w);
              *(LAS u32x4*)(lds + VI + off_b(r, 8 + ch)) = o; }
            { const int r = tid >> 3, part = tid & 7; float d = 0.f;
#pragma unroll
              for (int i = 0; i < 4; ++i) { const int ch32 = part * 4 + i; const u32x4 v = *(const LAS u32x4*)(lds + QI + (ch32 >> 4) * 16384 + off_b(r, ch32 & 15));
                  const f32x4 n0 = *(const LAS f32x4*)(sc + SC_N + ch32 * 8), n1 = *(const LAS f32x4*)(sc + SC_N + ch32 * 8 + 4);
                  d += bf_lo(v[0]) * n0[0] + bf_hi(v[0]) * n0[1] + bf_lo(v[1]) * n0[2] + bf_hi(v[1]) * n0[3] + bf_lo(v[2]) * n1[0] + bf_hi(v[2]) * n1[1] + bf_lo(v[3]) * n1[2] + bf_hi(v[3]) * n1[3]; }
              d += __shfl_xor(d, 1); d += __shfl_xor(d, 2); d += __shfl_xor(d, 4);
              if (part == 0) sc[SC_QN + r] = d; }
            { const f32x4 wi = *(const LAS f32x4*)(sc + SC_WI + 16 * tt + 4 * lg);
#pragma unroll
              for (int i = 0; i < 2; ++i) oc[i] = oc[i] * wi; }
            __syncthreads();
            const float a_dec = sc[SC_A];
#pragma unroll
            for (int ks = 0; ks < 2; ++ks) { const bf16x8 sf = ROWRD(SI, tt, ks);
#pragma unroll
                for (int i = 0; i < 2; ++i) { const bf16x8 vf = TRFRAG(VI, nb + i, ks);
                    oc[i] = mfma16(sf, vf, oc[i]); } }
            { const int t0 = 16 * tt + 4 * lg;
              const f32x4 wi = *(const LAS f32x4*)(sc + SC_WI + t0), qn = *(const LAS f32x4*)(sc + SC_QN + t0), d0 = *(const LAS f32x4*)(sc + SC_DEN + t0), d1 = *(const LAS f32x4*)(sc + SC_DEN + 64 + t0), ei = *(const LAS f32x4*)(sc + SC_EI + t0);
#pragma unroll
              for (int e = 0; e < 4; ++e) { const long g = ROWG(c, t0 + e);
                const float den = wi[e] * qn[e] + (d0[e] + d1[e]); const float inv = 1.f / fmaxf(fabsf(den), ei[e]);
                if (g >= 0) {
#pragma unroll
                    for (int i = 0; i < 2; ++i) { float* hp = HSUM + g * MLW + hd * 256 + js * 64 + 16 * (nb + i) + l15; const float hv = oc[i][e] * inv; if (dir) unsafeAtomicAdd(hp, hv); else *hp = hv; } } } }
#pragma unroll
            for (int mi = 0; mi < 2; ++mi)
#pragma unroll
                for (int cc = 0; cc < 4; ++cc) accC[mi][cc] = accC[mi][cc] * a_dec;
            accN[0] = accN[0] * a_dec; accN[1] = accN[1] * a_dec;
            const unsigned ktq = (unsigned)(KI + (wid >> 2) * 16384) + 64u * ((unsigned)(wid & 3) ^ (unsigned)(l15 >> 2));
#pragma unroll
            for (int ks = 0; ks < 2; ++ks) {
                bf16x8 kf[2], wf[4];
#pragma unroll
                for (int mi = 0; mi < 2; ++mi) kf[mi] = tr_frag(BT[0][mi] + ktq + (unsigned)(8192 * ks), BT[1][mi] + ktq + (unsigned)(8192 * ks));
#pragma unroll
                for (int cc = 0; cc < 4; ++cc) wf[cc] = TRFRAG(VI, 4 + cc, ks);
                { const f32x4 wa = *(const LAS f32x4*)(sc + SC_WW + 32 * ks + 8 * lg), wb = *(const LAS f32x4*)(sc + SC_WW + 32 * ks + 8 * lg + 4);
                  u32x4 wq; wq.x = pk2(wa[0], wa[1]); wq.y = pk2(wa[2], wa[3]); wq.z = pk2(wb[0], wb[1]); wq.w = pk2(wb[2], wb[3]);
                  if (l15 != 0) wq = (u32x4){0u, 0u, 0u, 0u};
                  const bf16x8 wfn = __builtin_bit_cast(bf16x8, wq);
#pragma unroll
                  for (int mi = 0; mi < 2; ++mi) accN[mi] = mfma16(kf[mi], wfn, accN[mi]); }
#pragma unroll
                for (int mi = 0; mi < 2; ++mi)
#pragma unroll
                    for (int cc = 0; cc < 4; ++cc) accC[mi][cc] = mfma16(kf[mi], wf[cc], accC[mi][cc]);
            }
#pragma unroll
            for (int mi = 0; mi < 2; ++mi)
#pragma unroll
                for (int cc = 0; cc < 4; ++cc) { const int dk0 = 32 * wid + 16 * mi + 4 * lg, dv = 16 * cc + l15; u32x2 w; w.x = pk2(accC[mi][cc][0], accC[mi][cc][1]); w.y = pk2(accC[mi][cc][2], accC[mi][cc][3]);
                    *(LAS u32x2*)(lds + CI + (dk0 >> 7) * 16384 + off_b(dv, (dk0 & 127) >> 3) + (dk0 & 7) * 2) = w; }
            if (l15 == 0) { *(LAS f32x4*)(sc + SC_N + 32 * wid + 4 * lg) = accN[0]; *(LAS f32x4*)(sc + SC_N + 32 * wid + 16 + 4 * lg) = accN[1]; }
            __syncthreads();
            if (ci + 1 < 65) STAGE_WRITE();
        }
    }
#undef ROWG
#undef STAGE_LOAD
#undef STAGE_WRITE
#undef ROWRD
#undef TRFRAG
}
__device__ __forceinline__ void mlstm_phase(int bx, const bf16_t* UQKVO, const float* GP, float* HSUM, LAS unsigned char* lds, LAS float* sc) {
    if (bx >= 192) return;
    const int xcd = bx & 7, idx = bx >> 3, pair = xcd * 6 + (idx >> 2), js = idx & 3;
    mlstm_unit(pair >> 2, pair & 3, js, UQKVO, GP, HSUM, lds, sc);
}
}

#ifndef PHM
#define PHM 0xffff
#endif
#ifndef REP_ML
#define REP_ML 1
#endif
#ifndef REP_ATTN
#define REP_ATTN 1
#endif
#ifndef REP_CONV
#define REP_CONV 1
#endif
#ifndef REP_SMALL
#define REP_SMALL 1
#endif
#ifndef KV_SPLIT
#define KV_SPLIT 193
#endif
#ifndef REP_WIN
#define REP_WIN 1
#endif
#ifndef REP_UP
#define REP_UP 1
#endif
__global__ void __launch_bounds__(512, 2) fwd_kernel(Params P, unsigned char* ws_arg, unsigned char* out_arg) {
    extern __shared__ __attribute__((aligned(16))) unsigned char lds_raw[];
    Frame F;
    F.lds = (LAS unsigned char*)lds_raw;
    F.tid = threadIdx.x; F.lane = F.tid & 63; F.wave = __builtin_amdgcn_readfirstlane(F.tid >> 6);
    F.G = GRID; F.bx = blockIdx.x; F.vcu = (F.bx % 8) * (GRID / 8) + F.bx / 8;
    F.gw = F.vcu * 8 + F.wave; F.ngw = F.G * 8;
    { unsigned char* ws0 = ws_arg;
      for (int u = F.tid; u < (LDS_BYTES - MISC_OFF) / 4; u += 512) ((LAS unsigned*)(F.lds + MISC_OFF))[u] = 0u;
      __syncthreads();
      (void)ws0; }
    LAS unsigned long long* ptab = (LAS unsigned long long*)(F.lds + MISC_OFF + 64);
    if (F.tid == 0) {
#pragma unroll
        for (int k = 0; k < 19; ++k) ptab[k] = (unsigned long long)(uintptr_t)P.in[k]; }
    __syncthreads();
    XcdBarrier bar = xcd_barrier_post((unsigned*)(ws_arg + WS_CTL) + CW_BAR, (volatile LAS unsigned*)(F.lds + MISC_OFF));
    LAS float* sc = (LAS float*)(F.lds + MISC_OFF + 1024);
#define BXL() ({ int b__ = F.bx; asm volatile("" : "+s"(b__)); b__; })
#define PFRAME() Frame Fp = F; { int t_ = threadIdx.x; asm volatile("" : "+v"(t_)); Fp.tid = t_; Fp.lane = t_ & 63; int b_ = BXL(); Fp.bx = b_; Fp.vcu = (b_ % 8) * (GRID / 8) + b_ / 8; Fp.gw = Fp.vcu * 8 + Fp.wave; }
#define WSB() ({ GAS unsigned char* w__ = (GAS unsigned char*)ws_arg; asm volatile("" : "+s"(w__)); (unsigned char*)w__; })
#ifndef STAG_N
#define STAG_N 1
#endif
#ifdef STAG_ON
#define STAGGER() do { int s__ = (BXL() * 37) & 255; for (int i__ = 0; i__ < s__; ++i__) __builtin_amdgcn_s_sleep(STAG_N); } while (0)
#else
#define STAGGER() do {} while (0)
#endif
#define WOFS(l_) (((l_) & 1) ? WSET_DELTA : (size_t)0)
#define DOB() ({ GAS unsigned char* w__ = (GAS unsigned char*)out_arg; asm volatile("" : "+s"(w__)); (unsigned char*)w__; })

    { unsigned char* ws = WSB(); prologue(F, ws, ptab); convert_weights(F, ws, ptab, 0, 0, -1); }
    xcd_barrier(bar);

    for (int l = 0; l < DEPTH; ++l) {
        { unsigned char* ws = WSB();
          pg8::Gemm g{(bf16_t*)(ws + WS_HB), (bf16_t*)(ws + WOFS(l) + WS_WIN), TP, NIN, DM, DM}; pg8::PanelOrder S; S.init(NPAN, 0, 0, 0, NIN, F.G, BXL());
          pg8::EpiWin E{(bf16_t*)(ws + WS_UQKVO), (bf16_t*)(ws + WS_UDQ), (bf16_t*)(ws + WS_UDKV), (bf16_t*)(ws + WS_KR), (float*)(ws + WS_GATES), (const float*)(ws + WS_COS), (const float*)(ws + WS_SIN)};
#if PHM & 2
          STAGGER(); pg8::gemm_phase<pg8::EpiWin, pg8::PanelOrder, true, true>(F.lds, g, S, E);
#endif
        }
        if (l + 1 < DEPTH && BXL() >= 20) { unsigned char* ws = WSB(); PFRAME(); Fp.gw = (Fp.bx - 20) * 8 + Fp.wave; Fp.ngw = (GRID - 20) * 8; convert_weights(Fp, ws, ptab, l + 1, WOFS(l + 1), 0); }
#if REP_WIN > 1
        __syncthreads();
        { unsigned char* ws = WSB();
          pg8::Gemm g{(bf16_t*)(ws + WS_HB), (bf16_t*)(ws + WOFS(l) + WS_WIN), TP, NIN, DM, DM}; pg8::PanelOrder S; S.init(NPAN, 0, 0, 0, NIN, F.G, BXL());
          pg8::EpiWin E{(bf16_t*)(ws + WS_UQKVO), (bf16_t*)(ws + WS_UDQ), (bf16_t*)(ws + WS_UDKV), (bf16_t*)(ws + WS_KR), (float*)(ws + WS_GATES), (const float*)(ws + WS_COS), (const float*)(ws + WS_SIN)};
          pg8::gemm_phase<pg8::EpiWin, pg8::PanelOrder, true, true>(F.lds, g, S, E);
        }
#endif
        xcd_barrier(bar);
        { unsigned char* ws = WSB(); unsigned char* dob = DOB(); PFRAME(); rstd_rows(Fp, (bf16_t*)(ws + WS_UDQ), (bf16_t*)(ws + WS_UDKV), (float*)(ws + WS_RSTD));
          ml::gate_prep(Fp.gw, Fp.ngw, Fp.lane, (const float*)(ws + WS_GATES), (const float*)(ws + WS_PAR) + PO_BG + l * 16, (float*)(dob + DO_GP)); }
#if REP_SMALL > 1
        { unsigned char* ws = WSB(); unsigned char* dob = DOB(); PFRAME(); rstd_rows(Fp, (bf16_t*)(ws + WS_UDQ), (bf16_t*)(ws + WS_UDKV), (float*)(ws + WS_RSTD));
          ml::gate_prep(Fp.gw, Fp.ngw, Fp.lane, (const float*)(ws + WS_GATES), (const float*)(ws + WS_PAR) + PO_BG + l * 16, (float*)(dob + DO_GP)); }
#endif
        xcd_barrier(bar);
        if (F.bx >= 192) {
        { unsigned char* ws = WSB(); unsigned char* dob = DOB();
          pg8::Gemm g{(bf16_t*)(ws + WS_UDQ), (bf16_t*)(ws + WOFS(l) + WS_WUQ), TP, NQ, 512, 512}; pg8::PanelOrder S; S.init(NPAN, 0, 0, 0, NQ, GRID - 192, BXL() - 192);
          pg8::EpiQ E{(bf16_t*)(dob + DO_MQ), (const float*)(ws + WS_RSTD), (const float*)(ws + WS_COS), (const float*)(ws + WS_SIN)};
#if PHM & 4
          pg8::gemm_phase<pg8::EpiQ, pg8::PanelOrder, true, true>(F.lds, g, S, E);
#endif
        }
        { unsigned char* ws = WSB();
          pg8::Gemm g{(bf16_t*)(ws + WS_UDKV), (bf16_t*)(ws + WOFS(l) + WS_WUKV), TP, NKV, 256, 256}; pg8::PanelOrder S; S.init(NPAN, 0, 0, 0, NKV, GRID - 192, BXL() - 192);
          pg8::EpiBf16G E{(bf16_t*)(ws + WS_MKV), NKV, (const float*)(ws + WS_RSTD) + 1, 0, -1, 0};
#if PHM & 8
          pg8::gemm_phase<pg8::EpiBf16G, pg8::PanelOrder, true, true>(F.lds, g, S, E);
#endif
        }
        } else {
#ifndef NO_ML
        for (int rep_ = 0; rep_ < REP_ML; ++rep_)
        { unsigned char* ws = WSB(); unsigned char* dob = DOB();
          ml::mlstm_phase(BXL(), (const bf16_t*)(ws + WS_UQKVO), (const float*)(dob + DO_GP), (float*)(dob + DO_HSUM), F.lds, sc); }
#endif
        }
        xcd_barrier(bar);
        { unsigned char* ws = WSB(); unsigned char* dob = DOB(); PFRAME();
          if (Fp.vcu >= 96) mlstm_finalize(Fp, (Fp.vcu - 96) * 8 + Fp.wave, (GRID - 96) * 8, (const float*)(dob + DO_HSUM), (const bf16_t*)(ws + WS_UQKVO), (const float*)(ws + WS_PAR) + PO_MLG + l * MLW, (bf16_t*)(ws + WS_HB)); }
#ifndef NO_ATTN
        for (int rep_ = 0; rep_ < REP_ATTN; ++rep_)
        { unsigned char* ws = WSB(); unsigned char* dob = DOB();
          att::attn_phase(({ int b__ = BXL(); (b__ % 8) * (GRID / 8) + b__ / 8; }), (const bf16_t*)(dob + DO_MQ), (const bf16_t*)(ws + WS_MKV), (const bf16_t*)(ws + WS_KR), (bf16_t*)(ws + WS_HB), (LAS char*)F.lds); }
#endif
        xcd_barrier(bar);
        { unsigned char* ws = WSB();
          pg8::Gemm g{(bf16_t*)(ws + WS_HB), (bf16_t*)(ws + WOFS(l) + WS_WOUT), TP, DM, DM, DM}; pg8::PanelOrder S; S.init(192, 0, 0, 0, DM, F.G, BXL());
          pg8::EpiResidLn E{(bf16_t*)(ws + WS_H), DM, ALPHA, (const float*)(ws + WS_STAT2), (const float*)(ws + WS_PAR) + (l > 0 ? PO_L2G + (l - 1) * DM : PO_ONE), (const float*)(ws + WS_PAR) + (l > 0 ? PO_L2B + (l - 1) * DM : PO_ZERO)};
#if PHM & 16
          STAGGER(); pg8::gemm_phase<pg8::EpiResidLn, pg8::PanelOrder, true, true>(F.lds, g, S, E);
#endif
        }
        { unsigned char* ws = WSB();
          pg8::Gemm g{(bf16_t*)(ws + WS_HB), (bf16_t*)(ws + WOFS(l) + WS_WOUT), TP, DM, DM / 4, DM}; pg8::SplitOrder S; S.init(PMETA, DM, 4, F.G, BXL());
          pg8::EpiPart E{(float*)(ws + WS_PART), DM};
#if PHM & 16
          pg8::gemm_phase<pg8::EpiPart, pg8::SplitOrder, true, true>(F.lds, g, S, E);
#endif
        }
        xcd_barrier(bar);
        { unsigned char* ws = WSB(); PFRAME(); ln_rows(Fp, (float*)(ws + WS_H), (bf16_t*)(ws + WS_HB), (const float*)(ws + WS_PAR) + PO_L1G + l * DM, (const float*)(ws + WS_PAR) + PO_L1B + l * DM, (float*)(ws + WS_STAT1), nullptr, (const float*)(ws + WS_PART), 4); }
        xcd_barrier(bar);
        { unsigned char* ws = WSB(); unsigned char* dob = DOB();
          pg8::Gemm g{(bf16_t*)(ws + WS_HB), (bf16_t*)(ws + WOFS(l) + WS_WUP), TP, NUP, DM, DM}; pg8::PanelOrder S; S.init(NPAN, 0, 0, 0, NUP, F.G, BXL());
          pg8::EpiFfn E{(bf16_t*)(ws + WS_ACT), (float*)(dob + DO_SIDE), (bf16_t*)(dob + DO_GVM), (const float*)(ws + WS_PAR) + PO_CW + (size_t)l * 3 * DFF, (const float*)(ws + WS_PAR) + PO_CB + (size_t)l * DFF, (LAS float*)(F.lds + MISC_OFF + 8192)};
#if PHM & 32
          STAGGER(); pg8::gemm_phase<pg8::EpiFfn, pg8::PanelOrder, true, true>(F.lds, g, S, E);
#if REP_UP > 1
          __syncthreads(); pg8::gemm_phase<pg8::EpiFfn, pg8::PanelOrder, true, true>(F.lds, g, S, E);
#endif
#endif
        }
        if (l + 1 < DEPTH && BXL() >= 44) { unsigned char* ws = WSB(); PFRAME(); Fp.gw = (Fp.bx - 44) * 8 + Fp.wave; Fp.ngw = (GRID - 44) * 8; convert_weights(Fp, ws, ptab, l + 1, WOFS(l + 1), 1); }
        xcd_barrier(bar);
        { unsigned char* ws = WSB(); unsigned char* dob = DOB(); PFRAME();
          ffn_fixup(Fp, (const float*)(dob + DO_SIDE), (const bf16_t*)(dob + DO_GVM), (bf16_t*)(ws + WS_ACT), (const float*)(ws + WS_PAR) + PO_CW + (size_t)l * 3 * DFF, (const float*)(ws + WS_PAR) + PO_CB + (size_t)l * DFF); }
#if REP_SMALL > 1
        { unsigned char* ws = WSB(); unsigned char* dob = DOB(); PFRAME();
          ffn_fixup(Fp, (const float*)(dob + DO_SIDE), (const bf16_t*)(dob + DO_GVM), (bf16_t*)(ws + WS_ACT), (const float*)(ws + WS_PAR) + PO_CW + (size_t)l * 3 * DFF, (const float*)(ws + WS_PAR) + PO_CB + (size_t)l * DFF); }
#endif
        xcd_barrier(bar);
        { unsigned char* ws = WSB();
          pg8::Gemm g{(bf16_t*)(ws + WS_ACT), (bf16_t*)(ws + WOFS(l) + WS_WDN), TP, DM, DFF, DFF}; pg8::PanelOrder S; S.init(192, 0, 0, 0, DM, F.G, BXL());
          pg8::EpiResidLn E{(bf16_t*)(ws + WS_H), DM, ALPHA, (const float*)(ws + WS_STAT1), (const float*)(ws + WS_PAR) + PO_L1G + l * DM, (const float*)(ws + WS_PAR) + PO_L1B + l * DM};
#if PHM & 64
          STAGGER(); pg8::gemm_phase<pg8::EpiResidLn, pg8::PanelOrder, true, true>(F.lds, g, S, E);
#endif
        }
        { unsigned char* ws = WSB();
          pg8::Gemm g{(bf16_t*)(ws + WS_ACT), (bf16_t*)(ws + WOFS(l) + WS_WDN), TP, DM, DFF / 11, DFF}; pg8::SplitOrder S; S.init(PMETA, DM, 11, F.G, BXL());
          pg8::EpiPart E{(float*)(ws + WS_PART), DM};
#if PHM & 64
          pg8::gemm_phase<pg8::EpiPart, pg8::SplitOrder, true, true>(F.lds, g, S, E);
#endif
        }
        xcd_barrier(bar);
        { unsigned char* ws = WSB(); unsigned char* dob = DOB();
          PFRAME(); ln_rows(Fp, (float*)(ws + WS_H), (bf16_t*)(ws + WS_HB), (const float*)(ws + WS_PAR) + PO_L2G + l * DM, (const float*)(ws + WS_PAR) + PO_L2B + l * DM, (float*)(ws + WS_STAT2), l == DEPTH - 1 ? (float*)dob : nullptr, (const float*)(ws + WS_PART), 11); }
#if REP_CONV > 1
#endif
        xcd_barrier(bar);
    }
}

extern "C" void kernel_launch(void* const* d_in, const int* in_sizes, int n_in, void* d_out, int out_size, void* d_ws, size_t ws_size, hipStream_t stream) {
    static int grid = 0;
    if (grid == 0) {
        if (n_in != 19 || out_size != NMAIN * DM || ws_size < WS_NEED) { fprintf(stderr, "kernel_launch: unexpected shapes (n_in %d out %d ws %zu need %zu)\n", n_in, out_size, ws_size, (size_t)WS_NEED); grid = -1; return; }
        int dev = 0, cus = 0;
        if (hipGetDevice(&dev) != hipSuccess || hipDeviceGetAttribute(&cus, hipDeviceAttributeMultiprocessorCount, dev) != hipSuccess) { grid = -1; return; }
        if (hipFuncSetAttribute((const void*)fwd_kernel, hipFuncAttributeMaxDynamicSharedMemorySize, LDS_BYTES) != hipSuccess) { fprintf(stderr, "kernel_launch: hipFuncSetAttribute failed\n"); grid = -1; return; }
        int per_cu = 0;
        if (hipOccupancyMaxActiveBlocksPerMultiprocessor(&per_cu, (const void*)fwd_kernel, 512, LDS_BYTES) != hipSuccess || per_cu < 1) { fprintf(stderr, "kernel_launch: occupancy query says %d blocks per CU\n", per_cu); (void)hipGetLastError(); grid = -1; return; }
        if (cus < GRID) { fprintf(stderr, "kernel_launch: needs %d CUs, device has %d\n", GRID, cus); grid = -1; return; }
        grid = GRID;
    }
    if (grid < 0) return;
    (void)hipMemsetAsync((char*)d_ws + WS_CTL, 0, CTL_BYTES, stream);
    Params p{};
    for (int i = 0; i < 19; ++i) p.in[i] = (const float*)d_in[i];
    hipLaunchKernelGGL(fwd_kernel, dim3(grid), dim3(512), LDS_BYTES, stream, p, (unsigned char*)d_ws, (unsigned char*)d_out);
}
```

```cpp
#include <hip/hip_runtime.h>
#include <cstdio>
#include <cstdint>

#define LAS __attribute__((address_space(3)))
#define GAS __attribute__((address_space(1)))
typedef float f32x2 __attribute__((ext_vector_type(2)));
typedef float f32x8 __attribute__((ext_vector_type(8)));
typedef float f32x16 __attribute__((ext_vector_type(16)));
typedef unsigned u32x2 __attribute__((ext_vector_type(2)));
typedef short s16x4 __attribute__((ext_vector_type(4)));
typedef __bf16 bf16x2v __attribute__((ext_vector_type(2)));

constexpr int DM = 2048, NSEQ = 12, LREAL = 4096, NMETA = 16, DEPTH = 4;
constexpr int NMAIN = NSEQ * LREAL;
constexpr int MROW0 = NMAIN;
constexpr int NTOK = NMAIN + NSEQ * NMETA;
constexpr int NPAN = 193, TP = NPAN * 256;
constexpr int PMETA = 192;
constexpr int INC = 4944, NIN = 5120;
constexpr int DFF = 5632, NUP = 2 * DFF;
constexpr int MLW = 1024, NQ = 1536, NKV = 2048;
constexpr float ALPHA = 1.681792830507429f;
constexpr float EPS = 1e-5f;
constexpr float NEGBIG = -1e30f;

constexpr size_t MiB = 1u << 20;
constexpr size_t WS_CTL = 0, CTL_BYTES = 1 * MiB;
constexpr size_t WS_COS = 1 * MiB;
constexpr size_t WS_SIN = WS_COS + (size_t)4112 * 32 * 4;
constexpr size_t WS_PAR = 2 * MiB + 128 * 1024;
constexpr int PO_BG = 0, PO_MLG = PO_BG + DEPTH * 16, PO_QG = PO_MLG + DEPTH * 1024, PO_KVG = PO_QG + DEPTH * 512, PO_L1G = PO_KVG + DEPTH * 256, PO_L1B = PO_L1G + DEPTH * 2048,
              PO_CW = PO_L1B + DEPTH * 2048, PO_CB = PO_CW + DEPTH * 3 * 5632, PO_L2G = PO_CB + DEPTH * 5632, PO_L2B = PO_L2G + DEPTH * 2048, PO_ONE = PO_L2B + DEPTH * 2048, PO_ZERO = PO_ONE + 2048, PO_END = PO_ZERO + 2048;
static_assert(WS_PAR + (size_t)PO_END * 4 <= 3 * MiB && WS_PAR >= 1 * MiB + 2 * 4112 * 32 * 4, "PAR block placement");
constexpr size_t WS_WIN = 3 * MiB;
constexpr size_t WS_WUQ = WS_WIN + (size_t)NIN * DM * 2;
constexpr size_t WS_WUKV = WS_WUQ + (size_t)NQ * 512 * 2;
constexpr size_t WS_WOUT = WS_WUKV + (size_t)NKV * 256 * 2;
constexpr size_t WS_WUP = WS_WOUT + (size_t)DM * DM * 2;
constexpr size_t WS_WDN = WS_WUP + (size_t)NUP * DM * 2;
constexpr size_t WS_STAT1 = WS_WDN + (size_t)DM * DFF * 2;
constexpr size_t WS_STAT2 = WS_CTL + 512 * 1024;
constexpr size_t WS_H = 100 * MiB;
constexpr size_t WS_PART = WS_H + 208 * MiB;
static_assert((size_t)NMAIN * DM * 2 <= 208 * MiB && 208 * MiB + (size_t)11 * 256 * DM * 4 <= (size_t)NMAIN * DM * 4, "PART sits between the bf16 rows and the f32 meta rows of H");
constexpr size_t WS_WSET2 = WS_H + 240 * MiB;
constexpr size_t WSET_BYTES = WS_STAT1 - WS_WIN, WSET_DELTA = WS_WSET2 - WS_WIN;
static_assert(WS_PART + (size_t)11 * 256 * DM * 4 <= WS_WSET2 && WS_WSET2 + WSET_BYTES <= WS_H + (size_t)NMAIN * DM * 4, "second weight set sits between the split-K parts and the f32 meta rows of H");
constexpr size_t WS_HB = WS_H + (size_t)TP * DM * 4;
constexpr size_t WS_R = WS_HB + (size_t)TP * DM * 2;
constexpr size_t WS_UQKVO = WS_R;
constexpr size_t WS_UDQ = WS_UQKVO + (size_t)TP * 4096 * 2;
constexpr size_t WS_UDKV = WS_UDQ + (size_t)TP * 512 * 2;
constexpr size_t WS_GATES = WS_UDKV + (size_t)TP * 256 * 2;
constexpr size_t WS_MKV = WS_GATES + (size_t)TP * 16 * 4;
constexpr size_t WS_KR = WS_MKV + (size_t)TP * NKV * 2;
constexpr size_t WS_RSTD = WS_KR + (size_t)TP * 64 * 2;
constexpr size_t WS_END_A = WS_RSTD + (size_t)TP * 2 * 4;
constexpr size_t WS_ACT = WS_R;
constexpr size_t WS_END_B = WS_ACT + (size_t)TP * DFF * 2;
constexpr size_t WS_NEED = (WS_END_A > WS_END_B ? WS_END_A : WS_END_B);
static_assert(WS_STAT1 + (size_t)TP * 8 <= WS_H && WS_STAT2 + (size_t)TP * 8 <= WS_CTL + CTL_BYTES, "weights and row statistics fit below H");
constexpr size_t DO_HSUM = 0;
constexpr size_t DO_MQ = DO_HSUM + (size_t)TP * MLW * 4;
constexpr size_t DO_GP = 340 * MiB;
constexpr size_t DO_SIDE = 0;
constexpr size_t DO_GVM = 32 * MiB;
static_assert(DO_MQ + (size_t)TP * NQ * 2 <= DO_GP && DO_GP + (size_t)96 * 65 * 200 * 4 <= (size_t)NMAIN * DM * 4 && (size_t)192 * 6 * DFF * 4 <= DO_GVM && DO_GVM + (size_t)256 * NUP * 2 <= (size_t)NMAIN * DM * 4, "d_out scratch fits");
constexpr int CW_BAR = 4096;

constexpr int RING_BYTES = 131072;
constexpr int MISC_OFF = RING_BYTES;
constexpr int LDS_BYTES = 147456;
constexpr int GRID = 256;

__device__ __forceinline__ int pos_of_row(int row) { return row < NMAIN ? NMETA + (row & (LREAL - 1)) : ((row - NMAIN) & (NMETA - 1)); }
__device__ __forceinline__ unsigned pk2(float lo, float hi) { f32x2 v = {lo, hi}; return __builtin_bit_cast(unsigned, __builtin_convertvector(v, bf16x2v)); }
__device__ __forceinline__ float bf_lo(unsigned w) { return __uint_as_float(w << 16); }
__device__ __forceinline__ float bf_hi(unsigned w) { return __uint_as_float(w & 0xffff0000u); }
typedef _Float16 f16x2v __attribute__((ext_vector_type(2)));
__device__ __forceinline__ unsigned pk2h(float lo, float hi) { f32x2 v = {lo, hi}; return __builtin_bit_cast(unsigned, __builtin_convertvector(v, f16x2v)); }
__device__ __forceinline__ float hf_lo(unsigned w) { return (float)__builtin_bit_cast(f16x2v, w)[0]; }
__device__ __forceinline__ float hf_hi(unsigned w) { return (float)__builtin_bit_cast(f16x2v, w)[1]; }
__device__ __forceinline__ float wave_sum(float v) {
#pragma unroll
    for (int o = 1; o < 64; o <<= 1) v += __shfl_xor(v, o);
    return v;
}
__device__ __forceinline__ float wave_max(float v) {
#pragma unroll
    for (int o = 1; o < 64; o <<= 1) v = fmaxf(v, __shfl_xor(v, o));
    return v;
}
namespace pg8 {
#define PG8_LAS __attribute__((address_space(3)))
typedef unsigned short bf16_t;
typedef short bf16x8 __attribute__((ext_vector_type(8)));
typedef float f32x4 __attribute__((ext_vector_type(4)));
typedef unsigned u32x4 __attribute__((ext_vector_type(4)));
constexpr int BM = 256, BK = 64, HALF = 128, HTB = HALF * BK * 2  , STAGE_BYTES = 8 * HTB, NXCD = 8, WGM = 4;

__host__ __device__ __forceinline__ int lds_byte(int r, int c) { const int st = (r >> 4) * 2 + (c >> 5), rr = r & 15, cc = c & 31, ob = rr * 64 + cc * 2; return st * 1024 + (ob ^ (((ob >> 9) & 1) << 5)); }
__host__ __device__ __forceinline__ void stage_rc(int b, int& R, int& C) { const int st = b / 1024, sb = b % 1024, swz = sb ^ (((sb >> 9) & 1) << 5); R = (st >> 1) * 16 + swz / 64; C = (st & 1) * 32 + (swz % 64) / 2; }
__host__ __device__ __forceinline__ int perm32(int rho) { const int n = rho >> 4, i = rho & 15; return 8 * (i >> 2) + 4 * n + (i & 3); }

struct Unit { int pm, pn, kk; };
struct Gemm { const bf16_t* A; const bf16_t* Bt; int M, N, K, ld; };

struct PanelOrder {
    int nM, nN, nwg, G, c, nMain, pm0, pmx;
    __device__ void init(int nMain_, int pm0_, int extra, int pmx_, int N, int G_, int c_) { nMain = nMain_; pm0 = pm0_; pmx = pmx_; nM = nMain_ + extra; nN = N / BM; nwg = nM * nN; G = G_; c = c_; }
    __device__ bool next(int i, Unit& u) const {
        const long L = (long)i * G + c; if (L >= nwg) return false;
        int wgid = (int)L; { const int q = nwg / NXCD, r = nwg % NXCD, xcd = wgid % NXCD, off = wgid / NXCD; wgid = (xcd < r ? xcd * (q + 1) : r * (q + 1) + (xcd - r) * q) + off; }
        const int nig = WGM * nN, gid = wgid / nig, fm = gid * WGM, gsz = (nM - fm) < WGM ? (nM - fm) : WGM;
        const int pl = fm + ((wgid % nig) % gsz); u.pm = pl < nMain ? pm0 + pl : pmx; u.pn = (wgid % nig) / gsz; u.kk = 0; return true;
    }
    __device__ __forceinline__ void a_ready(const Unit&) const {}
    __device__ __forceinline__ void done(const Unit&) const {}
};

struct SplitOrder {
    int pm, nN, nwg, G, c;
    __device__ void init(int pm_, int N, int nsplit, int G_, int c_) { pm = pm_; nN = N / BM; nwg = nN * nsplit; G = G_; c = c_; }
    __device__ bool next(int i, Unit& u) const { const int L = i * G + c; if (L >= nwg) return false; u.pm = pm; u.pn = L % nN; u.kk = L / nN; return true; }
    __device__ __forceinline__ void a_ready(const Unit&) const {}
    __device__ __forceinline__ void done(const Unit&) const {}
};

__device__ __forceinline__ u32x4 pack8(const f32x4 v0, const f32x4 v1) { u32x4 w; w.x = pk2(v0[0], v0[1]); w.y = pk2(v0[2], v0[3]); w.z = pk2(v1[0], v1[1]); w.w = pk2(v1[2], v1[3]); return w; }

struct EpiBf16G {
    static constexpr bool PERM = true, AFTER_DRAIN = false, PERMA = false;
    bf16_t* O; int ldc; const float* rs; int pm_sub, pm_sp, pm_sp_out;
    __device__ __forceinline__ void operator()(const f32x4 (&acc)[2][2][4][2], const Unit& u, int wr, int wc, int fr, int fq) const {
        const int opm = (u.pm == pm_sp) ? pm_sp_out : u.pm - pm_sub;
        const int rin = u.pm * BM + wr * 64 + fr, rout = opm * BM + wr * 64 + fr, col0 = u.pn * BM + wc * 32 + 8 * fq;
#pragma unroll
        for (int ai = 0; ai < 2; ++ai)
#pragma unroll
            for (int m = 0; m < 4; ++m) { const float sc = rs ? rs[(size_t)(rin + ai * HALF + m * 16) * 2] : 1.f;
                bf16_t* rowp = O + (size_t)(rout + ai * HALF + m * 16) * ldc + col0;
#pragma unroll
                for (int bj = 0; bj < 2; ++bj) *(u32x4*)(rowp + bj * HALF) = pack8(acc[ai][bj][m][0] * sc, acc[ai][bj][m][1] * sc); }
    }
};
struct EpiWin {
    static constexpr bool PERM = true, AFTER_DRAIN = false, PERMA = false;
    bf16_t *UQKVO, *UDQ, *UDKV, *KR; float* GATES; const float *COS, *SIN;
    __device__ __forceinline__ void operator()(const f32x4 (&acc)[2][2][4][2], const Unit& u, int wr, int wc, int fr, int fq) const {
        const int row0 = u.pm * BM + wr * 64 + fr;
        if (u.pn < 19) {
            bf16_t* base; int ldc, colt;
            if (u.pn < 16) { base = UQKVO; ldc = 4096; colt = u.pn * BM; } else if (u.pn < 18) { base = UDQ; ldc = 512; colt = (u.pn - 16) * BM; } else { base = UDKV; ldc = 256; colt = 0; }
            const int col0 = colt + wc * 32 + 8 * fq;
#pragma unroll
            for (int ai = 0; ai < 2; ++ai)
#pragma unroll
                for (int m = 0; m < 4; ++m) { bf16_t* rowp = base + (size_t)(row0 + ai * HALF + m * 16) * ldc + col0;
#pragma unroll
                    for (int bj = 0; bj < 2; ++bj) *(u32x4*)(rowp + bj * HALF) = pack8(acc[ai][bj][m][0], acc[ai][bj][m][1]); }
        } else {
            if (wc < 2) { const int g = 4 * wc + fq;
#pragma unroll
                for (int ai = 0; ai < 2; ++ai)
#pragma unroll
                    for (int m = 0; m < 4; ++m) { const int row = row0 + ai * HALF + m * 16, pos = pos_of_row(row);
                        const f32x4 cs = *(const f32x4*)(COS + pos * 32 + 4 * g), sn = *(const f32x4*)(SIN + pos * 32 + 4 * g);
                        const f32x4 x1 = acc[ai][0][m][0], x2 = acc[ai][0][m][1];
                        *(u32x4*)(KR + (size_t)row * 64 + 8 * g) = pack8(x1 * cs - x2 * sn, x1 * sn + x2 * cs); }
            } else if (wc == 2 && fq < 2) {
#pragma unroll
                for (int ai = 0; ai < 2; ++ai)
#pragma unroll
                    for (int m = 0; m < 4; ++m) { float* gp = GATES + (size_t)(row0 + ai * HALF + m * 16) * 16 + 8 * fq;
                        *(f32x4*)gp = acc[ai][0][m][0]; *(f32x4*)(gp + 4) = acc[ai][0][m][1]; }
            }
        }
    }
};
struct EpiQ {
    static constexpr bool PERM = true, AFTER_DRAIN = false, PERMA = false;
    bf16_t* MQ; const float *RSTD, *COS, *SIN;
    __device__ __forceinline__ void operator()(const f32x4 (&acc)[2][2][4][2], const Unit& u, int wr, int wc, int fr, int fq) const {
        const int row0 = u.pm * BM + wr * 64 + fr, colb = u.pn * BM + wc * 32 + 8 * fq;
#pragma unroll
        for (int ai = 0; ai < 2; ++ai)
#pragma unroll
            for (int m = 0; m < 4; ++m) { const int row = row0 + ai * HALF + m * 16, pos = pos_of_row(row); const float sc = RSTD[(size_t)row * 2];
#pragma unroll
                for (int bj = 0; bj < 2; ++bj) { const int col0 = colb + bj * HALF, o = col0 % 192;
                    f32x4 v0 = acc[ai][bj][m][0] * sc, v1 = acc[ai][bj][m][1] * sc;
                    if (o >= 128) { const int g = (o - 128) >> 3; const f32x4 cs = *(const f32x4*)(COS + pos * 32 + 4 * g), sn = *(const f32x4*)(SIN + pos * 32 + 4 * g);
                        const f32x4 x1 = v0, x2 = v1; v0 = x1 * cs - x2 * sn; v1 = x1 * sn + x2 * cs; }
                    *(u32x4*)(MQ + (size_t)row * NQ + col0) = pack8(v0, v1); } }
    }
};
__device__ __forceinline__ void resid_ln_tile(float* __restrict__ Cw, const float* __restrict__ Cr, const float* __restrict__ st, const float* __restrict__ g, const float* __restrict__ b,
                                              int ldc, float alpha, const f32x4 (&acc)[2][2][4][2], int row0, int col0) {
    asm volatile("" ::: "memory");
#pragma unroll
    for (int ai = 0; ai < 2; ++ai)
#pragma unroll
        for (int bj = 0; bj < 2; ++bj) {
            f32x4 gv[2], bv[2], hv[4][2]; f32x2 ms[4];
#pragma unroll
            for (int n = 0; n < 2; ++n) { gv[n] = *(const f32x4*)(g + col0 + bj * HALF + n * 16) * alpha; bv[n] = *(const f32x4*)(b + col0 + bj * HALF + n * 16) * alpha; }
#pragma unroll
            for (int m = 0; m < 4; ++m) { const int row = row0 + ai * HALF + m * 16; ms[m] = *(const f32x2*)(st + (size_t)row * 2);
#pragma unroll
                for (int n = 0; n < 2; ++n) hv[m][n] = *(const f32x4*)(Cr + (size_t)row * ldc + col0 + bj * HALF + n * 16); }
#pragma unroll
            for (int m = 0; m < 4; ++m) { const int row = row0 + ai * HALF + m * 16;
#pragma unroll
                for (int n = 0; n < 2; ++n) *(f32x4*)(Cw + (size_t)row * ldc + col0 + bj * HALF + n * 16) = (hv[m][n] - ms[m][0]) * ms[m][1] * gv[n] + bv[n] + acc[ai][bj][m][n]; }
        }
}
__device__ __forceinline__ void resid_ln_tile_bf(bf16_t* __restrict__ Cw, const bf16_t* __restrict__ Cr, const float* __restrict__ st, const float* __restrict__ g, const float* __restrict__ b,
                                                 int ldc, float alpha, const f32x4 (&acc)[2][2][4][2], int row0, int col0) {
    asm volatile("" ::: "memory");
#pragma unroll
    for (int ai = 0; ai < 2; ++ai)
#pragma unroll
        for (int bj = 0; bj < 2; ++bj) {
            f32x4 gv[2], bv[2]; u32x4 hv[4]; f32x2 ms[4];
#pragma unroll
            for (int n = 0; n < 2; ++n) { gv[n] = *(const f32x4*)(g + col0 + bj * HALF + n * 4) * alpha; bv[n] = *(const f32x4*)(b + col0 + bj * HALF + n * 4) * alpha; }
#pragma unroll
            for (int m = 0; m < 4; ++m) { const int row = row0 + ai * HALF + m * 16; ms[m] = *(const f32x2*)(st + (size_t)row * 2);
                hv[m] = *(const u32x4*)(Cr + (size_t)row * ldc + col0 + bj * HALF); }
#pragma unroll
            for (int m = 0; m < 4; ++m) { const int row = row0 + ai * HALF + m * 16;
                const f32x4 h0 = {hf_lo(hv[m].x), hf_hi(hv[m].x), hf_lo(hv[m].y), hf_hi(hv[m].y)}, h1 = {hf_lo(hv[m].z), hf_hi(hv[m].z), hf_lo(hv[m].w), hf_hi(hv[m].w)};
                const f32x4 o0 = (h0 - ms[m][0]) * ms[m][1] * gv[0] + bv[0] + acc[ai][bj][m][0], o1 = (h1 - ms[m][0]) * ms[m][1] * gv[1] + bv[1] + acc[ai][bj][m][1];
                u32x4 w; w.x = pk2h(o0[0], o0[1]); w.y = pk2h(o0[2], o0[3]); w.z = pk2h(o1[0], o1[1]); w.w = pk2h(o1[2], o1[3]);
                *(u32x4*)(Cw + (size_t)row * ldc + col0 + bj * HALF) = w; }
        }
}
struct EpiResidLn {
    static constexpr bool PERM = true, AFTER_DRAIN = false, PERMA = false;
    bf16_t* C; int ldc; float alpha; const float* st; const float* g; const float* b;
    __device__ __forceinline__ void operator()(const f32x4 (&acc)[2][2][4][2], const Unit& u, int wr, int wc, int fr, int fq) const {
        resid_ln_tile_bf(this->C, this->C, this->st, this->g, this->b, this->ldc, this->alpha, acc, u.pm * BM + wr * 64 + fr, u.pn * BM + wc * 32 + 8 * fq);
    }
};
struct EpiPart {
    static constexpr bool PERM = false, AFTER_DRAIN = false, PERMA = false;
    float* P; int ldc;
    __device__ __forceinline__ void operator()(const f32x4 (&acc)[2][2][4][2], const Unit& u, int wr, int wc, int fr, int fq) const {
        const int row0 = u.kk * BM + wr * 64 + fr, col0 = u.pn * BM + wc * 32 + 4 * fq;
#pragma unroll
        for (int ai = 0; ai < 2; ++ai)
#pragma unroll
            for (int m = 0; m < 4; ++m) { float* rowp = P + (size_t)(row0 + ai * HALF + m * 16) * ldc + col0;
#pragma unroll
                for (int bj = 0; bj < 2; ++bj)
#pragma unroll
                    for (int n = 0; n < 2; ++n) *(f32x4*)(rowp + bj * HALF + n * 16) = acc[ai][bj][m][n]; }
    }
};

__device__ __forceinline__ float dpp_shr1_old(float old, float x) { return __int_as_float(__builtin_amdgcn_update_dpp(__float_as_int(old), __float_as_int(x), 0x111, 0xf, 0xf, false)); }
__device__ __forceinline__ float dpp_shl1_old(float old, float x) { return __int_as_float(__builtin_amdgcn_update_dpp(__float_as_int(old), __float_as_int(x), 0x101, 0xf, 0xf, false)); }
struct EpiFfn {
    static constexpr bool PERM = true, AFTER_DRAIN = false, PERMA = true;
    bf16_t* ACT; float* SIDE; bf16_t* GVM; const float *cw, *cb; PG8_LAS float* X;
    __device__ __forceinline__ void operator()(const f32x4 (&acc)[2][2][4][2], const Unit& u, int wr_in, int wc_in, int fr_in, int fq_in) const {
        int fr = fr_in, fq = fq_in, wr = wr_in, wc = wc_in; asm volatile("" : "+v"(fr), "+v"(fq), "+s"(wr), "+s"(wc));
        const int cj = wc * 32 + 8 * fq, c0 = u.pn * 128 + cj;
        if (u.pm == PMETA) {
#pragma unroll
            for (int ai = 0; ai < 2; ++ai)
#pragma unroll
                for (int m = 0; m < 4; ++m) { bf16_t* rowp = GVM + (size_t)(ai * HALF + wr * 64 + 4 * fr + m) * NUP + c0;
                    *(u32x4*)rowp = pack8(acc[ai][0][m][0], acc[ai][0][m][1]); *(u32x4*)(rowp + DFF) = pack8(acc[ai][1][m][0], acc[ai][1][m][1]); }
            return;
        }
        f32x4 w0[2], w1[2], w2[2], bb[2];
#pragma unroll
        for (int n = 0; n < 2; ++n) { w0[n] = *(const f32x4*)(cw + c0 + 4 * n); w1[n] = *(const f32x4*)(cw + DFF + c0 + 4 * n); w2[n] = *(const f32x4*)(cw + 2 * DFF + c0 + 4 * n); bb[n] = *(const f32x4*)(cb + c0 + 4 * n); }
#pragma unroll
        for (int ai = 0; ai < 2; ++ai) { const int b = 2 * ai + wr;
            if (fr == 0) { *(PG8_LAS f32x4*)(X + (b * 2 + 0) * 128 + cj) = acc[ai][0][0][0]; *(PG8_LAS f32x4*)(X + (b * 2 + 0) * 128 + cj + 4) = acc[ai][0][0][1]; }
            if (fr == 15) { *(PG8_LAS f32x4*)(X + (b * 2 + 1) * 128 + cj) = acc[ai][0][3][0]; *(PG8_LAS f32x4*)(X + (b * 2 + 1) * 128 + cj + 4) = acc[ai][0][3][1]; } }
        asm volatile("s_waitcnt lgkmcnt(0)" ::: "memory"); __builtin_amdgcn_s_barrier(); asm volatile("" ::: "memory");
        const unsigned rowb = (unsigned)(u.pm * BM + wr * 64 + 4 * fr) * DFF + c0;
#pragma unroll
        for (int ai = 0; ai < 2; ++ai) { const int b = 2 * ai + wr;
            f32x4 xp[2], xn[2];
#pragma unroll
            for (int n = 0; n < 2; ++n) { xp[n] = b > 0 ? *(const PG8_LAS f32x4*)(X + ((b - 1) * 2 + 1) * 128 + cj + 4 * n) : (f32x4){0.f, 0.f, 0.f, 0.f};
                                          xn[n] = b < 3 ? *(const PG8_LAS f32x4*)(X + ((b + 1) * 2 + 0) * 128 + cj + 4 * n) : (f32x4){0.f, 0.f, 0.f, 0.f}; }
            f32x4 up0[2], dn3[2];
#pragma unroll
            for (int n = 0; n < 2; ++n)
#pragma unroll
                for (int e = 0; e < 4; ++e) { up0[n][e] = dpp_shr1_old(xp[n][e], acc[ai][0][3][n][e]); dn3[n][e] = dpp_shl1_old(xn[n][e], acc[ai][0][0][n][e]); }
#pragma unroll
            for (int m = 0; m < 4; ++m) { u32x4 ow;
#pragma unroll
                for (int n = 0; n < 2; ++n) {
                    const f32x4 g = acc[ai][0][m][n], pv = m > 0 ? acc[ai][0][m > 0 ? m - 1 : 0][n] : up0[n], nx = m < 3 ? acc[ai][0][m < 3 ? m + 1 : 3][n] : dn3[n];
                    const f32x4 x = w0[n] * pv + w1[n] * g + w2[n] * nx + bb[n]; f32x4 t, o;
#pragma unroll
                    for (int e = 0; e < 4; ++e) t[e] = __expf(-x[e]);
                    t = t + 1.f;
#pragma unroll
                    for (int e = 0; e < 4; ++e) t[e] = __builtin_amdgcn_rcpf(t[e]);
                    o = x * t * acc[ai][1][m][n];
                    if (n == 0) { ow.x = pk2(o[0], o[1]); ow.y = pk2(o[2], o[3]); } else { ow.z = pk2(o[0], o[1]); ow.w = pk2(o[2], o[3]); } }
                bf16_t* dst = ACT + (rowb + (unsigned)(ai * HALF + m) * DFF);
                if (ai == 0 ? m < 2 : m >= 2) {
                    const int r = ai * HALF + wr * 64 + 4 * fr + m;
                    if (r != 0 && r != 255) *(u32x4*)dst = ow;
                    const int slot = r == 0 ? 0 : r == 1 ? 1 : r == 254 ? 2 : r == 255 ? 3 : -1;
                    if (slot >= 0) { float* sp = SIDE + ((size_t)u.pm * 6 + slot) * DFF + c0; *(f32x4*)sp = acc[ai][0][m][0]; *(f32x4*)(sp + 4) = acc[ai][0][m][1];
                        if (slot == 0 || slot == 3) { float* vp = SIDE + ((size_t)u.pm * 6 + (slot == 0 ? 4 : 5)) * DFF + c0; *(f32x4*)vp = acc[ai][1][m][0]; *(f32x4*)(vp + 4) = acc[ai][1][m][1]; } }
                } else *(u32x4*)dst = ow;
            }
        }
    }
};
template <class Epi, class Sched, bool ALIGN_EPI = false, bool SP2 = false>
__device__ __forceinline__ void gemm_phase(PG8_LAS unsigned char* lds, const Gemm g, const Sched& S, const Epi& E) {
    int tid_ = threadIdx.x; asm volatile("" : "+v"(tid_));
    const int tid = tid_, wid = __builtin_amdgcn_readfirstlane(tid >> 6), lane = tid & 63, wr = wid >> 2, wc = wid & 3, fr = lane & 15, fq = lane >> 4;
    const int K = g.ld, nt = g.K / BK;
    unsigned voffA[2], voffB[2];
#pragma unroll
    for (int i = 0; i < 2; ++i) { int R, C; stage_rc(tid * 16 + i * 8192, R, C); const int Rb = Epi::PERM ? ((R & ~31) + perm32(R & 31)) : R;
        const int Ra = Epi::PERMA ? ((R & ~63) | ((R & 15) << 2) | ((R >> 4) & 3)) : R;
        voffA[i] = (unsigned)(Ra * K + C) * 2u; voffB[i] = (unsigned)(Rb * K + C) * 2u; }
    const size_t kstep = (size_t)(BK * 2);
    const size_t hstep = (size_t)HALF * K * 2;
    const size_t tstep = 2 * hstep;
    const unsigned ldsw = (unsigned)wid * 1024u;
    const int aoff = lds_byte(wr * 64 + fr, fq * 8), boff = lds_byte(wc * 32 + fr, fq * 8);
#define PG8_SA(b, h) (((b) * 2 + (h)) * HTB)
#define PG8_SB(b, h) ((4 + (b) * 2 + (h)) * HTB)
#define PG8_STAGE(bufoff, gbase, voff) do { _Pragma("unroll") for (int _i = 0; _i < 2; ++_i) \
        __builtin_amdgcn_global_load_lds((const unsigned*)((const char*)(gbase) + (voff)[_i]), (PG8_LAS unsigned*)(lds + (bufoff) + ldsw + _i * 8192), 16, 0, 0); } while (0)
#define PG8_LDA(dst, b, h) do { _Pragma("unroll") for (int m = 0; m < 4; ++m) _Pragma("unroll") for (int k = 0; k < 2; ++k) dst[m][k] = *(const PG8_LAS bf16x8*)(lds + PG8_SA(b, h) + aoff + m * 2048 + k * 1024); } while (0)
#define PG8_LDB(dst, b, h) do { _Pragma("unroll") for (int n = 0; n < 2; ++n) _Pragma("unroll") for (int k = 0; k < 2; ++k) dst[n][k] = *(const PG8_LAS bf16x8*)(lds + PG8_SB(b, h) + boff + n * 2048 + k * 1024); } while (0)
#define PG8_MMA(ai, bj, At, Bt) do { __builtin_amdgcn_s_setprio(1); _Pragma("unroll") for (int m = 0; m < 4; ++m) _Pragma("unroll") for (int n = 0; n < 2; ++n) _Pragma("unroll") for (int k = 0; k < 2; ++k) \
        acc[ai][bj][m][n] = __builtin_amdgcn_mfma_f32_16x16x32_bf16(Bt[n][k], At[m][k], acc[ai][bj][m][n], 0, 0, 0); __builtin_amdgcn_s_setprio(0); } while (0)
#define PG8_WAIT_V(n) asm volatile("s_waitcnt vmcnt(" #n ")" ::: "memory")
#define PG8_WAIT_L(n) asm volatile("s_waitcnt lgkmcnt(" #n ")" ::: "memory")
#define PG8_BAR __builtin_amdgcn_s_barrier()
#define PG8_SCHED __builtin_amdgcn_sched_barrier(0)
    Unit cur, nxt; int ui = 0;
    if (!S.next(0, cur)) return;
    f32x4 acc[2][2][4][2];
#pragma unroll
    for (int a = 0; a < 2; ++a)
#pragma unroll
        for (int b = 0; b < 2; ++b)
#pragma unroll
            for (int m = 0; m < 4; ++m)
#pragma unroll
                for (int n = 0; n < 2; ++n) acc[a][b][m][n] = (f32x4){0.f, 0.f, 0.f, 0.f};
    bf16x8 At[4][2], B0[2][2], B1[2][2];
    const size_t sstep = (size_t)g.K * 2;
    const char* cA = (const char*)g.A + (size_t)cur.pm * tstep + (size_t)cur.kk * sstep; const char* cB = (const char*)g.Bt + (size_t)cur.pn * tstep + (size_t)cur.kk * sstep;
    S.a_ready(cur);
    if constexpr (SP2) {
        PG8_STAGE(PG8_SB(0, 0), cB, voffB); PG8_STAGE(PG8_SB(0, 1), cB + hstep, voffB); PG8_STAGE(PG8_SA(0, 0), cA, voffA); PG8_STAGE(PG8_SA(0, 1), cA + hstep, voffA);
        if (wr == 1) PG8_BAR;
        PG8_WAIT_V(2); PG8_BAR;
        PG8_STAGE(PG8_SB(1, 0), cB + kstep, voffB); PG8_STAGE(PG8_SA(1, 0), cA + kstep, voffA); PG8_STAGE(PG8_SB(1, 1), cB + hstep + kstep, voffB);
        PG8_WAIT_V(6); PG8_BAR;
    } else {
        PG8_STAGE(PG8_SB(0, 0), cB, voffB); PG8_STAGE(PG8_SA(0, 0), cA, voffA); PG8_STAGE(PG8_SB(0, 1), cB + hstep, voffB); PG8_STAGE(PG8_SA(0, 1), cA + hstep, voffA);
        if (wr == 1) PG8_BAR;
        PG8_WAIT_V(4); PG8_BAR;
        PG8_STAGE(PG8_SB(1, 0), cB + kstep, voffB); PG8_STAGE(PG8_SA(1, 0), cA + kstep, voffA); PG8_STAGE(PG8_SB(1, 1), cB + hstep + kstep, voffB);
        PG8_WAIT_V(6); PG8_BAR;
    }
    for (;;) {
        const bool has_next = S.next(ui + 1, nxt);
        const char* nA = has_next ? (const char*)g.A + (size_t)nxt.pm * tstep + (size_t)nxt.kk * sstep : cA; const char* nB = has_next ? (const char*)g.Bt + (size_t)nxt.pn * tstep + (size_t)nxt.kk * sstep : cB;
        for (int t = 0; t < nt; t += 2) {
            const bool last = (t == nt - 2);
            const char* a1 = cA + (size_t)(t + 1) * kstep;
            const char* a2 = last ? nA : cA + (size_t)(t + 2) * kstep; const char* b2 = last ? nB : cB + (size_t)(t + 2) * kstep;
            const char* a3 = a2 + kstep; const char* b3 = b2 + kstep;
            if (last && has_next) S.a_ready(nxt);
            if constexpr (SP2) {
            PG8_LDB(B0, 0, 0); PG8_LDB(B1, 0, 1); PG8_SCHED; PG8_LDA(At, 0, 0); PG8_STAGE(PG8_SA(1, 1), a1 + hstep, voffA);
            PG8_WAIT_V(8); PG8_WAIT_L(0); PG8_BAR; PG8_MMA(0, 0, At, B0); PG8_MMA(0, 1, At, B1); PG8_BAR; PG8_SCHED;
            PG8_LDA(At, 0, 1); PG8_STAGE(PG8_SB(0, 0), b2, voffB); PG8_STAGE(PG8_SB(0, 1), b2 + hstep, voffB); PG8_STAGE(PG8_SA(0, 0), a2, voffA);
            PG8_WAIT_V(8); PG8_WAIT_L(0); PG8_BAR; PG8_MMA(1, 0, At, B0); PG8_MMA(1, 1, At, B1); PG8_BAR; PG8_SCHED;
            PG8_LDB(B0, 1, 0); PG8_LDB(B1, 1, 1); PG8_SCHED; PG8_LDA(At, 1, 0); PG8_STAGE(PG8_SA(0, 1), a2 + hstep, voffA);
            PG8_WAIT_V(8); PG8_WAIT_L(0); PG8_BAR; PG8_MMA(0, 0, At, B0); PG8_MMA(0, 1, At, B1); PG8_BAR; PG8_SCHED;
            PG8_LDA(At, 1, 1); PG8_STAGE(PG8_SB(1, 0), b3, voffB); PG8_STAGE(PG8_SB(1, 1), b3 + hstep, voffB); PG8_STAGE(PG8_SA(1, 0), a3, voffA);
            PG8_WAIT_V(8); PG8_WAIT_L(0); PG8_BAR; PG8_MMA(1, 0, At, B0); PG8_MMA(1, 1, At, B1); PG8_BAR; PG8_SCHED;
            } else {
            PG8_LDB(B0, 0, 0); PG8_SCHED; PG8_LDA(At, 0, 0); PG8_STAGE(PG8_SA(1, 1), a1 + hstep, voffA);
            PG8_WAIT_L(8); PG8_BAR; PG8_WAIT_L(0); PG8_MMA(0, 0, At, B0); PG8_BAR; PG8_SCHED;
            PG8_LDB(B1, 0, 1); PG8_STAGE(PG8_SB(0, 0), b2, voffB);
            PG8_BAR; PG8_WAIT_L(0); PG8_MMA(0, 1, At, B1); PG8_BAR;
            PG8_LDA(At, 0, 1); PG8_STAGE(PG8_SA(0, 0), a2, voffA);
            PG8_BAR; PG8_WAIT_L(0); PG8_MMA(1, 0, At, B0); PG8_BAR; PG8_SCHED;
            PG8_STAGE(PG8_SB(0, 1), b2 + hstep, voffB);
            PG8_WAIT_V(6); PG8_BAR; PG8_MMA(1, 1, At, B1); PG8_BAR;
            PG8_LDB(B0, 1, 0); PG8_SCHED; PG8_LDA(At, 1, 0); PG8_STAGE(PG8_SA(0, 1), a2 + hstep, voffA);
            PG8_WAIT_L(8); PG8_BAR; PG8_WAIT_L(0); PG8_MMA(0, 0, At, B0); PG8_BAR; PG8_SCHED;
            PG8_LDB(B1, 1, 1); PG8_STAGE(PG8_SB(1, 0), b3, voffB);
            PG8_BAR; PG8_WAIT_L(0); PG8_MMA(0, 1, At, B1); PG8_BAR;
            PG8_LDA(At, 1, 1); PG8_STAGE(PG8_SA(1, 0), a3, voffA);
            PG8_BAR; PG8_WAIT_L(0); PG8_MMA(1, 0, At, B0); PG8_BAR; PG8_SCHED;
            PG8_STAGE(PG8_SB(1, 1), b3 + hstep, voffB);
            PG8_WAIT_V(6); PG8_BAR; PG8_MMA(1, 1, At, B1); PG8_BAR;
            }
        }
        if constexpr (ALIGN_EPI) { if (wr == 0) PG8_BAR; }
        if constexpr (!Epi::AFTER_DRAIN) { E(acc, cur, wr, wc, fr, fq); S.done(cur); }
        if (!has_next) break;
#pragma unroll
        for (int a = 0; a < 2; ++a)
#pragma unroll
            for (int b = 0; b < 2; ++b)
#pragma unroll
                for (int m = 0; m < 4; ++m)
#pragma unroll
                    for (int n = 0; n < 2; ++n) acc[a][b][m][n] = (f32x4){0.f, 0.f, 0.f, 0.f};
        cur = nxt; cA = nA; cB = nB; ++ui;
        if constexpr (ALIGN_EPI) { if (wr == 1) PG8_BAR; }
    }
    PG8_WAIT_V(0);
    if constexpr (!ALIGN_EPI) { if (wr == 0) PG8_BAR; }
    PG8_BAR;
    if constexpr (Epi::AFTER_DRAIN) { E.fused(acc, cur, wr, wc, fr, fq, lds, wid, lane); S.done(cur); }
#undef PG8_SA
#undef PG8_SB
#undef PG8_STAGE
#undef PG8_LDA
#undef PG8_LDB
#undef PG8_MMA
#undef PG8_WAIT_V
#undef PG8_WAIT_L
#undef PG8_BAR
#undef PG8_SCHED
}
}
#define XB_TMO      128
#define XB_XCNT(j)  (256  + 64 * (j))
#define XB_XSUB(j)  (1280 + 64 * (j))
#define XB_XGEN(j)  (2304 + 64 * (j))
#define XB_TOP      3328
#define XB_TOPGEN   3392
#define XCD_BAR_WORDS 3456
#define XB_SPIN_CAP (1u << 21)

__device__ __forceinline__ unsigned xb_ld(unsigned* p)              { return __hip_atomic_load(p, __ATOMIC_RELAXED, __HIP_MEMORY_SCOPE_AGENT); }
__device__ __forceinline__ unsigned xb_add(unsigned* p, unsigned v) { return __hip_atomic_fetch_add(p, v, __ATOMIC_RELAXED, __HIP_MEMORY_SCOPE_AGENT); }
__device__ __forceinline__ unsigned xb_xcc_id() { return (unsigned)__builtin_amdgcn_s_getreg((3 << 11) | 20) & 0xFu; }
#define XB_SPIN(cond, bar) do { unsigned _sp = 0; while (cond) { __builtin_amdgcn_s_sleep(1); \
    if ((++_sp & 255u) == 0u) { if (xb_ld(&(bar)[XB_TMO])) break; if (_sp > XB_SPIN_CAP) { atomicAdd(&(bar)[XB_TMO], 1u); break; } } } } while (0)

struct XcdBarrier {
    unsigned* bar; unsigned x;
    volatile LAS unsigned* st;
};

__device__ __forceinline__ XcdBarrier xcd_barrier_post(unsigned* bar, volatile LAS unsigned* st) {
    XcdBarrier b; b.bar = bar; b.x = (unsigned)__builtin_amdgcn_readfirstlane((int)xb_xcc_id()); b.st = st;
    if (threadIdx.x == 0) (void)xb_add(&bar[XB_XCNT(b.x)], 1u);
    return b;
}
__device__ __forceinline__ void xcd_barrier_complete(unsigned* bar, unsigned x, unsigned& nloc, unsigned& nx) {
    const unsigned G = gridDim.x * gridDim.y * gridDim.z;
    unsigned sum, cnt, mine, sp = 0u;
    for (;;) {
        sum = 0u; cnt = 0u; mine = 0u;
#pragma unroll
        for (unsigned j = 0; j < 16; ++j) { const unsigned c = xb_ld(&bar[XB_XCNT(j)]); sum += c; cnt += (c > 0u) ? 1u : 0u; }
        mine = xb_ld(&bar[XB_XCNT(x)]);
        if (sum == G) { mine = xb_ld(&bar[XB_XCNT(x)]); break; }
        __builtin_amdgcn_s_sleep(1);
        if ((++sp & 255u) == 0u) { if (xb_ld(&bar[XB_TMO])) break; if (sp > XB_SPIN_CAP) { atomicAdd(&bar[XB_TMO], 1u); break; } }
    }
    nloc = mine > 0u ? mine : 1u; nx = cnt > 0u ? cnt : 1u;
}

__device__ __forceinline__ void xcd_barrier(const XcdBarrier& b) {
    asm volatile("s_waitcnt vmcnt(0)" ::: "memory");
    __syncthreads();
    if (threadIdx.x == 0) {
        unsigned* bar = b.bar; unsigned bx_ = b.x;
        asm volatile("" : "+s"(bx_));
        __builtin_amdgcn_s_waitcnt(0);
        unsigned nloc = b.st[0], nx = b.st[1];
        if (nloc == 0u) { xcd_barrier_complete(bar, bx_, nloc, nx); b.st[0] = nloc; b.st[1] = nx; }
        const unsigned old = xb_add(&bar[XB_XSUB(bx_)], 1u);
        const unsigned gen = old / nloc;
        if (old + 1u == (gen + 1u) * nloc) {
            __builtin_amdgcn_fence(__ATOMIC_RELEASE, "agent");
            asm volatile("s_waitcnt vmcnt(0)" ::: "memory");
            const unsigned og = xb_add(&bar[XB_TOP], 1u);
            const unsigned tg = og / nx;
            if (og + 1u == (tg + 1u) * nx) xb_add(&bar[XB_TOPGEN], 1u);
            else XB_SPIN(xb_ld(&bar[XB_TOPGEN]) == tg, bar);
            __builtin_amdgcn_fence(__ATOMIC_ACQUIRE, "agent");
            xb_add(&bar[XB_XGEN(bx_)], 1u);
            asm volatile("s_waitcnt vmcnt(0)" ::: "memory");
        } else {
            XB_SPIN(xb_ld(&bar[XB_XGEN(bx_)]) == gen, bar);
            __builtin_amdgcn_fence(__ATOMIC_ACQUIRE, "agent");
            asm volatile("s_waitcnt vmcnt(0)" ::: "memory");
        }
    }
    __syncthreads();
}

typedef unsigned short bf16_t;
typedef short bf16x8 __attribute__((ext_vector_type(8)));
typedef float f32x4 __attribute__((ext_vector_type(4)));
typedef unsigned u32x4 __attribute__((ext_vector_type(4)));
#define LDS_WAIT() asm volatile("s_waitcnt lgkmcnt(0)" ::: "memory")

struct Params {
    const float* in[19];
};
struct Frame {
    LAS unsigned char* lds;
    int tid, lane, wave, G, bx, vcu, gw, ngw;
};
__device__ __forceinline__ const float* uptr(const LAS unsigned long long* t, int k) {
    const unsigned long long v = t[k]; const unsigned lo = __builtin_amdgcn_readfirstlane((unsigned)v), hi = __builtin_amdgcn_readfirstlane((unsigned)(v >> 32));
    return (const float*)(const GAS float*)(((unsigned long long)hi << 32) | lo); }

template <class CMap>
__device__ __forceinline__ void transpose_load(float (&v)[32], const float* W, int Nsrc, const float* ks, int kb, int nb, int lane, CMap cmap) {
    const int k0 = 64 * kb, n0 = 32 * nb; const int sc = cmap(n0 + (lane & 31));
#pragma unroll
    for (int i = 0; i < 32; ++i) { const int kk = 2 * i + (lane >> 5); float x = 0.f; if (sc >= 0) x = W[(size_t)(k0 + kk) * Nsrc + sc]; if (ks) x *= ks[k0 + kk]; v[i] = x; }
}
__device__ __forceinline__ void transpose_store(const float (&v)[32], int K, bf16_t* WT, LAS float* scr, int kb, int nb, int lane) {
    const int k0 = 64 * kb, n0 = 32 * nb;
#pragma unroll
    for (int i = 0; i < 32; ++i) scr[(2 * i + (lane >> 5)) * 33 + (lane & 31)] = v[i];
    LDS_WAIT(); asm volatile("" ::: "memory");
    const int c = lane & 7;
#pragma unroll
    for (int j = 0; j < 4; ++j) { const int n = (lane >> 3) + 8 * j; const LAS float* s = scr + (8 * c) * 33 + n;
        u32x4 o; o.x = pk2(s[0 * 33], s[1 * 33]); o.y = pk2(s[2 * 33], s[3 * 33]); o.z = pk2(s[4 * 33], s[5 * 33]); o.w = pk2(s[6 * 33], s[7 * 33]);
        *(u32x4*)(WT + (size_t)(n0 + n) * K + k0 + 8 * c) = o; }
    LDS_WAIT(); asm volatile("" ::: "memory");
}
template <class CMap>
__device__ __forceinline__ void transpose_matrix(const Frame& F, const float* W, int K, int Nsrc, int Ndst, bf16_t* WT, const float* ks, LAS float* scr, CMap cmap) {
    const int nnb = Ndst / 32, items = (K / 64) * nnb;
    for (int it = F.gw; it < items; it += 2 * F.ngw) { const int it2 = it + F.ngw; float va[32], vb[32];
        transpose_load(va, W, Nsrc, ks, it / nnb, it % nnb, F.lane, cmap);
        if (it2 < items) transpose_load(vb, W, Nsrc, ks, it2 / nnb, it2 % nnb, F.lane, cmap);
        transpose_store(va, K, WT, scr, it / nnb, it % nnb, F.lane);
        if (it2 < items) transpose_store(vb, K, WT, scr, it2 / nnb, it2 % nnb, F.lane); }
}
__device__ __forceinline__ int rope_perm(int m) { const int g = m >> 3, j = m & 7; return j < 4 ? 4 * g + j : 32 + 4 * g + (j - 4); }
struct CMapIn { __device__ int operator()(int n) const {
    if (n < 4096) return n; if (n < 4608) return 4112 + (n - 4096); if (n < 4864) return 4624 + (n - 4608);
    if (n < 4928) return 4880 + rope_perm(n - 4864); if (n < 4944) return 4096 + (n - 4928); return -1; } };
struct CMapQ { __device__ int operator()(int n) const { const int h = n / 192, o = n % 192; return o < 128 ? n : h * 192 + 128 + rope_perm(o - 128); } };
struct CMapUp { __device__ int operator()(int n) const { const int pn = n >> 8, j = n & 255; return j < 128 ? 128 * pn + j : DFF + 128 * pn + (j - 128); } };
struct CMapId { __device__ int operator()(int n) const { return n; } };

__device__ __forceinline__ void convert_weights(const Frame& F, unsigned char* ws_, const LAS unsigned long long* pt, int l, size_t wo, int slot) {
    unsigned char* ws = ws_ + wo;
    LAS float* scr = (LAS float*)(F.lds + F.wave * 8448);
    if (slot != 1) {
        const float* w_in = uptr(pt, 3) + (size_t)l * DM * INC; const float* w_uq = uptr(pt, 8) + (size_t)l * 512 * NQ; const float* w_ukv = uptr(pt, 9) + (size_t)l * 256 * NKV;
        const float* w_out = uptr(pt, 10) + (size_t)l * DM * DM; const float* w_dn = uptr(pt, 16) + (size_t)l * DFF * DM;
        const float* qg = uptr(pt, 6) + (size_t)l * 512; const float* kvg = uptr(pt, 7) + (size_t)l * 256;
        transpose_matrix(F, w_in, DM, INC, NIN, (bf16_t*)(ws + WS_WIN), nullptr, scr, CMapIn());
        transpose_matrix(F, w_uq, 512, NQ, NQ, (bf16_t*)(ws + WS_WUQ), qg, scr, CMapQ());
        transpose_matrix(F, w_ukv, 256, NKV, NKV, (bf16_t*)(ws + WS_WUKV), kvg, scr, CMapId());
        transpose_matrix(F, w_out, DM, DM, DM, (bf16_t*)(ws + WS_WOUT), nullptr, scr, CMapId());
        transpose_matrix(F, w_dn, DFF, DM, DM, (bf16_t*)(ws + WS_WDN), nullptr, scr, CMapId());
    }
    if (slot != 0) { const float* w_up = uptr(pt, 13) + (size_t)l * DM * NUP;
        transpose_matrix(F, w_up, DM, NUP, NUP, (bf16_t*)(ws + WS_WUP), nullptr, scr, CMapUp()); }
}
__device__ __forceinline__ void prologue(const Frame& F, unsigned char* ws, const LAS unsigned long long* pt) {
    float* COS = (float*)(ws + WS_COS); float* SIN = (float*)(ws + WS_SIN);
    for (int i = F.bx * 512 + F.tid; i < 4112 * 32; i += F.G * 512) { const int pos = i >> 5, f = i & 31;
        const float inv = powf(10000.0f, -(float)(2 * f) / 64.0f); const float ang = (float)pos * inv; float s, c; sincosf(ang, &s, &c); COS[i] = c; SIN[i] = s; }
    { float* PAR = (float*)(ws + WS_PAR); const int gt = F.bx * 512 + F.tid, nt = F.G * 512;
      for (int i = gt; i < DEPTH * 16; i += nt) PAR[PO_BG + i] = uptr(pt, 4)[i];
      for (int i = gt; i < DEPTH * 1024; i += nt) PAR[PO_MLG + i] = uptr(pt, 5)[i];
      for (int i = gt; i < DEPTH * 512; i += nt) PAR[PO_QG + i] = uptr(pt, 6)[i];
      for (int i = gt; i < DEPTH * 256; i += nt) PAR[PO_KVG + i] = uptr(pt, 7)[i];
      for (int i = gt; i < 2048; i += nt) { PAR[PO_ONE + i] = 1.f; PAR[PO_ZERO + i] = 0.f; }
      { float* ST2 = (float*)(ws + WS_STAT2); for (int i = gt; i < TP; i += nt) { ST2[2 * i] = 0.f; ST2[2 * i + 1] = 1.f; } }
      for (int i = gt; i < DEPTH * 2048; i += nt) { PAR[PO_L1G + i] = uptr(pt, 11)[i]; PAR[PO_L1B + i] = uptr(pt, 12)[i]; PAR[PO_L2G + i] = uptr(pt, 17)[i]; PAR[PO_L2B + i] = uptr(pt, 18)[i]; }
      for (int i = gt; i < DEPTH * 3 * 5632; i += nt) PAR[PO_CW + i] = uptr(pt, 14)[i];
      for (int i = gt; i < DEPTH * 5632; i += nt) PAR[PO_CB + i] = uptr(pt, 15)[i]; }
    float* H = (float*)(ws + WS_H); bf16_t* HB = (bf16_t*)(ws + WS_HB);
    const float* xp = uptr(pt, 0); const float* xs = uptr(pt, 1); const float* mt = uptr(pt, 2);
    for (int row0 = F.gw; row0 < TP; row0 += 2 * F.ngw) {
        f32x4 v[2][8];
#pragma unroll
        for (int r = 0; r < 2; ++r) { const int row = row0 + r * F.ngw; const float* src = nullptr;
            if (row < 4 * LREAL) src = xp + (size_t)row * DM; else if (row < NMAIN) src = xs + (size_t)(row - 4 * LREAL) * DM; else if (row < NTOK) src = mt + (size_t)((row - NMAIN) & 15) * DM;
#pragma unroll
            for (int j = 0; j < 8; ++j) { v[r][j] = (f32x4){0.f, 0.f, 0.f, 0.f}; if (src) v[r][j] = ((const f32x4*)src)[F.lane + 64 * j]; } }
#pragma unroll
        for (int r = 0; r < 2; ++r) { const int row = row0 + r * F.ngw; if (row < TP) {
            f32x4* hd = (f32x4*)(H + (size_t)row * DM) + F.lane; u32x2* bd = (u32x2*)(HB + (size_t)row * DM) + F.lane; u32x2* hb = (u32x2*)((bf16_t*)H + (size_t)row * DM) + F.lane;
#pragma unroll
            for (int j = 0; j < 8; ++j) { const f32x4 x = v[r][j];
                u32x2 w; w.x = pk2(x[0], x[1]); w.y = pk2(x[2], x[3]); bd[64 * j] = w;
                if (row >= NMAIN) hd[64 * j] = x * ALPHA;
                else { u32x2 wh; wh.x = pk2h(x[0], x[1]); wh.y = pk2h(x[2], x[3]); hb[64 * j] = wh; } } } }
    }
}

__device__ __forceinline__ void ln_one(const f32x4 (&vin)[8], int row, int lane, float* __restrict__ Hw, bf16_t* __restrict__ HB, const float* __restrict__ g, const float* __restrict__ b, float* __restrict__ ST) {
    f32x4 v[8]; float s = 0.f;
#pragma unroll
    for (int j = 0; j < 8; ++j) { v[j] = vin[j]; s += (v[j][0] + v[j][1]) + (v[j][2] + v[j][3]); }
    const float mean = wave_sum(s) * (1.f / DM); float q = 0.f;
#pragma unroll
    for (int j = 0; j < 8; ++j) { v[j] = v[j] - mean; q += (v[j][0] * v[j][0] + v[j][1] * v[j][1]) + (v[j][2] * v[j][2] + v[j][3] * v[j][3]); }
    const float rstd = rsqrtf(wave_sum(q) * (1.f / DM) + EPS);
    if (lane == 0) { f32x2 ms = {mean, rstd}; *(f32x2*)(ST + (size_t)row * 2) = ms; }
    u32x2* bd = (u32x2*)(HB + (size_t)row * DM) + lane; f32x4* hp = (f32x4*)(Hw + (size_t)row * DM) + lane;
#pragma unroll
    for (int j = 0; j < 8; ++j) { const f32x4 gg = ((const f32x4*)g)[lane + 64 * j], bb = ((const f32x4*)b)[lane + 64 * j]; const f32x4 y = v[j] * rstd * gg + bb;
        u32x2 w; w.x = pk2(y[0], y[1]); w.y = pk2(y[2], y[3]); bd[64 * j] = w;
        hp[64 * j] = y * ALPHA; }
}
__device__ __forceinline__ void ln_one_bf(const u32x4 (&vin)[4], int row, int lane, bf16_t* __restrict__ HB, const float* __restrict__ g, const float* __restrict__ b, float* __restrict__ ST, float* __restrict__ out) {
    f32x4 v[8]; float s = 0.f;
#pragma unroll
    for (int j = 0; j < 4; ++j) { v[2 * j] = (f32x4){hf_lo(vin[j].x), hf_hi(vin[j].x), hf_lo(vin[j].y), hf_hi(vin[j].y)}; v[2 * j + 1] = (f32x4){hf_lo(vin[j].z), hf_hi(vin[j].z), hf_lo(vin[j].w), hf_hi(vin[j].w)}; }
#pragma unroll
    for (int j = 0; j < 8; ++j) s += (v[j][0] + v[j][1]) + (v[j][2] + v[j][3]);
    const float mean = wave_sum(s) * (1.f / DM); float q = 0.f;
#pragma unroll
    for (int j = 0; j < 8; ++j) { v[j] = v[j] - mean; q += (v[j][0] * v[j][0] + v[j][1] * v[j][1]) + (v[j][2] * v[j][2] + v[j][3] * v[j][3]); }
    const float rstd = rsqrtf(wave_sum(q) * (1.f / DM) + EPS);
    if (lane == 0) { f32x2 ms = {mean, rstd}; *(f32x2*)(ST + (size_t)row * 2) = ms; }
    u32x4* bd = (u32x4*)(HB + (size_t)row * DM) + lane;
#pragma unroll
    for (int j = 0; j < 4; ++j) { const int c4 = 2 * (lane + 64 * j);
        const f32x4 y0 = v[2 * j] * rstd * ((const f32x4*)g)[c4] + ((const f32x4*)b)[c4], y1 = v[2 * j + 1] * rstd * ((const f32x4*)g)[c4 + 1] + ((const f32x4*)b)[c4 + 1];
        if (out) { f32x4* op = (f32x4*)(out + (size_t)row * DM) + c4; op[0] = y0; op[1] = y1; }
        else bd[64 * j] = pg8::pack8(y0, y1); }
}
__device__ __forceinline__ void ln_rows(const Frame& F, float* H, bf16_t* HB, const float* g, const float* b, float* ST, float* out, const float* PART, int nk) {
    const bf16_t* __restrict__ Hr = (const bf16_t*)H;
    for (int row = F.gw; row < NMAIN; row += 4 * F.ngw) {
        const int row2 = row + F.ngw, row3 = row + 2 * F.ngw, row4 = row + 3 * F.ngw;
        u32x4 va[4], vb[4], vc[4], vd[4];
#pragma unroll
        for (int j = 0; j < 4; ++j) va[j] = ((const u32x4*)(Hr + (size_t)row * DM))[F.lane + 64 * j];
#pragma unroll
        for (int j = 0; j < 4; ++j) vb[j] = ((const u32x4*)(Hr + (size_t)row2 * DM))[F.lane + 64 * j];
#pragma unroll
        for (int j = 0; j < 4; ++j) vc[j] = ((const u32x4*)(Hr + (size_t)row3 * DM))[F.lane + 64 * j];
#pragma unroll
        for (int j = 0; j < 4; ++j) vd[j] = ((const u32x4*)(Hr + (size_t)row4 * DM))[F.lane + 64 * j];
        ln_one_bf(va, row, F.lane, HB, g, b, ST, out);
        ln_one_bf(vb, row2, F.lane, HB, g, b, ST, out);
        ln_one_bf(vc, row3, F.lane, HB, g, b, ST, out);
        ln_one_bf(vd, row4, F.lane, HB, g, b, ST, out);
    }
    if (F.gw < TP - NMAIN) {
        const int row = NMAIN + F.gw; const float* __restrict__ Hm = H; f32x4 va[8];
#pragma unroll
        for (int j = 0; j < 8; ++j) va[j] = ((const f32x4*)(Hm + (size_t)row * DM))[F.lane + 64 * j];
        const float* __restrict__ pp0 = PART + (size_t)F.gw * DM;
        int k = 0;
        for (; k + 4 <= nk; k += 4) {
            f32x4 t[4][8];
#pragma unroll
            for (int q = 0; q < 4; ++q)
#pragma unroll
                for (int j = 0; j < 8; ++j) t[q][j] = ((const f32x4*)(pp0 + (size_t)(k + q) * 256 * DM))[F.lane + 64 * j];
#pragma unroll
            for (int q = 0; q < 4; ++q)
#pragma unroll
                for (int j = 0; j < 8; ++j) va[j] += t[q][j]; }
        for (; k < nk; ++k) {
#pragma unroll
            for (int j = 0; j < 8; ++j) va[j] += ((const f32x4*)(pp0 + (size_t)k * 256 * DM))[F.lane + 64 * j]; }
        ln_one(va, row, F.lane, H, HB, g, b, ST);
    }
}

__device__ __forceinline__ void rstd_rows(const Frame& F, const bf16_t* UDQ, const bf16_t* UDKV, float* RSTD) {
    for (int row = F.gw; row < TP; row += F.ngw) {
        const u32x4 a = ((const u32x4*)(UDQ + (size_t)row * 512))[F.lane]; float s = 0.f;
#pragma unroll
        for (int j = 0; j < 4; ++j) { const float x = bf_lo(a[j]), y = bf_hi(a[j]); s += x * x + y * y; }
        float t = 0.f;
        if (F.lane < 32) { const u32x4 c = ((const u32x4*)(UDKV + (size_t)row * 256))[F.lane];
#pragma unroll
            for (int j = 0; j < 4; ++j) { const float x = bf_lo(c[j]), y = bf_hi(c[j]); t += x * x + y * y; } }
        s = wave_sum(s); t = wave_sum(t);
        if (F.lane == 0) { RSTD[(size_t)row * 2] = rsqrtf(s * (1.f / 512.f) + EPS); RSTD[(size_t)row * 2 + 1] = rsqrtf(t * (1.f / 256.f) + EPS); }
    }
}

__device__ __forceinline__ void mlstm_finalize(const Frame& F, int gw0, int ngw0, const float* HSUM, const bf16_t* UQKVO, const float* ng, bf16_t* MIX) {
    for (int row = gw0; row < TP; row += ngw0) {
#pragma unroll
        for (int j = 0; j < 4; ++j) {
            f32x4 v = ((const f32x4*)(HSUM + (size_t)row * MLW + 256 * j))[F.lane];
            const float mean = wave_sum((v[0] + v[1]) + (v[2] + v[3])) * (1.f / 256.f); v = v - mean;
            const float rstd = rsqrtf(wave_sum((v[0] * v[0] + v[1] * v[1]) + (v[2] * v[2] + v[3] * v[3])) * (1.f / 256.f) + EPS);
            const f32x4 gg = ((const f32x4*)(ng + 256 * j))[F.lane];
            const u32x2 uo = ((const u32x2*)(UQKVO + (size_t)row * 4096 + 3072 + 256 * j))[F.lane];
            const float o0 = bf_lo(uo.x), o1 = bf_hi(uo.x), o2 = bf_lo(uo.y), o3 = bf_hi(uo.y);
            const float y0 = v[0] * rstd * gg[0] / (1.f + __expf(-o0)), y1 = v[1] * rstd * gg[1] / (1.f + __expf(-o1));
            const float y2 = v[2] * rstd * gg[2] / (1.f + __expf(-o2)), y3 = v[3] * rstd * gg[3] / (1.f + __expf(-o3));
            u32x2 w; w.x = pk2(y0, y1); w.y = pk2(y2, y3); ((u32x2*)(MIX + (size_t)row * DM + 256 * j))[F.lane] = w;
        }
    }
}

__device__ __forceinline__ f32x8 ld8f(const float* p) { const f32x4 a = *(const f32x4*)p, b = *(const f32x4*)(p + 4); return (f32x8){a[0], a[1], a[2], a[3], b[0], b[1], b[2], b[3]}; }
__device__ __forceinline__ f32x8 ld8b(const bf16_t* p) { const u32x4 v = *(const u32x4*)p; return (f32x8){bf_lo(v[0]), bf_hi(v[0]), bf_lo(v[1]), bf_hi(v[1]), bf_lo(v[2]), bf_hi(v[2]), bf_lo(v[3]), bf_hi(v[3])}; }
__device__ __forceinline__ void act_store(bf16_t* dst, const f32x8 gp, const f32x8 gc, const f32x8 gn, const f32x8 vv, const f32x8 w0, const f32x8 w1, const f32x8 w2, const f32x8 bb) {
    float o[8];
#pragma unroll
    for (int i = 0; i < 8; ++i) { const float x = w0[i] * gp[i] + w1[i] * gc[i] + w2[i] * gn[i] + bb[i]; o[i] = x / (1.f + __expf(-x)) * vv[i]; }
    u32x4 w; w.x = pk2(o[0], o[1]); w.y = pk2(o[2], o[3]); w.z = pk2(o[4], o[5]); w.w = pk2(o[6], o[7]); *(u32x4*)dst = w;
}
__device__ __forceinline__ void ffn_fixup(const Frame& F, const float* SIDE, const bf16_t* GVM, bf16_t* ACT, const float* cw, const float* cb) {
    constexpr int NCH = DFF / 8;
    const f32x8 zero = {0.f, 0.f, 0.f, 0.f, 0.f, 0.f, 0.f, 0.f};
    const int gt = F.bx * 512 + F.tid, nt = GRID * 512;
    for (int idx = gt; idx < 192 * 2 * NCH; idx += nt) {
        const int ch = idx % NCH, rsel = (idx / NCH) & 1, pm = idx / (2 * NCH), c0 = 8 * ch, sq = pm >> 4;
        const f32x8 w0 = ld8f(cw + c0), w1 = ld8f(cw + DFF + c0), w2 = ld8f(cw + 2 * DFF + c0), bb = ld8f(cb + c0);
        const float* S0 = SIDE + (size_t)pm * 6 * DFF + c0;
        if (rsel == 0) { const f32x8 gp = (pm & 15) ? ld8f(S0 - 6 * DFF + 3 * DFF) : ld8b(GVM + (size_t)(16 * sq + 15) * NUP + c0);
            act_store(ACT + (size_t)(pm * 256) * DFF + c0, gp, ld8f(S0), ld8f(S0 + DFF), ld8f(S0 + 4 * DFF), w0, w1, w2, bb);
        } else { const f32x8 gn = ((pm & 15) != 15) ? ld8f(S0 + 6 * DFF) : zero;
            act_store(ACT + (size_t)(pm * 256 + 255) * DFF + c0, ld8f(S0 + 2 * DFF), ld8f(S0 + 3 * DFF), gn, ld8f(S0 + 5 * DFF), w0, w1, w2, bb); }
    }
    for (int idx = gt; idx < NSEQ * 16 * NCH; idx += nt) {
        const int ch = idx % NCH, rp = idx / NCH, pp = rp & 15, sq = rp >> 4, c0 = 8 * ch;
        const f32x8 w0 = ld8f(cw + c0), w1 = ld8f(cw + DFF + c0), w2 = ld8f(cw + 2 * DFF + c0), bb = ld8f(cb + c0);
        const bf16_t* G0 = GVM + (size_t)(16 * sq + pp) * NUP + c0;
        const f32x8 gp = pp > 0 ? ld8b(G0 - NUP) : zero, gc = ld8b(G0);
        const f32x8 gn = pp < 15 ? ld8b(G0 + NUP) : ld8f(SIDE + (size_t)(16 * sq) * 6 * DFF + c0);
        act_store(ACT + (size_t)(MROW0 + 16 * sq + pp) * DFF + c0, gp, gc, gn, ld8b(G0 + DFF), w0, w1, w2, bb);
    }
}

namespace att {
constexpr int NW = 8, QBLK = 32, KVBLK = 64, NT = 65;
constexpr int KROW = 400;
constexpr int SHM_V = KVBLK * 128 * 2, SHM_K = KVBLK * KROW;
constexpr int OFF_V = 0, OFF_K = 3 * SHM_V, OFF_WS = OFF_K + 3 * SHM_K, LDS_TOTAL = OFF_WS + NW * 64 * 4;
static_assert(LDS_TOTAL <= RING_BYTES, "attention LDS");
constexpr float SCALE = 0.07216878364870323f;
constexpr float THR = 8.f;
#define SBAR() __builtin_amdgcn_sched_barrier(0)
__device__ __forceinline__ int crow(int r, int hi) { return (r & 3) + 8 * (r >> 2) + 4 * hi; }
__device__ __forceinline__ unsigned cvtpk(float lo, float hi) { unsigned r; asm volatile("v_cvt_pk_bf16_f32 %0, %1, %2" : "=v"(r) : "v"(lo), "v"(hi)); return r; }

template <bool MASK16>
__device__ __forceinline__ void partialSM(f32x16& p0, f32x16& p1, float& m_reg, float& mn, float& alpha) {
    constexpr float C = SCALE * 1.4426950408889634f;
    if (MASK16) {
#pragma unroll
        for (int r = 8; r < 16; ++r) p0[r] = NEGBIG;
#pragma unroll
        for (int r = 0; r < 16; ++r) p1[r] = NEGBIG;
    }
    float pmax = p0[0];
#pragma unroll
    for (int r = 1; r < 16; ++r) pmax = fmaxf(pmax, p0[r]);
#pragma unroll
    for (int r = 0; r < 16; ++r) pmax = fmaxf(pmax, p1[r]);
    { auto rr = __builtin_amdgcn_permlane32_swap(__float_as_uint(pmax), __float_as_uint(pmax), false, false); pmax = fmaxf(__uint_as_float(rr[0]), __uint_as_float(rr[1])); }
    if (__builtin_expect(__all(pmax - m_reg <= THR / SCALE), 1)) { mn = m_reg; alpha = 1.f; }
    else { mn = fmaxf(m_reg, pmax); alpha = __builtin_amdgcn_exp2f((m_reg - mn) * C); m_reg = mn; }
    const float mnC = -mn * C;
#pragma unroll
    for (int r = 0; r < 16; ++r) p0[r] = fmaf(p0[r], C, mnC);
#pragma unroll
    for (int r = 0; r < 16; ++r) p1[r] = fmaf(p1[r], C, mnC);
#pragma unroll
    for (int r = 0; r < 16; ++r) p0[r] = __builtin_amdgcn_exp2f(p0[r]);
}
__device__ __forceinline__ void finishSM(f32x16& p0, f32x16& p1, float alpha, float& l_reg, bf16x8& pa0, bf16x8& pa1, bf16x8& pa2, bf16x8& pa3) {
#pragma unroll
    for (int r = 0; r < 16; ++r) p1[r] = __builtin_amdgcn_exp2f(p1[r]);
    float ps = 0;
#pragma unroll
    for (int r = 0; r < 16; ++r) ps += p0[r];
#pragma unroll
    for (int r = 0; r < 16; ++r) ps += p1[r];
    { auto rr = __builtin_amdgcn_permlane32_swap(__float_as_uint(ps), __float_as_uint(ps), false, false); ps = __uint_as_float(rr[0]) + __uint_as_float(rr[1]); }
    l_reg = l_reg * alpha + ps;
#define PK4(P, BASE, OUT) do { unsigned a0 = cvtpk(P[BASE + 0], P[BASE + 1]), a1 = cvtpk(P[BASE + 2], P[BASE + 3]);   \
    unsigned b0 = cvtpk(P[BASE + 4], P[BASE + 5]), b1 = cvtpk(P[BASE + 6], P[BASE + 7]);                              \
    auto r0 = __builtin_amdgcn_permlane32_swap(a0, b0, false, false); auto r1 = __builtin_amdgcn_permlane32_swap(a1, b1, false, false); \
    u32x4 w = {r0[0], r1[0], r0[1], r1[1]}; OUT = __builtin_bit_cast(bf16x8, w); } while (0)
    PK4(p0, 0, pa0); PK4(p0, 8, pa1); PK4(p1, 0, pa2); PK4(p1, 8, pa3);
#undef PK4
}
__device__ __forceinline__ void qkt(f32x16& p0, f32x16& p1, const LAS char* Ks, const bf16x8* qr, int r32, int hi) {
#pragma unroll
    for (int r = 0; r < 16; ++r) { p0[r] = 0.f; p1[r] = 0.f; }
#pragma unroll
    for (int d0 = 0; d0 < 12; ++d0) { const int cb = (d0 * 16 + hi * 8) * 2;
        const bf16x8 b0 = *(const LAS bf16x8*)(Ks + r32 * KROW + cb);
        const bf16x8 b1 = *(const LAS bf16x8*)(Ks + (32 + r32) * KROW + cb);
        p0 = __builtin_amdgcn_mfma_f32_32x32x16_bf16(b0, qr[d0], p0, 0, 0, 0);
        p1 = __builtin_amdgcn_mfma_f32_32x32x16_bf16(b1, qr[d0], p1, 0, 0, 0); }
}
__device__ __forceinline__ int v_st(int k, int c) { const int kk = (k & ~0xC) | ((k & 4) << 1) | ((k & 8) >> 1); return ((kk >> 3) * 4 + (c >> 5)) * 512 + ((kk & 7) * 32 + (c & 31)) * 2; }
__device__ __forceinline__ int v_rd_base(int lane) { return ((lane & 3) << 3) | (((lane >> 2) & 3) << 6) | (((lane >> 4) & 1) << 5) | (((lane >> 5) & 1) << 8); }
constexpr int v_rd_off(int d0, int ks, int half) { return d0 * 512 + ks * 4096 + half * 2048; }
template <int OFF> __device__ __forceinline__ s16x4 tr_read(int vb) { s16x4 r; asm volatile("ds_read_b64_tr_b16 %0, %1 offset:%2" : "=&v"(r) : "v"(vb), "i"(OFF) : "memory"); return r; }
template <int D0> __device__ __forceinline__ void pv_one(f32x16& od, int vb, bf16x8 pa0, bf16x8 pa1, bf16x8 pa2, bf16x8 pa3) {
    const s16x4 l0 = tr_read<v_rd_off(D0, 0, 0)>(vb), h0 = tr_read<v_rd_off(D0, 0, 1)>(vb), l1 = tr_read<v_rd_off(D0, 1, 0)>(vb), h1 = tr_read<v_rd_off(D0, 1, 1)>(vb);
    const s16x4 l2 = tr_read<v_rd_off(D0, 2, 0)>(vb), h2 = tr_read<v_rd_off(D0, 2, 1)>(vb), l3 = tr_read<v_rd_off(D0, 3, 0)>(vb), h3 = tr_read<v_rd_off(D0, 3, 1)>(vb);
    asm volatile("s_waitcnt lgkmcnt(0)" ::: "memory"); SBAR();
#define PKV(L, H) (bf16x8){L[0], L[1], L[2], L[3], H[0], H[1], H[2], H[3]}
    od = __builtin_amdgcn_mfma_f32_32x32x16_bf16(pa0, PKV(l0, h0), od, 0, 0, 0);
    od = __builtin_amdgcn_mfma_f32_32x32x16_bf16(pa1, PKV(l1, h1), od, 0, 0, 0);
    od = __builtin_amdgcn_mfma_f32_32x32x16_bf16(pa2, PKV(l2, h2), od, 0, 0, 0);
    od = __builtin_amdgcn_mfma_f32_32x32x16_bf16(pa3, PKV(l3, h3), od, 0, 0, 0);
#undef PKV
}
__device__ __forceinline__ void pv_d0(f32x16* o, int vb, bf16x8 pa0, bf16x8 pa1, bf16x8 pa2, bf16x8 pa3) {
    pv_one<0>(o[0], vb, pa0, pa1, pa2, pa3); pv_one<1>(o[1], vb, pa0, pa1, pa2, pa3); pv_one<2>(o[2], vb, pa0, pa1, pa2, pa3); pv_one<3>(o[3], vb, pa0, pa1, pa2, pa3);
}

__device__ __forceinline__ void attn_unit(int s, int h, int qb, const bf16_t* __restrict__ MQ, const bf16_t* __restrict__ MKV, const bf16_t* __restrict__ KR, bf16_t* __restrict__ MIX, LAS char* lds) {
    int tid_ = threadIdx.x; asm volatile("" : "+v"(tid_));
    const int tid = tid_, wid = tid >> 6, lane = tid & 63, r32 = lane & 31, hi = lane >> 5;
    LAS char* V_lds = lds + OFF_V; LAS char* K_lds = lds + OFF_K;
    LAS float* wsf = (LAS float*)(lds + OFF_WS) + wid * 64; LAS float* li_l = wsf; LAS float* al_l = wsf + 32;
    float m_reg = NEGBIG, l_reg = 0; f32x16 o[4]; bf16x8 qr[12];
#pragma unroll
    for (int d = 0; d < 4; ++d)
#pragma unroll
        for (int r = 0; r < 16; ++r) o[d][r] = 0.f;
    const int qi = wid * QBLK + r32;
    const unsigned qrow = qb < 16 ? (unsigned)s * LREAL + 256 * qb + qi : (unsigned)MROW0 + 16 * s + (qi < 15 ? qi : 15);
    { const bf16_t* Qw = MQ + (qrow * NQ + h * 192 + hi * 8);
#pragma unroll
      for (int d0 = 0; d0 < 12; ++d0) qr[d0] = *(const bf16x8*)(Qw + d0 * 16); }
    const int sr = tid >> 4, sc = (tid & 15) * 8, vst0 = v_st(sr, sc), vst1 = v_st(32 + sr, sc);
    const int kr_r = tid >> 3, kr_c = (tid & 7) * 8;
    const int vb0 = (int)(uintptr_t)V_lds + v_rd_base(lane);
    bf16x8 vs0, vs1, ks0, ks1, kr0;
    const unsigned mainrow0 = (unsigned)s * LREAL, metarow0 = (unsigned)MROW0 + 16 * s;
    const bf16_t* MKVh = MKV + h * 256;
#define KROWG(kt, k) ((kt) < 64 ? mainrow0 + 64u * (kt) + (k) : metarow0 + ((k) < 15 ? (k) : 15))
#define SLOAD(kt) do { const unsigned g0 = KROWG(kt, sr) * NKV + sc, g1 = KROWG(kt, 32 + sr) * NKV + sc, g2 = KROWG(kt, kr_r) * 64 + kr_c; \
    vs0 = *(const bf16x8*)(MKVh + 128 + g0); vs1 = *(const bf16x8*)(MKVh + 128 + g1); \
    ks0 = *(const bf16x8*)(MKVh + g0); ks1 = *(const bf16x8*)(MKVh + g1); kr0 = *(const bf16x8*)(KR + g2); } while (0)
#define SWRITE(b) do { *(LAS bf16x8*)(V_lds + (b) * SHM_V + vst0) = vs0; *(LAS bf16x8*)(V_lds + (b) * SHM_V + vst1) = vs1; \
    *(LAS bf16x8*)(K_lds + (b) * SHM_K + sr * KROW + sc * 2) = ks0; *(LAS bf16x8*)(K_lds + (b) * SHM_K + (32 + sr) * KROW + sc * 2) = ks1; \
    *(LAS bf16x8*)(K_lds + (b) * SHM_K + kr_r * KROW + 256 + kr_c * 2) = kr0; } while (0)
#define RESC(a) do { if (__any((a) < 1.f)) { if (hi == 0) al_l[r32] = (a); asm volatile("s_waitcnt lgkmcnt(0)" ::: "memory"); \
    _Pragma("unroll") for (int d = 0; d < 4; ++d) _Pragma("unroll") for (int r = 0; r < 16; ++r) o[d][r] *= al_l[crow(r, hi)]; } } while (0)
    f32x16 pA0, pA1, pB0, pB1; float mnA, mnB, alA, alB; bf16x8 pa0, pa1, pa2, pa3;
    __syncthreads();
    SLOAD(0); SWRITE(0); __syncthreads();
    qkt(pA0, pA1, K_lds, qr, r32, hi); partialSM<false>(pA0, pA1, m_reg, mnA, alA);
    SLOAD(1); SWRITE(1); __syncthreads();
    RESC(alA);
    int s0 = 0, s1 = 1, s2 = 2;
    for (int j = 1; j + 1 < NT; j += 2) {
        SBAR(); qkt(pB0, pB1, K_lds + s1 * SHM_K, qr, r32, hi);
        finishSM(pA0, pA1, alA, l_reg, pa0, pa1, pa2, pa3); SBAR();
        SLOAD(j + 1); SBAR();
        pv_d0(o, vb0 + s0 * SHM_V, pa0, pa1, pa2, pa3); partialSM<false>(pB0, pB1, m_reg, mnB, alB);
        SWRITE(s2);
        RESC(alB); __syncthreads();
        SBAR(); qkt(pA0, pA1, K_lds + s2 * SHM_K, qr, r32, hi);
        finishSM(pB0, pB1, alB, l_reg, pa0, pa1, pa2, pa3); SBAR();
        if (j + 2 < NT) SLOAD(j + 2); SBAR();
        pv_d0(o, vb0 + s1 * SHM_V, pa0, pa1, pa2, pa3);
        if (j + 1 == NT - 1) partialSM<true>(pA0, pA1, m_reg, mnA, alA); else partialSM<false>(pA0, pA1, m_reg, mnA, alA);
        if (j + 2 < NT) SWRITE(s0);
        RESC(alA); __syncthreads();
        { const int t0 = s0, t1 = s1; s0 = s2; s1 = t0; s2 = t1; }
    }
    finishSM(pA0, pA1, alA, l_reg, pa0, pa1, pa2, pa3); SBAR();
    pv_d0(o, vb0 + s0 * SHM_V, pa0, pa1, pa2, pa3);
    if (hi == 0) li_l[r32] = l_reg; asm volatile("s_waitcnt lgkmcnt(0)" ::: "memory");
    float rli[16];
#pragma unroll
    for (int r = 0; r < 16; ++r) rli[r] = __builtin_amdgcn_rcpf(li_l[crow(r, hi)]);
    if (qb < 16) {
        bf16_t* Ow = MIX + ((long)s * LREAL + 256 * qb + wid * QBLK) * DM + MLW + h * 128;
#pragma unroll
        for (int r = 0; r < 16; ++r) { const int orow = crow(r, hi);
#pragma unroll
            for (int d0 = 0; d0 < 4; ++d0) Ow[(long)orow * DM + d0 * 32 + r32] = (bf16_t)(pk2(o[d0][r] * rli[r], 0.f) & 0xffffu); }
    } else if (wid == 0) {
        bf16_t* Ow = MIX + ((long)MROW0 + 16 * s) * DM + MLW + h * 128;
#pragma unroll
        for (int r = 0; r < 16; ++r) { const int orow = crow(r, hi);
            if (orow < 16) {
#pragma unroll
                for (int d0 = 0; d0 < 4; ++d0) Ow[(long)orow * DM + d0 * 32 + r32] = (bf16_t)(pk2(o[d0][r] * rli[r], 0.f) & 0xffffu); } }
    }
#undef KROWG
#undef SLOAD
#undef SWRITE
#undef RESC
}
__device__ __forceinline__ void attn_phase(int vcu, const bf16_t* MQ, const bf16_t* MKV, const bf16_t* KR, bf16_t* MIX, LAS char* lds) {
    for (int i = (vcu < 96 ? -1 : 0); i < 6; ++i) { int sh, qb; if (i < 0) { sh = vcu; qb = 16; } else { const int id = i * GRID + vcu; sh = id >> 4; qb = id & 15; }
        attn_unit(sh >> 3, sh & 7, qb, MQ, MKV, KR, MIX, lds); }
}
#undef SBAR
}

namespace ml {
constexpr int QI = 0, KI = 32768, VI = 65536, SI = 81920, CI = 98304;
constexpr int SC_CT = 0, SC_BM = 64, SC_WI = 128, SC_EI = 192, SC_WW = 256, SC_DEN = 320, SC_QN = 448, SC_N = 512, SC_A = 768;
constexpr int GP_REC = 200;
__device__ __forceinline__ unsigned off_b(unsigned row, unsigned ch) { return 256u * row + 16u * (ch ^ (((row & 3) << 2) | ((row >> 2) & 3))); }
__device__ __forceinline__ unsigned row_read_addr_16(unsigned lane, unsigned rb, unsigned s) { return off_b((lane & 15) + 16 * rb, 4 * s + (lane >> 4)); }
__device__ __forceinline__ unsigned tr_read_addr_16(unsigned lane, unsigned c, unsigned ks, unsigned t) {
    const unsigned g = lane >> 4, q = (lane & 15) >> 2, p = lane & 3; return off_b(32 * ks + 8 * g + 4 * t + q, 2 * c + (p >> 1)) + 8 * (p & 1); }
__device__ __forceinline__ bf16x8 tr_frag(unsigned a0, unsigned a1) {
    const s16x4 lo = __builtin_amdgcn_ds_read_tr16_b64_v4i16((LAS s16x4*)a0), hi = __builtin_amdgcn_ds_read_tr16_b64_v4i16((LAS s16x4*)a1);
    return (bf16x8){lo[0], lo[1], lo[2], lo[3], hi[0], hi[1], hi[2], hi[3]};
}
__device__ __forceinline__ f32x4 mfma16(bf16x8 a, bf16x8 b, f32x4 c) { return __builtin_amdgcn_mfma_f32_16x16x32_bf16(a, b, c, 0, 0, 0); }
__device__ __forceinline__ float log_sigmoid(float x) { return fminf(x, 0.f) - __logf(1.f + __expf(-fabsf(x))); }

__device__ __forceinline__ void gate_prep(int gw, int ngw, int lane, const float* __restrict__ GATES, const float* __restrict__ bgl, float* __restrict__ GP) {
    for (int it = gw; it < 96 * 65; it += ngw) {
        const int chain = it / 65, c = it % 65, s = chain >> 3, hd = (chain >> 1) & 3, dir = chain & 1;
        const long g = c == 0 ? (lane >= 48 ? (long)MROW0 + 16 * s + lane - 48 : -1L) : (long)s * LREAL + 64 * (c - 1) + lane;
        float li = NEGBIG, lf = 0.f;
        if (g >= 0) { li = GATES[g * 16 + (dir ? 8 : 0) + hd] + bgl[(dir ? 8 : 0) + hd]; lf = log_sigmoid(GATES[g * 16 + (dir ? 12 : 4) + hd] + bgl[(dir ? 12 : 4) + hd]); }
        float x = dir ? __shfl(lf, 63 - lane) : lf;
#pragma unroll
        for (int o = 1; o < 64; o <<= 1) { const float y = __shfl_up(x, o); if (lane >= o) x += y; }
        const float btot = __shfl(x, 63);
        const float b = dir ? __shfl(x, 63 - lane) : x;
        const float a_s = li - b;
        float pm = dir ? __shfl(a_s, 63 - lane) : a_s;
#pragma unroll
        for (int o = 1; o < 64; o <<= 1) { const float y = __shfl_up(pm, o); if (lane >= o) pm = fmaxf(pm, y); }
        pm = dir ? __shfl(pm, 63 - lane) : pm;
        const float gmax = wave_max(btot - b + li);
        float* rec = GP + (size_t)it * GP_REC;
        rec[lane] = b; rec[64 + lane] = li; rec[128 + lane] = pm; if (lane == 0) { rec[192] = btot; rec[193] = gmax; }
    }
}

__device__ __forceinline__ void mlstm_unit(int s, int hd, int js, const bf16_t* __restrict__ UQKVO, const float* __restrict__ GP, float* __restrict__ HSUM, LAS unsigned char* lds, LAS float* sc) {
    const int wid = __builtin_amdgcn_readfirstlane((int)threadIdx.x >> 6);
    const unsigned ldsb = (unsigned)(uintptr_t)lds;
    const int tt = wid >> 1, nb = 2 * (wid & 1);
#define ROWRD(img, rb, s_) (*(const LAS bf16x8*)(uintptr_t)(RB[s_] + (unsigned)((img) + 4096 * (rb))))
#define TRFRAG(img, c_, ks) tr_frag(BT[0][(c_) & 1] + TQ[(c_) >> 1] + (unsigned)((img) + 8192 * (ks)), BT[1][(c_) & 1] + TQ[(c_) >> 1] + (unsigned)((img) + 8192 * (ks)))
    f32x4 accC[2][4], accN[2];
    for (int dir = 0; dir < 2; ++dir) {
        int tid; { int t0_ = threadIdx.x; asm volatile("" : "+v"(t0_)); tid = t0_; }
#pragma unroll
        for (int mi = 0; mi < 2; ++mi)
#pragma unroll
            for (int c = 0; c < 4; ++c) accC[mi][c] = (f32x4){0.f, 0.f, 0.f, 0.f};
        accN[0] = (f32x4){0.f, 0.f, 0.f, 0.f}; accN[1] = (f32x4){0.f, 0.f, 0.f, 0.f};
        if (tid < 256) sc[SC_N + tid] = 0.f;
        for (int i = tid; i < 32768 / 16; i += 512) *(LAS u32x4*)(lds + CI + i * 16) = (u32x4){0u, 0u, 0u, 0u};
        float m_state = 0.f;
        const float* GPc = GP + (size_t)(((s * 4 + hd) * 2 + dir) * 65) * GP_REC;
        u32x4 sq[4], sk[4], sv; float sb = 0.f, sli = NEGBIG, spm = NEGBIG, sbt = 0.f, sgm = NEGBIG;
#define ROWG(c, r) ((c) == 0 ? ((r) >= 48 ? (long)MROW0 + 16 * s + (r) - 48 : -1L) : (long)s * LREAL + 64 * ((c) - 1) + (r))
#define STAGE_LOAD(c) do { \
        _Pragma("unroll") for (int i = 0; i < 4; ++i) { const int id = tid + 512 * i, r = id >> 5, ch = id & 31; const long g = ROWG(c, r); \
            sq[i] = (u32x4){0u, 0u, 0u, 0u}; sk[i] = (u32x4){0u, 0u, 0u, 0u}; \
            if (g >= 0) { sq[i] = *(const u32x4*)(UQKVO + g * 4096 + hd * 256 + ch * 8); sk[i] = *(const u32x4*)(UQKVO + g * 4096 + 1024 + hd * 256 + ch * 8); } } \
        { const int r = tid >> 3, ch = tid & 7; const long g = ROWG(c, r); sv = (u32x4){0u, 0u, 0u, 0u}; if (g >= 0) sv = *(const u32x4*)(UQKVO + g * 4096 + 2048 + hd * 256 + js * 64 + ch * 8); } \
        if (tid < 64) { const float* rec = GPc + (size_t)(c) * GP_REC; sb = rec[tid]; sli = rec[64 + tid]; spm = rec[128 + tid]; sbt = rec[192]; sgm = rec[193]; } } while (0)
#define STAGE_WRITE() do { \
        _Pragma("unroll") for (int i = 0; i < 4; ++i) { const int id = tid + 512 * i, r = id >> 5, ch = id & 31; \
            *(LAS u32x4*)(lds + QI + (ch >> 4) * 16384 + off_b(r, ch & 15)) = sq[i]; *(LAS u32x4*)(lds + KI + (ch >> 4) * 16384 + off_b(r, ch & 15)) = sk[i]; } \
        { const int r = tid >> 3, ch = tid & 7; *(LAS u32x4*)(lds + VI + off_b(r, ch)) = sv; } \
        if (tid < 64) { const float m_inter = sb + m_state, mt = fmaxf(m_inter, sb + spm); const float m_new = fmaxf(sbt + m_state, sgm); \
            sc[SC_CT + tid] = sli - sb; sc[SC_BM + tid] = sb - mt; sc[SC_WI + tid] = __expf(m_inter - mt); sc[SC_EI + tid] = __expf(-mt); \
            sc[SC_WW + tid] = __expf(sbt - sb + sli - m_new) * 0.0625f; if (tid == 0) sc[SC_A] = __expf(sbt + m_state - m_new); m_state = m_new; } } while (0)
        const int c_first = dir ? 64 : 0, c_step = dir ? -1 : 1;
        STAGE_LOAD(c_first);
        __syncthreads();
        STAGE_WRITE();
        for (int ci = 0; ci < 65; ++ci) {
            const int c = c_first + c_step * ci;
            { int t2_ = threadIdx.x; asm volatile("" : "+v"(t2_)); tid = t2_; }
            const int lane = tid & 63, l15 = lane & 15, lg = lane >> 4;
            unsigned RB[4], BT[2][2], TQ[4];
            { const unsigned fl = ((l15 & 3) << 2) | (l15 >> 2), q = l15 >> 2, p = lane & 3, g = lg;
#pragma unroll
              for (int s_ = 0; s_ < 4; ++s_) { RB[s_] = ldsb + 256u * l15 + 16u * (lg ^ (fl & 3)) + 64u * (s_ ^ (fl >> 2)); TQ[s_] = 64u * (s_ ^ q); }
#pragma unroll
              for (int t_ = 0; t_ < 2; ++t_)
#pragma unroll
                  for (int cl = 0; cl < 2; ++cl) BT[t_][cl] = ldsb + 256u * (8 * g + q) + 8u * (p & 1) + 1024u * t_ + 16u * ((p >> 1) ^ t_) + 32u * (cl ^ (g & 1)); }
            __syncthreads();
            if (ci + 1 < 65) STAGE_LOAD(c + c_step);
            bf16x8 qf[8];
#pragma unroll
            for (int k = 0; k < 8; ++k) qf[k] = ROWRD(QI + (k >> 2) * 16384, tt, k & 3);
            f32x4 sT[2], oc[2];
#pragma unroll
            for (int i = 0; i < 2; ++i) { sT[i] = (f32x4){0.f, 0.f, 0.f, 0.f}; oc[i] = (f32x4){0.f, 0.f, 0.f, 0.f}; }
#pragma unroll
            for (int i = 0; i < 2; ++i)
#pragma unroll
                for (int k = 0; k < 8; ++k) {
                    const bf16x8 kf = ROWRD(KI + (k >> 2) * 16384, nb + i, k & 3);
                    sT[i] = mfma16(kf, qf[k], sT[i]);
                    const bf16x8 cf = ROWRD(CI + (k >> 2) * 16384, nb + i, k & 3);
                    oc[i] = mfma16(qf[k], cf, oc[i]);
                }
            {
                const int t = 16 * tt + l15; const float bmt = sc[SC_BM + t]; float rs = 0.f;
#pragma unroll
                for (int i = 0; i < 2; ++i) { const int s0 = 16 * (nb + i) + 4 * lg; const f32x4 ctv = *(const LAS f32x4*)(sc + SC_CT + s0); float v[4];
#pragma unroll
                    for (int e = 0; e < 4; ++e) { const int sx = s0 + e; const bool ok = dir ? (sx >= t) : (sx <= t);
                        const float ex = ok ? (bmt + ctv[e]) : NEGBIG; v[e] = sT[i][e] * 0.0625f * __expf(ex); rs += v[e]; }
                    u32x2 w; w.x = pk2(v[0], v[1]); w.y = pk2(v[2], v[3]);
                    *(LAS u32x2*)(lds + SI + off_b(t, s0 >> 3) + (s0 & 7) * 2) = w; }
                rs += __shfl_xor(rs, 16); rs += __shfl_xor(rs, 32);
                if (lg == 0) sc[SC_DEN + 64 * (wid & 1) + t] = rs;
            }
            { const int r = tid >> 3, ch = tid & 7; const u32x4 v = *(const LAS u32x4*)(lds + VI + off_b(r, ch)); const float w = sc[SC_WW + r]; u32x4 o;
#pragma unroll
              for (int jx = 0; jx < 4; ++jx) o[jx] = pk2(bf_lo(v[jx]) * w, bf_hi(v[jx]) * w);
              *(LAS u32x4*)(lds + VI + off_b(r, 8 + ch)) = o; }
            { const int r = tid >> 3, part = tid & 7; float d = 0.f;
#pragma unroll
              for (int i = 0; i < 4; ++i) { const int ch32 = part * 4 + i; const u32x4 v = *(const LAS u32x4*)(lds + QI + (ch32 >> 4) * 16384 + off_b(r, ch32 & 15));
                  const f32x4 n0 = *(const LAS f32x4*)(sc + SC_N + ch32 * 8), n1 = *(const LAS f32x4*)(sc + SC_N + ch32 * 8 + 4);
                  d += bf_lo(v[0]) * n0[0] + bf_hi(v[0]) * n0[1] + bf_lo(v[1]) * n0[2] + bf_hi(v[1]) * n0[3] + bf_lo(v[2]) * n1[0] + bf_hi(v[2]) * n1[1] + bf_lo(v[3]) * n1[2] + bf_hi(v[3]) * n1[3]; }
              d += __shfl_xor(d, 1); d += __shfl_xor(d, 2); d += __shfl_xor(d, 4);
              if (part == 0) sc[SC_QN + r] = d; }
            { const f32x4 wi = *(const LAS f32x4*)(sc + SC_WI + 16 * tt + 4 * lg);
#pragma unroll
              for (int i = 0; i < 2; ++i) oc[i] = oc[i] * wi; }
            __syncthreads();
            const float a_dec = sc[SC_A];
#pragma unroll
            for (int ks = 0; ks < 2; ++ks) { const bf16x8 sf = ROWRD(SI, tt, ks);
#pragma unroll
                for (int i = 0; i < 2; ++i) { const bf16x8 vf = TRFRAG(VI, nb + i, ks);
                    oc[i] = mfma16(sf, vf, oc[i]); } }
            { const int t0 = 16 * tt + 4 * lg;
              const f32x4 wi = *(const LAS f32x4*)(sc + SC_WI + t0), qn = *(const LAS f32x4*)(sc + SC_QN + t0), d0 = *(const LAS f32x4*)(sc + SC_DEN + t0), d1 = *(const LAS f32x4*)(sc + SC_DEN + 64 + t0), ei = *(const LAS f32x4*)(sc + SC_EI + t0);
#pragma unroll
              for (int e = 0; e < 4; ++e) { const long g = ROWG(c, t0 + e);
                const float den = wi[e] * qn[e] + (d0[e] + d1[e]); const float inv = 1.f / fmaxf(fabsf(den), ei[e]);
                if (g >= 0) {
#pragma unroll
                    for (int i = 0; i < 2; ++i) { float* hp = HSUM + g * MLW + hd * 256 + js * 64 + 16 * (nb + i) + l15; const float hv = oc[i][e] * inv; if (dir) unsafeAtomicAdd(hp, hv); else *hp = hv; } } } }
#pragma unroll
            for (int mi = 0; mi < 2; ++mi)
#pragma unroll
                for (int cc = 0; cc < 4; ++cc) accC[mi][cc] = accC[mi][cc] * a_dec;
            accN[0] = accN[0] * a_dec; accN[1] = accN[1] * a_dec;
            const unsigned ktq = (unsigned)(KI + (wid >> 2) * 16384) + 64u * ((unsigned)(wid & 3) ^ (unsigned)(l15 >> 2));
#pragma unroll
            for (int ks = 0; ks < 2; ++ks) {
                bf16x8 kf[2], wf[4];
#pragma unroll
                for (int mi = 0; mi < 2; ++mi) kf[mi] = tr_frag(BT[0][mi] + ktq + (unsigned)(8192 * ks), BT[1][mi] + ktq + (unsigned)(8192 * ks));
#pragma unroll
                for (int cc = 0; cc < 4; ++cc) wf[cc] = TRFRAG(VI, 4 + cc, ks);
                { const f32x4 wa = *(const LAS f32x4*)(sc + SC_WW + 32 * ks + 8 * lg), wb = *(const LAS f32x4*)(sc + SC_WW + 32 * ks + 8 * lg + 4);
                  u32x4 wq; wq.x = pk2(wa[0], wa[1]); wq.y = pk2(wa[2], wa[3]); wq.z = pk2(wb[0], wb[1]); wq.w = pk2(wb[2], wb[3]);
                  if (l15 != 0) wq = (u32x4){0u, 0u, 0u, 0u};
                  const bf16x8 wfn = __builtin_bit_cast(bf16x8, wq);
#pragma unroll
                  for (int mi = 0; mi < 2; ++mi) accN[mi] = mfma16(kf[mi], wfn, accN[mi]); }
#pragma unroll
                for (int mi = 0; mi < 2; ++mi)
#pragma unroll
                    for (int cc = 0; cc < 4; ++cc) accC[mi][cc] = mfma16(kf[mi], wf[cc], accC[mi][cc]);
            }
#pragma unroll
            for (int mi = 0; mi < 2; ++mi)
#pragma unroll
                for (int cc = 0; cc < 4; ++cc) { const int dk0 = 32 * wid + 16 * mi + 4 * lg, dv = 16 * cc + l15; u32x2 w; w.x = pk2(accC[mi][cc][0], accC[mi][cc][1]); w.y = pk2(accC[mi][cc][2], accC[mi][cc][3]);
                    *(LAS u32x2*)(lds + CI + (dk0 >> 7) * 16384 + off_b(dv, (dk0 & 127) >> 3) + (dk0 & 7) * 2) = w; }
            if (l15 == 0) { *(LAS f32x4*)(sc + SC_N + 32 * wid + 4 * lg) = accN[0]; *(LAS f32x4*)(sc + SC_N + 32 * wid + 16 + 4 * lg) = accN[1]; }
            __syncthreads();
            if (ci + 1 < 65) STAGE_WRITE();
        }
    }
#undef ROWG
#undef STAGE_LOAD
#undef STAGE_WRITE
#undef ROWRD
#undef TRFRAG
}
__device__ __forceinline__ void mlstm_phase(int bx, const bf16_t* UQKVO, const float* GP, float* HSUM, LAS unsigned char* lds, LAS float* sc) {
    if (bx >= 192) return;
    const int xcd = bx & 7, idx = bx >> 3, pair = xcd * 6 + (idx >> 2), js = idx & 3;
    mlstm_unit(pair >> 2, pair & 3, js, UQKVO, GP, HSUM, lds, sc);
}
}

#ifndef PHM
#define PHM 0xffff
#endif
#ifndef REP_ML
#define REP_ML 1
#endif
#ifndef REP_ATTN
#define REP_ATTN 1
#endif
#ifndef REP_CONV
#define REP_CONV 1
#endif
#ifndef REP_SMALL
#define REP_SMALL 1
#endif
#ifndef KV_SPLIT
#define KV_SPLIT 193
#endif
#ifndef REP_WIN
#define REP_WIN 1
#endif
#ifndef REP_UP
#define REP_UP 1
#endif
__global__ void __launch_bounds__(512, 2) fwd_kernel(Params P, unsigned char* ws_arg, unsigned char* out_arg) {
    extern __shared__ __attribute__((aligned(16))) unsigned char lds_raw[];
    Frame F;
    F.lds = (LAS unsigned char*)lds_raw;
    F.tid = threadIdx.x; F.lane = F.tid & 63; F.wave = __builtin_amdgcn_readfirstlane(F.tid >> 6);
    F.G = GRID; F.bx = blockIdx.x; F.vcu = (F.bx % 8) * (GRID / 8) + F.bx / 8;
    F.gw = F.vcu * 8 + F.wave; F.ngw = F.G * 8;
    { unsigned char* ws0 = ws_arg;
      for (int u = F.tid; u < (LDS_BYTES - MISC_OFF) / 4; u += 512) ((LAS unsigned*)(F.lds + MISC_OFF))[u] = 0u;
      __syncthreads();
      (void)ws0; }
    LAS unsigned long long* ptab = (LAS unsigned long long*)(F.lds + MISC_OFF + 64);
    if (F.tid == 0) {
#pragma unroll
        for (int k = 0; k < 19; ++k) ptab[k] = (unsigned long long)(uintptr_t)P.in[k]; }
    __syncthreads();
    XcdBarrier bar = xcd_barrier_post((unsigned*)(ws_arg + WS_CTL) + CW_BAR, (volatile LAS unsigned*)(F.lds + MISC_OFF));
    LAS float* sc = (LAS float*)(F.lds + MISC_OFF + 1024);
#define BXL() ({ int b__ = F.bx; asm volatile("" : "+s"(b__)); b__; })
#define PFRAME() Frame Fp = F; { int t_ = threadIdx.x; asm volatile("" : "+v"(t_)); Fp.tid = t_; Fp.lane = t_ & 63; int b_ = BXL(); Fp.bx = b_; Fp.vcu = (b_ % 8) * (GRID / 8) + b_ / 8; Fp.gw = Fp.vcu * 8 + Fp.wave; }
#define WSB() ({ GAS unsigned char* w__ = (GAS unsigned char*)ws_arg; asm volatile("" : "+s"(w__)); (unsigned char*)w__; })
#ifndef STAG_N
#define STAG_N 1
#endif
#ifdef STAG_ON
#define STAGGER() do { int s__ = (BXL() * 37) & 255; for (int i__ = 0; i__ < s__; ++i__) __builtin_amdgcn_s_sleep(STAG_N); } while (0)
#else
#define STAGGER() do {} while (0)
#endif
#define WOFS(l_) (((l_) & 1) ? WSET_DELTA : (size_t)0)
#define DOB() ({ GAS unsigned char* w__ = (GAS unsigned char*)out_arg; asm volatile("" : "+s"(w__)); (unsigned char*)w__; })

    { unsigned char* ws = WSB(); prologue(F, ws, ptab); convert_weights(F, ws, ptab, 0, 0, -1); }
    xcd_barrier(bar);

    for (int l = 0; l < DEPTH; ++l) {
        { unsigned char* ws = WSB();
          pg8::Gemm g{(bf16_t*)(ws + WS_HB), (bf16_t*)(ws + WOFS(l) + WS_WIN), TP, NIN, DM, DM}; pg8::PanelOrder S; S.init(NPAN, 0, 0, 0, NIN, F.G, BXL());
          pg8::EpiWin E{(bf16_t*)(ws + WS_UQKVO), (bf16_t*)(ws + WS_UDQ), (bf16_t*)(ws + WS_UDKV), (bf16_t*)(ws + WS_KR), (float*)(ws + WS_GATES), (const float*)(ws + WS_COS), (const float*)(ws + WS_SIN)};
#if PHM & 2
          STAGGER(); pg8::gemm_phase<pg8::EpiWin, pg8::PanelOrder, true, true>(F.lds, g, S, E);
#endif
        }
        if (l + 1 < DEPTH && BXL() >= 20) { unsigned char* ws = WSB(); PFRAME(); Fp.gw = (Fp.bx - 20) * 8 + Fp.wave; Fp.ngw = (GRID - 20) * 8; convert_weights(Fp, ws, ptab, l + 1, WOFS(l + 1), 0); }
#if REP_WIN > 1
        __syncthreads();
        { unsigned char* ws = WSB();
          pg8::Gemm g{(bf16_t*)(ws + WS_HB), (bf16_t*)(ws + WOFS(l) + WS_WIN), TP, NIN, DM, DM}; pg8::PanelOrder S; S.init(NPAN, 0, 0, 0, NIN, F.G, BXL());
          pg8::EpiWin E{(bf16_t*)(ws + WS_UQKVO), (bf16_t*)(ws + WS_UDQ), (bf16_t*)(ws + WS_UDKV), (bf16_t*)(ws + WS_KR), (float*)(ws + WS_GATES), (const float*)(ws + WS_COS), (const float*)(ws + WS_SIN)};
          pg8::gemm_phase<pg8::EpiWin, pg8::PanelOrder, true, true>(F.lds, g, S, E);
        }
#endif
        xcd_barrier(bar);
        { unsigned char* ws = WSB(); unsigned char* dob = DOB(); PFRAME(); rstd_rows(Fp, (bf16_t*)(ws + WS_UDQ), (bf16_t*)(ws + WS_UDKV), (float*)(ws + WS_RSTD));
          ml::gate_prep(Fp.gw, Fp.ngw, Fp.lane, (const float*)(ws + WS_GATES), (const float*)(ws + WS_PAR) + PO_BG + l * 16, (float*)(dob + DO_GP)); }
#if REP_SMALL > 1
        { unsigned char* ws = WSB(); unsigned char* dob = DOB(); PFRAME(); rstd_rows(Fp, (bf16_t*)(ws + WS_UDQ), (bf16_t*)(ws + WS_UDKV), (float*)(ws + WS_RSTD));
          ml::gate_prep(Fp.gw, Fp.ngw, Fp.lane, (const float*)(ws + WS_GATES), (const float*)(ws + WS_PAR) + PO_BG + l * 16, (float*)(dob + DO_GP)); }
#endif
        xcd_barrier(bar);
        if (F.bx >= 192) {
        { unsigned char* ws = WSB(); unsigned char* dob = DOB();
          pg8::Gemm g{(bf16_t*)(ws + WS_UDQ), (bf16_t*)(ws + WOFS(l) + WS_WUQ), TP, NQ, 512, 512}; pg8::PanelOrder S; S.init(NPAN, 0, 0, 0, NQ, GRID - 192, BXL() - 192);
          pg8::EpiQ E{(bf16_t*)(dob + DO_MQ), (const float*)(ws + WS_RSTD), (const float*)(ws + WS_COS), (const float*)(ws + WS_SIN)};
#if PHM & 4
          pg8::gemm_phase<pg8::EpiQ, pg8::PanelOrder, true, true>(F.lds, g, S, E);
#endif
        }
        { unsigned char* ws = WSB();
          pg8::Gemm g{(bf16_t*)(ws + WS_UDKV), (bf16_t*)(ws + WOFS(l) + WS_WUKV), TP, NKV, 256, 256}; pg8::PanelOrder S; S.init(NPAN, 0, 0, 0, NKV, GRID - 192, BXL() - 192);
          pg8::EpiBf16G E{(bf16_t*)(ws + WS_MKV), NKV, (const float*)(ws + WS_RSTD) + 1, 0, -1, 0};
#if PHM & 8
          pg8::gemm_phase<pg8::EpiBf16G, pg8::PanelOrder, true, true>(F.lds, g, S, E);
#endif
        }
        } else {
#ifndef NO_ML
        for (int rep_ = 0; rep_ < REP_ML; ++rep_)
        { unsigned char* ws = WSB(); unsigned char* dob = DOB();
          ml::mlstm_phase(BXL(), (const bf16_t*)(ws + WS_UQKVO), (const float*)(dob + DO_GP), (float*)(dob + DO_HSUM), F.lds, sc); }
#endif
        }
        xcd_barrier(bar);
        { unsigned char* ws = WSB(); unsigned char* dob = DOB(); PFRAME();
          if (Fp.vcu >= 96) mlstm_finalize(Fp, (Fp.vcu - 96) * 8 + Fp.wave, (GRID - 96) * 8, (const float*)(dob + DO_HSUM), (const bf16_t*)(ws + WS_UQKVO), (const float*)(ws + WS_PAR) + PO_MLG + l * MLW, (bf16_t*)(ws + WS_HB)); }
#ifndef NO_ATTN
        for (int rep_ = 0; rep_ < REP_ATTN; ++rep_)
        { unsigned char* ws = WSB(); unsigned char* dob = DOB();
          att::attn_phase(({ int b__ = BXL(); (b__ % 8) * (GRID / 8) + b__ / 8; }), (const bf16_t*)(dob + DO_MQ), (const bf16_t*)(ws + WS_MKV), (const bf16_t*)(ws + WS_KR), (bf16_t*)(ws + WS_HB), (LAS char*)F.lds); }
#endif
        xcd_barrier(bar);
        { unsigned char* ws = WSB();
          pg8::Gemm g{(bf16_t*)(ws + WS_HB), (bf16_t*)(ws + WOFS(l) + WS_WOUT), TP, DM, DM, DM}; pg8::PanelOrder S; S.init(192, 0, 0, 0, DM, F.G, BXL());
          pg8::EpiResidLn E{(bf16_t*)(ws + WS_H), DM, ALPHA, (const float*)(ws + WS_STAT2), (const float*)(ws + WS_PAR) + (l > 0 ? PO_L2G + (l - 1) * DM : PO_ONE), (const float*)(ws + WS_PAR) + (l > 0 ? PO_L2B + (l - 1) * DM : PO_ZERO)};
#if PHM & 16
          STAGGER(); pg8::gemm_phase<pg8::EpiResidLn, pg8::PanelOrder, true, true>(F.lds, g, S, E);
#endif
        }
        { unsigned char* ws = WSB();
          pg8::Gemm g{(bf16_t*)(ws + WS_HB), (bf16_t*)(ws + WOFS(l) + WS_WOUT), TP, DM, DM / 4, DM}; pg8::SplitOrder S; S.init(PMETA, DM, 4, F.G, BXL());
          pg8::EpiPart E{(float*)(ws + WS_PART), DM};
#if PHM & 16
          pg8::gemm_phase<pg8::EpiPart, pg8::SplitOrder, true, true>(F.lds, g, S, E);
#endif
        }
        xcd_barrier(bar);
        { unsigned char* ws = WSB(); PFRAME(); ln_rows(Fp, (float*)(ws + WS_H), (bf16_t*)(ws + WS_HB), (const float*)(ws + WS_PAR) + PO_L1G + l * DM, (const float*)(ws + WS_PAR) + PO_L1B + l * DM, (float*)(ws + WS_STAT1), nullptr, (const float*)(ws + WS_PART), 4); }
        xcd_barrier(bar);
        { unsigned char* ws = WSB(); unsigned char* dob = DOB();
          pg8::Gemm g{(bf16_t*)(ws + WS_HB), (bf16_t*)(ws + WOFS(l) + WS_WUP), TP, NUP, DM, DM}; pg8::PanelOrder S; S.init(NPAN, 0, 0, 0, NUP, F.G, BXL());
          pg8::EpiFfn E{(bf16_t*)(ws + WS_ACT), (float*)(dob + DO_SIDE), (bf16_t*)(dob + DO_GVM), (const float*)(ws + WS_PAR) + PO_CW + (size_t)l * 3 * DFF, (const float*)(ws + WS_PAR) + PO_CB + (size_t)l * DFF, (LAS float*)(F.lds + MISC_OFF + 8192)};
#if PHM & 32
          STAGGER(); pg8::gemm_phase<pg8::EpiFfn, pg8::PanelOrder, true, true>(F.lds, g, S, E);
#if REP_UP > 1
          __syncthreads(); pg8::gemm_phase<pg8::EpiFfn, pg8::PanelOrder, true, true>(F.lds, g, S, E);
#endif
#endif
        }
        if (l + 1 < DEPTH && BXL() >= 44) { unsigned char* ws = WSB(); PFRAME(); Fp.gw = (Fp.bx - 44) * 8 + Fp.wave; Fp.ngw = (GRID - 44) * 8; convert_weights(Fp, ws, ptab, l + 1, WOFS(l + 1), 1); }
        xcd_barrier(bar);
        { unsigned char* ws = WSB(); unsigned char* dob = DOB(); PFRAME();
          ffn_fixup(Fp, (const float*)(dob + DO_SIDE), (const bf16_t*)(dob + DO_GVM), (bf16_t*)(ws + WS_ACT), (const float*)(ws + WS_PAR) + PO_CW + (size_t)l * 3 * DFF, (const float*)(ws + WS_PAR) + PO_CB + (size_t)l * DFF); }
#if REP_SMALL > 1
        { unsigned char* ws = WSB(); unsigned char* dob = DOB(); PFRAME();
          ffn_fixup(Fp, (const float*)(dob + DO_SIDE), (const bf16_t*)(dob + DO_GVM), (bf16_t*)(ws + WS_ACT), (const float*)(ws + WS_PAR) + PO_CW + (size_t)l * 3 * DFF, (const float*)(ws + WS_PAR) + PO_CB + (size_t)l * DFF); }
#endif
        xcd_barrier(bar);
        { unsigned char* ws = WSB();
          pg8::Gemm g{(bf16_t*)(ws + WS_ACT), (bf16_t*)(ws + WOFS(l) + WS_WDN), TP, DM, DFF, DFF}; pg8::PanelOrder S; S.init(192, 0, 0, 0, DM, F.G, BXL());
          pg8::EpiResidLn E{(bf16_t*)(ws + WS_H), DM, ALPHA, (const float*)(ws + WS_STAT1), (const float*)(ws + WS_PAR) + PO_L1G + l * DM, (const float*)(ws + WS_PAR) + PO_L1B + l * DM};
#if PHM & 64
          STAGGER(); pg8::gemm_phase<pg8::EpiResidLn, pg8::PanelOrder, true, true>(F.lds, g, S, E);
#endif
        }
        { unsigned char* ws = WSB();
          pg8::Gemm g{(bf16_t*)(ws + WS_ACT), (bf16_t*)(ws + WOFS(l) + WS_WDN), TP, DM, DFF / 11, DFF}; pg8::SplitOrder S; S.init(PMETA, DM, 11, F.G, BXL());
          pg8::EpiPart E{(float*)(ws + WS_PART), DM};
#if PHM & 64
          pg8::gemm_phase<pg8::EpiPart, pg8::SplitOrder, true, true>(F.lds, g, S, E);
#endif
        }
        xcd_barrier(bar);
        { unsigned char* ws = WSB(); unsigned char* dob = DOB();
          PFRAME(); ln_rows(Fp, (float*)(ws + WS_H), (bf16_t*)(ws + WS_HB), (const float*)(ws + WS_PAR) + PO_L2G + l * DM, (const float*)(ws + WS_PAR) + PO_L2B + l * DM, (float*)(ws + WS_STAT2), l == DEPTH - 1 ? (float*)dob : nullptr, (const float*)(ws + WS_PART), 11); }
#if REP_CONV > 1
#endif
        xcd_barrier(bar);
    }
}

extern "C" void kernel_launch(void* const* d_in, const int* in_sizes, int n_in, void* d_out, int out_size, void* d_ws, size_t ws_size, hipStream_t stream) {
    static int grid = 0;
    if (grid == 0) {
        if (n_in != 19 || out_size != NMAIN * DM || ws_size < WS_NEED) { fprintf(stderr, "kernel_launch: unexpected shapes (n_in %d out %d ws %zu need %zu)\n", n_in, out_size, ws_size, (size_t)WS_NEED); grid = -1; return; }
        int dev = 0, cus = 0;
        if (hipGetDevice(&dev) != hipSuccess || hipDeviceGetAttribute(&cus, hipDeviceAttributeMultiprocessorCount, dev) != hipSuccess) { grid = -1; return; }
        if (hipFuncSetAttribute((const void*)fwd_kernel, hipFuncAttributeMaxDynamicSharedMemorySize, LDS_BYTES) != hipSuccess) { fprintf(stderr, "kernel_launch: hipFuncSetAttribute failed\n"); grid = -1; return; }
        int per_cu = 0;
        if (hipOccupancyMaxActiveBlocksPerMultiprocessor(&per_cu, (const void*)fwd_kernel, 512, LDS_BYTES) != hipSuccess || per_cu < 1) { fprintf(stderr, "kernel_launch: occupancy query says %d blocks per CU\n", per_cu); (void)hipGetLastError(); grid = -1; return; }
        if (cus < GRID) { fprintf(stderr, "kernel_launch: needs %d CUs, device has %d\n", GRID, cus); grid = -1; return; }
        grid = GRID;
    }
    if (grid < 0) return;
    (void)hipMemsetAsync((char*)d_ws + WS_CTL, 0, CTL_BYTES, stream);
    Params p{};
    for (int i = 0; i < 19; ++i) p.in[i] = (const float*)d_in[i];
    hipLaunchKernelGGL(fwd_kernel, dim3(grid), dim3(512), LDS_BYTES, stream, p, (unsigned char*)d_ws, (unsigned char*)d_out);
}
```

```cpp
#include <hip/hip_runtime.h>
#include <cstdio>
#include <cstdint>

#define LAS __attribute__((address_space(3)))
#define GAS __attribute__((address_space(1)))
typedef float f32x2 __attribute__((ext_vector_type(2)));
typedef float f32x8 __attribute__((ext_vector_type(8)));
typedef float f32x16 __attribute__((ext_vector_type(16)));
typedef unsigned u32x2 __attribute__((ext_vector_type(2)));
typedef short s16x4 __attribute__((ext_vector_type(4)));
typedef __bf16 bf16x2v __attribute__((ext_vector_type(2)));

constexpr int DM = 2048, NSEQ = 12, LREAL = 4096, NMETA = 16, DEPTH = 4;
constexpr int NMAIN = NSEQ * LREAL;
constexpr int MROW0 = NMAIN;
constexpr int NTOK = NMAIN + NSEQ * NMETA;
constexpr int NPAN = 193, TP = NPAN * 256;
constexpr int PMETA = 192;
constexpr int INC = 4944, NIN = 5120;
constexpr int DFF = 5632, NUP = 2 * DFF;
constexpr int MLW = 1024, NQ = 1536, NKV = 2048;
constexpr float ALPHA = 1.681792830507429f;
constexpr float EPS = 1e-5f;
constexpr float NEGBIG = -1e30f;

constexpr size_t MiB = 1u << 20;
constexpr size_t WS_CTL = 0, CTL_BYTES = 1 * MiB;
constexpr size_t WS_COS = 1 * MiB;
constexpr size_t WS_SIN = WS_COS + (size_t)4112 * 32 * 4;
constexpr size_t WS_PAR = 2 * MiB + 128 * 1024;
constexpr int PO_BG = 0, PO_MLG = PO_BG + DEPTH * 16, PO_QG = PO_MLG + DEPTH * 1024, PO_KVG = PO_QG + DEPTH * 512, PO_L1G = PO_KVG + DEPTH * 256, PO_L1B = PO_L1G + DEPTH * 2048,
              PO_CW = PO_L1B + DEPTH * 2048, PO_CB = PO_CW + DEPTH * 3 * 5632, PO_L2G = PO_CB + DEPTH * 5632, PO_L2B = PO_L2G + DEPTH * 2048, PO_ONE = PO_L2B + DEPTH * 2048, PO_ZERO = PO_ONE + 2048, PO_END = PO_ZERO + 2048;
static_assert(WS_PAR + (size_t)PO_END * 4 <= 3 * MiB && WS_PAR >= 1 * MiB + 2 * 4112 * 32 * 4, "PAR block placement");
constexpr size_t WS_WIN = 3 * MiB;
constexpr size_t WS_WUQ = WS_WIN + (size_t)NIN * DM * 2;
constexpr size_t WS_WUKV = WS_WUQ + (size_t)NQ * 512 * 2;
constexpr size_t WS_WOUT = WS_WUKV + (size_t)NKV * 256 * 2;
constexpr size_t WS_WUP = WS_WOUT + (size_t)DM * DM * 2;
constexpr size_t WS_WDN = WS_WUP + (size_t)NUP * DM * 2;
constexpr size_t WS_STAT1 = WS_WDN + (size_t)DM * DFF * 2;
constexpr size_t WS_STAT2 = WS_CTL + 512 * 1024;
constexpr size_t WS_H = 100 * MiB;
constexpr size_t WS_PART = WS_H + 208 * MiB;
static_assert((size_t)NMAIN * DM * 2 <= 208 * MiB && 208 * MiB + (size_t)11 * 256 * DM * 4 <= (size_t)NMAIN * DM * 4, "PART sits between the bf16 rows and the f32 meta rows of H");
constexpr size_t WS_WSET2 = WS_H + 240 * MiB;
constexpr size_t WSET_BYTES = WS_STAT1 - WS_WIN, WSET_DELTA = WS_WSET2 - WS_WIN;
static_assert(WS_PART + (size_t)11 * 256 * DM * 4 <= WS_WSET2 && WS_WSET2 + WSET_BYTES <= WS_H + (size_t)NMAIN * DM * 4, "second weight set sits between the split-K parts and the f32 meta rows of H");
constexpr size_t WS_HB = WS_H + (size_t)TP * DM * 4;
constexpr size_t WS_R = WS_HB + (size_t)TP * DM * 2;
constexpr size_t WS_UQKVO = WS_R;
constexpr size_t WS_UDQ = WS_UQKVO + (size_t)TP * 4096 * 2;
constexpr size_t WS_UDKV = WS_UDQ + (size_t)TP * 512 * 2;
constexpr size_t WS_GATES = WS_UDKV + (size_t)TP * 256 * 2;
constexpr size_t WS_MKV = WS_GATES + (size_t)TP * 16 * 4;
constexpr size_t WS_KR = WS_MKV + (size_t)TP * NKV * 2;
constexpr size_t WS_RSTD = WS_KR + (size_t)TP * 64 * 2;
constexpr size_t WS_END_A = WS_RSTD + (size_t)TP * 2 * 4;
constexpr size_t WS_ACT = WS_R;
constexpr size_t WS_END_B = WS_ACT + (size_t)TP * DFF * 2;
constexpr size_t WS_NEED = (WS_END_A > WS_END_B ? WS_END_A : WS_END_B);
static_assert(WS_STAT1 + (size_t)TP * 8 <= WS_H && WS_STAT2 + (size_t)TP * 8 <= WS_CTL + CTL_BYTES, "weights and row statistics fit below H");
constexpr size_t DO_HSUM = 0;
constexpr size_t DO_MQ = DO_HSUM + (size_t)TP * MLW * 4;
constexpr size_t DO_GP = 340 * MiB;
constexpr size_t DO_SIDE = 0;
constexpr size_t DO_GVM = 32 * MiB;
static_assert(DO_MQ + (size_t)TP * NQ * 2 <= DO_GP && DO_GP + (size_t)96 * 65 * 200 * 4 <= (size_t)NMAIN * DM * 4 && (size_t)192 * 6 * DFF * 4 <= DO_GVM && DO_GVM + (size_t)256 * NUP * 2 <= (size_t)NMAIN * DM * 4, "d_out scratch fits");
constexpr int CW_BAR = 4096;

constexpr int RING_BYTES = 131072;
constexpr int MISC_OFF = RING_BYTES;
constexpr int LDS_BYTES = 147456;
constexpr int GRID = 256;

__device__ __forceinline__ int pos_of_row(int row) { return row < NMAIN ? NMETA + (row & (LREAL - 1)) : ((row - NMAIN) & (NMETA - 1)); }
__device__ __forceinline__ unsigned pk2(float lo, float hi) { f32x2 v = {lo, hi}; return __builtin_bit_cast(unsigned, __builtin_convertvector(v, bf16x2v)); }
__device__ __forceinline__ float bf_lo(unsigned w) { return __uint_as_float(w << 16); }
__device__ __forceinline__ float bf_hi(unsigned w) { return __uint_as_float(w & 0xffff0000u); }
typedef _Float16 f16x2v __attribute__((ext_vector_type(2)));
__device__ __forceinline__ unsigned pk2h(float lo, float hi) { f32x2 v = {lo, hi}; return __builtin_bit_cast(unsigned, __builtin_convertvector(v, f16x2v)); }
__device__ __forceinline__ float hf_lo(unsigned w) { return (float)__builtin_bit_cast(f16x2v, w)[0]; }
__device__ __forceinline__ float hf_hi(unsigned w) { return (float)__builtin_bit_cast(f16x2v, w)[1]; }
__device__ __forceinline__ float wave_sum(float v) {
#pragma unroll
    for (int o = 1; o < 64; o <<= 1) v += __shfl_xor(v, o);
    return v;
}
__device__ __forceinline__ float wave_max(float v) {
#pragma unroll
    for (int o = 1; o < 64; o <<= 1) v = fmaxf(v, __shfl_xor(v, o));
    return v;
}
namespace pg8 {
#define PG8_LAS __attribute__((address_space(3)))
typedef unsigned short bf16_t;
typedef short bf16x8 __attribute__((ext_vector_type(8)));
typedef float f32x4 __attribute__((ext_vector_type(4)));
typedef unsigned u32x4 __attribute__((ext_vector_type(4)));
constexpr int BM = 256, BK = 64, HALF = 128, HTB = HALF * BK * 2  , STAGE_BYTES = 8 * HTB, NXCD = 8, WGM = 4;

__host__ __device__ __forceinline__ int lds_byte(int r, int c) { const int st = (r >> 4) * 2 + (c >> 5), rr = r & 15, cc = c & 31, ob = rr * 64 + cc * 2; return st * 1024 + (ob ^ (((ob >> 9) & 1) << 5)); }
__host__ __device__ __forceinline__ void stage_rc(int b, int& R, int& C) { const int st = b / 1024, sb = b % 1024, swz = sb ^ (((sb >> 9) & 1) << 5); R = (st >> 1) * 16 + swz / 64; C = (st & 1) * 32 + (swz % 64) / 2; }
__host__ __device__ __forceinline__ int perm32(int rho) { const int n = rho >> 4, i = rho & 15; return 8 * (i >> 2) + 4 * n + (i & 3); }

struct Unit { int pm, pn, kk; };
struct Gemm { const bf16_t* A; const bf16_t* Bt; int M, N, K, ld; };

struct PanelOrder {
    int nM, nN, nwg, G, c, nMain, pm0, pmx;
    __device__ void init(int nMain_, int pm0_, int extra, int pmx_, int N, int G_, int c_) { nMain = nMain_; pm0 = pm0_; pmx = pmx_; nM = nMain_ + extra; nN = N / BM; nwg = nM * nN; G = G_; c = c_; }
    __device__ bool next(int i, Unit& u) const {
        const long L = (long)i * G + c; if (L >= nwg) return false;
        int wgid = (int)L; { const int q = nwg / NXCD, r = nwg % NXCD, xcd = wgid % NXCD, off = wgid / NXCD; wgid = (xcd < r ? xcd * (q + 1) : r * (q + 1) + (xcd - r) * q) + off; }
        const int nig = WGM * nN, gid = wgid / nig, fm = gid * WGM, gsz = (nM - fm) < WGM ? (nM - fm) : WGM;
        const int pl = fm + ((wgid % nig) % gsz); u.pm = pl < nMain ? pm0 + pl : pmx; u.pn = (wgid % nig) / gsz; u.kk = 0; return true;
    }
    __device__ __forceinline__ void a_ready(const Unit&) const {}
    __device__ __forceinline__ void done(const Unit&) const {}
};

struct SplitOrder {
    int pm, nN, nwg, G, c;
    __device__ void init(int pm_, int N, int nsplit, int G_, int c_) { pm = pm_; nN = N / BM; nwg = nN * nsplit; G = G_; c = c_; }
    __device__ bool next(int i, Unit& u) const { const int L = i * G + c; if (L >= nwg) return false; u.pm = pm; u.pn = L % nN; u.kk = L / nN; return true; }
    __device__ __forceinline__ void a_ready(const Unit&) const {}
    __device__ __forceinline__ void done(const Unit&) const {}
};

__device__ __forceinline__ u32x4 pack8(const f32x4 v0, const f32x4 v1) { u32x4 w; w.x = pk2(v0[0], v0[1]); w.y = pk2(v0[2], v0[3]); w.z = pk2(v1[0], v1[1]); w.w = pk2(v1[2], v1[3]); return w; }

struct EpiBf16G {
    static constexpr bool PERM = true, AFTER_DRAIN = false, PERMA = false;
    bf16_t* O; int ldc; const float* rs; int pm_sub, pm_sp, pm_sp_out;
    __device__ __forceinline__ void operator()(const f32x4 (&acc)[2][2][4][2], const Unit& u, int wr, int wc, int fr, int fq) const {
        const int opm = (u.pm == pm_sp) ? pm_sp_out : u.pm - pm_sub;
        const int rin = u.pm * BM + wr * 64 + fr, rout = opm * BM + wr * 64 + fr, col0 = u.pn * BM + wc * 32 + 8 * fq;
#pragma unroll
        for (int ai = 0; ai < 2; ++ai)
#pragma unroll
            for (int m = 0; m < 4; ++m) { const float sc = rs ? rs[(size_t)(rin + ai * HALF + m * 16) * 2] : 1.f;
                bf16_t* rowp = O + (size_t)(rout + ai * HALF + m * 16) * ldc + col0;
#pragma unroll
                for (int bj = 0; bj < 2; ++bj) *(u32x4*)(rowp + bj * HALF) = pack8(acc[ai][bj][m][0] * sc, acc[ai][bj][m][1] * sc); }
    }
};
struct EpiWin {
    static constexpr bool PERM = true, AFTER_DRAIN = false, PERMA = false;
    bf16_t *UQKVO, *UDQ, *UDKV, *KR; float* GATES; const float *COS, *SIN;
    __device__ __forceinline__ void operator()(const f32x4 (&acc)[2][2][4][2], const Unit& u, int wr, int wc, int fr, int fq) const {
        const int row0 = u.pm * BM + wr * 64 + fr;
        if (u.pn < 19) {
            bf16_t* base; int ldc, colt;
            if (u.pn < 16) { base = UQKVO; ldc = 4096; colt = u.pn * BM; } else if (u.pn < 18) { base = UDQ; ldc = 512; colt = (u.pn - 16) * BM; } else { base = UDKV; ldc = 256; colt = 0; }
            const int col0 = colt + wc * 32 + 8 * fq;
#pragma unroll
            for (int ai = 0; ai < 2; ++ai)
#pragma unroll
                for (int m = 0; m < 4; ++m) { bf16_t* rowp = base + (size_t)(row0 + ai * HALF + m * 16) * ldc + col0;
#pragma unroll
                    for (int bj = 0; bj < 2; ++bj) *(u32x4*)(rowp + bj * HALF) = pack8(acc[ai][bj][m][0], acc[ai][bj][m][1]); }
        } else {
            if (wc < 2) { const int g = 4 * wc + fq;
#pragma unroll
                for (int ai = 0; ai < 2; ++ai)
#pragma unroll
                    for (int m = 0; m < 4; ++m) { const int row = row0 + ai * HALF + m * 16, pos = pos_of_row(row);
                        const f32x4 cs = *(const f32x4*)(COS + pos * 32 + 4 * g), sn = *(const f32x4*)(SIN + pos * 32 + 4 * g);
                        const f32x4 x1 = acc[ai][0][m][0], x2 = acc[ai][0][m][1];
                        *(u32x4*)(KR + (size_t)row * 64 + 8 * g) = pack8(x1 * cs - x2 * sn, x1 * sn + x2 * cs); }
            } else if (wc == 2 && fq < 2) {
#pragma unroll
                for (int ai = 0; ai < 2; ++ai)
#pragma unroll
                    for (int m = 0; m < 4; ++m) { float* gp = GATES + (size_t)(row0 + ai * HALF + m * 16) * 16 + 8 * fq;
                        *(f32x4*)gp = acc[ai][0][m][0]; *(f32x4*)(gp + 4) = acc[ai][0][m][1]; }
            }
        }
    }
};
struct EpiQ {
    static constexpr bool PERM = true, AFTER_DRAIN = false, PERMA = false;
    bf16_t* MQ; const float *RSTD, *COS, *SIN;
    __device__ __forceinline__ void operator()(const f32x4 (&acc)[2][2][4][2], const Unit& u, int wr, int wc, int fr, int fq) const {
        const int row0 = u.pm * BM + wr * 64 + fr, colb = u.pn * BM + wc * 32 + 8 * fq;
#pragma unroll
        for (int ai = 0; ai < 2; ++ai)
#pragma unroll
            for (int m = 0; m < 4; ++m) { const int row = row0 + ai * HALF + m * 16, pos = pos_of_row(row); const float sc = RSTD[(size_t)row * 2];
#pragma unroll
                for (int bj = 0; bj < 2; ++bj) { const int col0 = colb + bj * HALF, o = col0 % 192;
                    f32x4 v0 = acc[ai][bj][m][0] * sc, v1 = acc[ai][bj][m][1] * sc;
                    if (o >= 128) { const int g = (o - 128) >> 3; const f32x4 cs = *(const f32x4*)(COS + pos * 32 + 4 * g), sn = *(const f32x4*)(SIN + pos * 32 + 4 * g);
                        const f32x4 x1 = v0, x2 = v1; v0 = x1 * cs - x2 * sn; v1 = x1 * sn + x2 * cs; }
                    *(u32x4*)(MQ + (size_t)row * NQ + col0) = pack8(v0, v1); } }
    }
};
__device__ __forceinline__ void resid_ln_tile(float* __restrict__ Cw, const float* __restrict__ Cr, const float* __restrict__ st, const float* __restrict__ g, const float* __restrict__ b,
                                              int ldc, float alpha, const f32x4 (&acc)[2][2][4][2], int row0, int col0) {
    asm volatile("" ::: "memory");
#pragma unroll
    for (int ai = 0; ai < 2; ++ai)
#pragma unroll
        for (int bj = 0; bj < 2; ++bj) {
            f32x4 gv[2], bv[2], hv[4][2]; f32x2 ms[4];
#pragma unroll
            for (int n = 0; n < 2; ++n) { gv[n] = *(const f32x4*)(g + col0 + bj * HALF + n * 16) * alpha; bv[n] = *(const f32x4*)(b + col0 + bj * HALF + n * 16) * alpha; }
#pragma unroll
            for (int m = 0; m < 4; ++m) { const int row = row0 + ai * HALF + m * 16; ms[m] = *(const f32x2*)(st + (size_t)row * 2);
#pragma unroll
                for (int n = 0; n < 2; ++n) hv[m][n] = *(const f32x4*)(Cr + (size_t)row * ldc + col0 + bj * HALF + n * 16); }
#pragma unroll
            for (int m = 0; m < 4; ++m) { const int row = row0 + ai * HALF + m * 16;
#pragma unroll
                for (int n = 0; n < 2; ++n) *(f32x4*)(Cw + (size_t)row * ldc + col0 + bj * HALF + n * 16) = (hv[m][n] - ms[m][0]) * ms[m][1] * gv[n] + bv[n] + acc[ai][bj][m][n]; }
        }
}
__device__ __forceinline__ void resid_ln_tile_bf(bf16_t* __restrict__ Cw, const bf16_t* __restrict__ Cr, const float* __restrict__ st, const float* __restrict__ g, const float* __restrict__ b,
                                                 int ldc, float alpha, const f32x4 (&acc)[2][2][4][2], int row0, int col0) {
    asm volatile("" ::: "memory");
#pragma unroll
    for (int ai = 0; ai < 2; ++ai)
#pragma unroll
        for (int bj = 0; bj < 2; ++bj) {
            f32x4 gv[2], bv[2]; u32x4 hv[4]; f32x2 ms[4];
#pragma unroll
            for (int n = 0; n < 2; ++n) { gv[n] = *(const f32x4*)(g + col0 + bj * HALF + n * 4) * alpha; bv[n] = *(const f32x4*)(b + col0 + bj * HALF + n * 4) * alpha; }
#pragma unroll
            for (int m = 0; m < 4; ++m) { const int row = row0 + ai * HALF + m * 16; ms[m] = *(const f32x2*)(st + (size_t)row * 2);
                hv[m] = *(const u32x4*)(Cr + (size_t)row * ldc + col0 + bj * HALF); }
#pragma unroll
            for (int m = 0; m < 4; ++m) { const int row = row0 + ai * HALF + m * 16;
                const f32x4 h0 = {hf_lo(hv[m].x), hf_hi(hv[m].x), hf_lo(hv[m].y), hf_hi(hv[m].y)}, h1 = {hf_lo(hv[m].z), hf_hi(hv[m].z), hf_lo(hv[m].w), hf_hi(hv[m].w)};
                const f32x4 o0 = (h0 - ms[m][0]) * ms[m][1] * gv[0] + bv[0] + acc[ai][bj][m][0], o1 = (h1 - ms[m][0]) * ms[m][1] * gv[1] + bv[1] + acc[ai][bj][m][1];
                u32x4 w; w.x = pk2h(o0[0], o0[1]); w.y = pk2h(o0[2], o0[3]); w.z = pk2h(o1[0], o1[1]); w.w = pk2h(o1[2], o1[3]);
                *(u32x4*)(Cw + (size_t)row * ldc + col0 + bj * HALF) = w; }
        }
}
struct EpiResidLn {
    static constexpr bool PERM = true, AFTER_DRAIN = false, PERMA = false;
    bf16_t* C; int ldc; float alpha; const float* st; const float* g; const float* b;
    __device__ __forceinline__ void operator()(const f32x4 (&acc)[2][2][4][2], const Unit& u, int wr, int wc, int fr, int fq) const {
        resid_ln_tile_bf(this->C, this->C, this->st, this->g, this->b, this->ldc, this->alpha, acc, u.pm * BM + wr * 64 + fr, u.pn * BM + wc * 32 + 8 * fq);
    }
};
struct EpiPart {
    static constexpr bool PERM = false, AFTER_DRAIN = false, PERMA = false;
    float* P; int ldc;
    __device__ __forceinline__ void operator()(const f32x4 (&acc)[2][2][4][2], const Unit& u, int wr, int wc, int fr, int fq) const {
        const int row0 = u.kk * BM + wr * 64 + fr, col0 = u.pn * BM + wc * 32 + 4 * fq;
#pragma unroll
        for (int ai = 0; ai < 2; ++ai)
#pragma unroll
            for (int m = 0; m < 4; ++m) { float* rowp = P + (size_t)(row0 + ai * HALF + m * 16) * ldc + col0;
#pragma unroll
                for (int bj = 0; bj < 2; ++bj)
#pragma unroll
                    for (int n = 0; n < 2; ++n) *(f32x4*)(rowp + bj * HALF + n * 16) = acc[ai][bj][m][n]; }
    }
};

__device__ __forceinline__ float dpp_shr1_old(float old, float x) { return __int_as_float(__builtin_amdgcn_update_dpp(__float_as_int(old), __float_as_int(x), 0x111, 0xf, 0xf, false)); }
__device__ __forceinline__ float dpp_shl1_old(float old, float x) { return __int_as_float(__builtin_amdgcn_update_dpp(__float_as_int(old), __float_as_int(x), 0x101, 0xf, 0xf, false)); }
struct EpiFfn {
    static constexpr bool PERM = true, AFTER_DRAIN = false, PERMA = true;
    bf16_t* ACT; float* SIDE; bf16_t* GVM; const float *cw, *cb; PG8_LAS float* X;
    __device__ __forceinline__ void operator()(const f32x4 (&acc)[2][2][4][2], const Unit& u, int wr_in, int wc_in, int fr_in, int fq_in) const {
        int fr = fr_in, fq = fq_in, wr = wr_in, wc = wc_in; asm volatile("" : "+v"(fr), "+v"(fq), "+s"(wr), "+s"(wc));
        const int cj = wc * 32 + 8 * fq, c0 = u.pn * 128 + cj;
        if (u.pm == PMETA) {
#pragma unroll
            for (int ai = 0; ai < 2; ++ai)
#pragma unroll
                for (int m = 0; m < 4; ++m) { bf16_t* rowp = GVM + (size_t)(ai * HALF + wr * 64 + 4 * fr + m) * NUP + c0;
                    *(u32x4*)rowp = pack8(acc[ai][0][m][0], acc[ai][0][m][1]); *(u32x4*)(rowp + DFF) = pack8(acc[ai][1][m][0], acc[ai][1][m][1]); }
            return;
        }
        f32x4 w0[2], w1[2], w2[2], bb[2];
#pragma unroll
        for (int n = 0; n < 2; ++n) { w0[n] = *(const f32x4*)(cw + c0 + 4 * n); w1[n] = *(const f32x4*)(cw + DFF + c0 + 4 * n); w2[n] = *(const f32x4*)(cw + 2 * DFF + c0 + 4 * n); bb[n] = *(const f32x4*)(cb + c0 + 4 * n); }
#pragma unroll
        for (int ai = 0; ai < 2; ++ai) { const int b = 2 * ai + wr;
            if (fr == 0) { *(PG8_LAS f32x4*)(X + (b * 2 + 0) * 128 + cj) = acc[ai][0][0][0]; *(PG8_LAS f32x4*)(X + (b * 2 + 0) * 128 + cj + 4) = acc[ai][0][0][1]; }
            if (fr == 15) { *(PG8_LAS f32x4*)(X + (b * 2 + 1) * 128 + cj) = acc[ai][0][3][0]; *(PG8_LAS f32x4*)(X + (b * 2 + 1) * 128 + cj + 4) = acc[ai][0][3][1]; } }
        asm volatile("s_waitcnt lgkmcnt(0)" ::: "memory"); __builtin_amdgcn_s_barrier(); asm volatile("" ::: "memory");
        const unsigned rowb = (unsigned)(u.pm * BM + wr * 64 + 4 * fr) * DFF + c0;
#pragma unroll
        for (int ai = 0; ai < 2; ++ai) { const int b = 2 * ai + wr;
            f32x4 xp[2], xn[2];
#pragma unroll
            for (int n = 0; n < 2; ++n) { xp[n] = b > 0 ? *(const PG8_LAS f32x4*)(X + ((b - 1) * 2 + 1) * 128 + cj + 4 * n) : (f32x4){0.f, 0.f, 0.f, 0.f};
                                          xn[n] = b < 3 ? *(const PG8_LAS f32x4*)(X + ((b + 1) * 2 + 0) * 128 + cj + 4 * n) : (f32x4){0.f, 0.f, 0.f, 0.f}; }
            f32x4 up0[2], dn3[2];
#pragma unroll
            for (int n = 0; n < 2; ++n)
#pragma unroll
                for (int e = 0; e < 4; ++e) { up0[n][e] = dpp_shr1_old(xp[n][e], acc[ai][0][3][n][e]); dn3[n][e] = dpp_shl1_old(xn[n][e], acc[ai][0][0][n][e]); }
#pragma unroll
            for (int m = 0; m < 4; ++m) { u32x4 ow;
#pragma unroll
                for (int n = 0; n < 2; ++n) {
                    const f32x4 g = acc[ai][0][m][n], pv = m > 0 ? acc[ai][0][m > 0 ? m - 1 : 0][n] : up0[n], nx = m < 3 ? acc[ai][0][m < 3 ? m + 1 : 3][n] : dn3[n];
                    const f32x4 x = w0[n] * pv + w1[n] * g + w2[n] * nx + bb[n]; f32x4 t, o;
#pragma unroll
                    for (int e = 0; e < 4; ++e) t[e] = __expf(-x[e]);
                    t = t + 1.f;
#pragma unroll
                    for (int e = 0; e < 4; ++e) t[e] = __builtin_amdgcn_rcpf(t[e]);
                    o = x * t * acc[ai][1][m][n];
                    if (n == 0) { ow.x = pk2(o[0], o[1]); ow.y = pk2(o[2], o[3]); } else { ow.z = pk2(o[0], o[1]); ow.w = pk2(o[2], o[3]); } }
                bf16_t* dst = ACT + (rowb + (unsigned)(ai * HALF + m) * DFF);
                if (ai == 0 ? m < 2 : m >= 2) {
                    const int r = ai * HALF + wr * 64 + 4 * fr + m;
                    if (r != 0 && r != 255) *(u32x4*)dst = ow;
                    const int slot = r == 0 ? 0 : r == 1 ? 1 : r == 254 ? 2 : r == 255 ? 3 : -1;
                    if (slot >= 0) { float* sp = SIDE + ((size_t)u.pm * 6 + slot) * DFF + c0; *(f32x4*)sp = acc[ai][0][m][0]; *(f32x4*)(sp + 4) = acc[ai][0][m][1];
                        if (slot == 0 || slot == 3) { float* vp = SIDE + ((size_t)u.pm * 6 + (slot == 0 ? 4 : 5)) * DFF + c0; *(f32x4*)vp = acc[ai][1][m][0]; *(f32x4*)(vp + 4) = acc[ai][1][m][1]; } }
                } else *(u32x4*)dst = ow;
            }
        }
    }
};
template <class Epi, class Sched, bool ALIGN_EPI = false, bool SP2 = false>
__device__ __forceinline__ void gemm_phase(PG8_LAS unsigned char* lds, const Gemm g, const Sched& S, const Epi& E) {
    int tid_ = threadIdx.x; asm volatile("" : "+v"(tid_));
    const int tid = tid_, wid = __builtin_amdgcn_readfirstlane(tid >> 6), lane = tid & 63, wr = wid >> 2, wc = wid & 3, fr = lane & 15, fq = lane >> 4;
    const int K = g.ld, nt = g.K / BK;
    unsigned voffA[2], voffB[2];
#pragma unroll
    for (int i = 0; i < 2; ++i) { int R, C; stage_rc(tid * 16 + i * 8192, R, C); const int Rb = Epi::PERM ? ((R & ~31) + perm32(R & 31)) : R;
        const int Ra = Epi::PERMA ? ((R & ~63) | ((R & 15) << 2) | ((R >> 4) & 3)) : R;
        voffA[i] = (unsigned)(Ra * K + C) * 2u; voffB[i] = (unsigned)(Rb * K + C) * 2u; }
    const size_t kstep = (size_t)(BK * 2);
    const size_t hstep = (size_t)HALF * K * 2;
    const size_t tstep = 2 * hstep;
    const unsigned ldsw = (unsigned)wid * 1024u;
    const int aoff = lds_byte(wr * 64 + fr, fq * 8), boff = lds_byte(wc * 32 + fr, fq * 8);
#define PG8_SA(b, h) (((b) * 2 + (h)) * HTB)
#define PG8_SB(b, h) ((4 + (b) * 2 + (h)) * HTB)
#define PG8_STAGE(bufoff, gbase, voff) do { _Pragma("unroll") for (int _i = 0; _i < 2; ++_i) \
        __builtin_amdgcn_global_load_lds((const unsigned*)((const char*)(gbase) + (voff)[_i]), (PG8_LAS unsigned*)(lds + (bufoff) + ldsw + _i * 8192), 16, 0, 0); } while (0)
#define PG8_LDA(dst, b, h) do { _Pragma("unroll") for (int m = 0; m < 4; ++m) _Pragma("unroll") for (int k = 0; k < 2; ++k) dst[m][k] = *(const PG8_LAS bf16x8*)(lds + PG8_SA(b, h) + aoff + m * 2048 + k * 1024); } while (0)
#define PG8_LDB(dst, b, h) do { _Pragma("unroll") for (int n = 0; n < 2; ++n) _Pragma("unroll") for (int k = 0; k < 2; ++k) dst[n][k] = *(const PG8_LAS bf16x8*)(lds + PG8_SB(b, h) + boff + n * 2048 + k * 1024); } while (0)
#define PG8_MMA(ai, bj, At, Bt) do { __builtin_amdgcn_s_setprio(1); _Pragma("unroll") for (int m = 0; m < 4; ++m) _Pragma("unroll") for (int n = 0; n < 2; ++n) _Pragma("unroll") for (int k = 0; k < 2; ++k) \
        acc[ai][bj][m][n] = __builtin_amdgcn_mfma_f32_16x16x32_bf16(Bt[n][k], At[m][k], acc[ai][bj][m][n], 0, 0, 0); __builtin_amdgcn_s_setprio(0); } while (0)
#define PG8_WAIT_V(n) asm volatile("s_waitcnt vmcnt(" #n ")" ::: "memory")
#define PG8_WAIT_L(n) asm volatile("s_waitcnt lgkmcnt(" #n ")" ::: "memory")
#define PG8_BAR __builtin_amdgcn_s_barrier()
#define PG8_SCHED __builtin_amdgcn_sched_barrier(0)
    Unit cur, nxt; int ui = 0;
    if (!S.next(0, cur)) return;
    f32x4 acc[2][2][4][2];
#pragma unroll
    for (int a = 0; a < 2; ++a)
#pragma unroll
        for (int b = 0; b < 2; ++b)
#pragma unroll
            for (int m = 0; m < 4; ++m)
#pragma unroll
                for (int n = 0; n < 2; ++n) acc[a][b][m][n] = (f32x4){0.f, 0.f, 0.f, 0.f};
    bf16x8 At[4][2], B0[2][2], B1[2][2];
    const size_t sstep = (size_t)g.K * 2;
    const char* cA = (const char*)g.A + (size_t)cur.pm * tstep + (size_t)cur.kk * sstep; const char* cB = (const char*)g.Bt + (size_t)cur.pn * tstep + (size_t)cur.kk * sstep;
    S.a_ready(cur);
    if constexpr (SP2) {
        PG8_STAGE(PG8_SB(0, 0), cB, voffB); PG8_STAGE(PG8_SB(0, 1), cB + hstep, voffB); PG8_STAGE(PG8_SA(0, 0), cA, voffA); PG8_STAGE(PG8_SA(0, 1), cA + hstep, voffA);
        if (wr == 1) PG8_BAR;
        PG8_WAIT_V(2); PG8_BAR;
        PG8_STAGE(PG8_SB(1, 0), cB + kstep, voffB); PG8_STAGE(PG8_SA(1, 0), cA + kstep, voffA); PG8_STAGE(PG8_SB(1, 1), cB + hstep + kstep, voffB);
        PG8_WAIT_V(6); PG8_BAR;
    } else {
        PG8_STAGE(PG8_SB(0, 0), cB, voffB); PG8_STAGE(PG8_SA(0, 0), cA, voffA); PG8_STAGE(PG8_SB(0, 1), cB + hstep, voffB); PG8_STAGE(PG8_SA(0, 1), cA + hstep, voffA);
        if (wr == 1) PG8_BAR;
        PG8_WAIT_V(4); PG8_BAR;
        PG8_STAGE(PG8_SB(1, 0), cB + kstep, voffB); PG8_STAGE(PG8_SA(1, 0), cA + kstep, voffA); PG8_STAGE(PG8_SB(1, 1), cB + hstep + kstep, voffB);
        PG8_WAIT_V(6); PG8_BAR;
    }
    for (;;) {
        const bool has_next = S.next(ui + 1, nxt);
        const char* nA = has_next ? (const char*)g.A + (size_t)nxt.pm * tstep + (size_t)nxt.kk * sstep : cA; const char* nB = has_next ? (const char*)g.Bt + (size_t)nxt.pn * tstep + (size_t)nxt.kk * sstep : cB;
        for (int t = 0; t < nt; t += 2) {
            const bool last = (t == nt - 2);
            const char* a1 = cA + (size_t)(t + 1) * kstep;
            const char* a2 = last ? nA : cA + (size_t)(t + 2) * kstep; const char* b2 = last ? nB : cB + (size_t)(t + 2) * kstep;
            const char* a3 = a2 + kstep; const char* b3 = b2 + kstep;
            if (last && has_next) S.a_ready(nxt);
            if constexpr (SP2) {
            PG8_LDB(B0, 0, 0); PG8_LDB(B1, 0, 1); PG8_SCHED; PG8_LDA(At, 0, 0); PG8_STAGE(PG8_SA(1, 1), a1 + hstep, voffA);
            PG8_WAIT_V(8); PG8_WAIT_L(0); PG8_BAR; PG8_MMA(0, 0, At, B0); PG8_MMA(0, 1, At, B1); PG8_BAR; PG8_SCHED;
            PG8_LDA(At, 0, 1); PG8_STAGE(PG8_SB(0, 0), b2, voffB); PG8_STAGE(PG8_SB(0, 1), b2 + hstep, voffB); PG8_STAGE(PG8_SA(0, 0), a2, voffA);
            PG8_WAIT_V(8); PG8_WAIT_L(0); PG8_BAR; PG8_MMA(1, 0, At, B0); PG8_MMA(1, 1, At, B1); PG8_BAR; PG8_SCHED;
            PG8_LDB(B0, 1, 0); PG8_LDB(B1, 1, 1); PG8_SCHED; PG8_LDA(At, 1, 0); PG8_STAGE(PG8_SA(0, 1), a2 + hstep, voffA);
            PG8_WAIT_V(8); PG8_WAIT_L(0); PG8_BAR; PG8_MMA(0, 0, At, B0); PG8_MMA(0, 1, At, B1); PG8_BAR; PG8_SCHED;
            PG8_LDA(At, 1, 1); PG8_STAGE(PG8_SB(1, 0), b3, voffB); PG8_STAGE(PG8_SB(1, 1), b3 + hstep, voffB); PG8_STAGE(PG8_SA(1, 0), a3, voffA);
            PG8_WAIT_V(8); PG8_WAIT_L(0); PG8_BAR; PG8_MMA(1, 0, At, B0); PG8_MMA(1, 1, At, B1); PG8_BAR; PG8_SCHED;
            } else {
            PG8_LDB(B0, 0, 0); PG8_SCHED; PG8_LDA(At, 0, 0); PG8_STAGE(PG8_SA(1, 1), a1 + hstep, voffA);
            PG8_WAIT_L(8); PG8_BAR; PG8_WAIT_L(0); PG8_MMA(0, 0, At, B0); PG8_BAR; PG8_SCHED;
            PG8_LDB(B1, 0, 1); PG8_STAGE(PG8_SB(0, 0), b2, voffB);
            PG8_BAR; PG8_WAIT_L(0); PG8_MMA(0, 1, At, B1); PG8_BAR;
            PG8_LDA(At, 0, 1); PG8_STAGE(PG8_SA(0, 0), a2, voffA);
            PG8_BAR; PG8_WAIT_L(0); PG8_MMA(1, 0, At, B0); PG8_BAR; PG8_SCHED;
            PG8_STAGE(PG8_SB(0, 1), b2 + hstep, voffB);
            PG8_WAIT_V(6); PG8_BAR; PG8_MMA(1, 1, At, B1); PG8_BAR;
            PG8_LDB(B0, 1, 0); PG8_SCHED; PG8_LDA(At, 1, 0); PG8_STAGE(PG8_SA(0, 1), a2 + hstep, voffA);
            PG8_WAIT_L(8); PG8_BAR; PG8_WAIT_L(0); PG8_MMA(0, 0, At, B0); PG8_BAR; PG8_SCHED;
            PG8_LDB(B1, 1, 1); PG8_STAGE(PG8_SB(1, 0), b3, voffB);
            PG8_BAR; PG8_WAIT_L(0); PG8_MMA(0, 1, At, B1); PG8_BAR;
            PG8_LDA(At, 1, 1); PG8_STAGE(PG8_SA(1, 0), a3, voffA);
            PG8_BAR; PG8_WAIT_L(0); PG8_MMA(1, 0, At, B0); PG8_BAR; PG8_SCHED;
            PG8_STAGE(PG8_SB(1, 1), b3 + hstep, voffB);
            PG8_WAIT_V(6); PG8_BAR; PG8_MMA(1, 1, At, B1); PG8_BAR;
            }
        }
        if constexpr (ALIGN_EPI) { if (wr == 0) PG8_BAR; }
        if constexpr (!Epi::AFTER_DRAIN) { E(acc, cur, wr, wc, fr, fq); S.done(cur); }
        if (!has_next) break;
#pragma unroll
        for (int a = 0; a < 2; ++a)
#pragma unroll
            for (int b = 0; b < 2; ++b)
#pragma unroll
                for (int m = 0; m < 4; ++m)
#pragma unroll
                    for (int n = 0; n < 2; ++n) acc[a][b][m][n] = (f32x4){0.f, 0.f, 0.f, 0.f};
        cur = nxt; cA = nA; cB = nB; ++ui;
        if constexpr (ALIGN_EPI) { if (wr == 1) PG8_BAR; }
    }
    PG8_WAIT_V(0);
    if constexpr (!ALIGN_EPI) { if (wr == 0) PG8_BAR; }
    PG8_BAR;
    if constexpr (Epi::AFTER_DRAIN) { E.fused(acc, cur, wr, wc, fr, fq, lds, wid, lane); S.done(cur); }
#undef PG8_SA
#undef PG8_SB
#undef PG8_STAGE
#undef PG8_LDA
#undef PG8_LDB
#undef PG8_MMA
#undef PG8_WAIT_V
#undef PG8_WAIT_L
#undef PG8_BAR
#undef PG8_SCHED
}
}
#define XB_TMO      128
#define XB_XCNT(j)  (256  + 64 * (j))
#define XB_XSUB(j)  (1280 + 64 * (j))
#define XB_XGEN(j)  (2304 + 64 * (j))
#define XB_TOP      3328
#define XB_TOPGEN   3392
#define XCD_BAR_WORDS 3456
#define XB_SPIN_CAP (1u << 21)

__device__ __forceinline__ unsigned xb_ld(unsigned* p)              { return __hip_atomic_load(p, __ATOMIC_RELAXED, __HIP_MEMORY_SCOPE_AGENT); }
__device__ __forceinline__ unsigned xb_add(unsigned* p, unsigned v) { return __hip_atomic_fetch_add(p, v, __ATOMIC_RELAXED, __HIP_MEMORY_SCOPE_AGENT); }
__device__ __forceinline__ unsigned xb_xcc_id() { return (unsigned)__builtin_amdgcn_s_getreg((3 << 11) | 20) & 0xFu; }
#define XB_SPIN(cond, bar) do { unsigned _sp = 0; while (cond) { __builtin_amdgcn_s_sleep(1); \
    if ((++_sp & 255u) == 0u) { if (xb_ld(&(bar)[XB_TMO])) break; if (_sp > XB_SPIN_CAP) { atomicAdd(&(bar)[XB_TMO], 1u); break; } } } } while (0)

struct XcdBarrier {
    unsigned* bar; unsigned x;
    volatile LAS unsigned* st;
};

__device__ __forceinline__ XcdBarrier xcd_barrier_post(unsigned* bar, volatile LAS unsigned* st) {
    XcdBarrier b; b.bar = bar; b.x = (unsigned)__builtin_amdgcn_readfirstlane((int)xb_xcc_id()); b.st = st;
    if (threadIdx.x == 0) (void)xb_add(&bar[XB_XCNT(b.x)], 1u);
    return b;
}
__device__ __forceinline__ void xcd_barrier_complete(unsigned* bar, unsigned x, unsigned& nloc, unsigned& nx) {
    const unsigned G = gridDim.x * gridDim.y * gridDim.z;
    unsigned sum, cnt, mine, sp = 0u;
    for (;;) {
        sum = 0u; cnt = 0u; mine = 0u;
#pragma unroll
        for (unsigned j = 0; j < 16; ++j) { const unsigned c = xb_ld(&bar[XB_XCNT(j)]); sum += c; cnt += (c > 0u) ? 1u : 0u; }
        mine = xb_ld(&bar[XB_XCNT(x)]);
        if (sum == G) { mine = xb_ld(&bar[XB_XCNT(x)]); break; }
        __builtin_amdgcn_s_sleep(1);
        if ((++sp & 255u) == 0u) { if (xb_ld(&bar[XB_TMO])) break; if (sp > XB_SPIN_CAP) { atomicAdd(&bar[XB_TMO], 1u); break; } }
    }
    nloc = mine > 0u ? mine : 1u; nx = cnt > 0u ? cnt : 1u;
}

__device__ __forceinline__ void xcd_barrier(const XcdBarrier& b) {
    asm volatile("s_waitcnt vmcnt(0)" ::: "memory");
    __syncthreads();
    if (threadIdx.x == 0) {
        unsigned* bar = b.bar; unsigned bx_ = b.x;
        asm volatile("" : "+s"(bx_));
        __builtin_amdgcn_s_waitcnt(0);
        unsigned nloc = b.st[0], nx = b.st[1];
        if (nloc == 0u) { xcd_barrier_complete(bar, bx_, nloc, nx); b.st[0] = nloc; b.st[1] = nx; }
        const unsigned old = xb_add(&bar[XB_XSUB(bx_)], 1u);
        const unsigned gen = old / nloc;
        if (old + 1u == (gen + 1u) * nloc) {
            __builtin_amdgcn_fence(__ATOMIC_RELEASE, "agent");
            asm volatile("s_waitcnt vmcnt(0)" ::: "memory");
            const unsigned og = xb_add(&bar[XB_TOP], 1u);
            const unsigned tg = og / nx;
            if (og + 1u == (tg + 1u) * nx) xb_add(&bar[XB_TOPGEN], 1u);
            else XB_SPIN(xb_ld(&bar[XB_TOPGEN]) == tg, bar);
            __builtin_amdgcn_fence(__ATOMIC_ACQUIRE, "agent");
            xb_add(&bar[XB_XGEN(bx_)], 1u);
            asm volatile("s_waitcnt vmcnt(0)" ::: "memory");
        } else {
            XB_SPIN(xb_ld(&bar[XB_XGEN(bx_)]) == gen, bar);
            __builtin_amdgcn_fence(__ATOMIC_ACQUIRE, "agent");
            asm volatile("s_waitcnt vmcnt(0)" ::: "memory");
        }
    }
    __syncthreads();
}

typedef unsigned short bf16_t;
typedef short bf16x8 __attribute__((ext_vector_type(8)));
typedef float f32x4 __attribute__((ext_vector_type(4)));
typedef unsigned u32x4 __attribute__((ext_vector_type(4)));
#define LDS_WAIT() asm volatile("s_waitcnt lgkmcnt(0)" ::: "memory")

struct Params {
    const float* in[19];
};
struct Frame {
    LAS unsigned char* lds;
    int tid, lane, wave, G, bx, vcu, gw, ngw;
};
__device__ __forceinline__ const float* uptr(const LAS unsigned long long* t, int k) {
    const unsigned long long v = t[k]; const unsigned lo = __builtin_amdgcn_readfirstlane((unsigned)v), hi = __builtin_amdgcn_readfirstlane((unsigned)(v >> 32));
    return (const float*)(const GAS float*)(((unsigned long long)hi << 32) | lo); }

template <class CMap>
__device__ __forceinline__ void transpose_load(float (&v)[32], const float* W, int Nsrc, const float* ks, int kb, int nb, int lane, CMap cmap) {
    const int k0 = 64 * kb, n0 = 32 * nb; const int sc = cmap(n0 + (lane & 31));
#pragma unroll
    for (int i = 0; i < 32; ++i) { const int kk = 2 * i + (lane >> 5); float x = 0.f; if (sc >= 0) x = W[(size_t)(k0 + kk) * Nsrc + sc]; if (ks) x *= ks[k0 + kk]; v[i] = x; }
}
__device__ __forceinline__ void transpose_store(const float (&v)[32], int K, bf16_t* WT, LAS float* scr, int kb, int nb, int lane) {
    const int k0 = 64 * kb, n0 = 32 * nb;
#pragma unroll
    for (int i = 0; i < 32; ++i) scr[(2 * i + (lane >> 5)) * 33 + (lane & 31)] = v[i];
    LDS_WAIT(); asm volatile("" ::: "memory");
    const int c = lane & 7;
#pragma unroll
    for (int j = 0; j < 4; ++j) { const int n = (lane >> 3) + 8 * j; const LAS float* s = scr + (8 * c) * 33 + n;
        u32x4 o; o.x = pk2(s[0 * 33], s[1 * 33]); o.y = pk2(s[2 * 33], s[3 * 33]); o.z = pk2(s[4 * 33], s[5 * 33]); o.w = pk2(s[6 * 33], s[7 * 33]);
        *(u32x4*)(WT + (size_t)(n0 + n) * K + k0 + 8 * c) = o; }
    LDS_WAIT(); asm volatile("" ::: "memory");
}
template <class CMap>
__device__ __forceinline__ void transpose_matrix(const Frame& F, const float* W, int K, int Nsrc, int Ndst, bf16_t* WT, const float* ks, LAS float* scr, CMap cmap) {
    const int nnb = Ndst / 32, items = (K / 64) * nnb;
    for (int it = F.gw; it < items; it += 2 * F.ngw) { const int it2 = it + F.ngw; float va[32], vb[32];
        transpose_load(va, W, Nsrc, ks, it / nnb, it % nnb, F.lane, cmap);
        if (it2 < items) transpose_load(vb, W, Nsrc, ks, it2 / nnb, it2 % nnb, F.lane, cmap);
        transpose_store(va, K, WT, scr, it / nnb, it % nnb, F.lane);
        if (it2 < items) transpose_store(vb, K, WT, scr, it2 / nnb, it2 % nnb, F.lane); }
}
__device__ __forceinline__ int rope_perm(int m) { const int g = m >> 3, j = m & 7; return j < 4 ? 4 * g + j : 32 + 4 * g + (j - 4); }
struct CMapIn { __device__ int operator()(int n) const {
    if (n < 4096) return n; if (n < 4608) return 4112 + (n - 4096); if (n < 4864) return 4624 + (n - 4608);
    if (n < 4928) return 4880 + rope_perm(n - 4864); if (n < 4944) return 4096 + (n - 4928); return -1; } };
struct CMapQ { __device__ int operator()(int n) const { const int h = n / 192, o = n % 192; return o < 128 ? n : h * 192 + 128 + rope_perm(o - 128); } };
struct CMapUp { __device__ int operator()(int n) const { const int pn = n >> 8, j = n & 255; return j < 128 ? 128 * pn + j : DFF + 128 * pn + (j - 128); } };
struct CMapId { __device__ int operator()(int n) const { return n; } };

__device__ __forceinline__ void convert_weights(const Frame& F, unsigned char* ws_, const LAS unsigned long long* pt, int l, size_t wo, int slot) {
    unsigned char* ws = ws_ + wo;
    LAS float* scr = (LAS float*)(F.lds + F.wave * 8448);
    if (slot != 1) {
        const float* w_in = uptr(pt, 3) + (size_t)l * DM * INC; const float* w_uq = uptr(pt, 8) + (size_t)l * 512 * NQ; const float* w_ukv = uptr(pt, 9) + (size_t)l * 256 * NKV;
        const float* w_out = uptr(pt, 10) + (size_t)l * DM * DM; const float* w_dn = uptr(pt, 16) + (size_t)l * DFF * DM;
        const float* qg = uptr(pt, 6) + (size_t)l * 512; const float* kvg = uptr(pt, 7) + (size_t)l * 256;
        transpose_matrix(F, w_in, DM, INC, NIN, (bf16_t*)(ws + WS_WIN), nullptr, scr, CMapIn());
        transpose_matrix(F, w_uq, 512, NQ, NQ, (bf16_t*)(ws + WS_WUQ), qg, scr, CMapQ());
        transpose_matrix(F, w_ukv, 256, NKV, NKV, (bf16_t*)(ws + WS_WUKV), kvg, scr, CMapId());
        transpose_matrix(F, w_out, DM, DM, DM, (bf16_t*)(ws + WS_WOUT), nullptr, scr, CMapId());
        transpose_matrix(F, w_dn, DFF, DM, DM, (bf16_t*)(ws + WS_WDN), nullptr, scr, CMapId());
    }
    if (slot != 0) { const float* w_up = uptr(pt, 13) + (size_t)l * DM * NUP;
        transpose_matrix(F, w_up, DM, NUP, NUP, (bf16_t*)(ws + WS_WUP), nullptr, scr, CMapUp()); }
}
__device__ __forceinline__ void prologue(const Frame& F, unsigned char* ws, const LAS unsigned long long* pt) {
    float* COS = (float*)(ws + WS_COS); float* SIN = (float*)(ws + WS_SIN);
    for (int i = F.bx * 512 + F.tid; i < 4112 * 32; i += F.G * 512) { const int pos = i >> 5, f = i & 31;
        const float inv = powf(10000.0f, -(float)(2 * f) / 64.0f); const float ang = (float)pos * inv; float s, c; sincosf(ang, &s, &c); COS[i] = c; SIN[i] = s; }
    { float* PAR = (float*)(ws + WS_PAR); const int gt = F.bx * 512 + F.tid, nt = F.G * 512;
      for (int i = gt; i < DEPTH * 16; i += nt) PAR[PO_BG + i] = uptr(pt, 4)[i];
      for (int i = gt; i < DEPTH * 1024; i += nt) PAR[PO_MLG + i] = uptr(pt, 5)[i];
      for (int i = gt; i < DEPTH * 512; i += nt) PAR[PO_QG + i] = uptr(pt, 6)[i];
      for (int i = gt; i < DEPTH * 256; i += nt) PAR[PO_KVG + i] = uptr(pt, 7)[i];
      for (int i = gt; i < 2048; i += nt) { PAR[PO_ONE + i] = 1.f; PAR[PO_ZERO + i] = 0.f; }
      { float* ST2 = (float*)(ws + WS_STAT2); for (int i = gt; i < TP; i += nt) { ST2[2 * i] = 0.f; ST2[2 * i + 1] = 1.f; } }
      for (int i = gt; i < DEPTH * 2048; i += nt) { PAR[PO_L1G + i] = uptr(pt, 11)[i]; PAR[PO_L1B + i] = uptr(pt, 12)[i]; PAR[PO_L2G + i] = uptr(pt, 17)[i]; PAR[PO_L2B + i] = uptr(pt, 18)[i]; }
      for (int i = gt; i < DEPTH * 3 * 5632; i += nt) PAR[PO_CW + i] = uptr(pt, 14)[i];
      for (int i = gt; i < DEPTH * 5632; i += nt) PAR[PO_CB + i] = uptr(pt, 15)[i]; }
    float* H = (float*)(ws + WS_H); bf16_t* HB = (bf16_t*)(ws + WS_HB);
    const float* xp = uptr(pt, 0); const float* xs = uptr(pt, 1); const float* mt = uptr(pt, 2);
    for (int row0 = F.gw; row0 < TP; row0 += 2 * F.ngw) {
        f32x4 v[2][8];
#pragma unroll
        for (int r = 0; r < 2; ++r) { const int row = row0 + r * F.ngw; const float* src = nullptr;
            if (row < 4 * LREAL) src = xp + (size_t)row * DM; else if (row < NMAIN) src = xs + (size_t)(row - 4 * LREAL) * DM; else if (row < NTOK) src = mt + (size_t)((row - NMAIN) & 15) * DM;
#pragma unroll
            for (int j = 0; j < 8; ++j) { v[r][j] = (f32x4){0.f, 0.f, 0.f, 0.f}; if (src) v[r][j] = ((const f32x4*)src)[F.lane + 64 * j]; } }
#pragma unroll
        for (int r = 0; r < 2; ++r) { const int row = row0 + r * F.ngw; if (row < TP) {
            f32x4* hd = (f32x4*)(H + (size_t)row * DM) + F.lane; u32x2* bd = (u32x2*)(HB + (size_t)row * DM) + F.lane; u32x2* hb = (u32x2*)((bf16_t*)H + (size_t)row * DM) + F.lane;
#pragma unroll
            for (int j = 0; j < 8; ++j) { const f32x4 x = v[r][j];
                u32x2 w; w.x = pk2(x[0], x[1]); w.y = pk2(x[2], x[3]); bd[64 * j] = w;
                if (row >= NMAIN) hd[64 * j] = x * ALPHA;
                else { u32x2 wh; wh.x = pk2h(x[0], x[1]); wh.y = pk2h(x[2], x[3]); hb[64 * j] = wh; } } } }
    }
}

__device__ __forceinline__ void ln_one(const f32x4 (&vin)[8], int row, int lane, float* __restrict__ Hw, bf16_t* __restrict__ HB, const float* __restrict__ g, const float* __restrict__ b, float* __restrict__ ST) {
    f32x4 v[8]; float s = 0.f;
#pragma unroll
    for (int j = 0; j < 8; ++j) { v[j] = vin[j]; s += (v[j][0] + v[j][1]) + (v[j][2] + v[j][3]); }
    const float mean = wave_sum(s) * (1.f / DM); float q = 0.f;
#pragma unroll
    for (int j = 0; j < 8; ++j) { v[j] = v[j] - mean; q += (v[j][0] * v[j][0] + v[j][1] * v[j][1]) + (v[j][2] * v[j][2] + v[j][3] * v[j][3]); }
    const float rstd = rsqrtf(wave_sum(q) * (1.f / DM) + EPS);
    if (lane == 0) { f32x2 ms = {mean, rstd}; *(f32x2*)(ST + (size_t)row * 2) = ms; }
    u32x2* bd = (u32x2*)(HB + (size_t)row * DM) + lane; f32x4* hp = (f32x4*)(Hw + (size_t)row * DM) + lane;
#pragma unroll
    for (int j = 0; j < 8; ++j) { const f32x4 gg = ((const f32x4*)g)[lane + 64 * j], bb = ((const f32x4*)b)[lane + 64 * j]; const f32x4 y = v[j] * rstd * gg + bb;
        u32x2 w; w.x = pk2(y[0], y[1]); w.y = pk2(y[2], y[3]); bd[64 * j] = w;
        hp[64 * j] = y * ALPHA; }
}
__device__ __forceinline__ void ln_one_bf(const u32x4 (&vin)[4], int row, int lane, bf16_t* __restrict__ HB, const float* __restrict__ g, const float* __restrict__ b, float* __restrict__ ST, float* __restrict__ out) {
    f32x4 v[8]; float s = 0.f;
#pragma unroll
    for (int j = 0; j < 4; ++j) { v[2 * j] = (f32x4){hf_lo(vin[j].x), hf_hi(vin[j].x), hf_lo(vin[j].y), hf_hi(vin[j].y)}; v[2 * j + 1] = (f32x4){hf_lo(vin[j].z), hf_hi(vin[j].z), hf_lo(vin[j].w), hf_hi(vin[j].w)}; }
#pragma unroll
    for (int j = 0; j < 8; ++j) s += (v[j][0] + v[j][1]) + (v[j][2] + v[j][3]);
    const float mean = wave_sum(s) * (1.f / DM); float q = 0.f;
#pragma unroll
    for (int j = 0; j < 8; ++j) { v[j] = v[j] - mean; q += (v[j][0] * v[j][0] + v[j][1] * v[j][1]) + (v[j][2] * v[j][2] + v[j][3] * v[j][3]); }
    const float rstd = rsqrtf(wave_sum(q) * (1.f / DM) + EPS);
    if (lane == 0) { f32x2 ms = {mean, rstd}; *(f32x2*)(ST + (size_t)row * 2) = ms; }
    u32x4* bd = (u32x4*)(HB + (size_t)row * DM) + lane;
#pragma unroll
    for (int j = 0; j < 4; ++j) { const int c4 = 2 * (lane + 64 * j);
        const f32x4 y0 = v[2 * j] * rstd * ((const f32x4*)g)[c4] + ((const f32x4*)b)[c4], y1 = v[2 * j + 1] * rstd * ((const f32x4*)g)[c4 + 1] + ((const f32x4*)b)[c4 + 1];
        if (out) { f32x4* op = (f32x4*)(out + (size_t)row * DM) + c4; op[0] = y0; op[1] = y1; }
        else bd[64 * j] = pg8::pack8(y0, y1); }
}
__device__ __forceinline__ void ln_rows(const Frame& F, float* H, bf16_t* HB, const float* g, const float* b, float* ST, float* out, const float* PART, int nk) {
    const bf16_t* __restrict__ Hr = (const bf16_t*)H;
    for (int row = F.gw; row < NMAIN; row += 4 * F.ngw) {
        const int row2 = row + F.ngw, row3 = row + 2 * F.ngw, row4 = row + 3 * F.ngw;
        u32x4 va[4], vb[4], vc[4], vd[4];
#pragma unroll
        for (int j = 0; j < 4; ++j) va[j] = ((const u32x4*)(Hr + (size_t)row * DM))[F.lane + 64 * j];
#pragma unroll
        for (int j = 0; j < 4; ++j) vb[j] = ((const u32x4*)(Hr + (size_t)row2 * DM))[F.lane + 64 * j];
#pragma unroll
        for (int j = 0; j < 4; ++j) vc[j] = ((const u32x4*)(Hr + (size_t)row3 * DM))[F.lane + 64 * j];
#pragma unroll
        for (int j = 0; j < 4; ++j) vd[j] = ((const u32x4*)(Hr + (size_t)row4 * DM))[F.lane + 64 * j];
        ln_one_bf(va, row, F.lane, HB, g, b, ST, out);
        ln_one_bf(vb, row2, F.lane, HB, g, b, ST, out);
        ln_one_bf(vc, row3, F.lane, HB, g, b, ST, out);
        ln_one_bf(vd, row4, F.lane, HB, g, b, ST, out);
    }
    if (F.gw < TP - NMAIN) {
        const int row = NMAIN + F.gw; const float* __restrict__ Hm = H; f32x4 va[8];
#pragma unroll
        for (int j = 0; j < 8; ++j) va[j] = ((const f32x4*)(Hm + (size_t)row * DM))[F.lane + 64 * j];
        const float* __restrict__ pp0 = PART + (size_t)F.gw * DM;
        int k = 0;
        for (; k + 4 <= nk; k += 4) {
            f32x4 t[4][8];
#pragma unroll
            for (int q = 0; q < 4; ++q)
#pragma unroll
                for (int j = 0; j < 8; ++j) t[q][j] = ((const f32x4*)(pp0 + (size_t)(k + q) * 256 * DM))[F.lane + 64 * j];
#pragma unroll
            for (int q = 0; q < 4; ++q)
#pragma unroll
                for (int j = 0; j < 8; ++j) va[j] += t[q][j]; }
        for (; k < nk; ++k) {
#pragma unroll
            for (int j = 0; j < 8; ++j) va[j] += ((const f32x4*)(pp0 + (size_t)k * 256 * DM))[F.lane + 64 * j]; }
        ln_one(va, row, F.lane, H, HB, g, b, ST);
    }
}

__device__ __forceinline__ void rstd_rows(const Frame& F, const bf16_t* UDQ, const bf16_t* UDKV, float* RSTD) {
    for (int row = F.gw; row < TP; row += F.ngw) {
        const u32x4 a = ((const u32x4*)(UDQ + (size_t)row * 512))[F.lane]; float s = 0.f;
#pragma unroll
        for (int j = 0; j < 4; ++j) { const float x = bf_lo(a[j]), y = bf_hi(a[j]); s += x * x + y * y; }
        float t = 0.f;
        if (F.lane < 32) { const u32x4 c = ((const u32x4*)(UDKV + (size_t)row * 256))[F.lane];
#pragma unroll
            for (int j = 0; j < 4; ++j) { const float x = bf_lo(c[j]), y = bf_hi(c[j]); t += x * x + y * y; } }
        s = wave_sum(s); t = wave_sum(t);
        if (F.lane == 0) { RSTD[(size_t)row * 2] = rsqrtf(s * (1.f / 512.f) + EPS); RSTD[(size_t)row * 2 + 1] = rsqrtf(t * (1.f / 256.f) + EPS); }
    }
}

__device__ __forceinline__ void mlstm_fin_row(int row, int lane, const f32x4 (&hv)[4], const u32x2 (&ov)[4], const float* __restrict__ ng, bf16_t* __restrict__ MIX) {
#pragma unroll
    for (int j = 0; j < 4; ++j) {
        f32x4 v = hv[j];
        const float mean = wave_sum((v[0] + v[1]) + (v[2] + v[3])) * (1.f / 256.f); v = v - mean;
        const float rstd = rsqrtf(wave_sum((v[0] * v[0] + v[1] * v[1]) + (v[2] * v[2] + v[3] * v[3])) * (1.f / 256.f) + EPS);
        const f32x4 gg = ((const f32x4*)(ng + 256 * j))[lane];
        const u32x2 uo = ov[j];
        const float o0 = bf_lo(uo.x), o1 = bf_hi(uo.x), o2 = bf_lo(uo.y), o3 = bf_hi(uo.y);
        const float y0 = v[0] * rstd * gg[0] / (1.f + __expf(-o0)), y1 = v[1] * rstd * gg[1] / (1.f + __expf(-o1));
        const float y2 = v[2] * rstd * gg[2] / (1.f + __expf(-o2)), y3 = v[3] * rstd * gg[3] / (1.f + __expf(-o3));
        u32x2 w; w.x = pk2(y0, y1); w.y = pk2(y2, y3); ((u32x2*)(MIX + (size_t)row * DM + 256 * j))[lane] = w;
    }
}
__device__ __forceinline__ void mlstm_finalize(const Frame& F, int gw0, int ngw0, const float* HSUM, const bf16_t* UQKVO, const float* ng, bf16_t* MIX) {
    const float* __restrict__ Hs = HSUM; const bf16_t* __restrict__ Uo = UQKVO;
    for (int row = gw0; row < TP; row += 2 * ngw0) {
        const int row2 = row + ngw0; const bool two = row2 < TP; const int r2 = two ? row2 : row;
        f32x4 ha[4], hb[4]; u32x2 oa[4], ob[4];
#pragma unroll
        for (int j = 0; j < 4; ++j) { ha[j] = ((const f32x4*)(Hs + (size_t)row * MLW + 256 * j))[F.lane]; oa[j] = ((const u32x2*)(Uo + (size_t)row * 4096 + 3072 + 256 * j))[F.lane]; }
#pragma unroll
        for (int j = 0; j < 4; ++j) { hb[j] = ((const f32x4*)(Hs + (size_t)r2 * MLW + 256 * j))[F.lane]; ob[j] = ((const u32x2*)(Uo + (size_t)r2 * 4096 + 3072 + 256 * j))[F.lane]; }
        mlstm_fin_row(row, F.lane, ha, oa, ng, MIX);
        if (two) mlstm_fin_row(row2, F.lane, hb, ob, ng, MIX);
    }
}

__device__ __forceinline__ f32x8 ld8f(const float* p) { const f32x4 a = *(const f32x4*)p, b = *(const f32x4*)(p + 4); return (f32x8){a[0], a[1], a[2], a[3], b[0], b[1], b[2], b[3]}; }
__device__ __forceinline__ f32x8 ld8b(const bf16_t* p) { const u32x4 v = *(const u32x4*)p; return (f32x8){bf_lo(v[0]), bf_hi(v[0]), bf_lo(v[1]), bf_hi(v[1]), bf_lo(v[2]), bf_hi(v[2]), bf_lo(v[3]), bf_hi(v[3])}; }
__device__ __forceinline__ void act_store(bf16_t* dst, const f32x8 gp, const f32x8 gc, const f32x8 gn, const f32x8 vv, const f32x8 w0, const f32x8 w1, const f32x8 w2, const f32x8 bb) {
    float o[8];
#pragma unroll
    for (int i = 0; i < 8; ++i) { const float x = w0[i] * gp[i] + w1[i] * gc[i] + w2[i] * gn[i] + bb[i]; o[i] = x / (1.f + __expf(-x)) * vv[i]; }
    u32x4 w; w.x = pk2(o[0], o[1]); w.y = pk2(o[2], o[3]); w.z = pk2(o[4], o[5]); w.w = pk2(o[6], o[7]); *(u32x4*)dst = w;
}
__device__ __forceinline__ void ffn_fixup(const Frame& F, const float* SIDE, const bf16_t* GVM, bf16_t* ACT, const float* cw, const float* cb) {
    constexpr int NCH = DFF / 8;
    const f32x8 zero = {0.f, 0.f, 0.f, 0.f, 0.f, 0.f, 0.f, 0.f};
    const int gt = F.bx * 512 + F.tid, nt = GRID * 512;
    for (int idx = gt; idx < 192 * 2 * NCH; idx += nt) {
        const int ch = idx % NCH, rsel = (idx / NCH) & 1, pm = idx / (2 * NCH), c0 = 8 * ch, sq = pm >> 4;
        const f32x8 w0 = ld8f(cw + c0), w1 = ld8f(cw + DFF + c0), w2 = ld8f(cw + 2 * DFF + c0), bb = ld8f(cb + c0);
        const float* S0 = SIDE + (size_t)pm * 6 * DFF + c0;
        if (rsel == 0) { const f32x8 gp = (pm & 15) ? ld8f(S0 - 6 * DFF + 3 * DFF) : ld8b(GVM + (size_t)(16 * sq + 15) * NUP + c0);
            act_store(ACT + (size_t)(pm * 256) * DFF + c0, gp, ld8f(S0), ld8f(S0 + DFF), ld8f(S0 + 4 * DFF), w0, w1, w2, bb);
        } else { const f32x8 gn = ((pm & 15) != 15) ? ld8f(S0 + 6 * DFF) : zero;
            act_store(ACT + (size_t)(pm * 256 + 255) * DFF + c0, ld8f(S0 + 2 * DFF), ld8f(S0 + 3 * DFF), gn, ld8f(S0 + 5 * DFF), w0, w1, w2, bb); }
    }
    for (int idx = gt; idx < NSEQ * 16 * NCH; idx += nt) {
        const int ch = idx % NCH, rp = idx / NCH, pp = rp & 15, sq = rp >> 4, c0 = 8 * ch;
        const f32x8 w0 = ld8f(cw + c0), w1 = ld8f(cw + DFF + c0), w2 = ld8f(cw + 2 * DFF + c0), bb = ld8f(cb + c0);
        const bf16_t* G0 = GVM + (size_t)(16 * sq + pp) * NUP + c0;
        const f32x8 gp = pp > 0 ? ld8b(G0 - NUP) : zero, gc = ld8b(G0);
        const f32x8 gn = pp < 15 ? ld8b(G0 + NUP) : ld8f(SIDE + (size_t)(16 * sq) * 6 * DFF + c0);
        act_store(ACT + (size_t)(MROW0 + 16 * sq + pp) * DFF + c0, gp, gc, gn, ld8b(G0 + DFF), w0, w1, w2, bb);
    }
}

namespace att {
constexpr int NW = 8, QBLK = 32, KVBLK = 64, NT = 65;
constexpr int KROW = 400;
constexpr int SHM_V = KVBLK * 128 * 2, SHM_K = KVBLK * KROW;
constexpr int OFF_V = 0, OFF_K = 3 * SHM_V, OFF_WS = OFF_K + 3 * SHM_K, LDS_TOTAL = OFF_WS + NW * 64 * 4;
static_assert(LDS_TOTAL <= RING_BYTES, "attention LDS");
constexpr float SCALE = 0.07216878364870323f;
constexpr float THR = 8.f;
#define SBAR() __builtin_amdgcn_sched_barrier(0)
__device__ __forceinline__ int crow(int r, int hi) { return (r & 3) + 8 * (r >> 2) + 4 * hi; }
__device__ __forceinline__ unsigned cvtpk(float lo, float hi) { unsigned r; asm volatile("v_cvt_pk_bf16_f32 %0, %1, %2" : "=v"(r) : "v"(lo), "v"(hi)); return r; }

template <bool MASK16>
__device__ __forceinline__ void partialSM(f32x16& p0, f32x16& p1, float& m_reg, float& mn, float& alpha) {
    constexpr float C = SCALE * 1.4426950408889634f;
    if (MASK16) {
#pragma unroll
        for (int r = 8; r < 16; ++r) p0[r] = NEGBIG;
#pragma unroll
        for (int r = 0; r < 16; ++r) p1[r] = NEGBIG;
    }
    float pmax = p0[0];
#pragma unroll
    for (int r = 1; r < 16; ++r) pmax = fmaxf(pmax, p0[r]);
#pragma unroll
    for (int r = 0; r < 16; ++r) pmax = fmaxf(pmax, p1[r]);
    { auto rr = __builtin_amdgcn_permlane32_swap(__float_as_uint(pmax), __float_as_uint(pmax), false, false); pmax = fmaxf(__uint_as_float(rr[0]), __uint_as_float(rr[1])); }
    if (__builtin_expect(__all(pmax - m_reg <= THR / SCALE), 1)) { mn = m_reg; alpha = 1.f; }
    else { mn = fmaxf(m_reg, pmax); alpha = __builtin_amdgcn_exp2f((m_reg - mn) * C); m_reg = mn; }
    const float mnC = -mn * C;
#pragma unroll
    for (int r = 0; r < 16; ++r) p0[r] = fmaf(p0[r], C, mnC);
#pragma unroll
    for (int r = 0; r < 16; ++r) p1[r] = fmaf(p1[r], C, mnC);
#pragma unroll
    for (int r = 0; r < 16; ++r) p0[r] = __builtin_amdgcn_exp2f(p0[r]);
}
__device__ __forceinline__ void finishSM(f32x16& p0, f32x16& p1, float alpha, float& l_reg, bf16x8& pa0, bf16x8& pa1, bf16x8& pa2, bf16x8& pa3) {
#pragma unroll
    for (int r = 0; r < 16; ++r) p1[r] = __builtin_amdgcn_exp2f(p1[r]);
    float ps = 0;
#pragma unroll
    for (int r = 0; r < 16; ++r) ps += p0[r];
#pragma unroll
    for (int r = 0; r < 16; ++r) ps += p1[r];
    { auto rr = __builtin_amdgcn_permlane32_swap(__float_as_uint(ps), __float_as_uint(ps), false, false); ps = __uint_as_float(rr[0]) + __uint_as_float(rr[1]); }
    l_reg = l_reg * alpha + ps;
#define PK4(P, BASE, OUT) do { unsigned a0 = cvtpk(P[BASE + 0], P[BASE + 1]), a1 = cvtpk(P[BASE + 2], P[BASE + 3]);   \
    unsigned b0 = cvtpk(P[BASE + 4], P[BASE + 5]), b1 = cvtpk(P[BASE + 6], P[BASE + 7]);                              \
    auto r0 = __builtin_amdgcn_permlane32_swap(a0, b0, false, false); auto r1 = __builtin_amdgcn_permlane32_swap(a1, b1, false, false); \
    u32x4 w = {r0[0], r1[0], r0[1], r1[1]}; OUT = __builtin_bit_cast(bf16x8, w); } while (0)
    PK4(p0, 0, pa0); PK4(p0, 8, pa1); PK4(p1, 0, pa2); PK4(p1, 8, pa3);
#undef PK4
}
__device__ __forceinline__ void qkt(f32x16& p0, f32x16& p1, const LAS char* Ks, const bf16x8* qr, int r32, int hi) {
#pragma unroll
    for (int r = 0; r < 16; ++r) { p0[r] = 0.f; p1[r] = 0.f; }
#pragma unroll
    for (int d0 = 0; d0 < 12; ++d0) { const int cb = (d0 * 16 + hi * 8) * 2;
        const bf16x8 b0 = *(const LAS bf16x8*)(Ks + r32 * KROW + cb);
        const bf16x8 b1 = *(const LAS bf16x8*)(Ks + (32 + r32) * KROW + cb);
        p0 = __builtin_amdgcn_mfma_f32_32x32x16_bf16(b0, qr[d0], p0, 0, 0, 0);
        p1 = __builtin_amdgcn_mfma_f32_32x32x16_bf16(b1, qr[d0], p1, 0, 0, 0); }
}
__device__ __forceinline__ int v_st(int k, int c) { const int kk = (k & ~0xC) | ((k & 4) << 1) | ((k & 8) >> 1); return ((kk >> 3) * 4 + (c >> 5)) * 512 + ((kk & 7) * 32 + (c & 31)) * 2; }
__device__ __forceinline__ int v_rd_base(int lane) { return ((lane & 3) << 3) | (((lane >> 2) & 3) << 6) | (((lane >> 4) & 1) << 5) | (((lane >> 5) & 1) << 8); }
constexpr int v_rd_off(int d0, int ks, int half) { return d0 * 512 + ks * 4096 + half * 2048; }
template <int OFF> __device__ __forceinline__ s16x4 tr_read(int vb) { s16x4 r; asm volatile("ds_read_b64_tr_b16 %0, %1 offset:%2" : "=&v"(r) : "v"(vb), "i"(OFF) : "memory"); return r; }
template <int D0> __device__ __forceinline__ void pv_one(f32x16& od, int vb, bf16x8 pa0, bf16x8 pa1, bf16x8 pa2, bf16x8 pa3) {
    const s16x4 l0 = tr_read<v_rd_off(D0, 0, 0)>(vb), h0 = tr_read<v_rd_off(D0, 0, 1)>(vb), l1 = tr_read<v_rd_off(D0, 1, 0)>(vb), h1 = tr_read<v_rd_off(D0, 1, 1)>(vb);
    const s16x4 l2 = tr_read<v_rd_off(D0, 2, 0)>(vb), h2 = tr_read<v_rd_off(D0, 2, 1)>(vb), l3 = tr_read<v_rd_off(D0, 3, 0)>(vb), h3 = tr_read<v_rd_off(D0, 3, 1)>(vb);
    asm volatile("s_waitcnt lgkmcnt(0)" ::: "memory"); SBAR();
#define PKV(L, H) (bf16x8){L[0], L[1], L[2], L[3], H[0], H[1], H[2], H[3]}
    od = __builtin_amdgcn_mfma_f32_32x32x16_bf16(pa0, PKV(l0, h0), od, 0, 0, 0);
    od = __builtin_amdgcn_mfma_f32_32x32x16_bf16(pa1, PKV(l1, h1), od, 0, 0, 0);
    od = __builtin_amdgcn_mfma_f32_32x32x16_bf16(pa2, PKV(l2, h2), od, 0, 0, 0);
    od = __builtin_amdgcn_mfma_f32_32x32x16_bf16(pa3, PKV(l3, h3), od, 0, 0, 0);
#undef PKV
}
__device__ __forceinline__ void pv_d0(f32x16* o, int vb, bf16x8 pa0, bf16x8 pa1, bf16x8 pa2, bf16x8 pa3) {
    pv_one<0>(o[0], vb, pa0, pa1, pa2, pa3); pv_one<1>(o[1], vb, pa0, pa1, pa2, pa3); pv_one<2>(o[2], vb, pa0, pa1, pa2, pa3); pv_one<3>(o[3], vb, pa0, pa1, pa2, pa3);
}

__device__ __forceinline__ void attn_unit(int s, int h, int qb, const bf16_t* __restrict__ MQ, const bf16_t* __restrict__ MKV, const bf16_t* __restrict__ KR, bf16_t* __restrict__ MIX, LAS char* lds) {
    int tid_ = threadIdx.x; asm volatile("" : "+v"(tid_));
    const int tid = tid_, wid = tid >> 6, lane = tid & 63, r32 = lane & 31, hi = lane >> 5;
    LAS char* V_lds = lds + OFF_V; LAS char* K_lds = lds + OFF_K;
    LAS float* wsf = (LAS float*)(lds + OFF_WS) + wid * 64; LAS float* li_l = wsf; LAS float* al_l = wsf + 32;
    float m_reg = NEGBIG, l_reg = 0; f32x16 o[4]; bf16x8 qr[12];
#pragma unroll
    for (int d = 0; d < 4; ++d)
#pragma unroll
        for (int r = 0; r < 16; ++r) o[d][r] = 0.f;
    const int qi = wid * QBLK + r32;
    const unsigned qrow = qb < 16 ? (unsigned)s * LREAL + 256 * qb + qi : (unsigned)MROW0 + 16 * s + (qi < 15 ? qi : 15);
    { const bf16_t* Qw = MQ + (qrow * NQ + h * 192 + hi * 8);
#pragma unroll
      for (int d0 = 0; d0 < 12; ++d0) qr[d0] = *(const bf16x8*)(Qw + d0 * 16); }
    const int sr = tid >> 4, sc = (tid & 15) * 8, vst0 = v_st(sr, sc), vst1 = v_st(32 + sr, sc);
    const int kr_r = tid >> 3, kr_c = (tid & 7) * 8;
    const int vb0 = (int)(uintptr_t)V_lds + v_rd_base(lane);
    bf16x8 vs0, vs1, ks0, ks1, kr0;
    const unsigned mainrow0 = (unsigned)s * LREAL, metarow0 = (unsigned)MROW0 + 16 * s;
    const bf16_t* MKVh = MKV + h * 256;
#define KROWG(kt, k) ((kt) < 64 ? mainrow0 + 64u * (kt) + (k) : metarow0 + ((k) < 15 ? (k) : 15))
#define SLOAD(kt) do { const unsigned g0 = KROWG(kt, sr) * NKV + sc, g1 = KROWG(kt, 32 + sr) * NKV + sc, g2 = KROWG(kt, kr_r) * 64 + kr_c; \
    vs0 = *(const bf16x8*)(MKVh + 128 + g0); vs1 = *(const bf16x8*)(MKVh + 128 + g1); \
    ks0 = *(const bf16x8*)(MKVh + g0); ks1 = *(const bf16x8*)(MKVh + g1); kr0 = *(const bf16x8*)(KR + g2); } while (0)
#define SWRITE(b) do { *(LAS bf16x8*)(V_lds + (b) * SHM_V + vst0) = vs0; *(LAS bf16x8*)(V_lds + (b) * SHM_V + vst1) = vs1; \
    *(LAS bf16x8*)(K_lds + (b) * SHM_K + sr * KROW + sc * 2) = ks0; *(LAS bf16x8*)(K_lds + (b) * SHM_K + (32 + sr) * KROW + sc * 2) = ks1; \
    *(LAS bf16x8*)(K_lds + (b) * SHM_K + kr_r * KROW + 256 + kr_c * 2) = kr0; } while (0)
#define RESC(a) do { if (__any((a) < 1.f)) { if (hi == 0) al_l[r32] = (a); asm volatile("s_waitcnt lgkmcnt(0)" ::: "memory"); \
    _Pragma("unroll") for (int d = 0; d < 4; ++d) _Pragma("unroll") for (int r = 0; r < 16; ++r) o[d][r] *= al_l[crow(r, hi)]; } } while (0)
    f32x16 pA0, pA1, pB0, pB1; float mnA, mnB, alA, alB; bf16x8 pa0, pa1, pa2, pa3;
    __syncthreads();
    SLOAD(0); SWRITE(0); __syncthreads();
    qkt(pA0, pA1, K_lds, qr, r32, hi); partialSM<false>(pA0, pA1, m_reg, mnA, alA);
    SLOAD(1); SWRITE(1); __syncthreads();
    RESC(alA);
    int s0 = 0, s1 = 1, s2 = 2;
    for (int j = 1; j + 1 < NT; j += 2) {
        SBAR(); qkt(pB0, pB1, K_lds + s1 * SHM_K, qr, r32, hi);
        finishSM(pA0, pA1, alA, l_reg, pa0, pa1, pa2, pa3); SBAR();
        SLOAD(j + 1); SBAR();
        pv_d0(o, vb0 + s0 * SHM_V, pa0, pa1, pa2, pa3); partialSM<false>(pB0, pB1, m_reg, mnB, alB);
        SWRITE(s2);
        RESC(alB); __syncthreads();
        SBAR(); qkt(pA0, pA1, K_lds + s2 * SHM_K, qr, r32, hi);
        finishSM(pB0, pB1, alB, l_reg, pa0, pa1, pa2, pa3); SBAR();
        if (j + 2 < NT) SLOAD(j + 2); SBAR();
        pv_d0(o, vb0 + s1 * SHM_V, pa0, pa1, pa2, pa3);
        if (j + 1 == NT - 1) partialSM<true>(pA0, pA1, m_reg, mnA, alA); else partialSM<false>(pA0, pA1, m_reg, mnA, alA);
        if (j + 2 < NT) SWRITE(s0);
        RESC(alA); __syncthreads();
        { const int t0 = s0, t1 = s1; s0 = s2; s1 = t0; s2 = t1; }
    }
    finishSM(pA0, pA1, alA, l_reg, pa0, pa1, pa2, pa3); SBAR();
    pv_d0(o, vb0 + s0 * SHM_V, pa0, pa1, pa2, pa3);
    if (hi == 0) li_l[r32] = l_reg; asm volatile("s_waitcnt lgkmcnt(0)" ::: "memory");
    float rli[16];
#pragma unroll
    for (int r = 0; r < 16; ++r) rli[r] = __builtin_amdgcn_rcpf(li_l[crow(r, hi)]);
    if (qb < 16) {
        bf16_t* Ow = MIX + ((long)s * LREAL + 256 * qb + wid * QBLK) * DM + MLW + h * 128;
#pragma unroll
        for (int r = 0; r < 16; ++r) { const int orow = crow(r, hi);
#pragma unroll
            for (int d0 = 0; d0 < 4; ++d0) Ow[(long)orow * DM + d0 * 32 + r32] = (bf16_t)(pk2(o[d0][r] * rli[r], 0.f) & 0xffffu); }
    } else if (wid == 0) {
        bf16_t* Ow = MIX + ((long)MROW0 + 16 * s) * DM + MLW + h * 128;
#pragma unroll
        for (int r = 0; r < 16; ++r) { const int orow = crow(r, hi);
            if (orow < 16) {
#pragma unroll
                for (int d0 = 0; d0 < 4; ++d0) Ow[(long)orow * DM + d0 * 32 + r32] = (bf16_t)(pk2(o[d0][r] * rli[r], 0.f) & 0xffffu); } }
    }
#undef KROWG
#undef SLOAD
#undef SWRITE
#undef RESC
}
__device__ __forceinline__ void attn_phase(int vcu, const bf16_t* MQ, const bf16_t* MKV, const bf16_t* KR, bf16_t* MIX, LAS char* lds) {
    for (int i = (vcu < 96 ? -1 : 0); i < 6; ++i) { int sh, qb; if (i < 0) { sh = vcu; qb = 16; } else { const int id = i * GRID + vcu; sh = id >> 4; qb = id & 15; }
        attn_unit(sh >> 3, sh & 7, qb, MQ, MKV, KR, MIX, lds); }
}
#undef SBAR
}

namespace ml {
constexpr int QI = 0, KI = 32768, VI = 65536, SI = 81920, CI = 98304;
constexpr int SC_CT = 0, SC_BM = 64, SC_WI = 128, SC_EI = 192, SC_WW = 256, SC_DEN = 320, SC_QN = 448, SC_N = 512, SC_A = 768;
constexpr int GP_REC = 200;
__device__ __forceinline__ unsigned off_b(unsigned row, unsigned ch) { return 256u * row + 16u * (ch ^ (((row & 3) << 2) | ((row >> 2) & 3))); }
__device__ __forceinline__ unsigned row_read_addr_16(unsigned lane, unsigned rb, unsigned s) { return off_b((lane & 15) + 16 * rb, 4 * s + (lane >> 4)); }
__device__ __forceinline__ unsigned tr_read_addr_16(unsigned lane, unsigned c, unsigned ks, unsigned t) {
    const unsigned g = lane >> 4, q = (lane & 15) >> 2, p = lane & 3; return off_b(32 * ks + 8 * g + 4 * t + q, 2 * c + (p >> 1)) + 8 * (p & 1); }
__device__ __forceinline__ bf16x8 tr_frag(unsigned a0, unsigned a1) {
    const s16x4 lo = __builtin_amdgcn_ds_read_tr16_b64_v4i16((LAS s16x4*)a0), hi = __builtin_amdgcn_ds_read_tr16_b64_v4i16((LAS s16x4*)a1);
    return (bf16x8){lo[0], lo[1], lo[2], lo[3], hi[0], hi[1], hi[2], hi[3]};
}
__device__ __forceinline__ f32x4 mfma16(bf16x8 a, bf16x8 b, f32x4 c) { return __builtin_amdgcn_mfma_f32_16x16x32_bf16(a, b, c, 0, 0, 0); }
__device__ __forceinline__ float log_sigmoid(float x) { return fminf(x, 0.f) - __logf(1.f + __expf(-fabsf(x))); }

__device__ __forceinline__ void gate_prep(int gw, int ngw, int lane, const float* __restrict__ GATES, const float* __restrict__ bgl, float* __restrict__ GP) {
    for (int it = gw; it < 96 * 65; it += ngw) {
        const int chain = it / 65, c = it % 65, s = chain >> 3, hd = (chain >> 1) & 3, dir = chain & 1;
        const long g = c == 0 ? (lane >= 48 ? (long)MROW0 + 16 * s + lane - 48 : -1L) : (long)s * LREAL + 64 * (c - 1) + lane;
        float li = NEGBIG, lf = 0.f;
        if (g >= 0) { li = GATES[g * 16 + (dir ? 8 : 0) + hd] + bgl[(dir ? 8 : 0) + hd]; lf = log_sigmoid(GATES[g * 16 + (dir ? 12 : 4) + hd] + bgl[(dir ? 12 : 4) + hd]); }
        float x = dir ? __shfl(lf, 63 - lane) : lf;
#pragma unroll
        for (int o = 1; o < 64; o <<= 1) { const float y = __shfl_up(x, o); if (lane >= o) x += y; }
        const float btot = __shfl(x, 63);
        const float b = dir ? __shfl(x, 63 - lane) : x;
        const float a_s = li - b;
        float pm = dir ? __shfl(a_s, 63 - lane) : a_s;
#pragma unroll
        for (int o = 1; o < 64; o <<= 1) { const float y = __shfl_up(pm, o); if (lane >= o) pm = fmaxf(pm, y); }
        pm = dir ? __shfl(pm, 63 - lane) : pm;
        const float gmax = wave_max(btot - b + li);
        float* rec = GP + (size_t)it * GP_REC;
        rec[lane] = b; rec[64 + lane] = li; rec[128 + lane] = pm; if (lane == 0) { rec[192] = btot; rec[193] = gmax; }
    }
}

__device__ __forceinline__ void mlstm_unit(int s, int hd, int js, const bf16_t* __restrict__ UQKVO, const float* __restrict__ GP, float* __restrict__ HSUM, LAS unsigned char* lds, LAS float* sc) {
    const int wid = __builtin_amdgcn_readfirstlane((int)threadIdx.x >> 6);
    const unsigned ldsb = (unsigned)(uintptr_t)lds;
    const int tt = wid >> 1, nb = 2 * (wid & 1);
#define ROWRD(img, rb, s_) (*(const LAS bf16x8*)(uintptr_t)(RB[s_] + (unsigned)((img) + 4096 * (rb))))
#define TRFRAG(img, c_, ks) tr_frag(BT[0][(c_) & 1] + TQ[(c_) >> 1] + (unsigned)((img) + 8192 * (ks)), BT[1][(c_) & 1] + TQ[(c_) >> 1] + (unsigned)((img) + 8192 * (ks)))
    f32x4 accC[2][4], accN[2];
    for (int dir = 0; dir < 2; ++dir) {
        int tid; { int t0_ = threadIdx.x; asm volatile("" : "+v"(t0_)); tid = t0_; }
#pragma unroll
        for (int mi = 0; mi < 2; ++mi)
#pragma unroll
            for (int c = 0; c < 4; ++c) accC[mi][c] = (f32x4){0.f, 0.f, 0.f, 0.f};
        accN[0] = (f32x4){0.f, 0.f, 0.f, 0.f}; accN[1] = (f32x4){0.f, 0.f, 0.f, 0.f};
        if (tid < 256) sc[SC_N + tid] = 0.f;
        for (int i = tid; i < 32768 / 16; i += 512) *(LAS u32x4*)(lds + CI + i * 16) = (u32x4){0u, 0u, 0u, 0u};
        float m_state = 0.f;
        const float* GPc = GP + (size_t)(((s * 4 + hd) * 2 + dir) * 65) * GP_REC;
        u32x4 sq[4], sk[4], sv; float sb = 0.f, sli = NEGBIG, spm = NEGBIG, sbt = 0.f, sgm = NEGBIG;
#define ROWG(c, r) ((c) == 0 ? ((r) >= 48 ? (long)MROW0 + 16 * s + (r) - 48 : -1L) : (long)s * LREAL + 64 * ((c) - 1) + (r))
#define STAGE_LOAD(c) do { \
        _Pragma("unroll") for (int i = 0; i < 4; ++i) { const int id = tid + 512 * i, r = id >> 5, ch = id & 31; const long g = ROWG(c, r); \
            sq[i] = (u32x4){0u, 0u, 0u, 0u}; sk[i] = (u32x4){0u, 0u, 0u, 0u}; \
            if (g >= 0) { sq[i] = *(const u32x4*)(UQKVO + g * 4096 + hd * 256 + ch * 8); sk[i] = *(const u32x4*)(UQKVO + g * 4096 + 1024 + hd * 256 + ch * 8); } } \
        { const int r = tid >> 3, ch = tid & 7; const long g = ROWG(c, r); sv = (u32x4){0u, 0u, 0u, 0u}; if (g >= 0) sv = *(const u32x4*)(UQKVO + g * 4096 + 2048 + hd * 256 + js * 64 + ch * 8); } \
        if (tid < 64) { const float* rec = GPc + (size_t)(c) * GP_REC; sb = rec[tid]; sli = rec[64 + tid]; spm = rec[128 + tid]; sbt = rec[192]; sgm = rec[193]; } } while (0)
#define STAGE_WRITE() do { \
        _Pragma("unroll") for (int i = 0; i < 4; ++i) { const int id = tid + 512 * i, r = id >> 5, ch = id & 31; \
            *(LAS u32x4*)(lds + QI + (ch >> 4) * 16384 + off_b(r, ch & 15)) = sq[i]; *(LAS u32x4*)(lds + KI + (ch >> 4) * 16384 + off_b(r, ch & 15)) = sk[i]; } \
        { const int r = tid >> 3, ch = tid & 7; *(LAS u32x4*)(lds + VI + off_b(r, ch)) = sv; } \
        if (tid < 64) { const float m_inter = sb + m_state, mt = fmaxf(m_inter, sb + spm); const float m_new = fmaxf(sbt + m_state, sgm); \
            sc[SC_CT + tid] = sli - sb; sc[SC_BM + tid] = sb - mt; sc[SC_WI + tid] = __expf(m_inter - mt); sc[SC_EI + tid] = __expf(-mt); \
            sc[SC_WW + tid] = __expf(sbt - sb + sli - m_new) * 0.0625f; if (tid == 0) sc[SC_A] = __expf(sbt + m_state - m_new); m_state = m_new; } } while (0)
        const int c_first = dir ? 64 : 0, c_step = dir ? -1 : 1;
        STAGE_LOAD(c_first);
        __syncthreads();
        STAGE_WRITE();
        for (int ci = 0; ci < 65; ++ci) {
            const int c = c_first + c_step * ci;
            { int t2_ = threadIdx.x; asm volatile("" : "+v"(t2_)); tid = t2_; }
            const int lane = tid & 63, l15 = lane & 15, lg = lane >> 4;
            unsigned RB[4], BT[2][2], TQ[4];
            { const unsigned fl = ((l15 & 3) << 2) | (l15 >> 2), q = l15 >> 2, p = lane & 3, g = lg;
#pragma unroll
              for (int s_ = 0; s_ < 4; ++s_) { RB[s_] = ldsb + 256u * l15 + 16u * (lg ^ (fl & 3)) + 64u * (s_ ^ (fl >> 2)); TQ[s_] = 64u * (s_ ^ q); }
#pragma unroll
              for (int t_ = 0; t_ < 2; ++t_)
#pragma unroll
                  for (int cl = 0; cl < 2; ++cl) BT[t_][cl] = ldsb + 256u * (8 * g + q) + 8u * (p & 1) + 1024u * t_ + 16u * ((p >> 1) ^ t_) + 32u * (cl ^ (g & 1)); }
            __syncthreads();
            if (ci + 1 < 65) STAGE_LOAD(c + c_step);
            bf16x8 qf[8];
#pragma unroll
            for (int k = 0; k < 8; ++k) qf[k] = ROWRD(QI + (k >> 2) * 16384, tt, k & 3);
            f32x4 sT[2], oc[2];
#pragma unroll
            for (int i = 0; i < 2; ++i) { sT[i] = (f32x4){0.f, 0.f, 0.f, 0.f}; oc[i] = (f32x4){0.f, 0.f, 0.f, 0.f}; }
#pragma unroll
            for (int i = 0; i < 2; ++i)
#pragma unroll
                for (int k = 0; k < 8; ++k) {
                    const bf16x8 kf = ROWRD(KI + (k >> 2) * 16384, nb + i, k & 3);
                    sT[i] = mfma16(kf, qf[k], sT[i]);
                    const bf16x8 cf = ROWRD(CI + (k >> 2) * 16384, nb + i, k & 3);
                    oc[i] = mfma16(qf[k], cf, oc[i]);
                }
            {
                const int t = 16 * tt + l15; const float bmt = sc[SC_BM + t]; float rs = 0.f;
#pragma unroll
                for (int i = 0; i < 2; ++i) { const int s0 = 16 * (nb + i) + 4 * lg; const f32x4 ctv = *(const LAS f32x4*)(sc + SC_CT + s0); float v[4];
#pragma unroll
                    for (int e = 0; e < 4; ++e) { const int sx = s0 + e; const bool ok = dir ? (sx >= t) : (sx <= t);
                        const float ex = ok ? (bmt + ctv[e]) : NEGBIG; v[e] = sT[i][e] * 0.0625f * __expf(ex); rs += v[e]; }
                    u32x2 w; w.x = pk2(v[0], v[1]); w.y = pk2(v[2], v[3]);
                    *(LAS u32x2*)(lds + SI + off_b(t, s0 >> 3) + (s0 & 7) * 2) = w; }
                rs += __shfl_xor(rs, 16); rs += __shfl_xor(rs, 32);
                if (lg == 0) sc[SC_DEN + 64 * (wid & 1) + t] = rs;
            }
            { const int r = tid >> 3, ch = tid & 7; const u32x4 v = *(const LAS u32x4*)(lds + VI + off_b(r, ch)); const float w = sc[SC_WW + r]; u32x4 o;
#pragma unroll
              for (int jx = 0; jx < 4; ++jx) o[jx] = pk2(bf_lo(v[jx]) * w, bf_hi(v[jx]) * w);
              *(LAS u32x4*)(lds + VI + off_b(r, 8 + ch)) = o; }
            { const int r = tid >> 3, part = tid & 7; float d = 0.f;
#pragma unroll
              for (int i = 0; i < 4; ++i) { const int ch32 = part * 4 + i; const u32x4 v = *(const LAS u32x4*)(lds + QI + (ch32 >> 4) * 16384 + off_b(r, ch32 & 15));
                  const f32x4 n0 = *(const LAS f32x4*)(sc + SC_N + ch32 * 8), n1 = *(const LAS f32x4*)(sc + SC_N + ch32 * 8 + 4);
                  d += bf_lo(v[0]) * n0[0] + bf_hi(v[0]) * n0[1] + bf_lo(v[1]) * n0[2] + bf_hi(v[1]) * n0[3] + bf_lo(v[2]) * n1[0] + bf_hi(v[2]) * n1[1] + bf_lo(v[3]) * n1[2] + bf_hi(v[3]) * n1[3]; }
              d += __shfl_xor(d, 1); d += __shfl_xor(d, 2); d += __shfl_xor(d, 4);
              if (part == 0) sc[SC_QN + r] = d; }
            { const f32x4 wi = *(const LAS f32x4*)(sc + SC_WI + 16 * tt + 4 * lg);
#pragma unroll
              for (int i = 0; i < 2; ++i) oc[i] = oc[i] * wi; }
            __syncthreads();
            const float a_dec = sc[SC_A];
#pragma unroll
            for (int ks = 0; ks < 2; ++ks) { const bf16x8 sf = ROWRD(SI, tt, ks);
#pragma unroll
                for (int i = 0; i < 2; ++i) { const bf16x8 vf = TRFRAG(VI, nb + i, ks);
                    oc[i] = mfma16(sf, vf, oc[i]); } }
            { const int t0 = 16 * tt + 4 * lg;
              const f32x4 wi = *(const LAS f32x4*)(sc + SC_WI + t0), qn = *(const LAS f32x4*)(sc + SC_QN + t0), d0 = *(const LAS f32x4*)(sc + SC_DEN + t0), d1 = *(const LAS f32x4*)(sc + SC_DEN + 64 + t0), ei = *(const LAS f32x4*)(sc + SC_EI + t0);
#pragma unroll
              for (int e = 0; e < 4; ++e) { const long g = ROWG(c, t0 + e);
                const float den = wi[e] * qn[e] + (d0[e] + d1[e]); const float inv = 1.f / fmaxf(fabsf(den), ei[e]);
                if (g >= 0) {
#pragma unroll
                    for (int i = 0; i < 2; ++i) { float* hp = HSUM + g * MLW + hd * 256 + js * 64 + 16 * (nb + i) + l15; const float hv = oc[i][e] * inv; if (dir) unsafeAtomicAdd(hp, hv); else *hp = hv; } } } }
#pragma unroll
            for (int mi = 0; mi < 2; ++mi)
#pragma unroll
                for (int cc = 0; cc < 4; ++cc) accC[mi][cc] = accC[mi][cc] * a_dec;
            accN[0] = accN[0] * a_dec; accN[1] = accN[1] * a_dec;
            const unsigned ktq = (unsigned)(KI + (wid >> 2) * 16384) + 64u * ((unsigned)(wid & 3) ^ (unsigned)(l15 >> 2));
#pragma unroll
            for (int ks = 0; ks < 2; ++ks) {
                bf16x8 kf[2], wf[4];
#pragma unroll
                for (int mi = 0; mi < 2; ++mi) kf[mi] = tr_frag(BT[0][mi] + ktq + (unsigned)(8192 * ks), BT[1][mi] + ktq + (unsigned)(8192 * ks));
#pragma unroll
                for (int cc = 0; cc < 4; ++cc) wf[cc] = TRFRAG(VI, 4 + cc, ks);
                { const f32x4 wa = *(const LAS f32x4*)(sc + SC_WW + 32 * ks + 8 * lg), wb = *(const LAS f32x4*)(sc + SC_WW + 32 * ks + 8 * lg + 4);
                  u32x4 wq; wq.x = pk2(wa[0], wa[1]); wq.y = pk2(wa[2], wa[3]); wq.z = pk2(wb[0], wb[1]); wq.w = pk2(wb[2], wb[3]);
                  if (l15 != 0) wq = (u32x4){0u, 0u, 0u, 0u};
                  const bf16x8 wfn = __builtin_bit_cast(bf16x8, wq);
#pragma unroll
                  for (int mi = 0; mi < 2; ++mi) accN[mi] = mfma16(kf[mi], wfn, accN[mi]); }
#pragma unroll
                for (int mi = 0; mi < 2; ++mi)
#pragma unroll
                    for (int cc = 0; cc < 4; ++cc) accC[mi][cc] = mfma16(kf[mi], wf[cc], accC[mi][cc]);
            }
#pragma unroll
            for (int mi = 0; mi < 2; ++mi)
#pragma unroll
                for (int cc = 0; cc < 4; ++cc) { const int dk0 = 32 * wid + 16 * mi + 4 * lg, dv = 16 * cc + l15; u32x2 w; w.x = pk2(accC[mi][cc][0], accC[mi][cc][1]); w.y = pk2(accC[mi][cc][2], accC[mi][cc][3]);
                    *(LAS u32x2*)(lds + CI + (dk0 >> 7) * 16384 + off_b(dv, (dk0 & 127) >> 3) + (dk0 & 7) * 2) = w; }
            if (l15 == 0) { *(LAS f32x4*)(sc + SC_N + 32 * wid + 4 * lg) = accN[0]; *(LAS f32x4*)(sc + SC_N + 32 * wid + 16 + 4 * lg) = accN[1]; }
            __syncthreads();
            if (ci + 1 < 65) STAGE_WRITE();
        }
    }
#undef ROWG
#undef STAGE_LOAD
#undef STAGE_WRITE
#undef ROWRD
#undef TRFRAG
}
__device__ __forceinline__ void mlstm_phase(int bx, const bf16_t* UQKVO, const float* GP, float* HSUM, LAS unsigned char* lds, LAS float* sc) {
    if (bx >= 192) return;
    const int xcd = bx & 7, idx = bx >> 3, pair = xcd * 6 + (idx >> 2), js = idx & 3;
    mlstm_unit(pair >> 2, pair & 3, js, UQKVO, GP, HSUM, lds, sc);
}
}

#ifndef PHM
#define PHM 0xffff
#endif
#ifndef REP_ML
#define REP_ML 1
#endif
#ifndef REP_ATTN
#define REP_ATTN 1
#endif
#ifndef REP_CONV
#define REP_CONV 1
#endif
#ifndef REP_SMALL
#define REP_SMALL 1
#endif
#ifndef KV_SPLIT
#define KV_SPLIT 193
#endif
#ifndef REP_WIN
#define REP_WIN 1
#endif
#ifndef REP_UP
#define REP_UP 1
#endif
__global__ void __launch_bounds__(512, 2) fwd_kernel(Params P, unsigned char* ws_arg, unsigned char* out_arg) {
    extern __shared__ __attribute__((aligned(16))) unsigned char lds_raw[];
    Frame F;
    F.lds = (LAS unsigned char*)lds_raw;
    F.tid = threadIdx.x; F.lane = F.tid & 63; F.wave = __builtin_amdgcn_readfirstlane(F.tid >> 6);
    F.G = GRID; F.bx = blockIdx.x; F.vcu = (F.bx % 8) * (GRID / 8) + F.bx / 8;
    F.gw = F.vcu * 8 + F.wave; F.ngw = F.G * 8;
    { unsigned char* ws0 = ws_arg;
      for (int u = F.tid; u < (LDS_BYTES - MISC_OFF) / 4; u += 512) ((LAS unsigned*)(F.lds + MISC_OFF))[u] = 0u;
      __syncthreads();
      (void)ws0; }
    LAS unsigned long long* ptab = (LAS unsigned long long*)(F.lds + MISC_OFF + 64);
    if (F.tid == 0) {
#pragma unroll
        for (int k = 0; k < 19; ++k) ptab[k] = (unsigned long long)(uintptr_t)P.in[k]; }
    __syncthreads();
    XcdBarrier bar = xcd_barrier_post((unsigned*)(ws_arg + WS_CTL) + CW_BAR, (volatile LAS unsigned*)(F.lds + MISC_OFF));
    LAS float* sc = (LAS float*)(F.lds + MISC_OFF + 1024);
#define BXL() ({ int b__ = F.bx; asm volatile("" : "+s"(b__)); b__; })
#define PFRAME() Frame Fp = F; { int t_ = threadIdx.x; asm volatile("" : "+v"(t_)); Fp.tid = t_; Fp.lane = t_ & 63; int b_ = BXL(); Fp.bx = b_; Fp.vcu = (b_ % 8) * (GRID / 8) + b_ / 8; Fp.gw = Fp.vcu * 8 + Fp.wave; }
#define WSB() ({ GAS unsigned char* w__ = (GAS unsigned char*)ws_arg; asm volatile("" : "+s"(w__)); (unsigned char*)w__; })
#ifndef STAG_N
#define STAG_N 1
#endif
#ifdef STAG_ON
#define STAGGER() do { int s__ = (BXL() * 37) & 255; for (int i__ = 0; i__ < s__; ++i__) __builtin_amdgcn_s_sleep(STAG_N); } while (0)
#else
#define STAGGER() do {} while (0)
#endif
#define WOFS(l_) (((l_) & 1) ? WSET_DELTA : (size_t)0)
#define DOB() ({ GAS unsigned char* w__ = (GAS unsigned char*)out_arg; asm volatile("" : "+s"(w__)); (unsigned char*)w__; })

    { unsigned char* ws = WSB(); prologue(F, ws, ptab); convert_weights(F, ws, ptab, 0, 0, -1); }
    xcd_barrier(bar);

    for (int l = 0; l < DEPTH; ++l) {
        { unsigned char* ws = WSB();
          pg8::Gemm g{(bf16_t*)(ws + WS_HB), (bf16_t*)(ws + WOFS(l) + WS_WIN), TP, NIN, DM, DM}; pg8::PanelOrder S; S.init(NPAN, 0, 0, 0, NIN, F.G, BXL());
          pg8::EpiWin E{(bf16_t*)(ws + WS_UQKVO), (bf16_t*)(ws + WS_UDQ), (bf16_t*)(ws + WS_UDKV), (bf16_t*)(ws + WS_KR), (float*)(ws + WS_GATES), (const float*)(ws + WS_COS), (const float*)(ws + WS_SIN)};
#if PHM & 2
          STAGGER(); pg8::gemm_phase<pg8::EpiWin, pg8::PanelOrder, true, true>(F.lds, g, S, E);
#endif
        }
        if (l + 1 < DEPTH && BXL() >= 20) { unsigned char* ws = WSB(); PFRAME(); Fp.gw = (Fp.bx - 20) * 8 + Fp.wave; Fp.ngw = (GRID - 20) * 8; convert_weights(Fp, ws, ptab, l + 1, WOFS(l + 1), 0); }
#if REP_WIN > 1
        __syncthreads();
        { unsigned char* ws = WSB();
          pg8::Gemm g{(bf16_t*)(ws + WS_HB), (bf16_t*)(ws + WOFS(l) + WS_WIN), TP, NIN, DM, DM}; pg8::PanelOrder S; S.init(NPAN, 0, 0, 0, NIN, F.G, BXL());
          pg8::EpiWin E{(bf16_t*)(ws + WS_UQKVO), (bf16_t*)(ws + WS_UDQ), (bf16_t*)(ws + WS_UDKV), (bf16_t*)(ws + WS_KR), (float*)(ws + WS_GATES), (const float*)(ws + WS_COS), (const float*)(ws + WS_SIN)};
          pg8::gemm_phase<pg8::EpiWin, pg8::PanelOrder, true, true>(F.lds, g, S, E);
        }
#endif
        xcd_barrier(bar);
        { unsigned char* ws = WSB(); unsigned char* dob = DOB(); PFRAME(); rstd_rows(Fp, (bf16_t*)(ws + WS_UDQ), (bf16_t*)(ws + WS_UDKV), (float*)(ws + WS_RSTD));
          ml::gate_prep(Fp.gw, Fp.ngw, Fp.lane, (const float*)(ws + WS_GATES), (const float*)(ws + WS_PAR) + PO_BG + l * 16, (float*)(dob + DO_GP)); }
#if REP_SMALL > 1
        { unsigned char* ws = WSB(); unsigned char* dob = DOB(); PFRAME(); rstd_rows(Fp, (bf16_t*)(ws + WS_UDQ), (bf16_t*)(ws + WS_UDKV), (float*)(ws + WS_RSTD));
          ml::gate_prep(Fp.gw, Fp.ngw, Fp.lane, (const float*)(ws + WS_GATES), (const float*)(ws + WS_PAR) + PO_BG + l * 16, (float*)(dob + DO_GP)); }
#endif
        xcd_barrier(bar);
        if (F.bx >= 192) {
        { unsigned char* ws = WSB(); unsigned char* dob = DOB();
          pg8::Gemm g{(bf16_t*)(ws + WS_UDQ), (bf16_t*)(ws + WOFS(l) + WS_WUQ), TP, NQ, 512, 512}; pg8::PanelOrder S; S.init(NPAN, 0, 0, 0, NQ, GRID - 192, BXL() - 192);
          pg8::EpiQ E{(bf16_t*)(dob + DO_MQ), (const float*)(ws + WS_RSTD), (const float*)(ws + WS_COS), (const float*)(ws + WS_SIN)};
#if PHM & 4
          pg8::gemm_phase<pg8::EpiQ, pg8::PanelOrder, true, true>(F.lds, g, S, E);
#endif
        }
        { unsigned char* ws = WSB();
          pg8::Gemm g{(bf16_t*)(ws + WS_UDKV), (bf16_t*)(ws + WOFS(l) + WS_WUKV), TP, NKV, 256, 256}; pg8::PanelOrder S; S.init(NPAN, 0, 0, 0, NKV, GRID - 192, BXL() - 192);
          pg8::EpiBf16G E{(bf16_t*)(ws + WS_MKV), NKV, (const float*)(ws + WS_RSTD) + 1, 0, -1, 0};
#if PHM & 8
          pg8::gemm_phase<pg8::EpiBf16G, pg8::PanelOrder, true, true>(F.lds, g, S, E);
#endif
        }
        } else {
#ifndef NO_ML
        for (int rep_ = 0; rep_ < REP_ML; ++rep_)
        { unsigned char* ws = WSB(); unsigned char* dob = DOB();
          ml::mlstm_phase(BXL(), (const bf16_t*)(ws + WS_UQKVO), (const float*)(dob + DO_GP), (float*)(dob + DO_HSUM), F.lds, sc); }
#endif
        }
        xcd_barrier(bar);
        { unsigned char* ws = WSB(); unsigned char* dob = DOB(); PFRAME();
          if (Fp.vcu >= 96) mlstm_finalize(Fp, (Fp.vcu - 96) * 8 + Fp.wave, (GRID - 96) * 8, (const float*)(dob + DO_HSUM), (const bf16_t*)(ws + WS_UQKVO), (const float*)(ws + WS_PAR) + PO_MLG + l * MLW, (bf16_t*)(ws + WS_HB)); }
#ifndef NO_ATTN
        for (int rep_ = 0; rep_ < REP_ATTN; ++rep_)
        { unsigned char* ws = WSB(); unsigned char* dob = DOB();
          att::attn_phase(({ int b__ = BXL(); (b__ % 8) * (GRID / 8) + b__ / 8; }), (const bf16_t*)(dob + DO_MQ), (const bf16_t*)(ws + WS_MKV), (const bf16_t*)(ws + WS_KR), (bf16_t*)(ws + WS_HB), (LAS char*)F.lds); }
#endif
        xcd_barrier(bar);
        { unsigned char* ws = WSB();
          pg8::Gemm g{(bf16_t*)(ws + WS_HB), (bf16_t*)(ws + WOFS(l) + WS_WOUT), TP, DM, DM, DM}; pg8::PanelOrder S; S.init(192, 0, 0, 0, DM, F.G, BXL());
          pg8::EpiResidLn E{(bf16_t*)(ws + WS_H), DM, ALPHA, (const float*)(ws + WS_STAT2), (const float*)(ws + WS_PAR) + (l > 0 ? PO_L2G + (l - 1) * DM : PO_ONE), (const float*)(ws + WS_PAR) + (l > 0 ? PO_L2B + (l - 1) * DM : PO_ZERO)};
#if PHM & 16
          STAGGER(); pg8::gemm_phase<pg8::EpiResidLn, pg8::PanelOrder, true, true>(F.lds, g, S, E);
#endif
        }
        { unsigned char* ws = WSB();
          pg8::Gemm g{(bf16_t*)(ws + WS_HB), (bf16_t*)(ws + WOFS(l) + WS_WOUT), TP, DM, DM / 4, DM}; pg8::SplitOrder S; S.init(PMETA, DM, 4, F.G, BXL());
          pg8::EpiPart E{(float*)(ws + WS_PART), DM};
#if PHM & 16
          pg8::gemm_phase<pg8::EpiPart, pg8::SplitOrder, true, true>(F.lds, g, S, E);
#endif
        }
        xcd_barrier(bar);
        { unsigned char* ws = WSB(); PFRAME(); ln_rows(Fp, (float*)(ws + WS_H), (bf16_t*)(ws + WS_HB), (const float*)(ws + WS_PAR) + PO_L1G + l * DM, (const float*)(ws + WS_PAR) + PO_L1B + l * DM, (float*)(ws + WS_STAT1), nullptr, (const float*)(ws + WS_PART), 4); }
        xcd_barrier(bar);
        { unsigned char* ws = WSB(); unsigned char* dob = DOB();
          pg8::Gemm g{(bf16_t*)(ws + WS_HB), (bf16_t*)(ws + WOFS(l) + WS_WUP), TP, NUP, DM, DM}; pg8::PanelOrder S; S.init(NPAN, 0, 0, 0, NUP, F.G, BXL());
          pg8::EpiFfn E{(bf16_t*)(ws + WS_ACT), (float*)(dob + DO_SIDE), (bf16_t*)(dob + DO_GVM), (const float*)(ws + WS_PAR) + PO_CW + (size_t)l * 3 * DFF, (const float*)(ws + WS_PAR) + PO_CB + (size_t)l * DFF, (LAS float*)(F.lds + MISC_OFF + 8192)};
#if PHM & 32
          STAGGER(); pg8::gemm_phase<pg8::EpiFfn, pg8::PanelOrder, true, true>(F.lds, g, S, E);
#if REP_UP > 1
          __syncthreads(); pg8::gemm_phase<pg8::EpiFfn, pg8::PanelOrder, true, true>(F.lds, g, S, E);
#endif
#endif
        }
        if (l + 1 < DEPTH && BXL() >= 44) { unsigned char* ws = WSB(); PFRAME(); Fp.gw = (Fp.bx - 44) * 8 + Fp.wave; Fp.ngw = (GRID - 44) * 8; convert_weights(Fp, ws, ptab, l + 1, WOFS(l + 1), 1); }
        xcd_barrier(bar);
        { unsigned char* ws = WSB(); unsigned char* dob = DOB(); PFRAME();
          ffn_fixup(Fp, (const float*)(dob + DO_SIDE), (const bf16_t*)(dob + DO_GVM), (bf16_t*)(ws + WS_ACT), (const float*)(ws + WS_PAR) + PO_CW + (size_t)l * 3 * DFF, (const float*)(ws + WS_PAR) + PO_CB + (size_t)l * DFF); }
#if REP_SMALL > 1
        { unsigned char* ws = WSB(); unsigned char* dob = DOB(); PFRAME();
          ffn_fixup(Fp, (const float*)(dob + DO_SIDE), (const bf16_t*)(dob + DO_GVM), (bf16_t*)(ws + WS_ACT), (const float*)(ws + WS_PAR) + PO_CW + (size_t)l * 3 * DFF, (const float*)(ws + WS_PAR) + PO_CB + (size_t)l * DFF); }
#endif
        xcd_barrier(bar);
        { unsigned char* ws = WSB();
          pg8::Gemm g{(bf16_t*)(ws + WS_ACT), (bf16_t*)(ws + WOFS(l) + WS_WDN), TP, DM, DFF, DFF}; pg8::PanelOrder S; S.init(192, 0, 0, 0, DM, F.G, BXL());
          pg8::EpiResidLn E{(bf16_t*)(ws + WS_H), DM, ALPHA, (const float*)(ws + WS_STAT1), (const float*)(ws + WS_PAR) + PO_L1G + l * DM, (const float*)(ws + WS_PAR) + PO_L1B + l * DM};
#if PHM & 64
          STAGGER(); pg8::gemm_phase<pg8::EpiResidLn, pg8::PanelOrder, true, true>(F.lds, g, S, E);
#endif
        }
        { unsigned char* ws = WSB();
          pg8::Gemm g{(bf16_t*)(ws + WS_ACT), (bf16_t*)(ws + WOFS(l) + WS_WDN), TP, DM, DFF / 11, DFF}; pg8::SplitOrder S; S.init(PMETA, DM, 11, F.G, BXL());
          pg8::EpiPart E{(float*)(ws + WS_PART), DM};
#if PHM & 64
          pg8::gemm_phase<pg8::EpiPart, pg8::SplitOrder, true, true>(F.lds, g, S, E);
#endif
        }
        xcd_barrier(bar);
        { unsigned char* ws = WSB(); unsigned char* dob = DOB();
          PFRAME(); ln_rows(Fp, (float*)(ws + WS_H), (bf16_t*)(ws + WS_HB), (const float*)(ws + WS_PAR) + PO_L2G + l * DM, (const float*)(ws + WS_PAR) + PO_L2B + l * DM, (float*)(ws + WS_STAT2), l == DEPTH - 1 ? (float*)dob : nullptr, (const float*)(ws + WS_PART), 11); }
#if REP_CONV > 1
#endif
        xcd_barrier(bar);
    }
}

extern "C" void kernel_launch(void* const* d_in, const int* in_sizes, int n_in, void* d_out, int out_size, void* d_ws, size_t ws_size, hipStream_t stream) {
    static int grid = 0;
    if (grid == 0) {
        if (n_in != 19 || out_size != NMAIN * DM || ws_size < WS_NEED) { fprintf(stderr, "kernel_launch: unexpected shapes (n_in %d out %d ws %zu need %zu)\n", n_in, out_size, ws_size, (size_t)WS_NEED); grid = -1; return; }
        int dev = 0, cus = 0;
        if (hipGetDevice(&dev) != hipSuccess || hipDeviceGetAttribute(&cus, hipDeviceAttributeMultiprocessorCount, dev) != hipSuccess) { grid = -1; return; }
        if (hipFuncSetAttribute((const void*)fwd_kernel, hipFuncAttributeMaxDynamicSharedMemorySize, LDS_BYTES) != hipSuccess) { fprintf(stderr, "kernel_launch: hipFuncSetAttribute failed\n"); grid = -1; return; }
        int per_cu = 0;
        if (hipOccupancyMaxActiveBlocksPerMultiprocessor(&per_cu, (const void*)fwd_kernel, 512, LDS_BYTES) != hipSuccess || per_cu < 1) { fprintf(stderr, "kernel_launch: occupancy query says %d blocks per CU\n", per_cu); (void)hipGetLastError(); grid = -1; return; }
        if (cus < GRID) { fprintf(stderr, "kernel_launch: needs %d CUs, device has %d\n", GRID, cus); grid = -1; return; }
        grid = GRID;
    }
    if (grid < 0) return;
    (void)hipMemsetAsync((char*)d_ws + WS_CTL, 0, CTL_BYTES, stream);
    Params p{};
    for (int i = 0; i < 19; ++i) p.in[i] = (const float*)d_in[i];
    hipLaunchKernelGGL(fwd_kernel, dim3(grid), dim3(512), LDS_BYTES, stream, p, (unsigned char*)d_ws, (unsigned char*)d_out);
}
```

```cpp
#include <hip/hip_runtime.h>
#include <cstdio>
#include <cstdint>

#define LAS __attribute__((address_space(3)))
#define GAS __attribute__((address_space(1)))
typedef float f32x2 __attribute__((ext_vector_type(2)));
typedef float f32x8 __attribute__((ext_vector_type(8)));
typedef float f32x16 __attribute__((ext_vector_type(16)));
typedef unsigned u32x2 __attribute__((ext_vector_type(2)));
typedef short s16x4 __attribute__((ext_vector_type(4)));
typedef __bf16 bf16x2v __attribute__((ext_vector_type(2)));

constexpr int DM = 2048, NSEQ = 12, LREAL = 4096, NMETA = 16, DEPTH = 4;
constexpr int NMAIN = NSEQ * LREAL;
constexpr int MROW0 = NMAIN;
constexpr int NTOK = NMAIN + NSEQ * NMETA;
constexpr int NPAN = 193, TP = NPAN * 256;
constexpr int PMETA = 192;
constexpr int INC = 4944, NIN = 5120;
constexpr int DFF = 5632, NUP = 2 * DFF;
constexpr int MLW = 1024, NQ = 1536, NKV = 2048;
constexpr float ALPHA = 1.681792830507429f;
constexpr float EPS = 1e-5f;
constexpr float NEGBIG = -1e30f;

constexpr size_t MiB = 1u << 20;
constexpr size_t WS_CTL = 0, CTL_BYTES = 1 * MiB;
constexpr size_t WS_COS = 1 * MiB;
constexpr size_t WS_SIN = WS_COS + (size_t)4112 * 32 * 4;
constexpr size_t WS_PAR = 2 * MiB + 128 * 1024;
constexpr int PO_BG = 0, PO_MLG = PO_BG + DEPTH * 16, PO_QG = PO_MLG + DEPTH * 1024, PO_KVG = PO_QG + DEPTH * 512, PO_L1G = PO_KVG + DEPTH * 256, PO_L1B = PO_L1G + DEPTH * 2048,
              PO_CW = PO_L1B + DEPTH * 2048, PO_CB = PO_CW + DEPTH * 3 * 5632, PO_L2G = PO_CB + DEPTH * 5632, PO_L2B = PO_L2G + DEPTH * 2048, PO_ONE = PO_L2B + DEPTH * 2048, PO_ZERO = PO_ONE + 2048, PO_END = PO_ZERO + 2048;
static_assert(WS_PAR + (size_t)PO_END * 4 <= 3 * MiB && WS_PAR >= 1 * MiB + 2 * 4112 * 32 * 4, "PAR block placement");
constexpr size_t WS_WIN = 3 * MiB;
constexpr size_t WS_WUQ = WS_WIN + (size_t)NIN * DM * 2;
constexpr size_t WS_WUKV = WS_WUQ + (size_t)NQ * 512 * 2;
constexpr size_t WS_WOUT = WS_WUKV + (size_t)NKV * 256 * 2;
constexpr size_t WS_WUP = WS_WOUT + (size_t)DM * DM * 2;
constexpr size_t WS_WDN = WS_WUP + (size_t)NUP * DM * 2;
constexpr size_t WS_STAT1 = WS_WDN + (size_t)DM * DFF * 2;
constexpr size_t WS_STAT2 = WS_CTL + 512 * 1024;
constexpr size_t WS_H = 100 * MiB;
constexpr size_t WS_PART = WS_H + 208 * MiB;
static_assert((size_t)NMAIN * DM * 2 <= 208 * MiB && 208 * MiB + (size_t)11 * 256 * DM * 4 <= (size_t)NMAIN * DM * 4, "PART sits between the bf16 rows and the f32 meta rows of H");
constexpr size_t WS_WSET2 = WS_H + 240 * MiB;
constexpr size_t WSET_BYTES = WS_STAT1 - WS_WIN, WSET_DELTA = WS_WSET2 - WS_WIN;
static_assert(WS_PART + (size_t)11 * 256 * DM * 4 <= WS_WSET2 && WS_WSET2 + WSET_BYTES <= WS_H + (size_t)NMAIN * DM * 4, "second weight set sits between the split-K parts and the f32 meta rows of H");
constexpr size_t WS_HB = WS_H + (size_t)TP * DM * 4;
constexpr size_t WS_R = WS_HB + (size_t)TP * DM * 2;
constexpr size_t WS_UQKVO = WS_R;
constexpr size_t WS_UDQ = WS_UQKVO + (size_t)TP * 4096 * 2;
constexpr size_t WS_UDKV = WS_UDQ + (size_t)TP * 512 * 2;
constexpr size_t WS_GATES = WS_UDKV + (size_t)TP * 256 * 2;
constexpr size_t WS_MKV = WS_GATES + (size_t)TP * 16 * 4;
constexpr size_t WS_KR = WS_MKV + (size_t)TP * NKV * 2;
constexpr size_t WS_RSTD = WS_KR + (size_t)TP * 64 * 2;
constexpr size_t WS_END_A = WS_RSTD + (size_t)TP * 2 * 4;
constexpr size_t WS_ACT = WS_R;
constexpr size_t WS_END_B = WS_ACT + (size_t)TP * DFF * 2;
constexpr size_t WS_NEED = (WS_END_A > WS_END_B ? WS_END_A : WS_END_B);
static_assert(WS_STAT1 + (size_t)TP * 8 <= WS_H && WS_STAT2 + (size_t)TP * 8 <= WS_CTL + CTL_BYTES, "weights and row statistics fit below H");
constexpr size_t DO_HSUM = 0;
constexpr size_t DO_MQ = DO_HSUM + (size_t)TP * MLW * 4;
constexpr size_t DO_GP = 340 * MiB;
constexpr size_t DO_SIDE = 0;
constexpr size_t DO_GVM = 32 * MiB;
static_assert(DO_MQ + (size_t)TP * NQ * 2 <= DO_GP && DO_GP + (size_t)96 * 65 * 200 * 4 <= (size_t)NMAIN * DM * 4 && (size_t)192 * 6 * DFF * 4 <= DO_GVM && DO_GVM + (size_t)256 * NUP * 2 <= (size_t)NMAIN * DM * 4, "d_out scratch fits");
constexpr int CW_BAR = 4096;

constexpr int RING_BYTES = 131072;
constexpr int MISC_OFF = RING_BYTES;
constexpr int LDS_BYTES = 147456;
constexpr int GRID = 256;

__device__ __forceinline__ int pos_of_row(int row) { return row < NMAIN ? NMETA + (row & (LREAL - 1)) : ((row - NMAIN) & (NMETA - 1)); }
__device__ __forceinline__ unsigned pk2(float lo, float hi) { f32x2 v = {lo, hi}; return __builtin_bit_cast(unsigned, __builtin_convertvector(v, bf16x2v)); }
__device__ __forceinline__ float bf_lo(unsigned w) { return __uint_as_float(w << 16); }
__device__ __forceinline__ float bf_hi(unsigned w) { return __uint_as_float(w & 0xffff0000u); }
typedef _Float16 f16x2v __attribute__((ext_vector_type(2)));
__device__ __forceinline__ unsigned pk2h(float lo, float hi) { f32x2 v = {lo, hi}; return __builtin_bit_cast(unsigned, __builtin_convertvector(v, f16x2v)); }
__device__ __forceinline__ float hf_lo(unsigned w) { return (float)__builtin_bit_cast(f16x2v, w)[0]; }
__device__ __forceinline__ float hf_hi(unsigned w) { return (float)__builtin_bit_cast(f16x2v, w)[1]; }
__device__ __forceinline__ float wave_sum(float v) {
#pragma unroll
    for (int o = 1; o < 64; o <<= 1) v += __shfl_xor(v, o);
    return v;
}
__device__ __forceinline__ float wave_max(float v) {
#pragma unroll
    for (int o = 1; o < 64; o <<= 1) v = fmaxf(v, __shfl_xor(v, o));
    return v;
}
namespace pg8 {
#define PG8_LAS __attribute__((address_space(3)))
typedef unsigned short bf16_t;
typedef short bf16x8 __attribute__((ext_vector_type(8)));
typedef float f32x4 __attribute__((ext_vector_type(4)));
typedef unsigned u32x4 __attribute__((ext_vector_type(4)));
constexpr int BM = 256, BK = 64, HALF = 128, HTB = HALF * BK * 2  , STAGE_BYTES = 8 * HTB, NXCD = 8, WGM = 4;

__host__ __device__ __forceinline__ int lds_byte(int r, int c) { const int st = (r >> 4) * 2 + (c >> 5), rr = r & 15, cc = c & 31, ob = rr * 64 + cc * 2; return st * 1024 + (ob ^ (((ob >> 9) & 1) << 5)); }
__host__ __device__ __forceinline__ void stage_rc(int b, int& R, int& C) { const int st = b / 1024, sb = b % 1024, swz = sb ^ (((sb >> 9) & 1) << 5); R = (st >> 1) * 16 + swz / 64; C = (st & 1) * 32 + (swz % 64) / 2; }
__host__ __device__ __forceinline__ int perm32(int rho) { const int n = rho >> 4, i = rho & 15; return 8 * (i >> 2) + 4 * n + (i & 3); }

struct Unit { int pm, pn, kk; };
struct Gemm { const bf16_t* A; const bf16_t* Bt; int M, N, K, ld; };

struct PanelOrder {
    int nM, nN, nwg, G, c, nMain, pm0, pmx;
    __device__ void init(int nMain_, int pm0_, int extra, int pmx_, int N, int G_, int c_) { nMain = nMain_; pm0 = pm0_; pmx = pmx_; nM = nMain_ + extra; nN = N / BM; nwg = nM * nN; G = G_; c = c_; }
    __device__ bool next(int i, Unit& u) const {
        const long L = (long)i * G + c; if (L >= nwg) return false;
        int wgid = (int)L; { const int q = nwg / NXCD, r = nwg % NXCD, xcd = wgid % NXCD, off = wgid / NXCD; wgid = (xcd < r ? xcd * (q + 1) : r * (q + 1) + (xcd - r) * q) + off; }
        const int nig = WGM * nN, gid = wgid / nig, fm = gid * WGM, gsz = (nM - fm) < WGM ? (nM - fm) : WGM;
        const int pl = fm + ((wgid % nig) % gsz); u.pm = pl < nMain ? pm0 + pl : pmx; u.pn = (wgid % nig) / gsz; u.kk = 0; return true;
    }
    __device__ __forceinline__ void a_ready(const Unit&) const {}
    __device__ __forceinline__ void done(const Unit&) const {}
};

struct SplitOrder {
    int pm, nN, nwg, G, c;
    __device__ void init(int pm_, int N, int nsplit, int G_, int c_) { pm = pm_; nN = N / BM; nwg = nN * nsplit; G = G_; c = c_; }
    __device__ bool next(int i, Unit& u) const { const int L = i * G + c; if (L >= nwg) return false; u.pm = pm; u.pn = L % nN; u.kk = L / nN; return true; }
    __device__ __forceinline__ void a_ready(const Unit&) const {}
    __device__ __forceinline__ void done(const Unit&) const {}
};

__device__ __forceinline__ u32x4 pack8(const f32x4 v0, const f32x4 v1) { u32x4 w; w.x = pk2(v0[0], v0[1]); w.y = pk2(v0[2], v0[3]); w.z = pk2(v1[0], v1[1]); w.w = pk2(v1[2], v1[3]); return w; }

struct EpiBf16G {
    static constexpr bool PERM = true, AFTER_DRAIN = false, PERMA = false;
    bf16_t* O; int ldc; const float* rs; int pm_sub, pm_sp, pm_sp_out;
    __device__ __forceinline__ void operator()(const f32x4 (&acc)[2][2][4][2], const Unit& u, int wr, int wc, int fr, int fq) const {
        const int opm = (u.pm == pm_sp) ? pm_sp_out : u.pm - pm_sub;
        const int rin = u.pm * BM + wr * 64 + fr, rout = opm * BM + wr * 64 + fr, col0 = u.pn * BM + wc * 32 + 8 * fq;
#pragma unroll
        for (int ai = 0; ai < 2; ++ai)
#pragma unroll
            for (int m = 0; m < 4; ++m) { const float sc = rs ? rs[(size_t)(rin + ai * HALF + m * 16) * 2] : 1.f;
                bf16_t* rowp = O + (size_t)(rout + ai * HALF + m * 16) * ldc + col0;
#pragma unroll
                for (int bj = 0; bj < 2; ++bj) *(u32x4*)(rowp + bj * HALF) = pack8(acc[ai][bj][m][0] * sc, acc[ai][bj][m][1] * sc); }
    }
};
struct EpiWin {
    static constexpr bool PERM = true, AFTER_DRAIN = false, PERMA = false;
    bf16_t *UQKVO, *UDQ, *UDKV, *KR; float* GATES; const float *COS, *SIN;
    __device__ __forceinline__ void operator()(const f32x4 (&acc)[2][2][4][2], const Unit& u, int wr, int wc, int fr, int fq) const {
        const int row0 = u.pm * BM + wr * 64 + fr;
        if (u.pn < 19) {
            bf16_t* base; int ldc, colt;
            if (u.pn < 16) { base = UQKVO; ldc = 4096; colt = u.pn * BM; } else if (u.pn < 18) { base = UDQ; ldc = 512; colt = (u.pn - 16) * BM; } else { base = UDKV; ldc = 256; colt = 0; }
            const int col0 = colt + wc * 32 + 8 * fq;
#pragma unroll
            for (int ai = 0; ai < 2; ++ai)
#pragma unroll
                for (int m = 0; m < 4; ++m) { bf16_t* rowp = base + (size_t)(row0 + ai * HALF + m * 16) * ldc + col0;
#pragma unroll
                    for (int bj = 0; bj < 2; ++bj) *(u32x4*)(rowp + bj * HALF) = pack8(acc[ai][bj][m][0], acc[ai][bj][m][1]); }
        } else {
            if (wc < 2) { const int g = 4 * wc + fq;
#pragma unroll
                for (int ai = 0; ai < 2; ++ai)
#pragma unroll
                    for (int m = 0; m < 4; ++m) { const int row = row0 + ai * HALF + m * 16, pos = pos_of_row(row);
                        const f32x4 cs = *(const f32x4*)(COS + pos * 32 + 4 * g), sn = *(const f32x4*)(SIN + pos * 32 + 4 * g);
                        const f32x4 x1 = acc[ai][0][m][0], x2 = acc[ai][0][m][1];
                        *(u32x4*)(KR + (size_t)row * 64 + 8 * g) = pack8(x1 * cs - x2 * sn, x1 * sn + x2 * cs); }
            } else if (wc == 2 && fq < 2) {
#pragma unroll
                for (int ai = 0; ai < 2; ++ai)
#pragma unroll
                    for (int m = 0; m < 4; ++m) { float* gp = GATES + (size_t)(row0 + ai * HALF + m * 16) * 16 + 8 * fq;
                        *(f32x4*)gp = acc[ai][0][m][0]; *(f32x4*)(gp + 4) = acc[ai][0][m][1]; }
            }
        }
    }
};
struct EpiQ {
    static constexpr bool PERM = true, AFTER_DRAIN = false, PERMA = false;
    bf16_t* MQ; const float *RSTD, *COS, *SIN;
    __device__ __forceinline__ void operator()(const f32x4 (&acc)[2][2][4][2], const Unit& u, int wr, int wc, int fr, int fq) const {
        const int row0 = u.pm * BM + wr * 64 + fr, colb = u.pn * BM + wc * 32 + 8 * fq;
#pragma unroll
        for (int ai = 0; ai < 2; ++ai)
#pragma unroll
            for (int m = 0; m < 4; ++m) { const int row = row0 + ai * HALF + m * 16, pos = pos_of_row(row); const float sc = RSTD[(size_t)row * 2];
#pragma unroll
                for (int bj = 0; bj < 2; ++bj) { const int col0 = colb + bj * HALF, o = col0 % 192;
                    f32x4 v0 = acc[ai][bj][m][0] * sc, v1 = acc[ai][bj][m][1] * sc;
                    if (o >= 128) { const int g = (o - 128) >> 3; const f32x4 cs = *(const f32x4*)(COS + pos * 32 + 4 * g), sn = *(const f32x4*)(SIN + pos * 32 + 4 * g);
                        const f32x4 x1 = v0, x2 = v1; v0 = x1 * cs - x2 * sn; v1 = x1 * sn + x2 * cs; }
                    *(u32x4*)(MQ + (size_t)row * NQ + col0) = pack8(v0, v1); } }
    }
};
__device__ __forceinline__ void resid_ln_tile(float* __restrict__ Cw, const float* __restrict__ Cr, const float* __restrict__ st, const float* __restrict__ g, const float* __restrict__ b,
                                              int ldc, float alpha, const f32x4 (&acc)[2][2][4][2], int row0, int col0) {
    asm volatile("" ::: "memory");
#pragma unroll
    for (int ai = 0; ai < 2; ++ai)
#pragma unroll
        for (int bj = 0; bj < 2; ++bj) {
            f32x4 gv[2], bv[2], hv[4][2]; f32x2 ms[4];
#pragma unroll
            for (int n = 0; n < 2; ++n) { gv[n] = *(const f32x4*)(g + col0 + bj * HALF + n * 16) * alpha; bv[n] = *(const f32x4*)(b + col0 + bj * HALF + n * 16) * alpha; }
#pragma unroll
            for (int m = 0; m < 4; ++m) { const int row = row0 + ai * HALF + m * 16; ms[m] = *(const f32x2*)(st + (size_t)row * 2);
#pragma unroll
                for (int n = 0; n < 2; ++n) hv[m][n] = *(const f32x4*)(Cr + (size_t)row * ldc + col0 + bj * HALF + n * 16); }
#pragma unroll
            for (int m = 0; m < 4; ++m) { const int row = row0 + ai * HALF + m * 16;
#pragma unroll
                for (int n = 0; n < 2; ++n) *(f32x4*)(Cw + (size_t)row * ldc + col0 + bj * HALF + n * 16) = (hv[m][n] - ms[m][0]) * ms[m][1] * gv[n] + bv[n] + acc[ai][bj][m][n]; }
        }
}
__device__ __forceinline__ void resid_ln_tile_bf(bf16_t* __restrict__ Cw, const bf16_t* __restrict__ Cr, const float* __restrict__ st, const float* __restrict__ g, const float* __restrict__ b,
                                                 int ldc, float alpha, const f32x4 (&acc)[2][2][4][2], int row0, int col0) {
    asm volatile("" ::: "memory");
#pragma unroll
    for (int ai = 0; ai < 2; ++ai)
#pragma unroll
        for (int bj = 0; bj < 2; ++bj) {
            f32x4 gv[2], bv[2]; u32x4 hv[4]; f32x2 ms[4];
#pragma unroll
            for (int n = 0; n < 2; ++n) { gv[n] = *(const f32x4*)(g + col0 + bj * HALF + n * 4) * alpha; bv[n] = *(const f32x4*)(b + col0 + bj * HALF + n * 4) * alpha; }
#pragma unroll
            for (int m = 0; m < 4; ++m) { const int row = row0 + ai * HALF + m * 16; ms[m] = *(const f32x2*)(st + (size_t)row * 2);
                hv[m] = *(const u32x4*)(Cr + (size_t)row * ldc + col0 + bj * HALF); }
#pragma unroll
            for (int m = 0; m < 4; ++m) { const int row = row0 + ai * HALF + m * 16;
                const f32x4 h0 = {hf_lo(hv[m].x), hf_hi(hv[m].x), hf_lo(hv[m].y), hf_hi(hv[m].y)}, h1 = {hf_lo(hv[m].z), hf_hi(hv[m].z), hf_lo(hv[m].w), hf_hi(hv[m].w)};
                const f32x4 o0 = (h0 - ms[m][0]) * ms[m][1] * gv[0] + bv[0] + acc[ai][bj][m][0], o1 = (h1 - ms[m][0]) * ms[m][1] * gv[1] + bv[1] + acc[ai][bj][m][1];
                u32x4 w; w.x = pk2h(o0[0], o0[1]); w.y = pk2h(o0[2], o0[3]); w.z = pk2h(o1[0], o1[1]); w.w = pk2h(o1[2], o1[3]);
                *(u32x4*)(Cw + (size_t)row * ldc + col0 + bj * HALF) = w; }
        }
}
struct EpiResidLn {
    static constexpr bool PERM = true, AFTER_DRAIN = false, PERMA = false;
    bf16_t* C; int ldc; float alpha; const float* st; const float* g; const float* b;
    __device__ __forceinline__ void operator()(const f32x4 (&acc)[2][2][4][2], const Unit& u, int wr, int wc, int fr, int fq) const {
        resid_ln_tile_bf(this->C, this->C, this->st, this->g, this->b, this->ldc, this->alpha, acc, u.pm * BM + wr * 64 + fr, u.pn * BM + wc * 32 + 8 * fq);
    }
};
struct EpiPart {
    static constexpr bool PERM = false, AFTER_DRAIN = false, PERMA = false;
    float* P; int ldc;
    __device__ __forceinline__ void operator()(const f32x4 (&acc)[2][2][4][2], const Unit& u, int wr, int wc, int fr, int fq) const {
        const int row0 = u.kk * BM + wr * 64 + fr, col0 = u.pn * BM + wc * 32 + 4 * fq;
#pragma unroll
        for (int ai = 0; ai < 2; ++ai)
#pragma unroll
            for (int m = 0; m < 4; ++m) { float* rowp = P + (size_t)(row0 + ai * HALF + m * 16) * ldc + col0;
#pragma unroll
                for (int bj = 0; bj < 2; ++bj)
#pragma unroll
                    for (int n = 0; n < 2; ++n) *(f32x4*)(rowp + bj * HALF + n * 16) = acc[ai][bj][m][n]; }
    }
};

__device__ __forceinline__ float dpp_shr1_old(float old, float x) { return __int_as_float(__builtin_amdgcn_update_dpp(__float_as_int(old), __float_as_int(x), 0x111, 0xf, 0xf, false)); }
__device__ __forceinline__ float dpp_shl1_old(float old, float x) { return __int_as_float(__builtin_amdgcn_update_dpp(__float_as_int(old), __float_as_int(x), 0x101, 0xf, 0xf, false)); }
struct EpiFfn {
    static constexpr bool PERM = true, AFTER_DRAIN = false, PERMA = true;
    bf16_t* ACT; float* SIDE; bf16_t* GVM; const float *cw, *cb; PG8_LAS float* X;
    __device__ __forceinline__ void operator()(const f32x4 (&acc)[2][2][4][2], const Unit& u, int wr_in, int wc_in, int fr_in, int fq_in) const {
        int fr = fr_in, fq = fq_in, wr = wr_in, wc = wc_in; asm volatile("" : "+v"(fr), "+v"(fq), "+s"(wr), "+s"(wc));
        const int cj = wc * 32 + 8 * fq, c0 = u.pn * 128 + cj;
        if (u.pm == PMETA) {
#pragma unroll
            for (int ai = 0; ai < 2; ++ai)
#pragma unroll
                for (int m = 0; m < 4; ++m) { bf16_t* rowp = GVM + (size_t)(ai * HALF + wr * 64 + 4 * fr + m) * NUP + c0;
                    *(u32x4*)rowp = pack8(acc[ai][0][m][0], acc[ai][0][m][1]); *(u32x4*)(rowp + DFF) = pack8(acc[ai][1][m][0], acc[ai][1][m][1]); }
            return;
        }
        f32x4 w0[2], w1[2], w2[2], bb[2];
#pragma unroll
        for (int n = 0; n < 2; ++n) { w0[n] = *(const f32x4*)(cw + c0 + 4 * n); w1[n] = *(const f32x4*)(cw + DFF + c0 + 4 * n); w2[n] = *(const f32x4*)(cw + 2 * DFF + c0 + 4 * n); bb[n] = *(const f32x4*)(cb + c0 + 4 * n); }
#pragma unroll
        for (int ai = 0; ai < 2; ++ai) { const int b = 2 * ai + wr;
            if (fr == 0) { *(PG8_LAS f32x4*)(X + (b * 2 + 0) * 128 + cj) = acc[ai][0][0][0]; *(PG8_LAS f32x4*)(X + (b * 2 + 0) * 128 + cj + 4) = acc[ai][0][0][1]; }
            if (fr == 15) { *(PG8_LAS f32x4*)(X + (b * 2 + 1) * 128 + cj) = acc[ai][0][3][0]; *(PG8_LAS f32x4*)(X + (b * 2 + 1) * 128 + cj + 4) = acc[ai][0][3][1]; } }
        asm volatile("s_waitcnt lgkmcnt(0)" ::: "memory"); __builtin_amdgcn_s_barrier(); asm volatile("" ::: "memory");
        const unsigned rowb = (unsigned)(u.pm * BM + wr * 64 + 4 * fr) * DFF + c0;
#pragma unroll
        for (int ai = 0; ai < 2; ++ai) { const int b = 2 * ai + wr;
            f32x4 xp[2], xn[2];
#pragma unroll
            for (int n = 0; n < 2; ++n) { xp[n] = b > 0 ? *(const PG8_LAS f32x4*)(X + ((b - 1) * 2 + 1) * 128 + cj + 4 * n) : (f32x4){0.f, 0.f, 0.f, 0.f};
                                          xn[n] = b < 3 ? *(const PG8_LAS f32x4*)(X + ((b + 1) * 2 + 0) * 128 + cj + 4 * n) : (f32x4){0.f, 0.f, 0.f, 0.f}; }
            f32x4 up0[2], dn3[2];
#pragma unroll
            for (int n = 0; n < 2; ++n)
#pragma unroll
                for (int e = 0; e < 4; ++e) { up0[n][e] = dpp_shr1_old(xp[n][e], acc[ai][0][3][n][e]); dn3[n][e] = dpp_shl1_old(xn[n][e], acc[ai][0][0][n][e]); }
#pragma unroll
            for (int m = 0; m < 4; ++m) { u32x4 ow;
#pragma unroll
                for (int n = 0; n < 2; ++n) {
                    const f32x4 g = acc[ai][0][m][n], pv = m > 0 ? acc[ai][0][m > 0 ? m - 1 : 0][n] : up0[n], nx = m < 3 ? acc[ai][0][m < 3 ? m + 1 : 3][n] : dn3[n];
                    const f32x4 x = w0[n] * pv + w1[n] * g + w2[n] * nx + bb[n]; f32x4 t, o;
#pragma unroll
                    for (int e = 0; e < 4; ++e) t[e] = __expf(-x[e]);
                    t = t + 1.f;
#pragma unroll
                    for (int e = 0; e < 4; ++e) t[e] = __builtin_amdgcn_rcpf(t[e]);
                    o = x * t * acc[ai][1][m][n];
                    if (n == 0) { ow.x = pk2(o[0], o[1]); ow.y = pk2(o[2], o[3]); } else { ow.z = pk2(o[0], o[1]); ow.w = pk2(o[2], o[3]); } }
                bf16_t* dst = ACT + (rowb + (unsigned)(ai * HALF + m) * DFF);
                if (ai == 0 ? m < 2 : m >= 2) {
                    const int r = ai * HALF + wr * 64 + 4 * fr + m;
                    if (r != 0 && r != 255) *(u32x4*)dst = ow;
                    const int slot = r == 0 ? 0 : r == 1 ? 1 : r == 254 ? 2 : r == 255 ? 3 : -1;
                    if (slot >= 0) { float* sp = SIDE + ((size_t)u.pm * 6 + slot) * DFF + c0; *(f32x4*)sp = acc[ai][0][m][0]; *(f32x4*)(sp + 4) = acc[ai][0][m][1];
                        if (slot == 0 || slot == 3) { float* vp = SIDE + ((size_t)u.pm * 6 + (slot == 0 ? 4 : 5)) * DFF + c0; *(f32x4*)vp = acc[ai][1][m][0]; *(f32x4*)(vp + 4) = acc[ai][1][m][1]; } }
                } else *(u32x4*)dst = ow;
            }
        }
    }
};
template <class Epi, class Sched, bool ALIGN_EPI = false, bool SP2 = false>
__device__ __forceinline__ void gemm_phase(PG8_LAS unsigned char* lds, const Gemm g, const Sched& S, const Epi& E) {
    int tid_ = threadIdx.x; asm volatile("" : "+v"(tid_));
    const int tid = tid_, wid = __builtin_amdgcn_readfirstlane(tid >> 6), lane = tid & 63, wr = wid >> 2, wc = wid & 3, fr = lane & 15, fq = lane >> 4;
    const int K = g.ld, nt = g.K / BK;
    unsigned voffA[2], voffB[2];
#pragma unroll
    for (int i = 0; i < 2; ++i) { int R, C; stage_rc(tid * 16 + i * 8192, R, C); const int Rb = Epi::PERM ? ((R & ~31) + perm32(R & 31)) : R;
        const int Ra = Epi::PERMA ? ((R & ~63) | ((R & 15) << 2) | ((R >> 4) & 3)) : R;
        voffA[i] = (unsigned)(Ra * K + C) * 2u; voffB[i] = (unsigned)(Rb * K + C) * 2u; }
    const size_t kstep = (size_t)(BK * 2);
    const size_t hstep = (size_t)HALF * K * 2;
    const size_t tstep = 2 * hstep;
    const unsigned ldsw = (unsigned)wid * 1024u;
    const int aoff = lds_byte(wr * 64 + fr, fq * 8), boff = lds_byte(wc * 32 + fr, fq * 8);
#define PG8_SA(b, h) (((b) * 2 + (h)) * HTB)
#define PG8_SB(b, h) ((4 + (b) * 2 + (h)) * HTB)
#define PG8_STAGE(bufoff, gbase, voff) do { _Pragma("unroll") for (int _i = 0; _i < 2; ++_i) \
        __builtin_amdgcn_global_load_lds((const unsigned*)((const char*)(gbase) + (voff)[_i]), (PG8_LAS unsigned*)(lds + (bufoff) + ldsw + _i * 8192), 16, 0, 0); } while (0)
#define PG8_LDA(dst, b, h) do { _Pragma("unroll") for (int m = 0; m < 4; ++m) _Pragma("unroll") for (int k = 0; k < 2; ++k) dst[m][k] = *(const PG8_LAS bf16x8*)(lds + PG8_SA(b, h) + aoff + m * 2048 + k * 1024); } while (0)
#define PG8_LDB(dst, b, h) do { _Pragma("unroll") for (int n = 0; n < 2; ++n) _Pragma("unroll") for (int k = 0; k < 2; ++k) dst[n][k] = *(const PG8_LAS bf16x8*)(lds + PG8_SB(b, h) + boff + n * 2048 + k * 1024); } while (0)
#define PG8_MMA(ai, bj, At, Bt) do { __builtin_amdgcn_s_setprio(1); _Pragma("unroll") for (int m = 0; m < 4; ++m) _Pragma("unroll") for (int n = 0; n < 2; ++n) _Pragma("unroll") for (int k = 0; k < 2; ++k) \
        acc[ai][bj][m][n] = __builtin_amdgcn_mfma_f32_16x16x32_bf16(Bt[n][k], At[m][k], acc[ai][bj][m][n], 0, 0, 0); __builtin_amdgcn_s_setprio(0); } while (0)
#define PG8_WAIT_V(n) asm volatile("s_waitcnt vmcnt(" #n ")" ::: "memory")
#define PG8_WAIT_L(n) asm volatile("s_waitcnt lgkmcnt(" #n ")" ::: "memory")
#define PG8_BAR __builtin_amdgcn_s_barrier()
#define PG8_SCHED __builtin_amdgcn_sched_barrier(0)
    Unit cur, nxt; int ui = 0;
    if (!S.next(0, cur)) return;
    f32x4 acc[2][2][4][2];
#pragma unroll
    for (int a = 0; a < 2; ++a)
#pragma unroll
        for (int b = 0; b < 2; ++b)
#pragma unroll
            for (int m = 0; m < 4; ++m)
#pragma unroll
                for (int n = 0; n < 2; ++n) acc[a][b][m][n] = (f32x4){0.f, 0.f, 0.f, 0.f};
    bf16x8 At[4][2], B0[2][2], B1[2][2];
    const size_t sstep = (size_t)g.K * 2;
    const char* cA = (const char*)g.A + (size_t)cur.pm * tstep + (size_t)cur.kk * sstep; const char* cB = (const char*)g.Bt + (size_t)cur.pn * tstep + (size_t)cur.kk * sstep;
    S.a_ready(cur);
    if constexpr (SP2) {
        PG8_STAGE(PG8_SB(0, 0), cB, voffB); PG8_STAGE(PG8_SB(0, 1), cB + hstep, voffB); PG8_STAGE(PG8_SA(0, 0), cA, voffA); PG8_STAGE(PG8_SA(0, 1), cA + hstep, voffA);
        if (wr == 1) PG8_BAR;
        PG8_WAIT_V(2); PG8_BAR;
        PG8_STAGE(PG8_SB(1, 0), cB + kstep, voffB); PG8_STAGE(PG8_SA(1, 0), cA + kstep, voffA); PG8_STAGE(PG8_SB(1, 1), cB + hstep + kstep, voffB);
        PG8_WAIT_V(6); PG8_BAR;
    } else {
        PG8_STAGE(PG8_SB(0, 0), cB, voffB); PG8_STAGE(PG8_SA(0, 0), cA, voffA); PG8_STAGE(PG8_SB(0, 1), cB + hstep, voffB); PG8_STAGE(PG8_SA(0, 1), cA + hstep, voffA);
        if (wr == 1) PG8_BAR;
        PG8_WAIT_V(4); PG8_BAR;
        PG8_STAGE(PG8_SB(1, 0), cB + kstep, voffB); PG8_STAGE(PG8_SA(1, 0), cA + kstep, voffA); PG8_STAGE(PG8_SB(1, 1), cB + hstep + kstep, voffB);
        PG8_WAIT_V(6); PG8_BAR;
    }
    for (;;) {
        const bool has_next = S.next(ui + 1, nxt);
        const char* nA = has_next ? (const char*)g.A + (size_t)nxt.pm * tstep + (size_t)nxt.kk * sstep : cA; const char* nB = has_next ? (const char*)g.Bt + (size_t)nxt.pn * tstep + (size_t)nxt.kk * sstep : cB;
        for (int t = 0; t < nt; t += 2) {
            const bool last = (t == nt - 2);
            const char* a1 = cA + (size_t)(t + 1) * kstep;
            const char* a2 = last ? nA : cA + (size_t)(t + 2) * kstep; const char* b2 = last ? nB : cB + (size_t)(t + 2) * kstep;
            const char* a3 = a2 + kstep; const char* b3 = b2 + kstep;
            if (last && has_next) S.a_ready(nxt);
            if constexpr (SP2) {
            PG8_LDB(B0, 0, 0); PG8_LDB(B1, 0, 1); PG8_SCHED; PG8_LDA(At, 0, 0); PG8_STAGE(PG8_SA(1, 1), a1 + hstep, voffA);
            PG8_WAIT_V(8); PG8_WAIT_L(0); PG8_BAR; PG8_MMA(0, 0, At, B0); PG8_MMA(0, 1, At, B1); PG8_BAR; PG8_SCHED;
            PG8_LDA(At, 0, 1); PG8_STAGE(PG8_SB(0, 0), b2, voffB); PG8_STAGE(PG8_SB(0, 1), b2 + hstep, voffB); PG8_STAGE(PG8_SA(0, 0), a2, voffA);
            PG8_WAIT_V(8); PG8_WAIT_L(0); PG8_BAR; PG8_MMA(1, 0, At, B0); PG8_MMA(1, 1, At, B1); PG8_BAR; PG8_SCHED;
            PG8_LDB(B0, 1, 0); PG8_LDB(B1, 1, 1); PG8_SCHED; PG8_LDA(At, 1, 0); PG8_STAGE(PG8_SA(0, 1), a2 + hstep, voffA);
            PG8_WAIT_V(8); PG8_WAIT_L(0); PG8_BAR; PG8_MMA(0, 0, At, B0); PG8_MMA(0, 1, At, B1); PG8_BAR; PG8_SCHED;
            PG8_LDA(At, 1, 1); PG8_STAGE(PG8_SB(1, 0), b3, voffB); PG8_STAGE(PG8_SB(1, 1), b3 + hstep, voffB); PG8_STAGE(PG8_SA(1, 0), a3, voffA);
            PG8_WAIT_V(8); PG8_WAIT_L(0); PG8_BAR; PG8_MMA(1, 0, At, B0); PG8_MMA(1, 1, At, B1); PG8_BAR; PG8_SCHED;
            } else {
            PG8_LDB(B0, 0, 0); PG8_SCHED; PG8_LDA(At, 0, 0); PG8_STAGE(PG8_SA(1, 1), a1 + hstep, voffA);
            PG8_WAIT_L(8); PG8_BAR; PG8_WAIT_L(0); PG8_MMA(0, 0, At, B0); PG8_BAR; PG8_SCHED;
            PG8_LDB(B1, 0, 1); PG8_STAGE(PG8_SB(0, 0), b2, voffB);
            PG8_BAR; PG8_WAIT_L(0); PG8_MMA(0, 1, At, B1); PG8_BAR;
            PG8_LDA(At, 0, 1); PG8_STAGE(PG8_SA(0, 0), a2, voffA);
            PG8_BAR; PG8_WAIT_L(0); PG8_MMA(1, 0, At, B0); PG8_BAR; PG8_SCHED;
            PG8_STAGE(PG8_SB(0, 1), b2 + hstep, voffB);
            PG8_WAIT_V(6); PG8_BAR; PG8_MMA(1, 1, At, B1); PG8_BAR;
            PG8_LDB(B0, 1, 0); PG8_SCHED; PG8_LDA(At, 1, 0); PG8_STAGE(PG8_SA(0, 1), a2 + hstep, voffA);
            PG8_WAIT_L(8); PG8_BAR; PG8_WAIT_L(0); PG8_MMA(0, 0, At, B0); PG8_BAR; PG8_SCHED;
            PG8_LDB(B1, 1, 1); PG8_STAGE(PG8_SB(1, 0), b3, voffB);
            PG8_BAR; PG8_WAIT_L(0); PG8_MMA(0, 1, At, B1); PG8_BAR;
            PG8_LDA(At, 1, 1); PG8_STAGE(PG8_SA(1, 0), a3, voffA);
            PG8_BAR; PG8_WAIT_L(0); PG8_MMA(1, 0, At, B0); PG8_BAR; PG8_SCHED;
            PG8_STAGE(PG8_SB(1, 1), b3 + hstep, voffB);
            PG8_WAIT_V(6); PG8_BAR; PG8_MMA(1, 1, At, B1); PG8_BAR;
            }
        }
        if constexpr (ALIGN_EPI) { if (wr == 0) PG8_BAR; }
        if constexpr (!Epi::AFTER_DRAIN) { E(acc, cur, wr, wc, fr, fq); S.done(cur); }
        if (!has_next) break;
#pragma unroll
        for (int a = 0; a < 2; ++a)
#pragma unroll
            for (int b = 0; b < 2; ++b)
#pragma unroll
                for (int m = 0; m < 4; ++m)
#pragma unroll
                    for (int n = 0; n < 2; ++n) acc[a][b][m][n] = (f32x4){0.f, 0.f, 0.f, 0.f};
        cur = nxt; cA = nA; cB = nB; ++ui;
        if constexpr (ALIGN_EPI) { if (wr == 1) PG8_BAR; }
    }
    PG8_WAIT_V(0);
    if constexpr (!ALIGN_EPI) { if (wr == 0) PG8_BAR; }
    PG8_BAR;
    if constexpr (Epi::AFTER_DRAIN) { E.fused(acc, cur, wr, wc, fr, fq, lds, wid, lane); S.done(cur); }
#undef PG8_SA
#undef PG8_SB
#undef PG8_STAGE
#undef PG8_LDA
#undef PG8_LDB
#undef PG8_MMA
#undef PG8_WAIT_V
#undef PG8_WAIT_L
#undef PG8_BAR
#undef PG8_SCHED
}
}
#define XB_TMO      128
#define XB_XCNT(j)  (256  + 64 * (j))
#define XB_XSUB(j)  (1280 + 64 * (j))
#define XB_XGEN(j)  (2304 + 64 * (j))
#define XB_TOP      3328
#define XB_TOPGEN   3392
#define XCD_BAR_WORDS 3456
#define XB_SPIN_CAP (1u << 21)

__device__ __forceinline__ unsigned xb_ld(unsigned* p)              { return __hip_atomic_load(p, __ATOMIC_RELAXED, __HIP_MEMORY_SCOPE_AGENT); }
__device__ __forceinline__ unsigned xb_add(unsigned* p, unsigned v) { return __hip_atomic_fetch_add(p, v, __ATOMIC_RELAXED, __HIP_MEMORY_SCOPE_AGENT); }
__device__ __forceinline__ unsigned xb_xcc_id() { return (unsigned)__builtin_amdgcn_s_getreg((3 << 11) | 20) & 0xFu; }
#define XB_SPIN(cond, bar) do { unsigned _sp = 0; while (cond) { __builtin_amdgcn_s_sleep(1); \
    if ((++_sp & 255u) == 0u) { if (xb_ld(&(bar)[XB_TMO])) break; if (_sp > XB_SPIN_CAP) { atomicAdd(&(bar)[XB_TMO], 1u); break; } } } } while (0)

struct XcdBarrier {
    unsigned* bar; unsigned x;
    volatile LAS unsigned* st;
};

__device__ __forceinline__ XcdBarrier xcd_barrier_post(unsigned* bar, volatile LAS unsigned* st) {
    XcdBarrier b; b.bar = bar; b.x = (unsigned)__builtin_amdgcn_readfirstlane((int)xb_xcc_id()); b.st = st;
    if (threadIdx.x == 0) (void)xb_add(&bar[XB_XCNT(b.x)], 1u);
    return b;
}
__device__ __forceinline__ void xcd_barrier_complete(unsigned* bar, unsigned x, unsigned& nloc, unsigned& nx) {
    const unsigned G = gridDim.x * gridDim.y * gridDim.z;
    unsigned sum, cnt, mine, sp = 0u;
    for (;;) {
        sum = 0u; cnt = 0u; mine = 0u;
#pragma unroll
        for (unsigned j = 0; j < 16; ++j) { const unsigned c = xb_ld(&bar[XB_XCNT(j)]); sum += c; cnt += (c > 0u) ? 1u : 0u; }
        mine = xb_ld(&bar[XB_XCNT(x)]);
        if (sum == G) { mine = xb_ld(&bar[XB_XCNT(x)]); break; }
        __builtin_amdgcn_s_sleep(1);
        if ((++sp & 255u) == 0u) { if (xb_ld(&bar[XB_TMO])) break; if (sp > XB_SPIN_CAP) { atomicAdd(&bar[XB_TMO], 1u); break; } }
    }
    nloc = mine > 0u ? mine : 1u; nx = cnt > 0u ? cnt : 1u;
}

__device__ __forceinline__ void xcd_barrier(const XcdBarrier& b) {
    asm volatile("s_waitcnt vmcnt(0)" ::: "memory");
    __syncthreads();
    if (threadIdx.x == 0) {
        unsigned* bar = b.bar; unsigned bx_ = b.x;
        asm volatile("" : "+s"(bx_));
        __builtin_amdgcn_s_waitcnt(0);
        unsigned nloc = b.st[0], nx = b.st[1];
        if (nloc == 0u) { xcd_barrier_complete(bar, bx_, nloc, nx); b.st[0] = nloc; b.st[1] = nx; }
        const unsigned old = xb_add(&bar[XB_XSUB(bx_)], 1u);
        const unsigned gen = old / nloc;
        if (old + 1u == (gen + 1u) * nloc) {
            __builtin_amdgcn_fence(__ATOMIC_RELEASE, "agent");
            asm volatile("s_waitcnt vmcnt(0)" ::: "memory");
            const unsigned og = xb_add(&bar[XB_TOP], 1u);
            const unsigned tg = og / nx;
            if (og + 1u == (tg + 1u) * nx) xb_add(&bar[XB_TOPGEN], 1u);
            else XB_SPIN(xb_ld(&bar[XB_TOPGEN]) == tg, bar);
            __builtin_amdgcn_fence(__ATOMIC_ACQUIRE, "agent");
            xb_add(&bar[XB_XGEN(bx_)], 1u);
            asm volatile("s_waitcnt vmcnt(0)" ::: "memory");
        } else {
            XB_SPIN(xb_ld(&bar[XB_XGEN(bx_)]) == gen, bar);
            __builtin_amdgcn_fence(__ATOMIC_ACQUIRE, "agent");
            asm volatile("s_waitcnt vmcnt(0)" ::: "memory");
        }
    }
    __syncthreads();
}

typedef unsigned short bf16_t;
typedef short bf16x8 __attribute__((ext_vector_type(8)));
typedef float f32x4 __attribute__((ext_vector_type(4)));
typedef unsigned u32x4 __attribute__((ext_vector_type(4)));
#define LDS_WAIT() asm volatile("s_waitcnt lgkmcnt(0)" ::: "memory")

struct Params {
    const float* in[19];
};
struct Frame {
    LAS unsigned char* lds;
    int tid, lane, wave, G, bx, vcu, gw, ngw;
};
__device__ __forceinline__ const float* uptr(const LAS unsigned long long* t, int k) {
    const unsigned long long v = t[k]; const unsigned lo = __builtin_amdgcn_readfirstlane((unsigned)v), hi = __builtin_amdgcn_readfirstlane((unsigned)(v >> 32));
    return (const float*)(const GAS float*)(((unsigned long long)hi << 32) | lo); }

template <class CMap>
__device__ __forceinline__ void transpose_load(float (&v)[32], const float* W, int Nsrc, const float* ks, int kb, int nb, int lane, CMap cmap) {
    const int k0 = 64 * kb, n0 = 32 * nb; const int sc = cmap(n0 + (lane & 31));
#pragma unroll
    for (int i = 0; i < 32; ++i) { const int kk = 2 * i + (lane >> 5); float x = 0.f; if (sc >= 0) x = W[(size_t)(k0 + kk) * Nsrc + sc]; if (ks) x *= ks[k0 + kk]; v[i] = x; }
}
__device__ __forceinline__ void transpose_store(const float (&v)[32], int K, bf16_t* WT, LAS float* scr, int kb, int nb, int lane) {
    const int k0 = 64 * kb, n0 = 32 * nb;
#pragma unroll
    for (int i = 0; i < 32; ++i) scr[(2 * i + (lane >> 5)) * 33 + (lane & 31)] = v[i];
    LDS_WAIT(); asm volatile("" ::: "memory");
    const int c = lane & 7;
#pragma unroll
    for (int j = 0; j < 4; ++j) { const int n = (lane >> 3) + 8 * j; const LAS float* s = scr + (8 * c) * 33 + n;
        u32x4 o; o.x = pk2(s[0 * 33], s[1 * 33]); o.y = pk2(s[2 * 33], s[3 * 33]); o.z = pk2(s[4 * 33], s[5 * 33]); o.w = pk2(s[6 * 33], s[7 * 33]);
        *(u32x4*)(WT + (size_t)(n0 + n) * K + k0 + 8 * c) = o; }
    LDS_WAIT(); asm volatile("" ::: "memory");
}
template <class CMap>
__device__ __forceinline__ void transpose_matrix(const Frame& F, const float* W, int K, int Nsrc, int Ndst, bf16_t* WT, const float* ks, LAS float* scr, CMap cmap) {
    const int nnb = Ndst / 32, items = (K / 64) * nnb;
    for (int it = F.gw; it < items; it += 2 * F.ngw) { const int it2 = it + F.ngw; float va[32], vb[32];
        transpose_load(va, W, Nsrc, ks, it / nnb, it % nnb, F.lane, cmap);
        if (it2 < items) transpose_load(vb, W, Nsrc, ks, it2 / nnb, it2 % nnb, F.lane, cmap);
        transpose_store(va, K, WT, scr, it / nnb, it % nnb, F.lane);
        if (it2 < items) transpose_store(vb, K, WT, scr, it2 / nnb, it2 % nnb, F.lane); }
}
__device__ __forceinline__ int rope_perm(int m) { const int g = m >> 3, j = m & 7; return j < 4 ? 4 * g + j : 32 + 4 * g + (j - 4); }
struct CMapIn { __device__ int operator()(int n) const {
    if (n < 4096) return n; if (n < 4608) return 4112 + (n - 4096); if (n < 4864) return 4624 + (n - 4608);
    if (n < 4928) return 4880 + rope_perm(n - 4864); if (n < 4944) return 4096 + (n - 4928); return -1; } };
struct CMapQ { __device__ int operator()(int n) const { const int h = n / 192, o = n % 192; return o < 128 ? n : h * 192 + 128 + rope_perm(o - 128); } };
struct CMapUp { __device__ int operator()(int n) const { const int pn = n >> 8, j = n & 255; return j < 128 ? 128 * pn + j : DFF + 128 * pn + (j - 128); } };
struct CMapId { __device__ int operator()(int n) const { return n; } };

__device__ __forceinline__ void convert_weights(const Frame& F, unsigned char* ws_, const LAS unsigned long long* pt, int l, size_t wo, int slot) {
    unsigned char* ws = ws_ + wo;
    LAS float* scr = (LAS float*)(F.lds + F.wave * 8448);
    if (slot != 1) {
        const float* w_in = uptr(pt, 3) + (size_t)l * DM * INC; const float* w_uq = uptr(pt, 8) + (size_t)l * 512 * NQ; const float* w_ukv = uptr(pt, 9) + (size_t)l * 256 * NKV;
        const float* w_out = uptr(pt, 10) + (size_t)l * DM * DM; const float* w_dn = uptr(pt, 16) + (size_t)l * DFF * DM;
        const float* qg = uptr(pt, 6) + (size_t)l * 512; const float* kvg = uptr(pt, 7) + (size_t)l * 256;
        transpose_matrix(F, w_in, DM, INC, NIN, (bf16_t*)(ws + WS_WIN), nullptr, scr, CMapIn());
        transpose_matrix(F, w_uq, 512, NQ, NQ, (bf16_t*)(ws + WS_WUQ), qg, scr, CMapQ());
        transpose_matrix(F, w_ukv, 256, NKV, NKV, (bf16_t*)(ws + WS_WUKV), kvg, scr, CMapId());
        transpose_matrix(F, w_out, DM, DM, DM, (bf16_t*)(ws + WS_WOUT), nullptr, scr, CMapId());
        transpose_matrix(F, w_dn, DFF, DM, DM, (bf16_t*)(ws + WS_WDN), nullptr, scr, CMapId());
    }
    if (slot != 0) { const float* w_up = uptr(pt, 13) + (size_t)l * DM * NUP;
        transpose_matrix(F, w_up, DM, NUP, NUP, (bf16_t*)(ws + WS_WUP), nullptr, scr, CMapUp()); }
}
__device__ __forceinline__ void prologue(const Frame& F, unsigned char* ws, const LAS unsigned long long* pt) {
    float* COS = (float*)(ws + WS_COS); float* SIN = (float*)(ws + WS_SIN);
    for (int i = F.bx * 512 + F.tid; i < 4112 * 32; i += F.G * 512) { const int pos = i >> 5, f = i & 31;
        const float inv = powf(10000.0f, -(float)(2 * f) / 64.0f); const float ang = (float)pos * inv; float s, c; sincosf(ang, &s, &c); COS[i] = c; SIN[i] = s; }
    { float* PAR = (float*)(ws + WS_PAR); const int gt = F.bx * 512 + F.tid, nt = F.G * 512;
      for (int i = gt; i < DEPTH * 16; i += nt) PAR[PO_BG + i] = uptr(pt, 4)[i];
      for (int i = gt; i < DEPTH * 1024; i += nt) PAR[PO_MLG + i] = uptr(pt, 5)[i];
      for (int i = gt; i < DEPTH * 512; i += nt) PAR[PO_QG + i] = uptr(pt, 6)[i];
      for (int i = gt; i < DEPTH * 256; i += nt) PAR[PO_KVG + i] = uptr(pt, 7)[i];
      for (int i = gt; i < 2048; i += nt) { PAR[PO_ONE + i] = 1.f; PAR[PO_ZERO + i] = 0.f; }
      { float* ST2 = (float*)(ws + WS_STAT2); for (int i = gt; i < TP; i += nt) { ST2[2 * i] = 0.f; ST2[2 * i + 1] = 1.f; } }
      for (int i = gt; i < DEPTH * 2048; i += nt) { PAR[PO_L1G + i] = uptr(pt, 11)[i]; PAR[PO_L1B + i] = uptr(pt, 12)[i]; PAR[PO_L2G + i] = uptr(pt, 17)[i]; PAR[PO_L2B + i] = uptr(pt, 18)[i]; }
      for (int i = gt; i < DEPTH * 3 * 5632; i += nt) PAR[PO_CW + i] = uptr(pt, 14)[i];
      for (int i = gt; i < DEPTH * 5632; i += nt) PAR[PO_CB + i] = uptr(pt, 15)[i]; }
    float* H = (float*)(ws + WS_H); bf16_t* HB = (bf16_t*)(ws + WS_HB);
    const float* xp = uptr(pt, 0); const float* xs = uptr(pt, 1); const float* mt = uptr(pt, 2);
    for (int row0 = F.gw; row0 < TP; row0 += 2 * F.ngw) {
        f32x4 v[2][8];
#pragma unroll
        for (int r = 0; r < 2; ++r) { const int row = row0 + r * F.ngw; const float* src = nullptr;
            if (row < 4 * LREAL) src = xp + (size_t)row * DM; else if (row < NMAIN) src = xs + (size_t)(row - 4 * LREAL) * DM; else if (row < NTOK) src = mt + (size_t)((row - NMAIN) & 15) * DM;
#pragma unroll
            for (int j = 0; j < 8; ++j) { v[r][j] = (f32x4){0.f, 0.f, 0.f, 0.f}; if (src) v[r][j] = ((const f32x4*)src)[F.lane + 64 * j]; } }
#pragma unroll
        for (int r = 0; r < 2; ++r) { const int row = row0 + r * F.ngw; if (row < TP) {
            f32x4* hd = (f32x4*)(H + (size_t)row * DM) + F.lane; u32x2* bd = (u32x2*)(HB + (size_t)row * DM) + F.lane; u32x2* hb = (u32x2*)((bf16_t*)H + (size_t)row * DM) + F.lane;
#pragma unroll
            for (int j = 0; j < 8; ++j) { const f32x4 x = v[r][j];
                u32x2 w; w.x = pk2(x[0], x[1]); w.y = pk2(x[2], x[3]); bd[64 * j] = w;
                if (row >= NMAIN) hd[64 * j] = x * ALPHA;
                else { u32x2 wh; wh.x = pk2h(x[0], x[1]); wh.y = pk2h(x[2], x[3]); hb[64 * j] = wh; } } } }
    }
}

__device__ __forceinline__ void ln_one(const f32x4 (&vin)[8], int row, int lane, float* __restrict__ Hw, bf16_t* __restrict__ HB, const float* __restrict__ g, const float* __restrict__ b, float* __restrict__ ST) {
    f32x4 v[8]; float s = 0.f;
#pragma unroll
    for (int j = 0; j < 8; ++j) { v[j] = vin[j]; s += (v[j][0] + v[j][1]) + (v[j][2] + v[j][3]); }
    const float mean = wave_sum(s) * (1.f / DM); float q = 0.f;
#pragma unroll
    for (int j = 0; j < 8; ++j) { v[j] = v[j] - mean; q += (v[j][0] * v[j][0] + v[j][1] * v[j][1]) + (v[j][2] * v[j][2] + v[j][3] * v[j][3]); }
    const float rstd = rsqrtf(wave_sum(q) * (1.f / DM) + EPS);
    if (lane == 0) { f32x2 ms = {mean, rstd}; *(f32x2*)(ST + (size_t)row * 2) = ms; }
    u32x2* bd = (u32x2*)(HB + (size_t)row * DM) + lane; f32x4* hp = (f32x4*)(Hw + (size_t)row * DM) + lane;
#pragma unroll
    for (int j = 0; j < 8; ++j) { const f32x4 gg = ((const f32x4*)g)[lane + 64 * j], bb = ((const f32x4*)b)[lane + 64 * j]; const f32x4 y = v[j] * rstd * gg + bb;
        u32x2 w; w.x = pk2(y[0], y[1]); w.y = pk2(y[2], y[3]); bd[64 * j] = w;
        hp[64 * j] = y * ALPHA; }
}
__device__ __forceinline__ void ln_one_bf(const u32x4 (&vin)[4], int row, int lane, bf16_t* __restrict__ HB, const float* __restrict__ g, const float* __restrict__ b, float* __restrict__ ST, float* __restrict__ out) {
    f32x4 v[8]; float s = 0.f;
#pragma unroll
    for (int j = 0; j < 4; ++j) { v[2 * j] = (f32x4){hf_lo(vin[j].x), hf_hi(vin[j].x), hf_lo(vin[j].y), hf_hi(vin[j].y)}; v[2 * j + 1] = (f32x4){hf_lo(vin[j].z), hf_hi(vin[j].z), hf_lo(vin[j].w), hf_hi(vin[j].w)}; }
#pragma unroll
    for (int j = 0; j < 8; ++j) s += (v[j][0] + v[j][1]) + (v[j][2] + v[j][3]);
    const float mean = wave_sum(s) * (1.f / DM); float q = 0.f;
#pragma unroll
    for (int j = 0; j < 8; ++j) { v[j] = v[j] - mean; q += (v[j][0] * v[j][0] + v[j][1] * v[j][1]) + (v[j][2] * v[j][2] + v[j][3] * v[j][3]); }
    const float rstd = rsqrtf(wave_sum(q) * (1.f / DM) + EPS);
    if (lane == 0) { f32x2 ms = {mean, rstd}; *(f32x2*)(ST + (size_t)row * 2) = ms; }
    u32x4* bd = (u32x4*)(HB + (size_t)row * DM) + lane;
#pragma unroll
    for (int j = 0; j < 4; ++j) { const int c4 = 2 * (lane + 64 * j);
        const f32x4 y0 = v[2 * j] * rstd * ((const f32x4*)g)[c4] + ((const f32x4*)b)[c4], y1 = v[2 * j + 1] * rstd * ((const f32x4*)g)[c4 + 1] + ((const f32x4*)b)[c4 + 1];
        if (out) { f32x4* op = (f32x4*)(out + (size_t)row * DM) + c4; op[0] = y0; op[1] = y1; }
        else bd[64 * j] = pg8::pack8(y0, y1); }
}
__device__ __forceinline__ void ln_rows(const Frame& F, float* H, bf16_t* HB, const float* g, const float* b, float* ST, float* out, const float* PART, int nk) {
    const bf16_t* __restrict__ Hr = (const bf16_t*)H;
    for (int row = F.gw; row < NMAIN; row += 4 * F.ngw) {
        const int row2 = row + F.ngw, row3 = row + 2 * F.ngw, row4 = row + 3 * F.ngw;
        u32x4 va[4], vb[4], vc[4], vd[4];
#pragma unroll
        for (int j = 0; j < 4; ++j) va[j] = ((const u32x4*)(Hr + (size_t)row * DM))[F.lane + 64 * j];
#pragma unroll
        for (int j = 0; j < 4; ++j) vb[j] = ((const u32x4*)(Hr + (size_t)row2 * DM))[F.lane + 64 * j];
#pragma unroll
        for (int j = 0; j < 4; ++j) vc[j] = ((const u32x4*)(Hr + (size_t)row3 * DM))[F.lane + 64 * j];
#pragma unroll
        for (int j = 0; j < 4; ++j) vd[j] = ((const u32x4*)(Hr + (size_t)row4 * DM))[F.lane + 64 * j];
        ln_one_bf(va, row, F.lane, HB, g, b, ST, out);
        ln_one_bf(vb, row2, F.lane, HB, g, b, ST, out);
        ln_one_bf(vc, row3, F.lane, HB, g, b, ST, out);
        ln_one_bf(vd, row4, F.lane, HB, g, b, ST, out);
    }
    if (F.gw < TP - NMAIN) {
        const int row = NMAIN + F.gw; const float* __restrict__ Hm = H; f32x4 va[8];
#pragma unroll
        for (int j = 0; j < 8; ++j) va[j] = ((const f32x4*)(Hm + (size_t)row * DM))[F.lane + 64 * j];
        const float* __restrict__ pp0 = PART + (size_t)F.gw * DM;
        int k = 0;
        for (; k + 4 <= nk; k += 4) {
            f32x4 t[4][8];
#pragma unroll
            for (int q = 0; q < 4; ++q)
#pragma unroll
                for (int j = 0; j < 8; ++j) t[q][j] = ((const f32x4*)(pp0 + (size_t)(k + q) * 256 * DM))[F.lane + 64 * j];
#pragma unroll
            for (int q = 0; q < 4; ++q)
#pragma unroll
                for (int j = 0; j < 8; ++j) va[j] += t[q][j]; }
        for (; k < nk; ++k) {
#pragma unroll
            for (int j = 0; j < 8; ++j) va[j] += ((const f32x4*)(pp0 + (size_t)k * 256 * DM))[F.lane + 64 * j]; }
        ln_one(va, row, F.lane, H, HB, g, b, ST);
    }
}

__device__ __forceinline__ void rstd_rows(const Frame& F, const bf16_t* UDQ, const bf16_t* UDKV, float* RSTD) {
    for (int row = F.gw; row < TP; row += F.ngw) {
        const u32x4 a = ((const u32x4*)(UDQ + (size_t)row * 512))[F.lane]; float s = 0.f;
#pragma unroll
        for (int j = 0; j < 4; ++j) { const float x = bf_lo(a[j]), y = bf_hi(a[j]); s += x * x + y * y; }
        float t = 0.f;
        if (F.lane < 32) { const u32x4 c = ((const u32x4*)(UDKV + (size_t)row * 256))[F.lane];
#pragma unroll
            for (int j = 0; j < 4; ++j) { const float x = bf_lo(c[j]), y = bf_hi(c[j]); t += x * x + y * y; } }
        s = wave_sum(s); t = wave_sum(t);
        if (F.lane == 0) { RSTD[(size_t)row * 2] = rsqrtf(s * (1.f / 512.f) + EPS); RSTD[(size_t)row * 2 + 1] = rsqrtf(t * (1.f / 256.f) + EPS); }
    }
}

__device__ __forceinline__ void mlstm_fin_row(int row, int lane, const f32x4 (&hv)[4], const u32x2 (&ov)[4], const float* __restrict__ ng, bf16_t* __restrict__ MIX) {
#pragma unroll
    for (int j = 0; j < 4; ++j) {
        f32x4 v = hv[j];
        const float mean = wave_sum((v[0] + v[1]) + (v[2] + v[3])) * (1.f / 256.f); v = v - mean;
        const float rstd = rsqrtf(wave_sum((v[0] * v[0] + v[1] * v[1]) + (v[2] * v[2] + v[3] * v[3])) * (1.f / 256.f) + EPS);
        const f32x4 gg = ((const f32x4*)(ng + 256 * j))[lane];
        const u32x2 uo = ov[j];
        const float o0 = bf_lo(uo.x), o1 = bf_hi(uo.x), o2 = bf_lo(uo.y), o3 = bf_hi(uo.y);
        const float y0 = v[0] * rstd * gg[0] / (1.f + __expf(-o0)), y1 = v[1] * rstd * gg[1] / (1.f + __expf(-o1));
        const float y2 = v[2] * rstd * gg[2] / (1.f + __expf(-o2)), y3 = v[3] * rstd * gg[3] / (1.f + __expf(-o3));
        u32x2 w; w.x = pk2(y0, y1); w.y = pk2(y2, y3); ((u32x2*)(MIX + (size_t)row * DM + 256 * j))[lane] = w;
    }
}
__device__ __forceinline__ void mlstm_finalize(const Frame& F, int gw0, int ngw0, const float* HSUM, const bf16_t* UQKVO, const float* ng, bf16_t* MIX) {
    const float* __restrict__ Hs = HSUM; const bf16_t* __restrict__ Uo = UQKVO;
    for (int row = gw0; row < TP; row += 4 * ngw0) {
        int rr[4]; bool ok[4];
#pragma unroll
        for (int q = 0; q < 4; ++q) { const int r = row + q * ngw0; ok[q] = r < TP; rr[q] = ok[q] ? r : row; }
        f32x4 hv[4][4]; u32x2 ov[4][4];
#pragma unroll
        for (int q = 0; q < 4; ++q)
#pragma unroll
            for (int j = 0; j < 4; ++j) { hv[q][j] = ((const f32x4*)(Hs + (size_t)rr[q] * MLW + 256 * j))[F.lane]; ov[q][j] = ((const u32x2*)(Uo + (size_t)rr[q] * 4096 + 3072 + 256 * j))[F.lane]; }
#pragma unroll
        for (int q = 0; q < 4; ++q) if (ok[q]) mlstm_fin_row(rr[q], F.lane, hv[q], ov[q], ng, MIX);
    }
}

__device__ __forceinline__ f32x8 ld8f(const float* p) { const f32x4 a = *(const f32x4*)p, b = *(const f32x4*)(p + 4); return (f32x8){a[0], a[1], a[2], a[3], b[0], b[1], b[2], b[3]}; }
__device__ __forceinline__ f32x8 ld8b(const bf16_t* p) { const u32x4 v = *(const u32x4*)p; return (f32x8){bf_lo(v[0]), bf_hi(v[0]), bf_lo(v[1]), bf_hi(v[1]), bf_lo(v[2]), bf_hi(v[2]), bf_lo(v[3]), bf_hi(v[3])}; }
__device__ __forceinline__ void act_store(bf16_t* dst, const f32x8 gp, const f32x8 gc, const f32x8 gn, const f32x8 vv, const f32x8 w0, const f32x8 w1, const f32x8 w2, const f32x8 bb) {
    float o[8];
#pragma unroll
    for (int i = 0; i < 8; ++i) { const float x = w0[i] * gp[i] + w1[i] * gc[i] + w2[i] * gn[i] + bb[i]; o[i] = x / (1.f + __expf(-x)) * vv[i]; }
    u32x4 w; w.x = pk2(o[0], o[1]); w.y = pk2(o[2], o[3]); w.z = pk2(o[4], o[5]); w.w = pk2(o[6], o[7]); *(u32x4*)dst = w;
}
__device__ __forceinline__ void ffn_fixup(const Frame& F, const float* SIDE, const bf16_t* GVM, bf16_t* ACT, const float* cw, const float* cb) {
    constexpr int NCH = DFF / 8;
    const f32x8 zero = {0.f, 0.f, 0.f, 0.f, 0.f, 0.f, 0.f, 0.f};
    const int gt = F.bx * 512 + F.tid, nt = GRID * 512;
    for (int idx = gt; idx < 192 * 2 * NCH; idx += nt) {
        const int ch = idx % NCH, rsel = (idx / NCH) & 1, pm = idx / (2 * NCH), c0 = 8 * ch, sq = pm >> 4;
        const f32x8 w0 = ld8f(cw + c0), w1 = ld8f(cw + DFF + c0), w2 = ld8f(cw + 2 * DFF + c0), bb = ld8f(cb + c0);
        const float* S0 = SIDE + (size_t)pm * 6 * DFF + c0;
        if (rsel == 0) { const f32x8 gp = (pm & 15) ? ld8f(S0 - 6 * DFF + 3 * DFF) : ld8b(GVM + (size_t)(16 * sq + 15) * NUP + c0);
            act_store(ACT + (size_t)(pm * 256) * DFF + c0, gp, ld8f(S0), ld8f(S0 + DFF), ld8f(S0 + 4 * DFF), w0, w1, w2, bb);
        } else { const f32x8 gn = ((pm & 15) != 15) ? ld8f(S0 + 6 * DFF) : zero;
            act_store(ACT + (size_t)(pm * 256 + 255) * DFF + c0, ld8f(S0 + 2 * DFF), ld8f(S0 + 3 * DFF), gn, ld8f(S0 + 5 * DFF), w0, w1, w2, bb); }
    }
    for (int idx = gt; idx < NSEQ * 16 * NCH; idx += nt) {
        const int ch = idx % NCH, rp = idx / NCH, pp = rp & 15, sq = rp >> 4, c0 = 8 * ch;
        const f32x8 w0 = ld8f(cw + c0), w1 = ld8f(cw + DFF + c0), w2 = ld8f(cw + 2 * DFF + c0), bb = ld8f(cb + c0);
        const bf16_t* G0 = GVM + (size_t)(16 * sq + pp) * NUP + c0;
        const f32x8 gp = pp > 0 ? ld8b(G0 - NUP) : zero, gc = ld8b(G0);
        const f32x8 gn = pp < 15 ? ld8b(G0 + NUP) : ld8f(SIDE + (size_t)(16 * sq) * 6 * DFF + c0);
        act_store(ACT + (size_t)(MROW0 + 16 * sq + pp) * DFF + c0, gp, gc, gn, ld8b(G0 + DFF), w0, w1, w2, bb);
    }
}

namespace att {
constexpr int NW = 8, QBLK = 32, KVBLK = 64, NT = 65;
constexpr int KROW = 400;
constexpr int SHM_V = KVBLK * 128 * 2, SHM_K = KVBLK * KROW;
constexpr int OFF_V = 0, OFF_K = 3 * SHM_V, OFF_WS = OFF_K + 3 * SHM_K, LDS_TOTAL = OFF_WS + NW * 64 * 4;
static_assert(LDS_TOTAL <= RING_BYTES, "attention LDS");
constexpr float SCALE = 0.07216878364870323f;
constexpr float THR = 8.f;
#define SBAR() __builtin_amdgcn_sched_barrier(0)
__device__ __forceinline__ int crow(int r, int hi) { return (r & 3) + 8 * (r >> 2) + 4 * hi; }
__device__ __forceinline__ unsigned cvtpk(float lo, float hi) { unsigned r; asm volatile("v_cvt_pk_bf16_f32 %0, %1, %2" : "=v"(r) : "v"(lo), "v"(hi)); return r; }

template <bool MASK16>
__device__ __forceinline__ void partialSM(f32x16& p0, f32x16& p1, float& m_reg, float& mn, float& alpha) {
    constexpr float C = SCALE * 1.4426950408889634f;
    if (MASK16) {
#pragma unroll
        for (int r = 8; r < 16; ++r) p0[r] = NEGBIG;
#pragma unroll
        for (int r = 0; r < 16; ++r) p1[r] = NEGBIG;
    }
    float pmax = p0[0];
#pragma unroll
    for (int r = 1; r < 16; ++r) pmax = fmaxf(pmax, p0[r]);
#pragma unroll
    for (int r = 0; r < 16; ++r) pmax = fmaxf(pmax, p1[r]);
    { auto rr = __builtin_amdgcn_permlane32_swap(__float_as_uint(pmax), __float_as_uint(pmax), false, false); pmax = fmaxf(__uint_as_float(rr[0]), __uint_as_float(rr[1])); }
    if (__builtin_expect(__all(pmax - m_reg <= THR / SCALE), 1)) { mn = m_reg; alpha = 1.f; }
    else { mn = fmaxf(m_reg, pmax); alpha = __builtin_amdgcn_exp2f((m_reg - mn) * C); m_reg = mn; }
    const float mnC = -mn * C;
#pragma unroll
    for (int r = 0; r < 16; ++r) p0[r] = fmaf(p0[r], C, mnC);
#pragma unroll
    for (int r = 0; r < 16; ++r) p1[r] = fmaf(p1[r], C, mnC);
#pragma unroll
    for (int r = 0; r < 16; ++r) p0[r] = __builtin_amdgcn_exp2f(p0[r]);
}
__device__ __forceinline__ void finishSM(f32x16& p0, f32x16& p1, float alpha, float& l_reg, bf16x8& pa0, bf16x8& pa1, bf16x8& pa2, bf16x8& pa3) {
#pragma unroll
    for (int r = 0; r < 16; ++r) p1[r] = __builtin_amdgcn_exp2f(p1[r]);
    float ps = 0;
#pragma unroll
    for (int r = 0; r < 16; ++r) ps += p0[r];
#pragma unroll
    for (int r = 0; r < 16; ++r) ps += p1[r];
    { auto rr = __builtin_amdgcn_permlane32_swap(__float_as_uint(ps), __float_as_uint(ps), false, false); ps = __uint_as_float(rr[0]) + __uint_as_float(rr[1]); }
    l_reg = l_reg * alpha + ps;
#define PK4(P, BASE, OUT) do { unsigned a0 = cvtpk(P[BASE + 0], P[BASE + 1]), a1 = cvtpk(P[BASE + 2], P[BASE + 3]);   \
    unsigned b0 = cvtpk(P[BASE + 4], P[BASE + 5]), b1 = cvtpk(P[BASE + 6], P[BASE + 7]);                              \
    auto r0 = __builtin_amdgcn_permlane32_swap(a0, b0, false, false); auto r1 = __builtin_amdgcn_permlane32_swap(a1, b1, false, false); \
    u32x4 w = {r0[0], r1[0], r0[1], r1[1]}; OUT = __builtin_bit_cast(bf16x8, w); } while (0)
    PK4(p0, 0, pa0); PK4(p0, 8, pa1); PK4(p1, 0, pa2); PK4(p1, 8, pa3);
#undef PK4
}
__device__ __forceinline__ void qkt(f32x16& p0, f32x16& p1, const LAS char* Ks, const bf16x8* qr, int r32, int hi) {
#pragma unroll
    for (int r = 0; r < 16; ++r) { p0[r] = 0.f; p1[r] = 0.f; }
#pragma unroll
    for (int d0 = 0; d0 < 12; ++d0) { const int cb = (d0 * 16 + hi * 8) * 2;
        const bf16x8 b0 = *(const LAS bf16x8*)(Ks + r32 * KROW + cb);
        const bf16x8 b1 = *(const LAS bf16x8*)(Ks + (32 + r32) * KROW + cb);
        p0 = __builtin_amdgcn_mfma_f32_32x32x16_bf16(b0, qr[d0], p0, 0, 0, 0);
        p1 = __builtin_amdgcn_mfma_f32_32x32x16_bf16(b1, qr[d0], p1, 0, 0, 0); }
}
__device__ __forceinline__ int v_st(int k, int c) { const int kk = (k & ~0xC) | ((k & 4) << 1) | ((k & 8) >> 1); return ((kk >> 3) * 4 + (c >> 5)) * 512 + ((kk & 7) * 32 + (c & 31)) * 2; }
__device__ __forceinline__ int v_rd_base(int lane) { return ((lane & 3) << 3) | (((lane >> 2) & 3) << 6) | (((lane >> 4) & 1) << 5) | (((lane >> 5) & 1) << 8); }
constexpr int v_rd_off(int d0, int ks, int half) { return d0 * 512 + ks * 4096 + half * 2048; }
template <int OFF> __device__ __forceinline__ s16x4 tr_read(int vb) { s16x4 r; asm volatile("ds_read_b64_tr_b16 %0, %1 offset:%2" : "=&v"(r) : "v"(vb), "i"(OFF) : "memory"); return r; }
template <int D0> __device__ __forceinline__ void pv_one(f32x16& od, int vb, bf16x8 pa0, bf16x8 pa1, bf16x8 pa2, bf16x8 pa3) {
    const s16x4 l0 = tr_read<v_rd_off(D0, 0, 0)>(vb), h0 = tr_read<v_rd_off(D0, 0, 1)>(vb), l1 = tr_read<v_rd_off(D0, 1, 0)>(vb), h1 = tr_read<v_rd_off(D0, 1, 1)>(vb);
    const s16x4 l2 = tr_read<v_rd_off(D0, 2, 0)>(vb), h2 = tr_read<v_rd_off(D0, 2, 1)>(vb), l3 = tr_read<v_rd_off(D0, 3, 0)>(vb), h3 = tr_read<v_rd_off(D0, 3, 1)>(vb);
    asm volatile("s_waitcnt lgkmcnt(0)" ::: "memory"); SBAR();
#define PKV(L, H) (bf16x8){L[0], L[1], L[2], L[3], H[0], H[1], H[2], H[3]}
    od = __builtin_amdgcn_mfma_f32_32x32x16_bf16(pa0, PKV(l0, h0), od, 0, 0, 0);
    od = __builtin_amdgcn_mfma_f32_32x32x16_bf16(pa1, PKV(l1, h1), od, 0, 0, 0);
    od = __builtin_amdgcn_mfma_f32_32x32x16_bf16(pa2, PKV(l2, h2), od, 0, 0, 0);
    od = __builtin_amdgcn_mfma_f32_32x32x16_bf16(pa3, PKV(l3, h3), od, 0, 0, 0);
#undef PKV
}
__device__ __forceinline__ void pv_d0(f32x16* o, int vb, bf16x8 pa0, bf16x8 pa1, bf16x8 pa2, bf16x8 pa3) {
    pv_one<0>(o[0], vb, pa0, pa1, pa2, pa3); pv_one<1>(o[1], vb, pa0, pa1, pa2, pa3); pv_one<2>(o[2], vb, pa0, pa1, pa2, pa3); pv_one<3>(o[3], vb, pa0, pa1, pa2, pa3);
}

__device__ __forceinline__ void attn_unit(int s, int h, int qb, const bf16_t* __restrict__ MQ, const bf16_t* __restrict__ MKV, const bf16_t* __restrict__ KR, bf16_t* __restrict__ MIX, LAS char* lds) {
    int tid_ = threadIdx.x; asm volatile("" : "+v"(tid_));
    const int tid = tid_, wid = tid >> 6, lane = tid & 63, r32 = lane & 31, hi = lane >> 5;
    LAS char* V_lds = lds + OFF_V; LAS char* K_lds = lds + OFF_K;
    LAS float* wsf = (LAS float*)(lds + OFF_WS) + wid * 64; LAS float* li_l = wsf; LAS float* al_l = wsf + 32;
    float m_reg = NEGBIG, l_reg = 0; f32x16 o[4]; bf16x8 qr[12];
#pragma unroll
    for (int d = 0; d < 4; ++d)
#pragma unroll
        for (int r = 0; r < 16; ++r) o[d][r] = 0.f;
    const int qi = wid * QBLK + r32;
    const unsigned qrow = qb < 16 ? (unsigned)s * LREAL + 256 * qb + qi : (unsigned)MROW0 + 16 * s + (qi < 15 ? qi : 15);
    { const bf16_t* Qw = MQ + (qrow * NQ + h * 192 + hi * 8);
#pragma unroll
      for (int d0 = 0; d0 < 12; ++d0) qr[d0] = *(const bf16x8*)(Qw + d0 * 16); }
    const int sr = tid >> 4, sc = (tid & 15) * 8, vst0 = v_st(sr, sc), vst1 = v_st(32 + sr, sc);
    const int kr_r = tid >> 3, kr_c = (tid & 7) * 8;
    const int vb0 = (int)(uintptr_t)V_lds + v_rd_base(lane);
    bf16x8 vs0, vs1, ks0, ks1, kr0;
    const unsigned mainrow0 = (unsigned)s * LREAL, metarow0 = (unsigned)MROW0 + 16 * s;
    const bf16_t* MKVh = MKV + h * 256;
#define KROWG(kt, k) ((kt) < 64 ? mainrow0 + 64u * (kt) + (k) : metarow0 + ((k) < 15 ? (k) : 15))
#define SLOAD(kt) do { const unsigned g0 = KROWG(kt, sr) * NKV + sc, g1 = KROWG(kt, 32 + sr) * NKV + sc, g2 = KROWG(kt, kr_r) * 64 + kr_c; \
    vs0 = *(const bf16x8*)(MKVh + 128 + g0); vs1 = *(const bf16x8*)(MKVh + 128 + g1); \
    ks0 = *(const bf16x8*)(MKVh + g0); ks1 = *(const bf16x8*)(MKVh + g1); kr0 = *(const bf16x8*)(KR + g2); } while (0)
#define SWRITE(b) do { *(LAS bf16x8*)(V_lds + (b) * SHM_V + vst0) = vs0; *(LAS bf16x8*)(V_lds + (b) * SHM_V + vst1) = vs1; \
    *(LAS bf16x8*)(K_lds + (b) * SHM_K + sr * KROW + sc * 2) = ks0; *(LAS bf16x8*)(K_lds + (b) * SHM_K + (32 + sr) * KROW + sc * 2) = ks1; \
    *(LAS bf16x8*)(K_lds + (b) * SHM_K + kr_r * KROW + 256 + kr_c * 2) = kr0; } while (0)
#define RESC(a) do { if (__any((a) < 1.f)) { if (hi == 0) al_l[r32] = (a); asm volatile("s_waitcnt lgkmcnt(0)" ::: "memory"); \
    _Pragma("unroll") for (int d = 0; d < 4; ++d) _Pragma("unroll") for (int r = 0; r < 16; ++r) o[d][r] *= al_l[crow(r, hi)]; } } while (0)
    f32x16 pA0, pA1, pB0, pB1; float mnA, mnB, alA, alB; bf16x8 pa0, pa1, pa2, pa3;
    __syncthreads();
    SLOAD(0); SWRITE(0); __syncthreads();
    qkt(pA0, pA1, K_lds, qr, r32, hi); partialSM<false>(pA0, pA1, m_reg, mnA, alA);
    SLOAD(1); SWRITE(1); __syncthreads();
    RESC(alA);
    int s0 = 0, s1 = 1, s2 = 2;
    for (int j = 1; j + 1 < NT; j += 2) {
        SBAR(); qkt(pB0, pB1, K_lds + s1 * SHM_K, qr, r32, hi);
        finishSM(pA0, pA1, alA, l_reg, pa0, pa1, pa2, pa3); SBAR();
        SLOAD(j + 1); SBAR();
        pv_d0(o, vb0 + s0 * SHM_V, pa0, pa1, pa2, pa3); partialSM<false>(pB0, pB1, m_reg, mnB, alB);
        SWRITE(s2);
        RESC(alB); __syncthreads();
        SBAR(); qkt(pA0, pA1, K_lds + s2 * SHM_K, qr, r32, hi);
        finishSM(pB0, pB1, alB, l_reg, pa0, pa1, pa2, pa3); SBAR();
        if (j + 2 < NT) SLOAD(j + 2); SBAR();
        pv_d0(o, vb0 + s1 * SHM_V, pa0, pa1, pa2, pa3);
        if (j + 1 == NT - 1) partialSM<true>(pA0, pA1, m_reg, mnA, alA); else partialSM<false>(pA0, pA1, m_reg, mnA, alA);
        if (j + 2 < NT) SWRITE(s0);
        RESC(alA); __syncthreads();
        { const int t0 = s0, t1 = s1; s0 = s2; s1 = t0; s2 = t1; }
    }
    finishSM(pA0, pA1, alA, l_reg, pa0, pa1, pa2, pa3); SBAR();
    pv_d0(o, vb0 + s0 * SHM_V, pa0, pa1, pa2, pa3);
    if (hi == 0) li_l[r32] = l_reg; asm volatile("s_waitcnt lgkmcnt(0)" ::: "memory");
    float rli[16];
#pragma unroll
    for (int r = 0; r < 16; ++r) rli[r] = __builtin_amdgcn_rcpf(li_l[crow(r, hi)]);
    if (qb < 16) {
        bf16_t* Ow = MIX + ((long)s * LREAL + 256 * qb + wid * QBLK) * DM + MLW + h * 128;
#pragma unroll
        for (int r = 0; r < 16; ++r) { const int orow = crow(r, hi);
#pragma unroll
            for (int d0 = 0; d0 < 4; ++d0) Ow[(long)orow * DM + d0 * 32 + r32] = (bf16_t)(pk2(o[d0][r] * rli[r], 0.f) & 0xffffu); }
    } else if (wid == 0) {
        bf16_t* Ow = MIX + ((long)MROW0 + 16 * s) * DM + MLW + h * 128;
#pragma unroll
        for (int r = 0; r < 16; ++r) { const int orow = crow(r, hi);
            if (orow < 16) {
#pragma unroll
                for (int d0 = 0; d0 < 4; ++d0) Ow[(long)orow * DM + d0 * 32 + r32] = (bf16_t)(pk2(o[d0][r] * rli[r], 0.f) & 0xffffu); } }
    }
#undef KROWG
#undef SLOAD
#undef SWRITE
#undef RESC
}
__device__ __forceinline__ void attn_phase(int vcu, const bf16_t* MQ, const bf16_t* MKV, const bf16_t* KR, bf16_t* MIX, LAS char* lds) {
    for (int i = (vcu < 96 ? -1 : 0); i < 6; ++i) { int sh, qb; if (i < 0) { sh = vcu; qb = 16; } else { const int id = i * GRID + vcu; sh = id >> 4; qb = id & 15; }
        attn_unit(sh >> 3, sh & 7, qb, MQ, MKV, KR, MIX, lds); }
}
#undef SBAR
}

namespace ml {
constexpr int QI = 0, KI = 32768, VI = 65536, SI = 81920, CI = 98304;
constexpr int SC_CT = 0, SC_BM = 64, SC_WI = 128, SC_EI = 192, SC_WW = 256, SC_DEN = 320, SC_QN = 448, SC_N = 512, SC_A = 768;
constexpr int GP_REC = 200;
__device__ __forceinline__ unsigned off_b(unsigned row, unsigned ch) { return 256u * row + 16u * (ch ^ (((row & 3) << 2) | ((row >> 2) & 3))); }
__device__ __forceinline__ unsigned row_read_addr_16(unsigned lane, unsigned rb, unsigned s) { return off_b((lane & 15) + 16 * rb, 4 * s + (lane >> 4)); }
__device__ __forceinline__ unsigned tr_read_addr_16(unsigned lane, unsigned c, unsigned ks, unsigned t) {
    const unsigned g = lane >> 4, q = (lane & 15) >> 2, p = lane & 3; return off_b(32 * ks + 8 * g + 4 * t + q, 2 * c + (p >> 1)) + 8 * (p & 1); }
__device__ __forceinline__ bf16x8 tr_frag(unsigned a0, unsigned a1) {
    const s16x4 lo = __builtin_amdgcn_ds_read_tr16_b64_v4i16((LAS s16x4*)a0), hi = __builtin_amdgcn_ds_read_tr16_b64_v4i16((LAS s16x4*)a1);
    return (bf16x8){lo[0], lo[1], lo[2], lo[3], hi[0], hi[1], hi[2], hi[3]};
}
__device__ __forceinline__ f32x4 mfma16(bf16x8 a, bf16x8 b, f32x4 c) { return __builtin_amdgcn_mfma_f32_16x16x32_bf16(a, b, c, 0, 0, 0); }
__device__ __forceinline__ float log_sigmoid(float x) { return fminf(x, 0.f) - __logf(1.f + __expf(-fabsf(x))); }

__device__ __forceinline__ void gate_prep(int gw, int ngw, int lane, const float* __restrict__ GATES, const float* __restrict__ bgl, float* __restrict__ GP) {
    for (int it = gw; it < 96 * 65; it += ngw) {
        const int chain = it / 65, c = it % 65, s = chain >> 3, hd = (chain >> 1) & 3, dir = chain & 1;
        const long g = c == 0 ? (lane >= 48 ? (long)MROW0 + 16 * s + lane - 48 : -1L) : (long)s * LREAL + 64 * (c - 1) + lane;
        float li = NEGBIG, lf = 0.f;
        if (g >= 0) { li = GATES[g * 16 + (dir ? 8 : 0) + hd] + bgl[(dir ? 8 : 0) + hd]; lf = log_sigmoid(GATES[g * 16 + (dir ? 12 : 4) + hd] + bgl[(dir ? 12 : 4) + hd]); }
        float x = dir ? __shfl(lf, 63 - lane) : lf;
#pragma unroll
        for (int o = 1; o < 64; o <<= 1) { const float y = __shfl_up(x, o); if (lane >= o) x += y; }
        const float btot = __shfl(x, 63);
        const float b = dir ? __shfl(x, 63 - lane) : x;
        const float a_s = li - b;
        float pm = dir ? __shfl(a_s, 63 - lane) : a_s;
#pragma unroll
        for (int o = 1; o < 64; o <<= 1) { const float y = __shfl_up(pm, o); if (lane >= o) pm = fmaxf(pm, y); }
        pm = dir ? __shfl(pm, 63 - lane) : pm;
        const float gmax = wave_max(btot - b + li);
        float* rec = GP + (size_t)it * GP_REC;
        rec[lane] = b; rec[64 + lane] = li; rec[128 + lane] = pm; if (lane == 0) { rec[192] = btot; rec[193] = gmax; }
    }
}

__device__ __forceinline__ void mlstm_unit(int s, int hd, int js, const bf16_t* __restrict__ UQKVO, const float* __restrict__ GP, float* __restrict__ HSUM, LAS unsigned char* lds, LAS float* sc) {
    const int wid = __builtin_amdgcn_readfirstlane((int)threadIdx.x >> 6);
    const unsigned ldsb = (unsigned)(uintptr_t)lds;
    const int tt = wid >> 1, nb = 2 * (wid & 1);
#define ROWRD(img, rb, s_) (*(const LAS bf16x8*)(uintptr_t)(RB[s_] + (unsigned)((img) + 4096 * (rb))))
#define TRFRAG(img, c_, ks) tr_frag(BT[0][(c_) & 1] + TQ[(c_) >> 1] + (unsigned)((img) + 8192 * (ks)), BT[1][(c_) & 1] + TQ[(c_) >> 1] + (unsigned)((img) + 8192 * (ks)))
    f32x4 accC[2][4], accN[2];
    for (int dir = 0; dir < 2; ++dir) {
        int tid; { int t0_ = threadIdx.x; asm volatile("" : "+v"(t0_)); tid = t0_; }
#pragma unroll
        for (int mi = 0; mi < 2; ++mi)
#pragma unroll
            for (int c = 0; c < 4; ++c) accC[mi][c] = (f32x4){0.f, 0.f, 0.f, 0.f};
        accN[0] = (f32x4){0.f, 0.f, 0.f, 0.f}; accN[1] = (f32x4){0.f, 0.f, 0.f, 0.f};
        if (tid < 256) sc[SC_N + tid] = 0.f;
        for (int i = tid; i < 32768 / 16; i += 512) *(LAS u32x4*)(lds + CI + i * 16) = (u32x4){0u, 0u, 0u, 0u};
        float m_state = 0.f;
        const float* GPc = GP + (size_t)(((s * 4 + hd) * 2 + dir) * 65) * GP_REC;
        u32x4 sq[4], sk[4], sv; float sb = 0.f, sli = NEGBIG, spm = NEGBIG, sbt = 0.f, sgm = NEGBIG;
#define ROWG(c, r) ((c) == 0 ? ((r) >= 48 ? (long)MROW0 + 16 * s + (r) - 48 : -1L) : (long)s * LREAL + 64 * ((c) - 1) + (r))
#define STAGE_LOAD(c) do { \
        _Pragma("unroll") for (int i = 0; i < 4; ++i) { const int id = tid + 512 * i, r = id >> 5, ch = id & 31; const long g = ROWG(c, r); \
            sq[i] = (u32x4){0u, 0u, 0u, 0u}; sk[i] = (u32x4){0u, 0u, 0u, 0u}; \
            if (g >= 0) { sq[i] = *(const u32x4*)(UQKVO + g * 4096 + hd * 256 + ch * 8); sk[i] = *(const u32x4*)(UQKVO + g * 4096 + 1024 + hd * 256 + ch * 8); } } \
        { const int r = tid >> 3, ch = tid & 7; const long g = ROWG(c, r); sv = (u32x4){0u, 0u, 0u, 0u}; if (g >= 0) sv = *(const u32x4*)(UQKVO + g * 4096 + 2048 + hd * 256 + js * 64 + ch * 8); } \
        if (tid < 64) { const float* rec = GPc + (size_t)(c) * GP_REC; sb = rec[tid]; sli = rec[64 + tid]; spm = rec[128 + tid]; sbt = rec[192]; sgm = rec[193]; } } while (0)
#define STAGE_WRITE() do { \
        _Pragma("unroll") for (int i = 0; i < 4; ++i) { const int id = tid + 512 * i, r = id >> 5, ch = id & 31; \
            *(LAS u32x4*)(lds + QI + (ch >> 4) * 16384 + off_b(r, ch & 15)) = sq[i]; *(LAS u32x4*)(lds + KI + (ch >> 4) * 16384 + off_b(r, ch & 15)) = sk[i]; } \
        { const int r = tid >> 3, ch = tid & 7; *(LAS u32x4*)(lds + VI + off_b(r, ch)) = sv; } \
        if (tid < 64) { const float m_inter = sb + m_state, mt = fmaxf(m_inter, sb + spm); const float m_new = fmaxf(sbt + m_state, sgm); \
            sc[SC_CT + tid] = sli - sb; sc[SC_BM + tid] = sb - mt; sc[SC_WI + tid] = __expf(m_inter - mt); sc[SC_EI + tid] = __expf(-mt); \
            sc[SC_WW + tid] = __expf(sbt - sb + sli - m_new) * 0.0625f; if (tid == 0) sc[SC_A] = __expf(sbt + m_state - m_new); m_state = m_new; } } while (0)
        const int c_first = dir ? 64 : 0, c_step = dir ? -1 : 1;
        STAGE_LOAD(c_first);
        __syncthreads();
        STAGE_WRITE();
        for (int ci = 0; ci < 65; ++ci) {
            const int c = c_first + c_step * ci;
            { int t2_ = threadIdx.x; asm volatile("" : "+v"(t2_)); tid = t2_; }
            const int lane = tid & 63, l15 = lane & 15, lg = lane >> 4;
            unsigned RB[4], BT[2][2], TQ[4];
            { const unsigned fl = ((l15 & 3) << 2) | (l15 >> 2), q = l15 >> 2, p = lane & 3, g = lg;
#pragma unroll
              for (int s_ = 0; s_ < 4; ++s_) { RB[s_] = ldsb + 256u * l15 + 16u * (lg ^ (fl & 3)) + 64u * (s_ ^ (fl >> 2)); TQ[s_] = 64u * (s_ ^ q); }
#pragma unroll
              for (int t_ = 0; t_ < 2; ++t_)
#pragma unroll
                  for (int cl = 0; cl < 2; ++cl) BT[t_][cl] = ldsb + 256u * (8 * g + q) + 8u * (p & 1) + 1024u * t_ + 16u * ((p >> 1) ^ t_) + 32u * (cl ^ (g & 1)); }
            __syncthreads();
            if (ci + 1 < 65) STAGE_LOAD(c + c_step);
            bf16x8 qf[8];
#pragma unroll
            for (int k = 0; k < 8; ++k) qf[k] = ROWRD(QI + (k >> 2) * 16384, tt, k & 3);
            f32x4 sT[2], oc[2];
#pragma unroll
            for (int i = 0; i < 2; ++i) { sT[i] = (f32x4){0.f, 0.f, 0.f, 0.f}; oc[i] = (f32x4){0.f, 0.f, 0.f, 0.f}; }
#pragma unroll
            for (int i = 0; i < 2; ++i)
#pragma unroll
                for (int k = 0; k < 8; ++k) {
                    const bf16x8 kf = ROWRD(KI + (k >> 2) * 16384, nb + i, k & 3);
                    sT[i] = mfma16(kf, qf[k], sT[i]);
                    const bf16x8 cf = ROWRD(CI + (k >> 2) * 16384, nb + i, k & 3);
                    oc[i] = mfma16(qf[k], cf, oc[i]);
                }
            {
                const int t = 16 * tt + l15; const float bmt = sc[SC_BM + t]; float rs = 0.f;
#pragma unroll
                for (int i = 0; i < 2; ++i) { const int s0 = 16 * (nb + i) + 4 * lg; const f32x4 ctv = *(const LAS f32x4*)(sc + SC_CT + s0); float v[4];
#pragma unroll
                    for (int e = 0; e < 4; ++e) { const int sx = s0 + e; const bool ok = dir ? (sx >= t) : (sx <= t);
                        const float ex = ok ? (bmt + ctv[e]) : NEGBIG; v[e] = sT[i][e] * 0.0625f * __expf(ex); rs += v[e]; }
                    u32x2 w; w.x = pk2(v[0], v[1]); w.y = pk2(v[2], v[3]);
                    *(LAS u32x2*)(lds + SI + off_b(t, s0 >> 3) + (s0 & 7) * 2) = w; }
                rs += __shfl_xor(rs, 16); rs += __shfl_xor(rs, 32);
                if (lg == 0) sc[SC_DEN + 64 * (wid & 1) + t] = rs;
            }
            { const int r = tid >> 3, ch = tid & 7; const u32x4 v = *(const LAS u32x4*)(lds + VI + off_b(r, ch)); const float w = sc[SC_WW + r]; u32x4 o;
#pragma unroll
              for (int jx = 0; jx < 4; ++jx) o[jx] = pk2(bf_lo(v[jx]) * w, bf_hi(v[jx]) * w);
              *(LAS u32x4*)(lds + VI + off_b(r, 8 + ch)) = o; }
            { const int r = tid >> 3, part = tid & 7; float d = 0.f;
#pragma unroll
              for (int i = 0; i < 4; ++i) { const int ch32 = part * 4 + i; const u32x4 v = *(const LAS u32x4*)(lds + QI + (ch32 >> 4) * 16384 + off_b(r, ch32 & 15));
                  const f32x4 n0 = *(const LAS f32x4*)(sc + SC_N + ch32 * 8), n1 = *(const LAS f32x4*)(sc + SC_N + ch32 * 8 + 4);
                  d += bf_lo(v[0]) * n0[0] + bf_hi(v[0]) * n0[1] + bf_lo(v[1]) * n0[2] + bf_hi(v[1]) * n0[3] + bf_lo(v[2]) * n1[0] + bf_hi(v[2]) * n1[1] + bf_lo(v[3]) * n1[2] + bf_hi(v[3]) * n1[3]; }
              d += __shfl_xor(d, 1); d += __shfl_xor(d, 2); d += __shfl_xor(d, 4);
              if (part == 0) sc[SC_QN + r] = d; }
            { const f32x4 wi = *(const LAS f32x4*)(sc + SC_WI + 16 * tt + 4 * lg);
#pragma unroll
              for (int i = 0; i < 2; ++i) oc[i] = oc[i] * wi; }
            __syncthreads();
            const float a_dec = sc[SC_A];
#pragma unroll
            for (int ks = 0; ks < 2; ++ks) { const bf16x8 sf = ROWRD(SI, tt, ks);
#pragma unroll
                for (int i = 0; i < 2; ++i) { const bf16x8 vf = TRFRAG(VI, nb + i, ks);
                    oc[i] = mfma16(sf, vf, oc[i]); } }
            { const int t0 = 16 * tt + 4 * lg;
              const f32x4 wi = *(const LAS f32x4*)(sc + SC_WI + t0), qn = *(const LAS f32x4*)(sc + SC_QN + t0), d0 = *(const LAS f32x4*)(sc + SC_DEN + t0), d1 = *(const LAS f32x4*)(sc + SC_DEN + 64 + t0), ei = *(const LAS f32x4*)(sc + SC_EI + t0);
#pragma unroll
              for (int e = 0; e < 4; ++e) { const long g = ROWG(c, t0 + e);
                const float den = wi[e] * qn[e] + (d0[e] + d1[e]); const float inv = 1.f / fmaxf(fabsf(den), ei[e]);
                if (g >= 0) {
#pragma unroll
                    for (int i = 0; i < 2; ++i) { float* hp = HSUM + g * MLW + hd * 256 + js * 64 + 16 * (nb + i) + l15; const float hv = oc[i][e] * inv; if (dir) unsafeAtomicAdd(hp, hv); else *hp = hv; } } } }
#pragma unroll
            for (int mi = 0; mi < 2; ++mi)
#pragma unroll
                for (int cc = 0; cc < 4; ++cc) accC[mi][cc] = accC[mi][cc] * a_dec;
            accN[0] = accN[0] * a_dec; accN[1] = accN[1] * a_dec;
            const unsigned ktq = (unsigned)(KI + (wid >> 2) * 16384) + 64u * ((unsigned)(wid & 3) ^ (unsigned)(l15 >> 2));
#pragma unroll
            for (int ks = 0; ks < 2; ++ks) {
                bf16x8 kf[2], wf[4];
#pragma unroll
                for (int mi = 0; mi < 2; ++mi) kf[mi] = tr_frag(BT[0][mi] + ktq + (unsigned)(8192 * ks), BT[1][mi] + ktq + (unsigned)(8192 * ks));
#pragma unroll
                for (int cc = 0; cc < 4; ++cc) wf[cc] = TRFRAG(VI, 4 + cc, ks);
                { const f32x4 wa = *(const LAS f32x4*)(sc + SC_WW + 32 * ks + 8 * lg), wb = *(const LAS f32x4*)(sc + SC_WW + 32 * ks + 8 * lg + 4);
                  u32x4 wq; wq.x = pk2(wa[0], wa[1]); wq.y = pk2(wa[2], wa[3]); wq.z = pk2(wb[0], wb[1]); wq.w = pk2(wb[2], wb[3]);
                  if (l15 != 0) wq = (u32x4){0u, 0u, 0u, 0u};
                  const bf16x8 wfn = __builtin_bit_cast(bf16x8, wq);
#pragma unroll
                  for (int mi = 0; mi < 2; ++mi) accN[mi] = mfma16(kf[mi], wfn, accN[mi]); }
#pragma unroll
                for (int mi = 0; mi < 2; ++mi)
#pragma unroll
                    for (int cc = 0; cc < 4; ++cc) accC[mi][cc] = mfma16(kf[mi], wf[cc], accC[mi][cc]);
            }
#pragma unroll
            for (int mi = 0; mi < 2; ++mi)
#pragma unroll
                for (int cc = 0; cc < 4; ++cc) { const int dk0 = 32 * wid + 16 * mi + 4 * lg, dv = 16 * cc + l15; u32x2 w; w.x = pk2(accC[mi][cc][0], accC[mi][cc][1]); w.y = pk2(accC[mi][cc][2], accC[mi][cc][3]);
                    *(LAS u32x2*)(lds + CI + (dk0 >> 7) * 16384 + off_b(dv, (dk0 & 127) >> 3) + (dk0 & 7) * 2) = w; }
            if (l15 == 0) { *(LAS f32x4*)(sc + SC_N + 32 * wid + 4 * lg) = accN[0]; *(LAS f32x4*)(sc + SC_N + 32 * wid + 16 + 4 * lg) = accN[1]; }
            __syncthreads();
            if (ci + 1 < 65) STAGE_WRITE();
        }
    }
#undef ROWG
#undef STAGE_LOAD
#undef STAGE_WRITE
#undef ROWRD
#undef TRFRAG
}
__device__ __forceinline__ void mlstm_phase(int bx, const bf16_t* UQKVO, const float* GP, float* HSUM, LAS unsigned char* lds, LAS float* sc) {
    if (bx >= 192) return;
    const int xcd = bx & 7, idx = bx >> 3, pair = xcd * 6 + (idx >> 2), js = idx & 3;
    mlstm_unit(pair >> 2, pair & 3, js, UQKVO, GP, HSUM, lds, sc);
}
}

#ifndef PHM
#define PHM 0xffff
#endif
#ifndef REP_ML
#define REP_ML 1
#endif
#ifndef REP_ATTN
#define REP_ATTN 1
#endif
#ifndef REP_CONV
#define REP_CONV 1
#endif
#ifndef REP_SMALL
#define REP_SMALL 1
#endif
#ifndef KV_SPLIT
#define KV_SPLIT 193
#endif
#ifndef REP_WIN
#define REP_WIN 1
#endif
#ifndef REP_UP
#define REP_UP 1
#endif
__global__ void __launch_bounds__(512, 2) fwd_kernel(Params P, unsigned char* ws_arg, unsigned char* out_arg) {
    extern __shared__ __attribute__((aligned(16))) unsigned char lds_raw[];
    Frame F;
    F.lds = (LAS unsigned char*)lds_raw;
    F.tid = threadIdx.x; F.lane = F.tid & 63; F.wave = __builtin_amdgcn_readfirstlane(F.tid >> 6);
    F.G = GRID; F.bx = blockIdx.x; F.vcu = (F.bx % 8) * (GRID / 8) + F.bx / 8;
    F.gw = F.vcu * 8 + F.wave; F.ngw = F.G * 8;
    { unsigned char* ws0 = ws_arg;
      for (int u = F.tid; u < (LDS_BYTES - MISC_OFF) / 4; u += 512) ((LAS unsigned*)(F.lds + MISC_OFF))[u] = 0u;
      __syncthreads();
      (void)ws0; }
    LAS unsigned long long* ptab = (LAS unsigned long long*)(F.lds + MISC_OFF + 64);
    if (F.tid == 0) {
#pragma unroll
        for (int k = 0; k < 19; ++k) ptab[k] = (unsigned long long)(uintptr_t)P.in[k]; }
    __syncthreads();
    XcdBarrier bar = xcd_barrier_post((unsigned*)(ws_arg + WS_CTL) + CW_BAR, (volatile LAS unsigned*)(F.lds + MISC_OFF));
    LAS float* sc = (LAS float*)(F.lds + MISC_OFF + 1024);
#define BXL() ({ int b__ = F.bx; asm volatile("" : "+s"(b__)); b__; })
#define PFRAME() Frame Fp = F; { int t_ = threadIdx.x; asm volatile("" : "+v"(t_)); Fp.tid = t_; Fp.lane = t_ & 63; int b_ = BXL(); Fp.bx = b_; Fp.vcu = (b_ % 8) * (GRID / 8) + b_ / 8; Fp.gw = Fp.vcu * 8 + Fp.wave; }
#define WSB() ({ GAS unsigned char* w__ = (GAS unsigned char*)ws_arg; asm volatile("" : "+s"(w__)); (unsigned char*)w__; })
#ifndef STAG_N
#define STAG_N 1
#endif
#ifdef STAG_ON
#define STAGGER() do { int s__ = (BXL() * 37) & 255; for (int i__ = 0; i__ < s__; ++i__) __builtin_amdgcn_s_sleep(STAG_N); } while (0)
#else
#define STAGGER() do {} while (0)
#endif
#define WOFS(l_) (((l_) & 1) ? WSET_DELTA : (size_t)0)
#define DOB() ({ GAS unsigned char* w__ = (GAS unsigned char*)out_arg; asm volatile("" : "+s"(w__)); (unsigned char*)w__; })

    { unsigned char* ws = WSB(); prologue(F, ws, ptab); convert_weights(F, ws, ptab, 0, 0, -1); }
    xcd_barrier(bar);

    for (int l = 0; l < DEPTH; ++l) {
        { unsigned char* ws = WSB();
          pg8::Gemm g{(bf16_t*)(ws + WS_HB), (bf16_t*)(ws + WOFS(l) + WS_WIN), TP, NIN, DM, DM}; pg8::PanelOrder S; S.init(NPAN, 0, 0, 0, NIN, F.G, BXL());
          pg8::EpiWin E{(bf16_t*)(ws + WS_UQKVO), (bf16_t*)(ws + WS_UDQ), (bf16_t*)(ws + WS_UDKV), (bf16_t*)(ws + WS_KR), (float*)(ws + WS_GATES), (const float*)(ws + WS_COS), (const float*)(ws + WS_SIN)};
#if PHM & 2
          STAGGER(); pg8::gemm_phase<pg8::EpiWin, pg8::PanelOrder, true, true>(F.lds, g, S, E);
#endif
        }
        if (l + 1 < DEPTH && BXL() >= 20) { unsigned char* ws = WSB(); PFRAME(); Fp.gw = (Fp.bx - 20) * 8 + Fp.wave; Fp.ngw = (GRID - 20) * 8; convert_weights(Fp, ws, ptab, l + 1, WOFS(l + 1), 0); }
#if REP_WIN > 1
        __syncthreads();
        { unsigned char* ws = WSB();
          pg8::Gemm g{(bf16_t*)(ws + WS_HB), (bf16_t*)(ws + WOFS(l) + WS_WIN), TP, NIN, DM, DM}; pg8::PanelOrder S; S.init(NPAN, 0, 0, 0, NIN, F.G, BXL());
          pg8::EpiWin E{(bf16_t*)(ws + WS_UQKVO), (bf16_t*)(ws + WS_UDQ), (bf16_t*)(ws + WS_UDKV), (bf16_t*)(ws + WS_KR), (float*)(ws + WS_GATES), (const float*)(ws + WS_COS), (const float*)(ws + WS_SIN)};
          pg8::gemm_phase<pg8::EpiWin, pg8::PanelOrder, true, true>(F.lds, g, S, E);
        }
#endif
        xcd_barrier(bar);
        { unsigned char* ws = WSB(); unsigned char* dob = DOB(); PFRAME(); rstd_rows(Fp, (bf16_t*)(ws + WS_UDQ), (bf16_t*)(ws + WS_UDKV), (float*)(ws + WS_RSTD));
          ml::gate_prep(Fp.gw, Fp.ngw, Fp.lane, (const float*)(ws + WS_GATES), (const float*)(ws + WS_PAR) + PO_BG + l * 16, (float*)(dob + DO_GP)); }
#if REP_SMALL > 1
        { unsigned char* ws = WSB(); unsigned char* dob = DOB(); PFRAME(); rstd_rows(Fp, (bf16_t*)(ws + WS_UDQ), (bf16_t*)(ws + WS_UDKV), (float*)(ws + WS_RSTD));
          ml::gate_prep(Fp.gw, Fp.ngw, Fp.lane, (const float*)(ws + WS_GATES), (const float*)(ws + WS_PAR) + PO_BG + l * 16, (float*)(dob + DO_GP)); }
#endif
        xcd_barrier(bar);
        if (F.bx >= 192) {
        { unsigned char* ws = WSB(); unsigned char* dob = DOB();
          pg8::Gemm g{(bf16_t*)(ws + WS_UDQ), (bf16_t*)(ws + WOFS(l) + WS_WUQ), TP, NQ, 512, 512}; pg8::PanelOrder S; S.init(NPAN, 0, 0, 0, NQ, GRID - 192, BXL() - 192);
          pg8::EpiQ E{(bf16_t*)(dob + DO_MQ), (const float*)(ws + WS_RSTD), (const float*)(ws + WS_COS), (const float*)(ws + WS_SIN)};
#if PHM & 4
          pg8::gemm_phase<pg8::EpiQ, pg8::PanelOrder, true, true>(F.lds, g, S, E);
#endif
        }
        { unsigned char* ws = WSB();
          pg8::Gemm g{(bf16_t*)(ws + WS_UDKV), (bf16_t*)(ws + WOFS(l) + WS_WUKV), TP, NKV, 256, 256}; pg8::PanelOrder S; S.init(NPAN, 0, 0, 0, NKV, GRID - 192, BXL() - 192);
          pg8::EpiBf16G E{(bf16_t*)(ws + WS_MKV), NKV, (const float*)(ws + WS_RSTD) + 1, 0, -1, 0};
#if PHM & 8
          pg8::gemm_phase<pg8::EpiBf16G, pg8::PanelOrder, true, true>(F.lds, g, S, E);
#endif
        }
        } else {
#ifndef NO_ML
        for (int rep_ = 0; rep_ < REP_ML; ++rep_)
        { unsigned char* ws = WSB(); unsigned char* dob = DOB();
          ml::mlstm_phase(BXL(), (const bf16_t*)(ws + WS_UQKVO), (const float*)(dob + DO_GP), (float*)(dob + DO_HSUM), F.lds, sc); }
#endif
        }
        xcd_barrier(bar);
        { unsigned char* ws = WSB(); unsigned char* dob = DOB(); PFRAME();
          if (Fp.vcu >= 96) mlstm_finalize(Fp, (Fp.vcu - 96) * 8 + Fp.wave, (GRID - 96) * 8, (const float*)(dob + DO_HSUM), (const bf16_t*)(ws + WS_UQKVO), (const float*)(ws + WS_PAR) + PO_MLG + l * MLW, (bf16_t*)(ws + WS_HB)); }
#ifndef NO_ATTN
        for (int rep_ = 0; rep_ < REP_ATTN; ++rep_)
        { unsigned char* ws = WSB(); unsigned char* dob = DOB();
          att::attn_phase(({ int b__ = BXL(); (b__ % 8) * (GRID / 8) + b__ / 8; }), (const bf16_t*)(dob + DO_MQ), (const bf16_t*)(ws + WS_MKV), (const bf16_t*)(ws + WS_KR), (bf16_t*)(ws + WS_HB), (LAS char*)F.lds); }
#endif
        xcd_barrier(bar);
        { unsigned char* ws = WSB();
          pg8::Gemm g{(bf16_t*)(ws + WS_HB), (bf16_t*)(ws + WOFS(l) + WS_WOUT), TP, DM, DM, DM}; pg8::PanelOrder S; S.init(192, 0, 0, 0, DM, F.G, BXL());
          pg8::EpiResidLn E{(bf16_t*)(ws + WS_H), DM, ALPHA, (const float*)(ws + WS_STAT2), (const float*)(ws + WS_PAR) + (l > 0 ? PO_L2G + (l - 1) * DM : PO_ONE), (const float*)(ws + WS_PAR) + (l > 0 ? PO_L2B + (l - 1) * DM : PO_ZERO)};
#if PHM & 16
          STAGGER(); pg8::gemm_phase<pg8::EpiResidLn, pg8::PanelOrder, true, true>(F.lds, g, S, E);
#endif
        }
        { unsigned char* ws = WSB();
          pg8::Gemm g{(bf16_t*)(ws + WS_HB), (bf16_t*)(ws + WOFS(l) + WS_WOUT), TP, DM, DM / 4, DM}; pg8::SplitOrder S; S.init(PMETA, DM, 4, F.G, BXL());
          pg8::EpiPart E{(float*)(ws + WS_PART), DM};
#if PHM & 16
          pg8::gemm_phase<pg8::EpiPart, pg8::SplitOrder, true, true>(F.lds, g, S, E);
#endif
        }
        xcd_barrier(bar);
        { unsigned char* ws = WSB(); PFRAME(); ln_rows(Fp, (float*)(ws + WS_H), (bf16_t*)(ws + WS_HB), (const float*)(ws + WS_PAR) + PO_L1G + l * DM, (const float*)(ws + WS_PAR) + PO_L1B + l * DM, (float*)(ws + WS_STAT1), nullptr, (const float*)(ws + WS_PART), 4); }
        xcd_barrier(bar);
        { unsigned char* ws = WSB(); unsigned char* dob = DOB();
          pg8::Gemm g{(bf16_t*)(ws + WS_HB), (bf16_t*)(ws + WOFS(l) + WS_WUP), TP, NUP, DM, DM}; pg8::PanelOrder S; S.init(NPAN, 0, 0, 0, NUP, F.G, BXL());
          pg8::EpiFfn E{(bf16_t*)(ws + WS_ACT), (float*)(dob + DO_SIDE), (bf16_t*)(dob + DO_GVM), (const float*)(ws + WS_PAR) + PO_CW + (size_t)l * 3 * DFF, (const float*)(ws + WS_PAR) + PO_CB + (size_t)l * DFF, (LAS float*)(F.lds + MISC_OFF + 8192)};
#if PHM & 32
          STAGGER(); pg8::gemm_phase<pg8::EpiFfn, pg8::PanelOrder, true, true>(F.lds, g, S, E);
#if REP_UP > 1
          __syncthreads(); pg8::gemm_phase<pg8::EpiFfn, pg8::PanelOrder, true, true>(F.lds, g, S, E);
#endif
#endif
        }
        if (l + 1 < DEPTH && BXL() >= 44) { unsigned char* ws = WSB(); PFRAME(); Fp.gw = (Fp.bx - 44) * 8 + Fp.wave; Fp.ngw = (GRID - 44) * 8; convert_weights(Fp, ws, ptab, l + 1, WOFS(l + 1), 1); }
        xcd_barrier(bar);
        { unsigned char* ws = WSB(); unsigned char* dob = DOB(); PFRAME();
          ffn_fixup(Fp, (const float*)(dob + DO_SIDE), (const bf16_t*)(dob + DO_GVM), (bf16_t*)(ws + WS_ACT), (const float*)(ws + WS_PAR) + PO_CW + (size_t)l * 3 * DFF, (const float*)(ws + WS_PAR) + PO_CB + (size_t)l * DFF); }
#if REP_SMALL > 1
        { unsigned char* ws = WSB(); unsigned char* dob = DOB(); PFRAME();
          ffn_fixup(Fp, (const float*)(dob + DO_SIDE), (const bf16_t*)(dob + DO_GVM), (bf16_t*)(ws + WS_ACT), (const float*)(ws + WS_PAR) + PO_CW + (size_t)l * 3 * DFF, (const float*)(ws + WS_PAR) + PO_CB + (size_t)l * DFF); }
#endif
        xcd_barrier(bar);
        { unsigned char* ws = WSB();
          pg8::Gemm g{(bf16_t*)(ws + WS_ACT), (bf16_t*)(ws + WOFS(l) + WS_WDN), TP, DM, DFF, DFF}; pg8::PanelOrder S; S.init(192, 0, 0, 0, DM, F.G, BXL());
          pg8::EpiResidLn E{(bf16_t*)(ws + WS_H), DM, ALPHA, (const float*)(ws + WS_STAT1), (const float*)(ws + WS_PAR) + PO_L1G + l * DM, (const float*)(ws + WS_PAR) + PO_L1B + l * DM};
#if PHM & 64
          STAGGER(); pg8::gemm_phase<pg8::EpiResidLn, pg8::PanelOrder, true, true>(F.lds, g, S, E);
#endif
        }
        { unsigned char* ws = WSB();
          pg8::Gemm g{(bf16_t*)(ws + WS_ACT), (bf16_t*)(ws + WOFS(l) + WS_WDN), TP, DM, DFF / 11, DFF}; pg8::SplitOrder S; S.init(PMETA, DM, 11, F.G, BXL());
          pg8::EpiPart E{(float*)(ws + WS_PART), DM};
#if PHM & 64
          pg8::gemm_phase<pg8::EpiPart, pg8::SplitOrder, true, true>(F.lds, g, S, E);
#endif
        }
        xcd_barrier(bar);
        { unsigned char* ws = WSB(); unsigned char* dob = DOB();
          PFRAME(); ln_rows(Fp, (float*)(ws + WS_H), (bf16_t*)(ws + WS_HB), (const float*)(ws + WS_PAR) + PO_L2G + l * DM, (const float*)(ws + WS_PAR) + PO_L2B + l * DM, (float*)(ws + WS_STAT2), l == DEPTH - 1 ? (float*)dob : nullptr, (const float*)(ws + WS_PART), 11); }
#if REP_CONV > 1
#endif
        xcd_barrier(bar);
    }
}

extern "C" void kernel_launch(void* const* d_in, const int* in_sizes, int n_in, void* d_out, int out_size, void* d_ws, size_t ws_size, hipStream_t stream) {
    static int grid = 0;
    if (grid == 0) {
        if (n_in != 19 || out_size != NMAIN * DM || ws_size < WS_NEED) { fprintf(stderr, "kernel_launch: unexpected shapes (n_in %d out %d ws %zu need %zu)\n", n_in, out_size, ws_size, (size_t)WS_NEED); grid = -1; return; }
        int dev = 0, cus = 0;
        if (hipGetDevice(&dev) != hipSuccess || hipDeviceGetAttribute(&cus, hipDeviceAttributeMultiprocessorCount, dev) != hipSuccess) { grid = -1; return; }
        if (hipFuncSetAttribute((const void*)fwd_kernel, hipFuncAttributeMaxDynamicSharedMemorySize, LDS_BYTES) != hipSuccess) { fprintf(stderr, "kernel_launch: hipFuncSetAttribute failed\n"); grid = -1; return; }
        int per_cu = 0;
        if (hipOccupancyMaxActiveBlocksPerMultiprocessor(&per_cu, (const void*)fwd_kernel, 512, LDS_BYTES) != hipSuccess || per_cu < 1) { fprintf(stderr, "kernel_launch: occupancy query says %d blocks per CU\n", per_cu); (void)hipGetLastError(); grid = -1; return; }
        if (cus < GRID) { fprintf(stderr, "kernel_launch: needs %d CUs, device has %d\n", GRID, cus); grid = -1; return; }
        grid = GRID;
    }
    if (grid < 0) return;
    (void)hipMemsetAsync((char*)d_ws + WS_CTL, 0, CTL_BYTES, stream);
    Params p{};
    for (int i = 0; i < 19; ++i) p.in[i] = (const float*)d_in[i];
    hipLaunchKernelGGL(fwd_kernel, dim3(grid), dim3(512), LDS_BYTES, stream, p, (unsigned char*)d_ws, (unsigned char*)d_out);
}
```

```cpp
#include <hip/hip_runtime.h>
#include <cstdio>
#include <cstdint>

#define LAS __attribute__((address_space(3)))
#define GAS __attribute__((address_space(1)))
typedef float f32x2 __attribute__((ext_vector_type(2)));
typedef float f32x8 __attribute__((ext_vector_type(8)));
typedef float f32x16 __attribute__((ext_vector_type(16)));
typedef unsigned u32x2 __attribute__((ext_vector_type(2)));
typedef short s16x4 __attribute__((ext_vector_type(4)));
typedef __bf16 bf16x2v __attribute__((ext_vector_type(2)));

constexpr int DM = 2048, NSEQ = 12, LREAL = 4096, NMETA = 16, DEPTH = 4;
constexpr int NMAIN = NSEQ * LREAL;
constexpr int MROW0 = NMAIN;
constexpr int NTOK = NMAIN + NSEQ * NMETA;
constexpr int NPAN = 193, TP = NPAN * 256;
constexpr int PMETA = 192;
constexpr int INC = 4944, NIN = 5120;
constexpr int DFF = 5632, NUP = 2 * DFF;
constexpr int MLW = 1024, NQ = 1536, NKV = 2048;
constexpr float ALPHA = 1.681792830507429f;
constexpr float EPS = 1e-5f;
constexpr float NEGBIG = -1e30f;

constexpr size_t MiB = 1u << 20;
constexpr size_t WS_CTL = 0, CTL_BYTES = 1 * MiB;
constexpr size_t WS_COS = 1 * MiB;
constexpr size_t WS_SIN = WS_COS + (size_t)4112 * 32 * 4;
constexpr size_t WS_PAR = 2 * MiB + 128 * 1024;
constexpr int PO_BG = 0, PO_MLG = PO_BG + DEPTH * 16, PO_QG = PO_MLG + DEPTH * 1024, PO_KVG = PO_QG + DEPTH * 512, PO_L1G = PO_KVG + DEPTH * 256, PO_L1B = PO_L1G + DEPTH * 2048,
              PO_CW = PO_L1B + DEPTH * 2048, PO_CB = PO_CW + DEPTH * 3 * 5632, PO_L2G = PO_CB + DEPTH * 5632, PO_L2B = PO_L2G + DEPTH * 2048, PO_ONE = PO_L2B + DEPTH * 2048, PO_ZERO = PO_ONE + 2048, PO_END = PO_ZERO + 2048;
static_assert(WS_PAR + (size_t)PO_END * 4 <= 3 * MiB && WS_PAR >= 1 * MiB + 2 * 4112 * 32 * 4, "PAR block placement");
constexpr size_t WS_WIN = 3 * MiB;
constexpr size_t WS_WUQ = WS_WIN + (size_t)NIN * DM * 2;
constexpr size_t WS_WUKV = WS_WUQ + (size_t)NQ * 512 * 2;
constexpr size_t WS_WOUT = WS_WUKV + (size_t)NKV * 256 * 2;
constexpr size_t WS_WUP = WS_WOUT + (size_t)DM * DM * 2;
constexpr size_t WS_WDN = WS_WUP + (size_t)NUP * DM * 2;
constexpr size_t WS_STAT1 = WS_WDN + (size_t)DM * DFF * 2;
constexpr size_t WS_STAT2 = WS_CTL + 512 * 1024;
constexpr size_t WS_H = 100 * MiB;
constexpr size_t WS_PART = WS_H + 208 * MiB;
static_assert((size_t)NMAIN * DM * 2 <= 208 * MiB && 208 * MiB + (size_t)11 * 256 * DM * 4 <= (size_t)NMAIN * DM * 4, "PART sits between the bf16 rows and the f32 meta rows of H");
constexpr size_t WS_WSET2 = WS_H + 240 * MiB;
constexpr size_t WSET_BYTES = WS_STAT1 - WS_WIN, WSET_DELTA = WS_WSET2 - WS_WIN;
static_assert(WS_PART + (size_t)11 * 256 * DM * 4 <= WS_WSET2 && WS_WSET2 + WSET_BYTES <= WS_H + (size_t)NMAIN * DM * 4, "second weight set sits between the split-K parts and the f32 meta rows of H");
constexpr size_t WS_HB = WS_H + (size_t)TP * DM * 4;
constexpr size_t WS_R = WS_HB + (size_t)TP * DM * 2;
constexpr size_t WS_UQKVO = WS_R;
constexpr size_t WS_UDQ = WS_UQKVO + (size_t)TP * 4096 * 2;
constexpr size_t WS_UDKV = WS_UDQ + (size_t)TP * 512 * 2;
constexpr size_t WS_GATES = WS_UDKV + (size_t)TP * 256 * 2;
constexpr size_t WS_MKV = WS_GATES + (size_t)TP * 16 * 4;
constexpr size_t WS_KR = WS_MKV + (size_t)TP * NKV * 2;
constexpr size_t WS_RSTD = WS_KR + (size_t)TP * 64 * 2;
constexpr size_t WS_END_A = WS_RSTD + (size_t)TP * 2 * 4;
constexpr size_t WS_ACT = WS_R;
constexpr size_t WS_END_B = WS_ACT + (size_t)TP * DFF * 2;
constexpr size_t WS_NEED = (WS_END_A > WS_END_B ? WS_END_A : WS_END_B);
static_assert(WS_STAT1 + (size_t)TP * 8 <= WS_H && WS_STAT2 + (size_t)TP * 8 <= WS_CTL + CTL_BYTES, "weights and row statistics fit below H");
constexpr size_t DO_HSUM = 0;
constexpr size_t DO_MQ = DO_HSUM + (size_t)TP * MLW * 4;
constexpr size_t DO_GP = 340 * MiB;
constexpr size_t DO_SIDE = 0;
constexpr size_t DO_GVM = 32 * MiB;
static_assert(DO_MQ + (size_t)TP * NQ * 2 <= DO_GP && DO_GP + (size_t)96 * 65 * 200 * 4 <= (size_t)NMAIN * DM * 4 && (size_t)192 * 6 * DFF * 4 <= DO_GVM && DO_GVM + (size_t)256 * NUP * 2 <= (size_t)NMAIN * DM * 4, "d_out scratch fits");
constexpr int CW_BAR = 4096;

constexpr int RING_BYTES = 131072;
constexpr int MISC_OFF = RING_BYTES;
constexpr int LDS_BYTES = 147456;
constexpr int GRID = 256;

__device__ __forceinline__ int pos_of_row(int row) { return row < NMAIN ? NMETA + (row & (LREAL - 1)) : ((row - NMAIN) & (NMETA - 1)); }
__device__ __forceinline__ unsigned pk2(float lo, float hi) { f32x2 v = {lo, hi}; return __builtin_bit_cast(unsigned, __builtin_convertvector(v, bf16x2v)); }
__device__ __forceinline__ float bf_lo(unsigned w) { return __uint_as_float(w << 16); }
__device__ __forceinline__ float bf_hi(unsigned w) { return __uint_as_float(w & 0xffff0000u); }
typedef _Float16 f16x2v __attribute__((ext_vector_type(2)));
__device__ __forceinline__ unsigned pk2h(float lo, float hi) { f32x2 v = {lo, hi}; return __builtin_bit_cast(unsigned, __builtin_convertvector(v, f16x2v)); }
__device__ __forceinline__ float hf_lo(unsigned w) { return (float)__builtin_bit_cast(f16x2v, w)[0]; }
__device__ __forceinline__ float hf_hi(unsigned w) { return (float)__builtin_bit_cast(f16x2v, w)[1]; }
__device__ __forceinline__ float wave_sum(float v) {
#pragma unroll
    for (int o = 1; o < 64; o <<= 1) v += __shfl_xor(v, o);
    return v;
}
__device__ __forceinline__ float wave_max(float v) {
#pragma unroll
    for (int o = 1; o < 64; o <<= 1) v = fmaxf(v, __shfl_xor(v, o));
    return v;
}
namespace pg8 {
#define PG8_LAS __attribute__((address_space(3)))
typedef unsigned short bf16_t;
typedef short bf16x8 __attribute__((ext_vector_type(8)));
typedef float f32x4 __attribute__((ext_vector_type(4)));
typedef unsigned u32x4 __attribute__((ext_vector_type(4)));
constexpr int BM = 256, BK = 64, HALF = 128, HTB = HALF * BK * 2  , STAGE_BYTES = 8 * HTB, NXCD = 8, WGM = 4;

__host__ __device__ __forceinline__ int lds_byte(int r, int c) { const int st = (r >> 4) * 2 + (c >> 5), rr = r & 15, cc = c & 31, ob = rr * 64 + cc * 2; return st * 1024 + (ob ^ (((ob >> 9) & 1) << 5)); }
__host__ __device__ __forceinline__ void stage_rc(int b, int& R, int& C) { const int st = b / 1024, sb = b % 1024, swz = sb ^ (((sb >> 9) & 1) << 5); R = (st >> 1) * 16 + swz / 64; C = (st & 1) * 32 + (swz % 64) / 2; }
__host__ __device__ __forceinline__ int perm32(int rho) { const int n = rho >> 4, i = rho & 15; return 8 * (i >> 2) + 4 * n + (i & 3); }

struct Unit { int pm, pn, kk; };
struct Gemm { const bf16_t* A; const bf16_t* Bt; int M, N, K, ld; };

struct PanelOrder {
    int nM, nN, nwg, G, c, nMain, pm0, pmx;
    __device__ void init(int nMain_, int pm0_, int extra, int pmx_, int N, int G_, int c_) { nMain = nMain_; pm0 = pm0_; pmx = pmx_; nM = nMain_ + extra; nN = N / BM; nwg = nM * nN; G = G_; c = c_; }
    __device__ bool next(int i, Unit& u) const {
        const long L = (long)i * G + c; if (L >= nwg) return false;
        int wgid = (int)L; { const int q = nwg / NXCD, r = nwg % NXCD, xcd = wgid % NXCD, off = wgid / NXCD; wgid = (xcd < r ? xcd * (q + 1) : r * (q + 1) + (xcd - r) * q) + off; }
        const int nig = WGM * nN, gid = wgid / nig, fm = gid * WGM, gsz = (nM - fm) < WGM ? (nM - fm) : WGM;
        const int pl = fm + ((wgid % nig) % gsz); u.pm = pl < nMain ? pm0 + pl : pmx; u.pn = (wgid % nig) / gsz; u.kk = 0; return true;
    }
    __device__ __forceinline__ void a_ready(const Unit&) const {}
    __device__ __forceinline__ void done(const Unit&) const {}
};

struct SplitOrder {
    int pm, nN, nwg, G, c;
    __device__ void init(int pm_, int N, int nsplit, int G_, int c_) { pm = pm_; nN = N / BM; nwg = nN * nsplit; G = G_; c = c_; }
    __device__ bool next(int i, Unit& u) const { const int L = i * G + c; if (L >= nwg) return false; u.pm = pm; u.pn = L % nN; u.kk = L / nN; return true; }
    __device__ __forceinline__ void a_ready(const Unit&) const {}
    __device__ __forceinline__ void done(const Unit&) const {}
};

__device__ __forceinline__ u32x4 pack8(const f32x4 v0, const f32x4 v1) { u32x4 w; w.x = pk2(v0[0], v0[1]); w.y = pk2(v0[2], v0[3]); w.z = pk2(v1[0], v1[1]); w.w = pk2(v1[2], v1[3]); return w; }

struct EpiBf16G {
    static constexpr bool PERM = true, AFTER_DRAIN = false, PERMA = false;
    bf16_t* O; int ldc; const float* rs; int pm_sub, pm_sp, pm_sp_out;
    __device__ __forceinline__ void operator()(const f32x4 (&acc)[2][2][4][2], const Unit& u, int wr, int wc, int fr, int fq) const {
        const int opm = (u.pm == pm_sp) ? pm_sp_out : u.pm - pm_sub;
        const int rin = u.pm * BM + wr * 64 + fr, rout = opm * BM + wr * 64 + fr, col0 = u.pn * BM + wc * 32 + 8 * fq;
#pragma unroll
        for (int ai = 0; ai < 2; ++ai)
#pragma unroll
            for (int m = 0; m < 4; ++m) { const float sc = rs ? rs[(size_t)(rin + ai * HALF + m * 16) * 2] : 1.f;
                bf16_t* rowp = O + (size_t)(rout + ai * HALF + m * 16) * ldc + col0;
#pragma unroll
                for (int bj = 0; bj < 2; ++bj) *(u32x4*)(rowp + bj * HALF) = pack8(acc[ai][bj][m][0] * sc, acc[ai][bj][m][1] * sc); }
    }
};
struct EpiWin {
    static constexpr bool PERM = true, AFTER_DRAIN = false, PERMA = false;
    bf16_t *UQKVO, *UDQ, *UDKV, *KR; float* GATES; const float *COS, *SIN;
    __device__ __forceinline__ void operator()(const f32x4 (&acc)[2][2][4][2], const Unit& u, int wr, int wc, int fr, int fq) const {
        const int row0 = u.pm * BM + wr * 64 + fr;
        if (u.pn < 19) {
            bf16_t* base; int ldc, colt;
            if (u.pn < 16) { base = UQKVO; ldc = 4096; colt = u.pn * BM; } else if (u.pn < 18) { base = UDQ; ldc = 512; colt = (u.pn - 16) * BM; } else { base = UDKV; ldc = 256; colt = 0; }
            const int col0 = colt + wc * 32 + 8 * fq;
#pragma unroll
            for (int ai = 0; ai < 2; ++ai)
#pragma unroll
                for (int m = 0; m < 4; ++m) { bf16_t* rowp = base + (size_t)(row0 + ai * HALF + m * 16) * ldc + col0;
#pragma unroll
                    for (int bj = 0; bj < 2; ++bj) *(u32x4*)(rowp + bj * HALF) = pack8(acc[ai][bj][m][0], acc[ai][bj][m][1]); }
        } else {
            if (wc < 2) { const int g = 4 * wc + fq;
#pragma unroll
                for (int ai = 0; ai < 2; ++ai)
#pragma unroll
                    for (int m = 0; m < 4; ++m) { const int row = row0 + ai * HALF + m * 16, pos = pos_of_row(row);
                        const f32x4 cs = *(const f32x4*)(COS + pos * 32 + 4 * g), sn = *(const f32x4*)(SIN + pos * 32 + 4 * g);
                        const f32x4 x1 = acc[ai][0][m][0], x2 = acc[ai][0][m][1];
                        *(u32x4*)(KR + (size_t)row * 64 + 8 * g) = pack8(x1 * cs - x2 * sn, x1 * sn + x2 * cs); }
            } else if (wc == 2 && fq < 2) {
#pragma unroll
                for (int ai = 0; ai < 2; ++ai)
#pragma unroll
                    for (int m = 0; m < 4; ++m) { float* gp = GATES + (size_t)(row0 + ai * HALF + m * 16) * 16 + 8 * fq;
                        *(f32x4*)gp = acc[ai][0][m][0]; *(f32x4*)(gp + 4) = acc[ai][0][m][1]; }
            }
        }
    }
};
struct EpiQ {
    static constexpr bool PERM = true, AFTER_DRAIN = false, PERMA = false;
    bf16_t* MQ; const float *RSTD, *COS, *SIN;
    __device__ __forceinline__ void operator()(const f32x4 (&acc)[2][2][4][2], const Unit& u, int wr, int wc, int fr, int fq) const {
        const int row0 = u.pm * BM + wr * 64 + fr, colb = u.pn * BM + wc * 32 + 8 * fq;
#pragma unroll
        for (int ai = 0; ai < 2; ++ai)
#pragma unroll
            for (int m = 0; m < 4; ++m) { const int row = row0 + ai * HALF + m * 16, pos = pos_of_row(row); const float sc = RSTD[(size_t)row * 2];
#pragma unroll
                for (int bj = 0; bj < 2; ++bj) { const int col0 = colb + bj * HALF, o = col0 % 192;
                    f32x4 v0 = acc[ai][bj][m][0] * sc, v1 = acc[ai][bj][m][1] * sc;
                    if (o >= 128) { const int g = (o - 128) >> 3; const f32x4 cs = *(const f32x4*)(COS + pos * 32 + 4 * g), sn = *(const f32x4*)(SIN + pos * 32 + 4 * g);
                        const f32x4 x1 = v0, x2 = v1; v0 = x1 * cs - x2 * sn; v1 = x1 * sn + x2 * cs; }
                    *(u32x4*)(MQ + (size_t)row * NQ + col0) = pack8(v0, v1); } }
    }
};
__device__ __forceinline__ void resid_ln_tile(float* __restrict__ Cw, const float* __restrict__ Cr, const float* __restrict__ st, const float* __restrict__ g, const float* __restrict__ b,
                                              int ldc, float alpha, const f32x4 (&acc)[2][2][4][2], int row0, int col0) {
    asm volatile("" ::: "memory");
#pragma unroll
    for (int ai = 0; ai < 2; ++ai)
#pragma unroll
        for (int bj = 0; bj < 2; ++bj) {
            f32x4 gv[2], bv[2], hv[4][2]; f32x2 ms[4];
#pragma unroll
            for (int n = 0; n < 2; ++n) { gv[n] = *(const f32x4*)(g + col0 + bj * HALF + n * 16) * alpha; bv[n] = *(const f32x4*)(b + col0 + bj * HALF + n * 16) * alpha; }
#pragma unroll
            for (int m = 0; m < 4; ++m) { const int row = row0 + ai * HALF + m * 16; ms[m] = *(const f32x2*)(st + (size_t)row * 2);
#pragma unroll
                for (int n = 0; n < 2; ++n) hv[m][n] = *(const f32x4*)(Cr + (size_t)row * ldc + col0 + bj * HALF + n * 16); }
#pragma unroll
            for (int m = 0; m < 4; ++m) { const int row = row0 + ai * HALF + m * 16;
#pragma unroll
                for (int n = 0; n < 2; ++n) *(f32x4*)(Cw + (size_t)row * ldc + col0 + bj * HALF + n * 16) = (hv[m][n] - ms[m][0]) * ms[m][1] * gv[n] + bv[n] + acc[ai][bj][m][n]; }
        }
}
__device__ __forceinline__ void resid_ln_tile_bf(bf16_t* __restrict__ Cw, const bf16_t* __restrict__ Cr, const float* __restrict__ st, const float* __restrict__ g, const float* __restrict__ b,
                                                 int ldc, float alpha, const f32x4 (&acc)[2][2][4][2], int row0, int col0) {
    asm volatile("" ::: "memory");
    f32x4 gv[2][2], bv[2][2];
#pragma unroll
    for (int bj = 0; bj < 2; ++bj)
#pragma unroll
        for (int n = 0; n < 2; ++n) { gv[bj][n] = *(const f32x4*)(g + col0 + bj * HALF + n * 4); bv[bj][n] = *(const f32x4*)(b + col0 + bj * HALF + n * 4); }
#pragma unroll
    for (int ai = 0; ai < 2; ++ai) {
        u32x4 hv[2][4]; f32x2 ms[4];
#pragma unroll
        for (int m = 0; m < 4; ++m) { const int row = row0 + ai * HALF + m * 16; ms[m] = *(const f32x2*)(st + (size_t)row * 2);
#pragma unroll
            for (int bj = 0; bj < 2; ++bj) hv[bj][m] = *(const u32x4*)(Cr + (size_t)row * ldc + col0 + bj * HALF); }
#pragma unroll
        for (int bj = 0; bj < 2; ++bj)
#pragma unroll
            for (int m = 0; m < 4; ++m) { const int row = row0 + ai * HALF + m * 16; const u32x4 h = hv[bj][m]; const float mean = ms[m][0], rstd = ms[m][1];
                const f32x4 h0 = {hf_lo(h.x), hf_hi(h.x), hf_lo(h.y), hf_hi(h.y)}, h1 = {hf_lo(h.z), hf_hi(h.z), hf_lo(h.w), hf_hi(h.w)};
                const f32x4 o0 = ((h0 - mean) * rstd * gv[bj][0] + bv[bj][0]) * alpha + acc[ai][bj][m][0], o1 = ((h1 - mean) * rstd * gv[bj][1] + bv[bj][1]) * alpha + acc[ai][bj][m][1];
                u32x4 w; w.x = pk2h(o0[0], o0[1]); w.y = pk2h(o0[2], o0[3]); w.z = pk2h(o1[0], o1[1]); w.w = pk2h(o1[2], o1[3]);
                *(u32x4*)(Cw + (size_t)row * ldc + col0 + bj * HALF) = w; }
    }
}
struct EpiResidLn {
    static constexpr bool PERM = true, AFTER_DRAIN = false, PERMA = false;
    bf16_t* C; int ldc; float alpha; const float* st; const float* g; const float* b;
    __device__ __forceinline__ void operator()(const f32x4 (&acc)[2][2][4][2], const Unit& u, int wr, int wc, int fr, int fq) const {
        resid_ln_tile_bf(this->C, this->C, this->st, this->g, this->b, this->ldc, this->alpha, acc, u.pm * BM + wr * 64 + fr, u.pn * BM + wc * 32 + 8 * fq);
    }
};
struct EpiPart {
    static constexpr bool PERM = false, AFTER_DRAIN = false, PERMA = false;
    float* P; int ldc;
    __device__ __forceinline__ void operator()(const f32x4 (&acc)[2][2][4][2], const Unit& u, int wr, int wc, int fr, int fq) const {
        const int row0 = u.kk * BM + wr * 64 + fr, col0 = u.pn * BM + wc * 32 + 4 * fq;
#pragma unroll
        for (int ai = 0; ai < 2; ++ai)
#pragma unroll
            for (int m = 0; m < 4; ++m) { float* rowp = P + (size_t)(row0 + ai * HALF + m * 16) * ldc + col0;
#pragma unroll
                for (int bj = 0; bj < 2; ++bj)
#pragma unroll
                    for (int n = 0; n < 2; ++n) *(f32x4*)(rowp + bj * HALF + n * 16) = acc[ai][bj][m][n]; }
    }
};

__device__ __forceinline__ float dpp_shr1_old(float old, float x) { return __int_as_float(__builtin_amdgcn_update_dpp(__float_as_int(old), __float_as_int(x), 0x111, 0xf, 0xf, false)); }
__device__ __forceinline__ float dpp_shl1_old(float old, float x) { return __int_as_float(__builtin_amdgcn_update_dpp(__float_as_int(old), __float_as_int(x), 0x101, 0xf, 0xf, false)); }
struct EpiFfn {
    static constexpr bool PERM = true, AFTER_DRAIN = false, PERMA = true;
    bf16_t* ACT; float* SIDE; bf16_t* GVM; const float *cw, *cb; PG8_LAS float* X;
    __device__ __forceinline__ void operator()(const f32x4 (&acc)[2][2][4][2], const Unit& u, int wr_in, int wc_in, int fr_in, int fq_in) const {
        int fr = fr_in, fq = fq_in, wr = wr_in, wc = wc_in; asm volatile("" : "+v"(fr), "+v"(fq), "+s"(wr), "+s"(wc));
        const int cj = wc * 32 + 8 * fq, c0 = u.pn * 128 + cj;
        if (u.pm == PMETA) {
#pragma unroll
            for (int ai = 0; ai < 2; ++ai)
#pragma unroll
                for (int m = 0; m < 4; ++m) { bf16_t* rowp = GVM + (size_t)(ai * HALF + wr * 64 + 4 * fr + m) * NUP + c0;
                    *(u32x4*)rowp = pack8(acc[ai][0][m][0], acc[ai][0][m][1]); *(u32x4*)(rowp + DFF) = pack8(acc[ai][1][m][0], acc[ai][1][m][1]); }
            return;
        }
        f32x4 w0[2], w1[2], w2[2], bb[2];
#pragma unroll
        for (int n = 0; n < 2; ++n) { w0[n] = *(const f32x4*)(cw + c0 + 4 * n); w1[n] = *(const f32x4*)(cw + DFF + c0 + 4 * n); w2[n] = *(const f32x4*)(cw + 2 * DFF + c0 + 4 * n); bb[n] = *(const f32x4*)(cb + c0 + 4 * n); }
#pragma unroll
        for (int ai = 0; ai < 2; ++ai) { const int b = 2 * ai + wr;
            if (fr == 0) { *(PG8_LAS f32x4*)(X + (b * 2 + 0) * 128 + cj) = acc[ai][0][0][0]; *(PG8_LAS f32x4*)(X + (b * 2 + 0) * 128 + cj + 4) = acc[ai][0][0][1]; }
            if (fr == 15) { *(PG8_LAS f32x4*)(X + (b * 2 + 1) * 128 + cj) = acc[ai][0][3][0]; *(PG8_LAS f32x4*)(X + (b * 2 + 1) * 128 + cj + 4) = acc[ai][0][3][1]; } }
        asm volatile("s_waitcnt lgkmcnt(0)" ::: "memory"); __builtin_amdgcn_s_barrier(); asm volatile("" ::: "memory");
        const unsigned rowb = (unsigned)(u.pm * BM + wr * 64 + 4 * fr) * DFF + c0;
#pragma unroll
        for (int ai = 0; ai < 2; ++ai) { const int b = 2 * ai + wr;
            f32x4 xp[2], xn[2];
#pragma unroll
            for (int n = 0; n < 2; ++n) { xp[n] = b > 0 ? *(const PG8_LAS f32x4*)(X + ((b - 1) * 2 + 1) * 128 + cj + 4 * n) : (f32x4){0.f, 0.f, 0.f, 0.f};
                                          xn[n] = b < 3 ? *(const PG8_LAS f32x4*)(X + ((b + 1) * 2 + 0) * 128 + cj + 4 * n) : (f32x4){0.f, 0.f, 0.f, 0.f}; }
            f32x4 up0[2], dn3[2];
#pragma unroll
            for (int n = 0; n < 2; ++n)
#pragma unroll
                for (int e = 0; e < 4; ++e) { up0[n][e] = dpp_shr1_old(xp[n][e], acc[ai][0][3][n][e]); dn3[n][e] = dpp_shl1_old(xn[n][e], acc[ai][0][0][n][e]); }
#pragma unroll
            for (int m = 0; m < 4; ++m) { u32x4 ow;
#pragma unroll
                for (int n = 0; n < 2; ++n) {
                    const f32x4 g = acc[ai][0][m][n], pv = m > 0 ? acc[ai][0][m > 0 ? m - 1 : 0][n] : up0[n], nx = m < 3 ? acc[ai][0][m < 3 ? m + 1 : 3][n] : dn3[n];
                    const f32x4 x = w0[n] * pv + w1[n] * g + w2[n] * nx + bb[n]; f32x4 t, o;
#pragma unroll
                    for (int e = 0; e < 4; ++e) t[e] = __expf(-x[e]);
                    t = t + 1.f;
#pragma unroll
                    for (int e = 0; e < 4; ++e) t[e] = __builtin_amdgcn_rcpf(t[e]);
                    o = x * t * acc[ai][1][m][n];
                    if (n == 0) { ow.x = pk2(o[0], o[1]); ow.y = pk2(o[2], o[3]); } else { ow.z = pk2(o[0], o[1]); ow.w = pk2(o[2], o[3]); } }
                bf16_t* dst = ACT + (rowb + (unsigned)(ai * HALF + m) * DFF);
                if (ai == 0 ? m < 2 : m >= 2) {
                    const int r = ai * HALF + wr * 64 + 4 * fr + m;
                    if (r != 0 && r != 255) *(u32x4*)dst = ow;
                    const int slot = r == 0 ? 0 : r == 1 ? 1 : r == 254 ? 2 : r == 255 ? 3 : -1;
                    if (slot >= 0) { float* sp = SIDE + ((size_t)u.pm * 6 + slot) * DFF + c0; *(f32x4*)sp = acc[ai][0][m][0]; *(f32x4*)(sp + 4) = acc[ai][0][m][1];
                        if (slot == 0 || slot == 3) { float* vp = SIDE + ((size_t)u.pm * 6 + (slot == 0 ? 4 : 5)) * DFF + c0; *(f32x4*)vp = acc[ai][1][m][0]; *(f32x4*)(vp + 4) = acc[ai][1][m][1]; } }
                } else *(u32x4*)dst = ow;
            }
        }
    }
};
template <class Epi, class Sched, bool ALIGN_EPI = false, bool SP2 = false>
__device__ __forceinline__ void gemm_phase(PG8_LAS unsigned char* lds, const Gemm g, const Sched& S, const Epi& E) {
    int tid_ = threadIdx.x; asm volatile("" : "+v"(tid_));
    const int tid = tid_, wid = __builtin_amdgcn_readfirstlane(tid >> 6), lane = tid & 63, wr = wid >> 2, wc = wid & 3, fr = lane & 15, fq = lane >> 4;
    const int K = g.ld, nt = g.K / BK;
    unsigned voffA[2], voffB[2];
#pragma unroll
    for (int i = 0; i < 2; ++i) { int R, C; stage_rc(tid * 16 + i * 8192, R, C); const int Rb = Epi::PERM ? ((R & ~31) + perm32(R & 31)) : R;
        const int Ra = Epi::PERMA ? ((R & ~63) | ((R & 15) << 2) | ((R >> 4) & 3)) : R;
        voffA[i] = (unsigned)(Ra * K + C) * 2u; voffB[i] = (unsigned)(Rb * K + C) * 2u; }
    const size_t kstep = (size_t)(BK * 2);
    const size_t hstep = (size_t)HALF * K * 2;
    const size_t tstep = 2 * hstep;
    const unsigned ldsw = (unsigned)wid * 1024u;
    const int aoff = lds_byte(wr * 64 + fr, fq * 8), boff = lds_byte(wc * 32 + fr, fq * 8);
#define PG8_SA(b, h) (((b) * 2 + (h)) * HTB)
#define PG8_SB(b, h) ((4 + (b) * 2 + (h)) * HTB)
#define PG8_STAGE(bufoff, gbase, voff) do { _Pragma("unroll") for (int _i = 0; _i < 2; ++_i) \
        __builtin_amdgcn_global_load_lds((const unsigned*)((const char*)(gbase) + (voff)[_i]), (PG8_LAS unsigned*)(lds + (bufoff) + ldsw + _i * 8192), 16, 0, 0); } while (0)
#define PG8_LDA(dst, b, h) do { _Pragma("unroll") for (int m = 0; m < 4; ++m) _Pragma("unroll") for (int k = 0; k < 2; ++k) dst[m][k] = *(const PG8_LAS bf16x8*)(lds + PG8_SA(b, h) + aoff + m * 2048 + k * 1024); } while (0)
#define PG8_LDB(dst, b, h) do { _Pragma("unroll") for (int n = 0; n < 2; ++n) _Pragma("unroll") for (int k = 0; k < 2; ++k) dst[n][k] = *(const PG8_LAS bf16x8*)(lds + PG8_SB(b, h) + boff + n * 2048 + k * 1024); } while (0)
#define PG8_MMA(ai, bj, At, Bt) do { __builtin_amdgcn_s_setprio(1); _Pragma("unroll") for (int m = 0; m < 4; ++m) _Pragma("unroll") for (int n = 0; n < 2; ++n) _Pragma("unroll") for (int k = 0; k < 2; ++k) \
        acc[ai][bj][m][n] = __builtin_amdgcn_mfma_f32_16x16x32_bf16(Bt[n][k], At[m][k], acc[ai][bj][m][n], 0, 0, 0); __builtin_amdgcn_s_setprio(0); } while (0)
#define PG8_WAIT_V(n) asm volatile("s_waitcnt vmcnt(" #n ")" ::: "memory")
#define PG8_WAIT_L(n) asm volatile("s_waitcnt lgkmcnt(" #n ")" ::: "memory")
#define PG8_BAR __builtin_amdgcn_s_barrier()
#define PG8_SCHED __builtin_amdgcn_sched_barrier(0)
    Unit cur, nxt; int ui = 0;
    if (!S.next(0, cur)) return;
    f32x4 acc[2][2][4][2];
#pragma unroll
    for (int a = 0; a < 2; ++a)
#pragma unroll
        for (int b = 0; b < 2; ++b)
#pragma unroll
            for (int m = 0; m < 4; ++m)
#pragma unroll
                for (int n = 0; n < 2; ++n) acc[a][b][m][n] = (f32x4){0.f, 0.f, 0.f, 0.f};
    bf16x8 At[4][2], B0[2][2], B1[2][2];
    const size_t sstep = (size_t)g.K * 2;
    const char* cA = (const char*)g.A + (size_t)cur.pm * tstep + (size_t)cur.kk * sstep; const char* cB = (const char*)g.Bt + (size_t)cur.pn * tstep + (size_t)cur.kk * sstep;
    S.a_ready(cur);
    if constexpr (SP2) {
        PG8_STAGE(PG8_SB(0, 0), cB, voffB); PG8_STAGE(PG8_SB(0, 1), cB + hstep, voffB); PG8_STAGE(PG8_SA(0, 0), cA, voffA); PG8_STAGE(PG8_SA(0, 1), cA + hstep, voffA);
        if (wr == 1) PG8_BAR;
        PG8_WAIT_V(2); PG8_BAR;
        PG8_STAGE(PG8_SB(1, 0), cB + kstep, voffB); PG8_STAGE(PG8_SA(1, 0), cA + kstep, voffA); PG8_STAGE(PG8_SB(1, 1), cB + hstep + kstep, voffB);
        PG8_WAIT_V(6); PG8_BAR;
    } else {
        PG8_STAGE(PG8_SB(0, 0), cB, voffB); PG8_STAGE(PG8_SA(0, 0), cA, voffA); PG8_STAGE(PG8_SB(0, 1), cB + hstep, voffB); PG8_STAGE(PG8_SA(0, 1), cA + hstep, voffA);
        if (wr == 1) PG8_BAR;
        PG8_WAIT_V(4); PG8_BAR;
        PG8_STAGE(PG8_SB(1, 0), cB + kstep, voffB); PG8_STAGE(PG8_SA(1, 0), cA + kstep, voffA); PG8_STAGE(PG8_SB(1, 1), cB + hstep + kstep, voffB);
        PG8_WAIT_V(6); PG8_BAR;
    }
    for (;;) {
        const bool has_next = S.next(ui + 1, nxt);
        const char* nA = has_next ? (const char*)g.A + (size_t)nxt.pm * tstep + (size_t)nxt.kk * sstep : cA; const char* nB = has_next ? (const char*)g.Bt + (size_t)nxt.pn * tstep + (size_t)nxt.kk * sstep : cB;
        for (int t = 0; t < nt; t += 2) {
            const bool last = (t == nt - 2);
            const char* a1 = cA + (size_t)(t + 1) * kstep;
            const char* a2 = last ? nA : cA + (size_t)(t + 2) * kstep; const char* b2 = last ? nB : cB + (size_t)(t + 2) * kstep;
            const char* a3 = a2 + kstep; const char* b3 = b2 + kstep;
            if (last && has_next) S.a_ready(nxt);
            if constexpr (SP2) {
            PG8_LDB(B0, 0, 0); PG8_LDB(B1, 0, 1); PG8_SCHED; PG8_LDA(At, 0, 0); PG8_STAGE(PG8_SA(1, 1), a1 + hstep, voffA);
            PG8_WAIT_V(8); PG8_WAIT_L(0); PG8_BAR; PG8_MMA(0, 0, At, B0); PG8_MMA(0, 1, At, B1); PG8_BAR; PG8_SCHED;
            PG8_LDA(At, 0, 1); PG8_STAGE(PG8_SB(0, 0), b2, voffB); PG8_STAGE(PG8_SB(0, 1), b2 + hstep, voffB); PG8_STAGE(PG8_SA(0, 0), a2, voffA);
            PG8_WAIT_V(8); PG8_WAIT_L(0); PG8_BAR; PG8_MMA(1, 0, At, B0); PG8_MMA(1, 1, At, B1); PG8_BAR; PG8_SCHED;
            PG8_LDB(B0, 1, 0); PG8_LDB(B1, 1, 1); PG8_SCHED; PG8_LDA(At, 1, 0); PG8_STAGE(PG8_SA(0, 1), a2 + hstep, voffA);
            PG8_WAIT_V(8); PG8_WAIT_L(0); PG8_BAR; PG8_MMA(0, 0, At, B0); PG8_MMA(0, 1, At, B1); PG8_BAR; PG8_SCHED;
            PG8_LDA(At, 1, 1); PG8_STAGE(PG8_SB(1, 0), b3, voffB); PG8_STAGE(PG8_SB(1, 1), b3 + hstep, voffB); PG8_STAGE(PG8_SA(1, 0), a3, voffA);
            PG8_WAIT_V(8); PG8_WAIT_L(0); PG8_BAR; PG8_MMA(1, 0, At, B0); PG8_MMA(1, 1, At, B1); PG8_BAR; PG8_SCHED;
            } else {
            PG8_LDB(B0, 0, 0); PG8_SCHED; PG8_LDA(At, 0, 0); PG8_STAGE(PG8_SA(1, 1), a1 + hstep, voffA);
            PG8_WAIT_L(8); PG8_BAR; PG8_WAIT_L(0); PG8_MMA(0, 0, At, B0); PG8_BAR; PG8_SCHED;
            PG8_LDB(B1, 0, 1); PG8_STAGE(PG8_SB(0, 0), b2, voffB);
            PG8_BAR; PG8_WAIT_L(0); PG8_MMA(0, 1, At, B1); PG8_BAR;
            PG8_LDA(At, 0, 1); PG8_STAGE(PG8_SA(0, 0), a2, voffA);
            PG8_BAR; PG8_WAIT_L(0); PG8_MMA(1, 0, At, B0); PG8_BAR; PG8_SCHED;
            PG8_STAGE(PG8_SB(0, 1), b2 + hstep, voffB);
            PG8_WAIT_V(6); PG8_BAR; PG8_MMA(1, 1, At, B1); PG8_BAR;
            PG8_LDB(B0, 1, 0); PG8_SCHED; PG8_LDA(At, 1, 0); PG8_STAGE(PG8_SA(0, 1), a2 + hstep, voffA);
            PG8_WAIT_L(8); PG8_BAR; PG8_WAIT_L(0); PG8_MMA(0, 0, At, B0); PG8_BAR; PG8_SCHED;
            PG8_LDB(B1, 1, 1); PG8_STAGE(PG8_SB(1, 0), b3, voffB);
            PG8_BAR; PG8_WAIT_L(0); PG8_MMA(0, 1, At, B1); PG8_BAR;
            PG8_LDA(At, 1, 1); PG8_STAGE(PG8_SA(1, 0), a3, voffA);
            PG8_BAR; PG8_WAIT_L(0); PG8_MMA(1, 0, At, B0); PG8_BAR; PG8_SCHED;
            PG8_STAGE(PG8_SB(1, 1), b3 + hstep, voffB);
            PG8_WAIT_V(6); PG8_BAR; PG8_MMA(1, 1, At, B1); PG8_BAR;
            }
        }
        if constexpr (ALIGN_EPI) { if (wr == 0) PG8_BAR; }
        if constexpr (!Epi::AFTER_DRAIN) { E(acc, cur, wr, wc, fr, fq); S.done(cur); }
        if (!has_next) break;
#pragma unroll
        for (int a = 0; a < 2; ++a)
#pragma unroll
            for (int b = 0; b < 2; ++b)
#pragma unroll
                for (int m = 0; m < 4; ++m)
#pragma unroll
                    for (int n = 0; n < 2; ++n) acc[a][b][m][n] = (f32x4){0.f, 0.f, 0.f, 0.f};
        cur = nxt; cA = nA; cB = nB; ++ui;
        if constexpr (ALIGN_EPI) { if (wr == 1) PG8_BAR; }
    }
    PG8_WAIT_V(0);
    if constexpr (!ALIGN_EPI) { if (wr == 0) PG8_BAR; }
    PG8_BAR;
    if constexpr (Epi::AFTER_DRAIN) { E.fused(acc, cur, wr, wc, fr, fq, lds, wid, lane); S.done(cur); }
#undef PG8_SA
#undef PG8_SB
#undef PG8_STAGE
#undef PG8_LDA
#undef PG8_LDB
#undef PG8_MMA
#undef PG8_WAIT_V
#undef PG8_WAIT_L
#undef PG8_BAR
#undef PG8_SCHED
}
}
#define XB_TMO      128
#define XB_XCNT(j)  (256  + 64 * (j))
#define XB_XSUB(j)  (1280 + 64 * (j))
#define XB_XGEN(j)  (2304 + 64 * (j))
#define XB_TOP      3328
#define XB_TOPGEN   3392
#define XCD_BAR_WORDS 3456
#define XB_SPIN_CAP (1u << 21)

__device__ __forceinline__ unsigned xb_ld(unsigned* p)              { return __hip_atomic_load(p, __ATOMIC_RELAXED, __HIP_MEMORY_SCOPE_AGENT); }
__device__ __forceinline__ unsigned xb_add(unsigned* p, unsigned v) { return __hip_atomic_fetch_add(p, v, __ATOMIC_RELAXED, __HIP_MEMORY_SCOPE_AGENT); }
__device__ __forceinline__ unsigned xb_xcc_id() { return (unsigned)__builtin_amdgcn_s_getreg((3 << 11) | 20) & 0xFu; }
#define XB_SPIN(cond, bar) do { unsigned _sp = 0; while (cond) { __builtin_amdgcn_s_sleep(1); \
    if ((++_sp & 255u) == 0u) { if (xb_ld(&(bar)[XB_TMO])) break; if (_sp > XB_SPIN_CAP) { atomicAdd(&(bar)[XB_TMO], 1u); break; } } } } while (0)

struct XcdBarrier {
    unsigned* bar; unsigned x;
    volatile LAS unsigned* st;
};

__device__ __forceinline__ XcdBarrier xcd_barrier_post(unsigned* bar, volatile LAS unsigned* st) {
    XcdBarrier b; b.bar = bar; b.x = (unsigned)__builtin_amdgcn_readfirstlane((int)xb_xcc_id()); b.st = st;
    if (threadIdx.x == 0) (void)xb_add(&bar[XB_XCNT(b.x)], 1u);
    return b;
}
__device__ __forceinline__ void xcd_barrier_complete(unsigned* bar, unsigned x, unsigned& nloc, unsigned& nx) {
    const unsigned G = gridDim.x * gridDim.y * gridDim.z;
    unsigned sum, cnt, mine, sp = 0u;
    for (;;) {
        sum = 0u; cnt = 0u; mine = 0u;
#pragma unroll
        for (unsigned j = 0; j < 16; ++j) { const unsigned c = xb_ld(&bar[XB_XCNT(j)]); sum += c; cnt += (c > 0u) ? 1u : 0u; }
        mine = xb_ld(&bar[XB_XCNT(x)]);
        if (sum == G) { mine = xb_ld(&bar[XB_XCNT(x)]); break; }
        __builtin_amdgcn_s_sleep(1);
        if ((++sp & 255u) == 0u) { if (xb_ld(&bar[XB_TMO])) break; if (sp > XB_SPIN_CAP) { atomicAdd(&bar[XB_TMO], 1u); break; } }
    }
    nloc = mine > 0u ? mine : 1u; nx = cnt > 0u ? cnt : 1u;
}

__device__ __forceinline__ void xcd_barrier(const XcdBarrier& b) {
    asm volatile("s_waitcnt vmcnt(0)" ::: "memory");
    __syncthreads();
    if (threadIdx.x == 0) {
        unsigned* bar = b.bar; unsigned bx_ = b.x;
        asm volatile("" : "+s"(bx_));
        __builtin_amdgcn_s_waitcnt(0);
        unsigned nloc = b.st[0], nx = b.st[1];
        if (nloc == 0u) { xcd_barrier_complete(bar, bx_, nloc, nx); b.st[0] = nloc; b.st[1] = nx; }
        const unsigned old = xb_add(&bar[XB_XSUB(bx_)], 1u);
        const unsigned gen = old / nloc;
        if (old + 1u == (gen + 1u) * nloc) {
            __builtin_amdgcn_fence(__ATOMIC_RELEASE, "agent");
            asm volatile("s_waitcnt vmcnt(0)" ::: "memory");
            const unsigned og = xb_add(&bar[XB_TOP], 1u);
            const unsigned tg = og / nx;
            if (og + 1u == (tg + 1u) * nx) xb_add(&bar[XB_TOPGEN], 1u);
            else XB_SPIN(xb_ld(&bar[XB_TOPGEN]) == tg, bar);
            __builtin_amdgcn_fence(__ATOMIC_ACQUIRE, "agent");
            xb_add(&bar[XB_XGEN(bx_)], 1u);
            asm volatile("s_waitcnt vmcnt(0)" ::: "memory");
        } else {
            XB_SPIN(xb_ld(&bar[XB_XGEN(bx_)]) == gen, bar);
            __builtin_amdgcn_fence(__ATOMIC_ACQUIRE, "agent");
            asm volatile("s_waitcnt vmcnt(0)" ::: "memory");
        }
    }
    __syncthreads();
}

typedef unsigned short bf16_t;
typedef short bf16x8 __attribute__((ext_vector_type(8)));
typedef float f32x4 __attribute__((ext_vector_type(4)));
typedef unsigned u32x4 __attribute__((ext_vector_type(4)));
#define LDS_WAIT() asm volatile("s_waitcnt lgkmcnt(0)" ::: "memory")

struct Params {
    const float* in[19];
};
struct Frame {
    LAS unsigned char* lds;
    int tid, lane, wave, G, bx, vcu, gw, ngw;
};
__device__ __forceinline__ const float* uptr(const LAS unsigned long long* t, int k) {
    const unsigned long long v = t[k]; const unsigned lo = __builtin_amdgcn_readfirstlane((unsigned)v), hi = __builtin_amdgcn_readfirstlane((unsigned)(v >> 32));
    return (const float*)(const GAS float*)(((unsigned long long)hi << 32) | lo); }

template <class CMap>
__device__ __forceinline__ void transpose_load(float (&v)[32], const float* W, int Nsrc, const float* ks, int kb, int nb, int lane, CMap cmap) {
    const int k0 = 64 * kb, n0 = 32 * nb; const int sc = cmap(n0 + (lane & 31));
#pragma unroll
    for (int i = 0; i < 32; ++i) { const int kk = 2 * i + (lane >> 5); float x = 0.f; if (sc >= 0) x = W[(size_t)(k0 + kk) * Nsrc + sc]; if (ks) x *= ks[k0 + kk]; v[i] = x; }
}
__device__ __forceinline__ void transpose_store(const float (&v)[32], int K, bf16_t* WT, LAS float* scr, int kb, int nb, int lane) {
    const int k0 = 64 * kb, n0 = 32 * nb;
#pragma unroll
    for (int i = 0; i < 32; ++i) scr[(2 * i + (lane >> 5)) * 33 + (lane & 31)] = v[i];
    LDS_WAIT(); asm volatile("" ::: "memory");
    const int c = lane & 7;
#pragma unroll
    for (int j = 0; j < 4; ++j) { const int n = (lane >> 3) + 8 * j; const LAS float* s = scr + (8 * c) * 33 + n;
        u32x4 o; o.x = pk2(s[0 * 33], s[1 * 33]); o.y = pk2(s[2 * 33], s[3 * 33]); o.z = pk2(s[4 * 33], s[5 * 33]); o.w = pk2(s[6 * 33], s[7 * 33]);
        *(u32x4*)(WT + (size_t)(n0 + n) * K + k0 + 8 * c) = o; }
    LDS_WAIT(); asm volatile("" ::: "memory");
}
template <class CMap>
__device__ __forceinline__ void transpose_matrix(const Frame& F, const float* W, int K, int Nsrc, int Ndst, bf16_t* WT, const float* ks, LAS float* scr, CMap cmap) {
    const int nnb = Ndst / 32, items = (K / 64) * nnb;
    for (int it = F.gw; it < items; it += 2 * F.ngw) { const int it2 = it + F.ngw; float va[32], vb[32];
        transpose_load(va, W, Nsrc, ks, it / nnb, it % nnb, F.lane, cmap);
        if (it2 < items) transpose_load(vb, W, Nsrc, ks, it2 / nnb, it2 % nnb, F.lane, cmap);
        transpose_store(va, K, WT, scr, it / nnb, it % nnb, F.lane);
        if (it2 < items) transpose_store(vb, K, WT, scr, it2 / nnb, it2 % nnb, F.lane); }
}
__device__ __forceinline__ int rope_perm(int m) { const int g = m >> 3, j = m & 7; return j < 4 ? 4 * g + j : 32 + 4 * g + (j - 4); }
struct CMapIn { __device__ int operator()(int n) const {
    if (n < 4096) return n; if (n < 4608) return 4112 + (n - 4096); if (n < 4864) return 4624 + (n - 4608);
    if (n < 4928) return 4880 + rope_perm(n - 4864); if (n < 4944) return 4096 + (n - 4928); return -1; } };
struct CMapQ { __device__ int operator()(int n) const { const int h = n / 192, o = n % 192; return o < 128 ? n : h * 192 + 128 + rope_perm(o - 128); } };
struct CMapUp { __device__ int operator()(int n) const { const int pn = n >> 8, j = n & 255; return j < 128 ? 128 * pn + j : DFF + 128 * pn + (j - 128); } };
struct CMapId { __device__ int operator()(int n) const { return n; } };

__device__ __forceinline__ void convert_weights(const Frame& F, unsigned char* ws_, const LAS unsigned long long* pt, int l, size_t wo, int slot) {
    unsigned char* ws = ws_ + wo;
    LAS float* scr = (LAS float*)(F.lds + F.wave * 8448);
    if (slot != 1) {
        const float* w_in = uptr(pt, 3) + (size_t)l * DM * INC; const float* w_uq = uptr(pt, 8) + (size_t)l * 512 * NQ; const float* w_ukv = uptr(pt, 9) + (size_t)l * 256 * NKV;
        const float* w_out = uptr(pt, 10) + (size_t)l * DM * DM; const float* w_dn = uptr(pt, 16) + (size_t)l * DFF * DM;
        const float* qg = uptr(pt, 6) + (size_t)l * 512; const float* kvg = uptr(pt, 7) + (size_t)l * 256;
        transpose_matrix(F, w_in, DM, INC, NIN, (bf16_t*)(ws + WS_WIN), nullptr, scr, CMapIn());
        transpose_matrix(F, w_uq, 512, NQ, NQ, (bf16_t*)(ws + WS_WUQ), qg, scr, CMapQ());
        transpose_matrix(F, w_ukv, 256, NKV, NKV, (bf16_t*)(ws + WS_WUKV), kvg, scr, CMapId());
        transpose_matrix(F, w_out, DM, DM, DM, (bf16_t*)(ws + WS_WOUT), nullptr, scr, CMapId());
        transpose_matrix(F, w_dn, DFF, DM, DM, (bf16_t*)(ws + WS_WDN), nullptr, scr, CMapId());
    }
    if (slot != 0) { const float* w_up = uptr(pt, 13) + (size_t)l * DM * NUP;
        transpose_matrix(F, w_up, DM, NUP, NUP, (bf16_t*)(ws + WS_WUP), nullptr, scr, CMapUp()); }
}
__device__ __forceinline__ void prologue(const Frame& F, unsigned char* ws, const LAS unsigned long long* pt) {
    float* COS = (float*)(ws + WS_COS); float* SIN = (float*)(ws + WS_SIN);
    for (int i = F.bx * 512 + F.tid; i < 4112 * 32; i += F.G * 512) { const int pos = i >> 5, f = i & 31;
        const float inv = powf(10000.0f, -(float)(2 * f) / 64.0f); const float ang = (float)pos * inv; float s, c; sincosf(ang, &s, &c); COS[i] = c; SIN[i] = s; }
    { float* PAR = (float*)(ws + WS_PAR); const int gt = F.bx * 512 + F.tid, nt = F.G * 512;
      for (int i = gt; i < DEPTH * 16; i += nt) PAR[PO_BG + i] = uptr(pt, 4)[i];
      for (int i = gt; i < DEPTH * 1024; i += nt) PAR[PO_MLG + i] = uptr(pt, 5)[i];
      for (int i = gt; i < DEPTH * 512; i += nt) PAR[PO_QG + i] = uptr(pt, 6)[i];
      for (int i = gt; i < DEPTH * 256; i += nt) PAR[PO_KVG + i] = uptr(pt, 7)[i];
      for (int i = gt; i < 2048; i += nt) { PAR[PO_ONE + i] = 1.f; PAR[PO_ZERO + i] = 0.f; }
      { float* ST2 = (float*)(ws + WS_STAT2); for (int i = gt; i < TP; i += nt) { ST2[2 * i] = 0.f; ST2[2 * i + 1] = 1.f; } }
      for (int i = gt; i < DEPTH * 2048; i += nt) { PAR[PO_L1G + i] = uptr(pt, 11)[i]; PAR[PO_L1B + i] = uptr(pt, 12)[i]; PAR[PO_L2G + i] = uptr(pt, 17)[i]; PAR[PO_L2B + i] = uptr(pt, 18)[i]; }
      for (int i = gt; i < DEPTH * 3 * 5632; i += nt) PAR[PO_CW + i] = uptr(pt, 14)[i];
      for (int i = gt; i < DEPTH * 5632; i += nt) PAR[PO_CB + i] = uptr(pt, 15)[i]; }
    float* H = (float*)(ws + WS_H); bf16_t* HB = (bf16_t*)(ws + WS_HB);
    const float* xp = uptr(pt, 0); const float* xs = uptr(pt, 1); const float* mt = uptr(pt, 2);
    for (int row0 = F.gw; row0 < TP; row0 += 2 * F.ngw) {
        f32x4 v[2][8];
#pragma unroll
        for (int r = 0; r < 2; ++r) { const int row = row0 + r * F.ngw; const float* src = nullptr;
            if (row < 4 * LREAL) src = xp + (size_t)row * DM; else if (row < NMAIN) src = xs + (size_t)(row - 4 * LREAL) * DM; else if (row < NTOK) src = mt + (size_t)((row - NMAIN) & 15) * DM;
#pragma unroll
            for (int j = 0; j < 8; ++j) { v[r][j] = (f32x4){0.f, 0.f, 0.f, 0.f}; if (src) v[r][j] = ((const f32x4*)src)[F.lane + 64 * j]; } }
#pragma unroll
        for (int r = 0; r < 2; ++r) { const int row = row0 + r * F.ngw; if (row < TP) {
            f32x4* hd = (f32x4*)(H + (size_t)row * DM) + F.lane; u32x2* bd = (u32x2*)(HB + (size_t)row * DM) + F.lane; u32x2* hb = (u32x2*)((bf16_t*)H + (size_t)row * DM) + F.lane;
#pragma unroll
            for (int j = 0; j < 8; ++j) { const f32x4 x = v[r][j];
                u32x2 w; w.x = pk2(x[0], x[1]); w.y = pk2(x[2], x[3]); bd[64 * j] = w;
                if (row >= NMAIN) hd[64 * j] = x * ALPHA;
                else { u32x2 wh; wh.x = pk2h(x[0], x[1]); wh.y = pk2h(x[2], x[3]); hb[64 * j] = wh; } } } }
    }
}

__device__ __forceinline__ void ln_one(const f32x4 (&vin)[8], int row, int lane, float* __restrict__ Hw, bf16_t* __restrict__ HB, const float* __restrict__ g, const float* __restrict__ b, float* __restrict__ ST) {
    f32x4 v[8]; float s = 0.f;
#pragma unroll
    for (int j = 0; j < 8; ++j) { v[j] = vin[j]; s += (v[j][0] + v[j][1]) + (v[j][2] + v[j][3]); }
    const float mean = wave_sum(s) * (1.f / DM); float q = 0.f;
#pragma unroll
    for (int j = 0; j < 8; ++j) { v[j] = v[j] - mean; q += (v[j][0] * v[j][0] + v[j][1] * v[j][1]) + (v[j][2] * v[j][2] + v[j][3] * v[j][3]); }
    const float rstd = rsqrtf(wave_sum(q) * (1.f / DM) + EPS);
    if (lane == 0) { f32x2 ms = {mean, rstd}; *(f32x2*)(ST + (size_t)row * 2) = ms; }
    u32x2* bd = (u32x2*)(HB + (size_t)row * DM) + lane; f32x4* hp = (f32x4*)(Hw + (size_t)row * DM) + lane;
#pragma unroll
    for (int j = 0; j < 8; ++j) { const f32x4 gg = ((const f32x4*)g)[lane + 64 * j], bb = ((const f32x4*)b)[lane + 64 * j]; const f32x4 y = v[j] * rstd * gg + bb;
        u32x2 w; w.x = pk2(y[0], y[1]); w.y = pk2(y[2], y[3]); bd[64 * j] = w;
        hp[64 * j] = y * ALPHA; }
}
__device__ __forceinline__ void ln_one_bf(const u32x4 (&vin)[4], int row, int lane, bf16_t* __restrict__ HB, const float* __restrict__ g, const float* __restrict__ b, float* __restrict__ ST, float* __restrict__ out) {
    f32x4 v[8]; float s = 0.f;
#pragma unroll
    for (int j = 0; j < 4; ++j) { v[2 * j] = (f32x4){hf_lo(vin[j].x), hf_hi(vin[j].x), hf_lo(vin[j].y), hf_hi(vin[j].y)}; v[2 * j + 1] = (f32x4){hf_lo(vin[j].z), hf_hi(vin[j].z), hf_lo(vin[j].w), hf_hi(vin[j].w)}; }
#pragma unroll
    for (int j = 0; j < 8; ++j) s += (v[j][0] + v[j][1]) + (v[j][2] + v[j][3]);
    const float mean = wave_sum(s) * (1.f / DM); float q = 0.f;
#pragma unroll
    for (int j = 0; j < 8; ++j) { v[j] = v[j] - mean; q += (v[j][0] * v[j][0] + v[j][1] * v[j][1]) + (v[j][2] * v[j][2] + v[j][3] * v[j][3]); }
    const float rstd = rsqrtf(wave_sum(q) * (1.f / DM) + EPS);
    if (lane == 0) { f32x2 ms = {mean, rstd}; *(f32x2*)(ST + (size_t)row * 2) = ms; }
    u32x4* bd = (u32x4*)(HB + (size_t)row * DM) + lane;
#pragma unroll
    for (int j = 0; j < 4; ++j) { const int c4 = 2 * (lane + 64 * j);
        const f32x4 y0 = v[2 * j] * rstd * ((const f32x4*)g)[c4] + ((const f32x4*)b)[c4], y1 = v[2 * j + 1] * rstd * ((const f32x4*)g)[c4 + 1] + ((const f32x4*)b)[c4 + 1];
        if (out) { f32x4* op = (f32x4*)(out + (size_t)row * DM) + c4; op[0] = y0; op[1] = y1; }
        else bd[64 * j] = pg8::pack8(y0, y1); }
}
__device__ __forceinline__ void ln_rows(const Frame& F, float* H, bf16_t* HB, const float* g, const float* b, float* ST, float* out, const float* PART, int nk) {
    const bf16_t* __restrict__ Hr = (const bf16_t*)H;
    for (int row = F.gw; row < NMAIN; row += 4 * F.ngw) {
        const int row2 = row + F.ngw, row3 = row + 2 * F.ngw, row4 = row + 3 * F.ngw;
        u32x4 va[4], vb[4], vc[4], vd[4];
#pragma unroll
        for (int j = 0; j < 4; ++j) va[j] = ((const u32x4*)(Hr + (size_t)row * DM))[F.lane + 64 * j];
#pragma unroll
        for (int j = 0; j < 4; ++j) vb[j] = ((const u32x4*)(Hr + (size_t)row2 * DM))[F.lane + 64 * j];
#pragma unroll
        for (int j = 0; j < 4; ++j) vc[j] = ((const u32x4*)(Hr + (size_t)row3 * DM))[F.lane + 64 * j];
#pragma unroll
        for (int j = 0; j < 4; ++j) vd[j] = ((const u32x4*)(Hr + (size_t)row4 * DM))[F.lane + 64 * j];
        ln_one_bf(va, row, F.lane, HB, g, b, ST, out);
        ln_one_bf(vb, row2, F.lane, HB, g, b, ST, out);
        ln_one_bf(vc, row3, F.lane, HB, g, b, ST, out);
        ln_one_bf(vd, row4, F.lane, HB, g, b, ST, out);
    }
    if (F.gw < TP - NMAIN) {
        const int row = NMAIN + F.gw; const float* __restrict__ Hm = H; f32x4 va[8];
#pragma unroll
        for (int j = 0; j < 8; ++j) va[j] = ((const f32x4*)(Hm + (size_t)row * DM))[F.lane + 64 * j];
        const float* __restrict__ pp0 = PART + (size_t)F.gw * DM;
        int k = 0;
        for (; k + 4 <= nk; k += 4) {
            f32x4 t[4][8];
#pragma unroll
            for (int q = 0; q < 4; ++q)
#pragma unroll
                for (int j = 0; j < 8; ++j) t[q][j] = ((const f32x4*)(pp0 + (size_t)(k + q) * 256 * DM))[F.lane + 64 * j];
#pragma unroll
            for (int q = 0; q < 4; ++q)
#pragma unroll
                for (int j = 0; j < 8; ++j) va[j] += t[q][j]; }
        for (; k < nk; ++k) {
#pragma unroll
            for (int j = 0; j < 8; ++j) va[j] += ((const f32x4*)(pp0 + (size_t)k * 256 * DM))[F.lane + 64 * j]; }
        ln_one(va, row, F.lane, H, HB, g, b, ST);
    }
}

__device__ __forceinline__ void rstd_rows(const Frame& F, const bf16_t* UDQ, const bf16_t* UDKV, float* RSTD) {
    for (int row = F.gw; row < TP; row += F.ngw) {
        const u32x4 a = ((const u32x4*)(UDQ + (size_t)row * 512))[F.lane]; float s = 0.f;
#pragma unroll
        for (int j = 0; j < 4; ++j) { const float x = bf_lo(a[j]), y = bf_hi(a[j]); s += x * x + y * y; }
        float t = 0.f;
        if (F.lane < 32) { const u32x4 c = ((const u32x4*)(UDKV + (size_t)row * 256))[F.lane];
#pragma unroll
            for (int j = 0; j < 4; ++j) { const float x = bf_lo(c[j]), y = bf_hi(c[j]); t += x * x + y * y; } }
        s = wave_sum(s); t = wave_sum(t);
        if (F.lane == 0) { RSTD[(size_t)row * 2] = rsqrtf(s * (1.f / 512.f) + EPS); RSTD[(size_t)row * 2 + 1] = rsqrtf(t * (1.f / 256.f) + EPS); }
    }
}

__device__ __forceinline__ void mlstm_fin_row(int row, int lane, const f32x4 (&hv)[4], const u32x2 (&ov)[4], const float* __restrict__ ng, bf16_t* __restrict__ MIX) {
#pragma unroll
    for (int j = 0; j < 4; ++j) {
        f32x4 v = hv[j];
        const float mean = wave_sum((v[0] + v[1]) + (v[2] + v[3])) * (1.f / 256.f); v = v - mean;
        const float rstd = rsqrtf(wave_sum((v[0] * v[0] + v[1] * v[1]) + (v[2] * v[2] + v[3] * v[3])) * (1.f / 256.f) + EPS);
        const f32x4 gg = ((const f32x4*)(ng + 256 * j))[lane];
        const u32x2 uo = ov[j];
        const float o0 = bf_lo(uo.x), o1 = bf_hi(uo.x), o2 = bf_lo(uo.y), o3 = bf_hi(uo.y);
        const float y0 = v[0] * rstd * gg[0] / (1.f + __expf(-o0)), y1 = v[1] * rstd * gg[1] / (1.f + __expf(-o1));
        const float y2 = v[2] * rstd * gg[2] / (1.f + __expf(-o2)), y3 = v[3] * rstd * gg[3] / (1.f + __expf(-o3));
        u32x2 w; w.x = pk2(y0, y1); w.y = pk2(y2, y3); ((u32x2*)(MIX + (size_t)row * DM + 256 * j))[lane] = w;
    }
}
__device__ __forceinline__ void mlstm_finalize(const Frame& F, int gw0, int ngw0, const float* HSUM, const bf16_t* UQKVO, const float* ng, bf16_t* MIX) {
    const float* __restrict__ Hs = HSUM; const bf16_t* __restrict__ Uo = UQKVO;
    for (int row = gw0; row < TP; row += 4 * ngw0) {
        int rr[4]; bool ok[4];
#pragma unroll
        for (int q = 0; q < 4; ++q) { const int r = row + q * ngw0; ok[q] = r < TP; rr[q] = ok[q] ? r : row; }
        f32x4 hv[4][4]; u32x2 ov[4][4];
#pragma unroll
        for (int q = 0; q < 4; ++q)
#pragma unroll
            for (int j = 0; j < 4; ++j) { hv[q][j] = ((const f32x4*)(Hs + (size_t)rr[q] * MLW + 256 * j))[F.lane]; ov[q][j] = ((const u32x2*)(Uo + (size_t)rr[q] * 4096 + 3072 + 256 * j))[F.lane]; }
#pragma unroll
        for (int q = 0; q < 4; ++q) if (ok[q]) mlstm_fin_row(rr[q], F.lane, hv[q], ov[q], ng, MIX);
    }
}

__device__ __forceinline__ f32x8 ld8f(const float* p) { const f32x4 a = *(const f32x4*)p, b = *(const f32x4*)(p + 4); return (f32x8){a[0], a[1], a[2], a[3], b[0], b[1], b[2], b[3]}; }
__device__ __forceinline__ f32x8 ld8b(const bf16_t* p) { const u32x4 v = *(const u32x4*)p; return (f32x8){bf_lo(v[0]), bf_hi(v[0]), bf_lo(v[1]), bf_hi(v[1]), bf_lo(v[2]), bf_hi(v[2]), bf_lo(v[3]), bf_hi(v[3])}; }
__device__ __forceinline__ void act_store(bf16_t* dst, const f32x8 gp, const f32x8 gc, const f32x8 gn, const f32x8 vv, const f32x8 w0, const f32x8 w1, const f32x8 w2, const f32x8 bb) {
    float o[8];
#pragma unroll
    for (int i = 0; i < 8; ++i) { const float x = w0[i] * gp[i] + w1[i] * gc[i] + w2[i] * gn[i] + bb[i]; o[i] = x / (1.f + __expf(-x)) * vv[i]; }
    u32x4 w; w.x = pk2(o[0], o[1]); w.y = pk2(o[2], o[3]); w.z = pk2(o[4], o[5]); w.w = pk2(o[6], o[7]); *(u32x4*)dst = w;
}
__device__ __forceinline__ void ffn_fixup(const Frame& F, const float* SIDE, const bf16_t* GVM, bf16_t* ACT, const float* cw, const float* cb) {
    constexpr int NCH = DFF / 8;
    const f32x8 zero = {0.f, 0.f, 0.f, 0.f, 0.f, 0.f, 0.f, 0.f};
    const int gt = F.bx * 512 + F.tid, nt = GRID * 512;
    for (int idx = gt; idx < 192 * 2 * NCH; idx += nt) {
        const int ch = idx % NCH, rsel = (idx / NCH) & 1, pm = idx / (2 * NCH), c0 = 8 * ch, sq = pm >> 4;
        const f32x8 w0 = ld8f(cw + c0), w1 = ld8f(cw + DFF + c0), w2 = ld8f(cw + 2 * DFF + c0), bb = ld8f(cb + c0);
        const float* S0 = SIDE + (size_t)pm * 6 * DFF + c0;
        if (rsel == 0) { const f32x8 gp = (pm & 15) ? ld8f(S0 - 6 * DFF + 3 * DFF) : ld8b(GVM + (size_t)(16 * sq + 15) * NUP + c0);
            act_store(ACT + (size_t)(pm * 256) * DFF + c0, gp, ld8f(S0), ld8f(S0 + DFF), ld8f(S0 + 4 * DFF), w0, w1, w2, bb);
        } else { const f32x8 gn = ((pm & 15) != 15) ? ld8f(S0 + 6 * DFF) : zero;
            act_store(ACT + (size_t)(pm * 256 + 255) * DFF + c0, ld8f(S0 + 2 * DFF), ld8f(S0 + 3 * DFF), gn, ld8f(S0 + 5 * DFF), w0, w1, w2, bb); }
    }
    for (int idx = gt; idx < NSEQ * 16 * NCH; idx += nt) {
        const int ch = idx % NCH, rp = idx / NCH, pp = rp & 15, sq = rp >> 4, c0 = 8 * ch;
        const f32x8 w0 = ld8f(cw + c0), w1 = ld8f(cw + DFF + c0), w2 = ld8f(cw + 2 * DFF + c0), bb = ld8f(cb + c0);
        const bf16_t* G0 = GVM + (size_t)(16 * sq + pp) * NUP + c0;
        const f32x8 gp = pp > 0 ? ld8b(G0 - NUP) : zero, gc = ld8b(G0);
        const f32x8 gn = pp < 15 ? ld8b(G0 + NUP) : ld8f(SIDE + (size_t)(16 * sq) * 6 * DFF + c0);
        act_store(ACT + (size_t)(MROW0 + 16 * sq + pp) * DFF + c0, gp, gc, gn, ld8b(G0 + DFF), w0, w1, w2, bb);
    }
}

namespace att {
constexpr int NW = 8, QBLK = 32, KVBLK = 64, NT = 65;
constexpr int KROW = 400;
constexpr int SHM_V = KVBLK * 128 * 2, SHM_K = KVBLK * KROW;
constexpr int OFF_V = 0, OFF_K = 3 * SHM_V, OFF_WS = OFF_K + 3 * SHM_K, LDS_TOTAL = OFF_WS + NW * 64 * 4;
static_assert(LDS_TOTAL <= RING_BYTES, "attention LDS");
constexpr float SCALE = 0.07216878364870323f;
constexpr float THR = 8.f;
#define SBAR() __builtin_amdgcn_sched_barrier(0)
__device__ __forceinline__ int crow(int r, int hi) { return (r & 3) + 8 * (r >> 2) + 4 * hi; }
__device__ __forceinline__ unsigned cvtpk(float lo, float hi) { unsigned r; asm volatile("v_cvt_pk_bf16_f32 %0, %1, %2" : "=v"(r) : "v"(lo), "v"(hi)); return r; }

template <bool MASK16>
__device__ __forceinline__ void partialSM(f32x16& p0, f32x16& p1, float& m_reg, float& mn, float& alpha) {
    constexpr float C = SCALE * 1.4426950408889634f;
    if (MASK16) {
#pragma unroll
        for (int r = 8; r < 16; ++r) p0[r] = NEGBIG;
#pragma unroll
        for (int r = 0; r < 16; ++r) p1[r] = NEGBIG;
    }
    float pmax = p0[0];
#pragma unroll
    for (int r = 1; r < 16; ++r) pmax = fmaxf(pmax, p0[r]);
#pragma unroll
    for (int r = 0; r < 16; ++r) pmax = fmaxf(pmax, p1[r]);
    { auto rr = __builtin_amdgcn_permlane32_swap(__float_as_uint(pmax), __float_as_uint(pmax), false, false); pmax = fmaxf(__uint_as_float(rr[0]), __uint_as_float(rr[1])); }
    if (__builtin_expect(__all(pmax - m_reg <= THR / SCALE), 1)) { mn = m_reg; alpha = 1.f; }
    else { mn = fmaxf(m_reg, pmax); alpha = __builtin_amdgcn_exp2f((m_reg - mn) * C); m_reg = mn; }
    const float mnC = -mn * C;
#pragma unroll
    for (int r = 0; r < 16; ++r) p0[r] = fmaf(p0[r], C, mnC);
#pragma unroll
    for (int r = 0; r < 16; ++r) p1[r] = fmaf(p1[r], C, mnC);
#pragma unroll
    for (int r = 0; r < 16; ++r) p0[r] = __builtin_amdgcn_exp2f(p0[r]);
}
__device__ __forceinline__ void finishSM(f32x16& p0, f32x16& p1, float alpha, float& l_reg, bf16x8& pa0, bf16x8& pa1, bf16x8& pa2, bf16x8& pa3) {
#pragma unroll
    for (int r = 0; r < 16; ++r) p1[r] = __builtin_amdgcn_exp2f(p1[r]);
    float ps = 0;
#pragma unroll
    for (int r = 0; r < 16; ++r) ps += p0[r];
#pragma unroll
    for (int r = 0; r < 16; ++r) ps += p1[r];
    { auto rr = __builtin_amdgcn_permlane32_swap(__float_as_uint(ps), __float_as_uint(ps), false, false); ps = __uint_as_float(rr[0]) + __uint_as_float(rr[1]); }
    l_reg = l_reg * alpha + ps;
#define PK4(P, BASE, OUT) do { unsigned a0 = cvtpk(P[BASE + 0], P[BASE + 1]), a1 = cvtpk(P[BASE + 2], P[BASE + 3]);   \
    unsigned b0 = cvtpk(P[BASE + 4], P[BASE + 5]), b1 = cvtpk(P[BASE + 6], P[BASE + 7]);                              \
    auto r0 = __builtin_amdgcn_permlane32_swap(a0, b0, false, false); auto r1 = __builtin_amdgcn_permlane32_swap(a1, b1, false, false); \
    u32x4 w = {r0[0], r1[0], r0[1], r1[1]}; OUT = __builtin_bit_cast(bf16x8, w); } while (0)
    PK4(p0, 0, pa0); PK4(p0, 8, pa1); PK4(p1, 0, pa2); PK4(p1, 8, pa3);
#undef PK4
}
__device__ __forceinline__ void qkt(f32x16& p0, f32x16& p1, const LAS char* Ks, const bf16x8* qr, int r32, int hi) {
#pragma unroll
    for (int r = 0; r < 16; ++r) { p0[r] = 0.f; p1[r] = 0.f; }
#pragma unroll
    for (int d0 = 0; d0 < 12; ++d0) { const int cb = (d0 * 16 + hi * 8) * 2;
        const bf16x8 b0 = *(const LAS bf16x8*)(Ks + r32 * KROW + cb);
        const bf16x8 b1 = *(const LAS bf16x8*)(Ks + (32 + r32) * KROW + cb);
        p0 = __builtin_amdgcn_mfma_f32_32x32x16_bf16(b0, qr[d0], p0, 0, 0, 0);
        p1 = __builtin_amdgcn_mfma_f32_32x32x16_bf16(b1, qr[d0], p1, 0, 0, 0); }
}
__device__ __forceinline__ int v_st(int k, int c) { const int kk = (k & ~0xC) | ((k & 4) << 1) | ((k & 8) >> 1); return ((kk >> 3) * 4 + (c >> 5)) * 512 + ((kk & 7) * 32 + (c & 31)) * 2; }
__device__ __forceinline__ int v_rd_base(int lane) { return ((lane & 3) << 3) | (((lane >> 2) & 3) << 6) | (((lane >> 4) & 1) << 5) | (((lane >> 5) & 1) << 8); }
constexpr int v_rd_off(int d0, int ks, int half) { return d0 * 512 + ks * 4096 + half * 2048; }
template <int OFF> __device__ __forceinline__ s16x4 tr_read(int vb) { s16x4 r; asm volatile("ds_read_b64_tr_b16 %0, %1 offset:%2" : "=&v"(r) : "v"(vb), "i"(OFF) : "memory"); return r; }
template <int D0> __device__ __forceinline__ void pv_one(f32x16& od, int vb, bf16x8 pa0, bf16x8 pa1, bf16x8 pa2, bf16x8 pa3) {
    const s16x4 l0 = tr_read<v_rd_off(D0, 0, 0)>(vb), h0 = tr_read<v_rd_off(D0, 0, 1)>(vb), l1 = tr_read<v_rd_off(D0, 1, 0)>(vb), h1 = tr_read<v_rd_off(D0, 1, 1)>(vb);
    const s16x4 l2 = tr_read<v_rd_off(D0, 2, 0)>(vb), h2 = tr_read<v_rd_off(D0, 2, 1)>(vb), l3 = tr_read<v_rd_off(D0, 3, 0)>(vb), h3 = tr_read<v_rd_off(D0, 3, 1)>(vb);
    asm volatile("s_waitcnt lgkmcnt(0)" ::: "memory"); SBAR();
#define PKV(L, H) (bf16x8){L[0], L[1], L[2], L[3], H[0], H[1], H[2], H[3]}
    od = __builtin_amdgcn_mfma_f32_32x32x16_bf16(pa0, PKV(l0, h0), od, 0, 0, 0);
    od = __builtin_amdgcn_mfma_f32_32x32x16_bf16(pa1, PKV(l1, h1), od, 0, 0, 0);
    od = __builtin_amdgcn_mfma_f32_32x32x16_bf16(pa2, PKV(l2, h2), od, 0, 0, 0);
    od = __builtin_amdgcn_mfma_f32_32x32x16_bf16(pa3, PKV(l3, h3), od, 0, 0, 0);
#undef PKV
}
__device__ __forceinline__ void pv_d0(f32x16* o, int vb, bf16x8 pa0, bf16x8 pa1, bf16x8 pa2, bf16x8 pa3) {
    pv_one<0>(o[0], vb, pa0, pa1, pa2, pa3); pv_one<1>(o[1], vb, pa0, pa1, pa2, pa3); pv_one<2>(o[2], vb, pa0, pa1, pa2, pa3); pv_one<3>(o[3], vb, pa0, pa1, pa2, pa3);
}

__device__ __forceinline__ void attn_unit(int s, int h, int qb, const bf16_t* __restrict__ MQ, const bf16_t* __restrict__ MKV, const bf16_t* __restrict__ KR, bf16_t* __restrict__ MIX, LAS char* lds) {
    int tid_ = threadIdx.x; asm volatile("" : "+v"(tid_));
    const int tid = tid_, wid = tid >> 6, lane = tid & 63, r32 = lane & 31, hi = lane >> 5;
    LAS char* V_lds = lds + OFF_V; LAS char* K_lds = lds + OFF_K;
    LAS float* wsf = (LAS float*)(lds + OFF_WS) + wid * 64; LAS float* li_l = wsf; LAS float* al_l = wsf + 32;
    float m_reg = NEGBIG, l_reg = 0; f32x16 o[4]; bf16x8 qr[12];
#pragma unroll
    for (int d = 0; d < 4; ++d)
#pragma unroll
        for (int r = 0; r < 16; ++r) o[d][r] = 0.f;
    const int qi = wid * QBLK + r32;
    const unsigned qrow = qb < 16 ? (unsigned)s * LREAL + 256 * qb + qi : (unsigned)MROW0 + 16 * s + (qi < 15 ? qi : 15);
    { const bf16_t* Qw = MQ + (qrow * NQ + h * 192 + hi * 8);
#pragma unroll
      for (int d0 = 0; d0 < 12; ++d0) qr[d0] = *(const bf16x8*)(Qw + d0 * 16); }
    const int sr = tid >> 4, sc = (tid & 15) * 8, vst0 = v_st(sr, sc), vst1 = v_st(32 + sr, sc);
    const int kr_r = tid >> 3, kr_c = (tid & 7) * 8;
    const int vb0 = (int)(uintptr_t)V_lds + v_rd_base(lane);
    bf16x8 vs0, vs1, ks0, ks1, kr0;
    const unsigned mainrow0 = (unsigned)s * LREAL, metarow0 = (unsigned)MROW0 + 16 * s;
    const bf16_t* MKVh = MKV + h * 256;
#define KROWG(kt, k) ((kt) < 64 ? mainrow0 + 64u * (kt) + (k) : metarow0 + ((k) < 15 ? (k) : 15))
#define SLOAD(kt) do { const unsigned g0 = KROWG(kt, sr) * NKV + sc, g1 = KROWG(kt, 32 + sr) * NKV + sc, g2 = KROWG(kt, kr_r) * 64 + kr_c; \
    vs0 = *(const bf16x8*)(MKVh + 128 + g0); vs1 = *(const bf16x8*)(MKVh + 128 + g1); \
    ks0 = *(const bf16x8*)(MKVh + g0); ks1 = *(const bf16x8*)(MKVh + g1); kr0 = *(const bf16x8*)(KR + g2); } while (0)
#define SWRITE(b) do { *(LAS bf16x8*)(V_lds + (b) * SHM_V + vst0) = vs0; *(LAS bf16x8*)(V_lds + (b) * SHM_V + vst1) = vs1; \
    *(LAS bf16x8*)(K_lds + (b) * SHM_K + sr * KROW + sc * 2) = ks0; *(LAS bf16x8*)(K_lds + (b) * SHM_K + (32 + sr) * KROW + sc * 2) = ks1; \
    *(LAS bf16x8*)(K_lds + (b) * SHM_K + kr_r * KROW + 256 + kr_c * 2) = kr0; } while (0)
#define RESC(a) do { if (__any((a) < 1.f)) { if (hi == 0) al_l[r32] = (a); asm volatile("s_waitcnt lgkmcnt(0)" ::: "memory"); \
    _Pragma("unroll") for (int d = 0; d < 4; ++d) _Pragma("unroll") for (int r = 0; r < 16; ++r) o[d][r] *= al_l[crow(r, hi)]; } } while (0)
    f32x16 pA0, pA1, pB0, pB1; float mnA, mnB, alA, alB; bf16x8 pa0, pa1, pa2, pa3;
    __syncthreads();
    SLOAD(0); SWRITE(0); __syncthreads();
    qkt(pA0, pA1, K_lds, qr, r32, hi); partialSM<false>(pA0, pA1, m_reg, mnA, alA);
    SLOAD(1); SWRITE(1); __syncthreads();
    RESC(alA);
    int s0 = 0, s1 = 1, s2 = 2;
    for (int j = 1; j + 1 < NT; j += 2) {
        SBAR(); qkt(pB0, pB1, K_lds + s1 * SHM_K, qr, r32, hi);
        finishSM(pA0, pA1, alA, l_reg, pa0, pa1, pa2, pa3); SBAR();
        SLOAD(j + 1); SBAR();
        pv_d0(o, vb0 + s0 * SHM_V, pa0, pa1, pa2, pa3); partialSM<false>(pB0, pB1, m_reg, mnB, alB);
        SWRITE(s2);
        RESC(alB); __syncthreads();
        SBAR(); qkt(pA0, pA1, K_lds + s2 * SHM_K, qr, r32, hi);
        finishSM(pB0, pB1, alB, l_reg, pa0, pa1, pa2, pa3); SBAR();
        if (j + 2 < NT) SLOAD(j + 2); SBAR();
        pv_d0(o, vb0 + s1 * SHM_V, pa0, pa1, pa2, pa3);
        if (j + 1 == NT - 1) partialSM<true>(pA0, pA1, m_reg, mnA, alA); else partialSM<false>(pA0, pA1, m_reg, mnA, alA);
        if (j + 2 < NT) SWRITE(s0);
        RESC(alA); __syncthreads();
        { const int t0 = s0, t1 = s1; s0 = s2; s1 = t0; s2 = t1; }
    }
    finishSM(pA0, pA1, alA, l_reg, pa0, pa1, pa2, pa3); SBAR();
    pv_d0(o, vb0 + s0 * SHM_V, pa0, pa1, pa2, pa3);
    if (hi == 0) li_l[r32] = l_reg; asm volatile("s_waitcnt lgkmcnt(0)" ::: "memory");
    float rli[16];
#pragma unroll
    for (int r = 0; r < 16; ++r) rli[r] = __builtin_amdgcn_rcpf(li_l[crow(r, hi)]);
    if (qb < 16) {
        bf16_t* Ow = MIX + ((long)s * LREAL + 256 * qb + wid * QBLK) * DM + MLW + h * 128;
#pragma unroll
        for (int r = 0; r < 16; ++r) { const int orow = crow(r, hi);
#pragma unroll
            for (int d0 = 0; d0 < 4; ++d0) Ow[(long)orow * DM + d0 * 32 + r32] = (bf16_t)(pk2(o[d0][r] * rli[r], 0.f) & 0xffffu); }
    } else if (wid == 0) {
        bf16_t* Ow = MIX + ((long)MROW0 + 16 * s) * DM + MLW + h * 128;
#pragma unroll
        for (int r = 0; r < 16; ++r) { const int orow = crow(r, hi);
            if (orow < 16) {
#pragma unroll
                for (int d0 = 0; d0 < 4; ++d0) Ow[(long)orow * DM + d0 * 32 + r32] = (bf16_t)(pk2(o[d0][r] * rli[r], 0.f) & 0xffffu); } }
    }
#undef KROWG
#undef SLOAD
#undef SWRITE
#undef RESC
}
__device__ __forceinline__ void attn_phase(int vcu, const bf16_t* MQ, const bf16_t* MKV, const bf16_t* KR, bf16_t* MIX, LAS char* lds) {
    for (int i = (vcu < 96 ? -1 : 0); i < 6; ++i) { int sh, qb; if (i < 0) { sh = vcu; qb = 16; } else { const int id = i * GRID + vcu; sh = id >> 4; qb = id & 15; }
        attn_unit(sh >> 3, sh & 7, qb, MQ, MKV, KR, MIX, lds); }
}
#undef SBAR
}

namespace ml {
constexpr int QI = 0, KI = 32768, VI = 65536, SI = 81920, CI = 98304;
constexpr int SC_CT = 0, SC_BM = 64, SC_WI = 128, SC_EI = 192, SC_WW = 256, SC_DEN = 320, SC_QN = 448, SC_N = 512, SC_A = 768;
constexpr int GP_REC = 200;
__device__ __forceinline__ unsigned off_b(unsigned row, unsigned ch) { return 256u * row + 16u * (ch ^ (((row & 3) << 2) | ((row >> 2) & 3))); }
__device__ __forceinline__ unsigned row_read_addr_16(unsigned lane, unsigned rb, unsigned s) { return off_b((lane & 15) + 16 * rb, 4 * s + (lane >> 4)); }
__device__ __forceinline__ unsigned tr_read_addr_16(unsigned lane, unsigned c, unsigned ks, unsigned t) {
    const unsigned g = lane >> 4, q = (lane & 15) >> 2, p = lane & 3; return off_b(32 * ks + 8 * g + 4 * t + q, 2 * c + (p >> 1)) + 8 * (p & 1); }
__device__ __forceinline__ bf16x8 tr_frag(unsigned a0, unsigned a1) {
    const s16x4 lo = __builtin_amdgcn_ds_read_tr16_b64_v4i16((LAS s16x4*)a0), hi = __builtin_amdgcn_ds_read_tr16_b64_v4i16((LAS s16x4*)a1);
    return (bf16x8){lo[0], lo[1], lo[2], lo[3], hi[0], hi[1], hi[2], hi[3]};
}
__device__ __forceinline__ f32x4 mfma16(bf16x8 a, bf16x8 b, f32x4 c) { return __builtin_amdgcn_mfma_f32_16x16x32_bf16(a, b, c, 0, 0, 0); }
__device__ __forceinline__ float log_sigmoid(float x) { return fminf(x, 0.f) - __logf(1.f + __expf(-fabsf(x))); }

__device__ __forceinline__ void gate_prep(int gw, int ngw, int lane, const float* __restrict__ GATES, const float* __restrict__ bgl, float* __restrict__ GP) {
    for (int it = gw; it < 96 * 65; it += ngw) {
        const int chain = it / 65, c = it % 65, s = chain >> 3, hd = (chain >> 1) & 3, dir = chain & 1;
        const long g = c == 0 ? (lane >= 48 ? (long)MROW0 + 16 * s + lane - 48 : -1L) : (long)s * LREAL + 64 * (c - 1) + lane;
        float li = NEGBIG, lf = 0.f;
        if (g >= 0) { li = GATES[g * 16 + (dir ? 8 : 0) + hd] + bgl[(dir ? 8 : 0) + hd]; lf = log_sigmoid(GATES[g * 16 + (dir ? 12 : 4) + hd] + bgl[(dir ? 12 : 4) + hd]); }
        float x = dir ? __shfl(lf, 63 - lane) : lf;
#pragma unroll
        for (int o = 1; o < 64; o <<= 1) { const float y = __shfl_up(x, o); if (lane >= o) x += y; }
        const float btot = __shfl(x, 63);
        const float b = dir ? __shfl(x, 63 - lane) : x;
        const float a_s = li - b;
        float pm = dir ? __shfl(a_s, 63 - lane) : a_s;
#pragma unroll
        for (int o = 1; o < 64; o <<= 1) { const float y = __shfl_up(pm, o); if (lane >= o) pm = fmaxf(pm, y); }
        pm = dir ? __shfl(pm, 63 - lane) : pm;
        const float gmax = wave_max(btot - b + li);
        float* rec = GP + (size_t)it * GP_REC;
        rec[lane] = b; rec[64 + lane] = li; rec[128 + lane] = pm; if (lane == 0) { rec[192] = btot; rec[193] = gmax; }
    }
}

__device__ __forceinline__ void mlstm_unit(int s, int hd, int js, const bf16_t* __restrict__ UQKVO, const float* __restrict__ GP, float* __restrict__ HSUM, LAS unsigned char* lds, LAS float* sc) {
    const int wid = __builtin_amdgcn_readfirstlane((int)threadIdx.x >> 6);
    const unsigned ldsb = (unsigned)(uintptr_t)lds;
    const int tt = wid >> 1, nb = 2 * (wid & 1);
#define ROWRD(img, rb, s_) (*(const LAS bf16x8*)(uintptr_t)(RB[s_] + (unsigned)((img) + 4096 * (rb))))
#define TRFRAG(img, c_, ks) tr_frag(BT[0][(c_) & 1] + TQ[(c_) >> 1] + (unsigned)((img) + 8192 * (ks)), BT[1][(c_) & 1] + TQ[(c_) >> 1] + (unsigned)((img) + 8192 * (ks)))
    f32x4 accC[2][4], accN[2];
    for (int dir = 0; dir < 2; ++dir) {
        int tid; { int t0_ = threadIdx.x; asm volatile("" : "+v"(t0_)); tid = t0_; }
#pragma unroll
        for (int mi = 0; mi < 2; ++mi)
#pragma unroll
            for (int c = 0; c < 4; ++c) accC[mi][c] = (f32x4){0.f, 0.f, 0.f, 0.f};
        accN[0] = (f32x4){0.f, 0.f, 0.f, 0.f}; accN[1] = (f32x4){0.f, 0.f, 0.f, 0.f};
        if (tid < 256) sc[SC_N + tid] = 0.f;
        for (int i = tid; i < 32768 / 16; i += 512) *(LAS u32x4*)(lds + CI + i * 16) = (u32x4){0u, 0u, 0u, 0u};
        float m_state = 0.f;
        const float* GPc = GP + (size_t)(((s * 4 + hd) * 2 + dir) * 65) * GP_REC;
        u32x4 sq[4], sk[4], sv; float sb = 0.f, sli = NEGBIG, spm = NEGBIG, sbt = 0.f, sgm = NEGBIG;
#define ROWG(c, r) ((c) == 0 ? ((r) >= 48 ? (long)MROW0 + 16 * s + (r) - 48 : -1L) : (long)s * LREAL + 64 * ((c) - 1) + (r))
#define STAGE_LOAD(c) do { \
        _Pragma("unroll") for (int i = 0; i < 4; ++i) { const int id = tid + 512 * i, r = id >> 5, ch = id & 31; const long g = ROWG(c, r); \
            sq[i] = (u32x4){0u, 0u, 0u, 0u}; sk[i] = (u32x4){0u, 0u, 0u, 0u}; \
            if (g >= 0) { sq[i] = *(const u32x4*)(UQKVO + g * 4096 + hd * 256 + ch * 8); sk[i] = *(const u32x4*)(UQKVO + g * 4096 + 1024 + hd * 256 + ch * 8); } } \
        { const int r = tid >> 3, ch = tid & 7; const long g = ROWG(c, r); sv = (u32x4){0u, 0u, 0u, 0u}; if (g >= 0) sv = *(const u32x4*)(UQKVO + g * 4096 + 2048 + hd * 256 + js * 64 + ch * 8); } \
        if (tid < 64) { const float* rec = GPc + (size_t)(c) * GP_REC; sb = rec[tid]; sli = rec[64 + tid]; spm = rec[128 + tid]; sbt = rec[192]; sgm = rec[193]; } } while (0)
#define STAGE_WRITE() do { \
        _Pragma("unroll") for (int i = 0; i < 4; ++i) { const int id = tid + 512 * i, r = id >> 5, ch = id & 31; \
            *(LAS u32x4*)(lds + QI + (ch >> 4) * 16384 + off_b(r, ch & 15)) = sq[i]; *(LAS u32x4*)(lds + KI + (ch >> 4) * 16384 + off_b(r, ch & 15)) = sk[i]; } \
        { const int r = tid >> 3, ch = tid & 7; *(LAS u32x4*)(lds + VI + off_b(r, ch)) = sv; } \
        if (tid < 64) { const float m_inter = sb + m_state, mt = fmaxf(m_inter, sb + spm); const float m_new = fmaxf(sbt + m_state, sgm); \
            sc[SC_CT + tid] = sli - sb; sc[SC_BM + tid] = sb - mt; sc[SC_WI + tid] = __expf(m_inter - mt); sc[SC_EI + tid] = __expf(-mt); \
            sc[SC_WW + tid] = __expf(sbt - sb + sli - m_new) * 0.0625f; if (tid == 0) sc[SC_A] = __expf(sbt + m_state - m_new); m_state = m_new; } } while (0)
        const int c_first = dir ? 64 : 0, c_step = dir ? -1 : 1;
        STAGE_LOAD(c_first);
        __syncthreads();
        STAGE_WRITE();
        for (int ci = 0; ci < 65; ++ci) {
            const int c = c_first + c_step * ci;
            { int t2_ = threadIdx.x; asm volatile("" : "+v"(t2_)); tid = t2_; }
            const int lane = tid & 63, l15 = lane & 15, lg = lane >> 4;
            unsigned RB[4], BT[2][2], TQ[4];
            { const unsigned fl = ((l15 & 3) << 2) | (l15 >> 2), q = l15 >> 2, p = lane & 3, g = lg;
#pragma unroll
              for (int s_ = 0; s_ < 4; ++s_) { RB[s_] = ldsb + 256u * l15 + 16u * (lg ^ (fl & 3)) + 64u * (s_ ^ (fl >> 2)); TQ[s_] = 64u * (s_ ^ q); }
#pragma unroll
              for (int t_ = 0; t_ < 2; ++t_)
#pragma unroll
                  for (int cl = 0; cl < 2; ++cl) BT[t_][cl] = ldsb + 256u * (8 * g + q) + 8u * (p & 1) + 1024u * t_ + 16u * ((p >> 1) ^ t_) + 32u * (cl ^ (g & 1)); }
            __syncthreads();
            if (ci + 1 < 65) STAGE_LOAD(c + c_step);
            bf16x8 qf[8];
#pragma unroll
            for (int k = 0; k < 8; ++k) qf[k] = ROWRD(QI + (k >> 2) * 16384, tt, k & 3);
            f32x4 sT[2], oc[2];
#pragma unroll
            for (int i = 0; i < 2; ++i) { sT[i] = (f32x4){0.f, 0.f, 0.f, 0.f}; oc[i] = (f32x4){0.f, 0.f, 0.f, 0.f}; }
#pragma unroll
            for (int i = 0; i < 2; ++i)
#pragma unroll
                for (int k = 0; k < 8; ++k) {
                    const bf16x8 kf = ROWRD(KI + (k >> 2) * 16384, nb + i, k & 3);
                    sT[i] = mfma16(kf, qf[k], sT[i]);
                    const bf16x8 cf = ROWRD(CI + (k >> 2) * 16384, nb + i, k & 3);
                    oc[i] = mfma16(qf[k], cf, oc[i]);
                }
            {
                const int t = 16 * tt + l15; const float bmt = sc[SC_BM + t]; float rs = 0.f;
#pragma unroll
                for (int i = 0; i < 2; ++i) { const int s0 = 16 * (nb + i) + 4 * lg; const f32x4 ctv = *(const LAS f32x4*)(sc + SC_CT + s0); float v[4];
#pragma unroll
                    for (int e = 0; e < 4; ++e) { const int sx = s0 + e; const bool ok = dir ? (sx >= t) : (sx <= t);
                        const float ex = ok ? (bmt + ctv[e]) : NEGBIG; v[e] = sT[i][e] * 0.0625f * __expf(ex); rs += v[e]; }
                    u32x2 w; w.x = pk2(v[0], v[1]); w.y = pk2(v[2], v[3]);
                    *(LAS u32x2*)(lds + SI + off_b(t, s0 >> 3) + (s0 & 7) * 2) = w; }
                rs += __shfl_xor(rs, 16); rs += __shfl_xor(rs, 32);
                if (lg == 0) sc[SC_DEN + 64 * (wid & 1) + t] = rs;
            }
            { const int r = tid >> 3, ch = tid & 7; const u32x4 v = *(const LAS u32x4*)(lds + VI + off_b(r, ch)); const float w = sc[SC_WW + r]; u32x4 o;
#pragma unroll
              for (int jx = 0; jx < 4; ++jx) o[jx] = pk2(bf_lo(v[jx]) * w, bf_hi(v[jx]) * w);
              *(LAS u32x4*)(lds + VI + off_b(r, 8 + ch)) = o; }
            { const int r = tid >> 3, part = tid & 7; float d = 0.f;
#pragma unroll
              for (int i = 0; i < 4; ++i) { const int ch32 = part * 4 + i; const u32x4 v = *(const LAS u32x4*)(lds + QI + (ch32 >> 4) * 16384 + off_b(r, ch32 & 15));
                  const f32x4 n0 = *(const LAS f32x4*)(sc + SC_N + ch32 * 8), n1 = *(const LAS f32x4*)(sc + SC_N + ch32 * 8 + 4);
                  d += bf_lo(v[0]) * n0[0] + bf_hi(v[0]) * n0[1] + bf_lo(v[1]) * n0[2] + bf_hi(v[1]) * n0[3] + bf_lo(v[2]) * n1[0] + bf_hi(v[2]) * n1[1] + bf_lo(v[3]) * n1[2] + bf_hi(v[3]) * n1[3]; }
              d += __shfl_xor(d, 1); d += __shfl_xor(d, 2); d += __shfl_xor(d, 4);
              if (part == 0) sc[SC_QN + r] = d; }
            { const f32x4 wi = *(const LAS f32x4*)(sc + SC_WI + 16 * tt + 4 * lg);
#pragma unroll
              for (int i = 0; i < 2; ++i) oc[i] = oc[i] * wi; }
            __syncthreads();
            const float a_dec = sc[SC_A];
#pragma unroll
            for (int ks = 0; ks < 2; ++ks) { const bf16x8 sf = ROWRD(SI, tt, ks);
#pragma unroll
                for (int i = 0; i < 2; ++i) { const bf16x8 vf = TRFRAG(VI, nb + i, ks);
                    oc[i] = mfma16(sf, vf, oc[i]); } }
            { const int t0 = 16 * tt + 4 * lg;
              const f32x4 wi = *(const LAS f32x4*)(sc + SC_WI + t0), qn = *(const LAS f32x4*)(sc + SC_QN + t0), d0 = *(const LAS f32x4*)(sc + SC_DEN + t0), d1 = *(const LAS f32x4*)(sc + SC_DEN + 64 + t0), ei = *(const LAS f32x4*)(sc + SC_EI + t0);
#pragma unroll
              for (int e = 0; e < 4; ++e) { const long g = ROWG(c, t0 + e);
                const float den = wi[e] * qn[e] + (d0[e] + d1[e]); const float inv = 1.f / fmaxf(fabsf(den), ei[e]);
                if (g >= 0) {
#pragma unroll
                    for (int i = 0; i < 2; ++i) { float* hp = HSUM + g * MLW + hd * 256 + js * 64 + 16 * (nb + i) + l15; const float hv = oc[i][e] * inv; if (dir) unsafeAtomicAdd(hp, hv); else *hp = hv; } } } }
#pragma unroll
            for (int mi = 0; mi < 2; ++mi)
#pragma unroll
                for (int cc = 0; cc < 4; ++cc) accC[mi][cc] = accC[mi][cc] * a_dec;
            accN[0] = accN[0] * a_dec; accN[1] = accN[1] * a_dec;
            const unsigned ktq = (unsigned)(KI + (wid >> 2) * 16384) + 64u * ((unsigned)(wid & 3) ^ (unsigned)(l15 >> 2));
#pragma unroll
            for (int ks = 0; ks < 2; ++ks) {
                bf16x8 kf[2], wf[4];
#pragma unroll
                for (int mi = 0; mi < 2; ++mi) kf[mi] = tr_frag(BT[0][mi] + ktq + (unsigned)(8192 * ks), BT[1][mi] + ktq + (unsigned)(8192 * ks));
#pragma unroll
                for (int cc = 0; cc < 4; ++cc) wf[cc] = TRFRAG(VI, 4 + cc, ks);
                { const f32x4 wa = *(const LAS f32x4*)(sc + SC_WW + 32 * ks + 8 * lg), wb = *(const LAS f32x4*)(sc + SC_WW + 32 * ks + 8 * lg + 4);
                  u32x4 wq; wq.x = pk2(wa[0], wa[1]); wq.y = pk2(wa[2], wa[3]); wq.z = pk2(wb[0], wb[1]); wq.w = pk2(wb[2], wb[3]);
                  if (l15 != 0) wq = (u32x4){0u, 0u, 0u, 0u};
                  const bf16x8 wfn = __builtin_bit_cast(bf16x8, wq);
#pragma unroll
                  for (int mi = 0; mi < 2; ++mi) accN[mi] = mfma16(kf[mi], wfn, accN[mi]); }
#pragma unroll
                for (int mi = 0; mi < 2; ++mi)
#pragma unroll
                    for (int cc = 0; cc < 4; ++cc) accC[mi][cc] = mfma16(kf[mi], wf[cc], accC[mi][cc]);
            }
#pragma unroll
            for (int mi = 0; mi < 2; ++mi)
#pragma unroll
                for (int cc = 0; cc < 4; ++cc) { const int dk0 = 32 * wid + 16 * mi + 4 * lg, dv = 16 * cc + l15; u32x2 w; w.x = pk2(accC[mi][cc][0], accC[mi][cc][1]); w.y = pk2(accC[mi][cc][2], accC[mi][cc][3]);
                    *(LAS u32x2*)(lds + CI + (dk0 >> 7) * 16384 + off_b(dv, (dk0 & 127) >> 3) + (dk0 & 7) * 2) = w; }
            if (l15 == 0) { *(LAS f32x4*)(sc + SC_N + 32 * wid + 4 * lg) = accN[0]; *(LAS f32x4*)(sc + SC_N + 32 * wid + 16 + 4 * lg) = accN[1]; }
            __syncthreads();
            if (ci + 1 < 65) STAGE_WRITE();
        }
    }
#undef ROWG
#undef STAGE_LOAD
#undef STAGE_WRITE
#undef ROWRD
#undef TRFRAG
}
__device__ __forceinline__ void mlstm_phase(int bx, const bf16_t* UQKVO, const float* GP, float* HSUM, LAS unsigned char* lds, LAS float* sc) {
    if (bx >= 192) return;
    const int xcd = bx & 7, idx = bx >> 3, pair = xcd * 6 + (idx >> 2), js = idx & 3;
    mlstm_unit(pair >> 2, pair & 3, js, UQKVO, GP, HSUM, lds, sc);
}
}

#ifndef PHM
#define PHM 0xffff
#endif
#ifndef REP_ML
#define REP_ML 1
#endif
#ifndef REP_ATTN
#define REP_ATTN 1
#endif
#ifndef REP_CONV
#define REP_CONV 1
#endif
#ifndef REP_SMALL
#define REP_SMALL 1
#endif
#ifndef KV_SPLIT
#define KV_SPLIT 193
#endif
#ifndef REP_WIN
#define REP_WIN 1
#endif
#ifndef REP_UP
#define REP_UP 1
#endif
__global__ void __launch_bounds__(512, 2) fwd_kernel(Params P, unsigned char* ws_arg, unsigned char* out_arg) {
    extern __shared__ __attribute__((aligned(16))) unsigned char lds_raw[];
    Frame F;
    F.lds = (LAS unsigned char*)lds_raw;
    F.tid = threadIdx.x; F.lane = F.tid & 63; F.wave = __builtin_amdgcn_readfirstlane(F.tid >> 6);
    F.G = GRID; F.bx = blockIdx.x; F.vcu = (F.bx % 8) * (GRID / 8) + F.bx / 8;
    F.gw = F.vcu * 8 + F.wave; F.ngw = F.G * 8;
    { unsigned char* ws0 = ws_arg;
      for (int u = F.tid; u < (LDS_BYTES - MISC_OFF) / 4; u += 512) ((LAS unsigned*)(F.lds + MISC_OFF))[u] = 0u;
      __syncthreads();
      (void)ws0; }
    LAS unsigned long long* ptab = (LAS unsigned long long*)(F.lds + MISC_OFF + 64);
    if (F.tid == 0) {
#pragma unroll
        for (int k = 0; k < 19; ++k) ptab[k] = (unsigned long long)(uintptr_t)P.in[k]; }
    __syncthreads();
    XcdBarrier bar = xcd_barrier_post((unsigned*)(ws_arg + WS_CTL) + CW_BAR, (volatile LAS unsigned*)(F.lds + MISC_OFF));
    LAS float* sc = (LAS float*)(F.lds + MISC_OFF + 1024);
#define BXL() ({ int b__ = F.bx; asm volatile("" : "+s"(b__)); b__; })
#define PFRAME() Frame Fp = F; { int t_ = threadIdx.x; asm volatile("" : "+v"(t_)); Fp.tid = t_; Fp.lane = t_ & 63; int b_ = BXL(); Fp.bx = b_; Fp.vcu = (b_ % 8) * (GRID / 8) + b_ / 8; Fp.gw = Fp.vcu * 8 + Fp.wave; }
#define WSB() ({ GAS unsigned char* w__ = (GAS unsigned char*)ws_arg; asm volatile("" : "+s"(w__)); (unsigned char*)w__; })
#ifndef STAG_N
#define STAG_N 1
#endif
#ifdef STAG_ON
#define STAGGER() do { int s__ = (BXL() * 37) & 255; for (int i__ = 0; i__ < s__; ++i__) __builtin_amdgcn_s_sleep(STAG_N); } while (0)
#else
#define STAGGER() do {} while (0)
#endif
#define WOFS(l_) (((l_) & 1) ? WSET_DELTA : (size_t)0)
#define DOB() ({ GAS unsigned char* w__ = (GAS unsigned char*)out_arg; asm volatile("" : "+s"(w__)); (unsigned char*)w__; })

    { unsigned char* ws = WSB(); prologue(F, ws, ptab); convert_weights(F, ws, ptab, 0, 0, -1); }
    xcd_barrier(bar);

    for (int l = 0; l < DEPTH; ++l) {
        { unsigned char* ws = WSB();
          pg8::Gemm g{(bf16_t*)(ws + WS_HB), (bf16_t*)(ws + WOFS(l) + WS_WIN), TP, NIN, DM, DM}; pg8::PanelOrder S; S.init(NPAN, 0, 0, 0, NIN, F.G, BXL());
          pg8::EpiWin E{(bf16_t*)(ws + WS_UQKVO), (bf16_t*)(ws + WS_UDQ), (bf16_t*)(ws + WS_UDKV), (bf16_t*)(ws + WS_KR), (float*)(ws + WS_GATES), (const float*)(ws + WS_COS), (const float*)(ws + WS_SIN)};
#if PHM & 2
          STAGGER(); pg8::gemm_phase<pg8::EpiWin, pg8::PanelOrder, true, true>(F.lds, g, S, E);
#endif
        }
        if (l + 1 < DEPTH && BXL() >= 20) { unsigned char* ws = WSB(); PFRAME(); Fp.gw = (Fp.bx - 20) * 8 + Fp.wave; Fp.ngw = (GRID - 20) * 8; convert_weights(Fp, ws, ptab, l + 1, WOFS(l + 1), 0); }
#if REP_WIN > 1
        __syncthreads();
        { unsigned char* ws = WSB();
          pg8::Gemm g{(bf16_t*)(ws + WS_HB), (bf16_t*)(ws + WOFS(l) + WS_WIN), TP, NIN, DM, DM}; pg8::PanelOrder S; S.init(NPAN, 0, 0, 0, NIN, F.G, BXL());
          pg8::EpiWin E{(bf16_t*)(ws + WS_UQKVO), (bf16_t*)(ws + WS_UDQ), (bf16_t*)(ws + WS_UDKV), (bf16_t*)(ws + WS_KR), (float*)(ws + WS_GATES), (const float*)(ws + WS_COS), (const float*)(ws + WS_SIN)};
          pg8::gemm_phase<pg8::EpiWin, pg8::PanelOrder, true, true>(F.lds, g, S, E);
        }
#endif
        xcd_barrier(bar);
        { unsigned char* ws = WSB(); unsigned char* dob = DOB(); PFRAME(); rstd_rows(Fp, (bf16_t*)(ws + WS_UDQ), (bf16_t*)(ws + WS_UDKV), (float*)(ws + WS_RSTD));
          ml::gate_prep(Fp.gw, Fp.ngw, Fp.lane, (const float*)(ws + WS_GATES), (const float*)(ws + WS_PAR) + PO_BG + l * 16, (float*)(dob + DO_GP)); }
#if REP_SMALL > 1
        { unsigned char* ws = WSB(); unsigned char* dob = DOB(); PFRAME(); rstd_rows(Fp, (bf16_t*)(ws + WS_UDQ), (bf16_t*)(ws + WS_UDKV), (float*)(ws + WS_RSTD));
          ml::gate_prep(Fp.gw, Fp.ngw, Fp.lane, (const float*)(ws + WS_GATES), (const float*)(ws + WS_PAR) + PO_BG + l * 16, (float*)(dob + DO_GP)); }
#endif
        xcd_barrier(bar);
        if (F.bx >= 192) {
        { unsigned char* ws = WSB(); unsigned char* dob = DOB();
          pg8::Gemm g{(bf16_t*)(ws + WS_UDQ), (bf16_t*)(ws + WOFS(l) + WS_WUQ), TP, NQ, 512, 512}; pg8::PanelOrder S; S.init(NPAN, 0, 0, 0, NQ, GRID - 192, BXL() - 192);
          pg8::EpiQ E{(bf16_t*)(dob + DO_MQ), (const float*)(ws + WS_RSTD), (const float*)(ws + WS_COS), (const float*)(ws + WS_SIN)};
#if PHM & 4
          pg8::gemm_phase<pg8::EpiQ, pg8::PanelOrder, true, true>(F.lds, g, S, E);
#endif
        }
        { unsigned char* ws = WSB();
          pg8::Gemm g{(bf16_t*)(ws + WS_UDKV), (bf16_t*)(ws + WOFS(l) + WS_WUKV), TP, NKV, 256, 256}; pg8::PanelOrder S; S.init(NPAN, 0, 0, 0, NKV, GRID - 192, BXL() - 192);
          pg8::EpiBf16G E{(bf16_t*)(ws + WS_MKV), NKV, (const float*)(ws + WS_RSTD) + 1, 0, -1, 0};
#if PHM & 8
          pg8::gemm_phase<pg8::EpiBf16G, pg8::PanelOrder, true, true>(F.lds, g, S, E);
#endif
        }
        } else {
#ifndef NO_ML
        for (int rep_ = 0; rep_ < REP_ML; ++rep_)
        { unsigned char* ws = WSB(); unsigned char* dob = DOB();
          ml::mlstm_phase(BXL(), (const bf16_t*)(ws + WS_UQKVO), (const float*)(dob + DO_GP), (float*)(dob + DO_HSUM), F.lds, sc); }
#endif
        }
        xcd_barrier(bar);
        { unsigned char* ws = WSB(); unsigned char* dob = DOB(); PFRAME();
          if (Fp.vcu >= 96) mlstm_finalize(Fp, (Fp.vcu - 96) * 8 + Fp.wave, (GRID - 96) * 8, (const float*)(dob + DO_HSUM), (const bf16_t*)(ws + WS_UQKVO), (const float*)(ws + WS_PAR) + PO_MLG + l * MLW, (bf16_t*)(ws + WS_HB)); }
#ifndef NO_ATTN
        for (int rep_ = 0; rep_ < REP_ATTN; ++rep_)
        { unsigned char* ws = WSB(); unsigned char* dob = DOB();
          att::attn_phase(({ int b__ = BXL(); (b__ % 8) * (GRID / 8) + b__ / 8; }), (const bf16_t*)(dob + DO_MQ), (const bf16_t*)(ws + WS_MKV), (const bf16_t*)(ws + WS_KR), (bf16_t*)(ws + WS_HB), (LAS char*)F.lds); }
#endif
        xcd_barrier(bar);
        { unsigned char* ws = WSB();
          pg8::Gemm g{(bf16_t*)(ws + WS_HB), (bf16_t*)(ws + WOFS(l) + WS_WOUT), TP, DM, DM, DM}; pg8::PanelOrder S; S.init(192, 0, 0, 0, DM, F.G, BXL());
          pg8::EpiResidLn E{(bf16_t*)(ws + WS_H), DM, ALPHA, (const float*)(ws + WS_STAT2), (const float*)(ws + WS_PAR) + (l > 0 ? PO_L2G + (l - 1) * DM : PO_ONE), (const float*)(ws + WS_PAR) + (l > 0 ? PO_L2B + (l - 1) * DM : PO_ZERO)};
#if PHM & 16
          STAGGER(); pg8::gemm_phase<pg8::EpiResidLn, pg8::PanelOrder, true, true>(F.lds, g, S, E);
#endif
        }
        { unsigned char* ws = WSB();
          pg8::Gemm g{(bf16_t*)(ws + WS_HB), (bf16_t*)(ws + WOFS(l) + WS_WOUT), TP, DM, DM / 4, DM}; pg8::SplitOrder S; S.init(PMETA, DM, 4, F.G, BXL());
          pg8::EpiPart E{(float*)(ws + WS_PART), DM};
#if PHM & 16
          pg8::gemm_phase<pg8::EpiPart, pg8::SplitOrder, true, true>(F.lds, g, S, E);
#endif
        }
        xcd_barrier(bar);
        { unsigned char* ws = WSB(); PFRAME(); ln_rows(Fp, (float*)(ws + WS_H), (bf16_t*)(ws + WS_HB), (const float*)(ws + WS_PAR) + PO_L1G + l * DM, (const float*)(ws + WS_PAR) + PO_L1B + l * DM, (float*)(ws + WS_STAT1), nullptr, (const float*)(ws + WS_PART), 4); }
        xcd_barrier(bar);
        { unsigned char* ws = WSB(); unsigned char* dob = DOB();
          pg8::Gemm g{(bf16_t*)(ws + WS_HB), (bf16_t*)(ws + WOFS(l) + WS_WUP), TP, NUP, DM, DM}; pg8::PanelOrder S; S.init(NPAN, 0, 0, 0, NUP, F.G, BXL());
          pg8::EpiFfn E{(bf16_t*)(ws + WS_ACT), (float*)(dob + DO_SIDE), (bf16_t*)(dob + DO_GVM), (const float*)(ws + WS_PAR) + PO_CW + (size_t)l * 3 * DFF, (const float*)(ws + WS_PAR) + PO_CB + (size_t)l * DFF, (LAS float*)(F.lds + MISC_OFF + 8192)};
#if PHM & 32
          STAGGER(); pg8::gemm_phase<pg8::EpiFfn, pg8::PanelOrder, true, true>(F.lds, g, S, E);
#if REP_UP > 1
          __syncthreads(); pg8::gemm_phase<pg8::EpiFfn, pg8::PanelOrder, true, true>(F.lds, g, S, E);
#endif
#endif
        }
        if (l + 1 < DEPTH && BXL() >= 44) { unsigned char* ws = WSB(); PFRAME(); Fp.gw = (Fp.bx - 44) * 8 + Fp.wave; Fp.ngw = (GRID - 44) * 8; convert_weights(Fp, ws, ptab, l + 1, WOFS(l + 1), 1); }
        xcd_barrier(bar);
        { unsigned char* ws = WSB(); unsigned char* dob = DOB(); PFRAME();
          ffn_fixup(Fp, (const float*)(dob + DO_SIDE), (const bf16_t*)(dob + DO_GVM), (bf16_t*)(ws + WS_ACT), (const float*)(ws + WS_PAR) + PO_CW + (size_t)l * 3 * DFF, (const float*)(ws + WS_PAR) + PO_CB + (size_t)l * DFF); }
#if REP_SMALL > 1
        { unsigned char* ws = WSB(); unsigned char* dob = DOB(); PFRAME();
          ffn_fixup(Fp, (const float*)(dob + DO_SIDE), (const bf16_t*)(dob + DO_GVM), (bf16_t*)(ws + WS_ACT), (const float*)(ws + WS_PAR) + PO_CW + (size_t)l * 3 * DFF, (const float*)(ws + WS_PAR) + PO_CB + (size_t)l * DFF); }
#endif
        xcd_barrier(bar);
        { unsigned char* ws = WSB();
          pg8::Gemm g{(bf16_t*)(ws + WS_ACT), (bf16_t*)(ws + WOFS(l) + WS_WDN), TP, DM, DFF, DFF}; pg8::PanelOrder S; S.init(192, 0, 0, 0, DM, F.G, BXL());
          pg8::EpiResidLn E{(bf16_t*)(ws + WS_H), DM, ALPHA, (const float*)(ws + WS_STAT1), (const float*)(ws + WS_PAR) + PO_L1G + l * DM, (const float*)(ws + WS_PAR) + PO_L1B + l * DM};
#if PHM & 64
          STAGGER(); pg8::gemm_phase<pg8::EpiResidLn, pg8::PanelOrder, true, true>(F.lds, g, S, E);
#endif
        }
        { unsigned char* ws = WSB();
          pg8::Gemm g{(bf16_t*)(ws + WS_ACT), (bf16_t*)(ws + WOFS(l) + WS_WDN), TP, DM, DFF / 11, DFF}; pg8::SplitOrder S; S.init(PMETA, DM, 11, F.G, BXL());
          pg8::EpiPart E{(float*)(ws + WS_PART), DM};
#if PHM & 64
          pg8::gemm_phase<pg8::EpiPart, pg8::SplitOrder, true, true>(F.lds, g, S, E);
#endif
        }
        xcd_barrier(bar);
        { unsigned char* ws = WSB(); unsigned char* dob = DOB();
          PFRAME(); ln_rows(Fp, (float*)(ws + WS_H), (bf16_t*)(ws + WS_HB), (const float*)(ws + WS_PAR) + PO_L2G + l * DM, (const float*)(ws + WS_PAR) + PO_L2B + l * DM, (float*)(ws + WS_STAT2), l == DEPTH - 1 ? (float*)dob : nullptr, (const float*)(ws + WS_PART), 11); }
#if REP_CONV > 1
#endif
        xcd_barrier(bar);
    }
}

extern "C" void kernel_launch(void* const* d_in, const int* in_sizes, int n_in, void* d_out, int out_size, void* d_ws, size_t ws_size, hipStream_t stream) {
    static int grid = 0;
    if (grid == 0) {
        if (n_in != 19 || out_size != NMAIN * DM || ws_size < WS_NEED) { fprintf(stderr, "kernel_launch: unexpected shapes (n_in %d out %d ws %zu need %zu)\n", n_in, out_size, ws_size, (size_t)WS_NEED); grid = -1; return; }
        int dev = 0, cus = 0;
        if (hipGetDevice(&dev) != hipSuccess || hipDeviceGetAttribute(&cus, hipDeviceAttributeMultiprocessorCount, dev) != hipSuccess) { grid = -1; return; }
        if (hipFuncSetAttribute((const void*)fwd_kernel, hipFuncAttributeMaxDynamicSharedMemorySize, LDS_BYTES) != hipSuccess) { fprintf(stderr, "kernel_launch: hipFuncSetAttribute failed\n"); grid = -1; return; }
        int per_cu = 0;
        if (hipOccupancyMaxActiveBlocksPerMultiprocessor(&per_cu, (const void*)fwd_kernel, 512, LDS_BYTES) != hipSuccess || per_cu < 1) { fprintf(stderr, "kernel_launch: occupancy query says %d blocks per CU\n", per_cu); (void)hipGetLastError(); grid = -1; return; }
        if (cus < GRID) { fprintf(stderr, "kernel_launch: needs %d CUs, device has %d\n", GRID, cus); grid = -1; return; }
        grid = GRID;
    }
    if (grid < 0) return;
    (void)hipMemsetAsync((char*)d_ws + WS_CTL, 0, CTL_BYTES, stream);
    Params p{};
    for (int i = 0; i < 19; ++i) p.in[i] = (const float*)d_in[i];
    hipLaunchKernelGGL(fwd_kernel, dim3(grid), dim3(512), LDS_BYTES, stream, p, (unsigned char*)d_ws, (unsigned char*)d_out);
}
```

```cpp
#include <hip/hip_runtime.h>
#include <cstdio>
#include <cstdint>

#define LAS __attribute__((address_space(3)))
#define GAS __attribute__((address_space(1)))
typedef float f32x2 __attribute__((ext_vector_type(2)));
typedef float f32x8 __attribute__((ext_vector_type(8)));
typedef float f32x16 __attribute__((ext_vector_type(16)));
typedef unsigned u32x2 __attribute__((ext_vector_type(2)));
typedef short s16x4 __attribute__((ext_vector_type(4)));
typedef __bf16 bf16x2v __attribute__((ext_vector_type(2)));

constexpr int DM = 2048, NSEQ = 12, LREAL = 4096, NMETA = 16, DEPTH = 4;
constexpr int NMAIN = NSEQ * LREAL;
constexpr int MROW0 = NMAIN;
constexpr int NTOK = NMAIN + NSEQ * NMETA;
constexpr int NPAN = 193, TP = NPAN * 256;
constexpr int PMETA = 192;
constexpr int INC = 4944, NIN = 5120;
constexpr int DFF = 5632, NUP = 2 * DFF;
constexpr int MLW = 1024, NQ = 1536, NKV = 2048;
constexpr float ALPHA = 1.681792830507429f;
constexpr float EPS = 1e-5f;
constexpr float NEGBIG = -1e30f;

constexpr size_t MiB = 1u << 20;
constexpr size_t WS_CTL = 0, CTL_BYTES = 1 * MiB;
constexpr size_t WS_COS = 1 * MiB;
constexpr size_t WS_SIN = WS_COS + (size_t)4112 * 32 * 4;
constexpr size_t WS_PAR = 2 * MiB + 128 * 1024;
constexpr int PO_BG = 0, PO_MLG = PO_BG + DEPTH * 16, PO_QG = PO_MLG + DEPTH * 1024, PO_KVG = PO_QG + DEPTH * 512, PO_L1G = PO_KVG + DEPTH * 256, PO_L1B = PO_L1G + DEPTH * 2048,
              PO_CW = PO_L1B + DEPTH * 2048, PO_CB = PO_CW + DEPTH * 3 * 5632, PO_L2G = PO_CB + DEPTH * 5632, PO_L2B = PO_L2G + DEPTH * 2048, PO_ONE = PO_L2B + DEPTH * 2048, PO_ZERO = PO_ONE + 2048, PO_END = PO_ZERO + 2048;
static_assert(WS_PAR + (size_t)PO_END * 4 <= 3 * MiB && WS_PAR >= 1 * MiB + 2 * 4112 * 32 * 4, "PAR block placement");
constexpr size_t WS_WIN = 3 * MiB;
constexpr size_t WS_WUQ = WS_WIN + (size_t)NIN * DM * 2;
constexpr size_t WS_WUKV = WS_WUQ + (size_t)NQ * 512 * 2;
constexpr size_t WS_WOUT = WS_WUKV + (size_t)NKV * 256 * 2;
constexpr size_t WS_WUP = WS_WOUT + (size_t)DM * DM * 2;
constexpr size_t WS_WDN = WS_WUP + (size_t)NUP * DM * 2;
constexpr size_t WS_STAT1 = WS_WDN + (size_t)DM * DFF * 2;
constexpr size_t WS_STAT2 = WS_CTL + 512 * 1024;
constexpr size_t WS_H = 100 * MiB;
constexpr size_t WS_PART = WS_H + 208 * MiB;
static_assert((size_t)NMAIN * DM * 2 <= 208 * MiB && 208 * MiB + (size_t)11 * 256 * DM * 4 <= (size_t)NMAIN * DM * 4, "PART sits between the bf16 rows and the f32 meta rows of H");
constexpr size_t WS_WSET2 = WS_H + 240 * MiB;
constexpr size_t WSET_BYTES = WS_STAT1 - WS_WIN, WSET_DELTA = WS_WSET2 - WS_WIN;
static_assert(WS_PART + (size_t)11 * 256 * DM * 4 <= WS_WSET2 && WS_WSET2 + WSET_BYTES <= WS_H + (size_t)NMAIN * DM * 4, "second weight set sits between the split-K parts and the f32 meta rows of H");
constexpr size_t WS_HB = WS_H + (size_t)TP * DM * 4;
constexpr size_t WS_R = WS_HB + (size_t)TP * DM * 2;
constexpr size_t WS_UQKVO = WS_R;
constexpr size_t WS_UDQ = WS_UQKVO + (size_t)TP * 4096 * 2;
constexpr size_t WS_UDKV = WS_UDQ + (size_t)TP * 512 * 2;
constexpr size_t WS_GATES = WS_UDKV + (size_t)TP * 256 * 2;
constexpr size_t WS_MKV = WS_GATES + (size_t)TP * 16 * 4;
constexpr size_t WS_KR = WS_MKV + (size_t)TP * NKV * 2;
constexpr size_t WS_RSTD = WS_KR + (size_t)TP * 64 * 2;
constexpr size_t WS_END_A = WS_RSTD + (size_t)TP * 2 * 4;
constexpr size_t WS_ACT = WS_R;
constexpr size_t WS_END_B = WS_ACT + (size_t)TP * DFF * 2;
constexpr size_t WS_NEED = (WS_END_A > WS_END_B ? WS_END_A : WS_END_B);
static_assert(WS_STAT1 + (size_t)TP * 8 <= WS_H && WS_STAT2 + (size_t)TP * 8 <= WS_CTL + CTL_BYTES, "weights and row statistics fit below H");
constexpr size_t DO_HSUM = 0;
constexpr size_t DO_MQ = DO_HSUM + (size_t)TP * MLW * 4;
constexpr size_t DO_GP = 340 * MiB;
constexpr size_t DO_SIDE = 0;
constexpr size_t DO_GVM = 32 * MiB;
static_assert(DO_MQ + (size_t)TP * NQ * 2 <= DO_GP && DO_GP + (size_t)96 * 65 * 200 * 4 <= (size_t)NMAIN * DM * 4 && (size_t)192 * 6 * DFF * 4 <= DO_GVM && DO_GVM + (size_t)256 * NUP * 2 <= (size_t)NMAIN * DM * 4, "d_out scratch fits");
constexpr int CW_BAR = 4096;

constexpr int RING_BYTES = 131072;
constexpr int MISC_OFF = RING_BYTES;
constexpr int LDS_BYTES = 147456;
constexpr int GRID = 256;

__device__ __forceinline__ int pos_of_row(int row) { return row < NMAIN ? NMETA + (row & (LREAL - 1)) : ((row - NMAIN) & (NMETA - 1)); }
__device__ __forceinline__ unsigned pk2(float lo, float hi) { f32x2 v = {lo, hi}; return __builtin_bit_cast(unsigned, __builtin_convertvector(v, bf16x2v)); }
__device__ __forceinline__ float bf_lo(unsigned w) { return __uint_as_float(w << 16); }
__device__ __forceinline__ float bf_hi(unsigned w) { return __uint_as_float(w & 0xffff0000u); }
typedef _Float16 f16x2v __attribute__((ext_vector_type(2)));
__device__ __forceinline__ unsigned pk2h(float lo, float hi) { f32x2 v = {lo, hi}; return __builtin_bit_cast(unsigned, __builtin_convertvector(v, f16x2v)); }
__device__ __forceinline__ float hf_lo(unsigned w) { return (float)__builtin_bit_cast(f16x2v, w)[0]; }
__device__ __forceinline__ float hf_hi(unsigned w) { return (float)__builtin_bit_cast(f16x2v, w)[1]; }
__device__ __forceinline__ float wave_sum(float v) {
#pragma unroll
    for (int o = 1; o < 64; o <<= 1) v += __shfl_xor(v, o);
    return v;
}
__device__ __forceinline__ float wave_max(float v) {
#pragma unroll
    for (int o = 1; o < 64; o <<= 1) v = fmaxf(v, __shfl_xor(v, o));
    return v;
}
namespace pg8 {
#define PG8_LAS __attribute__((address_space(3)))
typedef unsigned short bf16_t;
typedef short bf16x8 __attribute__((ext_vector_type(8)));
typedef float f32x4 __attribute__((ext_vector_type(4)));
typedef unsigned u32x4 __attribute__((ext_vector_type(4)));
constexpr int BM = 256, BK = 64, HALF = 128, HTB = HALF * BK * 2  , STAGE_BYTES = 8 * HTB, NXCD = 8, WGM = 4;

__host__ __device__ __forceinline__ int lds_byte(int r, int c) { const int st = (r >> 4) * 2 + (c >> 5), rr = r & 15, cc = c & 31, ob = rr * 64 + cc * 2; return st * 1024 + (ob ^ (((ob >> 9) & 1) << 5)); }
__host__ __device__ __forceinline__ void stage_rc(int b, int& R, int& C) { const int st = b / 1024, sb = b % 1024, swz = sb ^ (((sb >> 9) & 1) << 5); R = (st >> 1) * 16 + swz / 64; C = (st & 1) * 32 + (swz % 64) / 2; }
__host__ __device__ __forceinline__ int perm32(int rho) { const int n = rho >> 4, i = rho & 15; return 8 * (i >> 2) + 4 * n + (i & 3); }

struct Unit { int pm, pn, kk; };
struct Gemm { const bf16_t* A; const bf16_t* Bt; int M, N, K, ld; };

struct PanelOrder {
    int nM, nN, nwg, G, c, nMain, pm0, pmx;
    __device__ void init(int nMain_, int pm0_, int extra, int pmx_, int N, int G_, int c_) { nMain = nMain_; pm0 = pm0_; pmx = pmx_; nM = nMain_ + extra; nN = N / BM; nwg = nM * nN; G = G_; c = c_; }
    __device__ bool next(int i, Unit& u) const {
        const long L = (long)i * G + c; if (L >= nwg) return false;
        int wgid = (int)L; { const int q = nwg / NXCD, r = nwg % NXCD, xcd = wgid % NXCD, off = wgid / NXCD; wgid = (xcd < r ? xcd * (q + 1) : r * (q + 1) + (xcd - r) * q) + off; }
        const int nig = WGM * nN, gid = wgid / nig, fm = gid * WGM, gsz = (nM - fm) < WGM ? (nM - fm) : WGM;
        const int pl = fm + ((wgid % nig) % gsz); u.pm = pl < nMain ? pm0 + pl : pmx; u.pn = (wgid % nig) / gsz; u.kk = 0; return true;
    }
    __device__ __forceinline__ void a_ready(const Unit&) const {}
    __device__ __forceinline__ void done(const Unit&) const {}
};

struct SplitOrder {
    int pm, nN, nwg, G, c;
    __device__ void init(int pm_, int N, int nsplit, int G_, int c_) { pm = pm_; nN = N / BM; nwg = nN * nsplit; G = G_; c = c_; }
    __device__ bool next(int i, Unit& u) const { const int L = i * G + c; if (L >= nwg) return false; u.pm = pm; u.pn = L % nN; u.kk = L / nN; return true; }
    __device__ __forceinline__ void a_ready(const Unit&) const {}
    __device__ __forceinline__ void done(const Unit&) const {}
};

__device__ __forceinline__ u32x4 pack8(const f32x4 v0, const f32x4 v1) { u32x4 w; w.x = pk2(v0[0], v0[1]); w.y = pk2(v0[2], v0[3]); w.z = pk2(v1[0], v1[1]); w.w = pk2(v1[2], v1[3]); return w; }

struct EpiBf16G {
    static constexpr bool PERM = true, AFTER_DRAIN = false, PERMA = false;
    bf16_t* O; int ldc; const float* rs; int pm_sub, pm_sp, pm_sp_out;
    __device__ __forceinline__ void operator()(const f32x4 (&acc)[2][2][4][2], const Unit& u, int wr, int wc, int fr, int fq) const {
        const int opm = (u.pm == pm_sp) ? pm_sp_out : u.pm - pm_sub;
        const int rin = u.pm * BM + wr * 64 + fr, rout = opm * BM + wr * 64 + fr, col0 = u.pn * BM + wc * 32 + 8 * fq;
#pragma unroll
        for (int ai = 0; ai < 2; ++ai)
#pragma unroll
            for (int m = 0; m < 4; ++m) { const float sc = rs ? rs[(size_t)(rin + ai * HALF + m * 16) * 2] : 1.f;
                bf16_t* rowp = O + (size_t)(rout + ai * HALF + m * 16) * ldc + col0;
#pragma unroll
                for (int bj = 0; bj < 2; ++bj) *(u32x4*)(rowp + bj * HALF) = pack8(acc[ai][bj][m][0] * sc, acc[ai][bj][m][1] * sc); }
    }
};
struct EpiWin {
    static constexpr bool PERM = true, AFTER_DRAIN = false, PERMA = false;
    bf16_t *UQKVO, *UDQ, *UDKV, *KR; float* GATES; const float *COS, *SIN;
    __device__ __forceinline__ void operator()(const f32x4 (&acc)[2][2][4][2], const Unit& u, int wr, int wc, int fr, int fq) const {
        const int row0 = u.pm * BM + wr * 64 + fr;
        if (u.pn < 19) {
            bf16_t* base; int ldc, colt;
            if (u.pn < 16) { base = UQKVO; ldc = 4096; colt = u.pn * BM; } else if (u.pn < 18) { base = UDQ; ldc = 512; colt = (u.pn - 16) * BM; } else { base = UDKV; ldc = 256; colt = 0; }
            const int col0 = colt + wc * 32 + 8 * fq;
#pragma unroll
            for (int ai = 0; ai < 2; ++ai)
#pragma unroll
                for (int m = 0; m < 4; ++m) { bf16_t* rowp = base + (size_t)(row0 + ai * HALF + m * 16) * ldc + col0;
#pragma unroll
                    for (int bj = 0; bj < 2; ++bj) *(u32x4*)(rowp + bj * HALF) = pack8(acc[ai][bj][m][0], acc[ai][bj][m][1]); }
        } else {
            if (wc < 2) { const int g = 4 * wc + fq;
#pragma unroll
                for (int ai = 0; ai < 2; ++ai)
#pragma unroll
                    for (int m = 0; m < 4; ++m) { const int row = row0 + ai * HALF + m * 16, pos = pos_of_row(row);
                        const f32x4 cs = *(const f32x4*)(COS + pos * 32 + 4 * g), sn = *(const f32x4*)(SIN + pos * 32 + 4 * g);
                        const f32x4 x1 = acc[ai][0][m][0], x2 = acc[ai][0][m][1];
                        *(u32x4*)(KR + (size_t)row * 64 + 8 * g) = pack8(x1 * cs - x2 * sn, x1 * sn + x2 * cs); }
            } else if (wc == 2 && fq < 2) {
#pragma unroll
                for (int ai = 0; ai < 2; ++ai)
#pragma unroll
                    for (int m = 0; m < 4; ++m) { float* gp = GATES + (size_t)(row0 + ai * HALF + m * 16) * 16 + 8 * fq;
                        *(f32x4*)gp = acc[ai][0][m][0]; *(f32x4*)(gp + 4) = acc[ai][0][m][1]; }
            }
        }
    }
};
struct EpiQ {
    static constexpr bool PERM = true, AFTER_DRAIN = false, PERMA = false;
    bf16_t* MQ; const float *RSTD, *COS, *SIN;
    __device__ __forceinline__ void operator()(const f32x4 (&acc)[2][2][4][2], const Unit& u, int wr, int wc, int fr, int fq) const {
        const int row0 = u.pm * BM + wr * 64 + fr, colb = u.pn * BM + wc * 32 + 8 * fq;
#pragma unroll
        for (int ai = 0; ai < 2; ++ai)
#pragma unroll
            for (int m = 0; m < 4; ++m) { const int row = row0 + ai * HALF + m * 16, pos = pos_of_row(row); const float sc = RSTD[(size_t)row * 2];
#pragma unroll
                for (int bj = 0; bj < 2; ++bj) { const int col0 = colb + bj * HALF, o = col0 % 192;
                    f32x4 v0 = acc[ai][bj][m][0] * sc, v1 = acc[ai][bj][m][1] * sc;
                    if (o >= 128) { const int g = (o - 128) >> 3; const f32x4 cs = *(const f32x4*)(COS + pos * 32 + 4 * g), sn = *(const f32x4*)(SIN + pos * 32 + 4 * g);
                        const f32x4 x1 = v0, x2 = v1; v0 = x1 * cs - x2 * sn; v1 = x1 * sn + x2 * cs; }
                    *(u32x4*)(MQ + (size_t)row * NQ + col0) = pack8(v0, v1); } }
    }
};
__device__ __forceinline__ void resid_ln_tile(float* __restrict__ Cw, const float* __restrict__ Cr, const float* __restrict__ st, const float* __restrict__ g, const float* __restrict__ b,
                                              int ldc, float alpha, const f32x4 (&acc)[2][2][4][2], int row0, int col0) {
    asm volatile("" ::: "memory");
#pragma unroll
    for (int ai = 0; ai < 2; ++ai)
#pragma unroll
        for (int bj = 0; bj < 2; ++bj) {
            f32x4 gv[2], bv[2], hv[4][2]; f32x2 ms[4];
#pragma unroll
            for (int n = 0; n < 2; ++n) { gv[n] = *(const f32x4*)(g + col0 + bj * HALF + n * 16) * alpha; bv[n] = *(const f32x4*)(b + col0 + bj * HALF + n * 16) * alpha; }
#pragma unroll
            for (int m = 0; m < 4; ++m) { const int row = row0 + ai * HALF + m * 16; ms[m] = *(const f32x2*)(st + (size_t)row * 2);
#pragma unroll
                for (int n = 0; n < 2; ++n) hv[m][n] = *(const f32x4*)(Cr + (size_t)row * ldc + col0 + bj * HALF + n * 16); }
#pragma unroll
            for (int m = 0; m < 4; ++m) { const int row = row0 + ai * HALF + m * 16;
#pragma unroll
                for (int n = 0; n < 2; ++n) *(f32x4*)(Cw + (size_t)row * ldc + col0 + bj * HALF + n * 16) = (hv[m][n] - ms[m][0]) * ms[m][1] * gv[n] + bv[n] + acc[ai][bj][m][n]; }
        }
}
__device__ __forceinline__ void resid_ln_tile_bf(bf16_t* __restrict__ Cw, const bf16_t* __restrict__ Cr, const float* __restrict__ st, const float* __restrict__ g, const float* __restrict__ b,
                                                 int ldc, float alpha, const f32x4 (&acc)[2][2][4][2], int row0, int col0) {
    asm volatile("" ::: "memory");
    f32x4 gv[2][2], bv[2][2];
#pragma unroll
    for (int bj = 0; bj < 2; ++bj)
#pragma unroll
        for (int n = 0; n < 2; ++n) { gv[bj][n] = *(const f32x4*)(g + col0 + bj * HALF + n * 4); bv[bj][n] = *(const f32x4*)(b + col0 + bj * HALF + n * 4); }
#pragma unroll
    for (int ai = 0; ai < 2; ++ai) {
        u32x4 hv[2][4]; f32x2 ms[4];
#pragma unroll
        for (int m = 0; m < 4; ++m) { const int row = row0 + ai * HALF + m * 16; ms[m] = *(const f32x2*)(st + (size_t)row * 2);
#pragma unroll
            for (int bj = 0; bj < 2; ++bj) hv[bj][m] = *(const u32x4*)(Cr + (size_t)row * ldc + col0 + bj * HALF); }
#pragma unroll
        for (int bj = 0; bj < 2; ++bj)
#pragma unroll
            for (int m = 0; m < 4; ++m) { const int row = row0 + ai * HALF + m * 16; const u32x4 h = hv[bj][m]; const float mean = ms[m][0], rstd = ms[m][1];
                const f32x4 h0 = {hf_lo(h.x), hf_hi(h.x), hf_lo(h.y), hf_hi(h.y)}, h1 = {hf_lo(h.z), hf_hi(h.z), hf_lo(h.w), hf_hi(h.w)};
                const f32x4 o0 = ((h0 - mean) * rstd * gv[bj][0] + bv[bj][0]) * alpha + acc[ai][bj][m][0], o1 = ((h1 - mean) * rstd * gv[bj][1] + bv[bj][1]) * alpha + acc[ai][bj][m][1];
                u32x4 w; w.x = pk2h(o0[0], o0[1]); w.y = pk2h(o0[2], o0[3]); w.z = pk2h(o1[0], o1[1]); w.w = pk2h(o1[2], o1[3]);
                *(u32x4*)(Cw + (size_t)row * ldc + col0 + bj * HALF) = w; }
    }
}
struct EpiResidLn {
    static constexpr bool PERM = true, AFTER_DRAIN = false, PERMA = false;
    bf16_t* C; int ldc; float alpha; const float* st; const float* g; const float* b;
    __device__ __forceinline__ void operator()(const f32x4 (&acc)[2][2][4][2], const Unit& u, int wr, int wc, int fr, int fq) const {
        resid_ln_tile_bf(this->C, this->C, this->st, this->g, this->b, this->ldc, this->alpha, acc, u.pm * BM + wr * 64 + fr, u.pn * BM + wc * 32 + 8 * fq);
    }
};
struct EpiPart {
    static constexpr bool PERM = false, AFTER_DRAIN = false, PERMA = false;
    float* P; int ldc;
    __device__ __forceinline__ void operator()(const f32x4 (&acc)[2][2][4][2], const Unit& u, int wr, int wc, int fr, int fq) const {
        const int row0 = u.kk * BM + wr * 64 + fr, col0 = u.pn * BM + wc * 32 + 4 * fq;
#pragma unroll
        for (int ai = 0; ai < 2; ++ai)
#pragma unroll
            for (int m = 0; m < 4; ++m) { float* rowp = P + (size_t)(row0 + ai * HALF + m * 16) * ldc + col0;
#pragma unroll
                for (int bj = 0; bj < 2; ++bj)
#pragma unroll
                    for (int n = 0; n < 2; ++n) *(f32x4*)(rowp + bj * HALF + n * 16) = acc[ai][bj][m][n]; }
    }
};

__device__ __forceinline__ float dpp_shr1_old(float old, float x) { return __int_as_float(__builtin_amdgcn_update_dpp(__float_as_int(old), __float_as_int(x), 0x111, 0xf, 0xf, false)); }
__device__ __forceinline__ float dpp_shl1_old(float old, float x) { return __int_as_float(__builtin_amdgcn_update_dpp(__float_as_int(old), __float_as_int(x), 0x101, 0xf, 0xf, false)); }
struct EpiFfn {
    static constexpr bool PERM = true, AFTER_DRAIN = false, PERMA = true;
    bf16_t* ACT; float* SIDE; bf16_t* GVM; const float *cw, *cb; PG8_LAS float* X;
    __device__ __forceinline__ void operator()(const f32x4 (&acc)[2][2][4][2], const Unit& u, int wr_in, int wc_in, int fr_in, int fq_in) const {
        int fr = fr_in, fq = fq_in, wr = wr_in, wc = wc_in; asm volatile("" : "+v"(fr), "+v"(fq), "+s"(wr), "+s"(wc));
        const int cj = wc * 32 + 8 * fq, c0 = u.pn * 128 + cj;
        if (u.pm == PMETA) {
#pragma unroll
            for (int ai = 0; ai < 2; ++ai)
#pragma unroll
                for (int m = 0; m < 4; ++m) { bf16_t* rowp = GVM + (size_t)(ai * HALF + wr * 64 + 4 * fr + m) * NUP + c0;
                    *(u32x4*)rowp = pack8(acc[ai][0][m][0], acc[ai][0][m][1]); *(u32x4*)(rowp + DFF) = pack8(acc[ai][1][m][0], acc[ai][1][m][1]); }
            return;
        }
        f32x4 w0[2], w1[2], w2[2], bb[2];
#pragma unroll
        for (int n = 0; n < 2; ++n) { w0[n] = *(const f32x4*)(cw + c0 + 4 * n); w1[n] = *(const f32x4*)(cw + DFF + c0 + 4 * n); w2[n] = *(const f32x4*)(cw + 2 * DFF + c0 + 4 * n); bb[n] = *(const f32x4*)(cb + c0 + 4 * n); }
#pragma unroll
        for (int ai = 0; ai < 2; ++ai) { const int b = 2 * ai + wr;
            if (fr == 0) { *(PG8_LAS f32x4*)(X + (b * 2 + 0) * 128 + cj) = acc[ai][0][0][0]; *(PG8_LAS f32x4*)(X + (b * 2 + 0) * 128 + cj + 4) = acc[ai][0][0][1]; }
            if (fr == 15) { *(PG8_LAS f32x4*)(X + (b * 2 + 1) * 128 + cj) = acc[ai][0][3][0]; *(PG8_LAS f32x4*)(X + (b * 2 + 1) * 128 + cj + 4) = acc[ai][0][3][1]; } }
        asm volatile("s_waitcnt lgkmcnt(0)" ::: "memory"); __builtin_amdgcn_s_barrier(); asm volatile("" ::: "memory");
        const unsigned rowb = (unsigned)(u.pm * BM + wr * 64 + 4 * fr) * DFF + c0;
#pragma unroll
        for (int ai = 0; ai < 2; ++ai) { const int b = 2 * ai + wr;
            f32x4 xp[2], xn[2];
#pragma unroll
            for (int n = 0; n < 2; ++n) { xp[n] = b > 0 ? *(const PG8_LAS f32x4*)(X + ((b - 1) * 2 + 1) * 128 + cj + 4 * n) : (f32x4){0.f, 0.f, 0.f, 0.f};
                                          xn[n] = b < 3 ? *(const PG8_LAS f32x4*)(X + ((b + 1) * 2 + 0) * 128 + cj + 4 * n) : (f32x4){0.f, 0.f, 0.f, 0.f}; }
            f32x4 up0[2], dn3[2];
#pragma unroll
            for (int n = 0; n < 2; ++n)
#pragma unroll
                for (int e = 0; e < 4; ++e) { up0[n][e] = dpp_shr1_old(xp[n][e], acc[ai][0][3][n][e]); dn3[n][e] = dpp_shl1_old(xn[n][e], acc[ai][0][0][n][e]); }
#pragma unroll
            for (int m = 0; m < 4; ++m) { u32x4 ow;
#pragma unroll
                for (int n = 0; n < 2; ++n) {
                    const f32x4 g = acc[ai][0][m][n], pv = m > 0 ? acc[ai][0][m > 0 ? m - 1 : 0][n] : up0[n], nx = m < 3 ? acc[ai][0][m < 3 ? m + 1 : 3][n] : dn3[n];
                    const f32x4 x = w0[n] * pv + w1[n] * g + w2[n] * nx + bb[n]; f32x4 t, o;
#pragma unroll
                    for (int e = 0; e < 4; ++e) t[e] = __expf(-x[e]);
                    t = t + 1.f;
#pragma unroll
                    for (int e = 0; e < 4; ++e) t[e] = __builtin_amdgcn_rcpf(t[e]);
                    o = x * t * acc[ai][1][m][n];
                    if (n == 0) { ow.x = pk2(o[0], o[1]); ow.y = pk2(o[2], o[3]); } else { ow.z = pk2(o[0], o[1]); ow.w = pk2(o[2], o[3]); } }
                bf16_t* dst = ACT + (rowb + (unsigned)(ai * HALF + m) * DFF);
                if (ai == 0 ? m < 2 : m >= 2) {
                    const int r = ai * HALF + wr * 64 + 4 * fr + m;
                    if (r != 0 && r != 255) *(u32x4*)dst = ow;
                    const int slot = r == 0 ? 0 : r == 1 ? 1 : r == 254 ? 2 : r == 255 ? 3 : -1;
                    if (slot >= 0) { float* sp = SIDE + ((size_t)u.pm * 6 + slot) * DFF + c0; *(f32x4*)sp = acc[ai][0][m][0]; *(f32x4*)(sp + 4) = acc[ai][0][m][1];
                        if (slot == 0 || slot == 3) { float* vp = SIDE + ((size_t)u.pm * 6 + (slot == 0 ? 4 : 5)) * DFF + c0; *(f32x4*)vp = acc[ai][1][m][0]; *(f32x4*)(vp + 4) = acc[ai][1][m][1]; } }
                } else *(u32x4*)dst = ow;
            }
        }
    }
};
template <class Epi, class Sched, bool ALIGN_EPI = false, bool SP2 = false>
__device__ __forceinline__ void gemm_phase(PG8_LAS unsigned char* lds, const Gemm g, const Sched& S, const Epi& E) {
    int tid_ = threadIdx.x; asm volatile("" : "+v"(tid_));
    const int tid = tid_, wid = __builtin_amdgcn_readfirstlane(tid >> 6), lane = tid & 63, wr = wid >> 2, wc = wid & 3, fr = lane & 15, fq = lane >> 4;
    const int K = g.ld, nt = g.K / BK;
    unsigned voffA[2], voffB[2];
#pragma unroll
    for (int i = 0; i < 2; ++i) { int R, C; stage_rc(tid * 16 + i * 8192, R, C); const int Rb = Epi::PERM ? ((R & ~31) + perm32(R & 31)) : R;
        const int Ra = Epi::PERMA ? ((R & ~63) | ((R & 15) << 2) | ((R >> 4) & 3)) : R;
        voffA[i] = (unsigned)(Ra * K + C) * 2u; voffB[i] = (unsigned)(Rb * K + C) * 2u; }
    const size_t kstep = (size_t)(BK * 2);
    const size_t hstep = (size_t)HALF * K * 2;
    const size_t tstep = 2 * hstep;
    const unsigned ldsw = (unsigned)wid * 1024u;
    const int aoff = lds_byte(wr * 64 + fr, fq * 8), boff = lds_byte(wc * 32 + fr, fq * 8);
#define PG8_SA(b, h) (((b) * 2 + (h)) * HTB)
#define PG8_SB(b, h) ((4 + (b) * 2 + (h)) * HTB)
#define PG8_STAGE(bufoff, gbase, voff) do { _Pragma("unroll") for (int _i = 0; _i < 2; ++_i) \
        __builtin_amdgcn_global_load_lds((const unsigned*)((const char*)(gbase) + (voff)[_i]), (PG8_LAS unsigned*)(lds + (bufoff) + ldsw + _i * 8192), 16, 0, 0); } while (0)
#define PG8_LDA(dst, b, h) do { _Pragma("unroll") for (int m = 0; m < 4; ++m) _Pragma("unroll") for (int k = 0; k < 2; ++k) dst[m][k] = *(const PG8_LAS bf16x8*)(lds + PG8_SA(b, h) + aoff + m * 2048 + k * 1024); } while (0)
#define PG8_LDB(dst, b, h) do { _Pragma("unroll") for (int n = 0; n < 2; ++n) _Pragma("unroll") for (int k = 0; k < 2; ++k) dst[n][k] = *(const PG8_LAS bf16x8*)(lds + PG8_SB(b, h) + boff + n * 2048 + k * 1024); } while (0)
#define PG8_MMA(ai, bj, At, Bt) do { __builtin_amdgcn_s_setprio(1); _Pragma("unroll") for (int m = 0; m < 4; ++m) _Pragma("unroll") for (int n = 0; n < 2; ++n) _Pragma("unroll") for (int k = 0; k < 2; ++k) \
        acc[ai][bj][m][n] = __builtin_amdgcn_mfma_f32_16x16x32_bf16(Bt[n][k], At[m][k], acc[ai][bj][m][n], 0, 0, 0); __builtin_amdgcn_s_setprio(0); } while (0)
#define PG8_WAIT_V(n) asm volatile("s_waitcnt vmcnt(" #n ")" ::: "memory")
#define PG8_WAIT_L(n) asm volatile("s_waitcnt lgkmcnt(" #n ")" ::: "memory")
#define PG8_BAR __builtin_amdgcn_s_barrier()
#define PG8_SCHED __builtin_amdgcn_sched_barrier(0)
    Unit cur, nxt; int ui = 0;
    if (!S.next(0, cur)) return;
    f32x4 acc[2][2][4][2];
#pragma unroll
    for (int a = 0; a < 2; ++a)
#pragma unroll
        for (int b = 0; b < 2; ++b)
#pragma unroll
            for (int m = 0; m < 4; ++m)
#pragma unroll
                for (int n = 0; n < 2; ++n) acc[a][b][m][n] = (f32x4){0.f, 0.f, 0.f, 0.f};
    bf16x8 At[4][2], B0[2][2], B1[2][2];
    const size_t sstep = (size_t)g.K * 2;
    const char* cA = (const char*)g.A + (size_t)cur.pm * tstep + (size_t)cur.kk * sstep; const char* cB = (const char*)g.Bt + (size_t)cur.pn * tstep + (size_t)cur.kk * sstep;
    S.a_ready(cur);
    if constexpr (SP2) {
        PG8_STAGE(PG8_SB(0, 0), cB, voffB); PG8_STAGE(PG8_SB(0, 1), cB + hstep, voffB); PG8_STAGE(PG8_SA(0, 0), cA, voffA); PG8_STAGE(PG8_SA(0, 1), cA + hstep, voffA);
        if (wr == 1) PG8_BAR;
        PG8_WAIT_V(2); PG8_BAR;
        PG8_STAGE(PG8_SB(1, 0), cB + kstep, voffB); PG8_STAGE(PG8_SA(1, 0), cA + kstep, voffA); PG8_STAGE(PG8_SB(1, 1), cB + hstep + kstep, voffB);
        PG8_WAIT_V(6); PG8_BAR;
    } else {
        PG8_STAGE(PG8_SB(0, 0), cB, voffB); PG8_STAGE(PG8_SA(0, 0), cA, voffA); PG8_STAGE(PG8_SB(0, 1), cB + hstep, voffB); PG8_STAGE(PG8_SA(0, 1), cA + hstep, voffA);
        if (wr == 1) PG8_BAR;
        PG8_WAIT_V(4); PG8_BAR;
        PG8_STAGE(PG8_SB(1, 0), cB + kstep, voffB); PG8_STAGE(PG8_SA(1, 0), cA + kstep, voffA); PG8_STAGE(PG8_SB(1, 1), cB + hstep + kstep, voffB);
        PG8_WAIT_V(6); PG8_BAR;
    }
    for (;;) {
        const bool has_next = S.next(ui + 1, nxt);
        const char* nA = has_next ? (const char*)g.A + (size_t)nxt.pm * tstep + (size_t)nxt.kk * sstep : cA; const char* nB = has_next ? (const char*)g.Bt + (size_t)nxt.pn * tstep + (size_t)nxt.kk * sstep : cB;
        for (int t = 0; t < nt; t += 2) {
            const bool last = (t == nt - 2);
            const char* a1 = cA + (size_t)(t + 1) * kstep;
            const char* a2 = last ? nA : cA + (size_t)(t + 2) * kstep; const char* b2 = last ? nB : cB + (size_t)(t + 2) * kstep;
            const char* a3 = a2 + kstep; const char* b3 = b2 + kstep;
            if (last && has_next) S.a_ready(nxt);
            if constexpr (SP2) {
            PG8_LDB(B0, 0, 0); PG8_LDB(B1, 0, 1); PG8_SCHED; PG8_LDA(At, 0, 0); PG8_STAGE(PG8_SA(1, 1), a1 + hstep, voffA);
            PG8_WAIT_V(8); PG8_WAIT_L(0); PG8_BAR; PG8_MMA(0, 0, At, B0); PG8_MMA(0, 1, At, B1); PG8_BAR; PG8_SCHED;
            PG8_LDA(At, 0, 1); PG8_STAGE(PG8_SB(0, 0), b2, voffB); PG8_STAGE(PG8_SB(0, 1), b2 + hstep, voffB); PG8_STAGE(PG8_SA(0, 0), a2, voffA);
            PG8_WAIT_V(8); PG8_WAIT_L(0); PG8_BAR; PG8_MMA(1, 0, At, B0); PG8_MMA(1, 1, At, B1); PG8_BAR; PG8_SCHED;
            PG8_LDB(B0, 1, 0); PG8_LDB(B1, 1, 1); PG8_SCHED; PG8_LDA(At, 1, 0); PG8_STAGE(PG8_SA(0, 1), a2 + hstep, voffA);
            PG8_WAIT_V(8); PG8_WAIT_L(0); PG8_BAR; PG8_MMA(0, 0, At, B0); PG8_MMA(0, 1, At, B1); PG8_BAR; PG8_SCHED;
            PG8_LDA(At, 1, 1); PG8_STAGE(PG8_SB(1, 0), b3, voffB); PG8_STAGE(PG8_SB(1, 1), b3 + hstep, voffB); PG8_STAGE(PG8_SA(1, 0), a3, voffA);
            PG8_WAIT_V(8); PG8_WAIT_L(0); PG8_BAR; PG8_MMA(1, 0, At, B0); PG8_MMA(1, 1, At, B1); PG8_BAR; PG8_SCHED;
            } else {
            PG8_LDB(B0, 0, 0); PG8_SCHED; PG8_LDA(At, 0, 0); PG8_STAGE(PG8_SA(1, 1), a1 + hstep, voffA);
            PG8_WAIT_L(8); PG8_BAR; PG8_WAIT_L(0); PG8_MMA(0, 0, At, B0); PG8_BAR; PG8_SCHED;
            PG8_LDB(B1, 0, 1); PG8_STAGE(PG8_SB(0, 0), b2, voffB);
            PG8_BAR; PG8_WAIT_L(0); PG8_MMA(0, 1, At, B1); PG8_BAR;
            PG8_LDA(At, 0, 1); PG8_STAGE(PG8_SA(0, 0), a2, voffA);
            PG8_BAR; PG8_WAIT_L(0); PG8_MMA(1, 0, At, B0); PG8_BAR; PG8_SCHED;
            PG8_STAGE(PG8_SB(0, 1), b2 + hstep, voffB);
            PG8_WAIT_V(6); PG8_BAR; PG8_MMA(1, 1, At, B1); PG8_BAR;
            PG8_LDB(B0, 1, 0); PG8_SCHED; PG8_LDA(At, 1, 0); PG8_STAGE(PG8_SA(0, 1), a2 + hstep, voffA);
            PG8_WAIT_L(8); PG8_BAR; PG8_WAIT_L(0); PG8_MMA(0, 0, At, B0); PG8_BAR; PG8_SCHED;
            PG8_LDB(B1, 1, 1); PG8_STAGE(PG8_SB(1, 0), b3, voffB);
            PG8_BAR; PG8_WAIT_L(0); PG8_MMA(0, 1, At, B1); PG8_BAR;
            PG8_LDA(At, 1, 1); PG8_STAGE(PG8_SA(1, 0), a3, voffA);
            PG8_BAR; PG8_WAIT_L(0); PG8_MMA(1, 0, At, B0); PG8_BAR; PG8_SCHED;
            PG8_STAGE(PG8_SB(1, 1), b3 + hstep, voffB);
            PG8_WAIT_V(6); PG8_BAR; PG8_MMA(1, 1, At, B1); PG8_BAR;
            }
        }
        if constexpr (ALIGN_EPI) { if (wr == 0) PG8_BAR; }
        if constexpr (!Epi::AFTER_DRAIN) { E(acc, cur, wr, wc, fr, fq); S.done(cur); }
        if (!has_next) break;
#pragma unroll
        for (int a = 0; a < 2; ++a)
#pragma unroll
            for (int b = 0; b < 2; ++b)
#pragma unroll
                for (int m = 0; m < 4; ++m)
#pragma unroll
                    for (int n = 0; n < 2; ++n) acc[a][b][m][n] = (f32x4){0.f, 0.f, 0.f, 0.f};
        cur = nxt; cA = nA; cB = nB; ++ui;
        if constexpr (ALIGN_EPI) { if (wr == 1) PG8_BAR; }
    }
    PG8_WAIT_V(0);
    if constexpr (!ALIGN_EPI) { if (wr == 0) PG8_BAR; }
    PG8_BAR;
    if constexpr (Epi::AFTER_DRAIN) { E.fused(acc, cur, wr, wc, fr, fq, lds, wid, lane); S.done(cur); }
#undef PG8_SA
#undef PG8_SB
#undef PG8_STAGE
#undef PG8_LDA
#undef PG8_LDB
#undef PG8_MMA
#undef PG8_WAIT_V
#undef PG8_WAIT_L
#undef PG8_BAR
#undef PG8_SCHED
}
}
#define XB_TMO      128
#define XB_XCNT(j)  (256  + 64 * (j))
#define XB_XSUB(j)  (1280 + 64 * (j))
#define XB_XGEN(j)  (2304 + 64 * (j))
#define XB_TOP      3328
#define XB_TOPGEN   3392
#define XCD_BAR_WORDS 3456
#define XB_SPIN_CAP (1u << 21)

__device__ __forceinline__ unsigned xb_ld(unsigned* p)              { return __hip_atomic_load(p, __ATOMIC_RELAXED, __HIP_MEMORY_SCOPE_AGENT); }
__device__ __forceinline__ unsigned xb_add(unsigned* p, unsigned v) { return __hip_atomic_fetch_add(p, v, __ATOMIC_RELAXED, __HIP_MEMORY_SCOPE_AGENT); }
__device__ __forceinline__ unsigned xb_xcc_id() { return (unsigned)__builtin_amdgcn_s_getreg((3 << 11) | 20) & 0xFu; }
#define XB_SPIN(cond, bar) do { unsigned _sp = 0; while (cond) { __builtin_amdgcn_s_sleep(1); \
    if ((++_sp & 255u) == 0u) { if (xb_ld(&(bar)[XB_TMO])) break; if (_sp > XB_SPIN_CAP) { atomicAdd(&(bar)[XB_TMO], 1u); break; } } } } while (0)

struct XcdBarrier {
    unsigned* bar; unsigned x;
    volatile LAS unsigned* st;
};

__device__ __forceinline__ XcdBarrier xcd_barrier_post(unsigned* bar, volatile LAS unsigned* st) {
    XcdBarrier b; b.bar = bar; b.x = (unsigned)__builtin_amdgcn_readfirstlane((int)xb_xcc_id()); b.st = st;
    if (threadIdx.x == 0) (void)xb_add(&bar[XB_XCNT(b.x)], 1u);
    return b;
}
__device__ __forceinline__ void xcd_barrier_complete(unsigned* bar, unsigned x, unsigned& nloc, unsigned& nx) {
    const unsigned G = gridDim.x * gridDim.y * gridDim.z;
    unsigned sum, cnt, mine, sp = 0u;
    for (;;) {
        sum = 0u; cnt = 0u; mine = 0u;
#pragma unroll
        for (unsigned j = 0; j < 16; ++j) { const unsigned c = xb_ld(&bar[XB_XCNT(j)]); sum += c; cnt += (c > 0u) ? 1u : 0u; }
        mine = xb_ld(&bar[XB_XCNT(x)]);
        if (sum == G) { mine = xb_ld(&bar[XB_XCNT(x)]); break; }
        __builtin_amdgcn_s_sleep(1);
        if ((++sp & 255u) == 0u) { if (xb_ld(&bar[XB_TMO])) break; if (sp > XB_SPIN_CAP) { atomicAdd(&bar[XB_TMO], 1u); break; } }
    }
    nloc = mine > 0u ? mine : 1u; nx = cnt > 0u ? cnt : 1u;
}

__device__ __forceinline__ void xcd_barrier(const XcdBarrier& b) {
    asm volatile("s_waitcnt vmcnt(0)" ::: "memory");
    __syncthreads();
    if (threadIdx.x == 0) {
        unsigned* bar = b.bar; unsigned bx_ = b.x;
        asm volatile("" : "+s"(bx_));
        __builtin_amdgcn_s_waitcnt(0);
        unsigned nloc = b.st[0], nx = b.st[1];
        if (nloc == 0u) { xcd_barrier_complete(bar, bx_, nloc, nx); b.st[0] = nloc; b.st[1] = nx; }
        const unsigned old = xb_add(&bar[XB_XSUB(bx_)], 1u);
        const unsigned gen = old / nloc;
        if (old + 1u == (gen + 1u) * nloc) {
            __builtin_amdgcn_fence(__ATOMIC_RELEASE, "agent");
            asm volatile("s_waitcnt vmcnt(0)" ::: "memory");
            const unsigned og = xb_add(&bar[XB_TOP], 1u);
            const unsigned tg = og / nx;
            if (og + 1u == (tg + 1u) * nx) xb_add(&bar[XB_TOPGEN], 1u);
            else XB_SPIN(xb_ld(&bar[XB_TOPGEN]) == tg, bar);
            __builtin_amdgcn_fence(__ATOMIC_ACQUIRE, "agent");
            xb_add(&bar[XB_XGEN(bx_)], 1u);
            asm volatile("s_waitcnt vmcnt(0)" ::: "memory");
        } else {
            XB_SPIN(xb_ld(&bar[XB_XGEN(bx_)]) == gen, bar);
            __builtin_amdgcn_fence(__ATOMIC_ACQUIRE, "agent");
            asm volatile("s_waitcnt vmcnt(0)" ::: "memory");
        }
    }
    __syncthreads();
}

typedef unsigned short bf16_t;
typedef short bf16x8 __attribute__((ext_vector_type(8)));
typedef float f32x4 __attribute__((ext_vector_type(4)));
typedef unsigned u32x4 __attribute__((ext_vector_type(4)));
#define LDS_WAIT() asm volatile("s_waitcnt lgkmcnt(0)" ::: "memory")

struct Params {
    const float* in[19];
};
struct Frame {
    LAS unsigned char* lds;
    int tid, lane, wave, G, bx, vcu, gw, ngw;
};
__device__ __forceinline__ const float* uptr(const LAS unsigned long long* t, int k) {
    const unsigned long long v = t[k]; const unsigned lo = __builtin_amdgcn_readfirstlane((unsigned)v), hi = __builtin_amdgcn_readfirstlane((unsigned)(v >> 32));
    return (const float*)(const GAS float*)(((unsigned long long)hi << 32) | lo); }

template <class CMap>
__device__ __forceinline__ void transpose_load(float (&v)[32], const float* W, int Nsrc, const float* ks, int kb, int nb, int lane, CMap cmap) {
    const int k0 = 64 * kb, n0 = 32 * nb; const int sc = cmap(n0 + (lane & 31));
#pragma unroll
    for (int i = 0; i < 32; ++i) { const int kk = 2 * i + (lane >> 5); float x = 0.f; if (sc >= 0) x = W[(size_t)(k0 + kk) * Nsrc + sc]; if (ks) x *= ks[k0 + kk]; v[i] = x; }
}
__device__ __forceinline__ void transpose_store(const float (&v)[32], int K, bf16_t* WT, LAS float* scr, int kb, int nb, int lane) {
    const int k0 = 64 * kb, n0 = 32 * nb;
#pragma unroll
    for (int i = 0; i < 32; ++i) scr[(2 * i + (lane >> 5)) * 33 + (lane & 31)] = v[i];
    LDS_WAIT(); asm volatile("" ::: "memory");
    const int c = lane & 7;
#pragma unroll
    for (int j = 0; j < 4; ++j) { const int n = (lane >> 3) + 8 * j; const LAS float* s = scr + (8 * c) * 33 + n;
        u32x4 o; o.x = pk2(s[0 * 33], s[1 * 33]); o.y = pk2(s[2 * 33], s[3 * 33]); o.z = pk2(s[4 * 33], s[5 * 33]); o.w = pk2(s[6 * 33], s[7 * 33]);
        *(u32x4*)(WT + (size_t)(n0 + n) * K + k0 + 8 * c) = o; }
    LDS_WAIT(); asm volatile("" ::: "memory");
}
template <class CMap>
__device__ __forceinline__ void transpose_matrix(const Frame& F, const float* W, int K, int Nsrc, int Ndst, bf16_t* WT, const float* ks, LAS float* scr, CMap cmap) {
    const int nnb = Ndst / 32, items = (K / 64) * nnb;
    for (int it = F.gw; it < items; it += 2 * F.ngw) { const int it2 = it + F.ngw; float va[32], vb[32];
        transpose_load(va, W, Nsrc, ks, it / nnb, it % nnb, F.lane, cmap);
        if (it2 < items) transpose_load(vb, W, Nsrc, ks, it2 / nnb, it2 % nnb, F.lane, cmap);
        transpose_store(va, K, WT, scr, it / nnb, it % nnb, F.lane);
        if (it2 < items) transpose_store(vb, K, WT, scr, it2 / nnb, it2 % nnb, F.lane); }
}
__device__ __forceinline__ int rope_perm(int m) { const int g = m >> 3, j = m & 7; return j < 4 ? 4 * g + j : 32 + 4 * g + (j - 4); }
struct CMapIn { __device__ int operator()(int n) const {
    if (n < 4096) return n; if (n < 4608) return 4112 + (n - 4096); if (n < 4864) return 4624 + (n - 4608);
    if (n < 4928) return 4880 + rope_perm(n - 4864); if (n < 4944) return 4096 + (n - 4928); return -1; } };
struct CMapQ { __device__ int operator()(int n) const { const int h = n / 192, o = n % 192; return o < 128 ? n : h * 192 + 128 + rope_perm(o - 128); } };
struct CMapUp { __device__ int operator()(int n) const { const int pn = n >> 8, j = n & 255; return j < 128 ? 128 * pn + j : DFF + 128 * pn + (j - 128); } };
struct CMapId { __device__ int operator()(int n) const { return n; } };

__device__ __forceinline__ void convert_weights(const Frame& F, unsigned char* ws_, const LAS unsigned long long* pt, int l, size_t wo, int slot) {
    unsigned char* ws = ws_ + wo;
    LAS float* scr = (LAS float*)(F.lds + F.wave * 8448);
    if (slot != 1) {
        const float* w_in = uptr(pt, 3) + (size_t)l * DM * INC; const float* w_uq = uptr(pt, 8) + (size_t)l * 512 * NQ; const float* w_ukv = uptr(pt, 9) + (size_t)l * 256 * NKV;
        const float* w_out = uptr(pt, 10) + (size_t)l * DM * DM; const float* w_dn = uptr(pt, 16) + (size_t)l * DFF * DM;
        const float* qg = uptr(pt, 6) + (size_t)l * 512; const float* kvg = uptr(pt, 7) + (size_t)l * 256;
        transpose_matrix(F, w_in, DM, INC, NIN, (bf16_t*)(ws + WS_WIN), nullptr, scr, CMapIn());
        transpose_matrix(F, w_uq, 512, NQ, NQ, (bf16_t*)(ws + WS_WUQ), qg, scr, CMapQ());
        transpose_matrix(F, w_ukv, 256, NKV, NKV, (bf16_t*)(ws + WS_WUKV), kvg, scr, CMapId());
        transpose_matrix(F, w_out, DM, DM, DM, (bf16_t*)(ws + WS_WOUT), nullptr, scr, CMapId());
        transpose_matrix(F, w_dn, DFF, DM, DM, (bf16_t*)(ws + WS_WDN), nullptr, scr, CMapId());
    }
    if (slot != 0) { const float* w_up = uptr(pt, 13) + (size_t)l * DM * NUP;
        transpose_matrix(F, w_up, DM, NUP, NUP, (bf16_t*)(ws + WS_WUP), nullptr, scr, CMapUp()); }
}
__device__ __forceinline__ void prologue(const Frame& F, unsigned char* ws, const LAS unsigned long long* pt) {
    float* COS = (float*)(ws + WS_COS); float* SIN = (float*)(ws + WS_SIN);
    for (int i = F.bx * 512 + F.tid; i < 4112 * 32; i += F.G * 512) { const int pos = i >> 5, f = i & 31;
        const float inv = powf(10000.0f, -(float)(2 * f) / 64.0f); const float ang = (float)pos * inv; float s, c; sincosf(ang, &s, &c); COS[i] = c; SIN[i] = s; }
    { float* PAR = (float*)(ws + WS_PAR); const int gt = F.bx * 512 + F.tid, nt = F.G * 512;
      for (int i = gt; i < DEPTH * 16; i += nt) PAR[PO_BG + i] = uptr(pt, 4)[i];
      for (int i = gt; i < DEPTH * 1024; i += nt) PAR[PO_MLG + i] = uptr(pt, 5)[i];
      for (int i = gt; i < DEPTH * 512; i += nt) PAR[PO_QG + i] = uptr(pt, 6)[i];
      for (int i = gt; i < DEPTH * 256; i += nt) PAR[PO_KVG + i] = uptr(pt, 7)[i];
      for (int i = gt; i < 2048; i += nt) { PAR[PO_ONE + i] = 1.f; PAR[PO_ZERO + i] = 0.f; }
      { float* ST2 = (float*)(ws + WS_STAT2); for (int i = gt; i < TP; i += nt) { ST2[2 * i] = 0.f; ST2[2 * i + 1] = 1.f; } }
      for (int i = gt; i < DEPTH * 2048; i += nt) { PAR[PO_L1G + i] = uptr(pt, 11)[i]; PAR[PO_L1B + i] = uptr(pt, 12)[i]; PAR[PO_L2G + i] = uptr(pt, 17)[i]; PAR[PO_L2B + i] = uptr(pt, 18)[i]; }
      for (int i = gt; i < DEPTH * 3 * 5632; i += nt) PAR[PO_CW + i] = uptr(pt, 14)[i];
      for (int i = gt; i < DEPTH * 5632; i += nt) PAR[PO_CB + i] = uptr(pt, 15)[i]; }
    float* H = (float*)(ws + WS_H); bf16_t* HB = (bf16_t*)(ws + WS_HB);
    const float* xp = uptr(pt, 0); const float* xs = uptr(pt, 1); const float* mt = uptr(pt, 2);
    for (int row0 = F.gw; row0 < TP; row0 += 2 * F.ngw) {
        f32x4 v[2][8];
#pragma unroll
        for (int r = 0; r < 2; ++r) { const int row = row0 + r * F.ngw; const float* src = nullptr;
            if (row < 4 * LREAL) src = xp + (size_t)row * DM; else if (row < NMAIN) src = xs + (size_t)(row - 4 * LREAL) * DM; else if (row < NTOK) src = mt + (size_t)((row - NMAIN) & 15) * DM;
#pragma unroll
            for (int j = 0; j < 8; ++j) { v[r][j] = (f32x4){0.f, 0.f, 0.f, 0.f}; if (src) v[r][j] = ((const f32x4*)src)[F.lane + 64 * j]; } }
#pragma unroll
        for (int r = 0; r < 2; ++r) { const int row = row0 + r * F.ngw; if (row < TP) {
            f32x4* hd = (f32x4*)(H + (size_t)row * DM) + F.lane; u32x2* bd = (u32x2*)(HB + (size_t)row * DM) + F.lane; u32x2* hb = (u32x2*)((bf16_t*)H + (size_t)row * DM) + F.lane;
#pragma unroll
            for (int j = 0; j < 8; ++j) { const f32x4 x = v[r][j];
                u32x2 w; w.x = pk2(x[0], x[1]); w.y = pk2(x[2], x[3]); bd[64 * j] = w;
                if (row >= NMAIN) hd[64 * j] = x * ALPHA;
                else { u32x2 wh; wh.x = pk2h(x[0], x[1]); wh.y = pk2h(x[2], x[3]); hb[64 * j] = wh; } } } }
    }
}

__device__ __forceinline__ void ln_one(const f32x4 (&vin)[8], int row, int lane, float* __restrict__ Hw, bf16_t* __restrict__ HB, const float* __restrict__ g, const float* __restrict__ b, float* __restrict__ ST) {
    f32x4 v[8]; float s = 0.f;
#pragma unroll
    for (int j = 0; j < 8; ++j) { v[j] = vin[j]; s += (v[j][0] + v[j][1]) + (v[j][2] + v[j][3]); }
    const float mean = wave_sum(s) * (1.f / DM); float q = 0.f;
#pragma unroll
    for (int j = 0; j < 8; ++j) { v[j] = v[j] - mean; q += (v[j][0] * v[j][0] + v[j][1] * v[j][1]) + (v[j][2] * v[j][2] + v[j][3] * v[j][3]); }
    const float rstd = rsqrtf(wave_sum(q) * (1.f / DM) + EPS);
    if (lane == 0) { f32x2 ms = {mean, rstd}; *(f32x2*)(ST + (size_t)row * 2) = ms; }
    u32x2* bd = (u32x2*)(HB + (size_t)row * DM) + lane; f32x4* hp = (f32x4*)(Hw + (size_t)row * DM) + lane;
#pragma unroll
    for (int j = 0; j < 8; ++j) { const f32x4 gg = ((const f32x4*)g)[lane + 64 * j], bb = ((const f32x4*)b)[lane + 64 * j]; const f32x4 y = v[j] * rstd * gg + bb;
        u32x2 w; w.x = pk2(y[0], y[1]); w.y = pk2(y[2], y[3]); bd[64 * j] = w;
        hp[64 * j] = y * ALPHA; }
}
__device__ __forceinline__ void ln_one_bf(const u32x4 (&vin)[4], int row, int lane, bf16_t* __restrict__ HB, const float* __restrict__ g, const float* __restrict__ b, float* __restrict__ ST, float* __restrict__ out) {
    f32x4 v[8]; float s = 0.f;
#pragma unroll
    for (int j = 0; j < 4; ++j) { v[2 * j] = (f32x4){hf_lo(vin[j].x), hf_hi(vin[j].x), hf_lo(vin[j].y), hf_hi(vin[j].y)}; v[2 * j + 1] = (f32x4){hf_lo(vin[j].z), hf_hi(vin[j].z), hf_lo(vin[j].w), hf_hi(vin[j].w)}; }
#pragma unroll
    for (int j = 0; j < 8; ++j) s += (v[j][0] + v[j][1]) + (v[j][2] + v[j][3]);
    const float mean = wave_sum(s) * (1.f / DM); float q = 0.f;
#pragma unroll
    for (int j = 0; j < 8; ++j) { v[j] = v[j] - mean; q += (v[j][0] * v[j][0] + v[j][1] * v[j][1]) + (v[j][2] * v[j][2] + v[j][3] * v[j][3]); }
    const float rstd = rsqrtf(wave_sum(q) * (1.f / DM) + EPS);
    if (lane == 0) { f32x2 ms = {mean, rstd}; *(f32x2*)(ST + (size_t)row * 2) = ms; }
    u32x4* bd = (u32x4*)(HB + (size_t)row * DM) + lane;
#pragma unroll
    for (int j = 0; j < 4; ++j) { const int c4 = 2 * (lane + 64 * j);
        const f32x4 y0 = v[2 * j] * rstd * ((const f32x4*)g)[c4] + ((const f32x4*)b)[c4], y1 = v[2 * j + 1] * rstd * ((const f32x4*)g)[c4 + 1] + ((const f32x4*)b)[c4 + 1];
        if (out) { f32x4* op = (f32x4*)(out + (size_t)row * DM) + c4; op[0] = y0; op[1] = y1; }
        else bd[64 * j] = pg8::pack8(y0, y1); }
}
__device__ __forceinline__ void ln_rows(const Frame& F, float* H, bf16_t* HB, const float* g, const float* b, float* ST, float* out, const float* PART, int nk) {
    const bf16_t* __restrict__ Hr = (const bf16_t*)H;
    for (int row = F.gw; row < NMAIN; row += 4 * F.ngw) {
        const int row2 = row + F.ngw, row3 = row + 2 * F.ngw, row4 = row + 3 * F.ngw;
        u32x4 va[4], vb[4], vc[4], vd[4];
#pragma unroll
        for (int j = 0; j < 4; ++j) va[j] = ((const u32x4*)(Hr + (size_t)row * DM))[F.lane + 64 * j];
#pragma unroll
        for (int j = 0; j < 4; ++j) vb[j] = ((const u32x4*)(Hr + (size_t)row2 * DM))[F.lane + 64 * j];
#pragma unroll
        for (int j = 0; j < 4; ++j) vc[j] = ((const u32x4*)(Hr + (size_t)row3 * DM))[F.lane + 64 * j];
#pragma unroll
        for (int j = 0; j < 4; ++j) vd[j] = ((const u32x4*)(Hr + (size_t)row4 * DM))[F.lane + 64 * j];
        ln_one_bf(va, row, F.lane, HB, g, b, ST, out);
        ln_one_bf(vb, row2, F.lane, HB, g, b, ST, out);
        ln_one_bf(vc, row3, F.lane, HB, g, b, ST, out);
        ln_one_bf(vd, row4, F.lane, HB, g, b, ST, out);
    }
    if (F.gw < TP - NMAIN) {
        const int row = NMAIN + F.gw; const float* __restrict__ Hm = H; f32x4 va[8];
#pragma unroll
        for (int j = 0; j < 8; ++j) va[j] = ((const f32x4*)(Hm + (size_t)row * DM))[F.lane + 64 * j];
        const float* __restrict__ pp0 = PART + (size_t)F.gw * DM;
        int k = 0;
        for (; k + 4 <= nk; k += 4) {
            f32x4 t[4][8];
#pragma unroll
            for (int q = 0; q < 4; ++q)
#pragma unroll
                for (int j = 0; j < 8; ++j) t[q][j] = ((const f32x4*)(pp0 + (size_t)(k + q) * 256 * DM))[F.lane + 64 * j];
#pragma unroll
            for (int q = 0; q < 4; ++q)
#pragma unroll
                for (int j = 0; j < 8; ++j) va[j] += t[q][j]; }
        for (; k < nk; ++k) {
#pragma unroll
            for (int j = 0; j < 8; ++j) va[j] += ((const f32x4*)(pp0 + (size_t)k * 256 * DM))[F.lane + 64 * j]; }
        ln_one(va, row, F.lane, H, HB, g, b, ST);
    }
}

__device__ __forceinline__ void rstd_rows(const Frame& F, const bf16_t* UDQ, const bf16_t* UDKV, float* RSTD) {
    for (int row = F.gw; row < TP; row += F.ngw) {
        const u32x4 a = ((const u32x4*)(UDQ + (size_t)row * 512))[F.lane]; float s = 0.f;
#pragma unroll
        for (int j = 0; j < 4; ++j) { const float x = bf_lo(a[j]), y = bf_hi(a[j]); s += x * x + y * y; }
        float t = 0.f;
        if (F.lane < 32) { const u32x4 c = ((const u32x4*)(UDKV + (size_t)row * 256))[F.lane];
#pragma unroll
            for (int j = 0; j < 4; ++j) { const float x = bf_lo(c[j]), y = bf_hi(c[j]); t += x * x + y * y; } }
        s = wave_sum(s); t = wave_sum(t);
        if (F.lane == 0) { RSTD[(size_t)row * 2] = rsqrtf(s * (1.f / 512.f) + EPS); RSTD[(size_t)row * 2 + 1] = rsqrtf(t * (1.f / 256.f) + EPS); }
    }
}

__device__ __forceinline__ void mlstm_fin_row(int row, int lane, const f32x4 (&hv)[4], const u32x2 (&ov)[4], const float* __restrict__ ng, bf16_t* __restrict__ MIX) {
#pragma unroll
    for (int j = 0; j < 4; ++j) {
        f32x4 v = hv[j];
        const float mean = wave_sum((v[0] + v[1]) + (v[2] + v[3])) * (1.f / 256.f); v = v - mean;
        const float rstd = rsqrtf(wave_sum((v[0] * v[0] + v[1] * v[1]) + (v[2] * v[2] + v[3] * v[3])) * (1.f / 256.f) + EPS);
        const f32x4 gg = ((const f32x4*)(ng + 256 * j))[lane];
        const u32x2 uo = ov[j];
        const float o0 = bf_lo(uo.x), o1 = bf_hi(uo.x), o2 = bf_lo(uo.y), o3 = bf_hi(uo.y);
        const float y0 = v[0] * rstd * gg[0] / (1.f + __expf(-o0)), y1 = v[1] * rstd * gg[1] / (1.f + __expf(-o1));
        const float y2 = v[2] * rstd * gg[2] / (1.f + __expf(-o2)), y3 = v[3] * rstd * gg[3] / (1.f + __expf(-o3));
        u32x2 w; w.x = pk2(y0, y1); w.y = pk2(y2, y3); ((u32x2*)(MIX + (size_t)row * DM + 256 * j))[lane] = w;
    }
}
__device__ __forceinline__ void mlstm_finalize(const Frame& F, int gw0, int ngw0, const float* HSUM, const bf16_t* UQKVO, const float* ng, bf16_t* MIX) {
    const float* __restrict__ Hs = HSUM; const bf16_t* __restrict__ Uo = UQKVO;
    for (int row = gw0; row < TP; row += 4 * ngw0) {
        int rr[4]; bool ok[4];
#pragma unroll
        for (int q = 0; q < 4; ++q) { const int r = row + q * ngw0; ok[q] = r < TP; rr[q] = ok[q] ? r : row; }
        f32x4 hv[4][4]; u32x2 ov[4][4];
#pragma unroll
        for (int q = 0; q < 4; ++q)
#pragma unroll
            for (int j = 0; j < 4; ++j) { hv[q][j] = ((const f32x4*)(Hs + (size_t)rr[q] * MLW + 256 * j))[F.lane]; ov[q][j] = ((const u32x2*)(Uo + (size_t)rr[q] * 4096 + 3072 + 256 * j))[F.lane]; }
#pragma unroll
        for (int q = 0; q < 4; ++q) if (ok[q]) mlstm_fin_row(rr[q], F.lane, hv[q], ov[q], ng, MIX);
    }
}

__device__ __forceinline__ f32x8 ld8f(const float* p) { const f32x4 a = *(const f32x4*)p, b = *(const f32x4*)(p + 4); return (f32x8){a[0], a[1], a[2], a[3], b[0], b[1], b[2], b[3]}; }
__device__ __forceinline__ f32x8 ld8b(const bf16_t* p) { const u32x4 v = *(const u32x4*)p; return (f32x8){bf_lo(v[0]), bf_hi(v[0]), bf_lo(v[1]), bf_hi(v[1]), bf_lo(v[2]), bf_hi(v[2]), bf_lo(v[3]), bf_hi(v[3])}; }
__device__ __forceinline__ void act_store(bf16_t* dst, const f32x8 gp, const f32x8 gc, const f32x8 gn, const f32x8 vv, const f32x8 w0, const f32x8 w1, const f32x8 w2, const f32x8 bb) {
    float o[8];
#pragma unroll
    for (int i = 0; i < 8; ++i) { const float x = w0[i] * gp[i] + w1[i] * gc[i] + w2[i] * gn[i] + bb[i]; o[i] = x / (1.f + __expf(-x)) * vv[i]; }
    u32x4 w; w.x = pk2(o[0], o[1]); w.y = pk2(o[2], o[3]); w.z = pk2(o[4], o[5]); w.w = pk2(o[6], o[7]); *(u32x4*)dst = w;
}
__device__ __forceinline__ void ffn_fixup(const Frame& F, const float* SIDE, const bf16_t* GVM, bf16_t* ACT, const float* cw, const float* cb) {
    constexpr int NCH = DFF / 8;
    const f32x8 zero = {0.f, 0.f, 0.f, 0.f, 0.f, 0.f, 0.f, 0.f};
    const int gt = F.bx * 512 + F.tid, nt = GRID * 512;
    for (int idx = gt; idx < 192 * 2 * NCH; idx += nt) {
        const int ch = idx % NCH, rsel = (idx / NCH) & 1, pm = idx / (2 * NCH), c0 = 8 * ch, sq = pm >> 4;
        const f32x8 w0 = ld8f(cw + c0), w1 = ld8f(cw + DFF + c0), w2 = ld8f(cw + 2 * DFF + c0), bb = ld8f(cb + c0);
        const float* S0 = SIDE + (size_t)pm * 6 * DFF + c0;
        if (rsel == 0) { const f32x8 gp = (pm & 15) ? ld8f(S0 - 6 * DFF + 3 * DFF) : ld8b(GVM + (size_t)(16 * sq + 15) * NUP + c0);
            act_store(ACT + (size_t)(pm * 256) * DFF + c0, gp, ld8f(S0), ld8f(S0 + DFF), ld8f(S0 + 4 * DFF), w0, w1, w2, bb);
        } else { const f32x8 gn = ((pm & 15) != 15) ? ld8f(S0 + 6 * DFF) : zero;
            act_store(ACT + (size_t)(pm * 256 + 255) * DFF + c0, ld8f(S0 + 2 * DFF), ld8f(S0 + 3 * DFF), gn, ld8f(S0 + 5 * DFF), w0, w1, w2, bb); }
    }
    for (int idx = gt; idx < NSEQ * 16 * NCH; idx += nt) {
        const int ch = idx % NCH, rp = idx / NCH, pp = rp & 15, sq = rp >> 4, c0 = 8 * ch;
        const f32x8 w0 = ld8f(cw + c0), w1 = ld8f(cw + DFF + c0), w2 = ld8f(cw + 2 * DFF + c0), bb = ld8f(cb + c0);
        const bf16_t* G0 = GVM + (size_t)(16 * sq + pp) * NUP + c0;
        const f32x8 gp = pp > 0 ? ld8b(G0 - NUP) : zero, gc = ld8b(G0);
        const f32x8 gn = pp < 15 ? ld8b(G0 + NUP) : ld8f(SIDE + (size_t)(16 * sq) * 6 * DFF + c0);
        act_store(ACT + (size_t)(MROW0 + 16 * sq + pp) * DFF + c0, gp, gc, gn, ld8b(G0 + DFF), w0, w1, w2, bb);
    }
}

namespace att {
constexpr int NW = 8, QBLK = 32, KVBLK = 64, NT = 65;
constexpr int KROW = 400;
constexpr int SHM_V = KVBLK * 128 * 2, SHM_K = KVBLK * KROW;
constexpr int OFF_V = 0, OFF_K = 3 * SHM_V, OFF_WS = OFF_K + 3 * SHM_K, LDS_TOTAL = OFF_WS + NW * 64 * 4;
static_assert(LDS_TOTAL <= RING_BYTES, "attention LDS");
constexpr float SCALE = 0.07216878364870323f;
constexpr float THR = 8.f;
#define SBAR() __builtin_amdgcn_sched_barrier(0)
__device__ __forceinline__ int crow(int r, int hi) { return (r & 3) + 8 * (r >> 2) + 4 * hi; }
__device__ __forceinline__ unsigned cvtpk(float lo, float hi) { unsigned r; asm volatile("v_cvt_pk_bf16_f32 %0, %1, %2" : "=v"(r) : "v"(lo), "v"(hi)); return r; }

template <bool MASK16>
__device__ __forceinline__ void partialSM(f32x16& p0, f32x16& p1, float& m_reg, float& mn, float& alpha) {
    constexpr float C = SCALE * 1.4426950408889634f;
    if (MASK16) {
#pragma unroll
        for (int r = 8; r < 16; ++r) p0[r] = NEGBIG;
#pragma unroll
        for (int r = 0; r < 16; ++r) p1[r] = NEGBIG;
    }
    float pmax = p0[0];
#pragma unroll
    for (int r = 1; r < 16; ++r) pmax = fmaxf(pmax, p0[r]);
#pragma unroll
    for (int r = 0; r < 16; ++r) pmax = fmaxf(pmax, p1[r]);
    { auto rr = __builtin_amdgcn_permlane32_swap(__float_as_uint(pmax), __float_as_uint(pmax), false, false); pmax = fmaxf(__uint_as_float(rr[0]), __uint_as_float(rr[1])); }
    if (__builtin_expect(__all(pmax - m_reg <= THR / SCALE), 1)) { mn = m_reg; alpha = 1.f; }
    else { mn = fmaxf(m_reg, pmax); alpha = __builtin_amdgcn_exp2f((m_reg - mn) * C); m_reg = mn; }
    const float mnC = -mn * C;
#pragma unroll
    for (int r = 0; r < 16; ++r) p0[r] = fmaf(p0[r], C, mnC);
#pragma unroll
    for (int r = 0; r < 16; ++r) p1[r] = fmaf(p1[r], C, mnC);
#pragma unroll
    for (int r = 0; r < 16; ++r) p0[r] = __builtin_amdgcn_exp2f(p0[r]);
}
__device__ __forceinline__ void finishSM(f32x16& p0, f32x16& p1, float alpha, float& l_reg, bf16x8& pa0, bf16x8& pa1, bf16x8& pa2, bf16x8& pa3) {
#pragma unroll
    for (int r = 0; r < 16; ++r) p1[r] = __builtin_amdgcn_exp2f(p1[r]);
    float ps = 0;
#pragma unroll
    for (int r = 0; r < 16; ++r) ps += p0[r];
#pragma unroll
    for (int r = 0; r < 16; ++r) ps += p1[r];
    { auto rr = __builtin_amdgcn_permlane32_swap(__float_as_uint(ps), __float_as_uint(ps), false, false); ps = __uint_as_float(rr[0]) + __uint_as_float(rr[1]); }
    l_reg = l_reg * alpha + ps;
#define PK4(P, BASE, OUT) do { unsigned a0 = cvtpk(P[BASE + 0], P[BASE + 1]), a1 = cvtpk(P[BASE + 2], P[BASE + 3]);   \
    unsigned b0 = cvtpk(P[BASE + 4], P[BASE + 5]), b1 = cvtpk(P[BASE + 6], P[BASE + 7]);                              \
    auto r0 = __builtin_amdgcn_permlane32_swap(a0, b0, false, false); auto r1 = __builtin_amdgcn_permlane32_swap(a1, b1, false, false); \
    u32x4 w = {r0[0], r1[0], r0[1], r1[1]}; OUT = __builtin_bit_cast(bf16x8, w); } while (0)
    PK4(p0, 0, pa0); PK4(p0, 8, pa1); PK4(p1, 0, pa2); PK4(p1, 8, pa3);
#undef PK4
}
__device__ __forceinline__ void qkt(f32x16& p0, f32x16& p1, const LAS char* Ks, const bf16x8* qr, int r32, int hi) {
#pragma unroll
    for (int r = 0; r < 16; ++r) { p0[r] = 0.f; p1[r] = 0.f; }
#pragma unroll
    for (int d0 = 0; d0 < 12; ++d0) { const int cb = (d0 * 16 + hi * 8) * 2;
        const bf16x8 b0 = *(const LAS bf16x8*)(Ks + r32 * KROW + cb);
        const bf16x8 b1 = *(const LAS bf16x8*)(Ks + (32 + r32) * KROW + cb);
        p0 = __builtin_amdgcn_mfma_f32_32x32x16_bf16(b0, qr[d0], p0, 0, 0, 0);
        p1 = __builtin_amdgcn_mfma_f32_32x32x16_bf16(b1, qr[d0], p1, 0, 0, 0); }
}
__device__ __forceinline__ int v_st(int k, int c) { const int kk = (k & ~0xC) | ((k & 4) << 1) | ((k & 8) >> 1); return ((kk >> 3) * 4 + (c >> 5)) * 512 + ((kk & 7) * 32 + (c & 31)) * 2; }
__device__ __forceinline__ int v_rd_base(int lane) { return ((lane & 3) << 3) | (((lane >> 2) & 3) << 6) | (((lane >> 4) & 1) << 5) | (((lane >> 5) & 1) << 8); }
constexpr int v_rd_off(int d0, int ks, int half) { return d0 * 512 + ks * 4096 + half * 2048; }
template <int OFF> __device__ __forceinline__ s16x4 tr_read(int vb) { s16x4 r; asm volatile("ds_read_b64_tr_b16 %0, %1 offset:%2" : "=&v"(r) : "v"(vb), "i"(OFF) : "memory"); return r; }
template <int D0> __device__ __forceinline__ void pv_one(f32x16& od, int vb, bf16x8 pa0, bf16x8 pa1, bf16x8 pa2, bf16x8 pa3) {
    const s16x4 l0 = tr_read<v_rd_off(D0, 0, 0)>(vb), h0 = tr_read<v_rd_off(D0, 0, 1)>(vb), l1 = tr_read<v_rd_off(D0, 1, 0)>(vb), h1 = tr_read<v_rd_off(D0, 1, 1)>(vb);
    const s16x4 l2 = tr_read<v_rd_off(D0, 2, 0)>(vb), h2 = tr_read<v_rd_off(D0, 2, 1)>(vb), l3 = tr_read<v_rd_off(D0, 3, 0)>(vb), h3 = tr_read<v_rd_off(D0, 3, 1)>(vb);
    asm volatile("s_waitcnt lgkmcnt(0)" ::: "memory"); SBAR();
#define PKV(L, H) (bf16x8){L[0], L[1], L[2], L[3], H[0], H[1], H[2], H[3]}
    od = __builtin_amdgcn_mfma_f32_32x32x16_bf16(pa0, PKV(l0, h0), od, 0, 0, 0);
    od = __builtin_amdgcn_mfma_f32_32x32x16_bf16(pa1, PKV(l1, h1), od, 0, 0, 0);
    od = __builtin_amdgcn_mfma_f32_32x32x16_bf16(pa2, PKV(l2, h2), od, 0, 0, 0);
    od = __builtin_amdgcn_mfma_f32_32x32x16_bf16(pa3, PKV(l3, h3), od, 0, 0, 0);
#undef PKV
}
__device__ __forceinline__ void pv_d0(f32x16* o, int vb, bf16x8 pa0, bf16x8 pa1, bf16x8 pa2, bf16x8 pa3) {
    pv_one<0>(o[0], vb, pa0, pa1, pa2, pa3); pv_one<1>(o[1], vb, pa0, pa1, pa2, pa3); pv_one<2>(o[2], vb, pa0, pa1, pa2, pa3); pv_one<3>(o[3], vb, pa0, pa1, pa2, pa3);
}

__device__ __forceinline__ void attn_unit(int s, int h, int qb, const bf16_t* __restrict__ MQ, const bf16_t* __restrict__ MKV, const bf16_t* __restrict__ KR, bf16_t* __restrict__ MIX, LAS char* lds) {
    int tid_ = threadIdx.x; asm volatile("" : "+v"(tid_));
    const int tid = tid_, wid = tid >> 6, lane = tid & 63, r32 = lane & 31, hi = lane >> 5;
    LAS char* V_lds = lds + OFF_V; LAS char* K_lds = lds + OFF_K;
    LAS float* wsf = (LAS float*)(lds + OFF_WS) + wid * 64; LAS float* li_l = wsf; LAS float* al_l = wsf + 32;
    float m_reg = NEGBIG, l_reg = 0; f32x16 o[4]; bf16x8 qr[12];
#pragma unroll
    for (int d = 0; d < 4; ++d)
#pragma unroll
        for (int r = 0; r < 16; ++r) o[d][r] = 0.f;
    const int qi = wid * QBLK + r32;
    const unsigned qrow = qb < 16 ? (unsigned)s * LREAL + 256 * qb + qi : (unsigned)MROW0 + 16 * s + (qi < 15 ? qi : 15);
    { const bf16_t* Qw = MQ + (qrow * NQ + h * 192 + hi * 8);
#pragma unroll
      for (int d0 = 0; d0 < 12; ++d0) qr[d0] = *(const bf16x8*)(Qw + d0 * 16); }
    const int sr = tid >> 4, sc = (tid & 15) * 8, vst0 = v_st(sr, sc), vst1 = v_st(32 + sr, sc);
    const int kr_r = tid >> 3, kr_c = (tid & 7) * 8;
    const int vb0 = (int)(uintptr_t)V_lds + v_rd_base(lane);
    bf16x8 vs0, vs1, ks0, ks1, kr0;
    const unsigned mainrow0 = (unsigned)s * LREAL, metarow0 = (unsigned)MROW0 + 16 * s;
    const bf16_t* MKVh = MKV + h * 256;
#define KROWG(kt, k) ((kt) < 64 ? mainrow0 + 64u * (kt) + (k) : metarow0 + ((k) < 15 ? (k) : 15))
#define SLOAD(kt) do { const unsigned g0 = KROWG(kt, sr) * NKV + sc, g1 = KROWG(kt, 32 + sr) * NKV + sc, g2 = KROWG(kt, kr_r) * 64 + kr_c; \
    vs0 = *(const bf16x8*)(MKVh + 128 + g0); vs1 = *(const bf16x8*)(MKVh + 128 + g1); \
    ks0 = *(const bf16x8*)(MKVh + g0); ks1 = *(const bf16x8*)(MKVh + g1); kr0 = *(const bf16x8*)(KR + g2); } while (0)
#define SWRITE(b) do { *(LAS bf16x8*)(V_lds + (b) * SHM_V + vst0) = vs0; *(LAS bf16x8*)(V_lds + (b) * SHM_V + vst1) = vs1; \
    *(LAS bf16x8*)(K_lds + (b) * SHM_K + sr * KROW + sc * 2) = ks0; *(LAS bf16x8*)(K_lds + (b) * SHM_K + (32 + sr) * KROW + sc * 2) = ks1; \
    *(LAS bf16x8*)(K_lds + (b) * SHM_K + kr_r * KROW + 256 + kr_c * 2) = kr0; } while (0)
#define RESC(a) do { if (__any((a) < 1.f)) { if (hi == 0) al_l[r32] = (a); asm volatile("s_waitcnt lgkmcnt(0)" ::: "memory"); \
    _Pragma("unroll") for (int d = 0; d < 4; ++d) _Pragma("unroll") for (int r = 0; r < 16; ++r) o[d][r] *= al_l[crow(r, hi)]; } } while (0)
    f32x16 pA0, pA1, pB0, pB1; float mnA, mnB, alA, alB; bf16x8 pa0, pa1, pa2, pa3;
    __syncthreads();
    SLOAD(0); SWRITE(0); __syncthreads();
    qkt(pA0, pA1, K_lds, qr, r32, hi); partialSM<false>(pA0, pA1, m_reg, mnA, alA);
    SLOAD(1); SWRITE(1); __syncthreads();
    RESC(alA);
    int s0 = 0, s1 = 1, s2 = 2;
    if (__builtin_amdgcn_readfirstlane(wid) >= 4) __builtin_amdgcn_s_setprio(1);
    for (int j = 1; j + 1 < NT; j += 2) {
        SBAR(); qkt(pB0, pB1, K_lds + s1 * SHM_K, qr, r32, hi);
        finishSM(pA0, pA1, alA, l_reg, pa0, pa1, pa2, pa3); SBAR();
        SLOAD(j + 1); SBAR();
        pv_d0(o, vb0 + s0 * SHM_V, pa0, pa1, pa2, pa3); partialSM<false>(pB0, pB1, m_reg, mnB, alB);
        SWRITE(s2);
        RESC(alB); __syncthreads();
        SBAR(); qkt(pA0, pA1, K_lds + s2 * SHM_K, qr, r32, hi);
        finishSM(pB0, pB1, alB, l_reg, pa0, pa1, pa2, pa3); SBAR();
        if (j + 2 < NT) SLOAD(j + 2); SBAR();
        pv_d0(o, vb0 + s1 * SHM_V, pa0, pa1, pa2, pa3);
        if (j + 1 == NT - 1) partialSM<true>(pA0, pA1, m_reg, mnA, alA); else partialSM<false>(pA0, pA1, m_reg, mnA, alA);
        if (j + 2 < NT) SWRITE(s0);
        RESC(alA); __syncthreads();
        { const int t0 = s0, t1 = s1; s0 = s2; s1 = t0; s2 = t1; }
    }
    finishSM(pA0, pA1, alA, l_reg, pa0, pa1, pa2, pa3); SBAR();
    pv_d0(o, vb0 + s0 * SHM_V, pa0, pa1, pa2, pa3);
    if (hi == 0) li_l[r32] = l_reg; asm volatile("s_waitcnt lgkmcnt(0)" ::: "memory");
    __builtin_amdgcn_s_setprio(0);
    float rli[16];
#pragma unroll
    for (int r = 0; r < 16; ++r) rli[r] = __builtin_amdgcn_rcpf(li_l[crow(r, hi)]);
    if (qb < 16) {
        bf16_t* Ow = MIX + ((long)s * LREAL + 256 * qb + wid * QBLK) * DM + MLW + h * 128;
#pragma unroll
        for (int r = 0; r < 16; ++r) { const int orow = crow(r, hi);
#pragma unroll
            for (int d0 = 0; d0 < 4; ++d0) Ow[(long)orow * DM + d0 * 32 + r32] = (bf16_t)(pk2(o[d0][r] * rli[r], 0.f) & 0xffffu); }
    } else if (wid == 0) {
        bf16_t* Ow = MIX + ((long)MROW0 + 16 * s) * DM + MLW + h * 128;
#pragma unroll
        for (int r = 0; r < 16; ++r) { const int orow = crow(r, hi);
            if (orow < 16) {
#pragma unroll
                for (int d0 = 0; d0 < 4; ++d0) Ow[(long)orow * DM + d0 * 32 + r32] = (bf16_t)(pk2(o[d0][r] * rli[r], 0.f) & 0xffffu); } }
    }
#undef KROWG
#undef SLOAD
#undef SWRITE
#undef RESC
}
__device__ __forceinline__ void attn_phase(int vcu, const bf16_t* MQ, const bf16_t* MKV, const bf16_t* KR, bf16_t* MIX, LAS char* lds) {
    for (int i = (vcu < 96 ? -1 : 0); i < 6; ++i) { int sh, qb; if (i < 0) { sh = vcu; qb = 16; } else { const int id = i * GRID + vcu; sh = id >> 4; qb = id & 15; }
        attn_unit(sh >> 3, sh & 7, qb, MQ, MKV, KR, MIX, lds); }
}
#undef SBAR
}

namespace ml {
constexpr int QI = 0, KI = 32768, VI = 65536, SI = 81920, CI = 98304;
constexpr int SC_CT = 0, SC_BM = 64, SC_WI = 128, SC_EI = 192, SC_WW = 256, SC_DEN = 320, SC_QN = 448, SC_N = 512, SC_A = 768;
constexpr int GP_REC = 200;
__device__ __forceinline__ unsigned off_b(unsigned row, unsigned ch) { return 256u * row + 16u * (ch ^ (((row & 3) << 2) | ((row >> 2) & 3))); }
__device__ __forceinline__ unsigned row_read_addr_16(unsigned lane, unsigned rb, unsigned s) { return off_b((lane & 15) + 16 * rb, 4 * s + (lane >> 4)); }
__device__ __forceinline__ unsigned tr_read_addr_16(unsigned lane, unsigned c, unsigned ks, unsigned t) {
    const unsigned g = lane >> 4, q = (lane & 15) >> 2, p = lane & 3; return off_b(32 * ks + 8 * g + 4 * t + q, 2 * c + (p >> 1)) + 8 * (p & 1); }
__device__ __forceinline__ bf16x8 tr_frag(unsigned a0, unsigned a1) {
    const s16x4 lo = __builtin_amdgcn_ds_read_tr16_b64_v4i16((LAS s16x4*)a0), hi = __builtin_amdgcn_ds_read_tr16_b64_v4i16((LAS s16x4*)a1);
    return (bf16x8){lo[0], lo[1], lo[2], lo[3], hi[0], hi[1], hi[2], hi[3]};
}
__device__ __forceinline__ f32x4 mfma16(bf16x8 a, bf16x8 b, f32x4 c) { return __builtin_amdgcn_mfma_f32_16x16x32_bf16(a, b, c, 0, 0, 0); }
__device__ __forceinline__ float log_sigmoid(float x) { return fminf(x, 0.f) - __logf(1.f + __expf(-fabsf(x))); }

__device__ __forceinline__ void gate_prep(int gw, int ngw, int lane, const float* __restrict__ GATES, const float* __restrict__ bgl, float* __restrict__ GP) {
    for (int it = gw; it < 96 * 65; it += ngw) {
        const int chain = it / 65, c = it % 65, s = chain >> 3, hd = (chain >> 1) & 3, dir = chain & 1;
        const long g = c == 0 ? (lane >= 48 ? (long)MROW0 + 16 * s + lane - 48 : -1L) : (long)s * LREAL + 64 * (c - 1) + lane;
        float li = NEGBIG, lf = 0.f;
        if (g >= 0) { li = GATES[g * 16 + (dir ? 8 : 0) + hd] + bgl[(dir ? 8 : 0) + hd]; lf = log_sigmoid(GATES[g * 16 + (dir ? 12 : 4) + hd] + bgl[(dir ? 12 : 4) + hd]); }
        float x = dir ? __shfl(lf, 63 - lane) : lf;
#pragma unroll
        for (int o = 1; o < 64; o <<= 1) { const float y = __shfl_up(x, o); if (lane >= o) x += y; }
        const float btot = __shfl(x, 63);
        const float b = dir ? __shfl(x, 63 - lane) : x;
        const float a_s = li - b;
        float pm = dir ? __shfl(a_s, 63 - lane) : a_s;
#pragma unroll
        for (int o = 1; o < 64; o <<= 1) { const float y = __shfl_up(pm, o); if (lane >= o) pm = fmaxf(pm, y); }
        pm = dir ? __shfl(pm, 63 - lane) : pm;
        const float gmax = wave_max(btot - b + li);
        float* rec = GP + (size_t)it * GP_REC;
        rec[lane] = b; rec[64 + lane] = li; rec[128 + lane] = pm; if (lane == 0) { rec[192] = btot; rec[193] = gmax; }
    }
}

__device__ __forceinline__ void mlstm_unit(int s, int hd, int js, const bf16_t* __restrict__ UQKVO, const float* __restrict__ GP, float* __restrict__ HSUM, LAS unsigned char* lds, LAS float* sc) {
    const int wid = __builtin_amdgcn_readfirstlane((int)threadIdx.x >> 6);
    const unsigned ldsb = (unsigned)(uintptr_t)lds;
    const int tt = wid >> 1, nb = 2 * (wid & 1);
#define ROWRD(img, rb, s_) (*(const LAS bf16x8*)(uintptr_t)(RB[s_] + (unsigned)((img) + 4096 * (rb))))
#define TRFRAG(img, c_, ks) tr_frag(BT[0][(c_) & 1] + TQ[(c_) >> 1] + (unsigned)((img) + 8192 * (ks)), BT[1][(c_) & 1] + TQ[(c_) >> 1] + (unsigned)((img) + 8192 * (ks)))
    f32x4 accC[2][4], accN[2];
    for (int dir = 0; dir < 2; ++dir) {
        int tid; { int t0_ = threadIdx.x; asm volatile("" : "+v"(t0_)); tid = t0_; }
#pragma unroll
        for (int mi = 0; mi < 2; ++mi)
#pragma unroll
            for (int c = 0; c < 4; ++c) accC[mi][c] = (f32x4){0.f, 0.f, 0.f, 0.f};
        accN[0] = (f32x4){0.f, 0.f, 0.f, 0.f}; accN[1] = (f32x4){0.f, 0.f, 0.f, 0.f};
        if (tid < 256) sc[SC_N + tid] = 0.f;
        for (int i = tid; i < 32768 / 16; i += 512) *(LAS u32x4*)(lds + CI + i * 16) = (u32x4){0u, 0u, 0u, 0u};
        float m_state = 0.f;
        const float* GPc = GP + (size_t)(((s * 4 + hd) * 2 + dir) * 65) * GP_REC;
        u32x4 sq[4], sk[4], sv; float sb = 0.f, sli = NEGBIG, spm = NEGBIG, sbt = 0.f, sgm = NEGBIG;
#define ROWG(c, r) ((c) == 0 ? ((r) >= 48 ? (long)MROW0 + 16 * s + (r) - 48 : -1L) : (long)s * LREAL + 64 * ((c) - 1) + (r))
#define STAGE_LOAD(c) do { \
        _Pragma("unroll") for (int i = 0; i < 4; ++i) { const int id = tid + 512 * i, r = id >> 5, ch = id & 31; const long g = ROWG(c, r); \
            sq[i] = (u32x4){0u, 0u, 0u, 0u}; sk[i] = (u32x4){0u, 0u, 0u, 0u}; \
            if (g >= 0) { sq[i] = *(const u32x4*)(UQKVO + g * 4096 + hd * 256 + ch * 8); sk[i] = *(const u32x4*)(UQKVO + g * 4096 + 1024 + hd * 256 + ch * 8); } } \
        { const int r = tid >> 3, ch = tid & 7; const long g = ROWG(c, r); sv = (u32x4){0u, 0u, 0u, 0u}; if (g >= 0) sv = *(const u32x4*)(UQKVO + g * 4096 + 2048 + hd * 256 + js * 64 + ch * 8); } \
        if (tid < 64) { const float* rec = GPc + (size_t)(c) * GP_REC; sb = rec[tid]; sli = rec[64 + tid]; spm = rec[128 + tid]; sbt = rec[192]; sgm = rec[193]; } } while (0)
#define STAGE_WRITE() do { \
        _Pragma("unroll") for (int i = 0; i < 4; ++i) { const int id = tid + 512 * i, r = id >> 5, ch = id & 31; \
            *(LAS u32x4*)(lds + QI + (ch >> 4) * 16384 + off_b(r, ch & 15)) = sq[i]; *(LAS u32x4*)(lds + KI + (ch >> 4) * 16384 + off_b(r, ch & 15)) = sk[i]; } \
        { const int r = tid >> 3, ch = tid & 7; *(LAS u32x4*)(lds + VI + off_b(r, ch)) = sv; } \
        if (tid < 64) { const float m_inter = sb + m_state, mt = fmaxf(m_inter, sb + spm); const float m_new = fmaxf(sbt + m_state, sgm); \
            sc[SC_CT + tid] = sli - sb; sc[SC_BM + tid] = sb - mt; sc[SC_WI + tid] = __expf(m_inter - mt); sc[SC_EI + tid] = __expf(-mt); \
            sc[SC_WW + tid] = __expf(sbt - sb + sli - m_new) * 0.0625f; if (tid == 0) sc[SC_A] = __expf(sbt + m_state - m_new); m_state = m_new; } } while (0)
        const int c_first = dir ? 64 : 0, c_step = dir ? -1 : 1;
        STAGE_LOAD(c_first);
        __syncthreads();
        STAGE_WRITE();
        for (int ci = 0; ci < 65; ++ci) {
            const int c = c_first + c_step * ci;
            { int t2_ = threadIdx.x; asm volatile("" : "+v"(t2_)); tid = t2_; }
            const int lane = tid & 63, l15 = lane & 15, lg = lane >> 4;
            unsigned RB[4], BT[2][2], TQ[4];
            { const unsigned fl = ((l15 & 3) << 2) | (l15 >> 2), q = l15 >> 2, p = lane & 3, g = lg;
#pragma unroll
              for (int s_ = 0; s_ < 4; ++s_) { RB[s_] = ldsb + 256u * l15 + 16u * (lg ^ (fl & 3)) + 64u * (s_ ^ (fl >> 2)); TQ[s_] = 64u * (s_ ^ q); }
#pragma unroll
              for (int t_ = 0; t_ < 2; ++t_)
#pragma unroll
                  for (int cl = 0; cl < 2; ++cl) BT[t_][cl] = ldsb + 256u * (8 * g + q) + 8u * (p & 1) + 1024u * t_ + 16u * ((p >> 1) ^ t_) + 32u * (cl ^ (g & 1)); }
            __syncthreads();
            if (ci + 1 < 65) STAGE_LOAD(c + c_step);
            bf16x8 qf[8];
#pragma unroll
            for (int k = 0; k < 8; ++k) qf[k] = ROWRD(QI + (k >> 2) * 16384, tt, k & 3);
            f32x4 sT[2], oc[2];
#pragma unroll
            for (int i = 0; i < 2; ++i) { sT[i] = (f32x4){0.f, 0.f, 0.f, 0.f}; oc[i] = (f32x4){0.f, 0.f, 0.f, 0.f}; }
#pragma unroll
            for (int i = 0; i < 2; ++i)
#pragma unroll
                for (int k = 0; k < 8; ++k) {
                    const bf16x8 kf = ROWRD(KI + (k >> 2) * 16384, nb + i, k & 3);
                    sT[i] = mfma16(kf, qf[k], sT[i]);
                    const bf16x8 cf = ROWRD(CI + (k >> 2) * 16384, nb + i, k & 3);
                    oc[i] = mfma16(qf[k], cf, oc[i]);
                }
            {
                const int t = 16 * tt + l15; const float bmt = sc[SC_BM + t]; float rs = 0.f;
#pragma unroll
                for (int i = 0; i < 2; ++i) { const int s0 = 16 * (nb + i) + 4 * lg; const f32x4 ctv = *(const LAS f32x4*)(sc + SC_CT + s0); float v[4];
#pragma unroll
                    for (int e = 0; e < 4; ++e) { const int sx = s0 + e; const bool ok = dir ? (sx >= t) : (sx <= t);
                        const float ex = ok ? (bmt + ctv[e]) : NEGBIG; v[e] = sT[i][e] * 0.0625f * __expf(ex); rs += v[e]; }
                    u32x2 w; w.x = pk2(v[0], v[1]); w.y = pk2(v[2], v[3]);
                    *(LAS u32x2*)(lds + SI + off_b(t, s0 >> 3) + (s0 & 7) * 2) = w; }
                rs += __shfl_xor(rs, 16); rs += __shfl_xor(rs, 32);
                if (lg == 0) sc[SC_DEN + 64 * (wid & 1) + t] = rs;
            }
            { const int r = tid >> 3, ch = tid & 7; const u32x4 v = *(const LAS u32x4*)(lds + VI + off_b(r, ch)); const float w = sc[SC_WW + r]; u32x4 o;
#pragma unroll
              for (int jx = 0; jx < 4; ++jx) o[jx] = pk2(bf_lo(v[jx]) * w, bf_hi(v[jx]) * w);
              *(LAS u32x4*)(lds + VI + off_b(r, 8 + ch)) = o; }
            { const int r = tid >> 3, part = tid & 7; float d = 0.f;
#pragma unroll
              for (int i = 0; i < 4; ++i) { const int ch32 = part * 4 + i; const u32x4 v = *(const LAS u32x4*)(lds + QI + (ch32 >> 4) * 16384 + off_b(r, ch32 & 15));
                  const f32x4 n0 = *(const LAS f32x4*)(sc + SC_N + ch32 * 8), n1 = *(const LAS f32x4*)(sc + SC_N + ch32 * 8 + 4);
                  d += bf_lo(v[0]) * n0[0] + bf_hi(v[0]) * n0[1] + bf_lo(v[1]) * n0[2] + bf_hi(v[1]) * n0[3] + bf_lo(v[2]) * n1[0] + bf_hi(v[2]) * n1[1] + bf_lo(v[3]) * n1[2] + bf_hi(v[3]) * n1[3]; }
              d += __shfl_xor(d, 1); d += __shfl_xor(d, 2); d += __shfl_xor(d, 4);
              if (part == 0) sc[SC_QN + r] = d; }
            { const f32x4 wi = *(const LAS f32x4*)(sc + SC_WI + 16 * tt + 4 * lg);
#pragma unroll
              for (int i = 0; i < 2; ++i) oc[i] = oc[i] * wi; }
            __syncthreads();
            const float a_dec = sc[SC_A];
#pragma unroll
            for (int ks = 0; ks < 2; ++ks) { const bf16x8 sf = ROWRD(SI, tt, ks);
#pragma unroll
                for (int i = 0; i < 2; ++i) { const bf16x8 vf = TRFRAG(VI, nb + i, ks);
                    oc[i] = mfma16(sf, vf, oc[i]); } }
            { const int t0 = 16 * tt + 4 * lg;
              const f32x4 wi = *(const LAS f32x4*)(sc + SC_WI + t0), qn = *(const LAS f32x4*)(sc + SC_QN + t0), d0 = *(const LAS f32x4*)(sc + SC_DEN + t0), d1 = *(const LAS f32x4*)(sc + SC_DEN + 64 + t0), ei = *(const LAS f32x4*)(sc + SC_EI + t0);
#pragma unroll
              for (int e = 0; e < 4; ++e) { const long g = ROWG(c, t0 + e);
                const float den = wi[e] * qn[e] + (d0[e] + d1[e]); const float inv = 1.f / fmaxf(fabsf(den), ei[e]);
                if (g >= 0) {
#pragma unroll
                    for (int i = 0; i < 2; ++i) { float* hp = HSUM + g * MLW + hd * 256 + js * 64 + 16 * (nb + i) + l15; const float hv = oc[i][e] * inv; if (dir) unsafeAtomicAdd(hp, hv); else *hp = hv; } } } }
#pragma unroll
            for (int mi = 0; mi < 2; ++mi)
#pragma unroll
                for (int cc = 0; cc < 4; ++cc) accC[mi][cc] = accC[mi][cc] * a_dec;
            accN[0] = accN[0] * a_dec; accN[1] = accN[1] * a_dec;
            const unsigned ktq = (unsigned)(KI + (wid >> 2) * 16384) + 64u * ((unsigned)(wid & 3) ^ (unsigned)(l15 >> 2));
#pragma unroll
            for (int ks = 0; ks < 2; ++ks) {
                bf16x8 kf[2], wf[4];
#pragma unroll
                for (int mi = 0; mi < 2; ++mi) kf[mi] = tr_frag(BT[0][mi] + ktq + (unsigned)(8192 * ks), BT[1][mi] + ktq + (unsigned)(8192 * ks));
#pragma unroll
                for (int cc = 0; cc < 4; ++cc) wf[cc] = TRFRAG(VI, 4 + cc, ks);
                { const f32x4 wa = *(const LAS f32x4*)(sc + SC_WW + 32 * ks + 8 * lg), wb = *(const LAS f32x4*)(sc + SC_WW + 32 * ks + 8 * lg + 4);
                  u32x4 wq; wq.x = pk2(wa[0], wa[1]); wq.y = pk2(wa[2], wa[3]); wq.z = pk2(wb[0], wb[1]); wq.w = pk2(wb[2], wb[3]);
                  if (l15 != 0) wq = (u32x4){0u, 0u, 0u, 0u};
                  const bf16x8 wfn = __builtin_bit_cast(bf16x8, wq);
#pragma unroll
                  for (int mi = 0; mi < 2; ++mi) accN[mi] = mfma16(kf[mi], wfn, accN[mi]); }
#pragma unroll
                for (int mi = 0; mi < 2; ++mi)
#pragma unroll
                    for (int cc = 0; cc < 4; ++cc) accC[mi][cc] = mfma16(kf[mi], wf[cc], accC[mi][cc]);
            }
#pragma unroll
            for (int mi = 0; mi < 2; ++mi)
#pragma unroll
                for (int cc = 0; cc < 4; ++cc) { const int dk0 = 32 * wid + 16 * mi + 4 * lg, dv = 16 * cc + l15; u32x2 w; w.x = pk2(accC[mi][cc][0], accC[mi][cc][1]); w.y = pk2(accC[mi][cc][2], accC[mi][cc][3]);
                    *(LAS u32x2*)(lds + CI + (dk0 >> 7) * 16384 + off_b(dv, (dk0 & 127) >> 3) + (dk0 & 7) * 2) = w; }
            if (l15 == 0) { *(LAS f32x4*)(sc + SC_N + 32 * wid + 4 * lg) = accN[0]; *(LAS f32x4*)(sc + SC_N + 32 * wid + 16 + 4 * lg) = accN[1]; }
            __syncthreads();
            if (ci + 1 < 65) STAGE_WRITE();
        }
    }
#undef ROWG
#undef STAGE_LOAD
#undef STAGE_WRITE
#undef ROWRD
#undef TRFRAG
}
__device__ __forceinline__ void mlstm_phase(int bx, const bf16_t* UQKVO, const float* GP, float* HSUM, LAS unsigned char* lds, LAS float* sc) {
    if (bx >= 192) return;
    const int xcd = bx & 7, idx = bx >> 3, pair = xcd * 6 + (idx >> 2), js = idx & 3;
    mlstm_unit(pair >> 2, pair & 3, js, UQKVO, GP, HSUM, lds, sc);
}
}

#ifndef PHM
#define PHM 0xffff
#endif
#ifndef REP_ML
#define REP_ML 1
#endif
#ifndef REP_ATTN
#define REP_ATTN 1
#endif
#ifndef REP_CONV
#define REP_CONV 1
#endif
#ifndef REP_SMALL
#define REP_SMALL 1
#endif
#ifndef KV_SPLIT
#define KV_SPLIT 193
#endif
#ifndef REP_WIN
#define REP_WIN 1
#endif
#ifndef REP_UP
#define REP_UP 1
#endif
__global__ void __launch_bounds__(512, 2) fwd_kernel(Params P, unsigned char* ws_arg, unsigned char* out_arg) {
    extern __shared__ __attribute__((aligned(16))) unsigned char lds_raw[];
    Frame F;
    F.lds = (LAS unsigned char*)lds_raw;
    F.tid = threadIdx.x; F.lane = F.tid & 63; F.wave = __builtin_amdgcn_readfirstlane(F.tid >> 6);
    F.G = GRID; F.bx = blockIdx.x; F.vcu = (F.bx % 8) * (GRID / 8) + F.bx / 8;
    F.gw = F.vcu * 8 + F.wave; F.ngw = F.G * 8;
    { unsigned char* ws0 = ws_arg;
      for (int u = F.tid; u < (LDS_BYTES - MISC_OFF) / 4; u += 512) ((LAS unsigned*)(F.lds + MISC_OFF))[u] = 0u;
      __syncthreads();
      (void)ws0; }
    LAS unsigned long long* ptab = (LAS unsigned long long*)(F.lds + MISC_OFF + 64);
    if (F.tid == 0) {
#pragma unroll
        for (int k = 0; k < 19; ++k) ptab[k] = (unsigned long long)(uintptr_t)P.in[k]; }
    __syncthreads();
    XcdBarrier bar = xcd_barrier_post((unsigned*)(ws_arg + WS_CTL) + CW_BAR, (volatile LAS unsigned*)(F.lds + MISC_OFF));
    LAS float* sc = (LAS float*)(F.lds + MISC_OFF + 1024);
#define BXL() ({ int b__ = F.bx; asm volatile("" : "+s"(b__)); b__; })
#define PFRAME() Frame Fp = F; { int t_ = threadIdx.x; asm volatile("" : "+v"(t_)); Fp.tid = t_; Fp.lane = t_ & 63; int b_ = BXL(); Fp.bx = b_; Fp.vcu = (b_ % 8) * (GRID / 8) + b_ / 8; Fp.gw = Fp.vcu * 8 + Fp.wave; }
#define WSB() ({ GAS unsigned char* w__ = (GAS unsigned char*)ws_arg; asm volatile("" : "+s"(w__)); (unsigned char*)w__; })
#ifndef STAG_N
#define STAG_N 1
#endif
#ifdef STAG_ON
#define STAGGER() do { int s__ = (BXL() * 37) & 255; for (int i__ = 0; i__ < s__; ++i__) __builtin_amdgcn_s_sleep(STAG_N); } while (0)
#else
#define STAGGER() do {} while (0)
#endif
#define WOFS(l_) (((l_) & 1) ? WSET_DELTA : (size_t)0)
#define DOB() ({ GAS unsigned char* w__ = (GAS unsigned char*)out_arg; asm volatile("" : "+s"(w__)); (unsigned char*)w__; })

    { unsigned char* ws = WSB(); prologue(F, ws, ptab); convert_weights(F, ws, ptab, 0, 0, -1); }
    xcd_barrier(bar);

    for (int l = 0; l < DEPTH; ++l) {
        { unsigned char* ws = WSB();
          pg8::Gemm g{(bf16_t*)(ws + WS_HB), (bf16_t*)(ws + WOFS(l) + WS_WIN), TP, NIN, DM, DM}; pg8::PanelOrder S; S.init(NPAN, 0, 0, 0, NIN, F.G, BXL());
          pg8::EpiWin E{(bf16_t*)(ws + WS_UQKVO), (bf16_t*)(ws + WS_UDQ), (bf16_t*)(ws + WS_UDKV), (bf16_t*)(ws + WS_KR), (float*)(ws + WS_GATES), (const float*)(ws + WS_COS), (const float*)(ws + WS_SIN)};
#if PHM & 2
          STAGGER(); pg8::gemm_phase<pg8::EpiWin, pg8::PanelOrder, true, true>(F.lds, g, S, E);
#endif
        }
        if (l + 1 < DEPTH && BXL() >= 20) { unsigned char* ws = WSB(); PFRAME(); Fp.gw = (Fp.bx - 20) * 8 + Fp.wave; Fp.ngw = (GRID - 20) * 8; convert_weights(Fp, ws, ptab, l + 1, WOFS(l + 1), 0); }
#if REP_WIN > 1
        __syncthreads();
        { unsigned char* ws = WSB();
          pg8::Gemm g{(bf16_t*)(ws + WS_HB), (bf16_t*)(ws + WOFS(l) + WS_WIN), TP, NIN, DM, DM}; pg8::PanelOrder S; S.init(NPAN, 0, 0, 0, NIN, F.G, BXL());
          pg8::EpiWin E{(bf16_t*)(ws + WS_UQKVO), (bf16_t*)(ws + WS_UDQ), (bf16_t*)(ws + WS_UDKV), (bf16_t*)(ws + WS_KR), (float*)(ws + WS_GATES), (const float*)(ws + WS_COS), (const float*)(ws + WS_SIN)};
          pg8::gemm_phase<pg8::EpiWin, pg8::PanelOrder, true, true>(F.lds, g, S, E);
        }
#endif
        xcd_barrier(bar);
        { unsigned char* ws = WSB(); unsigned char* dob = DOB(); PFRAME(); rstd_rows(Fp, (bf16_t*)(ws + WS_UDQ), (bf16_t*)(ws + WS_UDKV), (float*)(ws + WS_RSTD));
          ml::gate_prep(Fp.gw, Fp.ngw, Fp.lane, (const float*)(ws + WS_GATES), (const float*)(ws + WS_PAR) + PO_BG + l * 16, (float*)(dob + DO_GP)); }
#if REP_SMALL > 1
        { unsigned char* ws = WSB(); unsigned char* dob = DOB(); PFRAME(); rstd_rows(Fp, (bf16_t*)(ws + WS_UDQ), (bf16_t*)(ws + WS_UDKV), (float*)(ws + WS_RSTD));
          ml::gate_prep(Fp.gw, Fp.ngw, Fp.lane, (const float*)(ws + WS_GATES), (const float*)(ws + WS_PAR) + PO_BG + l * 16, (float*)(dob + DO_GP)); }
#endif
        xcd_barrier(bar);
        if (F.bx >= 192) {
        { unsigned char* ws = WSB(); unsigned char* dob = DOB();
          pg8::Gemm g{(bf16_t*)(ws + WS_UDQ), (bf16_t*)(ws + WOFS(l) + WS_WUQ), TP, NQ, 512, 512}; pg8::PanelOrder S; S.init(NPAN, 0, 0, 0, NQ, GRID - 192, BXL() - 192);
          pg8::EpiQ E{(bf16_t*)(dob + DO_MQ), (const float*)(ws + WS_RSTD), (const float*)(ws + WS_COS), (const float*)(ws + WS_SIN)};
#if PHM & 4
          pg8::gemm_phase<pg8::EpiQ, pg8::PanelOrder, true, true>(F.lds, g, S, E);
#endif
        }
        { unsigned char* ws = WSB();
          pg8::Gemm g{(bf16_t*)(ws + WS_UDKV), (bf16_t*)(ws + WOFS(l) + WS_WUKV), TP, NKV, 256, 256}; pg8::PanelOrder S; S.init(NPAN, 0, 0, 0, NKV, GRID - 192, BXL() - 192);
          pg8::EpiBf16G E{(bf16_t*)(ws + WS_MKV), NKV, (const float*)(ws + WS_RSTD) + 1, 0, -1, 0};
#if PHM & 8
          pg8::gemm_phase<pg8::EpiBf16G, pg8::PanelOrder, true, true>(F.lds, g, S, E);
#endif
        }
        } else {
#ifndef NO_ML
        for (int rep_ = 0; rep_ < REP_ML; ++rep_)
        { unsigned char* ws = WSB(); unsigned char* dob = DOB();
          ml::mlstm_phase(BXL(), (const bf16_t*)(ws + WS_UQKVO), (const float*)(dob + DO_GP), (float*)(dob + DO_HSUM), F.lds, sc); }
#endif
        }
        xcd_barrier(bar);
        { unsigned char* ws = WSB(); unsigned char* dob = DOB(); PFRAME();
          if (Fp.vcu >= 96) mlstm_finalize(Fp, (Fp.vcu - 96) * 8 + Fp.wave, (GRID - 96) * 8, (const float*)(dob + DO_HSUM), (const bf16_t*)(ws + WS_UQKVO), (const float*)(ws + WS_PAR) + PO_MLG + l * MLW, (bf16_t*)(ws + WS_HB)); }
#ifndef NO_ATTN
        for (int rep_ = 0; rep_ < REP_ATTN; ++rep_)
        { unsigned char* ws = WSB(); unsigned char* dob = DOB();
          att::attn_phase(({ int b__ = BXL(); (b__ % 8) * (GRID / 8) + b__ / 8; }), (const bf16_t*)(dob + DO_MQ), (const bf16_t*)(ws + WS_MKV), (const bf16_t*)(ws + WS_KR), (bf16_t*)(ws + WS_HB), (LAS char*)F.lds); }
#endif
        xcd_barrier(bar);
        { unsigned char* ws = WSB();
          pg8::Gemm g{(bf16_t*)(ws + WS_HB), (bf16_t*)(ws + WOFS(l) + WS_WOUT), TP, DM, DM, DM}; pg8::PanelOrder S; S.init(192, 0, 0, 0, DM, F.G, BXL());
          pg8::EpiResidLn E{(bf16_t*)(ws + WS_H), DM, ALPHA, (const float*)(ws + WS_STAT2), (const float*)(ws + WS_PAR) + (l > 0 ? PO_L2G + (l - 1) * DM : PO_ONE), (const float*)(ws + WS_PAR) + (l > 0 ? PO_L2B + (l - 1) * DM : PO_ZERO)};
#if PHM & 16
          STAGGER(); pg8::gemm_phase<pg8::EpiResidLn, pg8::PanelOrder, true, true>(F.lds, g, S, E);
#endif
        }
        { unsigned char* ws = WSB();
          pg8::Gemm g{(bf16_t*)(ws + WS_HB), (bf16_t*)(ws + WOFS(l) + WS_WOUT), TP, DM, DM / 4, DM}; pg8::SplitOrder S; S.init(PMETA, DM, 4, F.G, BXL());
          pg8::EpiPart E{(float*)(ws + WS_PART), DM};
#if PHM & 16
          pg8::gemm_phase<pg8::EpiPart, pg8::SplitOrder, true, true>(F.lds, g, S, E);
#endif
        }
        xcd_barrier(bar);
        { unsigned char* ws = WSB(); PFRAME(); ln_rows(Fp, (float*)(ws + WS_H), (bf16_t*)(ws + WS_HB), (const float*)(ws + WS_PAR) + PO_L1G + l * DM, (const float*)(ws + WS_PAR) + PO_L1B + l * DM, (float*)(ws + WS_STAT1), nullptr, (const float*)(ws + WS_PART), 4); }
        xcd_barrier(bar);
        { unsigned char* ws = WSB(); unsigned char* dob = DOB();
          pg8::Gemm g{(bf16_t*)(ws + WS_HB), (bf16_t*)(ws + WOFS(l) + WS_WUP), TP, NUP, DM, DM}; pg8::PanelOrder S; S.init(NPAN, 0, 0, 0, NUP, F.G, BXL());
          pg8::EpiFfn E{(bf16_t*)(ws + WS_ACT), (float*)(dob + DO_SIDE), (bf16_t*)(dob + DO_GVM), (const float*)(ws + WS_PAR) + PO_CW + (size_t)l * 3 * DFF, (const float*)(ws + WS_PAR) + PO_CB + (size_t)l * DFF, (LAS float*)(F.lds + MISC_OFF + 8192)};
#if PHM & 32
          STAGGER(); pg8::gemm_phase<pg8::EpiFfn, pg8::PanelOrder, true, true>(F.lds, g, S, E);
#if REP_UP > 1
          __syncthreads(); pg8::gemm_phase<pg8::EpiFfn, pg8::PanelOrder, true, true>(F.lds, g, S, E);
#endif
#endif
        }
        if (l + 1 < DEPTH && BXL() >= 44) { unsigned char* ws = WSB(); PFRAME(); Fp.gw = (Fp.bx - 44) * 8 + Fp.wave; Fp.ngw = (GRID - 44) * 8; convert_weights(Fp, ws, ptab, l + 1, WOFS(l + 1), 1); }
        xcd_barrier(bar);
        { unsigned char* ws = WSB(); unsigned char* dob = DOB(); PFRAME();
          ffn_fixup(Fp, (const float*)(dob + DO_SIDE), (const bf16_t*)(dob + DO_GVM), (bf16_t*)(ws + WS_ACT), (const float*)(ws + WS_PAR) + PO_CW + (size_t)l * 3 * DFF, (const float*)(ws + WS_PAR) + PO_CB + (size_t)l * DFF); }
#if REP_SMALL > 1
        { unsigned char* ws = WSB(); unsigned char* dob = DOB(); PFRAME();
          ffn_fixup(Fp, (const float*)(dob + DO_SIDE), (const bf16_t*)(dob + DO_GVM), (bf16_t*)(ws + WS_ACT), (const float*)(ws + WS_PAR) + PO_CW + (size_t)l * 3 * DFF, (const float*)(ws + WS_PAR) + PO_CB + (size_t)l * DFF); }
#endif
        xcd_barrier(bar);
        { unsigned char* ws = WSB();
          pg8::Gemm g{(bf16_t*)(ws + WS_ACT), (bf16_t*)(ws + WOFS(l) + WS_WDN), TP, DM, DFF, DFF}; pg8::PanelOrder S; S.init(192, 0, 0, 0, DM, F.G, BXL());
          pg8::EpiResidLn E{(bf16_t*)(ws + WS_H), DM, ALPHA, (const float*)(ws + WS_STAT1), (const float*)(ws + WS_PAR) + PO_L1G + l * DM, (const float*)(ws + WS_PAR) + PO_L1B + l * DM};
#if PHM & 64
          STAGGER(); pg8::gemm_phase<pg8::EpiResidLn, pg8::PanelOrder, true, true>(F.lds, g, S, E);
#endif
        }
        { unsigned char* ws = WSB();
          pg8::Gemm g{(bf16_t*)(ws + WS_ACT), (bf16_t*)(ws + WOFS(l) + WS_WDN), TP, DM, DFF / 11, DFF}; pg8::SplitOrder S; S.init(PMETA, DM, 11, F.G, BXL());
          pg8::EpiPart E{(float*)(ws + WS_PART), DM};
#if PHM & 64
          pg8::gemm_phase<pg8::EpiPart, pg8::SplitOrder, true, true>(F.lds, g, S, E);
#endif
        }
        xcd_barrier(bar);
        { unsigned char* ws = WSB(); unsigned char* dob = DOB();
          PFRAME(); ln_rows(Fp, (float*)(ws + WS_H), (bf16_t*)(ws + WS_HB), (const float*)(ws + WS_PAR) + PO_L2G + l * DM, (const float*)(ws + WS_PAR) + PO_L2B + l * DM, (float*)(ws + WS_STAT2), l == DEPTH - 1 ? (float*)dob : nullptr, (const float*)(ws + WS_PART), 11); }
#if REP_CONV > 1
#endif
        xcd_barrier(bar);
    }
}

extern "C" void kernel_launch(void* const* d_in, const int* in_sizes, int n_in, void* d_out, int out_size, void* d_ws, size_t ws_size, hipStream_t stream) {
    static int grid = 0;
    if (grid == 0) {
        if (n_in != 19 || out_size != NMAIN * DM || ws_size < WS_NEED) { fprintf(stderr, "kernel_launch: unexpected shapes (n_in %d out %d ws %zu need %zu)\n", n_in, out_size, ws_size, (size_t)WS_NEED); grid = -1; return; }
        int dev = 0, cus = 0;
        if (hipGetDevice(&dev) != hipSuccess || hipDeviceGetAttribute(&cus, hipDeviceAttributeMultiprocessorCount, dev) != hipSuccess) { grid = -1; return; }
        if (hipFuncSetAttribute((const void*)fwd_kernel, hipFuncAttributeMaxDynamicSharedMemorySize, LDS_BYTES) != hipSuccess) { fprintf(stderr, "kernel_launch: hipFuncSetAttribute failed\n"); grid = -1; return; }
        int per_cu = 0;
        if (hipOccupancyMaxActiveBlocksPerMultiprocessor(&per_cu, (const void*)fwd_kernel, 512, LDS_BYTES) != hipSuccess || per_cu < 1) { fprintf(stderr, "kernel_launch: occupancy query says %d blocks per CU\n", per_cu); (void)hipGetLastError(); grid = -1; return; }
        if (cus < GRID) { fprintf(stderr, "kernel_launch: needs %d CUs, device has %d\n", GRID, cus); grid = -1; return; }
        grid = GRID;
    }
    if (grid < 0) return;
    (void)hipMemsetAsync((char*)d_ws + WS_CTL, 0, CTL_BYTES, stream);
    Params p{};
    for (int i = 0; i < 19; ++i) p.in[i] = (const float*)d_in[i];
    hipLaunchKernelGGL(fwd_kernel, dim3(grid), dim3(512), LDS_BYTES, stream, p, (unsigned char*)d_ws, (unsigned char*)d_out);
}
```

```cpp
#include <hip/hip_runtime.h>
#include <cstdio>
#include <cstdint>

#define LAS __attribute__((address_space(3)))
#define GAS __attribute__((address_space(1)))
typedef float f32x2 __attribute__((ext_vector_type(2)));
typedef float f32x8 __attribute__((ext_vector_type(8)));
typedef float f32x16 __attribute__((ext_vector_type(16)));
typedef unsigned u32x2 __attribute__((ext_vector_type(2)));
typedef short s16x4 __attribute__((ext_vector_type(4)));
typedef __bf16 bf16x2v __attribute__((ext_vector_type(2)));

constexpr int DM = 2048, NSEQ = 12, LREAL = 4096, NMETA = 16, DEPTH = 4;
constexpr int NMAIN = NSEQ * LREAL;
constexpr int MROW0 = NMAIN;
constexpr int NTOK = NMAIN + NSEQ * NMETA;
constexpr int NPAN = 193, TP = NPAN * 256;
constexpr int PMETA = 192;
constexpr int INC = 4944, NIN = 5120;
constexpr int DFF = 5632, NUP = 2 * DFF;
constexpr int MLW = 1024, NQ = 1536, NKV = 2048;
constexpr float ALPHA = 1.681792830507429f;
constexpr float EPS = 1e-5f;
constexpr float NEGBIG = -1e30f;

constexpr size_t MiB = 1u << 20;
constexpr size_t WS_CTL = 0, CTL_BYTES = 1 * MiB;
constexpr size_t WS_COS = 1 * MiB;
constexpr size_t WS_SIN = WS_COS + (size_t)4112 * 32 * 4;
constexpr size_t WS_PAR = 2 * MiB + 128 * 1024;
constexpr int PO_BG = 0, PO_MLG = PO_BG + DEPTH * 16, PO_QG = PO_MLG + DEPTH * 1024, PO_KVG = PO_QG + DEPTH * 512, PO_L1G = PO_KVG + DEPTH * 256, PO_L1B = PO_L1G + DEPTH * 2048,
              PO_CW = PO_L1B + DEPTH * 2048, PO_CB = PO_CW + DEPTH * 3 * 5632, PO_L2G = PO_CB + DEPTH * 5632, PO_L2B = PO_L2G + DEPTH * 2048, PO_ONE = PO_L2B + DEPTH * 2048, PO_ZERO = PO_ONE + 2048, PO_END = PO_ZERO + 2048;
static_assert(WS_PAR + (size_t)PO_END * 4 <= 3 * MiB && WS_PAR >= 1 * MiB + 2 * 4112 * 32 * 4, "PAR block placement");
constexpr size_t WS_WIN = 3 * MiB;
constexpr size_t WS_WUQ = WS_WIN + (size_t)NIN * DM * 2;
constexpr size_t WS_WUKV = WS_WUQ + (size_t)NQ * 512 * 2;
constexpr size_t WS_WOUT = WS_WUKV + (size_t)NKV * 256 * 2;
constexpr size_t WS_WUP = WS_WOUT + (size_t)DM * DM * 2;
constexpr size_t WS_WDN = WS_WUP + (size_t)NUP * DM * 2;
constexpr size_t WS_STAT1 = WS_WDN + (size_t)DM * DFF * 2;
constexpr size_t WS_STAT2 = WS_CTL + 512 * 1024;
constexpr size_t WS_H = 100 * MiB;
constexpr size_t WS_PART = WS_H + 208 * MiB;
static_assert((size_t)NMAIN * DM * 2 <= 208 * MiB && 208 * MiB + (size_t)11 * 256 * DM * 4 <= (size_t)NMAIN * DM * 4, "PART sits between the bf16 rows and the f32 meta rows of H");
constexpr size_t WS_WSET2 = WS_H + 240 * MiB;
constexpr size_t WSET_BYTES = WS_STAT1 - WS_WIN, WSET_DELTA = WS_WSET2 - WS_WIN;
static_assert(WS_PART + (size_t)11 * 256 * DM * 4 <= WS_WSET2 && WS_WSET2 + WSET_BYTES <= WS_H + (size_t)NMAIN * DM * 4, "second weight set sits between the split-K parts and the f32 meta rows of H");
constexpr size_t WS_HB = WS_H + (size_t)TP * DM * 4;
constexpr size_t WS_R = WS_HB + (size_t)TP * DM * 2;
constexpr size_t WS_UQKVO = WS_R;
constexpr size_t WS_UDQ = WS_UQKVO + (size_t)TP * 4096 * 2;
constexpr size_t WS_UDKV = WS_UDQ + (size_t)TP * 512 * 2;
constexpr size_t WS_GATES = WS_UDKV + (size_t)TP * 256 * 2;
constexpr size_t WS_MKV = WS_GATES + (size_t)TP * 16 * 4;
constexpr size_t WS_KR = WS_MKV + (size_t)TP * NKV * 2;
constexpr size_t WS_RSTD = WS_KR + (size_t)TP * 64 * 2;
constexpr size_t WS_END_A = WS_RSTD + (size_t)TP * 2 * 4;
constexpr size_t WS_ACT = WS_R;
constexpr size_t WS_END_B = WS_ACT + (size_t)TP * DFF * 2;
constexpr size_t WS_NEED = (WS_END_A > WS_END_B ? WS_END_A : WS_END_B);
static_assert(WS_STAT1 + (size_t)TP * 8 <= WS_H && WS_STAT2 + (size_t)TP * 8 <= WS_CTL + CTL_BYTES, "weights and row statistics fit below H");
constexpr size_t DO_HSUM = 0;
constexpr size_t DO_MQ = DO_HSUM + (size_t)TP * MLW * 4;
constexpr size_t DO_GP = 340 * MiB;
constexpr size_t DO_SIDE = 0;
constexpr size_t DO_GVM = 32 * MiB;
static_assert(DO_MQ + (size_t)TP * NQ * 2 <= DO_GP && DO_GP + (size_t)96 * 65 * 200 * 4 <= (size_t)NMAIN * DM * 4 && (size_t)192 * 6 * DFF * 4 <= DO_GVM && DO_GVM + (size_t)256 * NUP * 2 <= (size_t)NMAIN * DM * 4, "d_out scratch fits");
constexpr int CW_BAR = 4096;

constexpr int RING_BYTES = 131072;
constexpr int MISC_OFF = RING_BYTES;
constexpr int LDS_BYTES = 147456;
constexpr int GRID = 256;

__device__ __forceinline__ int pos_of_row(int row) { return row < NMAIN ? NMETA + (row & (LREAL - 1)) : ((row - NMAIN) & (NMETA - 1)); }
__device__ __forceinline__ unsigned pk2(float lo, float hi) { f32x2 v = {lo, hi}; return __builtin_bit_cast(unsigned, __builtin_convertvector(v, bf16x2v)); }
__device__ __forceinline__ float bf_lo(unsigned w) { return __uint_as_float(w << 16); }
__device__ __forceinline__ float bf_hi(unsigned w) { return __uint_as_float(w & 0xffff0000u); }
typedef _Float16 f16x2v __attribute__((ext_vector_type(2)));
__device__ __forceinline__ unsigned pk2h(float lo, float hi) { f32x2 v = {lo, hi}; return __builtin_bit_cast(unsigned, __builtin_convertvector(v, f16x2v)); }
__device__ __forceinline__ float hf_lo(unsigned w) { return (float)__builtin_bit_cast(f16x2v, w)[0]; }
__device__ __forceinline__ float hf_hi(unsigned w) { return (float)__builtin_bit_cast(f16x2v, w)[1]; }
__device__ __forceinline__ float wave_sum(float v) {
#pragma unroll
    for (int o = 1; o < 64; o <<= 1) v += __shfl_xor(v, o);
    return v;
}
__device__ __forceinline__ float wave_max(float v) {
#pragma unroll
    for (int o = 1; o < 64; o <<= 1) v = fmaxf(v, __shfl_xor(v, o));
    return v;
}
namespace pg8 {
#define PG8_LAS __attribute__((address_space(3)))
typedef unsigned short bf16_t;
typedef short bf16x8 __attribute__((ext_vector_type(8)));
typedef float f32x4 __attribute__((ext_vector_type(4)));
typedef unsigned u32x4 __attribute__((ext_vector_type(4)));
constexpr int BM = 256, BK = 64, HALF = 128, HTB = HALF * BK * 2  , STAGE_BYTES = 8 * HTB, NXCD = 8, WGM = 4;

__host__ __device__ __forceinline__ int lds_byte(int r, int c) { const int st = (r >> 4) * 2 + (c >> 5), rr = r & 15, cc = c & 31, ob = rr * 64 + cc * 2; return st * 1024 + (ob ^ (((ob >> 9) & 1) << 5)); }
__host__ __device__ __forceinline__ void stage_rc(int b, int& R, int& C) { const int st = b / 1024, sb = b % 1024, swz = sb ^ (((sb >> 9) & 1) << 5); R = (st >> 1) * 16 + swz / 64; C = (st & 1) * 32 + (swz % 64) / 2; }
__host__ __device__ __forceinline__ int perm32(int rho) { const int n = rho >> 4, i = rho & 15; return 8 * (i >> 2) + 4 * n + (i & 3); }

struct Unit { int pm, pn, kk; };
struct Gemm { const bf16_t* A; const bf16_t* Bt; int M, N, K, ld; };

struct PanelOrder {
    int nM, nN, nwg, G, c, nMain, pm0, pmx;
    __device__ void init(int nMain_, int pm0_, int extra, int pmx_, int N, int G_, int c_) { nMain = nMain_; pm0 = pm0_; pmx = pmx_; nM = nMain_ + extra; nN = N / BM; nwg = nM * nN; G = G_; c = c_; }
    __device__ bool next(int i, Unit& u) const {
        const long L = (long)i * G + c; if (L >= nwg) return false;
        int wgid = (int)L; { const int q = nwg / NXCD, r = nwg % NXCD, xcd = wgid % NXCD, off = wgid / NXCD; wgid = (xcd < r ? xcd * (q + 1) : r * (q + 1) + (xcd - r) * q) + off; }
        const int nig = WGM * nN, gid = wgid / nig, fm = gid * WGM, gsz = (nM - fm) < WGM ? (nM - fm) : WGM;
        const int pl = fm + ((wgid % nig) % gsz); u.pm = pl < nMain ? pm0 + pl : pmx; u.pn = (wgid % nig) / gsz; u.kk = 0; return true;
    }
    __device__ __forceinline__ void a_ready(const Unit&) const {}
    __device__ __forceinline__ void done(const Unit&) const {}
};

struct SplitOrder {
    int pm, nN, nwg, G, c;
    __device__ void init(int pm_, int N, int nsplit, int G_, int c_) { pm = pm_; nN = N / BM; nwg = nN * nsplit; G = G_; c = c_; }
    __device__ bool next(int i, Unit& u) const { const int L = i * G + c; if (L >= nwg) return false; u.pm = pm; u.pn = L % nN; u.kk = L / nN; return true; }
    __device__ __forceinline__ void a_ready(const Unit&) const {}
    __device__ __forceinline__ void done(const Unit&) const {}
};

__device__ __forceinline__ u32x4 pack8(const f32x4 v0, const f32x4 v1) { u32x4 w; w.x = pk2(v0[0], v0[1]); w.y = pk2(v0[2], v0[3]); w.z = pk2(v1[0], v1[1]); w.w = pk2(v1[2], v1[3]); return w; }

struct EpiBf16G {
    static constexpr bool PERM = true, AFTER_DRAIN = false, PERMA = false;
    bf16_t* O; int ldc; const float* rs; int pm_sub, pm_sp, pm_sp_out;
    __device__ __forceinline__ void operator()(const f32x4 (&acc)[2][2][4][2], const Unit& u, int wr, int wc, int fr, int fq) const {
        const int opm = (u.pm == pm_sp) ? pm_sp_out : u.pm - pm_sub;
        const int rin = u.pm * BM + wr * 64 + fr, rout = opm * BM + wr * 64 + fr, col0 = u.pn * BM + wc * 32 + 8 * fq;
#pragma unroll
        for (int ai = 0; ai < 2; ++ai)
#pragma unroll
            for (int m = 0; m < 4; ++m) { const float sc = rs ? rs[(size_t)(rin + ai * HALF + m * 16) * 2] : 1.f;
                bf16_t* rowp = O + (size_t)(rout + ai * HALF + m * 16) * ldc + col0;
#pragma unroll
                for (int bj = 0; bj < 2; ++bj) *(u32x4*)(rowp + bj * HALF) = pack8(acc[ai][bj][m][0] * sc, acc[ai][bj][m][1] * sc); }
    }
};
struct EpiWin {
    static constexpr bool PERM = true, AFTER_DRAIN = false, PERMA = false;
    bf16_t *UQKVO, *UDQ, *UDKV, *KR; float* GATES; const float *COS, *SIN;
    __device__ __forceinline__ void operator()(const f32x4 (&acc)[2][2][4][2], const Unit& u, int wr, int wc, int fr, int fq) const {
        const int row0 = u.pm * BM + wr * 64 + fr;
        if (u.pn < 19) {
            bf16_t* base; int ldc, colt;
            if (u.pn < 16) { base = UQKVO; ldc = 4096; colt = u.pn * BM; } else if (u.pn < 18) { base = UDQ; ldc = 512; colt = (u.pn - 16) * BM; } else { base = UDKV; ldc = 256; colt = 0; }
            const int col0 = colt + wc * 32 + 8 * fq;
#pragma unroll
            for (int ai = 0; ai < 2; ++ai)
#pragma unroll
                for (int m = 0; m < 4; ++m) { bf16_t* rowp = base + (size_t)(row0 + ai * HALF + m * 16) * ldc + col0;
#pragma unroll
                    for (int bj = 0; bj < 2; ++bj) *(u32x4*)(rowp + bj * HALF) = pack8(acc[ai][bj][m][0], acc[ai][bj][m][1]); }
        } else {
            if (wc < 2) { const int g = 4 * wc + fq;
#pragma unroll
                for (int ai = 0; ai < 2; ++ai)
#pragma unroll
                    for (int m = 0; m < 4; ++m) { const int row = row0 + ai * HALF + m * 16, pos = pos_of_row(row);
                        const f32x4 cs = *(const f32x4*)(COS + pos * 32 + 4 * g), sn = *(const f32x4*)(SIN + pos * 32 + 4 * g);
                        const f32x4 x1 = acc[ai][0][m][0], x2 = acc[ai][0][m][1];
                        *(u32x4*)(KR + (size_t)row * 64 + 8 * g) = pack8(x1 * cs - x2 * sn, x1 * sn + x2 * cs); }
            } else if (wc == 2 && fq < 2) {
#pragma unroll
                for (int ai = 0; ai < 2; ++ai)
#pragma unroll
                    for (int m = 0; m < 4; ++m) { float* gp = GATES + (size_t)(row0 + ai * HALF + m * 16) * 16 + 8 * fq;
                        *(f32x4*)gp = acc[ai][0][m][0]; *(f32x4*)(gp + 4) = acc[ai][0][m][1]; }
            }
        }
    }
};
struct EpiQ {
    static constexpr bool PERM = true, AFTER_DRAIN = false, PERMA = false;
    bf16_t* MQ; const float *RSTD, *COS, *SIN;
    __device__ __forceinline__ void operator()(const f32x4 (&acc)[2][2][4][2], const Unit& u, int wr, int wc, int fr, int fq) const {
        const int row0 = u.pm * BM + wr * 64 + fr, colb = u.pn * BM + wc * 32 + 8 * fq;
#pragma unroll
        for (int ai = 0; ai < 2; ++ai)
#pragma unroll
            for (int m = 0; m < 4; ++m) { const int row = row0 + ai * HALF + m * 16, pos = pos_of_row(row); const float sc = RSTD[(size_t)row * 2] * 0.10411754961539605f;
#pragma unroll
                for (int bj = 0; bj < 2; ++bj) { const int col0 = colb + bj * HALF, o = col0 % 192;
                    f32x4 v0 = acc[ai][bj][m][0] * sc, v1 = acc[ai][bj][m][1] * sc;
                    if (o >= 128) { const int g = (o - 128) >> 3; const f32x4 cs = *(const f32x4*)(COS + pos * 32 + 4 * g), sn = *(const f32x4*)(SIN + pos * 32 + 4 * g);
                        const f32x4 x1 = v0, x2 = v1; v0 = x1 * cs - x2 * sn; v1 = x1 * sn + x2 * cs; }
                    *(u32x4*)(MQ + (size_t)row * NQ + col0) = pack8(v0, v1); } }
    }
};
__device__ __forceinline__ void resid_ln_tile(float* __restrict__ Cw, const float* __restrict__ Cr, const float* __restrict__ st, const float* __restrict__ g, const float* __restrict__ b,
                                              int ldc, float alpha, const f32x4 (&acc)[2][2][4][2], int row0, int col0) {
    asm volatile("" ::: "memory");
#pragma unroll
    for (int ai = 0; ai < 2; ++ai)
#pragma unroll
        for (int bj = 0; bj < 2; ++bj) {
            f32x4 gv[2], bv[2], hv[4][2]; f32x2 ms[4];
#pragma unroll
            for (int n = 0; n < 2; ++n) { gv[n] = *(const f32x4*)(g + col0 + bj * HALF + n * 16) * alpha; bv[n] = *(const f32x4*)(b + col0 + bj * HALF + n * 16) * alpha; }
#pragma unroll
            for (int m = 0; m < 4; ++m) { const int row = row0 + ai * HALF + m * 16; ms[m] = *(const f32x2*)(st + (size_t)row * 2);
#pragma unroll
                for (int n = 0; n < 2; ++n) hv[m][n] = *(const f32x4*)(Cr + (size_t)row * ldc + col0 + bj * HALF + n * 16); }
#pragma unroll
            for (int m = 0; m < 4; ++m) { const int row = row0 + ai * HALF + m * 16;
#pragma unroll
                for (int n = 0; n < 2; ++n) *(f32x4*)(Cw + (size_t)row * ldc + col0 + bj * HALF + n * 16) = (hv[m][n] - ms[m][0]) * ms[m][1] * gv[n] + bv[n] + acc[ai][bj][m][n]; }
        }
}
__device__ __forceinline__ void resid_ln_tile_bf(bf16_t* __restrict__ Cw, const bf16_t* __restrict__ Cr, const float* __restrict__ st, const float* __restrict__ g, const float* __restrict__ b,
                                                 int ldc, float alpha, const f32x4 (&acc)[2][2][4][2], int row0, int col0) {
    asm volatile("" ::: "memory");
    f32x4 gv[2][2], bv[2][2];
#pragma unroll
    for (int bj = 0; bj < 2; ++bj)
#pragma unroll
        for (int n = 0; n < 2; ++n) { gv[bj][n] = *(const f32x4*)(g + col0 + bj * HALF + n * 4); bv[bj][n] = *(const f32x4*)(b + col0 + bj * HALF + n * 4); }
#pragma unroll
    for (int ai = 0; ai < 2; ++ai) {
        u32x4 hv[2][4]; f32x2 ms[4];
#pragma unroll
        for (int m = 0; m < 4; ++m) { const int row = row0 + ai * HALF + m * 16; ms[m] = *(const f32x2*)(st + (size_t)row * 2);
#pragma unroll
            for (int bj = 0; bj < 2; ++bj) hv[bj][m] = *(const u32x4*)(Cr + (size_t)row * ldc + col0 + bj * HALF); }
#pragma unroll
        for (int bj = 0; bj < 2; ++bj)
#pragma unroll
            for (int m = 0; m < 4; ++m) { const int row = row0 + ai * HALF + m * 16; const u32x4 h = hv[bj][m]; const float mean = ms[m][0], rstd = ms[m][1];
                const f32x4 h0 = {hf_lo(h.x), hf_hi(h.x), hf_lo(h.y), hf_hi(h.y)}, h1 = {hf_lo(h.z), hf_hi(h.z), hf_lo(h.w), hf_hi(h.w)};
                const f32x4 o0 = ((h0 - mean) * rstd * gv[bj][0] + bv[bj][0]) * alpha + acc[ai][bj][m][0], o1 = ((h1 - mean) * rstd * gv[bj][1] + bv[bj][1]) * alpha + acc[ai][bj][m][1];
                u32x4 w; w.x = pk2h(o0[0], o0[1]); w.y = pk2h(o0[2], o0[3]); w.z = pk2h(o1[0], o1[1]); w.w = pk2h(o1[2], o1[3]);
                *(u32x4*)(Cw + (size_t)row * ldc + col0 + bj * HALF) = w; }
    }
}
struct EpiResidLn {
    static constexpr bool PERM = true, AFTER_DRAIN = false, PERMA = false;
    bf16_t* C; int ldc; float alpha; const float* st; const float* g; const float* b;
    __device__ __forceinline__ void operator()(const f32x4 (&acc)[2][2][4][2], const Unit& u, int wr, int wc, int fr, int fq) const {
        resid_ln_tile_bf(this->C, this->C, this->st, this->g, this->b, this->ldc, this->alpha, acc, u.pm * BM + wr * 64 + fr, u.pn * BM + wc * 32 + 8 * fq);
    }
};
struct EpiPart {
    static constexpr bool PERM = false, AFTER_DRAIN = false, PERMA = false;
    float* P; int ldc;
    __device__ __forceinline__ void operator()(const f32x4 (&acc)[2][2][4][2], const Unit& u, int wr, int wc, int fr, int fq) const {
        const int row0 = u.kk * BM + wr * 64 + fr, col0 = u.pn * BM + wc * 32 + 4 * fq;
#pragma unroll
        for (int ai = 0; ai < 2; ++ai)
#pragma unroll
            for (int m = 0; m < 4; ++m) { float* rowp = P + (size_t)(row0 + ai * HALF + m * 16) * ldc + col0;
#pragma unroll
                for (int bj = 0; bj < 2; ++bj)
#pragma unroll
                    for (int n = 0; n < 2; ++n) *(f32x4*)(rowp + bj * HALF + n * 16) = acc[ai][bj][m][n]; }
    }
};

__device__ __forceinline__ float dpp_shr1_old(float old, float x) { return __int_as_float(__builtin_amdgcn_update_dpp(__float_as_int(old), __float_as_int(x), 0x111, 0xf, 0xf, false)); }
__device__ __forceinline__ float dpp_shl1_old(float old, float x) { return __int_as_float(__builtin_amdgcn_update_dpp(__float_as_int(old), __float_as_int(x), 0x101, 0xf, 0xf, false)); }
struct EpiFfn {
    static constexpr bool PERM = true, AFTER_DRAIN = false, PERMA = true;
    bf16_t* ACT; float* SIDE; bf16_t* GVM; const float *cw, *cb; PG8_LAS float* X;
    __device__ __forceinline__ void operator()(const f32x4 (&acc)[2][2][4][2], const Unit& u, int wr_in, int wc_in, int fr_in, int fq_in) const {
        int fr = fr_in, fq = fq_in, wr = wr_in, wc = wc_in; asm volatile("" : "+v"(fr), "+v"(fq), "+s"(wr), "+s"(wc));
        const int cj = wc * 32 + 8 * fq, c0 = u.pn * 128 + cj;
        if (u.pm == PMETA) {
#pragma unroll
            for (int ai = 0; ai < 2; ++ai)
#pragma unroll
                for (int m = 0; m < 4; ++m) { bf16_t* rowp = GVM + (size_t)(ai * HALF + wr * 64 + 4 * fr + m) * NUP + c0;
                    *(u32x4*)rowp = pack8(acc[ai][0][m][0], acc[ai][0][m][1]); *(u32x4*)(rowp + DFF) = pack8(acc[ai][1][m][0], acc[ai][1][m][1]); }
            return;
        }
        f32x4 w0[2], w1[2], w2[2], bb[2];
#pragma unroll
        for (int n = 0; n < 2; ++n) { w0[n] = *(const f32x4*)(cw + c0 + 4 * n); w1[n] = *(const f32x4*)(cw + DFF + c0 + 4 * n); w2[n] = *(const f32x4*)(cw + 2 * DFF + c0 + 4 * n); bb[n] = *(const f32x4*)(cb + c0 + 4 * n); }
#pragma unroll
        for (int ai = 0; ai < 2; ++ai) { const int b = 2 * ai + wr;
            if (fr == 0) { *(PG8_LAS f32x4*)(X + (b * 2 + 0) * 128 + cj) = acc[ai][0][0][0]; *(PG8_LAS f32x4*)(X + (b * 2 + 0) * 128 + cj + 4) = acc[ai][0][0][1]; }
            if (fr == 15) { *(PG8_LAS f32x4*)(X + (b * 2 + 1) * 128 + cj) = acc[ai][0][3][0]; *(PG8_LAS f32x4*)(X + (b * 2 + 1) * 128 + cj + 4) = acc[ai][0][3][1]; } }
        asm volatile("s_waitcnt lgkmcnt(0)" ::: "memory"); __builtin_amdgcn_s_barrier(); asm volatile("" ::: "memory");
        const unsigned rowb = (unsigned)(u.pm * BM + wr * 64 + 4 * fr) * DFF + c0;
#pragma unroll
        for (int ai = 0; ai < 2; ++ai) { const int b = 2 * ai + wr;
            f32x4 xp[2], xn[2];
#pragma unroll
            for (int n = 0; n < 2; ++n) { xp[n] = b > 0 ? *(const PG8_LAS f32x4*)(X + ((b - 1) * 2 + 1) * 128 + cj + 4 * n) : (f32x4){0.f, 0.f, 0.f, 0.f};
                                          xn[n] = b < 3 ? *(const PG8_LAS f32x4*)(X + ((b + 1) * 2 + 0) * 128 + cj + 4 * n) : (f32x4){0.f, 0.f, 0.f, 0.f}; }
            f32x4 up0[2], dn3[2];
#pragma unroll
            for (int n = 0; n < 2; ++n)
#pragma unroll
                for (int e = 0; e < 4; ++e) { up0[n][e] = dpp_shr1_old(xp[n][e], acc[ai][0][3][n][e]); dn3[n][e] = dpp_shl1_old(xn[n][e], acc[ai][0][0][n][e]); }
#pragma unroll
            for (int m = 0; m < 4; ++m) { u32x4 ow;
#pragma unroll
                for (int n = 0; n < 2; ++n) {
                    const f32x4 g = acc[ai][0][m][n], pv = m > 0 ? acc[ai][0][m > 0 ? m - 1 : 0][n] : up0[n], nx = m < 3 ? acc[ai][0][m < 3 ? m + 1 : 3][n] : dn3[n];
                    const f32x4 x = w0[n] * pv + w1[n] * g + w2[n] * nx + bb[n]; f32x4 t, o;
#pragma unroll
                    for (int e = 0; e < 4; ++e) t[e] = __expf(-x[e]);
                    t = t + 1.f;
#pragma unroll
                    for (int e = 0; e < 4; ++e) t[e] = __builtin_amdgcn_rcpf(t[e]);
                    o = x * t * acc[ai][1][m][n];
                    if (n == 0) { ow.x = pk2(o[0], o[1]); ow.y = pk2(o[2], o[3]); } else { ow.z = pk2(o[0], o[1]); ow.w = pk2(o[2], o[3]); } }
                bf16_t* dst = ACT + (rowb + (unsigned)(ai * HALF + m) * DFF);
                if (ai == 0 ? m < 2 : m >= 2) {
                    const int r = ai * HALF + wr * 64 + 4 * fr + m;
                    if (r != 0 && r != 255) *(u32x4*)dst = ow;
                    const int slot = r == 0 ? 0 : r == 1 ? 1 : r == 254 ? 2 : r == 255 ? 3 : -1;
                    if (slot >= 0) { float* sp = SIDE + ((size_t)u.pm * 6 + slot) * DFF + c0; *(f32x4*)sp = acc[ai][0][m][0]; *(f32x4*)(sp + 4) = acc[ai][0][m][1];
                        if (slot == 0 || slot == 3) { float* vp = SIDE + ((size_t)u.pm * 6 + (slot == 0 ? 4 : 5)) * DFF + c0; *(f32x4*)vp = acc[ai][1][m][0]; *(f32x4*)(vp + 4) = acc[ai][1][m][1]; } }
                } else *(u32x4*)dst = ow;
            }
        }
    }
};
template <class Epi, class Sched, bool ALIGN_EPI = false, bool SP2 = false>
__device__ __forceinline__ void gemm_phase(PG8_LAS unsigned char* lds, const Gemm g, const Sched& S, const Epi& E) {
    int tid_ = threadIdx.x; asm volatile("" : "+v"(tid_));
    const int tid = tid_, wid = __builtin_amdgcn_readfirstlane(tid >> 6), lane = tid & 63, wr = wid >> 2, wc = wid & 3, fr = lane & 15, fq = lane >> 4;
    const int K = g.ld, nt = g.K / BK;
    unsigned voffA[2], voffB[2];
#pragma unroll
    for (int i = 0; i < 2; ++i) { int R, C; stage_rc(tid * 16 + i * 8192, R, C); const int Rb = Epi::PERM ? ((R & ~31) + perm32(R & 31)) : R;
        const int Ra = Epi::PERMA ? ((R & ~63) | ((R & 15) << 2) | ((R >> 4) & 3)) : R;
        voffA[i] = (unsigned)(Ra * K + C) * 2u; voffB[i] = (unsigned)(Rb * K + C) * 2u; }
    const size_t kstep = (size_t)(BK * 2);
    const size_t hstep = (size_t)HALF * K * 2;
    const size_t tstep = 2 * hstep;
    const unsigned ldsw = (unsigned)wid * 1024u;
    const int aoff = lds_byte(wr * 64 + fr, fq * 8), boff = lds_byte(wc * 32 + fr, fq * 8);
#define PG8_SA(b, h) (((b) * 2 + (h)) * HTB)
#define PG8_SB(b, h) ((4 + (b) * 2 + (h)) * HTB)
#define PG8_STAGE(bufoff, gbase, voff) do { _Pragma("unroll") for (int _i = 0; _i < 2; ++_i) \
        __builtin_amdgcn_global_load_lds((const unsigned*)((const char*)(gbase) + (voff)[_i]), (PG8_LAS unsigned*)(lds + (bufoff) + ldsw + _i * 8192), 16, 0, 0); } while (0)
#define PG8_LDA(dst, b, h) do { _Pragma("unroll") for (int m = 0; m < 4; ++m) _Pragma("unroll") for (int k = 0; k < 2; ++k) dst[m][k] = *(const PG8_LAS bf16x8*)(lds + PG8_SA(b, h) + aoff + m * 2048 + k * 1024); } while (0)
#define PG8_LDB(dst, b, h) do { _Pragma("unroll") for (int n = 0; n < 2; ++n) _Pragma("unroll") for (int k = 0; k < 2; ++k) dst[n][k] = *(const PG8_LAS bf16x8*)(lds + PG8_SB(b, h) + boff + n * 2048 + k * 1024); } while (0)
#define PG8_MMA(ai, bj, At, Bt) do { __builtin_amdgcn_s_setprio(1); _Pragma("unroll") for (int m = 0; m < 4; ++m) _Pragma("unroll") for (int n = 0; n < 2; ++n) _Pragma("unroll") for (int k = 0; k < 2; ++k) \
        acc[ai][bj][m][n] = __builtin_amdgcn_mfma_f32_16x16x32_bf16(Bt[n][k], At[m][k], acc[ai][bj][m][n], 0, 0, 0); __builtin_amdgcn_s_setprio(0); } while (0)
#define PG8_WAIT_V(n) asm volatile("s_waitcnt vmcnt(" #n ")" ::: "memory")
#define PG8_WAIT_L(n) asm volatile("s_waitcnt lgkmcnt(" #n ")" ::: "memory")
#define PG8_BAR __builtin_amdgcn_s_barrier()
#define PG8_SCHED __builtin_amdgcn_sched_barrier(0)
    Unit cur, nxt; int ui = 0;
    if (!S.next(0, cur)) return;
    f32x4 acc[2][2][4][2];
#pragma unroll
    for (int a = 0; a < 2; ++a)
#pragma unroll
        for (int b = 0; b < 2; ++b)
#pragma unroll
            for (int m = 0; m < 4; ++m)
#pragma unroll
                for (int n = 0; n < 2; ++n) acc[a][b][m][n] = (f32x4){0.f, 0.f, 0.f, 0.f};
    bf16x8 At[4][2], B0[2][2], B1[2][2];
    const size_t sstep = (size_t)g.K * 2;
    const char* cA = (const char*)g.A + (size_t)cur.pm * tstep + (size_t)cur.kk * sstep; const char* cB = (const char*)g.Bt + (size_t)cur.pn * tstep + (size_t)cur.kk * sstep;
    S.a_ready(cur);
    if constexpr (SP2) {
        PG8_STAGE(PG8_SB(0, 0), cB, voffB); PG8_STAGE(PG8_SB(0, 1), cB + hstep, voffB); PG8_STAGE(PG8_SA(0, 0), cA, voffA); PG8_STAGE(PG8_SA(0, 1), cA + hstep, voffA);
        if (wr == 1) PG8_BAR;
        PG8_WAIT_V(2); PG8_BAR;
        PG8_STAGE(PG8_SB(1, 0), cB + kstep, voffB); PG8_STAGE(PG8_SA(1, 0), cA + kstep, voffA); PG8_STAGE(PG8_SB(1, 1), cB + hstep + kstep, voffB);
        PG8_WAIT_V(6); PG8_BAR;
    } else {
        PG8_STAGE(PG8_SB(0, 0), cB, voffB); PG8_STAGE(PG8_SA(0, 0), cA, voffA); PG8_STAGE(PG8_SB(0, 1), cB + hstep, voffB); PG8_STAGE(PG8_SA(0, 1), cA + hstep, voffA);
        if (wr == 1) PG8_BAR;
        PG8_WAIT_V(4); PG8_BAR;
        PG8_STAGE(PG8_SB(1, 0), cB + kstep, voffB); PG8_STAGE(PG8_SA(1, 0), cA + kstep, voffA); PG8_STAGE(PG8_SB(1, 1), cB + hstep + kstep, voffB);
        PG8_WAIT_V(6); PG8_BAR;
    }
    for (;;) {
        const bool has_next = S.next(ui + 1, nxt);
        const char* nA = has_next ? (const char*)g.A + (size_t)nxt.pm * tstep + (size_t)nxt.kk * sstep : cA; const char* nB = has_next ? (const char*)g.Bt + (size_t)nxt.pn * tstep + (size_t)nxt.kk * sstep : cB;
        for (int t = 0; t < nt; t += 2) {
            const bool last = (t == nt - 2);
            const char* a1 = cA + (size_t)(t + 1) * kstep;
            const char* a2 = last ? nA : cA + (size_t)(t + 2) * kstep; const char* b2 = last ? nB : cB + (size_t)(t + 2) * kstep;
            const char* a3 = a2 + kstep; const char* b3 = b2 + kstep;
            if (last && has_next) S.a_ready(nxt);
            if constexpr (SP2) {
            PG8_LDB(B0, 0, 0); PG8_LDB(B1, 0, 1); PG8_SCHED; PG8_LDA(At, 0, 0); PG8_STAGE(PG8_SA(1, 1), a1 + hstep, voffA);
            PG8_WAIT_V(8); PG8_WAIT_L(0); PG8_BAR; PG8_MMA(0, 0, At, B0); PG8_MMA(0, 1, At, B1); PG8_BAR; PG8_SCHED;
            PG8_LDA(At, 0, 1); PG8_STAGE(PG8_SB(0, 0), b2, voffB); PG8_STAGE(PG8_SB(0, 1), b2 + hstep, voffB); PG8_STAGE(PG8_SA(0, 0), a2, voffA);
            PG8_WAIT_V(8); PG8_WAIT_L(0); PG8_BAR; PG8_MMA(1, 0, At, B0); PG8_MMA(1, 1, At, B1); PG8_BAR; PG8_SCHED;
            PG8_LDB(B0, 1, 0); PG8_LDB(B1, 1, 1); PG8_SCHED; PG8_LDA(At, 1, 0); PG8_STAGE(PG8_SA(0, 1), a2 + hstep, voffA);
            PG8_WAIT_V(8); PG8_WAIT_L(0); PG8_BAR; PG8_MMA(0, 0, At, B0); PG8_MMA(0, 1, At, B1); PG8_BAR; PG8_SCHED;
            PG8_LDA(At, 1, 1); PG8_STAGE(PG8_SB(1, 0), b3, voffB); PG8_STAGE(PG8_SB(1, 1), b3 + hstep, voffB); PG8_STAGE(PG8_SA(1, 0), a3, voffA);
            PG8_WAIT_V(8); PG8_WAIT_L(0); PG8_BAR; PG8_MMA(1, 0, At, B0); PG8_MMA(1, 1, At, B1); PG8_BAR; PG8_SCHED;
            } else {
            PG8_LDB(B0, 0, 0); PG8_SCHED; PG8_LDA(At, 0, 0); PG8_STAGE(PG8_SA(1, 1), a1 + hstep, voffA);
            PG8_WAIT_L(8); PG8_BAR; PG8_WAIT_L(0); PG8_MMA(0, 0, At, B0); PG8_BAR; PG8_SCHED;
            PG8_LDB(B1, 0, 1); PG8_STAGE(PG8_SB(0, 0), b2, voffB);
            PG8_BAR; PG8_WAIT_L(0); PG8_MMA(0, 1, At, B1); PG8_BAR;
            PG8_LDA(At, 0, 1); PG8_STAGE(PG8_SA(0, 0), a2, voffA);
            PG8_BAR; PG8_WAIT_L(0); PG8_MMA(1, 0, At, B0); PG8_BAR; PG8_SCHED;
            PG8_STAGE(PG8_SB(0, 1), b2 + hstep, voffB);
            PG8_WAIT_V(6); PG8_BAR; PG8_MMA(1, 1, At, B1); PG8_BAR;
            PG8_LDB(B0, 1, 0); PG8_SCHED; PG8_LDA(At, 1, 0); PG8_STAGE(PG8_SA(0, 1), a2 + hstep, voffA);
            PG8_WAIT_L(8); PG8_BAR; PG8_WAIT_L(0); PG8_MMA(0, 0, At, B0); PG8_BAR; PG8_SCHED;
            PG8_LDB(B1, 1, 1); PG8_STAGE(PG8_SB(1, 0), b3, voffB);
            PG8_BAR; PG8_WAIT_L(0); PG8_MMA(0, 1, At, B1); PG8_BAR;
            PG8_LDA(At, 1, 1); PG8_STAGE(PG8_SA(1, 0), a3, voffA);
            PG8_BAR; PG8_WAIT_L(0); PG8_MMA(1, 0, At, B0); PG8_BAR; PG8_SCHED;
            PG8_STAGE(PG8_SB(1, 1), b3 + hstep, voffB);
            PG8_WAIT_V(6); PG8_BAR; PG8_MMA(1, 1, At, B1); PG8_BAR;
            }
        }
        if constexpr (ALIGN_EPI) { if (wr == 0) PG8_BAR; }
        if constexpr (!Epi::AFTER_DRAIN) { E(acc, cur, wr, wc, fr, fq); S.done(cur); }
        if (!has_next) break;
#pragma unroll
        for (int a = 0; a < 2; ++a)
#pragma unroll
            for (int b = 0; b < 2; ++b)
#pragma unroll
                for (int m = 0; m < 4; ++m)
#pragma unroll
                    for (int n = 0; n < 2; ++n) acc[a][b][m][n] = (f32x4){0.f, 0.f, 0.f, 0.f};
        cur = nxt; cA = nA; cB = nB; ++ui;
        if constexpr (ALIGN_EPI) { if (wr == 1) PG8_BAR; }
    }
    PG8_WAIT_V(0);
    if constexpr (!ALIGN_EPI) { if (wr == 0) PG8_BAR; }
    PG8_BAR;
    if constexpr (Epi::AFTER_DRAIN) { E.fused(acc, cur, wr, wc, fr, fq, lds, wid, lane); S.done(cur); }
#undef PG8_SA
#undef PG8_SB
#undef PG8_STAGE
#undef PG8_LDA
#undef PG8_LDB
#undef PG8_MMA
#undef PG8_WAIT_V
#undef PG8_WAIT_L
#undef PG8_BAR
#undef PG8_SCHED
}
}
#define XB_TMO      128
#define XB_XCNT(j)  (256  + 64 * (j))
#define XB_XSUB(j)  (1280 + 64 * (j))
#define XB_XGEN(j)  (2304 + 64 * (j))
#define XB_TOP      3328
#define XB_TOPGEN   3392
#define XCD_BAR_WORDS 3456
#define XB_SPIN_CAP (1u << 21)

__device__ __forceinline__ unsigned xb_ld(unsigned* p)              { return __hip_atomic_load(p, __ATOMIC_RELAXED, __HIP_MEMORY_SCOPE_AGENT); }
__device__ __forceinline__ unsigned xb_add(unsigned* p, unsigned v) { return __hip_atomic_fetch_add(p, v, __ATOMIC_RELAXED, __HIP_MEMORY_SCOPE_AGENT); }
__device__ __forceinline__ unsigned xb_xcc_id() { return (unsigned)__builtin_amdgcn_s_getreg((3 << 11) | 20) & 0xFu; }
#define XB_SPIN(cond, bar) do { unsigned _sp = 0; while (cond) { __builtin_amdgcn_s_sleep(1); \
    if ((++_sp & 255u) == 0u) { if (xb_ld(&(bar)[XB_TMO])) break; if (_sp > XB_SPIN_CAP) { atomicAdd(&(bar)[XB_TMO], 1u); break; } } } } while (0)

struct XcdBarrier {
    unsigned* bar; unsigned x;
    volatile LAS unsigned* st;
};

__device__ __forceinline__ XcdBarrier xcd_barrier_post(unsigned* bar, volatile LAS unsigned* st) {
    XcdBarrier b; b.bar = bar; b.x = (unsigned)__builtin_amdgcn_readfirstlane((int)xb_xcc_id()); b.st = st;
    if (threadIdx.x == 0) (void)xb_add(&bar[XB_XCNT(b.x)], 1u);
    return b;
}
__device__ __forceinline__ void xcd_barrier_complete(unsigned* bar, unsigned x, unsigned& nloc, unsigned& nx) {
    const unsigned G = gridDim.x * gridDim.y * gridDim.z;
    unsigned sum, cnt, mine, sp = 0u;
    for (;;) {
        sum = 0u; cnt = 0u; mine = 0u;
#pragma unroll
        for (unsigned j = 0; j < 16; ++j) { const unsigned c = xb_ld(&bar[XB_XCNT(j)]); sum += c; cnt += (c > 0u) ? 1u : 0u; }
        mine = xb_ld(&bar[XB_XCNT(x)]);
        if (sum == G) { mine = xb_ld(&bar[XB_XCNT(x)]); break; }
        __builtin_amdgcn_s_sleep(1);
        if ((++sp & 255u) == 0u) { if (xb_ld(&bar[XB_TMO])) break; if (sp > XB_SPIN_CAP) { atomicAdd(&bar[XB_TMO], 1u); break; } }
    }
    nloc = mine > 0u ? mine : 1u; nx = cnt > 0u ? cnt : 1u;
}

__device__ __forceinline__ void xcd_barrier(const XcdBarrier& b) {
    asm volatile("s_waitcnt vmcnt(0)" ::: "memory");
    __syncthreads();
    if (threadIdx.x == 0) {
        unsigned* bar = b.bar; unsigned bx_ = b.x;
        asm volatile("" : "+s"(bx_));
        __builtin_amdgcn_s_waitcnt(0);
        unsigned nloc = b.st[0], nx = b.st[1];
        if (nloc == 0u) { xcd_barrier_complete(bar, bx_, nloc, nx); b.st[0] = nloc; b.st[1] = nx; }
        const unsigned old = xb_add(&bar[XB_XSUB(bx_)], 1u);
        const unsigned gen = old / nloc;
        if (old + 1u == (gen + 1u) * nloc) {
            __builtin_amdgcn_fence(__ATOMIC_RELEASE, "agent");
            asm volatile("s_waitcnt vmcnt(0)" ::: "memory");
            const unsigned og = xb_add(&bar[XB_TOP], 1u);
            const unsigned tg = og / nx;
            if (og + 1u == (tg + 1u) * nx) xb_add(&bar[XB_TOPGEN], 1u);
            else XB_SPIN(xb_ld(&bar[XB_TOPGEN]) == tg, bar);
            __builtin_amdgcn_fence(__ATOMIC_ACQUIRE, "agent");
            xb_add(&bar[XB_XGEN(bx_)], 1u);
            asm volatile("s_waitcnt vmcnt(0)" ::: "memory");
        } else {
            XB_SPIN(xb_ld(&bar[XB_XGEN(bx_)]) == gen, bar);
            __builtin_amdgcn_fence(__ATOMIC_ACQUIRE, "agent");
            asm volatile("s_waitcnt vmcnt(0)" ::: "memory");
        }
    }
    __syncthreads();
}

typedef unsigned short bf16_t;
typedef short bf16x8 __attribute__((ext_vector_type(8)));
typedef float f32x4 __attribute__((ext_vector_type(4)));
typedef unsigned u32x4 __attribute__((ext_vector_type(4)));
#define LDS_WAIT() asm volatile("s_waitcnt lgkmcnt(0)" ::: "memory")

struct Params {
    const float* in[19];
};
struct Frame {
    LAS unsigned char* lds;
    int tid, lane, wave, G, bx, vcu, gw, ngw;
};
__device__ __forceinline__ const float* uptr(const LAS unsigned long long* t, int k) {
    const unsigned long long v = t[k]; const unsigned lo = __builtin_amdgcn_readfirstlane((unsigned)v), hi = __builtin_amdgcn_readfirstlane((unsigned)(v >> 32));
    return (const float*)(const GAS float*)(((unsigned long long)hi << 32) | lo); }

template <class CMap>
__device__ __forceinline__ void transpose_load(float (&v)[32], const float* W, int Nsrc, const float* ks, int kb, int nb, int lane, CMap cmap) {
    const int k0 = 64 * kb, n0 = 32 * nb; const int sc = cmap(n0 + (lane & 31));
#pragma unroll
    for (int i = 0; i < 32; ++i) { const int kk = 2 * i + (lane >> 5); float x = 0.f; if (sc >= 0) x = W[(size_t)(k0 + kk) * Nsrc + sc]; if (ks) x *= ks[k0 + kk]; v[i] = x; }
}
__device__ __forceinline__ void transpose_store(const float (&v)[32], int K, bf16_t* WT, LAS float* scr, int kb, int nb, int lane) {
    const int k0 = 64 * kb, n0 = 32 * nb;
#pragma unroll
    for (int i = 0; i < 32; ++i) scr[(2 * i + (lane >> 5)) * 33 + (lane & 31)] = v[i];
    LDS_WAIT(); asm volatile("" ::: "memory");
    const int c = lane & 7;
#pragma unroll
    for (int j = 0; j < 4; ++j) { const int n = (lane >> 3) + 8 * j; const LAS float* s = scr + (8 * c) * 33 + n;
        u32x4 o; o.x = pk2(s[0 * 33], s[1 * 33]); o.y = pk2(s[2 * 33], s[3 * 33]); o.z = pk2(s[4 * 33], s[5 * 33]); o.w = pk2(s[6 * 33], s[7 * 33]);
        *(u32x4*)(WT + (size_t)(n0 + n) * K + k0 + 8 * c) = o; }
    LDS_WAIT(); asm volatile("" ::: "memory");
}
template <class CMap>
__device__ __forceinline__ void transpose_matrix(const Frame& F, const float* W, int K, int Nsrc, int Ndst, bf16_t* WT, const float* ks, LAS float* scr, CMap cmap) {
    const int nnb = Ndst / 32, items = (K / 64) * nnb;
    for (int it = F.gw; it < items; it += 2 * F.ngw) { const int it2 = it + F.ngw; float va[32], vb[32];
        transpose_load(va, W, Nsrc, ks, it / nnb, it % nnb, F.lane, cmap);
        if (it2 < items) transpose_load(vb, W, Nsrc, ks, it2 / nnb, it2 % nnb, F.lane, cmap);
        transpose_store(va, K, WT, scr, it / nnb, it % nnb, F.lane);
        if (it2 < items) transpose_store(vb, K, WT, scr, it2 / nnb, it2 % nnb, F.lane); }
}
__device__ __forceinline__ int rope_perm(int m) { const int g = m >> 3, j = m & 7; return j < 4 ? 4 * g + j : 32 + 4 * g + (j - 4); }
struct CMapIn { __device__ int operator()(int n) const {
    if (n < 4096) return n; if (n < 4608) return 4112 + (n - 4096); if (n < 4864) return 4624 + (n - 4608);
    if (n < 4928) return 4880 + rope_perm(n - 4864); if (n < 4944) return 4096 + (n - 4928); return -1; } };
struct CMapQ { __device__ int operator()(int n) const { const int h = n / 192, o = n % 192; return o < 128 ? n : h * 192 + 128 + rope_perm(o - 128); } };
struct CMapUp { __device__ int operator()(int n) const { const int pn = n >> 8, j = n & 255; return j < 128 ? 128 * pn + j : DFF + 128 * pn + (j - 128); } };
struct CMapId { __device__ int operator()(int n) const { return n; } };

__device__ __forceinline__ void convert_weights(const Frame& F, unsigned char* ws_, const LAS unsigned long long* pt, int l, size_t wo, int slot) {
    unsigned char* ws = ws_ + wo;
    LAS float* scr = (LAS float*)(F.lds + F.wave * 8448);
    if (slot != 1) {
        const float* w_in = uptr(pt, 3) + (size_t)l * DM * INC; const float* w_uq = uptr(pt, 8) + (size_t)l * 512 * NQ; const float* w_ukv = uptr(pt, 9) + (size_t)l * 256 * NKV;
        const float* w_out = uptr(pt, 10) + (size_t)l * DM * DM; const float* w_dn = uptr(pt, 16) + (size_t)l * DFF * DM;
        const float* qg = uptr(pt, 6) + (size_t)l * 512; const float* kvg = uptr(pt, 7) + (size_t)l * 256;
        transpose_matrix(F, w_in, DM, INC, NIN, (bf16_t*)(ws + WS_WIN), nullptr, scr, CMapIn());
        transpose_matrix(F, w_uq, 512, NQ, NQ, (bf16_t*)(ws + WS_WUQ), qg, scr, CMapQ());
        transpose_matrix(F, w_ukv, 256, NKV, NKV, (bf16_t*)(ws + WS_WUKV), kvg, scr, CMapId());
        transpose_matrix(F, w_out, DM, DM, DM, (bf16_t*)(ws + WS_WOUT), nullptr, scr, CMapId());
        transpose_matrix(F, w_dn, DFF, DM, DM, (bf16_t*)(ws + WS_WDN), nullptr, scr, CMapId());
    }
    if (slot != 0) { const float* w_up = uptr(pt, 13) + (size_t)l * DM * NUP;
        transpose_matrix(F, w_up, DM, NUP, NUP, (bf16_t*)(ws + WS_WUP), nullptr, scr, CMapUp()); }
}
__device__ __forceinline__ void prologue(const Frame& F, unsigned char* ws, const LAS unsigned long long* pt) {
    float* COS = (float*)(ws + WS_COS); float* SIN = (float*)(ws + WS_SIN);
    for (int i = F.bx * 512 + F.tid; i < 4112 * 32; i += F.G * 512) { const int pos = i >> 5, f = i & 31;
        const float inv = powf(10000.0f, -(float)(2 * f) / 64.0f); const float ang = (float)pos * inv; float s, c; sincosf(ang, &s, &c); COS[i] = c; SIN[i] = s; }
    { float* PAR = (float*)(ws + WS_PAR); const int gt = F.bx * 512 + F.tid, nt = F.G * 512;
      for (int i = gt; i < DEPTH * 16; i += nt) PAR[PO_BG + i] = uptr(pt, 4)[i];
      for (int i = gt; i < DEPTH * 1024; i += nt) PAR[PO_MLG + i] = uptr(pt, 5)[i];
      for (int i = gt; i < DEPTH * 512; i += nt) PAR[PO_QG + i] = uptr(pt, 6)[i];
      for (int i = gt; i < DEPTH * 256; i += nt) PAR[PO_KVG + i] = uptr(pt, 7)[i];
      for (int i = gt; i < 2048; i += nt) { PAR[PO_ONE + i] = 1.f; PAR[PO_ZERO + i] = 0.f; }
      { float* ST2 = (float*)(ws + WS_STAT2); for (int i = gt; i < TP; i += nt) { ST2[2 * i] = 0.f; ST2[2 * i + 1] = 1.f; } }
      for (int i = gt; i < DEPTH * 2048; i += nt) { PAR[PO_L1G + i] = uptr(pt, 11)[i]; PAR[PO_L1B + i] = uptr(pt, 12)[i]; PAR[PO_L2G + i] = uptr(pt, 17)[i]; PAR[PO_L2B + i] = uptr(pt, 18)[i]; }
      for (int i = gt; i < DEPTH * 3 * 5632; i += nt) PAR[PO_CW + i] = uptr(pt, 14)[i];
      for (int i = gt; i < DEPTH * 5632; i += nt) PAR[PO_CB + i] = uptr(pt, 15)[i]; }
    float* H = (float*)(ws + WS_H); bf16_t* HB = (bf16_t*)(ws + WS_HB);
    const float* xp = uptr(pt, 0); const float* xs = uptr(pt, 1); const float* mt = uptr(pt, 2);
    for (int row0 = F.gw; row0 < TP; row0 += 2 * F.ngw) {
        f32x4 v[2][8];
#pragma unroll
        for (int r = 0; r < 2; ++r) { const int row = row0 + r * F.ngw; const float* src = nullptr;
            if (row < 4 * LREAL) src = xp + (size_t)row * DM; else if (row < NMAIN) src = xs + (size_t)(row - 4 * LREAL) * DM; else if (row < NTOK) src = mt + (size_t)((row - NMAIN) & 15) * DM;
#pragma unroll
            for (int j = 0; j < 8; ++j) { v[r][j] = (f32x4){0.f, 0.f, 0.f, 0.f}; if (src) v[r][j] = ((const f32x4*)src)[F.lane + 64 * j]; } }
#pragma unroll
        for (int r = 0; r < 2; ++r) { const int row = row0 + r * F.ngw; if (row < TP) {
            f32x4* hd = (f32x4*)(H + (size_t)row * DM) + F.lane; u32x2* bd = (u32x2*)(HB + (size_t)row * DM) + F.lane; u32x2* hb = (u32x2*)((bf16_t*)H + (size_t)row * DM) + F.lane;
#pragma unroll
            for (int j = 0; j < 8; ++j) { const f32x4 x = v[r][j];
                u32x2 w; w.x = pk2(x[0], x[1]); w.y = pk2(x[2], x[3]); bd[64 * j] = w;
                if (row >= NMAIN) hd[64 * j] = x * ALPHA;
                else { u32x2 wh; wh.x = pk2h(x[0], x[1]); wh.y = pk2h(x[2], x[3]); hb[64 * j] = wh; } } } }
    }
}

__device__ __forceinline__ void ln_one(const f32x4 (&vin)[8], int row, int lane, float* __restrict__ Hw, bf16_t* __restrict__ HB, const float* __restrict__ g, const float* __restrict__ b, float* __restrict__ ST) {
    f32x4 v[8]; float s = 0.f;
#pragma unroll
    for (int j = 0; j < 8; ++j) { v[j] = vin[j]; s += (v[j][0] + v[j][1]) + (v[j][2] + v[j][3]); }
    const float mean = wave_sum(s) * (1.f / DM); float q = 0.f;
#pragma unroll
    for (int j = 0; j < 8; ++j) { v[j] = v[j] - mean; q += (v[j][0] * v[j][0] + v[j][1] * v[j][1]) + (v[j][2] * v[j][2] + v[j][3] * v[j][3]); }
    const float rstd = rsqrtf(wave_sum(q) * (1.f / DM) + EPS);
    if (lane == 0) { f32x2 ms = {mean, rstd}; *(f32x2*)(ST + (size_t)row * 2) = ms; }
    u32x2* bd = (u32x2*)(HB + (size_t)row * DM) + lane; f32x4* hp = (f32x4*)(Hw + (size_t)row * DM) + lane;
#pragma unroll
    for (int j = 0; j < 8; ++j) { const f32x4 gg = ((const f32x4*)g)[lane + 64 * j], bb = ((const f32x4*)b)[lane + 64 * j]; const f32x4 y = v[j] * rstd * gg + bb;
        u32x2 w; w.x = pk2(y[0], y[1]); w.y = pk2(y[2], y[3]); bd[64 * j] = w;
        hp[64 * j] = y * ALPHA; }
}
__device__ __forceinline__ void ln_one_bf(const u32x4 (&vin)[4], int row, int lane, bf16_t* __restrict__ HB, const float* __restrict__ g, const float* __restrict__ b, float* __restrict__ ST, float* __restrict__ out) {
    f32x4 v[8]; float s = 0.f;
#pragma unroll
    for (int j = 0; j < 4; ++j) { v[2 * j] = (f32x4){hf_lo(vin[j].x), hf_hi(vin[j].x), hf_lo(vin[j].y), hf_hi(vin[j].y)}; v[2 * j + 1] = (f32x4){hf_lo(vin[j].z), hf_hi(vin[j].z), hf_lo(vin[j].w), hf_hi(vin[j].w)}; }
#pragma unroll
    for (int j = 0; j < 8; ++j) s += (v[j][0] + v[j][1]) + (v[j][2] + v[j][3]);
    const float mean = wave_sum(s) * (1.f / DM); float q = 0.f;
#pragma unroll
    for (int j = 0; j < 8; ++j) { v[j] = v[j] - mean; q += (v[j][0] * v[j][0] + v[j][1] * v[j][1]) + (v[j][2] * v[j][2] + v[j][3] * v[j][3]); }
    const float rstd = rsqrtf(wave_sum(q) * (1.f / DM) + EPS);
    if (lane == 0) { f32x2 ms = {mean, rstd}; *(f32x2*)(ST + (size_t)row * 2) = ms; }
    u32x4* bd = (u32x4*)(HB + (size_t)row * DM) + lane;
#pragma unroll
    for (int j = 0; j < 4; ++j) { const int c4 = 2 * (lane + 64 * j);
        const f32x4 y0 = v[2 * j] * rstd * ((const f32x4*)g)[c4] + ((const f32x4*)b)[c4], y1 = v[2 * j + 1] * rstd * ((const f32x4*)g)[c4 + 1] + ((const f32x4*)b)[c4 + 1];
        if (out) { f32x4* op = (f32x4*)(out + (size_t)row * DM) + c4; op[0] = y0; op[1] = y1; }
        else bd[64 * j] = pg8::pack8(y0, y1); }
}
__device__ __forceinline__ void ln_rows(const Frame& F, float* H, bf16_t* HB, const float* g, const float* b, float* ST, float* out, const float* PART, int nk) {
    const bf16_t* __restrict__ Hr = (const bf16_t*)H;
    for (int row = F.gw; row < NMAIN; row += 4 * F.ngw) {
        const int row2 = row + F.ngw, row3 = row + 2 * F.ngw, row4 = row + 3 * F.ngw;
        u32x4 va[4], vb[4], vc[4], vd[4];
#pragma unroll
        for (int j = 0; j < 4; ++j) va[j] = ((const u32x4*)(Hr + (size_t)row * DM))[F.lane + 64 * j];
#pragma unroll
        for (int j = 0; j < 4; ++j) vb[j] = ((const u32x4*)(Hr + (size_t)row2 * DM))[F.lane + 64 * j];
#pragma unroll
        for (int j = 0; j < 4; ++j) vc[j] = ((const u32x4*)(Hr + (size_t)row3 * DM))[F.lane + 64 * j];
#pragma unroll
        for (int j = 0; j < 4; ++j) vd[j] = ((const u32x4*)(Hr + (size_t)row4 * DM))[F.lane + 64 * j];
        ln_one_bf(va, row, F.lane, HB, g, b, ST, out);
        ln_one_bf(vb, row2, F.lane, HB, g, b, ST, out);
        ln_one_bf(vc, row3, F.lane, HB, g, b, ST, out);
        ln_one_bf(vd, row4, F.lane, HB, g, b, ST, out);
    }
    if (F.gw < TP - NMAIN) {
        const int row = NMAIN + F.gw; const float* __restrict__ Hm = H; f32x4 va[8];
#pragma unroll
        for (int j = 0; j < 8; ++j) va[j] = ((const f32x4*)(Hm + (size_t)row * DM))[F.lane + 64 * j];
        const float* __restrict__ pp0 = PART + (size_t)F.gw * DM;
        int k = 0;
        for (; k + 4 <= nk; k += 4) {
            f32x4 t[4][8];
#pragma unroll
            for (int q = 0; q < 4; ++q)
#pragma unroll
                for (int j = 0; j < 8; ++j) t[q][j] = ((const f32x4*)(pp0 + (size_t)(k + q) * 256 * DM))[F.lane + 64 * j];
#pragma unroll
            for (int q = 0; q < 4; ++q)
#pragma unroll
                for (int j = 0; j < 8; ++j) va[j] += t[q][j]; }
        for (; k < nk; ++k) {
#pragma unroll
            for (int j = 0; j < 8; ++j) va[j] += ((const f32x4*)(pp0 + (size_t)k * 256 * DM))[F.lane + 64 * j]; }
        ln_one(va, row, F.lane, H, HB, g, b, ST);
    }
}

__device__ __forceinline__ void rstd_rows(const Frame& F, const bf16_t* UDQ, const bf16_t* UDKV, float* RSTD) {
    for (int row = F.gw; row < TP; row += F.ngw) {
        const u32x4 a = ((const u32x4*)(UDQ + (size_t)row * 512))[F.lane]; float s = 0.f;
#pragma unroll
        for (int j = 0; j < 4; ++j) { const float x = bf_lo(a[j]), y = bf_hi(a[j]); s += x * x + y * y; }
        float t = 0.f;
        if (F.lane < 32) { const u32x4 c = ((const u32x4*)(UDKV + (size_t)row * 256))[F.lane];
#pragma unroll
            for (int j = 0; j < 4; ++j) { const float x = bf_lo(c[j]), y = bf_hi(c[j]); t += x * x + y * y; } }
        s = wave_sum(s); t = wave_sum(t);
        if (F.lane == 0) { RSTD[(size_t)row * 2] = rsqrtf(s * (1.f / 512.f) + EPS); RSTD[(size_t)row * 2 + 1] = rsqrtf(t * (1.f / 256.f) + EPS); }
    }
}

__device__ __forceinline__ void mlstm_fin_row(int row, int lane, const f32x4 (&hv)[4], const u32x2 (&ov)[4], const float* __restrict__ ng, bf16_t* __restrict__ MIX) {
#pragma unroll
    for (int j = 0; j < 4; ++j) {
        f32x4 v = hv[j];
        const float mean = wave_sum((v[0] + v[1]) + (v[2] + v[3])) * (1.f / 256.f); v = v - mean;
        const float rstd = rsqrtf(wave_sum((v[0] * v[0] + v[1] * v[1]) + (v[2] * v[2] + v[3] * v[3])) * (1.f / 256.f) + EPS);
        const f32x4 gg = ((const f32x4*)(ng + 256 * j))[lane];
        const u32x2 uo = ov[j];
        const float o0 = bf_lo(uo.x), o1 = bf_hi(uo.x), o2 = bf_lo(uo.y), o3 = bf_hi(uo.y);
        const float y0 = v[0] * rstd * gg[0] / (1.f + __expf(-o0)), y1 = v[1] * rstd * gg[1] / (1.f + __expf(-o1));
        const float y2 = v[2] * rstd * gg[2] / (1.f + __expf(-o2)), y3 = v[3] * rstd * gg[3] / (1.f + __expf(-o3));
        u32x2 w; w.x = pk2(y0, y1); w.y = pk2(y2, y3); ((u32x2*)(MIX + (size_t)row * DM + 256 * j))[lane] = w;
    }
}
__device__ __forceinline__ void mlstm_finalize(const Frame& F, int gw0, int ngw0, const float* HSUM, const bf16_t* UQKVO, const float* ng, bf16_t* MIX) {
    const float* __restrict__ Hs = HSUM; const bf16_t* __restrict__ Uo = UQKVO;
    for (int row = gw0; row < TP; row += 4 * ngw0) {
        int rr[4]; bool ok[4];
#pragma unroll
        for (int q = 0; q < 4; ++q) { const int r = row + q * ngw0; ok[q] = r < TP; rr[q] = ok[q] ? r : row; }
        f32x4 hv[4][4]; u32x2 ov[4][4];
#pragma unroll
        for (int q = 0; q < 4; ++q)
#pragma unroll
            for (int j = 0; j < 4; ++j) { hv[q][j] = ((const f32x4*)(Hs + (size_t)rr[q] * MLW + 256 * j))[F.lane]; ov[q][j] = ((const u32x2*)(Uo + (size_t)rr[q] * 4096 + 3072 + 256 * j))[F.lane]; }
#pragma unroll
        for (int q = 0; q < 4; ++q) if (ok[q]) mlstm_fin_row(rr[q], F.lane, hv[q], ov[q], ng, MIX);
    }
}

__device__ __forceinline__ f32x8 ld8f(const float* p) { const f32x4 a = *(const f32x4*)p, b = *(const f32x4*)(p + 4); return (f32x8){a[0], a[1], a[2], a[3], b[0], b[1], b[2], b[3]}; }
__device__ __forceinline__ f32x8 ld8b(const bf16_t* p) { const u32x4 v = *(const u32x4*)p; return (f32x8){bf_lo(v[0]), bf_hi(v[0]), bf_lo(v[1]), bf_hi(v[1]), bf_lo(v[2]), bf_hi(v[2]), bf_lo(v[3]), bf_hi(v[3])}; }
__device__ __forceinline__ void act_store(bf16_t* dst, const f32x8 gp, const f32x8 gc, const f32x8 gn, const f32x8 vv, const f32x8 w0, const f32x8 w1, const f32x8 w2, const f32x8 bb) {
    float o[8];
#pragma unroll
    for (int i = 0; i < 8; ++i) { const float x = w0[i] * gp[i] + w1[i] * gc[i] + w2[i] * gn[i] + bb[i]; o[i] = x / (1.f + __expf(-x)) * vv[i]; }
    u32x4 w; w.x = pk2(o[0], o[1]); w.y = pk2(o[2], o[3]); w.z = pk2(o[4], o[5]); w.w = pk2(o[6], o[7]); *(u32x4*)dst = w;
}
__device__ __forceinline__ void ffn_fixup(const Frame& F, const float* SIDE, const bf16_t* GVM, bf16_t* ACT, const float* cw, const float* cb) {
    constexpr int NCH = DFF / 8;
    const f32x8 zero = {0.f, 0.f, 0.f, 0.f, 0.f, 0.f, 0.f, 0.f};
    const int gt = F.bx * 512 + F.tid, nt = GRID * 512;
    for (int idx = gt; idx < 192 * 2 * NCH; idx += nt) {
        const int ch = idx % NCH, rsel = (idx / NCH) & 1, pm = idx / (2 * NCH), c0 = 8 * ch, sq = pm >> 4;
        const f32x8 w0 = ld8f(cw + c0), w1 = ld8f(cw + DFF + c0), w2 = ld8f(cw + 2 * DFF + c0), bb = ld8f(cb + c0);
        const float* S0 = SIDE + (size_t)pm * 6 * DFF + c0;
        if (rsel == 0) { const f32x8 gp = (pm & 15) ? ld8f(S0 - 6 * DFF + 3 * DFF) : ld8b(GVM + (size_t)(16 * sq + 15) * NUP + c0);
            act_store(ACT + (size_t)(pm * 256) * DFF + c0, gp, ld8f(S0), ld8f(S0 + DFF), ld8f(S0 + 4 * DFF), w0, w1, w2, bb);
        } else { const f32x8 gn = ((pm & 15) != 15) ? ld8f(S0 + 6 * DFF) : zero;
            act_store(ACT + (size_t)(pm * 256 + 255) * DFF + c0, ld8f(S0 + 2 * DFF), ld8f(S0 + 3 * DFF), gn, ld8f(S0 + 5 * DFF), w0, w1, w2, bb); }
    }
    for (int idx = gt; idx < NSEQ * 16 * NCH; idx += nt) {
        const int ch = idx % NCH, rp = idx / NCH, pp = rp & 15, sq = rp >> 4, c0 = 8 * ch;
        const f32x8 w0 = ld8f(cw + c0), w1 = ld8f(cw + DFF + c0), w2 = ld8f(cw + 2 * DFF + c0), bb = ld8f(cb + c0);
        const bf16_t* G0 = GVM + (size_t)(16 * sq + pp) * NUP + c0;
        const f32x8 gp = pp > 0 ? ld8b(G0 - NUP) : zero, gc = ld8b(G0);
        const f32x8 gn = pp < 15 ? ld8b(G0 + NUP) : ld8f(SIDE + (size_t)(16 * sq) * 6 * DFF + c0);
        act_store(ACT + (size_t)(MROW0 + 16 * sq + pp) * DFF + c0, gp, gc, gn, ld8b(G0 + DFF), w0, w1, w2, bb);
    }
}

namespace att {
constexpr int NW = 8, QBLK = 32, KVBLK = 64, NT = 65;
constexpr int KROW = 400;
constexpr int SHM_V = KVBLK * 128 * 2, SHM_K = KVBLK * KROW;
constexpr int OFF_V = 0, OFF_K = 3 * SHM_V, OFF_WS = OFF_K + 3 * SHM_K, LDS_TOTAL = OFF_WS + NW * 64 * 4;
static_assert(LDS_TOTAL <= RING_BYTES, "attention LDS");
constexpr float SCALE = 0.07216878364870323f;
constexpr float THR = 8.f;
constexpr float QSCALE = SCALE * 1.4426950408889634f;
constexpr float THRL = THR * 1.4426950408889634f;
#define SBAR() __builtin_amdgcn_sched_barrier(0)
__device__ __forceinline__ int crow(int r, int hi) { return (r & 3) + 8 * (r >> 2) + 4 * hi; }
__device__ __forceinline__ unsigned cvtpk(float lo, float hi) { unsigned r; asm volatile("v_cvt_pk_bf16_f32 %0, %1, %2" : "=v"(r) : "v"(lo), "v"(hi)); return r; }

template <bool MASK16, bool FIRST>
__device__ __forceinline__ void partialSM(f32x16& p0, f32x16& p1, float& m_reg, float& alpha) {
    if (MASK16) {
#pragma unroll
        for (int r = 8; r < 16; ++r) p0[r] = NEGBIG;
#pragma unroll
        for (int r = 0; r < 16; ++r) p1[r] = NEGBIG;
    }
    float pmax = p0[0];
#pragma unroll
    for (int r = 1; r < 16; ++r) pmax = fmaxf(pmax, p0[r]);
#pragma unroll
    for (int r = 0; r < 16; ++r) pmax = fmaxf(pmax, p1[r]);
    { auto rr = __builtin_amdgcn_permlane32_swap(__float_as_uint(pmax), __float_as_uint(pmax), false, false); pmax = fmaxf(__uint_as_float(rr[0]), __uint_as_float(rr[1])); }
    if (!FIRST && __builtin_expect(__all(pmax <= THRL), 1)) { alpha = 1.f; }
    else { const float d = FIRST ? pmax : fmaxf(pmax, 0.f); alpha = FIRST ? 1.f : __builtin_amdgcn_exp2f(-d); m_reg += d;
#pragma unroll
        for (int r = 0; r < 16; ++r) { p0[r] -= d; p1[r] -= d; } }
#pragma unroll
    for (int r = 0; r < 16; ++r) p0[r] = __builtin_amdgcn_exp2f(p0[r]);
}
__device__ __forceinline__ void finishSM(f32x16& p0, f32x16& p1, float alpha, float& l_reg, bf16x8& pa0, bf16x8& pa1, bf16x8& pa2, bf16x8& pa3) {
#pragma unroll
    for (int r = 0; r < 16; ++r) p1[r] = __builtin_amdgcn_exp2f(p1[r]);
    float ps = 0;
#pragma unroll
    for (int r = 0; r < 16; ++r) ps += p0[r];
#pragma unroll
    for (int r = 0; r < 16; ++r) ps += p1[r];
    { auto rr = __builtin_amdgcn_permlane32_swap(__float_as_uint(ps), __float_as_uint(ps), false, false); ps = __uint_as_float(rr[0]) + __uint_as_float(rr[1]); }
    l_reg = l_reg * alpha + ps;
#define PK4(P, BASE, OUT) do { unsigned a0 = cvtpk(P[BASE + 0], P[BASE + 1]), a1 = cvtpk(P[BASE + 2], P[BASE + 3]);   \
    unsigned b0 = cvtpk(P[BASE + 4], P[BASE + 5]), b1 = cvtpk(P[BASE + 6], P[BASE + 7]);                              \
    auto r0 = __builtin_amdgcn_permlane32_swap(a0, b0, false, false); auto r1 = __builtin_amdgcn_permlane32_swap(a1, b1, false, false); \
    u32x4 w = {r0[0], r1[0], r0[1], r1[1]}; OUT = __builtin_bit_cast(bf16x8, w); } while (0)
    PK4(p0, 0, pa0); PK4(p0, 8, pa1); PK4(p1, 0, pa2); PK4(p1, 8, pa3);
#undef PK4
}
__device__ __forceinline__ void qkt(f32x16& p0, f32x16& p1, const LAS char* Ks, const bf16x8* qr, int r32, int hi, float init) {
#pragma unroll
    for (int r = 0; r < 16; ++r) { p0[r] = init; p1[r] = init; }
#pragma unroll
    for (int d0 = 0; d0 < 12; ++d0) { const int cb = (d0 * 16 + hi * 8) * 2;
        const bf16x8 b0 = *(const LAS bf16x8*)(Ks + r32 * KROW + cb);
        const bf16x8 b1 = *(const LAS bf16x8*)(Ks + (32 + r32) * KROW + cb);
        p0 = __builtin_amdgcn_mfma_f32_32x32x16_bf16(b0, qr[d0], p0, 0, 0, 0);
        p1 = __builtin_amdgcn_mfma_f32_32x32x16_bf16(b1, qr[d0], p1, 0, 0, 0); }
}
__device__ __forceinline__ int v_st(int k, int c) { const int kk = (k & ~0xC) | ((k & 4) << 1) | ((k & 8) >> 1); return ((kk >> 3) * 4 + (c >> 5)) * 512 + ((kk & 7) * 32 + (c & 31)) * 2; }
__device__ __forceinline__ int v_rd_base(int lane) { return ((lane & 3) << 3) | (((lane >> 2) & 3) << 6) | (((lane >> 4) & 1) << 5) | (((lane >> 5) & 1) << 8); }
constexpr int v_rd_off(int d0, int ks, int half) { return d0 * 512 + ks * 4096 + half * 2048; }
template <int OFF> __device__ __forceinline__ s16x4 tr_read(int vb) { s16x4 r; asm volatile("ds_read_b64_tr_b16 %0, %1 offset:%2" : "=&v"(r) : "v"(vb), "i"(OFF) : "memory"); return r; }
template <int D0> __device__ __forceinline__ void pv_one(f32x16& od, int vb, bf16x8 pa0, bf16x8 pa1, bf16x8 pa2, bf16x8 pa3) {
    const s16x4 l0 = tr_read<v_rd_off(D0, 0, 0)>(vb), h0 = tr_read<v_rd_off(D0, 0, 1)>(vb), l1 = tr_read<v_rd_off(D0, 1, 0)>(vb), h1 = tr_read<v_rd_off(D0, 1, 1)>(vb);
    const s16x4 l2 = tr_read<v_rd_off(D0, 2, 0)>(vb), h2 = tr_read<v_rd_off(D0, 2, 1)>(vb), l3 = tr_read<v_rd_off(D0, 3, 0)>(vb), h3 = tr_read<v_rd_off(D0, 3, 1)>(vb);
    asm volatile("s_waitcnt lgkmcnt(0)" ::: "memory"); SBAR();
#define PKV(L, H) (bf16x8){L[0], L[1], L[2], L[3], H[0], H[1], H[2], H[3]}
    od = __builtin_amdgcn_mfma_f32_32x32x16_bf16(pa0, PKV(l0, h0), od, 0, 0, 0);
    od = __builtin_amdgcn_mfma_f32_32x32x16_bf16(pa1, PKV(l1, h1), od, 0, 0, 0);
    od = __builtin_amdgcn_mfma_f32_32x32x16_bf16(pa2, PKV(l2, h2), od, 0, 0, 0);
    od = __builtin_amdgcn_mfma_f32_32x32x16_bf16(pa3, PKV(l3, h3), od, 0, 0, 0);
#undef PKV
}
__device__ __forceinline__ void pv_d0(f32x16* o, int vb, bf16x8 pa0, bf16x8 pa1, bf16x8 pa2, bf16x8 pa3) {
    pv_one<0>(o[0], vb, pa0, pa1, pa2, pa3); pv_one<1>(o[1], vb, pa0, pa1, pa2, pa3); pv_one<2>(o[2], vb, pa0, pa1, pa2, pa3); pv_one<3>(o[3], vb, pa0, pa1, pa2, pa3);
}

__device__ __forceinline__ void attn_unit(int s, int h, int qb, const bf16_t* __restrict__ MQ, const bf16_t* __restrict__ MKV, const bf16_t* __restrict__ KR, bf16_t* __restrict__ MIX, LAS char* lds) {
    int tid_ = threadIdx.x; asm volatile("" : "+v"(tid_));
    const int tid = tid_, wid = tid >> 6, lane = tid & 63, r32 = lane & 31, hi = lane >> 5;
    LAS char* V_lds = lds + OFF_V; LAS char* K_lds = lds + OFF_K;
    LAS float* wsf = (LAS float*)(lds + OFF_WS) + wid * 64; LAS float* li_l = wsf; LAS float* al_l = wsf + 32;
    float m_reg = 0.f, l_reg = 0; f32x16 o[4]; bf16x8 qr[12];
#pragma unroll
    for (int d = 0; d < 4; ++d)
#pragma unroll
        for (int r = 0; r < 16; ++r) o[d][r] = 0.f;
    const int qi = wid * QBLK + r32;
    const unsigned qrow = qb < 16 ? (unsigned)s * LREAL + 256 * qb + qi : (unsigned)MROW0 + 16 * s + (qi < 15 ? qi : 15);
    { const bf16_t* Qw = MQ + (qrow * NQ + h * 192 + hi * 8);
#pragma unroll
      for (int d0 = 0; d0 < 12; ++d0) qr[d0] = *(const bf16x8*)(Qw + d0 * 16); }
    const int sr = tid >> 4, sc = (tid & 15) * 8, vst0 = v_st(sr, sc), vst1 = v_st(32 + sr, sc);
    const int kr_r = tid >> 3, kr_c = (tid & 7) * 8;
    const int vb0 = (int)(uintptr_t)V_lds + v_rd_base(lane);
    bf16x8 vs0, vs1, ks0, ks1, kr0;
    const unsigned mainrow0 = (unsigned)s * LREAL, metarow0 = (unsigned)MROW0 + 16 * s;
    const bf16_t* MKVh = MKV + h * 256;
#define KROWG(kt, k) ((kt) < 64 ? mainrow0 + 64u * (kt) + (k) : metarow0 + ((k) < 15 ? (k) : 15))
#define SLOAD(kt) do { const unsigned g0 = KROWG(kt, sr) * NKV + sc, g1 = KROWG(kt, 32 + sr) * NKV + sc, g2 = KROWG(kt, kr_r) * 64 + kr_c; \
    vs0 = *(const bf16x8*)(MKVh + 128 + g0); vs1 = *(const bf16x8*)(MKVh + 128 + g1); \
    ks0 = *(const bf16x8*)(MKVh + g0); ks1 = *(const bf16x8*)(MKVh + g1); kr0 = *(const bf16x8*)(KR + g2); } while (0)
#define SWRITE(b) do { *(LAS bf16x8*)(V_lds + (b) * SHM_V + vst0) = vs0; *(LAS bf16x8*)(V_lds + (b) * SHM_V + vst1) = vs1; \
    *(LAS bf16x8*)(K_lds + (b) * SHM_K + sr * KROW + sc * 2) = ks0; *(LAS bf16x8*)(K_lds + (b) * SHM_K + (32 + sr) * KROW + sc * 2) = ks1; \
    *(LAS bf16x8*)(K_lds + (b) * SHM_K + kr_r * KROW + 256 + kr_c * 2) = kr0; } while (0)
#define RESC(a) do { if (__any((a) < 1.f)) { if (hi == 0) al_l[r32] = (a); asm volatile("s_waitcnt lgkmcnt(0)" ::: "memory"); \
    _Pragma("unroll") for (int d = 0; d < 4; ++d) _Pragma("unroll") for (int r = 0; r < 16; ++r) o[d][r] *= al_l[crow(r, hi)]; } } while (0)
    f32x16 pA0, pA1, pB0, pB1; float alA, alB; bf16x8 pa0, pa1, pa2, pa3;
    __syncthreads();
    SLOAD(0); SWRITE(0); __syncthreads();
    qkt(pA0, pA1, K_lds, qr, r32, hi, 0.f); partialSM<false, true>(pA0, pA1, m_reg, alA);
    SLOAD(1); SWRITE(1); __syncthreads();
    RESC(alA);
    int s0 = 0, s1 = 1, s2 = 2;
    if (__builtin_amdgcn_readfirstlane(wid) >= 4) __builtin_amdgcn_s_setprio(1);
    for (int j = 1; j + 1 < NT; j += 2) {
        SBAR(); qkt(pB0, pB1, K_lds + s1 * SHM_K, qr, r32, hi, -m_reg);
        finishSM(pA0, pA1, alA, l_reg, pa0, pa1, pa2, pa3); SBAR();
        SLOAD(j + 1); SBAR();
        pv_d0(o, vb0 + s0 * SHM_V, pa0, pa1, pa2, pa3); partialSM<false, false>(pB0, pB1, m_reg, alB);
        SWRITE(s2);
        RESC(alB); __syncthreads();
        SBAR(); qkt(pA0, pA1, K_lds + s2 * SHM_K, qr, r32, hi, -m_reg);
        finishSM(pB0, pB1, alB, l_reg, pa0, pa1, pa2, pa3); SBAR();
        if (j + 2 < NT) SLOAD(j + 2); SBAR();
        pv_d0(o, vb0 + s1 * SHM_V, pa0, pa1, pa2, pa3);
        if (j + 1 == NT - 1) partialSM<true, false>(pA0, pA1, m_reg, alA); else partialSM<false, false>(pA0, pA1, m_reg, alA);
        if (j + 2 < NT) SWRITE(s0);
        RESC(alA); __syncthreads();
        { const int t0 = s0, t1 = s1; s0 = s2; s1 = t0; s2 = t1; }
    }
    finishSM(pA0, pA1, alA, l_reg, pa0, pa1, pa2, pa3); SBAR();
    pv_d0(o, vb0 + s0 * SHM_V, pa0, pa1, pa2, pa3);
    if (hi == 0) li_l[r32] = l_reg; asm volatile("s_waitcnt lgkmcnt(0)" ::: "memory");
    __builtin_amdgcn_s_setprio(0);
    float rli[16];
#pragma unroll
    for (int r = 0; r < 16; ++r) rli[r] = __builtin_amdgcn_rcpf(li_l[crow(r, hi)]);
    if (qb < 16) {
        bf16_t* Ow = MIX + ((long)s * LREAL + 256 * qb + wid * QBLK) * DM + MLW + h * 128;
#pragma unroll
        for (int r = 0; r < 16; ++r) { const int orow = crow(r, hi);
#pragma unroll
            for (int d0 = 0; d0 < 4; ++d0) Ow[(long)orow * DM + d0 * 32 + r32] = (bf16_t)(pk2(o[d0][r] * rli[r], 0.f) & 0xffffu); }
    } else if (wid == 0) {
        bf16_t* Ow = MIX + ((long)MROW0 + 16 * s) * DM + MLW + h * 128;
#pragma unroll
        for (int r = 0; r < 16; ++r) { const int orow = crow(r, hi);
            if (orow < 16) {
#pragma unroll
                for (int d0 = 0; d0 < 4; ++d0) Ow[(long)orow * DM + d0 * 32 + r32] = (bf16_t)(pk2(o[d0][r] * rli[r], 0.f) & 0xffffu); } }
    }
#undef KROWG
#undef SLOAD
#undef SWRITE
#undef RESC
}
__device__ __forceinline__ void attn_phase(int vcu, const bf16_t* MQ, const bf16_t* MKV, const bf16_t* KR, bf16_t* MIX, LAS char* lds) {
    for (int i = (vcu < 96 ? -1 : 0); i < 6; ++i) { int sh, qb; if (i < 0) { sh = vcu; qb = 16; } else { const int id = i * GRID + vcu; sh = id >> 4; qb = id & 15; }
        attn_unit(sh >> 3, sh & 7, qb, MQ, MKV, KR, MIX, lds); }
}
#undef SBAR
}

namespace ml {
constexpr int QI = 0, KI = 32768, VI = 65536, SI = 81920, CI = 98304;
constexpr int SC_CT = 0, SC_BM = 64, SC_WI = 128, SC_EI = 192, SC_WW = 256, SC_DEN = 320, SC_QN = 448, SC_N = 512, SC_A = 768;
constexpr int GP_REC = 200;
__device__ __forceinline__ unsigned off_b(unsigned row, unsigned ch) { return 256u * row + 16u * (ch ^ (((row & 3) << 2) | ((row >> 2) & 3))); }
__device__ __forceinline__ unsigned row_read_addr_16(unsigned lane, unsigned rb, unsigned s) { return off_b((lane & 15) + 16 * rb, 4 * s + (lane >> 4)); }
__device__ __forceinline__ unsigned tr_read_addr_16(unsigned lane, unsigned c, unsigned ks, unsigned t) {
    const unsigned g = lane >> 4, q = (lane & 15) >> 2, p = lane & 3; return off_b(32 * ks + 8 * g + 4 * t + q, 2 * c + (p >> 1)) + 8 * (p & 1); }
__device__ __forceinline__ bf16x8 tr_frag(unsigned a0, unsigned a1) {
    const s16x4 lo = __builtin_amdgcn_ds_read_tr16_b64_v4i16((LAS s16x4*)a0), hi = __builtin_amdgcn_ds_read_tr16_b64_v4i16((LAS s16x4*)a1);
    return (bf16x8){lo[0], lo[1], lo[2], lo[3], hi[0], hi[1], hi[2], hi[3]};
}
__device__ __forceinline__ f32x4 mfma16(bf16x8 a, bf16x8 b, f32x4 c) { return __builtin_amdgcn_mfma_f32_16x16x32_bf16(a, b, c, 0, 0, 0); }
__device__ __forceinline__ float log_sigmoid(float x) { return fminf(x, 0.f) - __logf(1.f + __expf(-fabsf(x))); }

__device__ __forceinline__ void gate_prep(int gw, int ngw, int lane, const float* __restrict__ GATES, const float* __restrict__ bgl, float* __restrict__ GP) {
    for (int it = gw; it < 96 * 65; it += ngw) {
        const int chain = it / 65, c = it % 65, s = chain >> 3, hd = (chain >> 1) & 3, dir = chain & 1;
        const long g = c == 0 ? (lane >= 48 ? (long)MROW0 + 16 * s + lane - 48 : -1L) : (long)s * LREAL + 64 * (c - 1) + lane;
        float li = NEGBIG, lf = 0.f;
        if (g >= 0) { li = GATES[g * 16 + (dir ? 8 : 0) + hd] + bgl[(dir ? 8 : 0) + hd]; lf = log_sigmoid(GATES[g * 16 + (dir ? 12 : 4) + hd] + bgl[(dir ? 12 : 4) + hd]); }
        float x = dir ? __shfl(lf, 63 - lane) : lf;
#pragma unroll
        for (int o = 1; o < 64; o <<= 1) { const float y = __shfl_up(x, o); if (lane >= o) x += y; }
        const float btot = __shfl(x, 63);
        const float b = dir ? __shfl(x, 63 - lane) : x;
        const float a_s = li - b;
        float pm = dir ? __shfl(a_s, 63 - lane) : a_s;
#pragma unroll
        for (int o = 1; o < 64; o <<= 1) { const float y = __shfl_up(pm, o); if (lane >= o) pm = fmaxf(pm, y); }
        pm = dir ? __shfl(pm, 63 - lane) : pm;
        const float gmax = wave_max(btot - b + li);
        float* rec = GP + (size_t)it * GP_REC;
        rec[lane] = b; rec[64 + lane] = li; rec[128 + lane] = pm; if (lane == 0) { rec[192] = btot; rec[193] = gmax; }
    }
}

__device__ __forceinline__ void mlstm_unit(int s, int hd, int js, const bf16_t* __restrict__ UQKVO, const float* __restrict__ GP, float* __restrict__ HSUM, LAS unsigned char* lds, LAS float* sc) {
    const int wid = __builtin_amdgcn_readfirstlane((int)threadIdx.x >> 6);
    const unsigned ldsb = (unsigned)(uintptr_t)lds;
    const int tt = wid >> 1, nb = 2 * (wid & 1);
#define ROWRD(img, rb, s_) (*(const LAS bf16x8*)(uintptr_t)(RB[s_] + (unsigned)((img) + 4096 * (rb))))
#define TRFRAG(img, c_, ks) tr_frag(BT[0][(c_) & 1] + TQ[(c_) >> 1] + (unsigned)((img) + 8192 * (ks)), BT[1][(c_) & 1] + TQ[(c_) >> 1] + (unsigned)((img) + 8192 * (ks)))
    f32x4 accC[2][4], accN[2];
    for (int dir = 0; dir < 2; ++dir) {
        int tid; { int t0_ = threadIdx.x; asm volatile("" : "+v"(t0_)); tid = t0_; }
#pragma unroll
        for (int mi = 0; mi < 2; ++mi)
#pragma unroll
            for (int c = 0; c < 4; ++c) accC[mi][c] = (f32x4){0.f, 0.f, 0.f, 0.f};
        accN[0] = (f32x4){0.f, 0.f, 0.f, 0.f}; accN[1] = (f32x4){0.f, 0.f, 0.f, 0.f};
        if (tid < 256) sc[SC_N + tid] = 0.f;
        for (int i = tid; i < 32768 / 16; i += 512) *(LAS u32x4*)(lds + CI + i * 16) = (u32x4){0u, 0u, 0u, 0u};
        float m_state = 0.f;
        const float* GPc = GP + (size_t)(((s * 4 + hd) * 2 + dir) * 65) * GP_REC;
        u32x4 sq[4], sk[4], sv; float sb = 0.f, sli = NEGBIG, spm = NEGBIG, sbt = 0.f, sgm = NEGBIG;
#define ROWG(c, r) ((c) == 0 ? ((r) >= 48 ? (long)MROW0 + 16 * s + (r) - 48 : -1L) : (long)s * LREAL + 64 * ((c) - 1) + (r))
#define STAGE_LOAD(c) do { \
        _Pragma("unroll") for (int i = 0; i < 4; ++i) { const int id = tid + 512 * i, r = id >> 5, ch = id & 31; const long g = ROWG(c, r); \
            sq[i] = (u32x4){0u, 0u, 0u, 0u}; sk[i] = (u32x4){0u, 0u, 0u, 0u}; \
            if (g >= 0) { sq[i] = *(const u32x4*)(UQKVO + g * 4096 + hd * 256 + ch * 8); sk[i] = *(const u32x4*)(UQKVO + g * 4096 + 1024 + hd * 256 + ch * 8); } } \
        { const int r = tid >> 3, ch = tid & 7; const long g = ROWG(c, r); sv = (u32x4){0u, 0u, 0u, 0u}; if (g >= 0) sv = *(const u32x4*)(UQKVO + g * 4096 + 2048 + hd * 256 + js * 64 + ch * 8); } \
        if (tid < 64) { const float* rec = GPc + (size_t)(c) * GP_REC; sb = rec[tid]; sli = rec[64 + tid]; spm = rec[128 + tid]; sbt = rec[192]; sgm = rec[193]; } } while (0)
#define STAGE_WRITE() do { \
        _Pragma("unroll") for (int i = 0; i < 4; ++i) { const int id = tid + 512 * i, r = id >> 5, ch = id & 31; \
            *(LAS u32x4*)(lds + QI + (ch >> 4) * 16384 + off_b(r, ch & 15)) = sq[i]; *(LAS u32x4*)(lds + KI + (ch >> 4) * 16384 + off_b(r, ch & 15)) = sk[i]; } \
        { const int r = tid >> 3, ch = tid & 7; *(LAS u32x4*)(lds + VI + off_b(r, ch)) = sv; } \
        if (tid < 64) { const float m_inter = sb + m_state, mt = fmaxf(m_inter, sb + spm); const float m_new = fmaxf(sbt + m_state, sgm); \
            sc[SC_CT + tid] = sli - sb; sc[SC_BM + tid] = sb - mt; sc[SC_WI + tid] = __expf(m_inter - mt); sc[SC_EI + tid] = __expf(-mt); \
            sc[SC_WW + tid] = __expf(sbt - sb + sli - m_new) * 0.0625f; if (tid == 0) sc[SC_A] = __expf(sbt + m_state - m_new); m_state = m_new; } } while (0)
        const int c_first = dir ? 64 : 0, c_step = dir ? -1 : 1;
        STAGE_LOAD(c_first);
        __syncthreads();
        STAGE_WRITE();
        for (int ci = 0; ci < 65; ++ci) {
            const int c = c_first + c_step * ci;
            { int t2_ = threadIdx.x; asm volatile("" : "+v"(t2_)); tid = t2_; }
            const int lane = tid & 63, l15 = lane & 15, lg = lane >> 4;
            unsigned RB[4], BT[2][2], TQ[4];
            { const unsigned fl = ((l15 & 3) << 2) | (l15 >> 2), q = l15 >> 2, p = lane & 3, g = lg;
#pragma unroll
              for (int s_ = 0; s_ < 4; ++s_) { RB[s_] = ldsb + 256u * l15 + 16u * (lg ^ (fl & 3)) + 64u * (s_ ^ (fl >> 2)); TQ[s_] = 64u * (s_ ^ q); }
#pragma unroll
              for (int t_ = 0; t_ < 2; ++t_)
#pragma unroll
                  for (int cl = 0; cl < 2; ++cl) BT[t_][cl] = ldsb + 256u * (8 * g + q) + 8u * (p & 1) + 1024u * t_ + 16u * ((p >> 1) ^ t_) + 32u * (cl ^ (g & 1)); }
            __syncthreads();
            if (ci + 1 < 65) STAGE_LOAD(c + c_step);
            bf16x8 qf[8];
#pragma unroll
            for (int k = 0; k < 8; ++k) qf[k] = ROWRD(QI + (k >> 2) * 16384, tt, k & 3);
            f32x4 sT[2], oc[2];
#pragma unroll
            for (int i = 0; i < 2; ++i) { sT[i] = (f32x4){0.f, 0.f, 0.f, 0.f}; oc[i] = (f32x4){0.f, 0.f, 0.f, 0.f}; }
#pragma unroll
            for (int i = 0; i < 2; ++i)
#pragma unroll
                for (int k = 0; k < 8; ++k) {
                    const bf16x8 kf = ROWRD(KI + (k >> 2) * 16384, nb + i, k & 3);
                    sT[i] = mfma16(kf, qf[k], sT[i]);
                    const bf16x8 cf = ROWRD(CI + (k >> 2) * 16384, nb + i, k & 3);
                    oc[i] = mfma16(qf[k], cf, oc[i]);
                }
            {
                const int t = 16 * tt + l15; const float bmt = sc[SC_BM + t]; float rs = 0.f;
#pragma unroll
                for (int i = 0; i < 2; ++i) { const int s0 = 16 * (nb + i) + 4 * lg; const f32x4 ctv = *(const LAS f32x4*)(sc + SC_CT + s0); float v[4];
#pragma unroll
                    for (int e = 0; e < 4; ++e) { const int sx = s0 + e; const bool ok = dir ? (sx >= t) : (sx <= t);
                        const float ex = ok ? (bmt + ctv[e]) : NEGBIG; v[e] = sT[i][e] * 0.0625f * __expf(ex); rs += v[e]; }
                    u32x2 w; w.x = pk2(v[0], v[1]); w.y = pk2(v[2], v[3]);
                    *(LAS u32x2*)(lds + SI + off_b(t, s0 >> 3) + (s0 & 7) * 2) = w; }
                rs += __shfl_xor(rs, 16); rs += __shfl_xor(rs, 32);
                if (lg == 0) sc[SC_DEN + 64 * (wid & 1) + t] = rs;
            }
            { const int r = tid >> 3, ch = tid & 7; const u32x4 v = *(const LAS u32x4*)(lds + VI + off_b(r, ch)); const float w = sc[SC_WW + r]; u32x4 o;
#pragma unroll
              for (int jx = 0; jx < 4; ++jx) o[jx] = pk2(bf_lo(v[jx]) * w, bf_hi(v[jx]) * w);
              *(LAS u32x4*)(lds + VI + off_b(r, 8 + ch)) = o; }
            { const int r = tid >> 3, part = tid & 7; float d = 0.f;
#pragma unroll
              for (int i = 0; i < 4; ++i) { const int ch32 = part * 4 + i; const u32x4 v = *(const LAS u32x4*)(lds + QI + (ch32 >> 4) * 16384 + off_b(r, ch32 & 15));
                  const f32x4 n0 = *(const LAS f32x4*)(sc + SC_N + ch32 * 8), n1 = *(const LAS f32x4*)(sc + SC_N + ch32 * 8 + 4);
                  d += bf_lo(v[0]) * n0[0] + bf_hi(v[0]) * n0[1] + bf_lo(v[1]) * n0[2] + bf_hi(v[1]) * n0[3] + bf_lo(v[2]) * n1[0] + bf_hi(v[2]) * n1[1] + bf_lo(v[3]) * n1[2] + bf_hi(v[3]) * n1[3]; }
              d += __shfl_xor(d, 1); d += __shfl_xor(d, 2); d += __shfl_xor(d, 4);
              if (part == 0) sc[SC_QN + r] = d; }
            { const f32x4 wi = *(const LAS f32x4*)(sc + SC_WI + 16 * tt + 4 * lg);
#pragma unroll
              for (int i = 0; i < 2; ++i) oc[i] = oc[i] * wi; }
            __syncthreads();
            const float a_dec = sc[SC_A];
#pragma unroll
            for (int ks = 0; ks < 2; ++ks) { const bf16x8 sf = ROWRD(SI, tt, ks);
#pragma unroll
                for (int i = 0; i < 2; ++i) { const bf16x8 vf = TRFRAG(VI, nb + i, ks);
                    oc[i] = mfma16(sf, vf, oc[i]); } }
            { const int t0 = 16 * tt + 4 * lg;
              const f32x4 wi = *(const LAS f32x4*)(sc + SC_WI + t0), qn = *(const LAS f32x4*)(sc + SC_QN + t0), d0 = *(const LAS f32x4*)(sc + SC_DEN + t0), d1 = *(const LAS f32x4*)(sc + SC_DEN + 64 + t0), ei = *(const LAS f32x4*)(sc + SC_EI + t0);
#pragma unroll
              for (int e = 0; e < 4; ++e) { const long g = ROWG(c, t0 + e);
                const float den = wi[e] * qn[e] + (d0[e] + d1[e]); const float inv = 1.f / fmaxf(fabsf(den), ei[e]);
                if (g >= 0) {
#pragma unroll
                    for (int i = 0; i < 2; ++i) { float* hp = HSUM + g * MLW + hd * 256 + js * 64 + 16 * (nb + i) + l15; const float hv = oc[i][e] * inv; if (dir) unsafeAtomicAdd(hp, hv); else *hp = hv; } } } }
#pragma unroll
            for (int mi = 0; mi < 2; ++mi)
#pragma unroll
                for (int cc = 0; cc < 4; ++cc) accC[mi][cc] = accC[mi][cc] * a_dec;
            accN[0] = accN[0] * a_dec; accN[1] = accN[1] * a_dec;
            const unsigned ktq = (unsigned)(KI + (wid >> 2) * 16384) + 64u * ((unsigned)(wid & 3) ^ (unsigned)(l15 >> 2));
#pragma unroll
            for (int ks = 0; ks < 2; ++ks) {
                bf16x8 kf[2], wf[4];
#pragma unroll
                for (int mi = 0; mi < 2; ++mi) kf[mi] = tr_frag(BT[0][mi] + ktq + (unsigned)(8192 * ks), BT[1][mi] + ktq + (unsigned)(8192 * ks));
#pragma unroll
                for (int cc = 0; cc < 4; ++cc) wf[cc] = TRFRAG(VI, 4 + cc, ks);
                { const f32x4 wa = *(const LAS f32x4*)(sc + SC_WW + 32 * ks + 8 * lg), wb = *(const LAS f32x4*)(sc + SC_WW + 32 * ks + 8 * lg + 4);
                  u32x4 wq; wq.x = pk2(wa[0], wa[1]); wq.y = pk2(wa[2], wa[3]); wq.z = pk2(wb[0], wb[1]); wq.w = pk2(wb[2], wb[3]);
                  if (l15 != 0) wq = (u32x4){0u, 0u, 0u, 0u};
                  const bf16x8 wfn = __builtin_bit_cast(bf16x8, wq);
#pragma unroll
                  for (int mi = 0; mi < 2; ++mi) accN[mi] = mfma16(kf[mi], wfn, accN[mi]); }
#pragma unroll
                for (int mi = 0; mi < 2; ++mi)
#pragma unroll
                    for (int cc = 0; cc < 4; ++cc) accC[mi][cc] = mfma16(kf[mi], wf[cc], accC[mi][cc]);
            }
#pragma unroll
            for (int mi = 0; mi < 2; ++mi)
#pragma unroll
                for (int cc = 0; cc < 4; ++cc) { const int dk0 = 32 * wid + 16 * mi + 4 * lg, dv = 16 * cc + l15; u32x2 w; w.x = pk2(accC[mi][cc][0], accC[mi][cc][1]); w.y = pk2(accC[mi][cc][2], accC[mi][cc][3]);
                    *(LAS u32x2*)(lds + CI + (dk0 >> 7) * 16384 + off_b(dv, (dk0 & 127) >> 3) + (dk0 & 7) * 2) = w; }
            if (l15 == 0) { *(LAS f32x4*)(sc + SC_N + 32 * wid + 4 * lg) = accN[0]; *(LAS f32x4*)(sc + SC_N + 32 * wid + 16 + 4 * lg) = accN[1]; }
            __syncthreads();
            if (ci + 1 < 65) STAGE_WRITE();
        }
    }
#undef ROWG
#undef STAGE_LOAD
#undef STAGE_WRITE
#undef ROWRD
#undef TRFRAG
}
__device__ __forceinline__ void mlstm_phase(int bx, const bf16_t* UQKVO, const float* GP, float* HSUM, LAS unsigned char* lds, LAS float* sc) {
    if (bx >= 192) return;
    const int xcd = bx & 7, idx = bx >> 3, pair = xcd * 6 + (idx >> 2), js = idx & 3;
    mlstm_unit(pair >> 2, pair & 3, js, UQKVO, GP, HSUM, lds, sc);
}
}

#ifndef PHM
#define PHM 0xffff
#endif
#ifndef REP_ML
#define REP_ML 1
#endif
#ifndef REP_ATTN
#define REP_ATTN 1
#endif
#ifndef REP_CONV
#define REP_CONV 1
#endif
#ifndef REP_SMALL
#define REP_SMALL 1
#endif
#ifndef KV_SPLIT
#define KV_SPLIT 193
#endif
#ifndef REP_WIN
#define REP_WIN 1
#endif
#ifndef REP_UP
#define REP_UP 1
#endif
__global__ void __launch_bounds__(512, 2) fwd_kernel(Params P, unsigned char* ws_arg, unsigned char* out_arg) {
    extern __shared__ __attribute__((aligned(16))) unsigned char lds_raw[];
    Frame F;
    F.lds = (LAS unsigned char*)lds_raw;
    F.tid = threadIdx.x; F.lane = F.tid & 63; F.wave = __builtin_amdgcn_readfirstlane(F.tid >> 6);
    F.G = GRID; F.bx = blockIdx.x; F.vcu = (F.bx % 8) * (GRID / 8) + F.bx / 8;
    F.gw = F.vcu * 8 + F.wave; F.ngw = F.G * 8;
    { unsigned char* ws0 = ws_arg;
      for (int u = F.tid; u < (LDS_BYTES - MISC_OFF) / 4; u += 512) ((LAS unsigned*)(F.lds + MISC_OFF))[u] = 0u;
      __syncthreads();
      (void)ws0; }
    LAS unsigned long long* ptab = (LAS unsigned long long*)(F.lds + MISC_OFF + 64);
    if (F.tid == 0) {
#pragma unroll
        for (int k = 0; k < 19; ++k) ptab[k] = (unsigned long long)(uintptr_t)P.in[k]; }
    __syncthreads();
    XcdBarrier bar = xcd_barrier_post((unsigned*)(ws_arg + WS_CTL) + CW_BAR, (volatile LAS unsigned*)(F.lds + MISC_OFF));
    LAS float* sc = (LAS float*)(F.lds + MISC_OFF + 1024);
#define BXL() ({ int b__ = F.bx; asm volatile("" : "+s"(b__)); b__; })
#define PFRAME() Frame Fp = F; { int t_ = threadIdx.x; asm volatile("" : "+v"(t_)); Fp.tid = t_; Fp.lane = t_ & 63; int b_ = BXL(); Fp.bx = b_; Fp.vcu = (b_ % 8) * (GRID / 8) + b_ / 8; Fp.gw = Fp.vcu * 8 + Fp.wave; }
#define WSB() ({ GAS unsigned char* w__ = (GAS unsigned char*)ws_arg; asm volatile("" : "+s"(w__)); (unsigned char*)w__; })
#ifndef STAG_N
#define STAG_N 1
#endif
#ifdef STAG_ON
#define STAGGER() do { int s__ = (BXL() * 37) & 255; for (int i__ = 0; i__ < s__; ++i__) __builtin_amdgcn_s_sleep(STAG_N); } while (0)
#else
#define STAGGER() do {} while (0)
#endif
#define WOFS(l_) (((l_) & 1) ? WSET_DELTA : (size_t)0)
#define DOB() ({ GAS unsigned char* w__ = (GAS unsigned char*)out_arg; asm volatile("" : "+s"(w__)); (unsigned char*)w__; })

    { unsigned char* ws = WSB(); prologue(F, ws, ptab); convert_weights(F, ws, ptab, 0, 0, -1); }
    xcd_barrier(bar);

    for (int l = 0; l < DEPTH; ++l) {
        { unsigned char* ws = WSB();
          pg8::Gemm g{(bf16_t*)(ws + WS_HB), (bf16_t*)(ws + WOFS(l) + WS_WIN), TP, NIN, DM, DM}; pg8::PanelOrder S; S.init(NPAN, 0, 0, 0, NIN, F.G, BXL());
          pg8::EpiWin E{(bf16_t*)(ws + WS_UQKVO), (bf16_t*)(ws + WS_UDQ), (bf16_t*)(ws + WS_UDKV), (bf16_t*)(ws + WS_KR), (float*)(ws + WS_GATES), (const float*)(ws + WS_COS), (const float*)(ws + WS_SIN)};
#if PHM & 2
          STAGGER(); pg8::gemm_phase<pg8::EpiWin, pg8::PanelOrder, true, true>(F.lds, g, S, E);
#endif
        }
        if (l + 1 < DEPTH && BXL() >= 20) { unsigned char* ws = WSB(); PFRAME(); Fp.gw = (Fp.bx - 20) * 8 + Fp.wave; Fp.ngw = (GRID - 20) * 8; convert_weights(Fp, ws, ptab, l + 1, WOFS(l + 1), 0); }
#if REP_WIN > 1
        __syncthreads();
        { unsigned char* ws = WSB();
          pg8::Gemm g{(bf16_t*)(ws + WS_HB), (bf16_t*)(ws + WOFS(l) + WS_WIN), TP, NIN, DM, DM}; pg8::PanelOrder S; S.init(NPAN, 0, 0, 0, NIN, F.G, BXL());
          pg8::EpiWin E{(bf16_t*)(ws + WS_UQKVO), (bf16_t*)(ws + WS_UDQ), (bf16_t*)(ws + WS_UDKV), (bf16_t*)(ws + WS_KR), (float*)(ws + WS_GATES), (const float*)(ws + WS_COS), (const float*)(ws + WS_SIN)};
          pg8::gemm_phase<pg8::EpiWin, pg8::PanelOrder, true, true>(F.lds, g, S, E);
        }
#endif
        xcd_barrier(bar);
        { unsigned char* ws = WSB(); unsigned char* dob = DOB(); PFRAME(); rstd_rows(Fp, (bf16_t*)(ws + WS_UDQ), (bf16_t*)(ws + WS_UDKV), (float*)(ws + WS_RSTD));
          ml::gate_prep(Fp.gw, Fp.ngw, Fp.lane, (const float*)(ws + WS_GATES), (const float*)(ws + WS_PAR) + PO_BG + l * 16, (float*)(dob + DO_GP)); }
#if REP_SMALL > 1
        { unsigned char* ws = WSB(); unsigned char* dob = DOB(); PFRAME(); rstd_rows(Fp, (bf16_t*)(ws + WS_UDQ), (bf16_t*)(ws + WS_UDKV), (float*)(ws + WS_RSTD));
          ml::gate_prep(Fp.gw, Fp.ngw, Fp.lane, (const float*)(ws + WS_GATES), (const float*)(ws + WS_PAR) + PO_BG + l * 16, (float*)(dob + DO_GP)); }
#endif
        xcd_barrier(bar);
        if (F.bx >= 192) {
        { unsigned char* ws = WSB(); unsigned char* dob = DOB();
          pg8::Gemm g{(bf16_t*)(ws + WS_UDQ), (bf16_t*)(ws + WOFS(l) + WS_WUQ), TP, NQ, 512, 512}; pg8::PanelOrder S; S.init(NPAN, 0, 0, 0, NQ, GRID - 192, BXL() - 192);
          pg8::EpiQ E{(bf16_t*)(dob + DO_MQ), (const float*)(ws + WS_RSTD), (const float*)(ws + WS_COS), (const float*)(ws + WS_SIN)};
#if PHM & 4
          pg8::gemm_phase<pg8::EpiQ, pg8::PanelOrder, true, true>(F.lds, g, S, E);
#endif
        }
        { unsigned char* ws = WSB();
          pg8::Gemm g{(bf16_t*)(ws + WS_UDKV), (bf16_t*)(ws + WOFS(l) + WS_WUKV), TP, NKV, 256, 256}; pg8::PanelOrder S; S.init(NPAN, 0, 0, 0, NKV, GRID - 192, BXL() - 192);
          pg8::EpiBf16G E{(bf16_t*)(ws + WS_MKV), NKV, (const float*)(ws + WS_RSTD) + 1, 0, -1, 0};
#if PHM & 8
          pg8::gemm_phase<pg8::EpiBf16G, pg8::PanelOrder, true, true>(F.lds, g, S, E);
#endif
        }
        } else {
#ifndef NO_ML
        for (int rep_ = 0; rep_ < REP_ML; ++rep_)
        { unsigned char* ws = WSB(); unsigned char* dob = DOB();
          ml::mlstm_phase(BXL(), (const bf16_t*)(ws + WS_UQKVO), (const float*)(dob + DO_GP), (float*)(dob + DO_HSUM), F.lds, sc); }
#endif
        }
        xcd_barrier(bar);
        { unsigned char* ws = WSB(); unsigned char* dob = DOB(); PFRAME();
          if (Fp.vcu >= 96) mlstm_finalize(Fp, (Fp.vcu - 96) * 8 + Fp.wave, (GRID - 96) * 8, (const float*)(dob + DO_HSUM), (const bf16_t*)(ws + WS_UQKVO), (const float*)(ws + WS_PAR) + PO_MLG + l * MLW, (bf16_t*)(ws + WS_HB)); }
#ifndef NO_ATTN
        for (int rep_ = 0; rep_ < REP_ATTN; ++rep_)
        { unsigned char* ws = WSB(); unsigned char* dob = DOB();
          att::attn_phase(({ int b__ = BXL(); (b__ % 8) * (GRID / 8) + b__ / 8; }), (const bf16_t*)(dob + DO_MQ), (const bf16_t*)(ws + WS_MKV), (const bf16_t*)(ws + WS_KR), (bf16_t*)(ws + WS_HB), (LAS char*)F.lds); }
#endif
        xcd_barrier(bar);
        { unsigned char* ws = WSB();
          pg8::Gemm g{(bf16_t*)(ws + WS_HB), (bf16_t*)(ws + WOFS(l) + WS_WOUT), TP, DM, DM, DM}; pg8::PanelOrder S; S.init(192, 0, 0, 0, DM, F.G, BXL());
          pg8::EpiResidLn E{(bf16_t*)(ws + WS_H), DM, ALPHA, (const float*)(ws + WS_STAT2), (const float*)(ws + WS_PAR) + (l > 0 ? PO_L2G + (l - 1) * DM : PO_ONE), (const float*)(ws + WS_PAR) + (l > 0 ? PO_L2B + (l - 1) * DM : PO_ZERO)};
#if PHM & 16
          STAGGER(); pg8::gemm_phase<pg8::EpiResidLn, pg8::PanelOrder, true, true>(F.lds, g, S, E);
#endif
        }
        { unsigned char* ws = WSB();
          pg8::Gemm g{(bf16_t*)(ws + WS_HB), (bf16_t*)(ws + WOFS(l) + WS_WOUT), TP, DM, DM / 4, DM}; pg8::SplitOrder S; S.init(PMETA, DM, 4, F.G, BXL());
          pg8::EpiPart E{(float*)(ws + WS_PART), DM};
#if PHM & 16
          pg8::gemm_phase<pg8::EpiPart, pg8::SplitOrder, true, true>(F.lds, g, S, E);
#endif
        }
        xcd_barrier(bar);
        { unsigned char* ws = WSB(); PFRAME(); ln_rows(Fp, (float*)(ws + WS_H), (bf16_t*)(ws + WS_HB), (const float*)(ws + WS_PAR) + PO_L1G + l * DM, (const float*)(ws + WS_PAR) + PO_L1B + l * DM, (float*)(ws + WS_STAT1), nullptr, (const float*)(ws + WS_PART), 4); }
        xcd_barrier(bar);
        { unsigned char* ws = WSB(); unsigned char* dob = DOB();
          pg8::Gemm g{(bf16_t*)(ws + WS_HB), (bf16_t*)(ws + WOFS(l) + WS_WUP), TP, NUP, DM, DM}; pg8::PanelOrder S; S.init(NPAN, 0, 0, 0, NUP, F.G, BXL());
          pg8::EpiFfn E{(bf16_t*)(ws + WS_ACT), (float*)(dob + DO_SIDE), (bf16_t*)(dob + DO_GVM), (const float*)(ws + WS_PAR) + PO_CW + (size_t)l * 3 * DFF, (const float*)(ws + WS_PAR) + PO_CB + (size_t)l * DFF, (LAS float*)(F.lds + MISC_OFF + 8192)};
#if PHM & 32
          STAGGER(); pg8::gemm_phase<pg8::EpiFfn, pg8::PanelOrder, true, true>(F.lds, g, S, E);
#if REP_UP > 1
          __syncthreads(); pg8::gemm_phase<pg8::EpiFfn, pg8::PanelOrder, true, true>(F.lds, g, S, E);
#endif
#endif
        }
        if (l + 1 < DEPTH && BXL() >= 44) { unsigned char* ws = WSB(); PFRAME(); Fp.gw = (Fp.bx - 44) * 8 + Fp.wave; Fp.ngw = (GRID - 44) * 8; convert_weights(Fp, ws, ptab, l + 1, WOFS(l + 1), 1); }
        xcd_barrier(bar);
        { unsigned char* ws = WSB(); unsigned char* dob = DOB(); PFRAME();
          ffn_fixup(Fp, (const float*)(dob + DO_SIDE), (const bf16_t*)(dob + DO_GVM), (bf16_t*)(ws + WS_ACT), (const float*)(ws + WS_PAR) + PO_CW + (size_t)l * 3 * DFF, (const float*)(ws + WS_PAR) + PO_CB + (size_t)l * DFF); }
#if REP_SMALL > 1
        { unsigned char* ws = WSB(); unsigned char* dob = DOB(); PFRAME();
          ffn_fixup(Fp, (const float*)(dob + DO_SIDE), (const bf16_t*)(dob + DO_GVM), (bf16_t*)(ws + WS_ACT), (const float*)(ws + WS_PAR) + PO_CW + (size_t)l * 3 * DFF, (const float*)(ws + WS_PAR) + PO_CB + (size_t)l * DFF); }
#endif
        xcd_barrier(bar);
        { unsigned char* ws = WSB();
          pg8::Gemm g{(bf16_t*)(ws + WS_ACT), (bf16_t*)(ws + WOFS(l) + WS_WDN), TP, DM, DFF, DFF}; pg8::PanelOrder S; S.init(192, 0, 0, 0, DM, F.G, BXL());
          pg8::EpiResidLn E{(bf16_t*)(ws + WS_H), DM, ALPHA, (const float*)(ws + WS_STAT1), (const float*)(ws + WS_PAR) + PO_L1G + l * DM, (const float*)(ws + WS_PAR) + PO_L1B + l * DM};
#if PHM & 64
          STAGGER(); pg8::gemm_phase<pg8::EpiResidLn, pg8::PanelOrder, true, true>(F.lds, g, S, E);
#endif
        }
        { unsigned char* ws = WSB();
          pg8::Gemm g{(bf16_t*)(ws + WS_ACT), (bf16_t*)(ws + WOFS(l) + WS_WDN), TP, DM, DFF / 11, DFF}; pg8::SplitOrder S; S.init(PMETA, DM, 11, F.G, BXL());
          pg8::EpiPart E{(float*)(ws + WS_PART), DM};
#if PHM & 64
          pg8::gemm_phase<pg8::EpiPart, pg8::SplitOrder, true, true>(F.lds, g, S, E);
#endif
        }
        xcd_barrier(bar);
        { unsigned char* ws = WSB(); unsigned char* dob = DOB();
          PFRAME(); ln_rows(Fp, (float*)(ws + WS_H), (bf16_t*)(ws + WS_HB), (const float*)(ws + WS_PAR) + PO_L2G + l * DM, (const float*)(ws + WS_PAR) + PO_L2B + l * DM, (float*)(ws + WS_STAT2), l == DEPTH - 1 ? (float*)dob : nullptr, (const float*)(ws + WS_PART), 11); }
#if REP_CONV > 1
#endif
        xcd_barrier(bar);
    }
}

extern "C" void kernel_launch(void* const* d_in, const int* in_sizes, int n_in, void* d_out, int out_size, void* d_ws, size_t ws_size, hipStream_t stream) {
    static int grid = 0;
    if (grid == 0) {
        if (n_in != 19 || out_size != NMAIN * DM || ws_size < WS_NEED) { fprintf(stderr, "kernel_launch: unexpected shapes (n_in %d out %d ws %zu need %zu)\n", n_in, out_size, ws_size, (size_t)WS_NEED); grid = -1; return; }
        int dev = 0, cus = 0;
        if (hipGetDevice(&dev) != hipSuccess || hipDeviceGetAttribute(&cus, hipDeviceAttributeMultiprocessorCount, dev) != hipSuccess) { grid = -1; return; }
        if (hipFuncSetAttribute((const void*)fwd_kernel, hipFuncAttributeMaxDynamicSharedMemorySize, LDS_BYTES) != hipSuccess) { fprintf(stderr, "kernel_launch: hipFuncSetAttribute failed\n"); grid = -1; return; }
        int per_cu = 0;
        if (hipOccupancyMaxActiveBlocksPerMultiprocessor(&per_cu, (const void*)fwd_kernel, 512, LDS_BYTES) != hipSuccess || per_cu < 1) { fprintf(stderr, "kernel_launch: occupancy query says %d blocks per CU\n", per_cu); (void)hipGetLastError(); grid = -1; return; }
        if (cus < GRID) { fprintf(stderr, "kernel_launch: needs %d CUs, device has %d\n", GRID, cus); grid = -1; return; }
        grid = GRID;
    }
    if (grid < 0) return;
    (void)hipMemsetAsync((char*)d_ws + WS_CTL, 0, CTL_BYTES, stream);
    Params p{};
    for (int i = 0; i < 19; ++i) p.in[i] = (const float*)d_in[i];
    hipLaunchKernelGGL(fwd_kernel, dim3(grid), dim3(512), LDS_BYTES, stream, p, (unsigned char*)d_ws, (unsigned char*)d_out);
}
```

```cpp
#include <hip/hip_runtime.h>
#include <cstdio>
#include <cstdint>

#define LAS __attribute__((address_space(3)))
#define GAS __attribute__((address_space(1)))
typedef float f32x2 __attribute__((ext_vector_type(2)));
typedef float f32x8 __attribute__((ext_vector_type(8)));
typedef float f32x16 __attribute__((ext_vector_type(16)));
typedef unsigned u32x2 __attribute__((ext_vector_type(2)));
typedef short s16x4 __attribute__((ext_vector_type(4)));
typedef __bf16 bf16x2v __attribute__((ext_vector_type(2)));

constexpr int DM = 2048, NSEQ = 12, LREAL = 4096, NMETA = 16, DEPTH = 4;
constexpr int NMAIN = NSEQ * LREAL;
constexpr int MROW0 = NMAIN;
constexpr int NTOK = NMAIN + NSEQ * NMETA;
constexpr int NPAN = 193, TP = NPAN * 256;
constexpr int PMETA = 192;
constexpr int INC = 4944, NIN = 5120;
constexpr int DFF = 5632, NUP = 2 * DFF;
constexpr int MLW = 1024, NQ = 1536, NKV = 2048;
constexpr float ALPHA = 1.681792830507429f;
constexpr float EPS = 1e-5f;
constexpr float NEGBIG = -1e30f;

constexpr size_t MiB = 1u << 20;
constexpr size_t WS_CTL = 0, CTL_BYTES = 1 * MiB;
constexpr size_t WS_COS = 1 * MiB;
constexpr size_t WS_SIN = WS_COS + (size_t)4112 * 32 * 4;
constexpr size_t WS_PAR = 2 * MiB + 128 * 1024;
constexpr int PO_BG = 0, PO_MLG = PO_BG + DEPTH * 16, PO_QG = PO_MLG + DEPTH * 1024, PO_KVG = PO_QG + DEPTH * 512, PO_L1G = PO_KVG + DEPTH * 256, PO_L1B = PO_L1G + DEPTH * 2048,
              PO_CW = PO_L1B + DEPTH * 2048, PO_CB = PO_CW + DEPTH * 3 * 5632, PO_L2G = PO_CB + DEPTH * 5632, PO_L2B = PO_L2G + DEPTH * 2048, PO_ONE = PO_L2B + DEPTH * 2048, PO_ZERO = PO_ONE + 2048, PO_END = PO_ZERO + 2048;
static_assert(WS_PAR + (size_t)PO_END * 4 <= 3 * MiB && WS_PAR >= 1 * MiB + 2 * 4112 * 32 * 4, "PAR block placement");
constexpr size_t WS_WIN = 3 * MiB;
constexpr size_t WS_WUQ = WS_WIN + (size_t)NIN * DM * 2;
constexpr size_t WS_WUKV = WS_WUQ + (size_t)NQ * 512 * 2;
constexpr size_t WS_WOUT = WS_WUKV + (size_t)NKV * 256 * 2;
constexpr size_t WS_WUP = WS_WOUT + (size_t)DM * DM * 2;
constexpr size_t WS_WDN = WS_WUP + (size_t)NUP * DM * 2;
constexpr size_t WS_STAT1 = WS_WDN + (size_t)DM * DFF * 2;
constexpr size_t WS_STAT2 = WS_CTL + 512 * 1024;
constexpr size_t WS_H = 100 * MiB;
constexpr size_t WS_PART = WS_H + 208 * MiB;
static_assert((size_t)NMAIN * DM * 2 <= 208 * MiB && 208 * MiB + (size_t)11 * 256 * DM * 4 <= (size_t)NMAIN * DM * 4, "PART sits between the bf16 rows and the f32 meta rows of H");
constexpr size_t WS_WSET2 = WS_H + 240 * MiB;
constexpr size_t WSET_BYTES = WS_STAT1 - WS_WIN, WSET_DELTA = WS_WSET2 - WS_WIN;
static_assert(WS_PART + (size_t)11 * 256 * DM * 4 <= WS_WSET2 && WS_WSET2 + WSET_BYTES <= WS_H + (size_t)NMAIN * DM * 4, "second weight set sits between the split-K parts and the f32 meta rows of H");
constexpr size_t WS_HB = WS_H + (size_t)TP * DM * 4;
constexpr size_t WS_R = WS_HB + (size_t)TP * DM * 2;
constexpr size_t WS_UQKVO = WS_R;
constexpr size_t WS_UDQ = WS_UQKVO + (size_t)TP * 4096 * 2;
constexpr size_t WS_UDKV = WS_UDQ + (size_t)TP * 512 * 2;
constexpr size_t WS_GATES = WS_UDKV + (size_t)TP * 256 * 2;
constexpr size_t WS_MKV = WS_GATES + (size_t)TP * 16 * 4;
constexpr size_t WS_KR = WS_MKV + (size_t)TP * NKV * 2;
constexpr size_t WS_RSTD = WS_KR + (size_t)TP * 64 * 2;
constexpr size_t WS_END_A = WS_RSTD + (size_t)TP * 2 * 4;
constexpr size_t WS_ACT = WS_R;
constexpr size_t WS_END_B = WS_ACT + (size_t)TP * DFF * 2;
constexpr size_t WS_NEED = (WS_END_A > WS_END_B ? WS_END_A : WS_END_B);
static_assert(WS_STAT1 + (size_t)TP * 8 <= WS_H && WS_STAT2 + (size_t)TP * 8 <= WS_CTL + CTL_BYTES, "weights and row statistics fit below H");
constexpr size_t DO_HSUM = 0;
constexpr size_t DO_MQ = DO_HSUM + (size_t)TP * MLW * 4;
constexpr size_t DO_GP = 340 * MiB;
constexpr size_t DO_SIDE = 0;
constexpr size_t DO_GVM = 32 * MiB;
static_assert(DO_MQ + (size_t)TP * NQ * 2 <= DO_GP && DO_GP + (size_t)96 * 65 * 200 * 4 <= (size_t)NMAIN * DM * 4 && (size_t)192 * 6 * DFF * 4 <= DO_GVM && DO_GVM + (size_t)256 * NUP * 2 <= (size_t)NMAIN * DM * 4, "d_out scratch fits");
constexpr int CW_BAR = 4096;

constexpr int RING_BYTES = 131072;
constexpr int MISC_OFF = RING_BYTES;
constexpr int LDS_BYTES = 147456;
constexpr int GRID = 256;

__device__ __forceinline__ int pos_of_row(int row) { return row < NMAIN ? NMETA + (row & (LREAL - 1)) : ((row - NMAIN) & (NMETA - 1)); }
__device__ __forceinline__ unsigned pk2(float lo, float hi) { f32x2 v = {lo, hi}; return __builtin_bit_cast(unsigned, __builtin_convertvector(v, bf16x2v)); }
__device__ __forceinline__ float bf_lo(unsigned w) { return __uint_as_float(w << 16); }
__device__ __forceinline__ float bf_hi(unsigned w) { return __uint_as_float(w & 0xffff0000u); }
typedef _Float16 f16x2v __attribute__((ext_vector_type(2)));
__device__ __forceinline__ unsigned pk2h(float lo, float hi) { f32x2 v = {lo, hi}; return __builtin_bit_cast(unsigned, __builtin_convertvector(v, f16x2v)); }
__device__ __forceinline__ float hf_lo(unsigned w) { return (float)__builtin_bit_cast(f16x2v, w)[0]; }
__device__ __forceinline__ float hf_hi(unsigned w) { return (float)__builtin_bit_cast(f16x2v, w)[1]; }
__device__ __forceinline__ float wave_sum(float v) {
#pragma unroll
    for (int o = 1; o < 64; o <<= 1) v += __shfl_xor(v, o);
    return v;
}
__device__ __forceinline__ float wave_max(float v) {
#pragma unroll
    for (int o = 1; o < 64; o <<= 1) v = fmaxf(v, __shfl_xor(v, o));
    return v;
}
namespace pg8 {
#define PG8_LAS __attribute__((address_space(3)))
typedef unsigned short bf16_t;
typedef short bf16x8 __attribute__((ext_vector_type(8)));
typedef float f32x4 __attribute__((ext_vector_type(4)));
typedef unsigned u32x4 __attribute__((ext_vector_type(4)));
constexpr int BM = 256, BK = 64, HALF = 128, HTB = HALF * BK * 2  , STAGE_BYTES = 8 * HTB, NXCD = 8, WGM = 4;

__host__ __device__ __forceinline__ int lds_byte(int r, int c) { const int st = (r >> 4) * 2 + (c >> 5), rr = r & 15, cc = c & 31, ob = rr * 64 + cc * 2; return st * 1024 + (ob ^ (((ob >> 9) & 1) << 5)); }
__host__ __device__ __forceinline__ void stage_rc(int b, int& R, int& C) { const int st = b / 1024, sb = b % 1024, swz = sb ^ (((sb >> 9) & 1) << 5); R = (st >> 1) * 16 + swz / 64; C = (st & 1) * 32 + (swz % 64) / 2; }
__host__ __device__ __forceinline__ int perm32(int rho) { const int n = rho >> 4, i = rho & 15; return 8 * (i >> 2) + 4 * n + (i & 3); }

struct Unit { int pm, pn, kk; };
struct Gemm { const bf16_t* A; const bf16_t* Bt; int M, N, K, ld; };

struct PanelOrder {
    int nM, nN, nwg, G, c, nMain, pm0, pmx;
    __device__ void init(int nMain_, int pm0_, int extra, int pmx_, int N, int G_, int c_) { nMain = nMain_; pm0 = pm0_; pmx = pmx_; nM = nMain_ + extra; nN = N / BM; nwg = nM * nN; G = G_; c = c_; }
    __device__ bool next(int i, Unit& u) const {
        const long L = (long)i * G + c; if (L >= nwg) return false;
        int wgid = (int)L; { const int q = nwg / NXCD, r = nwg % NXCD, xcd = wgid % NXCD, off = wgid / NXCD; wgid = (xcd < r ? xcd * (q + 1) : r * (q + 1) + (xcd - r) * q) + off; }
        const int nig = WGM * nN, gid = wgid / nig, fm = gid * WGM, gsz = (nM - fm) < WGM ? (nM - fm) : WGM;
        const int pl = fm + ((wgid % nig) % gsz); u.pm = pl < nMain ? pm0 + pl : pmx; u.pn = (wgid % nig) / gsz; u.kk = 0; return true;
    }
    __device__ __forceinline__ void a_ready(const Unit&) const {}
    __device__ __forceinline__ void done(const Unit&) const {}
};

struct SplitOrder {
    int pm, nN, nwg, G, c;
    __device__ void init(int pm_, int N, int nsplit, int G_, int c_) { pm = pm_; nN = N / BM; nwg = nN * nsplit; G = G_; c = c_; }
    __device__ bool next(int i, Unit& u) const { const int L = i * G + c; if (L >= nwg) return false; u.pm = pm; u.pn = L % nN; u.kk = L / nN; return true; }
    __device__ __forceinline__ void a_ready(const Unit&) const {}
    __device__ __forceinline__ void done(const Unit&) const {}
};

__device__ __forceinline__ u32x4 pack8(const f32x4 v0, const f32x4 v1) { u32x4 w; w.x = pk2(v0[0], v0[1]); w.y = pk2(v0[2], v0[3]); w.z = pk2(v1[0], v1[1]); w.w = pk2(v1[2], v1[3]); return w; }

struct EpiBf16G {
    static constexpr bool PERM = true, AFTER_DRAIN = false, PERMA = false;
    bf16_t* O; int ldc; const float* rs; int pm_sub, pm_sp, pm_sp_out;
    __device__ __forceinline__ void operator()(const f32x4 (&acc)[2][2][4][2], const Unit& u, int wr, int wc, int fr, int fq) const {
        const int opm = (u.pm == pm_sp) ? pm_sp_out : u.pm - pm_sub;
        const int rin = u.pm * BM + wr * 64 + fr, rout = opm * BM + wr * 64 + fr, col0 = u.pn * BM + wc * 32 + 8 * fq;
#pragma unroll
        for (int ai = 0; ai < 2; ++ai)
#pragma unroll
            for (int m = 0; m < 4; ++m) { const float sc = rs ? rs[(size_t)(rin + ai * HALF + m * 16) * 2] : 1.f;
                bf16_t* rowp = O + (size_t)(rout + ai * HALF + m * 16) * ldc + col0;
#pragma unroll
                for (int bj = 0; bj < 2; ++bj) *(u32x4*)(rowp + bj * HALF) = pack8(acc[ai][bj][m][0] * sc, acc[ai][bj][m][1] * sc); }
    }
};
struct EpiWin {
    static constexpr bool PERM = true, AFTER_DRAIN = false, PERMA = false;
    bf16_t *UQKVO, *UDQ, *UDKV, *KR; float* GATES; const float *COS, *SIN;
    __device__ __forceinline__ void operator()(const f32x4 (&acc)[2][2][4][2], const Unit& u, int wr, int wc, int fr, int fq) const {
        const int row0 = u.pm * BM + wr * 64 + fr;
        if (u.pn < 19) {
            bf16_t* base; int ldc, colt;
            if (u.pn < 16) { base = UQKVO; ldc = 4096; colt = u.pn * BM; } else if (u.pn < 18) { base = UDQ; ldc = 512; colt = (u.pn - 16) * BM; } else { base = UDKV; ldc = 256; colt = 0; }
            const int col0 = colt + wc * 32 + 8 * fq;
#pragma unroll
            for (int ai = 0; ai < 2; ++ai)
#pragma unroll
                for (int m = 0; m < 4; ++m) { bf16_t* rowp = base + (size_t)(row0 + ai * HALF + m * 16) * ldc + col0;
#pragma unroll
                    for (int bj = 0; bj < 2; ++bj) *(u32x4*)(rowp + bj * HALF) = pack8(acc[ai][bj][m][0], acc[ai][bj][m][1]); }
        } else {
            if (wc < 2) { const int g = 4 * wc + fq;
#pragma unroll
                for (int ai = 0; ai < 2; ++ai)
#pragma unroll
                    for (int m = 0; m < 4; ++m) { const int row = row0 + ai * HALF + m * 16, pos = pos_of_row(row);
                        const f32x4 cs = *(const f32x4*)(COS + pos * 32 + 4 * g), sn = *(const f32x4*)(SIN + pos * 32 + 4 * g);
                        const f32x4 x1 = acc[ai][0][m][0], x2 = acc[ai][0][m][1];
                        *(u32x4*)(KR + (size_t)row * 64 + 8 * g) = pack8(x1 * cs - x2 * sn, x1 * sn + x2 * cs); }
            } else if (wc == 2 && fq < 2) {
#pragma unroll
                for (int ai = 0; ai < 2; ++ai)
#pragma unroll
                    for (int m = 0; m < 4; ++m) { float* gp = GATES + (size_t)(row0 + ai * HALF + m * 16) * 16 + 8 * fq;
                        *(f32x4*)gp = acc[ai][0][m][0]; *(f32x4*)(gp + 4) = acc[ai][0][m][1]; }
            }
        }
    }
};
struct EpiQ {
    static constexpr bool PERM = true, AFTER_DRAIN = false, PERMA = false;
    bf16_t* MQ; const float *RSTD, *COS, *SIN;
    __device__ __forceinline__ void operator()(const f32x4 (&acc)[2][2][4][2], const Unit& u, int wr, int wc, int fr, int fq) const {
        const int row0 = u.pm * BM + wr * 64 + fr, colb = u.pn * BM + wc * 32 + 8 * fq;
#pragma unroll
        for (int ai = 0; ai < 2; ++ai)
#pragma unroll
            for (int m = 0; m < 4; ++m) { const int row = row0 + ai * HALF + m * 16, pos = pos_of_row(row); const float sc = RSTD[(size_t)row * 2] * 0.10411754961539605f;
#pragma unroll
                for (int bj = 0; bj < 2; ++bj) { const int col0 = colb + bj * HALF, o = col0 % 192;
                    f32x4 v0 = acc[ai][bj][m][0] * sc, v1 = acc[ai][bj][m][1] * sc;
                    if (o >= 128) { const int g = (o - 128) >> 3; const f32x4 cs = *(const f32x4*)(COS + pos * 32 + 4 * g), sn = *(const f32x4*)(SIN + pos * 32 + 4 * g);
                        const f32x4 x1 = v0, x2 = v1; v0 = x1 * cs - x2 * sn; v1 = x1 * sn + x2 * cs; }
                    *(u32x4*)(MQ + (size_t)row * NQ + col0) = pack8(v0, v1); } }
    }
};
__device__ __forceinline__ void resid_ln_tile(float* __restrict__ Cw, const float* __restrict__ Cr, const float* __restrict__ st, const float* __restrict__ g, const float* __restrict__ b,
                                              int ldc, float alpha, const f32x4 (&acc)[2][2][4][2], int row0, int col0) {
    asm volatile("" ::: "memory");
#pragma unroll
    for (int ai = 0; ai < 2; ++ai)
#pragma unroll
        for (int bj = 0; bj < 2; ++bj) {
            f32x4 gv[2], bv[2], hv[4][2]; f32x2 ms[4];
#pragma unroll
            for (int n = 0; n < 2; ++n) { gv[n] = *(const f32x4*)(g + col0 + bj * HALF + n * 16) * alpha; bv[n] = *(const f32x4*)(b + col0 + bj * HALF + n * 16) * alpha; }
#pragma unroll
            for (int m = 0; m < 4; ++m) { const int row = row0 + ai * HALF + m * 16; ms[m] = *(const f32x2*)(st + (size_t)row * 2);
#pragma unroll
                for (int n = 0; n < 2; ++n) hv[m][n] = *(const f32x4*)(Cr + (size_t)row * ldc + col0 + bj * HALF + n * 16); }
#pragma unroll
            for (int m = 0; m < 4; ++m) { const int row = row0 + ai * HALF + m * 16;
#pragma unroll
                for (int n = 0; n < 2; ++n) *(f32x4*)(Cw + (size_t)row * ldc + col0 + bj * HALF + n * 16) = (hv[m][n] - ms[m][0]) * ms[m][1] * gv[n] + bv[n] + acc[ai][bj][m][n]; }
        }
}
__device__ __forceinline__ void resid_ln_tile_bf(bf16_t* __restrict__ Cw, const bf16_t* __restrict__ Cr, const float* __restrict__ st, const float* __restrict__ g, const float* __restrict__ b,
                                                 int ldc, float alpha, const f32x4 (&acc)[2][2][4][2], int row0, int col0) {
    asm volatile("" ::: "memory");
    f32x4 gv[2][2], bv[2][2];
#pragma unroll
    for (int bj = 0; bj < 2; ++bj)
#pragma unroll
        for (int n = 0; n < 2; ++n) { gv[bj][n] = *(const f32x4*)(g + col0 + bj * HALF + n * 4); bv[bj][n] = *(const f32x4*)(b + col0 + bj * HALF + n * 4); }
#pragma unroll
    for (int ai = 0; ai < 2; ++ai) {
        u32x4 hv[2][4]; f32x2 ms[4];
#pragma unroll
        for (int m = 0; m < 4; ++m) { const int row = row0 + ai * HALF + m * 16; ms[m] = *(const f32x2*)(st + (size_t)row * 2);
#pragma unroll
            for (int bj = 0; bj < 2; ++bj) hv[bj][m] = *(const u32x4*)(Cr + (size_t)row * ldc + col0 + bj * HALF); }
#pragma unroll
        for (int bj = 0; bj < 2; ++bj)
#pragma unroll
            for (int m = 0; m < 4; ++m) { const int row = row0 + ai * HALF + m * 16; const u32x4 h = hv[bj][m]; const float mean = ms[m][0], rstd = ms[m][1];
                const f32x4 h0 = {hf_lo(h.x), hf_hi(h.x), hf_lo(h.y), hf_hi(h.y)}, h1 = {hf_lo(h.z), hf_hi(h.z), hf_lo(h.w), hf_hi(h.w)};
                const f32x4 o0 = ((h0 - mean) * rstd * gv[bj][0] + bv[bj][0]) * alpha + acc[ai][bj][m][0], o1 = ((h1 - mean) * rstd * gv[bj][1] + bv[bj][1]) * alpha + acc[ai][bj][m][1];
                u32x4 w; w.x = pk2h(o0[0], o0[1]); w.y = pk2h(o0[2], o0[3]); w.z = pk2h(o1[0], o1[1]); w.w = pk2h(o1[2], o1[3]);
                *(u32x4*)(Cw + (size_t)row * ldc + col0 + bj * HALF) = w; }
    }
}
struct EpiResidLn {
    static constexpr bool PERM = true, AFTER_DRAIN = false, PERMA = false;
    bf16_t* C; int ldc; float alpha; const float* st; const float* g; const float* b;
    __device__ __forceinline__ void operator()(const f32x4 (&acc)[2][2][4][2], const Unit& u, int wr, int wc, int fr, int fq) const {
        resid_ln_tile_bf(this->C, this->C, this->st, this->g, this->b, this->ldc, this->alpha, acc, u.pm * BM + wr * 64 + fr, u.pn * BM + wc * 32 + 8 * fq);
    }
};
struct EpiPart {
    static constexpr bool PERM = false, AFTER_DRAIN = false, PERMA = false;
    float* P; int ldc;
    __device__ __forceinline__ void operator()(const f32x4 (&acc)[2][2][4][2], const Unit& u, int wr, int wc, int fr, int fq) const {
        const int row0 = u.kk * BM + wr * 64 + fr, col0 = u.pn * BM + wc * 32 + 4 * fq;
#pragma unroll
        for (int ai = 0; ai < 2; ++ai)
#pragma unroll
            for (int m = 0; m < 4; ++m) { float* rowp = P + (size_t)(row0 + ai * HALF + m * 16) * ldc + col0;
#pragma unroll
                for (int bj = 0; bj < 2; ++bj)
#pragma unroll
                    for (int n = 0; n < 2; ++n) *(f32x4*)(rowp + bj * HALF + n * 16) = acc[ai][bj][m][n]; }
    }
};

__device__ __forceinline__ float dpp_shr1_old(float old, float x) { return __int_as_float(__builtin_amdgcn_update_dpp(__float_as_int(old), __float_as_int(x), 0x111, 0xf, 0xf, false)); }
__device__ __forceinline__ float dpp_shl1_old(float old, float x) { return __int_as_float(__builtin_amdgcn_update_dpp(__float_as_int(old), __float_as_int(x), 0x101, 0xf, 0xf, false)); }
struct EpiFfn {
    static constexpr bool PERM = true, AFTER_DRAIN = false, PERMA = true;
    bf16_t* ACT; float* SIDE; bf16_t* GVM; const float *cw, *cb; PG8_LAS float* X;
    __device__ __forceinline__ void operator()(const f32x4 (&acc)[2][2][4][2], const Unit& u, int wr_in, int wc_in, int fr_in, int fq_in) const {
        int fr = fr_in, fq = fq_in, wr = wr_in, wc = wc_in; asm volatile("" : "+v"(fr), "+v"(fq), "+s"(wr), "+s"(wc));
        const int cj = wc * 32 + 8 * fq, c0 = u.pn * 128 + cj;
        if (u.pm == PMETA) {
#pragma unroll
            for (int ai = 0; ai < 2; ++ai)
#pragma unroll
                for (int m = 0; m < 4; ++m) { bf16_t* rowp = GVM + (size_t)(ai * HALF + wr * 64 + 4 * fr + m) * NUP + c0;
                    *(u32x4*)rowp = pack8(acc[ai][0][m][0], acc[ai][0][m][1]); *(u32x4*)(rowp + DFF) = pack8(acc[ai][1][m][0], acc[ai][1][m][1]); }
            return;
        }
        f32x4 w0[2], w1[2], w2[2], bb[2];
#pragma unroll
        for (int n = 0; n < 2; ++n) { w0[n] = *(const f32x4*)(cw + c0 + 4 * n); w1[n] = *(const f32x4*)(cw + DFF + c0 + 4 * n); w2[n] = *(const f32x4*)(cw + 2 * DFF + c0 + 4 * n); bb[n] = *(const f32x4*)(cb + c0 + 4 * n); }
#pragma unroll
        for (int ai = 0; ai < 2; ++ai) { const int b = 2 * ai + wr;
            if (fr == 0) { *(PG8_LAS f32x4*)(X + (b * 2 + 0) * 128 + cj) = acc[ai][0][0][0]; *(PG8_LAS f32x4*)(X + (b * 2 + 0) * 128 + cj + 4) = acc[ai][0][0][1]; }
            if (fr == 15) { *(PG8_LAS f32x4*)(X + (b * 2 + 1) * 128 + cj) = acc[ai][0][3][0]; *(PG8_LAS f32x4*)(X + (b * 2 + 1) * 128 + cj + 4) = acc[ai][0][3][1]; } }
        asm volatile("s_waitcnt lgkmcnt(0)" ::: "memory"); __builtin_amdgcn_s_barrier(); asm volatile("" ::: "memory");
        const unsigned rowb = (unsigned)(u.pm * BM + wr * 64 + 4 * fr) * DFF + c0;
#pragma unroll
        for (int ai = 0; ai < 2; ++ai) { const int b = 2 * ai + wr;
            f32x4 xp[2], xn[2];
#pragma unroll
            for (int n = 0; n < 2; ++n) { xp[n] = b > 0 ? *(const PG8_LAS f32x4*)(X + ((b - 1) * 2 + 1) * 128 + cj + 4 * n) : (f32x4){0.f, 0.f, 0.f, 0.f};
                                          xn[n] = b < 3 ? *(const PG8_LAS f32x4*)(X + ((b + 1) * 2 + 0) * 128 + cj + 4 * n) : (f32x4){0.f, 0.f, 0.f, 0.f}; }
            f32x4 up0[2], dn3[2];
#pragma unroll
            for (int n = 0; n < 2; ++n)
#pragma unroll
                for (int e = 0; e < 4; ++e) { up0[n][e] = dpp_shr1_old(xp[n][e], acc[ai][0][3][n][e]); dn3[n][e] = dpp_shl1_old(xn[n][e], acc[ai][0][0][n][e]); }
#pragma unroll
            for (int m = 0; m < 4; ++m) { u32x4 ow;
#pragma unroll
                for (int n = 0; n < 2; ++n) {
                    const f32x4 g = acc[ai][0][m][n], pv = m > 0 ? acc[ai][0][m > 0 ? m - 1 : 0][n] : up0[n], nx = m < 3 ? acc[ai][0][m < 3 ? m + 1 : 3][n] : dn3[n];
                    const f32x4 x = w0[n] * pv + w1[n] * g + w2[n] * nx + bb[n]; f32x4 t, o;
#pragma unroll
                    for (int e = 0; e < 4; ++e) t[e] = __expf(-x[e]);
                    t = t + 1.f;
#pragma unroll
                    for (int e = 0; e < 4; ++e) t[e] = __builtin_amdgcn_rcpf(t[e]);
                    o = x * t * acc[ai][1][m][n];
                    if (n == 0) { ow.x = pk2(o[0], o[1]); ow.y = pk2(o[2], o[3]); } else { ow.z = pk2(o[0], o[1]); ow.w = pk2(o[2], o[3]); } }
                bf16_t* dst = ACT + (rowb + (unsigned)(ai * HALF + m) * DFF);
                if (ai == 0 ? m < 2 : m >= 2) {
                    const int r = ai * HALF + wr * 64 + 4 * fr + m;
                    if (r != 0 && r != 255) *(u32x4*)dst = ow;
                    const int slot = r == 0 ? 0 : r == 1 ? 1 : r == 254 ? 2 : r == 255 ? 3 : -1;
                    if (slot >= 0) { float* sp = SIDE + ((size_t)u.pm * 6 + slot) * DFF + c0; *(f32x4*)sp = acc[ai][0][m][0]; *(f32x4*)(sp + 4) = acc[ai][0][m][1];
                        if (slot == 0 || slot == 3) { float* vp = SIDE + ((size_t)u.pm * 6 + (slot == 0 ? 4 : 5)) * DFF + c0; *(f32x4*)vp = acc[ai][1][m][0]; *(f32x4*)(vp + 4) = acc[ai][1][m][1]; } }
                } else *(u32x4*)dst = ow;
            }
        }
    }
};
template <class Epi, class Sched, bool ALIGN_EPI = false, bool SP2 = false>
__device__ __forceinline__ void gemm_phase(PG8_LAS unsigned char* lds, const Gemm g, const Sched& S, const Epi& E) {
    int tid_ = threadIdx.x; asm volatile("" : "+v"(tid_));
    const int tid = tid_, wid = __builtin_amdgcn_readfirstlane(tid >> 6), lane = tid & 63, wr = wid >> 2, wc = wid & 3, fr = lane & 15, fq = lane >> 4;
    const int K = g.ld, nt = g.K / BK;
    unsigned voffA[2], voffB[2];
#pragma unroll
    for (int i = 0; i < 2; ++i) { int R, C; stage_rc(tid * 16 + i * 8192, R, C); const int Rb = Epi::PERM ? ((R & ~31) + perm32(R & 31)) : R;
        const int Ra = Epi::PERMA ? ((R & ~63) | ((R & 15) << 2) | ((R >> 4) & 3)) : R;
        voffA[i] = (unsigned)(Ra * K + C) * 2u; voffB[i] = (unsigned)(Rb * K + C) * 2u; }
    const size_t kstep = (size_t)(BK * 2);
    const size_t hstep = (size_t)HALF * K * 2;
    const size_t tstep = 2 * hstep;
    const unsigned ldsw = (unsigned)wid * 1024u;
    const int aoff = lds_byte(wr * 64 + fr, fq * 8), boff = lds_byte(wc * 32 + fr, fq * 8);
#define PG8_SA(b, h) (((b) * 2 + (h)) * HTB)
#define PG8_SB(b, h) ((4 + (b) * 2 + (h)) * HTB)
#define PG8_STAGE(bufoff, gbase, voff) do { _Pragma("unroll") for (int _i = 0; _i < 2; ++_i) \
        __builtin_amdgcn_global_load_lds((const unsigned*)((const char*)(gbase) + (voff)[_i]), (PG8_LAS unsigned*)(lds + (bufoff) + ldsw + _i * 8192), 16, 0, 0); } while (0)
#define PG8_LDA(dst, b, h) do { _Pragma("unroll") for (int m = 0; m < 4; ++m) _Pragma("unroll") for (int k = 0; k < 2; ++k) dst[m][k] = *(const PG8_LAS bf16x8*)(lds + PG8_SA(b, h) + aoff + m * 2048 + k * 1024); } while (0)
#define PG8_LDB(dst, b, h) do { _Pragma("unroll") for (int n = 0; n < 2; ++n) _Pragma("unroll") for (int k = 0; k < 2; ++k) dst[n][k] = *(const PG8_LAS bf16x8*)(lds + PG8_SB(b, h) + boff + n * 2048 + k * 1024); } while (0)
#define PG8_MMA(ai, bj, At, Bt) do { __builtin_amdgcn_s_setprio(1); _Pragma("unroll") for (int m = 0; m < 4; ++m) _Pragma("unroll") for (int n = 0; n < 2; ++n) _Pragma("unroll") for (int k = 0; k < 2; ++k) \
        acc[ai][bj][m][n] = __builtin_amdgcn_mfma_f32_16x16x32_bf16(Bt[n][k], At[m][k], acc[ai][bj][m][n], 0, 0, 0); __builtin_amdgcn_s_setprio(0); } while (0)
#define PG8_WAIT_V(n) asm volatile("s_waitcnt vmcnt(" #n ")" ::: "memory")
#define PG8_WAIT_L(n) asm volatile("s_waitcnt lgkmcnt(" #n ")" ::: "memory")
#define PG8_BAR __builtin_amdgcn_s_barrier()
#define PG8_SCHED __builtin_amdgcn_sched_barrier(0)
    Unit cur, nxt; int ui = 0;
    if (!S.next(0, cur)) return;
    f32x4 acc[2][2][4][2];
#pragma unroll
    for (int a = 0; a < 2; ++a)
#pragma unroll
        for (int b = 0; b < 2; ++b)
#pragma unroll
            for (int m = 0; m < 4; ++m)
#pragma unroll
                for (int n = 0; n < 2; ++n) acc[a][b][m][n] = (f32x4){0.f, 0.f, 0.f, 0.f};
    bf16x8 At[4][2], B0[2][2], B1[2][2];
    const size_t sstep = (size_t)g.K * 2;
    const char* cA = (const char*)g.A + (size_t)cur.pm * tstep + (size_t)cur.kk * sstep; const char* cB = (const char*)g.Bt + (size_t)cur.pn * tstep + (size_t)cur.kk * sstep;
    S.a_ready(cur);
    if constexpr (SP2) {
        PG8_STAGE(PG8_SB(0, 0), cB, voffB); PG8_STAGE(PG8_SB(0, 1), cB + hstep, voffB); PG8_STAGE(PG8_SA(0, 0), cA, voffA); PG8_STAGE(PG8_SA(0, 1), cA + hstep, voffA);
        if (wr == 1) PG8_BAR;
        PG8_WAIT_V(2); PG8_BAR;
        PG8_STAGE(PG8_SB(1, 0), cB + kstep, voffB); PG8_STAGE(PG8_SA(1, 0), cA + kstep, voffA); PG8_STAGE(PG8_SB(1, 1), cB + hstep + kstep, voffB);
        PG8_WAIT_V(6); PG8_BAR;
    } else {
        PG8_STAGE(PG8_SB(0, 0), cB, voffB); PG8_STAGE(PG8_SA(0, 0), cA, voffA); PG8_STAGE(PG8_SB(0, 1), cB + hstep, voffB); PG8_STAGE(PG8_SA(0, 1), cA + hstep, voffA);
        if (wr == 1) PG8_BAR;
        PG8_WAIT_V(4); PG8_BAR;
        PG8_STAGE(PG8_SB(1, 0), cB + kstep, voffB); PG8_STAGE(PG8_SA(1, 0), cA + kstep, voffA); PG8_STAGE(PG8_SB(1, 1), cB + hstep + kstep, voffB);
        PG8_WAIT_V(6); PG8_BAR;
    }
    for (;;) {
        const bool has_next = S.next(ui + 1, nxt);
        const char* nA = has_next ? (const char*)g.A + (size_t)nxt.pm * tstep + (size_t)nxt.kk * sstep : cA; const char* nB = has_next ? (const char*)g.Bt + (size_t)nxt.pn * tstep + (size_t)nxt.kk * sstep : cB;
        for (int t = 0; t < nt; t += 2) {
            const bool last = (t == nt - 2);
            const char* a1 = cA + (size_t)(t + 1) * kstep;
            const char* a2 = last ? nA : cA + (size_t)(t + 2) * kstep; const char* b2 = last ? nB : cB + (size_t)(t + 2) * kstep;
            const char* a3 = a2 + kstep; const char* b3 = b2 + kstep;
            if (last && has_next) S.a_ready(nxt);
            if constexpr (SP2) {
            PG8_LDB(B0, 0, 0); PG8_LDB(B1, 0, 1); PG8_SCHED; PG8_LDA(At, 0, 0); PG8_STAGE(PG8_SA(1, 1), a1 + hstep, voffA);
            PG8_WAIT_V(8); PG8_WAIT_L(0); PG8_BAR; PG8_MMA(0, 0, At, B0); PG8_MMA(0, 1, At, B1); PG8_BAR; PG8_SCHED;
            PG8_LDA(At, 0, 1); PG8_STAGE(PG8_SB(0, 0), b2, voffB); PG8_STAGE(PG8_SB(0, 1), b2 + hstep, voffB); PG8_STAGE(PG8_SA(0, 0), a2, voffA);
            PG8_WAIT_V(8); PG8_WAIT_L(0); PG8_BAR; PG8_MMA(1, 0, At, B0); PG8_MMA(1, 1, At, B1); PG8_BAR; PG8_SCHED;
            PG8_LDB(B0, 1, 0); PG8_LDB(B1, 1, 1); PG8_SCHED; PG8_LDA(At, 1, 0); PG8_STAGE(PG8_SA(0, 1), a2 + hstep, voffA);
            PG8_WAIT_V(8); PG8_WAIT_L(0); PG8_BAR; PG8_MMA(0, 0, At, B0); PG8_MMA(0, 1, At, B1); PG8_BAR; PG8_SCHED;
            PG8_LDA(At, 1, 1); PG8_STAGE(PG8_SB(1, 0), b3, voffB); PG8_STAGE(PG8_SB(1, 1), b3 + hstep, voffB); PG8_STAGE(PG8_SA(1, 0), a3, voffA);
            PG8_WAIT_V(8); PG8_WAIT_L(0); PG8_BAR; PG8_MMA(1, 0, At, B0); PG8_MMA(1, 1, At, B1); PG8_BAR; PG8_SCHED;
            } else {
            PG8_LDB(B0, 0, 0); PG8_SCHED; PG8_LDA(At, 0, 0); PG8_STAGE(PG8_SA(1, 1), a1 + hstep, voffA);
            PG8_WAIT_L(8); PG8_BAR; PG8_WAIT_L(0); PG8_MMA(0, 0, At, B0); PG8_BAR; PG8_SCHED;
            PG8_LDB(B1, 0, 1); PG8_STAGE(PG8_SB(0, 0), b2, voffB);
            PG8_BAR; PG8_WAIT_L(0); PG8_MMA(0, 1, At, B1); PG8_BAR;
            PG8_LDA(At, 0, 1); PG8_STAGE(PG8_SA(0, 0), a2, voffA);
            PG8_BAR; PG8_WAIT_L(0); PG8_MMA(1, 0, At, B0); PG8_BAR; PG8_SCHED;
            PG8_STAGE(PG8_SB(0, 1), b2 + hstep, voffB);
            PG8_WAIT_V(6); PG8_BAR; PG8_MMA(1, 1, At, B1); PG8_BAR;
            PG8_LDB(B0, 1, 0); PG8_SCHED; PG8_LDA(At, 1, 0); PG8_STAGE(PG8_SA(0, 1), a2 + hstep, voffA);
            PG8_WAIT_L(8); PG8_BAR; PG8_WAIT_L(0); PG8_MMA(0, 0, At, B0); PG8_BAR; PG8_SCHED;
            PG8_LDB(B1, 1, 1); PG8_STAGE(PG8_SB(1, 0), b3, voffB);
            PG8_BAR; PG8_WAIT_L(0); PG8_MMA(0, 1, At, B1); PG8_BAR;
            PG8_LDA(At, 1, 1); PG8_STAGE(PG8_SA(1, 0), a3, voffA);
            PG8_BAR; PG8_WAIT_L(0); PG8_MMA(1, 0, At, B0); PG8_BAR; PG8_SCHED;
            PG8_STAGE(PG8_SB(1, 1), b3 + hstep, voffB);
            PG8_WAIT_V(6); PG8_BAR; PG8_MMA(1, 1, At, B1); PG8_BAR;
            }
        }
        if constexpr (ALIGN_EPI) { if (wr == 0) PG8_BAR; }
        if constexpr (!Epi::AFTER_DRAIN) { E(acc, cur, wr, wc, fr, fq); S.done(cur); }
        if (!has_next) break;
#pragma unroll
        for (int a = 0; a < 2; ++a)
#pragma unroll
            for (int b = 0; b < 2; ++b)
#pragma unroll
                for (int m = 0; m < 4; ++m)
#pragma unroll
                    for (int n = 0; n < 2; ++n) acc[a][b][m][n] = (f32x4){0.f, 0.f, 0.f, 0.f};
        cur = nxt; cA = nA; cB = nB; ++ui;
        if constexpr (ALIGN_EPI) { if (wr == 1) PG8_BAR; }
    }
    PG8_WAIT_V(0);
    if constexpr (!ALIGN_EPI) { if (wr == 0) PG8_BAR; }
    PG8_BAR;
    if constexpr (Epi::AFTER_DRAIN) { E.fused(acc, cur, wr, wc, fr, fq, lds, wid, lane); S.done(cur); }
#undef PG8_SA
#undef PG8_SB
#undef PG8_STAGE
#undef PG8_LDA
#undef PG8_LDB
#undef PG8_MMA
#undef PG8_WAIT_V
#undef PG8_WAIT_L
#undef PG8_BAR
#undef PG8_SCHED
}
}
#define XB_TMO      128
#define XB_XCNT(j)  (256  + 64 * (j))
#define XB_XSUB(j)  (1280 + 64 * (j))
#define XB_XGEN(j)  (2304 + 64 * (j))
#define XB_TOP      3328
#define XB_TOPGEN   3392
#define XCD_BAR_WORDS 3456
#define XB_SPIN_CAP (1u << 21)

__device__ __forceinline__ unsigned xb_ld(unsigned* p)              { return __hip_atomic_load(p, __ATOMIC_RELAXED, __HIP_MEMORY_SCOPE_AGENT); }
__device__ __forceinline__ unsigned xb_add(unsigned* p, unsigned v) { return __hip_atomic_fetch_add(p, v, __ATOMIC_RELAXED, __HIP_MEMORY_SCOPE_AGENT); }
__device__ __forceinline__ unsigned xb_xcc_id() { return (unsigned)__builtin_amdgcn_s_getreg((3 << 11) | 20) & 0xFu; }
#define XB_SPIN(cond, bar) do { unsigned _sp = 0; while (cond) { __builtin_amdgcn_s_sleep(1); \
    if ((++_sp & 255u) == 0u) { if (xb_ld(&(bar)[XB_TMO])) break; if (_sp > XB_SPIN_CAP) { atomicAdd(&(bar)[XB_TMO], 1u); break; } } } } while (0)

struct XcdBarrier {
    unsigned* bar; unsigned x;
    volatile LAS unsigned* st;
};

__device__ __forceinline__ XcdBarrier xcd_barrier_post(unsigned* bar, volatile LAS unsigned* st) {
    XcdBarrier b; b.bar = bar; b.x = (unsigned)__builtin_amdgcn_readfirstlane((int)xb_xcc_id()); b.st = st;
    if (threadIdx.x == 0) (void)xb_add(&bar[XB_XCNT(b.x)], 1u);
    return b;
}
__device__ __forceinline__ void xcd_barrier_complete(unsigned* bar, unsigned x, unsigned& nloc, unsigned& nx) {
    const unsigned G = gridDim.x * gridDim.y * gridDim.z;
    unsigned sum, cnt, mine, sp = 0u;
    for (;;) {
        sum = 0u; cnt = 0u; mine = 0u;
#pragma unroll
        for (unsigned j = 0; j < 16; ++j) { const unsigned c = xb_ld(&bar[XB_XCNT(j)]); sum += c; cnt += (c > 0u) ? 1u : 0u; }
        mine = xb_ld(&bar[XB_XCNT(x)]);
        if (sum == G) { mine = xb_ld(&bar[XB_XCNT(x)]); break; }
        __builtin_amdgcn_s_sleep(1);
        if ((++sp & 255u) == 0u) { if (xb_ld(&bar[XB_TMO])) break; if (sp > XB_SPIN_CAP) { atomicAdd(&bar[XB_TMO], 1u); break; } }
    }
    nloc = mine > 0u ? mine : 1u; nx = cnt > 0u ? cnt : 1u;
}

__device__ __forceinline__ void xcd_barrier(const XcdBarrier& b) {
    asm volatile("s_waitcnt vmcnt(0)" ::: "memory");
    __syncthreads();
    if (threadIdx.x == 0) {
        unsigned* bar = b.bar; unsigned bx_ = b.x;
        asm volatile("" : "+s"(bx_));
        __builtin_amdgcn_s_waitcnt(0);
        unsigned nloc = b.st[0], nx = b.st[1];
        if (nloc == 0u) { xcd_barrier_complete(bar, bx_, nloc, nx); b.st[0] = nloc; b.st[1] = nx; }
        const unsigned old = xb_add(&bar[XB_XSUB(bx_)], 1u);
        const unsigned gen = old / nloc;
        if (old + 1u == (gen + 1u) * nloc) {
            __builtin_amdgcn_fence(__ATOMIC_RELEASE, "agent");
            asm volatile("s_waitcnt vmcnt(0)" ::: "memory");
            const unsigned og = xb_add(&bar[XB_TOP], 1u);
            const unsigned tg = og / nx;
            if (og + 1u == (tg + 1u) * nx) xb_add(&bar[XB_TOPGEN], 1u);
            else XB_SPIN(xb_ld(&bar[XB_TOPGEN]) == tg, bar);
            __builtin_amdgcn_fence(__ATOMIC_ACQUIRE, "agent");
            xb_add(&bar[XB_XGEN(bx_)], 1u);
            asm volatile("s_waitcnt vmcnt(0)" ::: "memory");
        } else {
            XB_SPIN(xb_ld(&bar[XB_XGEN(bx_)]) == gen, bar);
            __builtin_amdgcn_fence(__ATOMIC_ACQUIRE, "agent");
            asm volatile("s_waitcnt vmcnt(0)" ::: "memory");
        }
    }
    __syncthreads();
}

typedef unsigned short bf16_t;
typedef short bf16x8 __attribute__((ext_vector_type(8)));
typedef float f32x4 __attribute__((ext_vector_type(4)));
typedef unsigned u32x4 __attribute__((ext_vector_type(4)));
#define LDS_WAIT() asm volatile("s_waitcnt lgkmcnt(0)" ::: "memory")

struct Params {
    const float* in[19];
};
struct Frame {
    LAS unsigned char* lds;
    int tid, lane, wave, G, bx, vcu, gw, ngw;
};
__device__ __forceinline__ const float* uptr(const LAS unsigned long long* t, int k) {
    const unsigned long long v = t[k]; const unsigned lo = __builtin_amdgcn_readfirstlane((unsigned)v), hi = __builtin_amdgcn_readfirstlane((unsigned)(v >> 32));
    return (const float*)(const GAS float*)(((unsigned long long)hi << 32) | lo); }

template <class CMap>
__device__ __forceinline__ void transpose_load(float (&v)[32], const float* W, int Nsrc, const float* ks, int kb, int nb, int lane, CMap cmap) {
    const int k0 = 64 * kb, n0 = 32 * nb; const int sc = cmap(n0 + (lane & 31));
#pragma unroll
    for (int i = 0; i < 32; ++i) { const int kk = 2 * i + (lane >> 5); float x = 0.f; if (sc >= 0) x = W[(size_t)(k0 + kk) * Nsrc + sc]; if (ks) x *= ks[k0 + kk]; v[i] = x; }
}
__device__ __forceinline__ void transpose_store(const float (&v)[32], int K, bf16_t* WT, LAS float* scr, int kb, int nb, int lane) {
    const int k0 = 64 * kb, n0 = 32 * nb;
#pragma unroll
    for (int i = 0; i < 32; ++i) scr[(2 * i + (lane >> 5)) * 33 + (lane & 31)] = v[i];
    LDS_WAIT(); asm volatile("" ::: "memory");
    const int c = lane & 7;
#pragma unroll
    for (int j = 0; j < 4; ++j) { const int n = (lane >> 3) + 8 * j; const LAS float* s = scr + (8 * c) * 33 + n;
        u32x4 o; o.x = pk2(s[0 * 33], s[1 * 33]); o.y = pk2(s[2 * 33], s[3 * 33]); o.z = pk2(s[4 * 33], s[5 * 33]); o.w = pk2(s[6 * 33], s[7 * 33]);
        *(u32x4*)(WT + (size_t)(n0 + n) * K + k0 + 8 * c) = o; }
    LDS_WAIT(); asm volatile("" ::: "memory");
}
template <class CMap>
__device__ __forceinline__ void transpose_matrix(const Frame& F, const float* W, int K, int Nsrc, int Ndst, bf16_t* WT, const float* ks, LAS float* scr, CMap cmap) {
    const int nnb = Ndst / 32, items = (K / 64) * nnb;
    for (int it = F.gw; it < items; it += 2 * F.ngw) { const int it2 = it + F.ngw; float va[32], vb[32];
        transpose_load(va, W, Nsrc, ks, it / nnb, it % nnb, F.lane, cmap);
        if (it2 < items) transpose_load(vb, W, Nsrc, ks, it2 / nnb, it2 % nnb, F.lane, cmap);
        transpose_store(va, K, WT, scr, it / nnb, it % nnb, F.lane);
        if (it2 < items) transpose_store(vb, K, WT, scr, it2 / nnb, it2 % nnb, F.lane); }
}
__device__ __forceinline__ int rope_perm(int m) { const int g = m >> 3, j = m & 7; return j < 4 ? 4 * g + j : 32 + 4 * g + (j - 4); }
struct CMapIn { __device__ int operator()(int n) const {
    if (n < 4096) return n; if (n < 4608) return 4112 + (n - 4096); if (n < 4864) return 4624 + (n - 4608);
    if (n < 4928) return 4880 + rope_perm(n - 4864); if (n < 4944) return 4096 + (n - 4928); return -1; } };
struct CMapQ { __device__ int operator()(int n) const { const int h = n / 192, o = n % 192; return o < 128 ? n : h * 192 + 128 + rope_perm(o - 128); } };
struct CMapUp { __device__ int operator()(int n) const { const int pn = n >> 8, j = n & 255; return j < 128 ? 128 * pn + j : DFF + 128 * pn + (j - 128); } };
struct CMapId { __device__ int operator()(int n) const { return n; } };

__device__ __forceinline__ void convert_weights(const Frame& F, unsigned char* ws_, const LAS unsigned long long* pt, int l, size_t wo, int slot) {
    unsigned char* ws = ws_ + wo;
    LAS float* scr = (LAS float*)(F.lds + F.wave * 8448);
    if (slot != 1) {
        const float* w_in = uptr(pt, 3) + (size_t)l * DM * INC; const float* w_uq = uptr(pt, 8) + (size_t)l * 512 * NQ; const float* w_ukv = uptr(pt, 9) + (size_t)l * 256 * NKV;
        const float* w_out = uptr(pt, 10) + (size_t)l * DM * DM; const float* w_dn = uptr(pt, 16) + (size_t)l * DFF * DM;
        const float* qg = uptr(pt, 6) + (size_t)l * 512; const float* kvg = uptr(pt, 7) + (size_t)l * 256;
        transpose_matrix(F, w_in, DM, INC, NIN, (bf16_t*)(ws + WS_WIN), nullptr, scr, CMapIn());
        transpose_matrix(F, w_uq, 512, NQ, NQ, (bf16_t*)(ws + WS_WUQ), qg, scr, CMapQ());
        transpose_matrix(F, w_ukv, 256, NKV, NKV, (bf16_t*)(ws + WS_WUKV), kvg, scr, CMapId());
        transpose_matrix(F, w_out, DM, DM, DM, (bf16_t*)(ws + WS_WOUT), nullptr, scr, CMapId());
        transpose_matrix(F, w_dn, DFF, DM, DM, (bf16_t*)(ws + WS_WDN), nullptr, scr, CMapId());
    }
    if (slot != 0) { const float* w_up = uptr(pt, 13) + (size_t)l * DM * NUP;
        transpose_matrix(F, w_up, DM, NUP, NUP, (bf16_t*)(ws + WS_WUP), nullptr, scr, CMapUp()); }
}
__device__ __forceinline__ void prologue(const Frame& F, unsigned char* ws, const LAS unsigned long long* pt) {
    float* COS = (float*)(ws + WS_COS); float* SIN = (float*)(ws + WS_SIN);
    for (int i = F.bx * 512 + F.tid; i < 4112 * 32; i += F.G * 512) { const int pos = i >> 5, f = i & 31;
        const float inv = powf(10000.0f, -(float)(2 * f) / 64.0f); const float ang = (float)pos * inv; float s, c; sincosf(ang, &s, &c); COS[i] = c; SIN[i] = s; }
    { float* PAR = (float*)(ws + WS_PAR); const int gt = F.bx * 512 + F.tid, nt = F.G * 512;
      for (int i = gt; i < DEPTH * 16; i += nt) PAR[PO_BG + i] = uptr(pt, 4)[i];
      for (int i = gt; i < DEPTH * 1024; i += nt) PAR[PO_MLG + i] = uptr(pt, 5)[i];
      for (int i = gt; i < DEPTH * 512; i += nt) PAR[PO_QG + i] = uptr(pt, 6)[i];
      for (int i = gt; i < DEPTH * 256; i += nt) PAR[PO_KVG + i] = uptr(pt, 7)[i];
      for (int i = gt; i < 2048; i += nt) { PAR[PO_ONE + i] = 1.f; PAR[PO_ZERO + i] = 0.f; }
      { float* ST2 = (float*)(ws + WS_STAT2); for (int i = gt; i < TP; i += nt) { ST2[2 * i] = 0.f; ST2[2 * i + 1] = 1.f; } }
      for (int i = gt; i < DEPTH * 2048; i += nt) { PAR[PO_L1G + i] = uptr(pt, 11)[i]; PAR[PO_L1B + i] = uptr(pt, 12)[i]; PAR[PO_L2G + i] = uptr(pt, 17)[i]; PAR[PO_L2B + i] = uptr(pt, 18)[i]; }
      for (int i = gt; i < DEPTH * 3 * 5632; i += nt) PAR[PO_CW + i] = uptr(pt, 14)[i];
      for (int i = gt; i < DEPTH * 5632; i += nt) PAR[PO_CB + i] = uptr(pt, 15)[i]; }
    float* H = (float*)(ws + WS_H); bf16_t* HB = (bf16_t*)(ws + WS_HB);
    const float* xp = uptr(pt, 0); const float* xs = uptr(pt, 1); const float* mt = uptr(pt, 2);
    for (int row0 = F.gw; row0 < TP; row0 += 2 * F.ngw) {
        f32x4 v[2][8];
#pragma unroll
        for (int r = 0; r < 2; ++r) { const int row = row0 + r * F.ngw; const float* src = nullptr;
            if (row < 4 * LREAL) src = xp + (size_t)row * DM; else if (row < NMAIN) src = xs + (size_t)(row - 4 * LREAL) * DM; else if (row < NTOK) src = mt + (size_t)((row - NMAIN) & 15) * DM;
#pragma unroll
            for (int j = 0; j < 8; ++j) { v[r][j] = (f32x4){0.f, 0.f, 0.f, 0.f}; if (src) v[r][j] = ((const f32x4*)src)[F.lane + 64 * j]; } }
#pragma unroll
        for (int r = 0; r < 2; ++r) { const int row = row0 + r * F.ngw; if (row < TP) {
            f32x4* hd = (f32x4*)(H + (size_t)row * DM) + F.lane; u32x2* bd = (u32x2*)(HB + (size_t)row * DM) + F.lane; u32x2* hb = (u32x2*)((bf16_t*)H + (size_t)row * DM) + F.lane;
#pragma unroll
            for (int j = 0; j < 8; ++j) { const f32x4 x = v[r][j];
                u32x2 w; w.x = pk2(x[0], x[1]); w.y = pk2(x[2], x[3]); bd[64 * j] = w;
                if (row >= NMAIN) hd[64 * j] = x * ALPHA;
                else { u32x2 wh; wh.x = pk2h(x[0], x[1]); wh.y = pk2h(x[2], x[3]); hb[64 * j] = wh; } } } }
    }
}

__device__ __forceinline__ void ln_one(const f32x4 (&vin)[8], int row, int lane, float* __restrict__ Hw, bf16_t* __restrict__ HB, const float* __restrict__ g, const float* __restrict__ b, float* __restrict__ ST) {
    f32x4 v[8]; float s = 0.f;
#pragma unroll
    for (int j = 0; j < 8; ++j) { v[j] = vin[j]; s += (v[j][0] + v[j][1]) + (v[j][2] + v[j][3]); }
    const float mean = wave_sum(s) * (1.f / DM); float q = 0.f;
#pragma unroll
    for (int j = 0; j < 8; ++j) { v[j] = v[j] - mean; q += (v[j][0] * v[j][0] + v[j][1] * v[j][1]) + (v[j][2] * v[j][2] + v[j][3] * v[j][3]); }
    const float rstd = rsqrtf(wave_sum(q) * (1.f / DM) + EPS);
    if (lane == 0) { f32x2 ms = {mean, rstd}; *(f32x2*)(ST + (size_t)row * 2) = ms; }
    u32x2* bd = (u32x2*)(HB + (size_t)row * DM) + lane; f32x4* hp = (f32x4*)(Hw + (size_t)row * DM) + lane;
#pragma unroll
    for (int j = 0; j < 8; ++j) { const f32x4 gg = ((const f32x4*)g)[lane + 64 * j], bb = ((const f32x4*)b)[lane + 64 * j]; const f32x4 y = v[j] * rstd * gg + bb;
        u32x2 w; w.x = pk2(y[0], y[1]); w.y = pk2(y[2], y[3]); bd[64 * j] = w;
        hp[64 * j] = y * ALPHA; }
}
__device__ __forceinline__ void ln_one_bf(const u32x4 (&vin)[4], int row, int lane, bf16_t* __restrict__ HB, const float* __restrict__ g, const float* __restrict__ b, float* __restrict__ ST, float* __restrict__ out) {
    f32x4 v[8]; float s = 0.f;
#pragma unroll
    for (int j = 0; j < 4; ++j) { v[2 * j] = (f32x4){hf_lo(vin[j].x), hf_hi(vin[j].x), hf_lo(vin[j].y), hf_hi(vin[j].y)}; v[2 * j + 1] = (f32x4){hf_lo(vin[j].z), hf_hi(vin[j].z), hf_lo(vin[j].w), hf_hi(vin[j].w)}; }
#pragma unroll
    for (int j = 0; j < 8; ++j) s += (v[j][0] + v[j][1]) + (v[j][2] + v[j][3]);
    const float mean = wave_sum(s) * (1.f / DM); float q = 0.f;
#pragma unroll
    for (int j = 0; j < 8; ++j) { v[j] = v[j] - mean; q += (v[j][0] * v[j][0] + v[j][1] * v[j][1]) + (v[j][2] * v[j][2] + v[j][3] * v[j][3]); }
    const float rstd = rsqrtf(wave_sum(q) * (1.f / DM) + EPS);
    if (lane == 0) { f32x2 ms = {mean, rstd}; *(f32x2*)(ST + (size_t)row * 2) = ms; }
    u32x4* bd = (u32x4*)(HB + (size_t)row * DM) + lane;
#pragma unroll
    for (int j = 0; j < 4; ++j) { const int c4 = 2 * (lane + 64 * j);
        const f32x4 y0 = v[2 * j] * rstd * ((const f32x4*)g)[c4] + ((const f32x4*)b)[c4], y1 = v[2 * j + 1] * rstd * ((const f32x4*)g)[c4 + 1] + ((const f32x4*)b)[c4 + 1];
        if (out) { f32x4* op = (f32x4*)(out + (size_t)row * DM) + c4; op[0] = y0; op[1] = y1; }
        else bd[64 * j] = pg8::pack8(y0, y1); }
}
__device__ __forceinline__ void ln_rows(const Frame& F, float* H, bf16_t* HB, const float* g, const float* b, float* ST, float* out, const float* PART, int nk) {
    const bf16_t* __restrict__ Hr = (const bf16_t*)H;
    for (int row = F.gw; row < NMAIN; row += 4 * F.ngw) {
        const int row2 = row + F.ngw, row3 = row + 2 * F.ngw, row4 = row + 3 * F.ngw;
        u32x4 va[4], vb[4], vc[4], vd[4];
#pragma unroll
        for (int j = 0; j < 4; ++j) va[j] = ((const u32x4*)(Hr + (size_t)row * DM))[F.lane + 64 * j];
#pragma unroll
        for (int j = 0; j < 4; ++j) vb[j] = ((const u32x4*)(Hr + (size_t)row2 * DM))[F.lane + 64 * j];
#pragma unroll
        for (int j = 0; j < 4; ++j) vc[j] = ((const u32x4*)(Hr + (size_t)row3 * DM))[F.lane + 64 * j];
#pragma unroll
        for (int j = 0; j < 4; ++j) vd[j] = ((const u32x4*)(Hr + (size_t)row4 * DM))[F.lane + 64 * j];
        ln_one_bf(va, row, F.lane, HB, g, b, ST, out);
        ln_one_bf(vb, row2, F.lane, HB, g, b, ST, out);
        ln_one_bf(vc, row3, F.lane, HB, g, b, ST, out);
        ln_one_bf(vd, row4, F.lane, HB, g, b, ST, out);
    }
    if (F.gw < TP - NMAIN) {
        const int row = NMAIN + F.gw; const float* __restrict__ Hm = H; f32x4 va[8];
#pragma unroll
        for (int j = 0; j < 8; ++j) va[j] = ((const f32x4*)(Hm + (size_t)row * DM))[F.lane + 64 * j];
        const float* __restrict__ pp0 = PART + (size_t)F.gw * DM;
        int k = 0;
        for (; k + 4 <= nk; k += 4) {
            f32x4 t[4][8];
#pragma unroll
            for (int q = 0; q < 4; ++q)
#pragma unroll
                for (int j = 0; j < 8; ++j) t[q][j] = ((const f32x4*)(pp0 + (size_t)(k + q) * 256 * DM))[F.lane + 64 * j];
#pragma unroll
            for (int q = 0; q < 4; ++q)
#pragma unroll
                for (int j = 0; j < 8; ++j) va[j] += t[q][j]; }
        for (; k < nk; ++k) {
#pragma unroll
            for (int j = 0; j < 8; ++j) va[j] += ((const f32x4*)(pp0 + (size_t)k * 256 * DM))[F.lane + 64 * j]; }
        ln_one(va, row, F.lane, H, HB, g, b, ST);
    }
}

__device__ __forceinline__ void rstd_rows(const Frame& F, const bf16_t* UDQ, const bf16_t* UDKV, float* RSTD) {
    for (int row = F.gw; row < TP; row += F.ngw) {
        const u32x4 a = ((const u32x4*)(UDQ + (size_t)row * 512))[F.lane]; float s = 0.f;
#pragma unroll
        for (int j = 0; j < 4; ++j) { const float x = bf_lo(a[j]), y = bf_hi(a[j]); s += x * x + y * y; }
        float t = 0.f;
        if (F.lane < 32) { const u32x4 c = ((const u32x4*)(UDKV + (size_t)row * 256))[F.lane];
#pragma unroll
            for (int j = 0; j < 4; ++j) { const float x = bf_lo(c[j]), y = bf_hi(c[j]); t += x * x + y * y; } }
        s = wave_sum(s); t = wave_sum(t);
        if (F.lane == 0) { RSTD[(size_t)row * 2] = rsqrtf(s * (1.f / 512.f) + EPS); RSTD[(size_t)row * 2 + 1] = rsqrtf(t * (1.f / 256.f) + EPS); }
    }
}

__device__ __forceinline__ void mlstm_fin_row(int row, int lane, const f32x4 (&hv)[4], const u32x2 (&ov)[4], const float* __restrict__ ng, bf16_t* __restrict__ MIX) {
#pragma unroll
    for (int j = 0; j < 4; ++j) {
        f32x4 v = hv[j];
        const float mean = wave_sum((v[0] + v[1]) + (v[2] + v[3])) * (1.f / 256.f); v = v - mean;
        const float rstd = rsqrtf(wave_sum((v[0] * v[0] + v[1] * v[1]) + (v[2] * v[2] + v[3] * v[3])) * (1.f / 256.f) + EPS);
        const f32x4 gg = ((const f32x4*)(ng + 256 * j))[lane];
        const u32x2 uo = ov[j];
        const float o0 = bf_lo(uo.x), o1 = bf_hi(uo.x), o2 = bf_lo(uo.y), o3 = bf_hi(uo.y);
        const float y0 = v[0] * rstd * gg[0] / (1.f + __expf(-o0)), y1 = v[1] * rstd * gg[1] / (1.f + __expf(-o1));
        const float y2 = v[2] * rstd * gg[2] / (1.f + __expf(-o2)), y3 = v[3] * rstd * gg[3] / (1.f + __expf(-o3));
        u32x2 w; w.x = pk2(y0, y1); w.y = pk2(y2, y3); ((u32x2*)(MIX + (size_t)row * DM + 256 * j))[lane] = w;
    }
}
__device__ __forceinline__ void mlstm_finalize(const Frame& F, int gw0, int ngw0, const float* HSUM, const bf16_t* UQKVO, const float* ng, bf16_t* MIX) {
    const float* __restrict__ Hs = HSUM; const bf16_t* __restrict__ Uo = UQKVO;
    for (int row = gw0; row < TP; row += 4 * ngw0) {
        int rr[4]; bool ok[4];
#pragma unroll
        for (int q = 0; q < 4; ++q) { const int r = row + q * ngw0; ok[q] = r < TP; rr[q] = ok[q] ? r : row; }
        f32x4 hv[4][4]; u32x2 ov[4][4];
#pragma unroll
        for (int q = 0; q < 4; ++q)
#pragma unroll
            for (int j = 0; j < 4; ++j) { hv[q][j] = ((const f32x4*)(Hs + (size_t)rr[q] * MLW + 256 * j))[F.lane]; ov[q][j] = ((const u32x2*)(Uo + (size_t)rr[q] * 4096 + 3072 + 256 * j))[F.lane]; }
#pragma unroll
        for (int q = 0; q < 4; ++q) if (ok[q]) mlstm_fin_row(rr[q], F.lane, hv[q], ov[q], ng, MIX);
    }
}

__device__ __forceinline__ f32x8 ld8f(const float* p) { const f32x4 a = *(const f32x4*)p, b = *(const f32x4*)(p + 4); return (f32x8){a[0], a[1], a[2], a[3], b[0], b[1], b[2], b[3]}; }
__device__ __forceinline__ f32x8 ld8b(const bf16_t* p) { const u32x4 v = *(const u32x4*)p; return (f32x8){bf_lo(v[0]), bf_hi(v[0]), bf_lo(v[1]), bf_hi(v[1]), bf_lo(v[2]), bf_hi(v[2]), bf_lo(v[3]), bf_hi(v[3])}; }
__device__ __forceinline__ void act_store(bf16_t* dst, const f32x8 gp, const f32x8 gc, const f32x8 gn, const f32x8 vv, const f32x8 w0, const f32x8 w1, const f32x8 w2, const f32x8 bb) {
    float o[8];
#pragma unroll
    for (int i = 0; i < 8; ++i) { const float x = w0[i] * gp[i] + w1[i] * gc[i] + w2[i] * gn[i] + bb[i]; o[i] = x / (1.f + __expf(-x)) * vv[i]; }
    u32x4 w; w.x = pk2(o[0], o[1]); w.y = pk2(o[2], o[3]); w.z = pk2(o[4], o[5]); w.w = pk2(o[6], o[7]); *(u32x4*)dst = w;
}
__device__ __forceinline__ void ffn_fixup(const Frame& F, const float* SIDE, const bf16_t* GVM, bf16_t* ACT, const float* cw, const float* cb) {
    constexpr int NCH = DFF / 8;
    const f32x8 zero = {0.f, 0.f, 0.f, 0.f, 0.f, 0.f, 0.f, 0.f};
    const int gt = F.bx * 512 + F.tid, nt = GRID * 512;
    for (int idx = gt; idx < 192 * 2 * NCH; idx += nt) {
        const int ch = idx % NCH, rsel = (idx / NCH) & 1, pm = idx / (2 * NCH), c0 = 8 * ch, sq = pm >> 4;
        const f32x8 w0 = ld8f(cw + c0), w1 = ld8f(cw + DFF + c0), w2 = ld8f(cw + 2 * DFF + c0), bb = ld8f(cb + c0);
        const float* S0 = SIDE + (size_t)pm * 6 * DFF + c0;
        if (rsel == 0) { const f32x8 gp = (pm & 15) ? ld8f(S0 - 6 * DFF + 3 * DFF) : ld8b(GVM + (size_t)(16 * sq + 15) * NUP + c0);
            act_store(ACT + (size_t)(pm * 256) * DFF + c0, gp, ld8f(S0), ld8f(S0 + DFF), ld8f(S0 + 4 * DFF), w0, w1, w2, bb);
        } else { const f32x8 gn = ((pm & 15) != 15) ? ld8f(S0 + 6 * DFF) : zero;
            act_store(ACT + (size_t)(pm * 256 + 255) * DFF + c0, ld8f(S0 + 2 * DFF), ld8f(S0 + 3 * DFF), gn, ld8f(S0 + 5 * DFF), w0, w1, w2, bb); }
    }
    for (int idx = gt; idx < NSEQ * 16 * NCH; idx += nt) {
        const int ch = idx % NCH, rp = idx / NCH, pp = rp & 15, sq = rp >> 4, c0 = 8 * ch;
        const f32x8 w0 = ld8f(cw + c0), w1 = ld8f(cw + DFF + c0), w2 = ld8f(cw + 2 * DFF + c0), bb = ld8f(cb + c0);
        const bf16_t* G0 = GVM + (size_t)(16 * sq + pp) * NUP + c0;
        const f32x8 gp = pp > 0 ? ld8b(G0 - NUP) : zero, gc = ld8b(G0);
        const f32x8 gn = pp < 15 ? ld8b(G0 + NUP) : ld8f(SIDE + (size_t)(16 * sq) * 6 * DFF + c0);
        act_store(ACT + (size_t)(MROW0 + 16 * sq + pp) * DFF + c0, gp, gc, gn, ld8b(G0 + DFF), w0, w1, w2, bb);
    }
}

namespace att {
constexpr int NW = 8, QBLK = 32, KVBLK = 64, NT = 65;
constexpr int KROW = 400;
constexpr int SHM_V = KVBLK * 128 * 2, SHM_K = KVBLK * KROW;
constexpr int OFF_V = 0, OFF_K = 3 * SHM_V, OFF_WS = OFF_K + 3 * SHM_K, LDS_TOTAL = OFF_WS + NW * 64 * 4;
static_assert(LDS_TOTAL <= RING_BYTES, "attention LDS");
constexpr float SCALE = 0.07216878364870323f;
constexpr float THR = 8.f;
constexpr float QSCALE = SCALE * 1.4426950408889634f;
constexpr float THRL = THR * 1.4426950408889634f;
#define SBAR() __builtin_amdgcn_sched_barrier(0)
__device__ __forceinline__ int crow(int r, int hi) { return (r & 3) + 8 * (r >> 2) + 4 * hi; }
__device__ __forceinline__ unsigned cvtpk(float lo, float hi) { return pk2(lo, hi); }

template <bool MASK16, bool FIRST>
__device__ __forceinline__ void partialSM(f32x16& p0, f32x16& p1, float& m_reg, float& alpha) {
    if (MASK16) {
#pragma unroll
        for (int r = 8; r < 16; ++r) p0[r] = NEGBIG;
#pragma unroll
        for (int r = 0; r < 16; ++r) p1[r] = NEGBIG;
    }
    float pmax = p0[0];
#pragma unroll
    for (int r = 1; r < 16; ++r) pmax = fmaxf(pmax, p0[r]);
#pragma unroll
    for (int r = 0; r < 16; ++r) pmax = fmaxf(pmax, p1[r]);
    { auto rr = __builtin_amdgcn_permlane32_swap(__float_as_uint(pmax), __float_as_uint(pmax), false, false); pmax = fmaxf(__uint_as_float(rr[0]), __uint_as_float(rr[1])); }
    if (!FIRST && __builtin_expect(__all(pmax <= THRL), 1)) { alpha = 1.f; }
    else { const float d = FIRST ? pmax : fmaxf(pmax, 0.f); alpha = FIRST ? 1.f : __builtin_amdgcn_exp2f(-d); m_reg += d;
#pragma unroll
        for (int r = 0; r < 16; ++r) { p0[r] -= d; p1[r] -= d; } }
#pragma unroll
    for (int r = 0; r < 16; ++r) p0[r] = __builtin_amdgcn_exp2f(p0[r]);
}
__device__ __forceinline__ void finishSM(f32x16& p0, f32x16& p1, float alpha, float& l_reg, bf16x8& pa0, bf16x8& pa1, bf16x8& pa2, bf16x8& pa3) {
#pragma unroll
    for (int r = 0; r < 16; ++r) p1[r] = __builtin_amdgcn_exp2f(p1[r]);
    float ps = 0;
#pragma unroll
    for (int r = 0; r < 16; ++r) ps += p0[r];
#pragma unroll
    for (int r = 0; r < 16; ++r) ps += p1[r];
    { auto rr = __builtin_amdgcn_permlane32_swap(__float_as_uint(ps), __float_as_uint(ps), false, false); ps = __uint_as_float(rr[0]) + __uint_as_float(rr[1]); }
    l_reg = l_reg * alpha + ps;
#define PK4(P, BASE, OUT) do { unsigned a0 = cvtpk(P[BASE + 0], P[BASE + 1]), a1 = cvtpk(P[BASE + 2], P[BASE + 3]);   \
    unsigned b0 = cvtpk(P[BASE + 4], P[BASE + 5]), b1 = cvtpk(P[BASE + 6], P[BASE + 7]);                              \
    auto r0 = __builtin_amdgcn_permlane32_swap(a0, b0, false, false); auto r1 = __builtin_amdgcn_permlane32_swap(a1, b1, false, false); \
    u32x4 w = {r0[0], r1[0], r0[1], r1[1]}; OUT = __builtin_bit_cast(bf16x8, w); } while (0)
    PK4(p0, 0, pa0); PK4(p0, 8, pa1); PK4(p1, 0, pa2); PK4(p1, 8, pa3);
#undef PK4
}
__device__ __forceinline__ void qkt(f32x16& p0, f32x16& p1, const LAS char* Ks, const bf16x8* qr, int r32, int hi, float init) {
#pragma unroll
    for (int r = 0; r < 16; ++r) { p0[r] = init; p1[r] = init; }
#pragma unroll
    for (int d0 = 0; d0 < 12; ++d0) { const int cb = (d0 * 16 + hi * 8) * 2;
        const bf16x8 b0 = *(const LAS bf16x8*)(Ks + r32 * KROW + cb);
        const bf16x8 b1 = *(const LAS bf16x8*)(Ks + (32 + r32) * KROW + cb);
        p0 = __builtin_amdgcn_mfma_f32_32x32x16_bf16(b0, qr[d0], p0, 0, 0, 0);
        p1 = __builtin_amdgcn_mfma_f32_32x32x16_bf16(b1, qr[d0], p1, 0, 0, 0); }
}
__device__ __forceinline__ int v_st(int k, int c) { const int kk = (k & ~0xC) | ((k & 4) << 1) | ((k & 8) >> 1); return ((kk >> 3) * 4 + (c >> 5)) * 512 + ((kk & 7) * 32 + (c & 31)) * 2; }
__device__ __forceinline__ int v_rd_base(int lane) { return ((lane & 3) << 3) | (((lane >> 2) & 3) << 6) | (((lane >> 4) & 1) << 5) | (((lane >> 5) & 1) << 8); }
constexpr int v_rd_off(int d0, int ks, int half) { return d0 * 512 + ks * 4096 + half * 2048; }
template <int OFF> __device__ __forceinline__ s16x4 tr_read(int vb) { s16x4 r; asm volatile("ds_read_b64_tr_b16 %0, %1 offset:%2" : "=&v"(r) : "v"(vb), "i"(OFF) : "memory"); return r; }
template <int D0> __device__ __forceinline__ void pv_one(f32x16& od, int vb, bf16x8 pa0, bf16x8 pa1, bf16x8 pa2, bf16x8 pa3) {
    const s16x4 l0 = tr_read<v_rd_off(D0, 0, 0)>(vb), h0 = tr_read<v_rd_off(D0, 0, 1)>(vb), l1 = tr_read<v_rd_off(D0, 1, 0)>(vb), h1 = tr_read<v_rd_off(D0, 1, 1)>(vb);
    const s16x4 l2 = tr_read<v_rd_off(D0, 2, 0)>(vb), h2 = tr_read<v_rd_off(D0, 2, 1)>(vb), l3 = tr_read<v_rd_off(D0, 3, 0)>(vb), h3 = tr_read<v_rd_off(D0, 3, 1)>(vb);
    asm volatile("s_waitcnt lgkmcnt(0)" ::: "memory"); SBAR();
#define PKV(L, H) (bf16x8){L[0], L[1], L[2], L[3], H[0], H[1], H[2], H[3]}
    od = __builtin_amdgcn_mfma_f32_32x32x16_bf16(pa0, PKV(l0, h0), od, 0, 0, 0);
    od = __builtin_amdgcn_mfma_f32_32x32x16_bf16(pa1, PKV(l1, h1), od, 0, 0, 0);
    od = __builtin_amdgcn_mfma_f32_32x32x16_bf16(pa2, PKV(l2, h2), od, 0, 0, 0);
    od = __builtin_amdgcn_mfma_f32_32x32x16_bf16(pa3, PKV(l3, h3), od, 0, 0, 0);
#undef PKV
}
__device__ __forceinline__ void pv_d0(f32x16* o, int vb, bf16x8 pa0, bf16x8 pa1, bf16x8 pa2, bf16x8 pa3) {
    pv_one<0>(o[0], vb, pa0, pa1, pa2, pa3); pv_one<1>(o[1], vb, pa0, pa1, pa2, pa3); pv_one<2>(o[2], vb, pa0, pa1, pa2, pa3); pv_one<3>(o[3], vb, pa0, pa1, pa2, pa3);
}

__device__ __forceinline__ void attn_unit(int s, int h, int qb, const bf16_t* __restrict__ MQ, const bf16_t* __restrict__ MKV, const bf16_t* __restrict__ KR, bf16_t* __restrict__ MIX, LAS char* lds) {
    int tid_ = threadIdx.x; asm volatile("" : "+v"(tid_));
    const int tid = tid_, wid = tid >> 6, lane = tid & 63, r32 = lane & 31, hi = lane >> 5;
    LAS char* V_lds = lds + OFF_V; LAS char* K_lds = lds + OFF_K;
    LAS float* wsf = (LAS float*)(lds + OFF_WS) + wid * 64; LAS float* li_l = wsf; LAS float* al_l = wsf + 32;
    float m_reg = 0.f, l_reg = 0; f32x16 o[4]; bf16x8 qr[12];
#pragma unroll
    for (int d = 0; d < 4; ++d)
#pragma unroll
        for (int r = 0; r < 16; ++r) o[d][r] = 0.f;
    const int qi = wid * QBLK + r32;
    const unsigned qrow = qb < 16 ? (unsigned)s * LREAL + 256 * qb + qi : (unsigned)MROW0 + 16 * s + (qi < 15 ? qi : 15);
    { const bf16_t* Qw = MQ + (qrow * NQ + h * 192 + hi * 8);
#pragma unroll
      for (int d0 = 0; d0 < 12; ++d0) qr[d0] = *(const bf16x8*)(Qw + d0 * 16); }
    const int sr = tid >> 4, sc = (tid & 15) * 8, vst0 = v_st(sr, sc), vst1 = v_st(32 + sr, sc);
    const int kr_r = tid >> 3, kr_c = (tid & 7) * 8;
    const int vb0 = (int)(uintptr_t)V_lds + v_rd_base(lane);
    bf16x8 vs0, vs1, ks0, ks1, kr0;
    const unsigned mainrow0 = (unsigned)s * LREAL, metarow0 = (unsigned)MROW0 + 16 * s;
    const bf16_t* MKVh = MKV + h * 256;
#define KROWG(kt, k) ((kt) < 64 ? mainrow0 + 64u * (kt) + (k) : metarow0 + ((k) < 15 ? (k) : 15))
#define SLOAD(kt) do { const unsigned g0 = KROWG(kt, sr) * NKV + sc, g1 = KROWG(kt, 32 + sr) * NKV + sc, g2 = KROWG(kt, kr_r) * 64 + kr_c; \
    vs0 = *(const bf16x8*)(MKVh + 128 + g0); vs1 = *(const bf16x8*)(MKVh + 128 + g1); \
    ks0 = *(const bf16x8*)(MKVh + g0); ks1 = *(const bf16x8*)(MKVh + g1); kr0 = *(const bf16x8*)(KR + g2); } while (0)
#define SWRITE(b) do { *(LAS bf16x8*)(V_lds + (b) * SHM_V + vst0) = vs0; *(LAS bf16x8*)(V_lds + (b) * SHM_V + vst1) = vs1; \
    *(LAS bf16x8*)(K_lds + (b) * SHM_K + sr * KROW + sc * 2) = ks0; *(LAS bf16x8*)(K_lds + (b) * SHM_K + (32 + sr) * KROW + sc * 2) = ks1; \
    *(LAS bf16x8*)(K_lds + (b) * SHM_K + kr_r * KROW + 256 + kr_c * 2) = kr0; } while (0)
#define RESC(a) do { if (__any((a) < 1.f)) { if (hi == 0) al_l[r32] = (a); asm volatile("s_waitcnt lgkmcnt(0)" ::: "memory"); \
    _Pragma("unroll") for (int d = 0; d < 4; ++d) _Pragma("unroll") for (int r = 0; r < 16; ++r) o[d][r] *= al_l[crow(r, hi)]; } } while (0)
    f32x16 pA0, pA1, pB0, pB1; float alA, alB; bf16x8 pa0, pa1, pa2, pa3;
    __syncthreads();
    SLOAD(0); SWRITE(0); __syncthreads();
    qkt(pA0, pA1, K_lds, qr, r32, hi, 0.f); partialSM<false, true>(pA0, pA1, m_reg, alA);
    SLOAD(1); SWRITE(1); __syncthreads();
    RESC(alA);
    int s0 = 0, s1 = 1, s2 = 2;
    if (__builtin_amdgcn_readfirstlane(wid) >= 4) __builtin_amdgcn_s_setprio(1);
    for (int j = 1; j + 1 < NT; j += 2) {
        SBAR(); qkt(pB0, pB1, K_lds + s1 * SHM_K, qr, r32, hi, -m_reg);
        finishSM(pA0, pA1, alA, l_reg, pa0, pa1, pa2, pa3); SBAR();
        SLOAD(j + 1); SBAR();
        pv_d0(o, vb0 + s0 * SHM_V, pa0, pa1, pa2, pa3); partialSM<false, false>(pB0, pB1, m_reg, alB);
        SWRITE(s2);
        RESC(alB); __syncthreads();
        SBAR(); qkt(pA0, pA1, K_lds + s2 * SHM_K, qr, r32, hi, -m_reg);
        finishSM(pB0, pB1, alB, l_reg, pa0, pa1, pa2, pa3); SBAR();
        if (j + 2 < NT) SLOAD(j + 2); SBAR();
        pv_d0(o, vb0 + s1 * SHM_V, pa0, pa1, pa2, pa3);
        if (j + 1 == NT - 1) partialSM<true, false>(pA0, pA1, m_reg, alA); else partialSM<false, false>(pA0, pA1, m_reg, alA);
        if (j + 2 < NT) SWRITE(s0);
        RESC(alA); __syncthreads();
        { const int t0 = s0, t1 = s1; s0 = s2; s1 = t0; s2 = t1; }
    }
    finishSM(pA0, pA1, alA, l_reg, pa0, pa1, pa2, pa3); SBAR();
    pv_d0(o, vb0 + s0 * SHM_V, pa0, pa1, pa2, pa3);
    if (hi == 0) li_l[r32] = l_reg; asm volatile("s_waitcnt lgkmcnt(0)" ::: "memory");
    __builtin_amdgcn_s_setprio(0);
    float rli[16];
#pragma unroll
    for (int r = 0; r < 16; ++r) rli[r] = __builtin_amdgcn_rcpf(li_l[crow(r, hi)]);
    if (qb < 16) {
        bf16_t* Ow = MIX + ((long)s * LREAL + 256 * qb + wid * QBLK) * DM + MLW + h * 128;
#pragma unroll
        for (int r = 0; r < 16; ++r) { const int orow = crow(r, hi);
#pragma unroll
            for (int d0 = 0; d0 < 4; ++d0) Ow[(long)orow * DM + d0 * 32 + r32] = (bf16_t)(pk2(o[d0][r] * rli[r], 0.f) & 0xffffu); }
    } else if (wid == 0) {
        bf16_t* Ow = MIX + ((long)MROW0 + 16 * s) * DM + MLW + h * 128;
#pragma unroll
        for (int r = 0; r < 16; ++r) { const int orow = crow(r, hi);
            if (orow < 16) {
#pragma unroll
                for (int d0 = 0; d0 < 4; ++d0) Ow[(long)orow * DM + d0 * 32 + r32] = (bf16_t)(pk2(o[d0][r] * rli[r], 0.f) & 0xffffu); } }
    }
#undef KROWG
#undef SLOAD
#undef SWRITE
#undef RESC
}
__device__ __forceinline__ void attn_phase(int vcu, const bf16_t* MQ, const bf16_t* MKV, const bf16_t* KR, bf16_t* MIX, LAS char* lds) {
    for (int i = (vcu < 96 ? -1 : 0); i < 6; ++i) { int sh, qb; if (i < 0) { sh = vcu; qb = 16; } else { const int id = i * GRID + vcu; sh = id >> 4; qb = id & 15; }
        attn_unit(sh >> 3, sh & 7, qb, MQ, MKV, KR, MIX, lds); }
}
#undef SBAR
}

namespace ml {
constexpr int QI = 0, KI = 32768, VI = 65536, SI = 81920, CI = 98304;
constexpr int SC_CT = 0, SC_BM = 64, SC_WI = 128, SC_EI = 192, SC_WW = 256, SC_DEN = 320, SC_QN = 448, SC_N = 512, SC_A = 768;
constexpr int GP_REC = 200;
__device__ __forceinline__ unsigned off_b(unsigned row, unsigned ch) { return 256u * row + 16u * (ch ^ (((row & 3) << 2) | ((row >> 2) & 3))); }
__device__ __forceinline__ unsigned row_read_addr_16(unsigned lane, unsigned rb, unsigned s) { return off_b((lane & 15) + 16 * rb, 4 * s + (lane >> 4)); }
__device__ __forceinline__ unsigned tr_read_addr_16(unsigned lane, unsigned c, unsigned ks, unsigned t) {
    const unsigned g = lane >> 4, q = (lane & 15) >> 2, p = lane & 3; return off_b(32 * ks + 8 * g + 4 * t + q, 2 * c + (p >> 1)) + 8 * (p & 1); }
__device__ __forceinline__ bf16x8 tr_frag(unsigned a0, unsigned a1) {
    const s16x4 lo = __builtin_amdgcn_ds_read_tr16_b64_v4i16((LAS s16x4*)a0), hi = __builtin_amdgcn_ds_read_tr16_b64_v4i16((LAS s16x4*)a1);
    return (bf16x8){lo[0], lo[1], lo[2], lo[3], hi[0], hi[1], hi[2], hi[3]};
}
__device__ __forceinline__ f32x4 mfma16(bf16x8 a, bf16x8 b, f32x4 c) { return __builtin_amdgcn_mfma_f32_16x16x32_bf16(a, b, c, 0, 0, 0); }
__device__ __forceinline__ float log_sigmoid(float x) { return fminf(x, 0.f) - __logf(1.f + __expf(-fabsf(x))); }

__device__ __forceinline__ void gate_prep(int gw, int ngw, int lane, const float* __restrict__ GATES, const float* __restrict__ bgl, float* __restrict__ GP) {
    for (int it = gw; it < 96 * 65; it += ngw) {
        const int chain = it / 65, c = it % 65, s = chain >> 3, hd = (chain >> 1) & 3, dir = chain & 1;
        const long g = c == 0 ? (lane >= 48 ? (long)MROW0 + 16 * s + lane - 48 : -1L) : (long)s * LREAL + 64 * (c - 1) + lane;
        float li = NEGBIG, lf = 0.f;
        if (g >= 0) { li = GATES[g * 16 + (dir ? 8 : 0) + hd] + bgl[(dir ? 8 : 0) + hd]; lf = log_sigmoid(GATES[g * 16 + (dir ? 12 : 4) + hd] + bgl[(dir ? 12 : 4) + hd]); }
        float x = dir ? __shfl(lf, 63 - lane) : lf;
#pragma unroll
        for (int o = 1; o < 64; o <<= 1) { const float y = __shfl_up(x, o); if (lane >= o) x += y; }
        const float btot = __shfl(x, 63);
        const float b = dir ? __shfl(x, 63 - lane) : x;
        const float a_s = li - b;
        float pm = dir ? __shfl(a_s, 63 - lane) : a_s;
#pragma unroll
        for (int o = 1; o < 64; o <<= 1) { const float y = __shfl_up(pm, o); if (lane >= o) pm = fmaxf(pm, y); }
        pm = dir ? __shfl(pm, 63 - lane) : pm;
        const float gmax = wave_max(btot - b + li);
        float* rec = GP + (size_t)it * GP_REC;
        rec[lane] = b; rec[64 + lane] = li; rec[128 + lane] = pm; if (lane == 0) { rec[192] = btot; rec[193] = gmax; }
    }
}

__device__ __forceinline__ void mlstm_unit(int s, int hd, int js, const bf16_t* __restrict__ UQKVO, const float* __restrict__ GP, float* __restrict__ HSUM, LAS unsigned char* lds, LAS float* sc) {
    const int wid = __builtin_amdgcn_readfirstlane((int)threadIdx.x >> 6);
    const unsigned ldsb = (unsigned)(uintptr_t)lds;
    const int tt = wid >> 1, nb = 2 * (wid & 1);
#define ROWRD(img, rb, s_) (*(const LAS bf16x8*)(uintptr_t)(RB[s_] + (unsigned)((img) + 4096 * (rb))))
#define TRFRAG(img, c_, ks) tr_frag(BT[0][(c_) & 1] + TQ[(c_) >> 1] + (unsigned)((img) + 8192 * (ks)), BT[1][(c_) & 1] + TQ[(c_) >> 1] + (unsigned)((img) + 8192 * (ks)))
    f32x4 accC[2][4], accN[2];
    for (int dir = 0; dir < 2; ++dir) {
        int tid; { int t0_ = threadIdx.x; asm volatile("" : "+v"(t0_)); tid = t0_; }
#pragma unroll
        for (int mi = 0; mi < 2; ++mi)
#pragma unroll
            for (int c = 0; c < 4; ++c) accC[mi][c] = (f32x4){0.f, 0.f, 0.f, 0.f};
        accN[0] = (f32x4){0.f, 0.f, 0.f, 0.f}; accN[1] = (f32x4){0.f, 0.f, 0.f, 0.f};
        if (tid < 256) sc[SC_N + tid] = 0.f;
        for (int i = tid; i < 32768 / 16; i += 512) *(LAS u32x4*)(lds + CI + i * 16) = (u32x4){0u, 0u, 0u, 0u};
        float m_state = 0.f;
        const float* GPc = GP + (size_t)(((s * 4 + hd) * 2 + dir) * 65) * GP_REC;
        u32x4 sq[4], sk[4], sv; float sb = 0.f, sli = NEGBIG, spm = NEGBIG, sbt = 0.f, sgm = NEGBIG;
#define ROWG(c, r) ((c) == 0 ? ((r) >= 48 ? (long)MROW0 + 16 * s + (r) - 48 : -1L) : (long)s * LREAL + 64 * ((c) - 1) + (r))
#define STAGE_LOAD(c) do { \
        _Pragma("unroll") for (int i = 0; i < 4; ++i) { const int id = tid + 512 * i, r = id >> 5, ch = id & 31; const long g = ROWG(c, r); \
            sq[i] = (u32x4){0u, 0u, 0u, 0u}; sk[i] = (u32x4){0u, 0u, 0u, 0u}; \
            if (g >= 0) { sq[i] = *(const u32x4*)(UQKVO + g * 4096 + hd * 256 + ch * 8); sk[i] = *(const u32x4*)(UQKVO + g * 4096 + 1024 + hd * 256 + ch * 8); } } \
        { const int r = tid >> 3, ch = tid & 7; const long g = ROWG(c, r); sv = (u32x4){0u, 0u, 0u, 0u}; if (g >= 0) sv = *(const u32x4*)(UQKVO + g * 4096 + 2048 + hd * 256 + js * 64 + ch * 8); } \
        if (tid < 64) { const float* rec = GPc + (size_t)(c) * GP_REC; sb = rec[tid]; sli = rec[64 + tid]; spm = rec[128 + tid]; sbt = rec[192]; sgm = rec[193]; } } while (0)
#define STAGE_WRITE() do { \
        _Pragma("unroll") for (int i = 0; i < 4; ++i) { const int id = tid + 512 * i, r = id >> 5, ch = id & 31; \
            *(LAS u32x4*)(lds + QI + (ch >> 4) * 16384 + off_b(r, ch & 15)) = sq[i]; *(LAS u32x4*)(lds + KI + (ch >> 4) * 16384 + off_b(r, ch & 15)) = sk[i]; } \
        { const int r = tid >> 3, ch = tid & 7; *(LAS u32x4*)(lds + VI + off_b(r, ch)) = sv; } \
        if (tid < 64) { const float m_inter = sb + m_state, mt = fmaxf(m_inter, sb + spm); const float m_new = fmaxf(sbt + m_state, sgm); \
            sc[SC_CT + tid] = sli - sb; sc[SC_BM + tid] = sb - mt; sc[SC_WI + tid] = __expf(m_inter - mt); sc[SC_EI + tid] = __expf(-mt); \
            sc[SC_WW + tid] = __expf(sbt - sb + sli - m_new) * 0.0625f; if (tid == 0) sc[SC_A] = __expf(sbt + m_state - m_new); m_state = m_new; } } while (0)
        const int c_first = dir ? 64 : 0, c_step = dir ? -1 : 1;
        STAGE_LOAD(c_first);
        __syncthreads();
        STAGE_WRITE();
        for (int ci = 0; ci < 65; ++ci) {
            const int c = c_first + c_step * ci;
            { int t2_ = threadIdx.x; asm volatile("" : "+v"(t2_)); tid = t2_; }
            const int lane = tid & 63, l15 = lane & 15, lg = lane >> 4;
            unsigned RB[4], BT[2][2], TQ[4];
            { const unsigned fl = ((l15 & 3) << 2) | (l15 >> 2), q = l15 >> 2, p = lane & 3, g = lg;
#pragma unroll
              for (int s_ = 0; s_ < 4; ++s_) { RB[s_] = ldsb + 256u * l15 + 16u * (lg ^ (fl & 3)) + 64u * (s_ ^ (fl >> 2)); TQ[s_] = 64u * (s_ ^ q); }
#pragma unroll
              for (int t_ = 0; t_ < 2; ++t_)
#pragma unroll
                  for (int cl = 0; cl < 2; ++cl) BT[t_][cl] = ldsb + 256u * (8 * g + q) + 8u * (p & 1) + 1024u * t_ + 16u * ((p >> 1) ^ t_) + 32u * (cl ^ (g & 1)); }
            __syncthreads();
            if (ci + 1 < 65) STAGE_LOAD(c + c_step);
            bf16x8 qf[8];
#pragma unroll
            for (int k = 0; k < 8; ++k) qf[k] = ROWRD(QI + (k >> 2) * 16384, tt, k & 3);
            f32x4 sT[2], oc[2];
#pragma unroll
            for (int i = 0; i < 2; ++i) { sT[i] = (f32x4){0.f, 0.f, 0.f, 0.f}; oc[i] = (f32x4){0.f, 0.f, 0.f, 0.f}; }
#pragma unroll
            for (int i = 0; i < 2; ++i)
#pragma unroll
                for (int k = 0; k < 8; ++k) {
                    const bf16x8 kf = ROWRD(KI + (k >> 2) * 16384, nb + i, k & 3);
                    sT[i] = mfma16(kf, qf[k], sT[i]);
                    const bf16x8 cf = ROWRD(CI + (k >> 2) * 16384, nb + i, k & 3);
                    oc[i] = mfma16(qf[k], cf, oc[i]);
                }
            {
                const int t = 16 * tt + l15; const float bmt = sc[SC_BM + t]; float rs = 0.f;
#pragma unroll
                for (int i = 0; i < 2; ++i) { const int s0 = 16 * (nb + i) + 4 * lg; const f32x4 ctv = *(const LAS f32x4*)(sc + SC_CT + s0); float v[4];
#pragma unroll
                    for (int e = 0; e < 4; ++e) { const int sx = s0 + e; const bool ok = dir ? (sx >= t) : (sx <= t);
                        const float ex = ok ? (bmt + ctv[e]) : NEGBIG; v[e] = sT[i][e] * 0.0625f * __expf(ex); rs += v[e]; }
                    u32x2 w; w.x = pk2(v[0], v[1]); w.y = pk2(v[2], v[3]);
                    *(LAS u32x2*)(lds + SI + off_b(t, s0 >> 3) + (s0 & 7) * 2) = w; }
                rs += __shfl_xor(rs, 16); rs += __shfl_xor(rs, 32);
                if (lg == 0) sc[SC_DEN + 64 * (wid & 1) + t] = rs;
            }
            { const int r = tid >> 3, ch = tid & 7; const u32x4 v = *(const LAS u32x4*)(lds + VI + off_b(r, ch)); const float w = sc[SC_WW + r]; u32x4 o;
#pragma unroll
              for (int jx = 0; jx < 4; ++jx) o[jx] = pk2(bf_lo(v[jx]) * w, bf_hi(v[jx]) * w);
              *(LAS u32x4*)(lds + VI + off_b(r, 8 + ch)) = o; }
            { const int r = tid >> 3, part = tid & 7; float d = 0.f;
#pragma unroll
              for (int i = 0; i < 4; ++i) { const int ch32 = part * 4 + i; const u32x4 v = *(const LAS u32x4*)(lds + QI + (ch32 >> 4) * 16384 + off_b(r, ch32 & 15));
                  const f32x4 n0 = *(const LAS f32x4*)(sc + SC_N + ch32 * 8), n1 = *(const LAS f32x4*)(sc + SC_N + ch32 * 8 + 4);
                  d += bf_lo(v[0]) * n0[0] + bf_hi(v[0]) * n0[1] + bf_lo(v[1]) * n0[2] + bf_hi(v[1]) * n0[3] + bf_lo(v[2]) * n1[0] + bf_hi(v[2]) * n1[1] + bf_lo(v[3]) * n1[2] + bf_hi(v[3]) * n1[3]; }
              d += __shfl_xor(d, 1); d += __shfl_xor(d, 2); d += __shfl_xor(d, 4);
              if (part == 0) sc[SC_QN + r] = d; }
            { const f32x4 wi = *(const LAS f32x4*)(sc + SC_WI + 16 * tt + 4 * lg);
#pragma unroll
              for (int i = 0; i < 2; ++i) oc[i] = oc[i] * wi; }
            __syncthreads();
            const float a_dec = sc[SC_A];
#pragma unroll
            for (int ks = 0; ks < 2; ++ks) { const bf16x8 sf = ROWRD(SI, tt, ks);
#pragma unroll
                for (int i = 0; i < 2; ++i) { const bf16x8 vf = TRFRAG(VI, nb + i, ks);
                    oc[i] = mfma16(sf, vf, oc[i]); } }
            { const int t0 = 16 * tt + 4 * lg;
              const f32x4 wi = *(const LAS f32x4*)(sc + SC_WI + t0), qn = *(const LAS f32x4*)(sc + SC_QN + t0), d0 = *(const LAS f32x4*)(sc + SC_DEN + t0), d1 = *(const LAS f32x4*)(sc + SC_DEN + 64 + t0), ei = *(const LAS f32x4*)(sc + SC_EI + t0);
#pragma unroll
              for (int e = 0; e < 4; ++e) { const long g = ROWG(c, t0 + e);
                const float den = wi[e] * qn[e] + (d0[e] + d1[e]); const float inv = 1.f / fmaxf(fabsf(den), ei[e]);
                if (g >= 0) {
#pragma unroll
                    for (int i = 0; i < 2; ++i) { float* hp = HSUM + g * MLW + hd * 256 + js * 64 + 16 * (nb + i) + l15; const float hv = oc[i][e] * inv; if (dir) unsafeAtomicAdd(hp, hv); else *hp = hv; } } } }
#pragma unroll
            for (int mi = 0; mi < 2; ++mi)
#pragma unroll
                for (int cc = 0; cc < 4; ++cc) accC[mi][cc] = accC[mi][cc] * a_dec;
            accN[0] = accN[0] * a_dec; accN[1] = accN[1] * a_dec;
            const unsigned ktq = (unsigned)(KI + (wid >> 2) * 16384) + 64u * ((unsigned)(wid & 3) ^ (unsigned)(l15 >> 2));
#pragma unroll
            for (int ks = 0; ks < 2; ++ks) {
                bf16x8 kf[2], wf[4];
#pragma unroll
                for (int mi = 0; mi < 2; ++mi) kf[mi] = tr_frag(BT[0][mi] + ktq + (unsigned)(8192 * ks), BT[1][mi] + ktq + (unsigned)(8192 * ks));
#pragma unroll
                for (int cc = 0; cc < 4; ++cc) wf[cc] = TRFRAG(VI, 4 + cc, ks);
                { const f32x4 wa = *(const LAS f32x4*)(sc + SC_WW + 32 * ks + 8 * lg), wb = *(const LAS f32x4*)(sc + SC_WW + 32 * ks + 8 * lg + 4);
                  u32x4 wq; wq.x = pk2(wa[0], wa[1]); wq.y = pk2(wa[2], wa[3]); wq.z = pk2(wb[0], wb[1]); wq.w = pk2(wb[2], wb[3]);
                  if (l15 != 0) wq = (u32x4){0u, 0u, 0u, 0u};
                  const bf16x8 wfn = __builtin_bit_cast(bf16x8, wq);
#pragma unroll
                  for (int mi = 0; mi < 2; ++mi) accN[mi] = mfma16(kf[mi], wfn, accN[mi]); }
#pragma unroll
                for (int mi = 0; mi < 2; ++mi)
#pragma unroll
                    for (int cc = 0; cc < 4; ++cc) accC[mi][cc] = mfma16(kf[mi], wf[cc], accC[mi][cc]);
            }
#pragma unroll
            for (int mi = 0; mi < 2; ++mi)
#pragma unroll
                for (int cc = 0; cc < 4; ++cc) { const int dk0 = 32 * wid + 16 * mi + 4 * lg, dv = 16 * cc + l15; u32x2 w; w.x = pk2(accC[mi][cc][0], accC[mi][cc][1]); w.y = pk2(accC[mi][cc][2], accC[mi][cc][3]);
                    *(LAS u32x2*)(lds + CI + (dk0 >> 7) * 16384 + off_b(dv, (dk0 & 127) >> 3) + (dk0 & 7) * 2) = w; }
            if (l15 == 0) { *(LAS f32x4*)(sc + SC_N + 32 * wid + 4 * lg) = accN[0]; *(LAS f32x4*)(sc + SC_N + 32 * wid + 16 + 4 * lg) = accN[1]; }
            __syncthreads();
            if (ci + 1 < 65) STAGE_WRITE();
        }
    }
#undef ROWG
#undef STAGE_LOAD
#undef STAGE_WRITE
#undef ROWRD
#undef TRFRAG
}
__device__ __forceinline__ void mlstm_phase(int bx, const bf16_t* UQKVO, const float* GP, float* HSUM, LAS unsigned char* lds, LAS float* sc) {
    if (bx >= 192) return;
    const int xcd = bx & 7, idx = bx >> 3, pair = xcd * 6 + (idx >> 2), js = idx & 3;
    mlstm_unit(pair >> 2, pair & 3, js, UQKVO, GP, HSUM, lds, sc);
}
}

#ifndef PHM
#define PHM 0xffff
#endif
#ifndef REP_ML
#define REP_ML 1
#endif
#ifndef REP_ATTN
#define REP_ATTN 1
#endif
#ifndef REP_CONV
#define REP_CONV 1
#endif
#ifndef REP_SMALL
#define REP_SMALL 1
#endif
#ifndef KV_SPLIT
#define KV_SPLIT 193
#endif
#ifndef REP_WIN
#define REP_WIN 1
#endif
#ifndef REP_UP
#define REP_UP 1
#endif
__global__ void __launch_bounds__(512, 2) fwd_kernel(Params P, unsigned char* ws_arg, unsigned char* out_arg) {
    extern __shared__ __attribute__((aligned(16))) unsigned char lds_raw[];
    Frame F;
    F.lds = (LAS unsigned char*)lds_raw;
    F.tid = threadIdx.x; F.lane = F.tid & 63; F.wave = __builtin_amdgcn_readfirstlane(F.tid >> 6);
    F.G = GRID; F.bx = blockIdx.x; F.vcu = (F.bx % 8) * (GRID / 8) + F.bx / 8;
    F.gw = F.vcu * 8 + F.wave; F.ngw = F.G * 8;
    { unsigned char* ws0 = ws_arg;
      for (int u = F.tid; u < (LDS_BYTES - MISC_OFF) / 4; u += 512) ((LAS unsigned*)(F.lds + MISC_OFF))[u] = 0u;
      __syncthreads();
      (void)ws0; }
    LAS unsigned long long* ptab = (LAS unsigned long long*)(F.lds + MISC_OFF + 64);
    if (F.tid == 0) {
#pragma unroll
        for (int k = 0; k < 19; ++k) ptab[k] = (unsigned long long)(uintptr_t)P.in[k]; }
    __syncthreads();
    XcdBarrier bar = xcd_barrier_post((unsigned*)(ws_arg + WS_CTL) + CW_BAR, (volatile LAS unsigned*)(F.lds + MISC_OFF));
    LAS float* sc = (LAS float*)(F.lds + MISC_OFF + 1024);
#define BXL() ({ int b__ = F.bx; asm volatile("" : "+s"(b__)); b__; })
#define PFRAME() Frame Fp = F; { int t_ = threadIdx.x; asm volatile("" : "+v"(t_)); Fp.tid = t_; Fp.lane = t_ & 63; int b_ = BXL(); Fp.bx = b_; Fp.vcu = (b_ % 8) * (GRID / 8) + b_ / 8; Fp.gw = Fp.vcu * 8 + Fp.wave; }
#define WSB() ({ GAS unsigned char* w__ = (GAS unsigned char*)ws_arg; asm volatile("" : "+s"(w__)); (unsigned char*)w__; })
#ifndef STAG_N
#define STAG_N 1
#endif
#ifdef STAG_ON
#define STAGGER() do { int s__ = (BXL() * 37) & 255; for (int i__ = 0; i__ < s__; ++i__) __builtin_amdgcn_s_sleep(STAG_N); } while (0)
#else
#define STAGGER() do {} while (0)
#endif
#define WOFS(l_) (((l_) & 1) ? WSET_DELTA : (size_t)0)
#define DOB() ({ GAS unsigned char* w__ = (GAS unsigned char*)out_arg; asm volatile("" : "+s"(w__)); (unsigned char*)w__; })

    { unsigned char* ws = WSB(); prologue(F, ws, ptab); convert_weights(F, ws, ptab, 0, 0, -1); }
    xcd_barrier(bar);

    for (int l = 0; l < DEPTH; ++l) {
        { unsigned char* ws = WSB();
          pg8::Gemm g{(bf16_t*)(ws + WS_HB), (bf16_t*)(ws + WOFS(l) + WS_WIN), TP, NIN, DM, DM}; pg8::PanelOrder S; S.init(NPAN, 0, 0, 0, NIN, F.G, BXL());
          pg8::EpiWin E{(bf16_t*)(ws + WS_UQKVO), (bf16_t*)(ws + WS_UDQ), (bf16_t*)(ws + WS_UDKV), (bf16_t*)(ws + WS_KR), (float*)(ws + WS_GATES), (const float*)(ws + WS_COS), (const float*)(ws + WS_SIN)};
#if PHM & 2
          STAGGER(); pg8::gemm_phase<pg8::EpiWin, pg8::PanelOrder, true, true>(F.lds, g, S, E);
#endif
        }
        if (l + 1 < DEPTH && BXL() >= 20) { unsigned char* ws = WSB(); PFRAME(); Fp.gw = (Fp.bx - 20) * 8 + Fp.wave; Fp.ngw = (GRID - 20) * 8; convert_weights(Fp, ws, ptab, l + 1, WOFS(l + 1), 0); }
#if REP_WIN > 1
        __syncthreads();
        { unsigned char* ws = WSB();
          pg8::Gemm g{(bf16_t*)(ws + WS_HB), (bf16_t*)(ws + WOFS(l) + WS_WIN), TP, NIN, DM, DM}; pg8::PanelOrder S; S.init(NPAN, 0, 0, 0, NIN, F.G, BXL());
          pg8::EpiWin E{(bf16_t*)(ws + WS_UQKVO), (bf16_t*)(ws + WS_UDQ), (bf16_t*)(ws + WS_UDKV), (bf16_t*)(ws + WS_KR), (float*)(ws + WS_GATES), (const float*)(ws + WS_COS), (const float*)(ws + WS_SIN)};
          pg8::gemm_phase<pg8::EpiWin, pg8::PanelOrder, true, true>(F.lds, g, S, E);
        }
#endif
        xcd_barrier(bar);
        { unsigned char* ws = WSB(); unsigned char* dob = DOB(); PFRAME(); rstd_rows(Fp, (bf16_t*)(ws + WS_UDQ), (bf16_t*)(ws + WS_UDKV), (float*)(ws + WS_RSTD));
          ml::gate_prep(Fp.gw, Fp.ngw, Fp.lane, (const float*)(ws + WS_GATES), (const float*)(ws + WS_PAR) + PO_BG + l * 16, (float*)(dob + DO_GP)); }
#if REP_SMALL > 1
        { unsigned char* ws = WSB(); unsigned char* dob = DOB(); PFRAME(); rstd_rows(Fp, (bf16_t*)(ws + WS_UDQ), (bf16_t*)(ws + WS_UDKV), (float*)(ws + WS_RSTD));
          ml::gate_prep(Fp.gw, Fp.ngw, Fp.lane, (const float*)(ws + WS_GATES), (const float*)(ws + WS_PAR) + PO_BG + l * 16, (float*)(dob + DO_GP)); }
#endif
        xcd_barrier(bar);
        if (F.bx >= 192) {
        { unsigned char* ws = WSB(); unsigned char* dob = DOB();
          pg8::Gemm g{(bf16_t*)(ws + WS_UDQ), (bf16_t*)(ws + WOFS(l) + WS_WUQ), TP, NQ, 512, 512}; pg8::PanelOrder S; S.init(NPAN, 0, 0, 0, NQ, GRID - 192, BXL() - 192);
          pg8::EpiQ E{(bf16_t*)(dob + DO_MQ), (const float*)(ws + WS_RSTD), (const float*)(ws + WS_COS), (const float*)(ws + WS_SIN)};
#if PHM & 4
          pg8::gemm_phase<pg8::EpiQ, pg8::PanelOrder, true, true>(F.lds, g, S, E);
#endif
        }
        { unsigned char* ws = WSB();
          pg8::Gemm g{(bf16_t*)(ws + WS_UDKV), (bf16_t*)(ws + WOFS(l) + WS_WUKV), TP, NKV, 256, 256}; pg8::PanelOrder S; S.init(NPAN, 0, 0, 0, NKV, GRID - 192, BXL() - 192);
          pg8::EpiBf16G E{(bf16_t*)(ws + WS_MKV), NKV, (const float*)(ws + WS_RSTD) + 1, 0, -1, 0};
#if PHM & 8
          pg8::gemm_phase<pg8::EpiBf16G, pg8::PanelOrder, true, true>(F.lds, g, S, E);
#endif
        }
        } else {
#ifndef NO_ML
        for (int rep_ = 0; rep_ < REP_ML; ++rep_)
        { unsigned char* ws = WSB(); unsigned char* dob = DOB();
          ml::mlstm_phase(BXL(), (const bf16_t*)(ws + WS_UQKVO), (const float*)(dob + DO_GP), (float*)(dob + DO_HSUM), F.lds, sc); }
#endif
        }
        xcd_barrier(bar);
        { unsigned char* ws = WSB(); unsigned char* dob = DOB(); PFRAME();
          if (Fp.vcu >= 96) mlstm_finalize(Fp, (Fp.vcu - 96) * 8 + Fp.wave, (GRID - 96) * 8, (const float*)(dob + DO_HSUM), (const bf16_t*)(ws + WS_UQKVO), (const float*)(ws + WS_PAR) + PO_MLG + l * MLW, (bf16_t*)(ws + WS_HB)); }
#ifndef NO_ATTN
        for (int rep_ = 0; rep_ < REP_ATTN; ++rep_)
        { unsigned char* ws = WSB(); unsigned char* dob = DOB();
          att::attn_phase(({ int b__ = BXL(); (b__ % 8) * (GRID / 8) + b__ / 8; }), (const bf16_t*)(dob + DO_MQ), (const bf16_t*)(ws + WS_MKV), (const bf16_t*)(ws + WS_KR), (bf16_t*)(ws + WS_HB), (LAS char*)F.lds); }
#endif
        xcd_barrier(bar);
        { unsigned char* ws = WSB();
          pg8::Gemm g{(bf16_t*)(ws + WS_HB), (bf16_t*)(ws + WOFS(l) + WS_WOUT), TP, DM, DM, DM}; pg8::PanelOrder S; S.init(192, 0, 0, 0, DM, F.G, BXL());
          pg8::EpiResidLn E{(bf16_t*)(ws + WS_H), DM, ALPHA, (const float*)(ws + WS_STAT2), (const float*)(ws + WS_PAR) + (l > 0 ? PO_L2G + (l - 1) * DM : PO_ONE), (const float*)(ws + WS_PAR) + (l > 0 ? PO_L2B + (l - 1) * DM : PO_ZERO)};
#if PHM & 16
          STAGGER(); pg8::gemm_phase<pg8::EpiResidLn, pg8::PanelOrder, true, true>(F.lds, g, S, E);
#endif
        }
        { unsigned char* ws = WSB();
          pg8::Gemm g{(bf16_t*)(ws + WS_HB), (bf16_t*)(ws + WOFS(l) + WS_WOUT), TP, DM, DM / 4, DM}; pg8::SplitOrder S; S.init(PMETA, DM, 4, F.G, BXL());
          pg8::EpiPart E{(float*)(ws + WS_PART), DM};
#if PHM & 16
          pg8::gemm_phase<pg8::EpiPart, pg8::SplitOrder, true, true>(F.lds, g, S, E);
#endif
        }
        xcd_barrier(bar);
        { unsigned char* ws = WSB(); PFRAME(); ln_rows(Fp, (float*)(ws + WS_H), (bf16_t*)(ws + WS_HB), (const float*)(ws + WS_PAR) + PO_L1G + l * DM, (const float*)(ws + WS_PAR) + PO_L1B + l * DM, (float*)(ws + WS_STAT1), nullptr, (const float*)(ws + WS_PART), 4); }
        xcd_barrier(bar);
        { unsigned char* ws = WSB(); unsigned char* dob = DOB();
          pg8::Gemm g{(bf16_t*)(ws + WS_HB), (bf16_t*)(ws + WOFS(l) + WS_WUP), TP, NUP, DM, DM}; pg8::PanelOrder S; S.init(NPAN, 0, 0, 0, NUP, F.G, BXL());
          pg8::EpiFfn E{(bf16_t*)(ws + WS_ACT), (float*)(dob + DO_SIDE), (bf16_t*)(dob + DO_GVM), (const float*)(ws + WS_PAR) + PO_CW + (size_t)l * 3 * DFF, (const float*)(ws + WS_PAR) + PO_CB + (size_t)l * DFF, (LAS float*)(F.lds + MISC_OFF + 8192)};
#if PHM & 32
          STAGGER(); pg8::gemm_phase<pg8::EpiFfn, pg8::PanelOrder, true, true>(F.lds, g, S, E);
#if REP_UP > 1
          __syncthreads(); pg8::gemm_phase<pg8::EpiFfn, pg8::PanelOrder, true, true>(F.lds, g, S, E);
#endif
#endif
        }
        if (l + 1 < DEPTH && BXL() >= 44) { unsigned char* ws = WSB(); PFRAME(); Fp.gw = (Fp.bx - 44) * 8 + Fp.wave; Fp.ngw = (GRID - 44) * 8; convert_weights(Fp, ws, ptab, l + 1, WOFS(l + 1), 1); }
        xcd_barrier(bar);
        { unsigned char* ws = WSB(); unsigned char* dob = DOB(); PFRAME();
          ffn_fixup(Fp, (const float*)(dob + DO_SIDE), (const bf16_t*)(dob + DO_GVM), (bf16_t*)(ws + WS_ACT), (const float*)(ws + WS_PAR) + PO_CW + (size_t)l * 3 * DFF, (const float*)(ws + WS_PAR) + PO_CB + (size_t)l * DFF); }
#if REP_SMALL > 1
        { unsigned char* ws = WSB(); unsigned char* dob = DOB(); PFRAME();
          ffn_fixup(Fp, (const float*)(dob + DO_SIDE), (const bf16_t*)(dob + DO_GVM), (bf16_t*)(ws + WS_ACT), (const float*)(ws + WS_PAR) + PO_CW + (size_t)l * 3 * DFF, (const float*)(ws + WS_PAR) + PO_CB + (size_t)l * DFF); }
#endif
        xcd_barrier(bar);
        { unsigned char* ws = WSB();
          pg8::Gemm g{(bf16_t*)(ws + WS_ACT), (bf16_t*)(ws + WOFS(l) + WS_WDN), TP, DM, DFF, DFF}; pg8::PanelOrder S; S.init(192, 0, 0, 0, DM, F.G, BXL());
          pg8::EpiResidLn E{(bf16_t*)(ws + WS_H), DM, ALPHA, (const float*)(ws + WS_STAT1), (const float*)(ws + WS_PAR) + PO_L1G + l * DM, (const float*)(ws + WS_PAR) + PO_L1B + l * DM};
#if PHM & 64
          STAGGER(); pg8::gemm_phase<pg8::EpiResidLn, pg8::PanelOrder, true, true>(F.lds, g, S, E);
#endif
        }
        { unsigned char* ws = WSB();
          pg8::Gemm g{(bf16_t*)(ws + WS_ACT), (bf16_t*)(ws + WOFS(l) + WS_WDN), TP, DM, DFF / 11, DFF}; pg8::SplitOrder S; S.init(PMETA, DM, 11, F.G, BXL());
          pg8::EpiPart E{(float*)(ws + WS_PART), DM};
#if PHM & 64
          pg8::gemm_phase<pg8::EpiPart, pg8::SplitOrder, true, true>(F.lds, g, S, E);
#endif
        }
        xcd_barrier(bar);
        { unsigned char* ws = WSB(); unsigned char* dob = DOB();
          PFRAME(); ln_rows(Fp, (float*)(ws + WS_H), (bf16_t*)(ws + WS_HB), (const float*)(ws + WS_PAR) + PO_L2G + l * DM, (const float*)(ws + WS_PAR) + PO_L2B + l * DM, (float*)(ws + WS_STAT2), l == DEPTH - 1 ? (float*)dob : nullptr, (const float*)(ws + WS_PART), 11); }
#if REP_CONV > 1
#endif
        xcd_barrier(bar);
    }
}

extern "C" void kernel_launch(void* const* d_in, const int* in_sizes, int n_in, void* d_out, int out_size, void* d_ws, size_t ws_size, hipStream_t stream) {
    static int grid = 0;
    if (grid == 0) {
        if (n_in != 19 || out_size != NMAIN * DM || ws_size < WS_NEED) { fprintf(stderr, "kernel_launch: unexpected shapes (n_in %d out %d ws %zu need %zu)\n", n_in, out_size, ws_size, (size_t)WS_NEED); grid = -1; return; }
        int dev = 0, cus = 0;
        if (hipGetDevice(&dev) != hipSuccess || hipDeviceGetAttribute(&cus, hipDeviceAttributeMultiprocessorCount, dev) != hipSuccess) { grid = -1; return; }
        if (hipFuncSetAttribute((const void*)fwd_kernel, hipFuncAttributeMaxDynamicSharedMemorySize, LDS_BYTES) != hipSuccess) { fprintf(stderr, "kernel_launch: hipFuncSetAttribute failed\n"); grid = -1; return; }
        int per_cu = 0;
        if (hipOccupancyMaxActiveBlocksPerMultiprocessor(&per_cu, (const void*)fwd_kernel, 512, LDS_BYTES) != hipSuccess || per_cu < 1) { fprintf(stderr, "kernel_launch: occupancy query says %d blocks per CU\n", per_cu); (void)hipGetLastError(); grid = -1; return; }
        if (cus < GRID) { fprintf(stderr, "kernel_launch: needs %d CUs, device has %d\n", GRID, cus); grid = -1; return; }
        grid = GRID;
    }
    if (grid < 0) return;
    (void)hipMemsetAsync((char*)d_ws + WS_CTL, 0, CTL_BYTES, stream);
    Params p{};
    for (int i = 0; i < 19; ++i) p.in[i] = (const float*)d_in[i];
    hipLaunchKernelGGL(fwd_kernel, dim3(grid), dim3(512), LDS_BYTES, stream, p, (unsigned char*)d_ws, (unsigned char*)d_out);
}
```

```cpp
#include <hip/hip_runtime.h>
#include <cstdio>
#include <cstdint>

#define LAS __attribute__((address_space(3)))
#define GAS __attribute__((address_space(1)))
typedef float f32x2 __attribute__((ext_vector_type(2)));
typedef float f32x8 __attribute__((ext_vector_type(8)));
typedef float f32x16 __attribute__((ext_vector_type(16)));
typedef unsigned u32x2 __attribute__((ext_vector_type(2)));
typedef short s16x4 __attribute__((ext_vector_type(4)));
typedef __bf16 bf16x2v __attribute__((ext_vector_type(2)));

constexpr int DM = 2048, NSEQ = 12, LREAL = 4096, NMETA = 16, DEPTH = 4;
constexpr int NMAIN = NSEQ * LREAL;
constexpr int MROW0 = NMAIN;
constexpr int NTOK = NMAIN + NSEQ * NMETA;
constexpr int NPAN = 193, TP = NPAN * 256;
constexpr int PMETA = 192;
constexpr int INC = 4944, NIN = 5120;
constexpr int DFF = 5632, NUP = 2 * DFF;
constexpr int MLW = 1024, NQ = 1536, NKV = 2048;
constexpr float ALPHA = 1.681792830507429f;
constexpr float EPS = 1e-5f;
constexpr float NEGBIG = -1e30f;

constexpr size_t MiB = 1u << 20;
constexpr size_t WS_CTL = 0, CTL_BYTES = 1 * MiB;
constexpr size_t WS_COS = 1 * MiB;
constexpr size_t WS_SIN = WS_COS + (size_t)4112 * 32 * 4;
constexpr size_t WS_PAR = 2 * MiB + 128 * 1024;
constexpr int PO_BG = 0, PO_MLG = PO_BG + DEPTH * 16, PO_QG = PO_MLG + DEPTH * 1024, PO_KVG = PO_QG + DEPTH * 512, PO_L1G = PO_KVG + DEPTH * 256, PO_L1B = PO_L1G + DEPTH * 2048,
              PO_CW = PO_L1B + DEPTH * 2048, PO_CB = PO_CW + DEPTH * 3 * 5632, PO_L2G = PO_CB + DEPTH * 5632, PO_L2B = PO_L2G + DEPTH * 2048, PO_ONE = PO_L2B + DEPTH * 2048, PO_ZERO = PO_ONE + 2048, PO_END = PO_ZERO + 2048;
static_assert(WS_PAR + (size_t)PO_END * 4 <= 3 * MiB && WS_PAR >= 1 * MiB + 2 * 4112 * 32 * 4, "PAR block placement");
constexpr size_t WS_WIN = 3 * MiB;
constexpr size_t WS_WUQ = WS_WIN + (size_t)NIN * DM * 2;
constexpr size_t WS_WUKV = WS_WUQ + (size_t)NQ * 512 * 2;
constexpr size_t WS_WOUT = WS_WUKV + (size_t)NKV * 256 * 2;
constexpr size_t WS_WUP = WS_WOUT + (size_t)DM * DM * 2;
constexpr size_t WS_WDN = WS_WUP + (size_t)NUP * DM * 2;
constexpr size_t WS_STAT1 = WS_WDN + (size_t)DM * DFF * 2;
constexpr size_t WS_STAT2 = WS_CTL + 512 * 1024;
constexpr size_t WS_H = 100 * MiB;
constexpr size_t WS_PART = WS_H + 208 * MiB;
static_assert((size_t)NMAIN * DM * 2 <= 208 * MiB && 208 * MiB + (size_t)11 * 256 * DM * 4 <= (size_t)NMAIN * DM * 4, "PART sits between the bf16 rows and the f32 meta rows of H");
constexpr size_t WS_WSET2 = WS_H + 240 * MiB;
constexpr size_t WSET_BYTES = WS_STAT1 - WS_WIN, WSET_DELTA = WS_WSET2 - WS_WIN;
static_assert(WS_PART + (size_t)11 * 256 * DM * 4 <= WS_WSET2 && WS_WSET2 + WSET_BYTES <= WS_H + (size_t)NMAIN * DM * 4, "second weight set sits between the split-K parts and the f32 meta rows of H");
constexpr size_t WS_HB = WS_H + (size_t)TP * DM * 4;
constexpr size_t WS_R = WS_HB + (size_t)TP * DM * 2;
constexpr size_t WS_UQKVO = WS_R;
constexpr size_t WS_UDQ = WS_UQKVO + (size_t)TP * 4096 * 2;
constexpr size_t WS_UDKV = WS_UDQ + (size_t)TP * 512 * 2;
constexpr size_t WS_GATES = WS_UDKV + (size_t)TP * 256 * 2;
constexpr size_t WS_MKV = WS_GATES + (size_t)TP * 16 * 4;
constexpr size_t WS_KR = WS_MKV + (size_t)TP * NKV * 2;
constexpr size_t WS_RSTD = WS_KR + (size_t)TP * 64 * 2;
constexpr size_t WS_END_A = WS_RSTD + (size_t)TP * 2 * 4;
constexpr size_t WS_ACT = WS_R;
constexpr size_t WS_END_B = WS_ACT + (size_t)TP * DFF * 2;
constexpr size_t WS_NEED = (WS_END_A > WS_END_B ? WS_END_A : WS_END_B);
static_assert(WS_STAT1 + (size_t)TP * 8 <= WS_H && WS_STAT2 + (size_t)TP * 8 <= WS_CTL + CTL_BYTES, "weights and row statistics fit below H");
constexpr size_t DO_HSUM = 0;
constexpr size_t DO_MQ = DO_HSUM + (size_t)TP * MLW * 4;
constexpr size_t DO_GP = 340 * MiB;
constexpr size_t DO_SIDE = 0;
constexpr size_t DO_GVM = 32 * MiB;
static_assert(DO_MQ + (size_t)TP * NQ * 2 <= DO_GP && DO_GP + (size_t)96 * 65 * 200 * 4 <= (size_t)NMAIN * DM * 4 && (size_t)192 * 6 * DFF * 4 <= DO_GVM && DO_GVM + (size_t)256 * NUP * 2 <= (size_t)NMAIN * DM * 4, "d_out scratch fits");
constexpr int CW_BAR = 4096;

constexpr int RING_BYTES = 131072;
constexpr int MISC_OFF = RING_BYTES;
constexpr int LDS_BYTES = 147456;
constexpr int GRID = 256;

__device__ __forceinline__ int pos_of_row(int row) { return row < NMAIN ? NMETA + (row & (LREAL - 1)) : ((row - NMAIN) & (NMETA - 1)); }
__device__ __forceinline__ unsigned pk2(float lo, float hi) { f32x2 v = {lo, hi}; return __builtin_bit_cast(unsigned, __builtin_convertvector(v, bf16x2v)); }
__device__ __forceinline__ float bf_lo(unsigned w) { return __uint_as_float(w << 16); }
__device__ __forceinline__ float bf_hi(unsigned w) { return __uint_as_float(w & 0xffff0000u); }
typedef _Float16 f16x2v __attribute__((ext_vector_type(2)));
__device__ __forceinline__ unsigned pk2h(float lo, float hi) { f32x2 v = {lo, hi}; return __builtin_bit_cast(unsigned, __builtin_convertvector(v, f16x2v)); }
__device__ __forceinline__ float hf_lo(unsigned w) { return (float)__builtin_bit_cast(f16x2v, w)[0]; }
__device__ __forceinline__ float hf_hi(unsigned w) { return (float)__builtin_bit_cast(f16x2v, w)[1]; }
__device__ __forceinline__ float wave_sum(float v) {
#pragma unroll
    for (int o = 1; o < 64; o <<= 1) v += __shfl_xor(v, o);
    return v;
}
__device__ __forceinline__ float wave_max(float v) {
#pragma unroll
    for (int o = 1; o < 64; o <<= 1) v = fmaxf(v, __shfl_xor(v, o));
    return v;
}
namespace pg8 {
#define PG8_LAS __attribute__((address_space(3)))
typedef unsigned short bf16_t;
typedef short bf16x8 __attribute__((ext_vector_type(8)));
typedef float f32x4 __attribute__((ext_vector_type(4)));
typedef unsigned u32x4 __attribute__((ext_vector_type(4)));
constexpr int BM = 256, BK = 64, HALF = 128, HTB = HALF * BK * 2  , STAGE_BYTES = 8 * HTB, NXCD = 8, WGM = 4;

__host__ __device__ __forceinline__ int lds_byte(int r, int c) { const int st = (r >> 4) * 2 + (c >> 5), rr = r & 15, cc = c & 31, ob = rr * 64 + cc * 2; return st * 1024 + (ob ^ (((ob >> 9) & 1) << 5)); }
__host__ __device__ __forceinline__ void stage_rc(int b, int& R, int& C) { const int st = b / 1024, sb = b % 1024, swz = sb ^ (((sb >> 9) & 1) << 5); R = (st >> 1) * 16 + swz / 64; C = (st & 1) * 32 + (swz % 64) / 2; }
__host__ __device__ __forceinline__ int perm32(int rho) { const int n = rho >> 4, i = rho & 15; return 8 * (i >> 2) + 4 * n + (i & 3); }

struct Unit { int pm, pn, kk; };
struct Gemm { const bf16_t* A; const bf16_t* Bt; int M, N, K, ld; };

struct PanelOrder {
    int nM, nN, nwg, G, c, nMain, pm0, pmx;
    __device__ void init(int nMain_, int pm0_, int extra, int pmx_, int N, int G_, int c_) { nMain = nMain_; pm0 = pm0_; pmx = pmx_; nM = nMain_ + extra; nN = N / BM; nwg = nM * nN; G = G_; c = c_; }
    __device__ bool next(int i, Unit& u) const {
        const long L = (long)i * G + c; if (L >= nwg) return false;
        int wgid = (int)L; { const int q = nwg / NXCD, r = nwg % NXCD, xcd = wgid % NXCD, off = wgid / NXCD; wgid = (xcd < r ? xcd * (q + 1) : r * (q + 1) + (xcd - r) * q) + off; }
        const int nig = WGM * nN, gid = wgid / nig, fm = gid * WGM, gsz = (nM - fm) < WGM ? (nM - fm) : WGM;
        const int pl = fm + ((wgid % nig) % gsz); u.pm = pl < nMain ? pm0 + pl : pmx; u.pn = (wgid % nig) / gsz; u.kk = 0; return true;
    }
    __device__ __forceinline__ void a_ready(const Unit&) const {}
    __device__ __forceinline__ void done(const Unit&) const {}
};

struct SplitOrder {
    int pm, nN, nwg, G, c;
    __device__ void init(int pm_, int N, int nsplit, int G_, int c_) { pm = pm_; nN = N / BM; nwg = nN * nsplit; G = G_; c = c_; }
    __device__ bool next(int i, Unit& u) const { const int L = i * G + c; if (L >= nwg) return false; u.pm = pm; u.pn = L % nN; u.kk = L / nN; return true; }
    __device__ __forceinline__ void a_ready(const Unit&) const {}
    __device__ __forceinline__ void done(const Unit&) const {}
};

__device__ __forceinline__ u32x4 pack8(const f32x4 v0, const f32x4 v1) { u32x4 w; w.x = pk2(v0[0], v0[1]); w.y = pk2(v0[2], v0[3]); w.z = pk2(v1[0], v1[1]); w.w = pk2(v1[2], v1[3]); return w; }

struct EpiBf16G {
    static constexpr bool PERM = true, AFTER_DRAIN = false, PERMA = false;
    bf16_t* O; int ldc; const float* rs; int pm_sub, pm_sp, pm_sp_out;
    __device__ __forceinline__ void operator()(const f32x4 (&acc)[2][2][4][2], const Unit& u, int wr, int wc, int fr, int fq) const {
        const int opm = (u.pm == pm_sp) ? pm_sp_out : u.pm - pm_sub;
        const int rin = u.pm * BM + wr * 64 + fr, rout = opm * BM + wr * 64 + fr, col0 = u.pn * BM + wc * 32 + 8 * fq;
#pragma unroll
        for (int ai = 0; ai < 2; ++ai)
#pragma unroll
            for (int m = 0; m < 4; ++m) { const float sc = rs ? rs[(size_t)(rin + ai * HALF + m * 16) * 2] : 1.f;
                bf16_t* rowp = O + (size_t)(rout + ai * HALF + m * 16) * ldc + col0;
#pragma unroll
                for (int bj = 0; bj < 2; ++bj) *(u32x4*)(rowp + bj * HALF) = pack8(acc[ai][bj][m][0] * sc, acc[ai][bj][m][1] * sc); }
    }
};
struct EpiWin {
    static constexpr bool PERM = true, AFTER_DRAIN = false, PERMA = false;
    bf16_t *UQKVO, *UDQ, *UDKV, *KR; float* GATES; const float *COS, *SIN;
    __device__ __forceinline__ void operator()(const f32x4 (&acc)[2][2][4][2], const Unit& u, int wr, int wc, int fr, int fq) const {
        const int row0 = u.pm * BM + wr * 64 + fr;
        if (u.pn < 19) {
            bf16_t* base; int ldc, colt;
            if (u.pn < 16) { base = UQKVO; ldc = 4096; colt = u.pn * BM; } else if (u.pn < 18) { base = UDQ; ldc = 512; colt = (u.pn - 16) * BM; } else { base = UDKV; ldc = 256; colt = 0; }
            const int col0 = colt + wc * 32 + 8 * fq;
#pragma unroll
            for (int ai = 0; ai < 2; ++ai)
#pragma unroll
                for (int m = 0; m < 4; ++m) { bf16_t* rowp = base + (size_t)(row0 + ai * HALF + m * 16) * ldc + col0;
#pragma unroll
                    for (int bj = 0; bj < 2; ++bj) *(u32x4*)(rowp + bj * HALF) = pack8(acc[ai][bj][m][0], acc[ai][bj][m][1]); }
        } else {
            if (wc < 2) { const int g = 4 * wc + fq;
#pragma unroll
                for (int ai = 0; ai < 2; ++ai)
#pragma unroll
                    for (int m = 0; m < 4; ++m) { const int row = row0 + ai * HALF + m * 16, pos = pos_of_row(row);
                        const f32x4 cs = *(const f32x4*)(COS + pos * 32 + 4 * g), sn = *(const f32x4*)(SIN + pos * 32 + 4 * g);
                        const f32x4 x1 = acc[ai][0][m][0], x2 = acc[ai][0][m][1];
                        *(u32x4*)(KR + (size_t)row * 64 + 8 * g) = pack8(x1 * cs - x2 * sn, x1 * sn + x2 * cs); }
            } else if (wc == 2 && fq < 2) {
#pragma unroll
                for (int ai = 0; ai < 2; ++ai)
#pragma unroll
                    for (int m = 0; m < 4; ++m) { float* gp = GATES + (size_t)(row0 + ai * HALF + m * 16) * 16 + 8 * fq;
                        *(f32x4*)gp = acc[ai][0][m][0]; *(f32x4*)(gp + 4) = acc[ai][0][m][1]; }
            }
        }
    }
};
struct EpiQ {
    static constexpr bool PERM = true, AFTER_DRAIN = false, PERMA = false;
    bf16_t* MQ; const float *RSTD, *COS, *SIN;
    __device__ __forceinline__ void operator()(const f32x4 (&acc)[2][2][4][2], const Unit& u, int wr, int wc, int fr, int fq) const {
        const int row0 = u.pm * BM + wr * 64 + fr, colb = u.pn * BM + wc * 32 + 8 * fq;
#pragma unroll
        for (int ai = 0; ai < 2; ++ai)
#pragma unroll
            for (int m = 0; m < 4; ++m) { const int row = row0 + ai * HALF + m * 16, pos = pos_of_row(row); const float sc = RSTD[(size_t)row * 2] * 0.10411754961539605f;
#pragma unroll
                for (int bj = 0; bj < 2; ++bj) { const int col0 = colb + bj * HALF, o = col0 % 192;
                    f32x4 v0 = acc[ai][bj][m][0] * sc, v1 = acc[ai][bj][m][1] * sc;
                    if (o >= 128) { const int g = (o - 128) >> 3; const f32x4 cs = *(const f32x4*)(COS + pos * 32 + 4 * g), sn = *(const f32x4*)(SIN + pos * 32 + 4 * g);
                        const f32x4 x1 = v0, x2 = v1; v0 = x1 * cs - x2 * sn; v1 = x1 * sn + x2 * cs; }
                    *(u32x4*)(MQ + (size_t)row * NQ + col0) = pack8(v0, v1); } }
    }
};
__device__ __forceinline__ void resid_ln_tile(float* __restrict__ Cw, const float* __restrict__ Cr, const float* __restrict__ st, const float* __restrict__ g, const float* __restrict__ b,
                                              int ldc, float alpha, const f32x4 (&acc)[2][2][4][2], int row0, int col0) {
    asm volatile("" ::: "memory");
#pragma unroll
    for (int ai = 0; ai < 2; ++ai)
#pragma unroll
        for (int bj = 0; bj < 2; ++bj) {
            f32x4 gv[2], bv[2], hv[4][2]; f32x2 ms[4];
#pragma unroll
            for (int n = 0; n < 2; ++n) { gv[n] = *(const f32x4*)(g + col0 + bj * HALF + n * 16) * alpha; bv[n] = *(const f32x4*)(b + col0 + bj * HALF + n * 16) * alpha; }
#pragma unroll
            for (int m = 0; m < 4; ++m) { const int row = row0 + ai * HALF + m * 16; ms[m] = *(const f32x2*)(st + (size_t)row * 2);
#pragma unroll
                for (int n = 0; n < 2; ++n) hv[m][n] = *(const f32x4*)(Cr + (size_t)row * ldc + col0 + bj * HALF + n * 16); }
#pragma unroll
            for (int m = 0; m < 4; ++m) { const int row = row0 + ai * HALF + m * 16;
#pragma unroll
                for (int n = 0; n < 2; ++n) *(f32x4*)(Cw + (size_t)row * ldc + col0 + bj * HALF + n * 16) = (hv[m][n] - ms[m][0]) * ms[m][1] * gv[n] + bv[n] + acc[ai][bj][m][n]; }
        }
}
__device__ __forceinline__ void resid_ln_tile_bf(bf16_t* __restrict__ Cw, const bf16_t* __restrict__ Cr, const float* __restrict__ st, const float* __restrict__ g, const float* __restrict__ b,
                                                 int ldc, float alpha, const f32x4 (&acc)[2][2][4][2], int row0, int col0) {
    asm volatile("" ::: "memory");
    f32x4 gv[2][2], bv[2][2];
#pragma unroll
    for (int bj = 0; bj < 2; ++bj)
#pragma unroll
        for (int n = 0; n < 2; ++n) { gv[bj][n] = *(const f32x4*)(g + col0 + bj * HALF + n * 4); bv[bj][n] = *(const f32x4*)(b + col0 + bj * HALF + n * 4); }
#pragma unroll
    for (int ai = 0; ai < 2; ++ai) {
        u32x4 hv[2][4]; f32x2 ms[4];
#pragma unroll
        for (int m = 0; m < 4; ++m) { const int row = row0 + ai * HALF + m * 16; ms[m] = *(const f32x2*)(st + (size_t)row * 2);
#pragma unroll
            for (int bj = 0; bj < 2; ++bj) hv[bj][m] = *(const u32x4*)(Cr + (size_t)row * ldc + col0 + bj * HALF); }
#pragma unroll
        for (int bj = 0; bj < 2; ++bj)
#pragma unroll
            for (int m = 0; m < 4; ++m) { const int row = row0 + ai * HALF + m * 16; const u32x4 h = hv[bj][m]; const float mean = ms[m][0], rstd = ms[m][1];
                const f32x4 h0 = {hf_lo(h.x), hf_hi(h.x), hf_lo(h.y), hf_hi(h.y)}, h1 = {hf_lo(h.z), hf_hi(h.z), hf_lo(h.w), hf_hi(h.w)};
                const f32x4 o0 = ((h0 - mean) * rstd * gv[bj][0] + bv[bj][0]) * alpha + acc[ai][bj][m][0], o1 = ((h1 - mean) * rstd * gv[bj][1] + bv[bj][1]) * alpha + acc[ai][bj][m][1];
                u32x4 w; w.x = pk2h(o0[0], o0[1]); w.y = pk2h(o0[2], o0[3]); w.z = pk2h(o1[0], o1[1]); w.w = pk2h(o1[2], o1[3]);
                *(u32x4*)(Cw + (size_t)row * ldc + col0 + bj * HALF) = w; }
    }
}
struct EpiResidLn {
    static constexpr bool PERM = true, AFTER_DRAIN = false, PERMA = false;
    bf16_t* C; int ldc; float alpha; const float* st; const float* g; const float* b;
    __device__ __forceinline__ void operator()(const f32x4 (&acc)[2][2][4][2], const Unit& u, int wr, int wc, int fr, int fq) const {
        resid_ln_tile_bf(this->C, this->C, this->st, this->g, this->b, this->ldc, this->alpha, acc, u.pm * BM + wr * 64 + fr, u.pn * BM + wc * 32 + 8 * fq);
    }
};
struct EpiPart {
    static constexpr bool PERM = false, AFTER_DRAIN = false, PERMA = false;
    float* P; int ldc;
    __device__ __forceinline__ void operator()(const f32x4 (&acc)[2][2][4][2], const Unit& u, int wr, int wc, int fr, int fq) const {
        const int row0 = u.kk * BM + wr * 64 + fr, col0 = u.pn * BM + wc * 32 + 4 * fq;
#pragma unroll
        for (int ai = 0; ai < 2; ++ai)
#pragma unroll
            for (int m = 0; m < 4; ++m) { float* rowp = P + (size_t)(row0 + ai * HALF + m * 16) * ldc + col0;
#pragma unroll
                for (int bj = 0; bj < 2; ++bj)
#pragma unroll
                    for (int n = 0; n < 2; ++n) *(f32x4*)(rowp + bj * HALF + n * 16) = acc[ai][bj][m][n]; }
    }
};

__device__ __forceinline__ float dpp_shr1_old(float old, float x) { return __int_as_float(__builtin_amdgcn_update_dpp(__float_as_int(old), __float_as_int(x), 0x111, 0xf, 0xf, false)); }
__device__ __forceinline__ float dpp_shl1_old(float old, float x) { return __int_as_float(__builtin_amdgcn_update_dpp(__float_as_int(old), __float_as_int(x), 0x101, 0xf, 0xf, false)); }
struct EpiFfn {
    static constexpr bool PERM = true, AFTER_DRAIN = false, PERMA = true;
    bf16_t* ACT; float* SIDE; bf16_t* GVM; const float *cw, *cb; PG8_LAS float* X;
    __device__ __forceinline__ void operator()(const f32x4 (&acc)[2][2][4][2], const Unit& u, int wr_in, int wc_in, int fr_in, int fq_in) const {
        int fr = fr_in, fq = fq_in, wr = wr_in, wc = wc_in; asm volatile("" : "+v"(fr), "+v"(fq), "+s"(wr), "+s"(wc));
        const int cj = wc * 32 + 8 * fq, c0 = u.pn * 128 + cj;
        if (u.pm == PMETA) {
#pragma unroll
            for (int ai = 0; ai < 2; ++ai)
#pragma unroll
                for (int m = 0; m < 4; ++m) { bf16_t* rowp = GVM + (size_t)(ai * HALF + wr * 64 + 4 * fr + m) * NUP + c0;
                    *(u32x4*)rowp = pack8(acc[ai][0][m][0], acc[ai][0][m][1]); *(u32x4*)(rowp + DFF) = pack8(acc[ai][1][m][0], acc[ai][1][m][1]); }
            return;
        }
        f32x4 w0[2], w1[2], w2[2], bb[2];
#pragma unroll
        for (int n = 0; n < 2; ++n) { w0[n] = *(const f32x4*)(cw + c0 + 4 * n); w1[n] = *(const f32x4*)(cw + DFF + c0 + 4 * n); w2[n] = *(const f32x4*)(cw + 2 * DFF + c0 + 4 * n); bb[n] = *(const f32x4*)(cb + c0 + 4 * n); }
#pragma unroll
        for (int ai = 0; ai < 2; ++ai) { const int b = 2 * ai + wr;
            if (fr == 0) { *(PG8_LAS f32x4*)(X + (b * 2 + 0) * 128 + cj) = acc[ai][0][0][0]; *(PG8_LAS f32x4*)(X + (b * 2 + 0) * 128 + cj + 4) = acc[ai][0][0][1]; }
            if (fr == 15) { *(PG8_LAS f32x4*)(X + (b * 2 + 1) * 128 + cj) = acc[ai][0][3][0]; *(PG8_LAS f32x4*)(X + (b * 2 + 1) * 128 + cj + 4) = acc[ai][0][3][1]; } }
        asm volatile("s_waitcnt lgkmcnt(0)" ::: "memory"); __builtin_amdgcn_s_barrier(); asm volatile("" ::: "memory");
        const unsigned rowb = (unsigned)(u.pm * BM + wr * 64 + 4 * fr) * DFF + c0;
#pragma unroll
        for (int ai = 0; ai < 2; ++ai) { const int b = 2 * ai + wr;
            f32x4 xp[2], xn[2];
#pragma unroll
            for (int n = 0; n < 2; ++n) { xp[n] = b > 0 ? *(const PG8_LAS f32x4*)(X + ((b - 1) * 2 + 1) * 128 + cj + 4 * n) : (f32x4){0.f, 0.f, 0.f, 0.f};
                                          xn[n] = b < 3 ? *(const PG8_LAS f32x4*)(X + ((b + 1) * 2 + 0) * 128 + cj + 4 * n) : (f32x4){0.f, 0.f, 0.f, 0.f}; }
            f32x4 up0[2], dn3[2];
#pragma unroll
            for (int n = 0; n < 2; ++n)
#pragma unroll
                for (int e = 0; e < 4; ++e) { up0[n][e] = dpp_shr1_old(xp[n][e], acc[ai][0][3][n][e]); dn3[n][e] = dpp_shl1_old(xn[n][e], acc[ai][0][0][n][e]); }
#pragma unroll
            for (int m = 0; m < 4; ++m) { u32x4 ow;
#pragma unroll
                for (int n = 0; n < 2; ++n) {
                    const f32x4 g = acc[ai][0][m][n], pv = m > 0 ? acc[ai][0][m > 0 ? m - 1 : 0][n] : up0[n], nx = m < 3 ? acc[ai][0][m < 3 ? m + 1 : 3][n] : dn3[n];
                    const f32x4 x = w0[n] * pv + w1[n] * g + w2[n] * nx + bb[n]; f32x4 t, o;
#pragma unroll
                    for (int e = 0; e < 4; ++e) t[e] = __expf(-x[e]);
                    t = t + 1.f;
#pragma unroll
                    for (int e = 0; e < 4; ++e) t[e] = __builtin_amdgcn_rcpf(t[e]);
                    o = x * t * acc[ai][1][m][n];
                    if (n == 0) { ow.x = pk2(o[0], o[1]); ow.y = pk2(o[2], o[3]); } else { ow.z = pk2(o[0], o[1]); ow.w = pk2(o[2], o[3]); } }
                bf16_t* dst = ACT + (rowb + (unsigned)(ai * HALF + m) * DFF);
                if (ai == 0 ? m < 2 : m >= 2) {
                    const int r = ai * HALF + wr * 64 + 4 * fr + m;
                    if (r != 0 && r != 255) *(u32x4*)dst = ow;
                    const int slot = r == 0 ? 0 : r == 1 ? 1 : r == 254 ? 2 : r == 255 ? 3 : -1;
                    if (slot >= 0) { float* sp = SIDE + ((size_t)u.pm * 6 + slot) * DFF + c0; *(f32x4*)sp = acc[ai][0][m][0]; *(f32x4*)(sp + 4) = acc[ai][0][m][1];
                        if (slot == 0 || slot == 3) { float* vp = SIDE + ((size_t)u.pm * 6 + (slot == 0 ? 4 : 5)) * DFF + c0; *(f32x4*)vp = acc[ai][1][m][0]; *(f32x4*)(vp + 4) = acc[ai][1][m][1]; } }
                } else *(u32x4*)dst = ow;
            }
        }
    }
};
template <class Epi, class Sched, bool ALIGN_EPI = false, bool SP2 = false>
__device__ __forceinline__ void gemm_phase(PG8_LAS unsigned char* lds, const Gemm g, const Sched& S, const Epi& E) {
    int tid_ = threadIdx.x; asm volatile("" : "+v"(tid_));
    const int tid = tid_, wid = __builtin_amdgcn_readfirstlane(tid >> 6), lane = tid & 63, wr = wid >> 2, wc = wid & 3, fr = lane & 15, fq = lane >> 4;
    const int K = g.ld, nt = g.K / BK;
    unsigned voffA[2], voffB[2];
#pragma unroll
    for (int i = 0; i < 2; ++i) { int R, C; stage_rc(tid * 16 + i * 8192, R, C); const int Rb = Epi::PERM ? ((R & ~31) + perm32(R & 31)) : R;
        const int Ra = Epi::PERMA ? ((R & ~63) | ((R & 15) << 2) | ((R >> 4) & 3)) : R;
        voffA[i] = (unsigned)(Ra * K + C) * 2u; voffB[i] = (unsigned)(Rb * K + C) * 2u; }
    const size_t kstep = (size_t)(BK * 2);
    const size_t hstep = (size_t)HALF * K * 2;
    const size_t tstep = 2 * hstep;
    const unsigned ldsw = (unsigned)wid * 1024u;
    const int aoff = lds_byte(wr * 64 + fr, fq * 8), boff = lds_byte(wc * 32 + fr, fq * 8);
#define PG8_SA(b, h) (((b) * 2 + (h)) * HTB)
#define PG8_SB(b, h) ((4 + (b) * 2 + (h)) * HTB)
#define PG8_STAGE(bufoff, gbase, voff) do { _Pragma("unroll") for (int _i = 0; _i < 2; ++_i) \
        __builtin_amdgcn_global_load_lds((const unsigned*)((const char*)(gbase) + (voff)[_i]), (PG8_LAS unsigned*)(lds + (bufoff) + ldsw + _i * 8192), 16, 0, 0); } while (0)
#define PG8_LDA(dst, b, h) do { _Pragma("unroll") for (int m = 0; m < 4; ++m) _Pragma("unroll") for (int k = 0; k < 2; ++k) dst[m][k] = *(const PG8_LAS bf16x8*)(lds + PG8_SA(b, h) + aoff + m * 2048 + k * 1024); } while (0)
#define PG8_LDB(dst, b, h) do { _Pragma("unroll") for (int n = 0; n < 2; ++n) _Pragma("unroll") for (int k = 0; k < 2; ++k) dst[n][k] = *(const PG8_LAS bf16x8*)(lds + PG8_SB(b, h) + boff + n * 2048 + k * 1024); } while (0)
#define PG8_MMA(ai, bj, At, Bt) do { __builtin_amdgcn_s_setprio(1); _Pragma("unroll") for (int m = 0; m < 4; ++m) _Pragma("unroll") for (int n = 0; n < 2; ++n) _Pragma("unroll") for (int k = 0; k < 2; ++k) \
        acc[ai][bj][m][n] = __builtin_amdgcn_mfma_f32_16x16x32_bf16(Bt[n][k], At[m][k], acc[ai][bj][m][n], 0, 0, 0); __builtin_amdgcn_s_setprio(0); } while (0)
#define PG8_WAIT_V(n) asm volatile("s_waitcnt vmcnt(" #n ")" ::: "memory")
#define PG8_WAIT_L(n) asm volatile("s_waitcnt lgkmcnt(" #n ")" ::: "memory")
#define PG8_BAR __builtin_amdgcn_s_barrier()
#define PG8_SCHED __builtin_amdgcn_sched_barrier(0)
    Unit cur, nxt; int ui = 0;
    if (!S.next(0, cur)) return;
    f32x4 acc[2][2][4][2];
#pragma unroll
    for (int a = 0; a < 2; ++a)
#pragma unroll
        for (int b = 0; b < 2; ++b)
#pragma unroll
            for (int m = 0; m < 4; ++m)
#pragma unroll
                for (int n = 0; n < 2; ++n) acc[a][b][m][n] = (f32x4){0.f, 0.f, 0.f, 0.f};
    bf16x8 At[4][2], B0[2][2], B1[2][2];
    const size_t sstep = (size_t)g.K * 2;
    const char* cA = (const char*)g.A + (size_t)cur.pm * tstep + (size_t)cur.kk * sstep; const char* cB = (const char*)g.Bt + (size_t)cur.pn * tstep + (size_t)cur.kk * sstep;
    S.a_ready(cur);
    if constexpr (SP2) {
        PG8_STAGE(PG8_SB(0, 0), cB, voffB); PG8_STAGE(PG8_SB(0, 1), cB + hstep, voffB); PG8_STAGE(PG8_SA(0, 0), cA, voffA); PG8_STAGE(PG8_SA(0, 1), cA + hstep, voffA);
        if (wr == 1) PG8_BAR;
        PG8_WAIT_V(2); PG8_BAR;
        PG8_STAGE(PG8_SB(1, 0), cB + kstep, voffB); PG8_STAGE(PG8_SA(1, 0), cA + kstep, voffA); PG8_STAGE(PG8_SB(1, 1), cB + hstep + kstep, voffB);
        PG8_WAIT_V(6); PG8_BAR;
    } else {
        PG8_STAGE(PG8_SB(0, 0), cB, voffB); PG8_STAGE(PG8_SA(0, 0), cA, voffA); PG8_STAGE(PG8_SB(0, 1), cB + hstep, voffB); PG8_STAGE(PG8_SA(0, 1), cA + hstep, voffA);
        if (wr == 1) PG8_BAR;
        PG8_WAIT_V(4); PG8_BAR;
        PG8_STAGE(PG8_SB(1, 0), cB + kstep, voffB); PG8_STAGE(PG8_SA(1, 0), cA + kstep, voffA); PG8_STAGE(PG8_SB(1, 1), cB + hstep + kstep, voffB);
        PG8_WAIT_V(6); PG8_BAR;
    }
    for (;;) {
        const bool has_next = S.next(ui + 1, nxt);
        const char* nA = has_next ? (const char*)g.A + (size_t)nxt.pm * tstep + (size_t)nxt.kk * sstep : cA; const char* nB = has_next ? (const char*)g.Bt + (size_t)nxt.pn * tstep + (size_t)nxt.kk * sstep : cB;
        for (int t = 0; t < nt; t += 2) {
            const bool last = (t == nt - 2);
            const char* a1 = cA + (size_t)(t + 1) * kstep;
            const char* a2 = last ? nA : cA + (size_t)(t + 2) * kstep; const char* b2 = last ? nB : cB + (size_t)(t + 2) * kstep;
            const char* a3 = a2 + kstep; const char* b3 = b2 + kstep;
            if (last && has_next) S.a_ready(nxt);
            if constexpr (SP2) {
            PG8_LDB(B0, 0, 0); PG8_LDB(B1, 0, 1); PG8_SCHED; PG8_LDA(At, 0, 0); PG8_STAGE(PG8_SA(1, 1), a1 + hstep, voffA);
            PG8_WAIT_V(8); PG8_WAIT_L(0); PG8_BAR; PG8_MMA(0, 0, At, B0); PG8_MMA(0, 1, At, B1); PG8_BAR; PG8_SCHED;
            PG8_LDA(At, 0, 1); PG8_STAGE(PG8_SB(0, 0), b2, voffB); PG8_STAGE(PG8_SB(0, 1), b2 + hstep, voffB); PG8_STAGE(PG8_SA(0, 0), a2, voffA);
            PG8_WAIT_V(8); PG8_WAIT_L(0); PG8_BAR; PG8_MMA(1, 0, At, B0); PG8_MMA(1, 1, At, B1); PG8_BAR; PG8_SCHED;
            PG8_LDB(B0, 1, 0); PG8_LDB(B1, 1, 1); PG8_SCHED; PG8_LDA(At, 1, 0); PG8_STAGE(PG8_SA(0, 1), a2 + hstep, voffA);
            PG8_WAIT_V(8); PG8_WAIT_L(0); PG8_BAR; PG8_MMA(0, 0, At, B0); PG8_MMA(0, 1, At, B1); PG8_BAR; PG8_SCHED;
            PG8_LDA(At, 1, 1); PG8_STAGE(PG8_SB(1, 0), b3, voffB); PG8_STAGE(PG8_SB(1, 1), b3 + hstep, voffB); PG8_STAGE(PG8_SA(1, 0), a3, voffA);
            PG8_WAIT_V(8); PG8_WAIT_L(0); PG8_BAR; PG8_MMA(1, 0, At, B0); PG8_MMA(1, 1, At, B1); PG8_BAR; PG8_SCHED;
            } else {
            PG8_LDB(B0, 0, 0); PG8_SCHED; PG8_LDA(At, 0, 0); PG8_STAGE(PG8_SA(1, 1), a1 + hstep, voffA);
            PG8_WAIT_L(8); PG8_BAR; PG8_WAIT_L(0); PG8_MMA(0, 0, At, B0); PG8_BAR; PG8_SCHED;
            PG8_LDB(B1, 0, 1); PG8_STAGE(PG8_SB(0, 0), b2, voffB);
            PG8_BAR; PG8_WAIT_L(0); PG8_MMA(0, 1, At, B1); PG8_BAR;
            PG8_LDA(At, 0, 1); PG8_STAGE(PG8_SA(0, 0), a2, voffA);
            PG8_BAR; PG8_WAIT_L(0); PG8_MMA(1, 0, At, B0); PG8_BAR; PG8_SCHED;
            PG8_STAGE(PG8_SB(0, 1), b2 + hstep, voffB);
            PG8_WAIT_V(6); PG8_BAR; PG8_MMA(1, 1, At, B1); PG8_BAR;
            PG8_LDB(B0, 1, 0); PG8_SCHED; PG8_LDA(At, 1, 0); PG8_STAGE(PG8_SA(0, 1), a2 + hstep, voffA);
            PG8_WAIT_L(8); PG8_BAR; PG8_WAIT_L(0); PG8_MMA(0, 0, At, B0); PG8_BAR; PG8_SCHED;
            PG8_LDB(B1, 1, 1); PG8_STAGE(PG8_SB(1, 0), b3, voffB);
            PG8_BAR; PG8_WAIT_L(0); PG8_MMA(0, 1, At, B1); PG8_BAR;
            PG8_LDA(At, 1, 1); PG8_STAGE(PG8_SA(1, 0), a3, voffA);
            PG8_BAR; PG8_WAIT_L(0); PG8_MMA(1, 0, At, B0); PG8_BAR; PG8_SCHED;
            PG8_STAGE(PG8_SB(1, 1), b3 + hstep, voffB);
            PG8_WAIT_V(6); PG8_BAR; PG8_MMA(1, 1, At, B1); PG8_BAR;
            }
        }
        if constexpr (ALIGN_EPI) { if (wr == 0) PG8_BAR; }
        if constexpr (!Epi::AFTER_DRAIN) { E(acc, cur, wr, wc, fr, fq); S.done(cur); }
        if (!has_next) break;
#pragma unroll
        for (int a = 0; a < 2; ++a)
#pragma unroll
            for (int b = 0; b < 2; ++b)
#pragma unroll
                for (int m = 0; m < 4; ++m)
#pragma unroll
                    for (int n = 0; n < 2; ++n) acc[a][b][m][n] = (f32x4){0.f, 0.f, 0.f, 0.f};
        cur = nxt; cA = nA; cB = nB; ++ui;
        if constexpr (ALIGN_EPI) { if (wr == 1) PG8_BAR; }
    }
    PG8_WAIT_V(0);
    if constexpr (!ALIGN_EPI) { if (wr == 0) PG8_BAR; }
    PG8_BAR;
    if constexpr (Epi::AFTER_DRAIN) { E.fused(acc, cur, wr, wc, fr, fq, lds, wid, lane); S.done(cur); }
#undef PG8_SA
#undef PG8_SB
#undef PG8_STAGE
#undef PG8_LDA
#undef PG8_LDB
#undef PG8_MMA
#undef PG8_WAIT_V
#undef PG8_WAIT_L
#undef PG8_BAR
#undef PG8_SCHED
}
}
#define XB_TMO      128
#define XB_XCNT(j)  (256  + 64 * (j))
#define XB_XSUB(j)  (1280 + 64 * (j))
#define XB_XGEN(j)  (2304 + 64 * (j))
#define XB_TOP      3328
#define XB_TOPGEN   3392
#define XCD_BAR_WORDS 3456
#define XB_SPIN_CAP (1u << 21)

__device__ __forceinline__ unsigned xb_ld(unsigned* p)              { return __hip_atomic_load(p, __ATOMIC_RELAXED, __HIP_MEMORY_SCOPE_AGENT); }
__device__ __forceinline__ unsigned xb_add(unsigned* p, unsigned v) { return __hip_atomic_fetch_add(p, v, __ATOMIC_RELAXED, __HIP_MEMORY_SCOPE_AGENT); }
__device__ __forceinline__ unsigned xb_xcc_id() { return (unsigned)__builtin_amdgcn_s_getreg((3 << 11) | 20) & 0xFu; }
#define XB_SPIN(cond, bar) do { unsigned _sp = 0; while (cond) { __builtin_amdgcn_s_sleep(1); \
    if ((++_sp & 255u) == 0u) { if (xb_ld(&(bar)[XB_TMO])) break; if (_sp > XB_SPIN_CAP) { atomicAdd(&(bar)[XB_TMO], 1u); break; } } } } while (0)

struct XcdBarrier {
    unsigned* bar; unsigned x;
    volatile LAS unsigned* st;
};

__device__ __forceinline__ XcdBarrier xcd_barrier_post(unsigned* bar, volatile LAS unsigned* st) {
    XcdBarrier b; b.bar = bar; b.x = (unsigned)__builtin_amdgcn_readfirstlane((int)xb_xcc_id()); b.st = st;
    if (threadIdx.x == 0) (void)xb_add(&bar[XB_XCNT(b.x)], 1u);
    return b;
}
__device__ __forceinline__ void xcd_barrier_complete(unsigned* bar, unsigned x, unsigned& nloc, unsigned& nx) {
    const unsigned G = gridDim.x * gridDim.y * gridDim.z;
    unsigned sum, cnt, mine, sp = 0u;
    for (;;) {
        sum = 0u; cnt = 0u; mine = 0u;
#pragma unroll
        for (unsigned j = 0; j < 16; ++j) { const unsigned c = xb_ld(&bar[XB_XCNT(j)]); sum += c; cnt += (c > 0u) ? 1u : 0u; }
        mine = xb_ld(&bar[XB_XCNT(x)]);
        if (sum == G) { mine = xb_ld(&bar[XB_XCNT(x)]); break; }
        __builtin_amdgcn_s_sleep(1);
        if ((++sp & 255u) == 0u) { if (xb_ld(&bar[XB_TMO])) break; if (sp > XB_SPIN_CAP) { atomicAdd(&bar[XB_TMO], 1u); break; } }
    }
    nloc = mine > 0u ? mine : 1u; nx = cnt > 0u ? cnt : 1u;
}

__device__ __forceinline__ void xcd_barrier(const XcdBarrier& b) {
    asm volatile("s_waitcnt vmcnt(0)" ::: "memory");
    __syncthreads();
    if (threadIdx.x == 0) {
        unsigned* bar = b.bar; unsigned bx_ = b.x;
        asm volatile("" : "+s"(bx_));
        __builtin_amdgcn_s_waitcnt(0);
        unsigned nloc = b.st[0], nx = b.st[1];
        if (nloc == 0u) { xcd_barrier_complete(bar, bx_, nloc, nx); b.st[0] = nloc; b.st[1] = nx; }
        const unsigned old = xb_add(&bar[XB_XSUB(bx_)], 1u);
        const unsigned gen = old / nloc;
        if (old + 1u == (gen + 1u) * nloc) {
            __builtin_amdgcn_fence(__ATOMIC_RELEASE, "agent");
            asm volatile("s_waitcnt vmcnt(0)" ::: "memory");
            const unsigned og = xb_add(&bar[XB_TOP], 1u);
            const unsigned tg = og / nx;
            if (og + 1u == (tg + 1u) * nx) xb_add(&bar[XB_TOPGEN], 1u);
            else XB_SPIN(xb_ld(&bar[XB_TOPGEN]) == tg, bar);
            __builtin_amdgcn_fence(__ATOMIC_ACQUIRE, "agent");
            xb_add(&bar[XB_XGEN(bx_)], 1u);
            asm volatile("s_waitcnt vmcnt(0)" ::: "memory");
        } else {
            XB_SPIN(xb_ld(&bar[XB_XGEN(bx_)]) == gen, bar);
            __builtin_amdgcn_fence(__ATOMIC_ACQUIRE, "agent");
            asm volatile("s_waitcnt vmcnt(0)" ::: "memory");
        }
    }
    __syncthreads();
}

typedef unsigned short bf16_t;
typedef short bf16x8 __attribute__((ext_vector_type(8)));
typedef float f32x4 __attribute__((ext_vector_type(4)));
typedef unsigned u32x4 __attribute__((ext_vector_type(4)));
#define LDS_WAIT() asm volatile("s_waitcnt lgkmcnt(0)" ::: "memory")

struct Params {
    const float* in[19];
};
struct Frame {
    LAS unsigned char* lds;
    int tid, lane, wave, G, bx, vcu, gw, ngw;
};
__device__ __forceinline__ const float* uptr(const LAS unsigned long long* t, int k) {
    const unsigned long long v = t[k]; const unsigned lo = __builtin_amdgcn_readfirstlane((unsigned)v), hi = __builtin_amdgcn_readfirstlane((unsigned)(v >> 32));
    return (const float*)(const GAS float*)(((unsigned long long)hi << 32) | lo); }

template <class CMap>
__device__ __forceinline__ void transpose_load(float (&v)[32], const float* W, int Nsrc, const float* ks, int kb, int nb, int lane, CMap cmap) {
    const int k0 = 64 * kb, n0 = 32 * nb; const int sc = cmap(n0 + (lane & 31));
#pragma unroll
    for (int i = 0; i < 32; ++i) { const int kk = 2 * i + (lane >> 5); float x = 0.f; if (sc >= 0) x = W[(size_t)(k0 + kk) * Nsrc + sc]; if (ks) x *= ks[k0 + kk]; v[i] = x; }
}
__device__ __forceinline__ void transpose_store(const float (&v)[32], int K, bf16_t* WT, LAS float* scr, int kb, int nb, int lane) {
    const int k0 = 64 * kb, n0 = 32 * nb;
#pragma unroll
    for (int i = 0; i < 32; ++i) scr[(2 * i + (lane >> 5)) * 33 + (lane & 31)] = v[i];
    LDS_WAIT(); asm volatile("" ::: "memory");
    const int c = lane & 7;
#pragma unroll
    for (int j = 0; j < 4; ++j) { const int n = (lane >> 3) + 8 * j; const LAS float* s = scr + (8 * c) * 33 + n;
        u32x4 o; o.x = pk2(s[0 * 33], s[1 * 33]); o.y = pk2(s[2 * 33], s[3 * 33]); o.z = pk2(s[4 * 33], s[5 * 33]); o.w = pk2(s[6 * 33], s[7 * 33]);
        *(u32x4*)(WT + (size_t)(n0 + n) * K + k0 + 8 * c) = o; }
    LDS_WAIT(); asm volatile("" ::: "memory");
}
template <class CMap>
__device__ __forceinline__ void transpose_matrix(const Frame& F, const float* W, int K, int Nsrc, int Ndst, bf16_t* WT, const float* ks, LAS float* scr, CMap cmap) {
    const int nnb = Ndst / 32, items = (K / 64) * nnb;
    for (int it = F.gw; it < items; it += 2 * F.ngw) { const int it2 = it + F.ngw; float va[32], vb[32];
        transpose_load(va, W, Nsrc, ks, it / nnb, it % nnb, F.lane, cmap);
        if (it2 < items) transpose_load(vb, W, Nsrc, ks, it2 / nnb, it2 % nnb, F.lane, cmap);
        transpose_store(va, K, WT, scr, it / nnb, it % nnb, F.lane);
        if (it2 < items) transpose_store(vb, K, WT, scr, it2 / nnb, it2 % nnb, F.lane); }
}
__device__ __forceinline__ int rope_perm(int m) { const int g = m >> 3, j = m & 7; return j < 4 ? 4 * g + j : 32 + 4 * g + (j - 4); }
struct CMapIn { __device__ int operator()(int n) const {
    if (n < 4096) return n; if (n < 4608) return 4112 + (n - 4096); if (n < 4864) return 4624 + (n - 4608);
    if (n < 4928) return 4880 + rope_perm(n - 4864); if (n < 4944) return 4096 + (n - 4928); return -1; } };
struct CMapQ { __device__ int operator()(int n) const { const int h = n / 192, o = n % 192; return o < 128 ? n : h * 192 + 128 + rope_perm(o - 128); } };
struct CMapUp { __device__ int operator()(int n) const { const int pn = n >> 8, j = n & 255; return j < 128 ? 128 * pn + j : DFF + 128 * pn + (j - 128); } };
struct CMapId { __device__ int operator()(int n) const { return n; } };

__device__ __forceinline__ void convert_weights(const Frame& F, unsigned char* ws_, const LAS unsigned long long* pt, int l, size_t wo, int slot) {
    unsigned char* ws = ws_ + wo;
    LAS float* scr = (LAS float*)(F.lds + F.wave * 8448);
    if (slot != 1) {
        const float* w_in = uptr(pt, 3) + (size_t)l * DM * INC; const float* w_uq = uptr(pt, 8) + (size_t)l * 512 * NQ; const float* w_ukv = uptr(pt, 9) + (size_t)l * 256 * NKV;
        const float* w_out = uptr(pt, 10) + (size_t)l * DM * DM; const float* w_dn = uptr(pt, 16) + (size_t)l * DFF * DM;
        const float* qg = uptr(pt, 6) + (size_t)l * 512; const float* kvg = uptr(pt, 7) + (size_t)l * 256;
        transpose_matrix(F, w_in, DM, INC, NIN, (bf16_t*)(ws + WS_WIN), nullptr, scr, CMapIn());
        transpose_matrix(F, w_uq, 512, NQ, NQ, (bf16_t*)(ws + WS_WUQ), qg, scr, CMapQ());
        transpose_matrix(F, w_ukv, 256, NKV, NKV, (bf16_t*)(ws + WS_WUKV), kvg, scr, CMapId());
        transpose_matrix(F, w_out, DM, DM, DM, (bf16_t*)(ws + WS_WOUT), nullptr, scr, CMapId());
        transpose_matrix(F, w_dn, DFF, DM, DM, (bf16_t*)(ws + WS_WDN), nullptr, scr, CMapId());
    }
    if (slot != 0) { const float* w_up = uptr(pt, 13) + (size_t)l * DM * NUP;
        transpose_matrix(F, w_up, DM, NUP, NUP, (bf16_t*)(ws + WS_WUP), nullptr, scr, CMapUp()); }
}
__device__ __forceinline__ void prologue(const Frame& F, unsigned char* ws, const LAS unsigned long long* pt) {
    float* COS = (float*)(ws + WS_COS); float* SIN = (float*)(ws + WS_SIN);
    for (int i = F.bx * 512 + F.tid; i < 4112 * 32; i += F.G * 512) { const int pos = i >> 5, f = i & 31;
        const float inv = powf(10000.0f, -(float)(2 * f) / 64.0f); const float ang = (float)pos * inv; float s, c; sincosf(ang, &s, &c); COS[i] = c; SIN[i] = s; }
    { float* PAR = (float*)(ws + WS_PAR); const int gt = F.bx * 512 + F.tid, nt = F.G * 512;
      for (int i = gt; i < DEPTH * 16; i += nt) PAR[PO_BG + i] = uptr(pt, 4)[i];
      for (int i = gt; i < DEPTH * 1024; i += nt) PAR[PO_MLG + i] = uptr(pt, 5)[i];
      for (int i = gt; i < DEPTH * 512; i += nt) PAR[PO_QG + i] = uptr(pt, 6)[i];
      for (int i = gt; i < DEPTH * 256; i += nt) PAR[PO_KVG + i] = uptr(pt, 7)[i];
      for (int i = gt; i < 2048; i += nt) { PAR[PO_ONE + i] = 1.f; PAR[PO_ZERO + i] = 0.f; }
      { float* ST2 = (float*)(ws + WS_STAT2); for (int i = gt; i < TP; i += nt) { ST2[2 * i] = 0.f; ST2[2 * i + 1] = 1.f; } }
      for (int i = gt; i < DEPTH * 2048; i += nt) { PAR[PO_L1G + i] = uptr(pt, 11)[i]; PAR[PO_L1B + i] = uptr(pt, 12)[i]; PAR[PO_L2G + i] = uptr(pt, 17)[i]; PAR[PO_L2B + i] = uptr(pt, 18)[i]; }
      for (int i = gt; i < DEPTH * 3 * 5632; i += nt) PAR[PO_CW + i] = uptr(pt, 14)[i];
      for (int i = gt; i < DEPTH * 5632; i += nt) PAR[PO_CB + i] = uptr(pt, 15)[i]; }
    float* H = (float*)(ws + WS_H); bf16_t* HB = (bf16_t*)(ws + WS_HB);
    const float* xp = uptr(pt, 0); const float* xs = uptr(pt, 1); const float* mt = uptr(pt, 2);
    for (int row0 = F.gw; row0 < TP; row0 += 2 * F.ngw) {
        f32x4 v[2][8];
#pragma unroll
        for (int r = 0; r < 2; ++r) { const int row = row0 + r * F.ngw; const float* src = nullptr;
            if (row < 4 * LREAL) src = xp + (size_t)row * DM; else if (row < NMAIN) src = xs + (size_t)(row - 4 * LREAL) * DM; else if (row < NTOK) src = mt + (size_t)((row - NMAIN) & 15) * DM;
#pragma unroll
            for (int j = 0; j < 8; ++j) { v[r][j] = (f32x4){0.f, 0.f, 0.f, 0.f}; if (src) v[r][j] = ((const f32x4*)src)[F.lane + 64 * j]; } }
#pragma unroll
        for (int r = 0; r < 2; ++r) { const int row = row0 + r * F.ngw; if (row < TP) {
            f32x4* hd = (f32x4*)(H + (size_t)row * DM) + F.lane; u32x2* bd = (u32x2*)(HB + (size_t)row * DM) + F.lane; u32x2* hb = (u32x2*)((bf16_t*)H + (size_t)row * DM) + F.lane;
#pragma unroll
            for (int j = 0; j < 8; ++j) { const f32x4 x = v[r][j];
                u32x2 w; w.x = pk2(x[0], x[1]); w.y = pk2(x[2], x[3]); bd[64 * j] = w;
                if (row >= NMAIN) hd[64 * j] = x * ALPHA;
                else { u32x2 wh; wh.x = pk2h(x[0], x[1]); wh.y = pk2h(x[2], x[3]); hb[64 * j] = wh; } } } }
    }
}

__device__ __forceinline__ void ln_one(const f32x4 (&vin)[8], int row, int lane, float* __restrict__ Hw, bf16_t* __restrict__ HB, const float* __restrict__ g, const float* __restrict__ b, float* __restrict__ ST) {
    f32x4 v[8]; float s = 0.f;
#pragma unroll
    for (int j = 0; j < 8; ++j) { v[j] = vin[j]; s += (v[j][0] + v[j][1]) + (v[j][2] + v[j][3]); }
    const float mean = wave_sum(s) * (1.f / DM); float q = 0.f;
#pragma unroll
    for (int j = 0; j < 8; ++j) { v[j] = v[j] - mean; q += (v[j][0] * v[j][0] + v[j][1] * v[j][1]) + (v[j][2] * v[j][2] + v[j][3] * v[j][3]); }
    const float rstd = rsqrtf(wave_sum(q) * (1.f / DM) + EPS);
    if (lane == 0) { f32x2 ms = {mean, rstd}; *(f32x2*)(ST + (size_t)row * 2) = ms; }
    u32x2* bd = (u32x2*)(HB + (size_t)row * DM) + lane; f32x4* hp = (f32x4*)(Hw + (size_t)row * DM) + lane;
#pragma unroll
    for (int j = 0; j < 8; ++j) { const f32x4 gg = ((const f32x4*)g)[lane + 64 * j], bb = ((const f32x4*)b)[lane + 64 * j]; const f32x4 y = v[j] * rstd * gg + bb;
        u32x2 w; w.x = pk2(y[0], y[1]); w.y = pk2(y[2], y[3]); bd[64 * j] = w;
        hp[64 * j] = y * ALPHA; }
}
__device__ __forceinline__ void ln_one_bf(const u32x4 (&vin)[4], int row, int lane, bf16_t* __restrict__ HB, const float* __restrict__ g, const float* __restrict__ b, float* __restrict__ ST, float* __restrict__ out) {
    f32x4 v[8]; float s = 0.f;
#pragma unroll
    for (int j = 0; j < 4; ++j) { v[2 * j] = (f32x4){hf_lo(vin[j].x), hf_hi(vin[j].x), hf_lo(vin[j].y), hf_hi(vin[j].y)}; v[2 * j + 1] = (f32x4){hf_lo(vin[j].z), hf_hi(vin[j].z), hf_lo(vin[j].w), hf_hi(vin[j].w)}; }
#pragma unroll
    for (int j = 0; j < 8; ++j) s += (v[j][0] + v[j][1]) + (v[j][2] + v[j][3]);
    const float mean = wave_sum(s) * (1.f / DM); float q = 0.f;
#pragma unroll
    for (int j = 0; j < 8; ++j) { v[j] = v[j] - mean; q += (v[j][0] * v[j][0] + v[j][1] * v[j][1]) + (v[j][2] * v[j][2] + v[j][3] * v[j][3]); }
    const float rstd = rsqrtf(wave_sum(q) * (1.f / DM) + EPS);
    if (lane == 0) { f32x2 ms = {mean, rstd}; *(f32x2*)(ST + (size_t)row * 2) = ms; }
    u32x4* bd = (u32x4*)(HB + (size_t)row * DM) + lane;
#pragma unroll
    for (int j = 0; j < 4; ++j) { const int c4 = 2 * (lane + 64 * j);
        const f32x4 y0 = v[2 * j] * rstd * ((const f32x4*)g)[c4] + ((const f32x4*)b)[c4], y1 = v[2 * j + 1] * rstd * ((const f32x4*)g)[c4 + 1] + ((const f32x4*)b)[c4 + 1];
        if (out) { f32x4* op = (f32x4*)(out + (size_t)row * DM) + c4; op[0] = y0; op[1] = y1; }
        else bd[64 * j] = pg8::pack8(y0, y1); }
}
__device__ __forceinline__ void ln_rows(const Frame& F, float* H, bf16_t* HB, const float* g, const float* b, float* ST, float* out, const float* PART, int nk) {
    const bf16_t* __restrict__ Hr = (const bf16_t*)H;
    for (int row = F.gw; row < NMAIN; row += 4 * F.ngw) {
        const int row2 = row + F.ngw, row3 = row + 2 * F.ngw, row4 = row + 3 * F.ngw;
        u32x4 va[4], vb[4], vc[4], vd[4];
#pragma unroll
        for (int j = 0; j < 4; ++j) va[j] = ((const u32x4*)(Hr + (size_t)row * DM))[F.lane + 64 * j];
#pragma unroll
        for (int j = 0; j < 4; ++j) vb[j] = ((const u32x4*)(Hr + (size_t)row2 * DM))[F.lane + 64 * j];
#pragma unroll
        for (int j = 0; j < 4; ++j) vc[j] = ((const u32x4*)(Hr + (size_t)row3 * DM))[F.lane + 64 * j];
#pragma unroll
        for (int j = 0; j < 4; ++j) vd[j] = ((const u32x4*)(Hr + (size_t)row4 * DM))[F.lane + 64 * j];
        ln_one_bf(va, row, F.lane, HB, g, b, ST, out);
        ln_one_bf(vb, row2, F.lane, HB, g, b, ST, out);
        ln_one_bf(vc, row3, F.lane, HB, g, b, ST, out);
        ln_one_bf(vd, row4, F.lane, HB, g, b, ST, out);
    }
    if (nk >= 0 && F.gw < TP - NMAIN) {
        const int row = NMAIN + F.gw; const float* __restrict__ Hm = H; f32x4 va[8];
#pragma unroll
        for (int j = 0; j < 8; ++j) va[j] = ((const f32x4*)(Hm + (size_t)row * DM))[F.lane + 64 * j];
        const float* __restrict__ pp0 = PART + (size_t)F.gw * DM;
        int k = 0;
        for (; k + 4 <= nk; k += 4) {
            f32x4 t[4][8];
#pragma unroll
            for (int q = 0; q < 4; ++q)
#pragma unroll
                for (int j = 0; j < 8; ++j) t[q][j] = ((const f32x4*)(pp0 + (size_t)(k + q) * 256 * DM))[F.lane + 64 * j];
#pragma unroll
            for (int q = 0; q < 4; ++q)
#pragma unroll
                for (int j = 0; j < 8; ++j) va[j] += t[q][j]; }
        for (; k < nk; ++k) {
#pragma unroll
            for (int j = 0; j < 8; ++j) va[j] += ((const f32x4*)(pp0 + (size_t)k * 256 * DM))[F.lane + 64 * j]; }
        ln_one(va, row, F.lane, H, HB, g, b, ST);
    }
}

__device__ __forceinline__ void rstd_rows(const Frame& F, const bf16_t* UDQ, const bf16_t* UDKV, float* RSTD) {
    for (int row = F.gw; row < TP; row += F.ngw) {
        const u32x4 a = ((const u32x4*)(UDQ + (size_t)row * 512))[F.lane]; float s = 0.f;
#pragma unroll
        for (int j = 0; j < 4; ++j) { const float x = bf_lo(a[j]), y = bf_hi(a[j]); s += x * x + y * y; }
        float t = 0.f;
        if (F.lane < 32) { const u32x4 c = ((const u32x4*)(UDKV + (size_t)row * 256))[F.lane];
#pragma unroll
            for (int j = 0; j < 4; ++j) { const float x = bf_lo(c[j]), y = bf_hi(c[j]); t += x * x + y * y; } }
        s = wave_sum(s); t = wave_sum(t);
        if (F.lane == 0) { RSTD[(size_t)row * 2] = rsqrtf(s * (1.f / 512.f) + EPS); RSTD[(size_t)row * 2 + 1] = rsqrtf(t * (1.f / 256.f) + EPS); }
    }
}

__device__ __forceinline__ void mlstm_fin_row(int row, int lane, const f32x4 (&hv)[4], const u32x2 (&ov)[4], const float* __restrict__ ng, bf16_t* __restrict__ MIX) {
#pragma unroll
    for (int j = 0; j < 4; ++j) {
        f32x4 v = hv[j];
        const float mean = wave_sum((v[0] + v[1]) + (v[2] + v[3])) * (1.f / 256.f); v = v - mean;
        const float rstd = rsqrtf(wave_sum((v[0] * v[0] + v[1] * v[1]) + (v[2] * v[2] + v[3] * v[3])) * (1.f / 256.f) + EPS);
        const f32x4 gg = ((const f32x4*)(ng + 256 * j))[lane];
        const u32x2 uo = ov[j];
        const float o0 = bf_lo(uo.x), o1 = bf_hi(uo.x), o2 = bf_lo(uo.y), o3 = bf_hi(uo.y);
        const float y0 = v[0] * rstd * gg[0] / (1.f + __expf(-o0)), y1 = v[1] * rstd * gg[1] / (1.f + __expf(-o1));
        const float y2 = v[2] * rstd * gg[2] / (1.f + __expf(-o2)), y3 = v[3] * rstd * gg[3] / (1.f + __expf(-o3));
        u32x2 w; w.x = pk2(y0, y1); w.y = pk2(y2, y3); ((u32x2*)(MIX + (size_t)row * DM + 256 * j))[lane] = w;
    }
}
__device__ __forceinline__ void mlstm_finalize(const Frame& F, int gw0, int ngw0, const float* HSUM, const bf16_t* UQKVO, const float* ng, bf16_t* MIX) {
    const float* __restrict__ Hs = HSUM; const bf16_t* __restrict__ Uo = UQKVO;
    for (int row = gw0; row < TP; row += 4 * ngw0) {
        int rr[4]; bool ok[4];
#pragma unroll
        for (int q = 0; q < 4; ++q) { const int r = row + q * ngw0; ok[q] = r < TP; rr[q] = ok[q] ? r : row; }
        f32x4 hv[4][4]; u32x2 ov[4][4];
#pragma unroll
        for (int q = 0; q < 4; ++q)
#pragma unroll
            for (int j = 0; j < 4; ++j) { hv[q][j] = ((const f32x4*)(Hs + (size_t)rr[q] * MLW + 256 * j))[F.lane]; ov[q][j] = ((const u32x2*)(Uo + (size_t)rr[q] * 4096 + 3072 + 256 * j))[F.lane]; }
#pragma unroll
        for (int q = 0; q < 4; ++q) if (ok[q]) mlstm_fin_row(rr[q], F.lane, hv[q], ov[q], ng, MIX);
    }
}

__device__ __forceinline__ f32x8 ld8f(const float* p) { const f32x4 a = *(const f32x4*)p, b = *(const f32x4*)(p + 4); return (f32x8){a[0], a[1], a[2], a[3], b[0], b[1], b[2], b[3]}; }
__device__ __forceinline__ f32x8 ld8b(const bf16_t* p) { const u32x4 v = *(const u32x4*)p; return (f32x8){bf_lo(v[0]), bf_hi(v[0]), bf_lo(v[1]), bf_hi(v[1]), bf_lo(v[2]), bf_hi(v[2]), bf_lo(v[3]), bf_hi(v[3])}; }
__device__ __forceinline__ void act_store(bf16_t* dst, const f32x8 gp, const f32x8 gc, const f32x8 gn, const f32x8 vv, const f32x8 w0, const f32x8 w1, const f32x8 w2, const f32x8 bb) {
    float o[8];
#pragma unroll
    for (int i = 0; i < 8; ++i) { const float x = w0[i] * gp[i] + w1[i] * gc[i] + w2[i] * gn[i] + bb[i]; o[i] = x / (1.f + __expf(-x)) * vv[i]; }
    u32x4 w; w.x = pk2(o[0], o[1]); w.y = pk2(o[2], o[3]); w.z = pk2(o[4], o[5]); w.w = pk2(o[6], o[7]); *(u32x4*)dst = w;
}
__device__ __forceinline__ void ffn_fixup(const Frame& F, const float* SIDE, const bf16_t* GVM, bf16_t* ACT, const float* cw, const float* cb, bool meta) {
    constexpr int NCH = DFF / 8;
    const f32x8 zero = {0.f, 0.f, 0.f, 0.f, 0.f, 0.f, 0.f, 0.f};
    const int gt = F.bx * 512 + F.tid, nt = GRID * 512;
    for (int idx = gt; idx < 192 * 2 * NCH; idx += nt) {
        const int ch = idx % NCH, rsel = (idx / NCH) & 1, pm = idx / (2 * NCH), c0 = 8 * ch, sq = pm >> 4;
        const f32x8 w0 = ld8f(cw + c0), w1 = ld8f(cw + DFF + c0), w2 = ld8f(cw + 2 * DFF + c0), bb = ld8f(cb + c0);
        const float* S0 = SIDE + (size_t)pm * 6 * DFF + c0;
        if (rsel == 0) { const f32x8 gp = (pm & 15) ? ld8f(S0 - 6 * DFF + 3 * DFF) : ld8b(GVM + (size_t)(16 * sq + 15) * NUP + c0);
            act_store(ACT + (size_t)(pm * 256) * DFF + c0, gp, ld8f(S0), ld8f(S0 + DFF), ld8f(S0 + 4 * DFF), w0, w1, w2, bb);
        } else { const f32x8 gn = ((pm & 15) != 15) ? ld8f(S0 + 6 * DFF) : zero;
            act_store(ACT + (size_t)(pm * 256 + 255) * DFF + c0, ld8f(S0 + 2 * DFF), ld8f(S0 + 3 * DFF), gn, ld8f(S0 + 5 * DFF), w0, w1, w2, bb); }
    }
    if (meta) for (int idx = gt; idx < NSEQ * 16 * NCH; idx += nt) {
        const int ch = idx % NCH, rp = idx / NCH, pp = rp & 15, sq = rp >> 4, c0 = 8 * ch;
        const f32x8 w0 = ld8f(cw + c0), w1 = ld8f(cw + DFF + c0), w2 = ld8f(cw + 2 * DFF + c0), bb = ld8f(cb + c0);
        const bf16_t* G0 = GVM + (size_t)(16 * sq + pp) * NUP + c0;
        const f32x8 gp = pp > 0 ? ld8b(G0 - NUP) : zero, gc = ld8b(G0);
        const f32x8 gn = pp < 15 ? ld8b(G0 + NUP) : ld8f(SIDE + (size_t)(16 * sq) * 6 * DFF + c0);
        act_store(ACT + (size_t)(MROW0 + 16 * sq + pp) * DFF + c0, gp, gc, gn, ld8b(G0 + DFF), w0, w1, w2, bb);
    }
}

namespace att {
constexpr int NW = 8, QBLK = 32, KVBLK = 64, NT = 65;
constexpr int KROW = 400;
constexpr int SHM_V = KVBLK * 128 * 2, SHM_K = KVBLK * KROW;
constexpr int OFF_V = 0, OFF_K = 3 * SHM_V, OFF_WS = OFF_K + 3 * SHM_K, LDS_TOTAL = OFF_WS + NW * 64 * 4;
static_assert(LDS_TOTAL <= RING_BYTES, "attention LDS");
constexpr float SCALE = 0.07216878364870323f;
constexpr float THR = 8.f;
constexpr float QSCALE = SCALE * 1.4426950408889634f;
constexpr float THRL = THR * 1.4426950408889634f;
#define SBAR() __builtin_amdgcn_sched_barrier(0)
__device__ __forceinline__ int crow(int r, int hi) { return (r & 3) + 8 * (r >> 2) + 4 * hi; }
__device__ __forceinline__ unsigned cvtpk(float lo, float hi) { return pk2(lo, hi); }

template <bool MASK16, bool FIRST>
__device__ __forceinline__ void partialSM(f32x16& p0, f32x16& p1, float& m_reg, float& alpha) {
    if (MASK16) {
#pragma unroll
        for (int r = 8; r < 16; ++r) p0[r] = NEGBIG;
#pragma unroll
        for (int r = 0; r < 16; ++r) p1[r] = NEGBIG;
    }
    float pmax = p0[0];
#pragma unroll
    for (int r = 1; r < 16; ++r) pmax = fmaxf(pmax, p0[r]);
#pragma unroll
    for (int r = 0; r < 16; ++r) pmax = fmaxf(pmax, p1[r]);
    { auto rr = __builtin_amdgcn_permlane32_swap(__float_as_uint(pmax), __float_as_uint(pmax), false, false); pmax = fmaxf(__uint_as_float(rr[0]), __uint_as_float(rr[1])); }
    if (!FIRST && __builtin_expect(__all(pmax <= THRL), 1)) { alpha = 1.f; }
    else { const float d = FIRST ? pmax : fmaxf(pmax, 0.f); alpha = FIRST ? 1.f : __builtin_amdgcn_exp2f(-d); m_reg += d;
#pragma unroll
        for (int r = 0; r < 16; ++r) { p0[r] -= d; p1[r] -= d; } }
#pragma unroll
    for (int r = 0; r < 16; ++r) p0[r] = __builtin_amdgcn_exp2f(p0[r]);
}
__device__ __forceinline__ void finishSM(f32x16& p0, f32x16& p1, float alpha, float& l_reg, bf16x8& pa0, bf16x8& pa1, bf16x8& pa2, bf16x8& pa3) {
#pragma unroll
    for (int r = 0; r < 16; ++r) p1[r] = __builtin_amdgcn_exp2f(p1[r]);
    float ps = 0;
#pragma unroll
    for (int r = 0; r < 16; ++r) ps += p0[r];
#pragma unroll
    for (int r = 0; r < 16; ++r) ps += p1[r];
    { auto rr = __builtin_amdgcn_permlane32_swap(__float_as_uint(ps), __float_as_uint(ps), false, false); ps = __uint_as_float(rr[0]) + __uint_as_float(rr[1]); }
    l_reg = l_reg * alpha + ps;
#define PK4(P, BASE, OUT) do { unsigned a0 = cvtpk(P[BASE + 0], P[BASE + 1]), a1 = cvtpk(P[BASE + 2], P[BASE + 3]);   \
    unsigned b0 = cvtpk(P[BASE + 4], P[BASE + 5]), b1 = cvtpk(P[BASE + 6], P[BASE + 7]);                              \
    auto r0 = __builtin_amdgcn_permlane32_swap(a0, b0, false, false); auto r1 = __builtin_amdgcn_permlane32_swap(a1, b1, false, false); \
    u32x4 w = {r0[0], r1[0], r0[1], r1[1]}; OUT = __builtin_bit_cast(bf16x8, w); } while (0)
    PK4(p0, 0, pa0); PK4(p0, 8, pa1); PK4(p1, 0, pa2); PK4(p1, 8, pa3);
#undef PK4
}
__device__ __forceinline__ void qkt(f32x16& p0, f32x16& p1, const LAS char* Ks, const bf16x8* qr, int r32, int hi, float init) {
#pragma unroll
    for (int r = 0; r < 16; ++r) { p0[r] = init; p1[r] = init; }
#pragma unroll
    for (int d0 = 0; d0 < 12; ++d0) { const int cb = (d0 * 16 + hi * 8) * 2;
        const bf16x8 b0 = *(const LAS bf16x8*)(Ks + r32 * KROW + cb);
        const bf16x8 b1 = *(const LAS bf16x8*)(Ks + (32 + r32) * KROW + cb);
        p0 = __builtin_amdgcn_mfma_f32_32x32x16_bf16(b0, qr[d0], p0, 0, 0, 0);
        p1 = __builtin_amdgcn_mfma_f32_32x32x16_bf16(b1, qr[d0], p1, 0, 0, 0); }
}
__device__ __forceinline__ int v_st(int k, int c) { const int kk = (k & ~0xC) | ((k & 4) << 1) | ((k & 8) >> 1); return ((kk >> 3) * 4 + (c >> 5)) * 512 + ((kk & 7) * 32 + (c & 31)) * 2; }
__device__ __forceinline__ int v_rd_base(int lane) { return ((lane & 3) << 3) | (((lane >> 2) & 3) << 6) | (((lane >> 4) & 1) << 5) | (((lane >> 5) & 1) << 8); }
constexpr int v_rd_off(int d0, int ks, int half) { return d0 * 512 + ks * 4096 + half * 2048; }
template <int OFF> __device__ __forceinline__ s16x4 tr_read(int vb) { s16x4 r; asm volatile("ds_read_b64_tr_b16 %0, %1 offset:%2" : "=&v"(r) : "v"(vb), "i"(OFF) : "memory"); return r; }
template <int D0> __device__ __forceinline__ void pv_one(f32x16& od, int vb, bf16x8 pa0, bf16x8 pa1, bf16x8 pa2, bf16x8 pa3) {
    const s16x4 l0 = tr_read<v_rd_off(D0, 0, 0)>(vb), h0 = tr_read<v_rd_off(D0, 0, 1)>(vb), l1 = tr_read<v_rd_off(D0, 1, 0)>(vb), h1 = tr_read<v_rd_off(D0, 1, 1)>(vb);
    const s16x4 l2 = tr_read<v_rd_off(D0, 2, 0)>(vb), h2 = tr_read<v_rd_off(D0, 2, 1)>(vb), l3 = tr_read<v_rd_off(D0, 3, 0)>(vb), h3 = tr_read<v_rd_off(D0, 3, 1)>(vb);
    asm volatile("s_waitcnt lgkmcnt(0)" ::: "memory"); SBAR();
#define PKV(L, H) (bf16x8){L[0], L[1], L[2], L[3], H[0], H[1], H[2], H[3]}
    od = __builtin_amdgcn_mfma_f32_32x32x16_bf16(pa0, PKV(l0, h0), od, 0, 0, 0);
    od = __builtin_amdgcn_mfma_f32_32x32x16_bf16(pa1, PKV(l1, h1), od, 0, 0, 0);
    od = __builtin_amdgcn_mfma_f32_32x32x16_bf16(pa2, PKV(l2, h2), od, 0, 0, 0);
    od = __builtin_amdgcn_mfma_f32_32x32x16_bf16(pa3, PKV(l3, h3), od, 0, 0, 0);
#undef PKV
}
__device__ __forceinline__ void pv_d0(f32x16* o, int vb, bf16x8 pa0, bf16x8 pa1, bf16x8 pa2, bf16x8 pa3) {
    pv_one<0>(o[0], vb, pa0, pa1, pa2, pa3); pv_one<1>(o[1], vb, pa0, pa1, pa2, pa3); pv_one<2>(o[2], vb, pa0, pa1, pa2, pa3); pv_one<3>(o[3], vb, pa0, pa1, pa2, pa3);
}

__device__ __forceinline__ void attn_unit(int s, int h, int qb, const bf16_t* __restrict__ MQ, const bf16_t* __restrict__ MKV, const bf16_t* __restrict__ KR, bf16_t* __restrict__ MIX, LAS char* lds) {
    int tid_ = threadIdx.x; asm volatile("" : "+v"(tid_));
    const int tid = tid_, wid = tid >> 6, lane = tid & 63, r32 = lane & 31, hi = lane >> 5;
    LAS char* V_lds = lds + OFF_V; LAS char* K_lds = lds + OFF_K;
    LAS float* wsf = (LAS float*)(lds + OFF_WS) + wid * 64; LAS float* li_l = wsf; LAS float* al_l = wsf + 32;
    float m_reg = 0.f, l_reg = 0; f32x16 o[4]; bf16x8 qr[12];
#pragma unroll
    for (int d = 0; d < 4; ++d)
#pragma unroll
        for (int r = 0; r < 16; ++r) o[d][r] = 0.f;
    const int qi = wid * QBLK + r32;
    const unsigned qrow = qb < 16 ? (unsigned)s * LREAL + 256 * qb + qi : (unsigned)MROW0 + 16 * s + (qi < 15 ? qi : 15);
    { const bf16_t* Qw = MQ + (qrow * NQ + h * 192 + hi * 8);
#pragma unroll
      for (int d0 = 0; d0 < 12; ++d0) qr[d0] = *(const bf16x8*)(Qw + d0 * 16); }
    const int sr = tid >> 4, sc = (tid & 15) * 8, vst0 = v_st(sr, sc), vst1 = v_st(32 + sr, sc);
    const int kr_r = tid >> 3, kr_c = (tid & 7) * 8;
    const int vb0 = (int)(uintptr_t)V_lds + v_rd_base(lane);
    bf16x8 vs0, vs1, ks0, ks1, kr0;
    const unsigned mainrow0 = (unsigned)s * LREAL, metarow0 = (unsigned)MROW0 + 16 * s;
    const bf16_t* MKVh = MKV + h * 256;
#define KROWG(kt, k) ((kt) < 64 ? mainrow0 + 64u * (kt) + (k) : metarow0 + ((k) < 15 ? (k) : 15))
#define SLOAD(kt) do { const unsigned g0 = KROWG(kt, sr) * NKV + sc, g1 = KROWG(kt, 32 + sr) * NKV + sc, g2 = KROWG(kt, kr_r) * 64 + kr_c; \
    vs0 = *(const bf16x8*)(MKVh + 128 + g0); vs1 = *(const bf16x8*)(MKVh + 128 + g1); \
    ks0 = *(const bf16x8*)(MKVh + g0); ks1 = *(const bf16x8*)(MKVh + g1); kr0 = *(const bf16x8*)(KR + g2); } while (0)
#define SWRITE(b) do { *(LAS bf16x8*)(V_lds + (b) * SHM_V + vst0) = vs0; *(LAS bf16x8*)(V_lds + (b) * SHM_V + vst1) = vs1; \
    *(LAS bf16x8*)(K_lds + (b) * SHM_K + sr * KROW + sc * 2) = ks0; *(LAS bf16x8*)(K_lds + (b) * SHM_K + (32 + sr) * KROW + sc * 2) = ks1; \
    *(LAS bf16x8*)(K_lds + (b) * SHM_K + kr_r * KROW + 256 + kr_c * 2) = kr0; } while (0)
#define RESC(a) do { if (__any((a) < 1.f)) { if (hi == 0) al_l[r32] = (a); asm volatile("s_waitcnt lgkmcnt(0)" ::: "memory"); \
    _Pragma("unroll") for (int d = 0; d < 4; ++d) _Pragma("unroll") for (int r = 0; r < 16; ++r) o[d][r] *= al_l[crow(r, hi)]; } } while (0)
    f32x16 pA0, pA1, pB0, pB1; float alA, alB; bf16x8 pa0, pa1, pa2, pa3;
    __syncthreads();
    SLOAD(0); SWRITE(0); __syncthreads();
    qkt(pA0, pA1, K_lds, qr, r32, hi, 0.f); partialSM<false, true>(pA0, pA1, m_reg, alA);
    SLOAD(1); SWRITE(1); __syncthreads();
    RESC(alA);
    int s0 = 0, s1 = 1, s2 = 2;
    if (__builtin_amdgcn_readfirstlane(wid) >= 4) __builtin_amdgcn_s_setprio(1);
    for (int j = 1; j + 1 < NT; j += 2) {
        SBAR(); qkt(pB0, pB1, K_lds + s1 * SHM_K, qr, r32, hi, -m_reg);
        finishSM(pA0, pA1, alA, l_reg, pa0, pa1, pa2, pa3); SBAR();
        SLOAD(j + 1); SBAR();
        pv_d0(o, vb0 + s0 * SHM_V, pa0, pa1, pa2, pa3); partialSM<false, false>(pB0, pB1, m_reg, alB);
        SWRITE(s2);
        RESC(alB); __syncthreads();
        SBAR(); qkt(pA0, pA1, K_lds + s2 * SHM_K, qr, r32, hi, -m_reg);
        finishSM(pB0, pB1, alB, l_reg, pa0, pa1, pa2, pa3); SBAR();
        if (j + 2 < NT) SLOAD(j + 2); SBAR();
        pv_d0(o, vb0 + s1 * SHM_V, pa0, pa1, pa2, pa3);
        if (j + 1 == NT - 1) partialSM<true, false>(pA0, pA1, m_reg, alA); else partialSM<false, false>(pA0, pA1, m_reg, alA);
        if (j + 2 < NT) SWRITE(s0);
        RESC(alA); __syncthreads();
        { const int t0 = s0, t1 = s1; s0 = s2; s1 = t0; s2 = t1; }
    }
    finishSM(pA0, pA1, alA, l_reg, pa0, pa1, pa2, pa3); SBAR();
    pv_d0(o, vb0 + s0 * SHM_V, pa0, pa1, pa2, pa3);
    if (hi == 0) li_l[r32] = l_reg; asm volatile("s_waitcnt lgkmcnt(0)" ::: "memory");
    __builtin_amdgcn_s_setprio(0);
    float rli[16];
#pragma unroll
    for (int r = 0; r < 16; ++r) rli[r] = __builtin_amdgcn_rcpf(li_l[crow(r, hi)]);
    if (qb < 16) {
        bf16_t* Ow = MIX + ((long)s * LREAL + 256 * qb + wid * QBLK) * DM + MLW + h * 128;
#pragma unroll
        for (int r = 0; r < 16; ++r) { const int orow = crow(r, hi);
#pragma unroll
            for (int d0 = 0; d0 < 4; ++d0) Ow[(long)orow * DM + d0 * 32 + r32] = (bf16_t)(pk2(o[d0][r] * rli[r], 0.f) & 0xffffu); }
    } else if (wid == 0) {
        bf16_t* Ow = MIX + ((long)MROW0 + 16 * s) * DM + MLW + h * 128;
#pragma unroll
        for (int r = 0; r < 16; ++r) { const int orow = crow(r, hi);
            if (orow < 16) {
#pragma unroll
                for (int d0 = 0; d0 < 4; ++d0) Ow[(long)orow * DM + d0 * 32 + r32] = (bf16_t)(pk2(o[d0][r] * rli[r], 0.f) & 0xffffu); } }
    }
#undef KROWG
#undef SLOAD
#undef SWRITE
#undef RESC
}
__device__ __forceinline__ void attn_phase(int vcu, const bf16_t* MQ, const bf16_t* MKV, const bf16_t* KR, bf16_t* MIX, LAS char* lds) {
    for (int i = (vcu < 96 ? -1 : 0); i < 6; ++i) { int sh, qb; if (i < 0) { sh = vcu; qb = 16; } else { const int id = i * GRID + vcu; sh = id >> 4; qb = id & 15; }
        attn_unit(sh >> 3, sh & 7, qb, MQ, MKV, KR, MIX, lds); }
}
#undef SBAR
}

namespace ml {
constexpr int QI = 0, KI = 32768, VI = 65536, SI = 81920, CI = 98304;
constexpr int SC_CT = 0, SC_BM = 64, SC_WI = 128, SC_EI = 192, SC_WW = 256, SC_DEN = 320, SC_QN = 448, SC_N = 512, SC_A = 768;
constexpr int GP_REC = 200;
__device__ __forceinline__ unsigned off_b(unsigned row, unsigned ch) { return 256u * row + 16u * (ch ^ (((row & 3) << 2) | ((row >> 2) & 3))); }
__device__ __forceinline__ unsigned row_read_addr_16(unsigned lane, unsigned rb, unsigned s) { return off_b((lane & 15) + 16 * rb, 4 * s + (lane >> 4)); }
__device__ __forceinline__ unsigned tr_read_addr_16(unsigned lane, unsigned c, unsigned ks, unsigned t) {
    const unsigned g = lane >> 4, q = (lane & 15) >> 2, p = lane & 3; return off_b(32 * ks + 8 * g + 4 * t + q, 2 * c + (p >> 1)) + 8 * (p & 1); }
__device__ __forceinline__ bf16x8 tr_frag(unsigned a0, unsigned a1) {
    const s16x4 lo = __builtin_amdgcn_ds_read_tr16_b64_v4i16((LAS s16x4*)a0), hi = __builtin_amdgcn_ds_read_tr16_b64_v4i16((LAS s16x4*)a1);
    return (bf16x8){lo[0], lo[1], lo[2], lo[3], hi[0], hi[1], hi[2], hi[3]};
}
__device__ __forceinline__ f32x4 mfma16(bf16x8 a, bf16x8 b, f32x4 c) { return __builtin_amdgcn_mfma_f32_16x16x32_bf16(a, b, c, 0, 0, 0); }
__device__ __forceinline__ float log_sigmoid(float x) { return fminf(x, 0.f) - __logf(1.f + __expf(-fabsf(x))); }

__device__ __forceinline__ void gate_prep(int gw, int ngw, int lane, const float* __restrict__ GATES, const float* __restrict__ bgl, float* __restrict__ GP) {
    for (int it = gw; it < 96 * 65; it += ngw) {
        const int chain = it / 65, c = it % 65, s = chain >> 3, hd = (chain >> 1) & 3, dir = chain & 1;
        const long g = c == 0 ? (lane >= 48 ? (long)MROW0 + 16 * s + lane - 48 : -1L) : (long)s * LREAL + 64 * (c - 1) + lane;
        float li = NEGBIG, lf = 0.f;
        if (g >= 0) { li = GATES[g * 16 + (dir ? 8 : 0) + hd] + bgl[(dir ? 8 : 0) + hd]; lf = log_sigmoid(GATES[g * 16 + (dir ? 12 : 4) + hd] + bgl[(dir ? 12 : 4) + hd]); }
        float x = dir ? __shfl(lf, 63 - lane) : lf;
#pragma unroll
        for (int o = 1; o < 64; o <<= 1) { const float y = __shfl_up(x, o); if (lane >= o) x += y; }
        const float btot = __shfl(x, 63);
        const float b = dir ? __shfl(x, 63 - lane) : x;
        const float a_s = li - b;
        float pm = dir ? __shfl(a_s, 63 - lane) : a_s;
#pragma unroll
        for (int o = 1; o < 64; o <<= 1) { const float y = __shfl_up(pm, o); if (lane >= o) pm = fmaxf(pm, y); }
        pm = dir ? __shfl(pm, 63 - lane) : pm;
        const float gmax = wave_max(btot - b + li);
        float* rec = GP + (size_t)it * GP_REC;
        rec[lane] = b; rec[64 + lane] = li; rec[128 + lane] = pm; if (lane == 0) { rec[192] = btot; rec[193] = gmax; }
    }
}

__device__ __forceinline__ void mlstm_unit(int s, int hd, int js, const bf16_t* __restrict__ UQKVO, const float* __restrict__ GP, float* __restrict__ HSUM, LAS unsigned char* lds, LAS float* sc) {
    const int wid = __builtin_amdgcn_readfirstlane((int)threadIdx.x >> 6);
    const unsigned ldsb = (unsigned)(uintptr_t)lds;
    const int tt = wid >> 1, nb = 2 * (wid & 1);
#define ROWRD(img, rb, s_) (*(const LAS bf16x8*)(uintptr_t)(RB[s_] + (unsigned)((img) + 4096 * (rb))))
#define TRFRAG(img, c_, ks) tr_frag(BT[0][(c_) & 1] + TQ[(c_) >> 1] + (unsigned)((img) + 8192 * (ks)), BT[1][(c_) & 1] + TQ[(c_) >> 1] + (unsigned)((img) + 8192 * (ks)))
    f32x4 accC[2][4], accN[2];
    for (int dir = 0; dir < 2; ++dir) {
        int tid; { int t0_ = threadIdx.x; asm volatile("" : "+v"(t0_)); tid = t0_; }
#pragma unroll
        for (int mi = 0; mi < 2; ++mi)
#pragma unroll
            for (int c = 0; c < 4; ++c) accC[mi][c] = (f32x4){0.f, 0.f, 0.f, 0.f};
        accN[0] = (f32x4){0.f, 0.f, 0.f, 0.f}; accN[1] = (f32x4){0.f, 0.f, 0.f, 0.f};
        if (tid < 256) sc[SC_N + tid] = 0.f;
        for (int i = tid; i < 32768 / 16; i += 512) *(LAS u32x4*)(lds + CI + i * 16) = (u32x4){0u, 0u, 0u, 0u};
        float m_state = 0.f;
        const float* GPc = GP + (size_t)(((s * 4 + hd) * 2 + dir) * 65) * GP_REC;
        u32x4 sq[4], sk[4], sv; float sb = 0.f, sli = NEGBIG, spm = NEGBIG, sbt = 0.f, sgm = NEGBIG;
#define ROWG(c, r) ((c) == 0 ? ((r) >= 48 ? (long)MROW0 + 16 * s + (r) - 48 : -1L) : (long)s * LREAL + 64 * ((c) - 1) + (r))
#define STAGE_LOAD(c) do { \
        _Pragma("unroll") for (int i = 0; i < 4; ++i) { const int id = tid + 512 * i, r = id >> 5, ch = id & 31; const long g = ROWG(c, r); \
            sq[i] = (u32x4){0u, 0u, 0u, 0u}; sk[i] = (u32x4){0u, 0u, 0u, 0u}; \
            if (g >= 0) { sq[i] = *(const u32x4*)(UQKVO + g * 4096 + hd * 256 + ch * 8); sk[i] = *(const u32x4*)(UQKVO + g * 4096 + 1024 + hd * 256 + ch * 8); } } \
        { const int r = tid >> 3, ch = tid & 7; const long g = ROWG(c, r); sv = (u32x4){0u, 0u, 0u, 0u}; if (g >= 0) sv = *(const u32x4*)(UQKVO + g * 4096 + 2048 + hd * 256 + js * 64 + ch * 8); } \
        if (tid < 64) { const float* rec = GPc + (size_t)(c) * GP_REC; sb = rec[tid]; sli = rec[64 + tid]; spm = rec[128 + tid]; sbt = rec[192]; sgm = rec[193]; } } while (0)
#define STAGE_WRITE() do { \
        _Pragma("unroll") for (int i = 0; i < 4; ++i) { const int id = tid + 512 * i, r = id >> 5, ch = id & 31; \
            *(LAS u32x4*)(lds + QI + (ch >> 4) * 16384 + off_b(r, ch & 15)) = sq[i]; *(LAS u32x4*)(lds + KI + (ch >> 4) * 16384 + off_b(r, ch & 15)) = sk[i]; } \
        { const int r = tid >> 3, ch = tid & 7; *(LAS u32x4*)(lds + VI + off_b(r, ch)) = sv; } \
        if (tid < 64) { const float m_inter = sb + m_state, mt = fmaxf(m_inter, sb + spm); const float m_new = fmaxf(sbt + m_state, sgm); \
            sc[SC_CT + tid] = sli - sb; sc[SC_BM + tid] = sb - mt; sc[SC_WI + tid] = __expf(m_inter - mt); sc[SC_EI + tid] = __expf(-mt); \
            sc[SC_WW + tid] = __expf(sbt - sb + sli - m_new) * 0.0625f; if (tid == 0) sc[SC_A] = __expf(sbt + m_state - m_new); m_state = m_new; } } while (0)
        const int c_first = dir ? 64 : 0, c_step = dir ? -1 : 1;
        STAGE_LOAD(c_first);
        __syncthreads();
        STAGE_WRITE();
        for (int ci = 0; ci < 65; ++ci) {
            const int c = c_first + c_step * ci;
            { int t2_ = threadIdx.x; asm volatile("" : "+v"(t2_)); tid = t2_; }
            const int lane = tid & 63, l15 = lane & 15, lg = lane >> 4;
            unsigned RB[4], BT[2][2], TQ[4];
            { const unsigned fl = ((l15 & 3) << 2) | (l15 >> 2), q = l15 >> 2, p = lane & 3, g = lg;
#pragma unroll
              for (int s_ = 0; s_ < 4; ++s_) { RB[s_] = ldsb + 256u * l15 + 16u * (lg ^ (fl & 3)) + 64u * (s_ ^ (fl >> 2)); TQ[s_] = 64u * (s_ ^ q); }
#pragma unroll
              for (int t_ = 0; t_ < 2; ++t_)
#pragma unroll
                  for (int cl = 0; cl < 2; ++cl) BT[t_][cl] = ldsb + 256u * (8 * g + q) + 8u * (p & 1) + 1024u * t_ + 16u * ((p >> 1) ^ t_) + 32u * (cl ^ (g & 1)); }
            __syncthreads();
            if (ci + 1 < 65) STAGE_LOAD(c + c_step);
            bf16x8 qf[8];
#pragma unroll
            for (int k = 0; k < 8; ++k) qf[k] = ROWRD(QI + (k >> 2) * 16384, tt, k & 3);
            f32x4 sT[2], oc[2];
#pragma unroll
            for (int i = 0; i < 2; ++i) { sT[i] = (f32x4){0.f, 0.f, 0.f, 0.f}; oc[i] = (f32x4){0.f, 0.f, 0.f, 0.f}; }
#pragma unroll
            for (int i = 0; i < 2; ++i)
#pragma unroll
                for (int k = 0; k < 8; ++k) {
                    const bf16x8 kf = ROWRD(KI + (k >> 2) * 16384, nb + i, k & 3);
                    sT[i] = mfma16(kf, qf[k], sT[i]);
                    const bf16x8 cf = ROWRD(CI + (k >> 2) * 16384, nb + i, k & 3);
                    oc[i] = mfma16(qf[k], cf, oc[i]);
                }
            {
                const int t = 16 * tt + l15; const float bmt = sc[SC_BM + t]; float rs = 0.f;
#pragma unroll
                for (int i = 0; i < 2; ++i) { const int s0 = 16 * (nb + i) + 4 * lg; const f32x4 ctv = *(const LAS f32x4*)(sc + SC_CT + s0); float v[4];
#pragma unroll
                    for (int e = 0; e < 4; ++e) { const int sx = s0 + e; const bool ok = dir ? (sx >= t) : (sx <= t);
                        const float ex = ok ? (bmt + ctv[e]) : NEGBIG; v[e] = sT[i][e] * 0.0625f * __expf(ex); rs += v[e]; }
                    u32x2 w; w.x = pk2(v[0], v[1]); w.y = pk2(v[2], v[3]);
                    *(LAS u32x2*)(lds + SI + off_b(t, s0 >> 3) + (s0 & 7) * 2) = w; }
                rs += __shfl_xor(rs, 16); rs += __shfl_xor(rs, 32);
                if (lg == 0) sc[SC_DEN + 64 * (wid & 1) + t] = rs;
            }
            { const int r = tid >> 3, ch = tid & 7; const u32x4 v = *(const LAS u32x4*)(lds + VI + off_b(r, ch)); const float w = sc[SC_WW + r]; u32x4 o;
#pragma unroll
              for (int jx = 0; jx < 4; ++jx) o[jx] = pk2(bf_lo(v[jx]) * w, bf_hi(v[jx]) * w);
              *(LAS u32x4*)(lds + VI + off_b(r, 8 + ch)) = o; }
            { const int r = tid >> 3, part = tid & 7; float d = 0.f;
#pragma unroll
              for (int i = 0; i < 4; ++i) { const int ch32 = part * 4 + i; const u32x4 v = *(const LAS u32x4*)(lds + QI + (ch32 >> 4) * 16384 + off_b(r, ch32 & 15));
                  const f32x4 n0 = *(const LAS f32x4*)(sc + SC_N + ch32 * 8), n1 = *(const LAS f32x4*)(sc + SC_N + ch32 * 8 + 4);
                  d += bf_lo(v[0]) * n0[0] + bf_hi(v[0]) * n0[1] + bf_lo(v[1]) * n0[2] + bf_hi(v[1]) * n0[3] + bf_lo(v[2]) * n1[0] + bf_hi(v[2]) * n1[1] + bf_lo(v[3]) * n1[2] + bf_hi(v[3]) * n1[3]; }
              d += __shfl_xor(d, 1); d += __shfl_xor(d, 2); d += __shfl_xor(d, 4);
              if (part == 0) sc[SC_QN + r] = d; }
            { const f32x4 wi = *(const LAS f32x4*)(sc + SC_WI + 16 * tt + 4 * lg);
#pragma unroll
              for (int i = 0; i < 2; ++i) oc[i] = oc[i] * wi; }
            __syncthreads();
            const float a_dec = sc[SC_A];
#pragma unroll
            for (int ks = 0; ks < 2; ++ks) { const bf16x8 sf = ROWRD(SI, tt, ks);
#pragma unroll
                for (int i = 0; i < 2; ++i) { const bf16x8 vf = TRFRAG(VI, nb + i, ks);
                    oc[i] = mfma16(sf, vf, oc[i]); } }
            { const int t0 = 16 * tt + 4 * lg;
              const f32x4 wi = *(const LAS f32x4*)(sc + SC_WI + t0), qn = *(const LAS f32x4*)(sc + SC_QN + t0), d0 = *(const LAS f32x4*)(sc + SC_DEN + t0), d1 = *(const LAS f32x4*)(sc + SC_DEN + 64 + t0), ei = *(const LAS f32x4*)(sc + SC_EI + t0);
#pragma unroll
              for (int e = 0; e < 4; ++e) { const long g = ROWG(c, t0 + e);
                const float den = wi[e] * qn[e] + (d0[e] + d1[e]); const float inv = 1.f / fmaxf(fabsf(den), ei[e]);
                if (g >= 0) {
#pragma unroll
                    for (int i = 0; i < 2; ++i) { float* hp = HSUM + g * MLW + hd * 256 + js * 64 + 16 * (nb + i) + l15; const float hv = oc[i][e] * inv; if (dir) unsafeAtomicAdd(hp, hv); else *hp = hv; } } } }
#pragma unroll
            for (int mi = 0; mi < 2; ++mi)
#pragma unroll
                for (int cc = 0; cc < 4; ++cc) accC[mi][cc] = accC[mi][cc] * a_dec;
            accN[0] = accN[0] * a_dec; accN[1] = accN[1] * a_dec;
            const unsigned ktq = (unsigned)(KI + (wid >> 2) * 16384) + 64u * ((unsigned)(wid & 3) ^ (unsigned)(l15 >> 2));
#pragma unroll
            for (int ks = 0; ks < 2; ++ks) {
                bf16x8 kf[2], wf[4];
#pragma unroll
                for (int mi = 0; mi < 2; ++mi) kf[mi] = tr_frag(BT[0][mi] + ktq + (unsigned)(8192 * ks), BT[1][mi] + ktq + (unsigned)(8192 * ks));
#pragma unroll
                for (int cc = 0; cc < 4; ++cc) wf[cc] = TRFRAG(VI, 4 + cc, ks);
                { const f32x4 wa = *(const LAS f32x4*)(sc + SC_WW + 32 * ks + 8 * lg), wb = *(const LAS f32x4*)(sc + SC_WW + 32 * ks + 8 * lg + 4);
                  u32x4 wq; wq.x = pk2(wa[0], wa[1]); wq.y = pk2(wa[2], wa[3]); wq.z = pk2(wb[0], wb[1]); wq.w = pk2(wb[2], wb[3]);
                  if (l15 != 0) wq = (u32x4){0u, 0u, 0u, 0u};
                  const bf16x8 wfn = __builtin_bit_cast(bf16x8, wq);
#pragma unroll
                  for (int mi = 0; mi < 2; ++mi) accN[mi] = mfma16(kf[mi], wfn, accN[mi]); }
#pragma unroll
                for (int mi = 0; mi < 2; ++mi)
#pragma unroll
                    for (int cc = 0; cc < 4; ++cc) accC[mi][cc] = mfma16(kf[mi], wf[cc], accC[mi][cc]);
            }
#pragma unroll
            for (int mi = 0; mi < 2; ++mi)
#pragma unroll
                for (int cc = 0; cc < 4; ++cc) { const int dk0 = 32 * wid + 16 * mi + 4 * lg, dv = 16 * cc + l15; u32x2 w; w.x = pk2(accC[mi][cc][0], accC[mi][cc][1]); w.y = pk2(accC[mi][cc][2], accC[mi][cc][3]);
                    *(LAS u32x2*)(lds + CI + (dk0 >> 7) * 16384 + off_b(dv, (dk0 & 127) >> 3) + (dk0 & 7) * 2) = w; }
            if (l15 == 0) { *(LAS f32x4*)(sc + SC_N + 32 * wid + 4 * lg) = accN[0]; *(LAS f32x4*)(sc + SC_N + 32 * wid + 16 + 4 * lg) = accN[1]; }
            __syncthreads();
            if (ci + 1 < 65) STAGE_WRITE();
        }
    }
#undef ROWG
#undef STAGE_LOAD
#undef STAGE_WRITE
#undef ROWRD
#undef TRFRAG
}
__device__ __forceinline__ void mlstm_phase(int bx, const bf16_t* UQKVO, const float* GP, float* HSUM, LAS unsigned char* lds, LAS float* sc) {
    if (bx >= 192) return;
    const int xcd = bx & 7, idx = bx >> 3, pair = xcd * 6 + (idx >> 2), js = idx & 3;
    mlstm_unit(pair >> 2, pair & 3, js, UQKVO, GP, HSUM, lds, sc);
}
}

#ifndef PHM
#define PHM 0xffff
#endif
#ifndef REP_ML
#define REP_ML 1
#endif
#ifndef REP_ATTN
#define REP_ATTN 1
#endif
#ifndef REP_CONV
#define REP_CONV 1
#endif
#ifndef REP_SMALL
#define REP_SMALL 1
#endif
#ifndef KV_SPLIT
#define KV_SPLIT 193
#endif
#ifndef REP_WIN
#define REP_WIN 1
#endif
#ifndef REP_UP
#define REP_UP 1
#endif
__global__ void __launch_bounds__(512, 2) fwd_kernel(Params P, unsigned char* ws_arg, unsigned char* out_arg) {
    extern __shared__ __attribute__((aligned(16))) unsigned char lds_raw[];
    Frame F;
    F.lds = (LAS unsigned char*)lds_raw;
    F.tid = threadIdx.x; F.lane = F.tid & 63; F.wave = __builtin_amdgcn_readfirstlane(F.tid >> 6);
    F.G = GRID; F.bx = blockIdx.x; F.vcu = (F.bx % 8) * (GRID / 8) + F.bx / 8;
    F.gw = F.vcu * 8 + F.wave; F.ngw = F.G * 8;
    { unsigned char* ws0 = ws_arg;
      for (int u = F.tid; u < (LDS_BYTES - MISC_OFF) / 4; u += 512) ((LAS unsigned*)(F.lds + MISC_OFF))[u] = 0u;
      __syncthreads();
      (void)ws0; }
    LAS unsigned long long* ptab = (LAS unsigned long long*)(F.lds + MISC_OFF + 64);
    if (F.tid == 0) {
#pragma unroll
        for (int k = 0; k < 19; ++k) ptab[k] = (unsigned long long)(uintptr_t)P.in[k]; }
    __syncthreads();
    XcdBarrier bar = xcd_barrier_post((unsigned*)(ws_arg + WS_CTL) + CW_BAR, (volatile LAS unsigned*)(F.lds + MISC_OFF));
    LAS float* sc = (LAS float*)(F.lds + MISC_OFF + 1024);
#define BXL() ({ int b__ = F.bx; asm volatile("" : "+s"(b__)); b__; })
#define PFRAME() Frame Fp = F; { int t_ = threadIdx.x; asm volatile("" : "+v"(t_)); Fp.tid = t_; Fp.lane = t_ & 63; int b_ = BXL(); Fp.bx = b_; Fp.vcu = (b_ % 8) * (GRID / 8) + b_ / 8; Fp.gw = Fp.vcu * 8 + Fp.wave; }
#define WSB() ({ GAS unsigned char* w__ = (GAS unsigned char*)ws_arg; asm volatile("" : "+s"(w__)); (unsigned char*)w__; })
#ifndef STAG_N
#define STAG_N 1
#endif
#ifdef STAG_ON
#define STAGGER() do { int s__ = (BXL() * 37) & 255; for (int i__ = 0; i__ < s__; ++i__) __builtin_amdgcn_s_sleep(STAG_N); } while (0)
#else
#define STAGGER() do {} while (0)
#endif
#define WOFS(l_) (((l_) & 1) ? WSET_DELTA : (size_t)0)
#define DOB() ({ GAS unsigned char* w__ = (GAS unsigned char*)out_arg; asm volatile("" : "+s"(w__)); (unsigned char*)w__; })

    { unsigned char* ws = WSB(); prologue(F, ws, ptab); convert_weights(F, ws, ptab, 0, 0, -1); }
    xcd_barrier(bar);

    for (int l = 0; l < DEPTH; ++l) {
        { unsigned char* ws = WSB();
          pg8::Gemm g{(bf16_t*)(ws + WS_HB), (bf16_t*)(ws + WOFS(l) + WS_WIN), TP, NIN, DM, DM}; pg8::PanelOrder S; S.init(NPAN, 0, 0, 0, NIN, F.G, BXL());
          pg8::EpiWin E{(bf16_t*)(ws + WS_UQKVO), (bf16_t*)(ws + WS_UDQ), (bf16_t*)(ws + WS_UDKV), (bf16_t*)(ws + WS_KR), (float*)(ws + WS_GATES), (const float*)(ws + WS_COS), (const float*)(ws + WS_SIN)};
#if PHM & 2
          STAGGER(); pg8::gemm_phase<pg8::EpiWin, pg8::PanelOrder, true, true>(F.lds, g, S, E);
#endif
        }
        if (l + 1 < DEPTH && BXL() >= 20) { unsigned char* ws = WSB(); PFRAME(); Fp.gw = (Fp.bx - 20) * 8 + Fp.wave; Fp.ngw = (GRID - 20) * 8; convert_weights(Fp, ws, ptab, l + 1, WOFS(l + 1), 0); }
#if REP_WIN > 1
        __syncthreads();
        { unsigned char* ws = WSB();
          pg8::Gemm g{(bf16_t*)(ws + WS_HB), (bf16_t*)(ws + WOFS(l) + WS_WIN), TP, NIN, DM, DM}; pg8::PanelOrder S; S.init(NPAN, 0, 0, 0, NIN, F.G, BXL());
          pg8::EpiWin E{(bf16_t*)(ws + WS_UQKVO), (bf16_t*)(ws + WS_UDQ), (bf16_t*)(ws + WS_UDKV), (bf16_t*)(ws + WS_KR), (float*)(ws + WS_GATES), (const float*)(ws + WS_COS), (const float*)(ws + WS_SIN)};
          pg8::gemm_phase<pg8::EpiWin, pg8::PanelOrder, true, true>(F.lds, g, S, E);
        }
#endif
        xcd_barrier(bar);
        { unsigned char* ws = WSB(); unsigned char* dob = DOB(); PFRAME(); rstd_rows(Fp, (bf16_t*)(ws + WS_UDQ), (bf16_t*)(ws + WS_UDKV), (float*)(ws + WS_RSTD));
          ml::gate_prep(Fp.gw, Fp.ngw, Fp.lane, (const float*)(ws + WS_GATES), (const float*)(ws + WS_PAR) + PO_BG + l * 16, (float*)(dob + DO_GP)); }
#if REP_SMALL > 1
        { unsigned char* ws = WSB(); unsigned char* dob = DOB(); PFRAME(); rstd_rows(Fp, (bf16_t*)(ws + WS_UDQ), (bf16_t*)(ws + WS_UDKV), (float*)(ws + WS_RSTD));
          ml::gate_prep(Fp.gw, Fp.ngw, Fp.lane, (const float*)(ws + WS_GATES), (const float*)(ws + WS_PAR) + PO_BG + l * 16, (float*)(dob + DO_GP)); }
#endif
        xcd_barrier(bar);
        if (F.bx >= 192) {
        { unsigned char* ws = WSB(); unsigned char* dob = DOB();
          pg8::Gemm g{(bf16_t*)(ws + WS_UDQ), (bf16_t*)(ws + WOFS(l) + WS_WUQ), TP, NQ, 512, 512}; pg8::PanelOrder S; S.init(NPAN, 0, 0, 0, NQ, GRID - 192, BXL() - 192);
          pg8::EpiQ E{(bf16_t*)(dob + DO_MQ), (const float*)(ws + WS_RSTD), (const float*)(ws + WS_COS), (const float*)(ws + WS_SIN)};
#if PHM & 4
          pg8::gemm_phase<pg8::EpiQ, pg8::PanelOrder, true, true>(F.lds, g, S, E);
#endif
        }
        { unsigned char* ws = WSB();
          pg8::Gemm g{(bf16_t*)(ws + WS_UDKV), (bf16_t*)(ws + WOFS(l) + WS_WUKV), TP, NKV, 256, 256}; pg8::PanelOrder S; S.init(NPAN, 0, 0, 0, NKV, GRID - 192, BXL() - 192);
          pg8::EpiBf16G E{(bf16_t*)(ws + WS_MKV), NKV, (const float*)(ws + WS_RSTD) + 1, 0, -1, 0};
#if PHM & 8
          pg8::gemm_phase<pg8::EpiBf16G, pg8::PanelOrder, true, true>(F.lds, g, S, E);
#endif
        }
        } else {
#ifndef NO_ML
        for (int rep_ = 0; rep_ < REP_ML; ++rep_)
        { unsigned char* ws = WSB(); unsigned char* dob = DOB();
          ml::mlstm_phase(BXL(), (const bf16_t*)(ws + WS_UQKVO), (const float*)(dob + DO_GP), (float*)(dob + DO_HSUM), F.lds, sc); }
#endif
        }
        xcd_barrier(bar);
        { unsigned char* ws = WSB(); unsigned char* dob = DOB(); PFRAME();
          if (Fp.vcu >= 96) mlstm_finalize(Fp, (Fp.vcu - 96) * 8 + Fp.wave, (GRID - 96) * 8, (const float*)(dob + DO_HSUM), (const bf16_t*)(ws + WS_UQKVO), (const float*)(ws + WS_PAR) + PO_MLG + l * MLW, (bf16_t*)(ws + WS_HB)); }
#ifndef NO_ATTN
        for (int rep_ = 0; rep_ < REP_ATTN; ++rep_)
        { unsigned char* ws = WSB(); unsigned char* dob = DOB();
          att::attn_phase(({ int b__ = BXL(); (b__ % 8) * (GRID / 8) + b__ / 8; }), (const bf16_t*)(dob + DO_MQ), (const bf16_t*)(ws + WS_MKV), (const bf16_t*)(ws + WS_KR), (bf16_t*)(ws + WS_HB), (LAS char*)F.lds); }
#endif
        xcd_barrier(bar);
        { unsigned char* ws = WSB();
          pg8::Gemm g{(bf16_t*)(ws + WS_HB), (bf16_t*)(ws + WOFS(l) + WS_WOUT), TP, DM, DM, DM}; pg8::PanelOrder S; S.init(192, 0, 0, 0, DM, F.G, BXL());
          pg8::EpiResidLn E{(bf16_t*)(ws + WS_H), DM, ALPHA, (const float*)(ws + WS_STAT2), (const float*)(ws + WS_PAR) + (l > 0 ? PO_L2G + (l - 1) * DM : PO_ONE), (const float*)(ws + WS_PAR) + (l > 0 ? PO_L2B + (l - 1) * DM : PO_ZERO)};
#if PHM & 16
          STAGGER(); pg8::gemm_phase<pg8::EpiResidLn, pg8::PanelOrder, true, true>(F.lds, g, S, E);
#endif
        }
        { unsigned char* ws = WSB();
          pg8::Gemm g{(bf16_t*)(ws + WS_HB), (bf16_t*)(ws + WOFS(l) + WS_WOUT), TP, DM, DM / 4, DM}; pg8::SplitOrder S; S.init(PMETA, DM, 4, F.G, BXL());
          pg8::EpiPart E{(float*)(ws + WS_PART), DM};
#if PHM & 16
          pg8::gemm_phase<pg8::EpiPart, pg8::SplitOrder, true, true>(F.lds, g, S, E);
#endif
        }
        xcd_barrier(bar);
        { unsigned char* ws = WSB(); PFRAME(); ln_rows(Fp, (float*)(ws + WS_H), (bf16_t*)(ws + WS_HB), (const float*)(ws + WS_PAR) + PO_L1G + l * DM, (const float*)(ws + WS_PAR) + PO_L1B + l * DM, (float*)(ws + WS_STAT1), nullptr, (const float*)(ws + WS_PART), 4); }
        xcd_barrier(bar);
        { unsigned char* ws = WSB(); unsigned char* dob = DOB();
          pg8::Gemm g{(bf16_t*)(ws + WS_HB), (bf16_t*)(ws + WOFS(l) + WS_WUP), TP, NUP, DM, DM}; pg8::PanelOrder S; S.init(NPAN, 0, 0, 0, NUP, F.G, BXL());
          pg8::EpiFfn E{(bf16_t*)(ws + WS_ACT), (float*)(dob + DO_SIDE), (bf16_t*)(dob + DO_GVM), (const float*)(ws + WS_PAR) + PO_CW + (size_t)l * 3 * DFF, (const float*)(ws + WS_PAR) + PO_CB + (size_t)l * DFF, (LAS float*)(F.lds + MISC_OFF + 8192)};
#if PHM & 32
          STAGGER(); pg8::gemm_phase<pg8::EpiFfn, pg8::PanelOrder, true, true>(F.lds, g, S, E);
#if REP_UP > 1
          __syncthreads(); pg8::gemm_phase<pg8::EpiFfn, pg8::PanelOrder, true, true>(F.lds, g, S, E);
#endif
#endif
        }
        if (l + 1 < DEPTH && BXL() >= 44) { unsigned char* ws = WSB(); PFRAME(); Fp.gw = (Fp.bx - 44) * 8 + Fp.wave; Fp.ngw = (GRID - 44) * 8; convert_weights(Fp, ws, ptab, l + 1, WOFS(l + 1), 1); }
        xcd_barrier(bar);
        { unsigned char* ws = WSB(); unsigned char* dob = DOB(); PFRAME();
          ffn_fixup(Fp, (const float*)(dob + DO_SIDE), (const bf16_t*)(dob + DO_GVM), (bf16_t*)(ws + WS_ACT), (const float*)(ws + WS_PAR) + PO_CW + (size_t)l * 3 * DFF, (const float*)(ws + WS_PAR) + PO_CB + (size_t)l * DFF, l + 1 < DEPTH); }
#if REP_SMALL > 1
        { unsigned char* ws = WSB(); unsigned char* dob = DOB(); PFRAME();
          ffn_fixup(Fp, (const float*)(dob + DO_SIDE), (const bf16_t*)(dob + DO_GVM), (bf16_t*)(ws + WS_ACT), (const float*)(ws + WS_PAR) + PO_CW + (size_t)l * 3 * DFF, (const float*)(ws + WS_PAR) + PO_CB + (size_t)l * DFF, l + 1 < DEPTH); }
#endif
        xcd_barrier(bar);
        { unsigned char* ws = WSB();
          pg8::Gemm g{(bf16_t*)(ws + WS_ACT), (bf16_t*)(ws + WOFS(l) + WS_WDN), TP, DM, DFF, DFF}; pg8::PanelOrder S; S.init(192, 0, 0, 0, DM, F.G, BXL());
          pg8::EpiResidLn E{(bf16_t*)(ws + WS_H), DM, ALPHA, (const float*)(ws + WS_STAT1), (const float*)(ws + WS_PAR) + PO_L1G + l * DM, (const float*)(ws + WS_PAR) + PO_L1B + l * DM};
#if PHM & 64
          STAGGER(); pg8::gemm_phase<pg8::EpiResidLn, pg8::PanelOrder, true, true>(F.lds, g, S, E);
#endif
        }
        if (l + 1 < DEPTH)
        { unsigned char* ws = WSB();
          pg8::Gemm g{(bf16_t*)(ws + WS_ACT), (bf16_t*)(ws + WOFS(l) + WS_WDN), TP, DM, DFF / 11, DFF}; pg8::SplitOrder S; S.init(PMETA, DM, 11, F.G, BXL());
          pg8::EpiPart E{(float*)(ws + WS_PART), DM};
#if PHM & 64
          pg8::gemm_phase<pg8::EpiPart, pg8::SplitOrder, true, true>(F.lds, g, S, E);
#endif
        }
        xcd_barrier(bar);
        { unsigned char* ws = WSB(); unsigned char* dob = DOB();
          PFRAME(); ln_rows(Fp, (float*)(ws + WS_H), (bf16_t*)(ws + WS_HB), (const float*)(ws + WS_PAR) + PO_L2G + l * DM, (const float*)(ws + WS_PAR) + PO_L2B + l * DM, (float*)(ws + WS_STAT2), l == DEPTH - 1 ? (float*)dob : nullptr, (const float*)(ws + WS_PART), l + 1 < DEPTH ? 11 : -1); }
#if REP_CONV > 1
#endif
        xcd_barrier(bar);
    }
}

extern "C" void kernel_launch(void* const* d_in, const int* in_sizes, int n_in, void* d_out, int out_size, void* d_ws, size_t ws_size, hipStream_t stream) {
    static int grid = 0;
    if (grid == 0) {
        if (n_in != 19 || out_size != NMAIN * DM || ws_size < WS_NEED) { fprintf(stderr, "kernel_launch: unexpected shapes (n_in %d out %d ws %zu need %zu)\n", n_in, out_size, ws_size, (size_t)WS_NEED); grid = -1; return; }
        int dev = 0, cus = 0;
        if (hipGetDevice(&dev) != hipSuccess || hipDeviceGetAttribute(&cus, hipDeviceAttributeMultiprocessorCount, dev) != hipSuccess) { grid = -1; return; }
        if (hipFuncSetAttribute((const void*)fwd_kernel, hipFuncAttributeMaxDynamicSharedMemorySize, LDS_BYTES) != hipSuccess) { fprintf(stderr, "kernel_launch: hipFuncSetAttribute failed\n"); grid = -1; return; }
        int per_cu = 0;
        if (hipOccupancyMaxActiveBlocksPerMultiprocessor(&per_cu, (const void*)fwd_kernel, 512, LDS_BYTES) != hipSuccess || per_cu < 1) { fprintf(stderr, "kernel_launch: occupancy query says %d blocks per CU\n", per_cu); (void)hipGetLastError(); grid = -1; return; }
        if (cus < GRID) { fprintf(stderr, "kernel_launch: needs %d CUs, device has %d\n", GRID, cus); grid = -1; return; }
        grid = GRID;
    }
    if (grid < 0) return;
    (void)hipMemsetAsync((char*)d_ws + WS_CTL, 0, CTL_BYTES, stream);
    Params p{};
    for (int i = 0; i < 19; ++i) p.in[i] = (const float*)d_in[i];
    hipLaunchKernelGGL(fwd_kernel, dim3(grid), dim3(512), LDS_BYTES, stream, p, (unsigned char*)d_ws, (unsigned char*)d_out);
}
```
